# Optimizing an MI355X kernel written in HIP

```python
import math
import jax
import jax.numpy as jnp
from jax import lax
import numpy as np

D_MODEL = 2048
BATCH = 4
SEQ = 4096
DEPTH = 2

GRID_W = 64
CTX_LEN = 256

DN_ALPHA = (2 * DEPTH) ** 0.25
DN_BETA = (8 * DEPTH) ** -0.25
N_SUB = 3
N_MOD = 3 * N_SUB
FFN_HALF = 0.5
D_FF = 5632
LN_EPS = 1e-5
RMS_EPS = 1e-6

BRANCH_W = D_MODEL // 2
N_BRANCH = 3

ATT_DH = 64
ATT_DV = 2 * ATT_DH
ATT_HEADS = BRANCH_W // ATT_DV
ATT_QK_W = ATT_HEADS * 2 * ATT_DH
ATT_BLOCK = 128
ROPE_BASE = 10000.0
ROPE_FREQS = ATT_DH // 4
LAMBDA_INIT_BASE = 0.8
LAMBDA_INIT_SPAN = 0.6
LAMBDA_INIT_RATE = 0.3

SSD_P = 64
SSD_HEADS = BRANCH_W // SSD_P
SSD_GROUPS = 4
SSD_HPG = SSD_HEADS // SSD_GROUPS
SSD_N = 128
SSD_CONV = 5
SSD_CHUNK = 128
SSD_INNER = SSD_HEADS * SSD_P
SSD_BC_W = SSD_GROUPS * SSD_N
SSD_XBC_W = SSD_INNER + 2 * SSD_BC_W
SSD_NORM_GROUP = SSD_INNER // SSD_GROUPS

S5_CH = BRANCH_W
S5_GROUP_CH = 16
S5_GROUPS = S5_CH // S5_GROUP_CH
S5_N = 64

IN_SPLITS = (ATT_QK_W, ATT_QK_W, ATT_HEADS * ATT_DV, SSD_INNER, SSD_XBC_W,
             2 * SSD_HEADS, S5_CH, N_BRANCH * D_MODEL)
IN_COLS = sum(IN_SPLITS)

kernel_name = "hybrid_diffattn_ssd_s5_dit_trunk"


def split_cols(t, sizes):
    cuts = [int(v) for v in np.cumsum(sizes)[:-1]]
    return jnp.split(t, cuts, axis=-1)


def flip_time(t, direction):
    return jnp.flip(t, axis=1) if direction else t


def layer_norm(t, g, b):
    tf = t.astype(jnp.float32)
    mu = jnp.mean(tf, axis=-1, keepdims=True)
    var = jnp.mean(jnp.square(tf - mu), axis=-1, keepdims=True)
    return ((tf - mu) * lax.rsqrt(var + LN_EPS) * g + b).astype(t.dtype)


def rms_norm(t, w):
    tf = t.astype(jnp.float32)
    return (tf * lax.rsqrt(jnp.mean(jnp.square(tf), axis=-1, keepdims=True) + RMS_EPS) * w).astype(t.dtype)


def swiglu(h, w1, w3, w2):
    return (jax.nn.silu(h @ w1) * (h @ w3)) @ w2


def adaln(m, j):
    return m[..., 3 * j, :], m[..., 3 * j + 1, :], m[..., 3 * j + 2, :]


def modulate(t, shift, scale):
    return t * (1.0 + scale) + shift


def post_norm(t, update, g, b):
    return layer_norm(DN_ALPHA * t + update, g, b)


def half_ffn(t, m, j, w1, w3, w2, g, b):
    shift, scale, gate = adaln(m, j)
    return post_norm(t, FFN_HALF * gate * swiglu(modulate(t, shift, scale), w1, w3, w2), g, b)


def axial_rope_tables(seq_len):
    rows = seq_len // GRID_W
    row = jnp.repeat(jnp.arange(rows), GRID_W)
    col = jnp.tile(jnp.arange(GRID_W), rows)
    inv = ROPE_BASE ** (-jnp.arange(ROPE_FREQS, dtype=jnp.float32) / ROPE_FREQS)
    ang = jnp.stack([row[:, None] * inv, col[:, None] * inv], axis=1)
    return jnp.cos(ang), jnp.sin(ang)


def apply_axial_rope(t, cos, sin):
    tr = t.astype(jnp.float32).reshape(*t.shape[:-1], 2, 2, ROPE_FREQS)
    t1, t2 = tr[..., 0, :], tr[..., 1, :]
    cs, sn = cos[:, None, None], sin[:, None, None]
    out = jnp.stack([t1 * cs - t2 * sn, t2 * cs + t1 * sn], axis=-2)
    return out.reshape(t.shape).astype(t.dtype)


def diff_attention(q, k, v, qc, kc, vc, lam_vec, subln_w, lam_init):
    bsz, seq = q.shape[:2]
    cos, sin = axial_rope_tables(seq)
    q = apply_axial_rope(q, cos, sin)
    k = apply_axial_rope(k, cos, sin)
    lv = lam_vec.astype(jnp.float32)
    lam = jnp.exp(jnp.sum(lv[0] * lv[1])) - jnp.exp(jnp.sum(lv[2] * lv[3])) + lam_init
    k_all = jnp.concatenate([kc, k], axis=1)
    v_all = jnp.concatenate([vc, v], axis=1)

    def attend(qb, kk, vv):
        s = jnp.einsum('bqhjd,bkhjd->bhjqk', qb, kk, preferred_element_type=jnp.float32) * (ATT_DH ** -0.5)
        p = jax.nn.softmax(s, axis=-1)
        a = p[:, :, 0] - lam * p[:, :, 1]
        return jnp.einsum('bhqk,bkhe->bqhe', a.astype(vv.dtype), vv)

    n_blk = seq // ATT_BLOCK
    q_blocks = q.reshape(bsz, n_blk, ATT_BLOCK, ATT_HEADS, 2, ATT_DH).swapaxes(0, 1)
    o = lax.map(lambda qb: attend(qb, k_all, v_all), q_blocks)
    o = o.swapaxes(0, 1).reshape(bsz, seq, ATT_HEADS, ATT_DV)
    oc = attend(qc, kc, vc)

    def heads_out(t):
        return (rms_norm(t, subln_w) * (1.0 - lam_init)).reshape(*t.shape[:2], ATT_HEADS * ATT_DV)

    return heads_out(o), heads_out(oc)


def dwconv_centred(u, w, b):
    out = lax.conv_general_dilated(
        u, w[:, None, :].astype(u.dtype), window_strides=(1,),
        padding=((SSD_CONV // 2, SSD_CONV // 2),),
        dimension_numbers=('NWC', 'WIO', 'NWC'), feature_group_count=u.shape[-1])
    return out + b.astype(u.dtype)


def ssd_chunked(xs, dt, a, bm, cm, h0):
    bsz, T, G, E, P = xs.shape
    N = bm.shape[-1]
    L = SSD_CHUNK
    nc = T // L
    f32 = jnp.float32
    xdt = (xs.astype(f32) * dt[..., None]).reshape(bsz, nc, L, G, E, P)
    bc = bm.astype(f32).reshape(bsz, nc, L, G, N)
    cc = cm.astype(f32).reshape(bsz, nc, L, G, N)
    da = (dt * a).reshape(bsz, nc, L, G, E).transpose(0, 1, 3, 4, 2)
    da_cs = jnp.cumsum(da, axis=-1)
    seg = da_cs[..., :, None] - da_cs[..., None, :]
    lower = jnp.tril(jnp.ones((L, L), dtype=bool))
    decay = jnp.where(lower, jnp.exp(jnp.where(lower, seg, 0.0)), 0.0)
    cb = jnp.einsum('bclgn,bcsgn->bcgls', cc, bc)
    y_diag = jnp.einsum('bcgels,bcsgep->bclgep', cb[:, :, :, None] * decay, xdt)
    to_end = jnp.exp(da_cs[..., -1:] - da_cs).transpose(0, 1, 4, 2, 3)
    states = jnp.einsum('bclgn,bclgep->bcgepn', bc, xdt * to_end[..., None])
    chunk_decay = jnp.exp(da_cs[..., -1])

    def carry_step(h, inp):
        dec, st = inp
        return h * dec[..., None, None] + st, h

    h_last, h_prev = lax.scan(carry_step, h0.astype(f32),
                              (chunk_decay.swapaxes(0, 1), states.swapaxes(0, 1)))
    h_prev = h_prev.swapaxes(0, 1)
    from_start = jnp.exp(da_cs).transpose(0, 1, 4, 2, 3)[..., None]
    y_off = jnp.einsum('bclgn,bcgepn->bclgep', cc, h_prev) * from_start
    return (y_diag + y_off).reshape(bsz, T, G, E, P), h_last


def mamba2_mixer(z, xbc, dt, zc, xbcc, dtc, conv_w, conv_b, a_log, dt_bias, d_skip, norm_w):
    f32 = jnp.float32
    a = -jnp.exp(a_log.astype(f32)).reshape(2, SSD_GROUPS, SSD_HPG)
    dsk = d_skip.astype(f32).reshape(SSD_GROUPS, SSD_HPG, 1)

    def prep(xbc_t, dt_t):
        bsz, T = xbc_t.shape[:2]
        xbc_t = jax.nn.silu(dwconv_centred(xbc_t, conv_w, conv_b))
        xs, bm, cm = split_cols(xbc_t, (SSD_INNER, SSD_BC_W, SSD_BC_W))
        xs = xs.reshape(bsz, T, SSD_GROUPS, SSD_HPG, SSD_P)
        bm = bm.reshape(bsz, T, SSD_GROUPS, SSD_N)
        cm = cm.reshape(bsz, T, SSD_GROUPS, SSD_N)
        dts = jax.nn.softplus(dt_t.astype(f32).reshape(bsz, T, 2, SSD_GROUPS, SSD_HPG)
                              + dt_bias.astype(f32).reshape(2, SSD_GROUPS, SSD_HPG))
        return xs, bm, cm, dts

    xs, bm, cm, dts = prep(xbc, dt)
    xsc, bmc, cmc, dtsc = prep(xbcc, dtc)
    y = xs.astype(f32) * dsk
    yc = xsc.astype(f32) * dsk
    h0 = jnp.zeros((xs.shape[0], SSD_GROUPS, SSD_HPG, SSD_P, SSD_N), f32)
    for direction in range(2):
        fl = lambda t: flip_time(t, direction)
        y_c, h_c = ssd_chunked(fl(xsc), fl(dtsc[:, :, direction]), a[direction], fl(bmc), fl(cmc), h0)
        y_l, _ = ssd_chunked(fl(xs), fl(dts[:, :, direction]), a[direction], fl(bm), fl(cm), h_c)
        yc = yc + fl(y_c)
        y = y + fl(y_l)

    def gate_norm(y_t, z_t):
        bsz, T = z_t.shape[:2]
        gated = y_t.reshape(bsz, T, SSD_INNER) * jax.nn.silu(z_t.astype(f32))
        normed = rms_norm(gated.reshape(bsz, T, SSD_GROUPS, SSD_NORM_GROUP),
                          norm_w.reshape(SSD_GROUPS, SSD_NORM_GROUP))
        return normed.reshape(bsz, T, SSD_INNER).astype(z_t.dtype)

    return gate_norm(y, z), gate_norm(yc, zc)


def complex_affine_combine(e1, e2):
    a1r, a1i, b1r, b1i = e1
    a2r, a2i, b2r, b2i = e2
    return (a1r * a2r - a1i * a2i, a1r * a2i + a1i * a2r,
            a2r * b1r - a2i * b1i + b2r, a2r * b1i + a2i * b1r + b2i)


def s5_scan(u, lam_re, lam_im, log_step, b_re, b_im, c_re, c_im, h0_re, h0_im):
    T = u.shape[1]
    step = jnp.exp(log_step)[:, None]
    mag = jnp.exp(lam_re * step)
    ang = lam_im * step
    ab_re, ab_im = mag * jnp.cos(ang), mag * jnp.sin(ang)
    den = lam_re * lam_re + lam_im * lam_im
    k_re = ((ab_re - 1.0) * lam_re + ab_im * lam_im) / den
    k_im = (ab_im * lam_re - (ab_re - 1.0) * lam_im) / den
    bb_re = k_re[..., None] * b_re - k_im[..., None] * b_im
    bb_im = k_re[..., None] * b_im + k_im[..., None] * b_re
    bu_re = jnp.einsum('btgh,gnh->btgn', u, bb_re)
    bu_im = jnp.einsum('btgh,gnh->btgn', u, bb_im)
    a_re = jnp.broadcast_to(ab_re, (1, T) + ab_re.shape)
    a_im = jnp.broadcast_to(ab_im, (1, T) + ab_im.shape)
    p_re, p_im, h_re, h_im = lax.associative_scan(
        complex_affine_combine, (a_re, a_im, bu_re, bu_im), axis=1)
    h_re, h_im = (h_re + p_re * h0_re[:, None] - p_im * h0_im[:, None],
                  h_im + p_re * h0_im[:, None] + p_im * h0_re[:, None])
    y = jnp.einsum('btgn,ghn->btgh', h_re, c_re) - jnp.einsum('btgn,ghn->btgh', h_im, c_im)
    return y, h_re[:, -1], h_im[:, -1]


def s5_mixer(u, uc, lam_re, lam_im, log_step, b_re, b_im, c_re, c_im, d_skip, glu_w, glu_b):
    f32 = jnp.float32
    grp = lambda t: t.astype(f32).reshape(*t.shape[:2], S5_GROUPS, S5_GROUP_CH)
    ug, ucg = grp(u), grp(uc)
    dsk = d_skip.astype(f32).reshape(S5_GROUPS, S5_GROUP_CH)
    y, yc = ug * dsk, ucg * dsk
    zeros = jnp.zeros((u.shape[0], S5_GROUPS, S5_N), f32)
    for direction in range(2):
        fl = lambda t: flip_time(t, direction)
        prm = [t[direction].astype(f32) for t in (lam_re, lam_im, log_step, b_re, b_im, c_re, c_im)]
        y_c, hc_re, hc_im = s5_scan(fl(ucg), *prm, zeros, zeros)
        y_l, _, _ = s5_scan(fl(ug), *prm, hc_re, hc_im)
        yc = yc + fl(y_c)
        y = y + fl(y_l)

    def glu(t):
        t = jax.nn.gelu(t.reshape(*t.shape[:2], S5_CH))
        return (t * jax.nn.sigmoid(t @ glu_w + glu_b)).astype(u.dtype)

    return glu(y), glu(yc)


def token_mixer(h, hc, w_in, att_lam, att_subln, lam_init, conv_w, conv_b, a_log, dt_bias,
                ssd_d, ssd_norm, lam_re, lam_im, log_step, b_re, b_im, c_re, c_im,
                s5_d, glu_w, glu_b, w_branch, w_out):
    q, k, v, z, xbc, dt, u, g = split_cols(h @ w_in, IN_SPLITS)
    qc, kc, vc, zc, xbcc, dtc, uc, gc = split_cols(hc @ w_in, IN_SPLITS)
    qk_heads = lambda t: t.reshape(*t.shape[:2], ATT_HEADS, 2, ATT_DH)
    v_heads = lambda t: t.reshape(*t.shape[:2], ATT_HEADS, ATT_DV)
    o_att, oc_att = diff_attention(qk_heads(q), qk_heads(k), v_heads(v),
                                   qk_heads(qc), qk_heads(kc), v_heads(vc),
                                   att_lam, att_subln, lam_init)
    o_ssd, oc_ssd = mamba2_mixer(z, xbc, dt, zc, xbcc, dtc, conv_w, conv_b, a_log, dt_bias, ssd_d, ssd_norm)
    o_s5, oc_s5 = s5_mixer(u, uc, lam_re, lam_im, log_step, b_re, b_im, c_re, c_im, s5_d, glu_w, glu_b)

    def merge(branches, gate_logits):
        br = jnp.stack([t.astype(gate_logits.dtype) for t in branches], axis=-2)
        gates = jax.nn.sigmoid(gate_logits.reshape(*gate_logits.shape[:-1], N_BRANCH, D_MODEL))
        mixed = jnp.sum(gates * jnp.einsum('btjc,jcd->btjd', br, w_branch), axis=-2)
        return mixed @ w_out

    return merge((o_att, o_ssd, o_s5), g), merge((oc_att, oc_ssd, oc_s5), gc)


def setup_inputs(seed: int = 0) -> dict:
    key = jax.random.key(seed)
    keys = jax.random.split(key, 40)
    kit = iter(range(40))
    f32 = jnp.float32
    L, D = DEPTH, D_MODEL

    def nrm(shape, scale):
        return jax.random.normal(keys[next(kit)], shape, f32) * scale

    def unif(shape, lo, hi):
        return jax.random.uniform(keys[next(kit)], shape, f32, lo, hi)

    x = nrm((BATCH, SEQ, D), 1.0)
    c = nrm((BATCH, D), 1.0)
    ctx = nrm((BATCH, CTX_LEN, D), 1.0)
    c_ctx = nrm((D,), 1.0)
    w_mod = nrm((L, D, N_MOD * D), D ** -0.5)
    b_mod = nrm((L, N_MOD * D), 0.01)
    ln_g = 1.0 + nrm((L, N_SUB, D), 0.02)
    ln_b = nrm((L, N_SUB, D), 0.02)
    ffn_w1 = nrm((L, 2, D, D_FF), D ** -0.5)
    ffn_w3 = nrm((L, 2, D, D_FF), D ** -0.5)
    ffn_w2 = nrm((L, 2, D_FF, D), DN_BETA * D_FF ** -0.5)
    w_in = nrm((L, D, IN_COLS), D ** -0.5)
    att_lam = nrm((L, 4, ATT_DH), 0.1)
    att_subln = 1.0 + nrm((L, ATT_DV), 0.02)
    ssd_conv_w = nrm((L, SSD_CONV, SSD_XBC_W), SSD_CONV ** -0.5)
    ssd_conv_b = nrm((L, SSD_XBC_W), 0.01)
    ssd_a_log = jnp.log(unif((L, 2, SSD_HEADS), 1.0, 16.0))
    dt0 = jnp.exp(unif((L, 2, SSD_HEADS), math.log(1e-3), math.log(1e-1)))
    ssd_dt_bias = dt0 + jnp.log(-jnp.expm1(-dt0))
    ssd_d = 1.0 + nrm((L, SSD_HEADS), 0.02)
    ssd_norm = 1.0 + nrm((L, SSD_INNER), 0.02)
    s5_lam_re = -0.5 * jnp.exp(nrm((L, 2, S5_GROUPS, S5_N), 0.02))
    s5_lam_im = math.pi * jnp.arange(S5_N, dtype=f32) + nrm((L, 2, S5_GROUPS, S5_N), 0.01)
    s5_log_step = unif((L, 2, S5_GROUPS), math.log(1e-3), math.log(1e-1))
    s5_b_re = nrm((L, 2, S5_GROUPS, S5_N, S5_GROUP_CH), (2 * S5_GROUP_CH) ** -0.5)
    s5_b_im = nrm((L, 2, S5_GROUPS, S5_N, S5_GROUP_CH), (2 * S5_GROUP_CH) ** -0.5)
    s5_c_re = nrm((L, 2, S5_GROUPS, S5_GROUP_CH, S5_N), S5_N ** -0.5)
    s5_c_im = nrm((L, 2, S5_GROUPS, S5_GROUP_CH, S5_N), S5_N ** -0.5)
    s5_d = nrm((L, S5_CH), 1.0)
    s5_glu_w = nrm((L, S5_CH, S5_CH), S5_CH ** -0.5)
    s5_glu_b = nrm((L, S5_CH), 0.01)
    w_branch = nrm((L, N_BRANCH, BRANCH_W, D), DN_BETA * BRANCH_W ** -0.5)
    w_out = nrm((L, D, D), DN_BETA * D ** -0.5)
    return {"x": x, "c": c, "ctx": ctx, "c_ctx": c_ctx, "w_mod": w_mod, "b_mod": b_mod,
            "ln_g": ln_g, "ln_b": ln_b, "ffn_w1": ffn_w1, "ffn_w3": ffn_w3, "ffn_w2": ffn_w2,
            "w_in": w_in, "att_lam": att_lam, "att_subln": att_subln,
            "ssd_conv_w": ssd_conv_w, "ssd_conv_b": ssd_conv_b, "ssd_a_log": ssd_a_log,
            "ssd_dt_bias": ssd_dt_bias, "ssd_d": ssd_d, "ssd_norm": ssd_norm,
            "s5_lam_re": s5_lam_re, "s5_lam_im": s5_lam_im, "s5_log_step": s5_log_step,
            "s5_b_re": s5_b_re, "s5_b_im": s5_b_im, "s5_c_re": s5_c_re, "s5_c_im": s5_c_im,
            "s5_d": s5_d, "s5_glu_w": s5_glu_w, "s5_glu_b": s5_glu_b,
            "w_branch": w_branch, "w_out": w_out}


def reference(x, c, ctx, c_ctx, w_mod, b_mod, ln_g, ln_b, ffn_w1, ffn_w3, ffn_w2, w_in,
              att_lam, att_subln, ssd_conv_w, ssd_conv_b, ssd_a_log, ssd_dt_bias, ssd_d, ssd_norm,
              s5_lam_re, s5_lam_im, s5_log_step, s5_b_re, s5_b_im, s5_c_re, s5_c_im,
              s5_d, s5_glu_w, s5_glu_b, w_branch, w_out):
    h, hc = x, ctx
    for i in range(DEPTH):
        mod = (jax.nn.silu(c) @ w_mod[i] + b_mod[i]).reshape(c.shape[0], 1, N_MOD, D_MODEL)
        mod_c = (jax.nn.silu(c_ctx) @ w_mod[i] + b_mod[i]).reshape(N_MOD, D_MODEL)
        lam_init = LAMBDA_INIT_BASE - LAMBDA_INIT_SPAN * math.exp(-LAMBDA_INIT_RATE * i)
        h = half_ffn(h, mod, 0, ffn_w1[i, 0], ffn_w3[i, 0], ffn_w2[i, 0], ln_g[i, 0], ln_b[i, 0])
        hc = half_ffn(hc, mod_c, 0, ffn_w1[i, 0], ffn_w3[i, 0], ffn_w2[i, 0], ln_g[i, 0], ln_b[i, 0])
        sh, sc, gt = adaln(mod, 1)
        shc, scc, gtc = adaln(mod_c, 1)
        y, yc = token_mixer(modulate(h, sh, sc), modulate(hc, shc, scc), w_in[i],
                            att_lam[i], att_subln[i], lam_init,
                            ssd_conv_w[i], ssd_conv_b[i], ssd_a_log[i], ssd_dt_bias[i], ssd_d[i], ssd_norm[i],
                            s5_lam_re[i], s5_lam_im[i], s5_log_step[i], s5_b_re[i], s5_b_im[i],
                            s5_c_re[i], s5_c_im[i], s5_d[i], s5_glu_w[i], s5_glu_b[i],
                            w_branch[i], w_out[i])
        h = post_norm(h, gt * y, ln_g[i, 1], ln_b[i, 1])
        h = half_ffn(h, mod, 2, ffn_w1[i, 1], ffn_w3[i, 1], ffn_w2[i, 1], ln_g[i, 2], ln_b[i, 2])
        if i + 1 < DEPTH:
            hc = post_norm(hc, gtc * yc, ln_g[i, 1], ln_b[i, 1])
            hc = half_ffn(hc, mod_c, 2, ffn_w1[i, 1], ffn_w3[i, 1], ffn_w2[i, 1], ln_g[i, 2], ln_b[i, 2])
    return h
```

```cpp
#include <hip/hip_runtime.h>
#include <hip/hip_bf16.h>
#include <cstdio>
#include <cstdint>
#include <cmath>

#ifndef MK_PER_PHASE
#define MK_PER_PHASE 0
#endif

#define LAS __attribute__((address_space(3)))
#define GAS __attribute__((address_space(1)))
typedef unsigned short bf16_t;
typedef short bf16x8 __attribute__((ext_vector_type(8)));
typedef float f32x4 __attribute__((ext_vector_type(4)));
typedef float f32x2 __attribute__((ext_vector_type(2)));
typedef float f32x16 __attribute__((ext_vector_type(16)));
typedef unsigned u32x4 __attribute__((ext_vector_type(4)));
typedef unsigned u32x2 __attribute__((ext_vector_type(2)));
typedef short s16x4 __attribute__((ext_vector_type(4)));

constexpr int NB = 4, SEQ = 4096, CTX = 256, RB = SEQ + CTX  , R = NB * RB  , NPAN = R / 256  , PPB = RB / 256  ;
constexpr int D = 2048, DFF = 5632, N13 = 2 * DFF, NMOD = 9 * D  ;
constexpr int LDP = 13312;
constexpr int NIN = 13568;
constexpr int PQ = 0, PK = 1024, PV = 2048, PZ = 3072, PX = 4096, PU = 6144, PG = 7168;
constexpr float DN_ALPHA = 1.41421356237309515f;
constexpr float LN_EPS = 1e-5f, RMS_EPS = 1e-6f;
constexpr float QSCALE = 0.125f * 1.4426950408889634f;

constexpr size_t MiB = 1u << 20;
constexpr size_t WS_CTL = 0, CTL_ZERO_BYTES = 1 * MiB;
constexpr size_t WS_MOD = 1 * MiB;
constexpr size_t WS_ROPE = 2 * MiB;
constexpr size_t WS_MODP = 3 * MiB;
constexpr size_t WS_DT = 15 * MiB;
constexpr size_t WS_H = 18 * MiB;
constexpr size_t WS_HM = 154 * MiB;
constexpr size_t WS_PROJ = 222 * MiB;
constexpr size_t WS_O = 664 * MiB;
constexpr size_t WS_YD = 732 * MiB;
constexpr size_t WS_YS = 800 * MiB;
constexpr size_t WS_W = 868 * MiB;
constexpr size_t W_13 = 0, W_2 = 88 * MiB, W_IN = 132 * MiB, W_B = 185 * MiB, W_O = 197 * MiB, W_GLU = 205 * MiB;
constexpr size_t WS_END = 1075 * MiB;
constexpr int CW_BAR = 4096;

__device__ __forceinline__ unsigned cvt_pk_bf16(float lo, float hi) { unsigned r; asm volatile("v_cvt_pk_bf16_f32 %0, %1, %2" : "=v"(r) : "v"(lo), "v"(hi)); return r; }
__device__ __forceinline__ float bflo(unsigned u) { return __uint_as_float(u << 16); }
__device__ __forceinline__ float bfhi(unsigned u) { return __uint_as_float(u & 0xffff0000u); }
__device__ __forceinline__ float bf1(bf16_t h) { return __uint_as_float((unsigned)h << 16); }
__device__ __forceinline__ float sigmoidf_(float x) { return __builtin_amdgcn_rcpf(1.0f + __builtin_amdgcn_exp2f(-1.4426950408889634f * x)); }
__device__ __forceinline__ float siluf_(float x) { return x * sigmoidf_(x); }
__device__ __forceinline__ float wave_sum(float v) {
#pragma unroll
    for (int o = 1; o < 64; o <<= 1) v += __shfl_xor(v, o);
    return v;
}
#define LDS_WAIT() asm volatile("s_waitcnt lgkmcnt(0)" ::: "memory")
#define VM_WAIT() asm volatile("s_waitcnt vmcnt(0)" ::: "memory")

namespace pg8 {
constexpr int BM = 256, BK = 64, HALF = 128, HTB = HALF * BK * 2, STAGE_BYTES = 8 * HTB, NXCD = 8, WGM = 8;
__host__ __device__ __forceinline__ int lds_byte(int r, int c) { const int st = (r >> 4) * 2 + (c >> 5), rr = r & 15, cc = c & 31, ob = rr * 64 + cc * 2; return st * 1024 + (ob ^ (((ob >> 9) & 1) << 5)); }
__host__ __device__ __forceinline__ void stage_rc(int b, int& R_, int& C_) { const int st = b / 1024, sb = b % 1024, swz = sb ^ (((sb >> 9) & 1) << 5); R_ = (st >> 1) * 16 + swz / 64; C_ = (st & 1) * 32 + (swz % 64) / 2; }

struct Unit { int pm, pn, aux, pad; const char* a; const char* b; };
struct Gemm { int lda, ldb, K; };

__device__ __forceinline__ void xcd_remap(int L, int nM, int nN, int& pm, int& pn) {
    const int nwg = nM * nN; int wgid = L;
    { const int q = nwg / NXCD, r = nwg % NXCD, xcd = wgid % NXCD, off = wgid / NXCD; wgid = (xcd < r ? xcd * (q + 1) : r * (q + 1) + (xcd - r) * q) + off; }
    const int nig = WGM * nN, gid = wgid / nig, fm = gid * WGM, gsz = (nM - fm) < WGM ? (nM - fm) : WGM;
    pm = fm + ((wgid % nig) % gsz); pn = (wgid % nig) / gsz;
}
struct StaticOrder {
    int nM, nN, nwg, G, c; const char* A; const char* B; size_t tA, tB;
    __device__ __forceinline__ void init(int nM_, int nN_, int G_, int c_, const void* A_, int lda, const void* B_, int ldb) { nM = nM_; nN = nN_; nwg = nM * nN; G = G_; c = c_; A = (const char*)A_; B = (const char*)B_; tA = (size_t)BM * lda * 2; tB = (size_t)BM * ldb * 2; }
    __device__ __forceinline__ bool next(int i, Unit& u) const {
        const long L = (long)i * G + c; if (L >= nwg) return false;
        xcd_remap((int)L, nM, nN, u.pm, u.pn); u.aux = 0; u.pad = 0; u.a = A + (size_t)u.pm * tA; u.b = B + (size_t)u.pn * tB; return true;
    }
};
struct TripleOrder {
    int nM, nN, ntile, G, c; const char* A0; const char* B; size_t tA, tB;
    __device__ __forceinline__ bool next(int i, Unit& u) const {
        const int ti = i / 3, j = i - 3 * ti; const long L = (long)ti * G + c; if (L >= ntile) return false;
        xcd_remap((int)L, nM, nN, u.pm, u.pn); u.aux = j; u.pad = 0; u.a = A0 + (size_t)(((j & 1) * PZ + (j >> 1) * PK) * 2) + (size_t)u.pm * tA; u.b = B + (size_t)(j * nN + u.pn) * tB; return true;
    }
};

template <class Epi, class Sched>
__device__ __forceinline__ void gemm_phase(LAS unsigned char* lds, const Gemm g, const Sched& S, const Epi& E, const int tid) {
    const int wid = __builtin_amdgcn_readfirstlane(tid >> 6), lane = tid & 63, wr = wid >> 2, wc = wid & 3, fr = lane & 15, fq = lane >> 4;
    const int nt = g.K / BK;
    unsigned voffA[2], voffB[2];
#pragma unroll
    for (int i = 0; i < 2; ++i) { int R_, C_; stage_rc(tid * 16 + i * 8192, R_, C_); voffA[i] = (unsigned)(R_ * g.lda + C_) * 2u; voffB[i] = (unsigned)(R_ * g.ldb + C_) * 2u; }
    const size_t kstep = (size_t)(BK * 2);
    const size_t hstepA = (size_t)HALF * g.lda * 2, hstepB = (size_t)HALF * g.ldb * 2;
    const unsigned ldsw = (unsigned)wid * 1024u;
    const int aoff = lds_byte(wr * 64 + fr, fq * 8), boff = lds_byte(wc * 32 + fr, fq * 8);
#define PG8_SA(b, h) (((b) * 2 + (h)) * HTB)
#define PG8_SB(b, h) ((4 + (b) * 2 + (h)) * HTB)
#define PG8_STAGE(bufoff, gbase, voff) do { _Pragma("unroll") for (int _i = 0; _i < 2; ++_i) \
        __builtin_amdgcn_global_load_lds((const unsigned*)((const char*)(gbase) + (voff)[_i]), (LAS unsigned*)(lds + (bufoff) + ldsw + _i * 8192), 16, 0, 0); } while (0)
#define PG8_LDA(dst, b, h) do { _Pragma("unroll") for (int m = 0; m < 4; ++m) _Pragma("unroll") for (int k = 0; k < 2; ++k) dst[m][k] = *(const LAS bf16x8*)(lds + PG8_SA(b, h) + aoff + m * 2048 + k * 1024); } while (0)
#define PG8_LDB(dst, b, h) do { _Pragma("unroll") for (int n = 0; n < 2; ++n) _Pragma("unroll") for (int k = 0; k < 2; ++k) dst[n][k] = *(const LAS bf16x8*)(lds + PG8_SB(b, h) + boff + n * 2048 + k * 1024); } while (0)
#define PG8_MMA(ai, bj, At, Bt) do { __builtin_amdgcn_s_setprio(1); _Pragma("unroll") for (int m = 0; m < 4; ++m) _Pragma("unroll") for (int n = 0; n < 2; ++n) _Pragma("unroll") for (int k = 0; k < 2; ++k) \
        acc[ai][bj][m][n] = __builtin_amdgcn_mfma_f32_16x16x32_bf16(Bt[n][k], At[m][k], acc[ai][bj][m][n], 0, 0, 0); __builtin_amdgcn_s_setprio(0); } while (0)
#define PG8_WAIT_V(n) asm volatile("s_waitcnt vmcnt(" #n ")" ::: "memory")
#define PG8_WAIT_L(n) asm volatile("s_waitcnt lgkmcnt(" #n ")" ::: "memory")
#define PG8_BAR __builtin_amdgcn_s_barrier()
#define PG8_SCHED __builtin_amdgcn_sched_barrier(0)
    Unit cur, nxt; int ui = 0;
    if (!S.next(0, cur)) return;
    f32x4 acc[2][2][4][2];
#pragma unroll
    for (int a = 0; a < 2; ++a)
#pragma unroll
        for (int b = 0; b < 2; ++b)
#pragma unroll
            for (int m = 0; m < 4; ++m)
#pragma unroll
                for (int n = 0; n < 2; ++n) acc[a][b][m][n] = (f32x4){0.f, 0.f, 0.f, 0.f};
    bf16x8 At[4][2], B0[2][2], B1[2][2];
    const char* cA = cur.a; const char* cB = cur.b;
    PG8_STAGE(PG8_SB(0, 0), cB, voffB); PG8_STAGE(PG8_SB(0, 1), cB + hstepB, voffB); PG8_STAGE(PG8_SA(0, 0), cA, voffA); PG8_STAGE(PG8_SA(0, 1), cA + hstepA, voffA);
    if (wr == 1) PG8_BAR;
    PG8_WAIT_V(2); PG8_BAR;
    PG8_STAGE(PG8_SB(1, 0), cB + kstep, voffB); PG8_STAGE(PG8_SA(1, 0), cA + kstep, voffA); PG8_STAGE(PG8_SB(1, 1), cB + hstepB + kstep, voffB);
    PG8_WAIT_V(6); PG8_BAR;
    for (;;) {
        const bool has_next = S.next(ui + 1, nxt);
        const char* nA = has_next ? nxt.a : cA; const char* nB = has_next ? nxt.b : cB;
        for (int t = 0; t < nt; t += 2) {
            const bool last = (t == nt - 2);
            const char* a1 = cA + (size_t)(t + 1) * kstep;
            const char* a2 = last ? nA : cA + (size_t)(t + 2) * kstep; const char* b2 = last ? nB : cB + (size_t)(t + 2) * kstep;
            const char* a3 = a2 + kstep; const char* b3 = b2 + kstep;
            PG8_LDB(B0, 0, 0); PG8_LDB(B1, 0, 1); PG8_SCHED; PG8_LDA(At, 0, 0); PG8_STAGE(PG8_SA(1, 1), a1 + hstepA, voffA);
            PG8_WAIT_V(8); PG8_WAIT_L(0); PG8_BAR; PG8_MMA(0, 0, At, B0); PG8_MMA(0, 1, At, B1); PG8_BAR; PG8_SCHED;
            PG8_LDA(At, 0, 1); PG8_STAGE(PG8_SB(0, 0), b2, voffB); PG8_STAGE(PG8_SB(0, 1), b2 + hstepB, voffB); PG8_STAGE(PG8_SA(0, 0), a2, voffA);
            PG8_WAIT_V(8); PG8_WAIT_L(0); PG8_BAR; PG8_MMA(1, 0, At, B0); PG8_MMA(1, 1, At, B1); PG8_BAR; PG8_SCHED;
            PG8_LDB(B0, 1, 0); PG8_LDB(B1, 1, 1); PG8_SCHED; PG8_LDA(At, 1, 0); PG8_STAGE(PG8_SA(0, 1), a2 + hstepA, voffA);
            PG8_WAIT_V(8); PG8_WAIT_L(0); PG8_BAR; PG8_MMA(0, 0, At, B0); PG8_MMA(0, 1, At, B1); PG8_BAR; PG8_SCHED;
            PG8_LDA(At, 1, 1); PG8_STAGE(PG8_SB(1, 0), b3, voffB); PG8_STAGE(PG8_SB(1, 1), b3 + hstepB, voffB); PG8_STAGE(PG8_SA(1, 0), a3, voffA);
            PG8_WAIT_V(8); PG8_WAIT_L(0); PG8_BAR; PG8_MMA(1, 0, At, B0); PG8_MMA(1, 1, At, B1); PG8_BAR; PG8_SCHED;
        }
        if (wr == 0) PG8_BAR;
        E(acc, cur, wr, wc, fr, fq);
        if (!has_next) break;
#pragma unroll
        for (int a = 0; a < 2; ++a)
#pragma unroll
            for (int b = 0; b < 2; ++b)
#pragma unroll
                for (int m = 0; m < 4; ++m)
#pragma unroll
                    for (int n = 0; n < 2; ++n) acc[a][b][m][n] = (f32x4){0.f, 0.f, 0.f, 0.f};
        cur = nxt; cA = nA; cB = nB; ++ui;
        if (wr == 1) PG8_BAR;
    }
    PG8_WAIT_V(0);
    PG8_BAR;
#undef PG8_SA
#undef PG8_SB
#undef PG8_STAGE
#undef PG8_LDA
#undef PG8_LDB
#undef PG8_MMA
#undef PG8_WAIT_V
#undef PG8_WAIT_L
#undef PG8_BAR
#undef PG8_SCHED
}
}

struct EpiSwiGLU {
    bf16_t* O;
    __device__ __forceinline__ void operator()(const f32x4 (&acc)[2][2][4][2], const pg8::Unit& u, int wr, int wc, int fr, int fq) const {
        const int row0 = u.pm * 256 + wr * 64 + fr, hc0 = u.pn * 128 + wc * 16 + 4 * fq;
#pragma unroll
        for (int ai = 0; ai < 2; ++ai)
#pragma unroll
            for (int m = 0; m < 4; ++m) { bf16_t* rowp = O + (size_t)(row0 + ai * 128 + m * 16) * DFF + hc0;
#pragma unroll
                for (int bj = 0; bj < 2; ++bj) { const f32x4 a = acc[ai][bj][m][0], b = acc[ai][bj][m][1];
                    u32x2 w; w.x = cvt_pk_bf16(siluf_(a[0]) * b[0], siluf_(a[1]) * b[1]); w.y = cvt_pk_bf16(siluf_(a[2]) * b[2], siluf_(a[3]) * b[3]);
                    *(u32x2*)(rowp + bj * 64) = w; } }
    }
};
struct EpiResid {
    float* H; const float* gate; float cg;
    __device__ __forceinline__ void operator()(const f32x4 (&acc)[2][2][4][2], const pg8::Unit& u, int wr, int wc, int fr, int fq) const {
        const int pp = u.pm % PPB, mi = (pp == 0) ? 4 : (u.pm / PPB);
        const int row0 = u.pm * 256 + wr * 64 + fr, col0 = u.pn * 256 + wc * 32 + 4 * fq;
        f32x4 gv[2][2];
#pragma unroll
        for (int bj = 0; bj < 2; ++bj)
#pragma unroll
            for (int n = 0; n < 2; ++n) gv[bj][n] = *(const f32x4*)(gate + (size_t)mi * NMOD + col0 + bj * 128 + n * 16) * cg;
#pragma unroll
        for (int ai = 0; ai < 2; ++ai)
#pragma unroll
            for (int m = 0; m < 4; ++m) { float* rowp = H + (size_t)(row0 + ai * 128 + m * 16) * D + col0;
#pragma unroll
                for (int bj = 0; bj < 2; ++bj)
#pragma unroll
                    for (int n = 0; n < 2; ++n) { f32x4* p = (f32x4*)(rowp + bj * 128 + n * 16); *p = *p * DN_ALPHA + gv[bj][n] * acc[ai][bj][m][n]; } }
    }
};
struct EpiProj {
    bf16_t* P; float* DT; const float* rc; const float* rs;
    __device__ __forceinline__ void operator()(const f32x4 (&acc)[2][2][4][2], const pg8::Unit& u, int wr, int wc, int fr, int fq) const {
        const int pp = u.pm % PPB; const int row0 = u.pm * 256 + wr * 64 + fr;
        const int pn = u.pn;
        if (pn == 52) {
            if (wc == 0) {
#pragma unroll
                for (int ai = 0; ai < 2; ++ai)
#pragma unroll
                    for (int m = 0; m < 4; ++m)
#pragma unroll
                        for (int n = 0; n < 2; ++n) *(f32x4*)(DT + (size_t)(row0 + ai * 128 + m * 16) * 32 + n * 16 + 4 * fq) = acc[ai][0][m][n];
            }
            return;
        }
        const int col0 = pn * 256 + wc * 32 + 4 * fq;
        const int mode = (pn < 8) ? ((pp != 0) ? 1 : 0) : ((pn >= 12 && pn < 16) ? 2 : (pn >= 28 ? 3 : 0));
        const float sc = (pn < 4) ? QSCALE : 1.0f;
#pragma unroll
        for (int ai = 0; ai < 2; ++ai)
#pragma unroll
            for (int m = 0; m < 4; ++m) { const int rl = ai * 128 + wr * 64 + m * 16 + fr; bf16_t* rowp = P + (size_t)(u.pm * 256 + rl) * LDP + col0;
                f32x4 cs = (f32x4){1.f, 1.f, 1.f, 1.f}, sn = (f32x4){0.f, 0.f, 0.f, 0.f};
                if (mode == 1) { const int t = (pp - 1) * 256 + rl; const int pos = (wc & 1) ? (t & 63) : (t >> 6); cs = *(const f32x4*)(rc + pos * 16 + 4 * fq); sn = *(const f32x4*)(rs + pos * 16 + 4 * fq); }
#pragma unroll
                for (int bj = 0; bj < 2; ++bj) { f32x4 v0 = acc[ai][bj][m][0], v1 = acc[ai][bj][m][1];
                    if (mode == 1) { const f32x4 o0 = v0 * cs - v1 * sn, o1 = v1 * cs + v0 * sn; v0 = o0; v1 = o1; }
                    else if (mode == 2) {
#pragma unroll
                        for (int e = 0; e < 4; ++e) { v0[e] = siluf_(v0[e]); v1[e] = siluf_(v1[e]); } }
                    else if (mode == 3) {
#pragma unroll
                        for (int e = 0; e < 4; ++e) { v0[e] = sigmoidf_(v0[e]); v1[e] = sigmoidf_(v1[e]); } }
                    v0 = v0 * sc; v1 = v1 * sc;
                    u32x2 w0, w1; w0.x = cvt_pk_bf16(v0[0], v0[1]); w0.y = cvt_pk_bf16(v0[2], v0[3]); w1.x = cvt_pk_bf16(v1[0], v1[1]); w1.y = cvt_pk_bf16(v1[2], v1[3]);
                    *(u32x2*)(rowp + bj * 128) = w0; *(u32x2*)(rowp + bj * 128 + 16) = w1; } }
    }
};
struct EpiGlu {
    bf16_t* P; const float* bias;
    __device__ __forceinline__ void operator()(const f32x4 (&acc)[2][2][4][2], const pg8::Unit& u, int wr, int wc, int fr, int fq) const {
        const int row0 = u.pm * 256 + wr * 64 + fr, col0 = u.pn * 256 + wc * 32 + 4 * fq;
#pragma unroll
        for (int ai = 0; ai < 2; ++ai)
#pragma unroll
            for (int m = 0; m < 4; ++m) { bf16_t* rowp = P + (size_t)(row0 + ai * 128 + m * 16) * LDP;
#pragma unroll
                for (int bj = 0; bj < 2; ++bj)
#pragma unroll
                    for (int n = 0; n < 2; ++n) { const int c = col0 + bj * 128 + n * 16; const f32x4 bv = *(const f32x4*)(bias + c); const u32x2 tv = *(const u32x2*)(rowp + PU + c);
                        const f32x4 a = acc[ai][bj][m][n] + bv; u32x2 w;
                        w.x = cvt_pk_bf16(bflo(tv.x) * sigmoidf_(a[0]), bfhi(tv.x) * sigmoidf_(a[1])); w.y = cvt_pk_bf16(bflo(tv.y) * sigmoidf_(a[2]), bfhi(tv.y) * sigmoidf_(a[3]));
                        *(u32x2*)(rowp + PK + c) = w; } }
    }
};
struct EpiBranch {
    const bf16_t* P; float* MIX; bf16_t* MIXB;
    __device__ __forceinline__ void operator()(const f32x4 (&acc)[2][2][4][2], const pg8::Unit& u, int wr, int wc, int fr, int fq) const {
        const int row0 = u.pm * 256 + wr * 64 + fr, col0 = u.pn * 256 + wc * 32 + 4 * fq; const int j = u.aux;
#pragma unroll
        for (int ai = 0; ai < 2; ++ai)
#pragma unroll
            for (int m = 0; m < 4; ++m) { const size_t row = (size_t)(row0 + ai * 128 + m * 16);
#pragma unroll
                for (int bj = 0; bj < 2; ++bj)
#pragma unroll
                    for (int n = 0; n < 2; ++n) { const int c = col0 + bj * 128 + n * 16; const u32x2 gv = *(const u32x2*)(P + row * LDP + PG + j * D + c);
                        f32x4 v = acc[ai][bj][m][n]; v[0] *= bflo(gv.x); v[1] *= bfhi(gv.x); v[2] *= bflo(gv.y); v[3] *= bfhi(gv.y);
                        f32x4* mp = (f32x4*)(MIX + row * D + c);
                        if (j == 0) *mp = v; else if (j == 1) *mp = *mp + v;
                        else { v = *mp + v; u32x2 w; w.x = cvt_pk_bf16(v[0], v[1]); w.y = cvt_pk_bf16(v[2], v[3]); *(u32x2*)(MIXB + row * D + c) = w; } } }
    }
};

namespace attn_body {
using bf16 = __hip_bfloat16;
constexpr int NW = 8, QBLK = 32, KVBLK = 64;
constexpr int PQKV = LDP, PO = 1024;
__device__ __forceinline__ int crow(int r, int hi) { return (r & 3) + 8 * (r >> 2) + 4 * hi; }
#define SBAR() __builtin_amdgcn_sched_barrier(0)
constexpr int NSLOT = 3, SLOTB = 8192;
constexpr int LDS_K = 0, LDS_V = NSLOT * SLOTB, LDS_WS = 2 * NSLOT * SLOTB, LDS_OST = LDS_WS + NW * 64 * 4, LDS_BYTES = LDS_OST + NW * 4096;
__device__ __forceinline__ void glds16(const void* gsrc, unsigned lds_dst) { unsigned keep;
  asm volatile("s_mov_b32 %0, m0\n\ts_mov_b32 m0, %2\n\ts_nop 0\n\tglobal_load_lds_dwordx4 %1, off\n\ts_mov_b32 m0, %0" : "=&s"(keep) : "v"(gsrc), "s"(lds_dst) : "memory"); }
__device__ __forceinline__ float max3f(float a, float b, float c) { float r; asm("v_max3_f32 %0, %1, %2, %3" : "=v"(r) : "v"(a), "v"(b), "v"(c)); return r; }
__device__ __forceinline__ float max2f(float a, float b) { float r; asm("v_max_f32_e32 %0, %1, %2" : "=v"(r) : "v"(a), "v"(b)); return r; }
__device__ __forceinline__ float fadd_s(float a, float b) { float r; asm("v_add_f32_e32 %0, %1, %2" : "=v"(r) : "v"(a), "v"(b)); return r; }
__device__ __forceinline__ float fsub_s(float a, float b) { float r; asm("v_sub_f32_e32 %0, %1, %2" : "=v"(r) : "v"(a), "v"(b)); return r; }
typedef float f32x2_t __attribute__((ext_vector_type(2))); typedef __bf16 bf16x2_t __attribute__((ext_vector_type(2)));
__device__ __forceinline__ unsigned cvtpk_s(float lo, float hi) { f32x2_t v = {lo, hi}; bf16x2_t b = __builtin_convertvector(v, bf16x2_t); return __builtin_bit_cast(unsigned, b); }
#define WAIT_BAR(N) asm volatile("s_waitcnt vmcnt(" #N ") lgkmcnt(0)\n\ts_barrier" ::: "memory")
__device__ __forceinline__ void qkt(f32x16& p0, f32x16& p1, const char* Kslot, const bf16x8* qr, const f32x16& negm, int r32, int hi) {
  const char* kb = Kslot + hi * 1024 + r32 * 16;
#pragma unroll
  for (int d0 = 0; d0 < 4; ++d0) {
    const bf16x8 b0 = *reinterpret_cast<const bf16x8*>(kb + d0 * 2048);
    const bf16x8 b1 = *reinterpret_cast<const bf16x8*>(kb + d0 * 2048 + 512);
    if (d0 == 0) { p0 = __builtin_amdgcn_mfma_f32_32x32x16_bf16(b0, qr[0], negm, 0, 0, 0); p1 = __builtin_amdgcn_mfma_f32_32x32x16_bf16(b1, qr[0], negm, 0, 0, 0); }
    else { p0 = __builtin_amdgcn_mfma_f32_32x32x16_bf16(b0, qr[d0], p0, 0, 0, 0); p1 = __builtin_amdgcn_mfma_f32_32x32x16_bf16(b1, qr[d0], p1, 0, 0, 0); } }
}
typedef __attribute__((address_space(3))) const char* lds_cptr;
typedef short v4i16_t __attribute__((ext_vector_type(4)));
__device__ __forceinline__ void kload8(bf16x8* kf, lds_cptr kp) {
  kf[0] = *(const __attribute__((address_space(3))) bf16x8*)(kp);        kf[1] = *(const __attribute__((address_space(3))) bf16x8*)(kp + 512);
  kf[2] = *(const __attribute__((address_space(3))) bf16x8*)(kp + 2048); kf[3] = *(const __attribute__((address_space(3))) bf16x8*)(kp + 2560);
  kf[4] = *(const __attribute__((address_space(3))) bf16x8*)(kp + 4096); kf[5] = *(const __attribute__((address_space(3))) bf16x8*)(kp + 4608);
  kf[6] = *(const __attribute__((address_space(3))) bf16x8*)(kp + 6144); kf[7] = *(const __attribute__((address_space(3))) bf16x8*)(kp + 6656);
}
__device__ __forceinline__ void kload2(bf16x8* kf, lds_cptr kp, int j) { kf[2 * j] = *(const __attribute__((address_space(3))) bf16x8*)(kp + j * 2048); kf[2 * j + 1] = *(const __attribute__((address_space(3))) bf16x8*)(kp + j * 2048 + 512); }
__device__ __forceinline__ s16x4 vtr(lds_cptr p) { return __builtin_bit_cast(s16x4, __builtin_amdgcn_ds_read_tr16_b64_v4i16((__attribute__((address_space(3))) v4i16_t*)p)); }
__device__ __forceinline__ float rowmax(const f32x16& p0, const f32x16& p1) {
  float a = max3f(p0[0], p0[1], p1[0]), b = max3f(p0[2], p0[3], p1[1]); a = max3f(a, p1[2], p1[3]);
#pragma unroll
  for (int r = 4; r < 16; r += 4) { a = max3f(a, p0[r], p0[r + 1]); b = max3f(b, p0[r + 2], p0[r + 3]); a = max3f(a, p1[r], p1[r + 1]); b = max3f(b, p1[r + 2], p1[r + 3]); }
  const float m = max2f(a, b);
  auto rr = __builtin_amdgcn_permlane32_swap(__float_as_uint(m), __float_as_uint(m), false, false);
  return max2f(__uint_as_float(rr[0]), __uint_as_float(rr[1]));
}
__device__ __forceinline__ void pv(f32x16* o, int vb, bf16x8 pa0, bf16x8 pa1, bf16x8 pa2, bf16x8 pa3) {
#pragma unroll
  for (int d0 = 0; d0 < 2; ++d0) { s16x4 lo[4], hi[4];
#pragma unroll
    for (int ks = 0; ks < 4; ++ks) {
      asm volatile("ds_read_b64_tr_b16 %0,%1 offset:%c2" : "=&v"(lo[ks]) : "v"(vb), "i"(d0 * 4096 + ks * 1024) : "memory");
      asm volatile("ds_read_b64_tr_b16 %0,%1 offset:%c2" : "=&v"(hi[ks]) : "v"(vb), "i"(d0 * 4096 + ks * 1024 + 512) : "memory"); }
    asm volatile("s_waitcnt lgkmcnt(0)" ::: "memory"); SBAR();
#define PK(k) (bf16x8){lo[k][0], lo[k][1], lo[k][2], lo[k][3], hi[k][0], hi[k][1], hi[k][2], hi[k][3]}
    o[d0] = __builtin_amdgcn_mfma_f32_32x32x16_bf16(pa0, PK(0), o[d0], 0, 0, 0);
    o[d0] = __builtin_amdgcn_mfma_f32_32x32x16_bf16(pa1, PK(1), o[d0], 0, 0, 0);
    o[d0] = __builtin_amdgcn_mfma_f32_32x32x16_bf16(pa2, PK(2), o[d0], 0, 0, 0);
    o[d0] = __builtin_amdgcn_mfma_f32_32x32x16_bf16(pa3, PK(3), o[d0], 0, 0, 0);
#undef PK
  }
}
template <int THRL> __device__ __forceinline__ void attn_unit(const bf16* Q0, const bf16* __restrict__ Kh, const bf16* __restrict__ Vh, bf16* O0, const int NT, char* shm, const int tid) {
  const int lane = tid & 63, r32 = lane & 31, hi = lane >> 5; const int wid = __builtin_amdgcn_readfirstlane(tid >> 6);
  const bf16* Qw = Q0 + (long)(wid * QBLK) * PQKV;
  const unsigned lds0 = (unsigned)(uintptr_t)shm;
  float* wsf = (float*)(shm + LDS_WS) + wid * 64;
  const bf16* ksrc = Kh + (long)lane * PQKV + wid * 8;
  const bf16* vsrc = Vh + (long)(16 * (wid & 3) + (lane >> 2)) * PQKV + (wid >> 2) * 32 + (lane & 3) * 8;
  const unsigned kdst = lds0 + LDS_K + wid * 1024, vdst = lds0 + LDS_V + wid * 1024;
#define DMA_K(t, slot) glds16(ksrc + (long)(t) * KVBLK * PQKV, (unsigned)__builtin_amdgcn_readfirstlane(kdst + (slot)))
#define DMA_V(t, slot) glds16(vsrc + (long)(t) * KVBLK * PQKV, (unsigned)__builtin_amdgcn_readfirstlane(vdst + (slot)))
  const int vb0 = (int)(lds0 + LDS_V) + ((lane >> 4) & 1) * 32 + (lane & 3) * 8 + (4 * hi + ((lane & 15) >> 2)) * 64;
  const char* Kbase = shm + LDS_K; bf16x8 kf[8];
  const lds_cptr shm3 = (lds_cptr)shm; const lds_cptr kp0 = shm3 + LDS_K + hi * 1024 + r32 * 16; const lds_cptr vp0 = shm3 + LDS_V + ((lane >> 4) & 1) * 32 + (lane & 3) * 8 + (4 * hi + ((lane & 15) >> 2)) * 64;
  DMA_K(0, 0); DMA_V(0, 0); DMA_K(1, SLOTB);
  bf16x8 qr[4];
#pragma unroll
  for (int d0 = 0; d0 < 4; ++d0) qr[d0] = *reinterpret_cast<const bf16x8*>(&Qw[(long)r32 * PQKV + d0 * 16 + hi * 8]);
  float zf_; asm volatile("v_mov_b32 %0, 0" : "=v"(zf_)); float mhat = 0.f, l_reg = 0.f; f32x16 o[2], negm;
  _Pragma("unroll") for (int r = 0; r < 16; ++r) { o[0][r] = zf_; o[1][r] = zf_; negm[r] = zf_; } asm volatile("" : "+v"(negm));
  bool resc = false;
#define START(P0, P1) do { const float rm = rowmax(P0, P1); resc = false; \
    { const float dl = rm; mhat = fadd_s(mhat, dl); \
      _Pragma("unroll") for (int r = 0; r < 16; ++r) { P0[r] = fsub_s(P0[r], dl); P1[r] = fsub_s(P1[r], dl); } \
      _Pragma("unroll") for (int r = 0; r < 16; ++r) negm[r] = -mhat; asm volatile("" : "+v"(negm)); } \
    _Pragma("unroll") for (int r = 0; r < 16; ++r) P0[r] = __builtin_amdgcn_exp2f(P0[r]); } while (0)
#define RESC() do { if (resc) { asm volatile("s_waitcnt lgkmcnt(0)" ::: "memory"); \
      _Pragma("unroll") for (int d_ = 0; d_ < 2; ++d_) _Pragma("unroll") for (int r = 0; r < 16; ++r) o[d_][r] *= wsf[crow(r, hi)]; } } while (0)
  f32x16 pA0, pA1, pB0, pB1;
  int sl_prev = 0, sl_cur = 0, sl_next = SLOTB;
#define ROT() do { sl_prev = sl_cur; sl_cur = sl_next; sl_next = (sl_next == (NSLOT - 1) * SLOTB) ? 0 : sl_next + SLOTB; } while (0)
  DMA_K(2, 2 * SLOTB);
  WAIT_BAR(3);
  qkt(pA0, pA1, Kbase, qr, negm, r32, hi); asm volatile("s_nop 15\n\ts_nop 7" : "+v"(pA0), "+v"(pA1));
  START(pA0, pA1);
  _Pragma("unroll") for (int r = 0; r < 16; ++r) pA1[r] = __builtin_amdgcn_exp2f(pA1[r]);
  WAIT_BAR(0);
  DMA_K(3, 0); DMA_V(1, SLOTB);
  ROT();
  kload8(kf, kp0 + sl_cur);
  WAIT_BAR(2);
  s16x4 vlo[8], vhi[8]; u32x4 pw0, pw1, pw2, pw3;
#define PKW(P, B) cvtpk_s(P[B], P[B + 1])
#define PAF(k) __builtin_bit_cast(bf16x8, pw##k)
#define VFR(i) (bf16x8){vlo[i][0], vlo[i][1], vlo[i][2], vlo[i][3], vhi[i][0], vhi[i][1], vhi[i][2], vhi[i][3]}
#define PIN(x) asm volatile("" : "+v"(x))
#define MX3(a, b, c) __builtin_fmaxf(__builtin_fmaxf((a), (b)), (c))
#define GAPA(MF, A0, A1, A2, A3, W0, W1, PW) do { MF; sacc += A0; sacc += A1; sacc += A2; sacc += A3; PIN(sacc); W0; W1; PIN(PW); SBAR(); } while (0)
#define EX(v) __builtin_amdgcn_exp2f(v)
#define GAPB(MF, X, B) do { MF; X[B] = EX(X[B]); X[B + 1] = EX(X[B + 1]); X[B + 2] = EX(X[B + 2]); X[B + 3] = EX(X[B + 3]); PIN(X); SBAR(); } while (0)
#define VRD(i) do { vlo[i] = vtr(vp_ + (((i) >> 2) * 4096 + ((i) & 3) * 1024)); vhi[i] = vtr(vp_ + (((i) >> 2) * 4096 + ((i) & 3) * 1024 + 512)); } while (0)
#define KRD(G, j) do { if (G) { kload2(kf, kp0 + sl_next, j); SBAR(); } } while (0)
#define STEP(C0, C1, P0, P1, t, GK, GV, GL) do { SBAR(); \
    const lds_cptr vp_ = vp0 + sl_prev; \
    VRD(0); SBAR(); float sacc = (P0[0] + P0[1]); \
    GAPA(C0 = __builtin_amdgcn_mfma_f32_32x32x16_bf16(kf[0], qr[0], negm, 0, 0, 0), P0[2], P0[3], P0[4], P0[5],     pw0[0] = PKW(P0, 0), pw0[1] = PKW(P0, 2), pw0); \
    VRD(4); SBAR(); GAPA(C1 = __builtin_amdgcn_mfma_f32_32x32x16_bf16(kf[1], qr[0], negm, 0, 0, 0), P0[6], P0[7], P0[8], P0[9],     pw0[2] = PKW(P0, 4), pw0[3] = PKW(P0, 6), pw0); \
    VRD(1); SBAR(); GAPA(C0 = __builtin_amdgcn_mfma_f32_32x32x16_bf16(kf[2], qr[1], C0, 0, 0, 0),   P0[10], P0[11], P0[12], P0[13], pw1[0] = PKW(P0, 8), pw1[1] = PKW(P0, 10), pw1); \
    VRD(5); SBAR(); GAPA(C1 = __builtin_amdgcn_mfma_f32_32x32x16_bf16(kf[3], qr[1], C1, 0, 0, 0),   P0[14], P0[15], P1[0], P1[1],   pw1[2] = PKW(P0, 12), pw1[3] = PKW(P0, 14), pw1); \
    VRD(2); SBAR(); GAPA(C0 = __builtin_amdgcn_mfma_f32_32x32x16_bf16(kf[4], qr[2], C0, 0, 0, 0),   P1[2], P1[3], P1[4], P1[5],     pw2[0] = PKW(P1, 0), pw2[1] = PKW(P1, 2), pw2); \
    VRD(6); SBAR(); GAPA(C1 = __builtin_amdgcn_mfma_f32_32x32x16_bf16(kf[5], qr[2], C1, 0, 0, 0),   P1[6], P1[7], P1[8], P1[9],     pw2[2] = PKW(P1, 4), pw2[3] = PKW(P1, 6), pw2); \
    VRD(3); SBAR(); GAPA(C0 = __builtin_amdgcn_mfma_f32_32x32x16_bf16(kf[6], qr[3], C0, 0, 0, 0),   P1[10], P1[11], P1[12], P1[13], pw3[0] = PKW(P1, 8), pw3[1] = PKW(P1, 10), pw3); \
    VRD(7); SBAR(); GAPA(C1 = __builtin_amdgcn_mfma_f32_32x32x16_bf16(kf[7], qr[3], C1, 0, 0, 0),   P1[14], P1[15], 0.f, 0.f,       pw3[2] = PKW(P1, 12), pw3[3] = PKW(P1, 14), pw3); \
    l_reg += sacc; \
    if (GK) { DMA_K((t) + 3, sl_cur); } if (GV) { DMA_V((t) + 1, sl_next); } \
    { float a = MX3(C0[0], C0[1], C1[0]), b = MX3(C0[2], C0[3], C1[1]); a = MX3(a, C1[2], C1[3]); \
      _Pragma("unroll") for (int r = 4; r < 16; r += 4) { a = MX3(a, C0[r], C0[r + 1]); b = MX3(b, C0[r + 2], C0[r + 3]); a = MX3(a, C1[r], C1[r + 1]); b = MX3(b, C1[r + 2], C1[r + 3]); } \
      float rm = __builtin_fmaxf(a, b); { auto rr = __builtin_amdgcn_permlane32_swap(__float_as_uint(rm), __float_as_uint(rm), false, false); rm = __builtin_fmaxf(__uint_as_float(rr[0]), __uint_as_float(rr[1])); } \
      resc = false; \
      if (__builtin_expect(__any(rm > (float)THRL), 0)) { const float dl = __builtin_fmaxf(rm, 0.f); mhat += dl; \
        _Pragma("unroll") for (int r = 0; r < 16; ++r) { C0[r] -= dl; C1[r] -= dl; } \
        _Pragma("unroll") for (int r = 0; r < 16; ++r) negm[r] = -mhat; asm volatile("" : "+v"(negm)); \
        const float f = __builtin_amdgcn_exp2f(-dl); l_reg *= f; if (hi == 0) wsf[r32] = f; resc = true; } } \
    SBAR(); \
    GAPB(o[0] = __builtin_amdgcn_mfma_f32_32x32x16_bf16(PAF(0), VFR(0), o[0], 0, 0, 0), C0, 0); \
    GAPB(o[1] = __builtin_amdgcn_mfma_f32_32x32x16_bf16(PAF(0), VFR(4), o[1], 0, 0, 0), C0, 4); \
    KRD(GL, 0); GAPB(o[0] = __builtin_amdgcn_mfma_f32_32x32x16_bf16(PAF(1), VFR(1), o[0], 0, 0, 0), C0, 8); \
    KRD(GL, 1); GAPB(o[1] = __builtin_amdgcn_mfma_f32_32x32x16_bf16(PAF(1), VFR(5), o[1], 0, 0, 0), C0, 12); \
    KRD(GL, 2); GAPB(o[0] = __builtin_amdgcn_mfma_f32_32x32x16_bf16(PAF(2), VFR(2), o[0], 0, 0, 0), C1, 0); \
    KRD(GL, 3); GAPB(o[1] = __builtin_amdgcn_mfma_f32_32x32x16_bf16(PAF(2), VFR(6), o[1], 0, 0, 0), C1, 4); \
    GAPB(o[0] = __builtin_amdgcn_mfma_f32_32x32x16_bf16(PAF(3), VFR(3), o[0], 0, 0, 0), C1, 8); \
    GAPB(o[1] = __builtin_amdgcn_mfma_f32_32x32x16_bf16(PAF(3), VFR(7), o[1], 0, 0, 0), C1, 12); \
    } while (0)
  int t = 1;
  for (; t + 5 < NT; t += 2) {
    STEP(pB0, pB1, pA0, pA1, t, true, true, true);     WAIT_BAR(2); RESC(); ROT();
    STEP(pA0, pA1, pB0, pB1, t + 1, true, true, true); WAIT_BAR(2); RESC(); ROT();
  }
#define ENDW(tt) do { if ((tt) + 3 < NT) { WAIT_BAR(2); } else if ((tt) + 2 < NT) { WAIT_BAR(1); } else { WAIT_BAR(0); } } while (0)
  for (; t + 1 < NT; t += 2) {
    STEP(pB0, pB1, pA0, pA1, t, (t + 3 < NT), (t + 1 < NT), (t + 1 < NT));         ENDW(t);     RESC(); ROT();
    STEP(pA0, pA1, pB0, pB1, t + 1, (t + 4 < NT), (t + 2 < NT), (t + 2 < NT));     ENDW(t + 1); RESC(); ROT();
  }
  STEP(pB0, pB1, pA0, pA1, NT - 1, false, false, false); RESC();
  { float sacc = pB0[0] + pB0[1]; _Pragma("unroll") for (int r = 2; r < 16; ++r) sacc += pB0[r]; _Pragma("unroll") for (int r = 0; r < 16; ++r) sacc += pB1[r]; l_reg += sacc;
    pw0 = (u32x4){PKW(pB0, 0), PKW(pB0, 2), PKW(pB0, 4), PKW(pB0, 6)}; pw1 = (u32x4){PKW(pB0, 8), PKW(pB0, 10), PKW(pB0, 12), PKW(pB0, 14)}; pw2 = (u32x4){PKW(pB1, 0), PKW(pB1, 2), PKW(pB1, 4), PKW(pB1, 6)}; pw3 = (u32x4){PKW(pB1, 8), PKW(pB1, 10), PKW(pB1, 12), PKW(pB1, 14)};
    SBAR(); pv(o, vb0 + sl_cur, PAF(0), PAF(1), PAF(2), PAF(3)); }
#undef PKW
#undef PAF
#undef VFR
#undef PIN
#undef MX3
#undef GAPA
#undef GAPB
#undef EX
#undef VRD
#undef KRD
#undef STEP
#undef ENDW
  { auto rr = __builtin_amdgcn_permlane32_swap(__float_as_uint(l_reg), __float_as_uint(l_reg), false, false); l_reg = __uint_as_float(rr[0]) + __uint_as_float(rr[1]); }
  if (hi == 0) wsf[32 + r32] = l_reg; asm volatile("s_waitcnt lgkmcnt(0)" ::: "memory");
  float rli[16];
#pragma unroll
  for (int r = 0; r < 16; ++r) rli[r] = __builtin_amdgcn_rcpf(wsf[32 + crow(r, hi)]);
  bf16* Ow = O0 + (long)(wid * QBLK) * PO;
  { bf16* stg = (bf16*)(shm + LDS_OST) + wid * 2048;
#pragma unroll
    for (int r = 0; r < 16; ++r) { const int orow = crow(r, hi);
#pragma unroll
      for (int d0 = 0; d0 < 2; ++d0) stg[orow * 64 + d0 * 32 + r32] = __float2bfloat16(o[d0][r] * rli[r]); }
    asm volatile("s_waitcnt lgkmcnt(0)" ::: "memory");
#pragma unroll
    for (int i = 0; i < 4; ++i) { const int row = i * 8 + (lane >> 3), ch = lane & 7; const u32x4 v = *(const u32x4*)(stg + row * 64 + ch * 8); *(u32x4*)(Ow + (long)row * PO + ch * 8) = v; } }
  asm volatile("s_waitcnt lgkmcnt(0)\n\ts_barrier" ::: "memory");
#undef DMA_K
#undef DMA_V
#undef START
#undef RESC
#undef ROT
}
#undef SBAR
#undef WAIT_BAR
}

#define XB_TMO      128
#define XB_XCNT(j)  (256  + 64 * (j))
#define XB_XSUB(j)  (1280 + 64 * (j))
#define XB_XGEN(j)  (2304 + 64 * (j))
#define XB_TOP      3328
#define XB_TOPGEN   3392
#define XCD_BAR_WORDS 3456
#define XB_SPIN_CAP (1u << 18)
__device__ __forceinline__ unsigned xb_ld(unsigned* p)              { return __hip_atomic_load(p, __ATOMIC_RELAXED, __HIP_MEMORY_SCOPE_AGENT); }
__device__ __forceinline__ unsigned xb_add(unsigned* p, unsigned v) { return __hip_atomic_fetch_add(p, v, __ATOMIC_RELAXED, __HIP_MEMORY_SCOPE_AGENT); }
__device__ __forceinline__ unsigned xb_xcc_id() { return (unsigned)__builtin_amdgcn_s_getreg((3 << 11) | 20) & 0xFu; }
#define XB_SPIN(cond, bar) do { unsigned _sp = 0; while (cond) { __builtin_amdgcn_s_sleep(1); \
    if ((++_sp & 255u) == 0u) { if (xb_ld(&(bar)[XB_TMO])) break; if (_sp > XB_SPIN_CAP) { atomicAdd(&(bar)[XB_TMO], 1u); break; } } } } while (0)
struct XcdBarrier { unsigned* bar; unsigned x; volatile LAS unsigned* st; };
__device__ __forceinline__ XcdBarrier xcd_barrier_post(unsigned* bar, volatile LAS unsigned* st) {
    XcdBarrier b; b.bar = bar; b.x = xb_xcc_id(); b.st = st;
    if (threadIdx.x == 0) (void)xb_add(&bar[XB_XCNT(b.x)], 1u);
    return b;
}
__device__ __forceinline__ void xcd_barrier_complete(unsigned* bar, unsigned x, unsigned& nloc, unsigned& nx) {
    const unsigned G = gridDim.x * gridDim.y * gridDim.z;
    unsigned sum, cnt, mine, sp = 0u;
    for (;;) {
        sum = 0u; cnt = 0u; mine = 0u;
#pragma unroll
        for (unsigned j = 0; j < 16; ++j) { const unsigned c = xb_ld(&bar[XB_XCNT(j)]); sum += c; cnt += (c > 0u) ? 1u : 0u; mine = (j == x) ? c : mine; }
        if (sum == G) break;
        __builtin_amdgcn_s_sleep(1);
        if ((++sp & 255u) == 0u) { if (xb_ld(&bar[XB_TMO])) break; if (sp > XB_SPIN_CAP) { atomicAdd(&bar[XB_TMO], 1u); break; } }
    }
    nloc = mine > 0u ? mine : 1u; nx = cnt > 0u ? cnt : 1u;
}
__device__ __forceinline__ void xcd_barrier(const XcdBarrier& b) {
    asm volatile("s_waitcnt vmcnt(0)" ::: "memory");
    __syncthreads();
    if (threadIdx.x == 0) {
        unsigned* bar = b.bar;
        __builtin_amdgcn_s_waitcnt(0);
        unsigned nloc = b.st[0], nx = b.st[1];
        if (nloc == 0u) { xcd_barrier_complete(bar, b.x, nloc, nx); b.st[0] = nloc; b.st[1] = nx; }
        const unsigned old = xb_add(&bar[XB_XSUB(b.x)], 1u);
        const unsigned gen = old / nloc;
        if (old + 1u == (gen + 1u) * nloc) {
            __builtin_amdgcn_fence(__ATOMIC_RELEASE, "agent");
            asm volatile("s_waitcnt vmcnt(0)" ::: "memory");
            const unsigned og = xb_add(&bar[XB_TOP], 1u);
            const unsigned tg = og / nx;
            if (og + 1u == (tg + 1u) * nx) xb_add(&bar[XB_TOPGEN], 1u);
            else XB_SPIN(xb_ld(&bar[XB_TOPGEN]) == tg, bar);
            __builtin_amdgcn_fence(__ATOMIC_ACQUIRE, "agent");
            xb_add(&bar[XB_XGEN(b.x)], 1u);
            asm volatile("s_waitcnt vmcnt(0)" ::: "memory");
        } else {
            XB_SPIN(xb_ld(&bar[XB_XGEN(b.x)]) == gen, bar);
            __builtin_amdgcn_fence(__ATOMIC_ACQUIRE, "agent");
            asm volatile("s_waitcnt vmcnt(0)" ::: "memory");
        }
    }
    __syncthreads();
}

constexpr int NWAVES = 8;
constexpr int RING_OFF = 0, RING_BYTES = 131072;
constexpr int LDSCTL_OFF = RING_BYTES, MISC_OFF = LDSCTL_OFF + 320;
constexpr int LDS_BYTES = 147456;
static_assert(attn_body::LDS_BYTES <= RING_BYTES, "attention scratch fits the ring");

struct Args { const float* in[32]; float* out; unsigned char* ws; int ph_lo, ph_hi; };
struct Frame {
    LAS unsigned char* lds; int tid, lane, wave, vcu, G, gw, NGW;
    unsigned char* ws;
};
enum { I_X = 0, I_C, I_CTX, I_CCTX, I_WMOD, I_BMOD, I_LNG, I_LNB, I_W1, I_W3, I_W2, I_WIN, I_ALAM, I_ASUB, I_CONVW, I_CONVB, I_ALOG, I_DTB, I_SSDD, I_SSDN,
       I_LRE, I_LIM, I_LSTEP, I_BRE, I_BIM, I_CRE, I_CIM, I_S5D, I_GLUW, I_GLUB, I_WBR, I_WOUT };

__device__ __forceinline__ void transpose_item(const float* srcA, const float* srcB, int ldn, bf16_t* dst, int ldk, LAS float* scr, int lane) {
    const int c = lane & 31; const float* src = (c < 16) ? (srcA ? srcA + c : nullptr) : (srcB ? srcB + (c - 16) : nullptr);
#pragma unroll 8
    for (int i = 0; i < 32; ++i) { const int kk = 2 * i + (lane >> 5); scr[kk * 33 + c] = src ? src[(size_t)kk * ldn] : 0.f; }
    LDS_WAIT(); asm volatile("" ::: "memory");
    const int c8 = lane & 7;
#pragma unroll
    for (int j = 0; j < 4; ++j) { const int n = (lane >> 3) + 8 * j; const LAS float* s = scr + (8 * c8) * 33 + n;
        u32x4 o; o.x = cvt_pk_bf16(s[0 * 33], s[1 * 33]); o.y = cvt_pk_bf16(s[2 * 33], s[3 * 33]); o.z = cvt_pk_bf16(s[4 * 33], s[5 * 33]); o.w = cvt_pk_bf16(s[6 * 33], s[7 * 33]);
        *(u32x4*)(dst + (size_t)n * ldk + 8 * c8) = o; }
    LDS_WAIT(); asm volatile("" ::: "memory");
}
__device__ __forceinline__ void convert_layer_weights(const Args& A_, Frame& F, int l) {
    LAS float* scr = (LAS float*)(F.lds + RING_OFF + F.wave * 16384);
    unsigned char* W = F.ws + WS_W;
    constexpr int I13 = 32 * 352, I2 = 88 * 64, IIN = 32 * 424, IB = 16 * 64, IO = 32 * 64, IG = 16 * 32;
    constexpr int NIT = 2 * I13 + 2 * I2 + IIN + 3 * IB + IO + IG;
    for (int it = F.gw; it < NIT; it += F.NGW) {
        int r = it;
        if (r < 2 * I13) { const int f = r / I13; r -= f * I13; const int kb = r / 352, nb = r % 352;
            const float* w1 = A_.in[I_W1] + ((size_t)(l * 2 + f) * D + 64 * kb) * DFF + 16 * nb; const float* w3 = A_.in[I_W3] + ((size_t)(l * 2 + f) * D + 64 * kb) * DFF + 16 * nb;
            transpose_item(w1, w3, DFF, (bf16_t*)(W + W_13) + ((size_t)f * N13 + 32 * nb) * D + 64 * kb, D, scr, F.lane); continue; }
        r -= 2 * I13;
        if (r < 2 * I2) { const int f = r / I2; r -= f * I2; const int kb = r / 64, nb = r % 64;
            const float* w2 = A_.in[I_W2] + ((size_t)(l * 2 + f) * DFF + 64 * kb) * D + 32 * nb;
            transpose_item(w2, w2 + 16, D, (bf16_t*)(W + W_2) + ((size_t)f * D + 32 * nb) * DFF + 64 * kb, DFF, scr, F.lane); continue; }
        r -= 2 * I2;
        if (r < IIN) { const int kb = r / 424, nb = r % 424; const int n0 = 32 * nb; int sc = -1;
            if (n0 < 6144) sc = n0; else if (n0 < 13312) sc = n0 + 32; else if (n0 == 13312) sc = 6144;
            const float* w = (sc >= 0) ? A_.in[I_WIN] + ((size_t)l * D + 64 * kb) * 13344 + sc : nullptr;
            transpose_item(w, w ? w + 16 : nullptr, 13344, (bf16_t*)(W + W_IN) + (size_t)n0 * D + 64 * kb, D, scr, F.lane); continue; }
        r -= IIN;
        if (r < 3 * IB) { const int j = r / IB; r -= j * IB; const int kb = r / 64, nb = r % 64;
            const float* w = A_.in[I_WBR] + ((size_t)(l * 3 + j) * 1024 + 64 * kb) * D + 32 * nb;
            transpose_item(w, w + 16, D, (bf16_t*)(W + W_B) + ((size_t)j * D + 32 * nb) * 1024 + 64 * kb, 1024, scr, F.lane); continue; }
        r -= 3 * IB;
        if (r < IO) { const int kb = r / 64, nb = r % 64; const float* w = A_.in[I_WOUT] + ((size_t)l * D + 64 * kb) * D + 32 * nb;
            transpose_item(w, w + 16, D, (bf16_t*)(W + W_O) + (size_t)(32 * nb) * D + 64 * kb, D, scr, F.lane); continue; }
        r -= IO;
        { const int kb = r / 32, nb = r % 32; const float* w = A_.in[I_GLUW] + ((size_t)l * 1024 + 64 * kb) * 1024 + 32 * nb;
            transpose_item(w, w + 16, 1024, (bf16_t*)(W + W_GLU) + (size_t)(32 * nb) * 1024 + 64 * kb, 1024, scr, F.lane); }
    }
}
__device__ __forceinline__ void mod_partials(const Args& A_, Frame& F) {
    float* MODP = (float*)(F.ws + WS_MODP);
    for (int it = F.gw; it < 2 * 72 * 16; it += F.NGW) {
        const int l = it / (72 * 16), r = it % (72 * 16), ks = r / 72, cg = r % 72;
        const int col = cg * 256 + F.lane * 4; const float* w = A_.in[I_WMOD] + ((size_t)l * D + ks * 128) * NMOD + col;
        f32x4 a0 = {0.f, 0.f, 0.f, 0.f}, a1 = a0, a2 = a0, a3 = a0, a4 = a0;
        const float* c = A_.in[I_C] + ks * 128; const float* cc = A_.in[I_CCTX] + ks * 128;
#pragma unroll 4
        for (int k = 0; k < 128; ++k) { const f32x4 wv = *(const f32x4*)(w + (size_t)k * NMOD);
            a0 += wv * siluf_(c[k]); a1 += wv * siluf_(c[D + k]); a2 += wv * siluf_(c[2 * D + k]); a3 += wv * siluf_(c[3 * D + k]); a4 += wv * siluf_(cc[k]); }
        float* o = MODP + ((size_t)(l * 16 + ks) * 5) * NMOD + col;
        *(f32x4*)(o) = a0; *(f32x4*)(o + NMOD) = a1; *(f32x4*)(o + 2 * NMOD) = a2; *(f32x4*)(o + 3 * NMOD) = a3; *(f32x4*)(o + 4 * NMOD) = a4;
    }
}
__device__ __forceinline__ void ln_pass(Frame& F, bool do_ln, const float* lng, const float* lnb, const float* modnext  , float* out) {
    float* H = (float*)(F.ws + WS_H); bf16_t* HM = (bf16_t*)(F.ws + WS_HM);
    for (int row = F.gw; row < R; row += F.NGW) {
        const int b = row / RB, rr = row % RB; const int mi = (rr < CTX) ? 4 : b;
        float* hr = H + (size_t)row * D;
        f32x4 v[8]; float s = 0.f;
#pragma unroll
        for (int i = 0; i < 8; ++i) { v[i] = *(const f32x4*)(hr + 256 * i + 4 * F.lane); s += (v[i][0] + v[i][1]) + (v[i][2] + v[i][3]); }
        if (do_ln) {
            const float mean = wave_sum(s) * (1.f / D); float s2 = 0.f;
#pragma unroll
            for (int i = 0; i < 8; ++i) { v[i] = v[i] - mean; s2 += (v[i][0] * v[i][0] + v[i][1] * v[i][1]) + (v[i][2] * v[i][2] + v[i][3] * v[i][3]); }
            const float rstd = 1.0f / sqrtf(wave_sum(s2) * (1.f / D) + LN_EPS);
#pragma unroll
            for (int i = 0; i < 8; ++i) { const f32x4 g = *(const f32x4*)(lng + 256 * i + 4 * F.lane), bb = *(const f32x4*)(lnb + 256 * i + 4 * F.lane); v[i] = v[i] * rstd * g + bb; *(f32x4*)(hr + 256 * i + 4 * F.lane) = v[i]; }
        }
        if (modnext) {
            const float* sh = modnext + (size_t)mi * NMOD; const float* sc = sh + D;
#pragma unroll
            for (int i = 0; i < 8; ++i) { const f32x4 a = *(const f32x4*)(sh + 256 * i + 4 * F.lane), c = *(const f32x4*)(sc + 256 * i + 4 * F.lane); const f32x4 m = v[i] * (c + 1.0f) + a;
                u32x2 w; w.x = cvt_pk_bf16(m[0], m[1]); w.y = cvt_pk_bf16(m[2], m[3]); *(u32x2*)(HM + (size_t)row * D + 256 * i + 4 * F.lane) = w; }
        }
        if (out && rr >= CTX) { float* orow = out + ((size_t)b * SEQ + (rr - CTX)) * D;
#pragma unroll
            for (int i = 0; i < 8; ++i) *(f32x4*)(orow + 256 * i + 4 * F.lane) = v[i]; }
    }
}

__device__ __forceinline__ void ssd_conv_pass(const Args& A_, Frame& F, int l) {
    const bf16_t* P = (const bf16_t*)(F.ws + WS_PROJ); bf16_t* XC = (bf16_t*)(F.ws + WS_HM); float* DT = (float*)(F.ws + WS_DT);
    const float* cw = A_.in[I_CONVW] + (size_t)l * 5 * 2048; const float* cb = A_.in[I_CONVB] + (size_t)l * 2048;
    for (int it = F.gw; it < R * 4; it += F.NGW) {
        const int row = it >> 2, c0 = (it & 3) * 512 + F.lane * 8; const int rr = row % RB; const int lo = (rr < CTX) ? 0 : CTX, hi = (rr < CTX) ? CTX : RB;
        float acc[8];
#pragma unroll
        for (int e = 0; e < 8; ++e) acc[e] = cb[c0 + e];
#pragma unroll
        for (int k = 0; k < 5; ++k) { const int r2 = rr + k - 2;
            if (r2 >= lo && r2 < hi) { const u32x4 xv = *(const u32x4*)(P + (size_t)(row + k - 2) * LDP + PX + c0); const f32x4 w0 = *(const f32x4*)(cw + k * 2048 + c0), w1 = *(const f32x4*)(cw + k * 2048 + c0 + 4);
                acc[0] += w0[0] * bflo(xv.x); acc[1] += w0[1] * bfhi(xv.x); acc[2] += w0[2] * bflo(xv.y); acc[3] += w0[3] * bfhi(xv.y);
                acc[4] += w1[0] * bflo(xv.z); acc[5] += w1[1] * bfhi(xv.z); acc[6] += w1[2] * bflo(xv.w); acc[7] += w1[3] * bfhi(xv.w); } }
        u32x4 o; o.x = cvt_pk_bf16(siluf_(acc[0]), siluf_(acc[1])); o.y = cvt_pk_bf16(siluf_(acc[2]), siluf_(acc[3])); o.z = cvt_pk_bf16(siluf_(acc[4]), siluf_(acc[5])); o.w = cvt_pk_bf16(siluf_(acc[6]), siluf_(acc[7]));
        *(u32x4*)(XC + (size_t)row * 2048 + c0) = o;
    }
    const float* dtb = A_.in[I_DTB] + l * 32;
    for (int i = (F.gw * 64 + F.lane); i < R * 32; i += F.NGW * 64) { const float x = DT[i] + dtb[i & 31]; DT[i] = fmaxf(x, 0.f) + log1pf(expf(-fabsf(x))); }
}
__device__ __forceinline__ int scan_row(int rb, int d, int step) { return d == 0 ? rb + step : (step < CTX ? rb + CTX - 1 - step : rb + (RB + CTX - 1) - step); }

__device__ __forceinline__ void ssd_scan_naive(const Args& A_, Frame& F, int l, int cid) {
    const int b = cid >> 5, d = (cid >> 4) & 1, hd = cid & 15, g = hd >> 2; const int rb = b * RB;
    const bf16_t* XC = (const bf16_t*)(F.ws + WS_HM); const float* DT = (const float*)(F.ws + WS_DT); bf16_t* YD = (bf16_t*)(F.ws + WS_YD) + (size_t)d * R * 1024;
    const float a = -expf(A_.in[I_ALOG][l * 32 + d * 16 + hd]);
    LAS bf16_t* Bs = (LAS bf16_t*)(F.lds); LAS bf16_t* Cs = (LAS bf16_t*)(F.lds + 16384); LAS float* Xs = (LAS float*)(F.lds + 32768); LAS float* dAs = (LAS float*)(F.lds + 49152); LAS float* Ys = (LAS float*)(F.lds + 49408);
    const int tid = F.tid, p = tid >> 3, nq = tid & 7;
    float h[16];
#pragma unroll
    for (int i = 0; i < 16; ++i) h[i] = 0.f;
    for (int s0 = 0; s0 < RB; s0 += 64) {
#pragma unroll
        for (int i = 0; i < 2; ++i) { const int idx = tid + 512 * i, ri = idx >> 4, seg = idx & 15; const int row = scan_row(rb, d, s0 + ri);
            *(LAS u32x4*)(Bs + ri * 128 + seg * 8) = *(const u32x4*)(XC + (size_t)row * 2048 + 1024 + g * 128 + seg * 8);
            *(LAS u32x4*)(Cs + ri * 128 + seg * 8) = *(const u32x4*)(XC + (size_t)row * 2048 + 1536 + g * 128 + seg * 8); }
        { const int ri = tid >> 3, seg = tid & 7; const int row = scan_row(rb, d, s0 + ri); const float dtv = DT[(size_t)row * 32 + d * 16 + hd];
            const u32x4 xv = *(const u32x4*)(XC + (size_t)row * 2048 + hd * 64 + seg * 8); LAS float* xs = Xs + ri * 64 + seg * 8;
            xs[0] = bflo(xv.x) * dtv; xs[1] = bfhi(xv.x) * dtv; xs[2] = bflo(xv.y) * dtv; xs[3] = bfhi(xv.y) * dtv; xs[4] = bflo(xv.z) * dtv; xs[5] = bfhi(xv.z) * dtv; xs[6] = bflo(xv.w) * dtv; xs[7] = bfhi(xv.w) * dtv;
            if (seg == 0) dAs[ri] = expf(dtv * a); }
        __syncthreads();
        for (int s = 0; s < 64; ++s) {
            const float da = dAs[s], xd = Xs[s * 64 + p];
            const u32x4 b0 = *(const LAS u32x4*)(Bs + s * 128 + nq * 16), b1 = *(const LAS u32x4*)(Bs + s * 128 + nq * 16 + 8);
            const u32x4 c0 = *(const LAS u32x4*)(Cs + s * 128 + nq * 16), c1 = *(const LAS u32x4*)(Cs + s * 128 + nq * 16 + 8);
            float y = 0.f;
#define SSDU(i, bw, cw_, lo_) { const float bv = lo_ ? bflo(bw) : bfhi(bw), cv = lo_ ? bflo(cw_) : bfhi(cw_); h[i] = da * h[i] + xd * bv; y += cv * h[i]; }
            SSDU(0, b0.x, c0.x, 1) SSDU(1, b0.x, c0.x, 0) SSDU(2, b0.y, c0.y, 1) SSDU(3, b0.y, c0.y, 0) SSDU(4, b0.z, c0.z, 1) SSDU(5, b0.z, c0.z, 0) SSDU(6, b0.w, c0.w, 1) SSDU(7, b0.w, c0.w, 0)
            SSDU(8, b1.x, c1.x, 1) SSDU(9, b1.x, c1.x, 0) SSDU(10, b1.y, c1.y, 1) SSDU(11, b1.y, c1.y, 0) SSDU(12, b1.z, c1.z, 1) SSDU(13, b1.z, c1.z, 0) SSDU(14, b1.w, c1.w, 1) SSDU(15, b1.w, c1.w, 0)
#undef SSDU
            y += __shfl_xor(y, 1); y += __shfl_xor(y, 2); y += __shfl_xor(y, 4);
            if (nq == 0) Ys[s * 64 + p] = y;
        }
        __syncthreads();
        { const int ri = tid >> 3, seg = tid & 7; const int row = scan_row(rb, d, s0 + ri); const LAS float* ys = Ys + ri * 64 + seg * 8;
            u32x4 o; o.x = cvt_pk_bf16(ys[0], ys[1]); o.y = cvt_pk_bf16(ys[2], ys[3]); o.z = cvt_pk_bf16(ys[4], ys[5]); o.w = cvt_pk_bf16(ys[6], ys[7]);
            *(u32x4*)(YD + (size_t)row * 1024 + hd * 64 + seg * 8) = o; }
        __syncthreads();
    }
}
__device__ __forceinline__ void s5_scan_naive(const Args& A_, Frame& F, int l, int cid) {
    const int b = cid >> 7, d = (cid >> 6) & 1, g = cid & 63; const int rb = b * RB, n = F.lane;
    const bf16_t* P = (const bf16_t*)(F.ws + WS_PROJ); bf16_t* YS = (bf16_t*)(F.ws + WS_YS) + (size_t)d * R * 1024;
    const int pg_ = (l * 2 + d) * 64 + g;
    const float lre = A_.in[I_LRE][pg_ * 64 + n], lim = A_.in[I_LIM][pg_ * 64 + n], step = expf(A_.in[I_LSTEP][pg_]);
    const float mag = expf(lre * step), ang = lim * step; const float abr = mag * cosf(ang), abi = mag * sinf(ang);
    const float den = lre * lre + lim * lim; const float kre = ((abr - 1.f) * lre + abi * lim) / den, kim = (abi * lre - (abr - 1.f) * lim) / den;
    float bbr[16], bbi[16], cr[16], ci[16];
    { const float* br = A_.in[I_BRE] + ((size_t)pg_ * 64 + n) * 16; const float* bi = A_.in[I_BIM] + ((size_t)pg_ * 64 + n) * 16;
#pragma unroll
      for (int i = 0; i < 16; ++i) { const float x = br[i], y = bi[i]; bbr[i] = kre * x - kim * y; bbi[i] = kre * y + kim * x; } }
#pragma unroll
    for (int o = 0; o < 16; ++o) { cr[o] = A_.in[I_CRE][((size_t)pg_ * 16 + o) * 64 + n]; ci[o] = A_.in[I_CIM][((size_t)pg_ * 16 + o) * 64 + n]; }
    float hr = 0.f, hi_ = 0.f;
    const int osel = 8 * ((n >> 5) & 1) + 4 * ((n >> 4) & 1) + 2 * ((n >> 3) & 1) + ((n >> 2) & 1);
    u32x4 ua, ub;
    { const int row = scan_row(rb, d, 0); ua = *(const u32x4*)(P + (size_t)row * LDP + PU + g * 16); ub = *(const u32x4*)(P + (size_t)row * LDP + PU + g * 16 + 8); }
    for (int s = 0; s < RB; ++s) {
        const int row = scan_row(rb, d, s);
        const u32x4 va = ua, vb = ub;
        if (s + 1 < RB) { const int r2 = scan_row(rb, d, s + 1); ua = *(const u32x4*)(P + (size_t)r2 * LDP + PU + g * 16); ub = *(const u32x4*)(P + (size_t)r2 * LDP + PU + g * 16 + 8); }
        float u[16];
        u[0] = bflo(va.x); u[1] = bfhi(va.x); u[2] = bflo(va.y); u[3] = bfhi(va.y); u[4] = bflo(va.z); u[5] = bfhi(va.z); u[6] = bflo(va.w); u[7] = bfhi(va.w);
        u[8] = bflo(vb.x); u[9] = bfhi(vb.x); u[10] = bflo(vb.y); u[11] = bfhi(vb.y); u[12] = bflo(vb.z); u[13] = bfhi(vb.z); u[14] = bflo(vb.w); u[15] = bfhi(vb.w);
        float bur = 0.f, bui = 0.f;
#pragma unroll
        for (int i = 0; i < 16; ++i) { bur += bbr[i] * u[i]; bui += bbi[i] * u[i]; }
        const float nr = abr * hr - abi * hi_ + bur, ni = abr * hi_ + abi * hr + bui; hr = nr; hi_ = ni;
        float pr[16];
#pragma unroll
        for (int o = 0; o < 16; ++o) pr[o] = cr[o] * hr - ci[o] * hi_;
        float r8[8], r4[4], r2[2], r1;
#pragma unroll
        for (int k = 0; k < 8; ++k) { const bool up = (n & 32) != 0; const float keep = up ? pr[k + 8] : pr[k], send = up ? pr[k] : pr[k + 8]; r8[k] = keep + __shfl_xor(send, 32); }
#pragma unroll
        for (int k = 0; k < 4; ++k) { const bool up = (n & 16) != 0; const float keep = up ? r8[k + 4] : r8[k], send = up ? r8[k] : r8[k + 4]; r4[k] = keep + __shfl_xor(send, 16); }
#pragma unroll
        for (int k = 0; k < 2; ++k) { const bool up = (n & 8) != 0; const float keep = up ? r4[k + 2] : r4[k], send = up ? r4[k] : r4[k + 2]; r2[k] = keep + __shfl_xor(send, 8); }
        { const bool up = (n & 4) != 0; const float keep = up ? r2[1] : r2[0], send = up ? r2[0] : r2[1]; r1 = keep + __shfl_xor(send, 4); }
        r1 += __shfl_xor(r1, 1); r1 += __shfl_xor(r1, 2);
        if ((n & 3) == 0) YS[(size_t)row * 1024 + g * 16 + osel] = (bf16_t)(cvt_pk_bf16(r1, 0.f) & 0xffffu);
    }
}
__device__ __forceinline__ void mixer_finalize(const Args& A_, Frame& F, int l) {
    bf16_t* P = (bf16_t*)(F.ws + WS_PROJ); const bf16_t* O0 = (const bf16_t*)(F.ws + WS_O); const bf16_t* O1 = O0 + (size_t)R * 1024;
    const bf16_t* XC = (const bf16_t*)(F.ws + WS_HM); const bf16_t* YD0 = (const bf16_t*)(F.ws + WS_YD); const bf16_t* YD1 = YD0 + (size_t)R * 1024;
    const bf16_t* YS0 = (const bf16_t*)(F.ws + WS_YS); const bf16_t* YS1 = YS0 + (size_t)R * 1024;
    const float lam_init = 0.8f - 0.6f * expf(-0.3f * (float)l);
    const float* lv = A_.in[I_ALAM] + l * 256;
    const float s01 = wave_sum(lv[F.lane] * lv[64 + F.lane]), s23 = wave_sum(lv[128 + F.lane] * lv[192 + F.lane]);
    const float lam = expf(s01) - expf(s23) + lam_init;
    const int c0 = F.lane * 16;
    for (int row = F.gw; row < R; row += F.NGW) {
        { const u32x4 a0 = *(const u32x4*)(O0 + (size_t)row * 1024 + c0), a1 = *(const u32x4*)(O0 + (size_t)row * 1024 + c0 + 8);
          const u32x4 b0 = *(const u32x4*)(O1 + (size_t)row * 1024 + c0), b1 = *(const u32x4*)(O1 + (size_t)row * 1024 + c0 + 8);
          float v[16];
#define DIF(i, wa, wb) v[2 * (i)] = bflo(wa) - lam * bflo(wb); v[2 * (i) + 1] = bfhi(wa) - lam * bfhi(wb);
          DIF(0, a0.x, b0.x) DIF(1, a0.y, b0.y) DIF(2, a0.z, b0.z) DIF(3, a0.w, b0.w) DIF(4, a1.x, b1.x) DIF(5, a1.y, b1.y) DIF(6, a1.z, b1.z) DIF(7, a1.w, b1.w)
#undef DIF
          float ss = 0.f;
#pragma unroll
          for (int e = 0; e < 16; ++e) ss += v[e] * v[e];
          ss += __shfl_xor(ss, 1); ss += __shfl_xor(ss, 2); ss += __shfl_xor(ss, 4);
          const float rs = (1.0f / sqrtf(ss * (1.f / 128.f) + RMS_EPS)) * (1.0f - lam_init);
          const float* sw = A_.in[I_ASUB] + l * 128 + (c0 & 127);
          u32x4 o0, o1;
          o0.x = cvt_pk_bf16(v[0] * rs * sw[0], v[1] * rs * sw[1]); o0.y = cvt_pk_bf16(v[2] * rs * sw[2], v[3] * rs * sw[3]); o0.z = cvt_pk_bf16(v[4] * rs * sw[4], v[5] * rs * sw[5]); o0.w = cvt_pk_bf16(v[6] * rs * sw[6], v[7] * rs * sw[7]);
          o1.x = cvt_pk_bf16(v[8] * rs * sw[8], v[9] * rs * sw[9]); o1.y = cvt_pk_bf16(v[10] * rs * sw[10], v[11] * rs * sw[11]); o1.z = cvt_pk_bf16(v[12] * rs * sw[12], v[13] * rs * sw[13]); o1.w = cvt_pk_bf16(v[14] * rs * sw[14], v[15] * rs * sw[15]);
          *(u32x4*)(P + (size_t)row * LDP + PQ + c0) = o0; *(u32x4*)(P + (size_t)row * LDP + PQ + c0 + 8) = o1; }
        { const float dsk = A_.in[I_SSDD][l * 16 + (c0 >> 6)];
          float v[16];
#pragma unroll
          for (int hh = 0; hh < 2; ++hh) { const u32x4 x = *(const u32x4*)(XC + (size_t)row * 2048 + c0 + 8 * hh), y0 = *(const u32x4*)(YD0 + (size_t)row * 1024 + c0 + 8 * hh), y1 = *(const u32x4*)(YD1 + (size_t)row * 1024 + c0 + 8 * hh), z = *(const u32x4*)(P + (size_t)row * LDP + PZ + c0 + 8 * hh);
#define SG(i, wx, wy0, wy1, wz) v[8 * hh + 2 * (i)] = (bflo(wx) * dsk + bflo(wy0) + bflo(wy1)) * bflo(wz); v[8 * hh + 2 * (i) + 1] = (bfhi(wx) * dsk + bfhi(wy0) + bfhi(wy1)) * bfhi(wz);
              SG(0, x.x, y0.x, y1.x, z.x) SG(1, x.y, y0.y, y1.y, z.y) SG(2, x.z, y0.z, y1.z, z.z) SG(3, x.w, y0.w, y1.w, z.w)
#undef SG
          }
          float ss = 0.f;
#pragma unroll
          for (int e = 0; e < 16; ++e) ss += v[e] * v[e];
          ss += __shfl_xor(ss, 1); ss += __shfl_xor(ss, 2); ss += __shfl_xor(ss, 4); ss += __shfl_xor(ss, 8);
          const float rs = 1.0f / sqrtf(ss * (1.f / 256.f) + RMS_EPS);
          const float* nw = A_.in[I_SSDN] + l * 1024 + c0;
          u32x4 o0, o1;
          o0.x = cvt_pk_bf16(v[0] * rs * nw[0], v[1] * rs * nw[1]); o0.y = cvt_pk_bf16(v[2] * rs * nw[2], v[3] * rs * nw[3]); o0.z = cvt_pk_bf16(v[4] * rs * nw[4], v[5] * rs * nw[5]); o0.w = cvt_pk_bf16(v[6] * rs * nw[6], v[7] * rs * nw[7]);
          o1.x = cvt_pk_bf16(v[8] * rs * nw[8], v[9] * rs * nw[9]); o1.y = cvt_pk_bf16(v[10] * rs * nw[10], v[11] * rs * nw[11]); o1.z = cvt_pk_bf16(v[12] * rs * nw[12], v[13] * rs * nw[13]); o1.w = cvt_pk_bf16(v[14] * rs * nw[14], v[15] * rs * nw[15]);
          *(u32x4*)(P + (size_t)row * LDP + PZ + c0) = o0; *(u32x4*)(P + (size_t)row * LDP + PZ + c0 + 8) = o1; }
        { const float* sd = A_.in[I_S5D] + l * 1024 + c0;
          float v[16];
#pragma unroll
          for (int hh = 0; hh < 2; ++hh) { const u32x4 x = *(const u32x4*)(P + (size_t)row * LDP + PU + c0 + 8 * hh), y0 = *(const u32x4*)(YS0 + (size_t)row * 1024 + c0 + 8 * hh), y1 = *(const u32x4*)(YS1 + (size_t)row * 1024 + c0 + 8 * hh);
#define SY(i, wx, wy0, wy1) v[8 * hh + 2 * (i)] = bflo(wx) * sd[8 * hh + 2 * (i)] + bflo(wy0) + bflo(wy1); v[8 * hh + 2 * (i) + 1] = bfhi(wx) * sd[8 * hh + 2 * (i) + 1] + bfhi(wy0) + bfhi(wy1);
              SY(0, x.x, y0.x, y1.x) SY(1, x.y, y0.y, y1.y) SY(2, x.z, y0.z, y1.z) SY(3, x.w, y0.w, y1.w)
#undef SY
          }
#pragma unroll
          for (int e = 0; e < 16; ++e) { const float x = v[e]; const float inner = 0.7978845608028654f * (x + 0.044715f * x * x * x); const float th = 1.0f - 2.0f * __builtin_amdgcn_rcpf(1.0f + __builtin_amdgcn_exp2f(2.8853900817779268f * inner)); v[e] = 0.5f * x * (1.0f + th); }
          u32x4 o0, o1;
          o0.x = cvt_pk_bf16(v[0], v[1]); o0.y = cvt_pk_bf16(v[2], v[3]); o0.z = cvt_pk_bf16(v[4], v[5]); o0.w = cvt_pk_bf16(v[6], v[7]);
          o1.x = cvt_pk_bf16(v[8], v[9]); o1.y = cvt_pk_bf16(v[10], v[11]); o1.z = cvt_pk_bf16(v[12], v[13]); o1.w = cvt_pk_bf16(v[14], v[15]);
          *(u32x4*)(P + (size_t)row * LDP + PU + c0) = o0; *(u32x4*)(P + (size_t)row * LDP + PU + c0 + 8) = o1; }
    }
}


__global__ void __launch_bounds__(NWAVES * 64, 2) trunk_fwd(Args args) {
    extern __shared__ __attribute__((aligned(16))) unsigned char lds_raw[];
    Frame F;
    F.lds = (LAS unsigned char*)lds_raw;
    F.tid = threadIdx.x; F.lane = F.tid & 63; F.wave = __builtin_amdgcn_readfirstlane(F.tid >> 6);
    F.G = gridDim.x; { const int bx = blockIdx.x; F.vcu = (F.G % 8 == 0) ? (bx % 8) * (F.G / 8) + bx / 8 : bx; }
    F.gw = F.vcu * NWAVES + F.wave; F.NGW = F.G * NWAVES;
    F.ws = args.ws;
    volatile LAS unsigned* MISC = (volatile LAS unsigned*)(F.lds + MISC_OFF);
    for (int u = F.tid; u < (LDS_BYTES - LDSCTL_OFF) / 4; u += NWAVES * 64) ((LAS unsigned*)(F.lds + LDSCTL_OFF))[u] = 0u;
    __syncthreads();
    (void)xcd_barrier_post((unsigned*)(args.ws + WS_CTL) + CW_BAR, MISC + 8);
    const int lo = args.ph_lo, hi = args.ph_hi;
    int pid = 0;
#define PH_BEGIN if (pid >= lo && pid < hi) { GAS unsigned char* wsg_ = (GAS unsigned char*)args.ws; int tid_ = threadIdx.x; asm volatile("; PHASE_MARK_BEGIN %2" : "+s"(wsg_), "+v"(tid_) : "i"(__LINE__)); unsigned char* ws = (unsigned char*)wsg_; F.ws = ws; F.tid = tid_; F.lane = tid_ & 63; F.wave = __builtin_amdgcn_readfirstlane(tid_ >> 6); F.gw = F.vcu * NWAVES + F.wave;
#define PH_END   asm volatile("; PHASE_MARK_END %0" :: "i"(__LINE__)); if (pid + 1 < hi) { XcdBarrier bar_; bar_.bar = (unsigned*)(args.ws + WS_CTL) + CW_BAR; bar_.x = xb_xcc_id(); bar_.st = (volatile LAS unsigned*)(F.lds + MISC_OFF) + 8; xcd_barrier(bar_); } } ++pid;

#define MOD ((float*)(ws + WS_MOD))
#define Hbuf ((float*)(ws + WS_H))
#define HM ((bf16_t*)(ws + WS_HM))
#define PROJ ((bf16_t*)(ws + WS_PROJ))
#define ROPEC ((float*)(ws + WS_ROPE))
#define ROPES (ROPEC + 1024)
#define WGT (ws + WS_W)

    PH_BEGIN
        convert_layer_weights(args, F, 0);
        mod_partials(args, F);
        for (int row = F.gw; row < R; row += F.NGW) { const int b = row / RB, rr = row % RB;
            const float* src = (rr < CTX) ? args.in[I_CTX] + ((size_t)b * CTX + rr) * D : args.in[I_X] + ((size_t)b * SEQ + (rr - CTX)) * D;
#pragma unroll
            for (int i = 0; i < 8; ++i) *(f32x4*)(Hbuf + (size_t)row * D + 256 * i + 4 * F.lane) = *(const f32x4*)(src + 256 * i + 4 * F.lane); }
        if (F.gw == 0) {
#pragma unroll
            for (int i = 0; i < 16; ++i) { const int idx = i * 64 + F.lane, pos = idx >> 4, f = idx & 15; const float inv = powf(10000.0f, -(float)f / 16.0f); const float ang = (float)pos * inv; ROPEC[idx] = cosf(ang); ROPES[idx] = sinf(ang); } }
    PH_END
    PH_BEGIN
        const float* MODP = (const float*)(ws + WS_MODP);
        for (int i = F.gw * 64 + F.lane; i < 2 * 5 * NMOD; i += F.NGW * 64) { const int l = i / (5 * NMOD), r = i % (5 * NMOD), c = r % NMOD;
            float s = args.in[I_BMOD][l * NMOD + c];
#pragma unroll
            for (int ks = 0; ks < 16; ++ks) s += MODP[(size_t)(l * 16 + ks) * 5 * NMOD + r];
            MOD[i] = s; }
    PH_END
    PH_BEGIN
        ln_pass(F, false, nullptr, nullptr, MOD, nullptr);
    PH_END

    for (int s = 0; s < 6; ++s) {
        const int l = s / 3, j = s - 3 * l;
        if (j != 1) {
            const int f = j >> 1;
            PH_BEGIN
                pg8::Gemm g{D, D, D}; pg8::StaticOrder S; S.init(NPAN, N13 / 256, F.G, (int)blockIdx.x, HM, D, (const bf16_t*)(WGT + W_13) + (size_t)f * N13 * D, D);
                EpiSwiGLU E{PROJ};
                pg8::gemm_phase<EpiSwiGLU, pg8::StaticOrder>(F.lds + RING_OFF, g, S, E, F.tid);
            PH_END
        } else {
            PH_BEGIN
                pg8::Gemm g{D, D, D}; pg8::StaticOrder S; S.init(NPAN, NIN / 256, F.G, (int)blockIdx.x, HM, D, (const bf16_t*)(WGT + W_IN), D);
                EpiProj E{PROJ, (float*)(ws + WS_DT), ROPEC, ROPES};
                pg8::gemm_phase<EpiProj, pg8::StaticOrder>(F.lds + RING_OFF, g, S, E, F.tid);
            PH_END
            PH_BEGIN
                ssd_conv_pass(args, F, l);
            PH_END
            PH_BEGIN
                if (blockIdx.x < 128) ssd_scan_naive(args, F, l, (int)blockIdx.x);
                else if (F.wave < 4) s5_scan_naive(args, F, l, ((int)blockIdx.x - 128) + 128 * F.wave);
                __syncthreads();
                {
                    bf16_t* Obuf = (bf16_t*)(ws + WS_O);
                    for (int i = 0;; ++i) { const int idx = i * F.G + F.vcu; if (idx >= 2048 + 128) break;
                        int b, hh, vh, q0, NT;
                        if (idx < 2048) { b = idx >> 9; hh = (idx >> 5) & 15; vh = (idx >> 4) & 1; q0 = b * RB + CTX + (idx & 15) * 256; NT = RB / 64; }
                        else { const int k = idx - 2048; b = k >> 5; hh = (k >> 1) & 15; vh = k & 1; q0 = b * RB; NT = CTX / 64; }
                        const bf16_t* Q0 = PROJ + (size_t)q0 * LDP + PQ + hh * 64; const bf16_t* Kh = PROJ + (size_t)(b * RB) * LDP + PK + hh * 64; const bf16_t* Vh = PROJ + (size_t)(b * RB) * LDP + PV + (hh >> 1) * 128 + vh * 64;
                        bf16_t* O0 = Obuf + (size_t)(hh & 1) * R * 1024 + (size_t)q0 * 1024 + (hh >> 1) * 128 + vh * 64;
                        attn_body::attn_unit<8>((const attn_body::bf16*)Q0, (const attn_body::bf16*)Kh, (const attn_body::bf16*)Vh, (attn_body::bf16*)O0, NT, (char*)lds_raw + RING_OFF, F.tid);
                    }
                }
            PH_END
            PH_BEGIN
                mixer_finalize(args, F, l);
            PH_END
            PH_BEGIN
                pg8::Gemm g{LDP, 1024, 1024}; pg8::StaticOrder S; S.init(NPAN, 4, F.G, (int)blockIdx.x, PROJ + PU, LDP, (const bf16_t*)(WGT + W_GLU), 1024);
                EpiGlu E{PROJ, args.in[I_GLUB] + l * 1024};
                pg8::gemm_phase<EpiGlu, pg8::StaticOrder>(F.lds + RING_OFF, g, S, E, F.tid);
            PH_END
            PH_BEGIN
                pg8::Gemm g{LDP, 1024, 1024}; pg8::TripleOrder S; S.nM = NPAN; S.nN = 8; S.ntile = NPAN * 8; S.G = F.G; S.c = (int)blockIdx.x;
                S.A0 = (const char*)(PROJ); S.B = (const char*)(WGT + W_B); S.tA = (size_t)256 * LDP * 2; S.tB = (size_t)256 * 1024 * 2;
                EpiBranch E{PROJ, (float*)(ws + WS_YD), HM};
                pg8::gemm_phase<EpiBranch, pg8::TripleOrder>(F.lds + RING_OFF, g, S, E, F.tid);
            PH_END
        }
        PH_BEGIN
            const int RK = (j == 1) ? D : DFF; const bf16_t* RA = (j == 1) ? HM : PROJ; const bf16_t* RBt = (j == 1) ? (const bf16_t*)(WGT + W_O) : (const bf16_t*)(WGT + W_2) + (size_t)(j >> 1) * D * DFF;
            pg8::Gemm g{RK, RK, RK}; pg8::StaticOrder S; S.init(NPAN, D / 256, F.G, (int)blockIdx.x, RA, RK, RBt, RK);
            EpiResid E{Hbuf, MOD + (size_t)l * 5 * NMOD + (3 * j + 2) * D, (j == 1) ? 1.0f : 0.5f};
            pg8::gemm_phase<EpiResid, pg8::StaticOrder>(F.lds + RING_OFF, g, S, E, F.tid);
        PH_END
        PH_BEGIN
            const bool fin = (s == 5);
            const int ln_ = (j == 2) ? l + 1 : l, jn = (j == 2) ? 0 : j + 1;
            ln_pass(F, true, args.in[I_LNG] + (size_t)(l * 3 + j) * D, args.in[I_LNB] + (size_t)(l * 3 + j) * D, fin ? nullptr : MOD + (size_t)ln_ * 5 * NMOD + 3 * jn * D, fin ? args.out : nullptr);
            if (s == 2) convert_layer_weights(args, F, 1);
        PH_END
    }
#undef PH_BEGIN
#undef PH_END
}

static int count_phases() { int n = 3; for (int s = 0; s < 6; ++s) n += ((s % 3) != 1 ? 1 : 6) + 2; return n; }
extern "C" void kernel_launch(void* const* d_in, const int* in_sizes, int n_in, void* d_out, int out_size, void* d_ws, size_t ws_size, hipStream_t stream) {
    static int grid = 0;
    if (grid == 0) {
        if (n_in != 32 || out_size != NB * SEQ * D || ws_size < WS_END) { fprintf(stderr, "kernel_launch: unexpected shapes (n_in %d, out %d, ws %zu < %zu)\n", n_in, out_size, ws_size, (size_t)WS_END); grid = -1; return; }
        int dev = 0, cus = 0, per_cu = 0;
        if (hipGetDevice(&dev) != hipSuccess || hipDeviceGetAttribute(&cus, hipDeviceAttributeMultiprocessorCount, dev) != hipSuccess) { grid = -1; return; }
        if (hipFuncSetAttribute((const void*)trunk_fwd, hipFuncAttributeMaxDynamicSharedMemorySize, LDS_BYTES) != hipSuccess) { fprintf(stderr, "kernel_launch: hipFuncSetAttribute failed\n"); grid = -1; return; }
        if (hipOccupancyMaxActiveBlocksPerMultiprocessor(&per_cu, (const void*)trunk_fwd, NWAVES * 64, LDS_BYTES) != hipSuccess || per_cu < 1) fprintf(stderr, "kernel_launch: occupancy query says %d\n", per_cu);
        (void)hipGetLastError();
        grid = cus;
    }
    if (grid < 0) return;
    (void)in_sizes;
    if (hipMemsetAsync((char*)d_ws + WS_CTL, 0, CTL_ZERO_BYTES, stream) != hipSuccess) return;
    Args a{};
    for (int i = 0; i < 32; ++i) a.in[i] = (const float*)d_in[i];
    a.out = (float*)d_out; a.ws = (unsigned char*)d_ws;
    const int nph = count_phases();
#if MK_PER_PHASE
    for (int p = 0; p < nph; ++p) { a.ph_lo = p; a.ph_hi = p + 1; hipLaunchKernelGGL(trunk_fwd, dim3(grid), dim3(NWAVES * 64), LDS_BYTES, stream, a); }
#else
    a.ph_lo = 0; a.ph_hi = nph;
    hipLaunchKernelGGL(trunk_fwd, dim3(grid), dim3(NWAVES * 64), LDS_BYTES, stream, a);
#endif
    const hipError_t le = hipPeekAtLastError();
    if (le != hipSuccess) fprintf(stderr, "kernel_launch: launch failed: %s\n", hipGetErrorName(le));
}
```

```cpp
#include <hip/hip_runtime.h>
#include <hip/hip_bf16.h>
#include <cstdio>
#include <cstdint>
#include <cmath>

#ifndef MK_PER_PHASE
#define MK_PER_PHASE 0
#endif

#define LAS __attribute__((address_space(3)))
#define GAS __attribute__((address_space(1)))
typedef unsigned short bf16_t;
typedef short bf16x8 __attribute__((ext_vector_type(8)));
typedef float f32x4 __attribute__((ext_vector_type(4)));
typedef float f32x2 __attribute__((ext_vector_type(2)));
typedef float f32x16 __attribute__((ext_vector_type(16)));
typedef unsigned u32x4 __attribute__((ext_vector_type(4)));
typedef unsigned u32x2 __attribute__((ext_vector_type(2)));
typedef short s16x4 __attribute__((ext_vector_type(4)));

constexpr int NB = 4, SEQ = 4096, CTX = 256, RB = SEQ + CTX  , R = NB * RB  , NPAN = R / 256  , PPB = RB / 256  ;
constexpr int D = 2048, DFF = 5632, N13 = 2 * DFF, NMOD = 9 * D  ;
constexpr int LDP = 13312;
constexpr int NIN = 13568;
constexpr int PQ = 0, PK = 1024, PV = 2048, PZ = 3072, PX = 4096, PU = 6144, PG = 7168;
constexpr float DN_ALPHA = 1.41421356237309515f;
constexpr float LN_EPS = 1e-5f, RMS_EPS = 1e-6f;
constexpr float QSCALE = 0.125f * 1.4426950408889634f;

constexpr size_t MiB = 1u << 20;
constexpr size_t WS_CTL = 0, CTL_ZERO_BYTES = 1 * MiB;
constexpr size_t WS_MOD = 1 * MiB;
constexpr size_t WS_ROPE = 2 * MiB;
constexpr size_t WS_MODP = 3 * MiB;
constexpr size_t WS_DT = 15 * MiB;
constexpr size_t WS_H = 18 * MiB;
constexpr size_t WS_HM = 154 * MiB;
constexpr size_t WS_PROJ = 222 * MiB;
constexpr size_t WS_O = 664 * MiB;
constexpr size_t WS_YD = 732 * MiB;
constexpr size_t WS_YS = 800 * MiB;
constexpr size_t WS_W = 868 * MiB;
constexpr size_t W_13 = 0, W_2 = 88 * MiB, W_IN = 132 * MiB, W_B = 185 * MiB, W_O = 197 * MiB, W_GLU = 205 * MiB;
constexpr size_t WS_S5ST = 1075 * MiB;
constexpr size_t WS_S5H = 1143 * MiB;
constexpr size_t WS_S5M = 1183 * MiB;
constexpr size_t WS_S5A = 1207 * MiB;
constexpr size_t WS_END = 1208 * MiB;
constexpr int S5M = 1088;
constexpr int CW_BAR = 4096;

__device__ __forceinline__ unsigned cvt_pk_bf16(float lo, float hi) { unsigned r; asm volatile("v_cvt_pk_bf16_f32 %0, %1, %2" : "=v"(r) : "v"(lo), "v"(hi)); return r; }
__device__ __forceinline__ float bflo(unsigned u) { return __uint_as_float(u << 16); }
__device__ __forceinline__ float bfhi(unsigned u) { return __uint_as_float(u & 0xffff0000u); }
__device__ __forceinline__ float bf1(bf16_t h) { return __uint_as_float((unsigned)h << 16); }
__device__ __forceinline__ float sigmoidf_(float x) { return __builtin_amdgcn_rcpf(1.0f + __builtin_amdgcn_exp2f(-1.4426950408889634f * x)); }
__device__ __forceinline__ float siluf_(float x) { return x * sigmoidf_(x); }
__device__ __forceinline__ int lane_now() { int l; asm volatile("v_mbcnt_lo_u32_b32 %0, -1, 0\n\tv_mbcnt_hi_u32_b32 %0, -1, %0" : "=v"(l)); return l; }
__device__ __forceinline__ float shx(float v, int m, int lane) { return __int_as_float(__builtin_amdgcn_ds_bpermute((lane ^ m) << 2, __float_as_int(v))); }
__device__ __forceinline__ float wave_sum(float v, int lane) {
#pragma unroll
    for (int o = 1; o < 64; o <<= 1) v += shx(v, o, lane);
    return v;
}
#define LDS_WAIT() asm volatile("s_waitcnt lgkmcnt(0)" ::: "memory")
#define VM_WAIT() asm volatile("s_waitcnt vmcnt(0)" ::: "memory")

namespace pg8 {
constexpr int BM = 256, BK = 64, HALF = 128, HTB = HALF * BK * 2, STAGE_BYTES = 8 * HTB, NXCD = 8, WGM = 8;
__host__ __device__ __forceinline__ int lds_byte(int r, int c) { const int st = (r >> 4) * 2 + (c >> 5), rr = r & 15, cc = c & 31, ob = rr * 64 + cc * 2; return st * 1024 + (ob ^ (((ob >> 9) & 1) << 5)); }
__host__ __device__ __forceinline__ void stage_rc(int b, int& R_, int& C_) { const int st = b / 1024, sb = b % 1024, swz = sb ^ (((sb >> 9) & 1) << 5); R_ = (st >> 1) * 16 + swz / 64; C_ = (st & 1) * 32 + (swz % 64) / 2; }

struct Unit { int pm, pn, aux, pad; const char* a; const char* b; };
struct Gemm { int lda, ldb, K; };

__device__ __forceinline__ void xcd_remap(int L, int nM, int nN, int& pm, int& pn) {
    const int nwg = nM * nN; int wgid = L;
    { const int q = nwg / NXCD, r = nwg % NXCD, xcd = wgid % NXCD, off = wgid / NXCD; wgid = (xcd < r ? xcd * (q + 1) : r * (q + 1) + (xcd - r) * q) + off; }
    const int nig = WGM * nN, gid = wgid / nig, fm = gid * WGM, gsz = (nM - fm) < WGM ? (nM - fm) : WGM;
    pm = fm + ((wgid % nig) % gsz); pn = (wgid % nig) / gsz;
}
struct StaticOrder {
    int nM, nN, nwg, G, c; const char* A; const char* B; size_t tA, tB;
    __device__ __forceinline__ void init(int nM_, int nN_, int G_, int c_, const void* A_, int lda, const void* B_, int ldb) { nM = nM_; nN = nN_; nwg = nM * nN; G = G_; c = c_; A = (const char*)A_; B = (const char*)B_; tA = (size_t)BM * lda * 2; tB = (size_t)BM * ldb * 2; }
    __device__ __forceinline__ bool next(int i, Unit& u) const {
        const long L = (long)i * G + c; if (L >= nwg) return false;
        xcd_remap((int)L, nM, nN, u.pm, u.pn); u.aux = 0; u.pad = 0; u.a = A + (size_t)u.pm * tA; u.b = B + (size_t)u.pn * tB; return true;
    }
};
struct TripleOrder {
    int nM, nN, ntile, G, c; const char* A0; const char* B; size_t tA, tB;
    __device__ __forceinline__ bool next(int i, Unit& u) const {
        const int ti = i / 3, j = i - 3 * ti; const long L = (long)ti * G + c; if (L >= ntile) return false;
        xcd_remap((int)L, nM, nN, u.pm, u.pn); u.aux = j; u.pad = 0; u.a = A0 + (size_t)(((j & 1) * PZ + (j >> 1) * PK) * 2) + (size_t)u.pm * tA; u.b = B + (size_t)(j * nN + u.pn) * tB; return true;
    }
};

template <class Epi, class Sched, int AMODE = 0>
__device__ __forceinline__ void gemm_phase(LAS unsigned char* lds, const Gemm g, const Sched& S, const Epi& E, const int tid) {
    const int wid = __builtin_amdgcn_readfirstlane(tid >> 6), lane = tid & 63, wr = wid >> 2, wc = wid & 3, fr = lane & 15, fq = lane >> 4;
    const int nt = g.K / BK;
    unsigned voffA[2], voffB[2];
#pragma unroll
    for (int i = 0; i < 2; ++i) { int R_, C_; stage_rc(tid * 16 + i * 8192, R_, C_);
        voffA[i] = (AMODE == 1) ? (unsigned)((R_ * 16 + (C_ >> 4)) * LDP + (C_ & 15)) * 2u : (unsigned)(R_ * g.lda + C_) * 2u; voffB[i] = (unsigned)(R_ * g.ldb + C_) * 2u; }
    const size_t kstep = (size_t)(BK * 2), kstepA = (AMODE == 1) ? (size_t)(4 * LDP * 2) : kstep;
    const size_t hstepA = (AMODE == 1) ? (size_t)HALF * 16 * LDP * 2 : (size_t)HALF * g.lda * 2, hstepB = (size_t)HALF * g.ldb * 2;
    const unsigned ldsw = (unsigned)wid * 1024u;
    const int aoff = lds_byte(wr * 64 + fr, fq * 8), boff = lds_byte(wc * 32 + fr, fq * 8);
#define PG8_SA(b, h) (((b) * 2 + (h)) * HTB)
#define PG8_SB(b, h) ((4 + (b) * 2 + (h)) * HTB)
#define PG8_STAGE(bufoff, gbase, voff) do { _Pragma("unroll") for (int _i = 0; _i < 2; ++_i) \
        __builtin_amdgcn_global_load_lds((const unsigned*)((const char*)(gbase) + (voff)[_i]), (LAS unsigned*)(lds + (bufoff) + ldsw + _i * 8192), 16, 0, 0); } while (0)
#define PG8_LDA(dst, b, h) do { _Pragma("unroll") for (int m = 0; m < 4; ++m) _Pragma("unroll") for (int k = 0; k < 2; ++k) dst[m][k] = *(const LAS bf16x8*)(lds + PG8_SA(b, h) + aoff + m * 2048 + k * 1024); } while (0)
#define PG8_LDB(dst, b, h) do { _Pragma("unroll") for (int n = 0; n < 2; ++n) _Pragma("unroll") for (int k = 0; k < 2; ++k) dst[n][k] = *(const LAS bf16x8*)(lds + PG8_SB(b, h) + boff + n * 2048 + k * 1024); } while (0)
#define PG8_MMA(ai, bj, At, Bt) do { __builtin_amdgcn_s_setprio(1); _Pragma("unroll") for (int m = 0; m < 4; ++m) _Pragma("unroll") for (int n = 0; n < 2; ++n) _Pragma("unroll") for (int k = 0; k < 2; ++k) \
        acc[ai][bj][m][n] = __builtin_amdgcn_mfma_f32_16x16x32_bf16(Bt[n][k], At[m][k], acc[ai][bj][m][n], 0, 0, 0); __builtin_amdgcn_s_setprio(0); } while (0)
#define PG8_WAIT_V(n) asm volatile("s_waitcnt vmcnt(" #n ")" ::: "memory")
#define PG8_WAIT_L(n) asm volatile("s_waitcnt lgkmcnt(" #n ")" ::: "memory")
#define PG8_BAR __builtin_amdgcn_s_barrier()
#define PG8_SCHED __builtin_amdgcn_sched_barrier(0)
    Unit cur, nxt; int ui = 0;
    if (!S.next(0, cur)) return;
    f32x4 acc[2][2][4][2];
#pragma unroll
    for (int a = 0; a < 2; ++a)
#pragma unroll
        for (int b = 0; b < 2; ++b)
#pragma unroll
            for (int m = 0; m < 4; ++m)
#pragma unroll
                for (int n = 0; n < 2; ++n) acc[a][b][m][n] = (f32x4){0.f, 0.f, 0.f, 0.f};
    bf16x8 At[4][2], B0[2][2], B1[2][2];
    const char* cA = cur.a; const char* cB = cur.b;
    PG8_STAGE(PG8_SB(0, 0), cB, voffB); PG8_STAGE(PG8_SB(0, 1), cB + hstepB, voffB); PG8_STAGE(PG8_SA(0, 0), cA, voffA); PG8_STAGE(PG8_SA(0, 1), cA + hstepA, voffA);
    if (wr == 1) PG8_BAR;
    PG8_WAIT_V(2); PG8_BAR;
    PG8_STAGE(PG8_SB(1, 0), cB + kstep, voffB); PG8_STAGE(PG8_SA(1, 0), cA + kstepA, voffA); PG8_STAGE(PG8_SB(1, 1), cB + hstepB + kstep, voffB);
    PG8_WAIT_V(6); PG8_BAR;
    for (;;) {
        const bool has_next = S.next(ui + 1, nxt);
        const char* nA = has_next ? nxt.a : cA; const char* nB = has_next ? nxt.b : cB;
        for (int t = 0; t < nt; t += 2) {
            const bool last = (t == nt - 2);
            const char* a1 = cA + (size_t)(t + 1) * kstepA;
            const char* a2 = last ? nA : cA + (size_t)(t + 2) * kstepA; const char* b2 = last ? nB : cB + (size_t)(t + 2) * kstep;
            const char* a3 = a2 + kstepA; const char* b3 = b2 + kstep;
            PG8_LDB(B0, 0, 0); PG8_LDB(B1, 0, 1); PG8_SCHED; PG8_LDA(At, 0, 0); PG8_STAGE(PG8_SA(1, 1), a1 + hstepA, voffA);
            PG8_WAIT_V(8); PG8_WAIT_L(0); PG8_BAR; PG8_MMA(0, 0, At, B0); PG8_MMA(0, 1, At, B1); PG8_BAR; PG8_SCHED;
            PG8_LDA(At, 0, 1); PG8_STAGE(PG8_SB(0, 0), b2, voffB); PG8_STAGE(PG8_SB(0, 1), b2 + hstepB, voffB); PG8_STAGE(PG8_SA(0, 0), a2, voffA);
            PG8_WAIT_V(8); PG8_WAIT_L(0); PG8_BAR; PG8_MMA(1, 0, At, B0); PG8_MMA(1, 1, At, B1); PG8_BAR; PG8_SCHED;
            PG8_LDB(B0, 1, 0); PG8_LDB(B1, 1, 1); PG8_SCHED; PG8_LDA(At, 1, 0); PG8_STAGE(PG8_SA(0, 1), a2 + hstepA, voffA);
            PG8_WAIT_V(8); PG8_WAIT_L(0); PG8_BAR; PG8_MMA(0, 0, At, B0); PG8_MMA(0, 1, At, B1); PG8_BAR; PG8_SCHED;
            PG8_LDA(At, 1, 1); PG8_STAGE(PG8_SB(1, 0), b3, voffB); PG8_STAGE(PG8_SB(1, 1), b3 + hstepB, voffB); PG8_STAGE(PG8_SA(1, 0), a3, voffA);
            PG8_WAIT_V(8); PG8_WAIT_L(0); PG8_BAR; PG8_MMA(1, 0, At, B0); PG8_MMA(1, 1, At, B1); PG8_BAR; PG8_SCHED;
        }
        if (wr == 0) PG8_BAR;
        E(acc, cur, wr, wc, fr, fq);
        if (!has_next) break;
#pragma unroll
        for (int a = 0; a < 2; ++a)
#pragma unroll
            for (int b = 0; b < 2; ++b)
#pragma unroll
                for (int m = 0; m < 4; ++m)
#pragma unroll
                    for (int n = 0; n < 2; ++n) acc[a][b][m][n] = (f32x4){0.f, 0.f, 0.f, 0.f};
        cur = nxt; cA = nA; cB = nB; ++ui;
        if (wr == 1) PG8_BAR;
    }
    PG8_WAIT_V(0);
    PG8_BAR;
#undef PG8_SA
#undef PG8_SB
#undef PG8_STAGE
#undef PG8_LDA
#undef PG8_LDB
#undef PG8_MMA
#undef PG8_WAIT_V
#undef PG8_WAIT_L
#undef PG8_BAR
#undef PG8_SCHED
}
}

struct EpiSwiGLU {
    bf16_t* O;
    __device__ __forceinline__ void operator()(const f32x4 (&acc)[2][2][4][2], const pg8::Unit& u, int wr, int wc, int, int) const { const int ln_ = lane_now(); const int fr = ln_ & 15, fq = ln_ >> 4;
        const int row0 = u.pm * 256 + wr * 64 + fr, hc0 = u.pn * 128 + wc * 16 + 4 * fq;
#pragma unroll
        for (int ai = 0; ai < 2; ++ai)
#pragma unroll
            for (int m = 0; m < 4; ++m) { bf16_t* rowp = O + (size_t)(row0 + ai * 128 + m * 16) * DFF + hc0;
#pragma unroll
                for (int bj = 0; bj < 2; ++bj) { const f32x4 a = acc[ai][bj][m][0], b = acc[ai][bj][m][1];
                    u32x2 w; w.x = cvt_pk_bf16(siluf_(a[0]) * b[0], siluf_(a[1]) * b[1]); w.y = cvt_pk_bf16(siluf_(a[2]) * b[2], siluf_(a[3]) * b[3]);
                    *(u32x2*)(rowp + bj * 64) = w; } }
    }
};
struct EpiResid {
    float* H; const float* gate; float cg;
    __device__ __forceinline__ void operator()(const f32x4 (&acc)[2][2][4][2], const pg8::Unit& u, int wr, int wc, int, int) const { const int ln_ = lane_now(); const int fr = ln_ & 15, fq = ln_ >> 4;
        const int pp = u.pm % PPB, mi = (pp == 0) ? 4 : (u.pm / PPB);
        const int row0 = u.pm * 256 + wr * 64 + fr, col0 = u.pn * 256 + wc * 32 + 4 * fq;
        f32x4 gv[2][2];
#pragma unroll
        for (int bj = 0; bj < 2; ++bj)
#pragma unroll
            for (int n = 0; n < 2; ++n) gv[bj][n] = *(const f32x4*)(gate + (size_t)mi * NMOD + col0 + bj * 128 + n * 16) * cg;
#pragma unroll
        for (int ai = 0; ai < 2; ++ai)
#pragma unroll
            for (int m = 0; m < 4; ++m) { float* rowp = H + (size_t)(row0 + ai * 128 + m * 16) * D + col0;
#pragma unroll
                for (int bj = 0; bj < 2; ++bj)
#pragma unroll
                    for (int n = 0; n < 2; ++n) { f32x4* p = (f32x4*)(rowp + bj * 128 + n * 16); *p = *p * DN_ALPHA + gv[bj][n] * acc[ai][bj][m][n]; } }
    }
};
struct EpiProj {
    bf16_t* P; float* DT; const float* rc; const float* rs;
    __device__ __forceinline__ void operator()(const f32x4 (&acc)[2][2][4][2], const pg8::Unit& u, int wr, int wc, int, int) const { const int ln_ = lane_now(); const int fr = ln_ & 15, fq = ln_ >> 4;
        const int pp = u.pm % PPB; const int row0 = u.pm * 256 + wr * 64 + fr;
        const int pn = u.pn;
        if (pn == 52) {
            if (wc == 0) {
#pragma unroll
                for (int ai = 0; ai < 2; ++ai)
#pragma unroll
                    for (int m = 0; m < 4; ++m)
#pragma unroll
                        for (int n = 0; n < 2; ++n) *(f32x4*)(DT + (size_t)(row0 + ai * 128 + m * 16) * 32 + n * 16 + 4 * fq) = acc[ai][0][m][n];
            }
            return;
        }
        const int col0 = pn * 256 + wc * 32 + 4 * fq;
        const int mode = (pn < 8) ? ((pp != 0) ? 1 : 0) : ((pn >= 12 && pn < 16) ? 2 : (pn >= 28 ? 3 : 0));
        const float sc = (pn < 4) ? QSCALE : 1.0f;
#pragma unroll
        for (int ai = 0; ai < 2; ++ai)
#pragma unroll
            for (int m = 0; m < 4; ++m) { const int rl = ai * 128 + wr * 64 + m * 16 + fr; bf16_t* rowp = P + (size_t)(u.pm * 256 + rl) * LDP + col0;
                f32x4 cs = (f32x4){1.f, 1.f, 1.f, 1.f}, sn = (f32x4){0.f, 0.f, 0.f, 0.f};
                if (mode == 1) { const int t = (pp - 1) * 256 + rl; const int pos = (wc & 1) ? (t & 63) : (t >> 6); cs = *(const f32x4*)(rc + pos * 16 + 4 * fq); sn = *(const f32x4*)(rs + pos * 16 + 4 * fq); }
#pragma unroll
                for (int bj = 0; bj < 2; ++bj) { f32x4 v0 = acc[ai][bj][m][0], v1 = acc[ai][bj][m][1];
                    if (mode == 1) { const f32x4 o0 = v0 * cs - v1 * sn, o1 = v1 * cs + v0 * sn; v0 = o0; v1 = o1; }
                    else if (mode == 2) {
#pragma unroll
                        for (int e = 0; e < 4; ++e) { v0[e] = siluf_(v0[e]); v1[e] = siluf_(v1[e]); } }
                    else if (mode == 3) {
#pragma unroll
                        for (int e = 0; e < 4; ++e) { v0[e] = sigmoidf_(v0[e]); v1[e] = sigmoidf_(v1[e]); } }
                    v0 = v0 * sc; v1 = v1 * sc;
                    u32x2 w0, w1; w0.x = cvt_pk_bf16(v0[0], v0[1]); w0.y = cvt_pk_bf16(v0[2], v0[3]); w1.x = cvt_pk_bf16(v1[0], v1[1]); w1.y = cvt_pk_bf16(v1[2], v1[3]);
                    *(u32x2*)(rowp + bj * 128) = w0; *(u32x2*)(rowp + bj * 128 + 16) = w1; } }
    }
};
struct EpiGlu {
    bf16_t* P; const float* bias;
    __device__ __forceinline__ void operator()(const f32x4 (&acc)[2][2][4][2], const pg8::Unit& u, int wr, int wc, int, int) const { const int ln_ = lane_now(); const int fr = ln_ & 15, fq = ln_ >> 4;
        const int row0 = u.pm * 256 + wr * 64 + fr, col0 = u.pn * 256 + wc * 32 + 4 * fq;
#pragma unroll
        for (int ai = 0; ai < 2; ++ai)
#pragma unroll
            for (int m = 0; m < 4; ++m) { bf16_t* rowp = P + (size_t)(row0 + ai * 128 + m * 16) * LDP;
#pragma unroll
                for (int bj = 0; bj < 2; ++bj)
#pragma unroll
                    for (int n = 0; n < 2; ++n) { const int c = col0 + bj * 128 + n * 16; const f32x4 bv = *(const f32x4*)(bias + c); const u32x2 tv = *(const u32x2*)(rowp + PU + c);
                        const f32x4 a = acc[ai][bj][m][n] + bv; u32x2 w;
                        w.x = cvt_pk_bf16(bflo(tv.x) * sigmoidf_(a[0]), bfhi(tv.x) * sigmoidf_(a[1])); w.y = cvt_pk_bf16(bflo(tv.y) * sigmoidf_(a[2]), bfhi(tv.y) * sigmoidf_(a[3]));
                        *(u32x2*)(rowp + PK + c) = w; } }
    }
};
struct EpiBranch {
    const bf16_t* P; float* MIX; bf16_t* MIXB;
    __device__ __forceinline__ void operator()(const f32x4 (&acc)[2][2][4][2], const pg8::Unit& u, int wr, int wc, int, int) const { const int ln_ = lane_now(); const int fr = ln_ & 15, fq = ln_ >> 4;
        const int row0 = u.pm * 256 + wr * 64 + fr, col0 = u.pn * 256 + wc * 32 + 4 * fq; const int j = u.aux;
#pragma unroll
        for (int ai = 0; ai < 2; ++ai)
#pragma unroll
            for (int m = 0; m < 4; ++m) { const size_t row = (size_t)(row0 + ai * 128 + m * 16);
#pragma unroll
                for (int bj = 0; bj < 2; ++bj)
#pragma unroll
                    for (int n = 0; n < 2; ++n) { const int c = col0 + bj * 128 + n * 16; const u32x2 gv = *(const u32x2*)(P + row * LDP + PG + j * D + c);
                        f32x4 v = acc[ai][bj][m][n]; v[0] *= bflo(gv.x); v[1] *= bfhi(gv.x); v[2] *= bflo(gv.y); v[3] *= bfhi(gv.y);
                        f32x4* mp = (f32x4*)(MIX + row * D + c);
                        if (j == 0) *mp = v; else if (j == 1) *mp = *mp + v;
                        else { v = *mp + v; u32x2 w; w.x = cvt_pk_bf16(v[0], v[1]); w.y = cvt_pk_bf16(v[2], v[3]); *(u32x2*)(MIXB + row * D + c) = w; } } }
    }
};


struct S5AOrder {
    int G, c; const char* A; const char* B;
    __device__ __forceinline__ bool next(int i, pg8::Unit& u) const {
        const int idx = i * G + c; if (idx >= 640) return false;
        const int g = idx / 10, r = idx - 10 * g, nt = r / 5, mt = r - 5 * nt;
        u.pm = mt; u.pn = nt; u.aux = g; u.pad = 0; u.a = A + (size_t)(16 * g) * 2 + (size_t)mt * 256 * 16 * LDP * 2; u.b = B + (size_t)(g * 512 + nt * 256) * 256 * 2; return true;
    }
};
struct EpiS5A {
    bf16_t* YL; float* ST;
    __device__ __forceinline__ void operator()(const f32x4 (&acc)[2][2][4][2], const pg8::Unit& u, int wr, int wc, int, int) const { const int ln_ = lane_now(); const int fr = ln_ & 15, fq = ln_ >> 4;
        const int g = u.aux;
#pragma unroll
        for (int ai = 0; ai < 2; ++ai)
#pragma unroll
            for (int m = 0; m < 4; ++m) { const int mr = u.pm * 256 + ai * 128 + wr * 64 + m * 16 + fr; if (mr < S5M) {
#pragma unroll
                for (int bj = 0; bj < 2; ++bj)
#pragma unroll
                    for (int n = 0; n < 2; ++n) { const f32x4 v = acc[ai][bj][m][n];
                        if (u.pn == 0) { const int rho = 8 * bj + 2 * wc + n; u32x2 w; w.x = cvt_pk_bf16(v[0], v[1]); w.y = cvt_pk_bf16(v[2], v[3]); *(u32x2*)(YL + (size_t)(16 * mr + rho) * 1024 + 16 * g + 4 * fq) = w; }
                        else *(f32x4*)(ST + ((size_t)g * S5M + mr) * 256 + bj * 128 + wc * 32 + n * 16 + 4 * fq) = v; } } }
    }
};
struct S5COrder {
    int G, c; const char* A; const char* B;
    __device__ __forceinline__ bool next(int i, pg8::Unit& u) const {
        const int idx = i * G + c; if (idx >= 320) return false;
        const int g = idx / 5, mt = idx - 5 * g;
        u.pm = mt; u.pn = 0; u.aux = g; u.pad = 0; u.a = A + ((size_t)g * 1280 + mt * 256) * 256 * 2; u.b = B + (size_t)g * 256 * 256 * 2; return true;
    }
};
struct EpiS5C {
    const bf16_t* YL; bf16_t* P;
    __device__ __forceinline__ void operator()(const f32x4 (&acc)[2][2][4][2], const pg8::Unit& u, int wr, int wc, int, int) const { const int ln_ = lane_now(); const int fr = ln_ & 15, fq = ln_ >> 4;
        const int g = u.aux;
#pragma unroll
        for (int ai = 0; ai < 2; ++ai)
#pragma unroll
            for (int m = 0; m < 4; ++m) { const int mr = u.pm * 256 + ai * 128 + wr * 64 + m * 16 + fr; if (mr < S5M) {
#pragma unroll
                for (int bj = 0; bj < 2; ++bj)
#pragma unroll
                    for (int n = 0; n < 2; ++n) { const int rho = 8 * bj + 2 * wc + n; const size_t row = (size_t)(16 * mr + rho);
                        const u32x2 yl = *(const u32x2*)(YL + row * 1024 + 16 * g + 4 * fq); f32x4 v = acc[ai][bj][m][n];
                        v[0] += bflo(yl.x); v[1] += bfhi(yl.x); v[2] += bflo(yl.y); v[3] += bfhi(yl.y);
#pragma unroll
                        for (int e = 0; e < 4; ++e) { const float x = v[e]; const float inner = 0.7978845608028654f * (x + 0.044715f * x * x * x); const float th = 1.0f - 2.0f * __builtin_amdgcn_rcpf(1.0f + __builtin_amdgcn_exp2f(2.8853900817779268f * inner)); v[e] = 0.5f * x * (1.0f + th); }
                        u32x2 w; w.x = cvt_pk_bf16(v[0], v[1]); w.y = cvt_pk_bf16(v[2], v[3]); *(u32x2*)(P + row * LDP + PU + 16 * g + 4 * fq) = w; } } }
    }
};

namespace attn_body {
using bf16 = __hip_bfloat16;
constexpr int NW = 8, QBLK = 32, KVBLK = 64;
constexpr int PQKV = LDP, PO = 1024;
__device__ __forceinline__ int crow(int r, int hi) { return (r & 3) + 8 * (r >> 2) + 4 * hi; }
#define SBAR() __builtin_amdgcn_sched_barrier(0)
constexpr int NSLOT = 3, SLOTB = 8192;
constexpr int LDS_K = 0, LDS_V = NSLOT * SLOTB, LDS_WS = 2 * NSLOT * SLOTB, LDS_OST = LDS_WS + NW * 64 * 4, LDS_BYTES = LDS_OST + NW * 4096;
__device__ __forceinline__ void glds16(const void* gsrc, unsigned lds_dst) { unsigned keep;
  asm volatile("s_mov_b32 %0, m0\n\ts_mov_b32 m0, %2\n\ts_nop 0\n\tglobal_load_lds_dwordx4 %1, off\n\ts_mov_b32 m0, %0" : "=&s"(keep) : "v"(gsrc), "s"(lds_dst) : "memory"); }
__device__ __forceinline__ float max3f(float a, float b, float c) { float r; asm("v_max3_f32 %0, %1, %2, %3" : "=v"(r) : "v"(a), "v"(b), "v"(c)); return r; }
__device__ __forceinline__ float max2f(float a, float b) { float r; asm("v_max_f32_e32 %0, %1, %2" : "=v"(r) : "v"(a), "v"(b)); return r; }
__device__ __forceinline__ float fadd_s(float a, float b) { float r; asm("v_add_f32_e32 %0, %1, %2" : "=v"(r) : "v"(a), "v"(b)); return r; }
__device__ __forceinline__ float fsub_s(float a, float b) { float r; asm("v_sub_f32_e32 %0, %1, %2" : "=v"(r) : "v"(a), "v"(b)); return r; }
typedef float f32x2_t __attribute__((ext_vector_type(2))); typedef __bf16 bf16x2_t __attribute__((ext_vector_type(2)));
__device__ __forceinline__ unsigned cvtpk_s(float lo, float hi) { f32x2_t v = {lo, hi}; bf16x2_t b = __builtin_convertvector(v, bf16x2_t); return __builtin_bit_cast(unsigned, b); }
#define WAIT_BAR(N) asm volatile("s_waitcnt vmcnt(" #N ") lgkmcnt(0)\n\ts_barrier" ::: "memory")
__device__ __forceinline__ void qkt(f32x16& p0, f32x16& p1, const char* Kslot, const bf16x8* qr, const f32x16& negm, int r32, int hi) {
  const char* kb = Kslot + hi * 1024 + r32 * 16;
#pragma unroll
  for (int d0 = 0; d0 < 4; ++d0) {
    const bf16x8 b0 = *reinterpret_cast<const bf16x8*>(kb + d0 * 2048);
    const bf16x8 b1 = *reinterpret_cast<const bf16x8*>(kb + d0 * 2048 + 512);
    if (d0 == 0) { p0 = __builtin_amdgcn_mfma_f32_32x32x16_bf16(b0, qr[0], negm, 0, 0, 0); p1 = __builtin_amdgcn_mfma_f32_32x32x16_bf16(b1, qr[0], negm, 0, 0, 0); }
    else { p0 = __builtin_amdgcn_mfma_f32_32x32x16_bf16(b0, qr[d0], p0, 0, 0, 0); p1 = __builtin_amdgcn_mfma_f32_32x32x16_bf16(b1, qr[d0], p1, 0, 0, 0); } }
}
typedef __attribute__((address_space(3))) const char* lds_cptr;
typedef short v4i16_t __attribute__((ext_vector_type(4)));
__device__ __forceinline__ void kload8(bf16x8* kf, lds_cptr kp) {
  kf[0] = *(const __attribute__((address_space(3))) bf16x8*)(kp);        kf[1] = *(const __attribute__((address_space(3))) bf16x8*)(kp + 512);
  kf[2] = *(const __attribute__((address_space(3))) bf16x8*)(kp + 2048); kf[3] = *(const __attribute__((address_space(3))) bf16x8*)(kp + 2560);
  kf[4] = *(const __attribute__((address_space(3))) bf16x8*)(kp + 4096); kf[5] = *(const __attribute__((address_space(3))) bf16x8*)(kp + 4608);
  kf[6] = *(const __attribute__((address_space(3))) bf16x8*)(kp + 6144); kf[7] = *(const __attribute__((address_space(3))) bf16x8*)(kp + 6656);
}
__device__ __forceinline__ void kload2(bf16x8* kf, lds_cptr kp, int j) { kf[2 * j] = *(const __attribute__((address_space(3))) bf16x8*)(kp + j * 2048); kf[2 * j + 1] = *(const __attribute__((address_space(3))) bf16x8*)(kp + j * 2048 + 512); }
__device__ __forceinline__ s16x4 vtr(lds_cptr p) { return __builtin_bit_cast(s16x4, __builtin_amdgcn_ds_read_tr16_b64_v4i16((__attribute__((address_space(3))) v4i16_t*)p)); }
__device__ __forceinline__ float rowmax(const f32x16& p0, const f32x16& p1) {
  float a = max3f(p0[0], p0[1], p1[0]), b = max3f(p0[2], p0[3], p1[1]); a = max3f(a, p1[2], p1[3]);
#pragma unroll
  for (int r = 4; r < 16; r += 4) { a = max3f(a, p0[r], p0[r + 1]); b = max3f(b, p0[r + 2], p0[r + 3]); a = max3f(a, p1[r], p1[r + 1]); b = max3f(b, p1[r + 2], p1[r + 3]); }
  const float m = max2f(a, b);
  auto rr = __builtin_amdgcn_permlane32_swap(__float_as_uint(m), __float_as_uint(m), false, false);
  return max2f(__uint_as_float(rr[0]), __uint_as_float(rr[1]));
}
__device__ __forceinline__ void pv(f32x16* o, int vb, bf16x8 pa0, bf16x8 pa1, bf16x8 pa2, bf16x8 pa3) {
#pragma unroll
  for (int d0 = 0; d0 < 2; ++d0) { s16x4 lo[4], hi[4];
#pragma unroll
    for (int ks = 0; ks < 4; ++ks) {
      asm volatile("ds_read_b64_tr_b16 %0,%1 offset:%c2" : "=&v"(lo[ks]) : "v"(vb), "i"(d0 * 4096 + ks * 1024) : "memory");
      asm volatile("ds_read_b64_tr_b16 %0,%1 offset:%c2" : "=&v"(hi[ks]) : "v"(vb), "i"(d0 * 4096 + ks * 1024 + 512) : "memory"); }
    asm volatile("s_waitcnt lgkmcnt(0)" ::: "memory"); SBAR();
#define PK(k) (bf16x8){lo[k][0], lo[k][1], lo[k][2], lo[k][3], hi[k][0], hi[k][1], hi[k][2], hi[k][3]}
    o[d0] = __builtin_amdgcn_mfma_f32_32x32x16_bf16(pa0, PK(0), o[d0], 0, 0, 0);
    o[d0] = __builtin_amdgcn_mfma_f32_32x32x16_bf16(pa1, PK(1), o[d0], 0, 0, 0);
    o[d0] = __builtin_amdgcn_mfma_f32_32x32x16_bf16(pa2, PK(2), o[d0], 0, 0, 0);
    o[d0] = __builtin_amdgcn_mfma_f32_32x32x16_bf16(pa3, PK(3), o[d0], 0, 0, 0);
#undef PK
  }
}
template <int THRL> __device__ __forceinline__ void attn_unit(const bf16* Q0, const bf16* __restrict__ Kh, const bf16* __restrict__ Vh, bf16* O0, const int NT, char* shm, const int tid) {
  const int lane = tid & 63, r32 = lane & 31, hi = lane >> 5; const int wid = __builtin_amdgcn_readfirstlane(tid >> 6);
  const bf16* Qw = Q0 + (long)(wid * QBLK) * PQKV;
  const unsigned lds0 = (unsigned)(uintptr_t)shm;
  float* wsf = (float*)(shm + LDS_WS) + wid * 64;
  const bf16* ksrc = Kh + (long)lane * PQKV + wid * 8;
  const bf16* vsrc = Vh + (long)(16 * (wid & 3) + (lane >> 2)) * PQKV + (wid >> 2) * 32 + (lane & 3) * 8;
  const unsigned kdst = lds0 + LDS_K + wid * 1024, vdst = lds0 + LDS_V + wid * 1024;
#define DMA_K(t, slot) glds16(ksrc + (long)(t) * KVBLK * PQKV, (unsigned)__builtin_amdgcn_readfirstlane(kdst + (slot)))
#define DMA_V(t, slot) glds16(vsrc + (long)(t) * KVBLK * PQKV, (unsigned)__builtin_amdgcn_readfirstlane(vdst + (slot)))
  const int vb0 = (int)(lds0 + LDS_V) + ((lane >> 4) & 1) * 32 + (lane & 3) * 8 + (4 * hi + ((lane & 15) >> 2)) * 64;
  const char* Kbase = shm + LDS_K; bf16x8 kf[8];
  const lds_cptr shm3 = (lds_cptr)shm; const lds_cptr kp0 = shm3 + LDS_K + hi * 1024 + r32 * 16; const lds_cptr vp0 = shm3 + LDS_V + ((lane >> 4) & 1) * 32 + (lane & 3) * 8 + (4 * hi + ((lane & 15) >> 2)) * 64;
  DMA_K(0, 0); DMA_V(0, 0); DMA_K(1, SLOTB);
  bf16x8 qr[4];
#pragma unroll
  for (int d0 = 0; d0 < 4; ++d0) qr[d0] = *reinterpret_cast<const bf16x8*>(&Qw[(long)r32 * PQKV + d0 * 16 + hi * 8]);
  float zf_; asm volatile("v_mov_b32 %0, 0" : "=v"(zf_)); float mhat = 0.f, l_reg = 0.f; f32x16 o[2], negm;
  _Pragma("unroll") for (int r = 0; r < 16; ++r) { o[0][r] = zf_; o[1][r] = zf_; negm[r] = zf_; } asm volatile("" : "+v"(negm));
  bool resc = false;
#define START(P0, P1) do { const float rm = rowmax(P0, P1); resc = false; \
    { const float dl = rm; mhat = fadd_s(mhat, dl); \
      _Pragma("unroll") for (int r = 0; r < 16; ++r) { P0[r] = fsub_s(P0[r], dl); P1[r] = fsub_s(P1[r], dl); } \
      _Pragma("unroll") for (int r = 0; r < 16; ++r) negm[r] = -mhat; asm volatile("" : "+v"(negm)); } \
    _Pragma("unroll") for (int r = 0; r < 16; ++r) P0[r] = __builtin_amdgcn_exp2f(P0[r]); } while (0)
#define RESC() do { if (resc) { asm volatile("s_waitcnt lgkmcnt(0)" ::: "memory"); \
      _Pragma("unroll") for (int d_ = 0; d_ < 2; ++d_) _Pragma("unroll") for (int r = 0; r < 16; ++r) o[d_][r] *= wsf[crow(r, hi)]; } } while (0)
  f32x16 pA0, pA1, pB0, pB1;
  int sl_prev = 0, sl_cur = 0, sl_next = SLOTB;
#define ROT() do { sl_prev = sl_cur; sl_cur = sl_next; sl_next = (sl_next == (NSLOT - 1) * SLOTB) ? 0 : sl_next + SLOTB; } while (0)
  DMA_K(2, 2 * SLOTB);
  WAIT_BAR(3);
  qkt(pA0, pA1, Kbase, qr, negm, r32, hi); asm volatile("s_nop 15\n\ts_nop 7" : "+v"(pA0), "+v"(pA1));
  START(pA0, pA1);
  _Pragma("unroll") for (int r = 0; r < 16; ++r) pA1[r] = __builtin_amdgcn_exp2f(pA1[r]);
  WAIT_BAR(0);
  DMA_K(3, 0); DMA_V(1, SLOTB);
  ROT();
  kload8(kf, kp0 + sl_cur);
  WAIT_BAR(2);
  s16x4 vlo[8], vhi[8]; u32x4 pw0, pw1, pw2, pw3;
#define PKW(P, B) cvtpk_s(P[B], P[B + 1])
#define PAF(k) __builtin_bit_cast(bf16x8, pw##k)
#define VFR(i) (bf16x8){vlo[i][0], vlo[i][1], vlo[i][2], vlo[i][3], vhi[i][0], vhi[i][1], vhi[i][2], vhi[i][3]}
#define PIN(x) asm volatile("" : "+v"(x))
#define MX3(a, b, c) __builtin_fmaxf(__builtin_fmaxf((a), (b)), (c))
#define GAPA(MF, A0, A1, A2, A3, W0, W1, PW) do { MF; sacc += A0; sacc += A1; sacc += A2; sacc += A3; PIN(sacc); W0; W1; PIN(PW); SBAR(); } while (0)
#define EX(v) __builtin_amdgcn_exp2f(v)
#define GAPB(MF, X, B) do { MF; X[B] = EX(X[B]); X[B + 1] = EX(X[B + 1]); X[B + 2] = EX(X[B + 2]); X[B + 3] = EX(X[B + 3]); PIN(X); SBAR(); } while (0)
#define VRD(i) do { vlo[i] = vtr(vp_ + (((i) >> 2) * 4096 + ((i) & 3) * 1024)); vhi[i] = vtr(vp_ + (((i) >> 2) * 4096 + ((i) & 3) * 1024 + 512)); } while (0)
#define KRD(G, j) do { if (G) { kload2(kf, kp0 + sl_next, j); SBAR(); } } while (0)
#define STEP(C0, C1, P0, P1, t, GK, GV, GL) do { SBAR(); \
    const lds_cptr vp_ = vp0 + sl_prev; \
    VRD(0); SBAR(); float sacc = (P0[0] + P0[1]); \
    GAPA(C0 = __builtin_amdgcn_mfma_f32_32x32x16_bf16(kf[0], qr[0], negm, 0, 0, 0), P0[2], P0[3], P0[4], P0[5],     pw0[0] = PKW(P0, 0), pw0[1] = PKW(P0, 2), pw0); \
    VRD(4); SBAR(); GAPA(C1 = __builtin_amdgcn_mfma_f32_32x32x16_bf16(kf[1], qr[0], negm, 0, 0, 0), P0[6], P0[7], P0[8], P0[9],     pw0[2] = PKW(P0, 4), pw0[3] = PKW(P0, 6), pw0); \
    VRD(1); SBAR(); GAPA(C0 = __builtin_amdgcn_mfma_f32_32x32x16_bf16(kf[2], qr[1], C0, 0, 0, 0),   P0[10], P0[11], P0[12], P0[13], pw1[0] = PKW(P0, 8), pw1[1] = PKW(P0, 10), pw1); \
    VRD(5); SBAR(); GAPA(C1 = __builtin_amdgcn_mfma_f32_32x32x16_bf16(kf[3], qr[1], C1, 0, 0, 0),   P0[14], P0[15], P1[0], P1[1],   pw1[2] = PKW(P0, 12), pw1[3] = PKW(P0, 14), pw1); \
    VRD(2); SBAR(); GAPA(C0 = __builtin_amdgcn_mfma_f32_32x32x16_bf16(kf[4], qr[2], C0, 0, 0, 0),   P1[2], P1[3], P1[4], P1[5],     pw2[0] = PKW(P1, 0), pw2[1] = PKW(P1, 2), pw2); \
    VRD(6); SBAR(); GAPA(C1 = __builtin_amdgcn_mfma_f32_32x32x16_bf16(kf[5], qr[2], C1, 0, 0, 0),   P1[6], P1[7], P1[8], P1[9],     pw2[2] = PKW(P1, 4), pw2[3] = PKW(P1, 6), pw2); \
    VRD(3); SBAR(); GAPA(C0 = __builtin_amdgcn_mfma_f32_32x32x16_bf16(kf[6], qr[3], C0, 0, 0, 0),   P1[10], P1[11], P1[12], P1[13], pw3[0] = PKW(P1, 8), pw3[1] = PKW(P1, 10), pw3); \
    VRD(7); SBAR(); GAPA(C1 = __builtin_amdgcn_mfma_f32_32x32x16_bf16(kf[7], qr[3], C1, 0, 0, 0),   P1[14], P1[15], 0.f, 0.f,       pw3[2] = PKW(P1, 12), pw3[3] = PKW(P1, 14), pw3); \
    l_reg += sacc; \
    if (GK) { DMA_K((t) + 3, sl_cur); } if (GV) { DMA_V((t) + 1, sl_next); } \
    { float a = MX3(C0[0], C0[1], C1[0]), b = MX3(C0[2], C0[3], C1[1]); a = MX3(a, C1[2], C1[3]); \
      _Pragma("unroll") for (int r = 4; r < 16; r += 4) { a = MX3(a, C0[r], C0[r + 1]); b = MX3(b, C0[r + 2], C0[r + 3]); a = MX3(a, C1[r], C1[r + 1]); b = MX3(b, C1[r + 2], C1[r + 3]); } \
      float rm = __builtin_fmaxf(a, b); { auto rr = __builtin_amdgcn_permlane32_swap(__float_as_uint(rm), __float_as_uint(rm), false, false); rm = __builtin_fmaxf(__uint_as_float(rr[0]), __uint_as_float(rr[1])); } \
      resc = false; \
      if (__builtin_expect(__any(rm > (float)THRL), 0)) { const float dl = __builtin_fmaxf(rm, 0.f); mhat += dl; \
        _Pragma("unroll") for (int r = 0; r < 16; ++r) { C0[r] -= dl; C1[r] -= dl; } \
        _Pragma("unroll") for (int r = 0; r < 16; ++r) negm[r] = -mhat; asm volatile("" : "+v"(negm)); \
        const float f = __builtin_amdgcn_exp2f(-dl); l_reg *= f; if (hi == 0) wsf[r32] = f; resc = true; } } \
    SBAR(); \
    GAPB(o[0] = __builtin_amdgcn_mfma_f32_32x32x16_bf16(PAF(0), VFR(0), o[0], 0, 0, 0), C0, 0); \
    GAPB(o[1] = __builtin_amdgcn_mfma_f32_32x32x16_bf16(PAF(0), VFR(4), o[1], 0, 0, 0), C0, 4); \
    KRD(GL, 0); GAPB(o[0] = __builtin_amdgcn_mfma_f32_32x32x16_bf16(PAF(1), VFR(1), o[0], 0, 0, 0), C0, 8); \
    KRD(GL, 1); GAPB(o[1] = __builtin_amdgcn_mfma_f32_32x32x16_bf16(PAF(1), VFR(5), o[1], 0, 0, 0), C0, 12); \
    KRD(GL, 2); GAPB(o[0] = __builtin_amdgcn_mfma_f32_32x32x16_bf16(PAF(2), VFR(2), o[0], 0, 0, 0), C1, 0); \
    KRD(GL, 3); GAPB(o[1] = __builtin_amdgcn_mfma_f32_32x32x16_bf16(PAF(2), VFR(6), o[1], 0, 0, 0), C1, 4); \
    GAPB(o[0] = __builtin_amdgcn_mfma_f32_32x32x16_bf16(PAF(3), VFR(3), o[0], 0, 0, 0), C1, 8); \
    GAPB(o[1] = __builtin_amdgcn_mfma_f32_32x32x16_bf16(PAF(3), VFR(7), o[1], 0, 0, 0), C1, 12); \
    } while (0)
  int t = 1;
  for (; t + 5 < NT; t += 2) {
    STEP(pB0, pB1, pA0, pA1, t, true, true, true);     WAIT_BAR(2); RESC(); ROT();
    STEP(pA0, pA1, pB0, pB1, t + 1, true, true, true); WAIT_BAR(2); RESC(); ROT();
  }
#define ENDW(tt) do { if ((tt) + 3 < NT) { WAIT_BAR(2); } else if ((tt) + 2 < NT) { WAIT_BAR(1); } else { WAIT_BAR(0); } } while (0)
  for (; t + 1 < NT; t += 2) {
    STEP(pB0, pB1, pA0, pA1, t, (t + 3 < NT), (t + 1 < NT), (t + 1 < NT));         ENDW(t);     RESC(); ROT();
    STEP(pA0, pA1, pB0, pB1, t + 1, (t + 4 < NT), (t + 2 < NT), (t + 2 < NT));     ENDW(t + 1); RESC(); ROT();
  }
  STEP(pB0, pB1, pA0, pA1, NT - 1, false, false, false); RESC();
  { float sacc = pB0[0] + pB0[1]; _Pragma("unroll") for (int r = 2; r < 16; ++r) sacc += pB0[r]; _Pragma("unroll") for (int r = 0; r < 16; ++r) sacc += pB1[r]; l_reg += sacc;
    pw0 = (u32x4){PKW(pB0, 0), PKW(pB0, 2), PKW(pB0, 4), PKW(pB0, 6)}; pw1 = (u32x4){PKW(pB0, 8), PKW(pB0, 10), PKW(pB0, 12), PKW(pB0, 14)}; pw2 = (u32x4){PKW(pB1, 0), PKW(pB1, 2), PKW(pB1, 4), PKW(pB1, 6)}; pw3 = (u32x4){PKW(pB1, 8), PKW(pB1, 10), PKW(pB1, 12), PKW(pB1, 14)};
    SBAR(); pv(o, vb0 + sl_cur, PAF(0), PAF(1), PAF(2), PAF(3)); }
#undef PKW
#undef PAF
#undef VFR
#undef PIN
#undef MX3
#undef GAPA
#undef GAPB
#undef EX
#undef VRD
#undef KRD
#undef STEP
#undef ENDW
  { auto rr = __builtin_amdgcn_permlane32_swap(__float_as_uint(l_reg), __float_as_uint(l_reg), false, false); l_reg = __uint_as_float(rr[0]) + __uint_as_float(rr[1]); }
  if (hi == 0) wsf[32 + r32] = l_reg; asm volatile("s_waitcnt lgkmcnt(0)" ::: "memory");
  float rli[16];
#pragma unroll
  for (int r = 0; r < 16; ++r) rli[r] = __builtin_amdgcn_rcpf(wsf[32 + crow(r, hi)]);
  bf16* Ow = O0 + (long)(wid * QBLK) * PO;
  { bf16* stg = (bf16*)(shm + LDS_OST) + wid * 2048;
#pragma unroll
    for (int r = 0; r < 16; ++r) { const int orow = crow(r, hi);
#pragma unroll
      for (int d0 = 0; d0 < 2; ++d0) stg[orow * 64 + d0 * 32 + r32] = __float2bfloat16(o[d0][r] * rli[r]); }
    asm volatile("s_waitcnt lgkmcnt(0)" ::: "memory");
#pragma unroll
    for (int i = 0; i < 4; ++i) { const int row = i * 8 + (lane >> 3), ch = lane & 7; const u32x4 v = *(const u32x4*)(stg + row * 64 + ch * 8); *(u32x4*)(Ow + (long)row * PO + ch * 8) = v; } }
  asm volatile("s_waitcnt lgkmcnt(0)\n\ts_barrier" ::: "memory");
#undef DMA_K
#undef DMA_V
#undef START
#undef RESC
#undef ROT
}
#undef SBAR
#undef WAIT_BAR
}

#define XB_TMO      128
#define XB_XCNT(j)  (256  + 64 * (j))
#define XB_XSUB(j)  (1280 + 64 * (j))
#define XB_XGEN(j)  (2304 + 64 * (j))
#define XB_TOP      3328
#define XB_TOPGEN   3392
#define XCD_BAR_WORDS 3456
#define XB_SPIN_CAP (1u << 18)
__device__ __forceinline__ unsigned xb_ld(unsigned* p)              { return __hip_atomic_load(p, __ATOMIC_RELAXED, __HIP_MEMORY_SCOPE_AGENT); }
__device__ __forceinline__ unsigned xb_add(unsigned* p, unsigned v) { return __hip_atomic_fetch_add(p, v, __ATOMIC_RELAXED, __HIP_MEMORY_SCOPE_AGENT); }
__device__ __forceinline__ unsigned xb_xcc_id() { return (unsigned)__builtin_amdgcn_s_getreg((3 << 11) | 20) & 0xFu; }
#define XB_SPIN(cond, bar) do { unsigned _sp = 0; while (cond) { __builtin_amdgcn_s_sleep(1); \
    if ((++_sp & 255u) == 0u) { if (xb_ld(&(bar)[XB_TMO])) break; if (_sp > XB_SPIN_CAP) { atomicAdd(&(bar)[XB_TMO], 1u); break; } } } } while (0)
struct XcdBarrier { unsigned* bar; unsigned x; volatile LAS unsigned* st; };
__device__ __forceinline__ XcdBarrier xcd_barrier_post(unsigned* bar, volatile LAS unsigned* st) {
    XcdBarrier b; b.bar = bar; b.x = xb_xcc_id(); b.st = st;
    if (threadIdx.x == 0) (void)xb_add(&bar[XB_XCNT(b.x)], 1u);
    return b;
}
__device__ __forceinline__ void xcd_barrier_complete(unsigned* bar, unsigned x, unsigned& nloc, unsigned& nx) {
    const unsigned G = gridDim.x * gridDim.y * gridDim.z;
    unsigned sum, cnt, mine, sp = 0u;
    for (;;) {
        sum = 0u; cnt = 0u; mine = 0u;
#pragma unroll
        for (unsigned j = 0; j < 16; ++j) { const unsigned c = xb_ld(&bar[XB_XCNT(j)]); sum += c; cnt += (c > 0u) ? 1u : 0u; mine = (j == x) ? c : mine; }
        if (sum == G) break;
        __builtin_amdgcn_s_sleep(1);
        if ((++sp & 255u) == 0u) { if (xb_ld(&bar[XB_TMO])) break; if (sp > XB_SPIN_CAP) { atomicAdd(&bar[XB_TMO], 1u); break; } }
    }
    nloc = mine > 0u ? mine : 1u; nx = cnt > 0u ? cnt : 1u;
}
__device__ __forceinline__ void xcd_barrier(const XcdBarrier& b, const int tid) {
    asm volatile("s_waitcnt vmcnt(0)" ::: "memory");
    __syncthreads();
    if (tid == 0) {
        unsigned* bar = b.bar;
        __builtin_amdgcn_s_waitcnt(0);
        unsigned nloc = b.st[0], nx = b.st[1];
        if (nloc == 0u) { xcd_barrier_complete(bar, b.x, nloc, nx); b.st[0] = nloc; b.st[1] = nx; }
        const unsigned old = xb_add(&bar[XB_XSUB(b.x)], 1u);
        const unsigned gen = old / nloc;
        if (old + 1u == (gen + 1u) * nloc) {
            __builtin_amdgcn_fence(__ATOMIC_RELEASE, "agent");
            asm volatile("s_waitcnt vmcnt(0)" ::: "memory");
            const unsigned og = xb_add(&bar[XB_TOP], 1u);
            const unsigned tg = og / nx;
            if (og + 1u == (tg + 1u) * nx) xb_add(&bar[XB_TOPGEN], 1u);
            else XB_SPIN(xb_ld(&bar[XB_TOPGEN]) == tg, bar);
            __builtin_amdgcn_fence(__ATOMIC_ACQUIRE, "agent");
            xb_add(&bar[XB_XGEN(b.x)], 1u);
            asm volatile("s_waitcnt vmcnt(0)" ::: "memory");
        } else {
            XB_SPIN(xb_ld(&bar[XB_XGEN(b.x)]) == gen, bar);
            __builtin_amdgcn_fence(__ATOMIC_ACQUIRE, "agent");
            asm volatile("s_waitcnt vmcnt(0)" ::: "memory");
        }
    }
    __syncthreads();
}

constexpr int NWAVES = 8;
constexpr int RING_OFF = 0, RING_BYTES = 131072;
constexpr int LDSCTL_OFF = RING_BYTES, MISC_OFF = LDSCTL_OFF + 320;
constexpr int LDS_BYTES = 147456;
static_assert(attn_body::LDS_BYTES <= RING_BYTES, "attention scratch fits the ring");

struct Args { const float* in[32]; float* out; unsigned char* ws; int ph_lo, ph_hi; };
struct Frame {
    LAS unsigned char* lds; int tid, lane, wave, vcu, G, gw, NGW;
    unsigned char* ws;
};
enum { I_X = 0, I_C, I_CTX, I_CCTX, I_WMOD, I_BMOD, I_LNG, I_LNB, I_W1, I_W3, I_W2, I_WIN, I_ALAM, I_ASUB, I_CONVW, I_CONVB, I_ALOG, I_DTB, I_SSDD, I_SSDN,
       I_LRE, I_LIM, I_LSTEP, I_BRE, I_BIM, I_CRE, I_CIM, I_S5D, I_GLUW, I_GLUB, I_WBR, I_WOUT };

__device__ __forceinline__ void transpose_item(const float* srcA, const float* srcB, int ldn, bf16_t* dst, int ldk, LAS float* scr, int lane) {
    const int c = lane & 31; const float* src = (c < 16) ? (srcA ? srcA + c : nullptr) : (srcB ? srcB + (c - 16) : nullptr);
#pragma unroll 8
    for (int i = 0; i < 32; ++i) { const int kk = 2 * i + (lane >> 5); scr[kk * 33 + c] = src ? src[(size_t)kk * ldn] : 0.f; }
    LDS_WAIT(); asm volatile("" ::: "memory");
    const int c8 = lane & 7;
#pragma unroll
    for (int j = 0; j < 4; ++j) { const int n = (lane >> 3) + 8 * j; const LAS float* s = scr + (8 * c8) * 33 + n;
        u32x4 o; o.x = cvt_pk_bf16(s[0 * 33], s[1 * 33]); o.y = cvt_pk_bf16(s[2 * 33], s[3 * 33]); o.z = cvt_pk_bf16(s[4 * 33], s[5 * 33]); o.w = cvt_pk_bf16(s[6 * 33], s[7 * 33]);
        *(u32x4*)(dst + (size_t)n * ldk + 8 * c8) = o; }
    LDS_WAIT(); asm volatile("" ::: "memory");
}
__device__ __forceinline__ void convert_layer_weights(const Args& A_, Frame& F, int l) {
    LAS float* scr = (LAS float*)(F.lds + RING_OFF + F.wave * 16384);
    unsigned char* W = F.ws + WS_W;
    constexpr int I13 = 32 * 352, I2 = 88 * 64, IIN = 32 * 424, IB = 16 * 64, IO = 32 * 64, IG = 16 * 32;
    constexpr int NIT = 2 * I13 + 2 * I2 + IIN + 3 * IB + IO + IG;
    for (int it = F.gw; it < NIT; it += F.NGW) {
        int r = it;
        if (r < 2 * I13) { const int f = r / I13; r -= f * I13; const int kb = r / 352, nb = r % 352;
            const float* w1 = A_.in[I_W1] + ((size_t)(l * 2 + f) * D + 64 * kb) * DFF + 16 * nb; const float* w3 = A_.in[I_W3] + ((size_t)(l * 2 + f) * D + 64 * kb) * DFF + 16 * nb;
            transpose_item(w1, w3, DFF, (bf16_t*)(W + W_13) + ((size_t)f * N13 + 32 * nb) * D + 64 * kb, D, scr, F.lane); continue; }
        r -= 2 * I13;
        if (r < 2 * I2) { const int f = r / I2; r -= f * I2; const int kb = r / 64, nb = r % 64;
            const float* w2 = A_.in[I_W2] + ((size_t)(l * 2 + f) * DFF + 64 * kb) * D + 32 * nb;
            transpose_item(w2, w2 + 16, D, (bf16_t*)(W + W_2) + ((size_t)f * D + 32 * nb) * DFF + 64 * kb, DFF, scr, F.lane); continue; }
        r -= 2 * I2;
        if (r < IIN) { const int kb = r / 424, nb = r % 424; const int n0 = 32 * nb; int sc = -1;
            if (n0 < 6144) sc = n0; else if (n0 < 13312) sc = n0 + 32; else if (n0 == 13312) sc = 6144;
            const float* w = (sc >= 0) ? A_.in[I_WIN] + ((size_t)l * D + 64 * kb) * 13344 + sc : nullptr;
            transpose_item(w, w ? w + 16 : nullptr, 13344, (bf16_t*)(W + W_IN) + (size_t)n0 * D + 64 * kb, D, scr, F.lane); continue; }
        r -= IIN;
        if (r < 3 * IB) { const int j = r / IB; r -= j * IB; const int kb = r / 64, nb = r % 64;
            const float* w = A_.in[I_WBR] + ((size_t)(l * 3 + j) * 1024 + 64 * kb) * D + 32 * nb;
            transpose_item(w, w + 16, D, (bf16_t*)(W + W_B) + ((size_t)j * D + 32 * nb) * 1024 + 64 * kb, 1024, scr, F.lane); continue; }
        r -= 3 * IB;
        if (r < IO) { const int kb = r / 64, nb = r % 64; const float* w = A_.in[I_WOUT] + ((size_t)l * D + 64 * kb) * D + 32 * nb;
            transpose_item(w, w + 16, D, (bf16_t*)(W + W_O) + (size_t)(32 * nb) * D + 64 * kb, D, scr, F.lane); continue; }
        r -= IO;
        { const int kb = r / 32, nb = r % 32; const float* w = A_.in[I_GLUW] + ((size_t)l * 1024 + 64 * kb) * 1024 + 32 * nb;
            transpose_item(w, w + 16, 1024, (bf16_t*)(W + W_GLU) + (size_t)(32 * nb) * 1024 + 64 * kb, 1024, scr, F.lane); }
    }
}
__device__ __forceinline__ void mod_partials(const Args& A_, Frame& F) {
    float* MODP = (float*)(F.ws + WS_MODP);
    for (int it = F.gw; it < 2 * 72 * 16; it += F.NGW) {
        const int l = it / (72 * 16), r = it % (72 * 16), ks = r / 72, cg = r % 72;
        const int col = cg * 256 + F.lane * 4; const float* w = A_.in[I_WMOD] + ((size_t)l * D + ks * 128) * NMOD + col;
        f32x4 a0 = {0.f, 0.f, 0.f, 0.f}, a1 = a0, a2 = a0, a3 = a0, a4 = a0;
        const float* c = A_.in[I_C] + ks * 128; const float* cc = A_.in[I_CCTX] + ks * 128;
#pragma unroll 4
        for (int k = 0; k < 128; ++k) { const f32x4 wv = *(const f32x4*)(w + (size_t)k * NMOD);
            a0 += wv * siluf_(c[k]); a1 += wv * siluf_(c[D + k]); a2 += wv * siluf_(c[2 * D + k]); a3 += wv * siluf_(c[3 * D + k]); a4 += wv * siluf_(cc[k]); }
        float* o = MODP + ((size_t)(l * 16 + ks) * 5) * NMOD + col;
        *(f32x4*)(o) = a0; *(f32x4*)(o + NMOD) = a1; *(f32x4*)(o + 2 * NMOD) = a2; *(f32x4*)(o + 3 * NMOD) = a3; *(f32x4*)(o + 4 * NMOD) = a4;
    }
}
__device__ __forceinline__ void ln_pass(Frame& F, bool do_ln, const float* lng, const float* lnb, const float* modnext  , float* out) {
    float* H = (float*)(F.ws + WS_H); bf16_t* HM = (bf16_t*)(F.ws + WS_HM);
    for (int row = F.gw; row < R; row += F.NGW) {
        const int b = row / RB, rr = row % RB; const int mi = (rr < CTX) ? 4 : b;
        float* hr = H + (size_t)row * D;
        f32x4 v[8]; float s = 0.f;
#pragma unroll
        for (int i = 0; i < 8; ++i) { v[i] = *(const f32x4*)(hr + 256 * i + 4 * F.lane); s += (v[i][0] + v[i][1]) + (v[i][2] + v[i][3]); }
        if (do_ln) {
            const float mean = wave_sum(s, F.lane) * (1.f / D); float s2 = 0.f;
#pragma unroll
            for (int i = 0; i < 8; ++i) { v[i] = v[i] - mean; s2 += (v[i][0] * v[i][0] + v[i][1] * v[i][1]) + (v[i][2] * v[i][2] + v[i][3] * v[i][3]); }
            const float rstd = 1.0f / sqrtf(wave_sum(s2, F.lane) * (1.f / D) + LN_EPS);
#pragma unroll
            for (int i = 0; i < 8; ++i) { const f32x4 g = *(const f32x4*)(lng + 256 * i + 4 * F.lane), bb = *(const f32x4*)(lnb + 256 * i + 4 * F.lane); v[i] = v[i] * rstd * g + bb; *(f32x4*)(hr + 256 * i + 4 * F.lane) = v[i]; }
        }
        if (modnext) {
            const float* sh = modnext + (size_t)mi * NMOD; const float* sc = sh + D;
#pragma unroll
            for (int i = 0; i < 8; ++i) { const f32x4 a = *(const f32x4*)(sh + 256 * i + 4 * F.lane), c = *(const f32x4*)(sc + 256 * i + 4 * F.lane); const f32x4 m = v[i] * (c + 1.0f) + a;
                u32x2 w; w.x = cvt_pk_bf16(m[0], m[1]); w.y = cvt_pk_bf16(m[2], m[3]); *(u32x2*)(HM + (size_t)row * D + 256 * i + 4 * F.lane) = w; }
        }
        if (out && rr >= CTX) { float* orow = out + ((size_t)b * SEQ + (rr - CTX)) * D;
#pragma unroll
            for (int i = 0; i < 8; ++i) *(f32x4*)(orow + 256 * i + 4 * F.lane) = v[i]; }
    }
}

__device__ __forceinline__ void ssd_conv_pass(const Args& A_, Frame& F, int l) {
    const bf16_t* P = (const bf16_t*)(F.ws + WS_PROJ); bf16_t* XC = (bf16_t*)(F.ws + WS_HM); float* DT = (float*)(F.ws + WS_DT);
    const float* cw = A_.in[I_CONVW] + (size_t)l * 5 * 2048; const float* cb = A_.in[I_CONVB] + (size_t)l * 2048;
    for (int it = F.gw; it < R * 4; it += F.NGW) {
        const int row = it >> 2, c0 = (it & 3) * 512 + F.lane * 8; const int rr = row % RB; const int lo = (rr < CTX) ? 0 : CTX, hi = (rr < CTX) ? CTX : RB;
        float acc[8];
#pragma unroll
        for (int e = 0; e < 8; ++e) acc[e] = cb[c0 + e];
#pragma unroll
        for (int k = 0; k < 5; ++k) { const int r2 = rr + k - 2;
            if (r2 >= lo && r2 < hi) { const u32x4 xv = *(const u32x4*)(P + (size_t)(row + k - 2) * LDP + PX + c0); const f32x4 w0 = *(const f32x4*)(cw + k * 2048 + c0), w1 = *(const f32x4*)(cw + k * 2048 + c0 + 4);
                acc[0] += w0[0] * bflo(xv.x); acc[1] += w0[1] * bfhi(xv.x); acc[2] += w0[2] * bflo(xv.y); acc[3] += w0[3] * bfhi(xv.y);
                acc[4] += w1[0] * bflo(xv.z); acc[5] += w1[1] * bfhi(xv.z); acc[6] += w1[2] * bflo(xv.w); acc[7] += w1[3] * bfhi(xv.w); } }
        u32x4 o; o.x = cvt_pk_bf16(siluf_(acc[0]), siluf_(acc[1])); o.y = cvt_pk_bf16(siluf_(acc[2]), siluf_(acc[3])); o.z = cvt_pk_bf16(siluf_(acc[4]), siluf_(acc[5])); o.w = cvt_pk_bf16(siluf_(acc[6]), siluf_(acc[7]));
        *(u32x4*)(XC + (size_t)row * 2048 + c0) = o;
    }
    const float* dtb = A_.in[I_DTB] + l * 32;
    for (int i = (F.gw * 64 + F.lane); i < R * 32; i += F.NGW * 64) { const float x = DT[i] + dtb[i & 31]; DT[i] = fmaxf(x, 0.f) + log1pf(expf(-fabsf(x))); }
}
__device__ __forceinline__ int scan_row(int rb, int d, int step) { return d == 0 ? rb + step : (step < CTX ? rb + CTX - 1 - step : rb + (RB + CTX - 1) - step); }

__device__ __forceinline__ unsigned short bf16_1(float v) { return (unsigned short)(cvt_pk_bf16(v, 0.f) & 0xffffu); }
__device__ __forceinline__ void ssd_chain_fast(const Args& A_, Frame& F, int l, int cid) {
    constexpr int LS = 136;
    const int b = cid >> 6, d = (cid >> 5) & 1, hd = (cid >> 1) & 15, ph = cid & 1, g = hd >> 2; const int rb = b * RB;
    const bf16_t* XC = (const bf16_t*)(F.ws + WS_HM); const float* DT = (const float*)(F.ws + WS_DT); bf16_t* YD = (bf16_t*)(F.ws + WS_YD) + (size_t)d * R * 1024;
    const float a = -expf(A_.in[I_ALOG][l * 32 + d * 16 + hd]);
    LAS bf16_t* Cs = (LAS bf16_t*)(F.lds); LAS bf16_t* Bs = Cs + 128 * LS; LAS bf16_t* Ms = Bs + 128 * LS; LAS bf16_t* XdT = Ms + 128 * LS; LAS bf16_t* Hb = XdT + 32 * LS;
    LAS float* csL = (LAS float*)(Hb + 32 * LS); LAS float* ecsL = csL + 128; LAS float* ewL = ecsL + 128; LAS float* misc = ewL + 128;
    const int tid = F.tid, lane = F.lane, w = F.wave, r = lane & 31, h = lane >> 5;
    f32x16 hacc;
#pragma unroll
    for (int i = 0; i < 16; ++i) hacc[i] = 0.f;
    for (int i = tid; i < 32 * LS / 2; i += 512) ((LAS unsigned*)Hb)[i] = 0u;
    for (int k = 0; k < 34; ++k) {
        const int r0 = (d == 0) ? rb + 128 * k : (k < 2 ? rb + 128 * (1 - k) : rb + 256 + 128 * (33 - k));
        __syncthreads();
#pragma unroll
        for (int i = 0; i < 4; ++i) { const int item = tid + 512 * i, row = item >> 4, seg = item & 15; const bf16_t* src = XC + (size_t)(r0 + row) * 2048 + g * 128 + seg * 8;
            *(LAS u32x4*)(Cs + row * LS + seg * 8) = *(const u32x4*)(src + 1536); *(LAS u32x4*)(Bs + row * LS + seg * 8) = *(const u32x4*)(src + 1024); }
        { const int row = tid >> 2, seg = tid & 3; const float dtv = DT[(size_t)(r0 + row) * 32 + d * 16 + hd]; const u32x4 xv = *(const u32x4*)(XC + (size_t)(r0 + row) * 2048 + hd * 64 + ph * 32 + seg * 8);
            LAS bf16_t* xo = XdT + (seg * 8) * LS + row;
            xo[0 * LS] = bf16_1(bflo(xv.x) * dtv); xo[1 * LS] = bf16_1(bfhi(xv.x) * dtv); xo[2 * LS] = bf16_1(bflo(xv.y) * dtv); xo[3 * LS] = bf16_1(bfhi(xv.y) * dtv);
            xo[4 * LS] = bf16_1(bflo(xv.z) * dtv); xo[5 * LS] = bf16_1(bfhi(xv.z) * dtv); xo[6 * LS] = bf16_1(bflo(xv.w) * dtv); xo[7 * LS] = bf16_1(bfhi(xv.w) * dtv); }
        if (w == 0) {
            const int rho0 = d ? 127 - lane : lane, rho1 = d ? 63 - lane : 64 + lane;
            float v0 = DT[(size_t)(r0 + rho0) * 32 + d * 16 + hd] * a, v1 = DT[(size_t)(r0 + rho1) * 32 + d * 16 + hd] * a;
#pragma unroll
            for (int o = 1; o < 64; o <<= 1) { const float t0 = __int_as_float(__builtin_amdgcn_ds_bpermute((lane - o) << 2, __float_as_int(v0))), t1 = __int_as_float(__builtin_amdgcn_ds_bpermute((lane - o) << 2, __float_as_int(v1))); if (lane >= o) { v0 += t0; v1 += t1; } }
            const float tot0 = __int_as_float(__builtin_amdgcn_ds_bpermute(63 << 2, __float_as_int(v0))); v1 += tot0;
            const float cend = __int_as_float(__builtin_amdgcn_ds_bpermute(63 << 2, __float_as_int(v1)));
            csL[rho0] = v0; csL[rho1] = v1; ecsL[rho0] = __builtin_amdgcn_exp2f(v0 * 1.4426950408889634f); ecsL[rho1] = __builtin_amdgcn_exp2f(v1 * 1.4426950408889634f);
            ewL[rho0] = __builtin_amdgcn_exp2f((cend - v0) * 1.4426950408889634f); ewL[rho1] = __builtin_amdgcn_exp2f((cend - v1) * 1.4426950408889634f);
            if (lane == 0) misc[0] = __builtin_amdgcn_exp2f(cend * 1.4426950408889634f);
        }
        __syncthreads();
        { const int lt = w >> 1;
#pragma unroll
          for (int q = 0; q < 2; ++q) { const int st = (w & 1) * 2 + q; const bool zero = (d == 0) ? (st > lt) : (st < lt);
            f32x16 acc;
#pragma unroll
            for (int i = 0; i < 16; ++i) acc[i] = 0.f;
            if (!zero) {
#pragma unroll
                for (int ks = 0; ks < 8; ++ks) { const bf16x8 af = *(const LAS bf16x8*)(Cs + (32 * lt + r) * LS + 16 * ks + 8 * h), bfv = *(const LAS bf16x8*)(Bs + (32 * st + r) * LS + 16 * ks + 8 * h);
                    acc = __builtin_amdgcn_mfma_f32_32x32x16_bf16(af, bfv, acc, 0, 0, 0); } }
            const int scol = 32 * st + r; const float css = csL[scol];
#pragma unroll
            for (int rg = 0; rg < 16; ++rg) { const int lrow = 32 * lt + (rg & 3) + 8 * (rg >> 2) + 4 * h; const bool valid = (d == 0) ? (scol <= lrow) : (scol >= lrow);
                const float v = valid ? acc[rg] * __builtin_amdgcn_exp2f((csL[lrow] - css) * 1.4426950408889634f) : 0.f; Ms[lrow * LS + scol] = bf16_1(v); } } }
        __syncthreads();
        if (w < 4) { const int lt = w;
            f32x16 acc;
#pragma unroll
            for (int i = 0; i < 16; ++i) acc[i] = 0.f;
#pragma unroll
            for (int ks = 0; ks < 8; ++ks) { const bf16x8 af = *(const LAS bf16x8*)(Cs + (32 * lt + r) * LS + 16 * ks + 8 * h), bfv = *(const LAS bf16x8*)(Hb + r * LS + 16 * ks + 8 * h);
                acc = __builtin_amdgcn_mfma_f32_32x32x16_bf16(af, bfv, acc, 0, 0, 0); }
#pragma unroll
            for (int rg = 0; rg < 16; ++rg) acc[rg] *= ecsL[32 * lt + (rg & 3) + 8 * (rg >> 2) + 4 * h];
#pragma unroll
            for (int ks = 0; ks < 8; ++ks) { const bool skip = (d == 0) ? (16 * ks >= 32 * (lt + 1)) : (16 * ks + 15 < 32 * lt);
                if (!skip) { const bf16x8 af = *(const LAS bf16x8*)(Ms + (32 * lt + r) * LS + 16 * ks + 8 * h), bfv = *(const LAS bf16x8*)(XdT + r * LS + 16 * ks + 8 * h);
                    acc = __builtin_amdgcn_mfma_f32_32x32x16_bf16(af, bfv, acc, 0, 0, 0); } }
            bf16_t* yo = YD + (size_t)(r0 + 32 * lt + 4 * h) * 1024 + hd * 64 + ph * 32 + r;
#pragma unroll
            for (int rg = 0; rg < 16; ++rg) yo[(size_t)((rg & 3) + 8 * (rg >> 2)) * 1024] = bf16_1(acc[rg]);
        } else { const int nt = w - 4; const float eend = misc[0];
#pragma unroll
            for (int i = 0; i < 16; ++i) hacc[i] *= eend;
#pragma unroll
            for (int ks = 0; ks < 8; ++ks) { const int k0 = 16 * ks + 8 * h; const u32x4 xa = *(const LAS u32x4*)(XdT + r * LS + k0); const f32x4 e0 = *(const LAS f32x4*)(ewL + k0), e1 = *(const LAS f32x4*)(ewL + k0 + 4);
                u32x4 aw; aw.x = cvt_pk_bf16(bflo(xa.x) * e0[0], bfhi(xa.x) * e0[1]); aw.y = cvt_pk_bf16(bflo(xa.y) * e0[2], bfhi(xa.y) * e0[3]); aw.z = cvt_pk_bf16(bflo(xa.z) * e1[0], bfhi(xa.z) * e1[1]); aw.w = cvt_pk_bf16(bflo(xa.w) * e1[2], bfhi(xa.w) * e1[3]);
                const LAS bf16_t* bp = Bs + k0 * LS + 32 * nt + r; u32x4 bw;
                bw.x = (unsigned)bp[0 * LS] | ((unsigned)bp[1 * LS] << 16); bw.y = (unsigned)bp[2 * LS] | ((unsigned)bp[3 * LS] << 16); bw.z = (unsigned)bp[4 * LS] | ((unsigned)bp[5 * LS] << 16); bw.w = (unsigned)bp[6 * LS] | ((unsigned)bp[7 * LS] << 16);
                hacc = __builtin_amdgcn_mfma_f32_32x32x16_bf16(__builtin_bit_cast(bf16x8, aw), __builtin_bit_cast(bf16x8, bw), hacc, 0, 0, 0); }
        }
        __syncthreads();
        if (w >= 4) { const int nt = w - 4;
#pragma unroll
            for (int rg = 0; rg < 16; ++rg) Hb[((rg & 3) + 8 * (rg >> 2) + 4 * h) * LS + 32 * nt + r] = bf16_1(hacc[rg]); }
    }
    __syncthreads();
}
__device__ __forceinline__ void s5_setup(const Args& A_, Frame& F, int l) {
    LAS float* Pre = (LAS float*)(F.lds); LAS float* Pim = Pre + 2 * 17 * 64; LAS float* BBr = Pim + 2 * 17 * 64; LAS float* BBi = BBr + 2 * 64 * 16; LAS float* Kt = BBi + 2 * 64 * 16;
    bf16_t* Bt1 = (bf16_t*)(F.ws + WS_S5M); bf16_t* Bt2 = Bt1 + (size_t)64 * 512 * 256; float* A16 = (float*)(F.ws + WS_S5A);
    const int tid = F.tid;
    for (int g = blockIdx.x; g < 64; g += F.G) {
        if (tid < 128) { const int d = tid >> 6, n = tid & 63; const int pg_ = (l * 2 + d) * 64 + g;
            const float lre = A_.in[I_LRE][pg_ * 64 + n], lim = A_.in[I_LIM][pg_ * 64 + n], step = expf(A_.in[I_LSTEP][pg_]);
            for (int dl = 0; dl <= 16; ++dl) { const float mag = expf(lre * step * (float)dl), ang = lim * step * (float)dl; Pre[(d * 17 + dl) * 64 + n] = mag * cosf(ang); Pim[(d * 17 + dl) * 64 + n] = mag * sinf(ang); }
            const float abr = Pre[(d * 17 + 1) * 64 + n], abi = Pim[(d * 17 + 1) * 64 + n];
            const float den = lre * lre + lim * lim; const float kre = ((abr - 1.f) * lre + abi * lim) / den, kim = (abi * lre - (abr - 1.f) * lim) / den;
            const float* br = A_.in[I_BRE] + ((size_t)pg_ * 64 + n) * 16; const float* bi = A_.in[I_BIM] + ((size_t)pg_ * 64 + n) * 16;
            for (int i = 0; i < 16; ++i) { const float x = br[i], y = bi[i]; BBr[(d * 64 + n) * 16 + i] = kre * x - kim * y; BBi[(d * 64 + n) * 16 + i] = kre * y + kim * x; }
            A16[((d * 64 + g) * 64 + n) * 2] = Pre[(d * 17 + 16) * 64 + n]; A16[((d * 64 + g) * 64 + n) * 2 + 1] = Pim[(d * 17 + 16) * 64 + n]; }
        __syncthreads();
        for (int q = 0; q < 16; ++q) { const int idx = tid + 512 * q; const int d = idx >> 12, dl = (idx >> 8) & 15, o = (idx >> 4) & 15, i = idx & 15; const int pg_ = (l * 2 + d) * 64 + g;
            const float* cr = A_.in[I_CRE] + ((size_t)pg_ * 16 + o) * 64; const float* ci = A_.in[I_CIM] + ((size_t)pg_ * 16 + o) * 64; float acc = 0.f;
            for (int n = 0; n < 64; ++n) { const float pr = Pre[(d * 17 + dl) * 64 + n], pi = Pim[(d * 17 + dl) * 64 + n], br = BBr[(d * 64 + n) * 16 + i], bi = BBi[(d * 64 + n) * 16 + i];
                acc += cr[n] * (pr * br - pi * bi) - ci[n] * (pr * bi + pi * br); }
            Kt[idx] = acc; }
        __syncthreads();
        for (int q = 0; q < 16; ++q) { const int item = tid + 512 * q; const int c1 = item >> 5, kb = (item & 31) * 8; const int rin = kb >> 4, i0 = kb & 15, rout = c1 >> 4, o = c1 & 15;
            float v[8];
#pragma unroll
            for (int e = 0; e < 8; ++e) { const int i = i0 + e; float x = 0.f; if (rout >= rin) x += Kt[((0 * 16 + (rout - rin)) * 16 + o) * 16 + i]; if (rin >= rout) x += Kt[((1 * 16 + (rin - rout)) * 16 + o) * 16 + i];
                if (rin == rout && i == o) x += A_.in[I_S5D][l * 1024 + 16 * g + i]; v[e] = x; }
            u32x4 w; w.x = cvt_pk_bf16(v[0], v[1]); w.y = cvt_pk_bf16(v[2], v[3]); w.z = cvt_pk_bf16(v[4], v[5]); w.w = cvt_pk_bf16(v[6], v[7]);
            *(u32x4*)(Bt1 + ((size_t)g * 512 + c1) * 256 + kb) = w; }
        for (int q = 0; q < 16; ++q) { const int item = tid + 512 * q; const int c1 = item >> 5, kb = (item & 31) * 8; const int rin = kb >> 4, i0 = kb & 15; const int d = c1 >> 7, part = (c1 >> 6) & 1, n = c1 & 63;
            const int ex = (d == 0) ? 15 - rin : rin; const float pr = Pre[(d * 17 + ex) * 64 + n], pi = Pim[(d * 17 + ex) * 64 + n];
            float v[8];
#pragma unroll
            for (int e = 0; e < 8; ++e) { const float br = BBr[(d * 64 + n) * 16 + i0 + e], bi = BBi[(d * 64 + n) * 16 + i0 + e]; v[e] = part ? (pr * bi + pi * br) : (pr * br - pi * bi); }
            u32x4 w; w.x = cvt_pk_bf16(v[0], v[1]); w.y = cvt_pk_bf16(v[2], v[3]); w.z = cvt_pk_bf16(v[4], v[5]); w.w = cvt_pk_bf16(v[6], v[7]);
            *(u32x4*)(Bt1 + ((size_t)g * 512 + 256 + c1) * 256 + kb) = w; }
        for (int q = 0; q < 16; ++q) { const int item = tid + 512 * q; const int c2 = item >> 5, kb = (item & 31) * 8; const int rout = c2 >> 4, o = c2 & 15; const int d = kb >> 7, part = (kb >> 6) & 1, n0 = kb & 63; const int pg_ = (l * 2 + d) * 64 + g;
            const int ex = (d == 0) ? rout + 1 : 16 - rout; const float* cr = A_.in[I_CRE] + ((size_t)pg_ * 16 + o) * 64 + n0; const float* ci = A_.in[I_CIM] + ((size_t)pg_ * 16 + o) * 64 + n0;
            float v[8];
#pragma unroll
            for (int e = 0; e < 8; ++e) { const float pr = Pre[(d * 17 + ex) * 64 + n0 + e], pi = Pim[(d * 17 + ex) * 64 + n0 + e]; v[e] = part ? -(cr[e] * pi + ci[e] * pr) : (cr[e] * pr - ci[e] * pi); }
            u32x4 w; w.x = cvt_pk_bf16(v[0], v[1]); w.y = cvt_pk_bf16(v[2], v[3]); w.z = cvt_pk_bf16(v[4], v[5]); w.w = cvt_pk_bf16(v[6], v[7]);
            *(u32x4*)(Bt2 + ((size_t)g * 256 + c2) * 256 + kb) = w; }
        __syncthreads();
    }
}
__device__ __forceinline__ void s5_carry(Frame& F, int cid) {
    const int b = cid >> 7, d = (cid >> 6) & 1, g = cid & 63, n = F.lane;
    const float* ST = (const float*)(F.ws + WS_S5ST) + ((size_t)g * S5M + b * 272) * 256 + d * 128 + n; bf16_t* HP = (bf16_t*)(F.ws + WS_S5H) + ((size_t)g * 1280 + b * 272) * 256 + d * 128 + n;
    const float* A16 = (const float*)(F.ws + WS_S5A); const float ar = A16[((d * 64 + g) * 64 + n) * 2], ai = A16[((d * 64 + g) * 64 + n) * 2 + 1];
    float hr = 0.f, hi_ = 0.f;
    for (int k0 = 0; k0 < 272; k0 += 8) {
        float sr[8], si[8]; int cc[8];
#pragma unroll
        for (int e = 0; e < 8; ++e) { const int k = k0 + e; cc[e] = (d == 0) ? k : (k < 16 ? 15 - k : 287 - k); sr[e] = ST[(size_t)cc[e] * 256]; si[e] = ST[(size_t)cc[e] * 256 + 64]; }
#pragma unroll
        for (int e = 0; e < 8; ++e) { HP[(size_t)cc[e] * 256] = (bf16_t)(cvt_pk_bf16(hr, 0.f) & 0xffffu); HP[(size_t)cc[e] * 256 + 64] = (bf16_t)(cvt_pk_bf16(hi_, 0.f) & 0xffffu);
            const float nr = ar * hr - ai * hi_ + sr[e], ni = ar * hi_ + ai * hr + si[e]; hr = nr; hi_ = ni; }
    }
}
__device__ __forceinline__ void mixer_finalize(const Args& A_, Frame& F, int l) {
    bf16_t* P = (bf16_t*)(F.ws + WS_PROJ); const bf16_t* O0 = (const bf16_t*)(F.ws + WS_O); const bf16_t* O1 = O0 + (size_t)R * 1024;
    const bf16_t* XC = (const bf16_t*)(F.ws + WS_HM); const bf16_t* YD0 = (const bf16_t*)(F.ws + WS_YD); const bf16_t* YD1 = YD0 + (size_t)R * 1024;
        const float lam_init = 0.8f - 0.6f * expf(-0.3f * (float)l);
    const float* lv = A_.in[I_ALAM] + l * 256;
    const float s01 = wave_sum(lv[F.lane] * lv[64 + F.lane], F.lane), s23 = wave_sum(lv[128 + F.lane] * lv[192 + F.lane], F.lane);
    const float lam = expf(s01) - expf(s23) + lam_init;
    const int c0 = F.lane * 16;
    for (int row = F.gw; row < R; row += F.NGW) {
        { const u32x4 a0 = *(const u32x4*)(O0 + (size_t)row * 1024 + c0), a1 = *(const u32x4*)(O0 + (size_t)row * 1024 + c0 + 8);
          const u32x4 b0 = *(const u32x4*)(O1 + (size_t)row * 1024 + c0), b1 = *(const u32x4*)(O1 + (size_t)row * 1024 + c0 + 8);
          float v[16];
#define DIF(i, wa, wb) v[2 * (i)] = bflo(wa) - lam * bflo(wb); v[2 * (i) + 1] = bfhi(wa) - lam * bfhi(wb);
          DIF(0, a0.x, b0.x) DIF(1, a0.y, b0.y) DIF(2, a0.z, b0.z) DIF(3, a0.w, b0.w) DIF(4, a1.x, b1.x) DIF(5, a1.y, b1.y) DIF(6, a1.z, b1.z) DIF(7, a1.w, b1.w)
#undef DIF
          float ss = 0.f;
#pragma unroll
          for (int e = 0; e < 16; ++e) ss += v[e] * v[e];
          ss += shx(ss, 1, F.lane); ss += shx(ss, 2, F.lane); ss += shx(ss, 4, F.lane);
          const float rs = (1.0f / sqrtf(ss * (1.f / 128.f) + RMS_EPS)) * (1.0f - lam_init);
          const float* sw = A_.in[I_ASUB] + l * 128 + (c0 & 127);
          u32x4 o0, o1;
          o0.x = cvt_pk_bf16(v[0] * rs * sw[0], v[1] * rs * sw[1]); o0.y = cvt_pk_bf16(v[2] * rs * sw[2], v[3] * rs * sw[3]); o0.z = cvt_pk_bf16(v[4] * rs * sw[4], v[5] * rs * sw[5]); o0.w = cvt_pk_bf16(v[6] * rs * sw[6], v[7] * rs * sw[7]);
          o1.x = cvt_pk_bf16(v[8] * rs * sw[8], v[9] * rs * sw[9]); o1.y = cvt_pk_bf16(v[10] * rs * sw[10], v[11] * rs * sw[11]); o1.z = cvt_pk_bf16(v[12] * rs * sw[12], v[13] * rs * sw[13]); o1.w = cvt_pk_bf16(v[14] * rs * sw[14], v[15] * rs * sw[15]);
          *(u32x4*)(P + (size_t)row * LDP + PQ + c0) = o0; *(u32x4*)(P + (size_t)row * LDP + PQ + c0 + 8) = o1; }
        { const float dsk = A_.in[I_SSDD][l * 16 + (c0 >> 6)];
          float v[16];
#pragma unroll
          for (int hh = 0; hh < 2; ++hh) { const u32x4 x = *(const u32x4*)(XC + (size_t)row * 2048 + c0 + 8 * hh), y0 = *(const u32x4*)(YD0 + (size_t)row * 1024 + c0 + 8 * hh), y1 = *(const u32x4*)(YD1 + (size_t)row * 1024 + c0 + 8 * hh), z = *(const u32x4*)(P + (size_t)row * LDP + PZ + c0 + 8 * hh);
#define SG(i, wx, wy0, wy1, wz) v[8 * hh + 2 * (i)] = (bflo(wx) * dsk + bflo(wy0) + bflo(wy1)) * bflo(wz); v[8 * hh + 2 * (i) + 1] = (bfhi(wx) * dsk + bfhi(wy0) + bfhi(wy1)) * bfhi(wz);
              SG(0, x.x, y0.x, y1.x, z.x) SG(1, x.y, y0.y, y1.y, z.y) SG(2, x.z, y0.z, y1.z, z.z) SG(3, x.w, y0.w, y1.w, z.w)
#undef SG
          }
          float ss = 0.f;
#pragma unroll
          for (int e = 0; e < 16; ++e) ss += v[e] * v[e];
          ss += shx(ss, 1, F.lane); ss += shx(ss, 2, F.lane); ss += shx(ss, 4, F.lane); ss += shx(ss, 8, F.lane);
          const float rs = 1.0f / sqrtf(ss * (1.f / 256.f) + RMS_EPS);
          const float* nw = A_.in[I_SSDN] + l * 1024 + c0;
          u32x4 o0, o1;
          o0.x = cvt_pk_bf16(v[0] * rs * nw[0], v[1] * rs * nw[1]); o0.y = cvt_pk_bf16(v[2] * rs * nw[2], v[3] * rs * nw[3]); o0.z = cvt_pk_bf16(v[4] * rs * nw[4], v[5] * rs * nw[5]); o0.w = cvt_pk_bf16(v[6] * rs * nw[6], v[7] * rs * nw[7]);
          o1.x = cvt_pk_bf16(v[8] * rs * nw[8], v[9] * rs * nw[9]); o1.y = cvt_pk_bf16(v[10] * rs * nw[10], v[11] * rs * nw[11]); o1.z = cvt_pk_bf16(v[12] * rs * nw[12], v[13] * rs * nw[13]); o1.w = cvt_pk_bf16(v[14] * rs * nw[14], v[15] * rs * nw[15]);
          *(u32x4*)(P + (size_t)row * LDP + PZ + c0) = o0; *(u32x4*)(P + (size_t)row * LDP + PZ + c0 + 8) = o1; }
    }
}


__global__ void __launch_bounds__(NWAVES * 64, 2) trunk_fwd(Args args) {
    extern __shared__ __attribute__((aligned(16))) unsigned char lds_raw[];
    Frame F;
    F.lds = (LAS unsigned char*)lds_raw;
    F.tid = threadIdx.x; F.lane = F.tid & 63; F.wave = __builtin_amdgcn_readfirstlane(F.tid >> 6);
    F.G = gridDim.x; { const int bx = blockIdx.x; F.vcu = (F.G % 8 == 0) ? (bx % 8) * (F.G / 8) + bx / 8 : bx; }
    F.gw = F.vcu * NWAVES + F.wave; F.NGW = F.G * NWAVES;
    F.ws = args.ws;
    volatile LAS unsigned* MISC = (volatile LAS unsigned*)(F.lds + MISC_OFF);
    for (int u = F.tid; u < (LDS_BYTES - LDSCTL_OFF) / 4; u += NWAVES * 64) ((LAS unsigned*)(F.lds + LDSCTL_OFF))[u] = 0u;
    __syncthreads();
    (void)xcd_barrier_post((unsigned*)(args.ws + WS_CTL) + CW_BAR, MISC + 8);
    const int lo = args.ph_lo, hi = args.ph_hi;
    const int wave0 = __builtin_amdgcn_readfirstlane((int)threadIdx.x >> 6);
    int pid = 0;
#define PH_BEGIN if (pid >= lo && pid < hi) { GAS unsigned char* wsg_ = (GAS unsigned char*)args.ws; int tid_; asm volatile("v_mbcnt_lo_u32_b32 %1, -1, 0\n\tv_mbcnt_hi_u32_b32 %1, -1, %1 ; PHASE_MARK_BEGIN %2" : "+s"(wsg_), "=v"(tid_) : "i"(__LINE__)); tid_ += wave0 * 64; unsigned char* ws = (unsigned char*)wsg_; F.ws = ws; F.tid = tid_; F.lane = tid_ & 63; F.wave = __builtin_amdgcn_readfirstlane(tid_ >> 6); F.gw = F.vcu * NWAVES + F.wave;
#define PH_END   asm volatile("; PHASE_MARK_END %0" :: "i"(__LINE__)); if (pid + 1 < hi) { XcdBarrier bar_; bar_.bar = (unsigned*)(args.ws + WS_CTL) + CW_BAR; bar_.x = xb_xcc_id(); bar_.st = (volatile LAS unsigned*)(F.lds + MISC_OFF) + 8; xcd_barrier(bar_, wave0 * 64 + lane_now()); } } ++pid;

#define MOD ((float*)(ws + WS_MOD))
#define Hbuf ((float*)(ws + WS_H))
#define HM ((bf16_t*)(ws + WS_HM))
#define PROJ ((bf16_t*)(ws + WS_PROJ))
#define ROPEC ((float*)(ws + WS_ROPE))
#define ROPES (ROPEC + 1024)
#define WGT (ws + WS_W)

    PH_BEGIN
        s5_setup(args, F, 0); __syncthreads();
        convert_layer_weights(args, F, 0);
        mod_partials(args, F);
        for (int row = F.gw; row < R; row += F.NGW) { const int b = row / RB, rr = row % RB;
            const float* src = (rr < CTX) ? args.in[I_CTX] + ((size_t)b * CTX + rr) * D : args.in[I_X] + ((size_t)b * SEQ + (rr - CTX)) * D;
#pragma unroll
            for (int i = 0; i < 8; ++i) *(f32x4*)(Hbuf + (size_t)row * D + 256 * i + 4 * F.lane) = *(const f32x4*)(src + 256 * i + 4 * F.lane); }
        if (F.gw == 0) {
#pragma unroll
            for (int i = 0; i < 16; ++i) { const int idx = i * 64 + F.lane, pos = idx >> 4, f = idx & 15; const float inv = powf(10000.0f, -(float)f / 16.0f); const float ang = (float)pos * inv; ROPEC[idx] = cosf(ang); ROPES[idx] = sinf(ang); } }
    PH_END
    PH_BEGIN
        const float* MODP = (const float*)(ws + WS_MODP);
        for (int i = F.gw * 64 + F.lane; i < 2 * 5 * NMOD; i += F.NGW * 64) { const int l = i / (5 * NMOD), r = i % (5 * NMOD), c = r % NMOD;
            float s = args.in[I_BMOD][l * NMOD + c];
#pragma unroll
            for (int ks = 0; ks < 16; ++ks) s += MODP[(size_t)(l * 16 + ks) * 5 * NMOD + r];
            MOD[i] = s; }
    PH_END
    PH_BEGIN
        ln_pass(F, false, nullptr, nullptr, MOD, nullptr);
    PH_END

    for (int s = 0; s < 6; ++s) {
        const int l = s / 3, j = s - 3 * l;
        if (j != 1) {
            const int f = j >> 1;
            PH_BEGIN
                pg8::Gemm g{D, D, D}; pg8::StaticOrder S; S.init(NPAN, N13 / 256, F.G, (int)blockIdx.x, HM, D, (const bf16_t*)(WGT + W_13) + (size_t)f * N13 * D, D);
                EpiSwiGLU E{PROJ};
                pg8::gemm_phase<EpiSwiGLU, pg8::StaticOrder>(F.lds + RING_OFF, g, S, E, F.tid);
            PH_END
        } else {
            PH_BEGIN
                pg8::Gemm g{D, D, D}; pg8::StaticOrder S; S.init(NPAN, NIN / 256, F.G, (int)blockIdx.x, HM, D, (const bf16_t*)(WGT + W_IN), D);
                EpiProj E{PROJ, (float*)(ws + WS_DT), ROPEC, ROPES};
                pg8::gemm_phase<EpiProj, pg8::StaticOrder>(F.lds + RING_OFF, g, S, E, F.tid);
            PH_END
            PH_BEGIN
                ssd_conv_pass(args, F, l);
                { pg8::Gemm g{0, 256, 256}; S5AOrder S{F.G, (int)blockIdx.x, (const char*)(PROJ + PU), (const char*)(ws + WS_S5M)};
                  EpiS5A E{(bf16_t*)(ws + WS_YS), (float*)(ws + WS_S5ST)};
                  pg8::gemm_phase<EpiS5A, S5AOrder, 1>(F.lds + RING_OFF, g, S, E, F.tid); }
            PH_END
            PH_BEGIN
                if (F.wave < 2) s5_carry(F, (int)blockIdx.x * 2 + F.wave);
                ssd_chain_fast(args, F, l, (int)blockIdx.x);
                {
                    bf16_t* Obuf = (bf16_t*)(ws + WS_O);
                    for (int i = 0;; ++i) { const int idx = i * F.G + F.vcu; if (idx >= 2048 + 128) break;
                        int b, hh, vh, q0, NT;
                        if (idx < 2048) { b = idx >> 9; hh = (idx >> 5) & 15; vh = (idx >> 4) & 1; q0 = b * RB + CTX + (idx & 15) * 256; NT = RB / 64; }
                        else { const int k = idx - 2048; b = k >> 5; hh = (k >> 1) & 15; vh = k & 1; q0 = b * RB; NT = CTX / 64; }
                        const bf16_t* Q0 = PROJ + (size_t)q0 * LDP + PQ + hh * 64; const bf16_t* Kh = PROJ + (size_t)(b * RB) * LDP + PK + hh * 64; const bf16_t* Vh = PROJ + (size_t)(b * RB) * LDP + PV + (hh >> 1) * 128 + vh * 64;
                        bf16_t* O0 = Obuf + (size_t)(hh & 1) * R * 1024 + (size_t)q0 * 1024 + (hh >> 1) * 128 + vh * 64;
                        attn_body::attn_unit<8>((const attn_body::bf16*)Q0, (const attn_body::bf16*)Kh, (const attn_body::bf16*)Vh, (attn_body::bf16*)O0, NT, (char*)lds_raw + RING_OFF, F.tid);
                    }
                }
            PH_END
            PH_BEGIN
                mixer_finalize(args, F, l);
                { pg8::Gemm g{256, 256, 256}; S5COrder S{F.G, (int)blockIdx.x, (const char*)(ws + WS_S5H), (const char*)((bf16_t*)(ws + WS_S5M) + (size_t)64 * 512 * 256)};
                  EpiS5C E{(const bf16_t*)(ws + WS_YS), PROJ};
                  pg8::gemm_phase<EpiS5C, S5COrder>(F.lds + RING_OFF, g, S, E, F.tid); }
            PH_END
            PH_BEGIN
                pg8::Gemm g{LDP, 1024, 1024}; pg8::StaticOrder S; S.init(NPAN, 4, F.G, (int)blockIdx.x, PROJ + PU, LDP, (const bf16_t*)(WGT + W_GLU), 1024);
                EpiGlu E{PROJ, args.in[I_GLUB] + l * 1024};
                pg8::gemm_phase<EpiGlu, pg8::StaticOrder>(F.lds + RING_OFF, g, S, E, F.tid);
            PH_END
            PH_BEGIN
                pg8::Gemm g{LDP, 1024, 1024}; pg8::TripleOrder S; S.nM = NPAN; S.nN = 8; S.ntile = NPAN * 8; S.G = F.G; S.c = (int)blockIdx.x;
                S.A0 = (const char*)(PROJ); S.B = (const char*)(WGT + W_B); S.tA = (size_t)256 * LDP * 2; S.tB = (size_t)256 * 1024 * 2;
                EpiBranch E{PROJ, (float*)(ws + WS_YD), HM};
                pg8::gemm_phase<EpiBranch, pg8::TripleOrder>(F.lds + RING_OFF, g, S, E, F.tid);
            PH_END
        }
        PH_BEGIN
            const int RK = (j == 1) ? D : DFF; const bf16_t* RA = (j == 1) ? HM : PROJ; const bf16_t* RBt = (j == 1) ? (const bf16_t*)(WGT + W_O) : (const bf16_t*)(WGT + W_2) + (size_t)(j >> 1) * D * DFF;
            pg8::Gemm g{RK, RK, RK}; pg8::StaticOrder S; S.init(NPAN, D / 256, F.G, (int)blockIdx.x, RA, RK, RBt, RK);
            EpiResid E{Hbuf, MOD + (size_t)l * 5 * NMOD + (3 * j + 2) * D, (j == 1) ? 1.0f : 0.5f};
            pg8::gemm_phase<EpiResid, pg8::StaticOrder>(F.lds + RING_OFF, g, S, E, F.tid);
        PH_END
        PH_BEGIN
            const bool fin = (s == 5);
            const int ln_ = (j == 2) ? l + 1 : l, jn = (j == 2) ? 0 : j + 1;
            ln_pass(F, true, args.in[I_LNG] + (size_t)(l * 3 + j) * D, args.in[I_LNB] + (size_t)(l * 3 + j) * D, fin ? nullptr : MOD + (size_t)ln_ * 5 * NMOD + 3 * jn * D, fin ? args.out : nullptr);
            if (s == 2) { s5_setup(args, F, 1); __syncthreads(); convert_layer_weights(args, F, 1); }
        PH_END
    }
#undef PH_BEGIN
#undef PH_END
}

static int count_phases() { int n = 3; for (int s = 0; s < 6; ++s) n += ((s % 3) != 1 ? 1 : 6) + 2; return n; }
extern "C" void kernel_launch(void* const* d_in, const int* in_sizes, int n_in, void* d_out, int out_size, void* d_ws, size_t ws_size, hipStream_t stream) {
    static int grid = 0;
    if (grid == 0) {
        if (n_in != 32 || out_size != NB * SEQ * D || ws_size < WS_END) { fprintf(stderr, "kernel_launch: unexpected shapes (n_in %d, out %d, ws %zu < %zu)\n", n_in, out_size, ws_size, (size_t)WS_END); grid = -1; return; }
        int dev = 0, cus = 0, per_cu = 0;
        if (hipGetDevice(&dev) != hipSuccess || hipDeviceGetAttribute(&cus, hipDeviceAttributeMultiprocessorCount, dev) != hipSuccess) { grid = -1; return; }
        if (hipFuncSetAttribute((const void*)trunk_fwd, hipFuncAttributeMaxDynamicSharedMemorySize, LDS_BYTES) != hipSuccess) { fprintf(stderr, "kernel_launch: hipFuncSetAttribute failed\n"); grid = -1; return; }
        if (hipOccupancyMaxActiveBlocksPerMultiprocessor(&per_cu, (const void*)trunk_fwd, NWAVES * 64, LDS_BYTES) != hipSuccess || per_cu < 1) fprintf(stderr, "kernel_launch: occupancy query says %d\n", per_cu);
        (void)hipGetLastError();
        grid = cus;
    }
    if (grid < 0) return;
    (void)in_sizes;
    if (hipMemsetAsync((char*)d_ws + WS_CTL, 0, CTL_ZERO_BYTES, stream) != hipSuccess) return;
    Args a{};
    for (int i = 0; i < 32; ++i) a.in[i] = (const float*)d_in[i];
    a.out = (float*)d_out; a.ws = (unsigned char*)d_ws;
    const int nph = count_phases();
#if MK_PER_PHASE
    for (int p = 0; p < nph; ++p) { a.ph_lo = p; a.ph_hi = p + 1; hipLaunchKernelGGL(trunk_fwd, dim3(grid), dim3(NWAVES * 64), LDS_BYTES, stream, a); }
#else
    a.ph_lo = 0; a.ph_hi = nph;
    hipLaunchKernelGGL(trunk_fwd, dim3(grid), dim3(NWAVES * 64), LDS_BYTES, stream, a);
#endif
    const hipError_t le = hipPeekAtLastError();
    if (le != hipSuccess) fprintf(stderr, "kernel_launch: launch failed: %s\n", hipGetErrorName(le));
}
```

```cpp
#include <hip/hip_runtime.h>
#include <hip/hip_bf16.h>
#include <cstdio>
#include <cstdint>
#include <cmath>

#ifndef MK_PER_PHASE
#define MK_PER_PHASE 0
#endif

#define LAS __attribute__((address_space(3)))
#define GAS __attribute__((address_space(1)))
typedef unsigned short bf16_t;
typedef short bf16x8 __attribute__((ext_vector_type(8)));
typedef float f32x4 __attribute__((ext_vector_type(4)));
typedef float f32x2 __attribute__((ext_vector_type(2)));
typedef float f32x16 __attribute__((ext_vector_type(16)));
typedef unsigned u32x4 __attribute__((ext_vector_type(4)));
typedef unsigned u32x2 __attribute__((ext_vector_type(2)));
typedef short s16x4 __attribute__((ext_vector_type(4)));

constexpr int NB = 4, SEQ = 4096, CTX = 256, RB = SEQ + CTX  , R = NB * RB  , NPAN = R / 256  , PPB = RB / 256  ;
constexpr int D = 2048, DFF = 5632, N13 = 2 * DFF, NMOD = 9 * D  ;
constexpr int LDP = 13312;
constexpr int NIN = 13568;
constexpr int PQ = 0, PK = 1024, PV = 2048, PZ = 3072, PX = 4096, PU = 6144, PG = 7168;
constexpr float DN_ALPHA = 1.41421356237309515f;
constexpr float LN_EPS = 1e-5f, RMS_EPS = 1e-6f;
constexpr float QSCALE = 0.125f * 1.4426950408889634f;

constexpr size_t MiB = 1u << 20;
constexpr size_t WS_CTL = 0, CTL_ZERO_BYTES = 1 * MiB;
constexpr size_t WS_MOD = 1 * MiB;
constexpr size_t WS_ROPE = 2 * MiB;
constexpr size_t WS_STATS = 2 * MiB + 65536;
constexpr size_t WS_IDENT = 2 * MiB + 262144;
constexpr size_t WS_MODP = 3 * MiB;
constexpr size_t WS_DT = 15 * MiB;
constexpr size_t WS_H = 18 * MiB;
constexpr size_t WS_HM = 154 * MiB;
constexpr size_t WS_PROJ = 222 * MiB;
constexpr size_t WS_O = 664 * MiB;
constexpr size_t WS_YD = 732 * MiB;
constexpr size_t WS_YS = 800 * MiB;
constexpr size_t WS_W = 868 * MiB;
constexpr size_t W_13 = 0, W_2 = 88 * MiB, W_IN = 132 * MiB, W_B = 185 * MiB, W_O = 197 * MiB, W_GLU = 205 * MiB;
constexpr size_t WS_S5ST = 1075 * MiB;
constexpr size_t WS_S5H = 1143 * MiB;
constexpr size_t WS_S5M = 1183 * MiB;
constexpr size_t WS_S5A = 1207 * MiB;
constexpr size_t WS_END = 1208 * MiB;
constexpr int S5M = 1088;
constexpr int CW_BAR = 4096;

__device__ __forceinline__ unsigned cvt_pk_bf16(float lo, float hi) { unsigned r; asm volatile("v_cvt_pk_bf16_f32 %0, %1, %2" : "=v"(r) : "v"(lo), "v"(hi)); return r; }
__device__ __forceinline__ float bflo(unsigned u) { return __uint_as_float(u << 16); }
__device__ __forceinline__ float bfhi(unsigned u) { return __uint_as_float(u & 0xffff0000u); }
__device__ __forceinline__ float bf1(bf16_t h) { return __uint_as_float((unsigned)h << 16); }
__device__ __forceinline__ float sigmoidf_(float x) { return __builtin_amdgcn_rcpf(1.0f + __builtin_amdgcn_exp2f(-1.4426950408889634f * x)); }
__device__ __forceinline__ float siluf_(float x) { return x * sigmoidf_(x); }
__device__ __forceinline__ int lane_now() { int l; asm volatile("v_mbcnt_lo_u32_b32 %0, -1, 0\n\tv_mbcnt_hi_u32_b32 %0, -1, %0" : "=v"(l)); return l; }
__device__ __forceinline__ float shx(float v, int m, int lane) { return __int_as_float(__builtin_amdgcn_ds_bpermute((lane ^ m) << 2, __float_as_int(v))); }
__device__ __forceinline__ float wave_sum(float v, int lane) {
#pragma unroll
    for (int o = 1; o < 64; o <<= 1) v += shx(v, o, lane);
    return v;
}
#define LDS_WAIT() asm volatile("s_waitcnt lgkmcnt(0)" ::: "memory")
#define VM_WAIT() asm volatile("s_waitcnt vmcnt(0)" ::: "memory")

namespace pg8 {
constexpr int BM = 256, BK = 64, HALF = 128, HTB = HALF * BK * 2, STAGE_BYTES = 8 * HTB, NXCD = 8, WGM = 8, PPB_ = 17;
__host__ __device__ __forceinline__ int lds_byte(int r, int c) { const int st = (r >> 4) * 2 + (c >> 5), rr = r & 15, cc = c & 31, ob = rr * 64 + cc * 2; return st * 1024 + (ob ^ (((ob >> 9) & 1) << 5)); }
__host__ __device__ __forceinline__ void stage_rc(int b, int& R_, int& C_) { const int st = b / 1024, sb = b % 1024, swz = sb ^ (((sb >> 9) & 1) << 5); R_ = (st >> 1) * 16 + swz / 64; C_ = (st & 1) * 32 + (swz % 64) / 2; }

struct Unit { int pm, pn, aux, kt; const char* a; const char* b; };
struct Gemm { int lda, ldb, K; };

__device__ __forceinline__ void xcd_remap(int L, int nM, int nN, int& pm, int& pn) {
    const int nwg = nM * nN; int wgid = L;
    { const int q = nwg / NXCD, r = nwg % NXCD, xcd = wgid % NXCD, off = wgid / NXCD; wgid = (xcd < r ? xcd * (q + 1) : r * (q + 1) + (xcd - r) * q) + off; }
    const int nig = WGM * nN, gid = wgid / nig, fm = gid * WGM, gsz = (nM - fm) < WGM ? (nM - fm) : WGM;
    pm = fm + ((wgid % nig) % gsz); pn = (wgid % nig) / gsz;
}
struct StaticOrder {
    int nM, nN, nwg, G, c, kt, latonly, nctx; const char* A; const char* B; size_t tA, tB;
    __device__ __forceinline__ void init(int nM_, int nN_, int G_, int c_, const void* A_, int lda, const void* B_, int ldb, int K, int latonly_ = 0, int nctx_ = 0) { nM = nM_; nN = nN_; nwg = nM * nN; G = G_; c = c_; kt = K / BK; latonly = latonly_; nctx = nctx_;
        A = (const char*)A_; B = (const char*)B_; tA = (size_t)BM * lda * 2; tB = (size_t)BM * ldb * 2; }
    __device__ __forceinline__ bool next(int i, Unit& u) const {
        const long L = (long)i * G + c;
        if (L < nwg) { xcd_remap((int)L, nM, nN, u.pm, u.pn); if (latonly) u.pm += (u.pm >> 4) + 1; u.aux = 0; u.kt = kt; u.a = A + (size_t)u.pm * tA; u.b = B + (size_t)u.pn * tB; return true; }
        const int x = (int)(L - nwg); if (x >= nctx) return false;
        const int q = x & 3, t2 = x >> 2; u.pm = PPB_ * (t2 / nN); u.pn = t2 % nN; u.aux = 1; u.kt = kt >> 2;
        u.a = A + (size_t)u.pm * tA + (size_t)q * (kt >> 2) * BK * 2; u.b = B + (size_t)u.pn * tB + (size_t)q * (kt >> 2) * BK * 2; return true;
    }
};
template <class Epi, class Sched, int AMODE = 0, bool HOOK = false>
__device__ __forceinline__ void gemm_phase(LAS unsigned char* lds, const Gemm g, const Sched& S, const Epi& E, const int tid) {
    const int wid = __builtin_amdgcn_readfirstlane(tid >> 6), lane = tid & 63, wr = wid >> 2, wc = wid & 3, fr = lane & 15, fq = lane >> 4;
    unsigned voffA[2], voffB[2];
#pragma unroll
    for (int i = 0; i < 2; ++i) { int R_, C_; stage_rc(tid * 16 + i * 8192, R_, C_);
        voffA[i] = (AMODE == 1) ? (unsigned)((R_ * 16 + (C_ >> 4)) * LDP + (C_ & 15)) * 2u : (unsigned)(R_ * g.lda + C_) * 2u; voffB[i] = (unsigned)(R_ * g.ldb + C_) * 2u; }
    const size_t kstep = (size_t)(BK * 2), kstepA = (AMODE == 1) ? (size_t)(4 * LDP * 2) : kstep;
    const size_t hstepA = (AMODE == 1) ? (size_t)HALF * 16 * LDP * 2 : (size_t)HALF * g.lda * 2, hstepB = (size_t)HALF * g.ldb * 2;
    const unsigned ldsw = (unsigned)wid * 1024u;
    const int aoff = lds_byte(wr * 64 + fr, fq * 8), boff = lds_byte(wc * 32 + fr, fq * 8);
#define PG8_SA(b, h) (((b) * 2 + (h)) * HTB)
#define PG8_SB(b, h) ((4 + (b) * 2 + (h)) * HTB)
#define PG8_STAGE(bufoff, gbase, voff) do { _Pragma("unroll") for (int _i = 0; _i < 2; ++_i) \
        __builtin_amdgcn_global_load_lds((const unsigned*)((const char*)(gbase) + (voff)[_i]), (LAS unsigned*)(lds + (bufoff) + ldsw + _i * 8192), 16, 0, 0); } while (0)
#define PG8_LDA(dst, b, h) do { _Pragma("unroll") for (int m = 0; m < 4; ++m) _Pragma("unroll") for (int k = 0; k < 2; ++k) dst[m][k] = *(const LAS bf16x8*)(lds + PG8_SA(b, h) + aoff + m * 2048 + k * 1024); } while (0)
#define PG8_LDB(dst, b, h) do { _Pragma("unroll") for (int n = 0; n < 2; ++n) _Pragma("unroll") for (int k = 0; k < 2; ++k) dst[n][k] = *(const LAS bf16x8*)(lds + PG8_SB(b, h) + boff + n * 2048 + k * 1024); } while (0)
#define PG8_MMA(ai, bj, At, Bt) do { __builtin_amdgcn_s_setprio(1); _Pragma("unroll") for (int m = 0; m < 4; ++m) _Pragma("unroll") for (int n = 0; n < 2; ++n) _Pragma("unroll") for (int k = 0; k < 2; ++k) \
        acc[ai][bj][m][n] = __builtin_amdgcn_mfma_f32_16x16x32_bf16(Bt[n][k], At[m][k], acc[ai][bj][m][n], 0, 0, 0); __builtin_amdgcn_s_setprio(0); } while (0)
#define PG8_WAIT_V(n) asm volatile("s_waitcnt vmcnt(" #n ")" ::: "memory")
#define PG8_WAIT_L(n) asm volatile("s_waitcnt lgkmcnt(" #n ")" ::: "memory")
#define PG8_BAR __builtin_amdgcn_s_barrier()
#define PG8_SCHED __builtin_amdgcn_sched_barrier(0)
    Unit cur, nxt; int ui = 0;
    if (!S.next(0, cur)) return;
    f32x4 acc[2][2][4][2];
#pragma unroll
    for (int a = 0; a < 2; ++a)
#pragma unroll
        for (int b = 0; b < 2; ++b)
#pragma unroll
            for (int m = 0; m < 4; ++m)
#pragma unroll
                for (int n = 0; n < 2; ++n) acc[a][b][m][n] = (f32x4){0.f, 0.f, 0.f, 0.f};
    bf16x8 At[4][2], B0[2][2], B1[2][2];
    const char* cA = cur.a; const char* cB = cur.b;
    PG8_STAGE(PG8_SB(0, 0), cB, voffB); PG8_STAGE(PG8_SB(0, 1), cB + hstepB, voffB); PG8_STAGE(PG8_SA(0, 0), cA, voffA); PG8_STAGE(PG8_SA(0, 1), cA + hstepA, voffA);
    if (wr == 1) PG8_BAR;
    PG8_WAIT_V(2); PG8_BAR;
    PG8_STAGE(PG8_SB(1, 0), cB + kstep, voffB); PG8_STAGE(PG8_SA(1, 0), cA + kstepA, voffA); PG8_STAGE(PG8_SB(1, 1), cB + hstepB + kstep, voffB);
    PG8_WAIT_V(6); PG8_BAR;
    for (;;) {
        const bool has_next = S.next(ui + 1, nxt);
        const char* nA = has_next ? nxt.a : cA; const char* nB = has_next ? nxt.b : cB;
        const int nt = cur.kt;
        for (int t = 0; t < nt; t += 2) {
            const bool last = (t == nt - 2);
            if constexpr (HOOK) { if (t == 16 || t == 32) E.mid(acc, cur, t >> 4, wr, wc); }
            const char* a1 = cA + (size_t)(t + 1) * kstepA;
            const char* a2 = last ? nA : cA + (size_t)(t + 2) * kstepA; const char* b2 = last ? nB : cB + (size_t)(t + 2) * kstep;
            const char* a3 = a2 + kstepA; const char* b3 = b2 + kstep;
            PG8_LDB(B0, 0, 0); PG8_LDB(B1, 0, 1); PG8_SCHED; PG8_LDA(At, 0, 0); PG8_STAGE(PG8_SA(1, 1), a1 + hstepA, voffA);
            PG8_WAIT_V(8); PG8_WAIT_L(0); PG8_BAR; PG8_MMA(0, 0, At, B0); PG8_MMA(0, 1, At, B1); PG8_BAR; PG8_SCHED;
            PG8_LDA(At, 0, 1); PG8_STAGE(PG8_SB(0, 0), b2, voffB); PG8_STAGE(PG8_SB(0, 1), b2 + hstepB, voffB); PG8_STAGE(PG8_SA(0, 0), a2, voffA);
            PG8_WAIT_V(8); PG8_WAIT_L(0); PG8_BAR; PG8_MMA(1, 0, At, B0); PG8_MMA(1, 1, At, B1); PG8_BAR; PG8_SCHED;
            PG8_LDB(B0, 1, 0); PG8_LDB(B1, 1, 1); PG8_SCHED; PG8_LDA(At, 1, 0); PG8_STAGE(PG8_SA(0, 1), a2 + hstepA, voffA);
            PG8_WAIT_V(8); PG8_WAIT_L(0); PG8_BAR; PG8_MMA(0, 0, At, B0); PG8_MMA(0, 1, At, B1); PG8_BAR; PG8_SCHED;
            PG8_LDA(At, 1, 1); PG8_STAGE(PG8_SB(1, 0), b3, voffB); PG8_STAGE(PG8_SB(1, 1), b3 + hstepB, voffB); PG8_STAGE(PG8_SA(1, 0), a3, voffA);
            PG8_WAIT_V(8); PG8_WAIT_L(0); PG8_BAR; PG8_MMA(1, 0, At, B0); PG8_MMA(1, 1, At, B1); PG8_BAR; PG8_SCHED;
        }
        if (wr == 0) PG8_BAR;
        E(acc, cur, wr, wc, fr, fq);
        if (!has_next) break;
#pragma unroll
        for (int a = 0; a < 2; ++a)
#pragma unroll
            for (int b = 0; b < 2; ++b)
#pragma unroll
                for (int m = 0; m < 4; ++m)
#pragma unroll
                    for (int n = 0; n < 2; ++n) acc[a][b][m][n] = (f32x4){0.f, 0.f, 0.f, 0.f};
        cur = nxt; cA = nA; cB = nB; ++ui;
        if (wr == 1) PG8_BAR;
    }
    PG8_WAIT_V(0);
    PG8_BAR;
#undef PG8_SA
#undef PG8_SB
#undef PG8_STAGE
#undef PG8_LDA
#undef PG8_LDB
#undef PG8_MMA
#undef PG8_WAIT_V
#undef PG8_WAIT_L
#undef PG8_BAR
#undef PG8_SCHED
}
}

struct EpiSwiGLU {
    bf16_t* O;
    __device__ __forceinline__ void operator()(const f32x4 (&acc)[2][2][4][2], const pg8::Unit& u, int wr, int wc, int, int) const { const int ln_ = lane_now(); const int fr = ln_ & 15, fq = ln_ >> 4;
        const int row0 = u.pm * 256 + wr * 64 + fr, hc0 = u.pn * 128 + wc * 16 + 4 * fq;
#pragma unroll
        for (int ai = 0; ai < 2; ++ai)
#pragma unroll
            for (int m = 0; m < 4; ++m) { bf16_t* rowp = O + (size_t)(row0 + ai * 128 + m * 16) * DFF + hc0;
#pragma unroll
                for (int bj = 0; bj < 2; ++bj) { const f32x4 a = acc[ai][bj][m][0], b = acc[ai][bj][m][1];
                    u32x2 w; w.x = cvt_pk_bf16(siluf_(a[0]) * b[0], siluf_(a[1]) * b[1]); w.y = cvt_pk_bf16(siluf_(a[2]) * b[2], siluf_(a[3]) * b[3]);
                    *(u32x2*)(rowp + bj * 64) = w; } }
    }
};
struct EpiResid {
    float* H; const float* gate; const float* lng; const float* lnb; const float* xsrc;
    __device__ __forceinline__ void operator()(const f32x4 (&acc)[2][2][4][2], const pg8::Unit& u, int wr, int wc, int, int) const { const int ln_ = lane_now(); const int fr = ln_ & 15, fq = ln_ >> 4;
        const int pp = u.pm % PPB, mi = (pp == 0) ? 4 : (u.pm / PPB);
        const int row0 = u.pm * 256 + wr * 64 + fr, col0 = u.pn * 256 + wc * 32 + 4 * fq;
        if (u.aux) {
#pragma unroll
            for (int bj = 0; bj < 2; ++bj)
#pragma unroll
                for (int n = 0; n < 2; ++n) { const f32x4 gv = *(const f32x4*)(gate + (size_t)mi * NMOD + col0 + bj * 128 + n * 16);
#pragma unroll
                    for (int ai = 0; ai < 2; ++ai)
#pragma unroll
                        for (int m = 0; m < 4; ++m) { float* p = H + (size_t)(row0 + ai * 128 + m * 16) * D + col0 + bj * 128 + n * 16; const f32x4 v = gv * acc[ai][bj][m][n];
                            unsafeAtomicAdd(p, v[0]); unsafeAtomicAdd(p + 1, v[1]); unsafeAtomicAdd(p + 2, v[2]); unsafeAtomicAdd(p + 3, v[3]); } }
            return;
        }
        const float* tsrc = xsrc ? xsrc + (size_t)((u.pm / PPB) * 16 + (pp - 1)) * 256 * D : H + (size_t)u.pm * 256 * D;
#pragma unroll
        for (int bj = 0; bj < 2; ++bj)
#pragma unroll
            for (int n = 0; n < 2; ++n) { const int c = col0 + bj * 128 + n * 16; const f32x4 gv = *(const f32x4*)(gate + (size_t)mi * NMOD + c);
                const f32x4 g4 = *(const f32x4*)(lng + c) * DN_ALPHA, b4 = *(const f32x4*)(lnb + c) * DN_ALPHA;
#pragma unroll
                for (int ai = 0; ai < 2; ++ai)
#pragma unroll
                    for (int m = 0; m < 4; ++m) { const size_t row = (size_t)(row0 + ai * 128 + m * 16); float* p = H + row * D + c; const f32x4 t = *(const f32x4*)(tsrc + (row - (size_t)u.pm * 256) * D + c);
                        const f32x2 st = *(const f32x2*)((const float*)((const char*)H - WS_H + WS_STATS) + row * 2);
                        *(f32x4*)p = (t - st.x) * st.y * g4 + b4 + gv * acc[ai][bj][m][n]; } }
    }
};
struct EpiProj {
    bf16_t* P; float* DT; const float* rc; const float* rs;
    __device__ __forceinline__ void operator()(const f32x4 (&acc)[2][2][4][2], const pg8::Unit& u, int wr, int wc, int, int) const { const int ln_ = lane_now(); const int fr = ln_ & 15, fq = ln_ >> 4;
        const int pp = u.pm % PPB; const int row0 = u.pm * 256 + wr * 64 + fr;
        const int pn = u.pn;
        if (pn == 52) {
            if (wc == 0) {
#pragma unroll
                for (int ai = 0; ai < 2; ++ai)
#pragma unroll
                    for (int m = 0; m < 4; ++m)
#pragma unroll
                        for (int n = 0; n < 2; ++n) *(f32x4*)(DT + (size_t)(row0 + ai * 128 + m * 16) * 32 + n * 16 + 4 * fq) = acc[ai][0][m][n];
            }
            return;
        }
        const int col0 = pn * 256 + wc * 32 + 4 * fq;
        const int mode = (pn < 8) ? ((pp != 0) ? 1 : 0) : ((pn >= 12 && pn < 16) ? 2 : (pn >= 28 ? 3 : 0));
        const float sc = (pn < 4) ? QSCALE : 1.0f;
#pragma unroll
        for (int ai = 0; ai < 2; ++ai)
#pragma unroll
            for (int m = 0; m < 4; ++m) { const int rl = ai * 128 + wr * 64 + m * 16 + fr; bf16_t* rowp = P + (size_t)(u.pm * 256 + rl) * LDP + col0;
                f32x4 cs = (f32x4){1.f, 1.f, 1.f, 1.f}, sn = (f32x4){0.f, 0.f, 0.f, 0.f};
                if (mode == 1) { const int t = (pp - 1) * 256 + rl; const int pos = (wc & 1) ? (t & 63) : (t >> 6); cs = *(const f32x4*)(rc + pos * 16 + 4 * fq); sn = *(const f32x4*)(rs + pos * 16 + 4 * fq); }
#pragma unroll
                for (int bj = 0; bj < 2; ++bj) { f32x4 v0 = acc[ai][bj][m][0], v1 = acc[ai][bj][m][1];
                    if (mode == 1) { const f32x4 o0 = v0 * cs - v1 * sn, o1 = v1 * cs + v0 * sn; v0 = o0; v1 = o1; }
                    else if (mode == 2) {
#pragma unroll
                        for (int e = 0; e < 4; ++e) { v0[e] = siluf_(v0[e]); v1[e] = siluf_(v1[e]); } }
                    else if (mode == 3) {
#pragma unroll
                        for (int e = 0; e < 4; ++e) { v0[e] = sigmoidf_(v0[e]); v1[e] = sigmoidf_(v1[e]); } }
                    v0 = v0 * sc; v1 = v1 * sc;
                    u32x2 w0, w1; w0.x = cvt_pk_bf16(v0[0], v0[1]); w0.y = cvt_pk_bf16(v0[2], v0[3]); w1.x = cvt_pk_bf16(v1[0], v1[1]); w1.y = cvt_pk_bf16(v1[2], v1[3]);
                    *(u32x2*)(rowp + bj * 128) = w0; *(u32x2*)(rowp + bj * 128 + 16) = w1; } }
    }
};
struct EpiGlu {
    bf16_t* P; const float* bias;
    __device__ __forceinline__ void operator()(const f32x4 (&acc)[2][2][4][2], const pg8::Unit& u, int wr, int wc, int, int) const { const int ln_ = lane_now(); const int fr = ln_ & 15, fq = ln_ >> 4;
        const int row0 = u.pm * 256 + wr * 64 + fr, col0 = u.pn * 256 + wc * 32 + 4 * fq;
#pragma unroll
        for (int ai = 0; ai < 2; ++ai)
#pragma unroll
            for (int m = 0; m < 4; ++m) { bf16_t* rowp = P + (size_t)(row0 + ai * 128 + m * 16) * LDP;
#pragma unroll
                for (int bj = 0; bj < 2; ++bj)
#pragma unroll
                    for (int n = 0; n < 2; ++n) { const int c = col0 + bj * 128 + n * 16; const f32x4 bv = *(const f32x4*)(bias + c); const u32x2 tv = *(const u32x2*)(rowp + PU + c);
                        const f32x4 a = acc[ai][bj][m][n] + bv; u32x2 w;
                        w.x = cvt_pk_bf16(bflo(tv.x) * sigmoidf_(a[0]), bfhi(tv.x) * sigmoidf_(a[1])); w.y = cvt_pk_bf16(bflo(tv.y) * sigmoidf_(a[2]), bfhi(tv.y) * sigmoidf_(a[3]));
                        *(u32x2*)(rowp + PK + c) = w; } }
    }
};
struct EpiMerge {
    const bf16_t* P; bf16_t* MIXB;
    static __device__ __forceinline__ int goff(int seg) { return PG + (seg == 0 ? 0 : (seg == 1 ? 4096 : 2048)); }
    __device__ __forceinline__ void mid(f32x4 (&acc)[2][2][4][2], const pg8::Unit& u, int seg, int wr, int wc) const {
        const int ln_ = lane_now(); const int fr = ln_ & 15, fq = ln_ >> 4;
        const int row0 = u.pm * 256 + wr * 64 + fr, col0 = u.pn * 256 + wc * 32 + 4 * fq; const int gp = goff(seg - 1), gn = goff(seg);
#pragma unroll
        for (int ai = 0; ai < 2; ++ai) {
            u32x2 a[4][2][2], b[4][2][2];
#pragma unroll
            for (int m = 0; m < 4; ++m) { const bf16_t* rp = P + (size_t)(row0 + ai * 128 + m * 16) * LDP + col0;
#pragma unroll
                for (int bj = 0; bj < 2; ++bj)
#pragma unroll
                    for (int n = 0; n < 2; ++n) { a[m][bj][n] = *(const u32x2*)(rp + gp + bj * 128 + n * 16); b[m][bj][n] = *(const u32x2*)(rp + gn + bj * 128 + n * 16); } }
            asm volatile("s_waitcnt vmcnt(0)" ::: "memory");
#pragma unroll
            for (int m = 0; m < 4; ++m)
#pragma unroll
                for (int bj = 0; bj < 2; ++bj)
#pragma unroll
                    for (int n = 0; n < 2; ++n) { f32x4 r;
                        r[0] = bflo(a[m][bj][n].x) * __builtin_amdgcn_rcpf(fmaxf(bflo(b[m][bj][n].x), 1e-30f)); r[1] = bfhi(a[m][bj][n].x) * __builtin_amdgcn_rcpf(fmaxf(bfhi(b[m][bj][n].x), 1e-30f));
                        r[2] = bflo(a[m][bj][n].y) * __builtin_amdgcn_rcpf(fmaxf(bflo(b[m][bj][n].y), 1e-30f)); r[3] = bfhi(a[m][bj][n].y) * __builtin_amdgcn_rcpf(fmaxf(bfhi(b[m][bj][n].y), 1e-30f));
                        acc[ai][bj][m][n] = acc[ai][bj][m][n] * r; }
            asm volatile("" ::: "memory"); }
    }
    __device__ __forceinline__ void operator()(const f32x4 (&acc)[2][2][4][2], const pg8::Unit& u, int wr, int wc, int, int) const { const int ln_ = lane_now(); const int fr = ln_ & 15, fq = ln_ >> 4;
        const int row0 = u.pm * 256 + wr * 64 + fr, col0 = u.pn * 256 + wc * 32 + 4 * fq; const int gl = goff(2);
#pragma unroll
        for (int ai = 0; ai < 2; ++ai)
#pragma unroll
            for (int m = 0; m < 4; ++m) { const size_t row = (size_t)(row0 + ai * 128 + m * 16);
#pragma unroll
                for (int bj = 0; bj < 2; ++bj)
#pragma unroll
                    for (int n = 0; n < 2; ++n) { const int c = col0 + bj * 128 + n * 16; const u32x2 gv = *(const u32x2*)(P + row * LDP + gl + c);
                        f32x4 v = acc[ai][bj][m][n]; v[0] *= fmaxf(bflo(gv.x), 1e-30f); v[1] *= fmaxf(bfhi(gv.x), 1e-30f); v[2] *= fmaxf(bflo(gv.y), 1e-30f); v[3] *= fmaxf(bfhi(gv.y), 1e-30f);
                        u32x2 w; w.x = cvt_pk_bf16(v[0], v[1]); w.y = cvt_pk_bf16(v[2], v[3]); *(u32x2*)(MIXB + row * D + c) = w; } }
    }
};

struct S5AOrder {
    int G, c; const char* A; const char* B;
    __device__ __forceinline__ bool next(int i, pg8::Unit& u) const {
        const int idx = i * G + c; if (idx >= 640) return false;
        const int g = idx / 10, r = idx - 10 * g, nt = r / 5, mt = r - 5 * nt;
        u.pm = mt; u.pn = nt; u.aux = g; u.kt = 4; u.a = A + (size_t)(16 * g) * 2 + (size_t)mt * 256 * 16 * LDP * 2; u.b = B + (size_t)(g * 512 + nt * 256) * 256 * 2; return true;
    }
};
struct EpiS5A {
    bf16_t* YL; float* ST;
    __device__ __forceinline__ void operator()(const f32x4 (&acc)[2][2][4][2], const pg8::Unit& u, int wr, int wc, int, int) const { const int ln_ = lane_now(); const int fr = ln_ & 15, fq = ln_ >> 4;
        const int g = u.aux;
#pragma unroll
        for (int ai = 0; ai < 2; ++ai)
#pragma unroll
            for (int m = 0; m < 4; ++m) { const int mr = u.pm * 256 + ai * 128 + wr * 64 + m * 16 + fr; if (mr < S5M) {
#pragma unroll
                for (int bj = 0; bj < 2; ++bj)
#pragma unroll
                    for (int n = 0; n < 2; ++n) { const f32x4 v = acc[ai][bj][m][n];
                        if (u.pn == 0) { const int rho = 8 * bj + 2 * wc + n; u32x2 w; w.x = cvt_pk_bf16(v[0], v[1]); w.y = cvt_pk_bf16(v[2], v[3]); *(u32x2*)(YL + (size_t)(16 * mr + rho) * 1024 + 16 * g + 4 * fq) = w; }
                        else *(f32x4*)(ST + ((size_t)g * S5M + mr) * 256 + bj * 128 + wc * 32 + n * 16 + 4 * fq) = v; } } }
    }
};
struct S5COrder {
    int G, c; const char* A; const char* B;
    __device__ __forceinline__ bool next(int i, pg8::Unit& u) const {
        const int idx = i * G + c; if (idx >= 320) return false;
        const int g = idx / 5, mt = idx - 5 * g;
        u.pm = mt; u.pn = 0; u.aux = g; u.kt = 4; u.a = A + ((size_t)g * 1280 + mt * 256) * 256 * 2; u.b = B + (size_t)g * 256 * 256 * 2; return true;
    }
};
struct EpiS5C {
    const bf16_t* YL; bf16_t* P;
    __device__ __forceinline__ void operator()(const f32x4 (&acc)[2][2][4][2], const pg8::Unit& u, int wr, int wc, int, int) const { const int ln_ = lane_now(); const int fr = ln_ & 15, fq = ln_ >> 4;
        const int g = u.aux;
#pragma unroll
        for (int ai = 0; ai < 2; ++ai)
#pragma unroll
            for (int m = 0; m < 4; ++m) { const int mr = u.pm * 256 + ai * 128 + wr * 64 + m * 16 + fr; if (mr < S5M) {
#pragma unroll
                for (int bj = 0; bj < 2; ++bj)
#pragma unroll
                    for (int n = 0; n < 2; ++n) { const int rho = 8 * bj + 2 * wc + n; const size_t row = (size_t)(16 * mr + rho);
                        const u32x2 yl = *(const u32x2*)(YL + row * 1024 + 16 * g + 4 * fq); f32x4 v = acc[ai][bj][m][n];
                        v[0] += bflo(yl.x); v[1] += bfhi(yl.x); v[2] += bflo(yl.y); v[3] += bfhi(yl.y);
#pragma unroll
                        for (int e = 0; e < 4; ++e) { const float x = v[e]; const float inner = 0.7978845608028654f * (x + 0.044715f * x * x * x); const float th = 1.0f - 2.0f * __builtin_amdgcn_rcpf(1.0f + __builtin_amdgcn_exp2f(2.8853900817779268f * inner)); v[e] = 0.5f * x * (1.0f + th); }
                        u32x2 w; w.x = cvt_pk_bf16(v[0], v[1]); w.y = cvt_pk_bf16(v[2], v[3]); *(u32x2*)(P + row * LDP + PU + 16 * g + 4 * fq) = w; } } }
    }
};

namespace attn_body {
using bf16 = __hip_bfloat16;
constexpr int NW = 8, QBLK = 32, KVBLK = 64;
constexpr int PQKV = LDP, PO = 1024;
__device__ __forceinline__ int crow(int r, int hi) { return (r & 3) + 8 * (r >> 2) + 4 * hi; }
#define SBAR() __builtin_amdgcn_sched_barrier(0)
constexpr int NSLOT = 3, SLOTB = 8192;
constexpr int LDS_K = 0, LDS_V = NSLOT * SLOTB, LDS_WS = 2 * NSLOT * SLOTB, LDS_OST = LDS_WS + NW * 64 * 4, LDS_BYTES = LDS_OST + NW * 4096;
__device__ __forceinline__ void glds16(const void* gsrc, unsigned lds_dst) { unsigned keep;
  asm volatile("s_mov_b32 %0, m0\n\ts_mov_b32 m0, %2\n\ts_nop 0\n\tglobal_load_lds_dwordx4 %1, off\n\ts_mov_b32 m0, %0" : "=&s"(keep) : "v"(gsrc), "s"(lds_dst) : "memory"); }
__device__ __forceinline__ float max3f(float a, float b, float c) { float r; asm("v_max3_f32 %0, %1, %2, %3" : "=v"(r) : "v"(a), "v"(b), "v"(c)); return r; }
__device__ __forceinline__ float max2f(float a, float b) { float r; asm("v_max_f32_e32 %0, %1, %2" : "=v"(r) : "v"(a), "v"(b)); return r; }
__device__ __forceinline__ float fadd_s(float a, float b) { float r; asm("v_add_f32_e32 %0, %1, %2" : "=v"(r) : "v"(a), "v"(b)); return r; }
__device__ __forceinline__ float fsub_s(float a, float b) { float r; asm("v_sub_f32_e32 %0, %1, %2" : "=v"(r) : "v"(a), "v"(b)); return r; }
typedef float f32x2_t __attribute__((ext_vector_type(2))); typedef __bf16 bf16x2_t __attribute__((ext_vector_type(2)));
__device__ __forceinline__ unsigned cvtpk_s(float lo, float hi) { f32x2_t v = {lo, hi}; bf16x2_t b = __builtin_convertvector(v, bf16x2_t); return __builtin_bit_cast(unsigned, b); }
#define WAIT_BAR(N) asm volatile("s_waitcnt vmcnt(" #N ") lgkmcnt(0)\n\ts_barrier" ::: "memory")
__device__ __forceinline__ void qkt(f32x16& p0, f32x16& p1, const char* Kslot, const bf16x8* qr, const f32x16& negm, int r32, int hi) {
  const char* kb = Kslot + hi * 1024 + r32 * 16;
#pragma unroll
  for (int d0 = 0; d0 < 4; ++d0) {
    const bf16x8 b0 = *reinterpret_cast<const bf16x8*>(kb + d0 * 2048);
    const bf16x8 b1 = *reinterpret_cast<const bf16x8*>(kb + d0 * 2048 + 512);
    if (d0 == 0) { p0 = __builtin_amdgcn_mfma_f32_32x32x16_bf16(b0, qr[0], negm, 0, 0, 0); p1 = __builtin_amdgcn_mfma_f32_32x32x16_bf16(b1, qr[0], negm, 0, 0, 0); }
    else { p0 = __builtin_amdgcn_mfma_f32_32x32x16_bf16(b0, qr[d0], p0, 0, 0, 0); p1 = __builtin_amdgcn_mfma_f32_32x32x16_bf16(b1, qr[d0], p1, 0, 0, 0); } }
}
typedef __attribute__((address_space(3))) const char* lds_cptr;
typedef short v4i16_t __attribute__((ext_vector_type(4)));
__device__ __forceinline__ void kload8(bf16x8* kf, lds_cptr kp) {
  kf[0] = *(const __attribute__((address_space(3))) bf16x8*)(kp);        kf[1] = *(const __attribute__((address_space(3))) bf16x8*)(kp + 512);
  kf[2] = *(const __attribute__((address_space(3))) bf16x8*)(kp + 2048); kf[3] = *(const __attribute__((address_space(3))) bf16x8*)(kp + 2560);
  kf[4] = *(const __attribute__((address_space(3))) bf16x8*)(kp + 4096); kf[5] = *(const __attribute__((address_space(3))) bf16x8*)(kp + 4608);
  kf[6] = *(const __attribute__((address_space(3))) bf16x8*)(kp + 6144); kf[7] = *(const __attribute__((address_space(3))) bf16x8*)(kp + 6656);
}
__device__ __forceinline__ void kload2(bf16x8* kf, lds_cptr kp, int j) { kf[2 * j] = *(const __attribute__((address_space(3))) bf16x8*)(kp + j * 2048); kf[2 * j + 1] = *(const __attribute__((address_space(3))) bf16x8*)(kp + j * 2048 + 512); }
__device__ __forceinline__ s16x4 vtr(lds_cptr p) { return __builtin_bit_cast(s16x4, __builtin_amdgcn_ds_read_tr16_b64_v4i16((__attribute__((address_space(3))) v4i16_t*)p)); }
__device__ __forceinline__ float rowmax(const f32x16& p0, const f32x16& p1) {
  float a = max3f(p0[0], p0[1], p1[0]), b = max3f(p0[2], p0[3], p1[1]); a = max3f(a, p1[2], p1[3]);
#pragma unroll
  for (int r = 4; r < 16; r += 4) { a = max3f(a, p0[r], p0[r + 1]); b = max3f(b, p0[r + 2], p0[r + 3]); a = max3f(a, p1[r], p1[r + 1]); b = max3f(b, p1[r + 2], p1[r + 3]); }
  const float m = max2f(a, b);
  auto rr = __builtin_amdgcn_permlane32_swap(__float_as_uint(m), __float_as_uint(m), false, false);
  return max2f(__uint_as_float(rr[0]), __uint_as_float(rr[1]));
}
__device__ __forceinline__ void pv(f32x16* o, int vb, bf16x8 pa0, bf16x8 pa1, bf16x8 pa2, bf16x8 pa3) {
#pragma unroll
  for (int d0 = 0; d0 < 2; ++d0) { s16x4 lo[4], hi[4];
#pragma unroll
    for (int ks = 0; ks < 4; ++ks) {
      asm volatile("ds_read_b64_tr_b16 %0,%1 offset:%c2" : "=&v"(lo[ks]) : "v"(vb), "i"(d0 * 4096 + ks * 1024) : "memory");
      asm volatile("ds_read_b64_tr_b16 %0,%1 offset:%c2" : "=&v"(hi[ks]) : "v"(vb), "i"(d0 * 4096 + ks * 1024 + 512) : "memory"); }
    asm volatile("s_waitcnt lgkmcnt(0)" ::: "memory"); SBAR();
#define PK(k) (bf16x8){lo[k][0], lo[k][1], lo[k][2], lo[k][3], hi[k][0], hi[k][1], hi[k][2], hi[k][3]}
    o[d0] = __builtin_amdgcn_mfma_f32_32x32x16_bf16(pa0, PK(0), o[d0], 0, 0, 0);
    o[d0] = __builtin_amdgcn_mfma_f32_32x32x16_bf16(pa1, PK(1), o[d0], 0, 0, 0);
    o[d0] = __builtin_amdgcn_mfma_f32_32x32x16_bf16(pa2, PK(2), o[d0], 0, 0, 0);
    o[d0] = __builtin_amdgcn_mfma_f32_32x32x16_bf16(pa3, PK(3), o[d0], 0, 0, 0);
#undef PK
  }
}
template <int THRL> __device__ __forceinline__ void attn_unit(const bf16* Q0, const bf16* __restrict__ Kh, const bf16* __restrict__ Vh, bf16* O0, const int NT, char* shm, const int tid) {
  const int lane = tid & 63, r32 = lane & 31, hi = lane >> 5; const int wid = __builtin_amdgcn_readfirstlane(tid >> 6);
  const bf16* Qw = Q0 + (long)(wid * QBLK) * PQKV;
  const unsigned lds0 = (unsigned)(uintptr_t)shm;
  float* wsf = (float*)(shm + LDS_WS) + wid * 64;
  const bf16* ksrc = Kh + (long)lane * PQKV + wid * 8;
  const bf16* vsrc = Vh + (long)(16 * (wid & 3) + (lane >> 2)) * PQKV + (wid >> 2) * 32 + (lane & 3) * 8;
  const unsigned kdst = lds0 + LDS_K + wid * 1024, vdst = lds0 + LDS_V + wid * 1024;
#define DMA_K(t, slot) glds16(ksrc + (long)(t) * KVBLK * PQKV, (unsigned)__builtin_amdgcn_readfirstlane(kdst + (slot)))
#define DMA_V(t, slot) glds16(vsrc + (long)(t) * KVBLK * PQKV, (unsigned)__builtin_amdgcn_readfirstlane(vdst + (slot)))
  const int vb0 = (int)(lds0 + LDS_V) + ((lane >> 4) & 1) * 32 + (lane & 3) * 8 + (4 * hi + ((lane & 15) >> 2)) * 64;
  const char* Kbase = shm + LDS_K; bf16x8 kf[8];
  const lds_cptr shm3 = (lds_cptr)shm; const lds_cptr kp0 = shm3 + LDS_K + hi * 1024 + r32 * 16; const lds_cptr vp0 = shm3 + LDS_V + ((lane >> 4) & 1) * 32 + (lane & 3) * 8 + (4 * hi + ((lane & 15) >> 2)) * 64;
  DMA_K(0, 0); DMA_V(0, 0); DMA_K(1, SLOTB);
  bf16x8 qr[4];
#pragma unroll
  for (int d0 = 0; d0 < 4; ++d0) qr[d0] = *reinterpret_cast<const bf16x8*>(&Qw[(long)r32 * PQKV + d0 * 16 + hi * 8]);
  float zf_; asm volatile("v_mov_b32 %0, 0" : "=v"(zf_)); float mhat = 0.f, l_reg = 0.f; f32x16 o[2], negm;
  _Pragma("unroll") for (int r = 0; r < 16; ++r) { o[0][r] = zf_; o[1][r] = zf_; negm[r] = zf_; } asm volatile("" : "+v"(negm));
  bool resc = false;
#define START(P0, P1) do { const float rm = rowmax(P0, P1); resc = false; \
    { const float dl = rm; mhat = fadd_s(mhat, dl); \
      _Pragma("unroll") for (int r = 0; r < 16; ++r) { P0[r] = fsub_s(P0[r], dl); P1[r] = fsub_s(P1[r], dl); } \
      _Pragma("unroll") for (int r = 0; r < 16; ++r) negm[r] = -mhat; asm volatile("" : "+v"(negm)); } \
    _Pragma("unroll") for (int r = 0; r < 16; ++r) P0[r] = __builtin_amdgcn_exp2f(P0[r]); } while (0)
#define RESC() do { if (resc) { asm volatile("s_waitcnt lgkmcnt(0)" ::: "memory"); \
      _Pragma("unroll") for (int d_ = 0; d_ < 2; ++d_) _Pragma("unroll") for (int r = 0; r < 16; ++r) o[d_][r] *= wsf[crow(r, hi)]; } } while (0)
  f32x16 pA0, pA1, pB0, pB1;
  int sl_prev = 0, sl_cur = 0, sl_next = SLOTB;
#define ROT() do { sl_prev = sl_cur; sl_cur = sl_next; sl_next = (sl_next == (NSLOT - 1) * SLOTB) ? 0 : sl_next + SLOTB; } while (0)
  DMA_K(2, 2 * SLOTB);
  WAIT_BAR(3);
  qkt(pA0, pA1, Kbase, qr, negm, r32, hi); asm volatile("s_nop 15\n\ts_nop 7" : "+v"(pA0), "+v"(pA1));
  START(pA0, pA1);
  _Pragma("unroll") for (int r = 0; r < 16; ++r) pA1[r] = __builtin_amdgcn_exp2f(pA1[r]);
  WAIT_BAR(0);
  DMA_K(3, 0); DMA_V(1, SLOTB);
  ROT();
  kload8(kf, kp0 + sl_cur);
  WAIT_BAR(2);
  s16x4 vlo[8], vhi[8]; u32x4 pw0, pw1, pw2, pw3;
#define PKW(P, B) cvtpk_s(P[B], P[B + 1])
#define PAF(k) __builtin_bit_cast(bf16x8, pw##k)
#define VFR(i) (bf16x8){vlo[i][0], vlo[i][1], vlo[i][2], vlo[i][3], vhi[i][0], vhi[i][1], vhi[i][2], vhi[i][3]}
#define PIN(x) asm volatile("" : "+v"(x))
#define MX3(a, b, c) __builtin_fmaxf(__builtin_fmaxf((a), (b)), (c))
#define GAPA(MF, A0, A1, A2, A3, W0, W1, PW) do { MF; sacc += A0; sacc += A1; sacc += A2; sacc += A3; PIN(sacc); W0; W1; PIN(PW); SBAR(); } while (0)
#define EX(v) __builtin_amdgcn_exp2f(v)
#define GAPB(MF, X, B) do { MF; X[B] = EX(X[B]); X[B + 1] = EX(X[B + 1]); X[B + 2] = EX(X[B + 2]); X[B + 3] = EX(X[B + 3]); PIN(X); SBAR(); } while (0)
#define VRD(i) do { vlo[i] = vtr(vp_ + (((i) >> 2) * 4096 + ((i) & 3) * 1024)); vhi[i] = vtr(vp_ + (((i) >> 2) * 4096 + ((i) & 3) * 1024 + 512)); } while (0)
#define KRD(G, j) do { if (G) { kload2(kf, kp0 + sl_next, j); SBAR(); } } while (0)
#define STEP(C0, C1, P0, P1, t, GK, GV, GL) do { SBAR(); \
    const lds_cptr vp_ = vp0 + sl_prev; \
    VRD(0); SBAR(); float sacc = (P0[0] + P0[1]); \
    GAPA(C0 = __builtin_amdgcn_mfma_f32_32x32x16_bf16(kf[0], qr[0], negm, 0, 0, 0), P0[2], P0[3], P0[4], P0[5],     pw0[0] = PKW(P0, 0), pw0[1] = PKW(P0, 2), pw0); \
    VRD(4); SBAR(); GAPA(C1 = __builtin_amdgcn_mfma_f32_32x32x16_bf16(kf[1], qr[0], negm, 0, 0, 0), P0[6], P0[7], P0[8], P0[9],     pw0[2] = PKW(P0, 4), pw0[3] = PKW(P0, 6), pw0); \
    VRD(1); SBAR(); GAPA(C0 = __builtin_amdgcn_mfma_f32_32x32x16_bf16(kf[2], qr[1], C0, 0, 0, 0),   P0[10], P0[11], P0[12], P0[13], pw1[0] = PKW(P0, 8), pw1[1] = PKW(P0, 10), pw1); \
    VRD(5); SBAR(); GAPA(C1 = __builtin_amdgcn_mfma_f32_32x32x16_bf16(kf[3], qr[1], C1, 0, 0, 0),   P0[14], P0[15], P1[0], P1[1],   pw1[2] = PKW(P0, 12), pw1[3] = PKW(P0, 14), pw1); \
    VRD(2); SBAR(); GAPA(C0 = __builtin_amdgcn_mfma_f32_32x32x16_bf16(kf[4], qr[2], C0, 0, 0, 0),   P1[2], P1[3], P1[4], P1[5],     pw2[0] = PKW(P1, 0), pw2[1] = PKW(P1, 2), pw2); \
    VRD(6); SBAR(); GAPA(C1 = __builtin_amdgcn_mfma_f32_32x32x16_bf16(kf[5], qr[2], C1, 0, 0, 0),   P1[6], P1[7], P1[8], P1[9],     pw2[2] = PKW(P1, 4), pw2[3] = PKW(P1, 6), pw2); \
    VRD(3); SBAR(); GAPA(C0 = __builtin_amdgcn_mfma_f32_32x32x16_bf16(kf[6], qr[3], C0, 0, 0, 0),   P1[10], P1[11], P1[12], P1[13], pw3[0] = PKW(P1, 8), pw3[1] = PKW(P1, 10), pw3); \
    VRD(7); SBAR(); GAPA(C1 = __builtin_amdgcn_mfma_f32_32x32x16_bf16(kf[7], qr[3], C1, 0, 0, 0),   P1[14], P1[15], 0.f, 0.f,       pw3[2] = PKW(P1, 12), pw3[3] = PKW(P1, 14), pw3); \
    l_reg += sacc; \
    if (GK) { DMA_K((t) + 3, sl_cur); } if (GV) { DMA_V((t) + 1, sl_next); } \
    { float a = MX3(C0[0], C0[1], C1[0]), b = MX3(C0[2], C0[3], C1[1]); a = MX3(a, C1[2], C1[3]); \
      _Pragma("unroll") for (int r = 4; r < 16; r += 4) { a = MX3(a, C0[r], C0[r + 1]); b = MX3(b, C0[r + 2], C0[r + 3]); a = MX3(a, C1[r], C1[r + 1]); b = MX3(b, C1[r + 2], C1[r + 3]); } \
      float rm = __builtin_fmaxf(a, b); { auto rr = __builtin_amdgcn_permlane32_swap(__float_as_uint(rm), __float_as_uint(rm), false, false); rm = __builtin_fmaxf(__uint_as_float(rr[0]), __uint_as_float(rr[1])); } \
      resc = false; \
      if (__builtin_expect(__any(rm > (float)THRL), 0)) { const float dl = __builtin_fmaxf(rm, 0.f); mhat += dl; \
        _Pragma("unroll") for (int r = 0; r < 16; ++r) { C0[r] -= dl; C1[r] -= dl; } \
        _Pragma("unroll") for (int r = 0; r < 16; ++r) negm[r] = -mhat; asm volatile("" : "+v"(negm)); \
        const float f = __builtin_amdgcn_exp2f(-dl); l_reg *= f; if (hi == 0) wsf[r32] = f; resc = true; } } \
    SBAR(); \
    GAPB(o[0] = __builtin_amdgcn_mfma_f32_32x32x16_bf16(PAF(0), VFR(0), o[0], 0, 0, 0), C0, 0); \
    GAPB(o[1] = __builtin_amdgcn_mfma_f32_32x32x16_bf16(PAF(0), VFR(4), o[1], 0, 0, 0), C0, 4); \
    KRD(GL, 0); GAPB(o[0] = __builtin_amdgcn_mfma_f32_32x32x16_bf16(PAF(1), VFR(1), o[0], 0, 0, 0), C0, 8); \
    KRD(GL, 1); GAPB(o[1] = __builtin_amdgcn_mfma_f32_32x32x16_bf16(PAF(1), VFR(5), o[1], 0, 0, 0), C0, 12); \
    KRD(GL, 2); GAPB(o[0] = __builtin_amdgcn_mfma_f32_32x32x16_bf16(PAF(2), VFR(2), o[0], 0, 0, 0), C1, 0); \
    KRD(GL, 3); GAPB(o[1] = __builtin_amdgcn_mfma_f32_32x32x16_bf16(PAF(2), VFR(6), o[1], 0, 0, 0), C1, 4); \
    GAPB(o[0] = __builtin_amdgcn_mfma_f32_32x32x16_bf16(PAF(3), VFR(3), o[0], 0, 0, 0), C1, 8); \
    GAPB(o[1] = __builtin_amdgcn_mfma_f32_32x32x16_bf16(PAF(3), VFR(7), o[1], 0, 0, 0), C1, 12); \
    } while (0)
  int t = 1;
  for (; t + 5 < NT; t += 2) {
    STEP(pB0, pB1, pA0, pA1, t, true, true, true);     WAIT_BAR(2); RESC(); ROT();
    STEP(pA0, pA1, pB0, pB1, t + 1, true, true, true); WAIT_BAR(2); RESC(); ROT();
  }
#define ENDW(tt) do { if ((tt) + 3 < NT) { WAIT_BAR(2); } else if ((tt) + 2 < NT) { WAIT_BAR(1); } else { WAIT_BAR(0); } } while (0)
  for (; t + 1 < NT; t += 2) {
    STEP(pB0, pB1, pA0, pA1, t, (t + 3 < NT), (t + 1 < NT), (t + 1 < NT));         ENDW(t);     RESC(); ROT();
    STEP(pA0, pA1, pB0, pB1, t + 1, (t + 4 < NT), (t + 2 < NT), (t + 2 < NT));     ENDW(t + 1); RESC(); ROT();
  }
  STEP(pB0, pB1, pA0, pA1, NT - 1, false, false, false); RESC();
  { float sacc = pB0[0] + pB0[1]; _Pragma("unroll") for (int r = 2; r < 16; ++r) sacc += pB0[r]; _Pragma("unroll") for (int r = 0; r < 16; ++r) sacc += pB1[r]; l_reg += sacc;
    pw0 = (u32x4){PKW(pB0, 0), PKW(pB0, 2), PKW(pB0, 4), PKW(pB0, 6)}; pw1 = (u32x4){PKW(pB0, 8), PKW(pB0, 10), PKW(pB0, 12), PKW(pB0, 14)}; pw2 = (u32x4){PKW(pB1, 0), PKW(pB1, 2), PKW(pB1, 4), PKW(pB1, 6)}; pw3 = (u32x4){PKW(pB1, 8), PKW(pB1, 10), PKW(pB1, 12), PKW(pB1, 14)};
    SBAR(); pv(o, vb0 + sl_cur, PAF(0), PAF(1), PAF(2), PAF(3)); }
#undef PKW
#undef PAF
#undef VFR
#undef PIN
#undef MX3
#undef GAPA
#undef GAPB
#undef EX
#undef VRD
#undef KRD
#undef STEP
#undef ENDW
  { auto rr = __builtin_amdgcn_permlane32_swap(__float_as_uint(l_reg), __float_as_uint(l_reg), false, false); l_reg = __uint_as_float(rr[0]) + __uint_as_float(rr[1]); }
  if (hi == 0) wsf[32 + r32] = l_reg; asm volatile("s_waitcnt lgkmcnt(0)" ::: "memory");
  float rli[16];
#pragma unroll
  for (int r = 0; r < 16; ++r) rli[r] = __builtin_amdgcn_rcpf(wsf[32 + crow(r, hi)]);
  bf16* Ow = O0 + (long)(wid * QBLK) * PO;
  { bf16* stg = (bf16*)(shm + LDS_OST) + wid * 2048;
#pragma unroll
    for (int r = 0; r < 16; ++r) { const int orow = crow(r, hi);
#pragma unroll
      for (int d0 = 0; d0 < 2; ++d0) stg[orow * 64 + d0 * 32 + r32] = __float2bfloat16(o[d0][r] * rli[r]); }
    asm volatile("s_waitcnt lgkmcnt(0)" ::: "memory");
#pragma unroll
    for (int i = 0; i < 4; ++i) { const int row = i * 8 + (lane >> 3), ch = lane & 7; const u32x4 v = *(const u32x4*)(stg + row * 64 + ch * 8); *(u32x4*)(Ow + (long)row * PO + ch * 8) = v; } }
  asm volatile("s_waitcnt lgkmcnt(0)\n\ts_barrier" ::: "memory");
#undef DMA_K
#undef DMA_V
#undef START
#undef RESC
#undef ROT
}
#undef SBAR
#undef WAIT_BAR
}


namespace attn128 {
using bf16 = __hip_bfloat16;
constexpr int NW = 8, QBLK = 32, KVBLK = 64, LDQ = LDP, LDK = LDP, LDO = 1024;
constexpr size_t SHM_V = KVBLK * 128 * 2, SHM_K = KVBLK * 64 * 2, SHM_ATTN = 2 * SHM_V + 2 * SHM_K + NW * 64 * 4;
constexpr float THRL = 11.5f;
#define A128_KSWZ(row, colB) ((row) * 128 + ((colB) ^ (((row) & 7) << 4)))
#define A128_SBAR() __builtin_amdgcn_sched_barrier(0)
__device__ __forceinline__ int crow(int r, int hi) { return (r & 3) + 8 * (r >> 2) + 4 * hi; }
__device__ __forceinline__ void partialSM(f32x16& p0, f32x16& p1, float& m_reg, float& mn, float& alpha) {
  float pmax = p0[0];
#pragma unroll
  for (int r = 1; r < 16; ++r) pmax = fmaxf(pmax, p0[r]);
#pragma unroll
  for (int r = 0; r < 16; ++r) pmax = fmaxf(pmax, p1[r]);
  { auto rr = __builtin_amdgcn_permlane32_swap(__float_as_uint(pmax), __float_as_uint(pmax), false, false); pmax = fmaxf(__uint_as_float(rr[0]), __uint_as_float(rr[1])); }
  if (__builtin_expect(__all(pmax - m_reg <= THRL), 1)) { mn = m_reg; alpha = 1.f; }
  else { mn = fmaxf(m_reg, pmax); alpha = __builtin_amdgcn_exp2f(m_reg - mn); m_reg = mn; }
#pragma unroll
  for (int r = 0; r < 16; ++r) { p0[r] = p0[r] - mn; p1[r] = p1[r] - mn; }
#pragma unroll
  for (int r = 0; r < 16; ++r) p0[r] = __builtin_amdgcn_exp2f(p0[r]);
}
__device__ __forceinline__ void finishSM(f32x16& p0, f32x16& p1, float alpha, float& l_reg, bf16x8& pa0, bf16x8& pa1, bf16x8& pa2, bf16x8& pa3) {
#pragma unroll
  for (int r = 0; r < 16; ++r) p1[r] = __builtin_amdgcn_exp2f(p1[r]);
  float ps = 0;
#pragma unroll
  for (int r = 0; r < 16; ++r) ps += p0[r];
#pragma unroll
  for (int r = 0; r < 16; ++r) ps += p1[r];
  { auto rr = __builtin_amdgcn_permlane32_swap(__float_as_uint(ps), __float_as_uint(ps), false, false); ps = __uint_as_float(rr[0]) + __uint_as_float(rr[1]); }
  l_reg = l_reg * alpha + ps;
#define A128_PK4(P, BASE, OUT) do { unsigned a0 = cvt_pk_bf16(P[BASE + 0], P[BASE + 1]), a1 = cvt_pk_bf16(P[BASE + 2], P[BASE + 3]);   \
    unsigned b0 = cvt_pk_bf16(P[BASE + 4], P[BASE + 5]), b1 = cvt_pk_bf16(P[BASE + 6], P[BASE + 7]);                              \
    auto r0 = __builtin_amdgcn_permlane32_swap(a0, b0, false, false); auto r1 = __builtin_amdgcn_permlane32_swap(a1, b1, false, false); \
    u32x4 w = {r0[0], r1[0], r0[1], r1[1]}; OUT = __builtin_bit_cast(bf16x8, w); } while (0)
  A128_PK4(p0, 0, pa0); A128_PK4(p0, 8, pa1); A128_PK4(p1, 0, pa2); A128_PK4(p1, 8, pa3);
#undef A128_PK4
}
__device__ __forceinline__ void qkt(f32x16& p0, f32x16& p1, const char* Ks, const bf16x8* qr, int r32, int hi) {
#pragma unroll
  for (int i = 0; i < 16; ++i) { p0[i] = 0.f; p1[i] = 0.f; }
#pragma unroll
  for (int d0 = 0; d0 < 4; ++d0) { const int cb = (d0 * 16 + hi * 8) * 2;
    const bf16x8 b0 = *reinterpret_cast<const bf16x8*>(Ks + A128_KSWZ(r32, cb));
    const bf16x8 b1 = *reinterpret_cast<const bf16x8*>(Ks + A128_KSWZ(32 + r32, cb));
    p0 = __builtin_amdgcn_mfma_f32_32x32x16_bf16(b0, qr[d0], p0, 0, 0, 0);
    p1 = __builtin_amdgcn_mfma_f32_32x32x16_bf16(b1, qr[d0], p1, 0, 0, 0); }
}
__device__ __forceinline__ int v_st(int k, int c) { const int kk = (k & ~0xC) | ((k & 4) << 1) | ((k & 8) >> 1); return ((kk >> 3) * 4 + (c >> 5)) * 512 + ((kk & 7) * 32 + (c & 31)) * 2; }
__device__ __forceinline__ int v_rd_base(int lane) { return ((lane & 3) << 3) | (((lane >> 2) & 3) << 6) | (((lane >> 4) & 1) << 5) | (((lane >> 5) & 1) << 8); }
constexpr int v_rd_off(int d0, int ks, int half) { return d0 * 512 + ks * 4096 + half * 2048; }
template <int OFF> __device__ __forceinline__ s16x4 tr_read(int vb) { s16x4 r; asm volatile("ds_read_b64_tr_b16 %0, %1 offset:%2" : "=&v"(r) : "v"(vb), "i"(OFF) : "memory"); return r; }
template <int D0> __device__ __forceinline__ void pv_one(f32x16& od, int vb, bf16x8 pa0, bf16x8 pa1, bf16x8 pa2, bf16x8 pa3) {
  const s16x4 l0 = tr_read<v_rd_off(D0, 0, 0)>(vb), h0 = tr_read<v_rd_off(D0, 0, 1)>(vb), l1 = tr_read<v_rd_off(D0, 1, 0)>(vb), h1 = tr_read<v_rd_off(D0, 1, 1)>(vb);
  const s16x4 l2 = tr_read<v_rd_off(D0, 2, 0)>(vb), h2 = tr_read<v_rd_off(D0, 2, 1)>(vb), l3 = tr_read<v_rd_off(D0, 3, 0)>(vb), h3 = tr_read<v_rd_off(D0, 3, 1)>(vb);
  asm volatile("s_waitcnt lgkmcnt(0)" ::: "memory"); A128_SBAR();
#define A128_PK(L, H) (bf16x8){L[0], L[1], L[2], L[3], H[0], H[1], H[2], H[3]}
  od = __builtin_amdgcn_mfma_f32_32x32x16_bf16(pa0, A128_PK(l0, h0), od, 0, 0, 0);
  od = __builtin_amdgcn_mfma_f32_32x32x16_bf16(pa1, A128_PK(l1, h1), od, 0, 0, 0);
  od = __builtin_amdgcn_mfma_f32_32x32x16_bf16(pa2, A128_PK(l2, h2), od, 0, 0, 0);
  od = __builtin_amdgcn_mfma_f32_32x32x16_bf16(pa3, A128_PK(l3, h3), od, 0, 0, 0);
#undef A128_PK
}
__device__ __forceinline__ void pv_d0(f32x16* o, int vb, bf16x8 pa0, bf16x8 pa1, bf16x8 pa2, bf16x8 pa3) {
  pv_one<0>(o[0], vb, pa0, pa1, pa2, pa3); pv_one<1>(o[1], vb, pa0, pa1, pa2, pa3); pv_one<2>(o[2], vb, pa0, pa1, pa2, pa3); pv_one<3>(o[3], vb, pa0, pa1, pa2, pa3);
}
__device__ __forceinline__ void unit(const bf16* __restrict__ Qb, const bf16* __restrict__ Kh, const bf16* __restrict__ Vh, bf16_t* __restrict__ Ob, int seq, char* lds, const int tid) {
  const int wid = __builtin_amdgcn_readfirstlane(tid >> 6), lane = tid & 63, r32 = lane & 31, hi = lane >> 5;
  char* V_lds = lds; char* K_lds = lds + 2 * SHM_V;
  float* ws = (float*)(lds + 2 * SHM_V + 2 * SHM_K) + wid * 64; float* li_l = ws; float* al_l = ws + 32;
  float m_reg = -1e30f, l_reg = 0; f32x16 o[4]; bf16x8 qr[4];
#pragma unroll
  for (int d = 0; d < 4; ++d)
#pragma unroll
    for (int r = 0; r < 16; ++r) o[d][r] = 0.f;
  const bf16* Qw = Qb + (long)(wid * QBLK + r32) * LDQ + hi * 8;
#pragma unroll
  for (int d0 = 0; d0 < 4; ++d0) qr[d0] = *reinterpret_cast<const bf16x8*>(Qw + d0 * 16);
  const int sr = tid >> 4, sc = (tid & 15) * 8, vst0 = v_st(sr, sc), vst1 = v_st(32 + sr, sc);
  const int kr = tid >> 3, kc = (tid & 7) * 8, kst = A128_KSWZ(kr, kc * 2);
  const int vb0 = (int)(uintptr_t)V_lds + v_rd_base(lane);
  struct { bf16x8 vs0, vs1, ks0; } sr_[2];
#define A128_SLOAD(i, k0) do { sr_[i].vs0 = *reinterpret_cast<const bf16x8*>(&Vh[(long)((k0) + sr) * LDK + sc]); sr_[i].vs1 = *reinterpret_cast<const bf16x8*>(&Vh[(long)((k0) + 32 + sr) * LDK + sc]); \
    sr_[i].ks0 = *reinterpret_cast<const bf16x8*>(&Kh[(long)((k0) + kr) * LDK + kc]); } while (0)
#define A128_SWRITE(b, i) do { *(bf16x8*)(V_lds + (b) * SHM_V + vst0) = sr_[i].vs0; *(bf16x8*)(V_lds + (b) * SHM_V + vst1) = sr_[i].vs1; *(bf16x8*)(K_lds + (b) * SHM_K + kst) = sr_[i].ks0; } while (0)
#define A128_SWAIT() asm volatile("s_waitcnt vmcnt(3)" ::: "memory")
#define A128_RESC(a) do { if (__any((a) < 1.f)) { if (hi == 0) al_l[r32] = (a); asm volatile("s_waitcnt lgkmcnt(0)" ::: "memory"); \
    _Pragma("unroll") for (int d = 0; d < 4; ++d) _Pragma("unroll") for (int r = 0; r < 16; ++r) o[d][r] *= al_l[crow(r, hi)]; } } while (0)
  f32x16 pA0, pA1, pB0, pB1; float mnA, mnB, alA, alB; bf16x8 pa0, pa1, pa2, pa3; const int NT = seq / KVBLK;
  A128_SLOAD(0, 0); asm volatile("s_waitcnt vmcnt(0)" ::: "memory"); A128_SWRITE(0, 0); __syncthreads();
  qkt(pA0, pA1, K_lds, qr, r32, hi); partialSM(pA0, pA1, m_reg, mnA, alA);
  A128_SLOAD(1, KVBLK); if (2 < NT) A128_SLOAD(0, 2 * KVBLK);
  A128_SWAIT(); A128_SWRITE(1, 1); __syncthreads();
  for (int j = 1; j + 1 < NT; j += 2) {
    A128_SBAR(); qkt(pB0, pB1, K_lds + SHM_K, qr, r32, hi);
    finishSM(pA0, pA1, alA, l_reg, pa0, pa1, pa2, pa3); A128_SBAR();
    A128_SLOAD(1, (j + 2) * KVBLK); A128_SBAR();
    pv_d0(o, vb0, pa0, pa1, pa2, pa3); partialSM(pB0, pB1, m_reg, mnB, alB);
    __syncthreads(); A128_SWAIT(); A128_SWRITE(0, 0);
    A128_RESC(alB); __syncthreads();
    A128_SBAR(); qkt(pA0, pA1, K_lds, qr, r32, hi);
    finishSM(pB0, pB1, alB, l_reg, pa0, pa1, pa2, pa3); A128_SBAR();
    if (j + 3 < NT) A128_SLOAD(0, (j + 3) * KVBLK); A128_SBAR();
    pv_d0(o, vb0 + (int)SHM_V, pa0, pa1, pa2, pa3); partialSM(pA0, pA1, m_reg, mnA, alA);
    __syncthreads(); A128_SWAIT(); A128_SWRITE(1, 1);
    A128_RESC(alA); __syncthreads();
  }
  A128_SBAR(); qkt(pB0, pB1, K_lds + SHM_K, qr, r32, hi);
  finishSM(pA0, pA1, alA, l_reg, pa0, pa1, pa2, pa3); A128_SBAR();
  pv_d0(o, vb0, pa0, pa1, pa2, pa3); partialSM(pB0, pB1, m_reg, mnB, alB);
  __syncthreads(); A128_RESC(alB);
  finishSM(pB0, pB1, alB, l_reg, pa0, pa1, pa2, pa3); A128_SBAR();
  pv_d0(o, vb0 + (int)SHM_V, pa0, pa1, pa2, pa3);
  if (hi == 0) li_l[r32] = l_reg; asm volatile("s_waitcnt lgkmcnt(0)" ::: "memory");
  float rli[16];
#pragma unroll
  for (int r = 0; r < 16; ++r) rli[r] = __builtin_amdgcn_rcpf(li_l[crow(r, hi)]);
  bf16_t* Ow = Ob + (long)(wid * QBLK) * LDO;
#pragma unroll
  for (int r = 0; r < 16; ++r) { const int orow = crow(r, hi);
#pragma unroll
    for (int d0 = 0; d0 < 4; ++d0) Ow[(long)orow * LDO + d0 * 32 + r32] = (bf16_t)(cvt_pk_bf16(o[d0][r] * rli[r], 0.f) & 0xffffu); }
  __syncthreads();
#undef A128_SLOAD
#undef A128_SWRITE
#undef A128_SWAIT
#undef A128_RESC
}
#undef A128_KSWZ
#undef A128_SBAR
}

#define XB_TMO      128
#define XB_XCNT(j)  (256  + 64 * (j))
#define XB_XSUB(j)  (1280 + 64 * (j))
#define XB_XGEN(j)  (2304 + 64 * (j))
#define XB_TOP      3328
#define XB_TOPGEN   3392
#define XCD_BAR_WORDS 3456
#define XB_SPIN_CAP (1u << 18)
__device__ __forceinline__ unsigned xb_ld(unsigned* p)              { return __hip_atomic_load(p, __ATOMIC_RELAXED, __HIP_MEMORY_SCOPE_AGENT); }
__device__ __forceinline__ unsigned xb_add(unsigned* p, unsigned v) { return __hip_atomic_fetch_add(p, v, __ATOMIC_RELAXED, __HIP_MEMORY_SCOPE_AGENT); }
__device__ __forceinline__ unsigned xb_xcc_id() { return (unsigned)__builtin_amdgcn_s_getreg((3 << 11) | 20) & 0xFu; }
#define XB_SPIN(cond, bar) do { unsigned _sp = 0; while (cond) { __builtin_amdgcn_s_sleep(1); \
    if ((++_sp & 255u) == 0u) { if (xb_ld(&(bar)[XB_TMO])) break; if (_sp > XB_SPIN_CAP) { atomicAdd(&(bar)[XB_TMO], 1u); break; } } } } while (0)
struct XcdBarrier { unsigned* bar; unsigned x; volatile LAS unsigned* st; };
__device__ __forceinline__ XcdBarrier xcd_barrier_post(unsigned* bar, volatile LAS unsigned* st) {
    XcdBarrier b; b.bar = bar; b.x = xb_xcc_id(); b.st = st;
    if (threadIdx.x == 0) (void)xb_add(&bar[XB_XCNT(b.x)], 1u);
    return b;
}
__device__ __forceinline__ void xcd_barrier_complete(unsigned* bar, unsigned x, unsigned& nloc, unsigned& nx) {
    const unsigned G = gridDim.x * gridDim.y * gridDim.z;
    unsigned sum, cnt, mine, sp = 0u;
    for (;;) {
        sum = 0u; cnt = 0u; mine = 0u;
#pragma unroll
        for (unsigned j = 0; j < 16; ++j) { const unsigned c = xb_ld(&bar[XB_XCNT(j)]); sum += c; cnt += (c > 0u) ? 1u : 0u; mine = (j == x) ? c : mine; }
        if (sum == G) break;
        __builtin_amdgcn_s_sleep(1);
        if ((++sp & 255u) == 0u) { if (xb_ld(&bar[XB_TMO])) break; if (sp > XB_SPIN_CAP) { atomicAdd(&bar[XB_TMO], 1u); break; } }
    }
    nloc = mine > 0u ? mine : 1u; nx = cnt > 0u ? cnt : 1u;
}
__device__ __forceinline__ void xcd_barrier(const XcdBarrier& b, const int tid) {
    asm volatile("s_waitcnt vmcnt(0)" ::: "memory");
    __syncthreads();
    if (tid == 0) {
        unsigned* bar = b.bar;
        __builtin_amdgcn_s_waitcnt(0);
        unsigned nloc = b.st[0], nx = b.st[1];
        if (nloc == 0u) { xcd_barrier_complete(bar, b.x, nloc, nx); b.st[0] = nloc; b.st[1] = nx; }
        const unsigned old = xb_add(&bar[XB_XSUB(b.x)], 1u);
        const unsigned gen = old / nloc;
        if (old + 1u == (gen + 1u) * nloc) {
            __builtin_amdgcn_fence(__ATOMIC_RELEASE, "agent");
            asm volatile("s_waitcnt vmcnt(0)" ::: "memory");
            const unsigned og = xb_add(&bar[XB_TOP], 1u);
            const unsigned tg = og / nx;
            if (og + 1u == (tg + 1u) * nx) xb_add(&bar[XB_TOPGEN], 1u);
            else XB_SPIN(xb_ld(&bar[XB_TOPGEN]) == tg, bar);
            __builtin_amdgcn_fence(__ATOMIC_ACQUIRE, "agent");
            xb_add(&bar[XB_XGEN(b.x)], 1u);
            asm volatile("s_waitcnt vmcnt(0)" ::: "memory");
        } else {
            XB_SPIN(xb_ld(&bar[XB_XGEN(b.x)]) == gen, bar);
            __builtin_amdgcn_fence(__ATOMIC_ACQUIRE, "agent");
            asm volatile("s_waitcnt vmcnt(0)" ::: "memory");
        }
    }
    __syncthreads();
}

constexpr int NWAVES = 8;
constexpr int RING_OFF = 0, RING_BYTES = 131072;
constexpr int LDSCTL_OFF = RING_BYTES, MISC_OFF = LDSCTL_OFF + 320;
constexpr int LDS_BYTES = 147456;
static_assert(attn_body::LDS_BYTES <= RING_BYTES, "attention scratch fits the ring");

struct Args { const float* in[32]; float* out; unsigned char* ws; int ph_lo, ph_hi; };
constexpr int INTAB_OFF = LDSCTL_OFF + 1024;
__device__ __forceinline__ const float* inptr(LAS unsigned char* lds, int i) {
    const unsigned long long v = ((const LAS unsigned long long*)(lds + INTAB_OFF))[i];
    const unsigned lo = __builtin_amdgcn_readfirstlane((unsigned)v), hi = __builtin_amdgcn_readfirstlane((unsigned)(v >> 32));
    return (const float*)(GAS const float*)(((unsigned long long)hi << 32) | lo);
}
#define INP(i) inptr(F.lds, (i))
struct Frame {
    LAS unsigned char* lds; int tid, lane, wave, vcu, G, gw, NGW;
    unsigned char* ws;
};
enum { I_X = 0, I_C, I_CTX, I_CCTX, I_WMOD, I_BMOD, I_LNG, I_LNB, I_W1, I_W3, I_W2, I_WIN, I_ALAM, I_ASUB, I_CONVW, I_CONVB, I_ALOG, I_DTB, I_SSDD, I_SSDN,
       I_LRE, I_LIM, I_LSTEP, I_BRE, I_BIM, I_CRE, I_CIM, I_S5D, I_GLUW, I_GLUB, I_WBR, I_WOUT };

__device__ __forceinline__ void transpose_item64(const float* srcA, const float* srcB, int ldn, bool ffn, bf16_t* dst, int ldk, LAS bf16_t* scr  , int lane) {
    const int q = lane & 15, kr = lane >> 4; const bool isB = q >= 8; const int c = (q & 7) * 4; const float* src = isB ? srcB : srcA;
    f32x4 v[16];
#pragma unroll
    for (int i = 0; i < 16; ++i) v[i] = src ? *(const f32x4*)(src + (size_t)(4 * i + kr) * ldn + c) : (f32x4){0.f, 0.f, 0.f, 0.f};
    const int drow = ffn ? (32 * (c >> 4) + (c & 15) + (isB ? 16 : 0)) : (c + (isB ? 32 : 0));
#pragma unroll
    for (int i = 0; i < 16; ++i) { const int k = 4 * i + kr; const unsigned p01 = cvt_pk_bf16(v[i][0], v[i][1]), p23 = cvt_pk_bf16(v[i][2], v[i][3]);
        scr[(drow + 0) * 72 + k] = (bf16_t)(p01 & 0xffffu); scr[(drow + 1) * 72 + k] = (bf16_t)(p01 >> 16); scr[(drow + 2) * 72 + k] = (bf16_t)(p23 & 0xffffu); scr[(drow + 3) * 72 + k] = (bf16_t)(p23 >> 16); }
    LDS_WAIT(); asm volatile("" ::: "memory");
    const int c8 = lane & 7;
#pragma unroll
    for (int jj = 0; jj < 8; ++jj) { const int n = (lane >> 3) + 8 * jj; *(u32x4*)(dst + (size_t)n * ldk + 8 * c8) = *(const LAS u32x4*)(scr + n * 72 + 8 * c8); }
    LDS_WAIT(); asm volatile("" ::: "memory");
}
__device__ __forceinline__ void convert_layer_weights(const Args& A_, Frame& F, int l) {
    LAS bf16_t* scr = (LAS bf16_t*)(F.lds + RING_OFF + F.wave * 16384);
    unsigned char* W = F.ws + WS_W;
    constexpr int I13 = 32 * 176, I2 = 88 * 32, IIN = 32 * 212, IB = 16 * 32, IO = 32 * 32, IG = 16 * 16;
    constexpr int NIT = 2 * I13 + 2 * I2 + IIN + 3 * IB + IO + IG;
    for (int it = F.gw; it < NIT; it += F.NGW) {
        int r = it;
        if (r < 2 * I13) { const int f = r / I13; r -= f * I13; const int kb = r / 176, nb = r % 176;
            const float* w1 = INP(I_W1) + ((size_t)(l * 2 + f) * D + 64 * kb) * DFF + 32 * nb; const float* w3 = INP(I_W3) + ((size_t)(l * 2 + f) * D + 64 * kb) * DFF + 32 * nb;
            transpose_item64(w1, w3, DFF, true, (bf16_t*)(W + W_13) + ((size_t)f * N13 + 64 * nb) * D + 64 * kb, D, scr, F.lane); continue; }
        r -= 2 * I13;
        if (r < 2 * I2) { const int f = r / I2; r -= f * I2; const int kb = r / 32, nb = r % 32;
            const float* w2 = INP(I_W2) + ((size_t)(l * 2 + f) * DFF + 64 * kb) * D + 64 * nb;
            transpose_item64(w2, w2 + 32, D, false, (bf16_t*)(W + W_2) + ((size_t)f * D + 64 * nb) * DFF + 64 * kb, DFF, scr, F.lane); continue; }
        r -= 2 * I2;
        if (r < IIN) { const int kb = r / 212, nb = r % 212; const int n0 = 64 * nb; const float* wb = INP(I_WIN) + ((size_t)l * D + 64 * kb) * 13344;
            const float* sa = nullptr; const float* sb = nullptr;
            if (n0 < 6144) { sa = wb + n0; sb = sa + 32; } else if (n0 < 13312) { sa = wb + n0 + 32; sb = sa + 32; } else if (n0 == 13312) { sa = wb + 6144; }
            transpose_item64(sa, sb, 13344, false, (bf16_t*)(W + W_IN) + (size_t)n0 * D + 64 * kb, D, scr, F.lane); continue; }
        r -= IIN;
        if (r < 3 * IB) { const int jb = r / IB; r -= jb * IB; const int kb = r / 32, nb = r % 32;
            const float* w = INP(I_WBR) + ((size_t)(l * 3 + jb) * 1024 + 64 * kb) * D + 64 * nb;
            const int sp = (jb == 0) ? 0 : (jb == 1 ? 2 : 1); transpose_item64(w, w + 32, D, false, (bf16_t*)(W + W_B) + (size_t)(64 * nb) * 3072 + sp * 1024 + 64 * kb, 3072, scr, F.lane); continue; }
        r -= 3 * IB;
        if (r < IO) { const int kb = r / 32, nb = r % 32; const float* w = INP(I_WOUT) + ((size_t)l * D + 64 * kb) * D + 64 * nb;
            transpose_item64(w, w + 32, D, false, (bf16_t*)(W + W_O) + (size_t)(64 * nb) * D + 64 * kb, D, scr, F.lane); continue; }
        r -= IO;
        { const int kb = r / 16, nb = r % 16; const float* w = INP(I_GLUW) + ((size_t)l * 1024 + 64 * kb) * 1024 + 64 * nb;
            transpose_item64(w, w + 32, 1024, false, (bf16_t*)(W + W_GLU) + (size_t)(64 * nb) * 1024 + 64 * kb, 1024, scr, F.lane); }
    }
}
__device__ __forceinline__ void mod_partials(const Args& A_, Frame& F) {
    float* MODw = (float*)(F.ws + WS_MOD);
    for (int it = F.gw; it < 2 * 72 * 16; it += F.NGW) {
        const int l = it / (72 * 16), r = it % (72 * 16), ks = r / 72, cg = r % 72;
        const int col = cg * 256 + F.lane * 4; const float* w = INP(I_WMOD) + ((size_t)l * D + ks * 128) * NMOD + col;
        f32x4 a0 = {0.f, 0.f, 0.f, 0.f}, a1 = a0, a2 = a0, a3 = a0, a4 = a0;
        const float* c = INP(I_C) + ks * 128; const float* cc = INP(I_CCTX) + ks * 128;
#pragma unroll 16
        for (int k = 0; k < 128; ++k) { const f32x4 wv = *(const f32x4*)(w + (size_t)k * NMOD);
            a0 += wv * siluf_(c[k]); a1 += wv * siluf_(c[D + k]); a2 += wv * siluf_(c[2 * D + k]); a3 += wv * siluf_(c[3 * D + k]); a4 += wv * siluf_(cc[k]); }
        const int r9 = col / D; const float sc = (r9 == 2 || r9 == 8) ? 0.5f : 1.0f;
        if (ks == 0) { const f32x4 bv = *(const f32x4*)(INP(I_BMOD) + (size_t)l * NMOD + col); a0 += bv; a1 += bv; a2 += bv; a3 += bv; a4 += bv; }
        float* o = MODw + (size_t)l * 5 * NMOD + col;
#pragma unroll
        for (int e = 0; e < 4; ++e) { unsafeAtomicAdd(o + e, a0[e] * sc); unsafeAtomicAdd(o + NMOD + e, a1[e] * sc); unsafeAtomicAdd(o + 2 * NMOD + e, a2[e] * sc); unsafeAtomicAdd(o + 3 * NMOD + e, a3[e] * sc); unsafeAtomicAdd(o + 4 * NMOD + e, a4[e] * sc); }
    }
}
__device__ __forceinline__ void ln_pass(Frame& F, bool do_ln, const float* lng, const float* lnb, const float* modnext  , float* out, const float* xin = nullptr, const float* cin = nullptr) {
    float* H = (float*)(F.ws + WS_H); bf16_t* HM = (bf16_t*)(F.ws + WS_HM); float* ST = (float*)(F.ws + WS_STATS);
    for (int row = F.gw; row < R; row += F.NGW) {
        const int b = row / RB, rr = row % RB; const bool isctx = rr < CTX; const int mi = isctx ? 4 : b;
        float* hr = H + (size_t)row * D;
        const float* src = xin ? (isctx ? cin + ((size_t)b * CTX + rr) * D : xin + ((size_t)b * SEQ + (rr - CTX)) * D) : hr;
        f32x4 v[8]; float s = 0.f;
#pragma unroll
        for (int i = 0; i < 8; ++i) { v[i] = *(const f32x4*)(src + 256 * i + 4 * F.lane); s += (v[i][0] + v[i][1]) + (v[i][2] + v[i][3]); }
        if (do_ln) {
            const float mean = wave_sum(s, F.lane) * (1.f / D); float s2 = 0.f;
#pragma unroll
            for (int i = 0; i < 8; ++i) { v[i] = v[i] - mean; s2 += (v[i][0] * v[i][0] + v[i][1] * v[i][1]) + (v[i][2] * v[i][2] + v[i][3] * v[i][3]); }
            const float rstd = 1.0f / sqrtf(wave_sum(s2, F.lane) * (1.f / D) + LN_EPS);
            if (!isctx && F.lane == 0) *(f32x2*)(ST + (size_t)row * 2) = (f32x2){mean, rstd};
#pragma unroll
            for (int i = 0; i < 8; ++i) { const f32x4 g = *(const f32x4*)(lng + 256 * i + 4 * F.lane), bb = *(const f32x4*)(lnb + 256 * i + 4 * F.lane); v[i] = v[i] * rstd * g + bb; if (isctx) *(f32x4*)(hr + 256 * i + 4 * F.lane) = v[i] * DN_ALPHA; }
        } else if (isctx) {
#pragma unroll
            for (int i = 0; i < 8; ++i) *(f32x4*)(hr + 256 * i + 4 * F.lane) = v[i] * DN_ALPHA;
        } else if (F.lane == 0) *(f32x2*)(ST + (size_t)row * 2) = (f32x2){0.f, 1.f};
        if (modnext) {
            const float* sh = modnext + (size_t)mi * NMOD; const float* sc = sh + D;
#pragma unroll
            for (int i = 0; i < 8; ++i) { const f32x4 a = *(const f32x4*)(sh + 256 * i + 4 * F.lane), c = *(const f32x4*)(sc + 256 * i + 4 * F.lane); const f32x4 m = v[i] * (c + 1.0f) + a;
                u32x2 w; w.x = cvt_pk_bf16(m[0], m[1]); w.y = cvt_pk_bf16(m[2], m[3]); *(u32x2*)(HM + (size_t)row * D + 256 * i + 4 * F.lane) = w; }
        }
        if (out && !isctx) { float* orow = out + ((size_t)b * SEQ + (rr - CTX)) * D;
#pragma unroll
            for (int i = 0; i < 8; ++i) *(f32x4*)(orow + 256 * i + 4 * F.lane) = v[i]; }
    }
}

__device__ __forceinline__ void dt_tile(Frame& F, int l, int tile) {
    const bf16_t* A = (const bf16_t*)(F.ws + WS_HM) + (size_t)tile * 32 * D; const bf16_t* Bt = (const bf16_t*)(F.ws + WS_W + W_IN) + (size_t)13312 * D; float* DT = (float*)(F.ws + WS_DT);
    const int r = F.lane & 31, h = F.lane >> 5;
    f32x16 acc;
#pragma unroll
    for (int i = 0; i < 16; ++i) acc[i] = 0.f;
    const bf16_t* ap = A + (size_t)r * D + 8 * h; const bf16_t* bp = Bt + (size_t)r * D + 8 * h;
    for (int k0 = 0; k0 < 128; k0 += 16) {
        bf16x8 af[16], bfv[16];
#pragma unroll
        for (int e = 0; e < 16; ++e) { af[e] = *(const bf16x8*)(ap + 16 * (k0 + e)); bfv[e] = *(const bf16x8*)(bp + 16 * (k0 + e)); }
#pragma unroll
        for (int e = 0; e < 16; ++e) acc = __builtin_amdgcn_mfma_f32_32x32x16_bf16(af[e], bfv[e], acc, 0, 0, 0);
    }
    const float bias = INP(I_DTB)[l * 32 + r];
#pragma unroll
    for (int rg = 0; rg < 16; ++rg) { const int row = tile * 32 + (rg & 3) + 8 * (rg >> 2) + 4 * h; const float x = acc[rg] + bias; DT[(size_t)row * 32 + r] = fmaxf(x, 0.f) + log1pf(expf(-fabsf(x))); }
}
__device__ __forceinline__ void ssd_conv_pass(const Args& A_, Frame& F, int l) {
    const bf16_t* P = (const bf16_t*)(F.ws + WS_PROJ); bf16_t* XC = (bf16_t*)(F.ws + WS_HM);
    const float* cw = INP(I_CONVW) + (size_t)l * 5 * 2048; const float* cb = INP(I_CONVB) + (size_t)l * 2048;
    for (int it = F.gw; it < R * 4; it += F.NGW) {
        const int row = it >> 2, c0 = (it & 3) * 512 + F.lane * 8; const int rr = row % RB; const int lo = (rr < CTX) ? 0 : CTX, hi = (rr < CTX) ? CTX : RB;
        float acc[8];
#pragma unroll
        for (int e = 0; e < 8; ++e) acc[e] = cb[c0 + e];
#pragma unroll
        for (int k = 0; k < 5; ++k) { const int r2 = rr + k - 2;
            if (r2 >= lo && r2 < hi) { const u32x4 xv = *(const u32x4*)(P + (size_t)(row + k - 2) * LDP + PX + c0); const f32x4 w0 = *(const f32x4*)(cw + k * 2048 + c0), w1 = *(const f32x4*)(cw + k * 2048 + c0 + 4);
                acc[0] += w0[0] * bflo(xv.x); acc[1] += w0[1] * bfhi(xv.x); acc[2] += w0[2] * bflo(xv.y); acc[3] += w0[3] * bfhi(xv.y);
                acc[4] += w1[0] * bflo(xv.z); acc[5] += w1[1] * bfhi(xv.z); acc[6] += w1[2] * bflo(xv.w); acc[7] += w1[3] * bfhi(xv.w); } }
        u32x4 o; o.x = cvt_pk_bf16(siluf_(acc[0]), siluf_(acc[1])); o.y = cvt_pk_bf16(siluf_(acc[2]), siluf_(acc[3])); o.z = cvt_pk_bf16(siluf_(acc[4]), siluf_(acc[5])); o.w = cvt_pk_bf16(siluf_(acc[6]), siluf_(acc[7]));
        *(u32x4*)(XC + (size_t)row * 2048 + c0) = o;
    }
}
__device__ __forceinline__ int scan_row(int rb, int d, int step) { return d == 0 ? rb + step : (step < CTX ? rb + CTX - 1 - step : rb + (RB + CTX - 1) - step); }

__device__ __forceinline__ unsigned short bf16_1(float v) { return (unsigned short)(cvt_pk_bf16(v, 0.f) & 0xffffu); }
__device__ __forceinline__ void ssd_chain_fast(const Args& A_, Frame& F, int l, int cid) {
    constexpr int LS = 136;
    const int b = cid >> 6, d = (cid >> 5) & 1, hd = (cid >> 1) & 15, ph = cid & 1, g = hd >> 2; const int rb = b * RB;
    const bf16_t* XC = (const bf16_t*)(F.ws + WS_HM); const float* DT = (const float*)(F.ws + WS_DT); bf16_t* YD = (bf16_t*)(F.ws + WS_YD) + (size_t)d * R * 1024;
    const float a = -expf(INP(I_ALOG)[l * 32 + d * 16 + hd]);
    LAS bf16_t* Cs = (LAS bf16_t*)(F.lds); LAS bf16_t* Bs = Cs + 128 * LS; LAS bf16_t* Ms = Bs + 128 * LS; LAS bf16_t* XdT = Ms + 128 * LS; LAS bf16_t* Hb = XdT + 32 * LS;
    LAS float* csL = (LAS float*)(Hb + 32 * LS); LAS float* ecsL = csL + 128; LAS float* ewL = ecsL + 128; LAS float* misc = ewL + 128;
    const int tid = F.tid, lane = F.lane, w = F.wave, r = lane & 31, h = lane >> 5;
    f32x16 hacc;
#pragma unroll
    for (int i = 0; i < 16; ++i) hacc[i] = 0.f;
    for (int i = tid; i < 32 * LS / 2; i += 512) ((LAS unsigned*)Hb)[i] = 0u;
    u32x4 pc[4], pb[4], px; float pdt, pv0 = 0.f, pv1 = 0.f;
    const int rho0 = d ? 127 - lane : lane, rho1 = d ? 63 - lane : 64 + lane;
#define SSD_R0(k_) ((d == 0) ? rb + 128 * (k_) : ((k_) < 2 ? rb + 128 * (1 - (k_)) : rb + 256 + 128 * (33 - (k_))))
#define SSD_ISSUE(k_) do { const int r0n = SSD_R0(k_); \
        _Pragma("unroll") for (int i = 0; i < 4; ++i) { const int item = tid + 512 * i, row = item >> 4, seg = item & 15; const bf16_t* src = XC + (size_t)(r0n + row) * 2048 + g * 128 + seg * 8; pc[i] = *(const u32x4*)(src + 1536); pb[i] = *(const u32x4*)(src + 1024); } \
        { const int row = tid >> 2, seg = tid & 3; pdt = DT[(size_t)(r0n + row) * 32 + d * 16 + hd]; px = *(const u32x4*)(XC + (size_t)(r0n + row) * 2048 + hd * 64 + ph * 32 + seg * 8); } \
        if (w == 0) { pv0 = DT[(size_t)(r0n + rho0) * 32 + d * 16 + hd]; pv1 = DT[(size_t)(r0n + rho1) * 32 + d * 16 + hd]; } } while (0)
    SSD_ISSUE(0);
    for (int k = 0; k < 34; ++k) {
        const int r0 = SSD_R0(k);
        __syncthreads();
#pragma unroll
        for (int i = 0; i < 4; ++i) { const int item = tid + 512 * i, row = item >> 4, seg = item & 15; *(LAS u32x4*)(Cs + row * LS + seg * 8) = pc[i]; *(LAS u32x4*)(Bs + row * LS + seg * 8) = pb[i]; }
        { const int row = tid >> 2, seg = tid & 3; const float dtv = pdt; const u32x4 xv = px;
            LAS bf16_t* xo = XdT + (seg * 8) * LS + row;
            xo[0 * LS] = bf16_1(bflo(xv.x) * dtv); xo[1 * LS] = bf16_1(bfhi(xv.x) * dtv); xo[2 * LS] = bf16_1(bflo(xv.y) * dtv); xo[3 * LS] = bf16_1(bfhi(xv.y) * dtv);
            xo[4 * LS] = bf16_1(bflo(xv.z) * dtv); xo[5 * LS] = bf16_1(bfhi(xv.z) * dtv); xo[6 * LS] = bf16_1(bflo(xv.w) * dtv); xo[7 * LS] = bf16_1(bfhi(xv.w) * dtv); }
        if (w == 0) {
            float v0 = pv0 * a, v1 = pv1 * a;
#pragma unroll
            for (int o = 1; o < 64; o <<= 1) { const float t0 = __int_as_float(__builtin_amdgcn_ds_bpermute((lane - o) << 2, __float_as_int(v0))), t1 = __int_as_float(__builtin_amdgcn_ds_bpermute((lane - o) << 2, __float_as_int(v1))); if (lane >= o) { v0 += t0; v1 += t1; } }
            const float tot0 = __int_as_float(__builtin_amdgcn_ds_bpermute(63 << 2, __float_as_int(v0))); v1 += tot0;
            const float cend = __int_as_float(__builtin_amdgcn_ds_bpermute(63 << 2, __float_as_int(v1)));
            csL[rho0] = v0; csL[rho1] = v1; ecsL[rho0] = __builtin_amdgcn_exp2f(v0 * 1.4426950408889634f); ecsL[rho1] = __builtin_amdgcn_exp2f(v1 * 1.4426950408889634f);
            ewL[rho0] = __builtin_amdgcn_exp2f((cend - v0) * 1.4426950408889634f); ewL[rho1] = __builtin_amdgcn_exp2f((cend - v1) * 1.4426950408889634f);
            if (lane == 0) misc[0] = __builtin_amdgcn_exp2f(cend * 1.4426950408889634f);
        }
        if (k + 1 < 34) SSD_ISSUE(k + 1);
        __syncthreads();
        { const int lt = w >> 1;
#pragma unroll
          for (int q = 0; q < 2; ++q) { const int st = (w & 1) * 2 + q; const bool zero = (d == 0) ? (st > lt) : (st < lt);
            f32x16 acc;
#pragma unroll
            for (int i = 0; i < 16; ++i) acc[i] = 0.f;
            if (!zero) {
#pragma unroll
                for (int ks = 0; ks < 8; ++ks) { const bf16x8 af = *(const LAS bf16x8*)(Cs + (32 * lt + r) * LS + 16 * ks + 8 * h), bfv = *(const LAS bf16x8*)(Bs + (32 * st + r) * LS + 16 * ks + 8 * h);
                    acc = __builtin_amdgcn_mfma_f32_32x32x16_bf16(af, bfv, acc, 0, 0, 0); } }
            const int scol = 32 * st + r; const float css = csL[scol];
#pragma unroll
            for (int rg = 0; rg < 16; ++rg) { const int lrow = 32 * lt + (rg & 3) + 8 * (rg >> 2) + 4 * h; const bool valid = (d == 0) ? (scol <= lrow) : (scol >= lrow);
                const float v = valid ? acc[rg] * __builtin_amdgcn_exp2f((csL[lrow] - css) * 1.4426950408889634f) : 0.f; Ms[lrow * LS + scol] = bf16_1(v); } } }
        __syncthreads();
        if (w < 4) { const int lt = w;
            f32x16 acc;
#pragma unroll
            for (int i = 0; i < 16; ++i) acc[i] = 0.f;
#pragma unroll
            for (int ks = 0; ks < 8; ++ks) { const bf16x8 af = *(const LAS bf16x8*)(Cs + (32 * lt + r) * LS + 16 * ks + 8 * h), bfv = *(const LAS bf16x8*)(Hb + r * LS + 16 * ks + 8 * h);
                acc = __builtin_amdgcn_mfma_f32_32x32x16_bf16(af, bfv, acc, 0, 0, 0); }
#pragma unroll
            for (int rg = 0; rg < 16; ++rg) acc[rg] *= ecsL[32 * lt + (rg & 3) + 8 * (rg >> 2) + 4 * h];
#pragma unroll
            for (int ks = 0; ks < 8; ++ks) { const bool skip = (d == 0) ? (16 * ks >= 32 * (lt + 1)) : (16 * ks + 15 < 32 * lt);
                if (!skip) { const bf16x8 af = *(const LAS bf16x8*)(Ms + (32 * lt + r) * LS + 16 * ks + 8 * h), bfv = *(const LAS bf16x8*)(XdT + r * LS + 16 * ks + 8 * h);
                    acc = __builtin_amdgcn_mfma_f32_32x32x16_bf16(af, bfv, acc, 0, 0, 0); } }
            bf16_t* yo = YD + (size_t)(r0 + 32 * lt + 4 * h) * 1024 + hd * 64 + ph * 32 + r;
#pragma unroll
            for (int rg = 0; rg < 16; ++rg) yo[(size_t)((rg & 3) + 8 * (rg >> 2)) * 1024] = bf16_1(acc[rg]);
        } else { const int nt = w - 4; const float eend = misc[0];
#pragma unroll
            for (int i = 0; i < 16; ++i) hacc[i] *= eend;
#pragma unroll
            for (int ks = 0; ks < 8; ++ks) { const int k0 = 16 * ks + 8 * h; const u32x4 xa = *(const LAS u32x4*)(XdT + r * LS + k0); const f32x4 e0 = *(const LAS f32x4*)(ewL + k0), e1 = *(const LAS f32x4*)(ewL + k0 + 4);
                u32x4 aw; aw.x = cvt_pk_bf16(bflo(xa.x) * e0[0], bfhi(xa.x) * e0[1]); aw.y = cvt_pk_bf16(bflo(xa.y) * e0[2], bfhi(xa.y) * e0[3]); aw.z = cvt_pk_bf16(bflo(xa.z) * e1[0], bfhi(xa.z) * e1[1]); aw.w = cvt_pk_bf16(bflo(xa.w) * e1[2], bfhi(xa.w) * e1[3]);
                const LAS bf16_t* bp = Bs + k0 * LS + 32 * nt + r; u32x4 bw;
                bw.x = (unsigned)bp[0 * LS] | ((unsigned)bp[1 * LS] << 16); bw.y = (unsigned)bp[2 * LS] | ((unsigned)bp[3 * LS] << 16); bw.z = (unsigned)bp[4 * LS] | ((unsigned)bp[5 * LS] << 16); bw.w = (unsigned)bp[6 * LS] | ((unsigned)bp[7 * LS] << 16);
                hacc = __builtin_amdgcn_mfma_f32_32x32x16_bf16(__builtin_bit_cast(bf16x8, aw), __builtin_bit_cast(bf16x8, bw), hacc, 0, 0, 0); }
        }
        __syncthreads();
        if (w >= 4) { const int nt = w - 4;
#pragma unroll
            for (int rg = 0; rg < 16; ++rg) Hb[((rg & 3) + 8 * (rg >> 2) + 4 * h) * LS + 32 * nt + r] = bf16_1(hacc[rg]); }
    }
    __syncthreads();
#undef SSD_R0
#undef SSD_ISSUE
}
__device__ __forceinline__ void s5_setup(const Args& A_, Frame& F, int l) {
    LAS float* Pre = (LAS float*)(F.lds); LAS float* Pim = Pre + 2 * 17 * 64; LAS float* BBr = Pim + 2 * 17 * 64; LAS float* BBi = BBr + 2 * 64 * 16; LAS float* Kt = BBi + 2 * 64 * 16;
    bf16_t* Bt1 = (bf16_t*)(F.ws + WS_S5M); bf16_t* Bt2 = Bt1 + (size_t)64 * 512 * 256; float* A16 = (float*)(F.ws + WS_S5A);
    const int tid = F.tid;
    for (int g = blockIdx.x; g < 64; g += F.G) {
        if (tid < 128) { const int d = tid >> 6, n = tid & 63; const int pg_ = (l * 2 + d) * 64 + g;
            const float lre = INP(I_LRE)[pg_ * 64 + n], lim = INP(I_LIM)[pg_ * 64 + n], step = expf(INP(I_LSTEP)[pg_]);
            for (int dl = 0; dl <= 16; ++dl) { const float mag = expf(lre * step * (float)dl), ang = lim * step * (float)dl; Pre[(d * 17 + dl) * 64 + n] = mag * cosf(ang); Pim[(d * 17 + dl) * 64 + n] = mag * sinf(ang); }
            const float abr = Pre[(d * 17 + 1) * 64 + n], abi = Pim[(d * 17 + 1) * 64 + n];
            const float den = lre * lre + lim * lim; const float kre = ((abr - 1.f) * lre + abi * lim) / den, kim = (abi * lre - (abr - 1.f) * lim) / den;
            const float* br = INP(I_BRE) + ((size_t)pg_ * 64 + n) * 16; const float* bi = INP(I_BIM) + ((size_t)pg_ * 64 + n) * 16;
            for (int i = 0; i < 16; ++i) { const float x = br[i], y = bi[i]; BBr[(d * 64 + n) * 16 + i] = kre * x - kim * y; BBi[(d * 64 + n) * 16 + i] = kre * y + kim * x; }
            A16[((d * 64 + g) * 64 + n) * 2] = Pre[(d * 17 + 16) * 64 + n]; A16[((d * 64 + g) * 64 + n) * 2 + 1] = Pim[(d * 17 + 16) * 64 + n]; }
        __syncthreads();
        for (int q = 0; q < 16; ++q) { const int idx = tid + 512 * q; const int d = idx >> 12, dl = (idx >> 8) & 15, o = (idx >> 4) & 15, i = idx & 15; const int pg_ = (l * 2 + d) * 64 + g;
            const float* cr = INP(I_CRE) + ((size_t)pg_ * 16 + o) * 64; const float* ci = INP(I_CIM) + ((size_t)pg_ * 16 + o) * 64; float acc = 0.f;
            for (int n = 0; n < 64; ++n) { const float pr = Pre[(d * 17 + dl) * 64 + n], pi = Pim[(d * 17 + dl) * 64 + n], br = BBr[(d * 64 + n) * 16 + i], bi = BBi[(d * 64 + n) * 16 + i];
                acc += cr[n] * (pr * br - pi * bi) - ci[n] * (pr * bi + pi * br); }
            Kt[idx] = acc; }
        __syncthreads();
        for (int q = 0; q < 16; ++q) { const int item = tid + 512 * q; const int c1 = item >> 5, kb = (item & 31) * 8; const int rin = kb >> 4, i0 = kb & 15, rout = c1 >> 4, o = c1 & 15;
            float v[8];
#pragma unroll
            for (int e = 0; e < 8; ++e) { const int i = i0 + e; float x = 0.f; if (rout >= rin) x += Kt[((0 * 16 + (rout - rin)) * 16 + o) * 16 + i]; if (rin >= rout) x += Kt[((1 * 16 + (rin - rout)) * 16 + o) * 16 + i];
                if (rin == rout && i == o) x += INP(I_S5D)[l * 1024 + 16 * g + i]; v[e] = x; }
            u32x4 w; w.x = cvt_pk_bf16(v[0], v[1]); w.y = cvt_pk_bf16(v[2], v[3]); w.z = cvt_pk_bf16(v[4], v[5]); w.w = cvt_pk_bf16(v[6], v[7]);
            *(u32x4*)(Bt1 + ((size_t)g * 512 + c1) * 256 + kb) = w; }
        for (int q = 0; q < 16; ++q) { const int item = tid + 512 * q; const int c1 = item >> 5, kb = (item & 31) * 8; const int rin = kb >> 4, i0 = kb & 15; const int d = c1 >> 7, part = (c1 >> 6) & 1, n = c1 & 63;
            const int ex = (d == 0) ? 15 - rin : rin; const float pr = Pre[(d * 17 + ex) * 64 + n], pi = Pim[(d * 17 + ex) * 64 + n];
            float v[8];
#pragma unroll
            for (int e = 0; e < 8; ++e) { const float br = BBr[(d * 64 + n) * 16 + i0 + e], bi = BBi[(d * 64 + n) * 16 + i0 + e]; v[e] = part ? (pr * bi + pi * br) : (pr * br - pi * bi); }
            u32x4 w; w.x = cvt_pk_bf16(v[0], v[1]); w.y = cvt_pk_bf16(v[2], v[3]); w.z = cvt_pk_bf16(v[4], v[5]); w.w = cvt_pk_bf16(v[6], v[7]);
            *(u32x4*)(Bt1 + ((size_t)g * 512 + 256 + c1) * 256 + kb) = w; }
        for (int q = 0; q < 16; ++q) { const int item = tid + 512 * q; const int c2 = item >> 5, kb = (item & 31) * 8; const int rout = c2 >> 4, o = c2 & 15; const int d = kb >> 7, part = (kb >> 6) & 1, n0 = kb & 63; const int pg_ = (l * 2 + d) * 64 + g;
            const int ex = (d == 0) ? rout + 1 : 16 - rout; const float* cr = INP(I_CRE) + ((size_t)pg_ * 16 + o) * 64 + n0; const float* ci = INP(I_CIM) + ((size_t)pg_ * 16 + o) * 64 + n0;
            float v[8];
#pragma unroll
            for (int e = 0; e < 8; ++e) { const float pr = Pre[(d * 17 + ex) * 64 + n0 + e], pi = Pim[(d * 17 + ex) * 64 + n0 + e]; v[e] = part ? -(cr[e] * pi + ci[e] * pr) : (cr[e] * pr - ci[e] * pi); }
            u32x4 w; w.x = cvt_pk_bf16(v[0], v[1]); w.y = cvt_pk_bf16(v[2], v[3]); w.z = cvt_pk_bf16(v[4], v[5]); w.w = cvt_pk_bf16(v[6], v[7]);
            *(u32x4*)(Bt2 + ((size_t)g * 256 + c2) * 256 + kb) = w; }
        __syncthreads();
    }
}
__device__ __forceinline__ void s5_carry(Frame& F, int cid) {
    const int b = cid >> 7, d = (cid >> 6) & 1, g = cid & 63, n = F.lane;
    const float* ST = (const float*)(F.ws + WS_S5ST) + ((size_t)g * S5M + b * 272) * 256 + d * 128 + n; bf16_t* HP = (bf16_t*)(F.ws + WS_S5H) + ((size_t)g * 1280 + b * 272) * 256 + d * 128 + n;
    const float* A16 = (const float*)(F.ws + WS_S5A); const float ar = A16[((d * 64 + g) * 64 + n) * 2], ai = A16[((d * 64 + g) * 64 + n) * 2 + 1];
    float hr = 0.f, hi_ = 0.f;
    for (int k0 = 0; k0 < 272; k0 += 34) {
        float sr[34], si[34]; int cc[34];
#pragma unroll
        for (int e = 0; e < 34; ++e) { const int k = k0 + e; cc[e] = (d == 0) ? k : (k < 16 ? 15 - k : 287 - k); sr[e] = ST[(size_t)cc[e] * 256]; si[e] = ST[(size_t)cc[e] * 256 + 64]; }
#pragma unroll
        for (int e = 0; e < 34; ++e) { HP[(size_t)cc[e] * 256] = (bf16_t)(cvt_pk_bf16(hr, 0.f) & 0xffffu); HP[(size_t)cc[e] * 256 + 64] = (bf16_t)(cvt_pk_bf16(hi_, 0.f) & 0xffffu);
            const float nr = ar * hr - ai * hi_ + sr[e], ni = ar * hi_ + ai * hr + si[e]; hr = nr; hi_ = ni; }
    }
}
__device__ __forceinline__ void mixer_finalize(const Args& A_, Frame& F, int l) {
    bf16_t* P = (bf16_t*)(F.ws + WS_PROJ); const bf16_t* O0 = (const bf16_t*)(F.ws + WS_O); const bf16_t* O1 = O0 + (size_t)R * 1024;
    const bf16_t* XC = (const bf16_t*)(F.ws + WS_HM); const bf16_t* YD0 = (const bf16_t*)(F.ws + WS_YD); const bf16_t* YD1 = YD0 + (size_t)R * 1024;
        const float lam_init = 0.8f - 0.6f * expf(-0.3f * (float)l);
    const float* lv = INP(I_ALAM) + l * 256;
    const float s01 = wave_sum(lv[F.lane] * lv[64 + F.lane], F.lane), s23 = wave_sum(lv[128 + F.lane] * lv[192 + F.lane], F.lane);
    const float lam = expf(s01) - expf(s23) + lam_init;
    const int c0 = F.lane * 16;
    for (int row = F.gw; row < R; row += F.NGW) {
        { const u32x4 a0 = *(const u32x4*)(O0 + (size_t)row * 1024 + c0), a1 = *(const u32x4*)(O0 + (size_t)row * 1024 + c0 + 8);
          const u32x4 b0 = *(const u32x4*)(O1 + (size_t)row * 1024 + c0), b1 = *(const u32x4*)(O1 + (size_t)row * 1024 + c0 + 8);
          float v[16];
#define DIF(i, wa, wb) v[2 * (i)] = bflo(wa) - lam * bflo(wb); v[2 * (i) + 1] = bfhi(wa) - lam * bfhi(wb);
          DIF(0, a0.x, b0.x) DIF(1, a0.y, b0.y) DIF(2, a0.z, b0.z) DIF(3, a0.w, b0.w) DIF(4, a1.x, b1.x) DIF(5, a1.y, b1.y) DIF(6, a1.z, b1.z) DIF(7, a1.w, b1.w)
#undef DIF
          float ss = 0.f;
#pragma unroll
          for (int e = 0; e < 16; ++e) ss += v[e] * v[e];
          ss += shx(ss, 1, F.lane); ss += shx(ss, 2, F.lane); ss += shx(ss, 4, F.lane);
          const float rs = (1.0f / sqrtf(ss * (1.f / 128.f) + RMS_EPS)) * (1.0f - lam_init);
          const float* sw = INP(I_ASUB) + l * 128 + (c0 & 127);
          u32x4 o0, o1;
          o0.x = cvt_pk_bf16(v[0] * rs * sw[0], v[1] * rs * sw[1]); o0.y = cvt_pk_bf16(v[2] * rs * sw[2], v[3] * rs * sw[3]); o0.z = cvt_pk_bf16(v[4] * rs * sw[4], v[5] * rs * sw[5]); o0.w = cvt_pk_bf16(v[6] * rs * sw[6], v[7] * rs * sw[7]);
          o1.x = cvt_pk_bf16(v[8] * rs * sw[8], v[9] * rs * sw[9]); o1.y = cvt_pk_bf16(v[10] * rs * sw[10], v[11] * rs * sw[11]); o1.z = cvt_pk_bf16(v[12] * rs * sw[12], v[13] * rs * sw[13]); o1.w = cvt_pk_bf16(v[14] * rs * sw[14], v[15] * rs * sw[15]);
          *(u32x4*)(P + (size_t)row * LDP + PQ + c0) = o0; *(u32x4*)(P + (size_t)row * LDP + PQ + c0 + 8) = o1; }
        { const float dsk = INP(I_SSDD)[l * 16 + (c0 >> 6)];
          float v[16];
#pragma unroll
          for (int hh = 0; hh < 2; ++hh) { const u32x4 x = *(const u32x4*)(XC + (size_t)row * 2048 + c0 + 8 * hh), y0 = *(const u32x4*)(YD0 + (size_t)row * 1024 + c0 + 8 * hh), y1 = *(const u32x4*)(YD1 + (size_t)row * 1024 + c0 + 8 * hh), z = *(const u32x4*)(P + (size_t)row * LDP + PZ + c0 + 8 * hh);
#define SG(i, wx, wy0, wy1, wz) v[8 * hh + 2 * (i)] = (bflo(wx) * dsk + bflo(wy0) + bflo(wy1)) * bflo(wz); v[8 * hh + 2 * (i) + 1] = (bfhi(wx) * dsk + bfhi(wy0) + bfhi(wy1)) * bfhi(wz);
              SG(0, x.x, y0.x, y1.x, z.x) SG(1, x.y, y0.y, y1.y, z.y) SG(2, x.z, y0.z, y1.z, z.z) SG(3, x.w, y0.w, y1.w, z.w)
#undef SG
          }
          float ss = 0.f;
#pragma unroll
          for (int e = 0; e < 16; ++e) ss += v[e] * v[e];
          ss += shx(ss, 1, F.lane); ss += shx(ss, 2, F.lane); ss += shx(ss, 4, F.lane); ss += shx(ss, 8, F.lane);
          const float rs = 1.0f / sqrtf(ss * (1.f / 256.f) + RMS_EPS);
          const float* nw = INP(I_SSDN) + l * 1024 + c0;
          u32x4 o0, o1;
          o0.x = cvt_pk_bf16(v[0] * rs * nw[0], v[1] * rs * nw[1]); o0.y = cvt_pk_bf16(v[2] * rs * nw[2], v[3] * rs * nw[3]); o0.z = cvt_pk_bf16(v[4] * rs * nw[4], v[5] * rs * nw[5]); o0.w = cvt_pk_bf16(v[6] * rs * nw[6], v[7] * rs * nw[7]);
          o1.x = cvt_pk_bf16(v[8] * rs * nw[8], v[9] * rs * nw[9]); o1.y = cvt_pk_bf16(v[10] * rs * nw[10], v[11] * rs * nw[11]); o1.z = cvt_pk_bf16(v[12] * rs * nw[12], v[13] * rs * nw[13]); o1.w = cvt_pk_bf16(v[14] * rs * nw[14], v[15] * rs * nw[15]);
          *(u32x4*)(P + (size_t)row * LDP + PV + c0) = o0; *(u32x4*)(P + (size_t)row * LDP + PV + c0 + 8) = o1; }
    }
}


__global__ void __launch_bounds__(NWAVES * 64, 2) trunk_fwd(Args args) {
    extern __shared__ __attribute__((aligned(16))) unsigned char lds_raw[];
    Frame F;
    F.lds = (LAS unsigned char*)lds_raw;
    F.tid = threadIdx.x; F.lane = F.tid & 63; F.wave = __builtin_amdgcn_readfirstlane(F.tid >> 6);
    F.G = gridDim.x; { const int bx = blockIdx.x; F.vcu = (F.G % 8 == 0) ? (bx % 8) * (F.G / 8) + bx / 8 : bx; }
    F.gw = F.vcu * NWAVES + F.wave; F.NGW = F.G * NWAVES;
    F.ws = args.ws;
    volatile LAS unsigned* MISC = (volatile LAS unsigned*)(F.lds + MISC_OFF);
    for (int u = F.tid; u < (LDS_BYTES - LDSCTL_OFF) / 4; u += NWAVES * 64) ((LAS unsigned*)(F.lds + LDSCTL_OFF))[u] = 0u;
    __syncthreads();
    if (threadIdx.x < 32) ((LAS unsigned long long*)(F.lds + INTAB_OFF))[threadIdx.x] = (unsigned long long)args.in[threadIdx.x];
    __syncthreads();
    (void)xcd_barrier_post((unsigned*)(args.ws + WS_CTL) + CW_BAR, MISC + 8);
    const int lo = args.ph_lo, hi = args.ph_hi;
    const int wave0 = __builtin_amdgcn_readfirstlane((int)threadIdx.x >> 6);
    int pid = 0;
#define PH_BEGIN if (pid >= lo && pid < hi) { GAS unsigned char* wsg_ = (GAS unsigned char*)args.ws; int tid_; asm volatile("v_mbcnt_lo_u32_b32 %1, -1, 0\n\tv_mbcnt_hi_u32_b32 %1, -1, %1 ; PHASE_MARK_BEGIN %2" : "+s"(wsg_), "=v"(tid_) : "i"(__LINE__) : "memory"); tid_ += wave0 * 64; unsigned char* ws = (unsigned char*)wsg_; F.ws = ws; F.tid = tid_; F.lane = tid_ & 63; F.wave = __builtin_amdgcn_readfirstlane(tid_ >> 6); F.gw = F.vcu * NWAVES + F.wave;
#define PH_END   asm volatile("; PHASE_MARK_END %0" :: "i"(__LINE__)); if (pid + 1 < hi) { XcdBarrier bar_; bar_.bar = (unsigned*)(args.ws + WS_CTL) + CW_BAR; bar_.x = xb_xcc_id(); bar_.st = (volatile LAS unsigned*)(F.lds + MISC_OFF) + 8; xcd_barrier(bar_, wave0 * 64 + lane_now()); } } ++pid;

#define MOD ((float*)(ws + WS_MOD))
#define Hbuf ((float*)(ws + WS_H))
#define HM ((bf16_t*)(ws + WS_HM))
#define PROJ ((bf16_t*)(ws + WS_PROJ))
#define ROPEC ((float*)(ws + WS_ROPE))
#define ROPES (ROPEC + 1024)
#define WGT (ws + WS_W)

    PH_BEGIN
        s5_setup(args, F, 0);
        mod_partials(args, F);
        if (F.gw == 1) { float* idn = (float*)(ws + WS_IDENT); for (int i = F.lane; i < 2048; i += 64) { idn[i] = 1.0f; idn[2048 + i] = 0.0f; } }
        if (F.gw == 0) {
#pragma unroll
            for (int i = 0; i < 16; ++i) { const int idx = i * 64 + F.lane, pos = idx >> 4, f = idx & 15; const float inv = powf(10000.0f, -(float)f / 16.0f); const float ang = (float)pos * inv; ROPEC[idx] = cosf(ang); ROPES[idx] = sinf(ang); } }
    PH_END
    PH_BEGIN
        convert_layer_weights(args, F, 0);
        ln_pass(F, false, nullptr, nullptr, MOD, nullptr, INP(I_X), INP(I_CTX));
    PH_END

    for (int s = 0; s < 6; ++s) {
        const int l = s / 3, j = s - 3 * l;
        if (j != 1) {
            const int f = j >> 1;
            PH_BEGIN
                const int lat = (l == 1 && j == 2); pg8::Gemm g{D, D, D}; pg8::StaticOrder S; S.init(lat ? 64 : NPAN, N13 / 256, F.G, (int)blockIdx.x, HM, D, (const bf16_t*)(WGT + W_13) + (size_t)f * N13 * D, D, D, lat);
                EpiSwiGLU E{PROJ};
                pg8::gemm_phase<EpiSwiGLU, pg8::StaticOrder>(F.lds + RING_OFF, g, S, E, F.tid);
            PH_END
        } else {
            PH_BEGIN
                pg8::Gemm g{D, D, D}; pg8::StaticOrder S; S.init(NPAN, LDP / 256, F.G, (int)blockIdx.x, HM, D, (const bf16_t*)(WGT + W_IN), D, D);
                EpiProj E{PROJ, (float*)(ws + WS_DT), ROPEC, ROPES};
                pg8::gemm_phase<EpiProj, pg8::StaticOrder>(F.lds + RING_OFF, g, S, E, F.tid);
                { const int nfull = (NPAN * (LDP / 256)) % F.G;
                  if ((int)blockIdx.x >= nfull) { const int nw = (F.G - nfull) * NWAVES; for (int t = ((int)blockIdx.x - nfull) * NWAVES + F.wave; t < R / 32; t += nw) dt_tile(F, l, t); } }
            PH_END
            PH_BEGIN
                ssd_conv_pass(args, F, l);
                { pg8::Gemm g{0, 256, 256}; S5AOrder S{F.G, (int)blockIdx.x, (const char*)(PROJ + PU), (const char*)(ws + WS_S5M)};
                  EpiS5A E{(bf16_t*)(ws + WS_YS), (float*)(ws + WS_S5ST)};
                  pg8::gemm_phase<EpiS5A, S5AOrder, 1>(F.lds + RING_OFF, g, S, E, F.tid); }
            PH_END
            PH_BEGIN
                if (F.wave < 2) s5_carry(F, (int)blockIdx.x * 2 + F.wave);
                ssd_chain_fast(args, F, l, (int)blockIdx.x);
                {
                    bf16_t* Obuf = (bf16_t*)(ws + WS_O);
                    for (int i = 0;; ++i) { const int idx = i * F.G + F.vcu; if (idx >= 1024 + (l == 0 ? 64 : 0)) break;
                        int b, hh, q0, seq;
                        if (idx < 1024) { b = idx >> 8; hh = (idx >> 4) & 15; q0 = b * RB + CTX + (idx & 15) * 256; seq = RB; }
                        else { const int k = idx - 1024; b = k >> 4; hh = k & 15; q0 = b * RB; seq = CTX; }
                        const bf16_t* Q0 = PROJ + (size_t)q0 * LDP + PQ + hh * 64; const bf16_t* Kh = PROJ + (size_t)(b * RB) * LDP + PK + hh * 64; const bf16_t* Vh = PROJ + (size_t)(b * RB) * LDP + PV + (hh >> 1) * 128;
                        bf16_t* O0 = Obuf + (size_t)(hh & 1) * R * 1024 + (size_t)q0 * 1024 + (hh >> 1) * 128;
                        attn128::unit((const attn128::bf16*)Q0, (const attn128::bf16*)Kh, (const attn128::bf16*)Vh, O0, seq, (char*)lds_raw + RING_OFF, F.tid);
                    }
                }
            PH_END
            PH_BEGIN
                mixer_finalize(args, F, l);
                { pg8::Gemm g{256, 256, 256}; S5COrder S{F.G, (int)blockIdx.x, (const char*)(ws + WS_S5H), (const char*)((bf16_t*)(ws + WS_S5M) + (size_t)64 * 512 * 256)};
                  EpiS5C E{(const bf16_t*)(ws + WS_YS), PROJ};
                  pg8::gemm_phase<EpiS5C, S5COrder>(F.lds + RING_OFF, g, S, E, F.tid); }
            PH_END
            PH_BEGIN
                pg8::Gemm g{LDP, 1024, 1024}; pg8::StaticOrder S; S.init(l == 1 ? 64 : NPAN, 4, F.G, (int)blockIdx.x, PROJ + PU, LDP, (const bf16_t*)(WGT + W_GLU), 1024, 1024, l == 1);
                EpiGlu E{PROJ, INP(I_GLUB) + l * 1024};
                pg8::gemm_phase<EpiGlu, pg8::StaticOrder>(F.lds + RING_OFF, g, S, E, F.tid);
            PH_END
            PH_BEGIN
                pg8::Gemm g{LDP, 3072, 3072}; pg8::StaticOrder S; S.init(l == 1 ? 64 : NPAN, 8, F.G, (int)blockIdx.x, PROJ, LDP, (const bf16_t*)(WGT + W_B), 3072, 3072, l == 1);
                EpiMerge E{PROJ, HM};
                pg8::gemm_phase<EpiMerge, pg8::StaticOrder, 0, true>(F.lds + RING_OFF, g, S, E, F.tid);
            PH_END
        }
        PH_BEGIN
            const int RK = (j == 1) ? D : DFF; const bf16_t* RA = (j == 1) ? HM : PROJ; const bf16_t* RBt = (j == 1) ? (const bf16_t*)(WGT + W_O) : (const bf16_t*)(WGT + W_2) + (size_t)(j >> 1) * D * DFF;
            const int lat = (l == 1 && j >= 1); pg8::Gemm g{RK, RK, RK}; pg8::StaticOrder S; S.init(64, D / 256, F.G, (int)blockIdx.x, RA, RK, RBt, RK, RK, 1, lat ? 0 : 128);
            const float* lg_ = (s == 0) ? (const float*)(ws + WS_IDENT) : INP(I_LNG) + (size_t)(s - 1) * D; const float* lb_ = (s == 0) ? (const float*)(ws + WS_IDENT) + 2048 : INP(I_LNB) + (size_t)(s - 1) * D;
            EpiResid E{Hbuf, MOD + (size_t)l * 5 * NMOD + (3 * j + 2) * D, lg_, lb_, (s == 0) ? INP(I_X) : nullptr};
            pg8::gemm_phase<EpiResid, pg8::StaticOrder>(F.lds + RING_OFF, g, S, E, F.tid);
        PH_END
        PH_BEGIN
            const bool fin = (s == 5);
            const int ln_ = (j == 2) ? l + 1 : l, jn = (j == 2) ? 0 : j + 1;
            ln_pass(F, true, INP(I_LNG) + (size_t)(l * 3 + j) * D, INP(I_LNB) + (size_t)(l * 3 + j) * D, fin ? nullptr : MOD + (size_t)ln_ * 5 * NMOD + 3 * jn * D, fin ? args.out : nullptr);
            if (s == 2) { s5_setup(args, F, 1); __syncthreads(); convert_layer_weights(args, F, 1); }
        PH_END
    }
#undef PH_BEGIN
#undef PH_END
}

static int count_phases() { int n = 2; for (int s = 0; s < 6; ++s) n += ((s % 3) != 1 ? 1 : 6) + 2; return n; }
extern "C" void kernel_launch(void* const* d_in, const int* in_sizes, int n_in, void* d_out, int out_size, void* d_ws, size_t ws_size, hipStream_t stream) {
    static int grid = 0;
    if (grid == 0) {
        if (n_in != 32 || out_size != NB * SEQ * D || ws_size < WS_END) { fprintf(stderr, "kernel_launch: unexpected shapes (n_in %d, out %d, ws %zu < %zu)\n", n_in, out_size, ws_size, (size_t)WS_END); grid = -1; return; }
        int dev = 0, cus = 0, per_cu = 0;
        if (hipGetDevice(&dev) != hipSuccess || hipDeviceGetAttribute(&cus, hipDeviceAttributeMultiprocessorCount, dev) != hipSuccess) { grid = -1; return; }
        if (hipFuncSetAttribute((const void*)trunk_fwd, hipFuncAttributeMaxDynamicSharedMemorySize, LDS_BYTES) != hipSuccess) { fprintf(stderr, "kernel_launch: hipFuncSetAttribute failed\n"); grid = -1; return; }
        if (hipOccupancyMaxActiveBlocksPerMultiprocessor(&per_cu, (const void*)trunk_fwd, NWAVES * 64, LDS_BYTES) != hipSuccess || per_cu < 1) fprintf(stderr, "kernel_launch: occupancy query says %d\n", per_cu);
        (void)hipGetLastError();
        grid = cus;
    }
    if (grid < 0) return;
    (void)in_sizes;
    if (hipMemsetAsync((char*)d_ws + WS_CTL, 0, 2 * MiB  , stream) != hipSuccess) return;
    Args a{};
    for (int i = 0; i < 32; ++i) a.in[i] = (const float*)d_in[i];
    a.out = (float*)d_out; a.ws = (unsigned char*)d_ws;
    const int nph = count_phases();
#if MK_PER_PHASE
    for (int p = 0; p < nph; ++p) { a.ph_lo = p; a.ph_hi = p + 1; hipLaunchKernelGGL(trunk_fwd, dim3(grid), dim3(NWAVES * 64), LDS_BYTES, stream, a); }
#else
    a.ph_lo = 0; a.ph_hi = nph;
    hipLaunchKernelGGL(trunk_fwd, dim3(grid), dim3(NWAVES * 64), LDS_BYTES, stream, a);
#endif
    const hipError_t le = hipPeekAtLastError();
    if (le != hipSuccess) fprintf(stderr, "kernel_launch: launch failed: %s\n", hipGetErrorName(le));
}
```

```cpp
#include <hip/hip_runtime.h>
#include <hip/hip_bf16.h>
#include <cstdio>
#include <cstdint>
#include <cmath>

#ifndef MK_PER_PHASE
#define MK_PER_PHASE 0
#endif

#define LAS __attribute__((address_space(3)))
#define GAS __attribute__((address_space(1)))
typedef unsigned short bf16_t;
typedef short bf16x8 __attribute__((ext_vector_type(8)));
typedef float f32x4 __attribute__((ext_vector_type(4)));
typedef float f32x2 __attribute__((ext_vector_type(2)));
typedef float f32x16 __attribute__((ext_vector_type(16)));
typedef unsigned u32x4 __attribute__((ext_vector_type(4)));
typedef unsigned u32x2 __attribute__((ext_vector_type(2)));
typedef short s16x4 __attribute__((ext_vector_type(4)));

constexpr int NB = 4, SEQ = 4096, CTX = 256, RB = SEQ + CTX  , R = NB * RB  , NPAN = R / 256  , PPB = RB / 256  ;
constexpr int D = 2048, DFF = 5632, N13 = 2 * DFF, NMOD = 9 * D  ;
constexpr int LDP = 13312;
constexpr int NIN = 13568;
constexpr int PQ = 0, PK = 1024, PV = 2048, PZ = 3072, PX = 4096, PU = 6144, PG = 7168;
constexpr float DN_ALPHA = 1.41421356237309515f;
constexpr float LN_EPS = 1e-5f, RMS_EPS = 1e-6f;
constexpr float QSCALE = 0.125f * 1.4426950408889634f;

constexpr size_t MiB = 1u << 20;
constexpr size_t WS_CTL = 0, CTL_ZERO_BYTES = 1 * MiB;
constexpr size_t WS_MOD = 1 * MiB;
constexpr size_t WS_ROPE = 2 * MiB;
constexpr size_t WS_STATS = 2 * MiB + 65536;
constexpr size_t WS_IDENT = 2 * MiB + 262144;
constexpr size_t WS_MODP = 3 * MiB;
constexpr size_t WS_DT = 15 * MiB;
constexpr size_t WS_H = 18 * MiB;
constexpr size_t WS_HC = WS_H + 68 * MiB;
constexpr size_t WS_HM = 154 * MiB;
constexpr size_t WS_PROJ = 222 * MiB;
constexpr size_t WS_O = 664 * MiB;
constexpr size_t WS_YD = 732 * MiB;
constexpr size_t WS_YS = 800 * MiB;
constexpr size_t WS_W = 868 * MiB;
constexpr size_t W_13 = 0, W_2 = 88 * MiB, W_IN = 132 * MiB, W_B = 185 * MiB, W_O = 197 * MiB, W_GLU = 205 * MiB;
constexpr size_t WS_S5ST = 1075 * MiB;
constexpr size_t WS_S5H = 1143 * MiB;
constexpr size_t WS_S5M = 1183 * MiB;
constexpr size_t WS_S5A = 1207 * MiB;
constexpr size_t WS_END = 1208 * MiB;
constexpr int S5M = 1088;
constexpr int CW_BAR = 4096;

__device__ __forceinline__ unsigned cvt_pk_bf16(float lo, float hi) { unsigned r; asm volatile("v_cvt_pk_bf16_f32 %0, %1, %2" : "=v"(r) : "v"(lo), "v"(hi)); return r; }
__device__ __forceinline__ float bflo(unsigned u) { return __uint_as_float(u << 16); }
__device__ __forceinline__ float bfhi(unsigned u) { return __uint_as_float(u & 0xffff0000u); }
__device__ __forceinline__ float bf1(bf16_t h) { return __uint_as_float((unsigned)h << 16); }
typedef _Float16 h16x2 __attribute__((ext_vector_type(2)));
typedef _Float16 h16x4 __attribute__((ext_vector_type(4)));
__device__ __forceinline__ f32x4 ld_h4(const _Float16* p) { const h16x4 h = *(const h16x4*)p; return (f32x4){(float)h[0], (float)h[1], (float)h[2], (float)h[3]}; }
__device__ __forceinline__ void st_h4(_Float16* p, f32x4 v) { h16x4 h; h[0] = (_Float16)v[0]; h[1] = (_Float16)v[1]; h[2] = (_Float16)v[2]; h[3] = (_Float16)v[3]; *(h16x4*)p = h; }
__device__ __forceinline__ float sigmoidf_(float x) { return __builtin_amdgcn_rcpf(1.0f + __builtin_amdgcn_exp2f(-1.4426950408889634f * x)); }
__device__ __forceinline__ float siluf_(float x) { return x * sigmoidf_(x); }
__device__ __forceinline__ int lane_now() { int l; asm volatile("v_mbcnt_lo_u32_b32 %0, -1, 0\n\tv_mbcnt_hi_u32_b32 %0, -1, %0" : "=v"(l)); return l; }
__device__ __forceinline__ float shx(float v, int m, int lane) { return __int_as_float(__builtin_amdgcn_ds_bpermute((lane ^ m) << 2, __float_as_int(v))); }
__device__ __forceinline__ float wave_sum(float v, int lane) {
#pragma unroll
    for (int o = 1; o < 64; o <<= 1) v += shx(v, o, lane);
    return v;
}
#define LDS_WAIT() asm volatile("s_waitcnt lgkmcnt(0)" ::: "memory")
#define VM_WAIT() asm volatile("s_waitcnt vmcnt(0)" ::: "memory")

namespace pg8 {
constexpr int BM = 256, BK = 64, HALF = 128, HTB = HALF * BK * 2, STAGE_BYTES = 8 * HTB, NXCD = 8, WGM = 8, PPB_ = 17;
__host__ __device__ __forceinline__ int lds_byte(int r, int c) { const int st = (r >> 4) * 2 + (c >> 5), rr = r & 15, cc = c & 31, ob = rr * 64 + cc * 2; return st * 1024 + (ob ^ (((ob >> 9) & 1) << 5)); }
__host__ __device__ __forceinline__ void stage_rc(int b, int& R_, int& C_) { const int st = b / 1024, sb = b % 1024, swz = sb ^ (((sb >> 9) & 1) << 5); R_ = (st >> 1) * 16 + swz / 64; C_ = (st & 1) * 32 + (swz % 64) / 2; }

struct Unit { int pm, pn, aux, kt; const char* a; const char* b; };
struct Gemm { int lda, ldb, K; };

__device__ __forceinline__ void xcd_remap(int L, int nM, int nN, int& pm, int& pn) {
    const int nwg = nM * nN; int wgid = L;
    { const int q = nwg / NXCD, r = nwg % NXCD, xcd = wgid % NXCD, off = wgid / NXCD; wgid = (xcd < r ? xcd * (q + 1) : r * (q + 1) + (xcd - r) * q) + off; }
    const int nig = WGM * nN, gid = wgid / nig, fm = gid * WGM, gsz = (nM - fm) < WGM ? (nM - fm) : WGM;
    pm = fm + ((wgid % nig) % gsz); pn = (wgid % nig) / gsz;
}
struct StaticOrder {
    int nM, nN, nwg, G, c, kt, latonly, nctx; const char* A; const char* B; size_t tA, tB;
    __device__ __forceinline__ void init(int nM_, int nN_, int G_, int c_, const void* A_, int lda, const void* B_, int ldb, int K, int latonly_ = 0, int nctx_ = 0) { nM = nM_; nN = nN_; nwg = nM * nN; G = G_; c = c_; kt = K / BK; latonly = latonly_; nctx = nctx_;
        A = (const char*)A_; B = (const char*)B_; tA = (size_t)BM * lda * 2; tB = (size_t)BM * ldb * 2; }
    __device__ __forceinline__ bool next(int i, Unit& u) const {
        const long L = (long)i * G + c;
        if (L < nwg) { xcd_remap((int)L, nM, nN, u.pm, u.pn); if (latonly) u.pm += (u.pm >> 4) + 1; u.aux = 0; u.kt = kt; u.a = A + (size_t)u.pm * tA; u.b = B + (size_t)u.pn * tB; return true; }
        const int x = (int)(L - nwg); if (x >= nctx) return false;
        const int q = x & 3, t2 = x >> 2; u.pm = PPB_ * (t2 / nN); u.pn = t2 % nN; u.aux = 1; u.kt = kt >> 2;
        u.a = A + (size_t)u.pm * tA + (size_t)q * (kt >> 2) * BK * 2; u.b = B + (size_t)u.pn * tB + (size_t)q * (kt >> 2) * BK * 2; return true;
    }
};
template <class Epi, class Sched, int AMODE = 0, bool HOOK = false>
__device__ __forceinline__ void gemm_phase(LAS unsigned char* lds, const Gemm g, const Sched& S, const Epi& E, const int tid) {
    const int wid = __builtin_amdgcn_readfirstlane(tid >> 6), lane = tid & 63, wr = wid >> 2, wc = wid & 3, fr = lane & 15, fq = lane >> 4;
    unsigned voffA[2], voffB[2];
#pragma unroll
    for (int i = 0; i < 2; ++i) { int R_, C_; stage_rc(tid * 16 + i * 8192, R_, C_);
        voffA[i] = (AMODE == 1) ? (unsigned)((R_ * 16 + (C_ >> 4)) * LDP + (C_ & 15)) * 2u : (unsigned)(R_ * g.lda + C_) * 2u; voffB[i] = (unsigned)(R_ * g.ldb + C_) * 2u; }
    const size_t kstep = (size_t)(BK * 2), kstepA = (AMODE == 1) ? (size_t)(4 * LDP * 2) : kstep;
    const size_t hstepA = (AMODE == 1) ? (size_t)HALF * 16 * LDP * 2 : (size_t)HALF * g.lda * 2, hstepB = (size_t)HALF * g.ldb * 2;
    const unsigned ldsw = (unsigned)wid * 1024u;
    const int aoff = lds_byte(wr * 64 + fr, fq * 8), boff = lds_byte(wc * 32 + fr, fq * 8);
#define PG8_SA(b, h) (((b) * 2 + (h)) * HTB)
#define PG8_SB(b, h) ((4 + (b) * 2 + (h)) * HTB)
#define PG8_STAGE(bufoff, gbase, voff) do { _Pragma("unroll") for (int _i = 0; _i < 2; ++_i) \
        __builtin_amdgcn_global_load_lds((const unsigned*)((const char*)(gbase) + (voff)[_i]), (LAS unsigned*)(lds + (bufoff) + ldsw + _i * 8192), 16, 0, 0); } while (0)
#define PG8_LDA(dst, b, h) do { _Pragma("unroll") for (int m = 0; m < 4; ++m) _Pragma("unroll") for (int k = 0; k < 2; ++k) dst[m][k] = *(const LAS bf16x8*)(lds + PG8_SA(b, h) + aoff + m * 2048 + k * 1024); } while (0)
#define PG8_LDB(dst, b, h) do { _Pragma("unroll") for (int n = 0; n < 2; ++n) _Pragma("unroll") for (int k = 0; k < 2; ++k) dst[n][k] = *(const LAS bf16x8*)(lds + PG8_SB(b, h) + boff + n * 2048 + k * 1024); } while (0)
#define PG8_MMA(ai, bj, At, Bt) do { __builtin_amdgcn_s_setprio(1); _Pragma("unroll") for (int m = 0; m < 4; ++m) _Pragma("unroll") for (int n = 0; n < 2; ++n) _Pragma("unroll") for (int k = 0; k < 2; ++k) \
        acc[ai][bj][m][n] = __builtin_amdgcn_mfma_f32_16x16x32_bf16(Bt[n][k], At[m][k], acc[ai][bj][m][n], 0, 0, 0); __builtin_amdgcn_s_setprio(0); } while (0)
#define PG8_WAIT_V(n) asm volatile("s_waitcnt vmcnt(" #n ")" ::: "memory")
#define PG8_WAIT_L(n) asm volatile("s_waitcnt lgkmcnt(" #n ")" ::: "memory")
#define PG8_BAR __builtin_amdgcn_s_barrier()
#define PG8_SCHED __builtin_amdgcn_sched_barrier(0)
    Unit cur, nxt; int ui = 0;
    if (!S.next(0, cur)) return;
    f32x4 acc[2][2][4][2];
#pragma unroll
    for (int a = 0; a < 2; ++a)
#pragma unroll
        for (int b = 0; b < 2; ++b)
#pragma unroll
            for (int m = 0; m < 4; ++m)
#pragma unroll
                for (int n = 0; n < 2; ++n) acc[a][b][m][n] = (f32x4){0.f, 0.f, 0.f, 0.f};
    bf16x8 At[4][2], B0[2][2], B1[2][2];
    const char* cA = cur.a; const char* cB = cur.b;
    PG8_STAGE(PG8_SB(0, 0), cB, voffB); PG8_STAGE(PG8_SB(0, 1), cB + hstepB, voffB); PG8_STAGE(PG8_SA(0, 0), cA, voffA); PG8_STAGE(PG8_SA(0, 1), cA + hstepA, voffA);
    if (wr == 1) PG8_BAR;
    PG8_WAIT_V(2); PG8_BAR;
    PG8_STAGE(PG8_SB(1, 0), cB + kstep, voffB); PG8_STAGE(PG8_SA(1, 0), cA + kstepA, voffA); PG8_STAGE(PG8_SB(1, 1), cB + hstepB + kstep, voffB);
    PG8_WAIT_V(6); PG8_BAR;
    for (;;) {
        const bool has_next = S.next(ui + 1, nxt);
        const char* nA = has_next ? nxt.a : cA; const char* nB = has_next ? nxt.b : cB;
        const int nt = cur.kt;
        for (int t = 0; t < nt; t += 2) {
            const bool last = (t == nt - 2);
            if constexpr (HOOK) { if (t == 16 || t == 32) E.mid(acc, cur, t >> 4, wr, wc); }
            const char* a1 = cA + (size_t)(t + 1) * kstepA;
            const char* a2 = last ? nA : cA + (size_t)(t + 2) * kstepA; const char* b2 = last ? nB : cB + (size_t)(t + 2) * kstep;
            const char* a3 = a2 + kstepA; const char* b3 = b2 + kstep;
            PG8_LDB(B0, 0, 0); PG8_LDB(B1, 0, 1); PG8_SCHED; PG8_LDA(At, 0, 0); PG8_STAGE(PG8_SA(1, 1), a1 + hstepA, voffA);
            PG8_WAIT_V(8); PG8_WAIT_L(0); PG8_BAR; PG8_MMA(0, 0, At, B0); PG8_MMA(0, 1, At, B1); PG8_BAR; PG8_SCHED;
            PG8_LDA(At, 0, 1); PG8_STAGE(PG8_SB(0, 0), b2, voffB); PG8_STAGE(PG8_SB(0, 1), b2 + hstepB, voffB); PG8_STAGE(PG8_SA(0, 0), a2, voffA);
            PG8_WAIT_V(8); PG8_WAIT_L(0); PG8_BAR; PG8_MMA(1, 0, At, B0); PG8_MMA(1, 1, At, B1); PG8_BAR; PG8_SCHED;
            PG8_LDB(B0, 1, 0); PG8_LDB(B1, 1, 1); PG8_SCHED; PG8_LDA(At, 1, 0); PG8_STAGE(PG8_SA(0, 1), a2 + hstepA, voffA);
            PG8_WAIT_V(8); PG8_WAIT_L(0); PG8_BAR; PG8_MMA(0, 0, At, B0); PG8_MMA(0, 1, At, B1); PG8_BAR; PG8_SCHED;
            PG8_LDA(At, 1, 1); PG8_STAGE(PG8_SB(1, 0), b3, voffB); PG8_STAGE(PG8_SB(1, 1), b3 + hstepB, voffB); PG8_STAGE(PG8_SA(1, 0), a3, voffA);
            PG8_WAIT_V(8); PG8_WAIT_L(0); PG8_BAR; PG8_MMA(1, 0, At, B0); PG8_MMA(1, 1, At, B1); PG8_BAR; PG8_SCHED;
        }
        if (wr == 0) PG8_BAR;
        E(acc, cur, wr, wc, fr, fq);
        if (!has_next) break;
#pragma unroll
        for (int a = 0; a < 2; ++a)
#pragma unroll
            for (int b = 0; b < 2; ++b)
#pragma unroll
                for (int m = 0; m < 4; ++m)
#pragma unroll
                    for (int n = 0; n < 2; ++n) acc[a][b][m][n] = (f32x4){0.f, 0.f, 0.f, 0.f};
        cur = nxt; cA = nA; cB = nB; ++ui;
        if (wr == 1) PG8_BAR;
    }
    PG8_WAIT_V(0);
    PG8_BAR;
#undef PG8_SA
#undef PG8_SB
#undef PG8_STAGE
#undef PG8_LDA
#undef PG8_LDB
#undef PG8_MMA
#undef PG8_WAIT_V
#undef PG8_WAIT_L
#undef PG8_BAR
#undef PG8_SCHED
}
}

struct EpiSwiGLU {
    bf16_t* O;
    __device__ __forceinline__ void operator()(const f32x4 (&acc)[2][2][4][2], const pg8::Unit& u, int wr, int wc, int, int) const { const int ln_ = lane_now(); const int fr = ln_ & 15, fq = ln_ >> 4;
        const int row0 = u.pm * 256 + wr * 64 + fr, hc0 = u.pn * 128 + wc * 16 + 4 * fq;
#pragma unroll
        for (int ai = 0; ai < 2; ++ai)
#pragma unroll
            for (int m = 0; m < 4; ++m) { bf16_t* rowp = O + (size_t)(row0 + ai * 128 + m * 16) * DFF + hc0;
#pragma unroll
                for (int bj = 0; bj < 2; ++bj) { const f32x4 a = acc[ai][bj][m][0], b = acc[ai][bj][m][1];
                    u32x2 w; w.x = cvt_pk_bf16(siluf_(a[0]) * b[0], siluf_(a[1]) * b[1]); w.y = cvt_pk_bf16(siluf_(a[2]) * b[2], siluf_(a[3]) * b[3]);
                    *(u32x2*)(rowp + bj * 64) = w; } }
    }
};
struct EpiResid {
    _Float16* H; float* HC; const float* gate; const float* lng; const float* lnb; const float* stats;
    __device__ __forceinline__ void operator()(const f32x4 (&acc)[2][2][4][2], const pg8::Unit& u, int wr, int wc, int, int) const { const int ln_ = lane_now(); const int fr = ln_ & 15, fq = ln_ >> 4;
        const int pp = u.pm % PPB, mi = (pp == 0) ? 4 : (u.pm / PPB);
        const int rl0 = wr * 64 + fr, col0 = u.pn * 256 + wc * 32 + 4 * fq;
        if (u.aux) {
            float* hc = HC + (size_t)(u.pm / PPB) * 256 * D;
#pragma unroll
            for (int bj = 0; bj < 2; ++bj)
#pragma unroll
                for (int n = 0; n < 2; ++n) { const f32x4 gv = *(const f32x4*)(gate + (size_t)mi * NMOD + col0 + bj * 128 + n * 16);
#pragma unroll
                    for (int ai = 0; ai < 2; ++ai)
#pragma unroll
                        for (int m = 0; m < 4; ++m) { float* p = hc + (size_t)(rl0 + ai * 128 + m * 16) * D + col0 + bj * 128 + n * 16; const f32x4 v = gv * acc[ai][bj][m][n];
                            unsafeAtomicAdd(p, v[0]); unsafeAtomicAdd(p + 1, v[1]); unsafeAtomicAdd(p + 2, v[2]); unsafeAtomicAdd(p + 3, v[3]); } }
            return;
        }
#pragma unroll
        for (int bj = 0; bj < 2; ++bj)
#pragma unroll
            for (int n = 0; n < 2; ++n) { const int c = col0 + bj * 128 + n * 16; const f32x4 gv = *(const f32x4*)(gate + (size_t)mi * NMOD + c);
                const f32x4 g4 = *(const f32x4*)(lng + c) * DN_ALPHA, b4 = *(const f32x4*)(lnb + c) * DN_ALPHA;
#pragma unroll
                for (int ai = 0; ai < 2; ++ai)
#pragma unroll
                    for (int m = 0; m < 4; ++m) { const size_t row = (size_t)(u.pm * 256 + rl0 + ai * 128 + m * 16); _Float16* p = H + row * D + c; const f32x4 t = ld_h4(p);
                        const f32x2 st = *(const f32x2*)(stats + row * 2);
                        st_h4(p, (t - st.x) * st.y * g4 + b4 + gv * acc[ai][bj][m][n]); } }
    }
};
struct EpiProj {
    bf16_t* P; float* DT; const float* rc; const float* rs;
    __device__ __forceinline__ void operator()(const f32x4 (&acc)[2][2][4][2], const pg8::Unit& u, int wr, int wc, int, int) const { const int ln_ = lane_now(); const int fr = ln_ & 15, fq = ln_ >> 4;
        const int pp = u.pm % PPB; const int row0 = u.pm * 256 + wr * 64 + fr;
        const int pn = u.pn;
        if (pn == 52) {
            if (wc == 0) {
#pragma unroll
                for (int ai = 0; ai < 2; ++ai)
#pragma unroll
                    for (int m = 0; m < 4; ++m)
#pragma unroll
                        for (int n = 0; n < 2; ++n) *(f32x4*)(DT + (size_t)(row0 + ai * 128 + m * 16) * 32 + n * 16 + 4 * fq) = acc[ai][0][m][n];
            }
            return;
        }
        const int col0 = pn * 256 + wc * 32 + 4 * fq;
        const int mode = (pn < 8) ? ((pp != 0) ? 1 : 0) : ((pn >= 12 && pn < 16) ? 2 : (pn >= 28 ? 3 : 0));
        const float sc = (pn < 4) ? QSCALE : 1.0f;
#pragma unroll
        for (int ai = 0; ai < 2; ++ai)
#pragma unroll
            for (int m = 0; m < 4; ++m) { const int rl = ai * 128 + wr * 64 + m * 16 + fr; bf16_t* rowp = P + (size_t)(u.pm * 256 + rl) * LDP + col0;
                f32x4 cs = (f32x4){1.f, 1.f, 1.f, 1.f}, sn = (f32x4){0.f, 0.f, 0.f, 0.f};
                if (mode == 1) { const int t = (pp - 1) * 256 + rl; const int pos = (wc & 1) ? (t & 63) : (t >> 6); cs = *(const f32x4*)(rc + pos * 16 + 4 * fq); sn = *(const f32x4*)(rs + pos * 16 + 4 * fq); }
#pragma unroll
                for (int bj = 0; bj < 2; ++bj) { f32x4 v0 = acc[ai][bj][m][0], v1 = acc[ai][bj][m][1];
                    if (mode == 1) { const f32x4 o0 = v0 * cs - v1 * sn, o1 = v1 * cs + v0 * sn; v0 = o0; v1 = o1; }
                    else if (mode == 2) {
#pragma unroll
                        for (int e = 0; e < 4; ++e) { v0[e] = siluf_(v0[e]); v1[e] = siluf_(v1[e]); } }
                    else if (mode == 3) {
#pragma unroll
                        for (int e = 0; e < 4; ++e) { v0[e] = sigmoidf_(v0[e]); v1[e] = sigmoidf_(v1[e]); } }
                    if (mode == 3) { unsigned char* gb = (unsigned char*)(P + (size_t)(u.pm * 256 + rl) * LDP + PG) + (col0 - PG) + bj * 128;
                        unsigned q0 = 0, q1 = 0;
#pragma unroll
                        for (int e = 0; e < 4; ++e) { q0 |= (unsigned)fmaxf(__builtin_rintf(v0[e] * 255.0f), 1.0f) << (8 * e); q1 |= (unsigned)fmaxf(__builtin_rintf(v1[e] * 255.0f), 1.0f) << (8 * e); }
                        *(unsigned*)gb = q0; *(unsigned*)(gb + 16) = q1; continue; }
                    v0 = v0 * sc; v1 = v1 * sc;
                    u32x2 w0, w1; w0.x = cvt_pk_bf16(v0[0], v0[1]); w0.y = cvt_pk_bf16(v0[2], v0[3]); w1.x = cvt_pk_bf16(v1[0], v1[1]); w1.y = cvt_pk_bf16(v1[2], v1[3]);
                    *(u32x2*)(rowp + bj * 128) = w0; *(u32x2*)(rowp + bj * 128 + 16) = w1; } }
    }
};
struct EpiGlu {
    bf16_t* P; const float* bias;
    __device__ __forceinline__ void operator()(const f32x4 (&acc)[2][2][4][2], const pg8::Unit& u, int wr, int wc, int, int) const { const int ln_ = lane_now(); const int fr = ln_ & 15, fq = ln_ >> 4;
        const int row0 = u.pm * 256 + wr * 64 + fr, col0 = u.pn * 256 + wc * 32 + 4 * fq;
#pragma unroll
        for (int ai = 0; ai < 2; ++ai)
#pragma unroll
            for (int m = 0; m < 4; ++m) { bf16_t* rowp = P + (size_t)(row0 + ai * 128 + m * 16) * LDP;
#pragma unroll
                for (int bj = 0; bj < 2; ++bj)
#pragma unroll
                    for (int n = 0; n < 2; ++n) { const int c = col0 + bj * 128 + n * 16; const f32x4 bv = *(const f32x4*)(bias + c); const u32x2 tv = *(const u32x2*)(rowp + PU + c);
                        const f32x4 a = acc[ai][bj][m][n] + bv; u32x2 w;
                        w.x = cvt_pk_bf16(bflo(tv.x) * sigmoidf_(a[0]), bfhi(tv.x) * sigmoidf_(a[1])); w.y = cvt_pk_bf16(bflo(tv.y) * sigmoidf_(a[2]), bfhi(tv.y) * sigmoidf_(a[3]));
                        *(u32x2*)(rowp + PK + c) = w; } }
    }
};
struct EpiMerge {
    const bf16_t* P; bf16_t* MIXB;
    static __device__ __forceinline__ int goff(int seg) { return (seg == 0 ? 0 : (seg == 1 ? 4096 : 2048)); }
    __device__ __forceinline__ void mid(f32x4 (&acc)[2][2][4][2], const pg8::Unit& u, int seg, int wr, int wc) const {
        const int ln_ = lane_now(); const int fr = ln_ & 15, fq = ln_ >> 4;
        const int row0 = u.pm * 256 + wr * 64 + fr, col0 = u.pn * 256 + wc * 32 + 4 * fq; const int gp = goff(seg - 1), gn = goff(seg);
#pragma unroll
        for (int ai = 0; ai < 2; ++ai) {
            unsigned a[4][2][2], b[4][2][2];
#pragma unroll
            for (int m = 0; m < 4; ++m) { const unsigned char* rp = (const unsigned char*)(P + (size_t)(row0 + ai * 128 + m * 16) * LDP + PG) + col0;
#pragma unroll
                for (int bj = 0; bj < 2; ++bj)
#pragma unroll
                    for (int n = 0; n < 2; ++n) { a[m][bj][n] = *(const unsigned*)(rp + gp + bj * 128 + n * 16); b[m][bj][n] = *(const unsigned*)(rp + gn + bj * 128 + n * 16); } }
            asm volatile("s_waitcnt vmcnt(0)" ::: "memory");
#pragma unroll
            for (int m = 0; m < 4; ++m)
#pragma unroll
                for (int bj = 0; bj < 2; ++bj)
#pragma unroll
                    for (int n = 0; n < 2; ++n) { f32x4 r;
#pragma unroll
                        for (int e = 0; e < 4; ++e) r[e] = (float)((a[m][bj][n] >> (8 * e)) & 255u) * __builtin_amdgcn_rcpf((float)((b[m][bj][n] >> (8 * e)) & 255u));
                        acc[ai][bj][m][n] = acc[ai][bj][m][n] * r; }
            asm volatile("" ::: "memory"); }
    }
    __device__ __forceinline__ void operator()(const f32x4 (&acc)[2][2][4][2], const pg8::Unit& u, int wr, int wc, int, int) const { const int ln_ = lane_now(); const int fr = ln_ & 15, fq = ln_ >> 4;
        const int row0 = u.pm * 256 + wr * 64 + fr, col0 = u.pn * 256 + wc * 32 + 4 * fq; const int gl = goff(2);
#pragma unroll
        for (int ai = 0; ai < 2; ++ai)
#pragma unroll
            for (int m = 0; m < 4; ++m) { const size_t row = (size_t)(row0 + ai * 128 + m * 16);
#pragma unroll
                for (int bj = 0; bj < 2; ++bj)
#pragma unroll
                    for (int n = 0; n < 2; ++n) { const int c = col0 + bj * 128 + n * 16; const unsigned gv = *(const unsigned*)((const unsigned char*)(P + row * LDP + PG) + gl + c);
                        f32x4 v = acc[ai][bj][m][n];
#pragma unroll
                        for (int e = 0; e < 4; ++e) v[e] *= (float)((gv >> (8 * e)) & 255u) * (1.0f / 255.0f);
                        u32x2 w; w.x = cvt_pk_bf16(v[0], v[1]); w.y = cvt_pk_bf16(v[2], v[3]); *(u32x2*)(MIXB + row * D + c) = w; } }
    }
};

struct S5AOrder {
    int G, c; const char* A; const char* B;
    __device__ __forceinline__ bool next(int i, pg8::Unit& u) const {
        const int idx = i * G + c; if (idx >= 640) return false;
        const int g = idx / 10, r = idx - 10 * g, nt = r / 5, mt = r - 5 * nt;
        u.pm = mt; u.pn = nt; u.aux = g; u.kt = 4; u.a = A + (size_t)(16 * g) * 2 + (size_t)mt * 256 * 16 * LDP * 2; u.b = B + (size_t)(g * 512 + nt * 256) * 256 * 2; return true;
    }
};
struct EpiS5A {
    bf16_t* YL; float* ST;
    __device__ __forceinline__ void operator()(const f32x4 (&acc)[2][2][4][2], const pg8::Unit& u, int wr, int wc, int, int) const { const int ln_ = lane_now(); const int fr = ln_ & 15, fq = ln_ >> 4;
        const int g = u.aux;
#pragma unroll
        for (int ai = 0; ai < 2; ++ai)
#pragma unroll
            for (int m = 0; m < 4; ++m) { const int mr = u.pm * 256 + ai * 128 + wr * 64 + m * 16 + fr; if (mr < S5M) {
#pragma unroll
                for (int bj = 0; bj < 2; ++bj)
#pragma unroll
                    for (int n = 0; n < 2; ++n) { const f32x4 v = acc[ai][bj][m][n];
                        if (u.pn == 0) { const int rho = 8 * bj + 2 * wc + n; u32x2 w; w.x = cvt_pk_bf16(v[0], v[1]); w.y = cvt_pk_bf16(v[2], v[3]); *(u32x2*)(YL + (size_t)(16 * mr + rho) * 1024 + 16 * g + 4 * fq) = w; }
                        else *(f32x4*)(ST + ((size_t)g * S5M + mr) * 256 + bj * 128 + wc * 32 + n * 16 + 4 * fq) = v; } } }
    }
};
struct S5COrder {
    int G, c; const char* A; const char* B;
    __device__ __forceinline__ bool next(int i, pg8::Unit& u) const {
        const int idx = i * G + c; if (idx >= 320) return false;
        const int g = idx / 5, mt = idx - 5 * g;
        u.pm = mt; u.pn = 0; u.aux = g; u.kt = 4; u.a = A + ((size_t)g * 1280 + mt * 256) * 256 * 2; u.b = B + (size_t)g * 256 * 256 * 2; return true;
    }
};
struct EpiS5C {
    const bf16_t* YL; bf16_t* P;
    __device__ __forceinline__ void operator()(const f32x4 (&acc)[2][2][4][2], const pg8::Unit& u, int wr, int wc, int, int) const { const int ln_ = lane_now(); const int fr = ln_ & 15, fq = ln_ >> 4;
        const int g = u.aux;
#pragma unroll
        for (int ai = 0; ai < 2; ++ai)
#pragma unroll
            for (int m = 0; m < 4; ++m) { const int mr = u.pm * 256 + ai * 128 + wr * 64 + m * 16 + fr; if (mr < S5M) {
#pragma unroll
                for (int bj = 0; bj < 2; ++bj)
#pragma unroll
                    for (int n = 0; n < 2; ++n) { const int rho = 8 * bj + 2 * wc + n; const size_t row = (size_t)(16 * mr + rho);
                        const u32x2 yl = *(const u32x2*)(YL + row * 1024 + 16 * g + 4 * fq); f32x4 v = acc[ai][bj][m][n];
                        v[0] += bflo(yl.x); v[1] += bfhi(yl.x); v[2] += bflo(yl.y); v[3] += bfhi(yl.y);
#pragma unroll
                        for (int e = 0; e < 4; ++e) { const float x = v[e]; const float inner = 0.7978845608028654f * (x + 0.044715f * x * x * x); const float th = 1.0f - 2.0f * __builtin_amdgcn_rcpf(1.0f + __builtin_amdgcn_exp2f(2.8853900817779268f * inner)); v[e] = 0.5f * x * (1.0f + th); }
                        u32x2 w; w.x = cvt_pk_bf16(v[0], v[1]); w.y = cvt_pk_bf16(v[2], v[3]); *(u32x2*)(P + row * LDP + PU + 16 * g + 4 * fq) = w; } } }
    }
};

namespace attn128 {
using bf16 = __hip_bfloat16;
constexpr int NW = 8, QBLK = 32, KVBLK = 64, LDQ = LDP, LDK = LDP, LDO = 1024;
constexpr size_t SHM_V = KVBLK * 128 * 2, SHM_K = KVBLK * 64 * 2, SHM_ATTN = 2 * SHM_V + 2 * SHM_K + NW * 64 * 4;
constexpr float THRL = 11.5f;
#define A128_KSWZ(row, colB) ((row) * 128 + ((colB) ^ (((row) & 7) << 4)))
#define A128_SBAR() __builtin_amdgcn_sched_barrier(0)
__device__ __forceinline__ int crow(int r, int hi) { return (r & 3) + 8 * (r >> 2) + 4 * hi; }
__device__ __forceinline__ void partialSM(f32x16& p0, f32x16& p1, float& m_reg, float& mn, float& alpha) {
  float pmax = p0[0];
#pragma unroll
  for (int r = 1; r < 16; ++r) pmax = fmaxf(pmax, p0[r]);
#pragma unroll
  for (int r = 0; r < 16; ++r) pmax = fmaxf(pmax, p1[r]);
  { auto rr = __builtin_amdgcn_permlane32_swap(__float_as_uint(pmax), __float_as_uint(pmax), false, false); pmax = fmaxf(__uint_as_float(rr[0]), __uint_as_float(rr[1])); }
  if (__builtin_expect(__all(pmax - m_reg <= THRL), 1)) { mn = m_reg; alpha = 1.f; }
  else { mn = fmaxf(m_reg, pmax); alpha = __builtin_amdgcn_exp2f(m_reg - mn); m_reg = mn; }
#pragma unroll
  for (int r = 0; r < 16; ++r) { p0[r] = p0[r] - mn; p1[r] = p1[r] - mn; }
#pragma unroll
  for (int r = 0; r < 16; ++r) p0[r] = __builtin_amdgcn_exp2f(p0[r]);
}
__device__ __forceinline__ void finishSM(f32x16& p0, f32x16& p1, float alpha, float& l_reg, bf16x8& pa0, bf16x8& pa1, bf16x8& pa2, bf16x8& pa3) {
#pragma unroll
  for (int r = 0; r < 16; ++r) p1[r] = __builtin_amdgcn_exp2f(p1[r]);
  float ps = 0;
#pragma unroll
  for (int r = 0; r < 16; ++r) ps += p0[r];
#pragma unroll
  for (int r = 0; r < 16; ++r) ps += p1[r];
  { auto rr = __builtin_amdgcn_permlane32_swap(__float_as_uint(ps), __float_as_uint(ps), false, false); ps = __uint_as_float(rr[0]) + __uint_as_float(rr[1]); }
  l_reg = l_reg * alpha + ps;
#define A128_PK4(P, BASE, OUT) do { unsigned a0 = cvt_pk_bf16(P[BASE + 0], P[BASE + 1]), a1 = cvt_pk_bf16(P[BASE + 2], P[BASE + 3]);   \
    unsigned b0 = cvt_pk_bf16(P[BASE + 4], P[BASE + 5]), b1 = cvt_pk_bf16(P[BASE + 6], P[BASE + 7]);                              \
    auto r0 = __builtin_amdgcn_permlane32_swap(a0, b0, false, false); auto r1 = __builtin_amdgcn_permlane32_swap(a1, b1, false, false); \
    u32x4 w = {r0[0], r1[0], r0[1], r1[1]}; OUT = __builtin_bit_cast(bf16x8, w); } while (0)
  A128_PK4(p0, 0, pa0); A128_PK4(p0, 8, pa1); A128_PK4(p1, 0, pa2); A128_PK4(p1, 8, pa3);
#undef A128_PK4
}
__device__ __forceinline__ void qkt(f32x16& p0, f32x16& p1, const char* Ks, const bf16x8* qr, int r32, int hi) {
#pragma unroll
  for (int i = 0; i < 16; ++i) { p0[i] = 0.f; p1[i] = 0.f; }
#pragma unroll
  for (int d0 = 0; d0 < 4; ++d0) { const int cb = (d0 * 16 + hi * 8) * 2;
    const bf16x8 b0 = *reinterpret_cast<const bf16x8*>(Ks + A128_KSWZ(r32, cb));
    const bf16x8 b1 = *reinterpret_cast<const bf16x8*>(Ks + A128_KSWZ(32 + r32, cb));
    p0 = __builtin_amdgcn_mfma_f32_32x32x16_bf16(b0, qr[d0], p0, 0, 0, 0);
    p1 = __builtin_amdgcn_mfma_f32_32x32x16_bf16(b1, qr[d0], p1, 0, 0, 0); }
}
__device__ __forceinline__ int v_st(int k, int c) { const int kk = (k & ~0xC) | ((k & 4) << 1) | ((k & 8) >> 1); return ((kk >> 3) * 4 + (c >> 5)) * 512 + ((kk & 7) * 32 + (c & 31)) * 2; }
__device__ __forceinline__ int v_rd_base(int lane) { return ((lane & 3) << 3) | (((lane >> 2) & 3) << 6) | (((lane >> 4) & 1) << 5) | (((lane >> 5) & 1) << 8); }
constexpr int v_rd_off(int d0, int ks, int half) { return d0 * 512 + ks * 4096 + half * 2048; }
template <int OFF> __device__ __forceinline__ s16x4 tr_read(int vb) { s16x4 r; asm volatile("ds_read_b64_tr_b16 %0, %1 offset:%2" : "=&v"(r) : "v"(vb), "i"(OFF) : "memory"); return r; }
template <int D0> __device__ __forceinline__ void pv_one(f32x16& od, int vb, bf16x8 pa0, bf16x8 pa1, bf16x8 pa2, bf16x8 pa3) {
  const s16x4 l0 = tr_read<v_rd_off(D0, 0, 0)>(vb), h0 = tr_read<v_rd_off(D0, 0, 1)>(vb), l1 = tr_read<v_rd_off(D0, 1, 0)>(vb), h1 = tr_read<v_rd_off(D0, 1, 1)>(vb);
  const s16x4 l2 = tr_read<v_rd_off(D0, 2, 0)>(vb), h2 = tr_read<v_rd_off(D0, 2, 1)>(vb), l3 = tr_read<v_rd_off(D0, 3, 0)>(vb), h3 = tr_read<v_rd_off(D0, 3, 1)>(vb);
  asm volatile("s_waitcnt lgkmcnt(0)" ::: "memory"); A128_SBAR();
#define A128_PK(L, H) (bf16x8){L[0], L[1], L[2], L[3], H[0], H[1], H[2], H[3]}
  od = __builtin_amdgcn_mfma_f32_32x32x16_bf16(pa0, A128_PK(l0, h0), od, 0, 0, 0);
  od = __builtin_amdgcn_mfma_f32_32x32x16_bf16(pa1, A128_PK(l1, h1), od, 0, 0, 0);
  od = __builtin_amdgcn_mfma_f32_32x32x16_bf16(pa2, A128_PK(l2, h2), od, 0, 0, 0);
  od = __builtin_amdgcn_mfma_f32_32x32x16_bf16(pa3, A128_PK(l3, h3), od, 0, 0, 0);
#undef A128_PK
}
__device__ __forceinline__ void pv_d0(f32x16* o, int vb, bf16x8 pa0, bf16x8 pa1, bf16x8 pa2, bf16x8 pa3) {
  pv_one<0>(o[0], vb, pa0, pa1, pa2, pa3); pv_one<1>(o[1], vb, pa0, pa1, pa2, pa3); pv_one<2>(o[2], vb, pa0, pa1, pa2, pa3); pv_one<3>(o[3], vb, pa0, pa1, pa2, pa3);
}
__device__ __forceinline__ void unit(const bf16* __restrict__ Qb, const bf16* __restrict__ Kh, const bf16* __restrict__ Vh, bf16_t* __restrict__ Ob, int seq, char* lds, const int tid) {
  const int wid = __builtin_amdgcn_readfirstlane(tid >> 6), lane = tid & 63, r32 = lane & 31, hi = lane >> 5;
  char* V_lds = lds; char* K_lds = lds + 2 * SHM_V;
  float* ws = (float*)(lds + 2 * SHM_V + 2 * SHM_K) + wid * 64; float* li_l = ws; float* al_l = ws + 32;
  float m_reg = -1e30f, l_reg = 0; f32x16 o[4]; bf16x8 qr[4];
#pragma unroll
  for (int d = 0; d < 4; ++d)
#pragma unroll
    for (int r = 0; r < 16; ++r) o[d][r] = 0.f;
  const bf16* Qw = Qb + (long)(wid * QBLK + r32) * LDQ + hi * 8;
#pragma unroll
  for (int d0 = 0; d0 < 4; ++d0) qr[d0] = *reinterpret_cast<const bf16x8*>(Qw + d0 * 16);
  const int sr = tid >> 4, sc = (tid & 15) * 8, vst0 = v_st(sr, sc), vst1 = v_st(32 + sr, sc);
  const int kr = tid >> 3, kc = (tid & 7) * 8, kst = A128_KSWZ(kr, kc * 2);
  const int vb0 = (int)(uintptr_t)V_lds + v_rd_base(lane);
  struct { bf16x8 vs0, vs1, ks0; } sr_[2];
#define A128_SLOAD(i, k0) do { sr_[i].vs0 = *reinterpret_cast<const bf16x8*>(&Vh[(long)((k0) + sr) * LDK + sc]); sr_[i].vs1 = *reinterpret_cast<const bf16x8*>(&Vh[(long)((k0) + 32 + sr) * LDK + sc]); \
    sr_[i].ks0 = *reinterpret_cast<const bf16x8*>(&Kh[(long)((k0) + kr) * LDK + kc]); } while (0)
#define A128_SWRITE(b, i) do { *(bf16x8*)(V_lds + (b) * SHM_V + vst0) = sr_[i].vs0; *(bf16x8*)(V_lds + (b) * SHM_V + vst1) = sr_[i].vs1; *(bf16x8*)(K_lds + (b) * SHM_K + kst) = sr_[i].ks0; } while (0)
#define A128_SWAIT() asm volatile("s_waitcnt vmcnt(3)" ::: "memory")
#define A128_RESC(a) do { if (__any((a) < 1.f)) { if (hi == 0) al_l[r32] = (a); asm volatile("s_waitcnt lgkmcnt(0)" ::: "memory"); \
    _Pragma("unroll") for (int d = 0; d < 4; ++d) _Pragma("unroll") for (int r = 0; r < 16; ++r) o[d][r] *= al_l[crow(r, hi)]; } } while (0)
  f32x16 pA0, pA1, pB0, pB1; float mnA, mnB, alA, alB; bf16x8 pa0, pa1, pa2, pa3; const int NT = seq / KVBLK;
  A128_SLOAD(0, 0); asm volatile("s_waitcnt vmcnt(0)" ::: "memory"); A128_SWRITE(0, 0); __syncthreads();
  qkt(pA0, pA1, K_lds, qr, r32, hi); partialSM(pA0, pA1, m_reg, mnA, alA);
  A128_SLOAD(1, KVBLK); if (2 < NT) A128_SLOAD(0, 2 * KVBLK);
  A128_SWAIT(); A128_SWRITE(1, 1); __syncthreads();
  for (int j = 1; j + 1 < NT; j += 2) {
    A128_SBAR(); qkt(pB0, pB1, K_lds + SHM_K, qr, r32, hi);
    finishSM(pA0, pA1, alA, l_reg, pa0, pa1, pa2, pa3); A128_SBAR();
    A128_SLOAD(1, (j + 2) * KVBLK); A128_SBAR();
    pv_d0(o, vb0, pa0, pa1, pa2, pa3); partialSM(pB0, pB1, m_reg, mnB, alB);
    __syncthreads(); A128_SWAIT(); A128_SWRITE(0, 0);
    A128_RESC(alB); __syncthreads();
    A128_SBAR(); qkt(pA0, pA1, K_lds, qr, r32, hi);
    finishSM(pB0, pB1, alB, l_reg, pa0, pa1, pa2, pa3); A128_SBAR();
    if (j + 3 < NT) A128_SLOAD(0, (j + 3) * KVBLK); A128_SBAR();
    pv_d0(o, vb0 + (int)SHM_V, pa0, pa1, pa2, pa3); partialSM(pA0, pA1, m_reg, mnA, alA);
    __syncthreads(); A128_SWAIT(); A128_SWRITE(1, 1);
    A128_RESC(alA); __syncthreads();
  }
  A128_SBAR(); qkt(pB0, pB1, K_lds + SHM_K, qr, r32, hi);
  finishSM(pA0, pA1, alA, l_reg, pa0, pa1, pa2, pa3); A128_SBAR();
  pv_d0(o, vb0, pa0, pa1, pa2, pa3); partialSM(pB0, pB1, m_reg, mnB, alB);
  __syncthreads(); A128_RESC(alB);
  finishSM(pB0, pB1, alB, l_reg, pa0, pa1, pa2, pa3); A128_SBAR();
  pv_d0(o, vb0 + (int)SHM_V, pa0, pa1, pa2, pa3);
  if (hi == 0) li_l[r32] = l_reg; asm volatile("s_waitcnt lgkmcnt(0)" ::: "memory");
  float rli[16];
#pragma unroll
  for (int r = 0; r < 16; ++r) rli[r] = __builtin_amdgcn_rcpf(li_l[crow(r, hi)]);
  bf16_t* Ow = Ob + (long)(wid * QBLK) * LDO;
#pragma unroll
  for (int r = 0; r < 16; ++r) { const int orow = crow(r, hi);
#pragma unroll
    for (int d0 = 0; d0 < 4; ++d0) Ow[(long)orow * LDO + d0 * 32 + r32] = (bf16_t)(cvt_pk_bf16(o[d0][r] * rli[r], 0.f) & 0xffffu); }
  __syncthreads();
#undef A128_SLOAD
#undef A128_SWRITE
#undef A128_SWAIT
#undef A128_RESC
}
#undef A128_KSWZ
#undef A128_SBAR
}

#define XB_TMO      128
#define XB_XCNT(j)  (256  + 64 * (j))
#define XB_XSUB(j)  (1280 + 64 * (j))
#define XB_XGEN(j)  (2304 + 64 * (j))
#define XB_TOP      3328
#define XB_TOPGEN   3392
#define XCD_BAR_WORDS 3456
#define XB_SPIN_CAP (1u << 18)
__device__ __forceinline__ unsigned xb_ld(unsigned* p)              { return __hip_atomic_load(p, __ATOMIC_RELAXED, __HIP_MEMORY_SCOPE_AGENT); }
__device__ __forceinline__ unsigned xb_add(unsigned* p, unsigned v) { return __hip_atomic_fetch_add(p, v, __ATOMIC_RELAXED, __HIP_MEMORY_SCOPE_AGENT); }
__device__ __forceinline__ unsigned xb_xcc_id() { return (unsigned)__builtin_amdgcn_s_getreg((3 << 11) | 20) & 0xFu; }
#define XB_SPIN(cond, bar) do { unsigned _sp = 0; while (cond) { __builtin_amdgcn_s_sleep(1); \
    if ((++_sp & 255u) == 0u) { if (xb_ld(&(bar)[XB_TMO])) break; if (_sp > XB_SPIN_CAP) { atomicAdd(&(bar)[XB_TMO], 1u); break; } } } } while (0)
struct XcdBarrier { unsigned* bar; unsigned x; volatile LAS unsigned* st; };
__device__ __forceinline__ XcdBarrier xcd_barrier_post(unsigned* bar, volatile LAS unsigned* st) {
    XcdBarrier b; b.bar = bar; b.x = xb_xcc_id(); b.st = st;
    if (threadIdx.x == 0) (void)xb_add(&bar[XB_XCNT(b.x)], 1u);
    return b;
}
__device__ __forceinline__ void xcd_barrier_complete(unsigned* bar, unsigned x, unsigned& nloc, unsigned& nx) {
    const unsigned G = gridDim.x * gridDim.y * gridDim.z;
    unsigned sum, cnt, mine, sp = 0u;
    for (;;) {
        sum = 0u; cnt = 0u; mine = 0u;
#pragma unroll
        for (unsigned j = 0; j < 16; ++j) { const unsigned c = xb_ld(&bar[XB_XCNT(j)]); sum += c; cnt += (c > 0u) ? 1u : 0u; mine = (j == x) ? c : mine; }
        if (sum == G) break;
        __builtin_amdgcn_s_sleep(1);
        if ((++sp & 255u) == 0u) { if (xb_ld(&bar[XB_TMO])) break; if (sp > XB_SPIN_CAP) { atomicAdd(&bar[XB_TMO], 1u); break; } }
    }
    nloc = mine > 0u ? mine : 1u; nx = cnt > 0u ? cnt : 1u;
}
__device__ __forceinline__ void xcd_barrier(const XcdBarrier& b, const int tid) {
    asm volatile("s_waitcnt vmcnt(0)" ::: "memory");
    __syncthreads();
    if (tid == 0) {
        unsigned* bar = b.bar;
        __builtin_amdgcn_s_waitcnt(0);
        unsigned nloc = b.st[0], nx = b.st[1];
        if (nloc == 0u) { xcd_barrier_complete(bar, b.x, nloc, nx); b.st[0] = nloc; b.st[1] = nx; }
        const unsigned old = xb_add(&bar[XB_XSUB(b.x)], 1u);
        const unsigned gen = old / nloc;
        if (old + 1u == (gen + 1u) * nloc) {
            __builtin_amdgcn_fence(__ATOMIC_RELEASE, "agent");
            asm volatile("s_waitcnt vmcnt(0)" ::: "memory");
            const unsigned og = xb_add(&bar[XB_TOP], 1u);
            const unsigned tg = og / nx;
            if (og + 1u == (tg + 1u) * nx) xb_add(&bar[XB_TOPGEN], 1u);
            else XB_SPIN(xb_ld(&bar[XB_TOPGEN]) == tg, bar);
            __builtin_amdgcn_fence(__ATOMIC_ACQUIRE, "agent");
            xb_add(&bar[XB_XGEN(b.x)], 1u);
            asm volatile("s_waitcnt vmcnt(0)" ::: "memory");
        } else {
            XB_SPIN(xb_ld(&bar[XB_XGEN(b.x)]) == gen, bar);
            __builtin_amdgcn_fence(__ATOMIC_ACQUIRE, "agent");
            asm volatile("s_waitcnt vmcnt(0)" ::: "memory");
        }
    }
    __syncthreads();
}

constexpr int NWAVES = 8;
constexpr int RING_OFF = 0, RING_BYTES = 131072;
constexpr int LDSCTL_OFF = RING_BYTES, MISC_OFF = LDSCTL_OFF + 320;
constexpr int LDS_BYTES = 147456;
static_assert(attn128::SHM_ATTN <= (size_t)RING_BYTES, "attention scratch fits the ring");

struct Args { const float* in[32]; float* out; unsigned char* ws; int ph_lo, ph_hi; };
constexpr int INTAB_OFF = LDSCTL_OFF + 1024;
__device__ __forceinline__ const float* inptr(LAS unsigned char* lds, int i) {
    const unsigned long long v = ((const LAS unsigned long long*)(lds + INTAB_OFF))[i];
    const unsigned lo = __builtin_amdgcn_readfirstlane((unsigned)v), hi = __builtin_amdgcn_readfirstlane((unsigned)(v >> 32));
    return (const float*)(GAS const float*)(((unsigned long long)hi << 32) | lo);
}
#define INP(i) inptr(F.lds, (i))
struct Frame {
    LAS unsigned char* lds; int tid, lane, wave, vcu, G, gw, NGW;
    unsigned char* ws;
};
enum { I_X = 0, I_C, I_CTX, I_CCTX, I_WMOD, I_BMOD, I_LNG, I_LNB, I_W1, I_W3, I_W2, I_WIN, I_ALAM, I_ASUB, I_CONVW, I_CONVB, I_ALOG, I_DTB, I_SSDD, I_SSDN,
       I_LRE, I_LIM, I_LSTEP, I_BRE, I_BIM, I_CRE, I_CIM, I_S5D, I_GLUW, I_GLUB, I_WBR, I_WOUT };

__device__ __forceinline__ void transpose_item64(const float* srcA, const float* srcB, int ldn, bool ffn, bf16_t* dst, int ldk, LAS bf16_t* scr  , int lane) {
    const int q = lane & 15, kr = lane >> 4; const bool isB = q >= 8; const int c = (q & 7) * 4; const float* src = isB ? srcB : srcA;
    f32x4 v[16];
#pragma unroll
    for (int i = 0; i < 16; ++i) v[i] = src ? *(const f32x4*)(src + (size_t)(4 * i + kr) * ldn + c) : (f32x4){0.f, 0.f, 0.f, 0.f};
    const int drow = ffn ? (32 * (c >> 4) + (c & 15) + (isB ? 16 : 0)) : (c + (isB ? 32 : 0));
#pragma unroll
    for (int i = 0; i < 16; ++i) { const int k = 4 * i + kr; const unsigned p01 = cvt_pk_bf16(v[i][0], v[i][1]), p23 = cvt_pk_bf16(v[i][2], v[i][3]);
        scr[(drow + 0) * 72 + k] = (bf16_t)(p01 & 0xffffu); scr[(drow + 1) * 72 + k] = (bf16_t)(p01 >> 16); scr[(drow + 2) * 72 + k] = (bf16_t)(p23 & 0xffffu); scr[(drow + 3) * 72 + k] = (bf16_t)(p23 >> 16); }
    LDS_WAIT(); asm volatile("" ::: "memory");
    const int c8 = lane & 7;
#pragma unroll
    for (int jj = 0; jj < 8; ++jj) { const int n = (lane >> 3) + 8 * jj; *(u32x4*)(dst + (size_t)n * ldk + 8 * c8) = *(const LAS u32x4*)(scr + n * 72 + 8 * c8); }
    LDS_WAIT(); asm volatile("" ::: "memory");
}
__device__ __forceinline__ void convert_layer_weights(const Args& A_, Frame& F, int l) {
    LAS bf16_t* scr = (LAS bf16_t*)(F.lds + RING_OFF + F.wave * 16384);
    unsigned char* W = F.ws + WS_W;
    constexpr int I13 = 32 * 176, I2 = 88 * 32, IIN = 32 * 212, IB = 16 * 32, IO = 32 * 32, IG = 16 * 16;
    constexpr int NIT = 2 * I13 + 2 * I2 + IIN + 3 * IB + IO + IG;
    for (int it = F.gw; it < NIT; it += F.NGW) {
        int r = it;
        if (r < 2 * I13) { const int f = r / I13; r -= f * I13; const int kb = r / 176, nb = r % 176;
            const float* w1 = INP(I_W1) + ((size_t)(l * 2 + f) * D + 64 * kb) * DFF + 32 * nb; const float* w3 = INP(I_W3) + ((size_t)(l * 2 + f) * D + 64 * kb) * DFF + 32 * nb;
            transpose_item64(w1, w3, DFF, true, (bf16_t*)(W + W_13) + ((size_t)f * N13 + 64 * nb) * D + 64 * kb, D, scr, F.lane); continue; }
        r -= 2 * I13;
        if (r < 2 * I2) { const int f = r / I2; r -= f * I2; const int kb = r / 32, nb = r % 32;
            const float* w2 = INP(I_W2) + ((size_t)(l * 2 + f) * DFF + 64 * kb) * D + 64 * nb;
            transpose_item64(w2, w2 + 32, D, false, (bf16_t*)(W + W_2) + ((size_t)f * D + 64 * nb) * DFF + 64 * kb, DFF, scr, F.lane); continue; }
        r -= 2 * I2;
        if (r < IIN) { const int kb = r / 212, nb = r % 212; const int n0 = 64 * nb; const float* wb = INP(I_WIN) + ((size_t)l * D + 64 * kb) * 13344;
            const float* sa = nullptr; const float* sb = nullptr;
            if (n0 < 6144) { sa = wb + n0; sb = sa + 32; } else if (n0 < 13312) { sa = wb + n0 + 32; sb = sa + 32; } else if (n0 == 13312) { sa = wb + 6144; }
            transpose_item64(sa, sb, 13344, false, (bf16_t*)(W + W_IN) + (size_t)n0 * D + 64 * kb, D, scr, F.lane); continue; }
        r -= IIN;
        if (r < 3 * IB) { const int jb = r / IB; r -= jb * IB; const int kb = r / 32, nb = r % 32;
            const float* w = INP(I_WBR) + ((size_t)(l * 3 + jb) * 1024 + 64 * kb) * D + 64 * nb;
            const int sp = (jb == 0) ? 0 : (jb == 1 ? 2 : 1); transpose_item64(w, w + 32, D, false, (bf16_t*)(W + W_B) + (size_t)(64 * nb) * 3072 + sp * 1024 + 64 * kb, 3072, scr, F.lane); continue; }
        r -= 3 * IB;
        if (r < IO) { const int kb = r / 32, nb = r % 32; const float* w = INP(I_WOUT) + ((size_t)l * D + 64 * kb) * D + 64 * nb;
            transpose_item64(w, w + 32, D, false, (bf16_t*)(W + W_O) + (size_t)(64 * nb) * D + 64 * kb, D, scr, F.lane); continue; }
        r -= IO;
        { const int kb = r / 16, nb = r % 16; const float* w = INP(I_GLUW) + ((size_t)l * 1024 + 64 * kb) * 1024 + 64 * nb;
            transpose_item64(w, w + 32, 1024, false, (bf16_t*)(W + W_GLU) + (size_t)(64 * nb) * 1024 + 64 * kb, 1024, scr, F.lane); }
    }
}
__device__ __forceinline__ void mod_partials(const Args& A_, Frame& F) {
    float* MODw = (float*)(F.ws + WS_MOD);
    for (int it = F.gw; it < 2 * 72 * 16; it += F.NGW) {
        const int l = it / (72 * 16), r = it % (72 * 16), ks = r / 72, cg = r % 72;
        const int col = cg * 256 + F.lane * 4; const float* w = INP(I_WMOD) + ((size_t)l * D + ks * 128) * NMOD + col;
        f32x4 a0 = {0.f, 0.f, 0.f, 0.f}, a1 = a0, a2 = a0, a3 = a0, a4 = a0;
        const float* c = INP(I_C) + ks * 128; const float* cc = INP(I_CCTX) + ks * 128;
#pragma unroll 16
        for (int k = 0; k < 128; ++k) { const f32x4 wv = *(const f32x4*)(w + (size_t)k * NMOD);
            a0 += wv * siluf_(c[k]); a1 += wv * siluf_(c[D + k]); a2 += wv * siluf_(c[2 * D + k]); a3 += wv * siluf_(c[3 * D + k]); a4 += wv * siluf_(cc[k]); }
        const int r9 = col / D; const float sc = (r9 == 2 || r9 == 8) ? 0.5f : 1.0f;
        if (ks == 0) { const f32x4 bv = *(const f32x4*)(INP(I_BMOD) + (size_t)l * NMOD + col); a0 += bv; a1 += bv; a2 += bv; a3 += bv; a4 += bv; }
        float* o = MODw + (size_t)l * 5 * NMOD + col;
#pragma unroll
        for (int e = 0; e < 4; ++e) { unsafeAtomicAdd(o + e, a0[e] * sc); unsafeAtomicAdd(o + NMOD + e, a1[e] * sc); unsafeAtomicAdd(o + 2 * NMOD + e, a2[e] * sc); unsafeAtomicAdd(o + 3 * NMOD + e, a3[e] * sc); unsafeAtomicAdd(o + 4 * NMOD + e, a4[e] * sc); }
    }
}
__device__ __forceinline__ void ln_pass(Frame& F, bool do_ln, const float* lng, const float* lnb, const float* modnext  , float* out, const float* xin = nullptr, const float* cin = nullptr) {
    _Float16* H = (_Float16*)(F.ws + WS_H); float* HC = (float*)(F.ws + WS_HC); bf16_t* HM = (bf16_t*)(F.ws + WS_HM); float* ST = (float*)(F.ws + WS_STATS);
    for (int row = F.gw; row < R; row += F.NGW) {
        const int b = row / RB, rr = row % RB; const bool isctx = rr < CTX; const int mi = isctx ? 4 : b;
        float* hc = HC + ((size_t)b * CTX + rr) * D; _Float16* hr = H + (size_t)row * D;
        f32x4 v[8]; float s = 0.f;
        if (xin) { const float* src = isctx ? cin + ((size_t)b * CTX + rr) * D : xin + ((size_t)b * SEQ + (rr - CTX)) * D;
#pragma unroll
            for (int i = 0; i < 8; ++i) v[i] = *(const f32x4*)(src + 256 * i + 4 * F.lane);
        } else if (isctx) {
#pragma unroll
            for (int i = 0; i < 8; ++i) v[i] = *(const f32x4*)(hc + 256 * i + 4 * F.lane);
        } else {
#pragma unroll
            for (int i = 0; i < 8; ++i) v[i] = ld_h4(hr + 256 * i + 4 * F.lane);
        }
#pragma unroll
        for (int i = 0; i < 8; ++i) s += (v[i][0] + v[i][1]) + (v[i][2] + v[i][3]);
        if (do_ln) {
            const float mean = wave_sum(s, F.lane) * (1.f / D); float s2 = 0.f;
#pragma unroll
            for (int i = 0; i < 8; ++i) { v[i] = v[i] - mean; s2 += (v[i][0] * v[i][0] + v[i][1] * v[i][1]) + (v[i][2] * v[i][2] + v[i][3] * v[i][3]); }
            const float rstd = 1.0f / sqrtf(wave_sum(s2, F.lane) * (1.f / D) + LN_EPS);
            if (!isctx && F.lane == 0) *(f32x2*)(ST + (size_t)row * 2) = (f32x2){mean, rstd};
#pragma unroll
            for (int i = 0; i < 8; ++i) { const f32x4 g = *(const f32x4*)(lng + 256 * i + 4 * F.lane), bb = *(const f32x4*)(lnb + 256 * i + 4 * F.lane); v[i] = v[i] * rstd * g + bb; if (isctx) *(f32x4*)(hc + 256 * i + 4 * F.lane) = v[i] * DN_ALPHA; }
        } else if (isctx) {
#pragma unroll
            for (int i = 0; i < 8; ++i) *(f32x4*)(hc + 256 * i + 4 * F.lane) = v[i] * DN_ALPHA;
        } else {
#pragma unroll
            for (int i = 0; i < 8; ++i) st_h4(hr + 256 * i + 4 * F.lane, v[i]);
            if (F.lane == 0) *(f32x2*)(ST + (size_t)row * 2) = (f32x2){0.f, 1.f};
        }
        if (modnext) {
            const float* sh = modnext + (size_t)mi * NMOD; const float* sc = sh + D;
#pragma unroll
            for (int i = 0; i < 8; ++i) { const f32x4 a = *(const f32x4*)(sh + 256 * i + 4 * F.lane), c = *(const f32x4*)(sc + 256 * i + 4 * F.lane); const f32x4 m = v[i] * (c + 1.0f) + a;
                u32x2 w; w.x = cvt_pk_bf16(m[0], m[1]); w.y = cvt_pk_bf16(m[2], m[3]); *(u32x2*)(HM + (size_t)row * D + 256 * i + 4 * F.lane) = w; }
        }
        if (out && !isctx) { float* orow = out + ((size_t)b * SEQ + (rr - CTX)) * D;
#pragma unroll
            for (int i = 0; i < 8; ++i) *(f32x4*)(orow + 256 * i + 4 * F.lane) = v[i]; }
    }
}

__device__ __forceinline__ void dt_tile(Frame& F, int l, int tile) {
    const bf16_t* A = (const bf16_t*)(F.ws + WS_HM) + (size_t)tile * 32 * D; const bf16_t* Bt = (const bf16_t*)(F.ws + WS_W + W_IN) + (size_t)13312 * D; float* DT = (float*)(F.ws + WS_DT);
    const int r = F.lane & 31, h = F.lane >> 5;
    f32x16 acc;
#pragma unroll
    for (int i = 0; i < 16; ++i) acc[i] = 0.f;
    const bf16_t* ap = A + (size_t)r * D + 8 * h; const bf16_t* bp = Bt + (size_t)r * D + 8 * h;
    for (int k0 = 0; k0 < 128; k0 += 16) {
        bf16x8 af[16], bfv[16];
#pragma unroll
        for (int e = 0; e < 16; ++e) { af[e] = *(const bf16x8*)(ap + 16 * (k0 + e)); bfv[e] = *(const bf16x8*)(bp + 16 * (k0 + e)); }
#pragma unroll
        for (int e = 0; e < 16; ++e) acc = __builtin_amdgcn_mfma_f32_32x32x16_bf16(af[e], bfv[e], acc, 0, 0, 0);
    }
    const float bias = INP(I_DTB)[l * 32 + r];
#pragma unroll
    for (int rg = 0; rg < 16; ++rg) { const int row = tile * 32 + (rg & 3) + 8 * (rg >> 2) + 4 * h; const float x = acc[rg] + bias; DT[(size_t)row * 32 + r] = fmaxf(x, 0.f) + log1pf(expf(-fabsf(x))); }
}
__device__ __forceinline__ void ssd_conv_pass(const Args& A_, Frame& F, int l) {
    const bf16_t* P = (const bf16_t*)(F.ws + WS_PROJ); bf16_t* XC = (bf16_t*)(F.ws + WS_HM);
    const float* cw = INP(I_CONVW) + (size_t)l * 5 * 2048; const float* cb = INP(I_CONVB) + (size_t)l * 2048;
    for (int it = F.gw; it < R * 4; it += F.NGW) {
        const int row = it >> 2, c0 = (it & 3) * 512 + F.lane * 8; const int rr = row % RB; const int lo = (rr < CTX) ? 0 : CTX, hi = (rr < CTX) ? CTX : RB;
        float acc[8];
#pragma unroll
        for (int e = 0; e < 8; ++e) acc[e] = cb[c0 + e];
#pragma unroll
        for (int k = 0; k < 5; ++k) { const int r2 = rr + k - 2;
            if (r2 >= lo && r2 < hi) { const u32x4 xv = *(const u32x4*)(P + (size_t)(row + k - 2) * LDP + PX + c0); const f32x4 w0 = *(const f32x4*)(cw + k * 2048 + c0), w1 = *(const f32x4*)(cw + k * 2048 + c0 + 4);
                acc[0] += w0[0] * bflo(xv.x); acc[1] += w0[1] * bfhi(xv.x); acc[2] += w0[2] * bflo(xv.y); acc[3] += w0[3] * bfhi(xv.y);
                acc[4] += w1[0] * bflo(xv.z); acc[5] += w1[1] * bfhi(xv.z); acc[6] += w1[2] * bflo(xv.w); acc[7] += w1[3] * bfhi(xv.w); } }
        u32x4 o; o.x = cvt_pk_bf16(siluf_(acc[0]), siluf_(acc[1])); o.y = cvt_pk_bf16(siluf_(acc[2]), siluf_(acc[3])); o.z = cvt_pk_bf16(siluf_(acc[4]), siluf_(acc[5])); o.w = cvt_pk_bf16(siluf_(acc[6]), siluf_(acc[7]));
        *(u32x4*)(XC + (size_t)row * 2048 + c0) = o;
    }
}
__device__ __forceinline__ int scan_row(int rb, int d, int step) { return d == 0 ? rb + step : (step < CTX ? rb + CTX - 1 - step : rb + (RB + CTX - 1) - step); }

__device__ __forceinline__ unsigned short bf16_1(float v) { return (unsigned short)(cvt_pk_bf16(v, 0.f) & 0xffffu); }
__device__ __forceinline__ void ssd_chain_fast(const Args& A_, Frame& F, int l, int cid) {
    constexpr int LS = 136;
    const int b = cid >> 6, d = (cid >> 5) & 1, hd = (cid >> 1) & 15, ph = cid & 1, g = hd >> 2; const int rb = b * RB;
    const bf16_t* XC = (const bf16_t*)(F.ws + WS_HM); const float* DT = (const float*)(F.ws + WS_DT); bf16_t* YD = (bf16_t*)(F.ws + WS_YD) + (size_t)d * R * 1024;
    const float a = -expf(INP(I_ALOG)[l * 32 + d * 16 + hd]);
    LAS bf16_t* Cs = (LAS bf16_t*)(F.lds); LAS bf16_t* Bs = Cs + 128 * LS; LAS bf16_t* Ms = Bs + 128 * LS; LAS bf16_t* XdT = Ms + 128 * LS; LAS bf16_t* Hb = XdT + 32 * LS;
    LAS float* csL = (LAS float*)(Hb + 32 * LS); LAS float* ecsL = csL + 128; LAS float* ewL = ecsL + 128; LAS float* misc = ewL + 128;
    const int tid = F.tid, lane = F.lane, w = F.wave, r = lane & 31, h = lane >> 5;
    f32x16 hacc;
#pragma unroll
    for (int i = 0; i < 16; ++i) hacc[i] = 0.f;
    for (int i = tid; i < 32 * LS / 2; i += 512) ((LAS unsigned*)Hb)[i] = 0u;
    u32x4 pc[4], pb[4], px; float pdt, pv0 = 0.f, pv1 = 0.f;
    const int rho0 = d ? 127 - lane : lane, rho1 = d ? 63 - lane : 64 + lane;
#define SSD_R0(k_) ((d == 0) ? rb + 128 * (k_) : ((k_) < 2 ? rb + 128 * (1 - (k_)) : rb + 256 + 128 * (33 - (k_))))
#define SSD_ISSUE(k_) do { const int r0n = SSD_R0(k_); \
        _Pragma("unroll") for (int i = 0; i < 4; ++i) { const int item = tid + 512 * i, row = item >> 4, seg = item & 15; const bf16_t* src = XC + (size_t)(r0n + row) * 2048 + g * 128 + seg * 8; pc[i] = *(const u32x4*)(src + 1536); pb[i] = *(const u32x4*)(src + 1024); } \
        { const int row = tid >> 2, seg = tid & 3; pdt = DT[(size_t)(r0n + row) * 32 + d * 16 + hd]; px = *(const u32x4*)(XC + (size_t)(r0n + row) * 2048 + hd * 64 + ph * 32 + seg * 8); } \
        if (w == 0) { pv0 = DT[(size_t)(r0n + rho0) * 32 + d * 16 + hd]; pv1 = DT[(size_t)(r0n + rho1) * 32 + d * 16 + hd]; } } while (0)
    SSD_ISSUE(0);
    for (int k = 0; k < 34; ++k) {
        const int r0 = SSD_R0(k);
        __syncthreads();
#pragma unroll
        for (int i = 0; i < 4; ++i) { const int item = tid + 512 * i, row = item >> 4, seg = item & 15; *(LAS u32x4*)(Cs + row * LS + seg * 8) = pc[i]; *(LAS u32x4*)(Bs + row * LS + seg * 8) = pb[i]; }
        { const int row = tid >> 2, seg = tid & 3; const float dtv = pdt; const u32x4 xv = px;
            LAS bf16_t* xo = XdT + (seg * 8) * LS + row;
            xo[0 * LS] = bf16_1(bflo(xv.x) * dtv); xo[1 * LS] = bf16_1(bfhi(xv.x) * dtv); xo[2 * LS] = bf16_1(bflo(xv.y) * dtv); xo[3 * LS] = bf16_1(bfhi(xv.y) * dtv);
            xo[4 * LS] = bf16_1(bflo(xv.z) * dtv); xo[5 * LS] = bf16_1(bfhi(xv.z) * dtv); xo[6 * LS] = bf16_1(bflo(xv.w) * dtv); xo[7 * LS] = bf16_1(bfhi(xv.w) * dtv); }
        if (w == 0) {
            float v0 = pv0 * a, v1 = pv1 * a;
#pragma unroll
            for (int o = 1; o < 64; o <<= 1) { const float t0 = __int_as_float(__builtin_amdgcn_ds_bpermute((lane - o) << 2, __float_as_int(v0))), t1 = __int_as_float(__builtin_amdgcn_ds_bpermute((lane - o) << 2, __float_as_int(v1))); if (lane >= o) { v0 += t0; v1 += t1; } }
            const float tot0 = __int_as_float(__builtin_amdgcn_ds_bpermute(63 << 2, __float_as_int(v0))); v1 += tot0;
            const float cend = __int_as_float(__builtin_amdgcn_ds_bpermute(63 << 2, __float_as_int(v1)));
            csL[rho0] = v0; csL[rho1] = v1; ecsL[rho0] = __builtin_amdgcn_exp2f(v0 * 1.4426950408889634f); ecsL[rho1] = __builtin_amdgcn_exp2f(v1 * 1.4426950408889634f);
            ewL[rho0] = __builtin_amdgcn_exp2f((cend - v0) * 1.4426950408889634f); ewL[rho1] = __builtin_amdgcn_exp2f((cend - v1) * 1.4426950408889634f);
            if (lane == 0) misc[0] = __builtin_amdgcn_exp2f(cend * 1.4426950408889634f);
        }
        if (k + 1 < 34) SSD_ISSUE(k + 1);
        __syncthreads();
        { const int lt = w >> 1;
#pragma unroll
          for (int q = 0; q < 2; ++q) { const int st = (w & 1) * 2 + q; const bool zero = (d == 0) ? (st > lt) : (st < lt);
            f32x16 acc;
#pragma unroll
            for (int i = 0; i < 16; ++i) acc[i] = 0.f;
            if (!zero) {
#pragma unroll
                for (int ks = 0; ks < 8; ++ks) { const bf16x8 af = *(const LAS bf16x8*)(Cs + (32 * lt + r) * LS + 16 * ks + 8 * h), bfv = *(const LAS bf16x8*)(Bs + (32 * st + r) * LS + 16 * ks + 8 * h);
                    acc = __builtin_amdgcn_mfma_f32_32x32x16_bf16(af, bfv, acc, 0, 0, 0); } }
            const int scol = 32 * st + r; const float css = csL[scol];
#pragma unroll
            for (int rg = 0; rg < 16; ++rg) { const int lrow = 32 * lt + (rg & 3) + 8 * (rg >> 2) + 4 * h; const bool valid = (d == 0) ? (scol <= lrow) : (scol >= lrow);
                const float v = valid ? acc[rg] * __builtin_amdgcn_exp2f((csL[lrow] - css) * 1.4426950408889634f) : 0.f; Ms[lrow * LS + scol] = bf16_1(v); } } }
        __syncthreads();
        if (w < 4) { const int lt = w;
            f32x16 acc;
#pragma unroll
            for (int i = 0; i < 16; ++i) acc[i] = 0.f;
#pragma unroll
            for (int ks = 0; ks < 8; ++ks) { const bf16x8 af = *(const LAS bf16x8*)(Cs + (32 * lt + r) * LS + 16 * ks + 8 * h), bfv = *(const LAS bf16x8*)(Hb + r * LS + 16 * ks + 8 * h);
                acc = __builtin_amdgcn_mfma_f32_32x32x16_bf16(af, bfv, acc, 0, 0, 0); }
#pragma unroll
            for (int rg = 0; rg < 16; ++rg) acc[rg] *= ecsL[32 * lt + (rg & 3) + 8 * (rg >> 2) + 4 * h];
#pragma unroll
            for (int ks = 0; ks < 8; ++ks) { const bool skip = (d == 0) ? (16 * ks >= 32 * (lt + 1)) : (16 * ks + 15 < 32 * lt);
                if (!skip) { const bf16x8 af = *(const LAS bf16x8*)(Ms + (32 * lt + r) * LS + 16 * ks + 8 * h), bfv = *(const LAS bf16x8*)(XdT + r * LS + 16 * ks + 8 * h);
                    acc = __builtin_amdgcn_mfma_f32_32x32x16_bf16(af, bfv, acc, 0, 0, 0); } }
            bf16_t* yo = YD + (size_t)(r0 + 32 * lt + 4 * h) * 1024 + hd * 64 + ph * 32 + r;
#pragma unroll
            for (int rg = 0; rg < 16; ++rg) yo[(size_t)((rg & 3) + 8 * (rg >> 2)) * 1024] = bf16_1(acc[rg]);
        } else { const int nt = w - 4; const float eend = misc[0];
#pragma unroll
            for (int i = 0; i < 16; ++i) hacc[i] *= eend;
#pragma unroll
            for (int ks = 0; ks < 8; ++ks) { const int k0 = 16 * ks + 8 * h; const u32x4 xa = *(const LAS u32x4*)(XdT + r * LS + k0); const f32x4 e0 = *(const LAS f32x4*)(ewL + k0), e1 = *(const LAS f32x4*)(ewL + k0 + 4);
                u32x4 aw; aw.x = cvt_pk_bf16(bflo(xa.x) * e0[0], bfhi(xa.x) * e0[1]); aw.y = cvt_pk_bf16(bflo(xa.y) * e0[2], bfhi(xa.y) * e0[3]); aw.z = cvt_pk_bf16(bflo(xa.z) * e1[0], bfhi(xa.z) * e1[1]); aw.w = cvt_pk_bf16(bflo(xa.w) * e1[2], bfhi(xa.w) * e1[3]);
                const LAS bf16_t* bp = Bs + k0 * LS + 32 * nt + r; u32x4 bw;
                bw.x = (unsigned)bp[0 * LS] | ((unsigned)bp[1 * LS] << 16); bw.y = (unsigned)bp[2 * LS] | ((unsigned)bp[3 * LS] << 16); bw.z = (unsigned)bp[4 * LS] | ((unsigned)bp[5 * LS] << 16); bw.w = (unsigned)bp[6 * LS] | ((unsigned)bp[7 * LS] << 16);
                hacc = __builtin_amdgcn_mfma_f32_32x32x16_bf16(__builtin_bit_cast(bf16x8, aw), __builtin_bit_cast(bf16x8, bw), hacc, 0, 0, 0); }
        }
        __syncthreads();
        if (w >= 4) { const int nt = w - 4;
#pragma unroll
            for (int rg = 0; rg < 16; ++rg) Hb[((rg & 3) + 8 * (rg >> 2) + 4 * h) * LS + 32 * nt + r] = bf16_1(hacc[rg]); }
    }
    __syncthreads();
#undef SSD_R0
#undef SSD_ISSUE
}
__device__ __forceinline__ void s5_setup(const Args& A_, Frame& F, int l) {
    LAS float* Pre = (LAS float*)(F.lds); LAS float* Pim = Pre + 2 * 17 * 64; LAS float* BBr = Pim + 2 * 17 * 64; LAS float* BBi = BBr + 2 * 64 * 16; LAS float* Kt = BBi + 2 * 64 * 16;
    bf16_t* Bt1 = (bf16_t*)(F.ws + WS_S5M); bf16_t* Bt2 = Bt1 + (size_t)64 * 512 * 256; float* A16 = (float*)(F.ws + WS_S5A);
    const int tid = F.tid;
    for (int g = blockIdx.x; g < 64; g += F.G) {
        if (tid < 128) { const int d = tid >> 6, n = tid & 63; const int pg_ = (l * 2 + d) * 64 + g;
            const float lre = INP(I_LRE)[pg_ * 64 + n], lim = INP(I_LIM)[pg_ * 64 + n], step = expf(INP(I_LSTEP)[pg_]);
            for (int dl = 0; dl <= 16; ++dl) { const float mag = expf(lre * step * (float)dl), ang = lim * step * (float)dl; Pre[(d * 17 + dl) * 64 + n] = mag * cosf(ang); Pim[(d * 17 + dl) * 64 + n] = mag * sinf(ang); }
            const float abr = Pre[(d * 17 + 1) * 64 + n], abi = Pim[(d * 17 + 1) * 64 + n];
            const float den = lre * lre + lim * lim; const float kre = ((abr - 1.f) * lre + abi * lim) / den, kim = (abi * lre - (abr - 1.f) * lim) / den;
            const float* br = INP(I_BRE) + ((size_t)pg_ * 64 + n) * 16; const float* bi = INP(I_BIM) + ((size_t)pg_ * 64 + n) * 16;
            for (int i = 0; i < 16; ++i) { const float x = br[i], y = bi[i]; BBr[(d * 64 + n) * 16 + i] = kre * x - kim * y; BBi[(d * 64 + n) * 16 + i] = kre * y + kim * x; }
            A16[((d * 64 + g) * 64 + n) * 2] = Pre[(d * 17 + 16) * 64 + n]; A16[((d * 64 + g) * 64 + n) * 2 + 1] = Pim[(d * 17 + 16) * 64 + n]; }
        __syncthreads();
        for (int q = 0; q < 16; ++q) { const int idx = tid + 512 * q; const int d = idx >> 12, dl = (idx >> 8) & 15, o = (idx >> 4) & 15, i = idx & 15; const int pg_ = (l * 2 + d) * 64 + g;
            const float* cr = INP(I_CRE) + ((size_t)pg_ * 16 + o) * 64; const float* ci = INP(I_CIM) + ((size_t)pg_ * 16 + o) * 64; float acc = 0.f;
            for (int n = 0; n < 64; ++n) { const float pr = Pre[(d * 17 + dl) * 64 + n], pi = Pim[(d * 17 + dl) * 64 + n], br = BBr[(d * 64 + n) * 16 + i], bi = BBi[(d * 64 + n) * 16 + i];
                acc += cr[n] * (pr * br - pi * bi) - ci[n] * (pr * bi + pi * br); }
            Kt[idx] = acc; }
        __syncthreads();
        for (int q = 0; q < 16; ++q) { const int item = tid + 512 * q; const int c1 = item >> 5, kb = (item & 31) * 8; const int rin = kb >> 4, i0 = kb & 15, rout = c1 >> 4, o = c1 & 15;
            float v[8];
#pragma unroll
            for (int e = 0; e < 8; ++e) { const int i = i0 + e; float x = 0.f; if (rout >= rin) x += Kt[((0 * 16 + (rout - rin)) * 16 + o) * 16 + i]; if (rin >= rout) x += Kt[((1 * 16 + (rin - rout)) * 16 + o) * 16 + i];
                if (rin == rout && i == o) x += INP(I_S5D)[l * 1024 + 16 * g + i]; v[e] = x; }
            u32x4 w; w.x = cvt_pk_bf16(v[0], v[1]); w.y = cvt_pk_bf16(v[2], v[3]); w.z = cvt_pk_bf16(v[4], v[5]); w.w = cvt_pk_bf16(v[6], v[7]);
            *(u32x4*)(Bt1 + ((size_t)g * 512 + c1) * 256 + kb) = w; }
        for (int q = 0; q < 16; ++q) { const int item = tid + 512 * q; const int c1 = item >> 5, kb = (item & 31) * 8; const int rin = kb >> 4, i0 = kb & 15; const int d = c1 >> 7, part = (c1 >> 6) & 1, n = c1 & 63;
            const int ex = (d == 0) ? 15 - rin : rin; const float pr = Pre[(d * 17 + ex) * 64 + n], pi = Pim[(d * 17 + ex) * 64 + n];
            float v[8];
#pragma unroll
            for (int e = 0; e < 8; ++e) { const float br = BBr[(d * 64 + n) * 16 + i0 + e], bi = BBi[(d * 64 + n) * 16 + i0 + e]; v[e] = part ? (pr * bi + pi * br) : (pr * br - pi * bi); }
            u32x4 w; w.x = cvt_pk_bf16(v[0], v[1]); w.y = cvt_pk_bf16(v[2], v[3]); w.z = cvt_pk_bf16(v[4], v[5]); w.w = cvt_pk_bf16(v[6], v[7]);
            *(u32x4*)(Bt1 + ((size_t)g * 512 + 256 + c1) * 256 + kb) = w; }
        for (int q = 0; q < 16; ++q) { const int item = tid + 512 * q; const int c2 = item >> 5, kb = (item & 31) * 8; const int rout = c2 >> 4, o = c2 & 15; const int d = kb >> 7, part = (kb >> 6) & 1, n0 = kb & 63; const int pg_ = (l * 2 + d) * 64 + g;
            const int ex = (d == 0) ? rout + 1 : 16 - rout; const float* cr = INP(I_CRE) + ((size_t)pg_ * 16 + o) * 64 + n0; const float* ci = INP(I_CIM) + ((size_t)pg_ * 16 + o) * 64 + n0;
            float v[8];
#pragma unroll
            for (int e = 0; e < 8; ++e) { const float pr = Pre[(d * 17 + ex) * 64 + n0 + e], pi = Pim[(d * 17 + ex) * 64 + n0 + e]; v[e] = part ? -(cr[e] * pi + ci[e] * pr) : (cr[e] * pr - ci[e] * pi); }
            u32x4 w; w.x = cvt_pk_bf16(v[0], v[1]); w.y = cvt_pk_bf16(v[2], v[3]); w.z = cvt_pk_bf16(v[4], v[5]); w.w = cvt_pk_bf16(v[6], v[7]);
            *(u32x4*)(Bt2 + ((size_t)g * 256 + c2) * 256 + kb) = w; }
        __syncthreads();
    }
}
__device__ __forceinline__ void s5_carry(Frame& F, int cid) {
    const int b = cid >> 7, d = (cid >> 6) & 1, g = cid & 63, n = F.lane;
    const float* ST = (const float*)(F.ws + WS_S5ST) + ((size_t)g * S5M + b * 272) * 256 + d * 128 + n; bf16_t* HP = (bf16_t*)(F.ws + WS_S5H) + ((size_t)g * 1280 + b * 272) * 256 + d * 128 + n;
    const float* A16 = (const float*)(F.ws + WS_S5A); const float ar = A16[((d * 64 + g) * 64 + n) * 2], ai = A16[((d * 64 + g) * 64 + n) * 2 + 1];
    float hr = 0.f, hi_ = 0.f;
    for (int k0 = 0; k0 < 272; k0 += 34) {
        float sr[34], si[34]; int cc[34];
#pragma unroll
        for (int e = 0; e < 34; ++e) { const int k = k0 + e; cc[e] = (d == 0) ? k : (k < 16 ? 15 - k : 287 - k); sr[e] = ST[(size_t)cc[e] * 256]; si[e] = ST[(size_t)cc[e] * 256 + 64]; }
#pragma unroll
        for (int e = 0; e < 34; ++e) { HP[(size_t)cc[e] * 256] = (bf16_t)(cvt_pk_bf16(hr, 0.f) & 0xffffu); HP[(size_t)cc[e] * 256 + 64] = (bf16_t)(cvt_pk_bf16(hi_, 0.f) & 0xffffu);
            const float nr = ar * hr - ai * hi_ + sr[e], ni = ar * hi_ + ai * hr + si[e]; hr = nr; hi_ = ni; }
    }
}
__device__ __forceinline__ void mixer_finalize(const Args& A_, Frame& F, int l) {
    bf16_t* P = (bf16_t*)(F.ws + WS_PROJ); const bf16_t* O0 = (const bf16_t*)(F.ws + WS_O); const bf16_t* O1 = O0 + (size_t)R * 1024;
    const bf16_t* XC = (const bf16_t*)(F.ws + WS_HM); const bf16_t* YD0 = (const bf16_t*)(F.ws + WS_YD); const bf16_t* YD1 = YD0 + (size_t)R * 1024;
        const float lam_init = 0.8f - 0.6f * expf(-0.3f * (float)l);
    const float* lv = INP(I_ALAM) + l * 256;
    const float s01 = wave_sum(lv[F.lane] * lv[64 + F.lane], F.lane), s23 = wave_sum(lv[128 + F.lane] * lv[192 + F.lane], F.lane);
    const float lam = expf(s01) - expf(s23) + lam_init;
    const int c0 = F.lane * 16;
    for (int row = F.gw; row < R; row += F.NGW) {
        { const u32x4 a0 = *(const u32x4*)(O0 + (size_t)row * 1024 + c0), a1 = *(const u32x4*)(O0 + (size_t)row * 1024 + c0 + 8);
          const u32x4 b0 = *(const u32x4*)(O1 + (size_t)row * 1024 + c0), b1 = *(const u32x4*)(O1 + (size_t)row * 1024 + c0 + 8);
          float v[16];
#define DIF(i, wa, wb) v[2 * (i)] = bflo(wa) - lam * bflo(wb); v[2 * (i) + 1] = bfhi(wa) - lam * bfhi(wb);
          DIF(0, a0.x, b0.x) DIF(1, a0.y, b0.y) DIF(2, a0.z, b0.z) DIF(3, a0.w, b0.w) DIF(4, a1.x, b1.x) DIF(5, a1.y, b1.y) DIF(6, a1.z, b1.z) DIF(7, a1.w, b1.w)
#undef DIF
          float ss = 0.f;
#pragma unroll
          for (int e = 0; e < 16; ++e) ss += v[e] * v[e];
          ss += shx(ss, 1, F.lane); ss += shx(ss, 2, F.lane); ss += shx(ss, 4, F.lane);
          const float rs = (1.0f / sqrtf(ss * (1.f / 128.f) + RMS_EPS)) * (1.0f - lam_init);
          const float* sw = INP(I_ASUB) + l * 128 + (c0 & 127);
          u32x4 o0, o1;
          o0.x = cvt_pk_bf16(v[0] * rs * sw[0], v[1] * rs * sw[1]); o0.y = cvt_pk_bf16(v[2] * rs * sw[2], v[3] * rs * sw[3]); o0.z = cvt_pk_bf16(v[4] * rs * sw[4], v[5] * rs * sw[5]); o0.w = cvt_pk_bf16(v[6] * rs * sw[6], v[7] * rs * sw[7]);
          o1.x = cvt_pk_bf16(v[8] * rs * sw[8], v[9] * rs * sw[9]); o1.y = cvt_pk_bf16(v[10] * rs * sw[10], v[11] * rs * sw[11]); o1.z = cvt_pk_bf16(v[12] * rs * sw[12], v[13] * rs * sw[13]); o1.w = cvt_pk_bf16(v[14] * rs * sw[14], v[15] * rs * sw[15]);
          *(u32x4*)(P + (size_t)row * LDP + PQ + c0) = o0; *(u32x4*)(P + (size_t)row * LDP + PQ + c0 + 8) = o1; }
        { const float dsk = INP(I_SSDD)[l * 16 + (c0 >> 6)];
          float v[16];
#pragma unroll
          for (int hh = 0; hh < 2; ++hh) { const u32x4 x = *(const u32x4*)(XC + (size_t)row * 2048 + c0 + 8 * hh), y0 = *(const u32x4*)(YD0 + (size_t)row * 1024 + c0 + 8 * hh), y1 = *(const u32x4*)(YD1 + (size_t)row * 1024 + c0 + 8 * hh), z = *(const u32x4*)(P + (size_t)row * LDP + PZ + c0 + 8 * hh);
#define SG(i, wx, wy0, wy1, wz) v[8 * hh + 2 * (i)] = (bflo(wx) * dsk + bflo(wy0) + bflo(wy1)) * bflo(wz); v[8 * hh + 2 * (i) + 1] = (bfhi(wx) * dsk + bfhi(wy0) + bfhi(wy1)) * bfhi(wz);
              SG(0, x.x, y0.x, y1.x, z.x) SG(1, x.y, y0.y, y1.y, z.y) SG(2, x.z, y0.z, y1.z, z.z) SG(3, x.w, y0.w, y1.w, z.w)
#undef SG
          }
          float ss = 0.f;
#pragma unroll
          for (int e = 0; e < 16; ++e) ss += v[e] * v[e];
          ss += shx(ss, 1, F.lane); ss += shx(ss, 2, F.lane); ss += shx(ss, 4, F.lane); ss += shx(ss, 8, F.lane);
          const float rs = 1.0f / sqrtf(ss * (1.f / 256.f) + RMS_EPS);
          const float* nw = INP(I_SSDN) + l * 1024 + c0;
          u32x4 o0, o1;
          o0.x = cvt_pk_bf16(v[0] * rs * nw[0], v[1] * rs * nw[1]); o0.y = cvt_pk_bf16(v[2] * rs * nw[2], v[3] * rs * nw[3]); o0.z = cvt_pk_bf16(v[4] * rs * nw[4], v[5] * rs * nw[5]); o0.w = cvt_pk_bf16(v[6] * rs * nw[6], v[7] * rs * nw[7]);
          o1.x = cvt_pk_bf16(v[8] * rs * nw[8], v[9] * rs * nw[9]); o1.y = cvt_pk_bf16(v[10] * rs * nw[10], v[11] * rs * nw[11]); o1.z = cvt_pk_bf16(v[12] * rs * nw[12], v[13] * rs * nw[13]); o1.w = cvt_pk_bf16(v[14] * rs * nw[14], v[15] * rs * nw[15]);
          *(u32x4*)(P + (size_t)row * LDP + PV + c0) = o0; *(u32x4*)(P + (size_t)row * LDP + PV + c0 + 8) = o1; }
    }
}


__global__ void __launch_bounds__(NWAVES * 64, 2) trunk_fwd(Args args) {
    extern __shared__ __attribute__((aligned(16))) unsigned char lds_raw[];
    Frame F;
    F.lds = (LAS unsigned char*)lds_raw;
    F.tid = threadIdx.x; F.lane = F.tid & 63; F.wave = __builtin_amdgcn_readfirstlane(F.tid >> 6);
    F.G = gridDim.x; { const int bx = blockIdx.x; F.vcu = (F.G % 8 == 0) ? (bx % 8) * (F.G / 8) + bx / 8 : bx; }
    F.gw = F.vcu * NWAVES + F.wave; F.NGW = F.G * NWAVES;
    F.ws = args.ws;
    volatile LAS unsigned* MISC = (volatile LAS unsigned*)(F.lds + MISC_OFF);
    for (int u = F.tid; u < (LDS_BYTES - LDSCTL_OFF) / 4; u += NWAVES * 64) ((LAS unsigned*)(F.lds + LDSCTL_OFF))[u] = 0u;
    __syncthreads();
    if (threadIdx.x < 32) ((LAS unsigned long long*)(F.lds + INTAB_OFF))[threadIdx.x] = (unsigned long long)args.in[threadIdx.x];
    __syncthreads();
    (void)xcd_barrier_post((unsigned*)(args.ws + WS_CTL) + CW_BAR, MISC + 8);
    const int lo = args.ph_lo, hi = args.ph_hi;
    const int wave0 = __builtin_amdgcn_readfirstlane((int)threadIdx.x >> 6);
    int pid = 0;
#define PH_BEGIN if (pid >= lo && pid < hi) { GAS unsigned char* wsg_ = (GAS unsigned char*)args.ws; int tid_; asm volatile("v_mbcnt_lo_u32_b32 %1, -1, 0\n\tv_mbcnt_hi_u32_b32 %1, -1, %1 ; PHASE_MARK_BEGIN %2" : "+s"(wsg_), "=v"(tid_) : "i"(__LINE__) : "memory"); tid_ += wave0 * 64; unsigned char* ws = (unsigned char*)wsg_; F.ws = ws; F.tid = tid_; F.lane = tid_ & 63; F.wave = __builtin_amdgcn_readfirstlane(tid_ >> 6); F.gw = F.vcu * NWAVES + F.wave;
#define PH_END   asm volatile("; PHASE_MARK_END %0" :: "i"(__LINE__)); if (pid + 1 < hi) { XcdBarrier bar_; bar_.bar = (unsigned*)(args.ws + WS_CTL) + CW_BAR; bar_.x = xb_xcc_id(); bar_.st = (volatile LAS unsigned*)(F.lds + MISC_OFF) + 8; xcd_barrier(bar_, wave0 * 64 + lane_now()); } } ++pid;

#define MOD ((float*)(ws + WS_MOD))
#define Hbuf ((float*)(ws + WS_H))
#define HM ((bf16_t*)(ws + WS_HM))
#define PROJ ((bf16_t*)(ws + WS_PROJ))
#define ROPEC ((float*)(ws + WS_ROPE))
#define ROPES (ROPEC + 1024)
#define WGT (ws + WS_W)

    PH_BEGIN
        s5_setup(args, F, 0);
        mod_partials(args, F);
        if (F.gw == 1) { float* idn = (float*)(ws + WS_IDENT); for (int i = F.lane; i < 2048; i += 64) { idn[i] = 1.0f; idn[2048 + i] = 0.0f; } }
        if (F.gw == 0) {
#pragma unroll
            for (int i = 0; i < 16; ++i) { const int idx = i * 64 + F.lane, pos = idx >> 4, f = idx & 15; const float inv = powf(10000.0f, -(float)f / 16.0f); const float ang = (float)pos * inv; ROPEC[idx] = cosf(ang); ROPES[idx] = sinf(ang); } }
    PH_END
    PH_BEGIN
        convert_layer_weights(args, F, 0);
        ln_pass(F, false, nullptr, nullptr, MOD, nullptr, INP(I_X), INP(I_CTX));
    PH_END

    for (int s = 0; s < 6; ++s) {
        const int l = s / 3, j = s - 3 * l;
        if (j != 1) {
            const int f = j >> 1;
            PH_BEGIN
                const int lat = (l == 1 && j == 2); pg8::Gemm g{D, D, D}; pg8::StaticOrder S; S.init(lat ? 64 : NPAN, N13 / 256, F.G, (int)blockIdx.x, HM, D, (const bf16_t*)(WGT + W_13) + (size_t)f * N13 * D, D, D, lat);
                EpiSwiGLU E{PROJ};
                pg8::gemm_phase<EpiSwiGLU, pg8::StaticOrder>(F.lds + RING_OFF, g, S, E, F.tid);
            PH_END
        } else {
            PH_BEGIN
                pg8::Gemm g{D, D, D}; pg8::StaticOrder S; S.init(NPAN, LDP / 256, F.G, (int)blockIdx.x, HM, D, (const bf16_t*)(WGT + W_IN), D, D);
                EpiProj E{PROJ, (float*)(ws + WS_DT), ROPEC, ROPES};
                pg8::gemm_phase<EpiProj, pg8::StaticOrder>(F.lds + RING_OFF, g, S, E, F.tid);
                { const int nfull = (NPAN * (LDP / 256)) % F.G;
                  if ((int)blockIdx.x >= nfull) { const int nw = (F.G - nfull) * NWAVES; for (int t = ((int)blockIdx.x - nfull) * NWAVES + F.wave; t < R / 32; t += nw) dt_tile(F, l, t); } }
            PH_END
            PH_BEGIN
                ssd_conv_pass(args, F, l);
                { pg8::Gemm g{0, 256, 256}; S5AOrder S{F.G, (int)blockIdx.x, (const char*)(PROJ + PU), (const char*)(ws + WS_S5M)};
                  EpiS5A E{(bf16_t*)(ws + WS_YS), (float*)(ws + WS_S5ST)};
                  pg8::gemm_phase<EpiS5A, S5AOrder, 1>(F.lds + RING_OFF, g, S, E, F.tid); }
            PH_END
            PH_BEGIN
                if (F.wave < 2) s5_carry(F, (int)blockIdx.x * 2 + F.wave);
                ssd_chain_fast(args, F, l, (int)blockIdx.x);
                {
                    bf16_t* Obuf = (bf16_t*)(ws + WS_O);
                    for (int i = 0;; ++i) { const int idx = i * F.G + F.vcu; if (idx >= 1024 + (l == 0 ? 64 : 0)) break;
                        int b, hh, q0, seq;
                        if (idx < 1024) { b = idx >> 8; hh = (idx >> 4) & 15; q0 = b * RB + CTX + (idx & 15) * 256; seq = RB; }
                        else { const int k = idx - 1024; b = k >> 4; hh = k & 15; q0 = b * RB; seq = CTX; }
                        const bf16_t* Q0 = PROJ + (size_t)q0 * LDP + PQ + hh * 64; const bf16_t* Kh = PROJ + (size_t)(b * RB) * LDP + PK + hh * 64; const bf16_t* Vh = PROJ + (size_t)(b * RB) * LDP + PV + (hh >> 1) * 128;
                        bf16_t* O0 = Obuf + (size_t)(hh & 1) * R * 1024 + (size_t)q0 * 1024 + (hh >> 1) * 128;
                        attn128::unit((const attn128::bf16*)Q0, (const attn128::bf16*)Kh, (const attn128::bf16*)Vh, O0, seq, (char*)lds_raw + RING_OFF, F.tid);
                    }
                }
            PH_END
            PH_BEGIN
                mixer_finalize(args, F, l);
                { pg8::Gemm g{256, 256, 256}; S5COrder S{F.G, (int)blockIdx.x, (const char*)(ws + WS_S5H), (const char*)((bf16_t*)(ws + WS_S5M) + (size_t)64 * 512 * 256)};
                  EpiS5C E{(const bf16_t*)(ws + WS_YS), PROJ};
                  pg8::gemm_phase<EpiS5C, S5COrder>(F.lds + RING_OFF, g, S, E, F.tid); }
            PH_END
            PH_BEGIN
                pg8::Gemm g{LDP, 1024, 1024}; pg8::StaticOrder S; S.init(l == 1 ? 64 : NPAN, 4, F.G, (int)blockIdx.x, PROJ + PU, LDP, (const bf16_t*)(WGT + W_GLU), 1024, 1024, l == 1);
                EpiGlu E{PROJ, INP(I_GLUB) + l * 1024};
                pg8::gemm_phase<EpiGlu, pg8::StaticOrder>(F.lds + RING_OFF, g, S, E, F.tid);
            PH_END
            PH_BEGIN
                pg8::Gemm g{LDP, 3072, 3072}; pg8::StaticOrder S; S.init(l == 1 ? 64 : NPAN, 8, F.G, (int)blockIdx.x, PROJ, LDP, (const bf16_t*)(WGT + W_B), 3072, 3072, l == 1);
                EpiMerge E{PROJ, HM};
                pg8::gemm_phase<EpiMerge, pg8::StaticOrder, 0, true>(F.lds + RING_OFF, g, S, E, F.tid);
            PH_END
        }
        PH_BEGIN
            const int RK = (j == 1) ? D : DFF; const bf16_t* RA = (j == 1) ? HM : PROJ; const bf16_t* RBt = (j == 1) ? (const bf16_t*)(WGT + W_O) : (const bf16_t*)(WGT + W_2) + (size_t)(j >> 1) * D * DFF;
            const int lat = (l == 1 && j >= 1); pg8::Gemm g{RK, RK, RK}; pg8::StaticOrder S; S.init(64, D / 256, F.G, (int)blockIdx.x, RA, RK, RBt, RK, RK, 1, lat ? 0 : 128);
            const float* lg_ = (s == 0) ? (const float*)(ws + WS_IDENT) : INP(I_LNG) + (size_t)(s - 1) * D; const float* lb_ = (s == 0) ? (const float*)(ws + WS_IDENT) + 2048 : INP(I_LNB) + (size_t)(s - 1) * D;
            EpiResid E{(_Float16*)(ws + WS_H), (float*)(ws + WS_HC), MOD + (size_t)l * 5 * NMOD + (3 * j + 2) * D, lg_, lb_, (const float*)(ws + WS_STATS)};
            pg8::gemm_phase<EpiResid, pg8::StaticOrder>(F.lds + RING_OFF, g, S, E, F.tid);
        PH_END
        PH_BEGIN
            const bool fin = (s == 5);
            const int ln_ = (j == 2) ? l + 1 : l, jn = (j == 2) ? 0 : j + 1;
            ln_pass(F, true, INP(I_LNG) + (size_t)(l * 3 + j) * D, INP(I_LNB) + (size_t)(l * 3 + j) * D, fin ? nullptr : MOD + (size_t)ln_ * 5 * NMOD + 3 * jn * D, fin ? args.out : nullptr);
            if (s == 2) { s5_setup(args, F, 1); __syncthreads(); convert_layer_weights(args, F, 1); }
        PH_END
    }
#undef PH_BEGIN
#undef PH_END
}

static int count_phases() { int n = 2; for (int s = 0; s < 6; ++s) n += ((s % 3) != 1 ? 1 : 6) + 2; return n; }
extern "C" void kernel_launch(void* const* d_in, const int* in_sizes, int n_in, void* d_out, int out_size, void* d_ws, size_t ws_size, hipStream_t stream) {
    static int grid = 0;
    if (grid == 0) {
        if (n_in != 32 || out_size != NB * SEQ * D || ws_size < WS_END) { fprintf(stderr, "kernel_launch: unexpected shapes (n_in %d, out %d, ws %zu < %zu)\n", n_in, out_size, ws_size, (size_t)WS_END); grid = -1; return; }
        int dev = 0, cus = 0, per_cu = 0;
        if (hipGetDevice(&dev) != hipSuccess || hipDeviceGetAttribute(&cus, hipDeviceAttributeMultiprocessorCount, dev) != hipSuccess) { grid = -1; return; }
        if (hipFuncSetAttribute((const void*)trunk_fwd, hipFuncAttributeMaxDynamicSharedMemorySize, LDS_BYTES) != hipSuccess) { fprintf(stderr, "kernel_launch: hipFuncSetAttribute failed\n"); grid = -1; return; }
        if (hipOccupancyMaxActiveBlocksPerMultiprocessor(&per_cu, (const void*)trunk_fwd, NWAVES * 64, LDS_BYTES) != hipSuccess || per_cu < 1) fprintf(stderr, "kernel_launch: occupancy query says %d\n", per_cu);
        (void)hipGetLastError();
        grid = cus;
    }
    if (grid < 0) return;
    (void)in_sizes;
    if (hipMemsetAsync((char*)d_ws + WS_CTL, 0, 2 * MiB  , stream) != hipSuccess) return;
    Args a{};
    for (int i = 0; i < 32; ++i) a.in[i] = (const float*)d_in[i];
    a.out = (float*)d_out; a.ws = (unsigned char*)d_ws;
    const int nph = count_phases();
#if MK_PER_PHASE
    for (int p = 0; p < nph; ++p) { a.ph_lo = p; a.ph_hi = p + 1; hipLaunchKernelGGL(trunk_fwd, dim3(grid), dim3(NWAVES * 64), LDS_BYTES, stream, a); }
#else
    a.ph_lo = 0; a.ph_hi = nph;
    hipLaunchKernelGGL(trunk_fwd, dim3(grid), dim3(NWAVES * 64), LDS_BYTES, stream, a);
#endif
    const hipError_t le = hipPeekAtLastError();
    if (le != hipSuccess) fprintf(stderr, "kernel_launch: launch failed: %s\n", hipGetErrorName(le));
}
```

```cpp
#include <hip/hip_runtime.h>
#include <hip/hip_bf16.h>
#include <cstdio>
#include <cstdint>
#include <cmath>

#ifndef MK_PER_PHASE
#define MK_PER_PHASE 0
#endif

#define LAS __attribute__((address_space(3)))
#define GAS __attribute__((address_space(1)))
typedef unsigned short bf16_t;
typedef short bf16x8 __attribute__((ext_vector_type(8)));
typedef float f32x4 __attribute__((ext_vector_type(4)));
typedef float f32x2 __attribute__((ext_vector_type(2)));
typedef float f32x16 __attribute__((ext_vector_type(16)));
typedef unsigned u32x4 __attribute__((ext_vector_type(4)));
typedef unsigned u32x2 __attribute__((ext_vector_type(2)));
typedef short s16x4 __attribute__((ext_vector_type(4)));

constexpr int NB = 4, SEQ = 4096, CTX = 256, RB = SEQ + CTX  , R = NB * RB  , NPAN = R / 256  , PPB = RB / 256  ;
constexpr int D = 2048, DFF = 5632, N13 = 2 * DFF, NMOD = 9 * D  ;
constexpr int LDP = 13312;
constexpr int NIN = 13568;
constexpr int PQ = 0, PK = 1024, PV = 2048, PZ = 3072, PX = 4096, PU = 6144, PG = 7168;
constexpr float DN_ALPHA = 1.41421356237309515f;
constexpr float LN_EPS = 1e-5f, RMS_EPS = 1e-6f;
constexpr float QSCALE = 0.125f * 1.4426950408889634f;

constexpr size_t MiB = 1u << 20;
constexpr size_t WS_CTL = 0, CTL_ZERO_BYTES = 1 * MiB;
constexpr size_t WS_MOD = 1 * MiB;
constexpr size_t WS_ROPE = 2 * MiB;
constexpr size_t WS_STATS = 2 * MiB + 65536;
constexpr size_t WS_IDENT = 2 * MiB + 262144;
constexpr size_t WS_MODP = 3 * MiB;
constexpr size_t WS_DT = 15 * MiB;
constexpr size_t WS_H = 18 * MiB;
constexpr size_t WS_HC = WS_H + 68 * MiB;
constexpr size_t WS_HM = 154 * MiB;
constexpr size_t WS_PROJ = 222 * MiB;
constexpr size_t WS_O = 664 * MiB;
constexpr size_t WS_YD = 732 * MiB;
constexpr size_t WS_YS = 800 * MiB;
constexpr size_t WS_W = 868 * MiB;
constexpr size_t W_13 = 0, W_2 = 88 * MiB, W_IN = 132 * MiB, W_B = 185 * MiB, W_O = 197 * MiB, W_GLU = 205 * MiB;
constexpr size_t WS_S5ST = 1075 * MiB;
constexpr size_t WS_S5H = 1143 * MiB;
constexpr size_t WS_S5M = 1183 * MiB;
constexpr size_t WS_S5A = 1207 * MiB;
constexpr size_t WS_END = 1208 * MiB;
constexpr int S5M = 1088;
constexpr int CW_BAR = 4096;

__device__ __forceinline__ unsigned cvt_pk_bf16(float lo, float hi) { unsigned r; asm volatile("v_cvt_pk_bf16_f32 %0, %1, %2" : "=v"(r) : "v"(lo), "v"(hi)); return r; }
__device__ __forceinline__ float bflo(unsigned u) { return __uint_as_float(u << 16); }
__device__ __forceinline__ float bfhi(unsigned u) { return __uint_as_float(u & 0xffff0000u); }
__device__ __forceinline__ float bf1(bf16_t h) { return __uint_as_float((unsigned)h << 16); }
typedef _Float16 h16x2 __attribute__((ext_vector_type(2)));
typedef _Float16 h16x4 __attribute__((ext_vector_type(4)));
__device__ __forceinline__ f32x4 ld_h4(const _Float16* p) { const h16x4 h = *(const h16x4*)p; return (f32x4){(float)h[0], (float)h[1], (float)h[2], (float)h[3]}; }
__device__ __forceinline__ void st_h4(_Float16* p, f32x4 v) { h16x4 h; h[0] = (_Float16)v[0]; h[1] = (_Float16)v[1]; h[2] = (_Float16)v[2]; h[3] = (_Float16)v[3]; *(h16x4*)p = h; }
__device__ __forceinline__ float sigmoidf_(float x) { return __builtin_amdgcn_rcpf(1.0f + __builtin_amdgcn_exp2f(-1.4426950408889634f * x)); }
__device__ __forceinline__ float siluf_(float x) { return x * sigmoidf_(x); }
__device__ __forceinline__ int lane_now() { int l; asm volatile("v_mbcnt_lo_u32_b32 %0, -1, 0\n\tv_mbcnt_hi_u32_b32 %0, -1, %0" : "=v"(l)); return l; }
__device__ __forceinline__ float shx(float v, int m, int lane) { return __int_as_float(__builtin_amdgcn_ds_bpermute((lane ^ m) << 2, __float_as_int(v))); }
__device__ __forceinline__ float wave_sum(float v, int lane) {
#pragma unroll
    for (int o = 1; o < 64; o <<= 1) v += shx(v, o, lane);
    return v;
}
#define LDS_WAIT() asm volatile("s_waitcnt lgkmcnt(0)" ::: "memory")
#define VM_WAIT() asm volatile("s_waitcnt vmcnt(0)" ::: "memory")

namespace pg8 {
constexpr int BM = 256, BK = 64, HALF = 128, HTB = HALF * BK * 2, STAGE_BYTES = 8 * HTB, NXCD = 8, WGM = 8, PPB_ = 17;
__host__ __device__ __forceinline__ int lds_byte(int r, int c) { const int st = (r >> 4) * 2 + (c >> 5), rr = r & 15, cc = c & 31, ob = rr * 64 + cc * 2; return st * 1024 + (ob ^ (((ob >> 9) & 1) << 5)); }
__host__ __device__ __forceinline__ void stage_rc(int b, int& R_, int& C_) { const int st = b / 1024, sb = b % 1024, swz = sb ^ (((sb >> 9) & 1) << 5); R_ = (st >> 1) * 16 + swz / 64; C_ = (st & 1) * 32 + (swz % 64) / 2; }

struct Unit { int pm, pn, aux, kt; const char* a; const char* b; };
struct Gemm { int lda, ldb, K; };

__device__ __forceinline__ void xcd_remap(int L, int nM, int nN, int& pm, int& pn) {
    const int nwg = nM * nN; int wgid = L;
    { const int q = nwg / NXCD, r = nwg % NXCD, xcd = wgid % NXCD, off = wgid / NXCD; wgid = (xcd < r ? xcd * (q + 1) : r * (q + 1) + (xcd - r) * q) + off; }
    const int nig = WGM * nN, gid = wgid / nig, fm = gid * WGM, gsz = (nM - fm) < WGM ? (nM - fm) : WGM;
    pm = fm + ((wgid % nig) % gsz); pn = (wgid % nig) / gsz;
}
struct StaticOrder {
    int nM, nN, nwg, G, c, kt, latonly, nctx; const char* A; const char* B; size_t tA, tB;
    __device__ __forceinline__ void init(int nM_, int nN_, int G_, int c_, const void* A_, int lda, const void* B_, int ldb, int K, int latonly_ = 0, int nctx_ = 0) { nM = nM_; nN = nN_; nwg = nM * nN; G = G_; c = c_; kt = K / BK; latonly = latonly_; nctx = nctx_;
        A = (const char*)A_; B = (const char*)B_; tA = (size_t)BM * lda * 2; tB = (size_t)BM * ldb * 2; }
    __device__ __forceinline__ bool next(int i, Unit& u) const {
        const long L = (long)i * G + c;
        if (L < nwg) { xcd_remap((int)L, nM, nN, u.pm, u.pn); if (latonly) u.pm += (u.pm >> 4) + 1; u.aux = 0; u.kt = kt; u.a = A + (size_t)u.pm * tA; u.b = B + (size_t)u.pn * tB; return true; }
        const int x = (int)(L - nwg); if (x >= nctx) return false;
        const int q = x & 3, t2 = x >> 2; u.pm = PPB_ * (t2 / nN); u.pn = t2 % nN; u.aux = 1; u.kt = kt >> 2;
        u.a = A + (size_t)u.pm * tA + (size_t)q * (kt >> 2) * BK * 2; u.b = B + (size_t)u.pn * tB + (size_t)q * (kt >> 2) * BK * 2; return true;
    }
};
template <class Epi, class Sched, int AMODE = 0, bool HOOK = false>
__device__ __forceinline__ void gemm_phase(LAS unsigned char* lds, const Gemm g, const Sched& S, const Epi& E, const int tid) {
    const int wid = __builtin_amdgcn_readfirstlane(tid >> 6), lane = tid & 63, wr = wid >> 2, wc = wid & 3, fr = lane & 15, fq = lane >> 4;
    unsigned voffA[2], voffB[2];
#pragma unroll
    for (int i = 0; i < 2; ++i) { int R_, C_; stage_rc(tid * 16 + i * 8192, R_, C_);
        voffA[i] = (AMODE == 1) ? (unsigned)((R_ * 16 + (C_ >> 4)) * LDP + (C_ & 15)) * 2u : (unsigned)(R_ * g.lda + C_) * 2u; voffB[i] = (unsigned)(R_ * g.ldb + C_) * 2u; }
    const size_t kstep = (size_t)(BK * 2), kstepA = (AMODE == 1) ? (size_t)(4 * LDP * 2) : kstep;
    const size_t hstepA = (AMODE == 1) ? (size_t)HALF * 16 * LDP * 2 : (size_t)HALF * g.lda * 2, hstepB = (size_t)HALF * g.ldb * 2;
    const unsigned ldsw = (unsigned)wid * 1024u;
    const int aoff = lds_byte(wr * 64 + fr, fq * 8), boff = lds_byte(wc * 32 + fr, fq * 8);
#define PG8_SA(b, h) (((b) * 2 + (h)) * HTB)
#define PG8_SB(b, h) ((4 + (b) * 2 + (h)) * HTB)
#define PG8_STAGE(bufoff, gbase, voff) do { _Pragma("unroll") for (int _i = 0; _i < 2; ++_i) \
        __builtin_amdgcn_global_load_lds((const unsigned*)((const char*)(gbase) + (voff)[_i]), (LAS unsigned*)(lds + (bufoff) + ldsw + _i * 8192), 16, 0, 0); } while (0)
#define PG8_LDA(dst, b, h) do { _Pragma("unroll") for (int m = 0; m < 4; ++m) _Pragma("unroll") for (int k = 0; k < 2; ++k) dst[m][k] = *(const LAS bf16x8*)(lds + PG8_SA(b, h) + aoff + m * 2048 + k * 1024); } while (0)
#define PG8_LDB(dst, b, h) do { _Pragma("unroll") for (int n = 0; n < 2; ++n) _Pragma("unroll") for (int k = 0; k < 2; ++k) dst[n][k] = *(const LAS bf16x8*)(lds + PG8_SB(b, h) + boff + n * 2048 + k * 1024); } while (0)
#define PG8_MMA(ai, bj, At, Bt) do { __builtin_amdgcn_s_setprio(1); _Pragma("unroll") for (int m = 0; m < 4; ++m) _Pragma("unroll") for (int n = 0; n < 2; ++n) _Pragma("unroll") for (int k = 0; k < 2; ++k) \
        acc[ai][bj][m][n] = __builtin_amdgcn_mfma_f32_16x16x32_bf16(Bt[n][k], At[m][k], acc[ai][bj][m][n], 0, 0, 0); __builtin_amdgcn_s_setprio(0); } while (0)
#define PG8_WAIT_V(n) asm volatile("s_waitcnt vmcnt(" #n ")" ::: "memory")
#define PG8_WAIT_L(n) asm volatile("s_waitcnt lgkmcnt(" #n ")" ::: "memory")
#define PG8_BAR __builtin_amdgcn_s_barrier()
#define PG8_SCHED __builtin_amdgcn_sched_barrier(0)
    Unit cur, nxt; int ui = 0;
    if (!S.next(0, cur)) return;
    f32x4 acc[2][2][4][2];
#pragma unroll
    for (int a = 0; a < 2; ++a)
#pragma unroll
        for (int b = 0; b < 2; ++b)
#pragma unroll
            for (int m = 0; m < 4; ++m)
#pragma unroll
                for (int n = 0; n < 2; ++n) acc[a][b][m][n] = (f32x4){0.f, 0.f, 0.f, 0.f};
    bf16x8 At[4][2], B0[2][2], B1[2][2];
    const char* cA = cur.a; const char* cB = cur.b;
    PG8_STAGE(PG8_SB(0, 0), cB, voffB); PG8_STAGE(PG8_SB(0, 1), cB + hstepB, voffB); PG8_STAGE(PG8_SA(0, 0), cA, voffA); PG8_STAGE(PG8_SA(0, 1), cA + hstepA, voffA);
    if (wr == 1) PG8_BAR;
    PG8_WAIT_V(2); PG8_BAR;
    PG8_STAGE(PG8_SB(1, 0), cB + kstep, voffB); PG8_STAGE(PG8_SA(1, 0), cA + kstepA, voffA); PG8_STAGE(PG8_SB(1, 1), cB + hstepB + kstep, voffB);
    PG8_WAIT_V(6); PG8_BAR;
    for (;;) {
        const bool has_next = S.next(ui + 1, nxt);
        const char* nA = has_next ? nxt.a : cA; const char* nB = has_next ? nxt.b : cB;
        const int nt = cur.kt;
        for (int t = 0; t < nt; t += 2) {
            const bool last = (t == nt - 2);
            if constexpr (HOOK) { if (t == 16 || t == 32) E.mid(acc, cur, t >> 4, wr, wc); }
            const char* a1 = cA + (size_t)(t + 1) * kstepA;
            const char* a2 = last ? nA : cA + (size_t)(t + 2) * kstepA; const char* b2 = last ? nB : cB + (size_t)(t + 2) * kstep;
            const char* a3 = a2 + kstepA; const char* b3 = b2 + kstep;
            PG8_LDB(B0, 0, 0); PG8_LDB(B1, 0, 1); PG8_SCHED; PG8_LDA(At, 0, 0); PG8_STAGE(PG8_SA(1, 1), a1 + hstepA, voffA);
            PG8_WAIT_V(8); PG8_WAIT_L(0); PG8_BAR; PG8_MMA(0, 0, At, B0); PG8_MMA(0, 1, At, B1); PG8_BAR; PG8_SCHED;
            PG8_LDA(At, 0, 1); PG8_STAGE(PG8_SB(0, 0), b2, voffB); PG8_STAGE(PG8_SB(0, 1), b2 + hstepB, voffB); PG8_STAGE(PG8_SA(0, 0), a2, voffA);
            PG8_WAIT_V(8); PG8_WAIT_L(0); PG8_BAR; PG8_MMA(1, 0, At, B0); PG8_MMA(1, 1, At, B1); PG8_BAR; PG8_SCHED;
            PG8_LDB(B0, 1, 0); PG8_LDB(B1, 1, 1); PG8_SCHED; PG8_LDA(At, 1, 0); PG8_STAGE(PG8_SA(0, 1), a2 + hstepA, voffA);
            PG8_WAIT_V(8); PG8_WAIT_L(0); PG8_BAR; PG8_MMA(0, 0, At, B0); PG8_MMA(0, 1, At, B1); PG8_BAR; PG8_SCHED;
            PG8_LDA(At, 1, 1); PG8_STAGE(PG8_SB(1, 0), b3, voffB); PG8_STAGE(PG8_SB(1, 1), b3 + hstepB, voffB); PG8_STAGE(PG8_SA(1, 0), a3, voffA);
            PG8_WAIT_V(8); PG8_WAIT_L(0); PG8_BAR; PG8_MMA(1, 0, At, B0); PG8_MMA(1, 1, At, B1); PG8_BAR; PG8_SCHED;
        }
        if (wr == 0) PG8_BAR;
        E(acc, cur, wr, wc, fr, fq);
        if (!has_next) break;
#pragma unroll
        for (int a = 0; a < 2; ++a)
#pragma unroll
            for (int b = 0; b < 2; ++b)
#pragma unroll
                for (int m = 0; m < 4; ++m)
#pragma unroll
                    for (int n = 0; n < 2; ++n) acc[a][b][m][n] = (f32x4){0.f, 0.f, 0.f, 0.f};
        cur = nxt; cA = nA; cB = nB; ++ui;
        if (wr == 1) PG8_BAR;
    }
    PG8_WAIT_V(0);
    PG8_BAR;
#undef PG8_SA
#undef PG8_SB
#undef PG8_STAGE
#undef PG8_LDA
#undef PG8_LDB
#undef PG8_MMA
#undef PG8_WAIT_V
#undef PG8_WAIT_L
#undef PG8_BAR
#undef PG8_SCHED
}
}

struct EpiSwiGLU {
    bf16_t* O;
    __device__ __forceinline__ void operator()(const f32x4 (&acc)[2][2][4][2], const pg8::Unit& u, int wr, int wc, int, int) const { const int ln_ = lane_now(); const int fr = ln_ & 15, fq = ln_ >> 4;
        const int row0 = u.pm * 256 + wr * 64 + fr, hc0 = u.pn * 128 + wc * 16 + 4 * fq;
#pragma unroll
        for (int ai = 0; ai < 2; ++ai)
#pragma unroll
            for (int m = 0; m < 4; ++m) { bf16_t* rowp = O + (size_t)(row0 + ai * 128 + m * 16) * DFF + hc0;
#pragma unroll
                for (int bj = 0; bj < 2; ++bj) { const f32x4 a = acc[ai][bj][m][0], b = acc[ai][bj][m][1];
                    u32x2 w; w.x = cvt_pk_bf16(siluf_(a[0]) * b[0], siluf_(a[1]) * b[1]); w.y = cvt_pk_bf16(siluf_(a[2]) * b[2], siluf_(a[3]) * b[3]);
                    *(u32x2*)(rowp + bj * 64) = w; } }
    }
};
struct EpiResid {
    _Float16* H; float* HC; const float* gate; const float* lng; const float* lnb; const float* stats;
    __device__ __forceinline__ void operator()(const f32x4 (&acc)[2][2][4][2], const pg8::Unit& u, int wr, int wc, int, int) const { const int ln_ = lane_now(); const int fr = ln_ & 15, fq = ln_ >> 4;
        const int pp = u.pm % PPB, mi = (pp == 0) ? 4 : (u.pm / PPB);
        const int rl0 = wr * 64 + fr, col0 = u.pn * 256 + wc * 32 + 4 * fq;
        if (u.aux) {
            float* hc = HC + (size_t)(u.pm / PPB) * 256 * D;
#pragma unroll
            for (int bj = 0; bj < 2; ++bj)
#pragma unroll
                for (int n = 0; n < 2; ++n) { const f32x4 gv = *(const f32x4*)(gate + (size_t)mi * NMOD + col0 + bj * 128 + n * 16);
#pragma unroll
                    for (int ai = 0; ai < 2; ++ai)
#pragma unroll
                        for (int m = 0; m < 4; ++m) { float* p = hc + (size_t)(rl0 + ai * 128 + m * 16) * D + col0 + bj * 128 + n * 16; const f32x4 v = gv * acc[ai][bj][m][n];
                            unsafeAtomicAdd(p, v[0]); unsafeAtomicAdd(p + 1, v[1]); unsafeAtomicAdd(p + 2, v[2]); unsafeAtomicAdd(p + 3, v[3]); } }
            return;
        }
        f32x2 st[2][4];
#pragma unroll
        for (int ai = 0; ai < 2; ++ai)
#pragma unroll
            for (int m = 0; m < 4; ++m) st[ai][m] = *(const f32x2*)(stats + (size_t)(u.pm * 256 + rl0 + ai * 128 + m * 16) * 2);
#pragma unroll
        for (int bj = 0; bj < 2; ++bj) {
            h16x4 tv[2][2][4];
#pragma unroll
            for (int n = 0; n < 2; ++n)
#pragma unroll
                for (int ai = 0; ai < 2; ++ai)
#pragma unroll
                    for (int m = 0; m < 4; ++m) tv[n][ai][m] = *(const h16x4*)(H + (size_t)(u.pm * 256 + rl0 + ai * 128 + m * 16) * D + col0 + bj * 128 + n * 16);
#pragma unroll
            for (int n = 0; n < 2; ++n) { const int c = col0 + bj * 128 + n * 16; const f32x4 gv = *(const f32x4*)(gate + (size_t)mi * NMOD + c);
                const f32x4 g4 = *(const f32x4*)(lng + c) * DN_ALPHA, b4 = *(const f32x4*)(lnb + c) * DN_ALPHA;
#pragma unroll
                for (int ai = 0; ai < 2; ++ai)
#pragma unroll
                    for (int m = 0; m < 4; ++m) { const h16x4 h = tv[n][ai][m]; const f32x4 t = (f32x4){(float)h[0], (float)h[1], (float)h[2], (float)h[3]};
                        st_h4(H + (size_t)(u.pm * 256 + rl0 + ai * 128 + m * 16) * D + c, (t - st[ai][m].x) * st[ai][m].y * g4 + b4 + gv * acc[ai][bj][m][n]); } }
            asm volatile("" ::: "memory"); }
    }
};
struct EpiProj {
    bf16_t* P; float* DT; const float* rc; const float* rs; bf16_t* U2;
    __device__ __forceinline__ void operator()(const f32x4 (&acc)[2][2][4][2], const pg8::Unit& u, int wr, int wc, int, int) const { const int ln_ = lane_now(); const int fr = ln_ & 15, fq = ln_ >> 4;
        const int pp = u.pm % PPB; const int row0 = u.pm * 256 + wr * 64 + fr;
        const int pn = u.pn;
        if (pn == 52) {
            if (wc == 0) {
#pragma unroll
                for (int ai = 0; ai < 2; ++ai)
#pragma unroll
                    for (int m = 0; m < 4; ++m)
#pragma unroll
                        for (int n = 0; n < 2; ++n) *(f32x4*)(DT + (size_t)(row0 + ai * 128 + m * 16) * 32 + n * 16 + 4 * fq) = acc[ai][0][m][n];
            }
            return;
        }
        const int col0 = pn * 256 + wc * 32 + 4 * fq;
        const int mode = (pn < 8) ? ((pp != 0) ? 1 : 0) : ((pn >= 12 && pn < 16) ? 2 : (pn >= 28 ? 3 : 0));
        const float sc = (pn < 4) ? QSCALE : 1.0f;
#pragma unroll
        for (int ai = 0; ai < 2; ++ai)
#pragma unroll
            for (int m = 0; m < 4; ++m) { const int rl = ai * 128 + wr * 64 + m * 16 + fr; bf16_t* rowp = P + (size_t)(u.pm * 256 + rl) * LDP + col0;
                f32x4 cs = (f32x4){1.f, 1.f, 1.f, 1.f}, sn = (f32x4){0.f, 0.f, 0.f, 0.f};
                if (mode == 1) { const int t = (pp - 1) * 256 + rl; const int pos = (wc & 1) ? (t & 63) : (t >> 6); cs = *(const f32x4*)(rc + pos * 16 + 4 * fq); sn = *(const f32x4*)(rs + pos * 16 + 4 * fq); }
#pragma unroll
                for (int bj = 0; bj < 2; ++bj) { f32x4 v0 = acc[ai][bj][m][0], v1 = acc[ai][bj][m][1];
                    if (mode == 1) { const f32x4 o0 = v0 * cs - v1 * sn, o1 = v1 * cs + v0 * sn; v0 = o0; v1 = o1; }
                    else if (mode == 2) {
#pragma unroll
                        for (int e = 0; e < 4; ++e) { v0[e] = siluf_(v0[e]); v1[e] = siluf_(v1[e]); } }
                    else if (mode == 3) {
#pragma unroll
                        for (int e = 0; e < 4; ++e) { v0[e] = sigmoidf_(v0[e]); v1[e] = sigmoidf_(v1[e]); } }
                    if (mode == 3) { unsigned char* gb = (unsigned char*)(P + (size_t)(u.pm * 256 + rl) * LDP + PG) + (col0 - PG) + bj * 128;
                        unsigned q0 = 0, q1 = 0;
#pragma unroll
                        for (int e = 0; e < 4; ++e) { q0 |= (unsigned)fmaxf(__builtin_rintf(v0[e] * 255.0f), 1.0f) << (8 * e); q1 |= (unsigned)fmaxf(__builtin_rintf(v1[e] * 255.0f), 1.0f) << (8 * e); }
                        *(unsigned*)gb = q0; *(unsigned*)(gb + 16) = q1; continue; }
                    if (pn >= 24 && pn < 28) {
                        bf16_t* u2 = U2 + ((size_t)(((pn - 24) * 256 + bj * 128 + wc * 32) >> 4) * R + (size_t)(u.pm * 256 + rl)) * 16 + 4 * fq;
                        u32x2 a0, a1; a0.x = cvt_pk_bf16(v0[0], v0[1]); a0.y = cvt_pk_bf16(v0[2], v0[3]); a1.x = cvt_pk_bf16(v1[0], v1[1]); a1.y = cvt_pk_bf16(v1[2], v1[3]);
                        *(u32x2*)u2 = a0; *(u32x2*)(u2 + (size_t)R * 16) = a1; continue; }
                    v0 = v0 * sc; v1 = v1 * sc;
                    u32x2 w0, w1; w0.x = cvt_pk_bf16(v0[0], v0[1]); w0.y = cvt_pk_bf16(v0[2], v0[3]); w1.x = cvt_pk_bf16(v1[0], v1[1]); w1.y = cvt_pk_bf16(v1[2], v1[3]);
                    *(u32x2*)(rowp + bj * 128) = w0; *(u32x2*)(rowp + bj * 128 + 16) = w1; } }
    }
};
struct EpiGlu {
    bf16_t* P; const float* bias;
    __device__ __forceinline__ void operator()(const f32x4 (&acc)[2][2][4][2], const pg8::Unit& u, int wr, int wc, int, int) const { const int ln_ = lane_now(); const int fr = ln_ & 15, fq = ln_ >> 4;
        const int row0 = u.pm * 256 + wr * 64 + fr, col0 = u.pn * 256 + wc * 32 + 4 * fq;
#pragma unroll
        for (int ai = 0; ai < 2; ++ai)
#pragma unroll
            for (int m = 0; m < 4; ++m) { bf16_t* rowp = P + (size_t)(row0 + ai * 128 + m * 16) * LDP;
#pragma unroll
                for (int bj = 0; bj < 2; ++bj)
#pragma unroll
                    for (int n = 0; n < 2; ++n) { const int c = col0 + bj * 128 + n * 16; const f32x4 bv = *(const f32x4*)(bias + c); const u32x2 tv = *(const u32x2*)(rowp + PU + c);
                        const f32x4 a = acc[ai][bj][m][n] + bv; u32x2 w;
                        w.x = cvt_pk_bf16(bflo(tv.x) * sigmoidf_(a[0]), bfhi(tv.x) * sigmoidf_(a[1])); w.y = cvt_pk_bf16(bflo(tv.y) * sigmoidf_(a[2]), bfhi(tv.y) * sigmoidf_(a[3]));
                        *(u32x2*)(rowp + PK + c) = w; } }
    }
};
struct EpiMerge {
    const bf16_t* P; bf16_t* MIXB;
    static __device__ __forceinline__ int goff(int seg) { return (seg == 0 ? 0 : (seg == 1 ? 4096 : 2048)); }
    __device__ __forceinline__ void mid(f32x4 (&acc)[2][2][4][2], const pg8::Unit& u, int seg, int wr, int wc) const {
        const int ln_ = lane_now(); const int fr = ln_ & 15, fq = ln_ >> 4;
        const int row0 = u.pm * 256 + wr * 64 + fr, col0 = u.pn * 256 + wc * 32 + 4 * fq; const int gp = goff(seg - 1), gn = goff(seg);
#pragma unroll
        for (int ai = 0; ai < 2; ++ai) {
            unsigned a[4][2][2], b[4][2][2];
#pragma unroll
            for (int m = 0; m < 4; ++m) { const unsigned char* rp = (const unsigned char*)(P + (size_t)(row0 + ai * 128 + m * 16) * LDP + PG) + col0;
#pragma unroll
                for (int bj = 0; bj < 2; ++bj)
#pragma unroll
                    for (int n = 0; n < 2; ++n) { a[m][bj][n] = *(const unsigned*)(rp + gp + bj * 128 + n * 16); b[m][bj][n] = *(const unsigned*)(rp + gn + bj * 128 + n * 16); } }
            asm volatile("s_waitcnt vmcnt(0)" ::: "memory");
#pragma unroll
            for (int m = 0; m < 4; ++m)
#pragma unroll
                for (int bj = 0; bj < 2; ++bj)
#pragma unroll
                    for (int n = 0; n < 2; ++n) { f32x4 r;
#pragma unroll
                        for (int e = 0; e < 4; ++e) r[e] = (float)((a[m][bj][n] >> (8 * e)) & 255u) * __builtin_amdgcn_rcpf((float)((b[m][bj][n] >> (8 * e)) & 255u));
                        acc[ai][bj][m][n] = acc[ai][bj][m][n] * r; }
            asm volatile("" ::: "memory"); }
    }
    __device__ __forceinline__ void operator()(const f32x4 (&acc)[2][2][4][2], const pg8::Unit& u, int wr, int wc, int, int) const { const int ln_ = lane_now(); const int fr = ln_ & 15, fq = ln_ >> 4;
        const int row0 = u.pm * 256 + wr * 64 + fr, col0 = u.pn * 256 + wc * 32 + 4 * fq; const int gl = goff(2);
#pragma unroll
        for (int ai = 0; ai < 2; ++ai)
#pragma unroll
            for (int m = 0; m < 4; ++m) { const size_t row = (size_t)(row0 + ai * 128 + m * 16);
#pragma unroll
                for (int bj = 0; bj < 2; ++bj)
#pragma unroll
                    for (int n = 0; n < 2; ++n) { const int c = col0 + bj * 128 + n * 16; const unsigned gv = *(const unsigned*)((const unsigned char*)(P + row * LDP + PG) + gl + c);
                        f32x4 v = acc[ai][bj][m][n];
#pragma unroll
                        for (int e = 0; e < 4; ++e) v[e] *= (float)((gv >> (8 * e)) & 255u) * (1.0f / 255.0f);
                        u32x2 w; w.x = cvt_pk_bf16(v[0], v[1]); w.y = cvt_pk_bf16(v[2], v[3]); *(u32x2*)(MIXB + row * D + c) = w; } }
    }
};

struct S5AOrder {
    int G, c; const char* A; const char* B;
    __device__ __forceinline__ bool next(int i, pg8::Unit& u) const {
        const int idx = i * G + c; if (idx >= 640) return false;
        const int g = idx / 10, r = idx - 10 * g, nt = r / 5, mt = r - 5 * nt;
        u.pm = mt; u.pn = nt; u.aux = g; u.kt = 4; u.a = A + ((size_t)g * (R / 16) + (size_t)mt * 256) * 256 * 2; u.b = B + (size_t)(g * 512 + nt * 256) * 256 * 2; return true;
    }
};
struct EpiS5A {
    bf16_t* YL; bf16_t* ST;
    __device__ __forceinline__ void operator()(const f32x4 (&acc)[2][2][4][2], const pg8::Unit& u, int wr, int wc, int, int) const { const int ln_ = lane_now(); const int fr = ln_ & 15, fq = ln_ >> 4;
        const int g = u.aux;
#pragma unroll
        for (int ai = 0; ai < 2; ++ai)
#pragma unroll
            for (int m = 0; m < 4; ++m) { const int mr = u.pm * 256 + ai * 128 + wr * 64 + m * 16 + fr; if (mr < S5M) {
#pragma unroll
                for (int bj = 0; bj < 2; ++bj)
#pragma unroll
                    for (int n = 0; n < 2; ++n) { const f32x4 v = acc[ai][bj][m][n];
                        if (u.pn == 0) { const int rho = 8 * bj + 2 * wc + n; u32x2 w; w.x = cvt_pk_bf16(v[0], v[1]); w.y = cvt_pk_bf16(v[2], v[3]); *(u32x2*)(YL + (size_t)(16 * mr + rho) * 1024 + 16 * g + 4 * fq) = w; }
                        else { u32x2 w; w.x = cvt_pk_bf16(v[0], v[1]); w.y = cvt_pk_bf16(v[2], v[3]); *(u32x2*)(ST + ((size_t)g * S5M + mr) * 256 + bj * 128 + wc * 32 + n * 16 + 4 * fq) = w; } } } }
    }
};
struct S5COrder {
    int G, c; const char* A; const char* B;
    __device__ __forceinline__ bool next(int i, pg8::Unit& u) const {
        const int idx = i * G + c; if (idx >= 320) return false;
        const int g = idx / 5, mt = idx - 5 * g;
        u.pm = mt; u.pn = 0; u.aux = g; u.kt = 4; u.a = A + ((size_t)g * 1280 + mt * 256) * 256 * 2; u.b = B + (size_t)g * 256 * 256 * 2; return true;
    }
};
struct EpiS5C {
    const bf16_t* YL; bf16_t* P;
    __device__ __forceinline__ void operator()(const f32x4 (&acc)[2][2][4][2], const pg8::Unit& u, int wr, int wc, int, int) const { const int ln_ = lane_now(); const int fr = ln_ & 15, fq = ln_ >> 4;
        const int g = u.aux;
#pragma unroll
        for (int ai = 0; ai < 2; ++ai)
#pragma unroll
            for (int m = 0; m < 4; ++m) { const int mr = u.pm * 256 + ai * 128 + wr * 64 + m * 16 + fr; if (mr < S5M) {
#pragma unroll
                for (int bj = 0; bj < 2; ++bj)
#pragma unroll
                    for (int n = 0; n < 2; ++n) { const int rho = 8 * bj + 2 * wc + n; const size_t row = (size_t)(16 * mr + rho);
                        const u32x2 yl = *(const u32x2*)(YL + row * 1024 + 16 * g + 4 * fq); f32x4 v = acc[ai][bj][m][n];
                        v[0] += bflo(yl.x); v[1] += bfhi(yl.x); v[2] += bflo(yl.y); v[3] += bfhi(yl.y);
#pragma unroll
                        for (int e = 0; e < 4; ++e) { const float x = v[e]; const float inner = 0.7978845608028654f * (x + 0.044715f * x * x * x); const float th = 1.0f - 2.0f * __builtin_amdgcn_rcpf(1.0f + __builtin_amdgcn_exp2f(2.8853900817779268f * inner)); v[e] = 0.5f * x * (1.0f + th); }
                        u32x2 w; w.x = cvt_pk_bf16(v[0], v[1]); w.y = cvt_pk_bf16(v[2], v[3]); *(u32x2*)(P + row * LDP + PU + 16 * g + 4 * fq) = w; } } }
    }
};

namespace attn128 {
using bf16 = __hip_bfloat16;
constexpr int NW = 8, QBLK = 32, KVBLK = 64, LDQ = LDP, LDK = LDP, LDOB = LDP;
constexpr size_t SHM_V = KVBLK * 128 * 2, SHM_K = KVBLK * 64 * 2, SHM_ATTN = 2 * SHM_V + 2 * SHM_K + NW * 64 * 4, SHM_TOTAL = SHM_ATTN + NW * 8192;
constexpr float THRL = 11.5f;
#define A128_KSWZ(row, colB) ((row) * 128 + ((colB) ^ (((row) & 7) << 4)))
#define A128_SBAR() __builtin_amdgcn_sched_barrier(0)
__device__ __forceinline__ int crow(int r, int hi) { return (r & 3) + 8 * (r >> 2) + 4 * hi; }
__device__ __forceinline__ void partialSM(f32x16& p0, f32x16& p1, float& m_reg, float& mn, float& alpha) {
  float pmax = p0[0];
#pragma unroll
  for (int r = 1; r < 16; ++r) pmax = fmaxf(pmax, p0[r]);
#pragma unroll
  for (int r = 0; r < 16; ++r) pmax = fmaxf(pmax, p1[r]);
  { auto rr = __builtin_amdgcn_permlane32_swap(__float_as_uint(pmax), __float_as_uint(pmax), false, false); pmax = fmaxf(__uint_as_float(rr[0]), __uint_as_float(rr[1])); }
  if (__builtin_expect(__all(pmax - m_reg <= THRL), 1)) { mn = m_reg; alpha = 1.f; }
  else { mn = fmaxf(m_reg, pmax); alpha = __builtin_amdgcn_exp2f(m_reg - mn); m_reg = mn; }
#pragma unroll
  for (int r = 0; r < 16; ++r) { p0[r] = p0[r] - mn; p1[r] = p1[r] - mn; }
#pragma unroll
  for (int r = 0; r < 16; ++r) p0[r] = __builtin_amdgcn_exp2f(p0[r]);
}
__device__ __forceinline__ void finishSM(f32x16& p0, f32x16& p1, float alpha, float& l_reg, bf16x8& pa0, bf16x8& pa1, bf16x8& pa2, bf16x8& pa3) {
#pragma unroll
  for (int r = 0; r < 16; ++r) p1[r] = __builtin_amdgcn_exp2f(p1[r]);
  float ps = 0;
#pragma unroll
  for (int r = 0; r < 16; ++r) ps += p0[r];
#pragma unroll
  for (int r = 0; r < 16; ++r) ps += p1[r];
  { auto rr = __builtin_amdgcn_permlane32_swap(__float_as_uint(ps), __float_as_uint(ps), false, false); ps = __uint_as_float(rr[0]) + __uint_as_float(rr[1]); }
  l_reg = l_reg * alpha + ps;
#define A128_PK4(P, BASE, OUT) do { unsigned a0 = cvt_pk_bf16(P[BASE + 0], P[BASE + 1]), a1 = cvt_pk_bf16(P[BASE + 2], P[BASE + 3]);   \
    unsigned b0 = cvt_pk_bf16(P[BASE + 4], P[BASE + 5]), b1 = cvt_pk_bf16(P[BASE + 6], P[BASE + 7]);                              \
    auto r0 = __builtin_amdgcn_permlane32_swap(a0, b0, false, false); auto r1 = __builtin_amdgcn_permlane32_swap(a1, b1, false, false); \
    u32x4 w = {r0[0], r1[0], r0[1], r1[1]}; OUT = __builtin_bit_cast(bf16x8, w); } while (0)
  A128_PK4(p0, 0, pa0); A128_PK4(p0, 8, pa1); A128_PK4(p1, 0, pa2); A128_PK4(p1, 8, pa3);
#undef A128_PK4
}
__device__ __forceinline__ void qkt(f32x16& p0, f32x16& p1, const char* Ks, const bf16x8* qr, int r32, int hi) {
#pragma unroll
  for (int i = 0; i < 16; ++i) { p0[i] = 0.f; p1[i] = 0.f; }
#pragma unroll
  for (int d0 = 0; d0 < 4; ++d0) { const int cb = (d0 * 16 + hi * 8) * 2;
    const bf16x8 b0 = *reinterpret_cast<const bf16x8*>(Ks + A128_KSWZ(r32, cb));
    const bf16x8 b1 = *reinterpret_cast<const bf16x8*>(Ks + A128_KSWZ(32 + r32, cb));
    p0 = __builtin_amdgcn_mfma_f32_32x32x16_bf16(b0, qr[d0], p0, 0, 0, 0);
    p1 = __builtin_amdgcn_mfma_f32_32x32x16_bf16(b1, qr[d0], p1, 0, 0, 0); }
}
__device__ __forceinline__ int v_st(int k, int c) { const int kk = (k & ~0xC) | ((k & 4) << 1) | ((k & 8) >> 1); return ((kk >> 3) * 4 + (c >> 5)) * 512 + ((kk & 7) * 32 + (c & 31)) * 2; }
__device__ __forceinline__ int v_rd_base(int lane) { return ((lane & 3) << 3) | (((lane >> 2) & 3) << 6) | (((lane >> 4) & 1) << 5) | (((lane >> 5) & 1) << 8); }
constexpr int v_rd_off(int d0, int ks, int half) { return d0 * 512 + ks * 4096 + half * 2048; }
template <int OFF> __device__ __forceinline__ s16x4 tr_read(int vb) { s16x4 r; asm volatile("ds_read_b64_tr_b16 %0, %1 offset:%2" : "=&v"(r) : "v"(vb), "i"(OFF) : "memory"); return r; }
template <int D0> __device__ __forceinline__ void pv_one(f32x16& od, int vb, bf16x8 pa0, bf16x8 pa1, bf16x8 pa2, bf16x8 pa3) {
  const s16x4 l0 = tr_read<v_rd_off(D0, 0, 0)>(vb), h0 = tr_read<v_rd_off(D0, 0, 1)>(vb), l1 = tr_read<v_rd_off(D0, 1, 0)>(vb), h1 = tr_read<v_rd_off(D0, 1, 1)>(vb);
  const s16x4 l2 = tr_read<v_rd_off(D0, 2, 0)>(vb), h2 = tr_read<v_rd_off(D0, 2, 1)>(vb), l3 = tr_read<v_rd_off(D0, 3, 0)>(vb), h3 = tr_read<v_rd_off(D0, 3, 1)>(vb);
  asm volatile("s_waitcnt lgkmcnt(0)" ::: "memory"); A128_SBAR();
#define A128_PK(L, H) (bf16x8){L[0], L[1], L[2], L[3], H[0], H[1], H[2], H[3]}
  od = __builtin_amdgcn_mfma_f32_32x32x16_bf16(pa0, A128_PK(l0, h0), od, 0, 0, 0);
  od = __builtin_amdgcn_mfma_f32_32x32x16_bf16(pa1, A128_PK(l1, h1), od, 0, 0, 0);
  od = __builtin_amdgcn_mfma_f32_32x32x16_bf16(pa2, A128_PK(l2, h2), od, 0, 0, 0);
  od = __builtin_amdgcn_mfma_f32_32x32x16_bf16(pa3, A128_PK(l3, h3), od, 0, 0, 0);
#undef A128_PK
}
__device__ __forceinline__ void pv_d0(f32x16* o, int vb, bf16x8 pa0, bf16x8 pa1, bf16x8 pa2, bf16x8 pa3) {
  pv_one<0>(o[0], vb, pa0, pa1, pa2, pa3); pv_one<1>(o[1], vb, pa0, pa1, pa2, pa3); pv_one<2>(o[2], vb, pa0, pa1, pa2, pa3); pv_one<3>(o[3], vb, pa0, pa1, pa2, pa3);
}
__device__ __forceinline__ void unit(const bf16* __restrict__ Qb0, const bf16* __restrict__ Kh0, const bf16* __restrict__ Vh, bf16_t* Ob, int seq, char* lds, const int tid_in, const float lam, const float onem, const float* __restrict__ subw) {
#pragma unroll 1
 for (int mp = 0; mp < 2; ++mp) {
  int tid = tid_in; asm volatile("" : "+v"(tid));
  bf16_t* stage = (bf16_t*)(lds + SHM_ATTN) + (tid >> 6) * 4096;
  const bf16* Qb = Qb0 + mp * 64; const bf16* Kh = Kh0 + mp * 64;
  const int wid = __builtin_amdgcn_readfirstlane(tid >> 6), lane = tid & 63, r32 = lane & 31, hi = lane >> 5;
  char* V_lds = lds; char* K_lds = lds + 2 * SHM_V;
  float* ws = (float*)(lds + 2 * SHM_V + 2 * SHM_K) + wid * 64; float* li_l = ws; float* al_l = ws + 32;
  float m_reg = -1e30f, l_reg = 0; f32x16 o[4]; bf16x8 qr[4];
#pragma unroll
  for (int d = 0; d < 4; ++d)
#pragma unroll
    for (int r = 0; r < 16; ++r) o[d][r] = 0.f;
  const bf16* Qw = Qb + (long)(wid * QBLK + r32) * LDQ + hi * 8;
#pragma unroll
  for (int d0 = 0; d0 < 4; ++d0) qr[d0] = *reinterpret_cast<const bf16x8*>(Qw + d0 * 16);
  const int sr = tid >> 4, sc = (tid & 15) * 8, vst0 = v_st(sr, sc), vst1 = v_st(32 + sr, sc);
  const int kr = tid >> 3, kc = (tid & 7) * 8, kst = A128_KSWZ(kr, kc * 2);
  const int vb0 = (int)(uintptr_t)V_lds + v_rd_base(lane);
  struct { bf16x8 vs0, vs1, ks0; } sr_[2];
#define A128_SLOAD(i, k0) do { sr_[i].vs0 = *reinterpret_cast<const bf16x8*>(&Vh[(long)((k0) + sr) * LDK + sc]); sr_[i].vs1 = *reinterpret_cast<const bf16x8*>(&Vh[(long)((k0) + 32 + sr) * LDK + sc]); \
    sr_[i].ks0 = *reinterpret_cast<const bf16x8*>(&Kh[(long)((k0) + kr) * LDK + kc]); } while (0)
#define A128_SWRITE(b, i) do { *(bf16x8*)(V_lds + (b) * SHM_V + vst0) = sr_[i].vs0; *(bf16x8*)(V_lds + (b) * SHM_V + vst1) = sr_[i].vs1; *(bf16x8*)(K_lds + (b) * SHM_K + kst) = sr_[i].ks0; } while (0)
#define A128_SWAIT() asm volatile("s_waitcnt vmcnt(3)" ::: "memory")
#define A128_RESC(a) do { if (__any((a) < 1.f)) { if (hi == 0) al_l[r32] = (a); asm volatile("s_waitcnt lgkmcnt(0)" ::: "memory"); \
    _Pragma("unroll") for (int d = 0; d < 4; ++d) _Pragma("unroll") for (int r = 0; r < 16; ++r) o[d][r] *= al_l[crow(r, hi)]; } } while (0)
  f32x16 pA0, pA1, pB0, pB1; float mnA, mnB, alA, alB; bf16x8 pa0, pa1, pa2, pa3; const int NT = seq / KVBLK;
  A128_SLOAD(0, 0); asm volatile("s_waitcnt vmcnt(0)" ::: "memory"); A128_SWRITE(0, 0); __syncthreads();
  qkt(pA0, pA1, K_lds, qr, r32, hi); partialSM(pA0, pA1, m_reg, mnA, alA);
  A128_SLOAD(1, KVBLK); if (2 < NT) A128_SLOAD(0, 2 * KVBLK);
  A128_SWAIT(); A128_SWRITE(1, 1); __syncthreads();
  for (int j = 1; j + 1 < NT; j += 2) {
    A128_SBAR(); qkt(pB0, pB1, K_lds + SHM_K, qr, r32, hi);
    finishSM(pA0, pA1, alA, l_reg, pa0, pa1, pa2, pa3); A128_SBAR();
    A128_SLOAD(1, (j + 2) * KVBLK); A128_SBAR();
    pv_d0(o, vb0, pa0, pa1, pa2, pa3); partialSM(pB0, pB1, m_reg, mnB, alB);
    __syncthreads(); A128_SWAIT(); A128_SWRITE(0, 0);
    A128_RESC(alB); __syncthreads();
    A128_SBAR(); qkt(pA0, pA1, K_lds, qr, r32, hi);
    finishSM(pB0, pB1, alB, l_reg, pa0, pa1, pa2, pa3); A128_SBAR();
    if (j + 3 < NT) A128_SLOAD(0, (j + 3) * KVBLK); A128_SBAR();
    pv_d0(o, vb0 + (int)SHM_V, pa0, pa1, pa2, pa3); partialSM(pA0, pA1, m_reg, mnA, alA);
    __syncthreads(); A128_SWAIT(); A128_SWRITE(1, 1);
    A128_RESC(alA); __syncthreads();
  }
  A128_SBAR(); qkt(pB0, pB1, K_lds + SHM_K, qr, r32, hi);
  finishSM(pA0, pA1, alA, l_reg, pa0, pa1, pa2, pa3); A128_SBAR();
  pv_d0(o, vb0, pa0, pa1, pa2, pa3); partialSM(pB0, pB1, m_reg, mnB, alB);
  __syncthreads(); A128_RESC(alB);
  finishSM(pB0, pB1, alB, l_reg, pa0, pa1, pa2, pa3); A128_SBAR();
  pv_d0(o, vb0 + (int)SHM_V, pa0, pa1, pa2, pa3);
  if (hi == 0) li_l[r32] = l_reg; asm volatile("s_waitcnt lgkmcnt(0)" ::: "memory");
  float rli[16];
#pragma unroll
  for (int r = 0; r < 16; ++r) rli[r] = __builtin_amdgcn_rcpf(li_l[crow(r, hi)]);
  if (mp == 0) {
#pragma unroll
    for (int r = 0; r < 16; ++r)
#pragma unroll
      for (int d0 = 0; d0 < 4; ++d0) stage[(r * 4 + d0) * 64 + lane] = (bf16_t)(cvt_pk_bf16(o[d0][r] * rli[r], 0.f) & 0xffffu);
  } else {
    float ss[16];
#pragma unroll
    for (int r = 0; r < 16; ++r) { float q = 0.f;
#pragma unroll
      for (int d0 = 0; d0 < 4; ++d0) { const float a = bf1(stage[(r * 4 + d0) * 64 + lane]) - lam * bf1((bf16_t)(cvt_pk_bf16(o[d0][r] * rli[r], 0.f) & 0xffffu)); o[d0][r] = a; q += a * a; }
      ss[r] = q; }
#pragma unroll
    for (int m = 1; m < 32; m <<= 1)
#pragma unroll
      for (int r = 0; r < 16; ++r) ss[r] += __int_as_float(__builtin_amdgcn_ds_bpermute((lane ^ m) << 2, __float_as_int(ss[r])));
    float sw[4];
#pragma unroll
    for (int d0 = 0; d0 < 4; ++d0) sw[d0] = subw[d0 * 32 + r32] * onem;
    bf16_t* Ow = Ob + (long)(wid * QBLK) * LDOB;
#pragma unroll
    for (int r = 0; r < 16; ++r) { const int orow = crow(r, hi); const float rs = 1.0f / sqrtf(ss[r] * (1.f / 128.f) + RMS_EPS);
#pragma unroll
      for (int d0 = 0; d0 < 4; ++d0) Ow[(long)orow * LDOB + d0 * 32 + r32] = (bf16_t)(cvt_pk_bf16(o[d0][r] * rs * sw[d0], 0.f) & 0xffffu); }
  }
  __syncthreads();
 }
#undef A128_SLOAD
#undef A128_SWRITE
#undef A128_SWAIT
#undef A128_RESC
}
#undef A128_KSWZ
#undef A128_SBAR
}

#define XB_TMO      128
#define XB_XCNT(j)  (256  + 64 * (j))
#define XB_XSUB(j)  (1280 + 64 * (j))
#define XB_XGEN(j)  (2304 + 64 * (j))
#define XB_TOP      3328
#define XB_TOPGEN   3392
#define XCD_BAR_WORDS 3456
#define XB_SPIN_CAP (1u << 18)
__device__ __forceinline__ unsigned xb_ld(unsigned* p)              { return __hip_atomic_load(p, __ATOMIC_RELAXED, __HIP_MEMORY_SCOPE_AGENT); }
__device__ __forceinline__ unsigned xb_add(unsigned* p, unsigned v) { return __hip_atomic_fetch_add(p, v, __ATOMIC_RELAXED, __HIP_MEMORY_SCOPE_AGENT); }
__device__ __forceinline__ unsigned xb_xcc_id() { return (unsigned)__builtin_amdgcn_s_getreg((3 << 11) | 20) & 0xFu; }
#define XB_SPIN(cond, bar) do { unsigned _sp = 0; while (cond) { __builtin_amdgcn_s_sleep(1); \
    if ((++_sp & 255u) == 0u) { if (xb_ld(&(bar)[XB_TMO])) break; if (_sp > XB_SPIN_CAP) { atomicAdd(&(bar)[XB_TMO], 1u); break; } } } } while (0)
struct XcdBarrier { unsigned* bar; unsigned x; volatile LAS unsigned* st; };
__device__ __forceinline__ XcdBarrier xcd_barrier_post(unsigned* bar, volatile LAS unsigned* st) {
    XcdBarrier b; b.bar = bar; b.x = xb_xcc_id(); b.st = st;
    if (threadIdx.x == 0) (void)xb_add(&bar[XB_XCNT(b.x)], 1u);
    return b;
}
__device__ __forceinline__ void xcd_barrier_complete(unsigned* bar, unsigned x, unsigned& nloc, unsigned& nx) {
    const unsigned G = gridDim.x * gridDim.y * gridDim.z;
    unsigned sum, cnt, mine, sp = 0u;
    for (;;) {
        sum = 0u; cnt = 0u; mine = 0u;
#pragma unroll
        for (unsigned j = 0; j < 16; ++j) { const unsigned c = xb_ld(&bar[XB_XCNT(j)]); sum += c; cnt += (c > 0u) ? 1u : 0u; mine = (j == x) ? c : mine; }
        if (sum == G) break;
        __builtin_amdgcn_s_sleep(1);
        if ((++sp & 255u) == 0u) { if (xb_ld(&bar[XB_TMO])) break; if (sp > XB_SPIN_CAP) { atomicAdd(&bar[XB_TMO], 1u); break; } }
    }
    nloc = mine > 0u ? mine : 1u; nx = cnt > 0u ? cnt : 1u;
}
__device__ __forceinline__ void xcd_barrier(const XcdBarrier& b, const int tid) {
    asm volatile("s_waitcnt vmcnt(0)" ::: "memory");
    __syncthreads();
    if (tid == 0) {
        unsigned* bar = b.bar;
        __builtin_amdgcn_s_waitcnt(0);
        unsigned nloc = b.st[0], nx = b.st[1];
        if (nloc == 0u) { xcd_barrier_complete(bar, b.x, nloc, nx); b.st[0] = nloc; b.st[1] = nx; }
        const unsigned old = xb_add(&bar[XB_XSUB(b.x)], 1u);
        const unsigned gen = old / nloc;
        if (old + 1u == (gen + 1u) * nloc) {
            __builtin_amdgcn_fence(__ATOMIC_RELEASE, "agent");
            asm volatile("s_waitcnt vmcnt(0)" ::: "memory");
            const unsigned og = xb_add(&bar[XB_TOP], 1u);
            const unsigned tg = og / nx;
            if (og + 1u == (tg + 1u) * nx) xb_add(&bar[XB_TOPGEN], 1u);
            else XB_SPIN(xb_ld(&bar[XB_TOPGEN]) == tg, bar);
            __builtin_amdgcn_fence(__ATOMIC_ACQUIRE, "agent");
            xb_add(&bar[XB_XGEN(b.x)], 1u);
            asm volatile("s_waitcnt vmcnt(0)" ::: "memory");
        } else {
            XB_SPIN(xb_ld(&bar[XB_XGEN(b.x)]) == gen, bar);
            __builtin_amdgcn_fence(__ATOMIC_ACQUIRE, "agent");
            asm volatile("s_waitcnt vmcnt(0)" ::: "memory");
        }
    }
    __syncthreads();
}

constexpr int NWAVES = 8;
constexpr int RING_OFF = 0, RING_BYTES = 131072;
constexpr int LDSCTL_OFF = RING_BYTES, MISC_OFF = LDSCTL_OFF + 320;
constexpr int LDS_BYTES = 147456;
static_assert(attn128::SHM_TOTAL <= (size_t)RING_BYTES, "attention scratch fits the ring");

struct Args { const float* in[32]; float* out; unsigned char* ws; int ph_lo, ph_hi; };
constexpr int INTAB_OFF = LDSCTL_OFF + 1024;
__device__ __forceinline__ const float* inptr(LAS unsigned char* lds, int i) {
    const unsigned long long v = ((const LAS unsigned long long*)(lds + INTAB_OFF))[i];
    const unsigned lo = __builtin_amdgcn_readfirstlane((unsigned)v), hi = __builtin_amdgcn_readfirstlane((unsigned)(v >> 32));
    return (const float*)(GAS const float*)(((unsigned long long)hi << 32) | lo);
}
#define INP(i) inptr(F.lds, (i))
struct Frame {
    LAS unsigned char* lds; int tid, lane, wave, vcu, G, gw, NGW;
    unsigned char* ws;
};
enum { I_X = 0, I_C, I_CTX, I_CCTX, I_WMOD, I_BMOD, I_LNG, I_LNB, I_W1, I_W3, I_W2, I_WIN, I_ALAM, I_ASUB, I_CONVW, I_CONVB, I_ALOG, I_DTB, I_SSDD, I_SSDN,
       I_LRE, I_LIM, I_LSTEP, I_BRE, I_BIM, I_CRE, I_CIM, I_S5D, I_GLUW, I_GLUB, I_WBR, I_WOUT };

__device__ __forceinline__ void transpose_item64(const float* srcA, const float* srcB, int ldn, bool ffn, bf16_t* dst, int ldk, LAS bf16_t* scr  , int lane) {
    const int q = lane & 15, kr = lane >> 4; const bool isB = q >= 8; const int c = (q & 7) * 4; const float* src = isB ? srcB : srcA;
    f32x4 v[16];
#pragma unroll
    for (int i = 0; i < 16; ++i) v[i] = src ? *(const f32x4*)(src + (size_t)(4 * i + kr) * ldn + c) : (f32x4){0.f, 0.f, 0.f, 0.f};
    const int drow = ffn ? (32 * (c >> 4) + (c & 15) + (isB ? 16 : 0)) : (c + (isB ? 32 : 0));
#pragma unroll
    for (int i = 0; i < 16; ++i) { const int k = 4 * i + kr; const unsigned p01 = cvt_pk_bf16(v[i][0], v[i][1]), p23 = cvt_pk_bf16(v[i][2], v[i][3]);
        scr[(drow + 0) * 72 + k] = (bf16_t)(p01 & 0xffffu); scr[(drow + 1) * 72 + k] = (bf16_t)(p01 >> 16); scr[(drow + 2) * 72 + k] = (bf16_t)(p23 & 0xffffu); scr[(drow + 3) * 72 + k] = (bf16_t)(p23 >> 16); }
    LDS_WAIT(); asm volatile("" ::: "memory");
    const int c8 = lane & 7;
#pragma unroll
    for (int jj = 0; jj < 8; ++jj) { const int n = (lane >> 3) + 8 * jj; *(u32x4*)(dst + (size_t)n * ldk + 8 * c8) = *(const LAS u32x4*)(scr + n * 72 + 8 * c8); }
    LDS_WAIT(); asm volatile("" ::: "memory");
}
__device__ __forceinline__ void convert_layer_weights(const Args& A_, Frame& F, int l) {
    LAS bf16_t* scr = (LAS bf16_t*)(F.lds + RING_OFF + F.wave * 16384);
    unsigned char* W = F.ws + WS_W;
    constexpr int I13 = 32 * 176, I2 = 88 * 32, IIN = 32 * 212, IB = 16 * 32, IO = 32 * 32, IG = 16 * 16;
    constexpr int NIT = 2 * I13 + 2 * I2 + IIN + 3 * IB + IO + IG;
    for (int it = F.gw; it < NIT; it += F.NGW) {
        int r = it;
        if (r < 2 * I13) { const int f = r / I13; r -= f * I13; const int kb = r / 176, nb = r % 176;
            const float* w1 = INP(I_W1) + ((size_t)(l * 2 + f) * D + 64 * kb) * DFF + 32 * nb; const float* w3 = INP(I_W3) + ((size_t)(l * 2 + f) * D + 64 * kb) * DFF + 32 * nb;
            transpose_item64(w1, w3, DFF, true, (bf16_t*)(W + W_13) + ((size_t)f * N13 + 64 * nb) * D + 64 * kb, D, scr, F.lane); continue; }
        r -= 2 * I13;
        if (r < 2 * I2) { const int f = r / I2; r -= f * I2; const int kb = r / 32, nb = r % 32;
            const float* w2 = INP(I_W2) + ((size_t)(l * 2 + f) * DFF + 64 * kb) * D + 64 * nb;
            transpose_item64(w2, w2 + 32, D, false, (bf16_t*)(W + W_2) + ((size_t)f * D + 64 * nb) * DFF + 64 * kb, DFF, scr, F.lane); continue; }
        r -= 2 * I2;
        if (r < IIN) { const int kb = r / 212, nb = r % 212; const int n0 = 64 * nb; const float* wb = INP(I_WIN) + ((size_t)l * D + 64 * kb) * 13344;
            const float* sa = nullptr; const float* sb = nullptr;
            if (n0 < 6144) { sa = wb + n0; sb = sa + 32; } else if (n0 < 13312) { sa = wb + n0 + 32; sb = sa + 32; } else if (n0 == 13312) { sa = wb + 6144; }
            transpose_item64(sa, sb, 13344, false, (bf16_t*)(W + W_IN) + (size_t)n0 * D + 64 * kb, D, scr, F.lane); continue; }
        r -= IIN;
        if (r < 3 * IB) { const int jb = r / IB; r -= jb * IB; const int kb = r / 32, nb = r % 32;
            const float* w = INP(I_WBR) + ((size_t)(l * 3 + jb) * 1024 + 64 * kb) * D + 64 * nb;
            const int sp = (jb == 0) ? 0 : (jb == 1 ? 2 : 1); transpose_item64(w, w + 32, D, false, (bf16_t*)(W + W_B) + (size_t)(64 * nb) * 3072 + sp * 1024 + 64 * kb, 3072, scr, F.lane); continue; }
        r -= 3 * IB;
        if (r < IO) { const int kb = r / 32, nb = r % 32; const float* w = INP(I_WOUT) + ((size_t)l * D + 64 * kb) * D + 64 * nb;
            transpose_item64(w, w + 32, D, false, (bf16_t*)(W + W_O) + (size_t)(64 * nb) * D + 64 * kb, D, scr, F.lane); continue; }
        r -= IO;
        { const int kb = r / 16, nb = r % 16; const float* w = INP(I_GLUW) + ((size_t)l * 1024 + 64 * kb) * 1024 + 64 * nb;
            transpose_item64(w, w + 32, 1024, false, (bf16_t*)(W + W_GLU) + (size_t)(64 * nb) * 1024 + 64 * kb, 1024, scr, F.lane); }
    }
}
__device__ __forceinline__ void mod_partials(const Args& A_, Frame& F) {
    float* MODw = (float*)(F.ws + WS_MOD);
    for (int it = F.gw; it < 2 * 72 * 16; it += F.NGW) {
        const int l = it / (72 * 16), r = it % (72 * 16), ks = r / 72, cg = r % 72;
        const int col = cg * 256 + F.lane * 4; const float* w = INP(I_WMOD) + ((size_t)l * D + ks * 128) * NMOD + col;
        f32x4 a0 = {0.f, 0.f, 0.f, 0.f}, a1 = a0, a2 = a0, a3 = a0, a4 = a0;
        const float* c = INP(I_C) + ks * 128; const float* cc = INP(I_CCTX) + ks * 128;
#pragma unroll 16
        for (int k = 0; k < 128; ++k) { const f32x4 wv = *(const f32x4*)(w + (size_t)k * NMOD);
            a0 += wv * siluf_(c[k]); a1 += wv * siluf_(c[D + k]); a2 += wv * siluf_(c[2 * D + k]); a3 += wv * siluf_(c[3 * D + k]); a4 += wv * siluf_(cc[k]); }
        const int r9 = col / D; const float sc = (r9 == 2 || r9 == 8) ? 0.5f : 1.0f;
        if (ks == 0) { const f32x4 bv = *(const f32x4*)(INP(I_BMOD) + (size_t)l * NMOD + col); a0 += bv; a1 += bv; a2 += bv; a3 += bv; a4 += bv; }
        float* o = MODw + (size_t)l * 5 * NMOD + col;
#pragma unroll
        for (int e = 0; e < 4; ++e) { unsafeAtomicAdd(o + e, a0[e] * sc); unsafeAtomicAdd(o + NMOD + e, a1[e] * sc); unsafeAtomicAdd(o + 2 * NMOD + e, a2[e] * sc); unsafeAtomicAdd(o + 3 * NMOD + e, a3[e] * sc); unsafeAtomicAdd(o + 4 * NMOD + e, a4[e] * sc); }
    }
}
__device__ __forceinline__ void ln_pass(Frame& F, bool do_ln, const float* lng, const float* lnb, const float* modnext  , float* out, const float* xin = nullptr, const float* cin = nullptr) {
    _Float16* H = (_Float16*)(F.ws + WS_H); float* HC = (float*)(F.ws + WS_HC); bf16_t* HM = (bf16_t*)(F.ws + WS_HM); float* ST = (float*)(F.ws + WS_STATS);
    for (int row = F.gw; row < R; row += F.NGW) {
        const int b = row / RB, rr = row % RB; const bool isctx = rr < CTX; const int mi = isctx ? 4 : b;
        float* hc = HC + ((size_t)b * CTX + rr) * D; _Float16* hr = H + (size_t)row * D;
        f32x4 v[8]; float s = 0.f;
        if (xin) { const float* src = isctx ? cin + ((size_t)b * CTX + rr) * D : xin + ((size_t)b * SEQ + (rr - CTX)) * D;
#pragma unroll
            for (int i = 0; i < 8; ++i) v[i] = *(const f32x4*)(src + 256 * i + 4 * F.lane);
        } else if (isctx) {
#pragma unroll
            for (int i = 0; i < 8; ++i) v[i] = *(const f32x4*)(hc + 256 * i + 4 * F.lane);
        } else {
#pragma unroll
            for (int i = 0; i < 8; ++i) v[i] = ld_h4(hr + 256 * i + 4 * F.lane);
        }
#pragma unroll
        for (int i = 0; i < 8; ++i) s += (v[i][0] + v[i][1]) + (v[i][2] + v[i][3]);
        if (do_ln) {
            const float mean = wave_sum(s, F.lane) * (1.f / D); float s2 = 0.f;
#pragma unroll
            for (int i = 0; i < 8; ++i) { v[i] = v[i] - mean; s2 += (v[i][0] * v[i][0] + v[i][1] * v[i][1]) + (v[i][2] * v[i][2] + v[i][3] * v[i][3]); }
            const float rstd = 1.0f / sqrtf(wave_sum(s2, F.lane) * (1.f / D) + LN_EPS);
            if (!isctx && F.lane == 0) *(f32x2*)(ST + (size_t)row * 2) = (f32x2){mean, rstd};
#pragma unroll
            for (int i = 0; i < 8; ++i) { const f32x4 g = *(const f32x4*)(lng + 256 * i + 4 * F.lane), bb = *(const f32x4*)(lnb + 256 * i + 4 * F.lane); v[i] = v[i] * rstd * g + bb; if (isctx) *(f32x4*)(hc + 256 * i + 4 * F.lane) = v[i] * DN_ALPHA; }
        } else if (isctx) {
#pragma unroll
            for (int i = 0; i < 8; ++i) *(f32x4*)(hc + 256 * i + 4 * F.lane) = v[i] * DN_ALPHA;
        } else {
#pragma unroll
            for (int i = 0; i < 8; ++i) st_h4(hr + 256 * i + 4 * F.lane, v[i]);
            if (F.lane == 0) *(f32x2*)(ST + (size_t)row * 2) = (f32x2){0.f, 1.f};
        }
        if (modnext) {
            const float* sh = modnext + (size_t)mi * NMOD; const float* sc = sh + D;
#pragma unroll
            for (int i = 0; i < 8; ++i) { const f32x4 a = *(const f32x4*)(sh + 256 * i + 4 * F.lane), c = *(const f32x4*)(sc + 256 * i + 4 * F.lane); const f32x4 m = v[i] * (c + 1.0f) + a;
                u32x2 w; w.x = cvt_pk_bf16(m[0], m[1]); w.y = cvt_pk_bf16(m[2], m[3]); *(u32x2*)(HM + (size_t)row * D + 256 * i + 4 * F.lane) = w; }
        }
        if (out && !isctx) { float* orow = out + ((size_t)b * SEQ + (rr - CTX)) * D;
#pragma unroll
            for (int i = 0; i < 8; ++i) *(f32x4*)(orow + 256 * i + 4 * F.lane) = v[i]; }
    }
}

__device__ __forceinline__ void dt_tile(Frame& F, int l, int tile) {
    const bf16_t* A = (const bf16_t*)(F.ws + WS_HM) + (size_t)tile * 32 * D; const bf16_t* Bt = (const bf16_t*)(F.ws + WS_W + W_IN) + (size_t)13312 * D; float* DT = (float*)(F.ws + WS_DT);
    const int r = F.lane & 31, h = F.lane >> 5;
    f32x16 acc;
#pragma unroll
    for (int i = 0; i < 16; ++i) acc[i] = 0.f;
    const bf16_t* ap = A + (size_t)r * D + 8 * h; const bf16_t* bp = Bt + (size_t)r * D + 8 * h;
    for (int k0 = 0; k0 < 128; k0 += 16) {
        bf16x8 af[16], bfv[16];
#pragma unroll
        for (int e = 0; e < 16; ++e) { af[e] = *(const bf16x8*)(ap + 16 * (k0 + e)); bfv[e] = *(const bf16x8*)(bp + 16 * (k0 + e)); }
#pragma unroll
        for (int e = 0; e < 16; ++e) acc = __builtin_amdgcn_mfma_f32_32x32x16_bf16(af[e], bfv[e], acc, 0, 0, 0);
    }
    const float bias = INP(I_DTB)[l * 32 + r];
#pragma unroll
    for (int rg = 0; rg < 16; ++rg) { const int row = tile * 32 + (rg & 3) + 8 * (rg >> 2) + 4 * h; const float x = acc[rg] + bias; DT[(size_t)row * 32 + r] = fmaxf(x, 0.f) + log1pf(expf(-fabsf(x))); }
}
__device__ __forceinline__ void ssd_conv_pass(const Args& A_, Frame& F, int l) {
    const bf16_t* P = (const bf16_t*)(F.ws + WS_PROJ); bf16_t* XC = (bf16_t*)(F.ws + WS_HM);
    const float* cw = INP(I_CONVW) + (size_t)l * 5 * 2048; const float* cb = INP(I_CONVB) + (size_t)l * 2048;
    for (int it = F.gw; it < (R / 8) * 4; it += F.NGW) {
        const int r0 = (it >> 2) * 8, c0 = (it & 3) * 512 + F.lane * 8; const int rr0 = r0 % RB; const int lo = (rr0 < CTX) ? 0 : CTX, hi = (rr0 < CTX) ? CTX : RB;
        u32x4 x[12];
#pragma unroll
        for (int h = 0; h < 12; ++h) { const int r2 = rr0 + h - 2; x[h] = (r2 >= lo && r2 < hi) ? *(const u32x4*)(P + (size_t)(r0 + h - 2) * LDP + PX + c0) : (u32x4){0u, 0u, 0u, 0u}; }
        f32x4 w0[5], w1[5];
#pragma unroll
        for (int k = 0; k < 5; ++k) { w0[k] = *(const f32x4*)(cw + k * 2048 + c0); w1[k] = *(const f32x4*)(cw + k * 2048 + c0 + 4); }
        const f32x4 b0 = *(const f32x4*)(cb + c0), b1 = *(const f32x4*)(cb + c0 + 4);
#pragma unroll
        for (int jr = 0; jr < 8; ++jr) { f32x4 a0 = b0, a1 = b1;
#pragma unroll
            for (int k = 0; k < 5; ++k) { const u32x4 xv = x[jr + k];
                a0[0] += w0[k][0] * bflo(xv.x); a0[1] += w0[k][1] * bfhi(xv.x); a0[2] += w0[k][2] * bflo(xv.y); a0[3] += w0[k][3] * bfhi(xv.y);
                a1[0] += w1[k][0] * bflo(xv.z); a1[1] += w1[k][1] * bfhi(xv.z); a1[2] += w1[k][2] * bflo(xv.w); a1[3] += w1[k][3] * bfhi(xv.w); }
            u32x4 o; o.x = cvt_pk_bf16(siluf_(a0[0]), siluf_(a0[1])); o.y = cvt_pk_bf16(siluf_(a0[2]), siluf_(a0[3])); o.z = cvt_pk_bf16(siluf_(a1[0]), siluf_(a1[1])); o.w = cvt_pk_bf16(siluf_(a1[2]), siluf_(a1[3]));
            *(u32x4*)(XC + (size_t)(r0 + jr) * 2048 + c0) = o; }
    }
}
__device__ __forceinline__ int scan_row(int rb, int d, int step) { return d == 0 ? rb + step : (step < CTX ? rb + CTX - 1 - step : rb + (RB + CTX - 1) - step); }

__device__ __forceinline__ unsigned short bf16_1(float v) { return (unsigned short)(cvt_pk_bf16(v, 0.f) & 0xffffu); }
__device__ __forceinline__ void ssd_chain_fast(const Args& A_, Frame& F, int l, int cid) {
    constexpr int LS = 136;
    const int b = cid >> 6, d = (cid >> 5) & 1, hd = (cid >> 1) & 15, ph = cid & 1, g = hd >> 2; const int rb = b * RB;
    const bf16_t* XC = (const bf16_t*)(F.ws + WS_HM); const float* DT = (const float*)(F.ws + WS_DT); bf16_t* YD = (bf16_t*)(F.ws + WS_YD) + (size_t)d * R * 1024;
    const float a = -expf(INP(I_ALOG)[l * 32 + d * 16 + hd]);
    LAS bf16_t* Cs = (LAS bf16_t*)(F.lds); LAS bf16_t* Bs = Cs + 128 * LS; LAS bf16_t* Ms = Bs + 128 * LS; LAS bf16_t* XdT = Ms + 128 * LS; LAS bf16_t* Hb = XdT + 32 * LS;
    LAS float* csL = (LAS float*)(Hb + 32 * LS); LAS float* ecsL = csL + 128; LAS float* ewL = ecsL + 128; LAS float* misc = ewL + 128;
    const int tid = F.tid, lane = F.lane, w = F.wave, r = lane & 31, h = lane >> 5;
    f32x16 hacc;
#pragma unroll
    for (int i = 0; i < 16; ++i) hacc[i] = 0.f;
    for (int i = tid; i < 32 * LS / 2; i += 512) ((LAS unsigned*)Hb)[i] = 0u;
    u32x4 pc[4], pb[4], px; float pdt, pv0 = 0.f, pv1 = 0.f;
    const int rho0 = d ? 127 - lane : lane, rho1 = d ? 63 - lane : 64 + lane;
#define SSD_R0(k_) ((d == 0) ? rb + 128 * (k_) : ((k_) < 2 ? rb + 128 * (1 - (k_)) : rb + 256 + 128 * (33 - (k_))))
#define SSD_ISSUE(k_) do { const int r0n = SSD_R0(k_); \
        _Pragma("unroll") for (int i = 0; i < 4; ++i) { const int item = tid + 512 * i, row = item >> 4, seg = item & 15; const bf16_t* src = XC + (size_t)(r0n + row) * 2048 + g * 128 + seg * 8; pc[i] = *(const u32x4*)(src + 1536); pb[i] = *(const u32x4*)(src + 1024); } \
        { const int row = tid >> 2, seg = tid & 3; pdt = DT[(size_t)(r0n + row) * 32 + d * 16 + hd]; px = *(const u32x4*)(XC + (size_t)(r0n + row) * 2048 + hd * 64 + ph * 32 + seg * 8); } \
        if (w == 0) { pv0 = DT[(size_t)(r0n + rho0) * 32 + d * 16 + hd]; pv1 = DT[(size_t)(r0n + rho1) * 32 + d * 16 + hd]; } } while (0)
    SSD_ISSUE(0);
    for (int k = 0; k < 34; ++k) {
        const int r0 = SSD_R0(k);
        __syncthreads();
#pragma unroll
        for (int i = 0; i < 4; ++i) { const int item = tid + 512 * i, row = item >> 4, seg = item & 15; *(LAS u32x4*)(Cs + row * LS + seg * 8) = pc[i]; *(LAS u32x4*)(Bs + row * LS + seg * 8) = pb[i]; }
        { const int row = tid >> 2, seg = tid & 3; const float dtv = pdt; const u32x4 xv = px;
            LAS bf16_t* xo = XdT + (seg * 8) * LS + row;
            xo[0 * LS] = bf16_1(bflo(xv.x) * dtv); xo[1 * LS] = bf16_1(bfhi(xv.x) * dtv); xo[2 * LS] = bf16_1(bflo(xv.y) * dtv); xo[3 * LS] = bf16_1(bfhi(xv.y) * dtv);
            xo[4 * LS] = bf16_1(bflo(xv.z) * dtv); xo[5 * LS] = bf16_1(bfhi(xv.z) * dtv); xo[6 * LS] = bf16_1(bflo(xv.w) * dtv); xo[7 * LS] = bf16_1(bfhi(xv.w) * dtv); }
        if (w == 0) {
            float v0 = pv0 * a, v1 = pv1 * a;
#pragma unroll
            for (int o = 1; o < 64; o <<= 1) { const float t0 = __int_as_float(__builtin_amdgcn_ds_bpermute((lane - o) << 2, __float_as_int(v0))), t1 = __int_as_float(__builtin_amdgcn_ds_bpermute((lane - o) << 2, __float_as_int(v1))); if (lane >= o) { v0 += t0; v1 += t1; } }
            const float tot0 = __int_as_float(__builtin_amdgcn_ds_bpermute(63 << 2, __float_as_int(v0))); v1 += tot0;
            const float cend = __int_as_float(__builtin_amdgcn_ds_bpermute(63 << 2, __float_as_int(v1)));
            csL[rho0] = v0; csL[rho1] = v1; ecsL[rho0] = __builtin_amdgcn_exp2f(v0 * 1.4426950408889634f); ecsL[rho1] = __builtin_amdgcn_exp2f(v1 * 1.4426950408889634f);
            ewL[rho0] = __builtin_amdgcn_exp2f((cend - v0) * 1.4426950408889634f); ewL[rho1] = __builtin_amdgcn_exp2f((cend - v1) * 1.4426950408889634f);
            if (lane == 0) misc[0] = __builtin_amdgcn_exp2f(cend * 1.4426950408889634f);
        }
        if (k + 1 < 34) SSD_ISSUE(k + 1);
        __syncthreads();
        { const int lt = w >> 1;
#pragma unroll
          for (int q = 0; q < 2; ++q) { const int st = (w & 1) * 2 + q; const bool zero = (d == 0) ? (st > lt) : (st < lt);
            f32x16 acc;
#pragma unroll
            for (int i = 0; i < 16; ++i) acc[i] = 0.f;
            if (!zero) {
#pragma unroll
                for (int ks = 0; ks < 8; ++ks) { const bf16x8 af = *(const LAS bf16x8*)(Cs + (32 * lt + r) * LS + 16 * ks + 8 * h), bfv = *(const LAS bf16x8*)(Bs + (32 * st + r) * LS + 16 * ks + 8 * h);
                    acc = __builtin_amdgcn_mfma_f32_32x32x16_bf16(af, bfv, acc, 0, 0, 0); } }
            const int scol = 32 * st + r; const float css = csL[scol];
#pragma unroll
            for (int rg = 0; rg < 16; ++rg) { const int lrow = 32 * lt + (rg & 3) + 8 * (rg >> 2) + 4 * h; const bool valid = (d == 0) ? (scol <= lrow) : (scol >= lrow);
                const float v = valid ? acc[rg] * __builtin_amdgcn_exp2f((csL[lrow] - css) * 1.4426950408889634f) : 0.f; Ms[lrow * LS + scol] = bf16_1(v); } } }
        __syncthreads();
        if (w < 4) { const int lt = w;
            f32x16 acc;
#pragma unroll
            for (int i = 0; i < 16; ++i) acc[i] = 0.f;
#pragma unroll
            for (int ks = 0; ks < 8; ++ks) { const bf16x8 af = *(const LAS bf16x8*)(Cs + (32 * lt + r) * LS + 16 * ks + 8 * h), bfv = *(const LAS bf16x8*)(Hb + r * LS + 16 * ks + 8 * h);
                acc = __builtin_amdgcn_mfma_f32_32x32x16_bf16(af, bfv, acc, 0, 0, 0); }
#pragma unroll
            for (int rg = 0; rg < 16; ++rg) acc[rg] *= ecsL[32 * lt + (rg & 3) + 8 * (rg >> 2) + 4 * h];
#pragma unroll
            for (int ks = 0; ks < 8; ++ks) { const bool skip = (d == 0) ? (16 * ks >= 32 * (lt + 1)) : (16 * ks + 15 < 32 * lt);
                if (!skip) { const bf16x8 af = *(const LAS bf16x8*)(Ms + (32 * lt + r) * LS + 16 * ks + 8 * h), bfv = *(const LAS bf16x8*)(XdT + r * LS + 16 * ks + 8 * h);
                    acc = __builtin_amdgcn_mfma_f32_32x32x16_bf16(af, bfv, acc, 0, 0, 0); } }
            bf16_t* yo = YD + (size_t)(r0 + 32 * lt + 4 * h) * 1024 + hd * 64 + ph * 32 + r;
#pragma unroll
            for (int rg = 0; rg < 16; ++rg) yo[(size_t)((rg & 3) + 8 * (rg >> 2)) * 1024] = bf16_1(acc[rg]);
        } else { const int nt = w - 4; const float eend = misc[0];
#pragma unroll
            for (int i = 0; i < 16; ++i) hacc[i] *= eend;
#pragma unroll
            for (int ks = 0; ks < 8; ++ks) { const int k0 = 16 * ks + 8 * h; const u32x4 xa = *(const LAS u32x4*)(XdT + r * LS + k0); const f32x4 e0 = *(const LAS f32x4*)(ewL + k0), e1 = *(const LAS f32x4*)(ewL + k0 + 4);
                u32x4 aw; aw.x = cvt_pk_bf16(bflo(xa.x) * e0[0], bfhi(xa.x) * e0[1]); aw.y = cvt_pk_bf16(bflo(xa.y) * e0[2], bfhi(xa.y) * e0[3]); aw.z = cvt_pk_bf16(bflo(xa.z) * e1[0], bfhi(xa.z) * e1[1]); aw.w = cvt_pk_bf16(bflo(xa.w) * e1[2], bfhi(xa.w) * e1[3]);
                const LAS bf16_t* bp = Bs + k0 * LS + 32 * nt + r; u32x4 bw;
                bw.x = (unsigned)bp[0 * LS] | ((unsigned)bp[1 * LS] << 16); bw.y = (unsigned)bp[2 * LS] | ((unsigned)bp[3 * LS] << 16); bw.z = (unsigned)bp[4 * LS] | ((unsigned)bp[5 * LS] << 16); bw.w = (unsigned)bp[6 * LS] | ((unsigned)bp[7 * LS] << 16);
                hacc = __builtin_amdgcn_mfma_f32_32x32x16_bf16(__builtin_bit_cast(bf16x8, aw), __builtin_bit_cast(bf16x8, bw), hacc, 0, 0, 0); }
        }
        __syncthreads();
        if (w >= 4) { const int nt = w - 4;
#pragma unroll
            for (int rg = 0; rg < 16; ++rg) Hb[((rg & 3) + 8 * (rg >> 2) + 4 * h) * LS + 32 * nt + r] = bf16_1(hacc[rg]); }
    }
    __syncthreads();
#undef SSD_R0
#undef SSD_ISSUE
}
__device__ __forceinline__ void s5_setup(const Args& A_, Frame& F, int l) {
    LAS float* Pre = (LAS float*)(F.lds); LAS float* Pim = Pre + 2 * 17 * 64; LAS float* BBr = Pim + 2 * 17 * 64; LAS float* BBi = BBr + 2 * 64 * 16; LAS float* Kt = BBi + 2 * 64 * 16;
    bf16_t* Bt1 = (bf16_t*)(F.ws + WS_S5M); bf16_t* Bt2 = Bt1 + (size_t)64 * 512 * 256; float* A16 = (float*)(F.ws + WS_S5A);
    const int tid = F.tid;
    for (int g = blockIdx.x; g < 64; g += F.G) {
        if (tid < 128) { const int d = tid >> 6, n = tid & 63; const int pg_ = (l * 2 + d) * 64 + g;
            const float lre = INP(I_LRE)[pg_ * 64 + n], lim = INP(I_LIM)[pg_ * 64 + n], step = expf(INP(I_LSTEP)[pg_]);
            for (int dl = 0; dl <= 16; ++dl) { const float mag = expf(lre * step * (float)dl), ang = lim * step * (float)dl; Pre[(d * 17 + dl) * 64 + n] = mag * cosf(ang); Pim[(d * 17 + dl) * 64 + n] = mag * sinf(ang); }
            const float abr = Pre[(d * 17 + 1) * 64 + n], abi = Pim[(d * 17 + 1) * 64 + n];
            const float den = lre * lre + lim * lim; const float kre = ((abr - 1.f) * lre + abi * lim) / den, kim = (abi * lre - (abr - 1.f) * lim) / den;
            const float* br = INP(I_BRE) + ((size_t)pg_ * 64 + n) * 16; const float* bi = INP(I_BIM) + ((size_t)pg_ * 64 + n) * 16;
            for (int i = 0; i < 16; ++i) { const float x = br[i], y = bi[i]; BBr[(d * 64 + n) * 16 + i] = kre * x - kim * y; BBi[(d * 64 + n) * 16 + i] = kre * y + kim * x; }
            A16[((d * 64 + g) * 64 + n) * 2] = Pre[(d * 17 + 16) * 64 + n]; A16[((d * 64 + g) * 64 + n) * 2 + 1] = Pim[(d * 17 + 16) * 64 + n]; }
        __syncthreads();
        for (int q = 0; q < 16; ++q) { const int idx = tid + 512 * q; const int d = idx >> 12, dl = (idx >> 8) & 15, o = (idx >> 4) & 15, i = idx & 15; const int pg_ = (l * 2 + d) * 64 + g;
            const float* cr = INP(I_CRE) + ((size_t)pg_ * 16 + o) * 64; const float* ci = INP(I_CIM) + ((size_t)pg_ * 16 + o) * 64; float acc = 0.f;
            for (int n = 0; n < 64; ++n) { const float pr = Pre[(d * 17 + dl) * 64 + n], pi = Pim[(d * 17 + dl) * 64 + n], br = BBr[(d * 64 + n) * 16 + i], bi = BBi[(d * 64 + n) * 16 + i];
                acc += cr[n] * (pr * br - pi * bi) - ci[n] * (pr * bi + pi * br); }
            Kt[idx] = acc; }
        __syncthreads();
        for (int q = 0; q < 16; ++q) { const int item = tid + 512 * q; const int c1 = item >> 5, kb = (item & 31) * 8; const int rin = kb >> 4, i0 = kb & 15, rout = c1 >> 4, o = c1 & 15;
            float v[8];
#pragma unroll
            for (int e = 0; e < 8; ++e) { const int i = i0 + e; float x = 0.f; if (rout >= rin) x += Kt[((0 * 16 + (rout - rin)) * 16 + o) * 16 + i]; if (rin >= rout) x += Kt[((1 * 16 + (rin - rout)) * 16 + o) * 16 + i];
                if (rin == rout && i == o) x += INP(I_S5D)[l * 1024 + 16 * g + i]; v[e] = x; }
            u32x4 w; w.x = cvt_pk_bf16(v[0], v[1]); w.y = cvt_pk_bf16(v[2], v[3]); w.z = cvt_pk_bf16(v[4], v[5]); w.w = cvt_pk_bf16(v[6], v[7]);
            *(u32x4*)(Bt1 + ((size_t)g * 512 + c1) * 256 + kb) = w; }
        for (int q = 0; q < 16; ++q) { const int item = tid + 512 * q; const int c1 = item >> 5, kb = (item & 31) * 8; const int rin = kb >> 4, i0 = kb & 15; const int d = c1 >> 7, part = (c1 >> 6) & 1, n = c1 & 63;
            const int ex = (d == 0) ? 15 - rin : rin; const float pr = Pre[(d * 17 + ex) * 64 + n], pi = Pim[(d * 17 + ex) * 64 + n];
            float v[8];
#pragma unroll
            for (int e = 0; e < 8; ++e) { const float br = BBr[(d * 64 + n) * 16 + i0 + e], bi = BBi[(d * 64 + n) * 16 + i0 + e]; v[e] = part ? (pr * bi + pi * br) : (pr * br - pi * bi); }
            u32x4 w; w.x = cvt_pk_bf16(v[0], v[1]); w.y = cvt_pk_bf16(v[2], v[3]); w.z = cvt_pk_bf16(v[4], v[5]); w.w = cvt_pk_bf16(v[6], v[7]);
            *(u32x4*)(Bt1 + ((size_t)g * 512 + 256 + c1) * 256 + kb) = w; }
        for (int q = 0; q < 16; ++q) { const int item = tid + 512 * q; const int c2 = item >> 5, kb = (item & 31) * 8; const int rout = c2 >> 4, o = c2 & 15; const int d = kb >> 7, part = (kb >> 6) & 1, n0 = kb & 63; const int pg_ = (l * 2 + d) * 64 + g;
            const int ex = (d == 0) ? rout + 1 : 16 - rout; const float* cr = INP(I_CRE) + ((size_t)pg_ * 16 + o) * 64 + n0; const float* ci = INP(I_CIM) + ((size_t)pg_ * 16 + o) * 64 + n0;
            float v[8];
#pragma unroll
            for (int e = 0; e < 8; ++e) { const float pr = Pre[(d * 17 + ex) * 64 + n0 + e], pi = Pim[(d * 17 + ex) * 64 + n0 + e]; v[e] = part ? -(cr[e] * pi + ci[e] * pr) : (cr[e] * pr - ci[e] * pi); }
            u32x4 w; w.x = cvt_pk_bf16(v[0], v[1]); w.y = cvt_pk_bf16(v[2], v[3]); w.z = cvt_pk_bf16(v[4], v[5]); w.w = cvt_pk_bf16(v[6], v[7]);
            *(u32x4*)(Bt2 + ((size_t)g * 256 + c2) * 256 + kb) = w; }
        __syncthreads();
    }
}
__device__ __forceinline__ void s5_carry(Frame& F, int cid) {
    const int b = cid >> 7, d = (cid >> 6) & 1, g = cid & 63, n = F.lane;
    const bf16_t* ST = (const bf16_t*)(F.ws + WS_S5ST) + ((size_t)g * S5M + b * 272) * 256 + d * 128 + n; bf16_t* HP = (bf16_t*)(F.ws + WS_S5H) + ((size_t)g * 1280 + b * 272) * 256 + d * 128 + n;
    const float* A16 = (const float*)(F.ws + WS_S5A); const float ar = A16[((d * 64 + g) * 64 + n) * 2], ai = A16[((d * 64 + g) * 64 + n) * 2 + 1];
    float hr = 0.f, hi_ = 0.f;
    for (int k0 = 0; k0 < 272; k0 += 34) {
        float sr[34], si[34]; int cc[34];
#pragma unroll
        for (int e = 0; e < 34; ++e) { const int k = k0 + e; cc[e] = (d == 0) ? k : (k < 16 ? 15 - k : 287 - k); sr[e] = bf1(ST[(size_t)cc[e] * 256]); si[e] = bf1(ST[(size_t)cc[e] * 256 + 64]); }
#pragma unroll
        for (int e = 0; e < 34; ++e) { HP[(size_t)cc[e] * 256] = (bf16_t)(cvt_pk_bf16(hr, 0.f) & 0xffffu); HP[(size_t)cc[e] * 256 + 64] = (bf16_t)(cvt_pk_bf16(hi_, 0.f) & 0xffffu);
            const float nr = ar * hr - ai * hi_ + sr[e], ni = ar * hi_ + ai * hr + si[e]; hr = nr; hi_ = ni; }
    }
}
__device__ __forceinline__ void mixer_finalize(const Args& A_, Frame& F, int l) {
    bf16_t* P = (bf16_t*)(F.ws + WS_PROJ);
    const bf16_t* XC = (const bf16_t*)(F.ws + WS_HM); const bf16_t* YD0 = (const bf16_t*)(F.ws + WS_YD); const bf16_t* YD1 = YD0 + (size_t)R * 1024;
        const int c0 = F.lane * 16;
    for (int row = F.gw; row < R; row += F.NGW) {
        { const float dsk = INP(I_SSDD)[l * 16 + (c0 >> 6)];
          float v[16];
#pragma unroll
          for (int hh = 0; hh < 2; ++hh) { const u32x4 x = *(const u32x4*)(XC + (size_t)row * 2048 + c0 + 8 * hh), y0 = *(const u32x4*)(YD0 + (size_t)row * 1024 + c0 + 8 * hh), y1 = *(const u32x4*)(YD1 + (size_t)row * 1024 + c0 + 8 * hh), z = *(const u32x4*)(P + (size_t)row * LDP + PZ + c0 + 8 * hh);
#define SG(i, wx, wy0, wy1, wz) v[8 * hh + 2 * (i)] = (bflo(wx) * dsk + bflo(wy0) + bflo(wy1)) * bflo(wz); v[8 * hh + 2 * (i) + 1] = (bfhi(wx) * dsk + bfhi(wy0) + bfhi(wy1)) * bfhi(wz);
              SG(0, x.x, y0.x, y1.x, z.x) SG(1, x.y, y0.y, y1.y, z.y) SG(2, x.z, y0.z, y1.z, z.z) SG(3, x.w, y0.w, y1.w, z.w)
#undef SG
          }
          float ss = 0.f;
#pragma unroll
          for (int e = 0; e < 16; ++e) ss += v[e] * v[e];
          ss += shx(ss, 1, F.lane); ss += shx(ss, 2, F.lane); ss += shx(ss, 4, F.lane); ss += shx(ss, 8, F.lane);
          const float rs = 1.0f / sqrtf(ss * (1.f / 256.f) + RMS_EPS);
          const float* nw = INP(I_SSDN) + l * 1024 + c0;
          u32x4 o0, o1;
          o0.x = cvt_pk_bf16(v[0] * rs * nw[0], v[1] * rs * nw[1]); o0.y = cvt_pk_bf16(v[2] * rs * nw[2], v[3] * rs * nw[3]); o0.z = cvt_pk_bf16(v[4] * rs * nw[4], v[5] * rs * nw[5]); o0.w = cvt_pk_bf16(v[6] * rs * nw[6], v[7] * rs * nw[7]);
          o1.x = cvt_pk_bf16(v[8] * rs * nw[8], v[9] * rs * nw[9]); o1.y = cvt_pk_bf16(v[10] * rs * nw[10], v[11] * rs * nw[11]); o1.z = cvt_pk_bf16(v[12] * rs * nw[12], v[13] * rs * nw[13]); o1.w = cvt_pk_bf16(v[14] * rs * nw[14], v[15] * rs * nw[15]);
          *(u32x4*)(P + (size_t)row * LDP + PV + c0) = o0; *(u32x4*)(P + (size_t)row * LDP + PV + c0 + 8) = o1; }
    }
}


__global__ void __launch_bounds__(NWAVES * 64, 2) trunk_fwd(Args args) {
    extern __shared__ __attribute__((aligned(16))) unsigned char lds_raw[];
    Frame F;
    F.lds = (LAS unsigned char*)lds_raw;
    F.tid = threadIdx.x; F.lane = F.tid & 63; F.wave = __builtin_amdgcn_readfirstlane(F.tid >> 6);
    F.G = gridDim.x; { const int bx = blockIdx.x; F.vcu = (F.G % 8 == 0) ? (bx % 8) * (F.G / 8) + bx / 8 : bx; }
    F.gw = F.vcu * NWAVES + F.wave; F.NGW = F.G * NWAVES;
    F.ws = args.ws;
    volatile LAS unsigned* MISC = (volatile LAS unsigned*)(F.lds + MISC_OFF);
    for (int u = F.tid; u < (LDS_BYTES - LDSCTL_OFF) / 4; u += NWAVES * 64) ((LAS unsigned*)(F.lds + LDSCTL_OFF))[u] = 0u;
    __syncthreads();
    if (threadIdx.x < 32) ((LAS unsigned long long*)(F.lds + INTAB_OFF))[threadIdx.x] = (unsigned long long)args.in[threadIdx.x];
    __syncthreads();
    (void)xcd_barrier_post((unsigned*)(args.ws + WS_CTL) + CW_BAR, MISC + 8);
    const int lo = args.ph_lo, hi = args.ph_hi;
    const int wave0 = __builtin_amdgcn_readfirstlane((int)threadIdx.x >> 6);
    int pid = 0;
#define PH_BEGIN if (pid >= lo && pid < hi) { GAS unsigned char* wsg_ = (GAS unsigned char*)args.ws; int tid_; asm volatile("v_mbcnt_lo_u32_b32 %1, -1, 0\n\tv_mbcnt_hi_u32_b32 %1, -1, %1 ; PHASE_MARK_BEGIN %2" : "+s"(wsg_), "=v"(tid_) : "i"(__LINE__) : "memory"); tid_ += wave0 * 64; unsigned char* ws = (unsigned char*)wsg_; F.ws = ws; F.tid = tid_; F.lane = tid_ & 63; F.wave = __builtin_amdgcn_readfirstlane(tid_ >> 6); F.gw = F.vcu * NWAVES + F.wave;
#define PH_END   asm volatile("; PHASE_MARK_END %0" :: "i"(__LINE__)); if (pid + 1 < hi) { XcdBarrier bar_; bar_.bar = (unsigned*)(args.ws + WS_CTL) + CW_BAR; bar_.x = xb_xcc_id(); bar_.st = (volatile LAS unsigned*)(F.lds + MISC_OFF) + 8; xcd_barrier(bar_, wave0 * 64 + lane_now()); } } ++pid;

#define MOD ((float*)(ws + WS_MOD))
#define Hbuf ((float*)(ws + WS_H))
#define HM ((bf16_t*)(ws + WS_HM))
#define PROJ ((bf16_t*)(ws + WS_PROJ))
#define ROPEC ((float*)(ws + WS_ROPE))
#define ROPES (ROPEC + 1024)
#define WGT (ws + WS_W)

    PH_BEGIN
        s5_setup(args, F, 0);
        mod_partials(args, F);
        if (F.gw == 1) { float* idn = (float*)(ws + WS_IDENT); for (int i = F.lane; i < 2048; i += 64) { idn[i] = 1.0f; idn[2048 + i] = 0.0f; } }
        if (F.gw == 0) {
#pragma unroll
            for (int i = 0; i < 16; ++i) { const int idx = i * 64 + F.lane, pos = idx >> 4, f = idx & 15; const float inv = powf(10000.0f, -(float)f / 16.0f); const float ang = (float)pos * inv; ROPEC[idx] = cosf(ang); ROPES[idx] = sinf(ang); } }
    PH_END
    PH_BEGIN
        convert_layer_weights(args, F, 0);
        ln_pass(F, false, nullptr, nullptr, MOD, nullptr, INP(I_X), INP(I_CTX));
    PH_END

    for (int s = 0; s < 6; ++s) {
        const int l = s / 3, j = s - 3 * l;
        if (j != 1) {
            const int f = j >> 1;
            PH_BEGIN
                const int lat = (l == 1 && j == 2); pg8::Gemm g{D, D, D}; pg8::StaticOrder S; S.init(lat ? 64 : NPAN, N13 / 256, F.G, (int)blockIdx.x, HM, D, (const bf16_t*)(WGT + W_13) + (size_t)f * N13 * D, D, D, lat);
                EpiSwiGLU E{PROJ};
                pg8::gemm_phase<EpiSwiGLU, pg8::StaticOrder>(F.lds + RING_OFF, g, S, E, F.tid);
            PH_END
        } else {
            PH_BEGIN
                pg8::Gemm g{D, D, D}; pg8::StaticOrder S; S.init(NPAN, LDP / 256, F.G, (int)blockIdx.x, HM, D, (const bf16_t*)(WGT + W_IN), D, D);
                EpiProj E{PROJ, (float*)(ws + WS_DT), ROPEC, ROPES, (bf16_t*)(ws + WS_O)};
                pg8::gemm_phase<EpiProj, pg8::StaticOrder>(F.lds + RING_OFF, g, S, E, F.tid);
                { const int nfull = (NPAN * (LDP / 256)) % F.G;
                  if ((int)blockIdx.x >= nfull) { const int nw = (F.G - nfull) * NWAVES; for (int t = ((int)blockIdx.x - nfull) * NWAVES + F.wave; t < R / 32; t += nw) dt_tile(F, l, t); } }
            PH_END
            PH_BEGIN
                ssd_conv_pass(args, F, l);
                { pg8::Gemm g{256, 256, 256}; S5AOrder S{F.G, (int)blockIdx.x, (const char*)(ws + WS_O), (const char*)(ws + WS_S5M)};
                  EpiS5A E{(bf16_t*)(ws + WS_YS), (bf16_t*)(ws + WS_S5ST)};
                  pg8::gemm_phase<EpiS5A, S5AOrder>(F.lds + RING_OFF, g, S, E, F.tid); }
            PH_END
            PH_BEGIN
                if (F.wave < 2) s5_carry(F, (int)blockIdx.x * 2 + F.wave);
                ssd_chain_fast(args, F, l, (int)blockIdx.x);
                {
                    const float lam_init = 0.8f - 0.6f * expf(-0.3f * (float)l);
                    const float* lv = INP(I_ALAM) + l * 256;
                    const float s01 = wave_sum(lv[F.lane] * lv[64 + F.lane], F.lane), s23 = wave_sum(lv[128 + F.lane] * lv[192 + F.lane], F.lane);
                    const float lam = expf(s01) - expf(s23) + lam_init;
                    for (int i = 0;; ++i) { const int idx = i * F.G + F.vcu; if (idx >= 512 + (l == 0 ? 32 : 0)) break;
                        int b, h, q0, seq;
                        if (idx < 512) { b = idx >> 7; h = (idx >> 4) & 7; q0 = b * RB + CTX + (idx & 15) * 256; seq = RB; }
                        else { const int k = idx - 512; b = k >> 3; h = k & 7; q0 = b * RB; seq = CTX; }
                        const bf16_t* Q0 = PROJ + (size_t)q0 * LDP + PQ + h * 128; const bf16_t* Kh = PROJ + (size_t)(b * RB) * LDP + PK + h * 128; const bf16_t* Vh = PROJ + (size_t)(b * RB) * LDP + PV + h * 128;
                        attn128::unit((const attn128::bf16*)Q0, (const attn128::bf16*)Kh, (const attn128::bf16*)Vh, PROJ + (size_t)q0 * LDP + PQ + h * 128, seq, (char*)lds_raw + RING_OFF, F.tid, lam, 1.0f - lam_init, INP(I_ASUB) + l * 128);
                    }
                }
            PH_END
            PH_BEGIN
                mixer_finalize(args, F, l);
                { pg8::Gemm g{256, 256, 256}; S5COrder S{F.G, (int)blockIdx.x, (const char*)(ws + WS_S5H), (const char*)((bf16_t*)(ws + WS_S5M) + (size_t)64 * 512 * 256)};
                  EpiS5C E{(const bf16_t*)(ws + WS_YS), PROJ};
                  pg8::gemm_phase<EpiS5C, S5COrder>(F.lds + RING_OFF, g, S, E, F.tid); }
            PH_END
            PH_BEGIN
                pg8::Gemm g{LDP, 1024, 1024}; pg8::StaticOrder S; S.init(l == 1 ? 64 : NPAN, 4, F.G, (int)blockIdx.x, PROJ + PU, LDP, (const bf16_t*)(WGT + W_GLU), 1024, 1024, l == 1);
                EpiGlu E{PROJ, INP(I_GLUB) + l * 1024};
                pg8::gemm_phase<EpiGlu, pg8::StaticOrder>(F.lds + RING_OFF, g, S, E, F.tid);
            PH_END
            PH_BEGIN
                pg8::Gemm g{LDP, 3072, 3072}; pg8::StaticOrder S; S.init(l == 1 ? 64 : NPAN, 8, F.G, (int)blockIdx.x, PROJ, LDP, (const bf16_t*)(WGT + W_B), 3072, 3072, l == 1);
                EpiMerge E{PROJ, HM};
                pg8::gemm_phase<EpiMerge, pg8::StaticOrder, 0, true>(F.lds + RING_OFF, g, S, E, F.tid);
            PH_END
        }
        PH_BEGIN
            const int RK = (j == 1) ? D : DFF; const bf16_t* RA = (j == 1) ? HM : PROJ; const bf16_t* RBt = (j == 1) ? (const bf16_t*)(WGT + W_O) : (const bf16_t*)(WGT + W_2) + (size_t)(j >> 1) * D * DFF;
            const int lat = (l == 1 && j >= 1); pg8::Gemm g{RK, RK, RK}; pg8::StaticOrder S; S.init(64, D / 256, F.G, (int)blockIdx.x, RA, RK, RBt, RK, RK, 1, lat ? 0 : 128);
            const float* lg_ = (s == 0) ? (const float*)(ws + WS_IDENT) : INP(I_LNG) + (size_t)(s - 1) * D; const float* lb_ = (s == 0) ? (const float*)(ws + WS_IDENT) + 2048 : INP(I_LNB) + (size_t)(s - 1) * D;
            EpiResid E{(_Float16*)(ws + WS_H), (float*)(ws + WS_HC), MOD + (size_t)l * 5 * NMOD + (3 * j + 2) * D, lg_, lb_, (const float*)(ws + WS_STATS)};
            pg8::gemm_phase<EpiResid, pg8::StaticOrder>(F.lds + RING_OFF, g, S, E, F.tid);
        PH_END
        PH_BEGIN
            const bool fin = (s == 5);
            const int ln_ = (j == 2) ? l + 1 : l, jn = (j == 2) ? 0 : j + 1;
            ln_pass(F, true, INP(I_LNG) + (size_t)(l * 3 + j) * D, INP(I_LNB) + (size_t)(l * 3 + j) * D, fin ? nullptr : MOD + (size_t)ln_ * 5 * NMOD + 3 * jn * D, fin ? args.out : nullptr);
            if (s == 2) { s5_setup(args, F, 1); __syncthreads(); convert_layer_weights(args, F, 1); }
        PH_END
    }
#undef PH_BEGIN
#undef PH_END
}

static int count_phases() { int n = 2; for (int s = 0; s < 6; ++s) n += ((s % 3) != 1 ? 1 : 6) + 2; return n; }
extern "C" void kernel_launch(void* const* d_in, const int* in_sizes, int n_in, void* d_out, int out_size, void* d_ws, size_t ws_size, hipStream_t stream) {
    static int grid = 0;
    if (grid == 0) {
        if (n_in != 32 || out_size != NB * SEQ * D || ws_size < WS_END) { fprintf(stderr, "kernel_launch: unexpected shapes (n_in %d, out %d, ws %zu < %zu)\n", n_in, out_size, ws_size, (size_t)WS_END); grid = -1; return; }
        int dev = 0, cus = 0, per_cu = 0;
        if (hipGetDevice(&dev) != hipSuccess || hipDeviceGetAttribute(&cus, hipDeviceAttributeMultiprocessorCount, dev) != hipSuccess) { grid = -1; return; }
        if (hipFuncSetAttribute((const void*)trunk_fwd, hipFuncAttributeMaxDynamicSharedMemorySize, LDS_BYTES) != hipSuccess) { fprintf(stderr, "kernel_launch: hipFuncSetAttribute failed\n"); grid = -1; return; }
        if (hipOccupancyMaxActiveBlocksPerMultiprocessor(&per_cu, (const void*)trunk_fwd, NWAVES * 64, LDS_BYTES) != hipSuccess || per_cu < 1) fprintf(stderr, "kernel_launch: occupancy query says %d\n", per_cu);
        (void)hipGetLastError();
        if (cus != 256) { fprintf(stderr, "kernel_launch: this kernel deals its SSD chains / carries / attention units over exactly 256 workgroups (one per CU); device reports %d CUs; nothing launched\n", cus); grid = -1; return; }
        grid = cus;
    }
    if (grid < 0) return;
    (void)in_sizes;
    if (hipMemsetAsync((char*)d_ws + WS_CTL, 0, 2 * MiB  , stream) != hipSuccess) return;
    Args a{};
    for (int i = 0; i < 32; ++i) a.in[i] = (const float*)d_in[i];
    a.out = (float*)d_out; a.ws = (unsigned char*)d_ws;
    const int nph = count_phases();
#if MK_PER_PHASE
    for (int p = 0; p < nph; ++p) { a.ph_lo = p; a.ph_hi = p + 1; hipLaunchKernelGGL(trunk_fwd, dim3(grid), dim3(NWAVES * 64), LDS_BYTES, stream, a); }
#else
    a.ph_lo = 0; a.ph_hi = nph;
    hipLaunchKernelGGL(trunk_fwd, dim3(grid), dim3(NWAVES * 64), LDS_BYTES, stream, a);
#endif
    const hipError_t le = hipPeekAtLastError();
    if (le != hipSuccess) fprintf(stderr, "kernel_launch: launch failed: %s\n", hipGetErrorName(le));
}
```

```cpp
#include <hip/hip_runtime.h>
#include <hip/hip_bf16.h>
#include <cstdio>
#include <cstdint>
#include <cmath>

#ifndef MK_PER_PHASE
#define MK_PER_PHASE 0
#endif

#define LAS __attribute__((address_space(3)))
#define GAS __attribute__((address_space(1)))
typedef unsigned short bf16_t;
typedef short bf16x8 __attribute__((ext_vector_type(8)));
typedef float f32x4 __attribute__((ext_vector_type(4)));
typedef float f32x2 __attribute__((ext_vector_type(2)));
typedef float f32x16 __attribute__((ext_vector_type(16)));
typedef unsigned u32x4 __attribute__((ext_vector_type(4)));
typedef unsigned u32x2 __attribute__((ext_vector_type(2)));
typedef short s16x4 __attribute__((ext_vector_type(4)));

constexpr int NB = 4, SEQ = 4096, CTX = 256, RB = SEQ + CTX  , R = NB * RB  , NPAN = R / 256  , PPB = RB / 256  ;
constexpr int D = 2048, DFF = 5632, N13 = 2 * DFF, NMOD = 9 * D  ;
constexpr int LDP = 13312;
constexpr int NIN = 13568;
constexpr int PQ = 0, PK = 1024, PV = 2048, PZ = 3072, PX = 4096, PU = 6144, PG = 7168;
constexpr float DN_ALPHA = 1.41421356237309515f;
constexpr float LN_EPS = 1e-5f, RMS_EPS = 1e-6f;
constexpr float QSCALE = 0.125f * 1.4426950408889634f;

constexpr size_t MiB = 1u << 20;
constexpr size_t WS_CTL = 0, CTL_ZERO_BYTES = 1 * MiB;
constexpr size_t WS_MOD = 1 * MiB;
constexpr size_t WS_ROPE = 2 * MiB;
constexpr size_t WS_STATS = 2 * MiB + 65536;
constexpr size_t WS_IDENT = 2 * MiB + 262144;
constexpr size_t WS_MODP = 3 * MiB;
constexpr size_t WS_DT = 15 * MiB;
constexpr size_t WS_H = 18 * MiB;
constexpr size_t WS_HC = WS_H + 68 * MiB;
constexpr size_t WS_HM = 154 * MiB;
constexpr size_t WS_PROJ = 222 * MiB;
constexpr size_t WS_O = 664 * MiB;
constexpr size_t WS_YD = 732 * MiB;
constexpr size_t WS_YS = 800 * MiB;
constexpr size_t WS_W = 868 * MiB;
constexpr size_t W_13 = 0, W_2 = 88 * MiB, W_IN = 132 * MiB, W_B = 185 * MiB, W_O = 197 * MiB, W_GLU = 205 * MiB;
constexpr size_t WS_S5ST = 1075 * MiB;
constexpr size_t WS_S5H = 1143 * MiB;
constexpr size_t WS_S5M = 1183 * MiB;
constexpr size_t WS_S5A = 1207 * MiB;
constexpr size_t WS_GQ0 = WS_O + 34 * MiB, WS_GQ1 = WS_YS + 34 * MiB, WS_GQ2 = 1208 * MiB;
constexpr size_t WS_END = 1242 * MiB;
__device__ __forceinline__ size_t gq_off(int j) { return j == 0 ? WS_GQ0 : (j == 1 ? WS_GQ1 : WS_GQ2); }
constexpr int S5M = 1088;
constexpr int CW_BAR = 4096;

__device__ __forceinline__ unsigned cvt_pk_bf16(float lo, float hi) { unsigned r; asm volatile("v_cvt_pk_bf16_f32 %0, %1, %2" : "=v"(r) : "v"(lo), "v"(hi)); return r; }
__device__ __forceinline__ float bflo(unsigned u) { return __uint_as_float(u << 16); }
__device__ __forceinline__ float bfhi(unsigned u) { return __uint_as_float(u & 0xffff0000u); }
__device__ __forceinline__ float bf1(bf16_t h) { return __uint_as_float((unsigned)h << 16); }
typedef _Float16 h16x2 __attribute__((ext_vector_type(2)));
typedef _Float16 h16x4 __attribute__((ext_vector_type(4)));
__device__ __forceinline__ f32x4 ld_h4(const _Float16* p) { const h16x4 h = *(const h16x4*)p; return (f32x4){(float)h[0], (float)h[1], (float)h[2], (float)h[3]}; }
__device__ __forceinline__ void st_h4(_Float16* p, f32x4 v) { h16x4 h; h[0] = (_Float16)v[0]; h[1] = (_Float16)v[1]; h[2] = (_Float16)v[2]; h[3] = (_Float16)v[3]; *(h16x4*)p = h; }
__device__ __forceinline__ float sigmoidf_(float x) { return __builtin_amdgcn_rcpf(1.0f + __builtin_amdgcn_exp2f(-1.4426950408889634f * x)); }
__device__ __forceinline__ float siluf_(float x) { return x * sigmoidf_(x); }
__device__ __forceinline__ int lane_now() { int l; asm volatile("v_mbcnt_lo_u32_b32 %0, -1, 0\n\tv_mbcnt_hi_u32_b32 %0, -1, %0" : "=v"(l)); return l; }
__device__ __forceinline__ float shx(float v, int m, int lane) { return __int_as_float(__builtin_amdgcn_ds_bpermute((lane ^ m) << 2, __float_as_int(v))); }
__device__ __forceinline__ float wave_sum(float v, int lane) {
#pragma unroll
    for (int o = 1; o < 64; o <<= 1) v += shx(v, o, lane);
    return v;
}
#define LDS_WAIT() asm volatile("s_waitcnt lgkmcnt(0)" ::: "memory")
#define VM_WAIT() asm volatile("s_waitcnt vmcnt(0)" ::: "memory")

namespace pg8 {
constexpr int BM = 256, BK = 64, HALF = 128, HTB = HALF * BK * 2, STAGE_BYTES = 8 * HTB, NXCD = 8, WGM = 8, PPB_ = 17;
__host__ __device__ __forceinline__ int lds_byte(int r, int c) { const int st = (r >> 4) * 2 + (c >> 5), rr = r & 15, cc = c & 31, ob = rr * 64 + cc * 2; return st * 1024 + (ob ^ (((ob >> 9) & 1) << 5)); }
__host__ __device__ __forceinline__ void stage_rc(int b, int& R_, int& C_) { const int st = b / 1024, sb = b % 1024, swz = sb ^ (((sb >> 9) & 1) << 5); R_ = (st >> 1) * 16 + swz / 64; C_ = (st & 1) * 32 + (swz % 64) / 2; }

struct Unit { int pm, pn, aux, kt; const char* a; const char* b; };
struct Gemm { int lda, ldb, K; };

__device__ __forceinline__ void xcd_remap(int L, int nM, int nN, int& pm, int& pn) {
    const int nwg = nM * nN; int wgid = L;
    { const int q = nwg / NXCD, r = nwg % NXCD, xcd = wgid % NXCD, off = wgid / NXCD; wgid = (xcd < r ? xcd * (q + 1) : r * (q + 1) + (xcd - r) * q) + off; }
    const int nig = WGM * nN, gid = wgid / nig, fm = gid * WGM, gsz = (nM - fm) < WGM ? (nM - fm) : WGM;
    pm = fm + ((wgid % nig) % gsz); pn = (wgid % nig) / gsz;
}
struct StaticOrder {
    int nM, nN, nwg, G, c, kt, latonly, nctx; const char* A; const char* B; size_t tA, tB;
    __device__ __forceinline__ void init(int nM_, int nN_, int G_, int c_, const void* A_, int lda, const void* B_, int ldb, int K, int latonly_ = 0, int nctx_ = 0) { nM = nM_; nN = nN_; nwg = nM * nN; G = G_; c = c_; kt = K / BK; latonly = latonly_; nctx = nctx_;
        A = (const char*)A_; B = (const char*)B_; tA = (size_t)BM * lda * 2; tB = (size_t)BM * ldb * 2; }
    __device__ __forceinline__ bool next(int i, Unit& u) const {
        const long L = (long)i * G + c;
        if (L < nwg) { xcd_remap((int)L, nM, nN, u.pm, u.pn); if (latonly) u.pm += (u.pm >> 4) + 1; u.aux = 0; u.kt = kt; u.a = A + (size_t)u.pm * tA; u.b = B + (size_t)u.pn * tB; return true; }
        const int x = (int)(L - nwg); if (x >= nctx) return false;
        const int q = x & 3, t2 = x >> 2; u.pm = PPB_ * (t2 / nN); u.pn = t2 % nN; u.aux = 1; u.kt = kt >> 2;
        u.a = A + (size_t)u.pm * tA + (size_t)q * (kt >> 2) * BK * 2; u.b = B + (size_t)u.pn * tB + (size_t)q * (kt >> 2) * BK * 2; return true;
    }
};
template <class Epi, class Sched, int AMODE = 0, bool HOOK = false>
__device__ __forceinline__ void gemm_phase(LAS unsigned char* lds, const Gemm g, const Sched& S, const Epi& E, const int tid) {
    const int wid = __builtin_amdgcn_readfirstlane(tid >> 6), lane = tid & 63, wr = wid >> 2, wc = wid & 3, fr = lane & 15, fq = lane >> 4;
    unsigned voffA[2], voffB[2];
#pragma unroll
    for (int i = 0; i < 2; ++i) { int R_, C_; stage_rc(tid * 16 + i * 8192, R_, C_);
        voffA[i] = (AMODE == 1) ? (unsigned)((R_ * 16 + (C_ >> 4)) * LDP + (C_ & 15)) * 2u : (unsigned)(R_ * g.lda + C_) * 2u; voffB[i] = (unsigned)(R_ * g.ldb + C_) * 2u; }
    const size_t kstep = (size_t)(BK * 2), kstepA = (AMODE == 1) ? (size_t)(4 * LDP * 2) : kstep;
    const size_t hstepA = (AMODE == 1) ? (size_t)HALF * 16 * LDP * 2 : (size_t)HALF * g.lda * 2, hstepB = (size_t)HALF * g.ldb * 2;
    const unsigned ldsw = (unsigned)wid * 1024u;
    const int aoff = lds_byte(wr * 64 + fr, fq * 8), boff = lds_byte(wc * 32 + fr, fq * 8);
#define PG8_SA(b, h) (((b) * 2 + (h)) * HTB)
#define PG8_SB(b, h) ((4 + (b) * 2 + (h)) * HTB)
#define PG8_STAGE(bufoff, gbase, voff) do { _Pragma("unroll") for (int _i = 0; _i < 2; ++_i) \
        __builtin_amdgcn_global_load_lds((const unsigned*)((const char*)(gbase) + (voff)[_i]), (LAS unsigned*)(lds + (bufoff) + ldsw + _i * 8192), 16, 0, 0); } while (0)
#define PG8_LDA(dst, b, h) do { _Pragma("unroll") for (int m = 0; m < 4; ++m) _Pragma("unroll") for (int k = 0; k < 2; ++k) dst[m][k] = *(const LAS bf16x8*)(lds + PG8_SA(b, h) + aoff + m * 2048 + k * 1024); } while (0)
#define PG8_LDB(dst, b, h) do { _Pragma("unroll") for (int n = 0; n < 2; ++n) _Pragma("unroll") for (int k = 0; k < 2; ++k) dst[n][k] = *(const LAS bf16x8*)(lds + PG8_SB(b, h) + boff + n * 2048 + k * 1024); } while (0)
#define PG8_MMA(ai, bj, At, Bt) do { __builtin_amdgcn_s_setprio(1); _Pragma("unroll") for (int m = 0; m < 4; ++m) _Pragma("unroll") for (int n = 0; n < 2; ++n) _Pragma("unroll") for (int k = 0; k < 2; ++k) \
        acc[ai][bj][m][n] = __builtin_amdgcn_mfma_f32_16x16x32_bf16(Bt[n][k], At[m][k], acc[ai][bj][m][n], 0, 0, 0); __builtin_amdgcn_s_setprio(0); } while (0)
#define PG8_WAIT_V(n) asm volatile("s_waitcnt vmcnt(" #n ")" ::: "memory")
#define PG8_WAIT_L(n) asm volatile("s_waitcnt lgkmcnt(" #n ")" ::: "memory")
#define PG8_BAR __builtin_amdgcn_s_barrier()
#define PG8_SCHED __builtin_amdgcn_sched_barrier(0)
    Unit cur, nxt; int ui = 0;
    if (!S.next(0, cur)) return;
    f32x4 acc[2][2][4][2];
#pragma unroll
    for (int a = 0; a < 2; ++a)
#pragma unroll
        for (int b = 0; b < 2; ++b)
#pragma unroll
            for (int m = 0; m < 4; ++m)
#pragma unroll
                for (int n = 0; n < 2; ++n) acc[a][b][m][n] = (f32x4){0.f, 0.f, 0.f, 0.f};
    bf16x8 At[4][2], B0[2][2], B1[2][2];
    const char* cA = cur.a; const char* cB = cur.b;
    PG8_STAGE(PG8_SB(0, 0), cB, voffB); PG8_STAGE(PG8_SB(0, 1), cB + hstepB, voffB); PG8_STAGE(PG8_SA(0, 0), cA, voffA); PG8_STAGE(PG8_SA(0, 1), cA + hstepA, voffA);
    if (wr == 1) PG8_BAR;
    PG8_WAIT_V(2); PG8_BAR;
    PG8_STAGE(PG8_SB(1, 0), cB + kstep, voffB); PG8_STAGE(PG8_SA(1, 0), cA + kstepA, voffA); PG8_STAGE(PG8_SB(1, 1), cB + hstepB + kstep, voffB);
    PG8_WAIT_V(6); PG8_BAR;
    for (;;) {
        const bool has_next = S.next(ui + 1, nxt);
        const char* nA = has_next ? nxt.a : cA; const char* nB = has_next ? nxt.b : cB;
        const int nt = cur.kt;
        for (int t = 0; t < nt; t += 2) {
            const bool last = (t == nt - 2);
            if constexpr (HOOK) { if (t == 16 || t == 32) E.mid(acc, cur, t >> 4, wr, wc); }
            const char* a1 = cA + (size_t)(t + 1) * kstepA;
            const char* a2 = last ? nA : cA + (size_t)(t + 2) * kstepA; const char* b2 = last ? nB : cB + (size_t)(t + 2) * kstep;
            const char* a3 = a2 + kstepA; const char* b3 = b2 + kstep;
            PG8_LDB(B0, 0, 0); PG8_LDB(B1, 0, 1); PG8_SCHED; PG8_LDA(At, 0, 0); PG8_STAGE(PG8_SA(1, 1), a1 + hstepA, voffA);
            PG8_WAIT_V(8); PG8_WAIT_L(0); PG8_BAR; PG8_MMA(0, 0, At, B0); PG8_MMA(0, 1, At, B1); PG8_BAR; PG8_SCHED;
            PG8_LDA(At, 0, 1); PG8_STAGE(PG8_SB(0, 0), b2, voffB); PG8_STAGE(PG8_SB(0, 1), b2 + hstepB, voffB); PG8_STAGE(PG8_SA(0, 0), a2, voffA);
            PG8_WAIT_V(8); PG8_WAIT_L(0); PG8_BAR; PG8_MMA(1, 0, At, B0); PG8_MMA(1, 1, At, B1); PG8_BAR; PG8_SCHED;
            PG8_LDB(B0, 1, 0); PG8_LDB(B1, 1, 1); PG8_SCHED; PG8_LDA(At, 1, 0); PG8_STAGE(PG8_SA(0, 1), a2 + hstepA, voffA);
            PG8_WAIT_V(8); PG8_WAIT_L(0); PG8_BAR; PG8_MMA(0, 0, At, B0); PG8_MMA(0, 1, At, B1); PG8_BAR; PG8_SCHED;
            PG8_LDA(At, 1, 1); PG8_STAGE(PG8_SB(1, 0), b3, voffB); PG8_STAGE(PG8_SB(1, 1), b3 + hstepB, voffB); PG8_STAGE(PG8_SA(1, 0), a3, voffA);
            PG8_WAIT_V(8); PG8_WAIT_L(0); PG8_BAR; PG8_MMA(1, 0, At, B0); PG8_MMA(1, 1, At, B1); PG8_BAR; PG8_SCHED;
        }
        if (wr == 0) PG8_BAR;
        E(acc, cur, wr, wc, fr, fq);
        if (!has_next) break;
#pragma unroll
        for (int a = 0; a < 2; ++a)
#pragma unroll
            for (int b = 0; b < 2; ++b)
#pragma unroll
                for (int m = 0; m < 4; ++m)
#pragma unroll
                    for (int n = 0; n < 2; ++n) acc[a][b][m][n] = (f32x4){0.f, 0.f, 0.f, 0.f};
        cur = nxt; cA = nA; cB = nB; ++ui;
        if (wr == 1) PG8_BAR;
    }
    PG8_WAIT_V(0);
    PG8_BAR;
#undef PG8_SA
#undef PG8_SB
#undef PG8_STAGE
#undef PG8_LDA
#undef PG8_LDB
#undef PG8_MMA
#undef PG8_WAIT_V
#undef PG8_WAIT_L
#undef PG8_BAR
#undef PG8_SCHED
}
}

struct EpiSwiGLU {
    bf16_t* O;
    __device__ __forceinline__ void operator()(const f32x4 (&acc)[2][2][4][2], const pg8::Unit& u, int wr, int wc, int, int) const { const int ln_ = lane_now(); const int fr = ln_ & 15, fq = ln_ >> 4;
        const int row0 = u.pm * 256 + wr * 64 + fr, hc0 = u.pn * 128 + wc * 16 + 4 * fq;
#pragma unroll
        for (int ai = 0; ai < 2; ++ai)
#pragma unroll
            for (int m = 0; m < 4; ++m) { bf16_t* rowp = O + (size_t)(row0 + ai * 128 + m * 16) * DFF + hc0;
#pragma unroll
                for (int bj = 0; bj < 2; ++bj) { const f32x4 a = acc[ai][bj][m][0], b = acc[ai][bj][m][1];
                    u32x2 w; w.x = cvt_pk_bf16(siluf_(a[0]) * b[0], siluf_(a[1]) * b[1]); w.y = cvt_pk_bf16(siluf_(a[2]) * b[2], siluf_(a[3]) * b[3]);
                    *(u32x2*)(rowp + bj * 64) = w; } }
    }
};
struct EpiResid {
    _Float16* H; float* HC; const float* gate; const float* lng; const float* lnb; const float* stats;
    __device__ __forceinline__ void operator()(const f32x4 (&acc)[2][2][4][2], const pg8::Unit& u, int wr, int wc, int, int) const { const int ln_ = lane_now(); const int fr = ln_ & 15, fq = ln_ >> 4;
        const int pp = u.pm % PPB, mi = (pp == 0) ? 4 : (u.pm / PPB);
        const int rl0 = wr * 64 + fr, col0 = u.pn * 256 + wc * 32 + 4 * fq;
        if (u.aux) {
            float* hc = HC + (size_t)(u.pm / PPB) * 256 * D;
#pragma unroll
            for (int bj = 0; bj < 2; ++bj)
#pragma unroll
                for (int n = 0; n < 2; ++n) { const f32x4 gv = *(const f32x4*)(gate + (size_t)mi * NMOD + col0 + bj * 128 + n * 16);
#pragma unroll
                    for (int ai = 0; ai < 2; ++ai)
#pragma unroll
                        for (int m = 0; m < 4; ++m) { float* p = hc + (size_t)(rl0 + ai * 128 + m * 16) * D + col0 + bj * 128 + n * 16; const f32x4 v = gv * acc[ai][bj][m][n];
                            unsafeAtomicAdd(p, v[0]); unsafeAtomicAdd(p + 1, v[1]); unsafeAtomicAdd(p + 2, v[2]); unsafeAtomicAdd(p + 3, v[3]); } }
            return;
        }
        f32x2 st[2][4];
#pragma unroll
        for (int ai = 0; ai < 2; ++ai)
#pragma unroll
            for (int m = 0; m < 4; ++m) st[ai][m] = *(const f32x2*)(stats + (size_t)(u.pm * 256 + rl0 + ai * 128 + m * 16) * 2);
#pragma unroll
        for (int bj = 0; bj < 2; ++bj) {
            h16x4 tv[2][2][4];
#pragma unroll
            for (int n = 0; n < 2; ++n)
#pragma unroll
                for (int ai = 0; ai < 2; ++ai)
#pragma unroll
                    for (int m = 0; m < 4; ++m) tv[n][ai][m] = *(const h16x4*)(H + (size_t)(u.pm * 256 + rl0 + ai * 128 + m * 16) * D + col0 + bj * 128 + n * 16);
#pragma unroll
            for (int n = 0; n < 2; ++n) { const int c = col0 + bj * 128 + n * 16; const f32x4 gv = *(const f32x4*)(gate + (size_t)mi * NMOD + c);
                const f32x4 g4 = *(const f32x4*)(lng + c) * DN_ALPHA, b4 = *(const f32x4*)(lnb + c) * DN_ALPHA;
#pragma unroll
                for (int ai = 0; ai < 2; ++ai)
#pragma unroll
                    for (int m = 0; m < 4; ++m) { const h16x4 h = tv[n][ai][m]; const f32x4 t = (f32x4){(float)h[0], (float)h[1], (float)h[2], (float)h[3]};
                        st_h4(H + (size_t)(u.pm * 256 + rl0 + ai * 128 + m * 16) * D + c, (t - st[ai][m].x) * st[ai][m].y * g4 + b4 + gv * acc[ai][bj][m][n]); } }
            asm volatile("" ::: "memory"); }
    }
};
struct EpiProj {
    bf16_t* P; float* DT; const float* rc; const float* rs; bf16_t* U2;
    __device__ __forceinline__ void operator()(const f32x4 (&acc)[2][2][4][2], const pg8::Unit& u, int wr, int wc, int, int) const { const int ln_ = lane_now(); const int fr = ln_ & 15, fq = ln_ >> 4;
        const int pp = u.pm % PPB; const int row0 = u.pm * 256 + wr * 64 + fr;
        const int pn = u.pn;
        if (pn == 52) {
            if (wc == 0) {
#pragma unroll
                for (int ai = 0; ai < 2; ++ai)
#pragma unroll
                    for (int m = 0; m < 4; ++m)
#pragma unroll
                        for (int n = 0; n < 2; ++n) *(f32x4*)(DT + (size_t)(row0 + ai * 128 + m * 16) * 32 + n * 16 + 4 * fq) = acc[ai][0][m][n];
            }
            return;
        }
        if (pn >= 28) {
            const int jg = (pn - 28) >> 3, pnd = (pn - 28) & 7;
            unsigned char* gq = (unsigned char*)P - WS_PROJ + gq_off(jg) + ((size_t)((u.pm * 8 + pnd) * 512 + (wr * 4 + wc) * 64 + ln_)) * 128;
#pragma unroll
            for (int ai = 0; ai < 2; ++ai)
#pragma unroll
                for (int m = 0; m < 4; ++m) { u32x4 w;
#pragma unroll
                    for (int bj = 0; bj < 2; ++bj)
#pragma unroll
                        for (int n = 0; n < 2; ++n) { const f32x4 v = acc[ai][bj][m][n]; unsigned q = 0;
#pragma unroll
                            for (int e = 0; e < 4; ++e) q |= (unsigned)fmaxf(__builtin_rintf(sigmoidf_(v[e]) * 255.0f), 1.0f) << (8 * e);
                            w[bj * 2 + n] = q; }
                    *(u32x4*)(gq + (ai * 4 + m) * 16) = w; }
            return;
        }
        const int col0 = pn * 256 + wc * 32 + 4 * fq;
        const int mode = (pn < 8) ? ((pp != 0) ? 1 : 0) : ((pn >= 12 && pn < 16) ? 2 : 0);
        const float sc = (pn < 4) ? QSCALE : 1.0f;
#pragma unroll
        for (int ai = 0; ai < 2; ++ai)
#pragma unroll
            for (int m = 0; m < 4; ++m) { const int rl = ai * 128 + wr * 64 + m * 16 + fr; bf16_t* rowp = P + (size_t)(u.pm * 256 + rl) * LDP + col0;
                f32x4 cs = (f32x4){1.f, 1.f, 1.f, 1.f}, sn = (f32x4){0.f, 0.f, 0.f, 0.f};
                if (mode == 1) { const int t = (pp - 1) * 256 + rl; const int pos = (wc & 1) ? (t & 63) : (t >> 6); cs = *(const f32x4*)(rc + pos * 16 + 4 * fq); sn = *(const f32x4*)(rs + pos * 16 + 4 * fq); }
#pragma unroll
                for (int bj = 0; bj < 2; ++bj) { f32x4 v0 = acc[ai][bj][m][0], v1 = acc[ai][bj][m][1];
                    if (mode == 1) { const f32x4 o0 = v0 * cs - v1 * sn, o1 = v1 * cs + v0 * sn; v0 = o0; v1 = o1; }
                    else if (mode == 2) {
#pragma unroll
                        for (int e = 0; e < 4; ++e) { v0[e] = siluf_(v0[e]); v1[e] = siluf_(v1[e]); } }
                    if (pn >= 24 && pn < 28) {
                        bf16_t* u2 = U2 + ((size_t)(((pn - 24) * 256 + bj * 128 + wc * 32) >> 4) * R + (size_t)(u.pm * 256 + rl)) * 16 + 4 * fq;
                        u32x2 a0, a1; a0.x = cvt_pk_bf16(v0[0], v0[1]); a0.y = cvt_pk_bf16(v0[2], v0[3]); a1.x = cvt_pk_bf16(v1[0], v1[1]); a1.y = cvt_pk_bf16(v1[2], v1[3]);
                        *(u32x2*)u2 = a0; *(u32x2*)(u2 + (size_t)R * 16) = a1; continue; }
                    v0 = v0 * sc; v1 = v1 * sc;
                    u32x2 w0, w1; w0.x = cvt_pk_bf16(v0[0], v0[1]); w0.y = cvt_pk_bf16(v0[2], v0[3]); w1.x = cvt_pk_bf16(v1[0], v1[1]); w1.y = cvt_pk_bf16(v1[2], v1[3]);
                    *(u32x2*)(rowp + bj * 128) = w0; *(u32x2*)(rowp + bj * 128 + 16) = w1; } }
    }
};
struct EpiGlu {
    bf16_t* P; const float* bias;
    __device__ __forceinline__ void operator()(const f32x4 (&acc)[2][2][4][2], const pg8::Unit& u, int wr, int wc, int, int) const { const int ln_ = lane_now(); const int fr = ln_ & 15, fq = ln_ >> 4;
        const int row0 = u.pm * 256 + wr * 64 + fr, col0 = u.pn * 256 + wc * 32 + 4 * fq;
#pragma unroll
        for (int ai = 0; ai < 2; ++ai)
#pragma unroll
            for (int m = 0; m < 4; ++m) { bf16_t* rowp = P + (size_t)(row0 + ai * 128 + m * 16) * LDP;
#pragma unroll
                for (int bj = 0; bj < 2; ++bj)
#pragma unroll
                    for (int n = 0; n < 2; ++n) { const int c = col0 + bj * 128 + n * 16; const f32x4 bv = *(const f32x4*)(bias + c); const u32x2 tv = *(const u32x2*)(rowp + PU + c);
                        const f32x4 a = acc[ai][bj][m][n] + bv; u32x2 w;
                        w.x = cvt_pk_bf16(bflo(tv.x) * sigmoidf_(a[0]), bfhi(tv.x) * sigmoidf_(a[1])); w.y = cvt_pk_bf16(bflo(tv.y) * sigmoidf_(a[2]), bfhi(tv.y) * sigmoidf_(a[3]));
                        *(u32x2*)(rowp + PK + c) = w; } }
    }
};
struct EpiMerge {
    const bf16_t* P; bf16_t* MIXB;
    static __device__ __forceinline__ int jmap(int seg) { return seg == 0 ? 0 : (seg == 1 ? 2 : 1); }
    __device__ __forceinline__ const unsigned char* gbase(const pg8::Unit& u, int seg, int wr, int wc, int ln_) const {
        return (const unsigned char*)P - WS_PROJ + gq_off(jmap(seg)) + ((size_t)((u.pm * 8 + u.pn) * 512 + (wr * 4 + wc) * 64 + ln_)) * 128; }
    __device__ __forceinline__ void mid(f32x4 (&acc)[2][2][4][2], const pg8::Unit& u, int seg, int wr, int wc) const {
        const int ln_ = lane_now(); const unsigned char* ga = gbase(u, seg - 1, wr, wc, ln_); const unsigned char* gb = gbase(u, seg, wr, wc, ln_);
        u32x4 a[2][4], b[2][4];
#pragma unroll
        for (int ai = 0; ai < 2; ++ai)
#pragma unroll
            for (int m = 0; m < 4; ++m) { a[ai][m] = *(const u32x4*)(ga + (ai * 4 + m) * 16); b[ai][m] = *(const u32x4*)(gb + (ai * 4 + m) * 16); }
        asm volatile("s_waitcnt vmcnt(0)" ::: "memory");
#pragma unroll
        for (int ai = 0; ai < 2; ++ai)
#pragma unroll
            for (int m = 0; m < 4; ++m)
#pragma unroll
                for (int bj = 0; bj < 2; ++bj)
#pragma unroll
                    for (int n = 0; n < 2; ++n) { const unsigned qa = a[ai][m][bj * 2 + n], qb = b[ai][m][bj * 2 + n]; f32x4 r;
#pragma unroll
                        for (int e = 0; e < 4; ++e) r[e] = (float)((qa >> (8 * e)) & 255u) * __builtin_amdgcn_rcpf((float)((qb >> (8 * e)) & 255u));
                        acc[ai][bj][m][n] = acc[ai][bj][m][n] * r; }
    }
    __device__ __forceinline__ void operator()(const f32x4 (&acc)[2][2][4][2], const pg8::Unit& u, int wr, int wc, int, int) const { const int ln_ = lane_now(); const int fr = ln_ & 15, fq = ln_ >> 4;
        const int row0 = u.pm * 256 + wr * 64 + fr, col0 = u.pn * 256 + wc * 32 + 4 * fq; const unsigned char* gl = gbase(u, 2, wr, wc, ln_);
#pragma unroll
        for (int ai = 0; ai < 2; ++ai)
#pragma unroll
            for (int m = 0; m < 4; ++m) { const size_t row = (size_t)(row0 + ai * 128 + m * 16); const u32x4 g4 = *(const u32x4*)(gl + (ai * 4 + m) * 16);
#pragma unroll
                for (int bj = 0; bj < 2; ++bj)
#pragma unroll
                    for (int n = 0; n < 2; ++n) { const int c = col0 + bj * 128 + n * 16; const unsigned gv = g4[bj * 2 + n];
                        f32x4 v = acc[ai][bj][m][n];
#pragma unroll
                        for (int e = 0; e < 4; ++e) v[e] *= (float)((gv >> (8 * e)) & 255u) * (1.0f / 255.0f);
                        u32x2 w; w.x = cvt_pk_bf16(v[0], v[1]); w.y = cvt_pk_bf16(v[2], v[3]); *(u32x2*)(MIXB + row * D + c) = w; } }
    }
};

struct S5AOrder {
    int G, c; const char* A; const char* B;
    __device__ __forceinline__ bool next(int i, pg8::Unit& u) const {
        const int idx = i * G + c; if (idx >= 640) return false;
        const int g = idx / 10, r = idx - 10 * g, nt = r / 5, mt = r - 5 * nt;
        u.pm = mt; u.pn = nt; u.aux = g; u.kt = 4; u.a = A + ((size_t)g * (R / 16) + (size_t)mt * 256) * 256 * 2; u.b = B + (size_t)(g * 512 + nt * 256) * 256 * 2; return true;
    }
};
struct EpiS5A {
    bf16_t* YL; bf16_t* ST;
    __device__ __forceinline__ void operator()(const f32x4 (&acc)[2][2][4][2], const pg8::Unit& u, int wr, int wc, int, int) const { const int ln_ = lane_now(); const int fr = ln_ & 15, fq = ln_ >> 4;
        const int g = u.aux;
#pragma unroll
        for (int ai = 0; ai < 2; ++ai)
#pragma unroll
            for (int m = 0; m < 4; ++m) { const int mr = u.pm * 256 + ai * 128 + wr * 64 + m * 16 + fr; if (mr < S5M) {
#pragma unroll
                for (int bj = 0; bj < 2; ++bj)
#pragma unroll
                    for (int n = 0; n < 2; ++n) { const f32x4 v = acc[ai][bj][m][n];
                        if (u.pn == 0) { const int rho = 8 * bj + 2 * wc + n; u32x2 w; w.x = cvt_pk_bf16(v[0], v[1]); w.y = cvt_pk_bf16(v[2], v[3]); *(u32x2*)(YL + (size_t)(16 * mr + rho) * 1024 + 16 * g + 4 * fq) = w; }
                        else { u32x2 w; w.x = cvt_pk_bf16(v[0], v[1]); w.y = cvt_pk_bf16(v[2], v[3]); *(u32x2*)(ST + ((size_t)g * S5M + mr) * 256 + bj * 128 + wc * 32 + n * 16 + 4 * fq) = w; } } } }
    }
};
struct S5COrder {
    int G, c; const char* A; const char* B;
    __device__ __forceinline__ bool next(int i, pg8::Unit& u) const {
        const int idx = i * G + c; if (idx >= 320) return false;
        const int g = idx / 5, mt = idx - 5 * g;
        u.pm = mt; u.pn = 0; u.aux = g; u.kt = 4; u.a = A + ((size_t)g * 1280 + mt * 256) * 256 * 2; u.b = B + (size_t)g * 256 * 256 * 2; return true;
    }
};
struct EpiS5C {
    const bf16_t* YL; bf16_t* P;
    __device__ __forceinline__ void operator()(const f32x4 (&acc)[2][2][4][2], const pg8::Unit& u, int wr, int wc, int, int) const { const int ln_ = lane_now(); const int fr = ln_ & 15, fq = ln_ >> 4;
        const int g = u.aux;
#pragma unroll
        for (int ai = 0; ai < 2; ++ai)
#pragma unroll
            for (int m = 0; m < 4; ++m) { const int mr = u.pm * 256 + ai * 128 + wr * 64 + m * 16 + fr; if (mr < S5M) {
#pragma unroll
                for (int bj = 0; bj < 2; ++bj)
#pragma unroll
                    for (int n = 0; n < 2; ++n) { const int rho = 8 * bj + 2 * wc + n; const size_t row = (size_t)(16 * mr + rho);
                        const u32x2 yl = *(const u32x2*)(YL + row * 1024 + 16 * g + 4 * fq); f32x4 v = acc[ai][bj][m][n];
                        v[0] += bflo(yl.x); v[1] += bfhi(yl.x); v[2] += bflo(yl.y); v[3] += bfhi(yl.y);
#pragma unroll
                        for (int e = 0; e < 4; ++e) { const float x = v[e]; const float inner = 0.7978845608028654f * (x + 0.044715f * x * x * x); const float th = 1.0f - 2.0f * __builtin_amdgcn_rcpf(1.0f + __builtin_amdgcn_exp2f(2.8853900817779268f * inner)); v[e] = 0.5f * x * (1.0f + th); }
                        u32x2 w; w.x = cvt_pk_bf16(v[0], v[1]); w.y = cvt_pk_bf16(v[2], v[3]); *(u32x2*)(P + row * LDP + PU + 16 * g + 4 * fq) = w; } } }
    }
};

namespace attn128 {
using bf16 = __hip_bfloat16;
constexpr int NW = 8, QBLK = 32, KVBLK = 64, LDQ = LDP, LDK = LDP, LDOB = LDP;
constexpr size_t SHM_V = KVBLK * 128 * 2, SHM_K = KVBLK * 64 * 2, SHM_ATTN = 2 * SHM_V + 2 * SHM_K + NW * 64 * 4, SHM_TOTAL = SHM_ATTN + NW * 8192;
constexpr float THRL = 11.5f;
#define A128_KSWZ(row, colB) ((row) * 128 + ((colB) ^ (((row) & 7) << 4)))
#define A128_SBAR() __builtin_amdgcn_sched_barrier(0)
__device__ __forceinline__ int crow(int r, int hi) { return (r & 3) + 8 * (r >> 2) + 4 * hi; }
__device__ __forceinline__ void partialSM(f32x16& p0, f32x16& p1, float& m_reg, float& mn, float& alpha) {
  float pmax = p0[0];
#pragma unroll
  for (int r = 1; r < 16; ++r) pmax = fmaxf(pmax, p0[r]);
#pragma unroll
  for (int r = 0; r < 16; ++r) pmax = fmaxf(pmax, p1[r]);
  { auto rr = __builtin_amdgcn_permlane32_swap(__float_as_uint(pmax), __float_as_uint(pmax), false, false); pmax = fmaxf(__uint_as_float(rr[0]), __uint_as_float(rr[1])); }
  if (__builtin_expect(__all(pmax - m_reg <= THRL), 1)) { mn = m_reg; alpha = 1.f; }
  else { mn = fmaxf(m_reg, pmax); alpha = __builtin_amdgcn_exp2f(m_reg - mn); m_reg = mn; }
#pragma unroll
  for (int r = 0; r < 16; ++r) { p0[r] = p0[r] - mn; p1[r] = p1[r] - mn; }
#pragma unroll
  for (int r = 0; r < 16; ++r) p0[r] = __builtin_amdgcn_exp2f(p0[r]);
}
__device__ __forceinline__ void finishSM(f32x16& p0, f32x16& p1, float alpha, float& l_reg, bf16x8& pa0, bf16x8& pa1, bf16x8& pa2, bf16x8& pa3) {
#pragma unroll
  for (int r = 0; r < 16; ++r) p1[r] = __builtin_amdgcn_exp2f(p1[r]);
  float ps = 0;
#pragma unroll
  for (int r = 0; r < 16; ++r) ps += p0[r];
#pragma unroll
  for (int r = 0; r < 16; ++r) ps += p1[r];
  { auto rr = __builtin_amdgcn_permlane32_swap(__float_as_uint(ps), __float_as_uint(ps), false, false); ps = __uint_as_float(rr[0]) + __uint_as_float(rr[1]); }
  l_reg = l_reg * alpha + ps;
#define A128_PK4(P, BASE, OUT) do { unsigned a0 = cvt_pk_bf16(P[BASE + 0], P[BASE + 1]), a1 = cvt_pk_bf16(P[BASE + 2], P[BASE + 3]);   \
    unsigned b0 = cvt_pk_bf16(P[BASE + 4], P[BASE + 5]), b1 = cvt_pk_bf16(P[BASE + 6], P[BASE + 7]);                              \
    auto r0 = __builtin_amdgcn_permlane32_swap(a0, b0, false, false); auto r1 = __builtin_amdgcn_permlane32_swap(a1, b1, false, false); \
    u32x4 w = {r0[0], r1[0], r0[1], r1[1]}; OUT = __builtin_bit_cast(bf16x8, w); } while (0)
  A128_PK4(p0, 0, pa0); A128_PK4(p0, 8, pa1); A128_PK4(p1, 0, pa2); A128_PK4(p1, 8, pa3);
#undef A128_PK4
}
__device__ __forceinline__ void qkt(f32x16& p0, f32x16& p1, const char* Ks, const bf16x8* qr, int r32, int hi) {
#pragma unroll
  for (int i = 0; i < 16; ++i) { p0[i] = 0.f; p1[i] = 0.f; }
#pragma unroll
  for (int d0 = 0; d0 < 4; ++d0) { const int cb = (d0 * 16 + hi * 8) * 2;
    const bf16x8 b0 = *reinterpret_cast<const bf16x8*>(Ks + A128_KSWZ(r32, cb));
    const bf16x8 b1 = *reinterpret_cast<const bf16x8*>(Ks + A128_KSWZ(32 + r32, cb));
    p0 = __builtin_amdgcn_mfma_f32_32x32x16_bf16(b0, qr[d0], p0, 0, 0, 0);
    p1 = __builtin_amdgcn_mfma_f32_32x32x16_bf16(b1, qr[d0], p1, 0, 0, 0); }
}
__device__ __forceinline__ int v_st(int k, int c) { const int kk = (k & ~0xC) | ((k & 4) << 1) | ((k & 8) >> 1); return ((kk >> 3) * 4 + (c >> 5)) * 512 + ((kk & 7) * 32 + (c & 31)) * 2; }
__device__ __forceinline__ int v_rd_base(int lane) { return ((lane & 3) << 3) | (((lane >> 2) & 3) << 6) | (((lane >> 4) & 1) << 5) | (((lane >> 5) & 1) << 8); }
constexpr int v_rd_off(int d0, int ks, int half) { return d0 * 512 + ks * 4096 + half * 2048; }
template <int OFF> __device__ __forceinline__ s16x4 tr_read(int vb) { s16x4 r; asm volatile("ds_read_b64_tr_b16 %0, %1 offset:%2" : "=&v"(r) : "v"(vb), "i"(OFF) : "memory"); return r; }
template <int D0> __device__ __forceinline__ void pv_one(f32x16& od, int vb, bf16x8 pa0, bf16x8 pa1, bf16x8 pa2, bf16x8 pa3) {
  const s16x4 l0 = tr_read<v_rd_off(D0, 0, 0)>(vb), h0 = tr_read<v_rd_off(D0, 0, 1)>(vb), l1 = tr_read<v_rd_off(D0, 1, 0)>(vb), h1 = tr_read<v_rd_off(D0, 1, 1)>(vb);
  const s16x4 l2 = tr_read<v_rd_off(D0, 2, 0)>(vb), h2 = tr_read<v_rd_off(D0, 2, 1)>(vb), l3 = tr_read<v_rd_off(D0, 3, 0)>(vb), h3 = tr_read<v_rd_off(D0, 3, 1)>(vb);
  asm volatile("s_waitcnt lgkmcnt(0)" ::: "memory"); A128_SBAR();
#define A128_PK(L, H) (bf16x8){L[0], L[1], L[2], L[3], H[0], H[1], H[2], H[3]}
  od = __builtin_amdgcn_mfma_f32_32x32x16_bf16(pa0, A128_PK(l0, h0), od, 0, 0, 0);
  od = __builtin_amdgcn_mfma_f32_32x32x16_bf16(pa1, A128_PK(l1, h1), od, 0, 0, 0);
  od = __builtin_amdgcn_mfma_f32_32x32x16_bf16(pa2, A128_PK(l2, h2), od, 0, 0, 0);
  od = __builtin_amdgcn_mfma_f32_32x32x16_bf16(pa3, A128_PK(l3, h3), od, 0, 0, 0);
#undef A128_PK
}
__device__ __forceinline__ void pv_d0(f32x16* o, int vb, bf16x8 pa0, bf16x8 pa1, bf16x8 pa2, bf16x8 pa3) {
  pv_one<0>(o[0], vb, pa0, pa1, pa2, pa3); pv_one<1>(o[1], vb, pa0, pa1, pa2, pa3); pv_one<2>(o[2], vb, pa0, pa1, pa2, pa3); pv_one<3>(o[3], vb, pa0, pa1, pa2, pa3);
}
__device__ __forceinline__ void unit(const bf16* __restrict__ Qb0, const bf16* __restrict__ Kh0, const bf16* __restrict__ Vh, bf16_t* Ob, int seq, char* lds, const int tid_in, const float lam, const float onem, const float* __restrict__ subw) {
#pragma unroll 1
 for (int mp = 0; mp < 2; ++mp) {
  int tid = tid_in; asm volatile("" : "+v"(tid));
  bf16_t* stage = (bf16_t*)(lds + SHM_ATTN) + (tid >> 6) * 4096;
  const bf16* Qb = Qb0 + mp * 64; const bf16* Kh = Kh0 + mp * 64;
  const int wid = __builtin_amdgcn_readfirstlane(tid >> 6), lane = tid & 63, r32 = lane & 31, hi = lane >> 5;
  char* V_lds = lds; char* K_lds = lds + 2 * SHM_V;
  float* ws = (float*)(lds + 2 * SHM_V + 2 * SHM_K) + wid * 64; float* li_l = ws; float* al_l = ws + 32;
  float m_reg = -1e30f, l_reg = 0; f32x16 o[4]; bf16x8 qr[4];
#pragma unroll
  for (int d = 0; d < 4; ++d)
#pragma unroll
    for (int r = 0; r < 16; ++r) o[d][r] = 0.f;
  const bf16* Qw = Qb + (long)(wid * QBLK + r32) * LDQ + hi * 8;
#pragma unroll
  for (int d0 = 0; d0 < 4; ++d0) qr[d0] = *reinterpret_cast<const bf16x8*>(Qw + d0 * 16);
  const int sr = tid >> 4, sc = (tid & 15) * 8, vst0 = v_st(sr, sc), vst1 = v_st(32 + sr, sc);
  const int kr = tid >> 3, kc = (tid & 7) * 8, kst = A128_KSWZ(kr, kc * 2);
  const int vb0 = (int)(uintptr_t)V_lds + v_rd_base(lane);
  struct { bf16x8 vs0, vs1, ks0; } sr_[2];
#define A128_SLOAD(i, k0) do { sr_[i].vs0 = *reinterpret_cast<const bf16x8*>(&Vh[(long)((k0) + sr) * LDK + sc]); sr_[i].vs1 = *reinterpret_cast<const bf16x8*>(&Vh[(long)((k0) + 32 + sr) * LDK + sc]); \
    sr_[i].ks0 = *reinterpret_cast<const bf16x8*>(&Kh[(long)((k0) + kr) * LDK + kc]); } while (0)
#define A128_SWRITE(b, i) do { *(bf16x8*)(V_lds + (b) * SHM_V + vst0) = sr_[i].vs0; *(bf16x8*)(V_lds + (b) * SHM_V + vst1) = sr_[i].vs1; *(bf16x8*)(K_lds + (b) * SHM_K + kst) = sr_[i].ks0; } while (0)
#define A128_SWAIT() asm volatile("s_waitcnt vmcnt(3)" ::: "memory")
#define A128_RESC(a) do { if (__any((a) < 1.f)) { if (hi == 0) al_l[r32] = (a); asm volatile("s_waitcnt lgkmcnt(0)" ::: "memory"); \
    _Pragma("unroll") for (int d = 0; d < 4; ++d) _Pragma("unroll") for (int r = 0; r < 16; ++r) o[d][r] *= al_l[crow(r, hi)]; } } while (0)
  f32x16 pA0, pA1, pB0, pB1; float mnA, mnB, alA, alB; bf16x8 pa0, pa1, pa2, pa3; const int NT = seq / KVBLK;
  A128_SLOAD(0, 0); asm volatile("s_waitcnt vmcnt(0)" ::: "memory"); A128_SWRITE(0, 0); __syncthreads();
  qkt(pA0, pA1, K_lds, qr, r32, hi); partialSM(pA0, pA1, m_reg, mnA, alA);
  A128_SLOAD(1, KVBLK); if (2 < NT) A128_SLOAD(0, 2 * KVBLK);
  A128_SWAIT(); A128_SWRITE(1, 1); __syncthreads();
  for (int j = 1; j + 1 < NT; j += 2) {
    A128_SBAR(); qkt(pB0, pB1, K_lds + SHM_K, qr, r32, hi);
    finishSM(pA0, pA1, alA, l_reg, pa0, pa1, pa2, pa3); A128_SBAR();
    A128_SLOAD(1, (j + 2) * KVBLK); A128_SBAR();
    pv_d0(o, vb0, pa0, pa1, pa2, pa3); partialSM(pB0, pB1, m_reg, mnB, alB);
    __syncthreads(); A128_SWAIT(); A128_SWRITE(0, 0);
    A128_RESC(alB); __syncthreads();
    A128_SBAR(); qkt(pA0, pA1, K_lds, qr, r32, hi);
    finishSM(pB0, pB1, alB, l_reg, pa0, pa1, pa2, pa3); A128_SBAR();
    if (j + 3 < NT) A128_SLOAD(0, (j + 3) * KVBLK); A128_SBAR();
    pv_d0(o, vb0 + (int)SHM_V, pa0, pa1, pa2, pa3); partialSM(pA0, pA1, m_reg, mnA, alA);
    __syncthreads(); A128_SWAIT(); A128_SWRITE(1, 1);
    A128_RESC(alA); __syncthreads();
  }
  A128_SBAR(); qkt(pB0, pB1, K_lds + SHM_K, qr, r32, hi);
  finishSM(pA0, pA1, alA, l_reg, pa0, pa1, pa2, pa3); A128_SBAR();
  pv_d0(o, vb0, pa0, pa1, pa2, pa3); partialSM(pB0, pB1, m_reg, mnB, alB);
  __syncthreads(); A128_RESC(alB);
  finishSM(pB0, pB1, alB, l_reg, pa0, pa1, pa2, pa3); A128_SBAR();
  pv_d0(o, vb0 + (int)SHM_V, pa0, pa1, pa2, pa3);
  if (hi == 0) li_l[r32] = l_reg; asm volatile("s_waitcnt lgkmcnt(0)" ::: "memory");
  float rli[16];
#pragma unroll
  for (int r = 0; r < 16; ++r) rli[r] = __builtin_amdgcn_rcpf(li_l[crow(r, hi)]);
  if (mp == 0) {
#pragma unroll
    for (int r = 0; r < 16; ++r)
#pragma unroll
      for (int d0 = 0; d0 < 4; ++d0) stage[(r * 4 + d0) * 64 + lane] = (bf16_t)(cvt_pk_bf16(o[d0][r] * rli[r], 0.f) & 0xffffu);
  } else {
    float ss[16];
#pragma unroll
    for (int r = 0; r < 16; ++r) { float q = 0.f;
#pragma unroll
      for (int d0 = 0; d0 < 4; ++d0) { const float a = bf1(stage[(r * 4 + d0) * 64 + lane]) - lam * bf1((bf16_t)(cvt_pk_bf16(o[d0][r] * rli[r], 0.f) & 0xffffu)); o[d0][r] = a; q += a * a; }
      ss[r] = q; }
#pragma unroll
    for (int m = 1; m < 32; m <<= 1)
#pragma unroll
      for (int r = 0; r < 16; ++r) ss[r] += __int_as_float(__builtin_amdgcn_ds_bpermute((lane ^ m) << 2, __float_as_int(ss[r])));
    float sw[4];
#pragma unroll
    for (int d0 = 0; d0 < 4; ++d0) sw[d0] = subw[d0 * 32 + r32] * onem;
    bf16_t* Ow = Ob + (long)(wid * QBLK) * LDOB;
#pragma unroll
    for (int r = 0; r < 16; ++r) { const int orow = crow(r, hi); const float rs = 1.0f / sqrtf(ss[r] * (1.f / 128.f) + RMS_EPS);
#pragma unroll
      for (int d0 = 0; d0 < 4; ++d0) Ow[(long)orow * LDOB + d0 * 32 + r32] = (bf16_t)(cvt_pk_bf16(o[d0][r] * rs * sw[d0], 0.f) & 0xffffu); }
  }
  __syncthreads();
 }
#undef A128_SLOAD
#undef A128_SWRITE
#undef A128_SWAIT
#undef A128_RESC
}
#undef A128_KSWZ
#undef A128_SBAR
}

#define XB_TMO      128
#define XB_XCNT(j)  (256  + 64 * (j))
#define XB_XSUB(j)  (1280 + 64 * (j))
#define XB_XGEN(j)  (2304 + 64 * (j))
#define XB_TOP      3328
#define XB_TOPGEN   3392
#define XCD_BAR_WORDS 3456
#define XB_SPIN_CAP (1u << 18)
__device__ __forceinline__ unsigned xb_ld(unsigned* p)              { return __hip_atomic_load(p, __ATOMIC_RELAXED, __HIP_MEMORY_SCOPE_AGENT); }
__device__ __forceinline__ unsigned xb_add(unsigned* p, unsigned v) { return __hip_atomic_fetch_add(p, v, __ATOMIC_RELAXED, __HIP_MEMORY_SCOPE_AGENT); }
__device__ __forceinline__ unsigned xb_xcc_id() { return (unsigned)__builtin_amdgcn_s_getreg((3 << 11) | 20) & 0xFu; }
#define XB_SPIN(cond, bar) do { unsigned _sp = 0; while (cond) { __builtin_amdgcn_s_sleep(1); \
    if ((++_sp & 255u) == 0u) { if (xb_ld(&(bar)[XB_TMO])) break; if (_sp > XB_SPIN_CAP) { atomicAdd(&(bar)[XB_TMO], 1u); break; } } } } while (0)
struct XcdBarrier { unsigned* bar; unsigned x; volatile LAS unsigned* st; };
__device__ __forceinline__ XcdBarrier xcd_barrier_post(unsigned* bar, volatile LAS unsigned* st) {
    XcdBarrier b; b.bar = bar; b.x = xb_xcc_id(); b.st = st;
    if (threadIdx.x == 0) (void)xb_add(&bar[XB_XCNT(b.x)], 1u);
    return b;
}
__device__ __forceinline__ void xcd_barrier_complete(unsigned* bar, unsigned x, unsigned& nloc, unsigned& nx) {
    const unsigned G = gridDim.x * gridDim.y * gridDim.z;
    unsigned sum, cnt, mine, sp = 0u;
    for (;;) {
        sum = 0u; cnt = 0u; mine = 0u;
#pragma unroll
        for (unsigned j = 0; j < 16; ++j) { const unsigned c = xb_ld(&bar[XB_XCNT(j)]); sum += c; cnt += (c > 0u) ? 1u : 0u; mine = (j == x) ? c : mine; }
        if (sum == G) break;
        __builtin_amdgcn_s_sleep(1);
        if ((++sp & 255u) == 0u) { if (xb_ld(&bar[XB_TMO])) break; if (sp > XB_SPIN_CAP) { atomicAdd(&bar[XB_TMO], 1u); break; } }
    }
    nloc = mine > 0u ? mine : 1u; nx = cnt > 0u ? cnt : 1u;
}
__device__ __forceinline__ void xcd_barrier(const XcdBarrier& b, const int tid) {
    asm volatile("s_waitcnt vmcnt(0)" ::: "memory");
    __syncthreads();
    if (tid == 0) {
        unsigned* bar = b.bar;
        __builtin_amdgcn_s_waitcnt(0);
        unsigned nloc = b.st[0], nx = b.st[1];
        if (nloc == 0u) { xcd_barrier_complete(bar, b.x, nloc, nx); b.st[0] = nloc; b.st[1] = nx; }
        const unsigned old = xb_add(&bar[XB_XSUB(b.x)], 1u);
        const unsigned gen = old / nloc;
        if (old + 1u == (gen + 1u) * nloc) {
            __builtin_amdgcn_fence(__ATOMIC_RELEASE, "agent");
            asm volatile("s_waitcnt vmcnt(0)" ::: "memory");
            const unsigned og = xb_add(&bar[XB_TOP], 1u);
            const unsigned tg = og / nx;
            if (og + 1u == (tg + 1u) * nx) xb_add(&bar[XB_TOPGEN], 1u);
            else XB_SPIN(xb_ld(&bar[XB_TOPGEN]) == tg, bar);
            __builtin_amdgcn_fence(__ATOMIC_ACQUIRE, "agent");
            xb_add(&bar[XB_XGEN(b.x)], 1u);
            asm volatile("s_waitcnt vmcnt(0)" ::: "memory");
        } else {
            XB_SPIN(xb_ld(&bar[XB_XGEN(b.x)]) == gen, bar);
            __builtin_amdgcn_fence(__ATOMIC_ACQUIRE, "agent");
            asm volatile("s_waitcnt vmcnt(0)" ::: "memory");
        }
    }
    __syncthreads();
}

constexpr int NWAVES = 8;
constexpr int RING_OFF = 0, RING_BYTES = 131072;
constexpr int LDSCTL_OFF = RING_BYTES, MISC_OFF = LDSCTL_OFF + 320;
constexpr int LDS_BYTES = 147456;
static_assert(attn128::SHM_TOTAL <= (size_t)RING_BYTES, "attention scratch fits the ring");

struct Args { const float* in[32]; float* out; unsigned char* ws; int ph_lo, ph_hi; };
constexpr int INTAB_OFF = LDSCTL_OFF + 1024;
__device__ __forceinline__ const float* inptr(LAS unsigned char* lds, int i) {
    const unsigned long long v = ((const LAS unsigned long long*)(lds + INTAB_OFF))[i];
    const unsigned lo = __builtin_amdgcn_readfirstlane((unsigned)v), hi = __builtin_amdgcn_readfirstlane((unsigned)(v >> 32));
    return (const float*)(GAS const float*)(((unsigned long long)hi << 32) | lo);
}
#define INP(i) inptr(F.lds, (i))
struct Frame {
    LAS unsigned char* lds; int tid, lane, wave, vcu, G, gw, NGW;
    unsigned char* ws;
};
enum { I_X = 0, I_C, I_CTX, I_CCTX, I_WMOD, I_BMOD, I_LNG, I_LNB, I_W1, I_W3, I_W2, I_WIN, I_ALAM, I_ASUB, I_CONVW, I_CONVB, I_ALOG, I_DTB, I_SSDD, I_SSDN,
       I_LRE, I_LIM, I_LSTEP, I_BRE, I_BIM, I_CRE, I_CIM, I_S5D, I_GLUW, I_GLUB, I_WBR, I_WOUT };

__device__ __forceinline__ void transpose_item64(const float* srcA, const float* srcB, int ldn, bool ffn, bf16_t* dst, int ldk, LAS bf16_t* scr  , int lane) {
    const int q = lane & 15, kr = lane >> 4; const bool isB = q >= 8; const int c = (q & 7) * 4; const float* src = isB ? srcB : srcA;
    f32x4 v[16];
#pragma unroll
    for (int i = 0; i < 16; ++i) v[i] = src ? *(const f32x4*)(src + (size_t)(4 * i + kr) * ldn + c) : (f32x4){0.f, 0.f, 0.f, 0.f};
    const int drow = ffn ? (32 * (c >> 4) + (c & 15) + (isB ? 16 : 0)) : (c + (isB ? 32 : 0));
#pragma unroll
    for (int i = 0; i < 16; ++i) { const int k = 4 * i + kr; const unsigned p01 = cvt_pk_bf16(v[i][0], v[i][1]), p23 = cvt_pk_bf16(v[i][2], v[i][3]);
        scr[(drow + 0) * 72 + k] = (bf16_t)(p01 & 0xffffu); scr[(drow + 1) * 72 + k] = (bf16_t)(p01 >> 16); scr[(drow + 2) * 72 + k] = (bf16_t)(p23 & 0xffffu); scr[(drow + 3) * 72 + k] = (bf16_t)(p23 >> 16); }
    LDS_WAIT(); asm volatile("" ::: "memory");
    const int c8 = lane & 7;
#pragma unroll
    for (int jj = 0; jj < 8; ++jj) { const int n = (lane >> 3) + 8 * jj; *(u32x4*)(dst + (size_t)n * ldk + 8 * c8) = *(const LAS u32x4*)(scr + n * 72 + 8 * c8); }
    LDS_WAIT(); asm volatile("" ::: "memory");
}
__device__ __forceinline__ void convert_layer_weights(const Args& A_, Frame& F, int l) {
    LAS bf16_t* scr = (LAS bf16_t*)(F.lds + RING_OFF + F.wave * 16384);
    unsigned char* W = F.ws + WS_W;
    constexpr int I13 = 32 * 176, I2 = 88 * 32, IIN = 32 * 212, IB = 16 * 32, IO = 32 * 32, IG = 16 * 16;
    constexpr int NIT = 2 * I13 + 2 * I2 + IIN + 3 * IB + IO + IG;
    for (int it = F.gw; it < NIT; it += F.NGW) {
        int r = it;
        if (r < 2 * I13) { const int f = r / I13; r -= f * I13; const int kb = r / 176, nb = r % 176;
            const float* w1 = INP(I_W1) + ((size_t)(l * 2 + f) * D + 64 * kb) * DFF + 32 * nb; const float* w3 = INP(I_W3) + ((size_t)(l * 2 + f) * D + 64 * kb) * DFF + 32 * nb;
            transpose_item64(w1, w3, DFF, true, (bf16_t*)(W + W_13) + ((size_t)f * N13 + 64 * nb) * D + 64 * kb, D, scr, F.lane); continue; }
        r -= 2 * I13;
        if (r < 2 * I2) { const int f = r / I2; r -= f * I2; const int kb = r / 32, nb = r % 32;
            const float* w2 = INP(I_W2) + ((size_t)(l * 2 + f) * DFF + 64 * kb) * D + 64 * nb;
            transpose_item64(w2, w2 + 32, D, false, (bf16_t*)(W + W_2) + ((size_t)f * D + 64 * nb) * DFF + 64 * kb, DFF, scr, F.lane); continue; }
        r -= 2 * I2;
        if (r < IIN) { const int kb = r / 212, nb = r % 212; const int n0 = 64 * nb; const float* wb = INP(I_WIN) + ((size_t)l * D + 64 * kb) * 13344;
            const float* sa = nullptr; const float* sb = nullptr;
            if (n0 < 6144) { sa = wb + n0; sb = sa + 32; } else if (n0 < 13312) { sa = wb + n0 + 32; sb = sa + 32; } else if (n0 == 13312) { sa = wb + 6144; }
            transpose_item64(sa, sb, 13344, false, (bf16_t*)(W + W_IN) + (size_t)n0 * D + 64 * kb, D, scr, F.lane); continue; }
        r -= IIN;
        if (r < 3 * IB) { const int jb = r / IB; r -= jb * IB; const int kb = r / 32, nb = r % 32;
            const float* w = INP(I_WBR) + ((size_t)(l * 3 + jb) * 1024 + 64 * kb) * D + 64 * nb;
            const int sp = (jb == 0) ? 0 : (jb == 1 ? 2 : 1); transpose_item64(w, w + 32, D, false, (bf16_t*)(W + W_B) + (size_t)(64 * nb) * 3072 + sp * 1024 + 64 * kb, 3072, scr, F.lane); continue; }
        r -= 3 * IB;
        if (r < IO) { const int kb = r / 32, nb = r % 32; const float* w = INP(I_WOUT) + ((size_t)l * D + 64 * kb) * D + 64 * nb;
            transpose_item64(w, w + 32, D, false, (bf16_t*)(W + W_O) + (size_t)(64 * nb) * D + 64 * kb, D, scr, F.lane); continue; }
        r -= IO;
        { const int kb = r / 16, nb = r % 16; const float* w = INP(I_GLUW) + ((size_t)l * 1024 + 64 * kb) * 1024 + 64 * nb;
            transpose_item64(w, w + 32, 1024, false, (bf16_t*)(W + W_GLU) + (size_t)(64 * nb) * 1024 + 64 * kb, 1024, scr, F.lane); }
    }
}
__device__ __forceinline__ void mod_partials(const Args& A_, Frame& F) {
    float* MODw = (float*)(F.ws + WS_MOD);
    for (int it = F.gw; it < 2 * 72 * 16; it += F.NGW) {
        const int l = it / (72 * 16), r = it % (72 * 16), ks = r / 72, cg = r % 72;
        const int col = cg * 256 + F.lane * 4; const float* w = INP(I_WMOD) + ((size_t)l * D + ks * 128) * NMOD + col;
        f32x4 a0 = {0.f, 0.f, 0.f, 0.f}, a1 = a0, a2 = a0, a3 = a0, a4 = a0;
        const float* c = INP(I_C) + ks * 128; const float* cc = INP(I_CCTX) + ks * 128;
#pragma unroll 16
        for (int k = 0; k < 128; ++k) { const f32x4 wv = *(const f32x4*)(w + (size_t)k * NMOD);
            a0 += wv * siluf_(c[k]); a1 += wv * siluf_(c[D + k]); a2 += wv * siluf_(c[2 * D + k]); a3 += wv * siluf_(c[3 * D + k]); a4 += wv * siluf_(cc[k]); }
        const int r9 = col / D; const float sc = (r9 == 2 || r9 == 8) ? 0.5f : 1.0f;
        if (ks == 0) { const f32x4 bv = *(const f32x4*)(INP(I_BMOD) + (size_t)l * NMOD + col); a0 += bv; a1 += bv; a2 += bv; a3 += bv; a4 += bv; }
        float* o = MODw + (size_t)l * 5 * NMOD + col;
#pragma unroll
        for (int e = 0; e < 4; ++e) { unsafeAtomicAdd(o + e, a0[e] * sc); unsafeAtomicAdd(o + NMOD + e, a1[e] * sc); unsafeAtomicAdd(o + 2 * NMOD + e, a2[e] * sc); unsafeAtomicAdd(o + 3 * NMOD + e, a3[e] * sc); unsafeAtomicAdd(o + 4 * NMOD + e, a4[e] * sc); }
    }
}
__device__ __forceinline__ void ln_pass(Frame& F, bool do_ln, const float* lng, const float* lnb, const float* modnext  , float* out, const float* xin = nullptr, const float* cin = nullptr) {
    _Float16* H = (_Float16*)(F.ws + WS_H); float* HC = (float*)(F.ws + WS_HC); bf16_t* HM = (bf16_t*)(F.ws + WS_HM); float* ST = (float*)(F.ws + WS_STATS);
    for (int row = F.gw; row < R; row += F.NGW) {
        const int b = row / RB, rr = row % RB; const bool isctx = rr < CTX; const int mi = isctx ? 4 : b;
        float* hc = HC + ((size_t)b * CTX + rr) * D; _Float16* hr = H + (size_t)row * D;
        f32x4 v[8]; float s = 0.f;
        if (xin) { const float* src = isctx ? cin + ((size_t)b * CTX + rr) * D : xin + ((size_t)b * SEQ + (rr - CTX)) * D;
#pragma unroll
            for (int i = 0; i < 8; ++i) v[i] = *(const f32x4*)(src + 256 * i + 4 * F.lane);
        } else if (isctx) {
#pragma unroll
            for (int i = 0; i < 8; ++i) v[i] = *(const f32x4*)(hc + 256 * i + 4 * F.lane);
        } else {
#pragma unroll
            for (int i = 0; i < 8; ++i) v[i] = ld_h4(hr + 256 * i + 4 * F.lane);
        }
#pragma unroll
        for (int i = 0; i < 8; ++i) s += (v[i][0] + v[i][1]) + (v[i][2] + v[i][3]);
        if (do_ln) {
            const float mean = wave_sum(s, F.lane) * (1.f / D); float s2 = 0.f;
#pragma unroll
            for (int i = 0; i < 8; ++i) { v[i] = v[i] - mean; s2 += (v[i][0] * v[i][0] + v[i][1] * v[i][1]) + (v[i][2] * v[i][2] + v[i][3] * v[i][3]); }
            const float rstd = 1.0f / sqrtf(wave_sum(s2, F.lane) * (1.f / D) + LN_EPS);
            if (!isctx && F.lane == 0) *(f32x2*)(ST + (size_t)row * 2) = (f32x2){mean, rstd};
#pragma unroll
            for (int i = 0; i < 8; ++i) { const f32x4 g = *(const f32x4*)(lng + 256 * i + 4 * F.lane), bb = *(const f32x4*)(lnb + 256 * i + 4 * F.lane); v[i] = v[i] * rstd * g + bb; if (isctx) *(f32x4*)(hc + 256 * i + 4 * F.lane) = v[i] * DN_ALPHA; }
        } else if (isctx) {
#pragma unroll
            for (int i = 0; i < 8; ++i) *(f32x4*)(hc + 256 * i + 4 * F.lane) = v[i] * DN_ALPHA;
        } else {
#pragma unroll
            for (int i = 0; i < 8; ++i) st_h4(hr + 256 * i + 4 * F.lane, v[i]);
            if (F.lane == 0) *(f32x2*)(ST + (size_t)row * 2) = (f32x2){0.f, 1.f};
        }
        if (modnext) {
            const float* sh = modnext + (size_t)mi * NMOD; const float* sc = sh + D;
#pragma unroll
            for (int i = 0; i < 8; ++i) { const f32x4 a = *(const f32x4*)(sh + 256 * i + 4 * F.lane), c = *(const f32x4*)(sc + 256 * i + 4 * F.lane); const f32x4 m = v[i] * (c + 1.0f) + a;
                u32x2 w; w.x = cvt_pk_bf16(m[0], m[1]); w.y = cvt_pk_bf16(m[2], m[3]); *(u32x2*)(HM + (size_t)row * D + 256 * i + 4 * F.lane) = w; }
        }
        if (out && !isctx) { float* orow = out + ((size_t)b * SEQ + (rr - CTX)) * D;
#pragma unroll
            for (int i = 0; i < 8; ++i) *(f32x4*)(orow + 256 * i + 4 * F.lane) = v[i]; }
    }
}

__device__ __forceinline__ void dt_tile(Frame& F, int l, int tile) {
    const bf16_t* A = (const bf16_t*)(F.ws + WS_HM) + (size_t)tile * 32 * D; const bf16_t* Bt = (const bf16_t*)(F.ws + WS_W + W_IN) + (size_t)13312 * D; float* DT = (float*)(F.ws + WS_DT);
    const int r = F.lane & 31, h = F.lane >> 5;
    f32x16 acc;
#pragma unroll
    for (int i = 0; i < 16; ++i) acc[i] = 0.f;
    const bf16_t* ap = A + (size_t)r * D + 8 * h; const bf16_t* bp = Bt + (size_t)r * D + 8 * h;
    for (int k0 = 0; k0 < 128; k0 += 16) {
        bf16x8 af[16], bfv[16];
#pragma unroll
        for (int e = 0; e < 16; ++e) { af[e] = *(const bf16x8*)(ap + 16 * (k0 + e)); bfv[e] = *(const bf16x8*)(bp + 16 * (k0 + e)); }
#pragma unroll
        for (int e = 0; e < 16; ++e) acc = __builtin_amdgcn_mfma_f32_32x32x16_bf16(af[e], bfv[e], acc, 0, 0, 0);
    }
    const float bias = INP(I_DTB)[l * 32 + r];
#pragma unroll
    for (int rg = 0; rg < 16; ++rg) { const int row = tile * 32 + (rg & 3) + 8 * (rg >> 2) + 4 * h; const float x = acc[rg] + bias; DT[(size_t)row * 32 + r] = fmaxf(x, 0.f) + log1pf(expf(-fabsf(x))); }
}
__device__ __forceinline__ void ssd_conv_pass(const Args& A_, Frame& F, int l) {
    const bf16_t* P = (const bf16_t*)(F.ws + WS_PROJ); bf16_t* XC = (bf16_t*)(F.ws + WS_HM);
    const float* cw = INP(I_CONVW) + (size_t)l * 5 * 2048; const float* cb = INP(I_CONVB) + (size_t)l * 2048;
    for (int it = F.gw; it < (R / 8) * 4; it += F.NGW) {
        const int r0 = (it >> 2) * 8, c0 = (it & 3) * 512 + F.lane * 8; const int rr0 = r0 % RB; const int lo = (rr0 < CTX) ? 0 : CTX, hi = (rr0 < CTX) ? CTX : RB;
        u32x4 x[12];
#pragma unroll
        for (int h = 0; h < 12; ++h) { const int r2 = rr0 + h - 2; x[h] = (r2 >= lo && r2 < hi) ? *(const u32x4*)(P + (size_t)(r0 + h - 2) * LDP + PX + c0) : (u32x4){0u, 0u, 0u, 0u}; }
        f32x4 w0[5], w1[5];
#pragma unroll
        for (int k = 0; k < 5; ++k) { w0[k] = *(const f32x4*)(cw + k * 2048 + c0); w1[k] = *(const f32x4*)(cw + k * 2048 + c0 + 4); }
        const f32x4 b0 = *(const f32x4*)(cb + c0), b1 = *(const f32x4*)(cb + c0 + 4);
#pragma unroll
        for (int jr = 0; jr < 8; ++jr) { f32x4 a0 = b0, a1 = b1;
#pragma unroll
            for (int k = 0; k < 5; ++k) { const u32x4 xv = x[jr + k];
                a0[0] += w0[k][0] * bflo(xv.x); a0[1] += w0[k][1] * bfhi(xv.x); a0[2] += w0[k][2] * bflo(xv.y); a0[3] += w0[k][3] * bfhi(xv.y);
                a1[0] += w1[k][0] * bflo(xv.z); a1[1] += w1[k][1] * bfhi(xv.z); a1[2] += w1[k][2] * bflo(xv.w); a1[3] += w1[k][3] * bfhi(xv.w); }
            u32x4 o; o.x = cvt_pk_bf16(siluf_(a0[0]), siluf_(a0[1])); o.y = cvt_pk_bf16(siluf_(a0[2]), siluf_(a0[3])); o.z = cvt_pk_bf16(siluf_(a1[0]), siluf_(a1[1])); o.w = cvt_pk_bf16(siluf_(a1[2]), siluf_(a1[3]));
            *(u32x4*)(XC + (size_t)(r0 + jr) * 2048 + c0) = o; }
    }
}
__device__ __forceinline__ int scan_row(int rb, int d, int step) { return d == 0 ? rb + step : (step < CTX ? rb + CTX - 1 - step : rb + (RB + CTX - 1) - step); }

__device__ __forceinline__ unsigned short bf16_1(float v) { return (unsigned short)(cvt_pk_bf16(v, 0.f) & 0xffffu); }
__device__ __forceinline__ void ssd_chain_fast(const Args& A_, Frame& F, int l, int cid) {
    constexpr int LS = 136;
    const int b = cid >> 6, d = (cid >> 5) & 1, hd = (cid >> 1) & 15, ph = cid & 1, g = hd >> 2; const int rb = b * RB;
    const bf16_t* XC = (const bf16_t*)(F.ws + WS_HM); const float* DT = (const float*)(F.ws + WS_DT); bf16_t* YD = (bf16_t*)(F.ws + WS_YD) + (size_t)d * R * 1024;
    const float a = -expf(INP(I_ALOG)[l * 32 + d * 16 + hd]);
    LAS bf16_t* Cs = (LAS bf16_t*)(F.lds); LAS bf16_t* Bs = Cs + 128 * LS; LAS bf16_t* Ms = Bs + 128 * LS; LAS bf16_t* XdT = Ms + 128 * LS; LAS bf16_t* Hb = XdT + 32 * LS;
    LAS float* csL = (LAS float*)(Hb + 32 * LS); LAS float* ecsL = csL + 128; LAS float* ewL = ecsL + 128; LAS float* misc = ewL + 128;
    const int tid = F.tid, lane = F.lane, w = F.wave, r = lane & 31, h = lane >> 5;
    f32x16 hacc;
#pragma unroll
    for (int i = 0; i < 16; ++i) hacc[i] = 0.f;
    for (int i = tid; i < 32 * LS / 2; i += 512) ((LAS unsigned*)Hb)[i] = 0u;
    u32x4 pc[4], pb[4], px; float pdt, pv0 = 0.f, pv1 = 0.f;
    const int rho0 = d ? 127 - lane : lane, rho1 = d ? 63 - lane : 64 + lane;
#define SSD_R0(k_) ((d == 0) ? rb + 128 * (k_) : ((k_) < 2 ? rb + 128 * (1 - (k_)) : rb + 256 + 128 * (33 - (k_))))
#define SSD_ISSUE(k_) do { const int r0n = SSD_R0(k_); \
        _Pragma("unroll") for (int i = 0; i < 4; ++i) { const int item = tid + 512 * i, row = item >> 4, seg = item & 15; const bf16_t* src = XC + (size_t)(r0n + row) * 2048 + g * 128 + seg * 8; pc[i] = *(const u32x4*)(src + 1536); pb[i] = *(const u32x4*)(src + 1024); } \
        { const int row = tid >> 2, seg = tid & 3; pdt = DT[(size_t)(r0n + row) * 32 + d * 16 + hd]; px = *(const u32x4*)(XC + (size_t)(r0n + row) * 2048 + hd * 64 + ph * 32 + seg * 8); } \
        if (w == 0) { pv0 = DT[(size_t)(r0n + rho0) * 32 + d * 16 + hd]; pv1 = DT[(size_t)(r0n + rho1) * 32 + d * 16 + hd]; } } while (0)
    SSD_ISSUE(0);
    for (int k = 0; k < 34; ++k) {
        const int r0 = SSD_R0(k);
        __syncthreads();
#pragma unroll
        for (int i = 0; i < 4; ++i) { const int item = tid + 512 * i, row = item >> 4, seg = item & 15; *(LAS u32x4*)(Cs + row * LS + seg * 8) = pc[i]; *(LAS u32x4*)(Bs + row * LS + seg * 8) = pb[i]; }
        { const int row = tid >> 2, seg = tid & 3; const float dtv = pdt; const u32x4 xv = px;
            LAS bf16_t* xo = XdT + (seg * 8) * LS + row;
            xo[0 * LS] = bf16_1(bflo(xv.x) * dtv); xo[1 * LS] = bf16_1(bfhi(xv.x) * dtv); xo[2 * LS] = bf16_1(bflo(xv.y) * dtv); xo[3 * LS] = bf16_1(bfhi(xv.y) * dtv);
            xo[4 * LS] = bf16_1(bflo(xv.z) * dtv); xo[5 * LS] = bf16_1(bfhi(xv.z) * dtv); xo[6 * LS] = bf16_1(bflo(xv.w) * dtv); xo[7 * LS] = bf16_1(bfhi(xv.w) * dtv); }
        if (w == 0) {
            float v0 = pv0 * a, v1 = pv1 * a;
#pragma unroll
            for (int o = 1; o < 64; o <<= 1) { const float t0 = __int_as_float(__builtin_amdgcn_ds_bpermute((lane - o) << 2, __float_as_int(v0))), t1 = __int_as_float(__builtin_amdgcn_ds_bpermute((lane - o) << 2, __float_as_int(v1))); if (lane >= o) { v0 += t0; v1 += t1; } }
            const float tot0 = __int_as_float(__builtin_amdgcn_ds_bpermute(63 << 2, __float_as_int(v0))); v1 += tot0;
            const float cend = __int_as_float(__builtin_amdgcn_ds_bpermute(63 << 2, __float_as_int(v1)));
            csL[rho0] = v0; csL[rho1] = v1; ecsL[rho0] = __builtin_amdgcn_exp2f(v0 * 1.4426950408889634f); ecsL[rho1] = __builtin_amdgcn_exp2f(v1 * 1.4426950408889634f);
            ewL[rho0] = __builtin_amdgcn_exp2f((cend - v0) * 1.4426950408889634f); ewL[rho1] = __builtin_amdgcn_exp2f((cend - v1) * 1.4426950408889634f);
            if (lane == 0) misc[0] = __builtin_amdgcn_exp2f(cend * 1.4426950408889634f);
        }
        if (k + 1 < 34) SSD_ISSUE(k + 1);
        __syncthreads();
        { const int lt = w >> 1;
#pragma unroll
          for (int q = 0; q < 2; ++q) { const int st = (w & 1) * 2 + q; const bool zero = (d == 0) ? (st > lt) : (st < lt);
            f32x16 acc;
#pragma unroll
            for (int i = 0; i < 16; ++i) acc[i] = 0.f;
            if (!zero) {
#pragma unroll
                for (int ks = 0; ks < 8; ++ks) { const bf16x8 af = *(const LAS bf16x8*)(Cs + (32 * lt + r) * LS + 16 * ks + 8 * h), bfv = *(const LAS bf16x8*)(Bs + (32 * st + r) * LS + 16 * ks + 8 * h);
                    acc = __builtin_amdgcn_mfma_f32_32x32x16_bf16(af, bfv, acc, 0, 0, 0); } }
            const int scol = 32 * st + r; const float css = csL[scol];
#pragma unroll
            for (int rg = 0; rg < 16; ++rg) { const int lrow = 32 * lt + (rg & 3) + 8 * (rg >> 2) + 4 * h; const bool valid = (d == 0) ? (scol <= lrow) : (scol >= lrow);
                const float v = valid ? acc[rg] * __builtin_amdgcn_exp2f((csL[lrow] - css) * 1.4426950408889634f) : 0.f; Ms[lrow * LS + scol] = bf16_1(v); } } }
        __syncthreads();
        if (w < 4) { const int lt = w;
            f32x16 acc;
#pragma unroll
            for (int i = 0; i < 16; ++i) acc[i] = 0.f;
#pragma unroll
            for (int ks = 0; ks < 8; ++ks) { const bf16x8 af = *(const LAS bf16x8*)(Cs + (32 * lt + r) * LS + 16 * ks + 8 * h), bfv = *(const LAS bf16x8*)(Hb + r * LS + 16 * ks + 8 * h);
                acc = __builtin_amdgcn_mfma_f32_32x32x16_bf16(af, bfv, acc, 0, 0, 0); }
#pragma unroll
            for (int rg = 0; rg < 16; ++rg) acc[rg] *= ecsL[32 * lt + (rg & 3) + 8 * (rg >> 2) + 4 * h];
#pragma unroll
            for (int ks = 0; ks < 8; ++ks) { const bool skip = (d == 0) ? (16 * ks >= 32 * (lt + 1)) : (16 * ks + 15 < 32 * lt);
                if (!skip) { const bf16x8 af = *(const LAS bf16x8*)(Ms + (32 * lt + r) * LS + 16 * ks + 8 * h), bfv = *(const LAS bf16x8*)(XdT + r * LS + 16 * ks + 8 * h);
                    acc = __builtin_amdgcn_mfma_f32_32x32x16_bf16(af, bfv, acc, 0, 0, 0); } }
            bf16_t* yo = YD + (size_t)(r0 + 32 * lt + 4 * h) * 1024 + hd * 64 + ph * 32 + r;
#pragma unroll
            for (int rg = 0; rg < 16; ++rg) yo[(size_t)((rg & 3) + 8 * (rg >> 2)) * 1024] = bf16_1(acc[rg]);
        } else { const int nt = w - 4; const float eend = misc[0];
#pragma unroll
            for (int i = 0; i < 16; ++i) hacc[i] *= eend;
#pragma unroll
            for (int ks = 0; ks < 8; ++ks) { const int k0 = 16 * ks + 8 * h; const u32x4 xa = *(const LAS u32x4*)(XdT + r * LS + k0); const f32x4 e0 = *(const LAS f32x4*)(ewL + k0), e1 = *(const LAS f32x4*)(ewL + k0 + 4);
                u32x4 aw; aw.x = cvt_pk_bf16(bflo(xa.x) * e0[0], bfhi(xa.x) * e0[1]); aw.y = cvt_pk_bf16(bflo(xa.y) * e0[2], bfhi(xa.y) * e0[3]); aw.z = cvt_pk_bf16(bflo(xa.z) * e1[0], bfhi(xa.z) * e1[1]); aw.w = cvt_pk_bf16(bflo(xa.w) * e1[2], bfhi(xa.w) * e1[3]);
                const LAS bf16_t* bp = Bs + k0 * LS + 32 * nt + r; u32x4 bw;
                bw.x = (unsigned)bp[0 * LS] | ((unsigned)bp[1 * LS] << 16); bw.y = (unsigned)bp[2 * LS] | ((unsigned)bp[3 * LS] << 16); bw.z = (unsigned)bp[4 * LS] | ((unsigned)bp[5 * LS] << 16); bw.w = (unsigned)bp[6 * LS] | ((unsigned)bp[7 * LS] << 16);
                hacc = __builtin_amdgcn_mfma_f32_32x32x16_bf16(__builtin_bit_cast(bf16x8, aw), __builtin_bit_cast(bf16x8, bw), hacc, 0, 0, 0); }
        }
        __syncthreads();
        if (w >= 4) { const int nt = w - 4;
#pragma unroll
            for (int rg = 0; rg < 16; ++rg) Hb[((rg & 3) + 8 * (rg >> 2) + 4 * h) * LS + 32 * nt + r] = bf16_1(hacc[rg]); }
    }
    __syncthreads();
#undef SSD_R0
#undef SSD_ISSUE
}
__device__ __forceinline__ void s5_setup(const Args& A_, Frame& F, int l) {
    LAS float* Pre = (LAS float*)(F.lds); LAS float* Pim = Pre + 2 * 17 * 64; LAS float* BBr = Pim + 2 * 17 * 64; LAS float* BBi = BBr + 2 * 64 * 16; LAS float* Kt = BBi + 2 * 64 * 16;
    bf16_t* Bt1 = (bf16_t*)(F.ws + WS_S5M); bf16_t* Bt2 = Bt1 + (size_t)64 * 512 * 256; float* A16 = (float*)(F.ws + WS_S5A);
    const int tid = F.tid;
    for (int g = blockIdx.x; g < 64; g += F.G) {
        if (tid < 128) { const int d = tid >> 6, n = tid & 63; const int pg_ = (l * 2 + d) * 64 + g;
            const float lre = INP(I_LRE)[pg_ * 64 + n], lim = INP(I_LIM)[pg_ * 64 + n], step = expf(INP(I_LSTEP)[pg_]);
            for (int dl = 0; dl <= 16; ++dl) { const float mag = expf(lre * step * (float)dl), ang = lim * step * (float)dl; Pre[(d * 17 + dl) * 64 + n] = mag * cosf(ang); Pim[(d * 17 + dl) * 64 + n] = mag * sinf(ang); }
            const float abr = Pre[(d * 17 + 1) * 64 + n], abi = Pim[(d * 17 + 1) * 64 + n];
            const float den = lre * lre + lim * lim; const float kre = ((abr - 1.f) * lre + abi * lim) / den, kim = (abi * lre - (abr - 1.f) * lim) / den;
            const float* br = INP(I_BRE) + ((size_t)pg_ * 64 + n) * 16; const float* bi = INP(I_BIM) + ((size_t)pg_ * 64 + n) * 16;
            for (int i = 0; i < 16; ++i) { const float x = br[i], y = bi[i]; BBr[(d * 64 + n) * 16 + i] = kre * x - kim * y; BBi[(d * 64 + n) * 16 + i] = kre * y + kim * x; }
            A16[((d * 64 + g) * 64 + n) * 2] = Pre[(d * 17 + 16) * 64 + n]; A16[((d * 64 + g) * 64 + n) * 2 + 1] = Pim[(d * 17 + 16) * 64 + n]; }
        __syncthreads();
        for (int q = 0; q < 16; ++q) { const int idx = tid + 512 * q; const int d = idx >> 12, dl = (idx >> 8) & 15, o = (idx >> 4) & 15, i = idx & 15; const int pg_ = (l * 2 + d) * 64 + g;
            const float* cr = INP(I_CRE) + ((size_t)pg_ * 16 + o) * 64; const float* ci = INP(I_CIM) + ((size_t)pg_ * 16 + o) * 64; float acc = 0.f;
            for (int n = 0; n < 64; ++n) { const float pr = Pre[(d * 17 + dl) * 64 + n], pi = Pim[(d * 17 + dl) * 64 + n], br = BBr[(d * 64 + n) * 16 + i], bi = BBi[(d * 64 + n) * 16 + i];
                acc += cr[n] * (pr * br - pi * bi) - ci[n] * (pr * bi + pi * br); }
            Kt[idx] = acc; }
        __syncthreads();
        for (int q = 0; q < 16; ++q) { const int item = tid + 512 * q; const int c1 = item >> 5, kb = (item & 31) * 8; const int rin = kb >> 4, i0 = kb & 15, rout = c1 >> 4, o = c1 & 15;
            float v[8];
#pragma unroll
            for (int e = 0; e < 8; ++e) { const int i = i0 + e; float x = 0.f; if (rout >= rin) x += Kt[((0 * 16 + (rout - rin)) * 16 + o) * 16 + i]; if (rin >= rout) x += Kt[((1 * 16 + (rin - rout)) * 16 + o) * 16 + i];
                if (rin == rout && i == o) x += INP(I_S5D)[l * 1024 + 16 * g + i]; v[e] = x; }
            u32x4 w; w.x = cvt_pk_bf16(v[0], v[1]); w.y = cvt_pk_bf16(v[2], v[3]); w.z = cvt_pk_bf16(v[4], v[5]); w.w = cvt_pk_bf16(v[6], v[7]);
            *(u32x4*)(Bt1 + ((size_t)g * 512 + c1) * 256 + kb) = w; }
        for (int q = 0; q < 16; ++q) { const int item = tid + 512 * q; const int c1 = item >> 5, kb = (item & 31) * 8; const int rin = kb >> 4, i0 = kb & 15; const int d = c1 >> 7, part = (c1 >> 6) & 1, n = c1 & 63;
            const int ex = (d == 0) ? 15 - rin : rin; const float pr = Pre[(d * 17 + ex) * 64 + n], pi = Pim[(d * 17 + ex) * 64 + n];
            float v[8];
#pragma unroll
            for (int e = 0; e < 8; ++e) { const float br = BBr[(d * 64 + n) * 16 + i0 + e], bi = BBi[(d * 64 + n) * 16 + i0 + e]; v[e] = part ? (pr * bi + pi * br) : (pr * br - pi * bi); }
            u32x4 w; w.x = cvt_pk_bf16(v[0], v[1]); w.y = cvt_pk_bf16(v[2], v[3]); w.z = cvt_pk_bf16(v[4], v[5]); w.w = cvt_pk_bf16(v[6], v[7]);
            *(u32x4*)(Bt1 + ((size_t)g * 512 + 256 + c1) * 256 + kb) = w; }
        for (int q = 0; q < 16; ++q) { const int item = tid + 512 * q; const int c2 = item >> 5, kb = (item & 31) * 8; const int rout = c2 >> 4, o = c2 & 15; const int d = kb >> 7, part = (kb >> 6) & 1, n0 = kb & 63; const int pg_ = (l * 2 + d) * 64 + g;
            const int ex = (d == 0) ? rout + 1 : 16 - rout; const float* cr = INP(I_CRE) + ((size_t)pg_ * 16 + o) * 64 + n0; const float* ci = INP(I_CIM) + ((size_t)pg_ * 16 + o) * 64 + n0;
            float v[8];
#pragma unroll
            for (int e = 0; e < 8; ++e) { const float pr = Pre[(d * 17 + ex) * 64 + n0 + e], pi = Pim[(d * 17 + ex) * 64 + n0 + e]; v[e] = part ? -(cr[e] * pi + ci[e] * pr) : (cr[e] * pr - ci[e] * pi); }
            u32x4 w; w.x = cvt_pk_bf16(v[0], v[1]); w.y = cvt_pk_bf16(v[2], v[3]); w.z = cvt_pk_bf16(v[4], v[5]); w.w = cvt_pk_bf16(v[6], v[7]);
            *(u32x4*)(Bt2 + ((size_t)g * 256 + c2) * 256 + kb) = w; }
        __syncthreads();
    }
}
__device__ __forceinline__ void s5_carry(Frame& F, int cid) {
    const int b = cid >> 7, d = (cid >> 6) & 1, g = cid & 63, n = F.lane;
    const bf16_t* ST = (const bf16_t*)(F.ws + WS_S5ST) + ((size_t)g * S5M + b * 272) * 256 + d * 128 + n; bf16_t* HP = (bf16_t*)(F.ws + WS_S5H) + ((size_t)g * 1280 + b * 272) * 256 + d * 128 + n;
    const float* A16 = (const float*)(F.ws + WS_S5A); const float ar = A16[((d * 64 + g) * 64 + n) * 2], ai = A16[((d * 64 + g) * 64 + n) * 2 + 1];
    float hr = 0.f, hi_ = 0.f;
    for (int k0 = 0; k0 < 272; k0 += 34) {
        float sr[34], si[34]; int cc[34];
#pragma unroll
        for (int e = 0; e < 34; ++e) { const int k = k0 + e; cc[e] = (d == 0) ? k : (k < 16 ? 15 - k : 287 - k); sr[e] = bf1(ST[(size_t)cc[e] * 256]); si[e] = bf1(ST[(size_t)cc[e] * 256 + 64]); }
#pragma unroll
        for (int e = 0; e < 34; ++e) { HP[(size_t)cc[e] * 256] = (bf16_t)(cvt_pk_bf16(hr, 0.f) & 0xffffu); HP[(size_t)cc[e] * 256 + 64] = (bf16_t)(cvt_pk_bf16(hi_, 0.f) & 0xffffu);
            const float nr = ar * hr - ai * hi_ + sr[e], ni = ar * hi_ + ai * hr + si[e]; hr = nr; hi_ = ni; }
    }
}
__device__ __forceinline__ void mixer_finalize(const Args& A_, Frame& F, int l) {
    bf16_t* P = (bf16_t*)(F.ws + WS_PROJ);
    const bf16_t* XC = (const bf16_t*)(F.ws + WS_HM); const bf16_t* YD0 = (const bf16_t*)(F.ws + WS_YD); const bf16_t* YD1 = YD0 + (size_t)R * 1024;
        const int c0 = F.lane * 16;
    for (int row = F.gw; row < R; row += F.NGW) {
        { const float dsk = INP(I_SSDD)[l * 16 + (c0 >> 6)];
          float v[16];
#pragma unroll
          for (int hh = 0; hh < 2; ++hh) { const u32x4 x = *(const u32x4*)(XC + (size_t)row * 2048 + c0 + 8 * hh), y0 = *(const u32x4*)(YD0 + (size_t)row * 1024 + c0 + 8 * hh), y1 = *(const u32x4*)(YD1 + (size_t)row * 1024 + c0 + 8 * hh), z = *(const u32x4*)(P + (size_t)row * LDP + PZ + c0 + 8 * hh);
#define SG(i, wx, wy0, wy1, wz) v[8 * hh + 2 * (i)] = (bflo(wx) * dsk + bflo(wy0) + bflo(wy1)) * bflo(wz); v[8 * hh + 2 * (i) + 1] = (bfhi(wx) * dsk + bfhi(wy0) + bfhi(wy1)) * bfhi(wz);
              SG(0, x.x, y0.x, y1.x, z.x) SG(1, x.y, y0.y, y1.y, z.y) SG(2, x.z, y0.z, y1.z, z.z) SG(3, x.w, y0.w, y1.w, z.w)
#undef SG
          }
          float ss = 0.f;
#pragma unroll
          for (int e = 0; e < 16; ++e) ss += v[e] * v[e];
          ss += shx(ss, 1, F.lane); ss += shx(ss, 2, F.lane); ss += shx(ss, 4, F.lane); ss += shx(ss, 8, F.lane);
          const float rs = 1.0f / sqrtf(ss * (1.f / 256.f) + RMS_EPS);
          const float* nw = INP(I_SSDN) + l * 1024 + c0;
          u32x4 o0, o1;
          o0.x = cvt_pk_bf16(v[0] * rs * nw[0], v[1] * rs * nw[1]); o0.y = cvt_pk_bf16(v[2] * rs * nw[2], v[3] * rs * nw[3]); o0.z = cvt_pk_bf16(v[4] * rs * nw[4], v[5] * rs * nw[5]); o0.w = cvt_pk_bf16(v[6] * rs * nw[6], v[7] * rs * nw[7]);
          o1.x = cvt_pk_bf16(v[8] * rs * nw[8], v[9] * rs * nw[9]); o1.y = cvt_pk_bf16(v[10] * rs * nw[10], v[11] * rs * nw[11]); o1.z = cvt_pk_bf16(v[12] * rs * nw[12], v[13] * rs * nw[13]); o1.w = cvt_pk_bf16(v[14] * rs * nw[14], v[15] * rs * nw[15]);
          *(u32x4*)(P + (size_t)row * LDP + PV + c0) = o0; *(u32x4*)(P + (size_t)row * LDP + PV + c0 + 8) = o1; }
    }
}


__global__ void __launch_bounds__(NWAVES * 64, 2) trunk_fwd(Args args) {
    extern __shared__ __attribute__((aligned(16))) unsigned char lds_raw[];
    Frame F;
    F.lds = (LAS unsigned char*)lds_raw;
    F.tid = threadIdx.x; F.lane = F.tid & 63; F.wave = __builtin_amdgcn_readfirstlane(F.tid >> 6);
    F.G = gridDim.x; { const int bx = blockIdx.x; F.vcu = (F.G % 8 == 0) ? (bx % 8) * (F.G / 8) + bx / 8 : bx; }
    F.gw = F.vcu * NWAVES + F.wave; F.NGW = F.G * NWAVES;
    F.ws = args.ws;
    volatile LAS unsigned* MISC = (volatile LAS unsigned*)(F.lds + MISC_OFF);
    for (int u = F.tid; u < (LDS_BYTES - LDSCTL_OFF) / 4; u += NWAVES * 64) ((LAS unsigned*)(F.lds + LDSCTL_OFF))[u] = 0u;
    __syncthreads();
    if (threadIdx.x < 32) ((LAS unsigned long long*)(F.lds + INTAB_OFF))[threadIdx.x] = (unsigned long long)args.in[threadIdx.x];
    __syncthreads();
    (void)xcd_barrier_post((unsigned*)(args.ws + WS_CTL) + CW_BAR, MISC + 8);
    const int lo = args.ph_lo, hi = args.ph_hi;
    const int wave0 = __builtin_amdgcn_readfirstlane((int)threadIdx.x >> 6);
    int pid = 0;
#define PH_BEGIN if (pid >= lo && pid < hi) { GAS unsigned char* wsg_ = (GAS unsigned char*)args.ws; int tid_; asm volatile("v_mbcnt_lo_u32_b32 %1, -1, 0\n\tv_mbcnt_hi_u32_b32 %1, -1, %1 ; PHASE_MARK_BEGIN %2" : "+s"(wsg_), "=v"(tid_) : "i"(__LINE__) : "memory"); tid_ += wave0 * 64; unsigned char* ws = (unsigned char*)wsg_; F.ws = ws; F.tid = tid_; F.lane = tid_ & 63; F.wave = __builtin_amdgcn_readfirstlane(tid_ >> 6); F.gw = F.vcu * NWAVES + F.wave;
#define PH_END   asm volatile("; PHASE_MARK_END %0" :: "i"(__LINE__)); if (pid + 1 < hi) { XcdBarrier bar_; bar_.bar = (unsigned*)(args.ws + WS_CTL) + CW_BAR; bar_.x = xb_xcc_id(); bar_.st = (volatile LAS unsigned*)(F.lds + MISC_OFF) + 8; xcd_barrier(bar_, wave0 * 64 + lane_now()); } } ++pid;

#define MOD ((float*)(ws + WS_MOD))
#define Hbuf ((float*)(ws + WS_H))
#define HM ((bf16_t*)(ws + WS_HM))
#define PROJ ((bf16_t*)(ws + WS_PROJ))
#define ROPEC ((float*)(ws + WS_ROPE))
#define ROPES (ROPEC + 1024)
#define WGT (ws + WS_W)

    PH_BEGIN
        s5_setup(args, F, 0);
        mod_partials(args, F);
        if (F.gw == 1) { float* idn = (float*)(ws + WS_IDENT); for (int i = F.lane; i < 2048; i += 64) { idn[i] = 1.0f; idn[2048 + i] = 0.0f; } }
        if (F.gw == 0) {
#pragma unroll
            for (int i = 0; i < 16; ++i) { const int idx = i * 64 + F.lane, pos = idx >> 4, f = idx & 15; const float inv = powf(10000.0f, -(float)f / 16.0f); const float ang = (float)pos * inv; ROPEC[idx] = cosf(ang); ROPES[idx] = sinf(ang); } }
    PH_END
    PH_BEGIN
        convert_layer_weights(args, F, 0);
        ln_pass(F, false, nullptr, nullptr, MOD, nullptr, INP(I_X), INP(I_CTX));
    PH_END

    for (int s = 0; s < 6; ++s) {
        const int l = s / 3, j = s - 3 * l;
        if (j != 1) {
            const int f = j >> 1;
            PH_BEGIN
                const int lat = (l == 1 && j == 2); pg8::Gemm g{D, D, D}; pg8::StaticOrder S; S.init(lat ? 64 : NPAN, N13 / 256, F.G, (int)blockIdx.x, HM, D, (const bf16_t*)(WGT + W_13) + (size_t)f * N13 * D, D, D, lat);
                EpiSwiGLU E{PROJ};
                pg8::gemm_phase<EpiSwiGLU, pg8::StaticOrder>(F.lds + RING_OFF, g, S, E, F.tid);
            PH_END
        } else {
            PH_BEGIN
                pg8::Gemm g{D, D, D}; pg8::StaticOrder S; S.init(NPAN, LDP / 256, F.G, (int)blockIdx.x, HM, D, (const bf16_t*)(WGT + W_IN), D, D);
                EpiProj E{PROJ, (float*)(ws + WS_DT), ROPEC, ROPES, (bf16_t*)(ws + WS_O)};
                pg8::gemm_phase<EpiProj, pg8::StaticOrder>(F.lds + RING_OFF, g, S, E, F.tid);
                { const int nfull = (NPAN * (LDP / 256)) % F.G;
                  if ((int)blockIdx.x >= nfull) { const int nw = (F.G - nfull) * NWAVES; for (int t = ((int)blockIdx.x - nfull) * NWAVES + F.wave; t < R / 32; t += nw) dt_tile(F, l, t); } }
            PH_END
            PH_BEGIN
                ssd_conv_pass(args, F, l);
                { pg8::Gemm g{256, 256, 256}; S5AOrder S{F.G, (int)blockIdx.x, (const char*)(ws + WS_O), (const char*)(ws + WS_S5M)};
                  EpiS5A E{(bf16_t*)(ws + WS_YS), (bf16_t*)(ws + WS_S5ST)};
                  pg8::gemm_phase<EpiS5A, S5AOrder>(F.lds + RING_OFF, g, S, E, F.tid); }
            PH_END
            PH_BEGIN
                if (F.wave < 2) s5_carry(F, (int)blockIdx.x * 2 + F.wave);
                ssd_chain_fast(args, F, l, (int)blockIdx.x);
                {
                    const float lam_init = 0.8f - 0.6f * expf(-0.3f * (float)l);
                    const float* lv = INP(I_ALAM) + l * 256;
                    const float s01 = wave_sum(lv[F.lane] * lv[64 + F.lane], F.lane), s23 = wave_sum(lv[128 + F.lane] * lv[192 + F.lane], F.lane);
                    const float lam = expf(s01) - expf(s23) + lam_init;
                    for (int i = 0;; ++i) { const int idx = i * F.G + F.vcu; if (idx >= 512 + (l == 0 ? 32 : 0)) break;
                        int b, h, q0, seq;
                        if (idx < 512) { b = idx >> 7; h = (idx >> 4) & 7; q0 = b * RB + CTX + (idx & 15) * 256; seq = RB; }
                        else { const int k = idx - 512; b = k >> 3; h = k & 7; q0 = b * RB; seq = CTX; }
                        const bf16_t* Q0 = PROJ + (size_t)q0 * LDP + PQ + h * 128; const bf16_t* Kh = PROJ + (size_t)(b * RB) * LDP + PK + h * 128; const bf16_t* Vh = PROJ + (size_t)(b * RB) * LDP + PV + h * 128;
                        attn128::unit((const attn128::bf16*)Q0, (const attn128::bf16*)Kh, (const attn128::bf16*)Vh, PROJ + (size_t)q0 * LDP + PQ + h * 128, seq, (char*)lds_raw + RING_OFF, F.tid, lam, 1.0f - lam_init, INP(I_ASUB) + l * 128);
                    }
                }
            PH_END
            PH_BEGIN
                mixer_finalize(args, F, l);
                { pg8::Gemm g{256, 256, 256}; S5COrder S{F.G, (int)blockIdx.x, (const char*)(ws + WS_S5H), (const char*)((bf16_t*)(ws + WS_S5M) + (size_t)64 * 512 * 256)};
                  EpiS5C E{(const bf16_t*)(ws + WS_YS), PROJ};
                  pg8::gemm_phase<EpiS5C, S5COrder>(F.lds + RING_OFF, g, S, E, F.tid); }
            PH_END
            PH_BEGIN
                pg8::Gemm g{LDP, 1024, 1024}; pg8::StaticOrder S; S.init(l == 1 ? 64 : NPAN, 4, F.G, (int)blockIdx.x, PROJ + PU, LDP, (const bf16_t*)(WGT + W_GLU), 1024, 1024, l == 1);
                EpiGlu E{PROJ, INP(I_GLUB) + l * 1024};
                pg8::gemm_phase<EpiGlu, pg8::StaticOrder>(F.lds + RING_OFF, g, S, E, F.tid);
            PH_END
            PH_BEGIN
                pg8::Gemm g{LDP, 3072, 3072}; pg8::StaticOrder S; S.init(l == 1 ? 64 : NPAN, 8, F.G, (int)blockIdx.x, PROJ, LDP, (const bf16_t*)(WGT + W_B), 3072, 3072, l == 1);
                EpiMerge E{PROJ, HM};
                pg8::gemm_phase<EpiMerge, pg8::StaticOrder, 0, true>(F.lds + RING_OFF, g, S, E, F.tid);
            PH_END
        }
        PH_BEGIN
            const int RK = (j == 1) ? D : DFF; const bf16_t* RA = (j == 1) ? HM : PROJ; const bf16_t* RBt = (j == 1) ? (const bf16_t*)(WGT + W_O) : (const bf16_t*)(WGT + W_2) + (size_t)(j >> 1) * D * DFF;
            const int lat = (l == 1 && j >= 1); pg8::Gemm g{RK, RK, RK}; pg8::StaticOrder S; S.init(64, D / 256, F.G, (int)blockIdx.x, RA, RK, RBt, RK, RK, 1, lat ? 0 : 128);
            const float* lg_ = (s == 0) ? (const float*)(ws + WS_IDENT) : INP(I_LNG) + (size_t)(s - 1) * D; const float* lb_ = (s == 0) ? (const float*)(ws + WS_IDENT) + 2048 : INP(I_LNB) + (size_t)(s - 1) * D;
            EpiResid E{(_Float16*)(ws + WS_H), (float*)(ws + WS_HC), MOD + (size_t)l * 5 * NMOD + (3 * j + 2) * D, lg_, lb_, (const float*)(ws + WS_STATS)};
            pg8::gemm_phase<EpiResid, pg8::StaticOrder>(F.lds + RING_OFF, g, S, E, F.tid);
        PH_END
        PH_BEGIN
            const bool fin = (s == 5);
            const int ln_ = (j == 2) ? l + 1 : l, jn = (j == 2) ? 0 : j + 1;
            ln_pass(F, true, INP(I_LNG) + (size_t)(l * 3 + j) * D, INP(I_LNB) + (size_t)(l * 3 + j) * D, fin ? nullptr : MOD + (size_t)ln_ * 5 * NMOD + 3 * jn * D, fin ? args.out : nullptr);
            if (s == 2) { s5_setup(args, F, 1); __syncthreads(); convert_layer_weights(args, F, 1); }
        PH_END
    }
#undef PH_BEGIN
#undef PH_END
}

static int count_phases() { int n = 2; for (int s = 0; s < 6; ++s) n += ((s % 3) != 1 ? 1 : 6) + 2; return n; }
extern "C" void kernel_launch(void* const* d_in, const int* in_sizes, int n_in, void* d_out, int out_size, void* d_ws, size_t ws_size, hipStream_t stream) {
    static int grid = 0;
    if (grid == 0) {
        if (n_in != 32 || out_size != NB * SEQ * D || ws_size < WS_END) { fprintf(stderr, "kernel_launch: unexpected shapes (n_in %d, out %d, ws %zu < %zu)\n", n_in, out_size, ws_size, (size_t)WS_END); grid = -1; return; }
        int dev = 0, cus = 0, per_cu = 0;
        if (hipGetDevice(&dev) != hipSuccess || hipDeviceGetAttribute(&cus, hipDeviceAttributeMultiprocessorCount, dev) != hipSuccess) { grid = -1; return; }
        if (hipFuncSetAttribute((const void*)trunk_fwd, hipFuncAttributeMaxDynamicSharedMemorySize, LDS_BYTES) != hipSuccess) { fprintf(stderr, "kernel_launch: hipFuncSetAttribute failed\n"); grid = -1; return; }
        if (hipOccupancyMaxActiveBlocksPerMultiprocessor(&per_cu, (const void*)trunk_fwd, NWAVES * 64, LDS_BYTES) != hipSuccess || per_cu < 1) fprintf(stderr, "kernel_launch: occupancy query says %d\n", per_cu);
        (void)hipGetLastError();
        if (cus != 256) { fprintf(stderr, "kernel_launch: this kernel deals its SSD chains / carries / attention units over exactly 256 workgroups (one per CU); device reports %d CUs; nothing launched\n", cus); grid = -1; return; }
        grid = cus;
    }
    if (grid < 0) return;
    (void)in_sizes;
    if (hipMemsetAsync((char*)d_ws + WS_CTL, 0, 2 * MiB  , stream) != hipSuccess) return;
    Args a{};
    for (int i = 0; i < 32; ++i) a.in[i] = (const float*)d_in[i];
    a.out = (float*)d_out; a.ws = (unsigned char*)d_ws;
    const int nph = count_phases();
#if MK_PER_PHASE
    for (int p = 0; p < nph; ++p) { a.ph_lo = p; a.ph_hi = p + 1; hipLaunchKernelGGL(trunk_fwd, dim3(grid), dim3(NWAVES * 64), LDS_BYTES, stream, a); }
#else
    a.ph_lo = 0; a.ph_hi = nph;
    hipLaunchKernelGGL(trunk_fwd, dim3(grid), dim3(NWAVES * 64), LDS_BYTES, stream, a);
#endif
    const hipError_t le = hipPeekAtLastError();
    if (le != hipSuccess) fprintf(stderr, "kernel_launch: launch failed: %s\n", hipGetErrorName(le));
}
```

```cpp
#include <hip/hip_runtime.h>
#include <hip/hip_bf16.h>
#include <cstdio>
#include <cstdint>
#include <cmath>

#ifndef MK_PER_PHASE
#define MK_PER_PHASE 0
#endif

#define LAS __attribute__((address_space(3)))
#define GAS __attribute__((address_space(1)))
typedef unsigned short bf16_t;
typedef short bf16x8 __attribute__((ext_vector_type(8)));
typedef float f32x4 __attribute__((ext_vector_type(4)));
typedef float f32x2 __attribute__((ext_vector_type(2)));
typedef float f32x16 __attribute__((ext_vector_type(16)));
typedef unsigned u32x4 __attribute__((ext_vector_type(4)));
typedef unsigned u32x2 __attribute__((ext_vector_type(2)));
typedef short s16x4 __attribute__((ext_vector_type(4)));

constexpr int NB = 4, SEQ = 4096, CTX = 256, RB = SEQ + CTX  , R = NB * RB  , NPAN = R / 256  , PPB = RB / 256  ;
constexpr int D = 2048, DFF = 5632, N13 = 2 * DFF, NMOD = 9 * D  ;
constexpr int LDP = 13312;
constexpr int NIN = 13568;
constexpr int PQ = 0, PK = 1024, PV = 2048, PZ = 3072, PX = 4096, PU = 6144, PG = 7168;
constexpr float DN_ALPHA = 1.41421356237309515f;
constexpr float LN_EPS = 1e-5f, RMS_EPS = 1e-6f;
constexpr float QSCALE = 0.125f * 1.4426950408889634f;

constexpr size_t MiB = 1u << 20;
constexpr size_t WS_CTL = 0, CTL_ZERO_BYTES = 1 * MiB;
constexpr size_t WS_MOD = 1 * MiB;
constexpr size_t WS_ROPE = 2 * MiB;
constexpr size_t WS_STATS = 2 * MiB + 65536;
constexpr size_t WS_IDENT = 2 * MiB + 262144;
constexpr size_t WS_MODP = 3 * MiB;
constexpr size_t WS_DT = 15 * MiB;
constexpr size_t WS_H = 18 * MiB;
constexpr size_t WS_HC = WS_H + 68 * MiB;
constexpr size_t WS_HM = 154 * MiB;
constexpr size_t WS_PROJ = 222 * MiB;
constexpr size_t WS_O = 664 * MiB;
constexpr size_t WS_YD = 732 * MiB;
constexpr size_t WS_YS = 800 * MiB;
constexpr size_t WS_W = 868 * MiB;
constexpr size_t W_13 = 0, W_2 = 88 * MiB, W_IN = 132 * MiB, W_B = 185 * MiB, W_O = 197 * MiB, W_GLU = 205 * MiB;
constexpr size_t WS_S5ST = 1075 * MiB;
constexpr size_t WS_S5H = 1143 * MiB;
constexpr size_t WS_S5M = 1183 * MiB;
constexpr size_t WS_S5A = 1207 * MiB;
constexpr size_t WS_GQ0 = WS_O + 34 * MiB, WS_GQ1 = WS_S5ST + 34 * MiB  , WS_GQ2 = 1208 * MiB;
constexpr size_t WS_END = 1242 * MiB;
__device__ __forceinline__ size_t gq_off(int j) { return j == 0 ? WS_GQ0 : (j == 1 ? WS_GQ1 : WS_GQ2); }
constexpr int S5M = 1088;
constexpr int CW_BAR = 4096;

__device__ __forceinline__ unsigned cvt_pk_bf16(float lo, float hi) { unsigned r; asm volatile("v_cvt_pk_bf16_f32 %0, %1, %2" : "=v"(r) : "v"(lo), "v"(hi)); return r; }
__device__ __forceinline__ float bflo(unsigned u) { return __uint_as_float(u << 16); }
__device__ __forceinline__ float bfhi(unsigned u) { return __uint_as_float(u & 0xffff0000u); }
__device__ __forceinline__ float bf1(bf16_t h) { return __uint_as_float((unsigned)h << 16); }
typedef _Float16 h16x2 __attribute__((ext_vector_type(2)));
typedef _Float16 h16x4 __attribute__((ext_vector_type(4)));
__device__ __forceinline__ f32x4 ld_h4(const _Float16* p) { const h16x4 h = *(const h16x4*)p; return (f32x4){(float)h[0], (float)h[1], (float)h[2], (float)h[3]}; }
__device__ __forceinline__ void st_h4(_Float16* p, f32x4 v) { h16x4 h; h[0] = (_Float16)v[0]; h[1] = (_Float16)v[1]; h[2] = (_Float16)v[2]; h[3] = (_Float16)v[3]; *(h16x4*)p = h; }
__device__ __forceinline__ float sigmoidf_(float x) { return __builtin_amdgcn_rcpf(1.0f + __builtin_amdgcn_exp2f(-1.4426950408889634f * x)); }
__device__ __forceinline__ float siluf_(float x) { return x * sigmoidf_(x); }
__device__ __forceinline__ int lane_now() { int l; asm volatile("v_mbcnt_lo_u32_b32 %0, -1, 0\n\tv_mbcnt_hi_u32_b32 %0, -1, %0" : "=v"(l)); return l; }
__device__ __forceinline__ float shx(float v, int m, int lane) { return __int_as_float(__builtin_amdgcn_ds_bpermute((lane ^ m) << 2, __float_as_int(v))); }
__device__ __forceinline__ float wave_sum(float v, int lane) {
#pragma unroll
    for (int o = 1; o < 64; o <<= 1) v += shx(v, o, lane);
    return v;
}
#define LDS_WAIT() asm volatile("s_waitcnt lgkmcnt(0)" ::: "memory")
#define VM_WAIT() asm volatile("s_waitcnt vmcnt(0)" ::: "memory")

namespace pg8 {
constexpr int BM = 256, BK = 64, HALF = 128, HTB = HALF * BK * 2, STAGE_BYTES = 8 * HTB, NXCD = 8, WGM = 8, PPB_ = 17;
__host__ __device__ __forceinline__ int lds_byte(int r, int c) { const int st = (r >> 4) * 2 + (c >> 5), rr = r & 15, cc = c & 31, ob = rr * 64 + cc * 2; return st * 1024 + (ob ^ (((ob >> 9) & 1) << 5)); }
__host__ __device__ __forceinline__ void stage_rc(int b, int& R_, int& C_) { const int st = b / 1024, sb = b % 1024, swz = sb ^ (((sb >> 9) & 1) << 5); R_ = (st >> 1) * 16 + swz / 64; C_ = (st & 1) * 32 + (swz % 64) / 2; }

struct Unit { int pm, pn, aux, kt; const char* a; const char* b; };
struct Gemm { int lda, ldb, K; };

__device__ __forceinline__ void xcd_remap(int L, int nM, int nN, int& pm, int& pn) {
    const int nwg = nM * nN; int wgid = L;
    { const int q = nwg / NXCD, r = nwg % NXCD, xcd = wgid % NXCD, off = wgid / NXCD; wgid = (xcd < r ? xcd * (q + 1) : r * (q + 1) + (xcd - r) * q) + off; }
    const int nig = WGM * nN, gid = wgid / nig, fm = gid * WGM, gsz = (nM - fm) < WGM ? (nM - fm) : WGM;
    pm = fm + ((wgid % nig) % gsz); pn = (wgid % nig) / gsz;
}
struct StaticOrder {
    int nM, nN, nwg, G, c, kt, latonly, nctx; const char* A; const char* B; size_t tA, tB;
    __device__ __forceinline__ void init(int nM_, int nN_, int G_, int c_, const void* A_, int lda, const void* B_, int ldb, int K, int latonly_ = 0, int nctx_ = 0) { nM = nM_; nN = nN_; nwg = nM * nN; G = G_; c = c_; kt = K / BK; latonly = latonly_; nctx = nctx_;
        A = (const char*)A_; B = (const char*)B_; tA = (size_t)BM * lda * 2; tB = (size_t)BM * ldb * 2; }
    __device__ __forceinline__ bool next(int i, Unit& u) const {
        const long L = (long)i * G + c;
        if (L < nwg) { xcd_remap((int)L, nM, nN, u.pm, u.pn); if (latonly) u.pm += (u.pm >> 4) + 1; u.aux = 0; u.kt = kt; u.a = A + (size_t)u.pm * tA; u.b = B + (size_t)u.pn * tB; return true; }
        const int x = (int)(L - nwg); if (x >= nctx) return false;
        const int q = x & 3, t2 = x >> 2; u.pm = PPB_ * (t2 / nN); u.pn = t2 % nN; u.aux = 1; u.kt = kt >> 2;
        u.a = A + (size_t)u.pm * tA + (size_t)q * (kt >> 2) * BK * 2; u.b = B + (size_t)u.pn * tB + (size_t)q * (kt >> 2) * BK * 2; return true;
    }
};
template <class Epi, class Sched, int AMODE = 0, bool HOOK = false>
__device__ __forceinline__ void gemm_phase(LAS unsigned char* lds, const Gemm g, const Sched& S, const Epi& E, const int tid) {
    const int wid = __builtin_amdgcn_readfirstlane(tid >> 6), lane = tid & 63, wr = wid >> 2, wc = wid & 3, fr = lane & 15, fq = lane >> 4;
    unsigned voffA[2], voffB[2];
#pragma unroll
    for (int i = 0; i < 2; ++i) { int R_, C_; stage_rc(tid * 16 + i * 8192, R_, C_);
        voffA[i] = (AMODE == 1) ? (unsigned)((R_ * 16 + (C_ >> 4)) * LDP + (C_ & 15)) * 2u : (unsigned)(R_ * g.lda + C_) * 2u; voffB[i] = (unsigned)(R_ * g.ldb + C_) * 2u; }
    const size_t kstep = (size_t)(BK * 2), kstepA = (AMODE == 1) ? (size_t)(4 * LDP * 2) : kstep;
    const size_t hstepA = (AMODE == 1) ? (size_t)HALF * 16 * LDP * 2 : (size_t)HALF * g.lda * 2, hstepB = (size_t)HALF * g.ldb * 2;
    const unsigned ldsw = (unsigned)wid * 1024u;
    const int aoff = lds_byte(wr * 64 + fr, fq * 8), boff = lds_byte(wc * 32 + fr, fq * 8);
#define PG8_SA(b, h) (((b) * 2 + (h)) * HTB)
#define PG8_SB(b, h) ((4 + (b) * 2 + (h)) * HTB)
#define PG8_STAGE(bufoff, gbase, voff) do { _Pragma("unroll") for (int _i = 0; _i < 2; ++_i) \
        __builtin_amdgcn_global_load_lds((const unsigned*)((const char*)(gbase) + (voff)[_i]), (LAS unsigned*)(lds + (bufoff) + ldsw + _i * 8192), 16, 0, 0); } while (0)
#define PG8_LDA(dst, b, h) do { _Pragma("unroll") for (int m = 0; m < 4; ++m) _Pragma("unroll") for (int k = 0; k < 2; ++k) dst[m][k] = *(const LAS bf16x8*)(lds + PG8_SA(b, h) + aoff + m * 2048 + k * 1024); } while (0)
#define PG8_LDB(dst, b, h) do { _Pragma("unroll") for (int n = 0; n < 2; ++n) _Pragma("unroll") for (int k = 0; k < 2; ++k) dst[n][k] = *(const LAS bf16x8*)(lds + PG8_SB(b, h) + boff + n * 2048 + k * 1024); } while (0)
#define PG8_MMA(ai, bj, At, Bt) do { __builtin_amdgcn_s_setprio(1); _Pragma("unroll") for (int m = 0; m < 4; ++m) _Pragma("unroll") for (int n = 0; n < 2; ++n) _Pragma("unroll") for (int k = 0; k < 2; ++k) \
        acc[ai][bj][m][n] = __builtin_amdgcn_mfma_f32_16x16x32_bf16(Bt[n][k], At[m][k], acc[ai][bj][m][n], 0, 0, 0); __builtin_amdgcn_s_setprio(0); } while (0)
#define PG8_WAIT_V(n) asm volatile("s_waitcnt vmcnt(" #n ")" ::: "memory")
#define PG8_WAIT_L(n) asm volatile("s_waitcnt lgkmcnt(" #n ")" ::: "memory")
#define PG8_BAR __builtin_amdgcn_s_barrier()
#define PG8_SCHED __builtin_amdgcn_sched_barrier(0)
    Unit cur, nxt; int ui = 0;
    if (!S.next(0, cur)) return;
    f32x4 acc[2][2][4][2];
#pragma unroll
    for (int a = 0; a < 2; ++a)
#pragma unroll
        for (int b = 0; b < 2; ++b)
#pragma unroll
            for (int m = 0; m < 4; ++m)
#pragma unroll
                for (int n = 0; n < 2; ++n) acc[a][b][m][n] = (f32x4){0.f, 0.f, 0.f, 0.f};
    bf16x8 At[4][2], B0[2][2], B1[2][2];
    const char* cA = cur.a; const char* cB = cur.b;
    PG8_STAGE(PG8_SB(0, 0), cB, voffB); PG8_STAGE(PG8_SB(0, 1), cB + hstepB, voffB); PG8_STAGE(PG8_SA(0, 0), cA, voffA); PG8_STAGE(PG8_SA(0, 1), cA + hstepA, voffA);
    if (wr == 1) PG8_BAR;
    PG8_WAIT_V(2); PG8_BAR;
    PG8_STAGE(PG8_SB(1, 0), cB + kstep, voffB); PG8_STAGE(PG8_SA(1, 0), cA + kstepA, voffA); PG8_STAGE(PG8_SB(1, 1), cB + hstepB + kstep, voffB);
    PG8_WAIT_V(6); PG8_BAR;
    for (;;) {
        const bool has_next = S.next(ui + 1, nxt);
        const char* nA = has_next ? nxt.a : cA; const char* nB = has_next ? nxt.b : cB;
        const int nt = cur.kt;
        for (int t = 0; t < nt; t += 2) {
            const bool last = (t == nt - 2);
            if constexpr (HOOK) { if (t == 16 || t == 32) E.mid(acc, cur, t >> 4, wr, wc); }
            const char* a1 = cA + (size_t)(t + 1) * kstepA;
            const char* a2 = last ? nA : cA + (size_t)(t + 2) * kstepA; const char* b2 = last ? nB : cB + (size_t)(t + 2) * kstep;
            const char* a3 = a2 + kstepA; const char* b3 = b2 + kstep;
            PG8_LDB(B0, 0, 0); PG8_LDB(B1, 0, 1); PG8_SCHED; PG8_LDA(At, 0, 0); PG8_STAGE(PG8_SA(1, 1), a1 + hstepA, voffA);
            PG8_WAIT_V(8); PG8_WAIT_L(0); PG8_BAR; PG8_MMA(0, 0, At, B0); PG8_MMA(0, 1, At, B1); PG8_BAR; PG8_SCHED;
            PG8_LDA(At, 0, 1); PG8_STAGE(PG8_SB(0, 0), b2, voffB); PG8_STAGE(PG8_SB(0, 1), b2 + hstepB, voffB); PG8_STAGE(PG8_SA(0, 0), a2, voffA);
            PG8_WAIT_V(8); PG8_WAIT_L(0); PG8_BAR; PG8_MMA(1, 0, At, B0); PG8_MMA(1, 1, At, B1); PG8_BAR; PG8_SCHED;
            PG8_LDB(B0, 1, 0); PG8_LDB(B1, 1, 1); PG8_SCHED; PG8_LDA(At, 1, 0); PG8_STAGE(PG8_SA(0, 1), a2 + hstepA, voffA);
            PG8_WAIT_V(8); PG8_WAIT_L(0); PG8_BAR; PG8_MMA(0, 0, At, B0); PG8_MMA(0, 1, At, B1); PG8_BAR; PG8_SCHED;
            PG8_LDA(At, 1, 1); PG8_STAGE(PG8_SB(1, 0), b3, voffB); PG8_STAGE(PG8_SB(1, 1), b3 + hstepB, voffB); PG8_STAGE(PG8_SA(1, 0), a3, voffA);
            PG8_WAIT_V(8); PG8_WAIT_L(0); PG8_BAR; PG8_MMA(1, 0, At, B0); PG8_MMA(1, 1, At, B1); PG8_BAR; PG8_SCHED;
        }
        if (wr == 0) PG8_BAR;
        E(acc, cur, wr, wc, fr, fq);
        if (!has_next) break;
#pragma unroll
        for (int a = 0; a < 2; ++a)
#pragma unroll
            for (int b = 0; b < 2; ++b)
#pragma unroll
                for (int m = 0; m < 4; ++m)
#pragma unroll
                    for (int n = 0; n < 2; ++n) acc[a][b][m][n] = (f32x4){0.f, 0.f, 0.f, 0.f};
        cur = nxt; cA = nA; cB = nB; ++ui;
        if (wr == 1) PG8_BAR;
    }
    PG8_WAIT_V(0);
    PG8_BAR;
#undef PG8_SA
#undef PG8_SB
#undef PG8_STAGE
#undef PG8_LDA
#undef PG8_LDB
#undef PG8_MMA
#undef PG8_WAIT_V
#undef PG8_WAIT_L
#undef PG8_BAR
#undef PG8_SCHED
}
}

struct EpiSwiGLU {
    bf16_t* O;
    __device__ __forceinline__ void operator()(const f32x4 (&acc)[2][2][4][2], const pg8::Unit& u, int wr, int wc, int, int) const { const int ln_ = lane_now(); const int fr = ln_ & 15, fq = ln_ >> 4;
        const int row0 = u.pm * 256 + wr * 64 + fr, hc0 = u.pn * 128 + wc * 16 + 4 * fq;
#pragma unroll
        for (int ai = 0; ai < 2; ++ai)
#pragma unroll
            for (int m = 0; m < 4; ++m) { bf16_t* rowp = O + (size_t)(row0 + ai * 128 + m * 16) * DFF + hc0;
#pragma unroll
                for (int bj = 0; bj < 2; ++bj) { const f32x4 a = acc[ai][bj][m][0], b = acc[ai][bj][m][1];
                    u32x2 w; w.x = cvt_pk_bf16(siluf_(a[0]) * b[0], siluf_(a[1]) * b[1]); w.y = cvt_pk_bf16(siluf_(a[2]) * b[2], siluf_(a[3]) * b[3]);
                    *(u32x2*)(rowp + bj * 64) = w; } }
    }
};
struct EpiResid {
    _Float16* H; float* HC; const float* gate; const float* lng; const float* lnb; const float* stats;
    __device__ __forceinline__ void operator()(const f32x4 (&acc)[2][2][4][2], const pg8::Unit& u, int wr, int wc, int, int) const { const int ln_ = lane_now(); const int fr = ln_ & 15, fq = ln_ >> 4;
        const int pp = u.pm % PPB, mi = (pp == 0) ? 4 : (u.pm / PPB);
        const int rl0 = wr * 64 + fr, col0 = u.pn * 256 + wc * 32 + 4 * fq;
        if (u.aux) {
            float* hc = HC + (size_t)(u.pm / PPB) * 256 * D;
#pragma unroll
            for (int bj = 0; bj < 2; ++bj)
#pragma unroll
                for (int n = 0; n < 2; ++n) { const f32x4 gv = *(const f32x4*)(gate + (size_t)mi * NMOD + col0 + bj * 128 + n * 16);
#pragma unroll
                    for (int ai = 0; ai < 2; ++ai)
#pragma unroll
                        for (int m = 0; m < 4; ++m) { float* p = hc + (size_t)(rl0 + ai * 128 + m * 16) * D + col0 + bj * 128 + n * 16; const f32x4 v = gv * acc[ai][bj][m][n];
                            unsafeAtomicAdd(p, v[0]); unsafeAtomicAdd(p + 1, v[1]); unsafeAtomicAdd(p + 2, v[2]); unsafeAtomicAdd(p + 3, v[3]); } }
            return;
        }
        f32x2 st[2][4];
#pragma unroll
        for (int ai = 0; ai < 2; ++ai)
#pragma unroll
            for (int m = 0; m < 4; ++m) st[ai][m] = *(const f32x2*)(stats + (size_t)(u.pm * 256 + rl0 + ai * 128 + m * 16) * 2);
#pragma unroll
        for (int bj = 0; bj < 2; ++bj) {
            h16x4 tv[2][2][4];
#pragma unroll
            for (int n = 0; n < 2; ++n)
#pragma unroll
                for (int ai = 0; ai < 2; ++ai)
#pragma unroll
                    for (int m = 0; m < 4; ++m) tv[n][ai][m] = *(const h16x4*)(H + (size_t)(u.pm * 256 + rl0 + ai * 128 + m * 16) * D + col0 + bj * 128 + n * 16);
#pragma unroll
            for (int n = 0; n < 2; ++n) { const int c = col0 + bj * 128 + n * 16; const f32x4 gv = *(const f32x4*)(gate + (size_t)mi * NMOD + c);
                const f32x4 g4 = *(const f32x4*)(lng + c) * DN_ALPHA, b4 = *(const f32x4*)(lnb + c) * DN_ALPHA;
#pragma unroll
                for (int ai = 0; ai < 2; ++ai)
#pragma unroll
                    for (int m = 0; m < 4; ++m) { const h16x4 h = tv[n][ai][m]; const f32x4 t = (f32x4){(float)h[0], (float)h[1], (float)h[2], (float)h[3]};
                        st_h4(H + (size_t)(u.pm * 256 + rl0 + ai * 128 + m * 16) * D + c, (t - st[ai][m].x) * st[ai][m].y * g4 + b4 + gv * acc[ai][bj][m][n]); } }
            asm volatile("" ::: "memory"); }
    }
};
struct EpiProj {
    bf16_t* P; float* DT; const float* rc; const float* rs; bf16_t* U2;
    __device__ __forceinline__ void operator()(const f32x4 (&acc)[2][2][4][2], const pg8::Unit& u, int wr, int wc, int, int) const { const int ln_ = lane_now(); const int fr = ln_ & 15, fq = ln_ >> 4;
        const int pp = u.pm % PPB; const int row0 = u.pm * 256 + wr * 64 + fr;
        const int pn = u.pn;
        if (pn == 52) {
            if (wc == 0) {
#pragma unroll
                for (int ai = 0; ai < 2; ++ai)
#pragma unroll
                    for (int m = 0; m < 4; ++m)
#pragma unroll
                        for (int n = 0; n < 2; ++n) *(f32x4*)(DT + (size_t)(row0 + ai * 128 + m * 16) * 32 + n * 16 + 4 * fq) = acc[ai][0][m][n];
            }
            return;
        }
        if (pn >= 28) {
            const int jg = (pn - 28) >> 3, pnd = (pn - 28) & 7;
            unsigned char* gq = (unsigned char*)P - WS_PROJ + gq_off(jg) + ((size_t)((u.pm * 8 + pnd) * 512 + (wr * 4 + wc) * 64 + ln_)) * 128;
#pragma unroll
            for (int ai = 0; ai < 2; ++ai)
#pragma unroll
                for (int m = 0; m < 4; ++m) { u32x4 w;
#pragma unroll
                    for (int bj = 0; bj < 2; ++bj)
#pragma unroll
                        for (int n = 0; n < 2; ++n) { const f32x4 v = acc[ai][bj][m][n]; unsigned q = 0;
#pragma unroll
                            for (int e = 0; e < 4; ++e) q |= (unsigned)fmaxf(__builtin_rintf(sigmoidf_(v[e]) * 255.0f), 1.0f) << (8 * e);
                            w[bj * 2 + n] = q; }
                    *(u32x4*)(gq + (ai * 4 + m) * 16) = w; }
            return;
        }
        const int col0 = pn * 256 + wc * 32 + 4 * fq;
        const int mode = (pn < 8) ? ((pp != 0) ? 1 : 0) : ((pn >= 12 && pn < 16) ? 2 : 0);
        const float sc = (pn < 4) ? QSCALE : 1.0f;
#pragma unroll
        for (int ai = 0; ai < 2; ++ai) {
          f32x4 csv[4], snv[4];
          if (mode == 1) {
#pragma unroll
              for (int m = 0; m < 4; ++m) { const int rl = ai * 128 + wr * 64 + m * 16 + fr; const int t = (pp - 1) * 256 + rl; const int pos = (wc & 1) ? (t & 63) : (t >> 6); csv[m] = *(const f32x4*)(rc + pos * 16 + 4 * fq); snv[m] = *(const f32x4*)(rs + pos * 16 + 4 * fq); }
              asm volatile("s_waitcnt vmcnt(0)" ::: "memory"); }
#pragma unroll
            for (int m = 0; m < 4; ++m) { const int rl = ai * 128 + wr * 64 + m * 16 + fr; bf16_t* rowp = P + (size_t)(u.pm * 256 + rl) * LDP + col0;
                f32x4 cs = (f32x4){1.f, 1.f, 1.f, 1.f}, sn = (f32x4){0.f, 0.f, 0.f, 0.f};
                if (mode == 1) { cs = csv[m]; sn = snv[m]; }
#pragma unroll
                for (int bj = 0; bj < 2; ++bj) { f32x4 v0 = acc[ai][bj][m][0], v1 = acc[ai][bj][m][1];
                    if (mode == 1) { const f32x4 o0 = v0 * cs - v1 * sn, o1 = v1 * cs + v0 * sn; v0 = o0; v1 = o1; }
                    else if (mode == 2) {
#pragma unroll
                        for (int e = 0; e < 4; ++e) { v0[e] = siluf_(v0[e]); v1[e] = siluf_(v1[e]); } }
                    if (pn >= 24 && pn < 28) {
                        bf16_t* u2 = U2 + ((size_t)(((pn - 24) * 256 + bj * 128 + wc * 32) >> 4) * R + (size_t)(u.pm * 256 + rl)) * 16 + 4 * fq;
                        u32x2 a0, a1; a0.x = cvt_pk_bf16(v0[0], v0[1]); a0.y = cvt_pk_bf16(v0[2], v0[3]); a1.x = cvt_pk_bf16(v1[0], v1[1]); a1.y = cvt_pk_bf16(v1[2], v1[3]);
                        *(u32x2*)u2 = a0; *(u32x2*)(u2 + (size_t)R * 16) = a1; continue; }
                    v0 = v0 * sc; v1 = v1 * sc;
                    u32x2 w0, w1; w0.x = cvt_pk_bf16(v0[0], v0[1]); w0.y = cvt_pk_bf16(v0[2], v0[3]); w1.x = cvt_pk_bf16(v1[0], v1[1]); w1.y = cvt_pk_bf16(v1[2], v1[3]);
                    *(u32x2*)(rowp + bj * 128) = w0; *(u32x2*)(rowp + bj * 128 + 16) = w1; } } }
    }
};
struct EpiGlu {
    bf16_t* P; const float* bias;
    __device__ __forceinline__ void operator()(const f32x4 (&acc)[2][2][4][2], const pg8::Unit& u, int wr, int wc, int, int) const { const int ln_ = lane_now(); const int fr = ln_ & 15, fq = ln_ >> 4;
        const int row0 = u.pm * 256 + wr * 64 + fr, col0 = u.pn * 256 + wc * 32 + 4 * fq;
        f32x4 bv[2][2];
#pragma unroll
        for (int bj = 0; bj < 2; ++bj)
#pragma unroll
            for (int n = 0; n < 2; ++n) bv[bj][n] = *(const f32x4*)(bias + col0 + bj * 128 + n * 16);
#pragma unroll
        for (int ai = 0; ai < 2; ++ai) {
            u32x2 tv[4][2][2];
#pragma unroll
            for (int m = 0; m < 4; ++m)
#pragma unroll
                for (int bj = 0; bj < 2; ++bj)
#pragma unroll
                    for (int n = 0; n < 2; ++n) tv[m][bj][n] = *(const u32x2*)(P + (size_t)(row0 + ai * 128 + m * 16) * LDP + PU + col0 + bj * 128 + n * 16);
            asm volatile("s_waitcnt vmcnt(0)" ::: "memory");
#pragma unroll
            for (int m = 0; m < 4; ++m) { bf16_t* rowp = P + (size_t)(row0 + ai * 128 + m * 16) * LDP;
#pragma unroll
                for (int bj = 0; bj < 2; ++bj)
#pragma unroll
                    for (int n = 0; n < 2; ++n) { const int c = col0 + bj * 128 + n * 16; const u32x2 t = tv[m][bj][n];
                        const f32x4 a = acc[ai][bj][m][n] + bv[bj][n]; u32x2 w;
                        w.x = cvt_pk_bf16(bflo(t.x) * sigmoidf_(a[0]), bfhi(t.x) * sigmoidf_(a[1])); w.y = cvt_pk_bf16(bflo(t.y) * sigmoidf_(a[2]), bfhi(t.y) * sigmoidf_(a[3]));
                        *(u32x2*)(rowp + PK + c) = w; } } }
    }
};
struct EpiMerge {
    const bf16_t* P; bf16_t* MIXB;
    static __device__ __forceinline__ int jmap(int seg) { return seg == 0 ? 0 : (seg == 1 ? 2 : 1); }
    __device__ __forceinline__ const unsigned char* gbase(const pg8::Unit& u, int seg, int wr, int wc, int ln_) const {
        return (const unsigned char*)P - WS_PROJ + gq_off(jmap(seg)) + ((size_t)((u.pm * 8 + u.pn) * 512 + (wr * 4 + wc) * 64 + ln_)) * 128; }
    __device__ __forceinline__ void mid(f32x4 (&acc)[2][2][4][2], const pg8::Unit& u, int seg, int wr, int wc) const {
        const int ln_ = lane_now(); const unsigned char* ga = gbase(u, seg - 1, wr, wc, ln_); const unsigned char* gb = gbase(u, seg, wr, wc, ln_);
        u32x4 a[2][4], b[2][4];
#pragma unroll
        for (int ai = 0; ai < 2; ++ai)
#pragma unroll
            for (int m = 0; m < 4; ++m) { a[ai][m] = *(const u32x4*)(ga + (ai * 4 + m) * 16); b[ai][m] = *(const u32x4*)(gb + (ai * 4 + m) * 16); }
        asm volatile("s_waitcnt vmcnt(0)" ::: "memory");
#pragma unroll
        for (int ai = 0; ai < 2; ++ai)
#pragma unroll
            for (int m = 0; m < 4; ++m)
#pragma unroll
                for (int bj = 0; bj < 2; ++bj)
#pragma unroll
                    for (int n = 0; n < 2; ++n) { const unsigned qa = a[ai][m][bj * 2 + n], qb = b[ai][m][bj * 2 + n]; f32x4 r;
#pragma unroll
                        for (int e = 0; e < 4; ++e) r[e] = (float)((qa >> (8 * e)) & 255u) * __builtin_amdgcn_rcpf((float)((qb >> (8 * e)) & 255u));
                        acc[ai][bj][m][n] = acc[ai][bj][m][n] * r; }
    }
    __device__ __forceinline__ void operator()(const f32x4 (&acc)[2][2][4][2], const pg8::Unit& u, int wr, int wc, int, int) const { const int ln_ = lane_now(); const int fr = ln_ & 15, fq = ln_ >> 4;
        const int row0 = u.pm * 256 + wr * 64 + fr, col0 = u.pn * 256 + wc * 32 + 4 * fq; const unsigned char* gl = gbase(u, 2, wr, wc, ln_);
        u32x4 gq[2][4];
#pragma unroll
        for (int ai = 0; ai < 2; ++ai)
#pragma unroll
            for (int m = 0; m < 4; ++m) gq[ai][m] = *(const u32x4*)(gl + (ai * 4 + m) * 16);
        asm volatile("s_waitcnt vmcnt(0)" ::: "memory");
#pragma unroll
        for (int ai = 0; ai < 2; ++ai)
#pragma unroll
            for (int m = 0; m < 4; ++m) { const size_t row = (size_t)(row0 + ai * 128 + m * 16); const u32x4 g4 = gq[ai][m];
#pragma unroll
                for (int bj = 0; bj < 2; ++bj)
#pragma unroll
                    for (int n = 0; n < 2; ++n) { const int c = col0 + bj * 128 + n * 16; const unsigned gv = g4[bj * 2 + n];
                        f32x4 v = acc[ai][bj][m][n];
#pragma unroll
                        for (int e = 0; e < 4; ++e) v[e] *= (float)((gv >> (8 * e)) & 255u) * (1.0f / 255.0f);
                        u32x2 w; w.x = cvt_pk_bf16(v[0], v[1]); w.y = cvt_pk_bf16(v[2], v[3]); *(u32x2*)(MIXB + row * D + c) = w; } }
    }
};

struct S5AOrder {
    int G, c; const char* A; const char* B;
    __device__ __forceinline__ bool next(int i, pg8::Unit& u) const {
        const int idx = i * G + c; if (idx >= 640) return false;
        const int g = idx / 10, r = idx - 10 * g, nt = r / 5, mt = r - 5 * nt;
        u.pm = mt; u.pn = nt; u.aux = g; u.kt = 4; u.a = A + ((size_t)g * (R / 16) + (size_t)mt * 256) * 256 * 2; u.b = B + (size_t)(g * 512 + nt * 256) * 256 * 2; return true;
    }
};
struct EpiS5A {
    unsigned char* YLF; bf16_t* ST;
    __device__ __forceinline__ void operator()(const f32x4 (&acc)[2][2][4][2], const pg8::Unit& u, int wr, int wc, int, int) const { const int ln_ = lane_now(); const int fr = ln_ & 15, fq = ln_ >> 4;
        const int g = u.aux;
        if (u.pn == 0) { unsigned char* yl = YLF + ((size_t)((g * 5 + u.pm) * 512 + (wr * 4 + wc) * 64 + ln_)) * 256;
#pragma unroll
            for (int ai = 0; ai < 2; ++ai)
#pragma unroll
                for (int m = 0; m < 4; ++m) { u32x4 w0, w1;
                    w0.x = cvt_pk_bf16(acc[ai][0][m][0][0], acc[ai][0][m][0][1]); w0.y = cvt_pk_bf16(acc[ai][0][m][0][2], acc[ai][0][m][0][3]); w0.z = cvt_pk_bf16(acc[ai][0][m][1][0], acc[ai][0][m][1][1]); w0.w = cvt_pk_bf16(acc[ai][0][m][1][2], acc[ai][0][m][1][3]);
                    w1.x = cvt_pk_bf16(acc[ai][1][m][0][0], acc[ai][1][m][0][1]); w1.y = cvt_pk_bf16(acc[ai][1][m][0][2], acc[ai][1][m][0][3]); w1.z = cvt_pk_bf16(acc[ai][1][m][1][0], acc[ai][1][m][1][1]); w1.w = cvt_pk_bf16(acc[ai][1][m][1][2], acc[ai][1][m][1][3]);
                    *(u32x4*)(yl + (ai * 4 + m) * 32) = w0; *(u32x4*)(yl + (ai * 4 + m) * 32 + 16) = w1; }
            return; }
#pragma unroll
        for (int ai = 0; ai < 2; ++ai)
#pragma unroll
            for (int m = 0; m < 4; ++m) { const int mr = u.pm * 256 + ai * 128 + wr * 64 + m * 16 + fr; if (mr < S5M) {
#pragma unroll
                for (int bj = 0; bj < 2; ++bj)
#pragma unroll
                    for (int n = 0; n < 2; ++n) { const f32x4 v = acc[ai][bj][m][n];
                        u32x2 w; w.x = cvt_pk_bf16(v[0], v[1]); w.y = cvt_pk_bf16(v[2], v[3]); *(u32x2*)(ST + ((size_t)g * S5M + mr) * 256 + bj * 128 + wc * 32 + n * 16 + 4 * fq) = w; } } }
    }
};
struct S5COrder {
    int G, c; const char* A; const char* B;
    __device__ __forceinline__ bool next(int i, pg8::Unit& u) const {
        const int idx = i * G + c; if (idx >= 320) return false;
        const int g = idx / 5, mt = idx - 5 * g;
        u.pm = mt; u.pn = 0; u.aux = g; u.kt = 4; u.a = A + ((size_t)g * 1280 + mt * 256) * 256 * 2; u.b = B + (size_t)g * 256 * 256 * 2; return true;
    }
};
struct EpiS5C {
    const unsigned char* YLF; bf16_t* P;
    __device__ __forceinline__ void operator()(const f32x4 (&acc)[2][2][4][2], const pg8::Unit& u, int wr, int wc, int, int) const { const int ln_ = lane_now(); const int fr = ln_ & 15, fq = ln_ >> 4;
        const int g = u.aux; const unsigned char* yl = YLF + ((size_t)((g * 5 + u.pm) * 512 + (wr * 4 + wc) * 64 + ln_)) * 256;
        u32x4 y0[2][4], y1[2][4];
#pragma unroll
        for (int ai = 0; ai < 2; ++ai)
#pragma unroll
            for (int m = 0; m < 4; ++m) { y0[ai][m] = *(const u32x4*)(yl + (ai * 4 + m) * 32); y1[ai][m] = *(const u32x4*)(yl + (ai * 4 + m) * 32 + 16); }
        asm volatile("s_waitcnt vmcnt(0)" ::: "memory");
#pragma unroll
        for (int ai = 0; ai < 2; ++ai)
#pragma unroll
            for (int m = 0; m < 4; ++m) { const int mr = u.pm * 256 + ai * 128 + wr * 64 + m * 16 + fr; if (mr < S5M) {
#pragma unroll
                for (int bj = 0; bj < 2; ++bj)
#pragma unroll
                    for (int n = 0; n < 2; ++n) { const int rho = 8 * bj + 2 * wc + n; const size_t row = (size_t)(16 * mr + rho);
                        const u32x4 yy = bj ? y1[ai][m] : y0[ai][m]; const unsigned ya = n ? yy.z : yy.x, yb = n ? yy.w : yy.y; f32x4 v = acc[ai][bj][m][n];
                        v[0] += bflo(ya); v[1] += bfhi(ya); v[2] += bflo(yb); v[3] += bfhi(yb);
#pragma unroll
                        for (int e = 0; e < 4; ++e) { const float x = v[e]; const float inner = 0.7978845608028654f * (x + 0.044715f * x * x * x); const float th = 1.0f - 2.0f * __builtin_amdgcn_rcpf(1.0f + __builtin_amdgcn_exp2f(2.8853900817779268f * inner)); v[e] = 0.5f * x * (1.0f + th); }
                        u32x2 w; w.x = cvt_pk_bf16(v[0], v[1]); w.y = cvt_pk_bf16(v[2], v[3]); *(u32x2*)(P + row * LDP + PU + 16 * g + 4 * fq) = w; } } }
    }
};

namespace attn128 {
using bf16 = __hip_bfloat16;
constexpr int NW = 8, QBLK = 32, KVBLK = 64, LDQ = LDP, LDK = LDP, LDOB = LDP;
constexpr size_t SHM_V = KVBLK * 128 * 2, SHM_K = KVBLK * 64 * 2, SHM_ATTN = 2 * SHM_V + 2 * SHM_K + NW * 64 * 4, SHM_TOTAL = SHM_ATTN + NW * 8192;
constexpr float THRL = 11.5f;
#define A128_KSWZ(row, colB) ((row) * 128 + ((colB) ^ (((row) & 7) << 4)))
#define A128_SBAR() __builtin_amdgcn_sched_barrier(0)
__device__ __forceinline__ int crow(int r, int hi) { return (r & 3) + 8 * (r >> 2) + 4 * hi; }
__device__ __forceinline__ void partialSM(f32x16& p0, f32x16& p1, float& m_reg, float& mn, float& alpha) {
  float pmax = p0[0];
#pragma unroll
  for (int r = 1; r < 16; ++r) pmax = fmaxf(pmax, p0[r]);
#pragma unroll
  for (int r = 0; r < 16; ++r) pmax = fmaxf(pmax, p1[r]);
  { auto rr = __builtin_amdgcn_permlane32_swap(__float_as_uint(pmax), __float_as_uint(pmax), false, false); pmax = fmaxf(__uint_as_float(rr[0]), __uint_as_float(rr[1])); }
  if (__builtin_expect(__all(pmax - m_reg <= THRL), 1)) { mn = m_reg; alpha = 1.f; }
  else { mn = fmaxf(m_reg, pmax); alpha = __builtin_amdgcn_exp2f(m_reg - mn); m_reg = mn; }
#pragma unroll
  for (int r = 0; r < 16; ++r) { p0[r] = p0[r] - mn; p1[r] = p1[r] - mn; }
#pragma unroll
  for (int r = 0; r < 16; ++r) p0[r] = __builtin_amdgcn_exp2f(p0[r]);
}
__device__ __forceinline__ void finishSM(f32x16& p0, f32x16& p1, float alpha, float& l_reg, bf16x8& pa0, bf16x8& pa1, bf16x8& pa2, bf16x8& pa3) {
#pragma unroll
  for (int r = 0; r < 16; ++r) p1[r] = __builtin_amdgcn_exp2f(p1[r]);
  float ps = 0;
#pragma unroll
  for (int r = 0; r < 16; ++r) ps += p0[r];
#pragma unroll
  for (int r = 0; r < 16; ++r) ps += p1[r];
  { auto rr = __builtin_amdgcn_permlane32_swap(__float_as_uint(ps), __float_as_uint(ps), false, false); ps = __uint_as_float(rr[0]) + __uint_as_float(rr[1]); }
  l_reg = l_reg * alpha + ps;
#define A128_PK4(P, BASE, OUT) do { unsigned a0 = cvt_pk_bf16(P[BASE + 0], P[BASE + 1]), a1 = cvt_pk_bf16(P[BASE + 2], P[BASE + 3]);   \
    unsigned b0 = cvt_pk_bf16(P[BASE + 4], P[BASE + 5]), b1 = cvt_pk_bf16(P[BASE + 6], P[BASE + 7]);                              \
    auto r0 = __builtin_amdgcn_permlane32_swap(a0, b0, false, false); auto r1 = __builtin_amdgcn_permlane32_swap(a1, b1, false, false); \
    u32x4 w = {r0[0], r1[0], r0[1], r1[1]}; OUT = __builtin_bit_cast(bf16x8, w); } while (0)
  A128_PK4(p0, 0, pa0); A128_PK4(p0, 8, pa1); A128_PK4(p1, 0, pa2); A128_PK4(p1, 8, pa3);
#undef A128_PK4
}
__device__ __forceinline__ void qkt(f32x16& p0, f32x16& p1, const char* Ks, const bf16x8* qr, int r32, int hi) {
#pragma unroll
  for (int i = 0; i < 16; ++i) { p0[i] = 0.f; p1[i] = 0.f; }
#pragma unroll
  for (int d0 = 0; d0 < 4; ++d0) { const int cb = (d0 * 16 + hi * 8) * 2;
    const bf16x8 b0 = *reinterpret_cast<const bf16x8*>(Ks + A128_KSWZ(r32, cb));
    const bf16x8 b1 = *reinterpret_cast<const bf16x8*>(Ks + A128_KSWZ(32 + r32, cb));
    p0 = __builtin_amdgcn_mfma_f32_32x32x16_bf16(b0, qr[d0], p0, 0, 0, 0);
    p1 = __builtin_amdgcn_mfma_f32_32x32x16_bf16(b1, qr[d0], p1, 0, 0, 0); }
}
__device__ __forceinline__ int v_st(int k, int c) { const int kk = (k & ~0xC) | ((k & 4) << 1) | ((k & 8) >> 1); return ((kk >> 3) * 4 + (c >> 5)) * 512 + ((kk & 7) * 32 + (c & 31)) * 2; }
__device__ __forceinline__ int v_rd_base(int lane) { return ((lane & 3) << 3) | (((lane >> 2) & 3) << 6) | (((lane >> 4) & 1) << 5) | (((lane >> 5) & 1) << 8); }
constexpr int v_rd_off(int d0, int ks, int half) { return d0 * 512 + ks * 4096 + half * 2048; }
template <int OFF> __device__ __forceinline__ s16x4 tr_read(int vb) { s16x4 r; asm volatile("ds_read_b64_tr_b16 %0, %1 offset:%2" : "=&v"(r) : "v"(vb), "i"(OFF) : "memory"); return r; }
template <int D0> __device__ __forceinline__ void pv_one(f32x16& od, int vb, bf16x8 pa0, bf16x8 pa1, bf16x8 pa2, bf16x8 pa3) {
  const s16x4 l0 = tr_read<v_rd_off(D0, 0, 0)>(vb), h0 = tr_read<v_rd_off(D0, 0, 1)>(vb), l1 = tr_read<v_rd_off(D0, 1, 0)>(vb), h1 = tr_read<v_rd_off(D0, 1, 1)>(vb);
  const s16x4 l2 = tr_read<v_rd_off(D0, 2, 0)>(vb), h2 = tr_read<v_rd_off(D0, 2, 1)>(vb), l3 = tr_read<v_rd_off(D0, 3, 0)>(vb), h3 = tr_read<v_rd_off(D0, 3, 1)>(vb);
  asm volatile("s_waitcnt lgkmcnt(0)" ::: "memory"); A128_SBAR();
#define A128_PK(L, H) (bf16x8){L[0], L[1], L[2], L[3], H[0], H[1], H[2], H[3]}
  od = __builtin_amdgcn_mfma_f32_32x32x16_bf16(pa0, A128_PK(l0, h0), od, 0, 0, 0);
  od = __builtin_amdgcn_mfma_f32_32x32x16_bf16(pa1, A128_PK(l1, h1), od, 0, 0, 0);
  od = __builtin_amdgcn_mfma_f32_32x32x16_bf16(pa2, A128_PK(l2, h2), od, 0, 0, 0);
  od = __builtin_amdgcn_mfma_f32_32x32x16_bf16(pa3, A128_PK(l3, h3), od, 0, 0, 0);
#undef A128_PK
}
__device__ __forceinline__ void pv_d0(f32x16* o, int vb, bf16x8 pa0, bf16x8 pa1, bf16x8 pa2, bf16x8 pa3) {
  pv_one<0>(o[0], vb, pa0, pa1, pa2, pa3); pv_one<1>(o[1], vb, pa0, pa1, pa2, pa3); pv_one<2>(o[2], vb, pa0, pa1, pa2, pa3); pv_one<3>(o[3], vb, pa0, pa1, pa2, pa3);
}
__device__ __forceinline__ void unit(const bf16* __restrict__ Qb0, const bf16* __restrict__ Kh0, const bf16* __restrict__ Vh, bf16_t* Ob, int seq, char* lds, const int tid_in, const float lam, const float onem, const float* __restrict__ subw) {
#pragma unroll 1
 for (int mp = 0; mp < 2; ++mp) {
  int tid = tid_in; asm volatile("" : "+v"(tid));
  bf16_t* stage = (bf16_t*)(lds + SHM_ATTN) + (tid >> 6) * 4096;
  const bf16* Qb = Qb0 + mp * 64; const bf16* Kh = Kh0 + mp * 64;
  const int wid = __builtin_amdgcn_readfirstlane(tid >> 6), lane = tid & 63, r32 = lane & 31, hi = lane >> 5;
  char* V_lds = lds; char* K_lds = lds + 2 * SHM_V;
  float* ws = (float*)(lds + 2 * SHM_V + 2 * SHM_K) + wid * 64; float* li_l = ws; float* al_l = ws + 32;
  float m_reg = -1e30f, l_reg = 0; f32x16 o[4]; bf16x8 qr[4];
#pragma unroll
  for (int d = 0; d < 4; ++d)
#pragma unroll
    for (int r = 0; r < 16; ++r) o[d][r] = 0.f;
  const bf16* Qw = Qb + (long)(wid * QBLK + r32) * LDQ + hi * 8;
#pragma unroll
  for (int d0 = 0; d0 < 4; ++d0) qr[d0] = *reinterpret_cast<const bf16x8*>(Qw + d0 * 16);
  const int sr = tid >> 4, sc = (tid & 15) * 8, vst0 = v_st(sr, sc), vst1 = v_st(32 + sr, sc);
  const int kr = tid >> 3, kc = (tid & 7) * 8, kst = A128_KSWZ(kr, kc * 2);
  const int vb0 = (int)(uintptr_t)V_lds + v_rd_base(lane);
  struct { bf16x8 vs0, vs1, ks0; } sr_[2];
#define A128_SLOAD(i, k0) do { sr_[i].vs0 = *reinterpret_cast<const bf16x8*>(&Vh[(long)((k0) + sr) * LDK + sc]); sr_[i].vs1 = *reinterpret_cast<const bf16x8*>(&Vh[(long)((k0) + 32 + sr) * LDK + sc]); \
    sr_[i].ks0 = *reinterpret_cast<const bf16x8*>(&Kh[(long)((k0) + kr) * LDK + kc]); } while (0)
#define A128_SWRITE(b, i) do { *(bf16x8*)(V_lds + (b) * SHM_V + vst0) = sr_[i].vs0; *(bf16x8*)(V_lds + (b) * SHM_V + vst1) = sr_[i].vs1; *(bf16x8*)(K_lds + (b) * SHM_K + kst) = sr_[i].ks0; } while (0)
#define A128_SWAIT() asm volatile("s_waitcnt vmcnt(3)" ::: "memory")
#define A128_RESC(a) do { if (__any((a) < 1.f)) { if (hi == 0) al_l[r32] = (a); asm volatile("s_waitcnt lgkmcnt(0)" ::: "memory"); \
    _Pragma("unroll") for (int d = 0; d < 4; ++d) _Pragma("unroll") for (int r = 0; r < 16; ++r) o[d][r] *= al_l[crow(r, hi)]; } } while (0)
  f32x16 pA0, pA1, pB0, pB1; float mnA, mnB, alA, alB; bf16x8 pa0, pa1, pa2, pa3; const int NT = seq / KVBLK;
  A128_SLOAD(0, 0); asm volatile("s_waitcnt vmcnt(0)" ::: "memory"); A128_SWRITE(0, 0); __syncthreads();
  qkt(pA0, pA1, K_lds, qr, r32, hi); partialSM(pA0, pA1, m_reg, mnA, alA);
  A128_SLOAD(1, KVBLK); if (2 < NT) A128_SLOAD(0, 2 * KVBLK);
  A128_SWAIT(); A128_SWRITE(1, 1); __syncthreads();
  for (int j = 1; j + 1 < NT; j += 2) {
    A128_SBAR(); qkt(pB0, pB1, K_lds + SHM_K, qr, r32, hi);
    finishSM(pA0, pA1, alA, l_reg, pa0, pa1, pa2, pa3); A128_SBAR();
    A128_SLOAD(1, (j + 2) * KVBLK); A128_SBAR();
    pv_d0(o, vb0, pa0, pa1, pa2, pa3); partialSM(pB0, pB1, m_reg, mnB, alB);
    __syncthreads(); A128_SWAIT(); A128_SWRITE(0, 0);
    A128_RESC(alB); __syncthreads();
    A128_SBAR(); qkt(pA0, pA1, K_lds, qr, r32, hi);
    finishSM(pB0, pB1, alB, l_reg, pa0, pa1, pa2, pa3); A128_SBAR();
    if (j + 3 < NT) A128_SLOAD(0, (j + 3) * KVBLK); A128_SBAR();
    pv_d0(o, vb0 + (int)SHM_V, pa0, pa1, pa2, pa3); partialSM(pA0, pA1, m_reg, mnA, alA);
    __syncthreads(); A128_SWAIT(); A128_SWRITE(1, 1);
    A128_RESC(alA); __syncthreads();
  }
  A128_SBAR(); qkt(pB0, pB1, K_lds + SHM_K, qr, r32, hi);
  finishSM(pA0, pA1, alA, l_reg, pa0, pa1, pa2, pa3); A128_SBAR();
  pv_d0(o, vb0, pa0, pa1, pa2, pa3); partialSM(pB0, pB1, m_reg, mnB, alB);
  __syncthreads(); A128_RESC(alB);
  finishSM(pB0, pB1, alB, l_reg, pa0, pa1, pa2, pa3); A128_SBAR();
  pv_d0(o, vb0 + (int)SHM_V, pa0, pa1, pa2, pa3);
  if (hi == 0) li_l[r32] = l_reg; asm volatile("s_waitcnt lgkmcnt(0)" ::: "memory");
  float rli[16];
#pragma unroll
  for (int r = 0; r < 16; ++r) rli[r] = __builtin_amdgcn_rcpf(li_l[crow(r, hi)]);
  if (mp == 0) {
#pragma unroll
    for (int r = 0; r < 16; ++r)
#pragma unroll
      for (int d0 = 0; d0 < 4; ++d0) stage[(r * 4 + d0) * 64 + lane] = (bf16_t)(cvt_pk_bf16(o[d0][r] * rli[r], 0.f) & 0xffffu);
  } else {
    float ss[16];
#pragma unroll
    for (int r = 0; r < 16; ++r) { float q = 0.f;
#pragma unroll
      for (int d0 = 0; d0 < 4; ++d0) { const float a = bf1(stage[(r * 4 + d0) * 64 + lane]) - lam * bf1((bf16_t)(cvt_pk_bf16(o[d0][r] * rli[r], 0.f) & 0xffffu)); o[d0][r] = a; q += a * a; }
      ss[r] = q; }
#pragma unroll
    for (int m = 1; m < 32; m <<= 1)
#pragma unroll
      for (int r = 0; r < 16; ++r) ss[r] += __int_as_float(__builtin_amdgcn_ds_bpermute((lane ^ m) << 2, __float_as_int(ss[r])));
    float sw[4];
#pragma unroll
    for (int d0 = 0; d0 < 4; ++d0) sw[d0] = subw[d0 * 32 + r32] * onem;
    bf16_t* Ow = Ob + (long)(wid * QBLK) * LDOB;
#pragma unroll
    for (int r = 0; r < 16; ++r) { const int orow = crow(r, hi); const float rs = 1.0f / sqrtf(ss[r] * (1.f / 128.f) + RMS_EPS);
#pragma unroll
      for (int d0 = 0; d0 < 4; ++d0) Ow[(long)orow * LDOB + d0 * 32 + r32] = (bf16_t)(cvt_pk_bf16(o[d0][r] * rs * sw[d0], 0.f) & 0xffffu); }
  }
  __syncthreads();
 }
#undef A128_SLOAD
#undef A128_SWRITE
#undef A128_SWAIT
#undef A128_RESC
}
#undef A128_KSWZ
#undef A128_SBAR
}

#define XB_TMO      128
#define XB_XCNT(j)  (256  + 64 * (j))
#define XB_XSUB(j)  (1280 + 64 * (j))
#define XB_XGEN(j)  (2304 + 64 * (j))
#define XB_TOP      3328
#define XB_TOPGEN   3392
#define XCD_BAR_WORDS 3456
#define XB_SPIN_CAP (1u << 18)
__device__ __forceinline__ unsigned xb_ld(unsigned* p)              { return __hip_atomic_load(p, __ATOMIC_RELAXED, __HIP_MEMORY_SCOPE_AGENT); }
__device__ __forceinline__ unsigned xb_add(unsigned* p, unsigned v) { return __hip_atomic_fetch_add(p, v, __ATOMIC_RELAXED, __HIP_MEMORY_SCOPE_AGENT); }
__device__ __forceinline__ unsigned xb_xcc_id() { return (unsigned)__builtin_amdgcn_s_getreg((3 << 11) | 20) & 0xFu; }
#define XB_SPIN(cond, bar) do { unsigned _sp = 0; while (cond) { __builtin_amdgcn_s_sleep(1); \
    if ((++_sp & 255u) == 0u) { if (xb_ld(&(bar)[XB_TMO])) break; if (_sp > XB_SPIN_CAP) { atomicAdd(&(bar)[XB_TMO], 1u); break; } } } } while (0)
struct XcdBarrier { unsigned* bar; unsigned x; volatile LAS unsigned* st; };
__device__ __forceinline__ XcdBarrier xcd_barrier_post(unsigned* bar, volatile LAS unsigned* st) {
    XcdBarrier b; b.bar = bar; b.x = xb_xcc_id(); b.st = st;
    if (threadIdx.x == 0) (void)xb_add(&bar[XB_XCNT(b.x)], 1u);
    return b;
}
__device__ __forceinline__ void xcd_barrier_complete(unsigned* bar, unsigned x, unsigned& nloc, unsigned& nx) {
    const unsigned G = gridDim.x * gridDim.y * gridDim.z;
    unsigned sum, cnt, mine, sp = 0u;
    for (;;) {
        sum = 0u; cnt = 0u; mine = 0u;
#pragma unroll
        for (unsigned j = 0; j < 16; ++j) { const unsigned c = xb_ld(&bar[XB_XCNT(j)]); sum += c; cnt += (c > 0u) ? 1u : 0u; mine = (j == x) ? c : mine; }
        if (sum == G) break;
        __builtin_amdgcn_s_sleep(1);
        if ((++sp & 255u) == 0u) { if (xb_ld(&bar[XB_TMO])) break; if (sp > XB_SPIN_CAP) { atomicAdd(&bar[XB_TMO], 1u); break; } }
    }
    nloc = mine > 0u ? mine : 1u; nx = cnt > 0u ? cnt : 1u;
}
__device__ __forceinline__ void xcd_barrier(const XcdBarrier& b, const int tid) {
    asm volatile("s_waitcnt vmcnt(0)" ::: "memory");
    __syncthreads();
    if (tid == 0) {
        unsigned* bar = b.bar;
        __builtin_amdgcn_s_waitcnt(0);
        unsigned nloc = b.st[0], nx = b.st[1];
        if (nloc == 0u) { xcd_barrier_complete(bar, b.x, nloc, nx); b.st[0] = nloc; b.st[1] = nx; }
        const unsigned old = xb_add(&bar[XB_XSUB(b.x)], 1u);
        const unsigned gen = old / nloc;
        if (old + 1u == (gen + 1u) * nloc) {
            __builtin_amdgcn_fence(__ATOMIC_RELEASE, "agent");
            asm volatile("s_waitcnt vmcnt(0)" ::: "memory");
            const unsigned og = xb_add(&bar[XB_TOP], 1u);
            const unsigned tg = og / nx;
            if (og + 1u == (tg + 1u) * nx) xb_add(&bar[XB_TOPGEN], 1u);
            else XB_SPIN(xb_ld(&bar[XB_TOPGEN]) == tg, bar);
            __builtin_amdgcn_fence(__ATOMIC_ACQUIRE, "agent");
            xb_add(&bar[XB_XGEN(b.x)], 1u);
            asm volatile("s_waitcnt vmcnt(0)" ::: "memory");
        } else {
            XB_SPIN(xb_ld(&bar[XB_XGEN(b.x)]) == gen, bar);
            __builtin_amdgcn_fence(__ATOMIC_ACQUIRE, "agent");
            asm volatile("s_waitcnt vmcnt(0)" ::: "memory");
        }
    }
    __syncthreads();
}

constexpr int NWAVES = 8;
constexpr int RING_OFF = 0, RING_BYTES = 131072;
constexpr int LDSCTL_OFF = RING_BYTES, MISC_OFF = LDSCTL_OFF + 320;
constexpr int LDS_BYTES = 147456;
static_assert(attn128::SHM_TOTAL <= (size_t)RING_BYTES, "attention scratch fits the ring");

struct Args { const float* in[32]; float* out; unsigned char* ws; int ph_lo, ph_hi; };
constexpr int INTAB_OFF = LDSCTL_OFF + 1024;
__device__ __forceinline__ const float* inptr(LAS unsigned char* lds, int i) {
    const unsigned long long v = ((const LAS unsigned long long*)(lds + INTAB_OFF))[i];
    const unsigned lo = __builtin_amdgcn_readfirstlane((unsigned)v), hi = __builtin_amdgcn_readfirstlane((unsigned)(v >> 32));
    return (const float*)(GAS const float*)(((unsigned long long)hi << 32) | lo);
}
#define INP(i) inptr(F.lds, (i))
struct Frame {
    LAS unsigned char* lds; int tid, lane, wave, vcu, G, gw, NGW;
    unsigned char* ws;
};
enum { I_X = 0, I_C, I_CTX, I_CCTX, I_WMOD, I_BMOD, I_LNG, I_LNB, I_W1, I_W3, I_W2, I_WIN, I_ALAM, I_ASUB, I_CONVW, I_CONVB, I_ALOG, I_DTB, I_SSDD, I_SSDN,
       I_LRE, I_LIM, I_LSTEP, I_BRE, I_BIM, I_CRE, I_CIM, I_S5D, I_GLUW, I_GLUB, I_WBR, I_WOUT };

__device__ __forceinline__ void transpose_item64(const float* srcA, const float* srcB, int ldn, bool ffn, bf16_t* dst, int ldk, LAS bf16_t* scr  , int lane) {
    const int q = lane & 15, kr = lane >> 4; const bool isB = q >= 8; const int c = (q & 7) * 4; const float* src = isB ? srcB : srcA;
    f32x4 v[16];
#pragma unroll
    for (int i = 0; i < 16; ++i) v[i] = src ? *(const f32x4*)(src + (size_t)(4 * i + kr) * ldn + c) : (f32x4){0.f, 0.f, 0.f, 0.f};
    const int drow = ffn ? (32 * (c >> 4) + (c & 15) + (isB ? 16 : 0)) : (c + (isB ? 32 : 0));
#pragma unroll
    for (int i = 0; i < 16; ++i) { const int k = 4 * i + kr; const unsigned p01 = cvt_pk_bf16(v[i][0], v[i][1]), p23 = cvt_pk_bf16(v[i][2], v[i][3]);
        scr[(drow + 0) * 72 + k] = (bf16_t)(p01 & 0xffffu); scr[(drow + 1) * 72 + k] = (bf16_t)(p01 >> 16); scr[(drow + 2) * 72 + k] = (bf16_t)(p23 & 0xffffu); scr[(drow + 3) * 72 + k] = (bf16_t)(p23 >> 16); }
    LDS_WAIT(); asm volatile("" ::: "memory");
    const int c8 = lane & 7;
#pragma unroll
    for (int jj = 0; jj < 8; ++jj) { const int n = (lane >> 3) + 8 * jj; *(u32x4*)(dst + (size_t)n * ldk + 8 * c8) = *(const LAS u32x4*)(scr + n * 72 + 8 * c8); }
    LDS_WAIT(); asm volatile("" ::: "memory");
}
__device__ __forceinline__ void convert_layer_weights(const Args& A_, Frame& F, int l) {
    LAS bf16_t* scr = (LAS bf16_t*)(F.lds + RING_OFF + F.wave * 16384);
    unsigned char* W = F.ws + WS_W;
    constexpr int I13 = 32 * 176, I2 = 88 * 32, IIN = 32 * 212, IB = 16 * 32, IO = 32 * 32, IG = 16 * 16;
    constexpr int NIT = 2 * I13 + 2 * I2 + IIN + 3 * IB + IO + IG;
    for (int it = F.gw; it < NIT; it += F.NGW) {
        int r = it;
        if (r < 2 * I13) { const int f = r / I13; r -= f * I13; const int kb = r / 176, nb = r % 176;
            const float* w1 = INP(I_W1) + ((size_t)(l * 2 + f) * D + 64 * kb) * DFF + 32 * nb; const float* w3 = INP(I_W3) + ((size_t)(l * 2 + f) * D + 64 * kb) * DFF + 32 * nb;
            transpose_item64(w1, w3, DFF, true, (bf16_t*)(W + W_13) + ((size_t)f * N13 + 64 * nb) * D + 64 * kb, D, scr, F.lane); continue; }
        r -= 2 * I13;
        if (r < 2 * I2) { const int f = r / I2; r -= f * I2; const int kb = r / 32, nb = r % 32;
            const float* w2 = INP(I_W2) + ((size_t)(l * 2 + f) * DFF + 64 * kb) * D + 64 * nb;
            transpose_item64(w2, w2 + 32, D, false, (bf16_t*)(W + W_2) + ((size_t)f * D + 64 * nb) * DFF + 64 * kb, DFF, scr, F.lane); continue; }
        r -= 2 * I2;
        if (r < IIN) { const int kb = r / 212, nb = r % 212; const int n0 = 64 * nb; const float* wb = INP(I_WIN) + ((size_t)l * D + 64 * kb) * 13344;
            const float* sa = nullptr; const float* sb = nullptr;
            if (n0 < 6144) { sa = wb + n0; sb = sa + 32; } else if (n0 < 13312) { sa = wb + n0 + 32; sb = sa + 32; } else if (n0 == 13312) { sa = wb + 6144; }
            transpose_item64(sa, sb, 13344, false, (bf16_t*)(W + W_IN) + (size_t)n0 * D + 64 * kb, D, scr, F.lane); continue; }
        r -= IIN;
        if (r < 3 * IB) { const int jb = r / IB; r -= jb * IB; const int kb = r / 32, nb = r % 32;
            const float* w = INP(I_WBR) + ((size_t)(l * 3 + jb) * 1024 + 64 * kb) * D + 64 * nb;
            const int sp = (jb == 0) ? 0 : (jb == 1 ? 2 : 1); transpose_item64(w, w + 32, D, false, (bf16_t*)(W + W_B) + (size_t)(64 * nb) * 3072 + sp * 1024 + 64 * kb, 3072, scr, F.lane); continue; }
        r -= 3 * IB;
        if (r < IO) { const int kb = r / 32, nb = r % 32; const float* w = INP(I_WOUT) + ((size_t)l * D + 64 * kb) * D + 64 * nb;
            transpose_item64(w, w + 32, D, false, (bf16_t*)(W + W_O) + (size_t)(64 * nb) * D + 64 * kb, D, scr, F.lane); continue; }
        r -= IO;
        { const int kb = r / 16, nb = r % 16; const float* w = INP(I_GLUW) + ((size_t)l * 1024 + 64 * kb) * 1024 + 64 * nb;
            transpose_item64(w, w + 32, 1024, false, (bf16_t*)(W + W_GLU) + (size_t)(64 * nb) * 1024 + 64 * kb, 1024, scr, F.lane); }
    }
}
__device__ __forceinline__ void mod_partials(const Args& A_, Frame& F) {
    float* MODw = (float*)(F.ws + WS_MOD);
    LAS float* sl = (LAS float*)(F.lds + RING_OFF + 98304 + F.wave * 4096);
    for (int it = F.gw; it < 2 * 72 * 16; it += F.NGW) {
        const int l = it / (72 * 16), r = it % (72 * 16), ks = r / 72, cg = r % 72;
        const int col = cg * 256 + F.lane * 4; const float* w = INP(I_WMOD) + ((size_t)l * D + ks * 128) * NMOD + col;
        const float* c = INP(I_C) + ks * 128; const float* cc = INP(I_CCTX) + ks * 128;
#pragma unroll
        for (int h = 0; h < 2; ++h) { const int k = F.lane + 64 * h;
            sl[0 * 128 + k] = siluf_(c[k]); sl[1 * 128 + k] = siluf_(c[D + k]); sl[2 * 128 + k] = siluf_(c[2 * D + k]); sl[3 * 128 + k] = siluf_(c[3 * D + k]); sl[4 * 128 + k] = siluf_(cc[k]); }
        LDS_WAIT(); asm volatile("" ::: "memory");
        f32x4 a0 = {0.f, 0.f, 0.f, 0.f}, a1 = a0, a2 = a0, a3 = a0, a4 = a0;
        for (int k0 = 0; k0 < 128; k0 += 16) {
            f32x4 wv[16];
#pragma unroll
            for (int e = 0; e < 16; ++e) wv[e] = *(const f32x4*)(w + (size_t)(k0 + e) * NMOD);
            asm volatile("s_waitcnt vmcnt(0)" ::: "memory");
#pragma unroll
            for (int e = 0; e < 16; ++e) { a0 += wv[e] * sl[0 * 128 + k0 + e]; a1 += wv[e] * sl[1 * 128 + k0 + e]; a2 += wv[e] * sl[2 * 128 + k0 + e]; a3 += wv[e] * sl[3 * 128 + k0 + e]; a4 += wv[e] * sl[4 * 128 + k0 + e]; }
        }
        const int r9 = col / D; const float sc = (r9 == 2 || r9 == 8) ? 0.5f : 1.0f;
        if (ks == 0) { const f32x4 bv = *(const f32x4*)(INP(I_BMOD) + (size_t)l * NMOD + col); a0 += bv; a1 += bv; a2 += bv; a3 += bv; a4 += bv; }
        float* o = MODw + (size_t)l * 5 * NMOD + col;
#pragma unroll
        for (int e = 0; e < 4; ++e) { unsafeAtomicAdd(o + e, a0[e] * sc); unsafeAtomicAdd(o + NMOD + e, a1[e] * sc); unsafeAtomicAdd(o + 2 * NMOD + e, a2[e] * sc); unsafeAtomicAdd(o + 3 * NMOD + e, a3[e] * sc); unsafeAtomicAdd(o + 4 * NMOD + e, a4[e] * sc); }
        LDS_WAIT(); asm volatile("" ::: "memory");
    }
}
__device__ __forceinline__ void ln_pass(Frame& F, bool do_ln, const float* lng, const float* lnb, const float* modnext  , float* out, const float* xin = nullptr, const float* cin = nullptr) {
    _Float16* H = (_Float16*)(F.ws + WS_H); float* HC = (float*)(F.ws + WS_HC); bf16_t* HM = (bf16_t*)(F.ws + WS_HM); float* ST = (float*)(F.ws + WS_STATS);
    f32x4 G[8], Bv[8];
    if (do_ln) {
#pragma unroll
        for (int i = 0; i < 8; ++i) { G[i] = *(const f32x4*)(lng + 256 * i + 4 * F.lane); Bv[i] = *(const f32x4*)(lnb + 256 * i + 4 * F.lane); }
    }
    for (int row = F.gw; row < R; row += F.NGW) {
        const int b = row / RB, rr = row % RB; const bool isctx = rr < CTX; const int mi = isctx ? 4 : b;
        float* hc = HC + ((size_t)b * CTX + rr) * D; _Float16* hr = H + (size_t)row * D;
        f32x4 v[8], sh4[8], sc4[8]; float s = 0.f;
        if (xin) { const float* src = isctx ? cin + ((size_t)b * CTX + rr) * D : xin + ((size_t)b * SEQ + (rr - CTX)) * D;
#pragma unroll
            for (int i = 0; i < 8; ++i) v[i] = *(const f32x4*)(src + 256 * i + 4 * F.lane);
        } else if (isctx) {
#pragma unroll
            for (int i = 0; i < 8; ++i) v[i] = *(const f32x4*)(hc + 256 * i + 4 * F.lane);
        } else {
#pragma unroll
            for (int i = 0; i < 8; ++i) v[i] = ld_h4(hr + 256 * i + 4 * F.lane);
        }
        if (modnext) { const float* sh = modnext + (size_t)mi * NMOD; const float* sc = sh + D;
#pragma unroll
            for (int i = 0; i < 8; ++i) { sh4[i] = *(const f32x4*)(sh + 256 * i + 4 * F.lane); sc4[i] = *(const f32x4*)(sc + 256 * i + 4 * F.lane); } }
        asm volatile("s_waitcnt vmcnt(0)" ::: "memory");
#pragma unroll
        for (int i = 0; i < 8; ++i) s += (v[i][0] + v[i][1]) + (v[i][2] + v[i][3]);
        if (do_ln) {
            const float mean = wave_sum(s, F.lane) * (1.f / D); float s2 = 0.f;
#pragma unroll
            for (int i = 0; i < 8; ++i) { v[i] = v[i] - mean; s2 += (v[i][0] * v[i][0] + v[i][1] * v[i][1]) + (v[i][2] * v[i][2] + v[i][3] * v[i][3]); }
            const float rstd = 1.0f / sqrtf(wave_sum(s2, F.lane) * (1.f / D) + LN_EPS);
            if (!isctx && F.lane == 0) *(f32x2*)(ST + (size_t)row * 2) = (f32x2){mean, rstd};
#pragma unroll
            for (int i = 0; i < 8; ++i) { v[i] = v[i] * rstd * G[i] + Bv[i]; if (isctx) *(f32x4*)(hc + 256 * i + 4 * F.lane) = v[i] * DN_ALPHA; }
        } else if (isctx) {
#pragma unroll
            for (int i = 0; i < 8; ++i) *(f32x4*)(hc + 256 * i + 4 * F.lane) = v[i] * DN_ALPHA;
        } else {
#pragma unroll
            for (int i = 0; i < 8; ++i) st_h4(hr + 256 * i + 4 * F.lane, v[i]);
            if (F.lane == 0) *(f32x2*)(ST + (size_t)row * 2) = (f32x2){0.f, 1.f};
        }
        if (modnext) {
#pragma unroll
            for (int i = 0; i < 8; ++i) { const f32x4 m = v[i] * (sc4[i] + 1.0f) + sh4[i];
                u32x2 w; w.x = cvt_pk_bf16(m[0], m[1]); w.y = cvt_pk_bf16(m[2], m[3]); *(u32x2*)(HM + (size_t)row * D + 256 * i + 4 * F.lane) = w; }
        }
        if (out && !isctx) { float* orow = out + ((size_t)b * SEQ + (rr - CTX)) * D;
#pragma unroll
            for (int i = 0; i < 8; ++i) *(f32x4*)(orow + 256 * i + 4 * F.lane) = v[i]; }
    }
}

__device__ __forceinline__ void dt_tile(Frame& F, int l, int tile) {
    const bf16_t* A = (const bf16_t*)(F.ws + WS_HM) + (size_t)tile * 32 * D; const bf16_t* Bt = (const bf16_t*)(F.ws + WS_W + W_IN) + (size_t)13312 * D; float* DT = (float*)(F.ws + WS_DT);
    const int r = F.lane & 31, h = F.lane >> 5;
    f32x16 acc;
#pragma unroll
    for (int i = 0; i < 16; ++i) acc[i] = 0.f;
    const bf16_t* ap = A + (size_t)r * D + 8 * h; const bf16_t* bp = Bt + (size_t)r * D + 8 * h;
    for (int k0 = 0; k0 < 128; k0 += 16) {
        bf16x8 af[16], bfv[16];
#pragma unroll
        for (int e = 0; e < 16; ++e) { af[e] = *(const bf16x8*)(ap + 16 * (k0 + e)); bfv[e] = *(const bf16x8*)(bp + 16 * (k0 + e)); }
#pragma unroll
        for (int e = 0; e < 16; ++e) acc = __builtin_amdgcn_mfma_f32_32x32x16_bf16(af[e], bfv[e], acc, 0, 0, 0);
    }
    const float bias = INP(I_DTB)[l * 32 + r];
#pragma unroll
    for (int rg = 0; rg < 16; ++rg) { const int row = tile * 32 + (rg & 3) + 8 * (rg >> 2) + 4 * h; const float x = acc[rg] + bias; DT[(size_t)row * 32 + r] = fmaxf(x, 0.f) + log1pf(expf(-fabsf(x))); }
}
__device__ __forceinline__ void ssd_conv_pass(const Args& A_, Frame& F, int l) {
    const bf16_t* P = (const bf16_t*)(F.ws + WS_PROJ); bf16_t* XC = (bf16_t*)(F.ws + WS_HM);
    const float* cw = INP(I_CONVW) + (size_t)l * 5 * 2048; const float* cb = INP(I_CONVB) + (size_t)l * 2048;
    for (int it = F.gw; it < (R / 8) * 4; it += F.NGW) {
        const int r0 = (it >> 2) * 8, c0 = (it & 3) * 512 + F.lane * 8; const int rr0 = r0 % RB; const int lo = (rr0 < CTX) ? 0 : CTX, hi = (rr0 < CTX) ? CTX : RB;
        u32x4 x[12];
#pragma unroll
        for (int h = 0; h < 12; ++h) { const int r2 = rr0 + h - 2; x[h] = (r2 >= lo && r2 < hi) ? *(const u32x4*)(P + (size_t)(r0 + h - 2) * LDP + PX + c0) : (u32x4){0u, 0u, 0u, 0u}; }
        f32x4 w0[5], w1[5];
#pragma unroll
        for (int k = 0; k < 5; ++k) { w0[k] = *(const f32x4*)(cw + k * 2048 + c0); w1[k] = *(const f32x4*)(cw + k * 2048 + c0 + 4); }
        const f32x4 b0 = *(const f32x4*)(cb + c0), b1 = *(const f32x4*)(cb + c0 + 4);
#pragma unroll
        for (int jr = 0; jr < 8; ++jr) { f32x4 a0 = b0, a1 = b1;
#pragma unroll
            for (int k = 0; k < 5; ++k) { const u32x4 xv = x[jr + k];
                a0[0] += w0[k][0] * bflo(xv.x); a0[1] += w0[k][1] * bfhi(xv.x); a0[2] += w0[k][2] * bflo(xv.y); a0[3] += w0[k][3] * bfhi(xv.y);
                a1[0] += w1[k][0] * bflo(xv.z); a1[1] += w1[k][1] * bfhi(xv.z); a1[2] += w1[k][2] * bflo(xv.w); a1[3] += w1[k][3] * bfhi(xv.w); }
            u32x4 o; o.x = cvt_pk_bf16(siluf_(a0[0]), siluf_(a0[1])); o.y = cvt_pk_bf16(siluf_(a0[2]), siluf_(a0[3])); o.z = cvt_pk_bf16(siluf_(a1[0]), siluf_(a1[1])); o.w = cvt_pk_bf16(siluf_(a1[2]), siluf_(a1[3]));
            *(u32x4*)(XC + (size_t)(r0 + jr) * 2048 + c0) = o; }
    }
}
__device__ __forceinline__ int scan_row(int rb, int d, int step) { return d == 0 ? rb + step : (step < CTX ? rb + CTX - 1 - step : rb + (RB + CTX - 1) - step); }

__device__ __forceinline__ unsigned short bf16_1(float v) { return (unsigned short)(cvt_pk_bf16(v, 0.f) & 0xffffu); }
__device__ __forceinline__ void ssd_chain_fast(const Args& A_, Frame& F, int l, int cid) {
    constexpr int LS = 136;
    const int b = cid >> 6, d = (cid >> 5) & 1, hd = (cid >> 1) & 15, ph = cid & 1, g = hd >> 2; const int rb = b * RB;
    const bf16_t* XC = (const bf16_t*)(F.ws + WS_HM); const float* DT = (const float*)(F.ws + WS_DT); bf16_t* YD = (bf16_t*)(F.ws + WS_YD) + (size_t)d * R * 1024;
    const float a = -expf(INP(I_ALOG)[l * 32 + d * 16 + hd]);
    LAS bf16_t* Cs = (LAS bf16_t*)(F.lds); LAS bf16_t* Bs = Cs + 128 * LS; LAS bf16_t* Ms = Bs + 128 * LS; LAS bf16_t* XdT = Ms + 128 * LS; LAS bf16_t* Hb = XdT + 32 * LS;
    LAS float* csL = (LAS float*)(Hb + 32 * LS); LAS float* ecsL = csL + 128; LAS float* ewL = ecsL + 128; LAS float* misc = ewL + 128;
    const int tid = F.tid, lane = F.lane, w = F.wave, r = lane & 31, h = lane >> 5;
    f32x16 hacc;
#pragma unroll
    for (int i = 0; i < 16; ++i) hacc[i] = 0.f;
    for (int i = tid; i < 32 * LS / 2; i += 512) ((LAS unsigned*)Hb)[i] = 0u;
    u32x4 pc[4], pb[4], px; float pdt, pv0 = 0.f, pv1 = 0.f;
    const int rho0 = d ? 127 - lane : lane, rho1 = d ? 63 - lane : 64 + lane;
#define SSD_R0(k_) ((d == 0) ? rb + 128 * (k_) : ((k_) < 2 ? rb + 128 * (1 - (k_)) : rb + 256 + 128 * (33 - (k_))))
#define SSD_ISSUE(k_) do { const int r0n = SSD_R0(k_); \
        _Pragma("unroll") for (int i = 0; i < 4; ++i) { const int item = tid + 512 * i, row = item >> 4, seg = item & 15; const bf16_t* src = XC + (size_t)(r0n + row) * 2048 + g * 128 + seg * 8; pc[i] = *(const u32x4*)(src + 1536); pb[i] = *(const u32x4*)(src + 1024); } \
        { const int row = tid >> 2, seg = tid & 3; pdt = DT[(size_t)(r0n + row) * 32 + d * 16 + hd]; px = *(const u32x4*)(XC + (size_t)(r0n + row) * 2048 + hd * 64 + ph * 32 + seg * 8); } \
        if (w == 0) { pv0 = DT[(size_t)(r0n + rho0) * 32 + d * 16 + hd]; pv1 = DT[(size_t)(r0n + rho1) * 32 + d * 16 + hd]; } } while (0)
    SSD_ISSUE(0);
    for (int k = 0; k < 34; ++k) {
        const int r0 = SSD_R0(k);
        __syncthreads();
#pragma unroll
        for (int i = 0; i < 4; ++i) { const int item = tid + 512 * i, row = item >> 4, seg = item & 15; *(LAS u32x4*)(Cs + row * LS + seg * 8) = pc[i]; *(LAS u32x4*)(Bs + row * LS + seg * 8) = pb[i]; }
        { const int row = tid >> 2, seg = tid & 3; const float dtv = pdt; const u32x4 xv = px;
            LAS bf16_t* xo = XdT + (seg * 8) * LS + row;
            xo[0 * LS] = bf16_1(bflo(xv.x) * dtv); xo[1 * LS] = bf16_1(bfhi(xv.x) * dtv); xo[2 * LS] = bf16_1(bflo(xv.y) * dtv); xo[3 * LS] = bf16_1(bfhi(xv.y) * dtv);
            xo[4 * LS] = bf16_1(bflo(xv.z) * dtv); xo[5 * LS] = bf16_1(bfhi(xv.z) * dtv); xo[6 * LS] = bf16_1(bflo(xv.w) * dtv); xo[7 * LS] = bf16_1(bfhi(xv.w) * dtv); }
        if (w == 0) {
            float v0 = pv0 * a, v1 = pv1 * a;
#pragma unroll
            for (int o = 1; o < 64; o <<= 1) { const float t0 = __int_as_float(__builtin_amdgcn_ds_bpermute((lane - o) << 2, __float_as_int(v0))), t1 = __int_as_float(__builtin_amdgcn_ds_bpermute((lane - o) << 2, __float_as_int(v1))); if (lane >= o) { v0 += t0; v1 += t1; } }
            const float tot0 = __int_as_float(__builtin_amdgcn_ds_bpermute(63 << 2, __float_as_int(v0))); v1 += tot0;
            const float cend = __int_as_float(__builtin_amdgcn_ds_bpermute(63 << 2, __float_as_int(v1)));
            csL[rho0] = v0; csL[rho1] = v1; ecsL[rho0] = __builtin_amdgcn_exp2f(v0 * 1.4426950408889634f); ecsL[rho1] = __builtin_amdgcn_exp2f(v1 * 1.4426950408889634f);
            ewL[rho0] = __builtin_amdgcn_exp2f((cend - v0) * 1.4426950408889634f); ewL[rho1] = __builtin_amdgcn_exp2f((cend - v1) * 1.4426950408889634f);
            if (lane == 0) misc[0] = __builtin_amdgcn_exp2f(cend * 1.4426950408889634f);
        }
        if (k + 1 < 34) SSD_ISSUE(k + 1);
        __syncthreads();
        { const int lt = w >> 1;
#pragma unroll
          for (int q = 0; q < 2; ++q) { const int st = (w & 1) * 2 + q; const bool zero = (d == 0) ? (st > lt) : (st < lt);
            f32x16 acc;
#pragma unroll
            for (int i = 0; i < 16; ++i) acc[i] = 0.f;
            if (!zero) {
#pragma unroll
                for (int ks = 0; ks < 8; ++ks) { const bf16x8 af = *(const LAS bf16x8*)(Cs + (32 * lt + r) * LS + 16 * ks + 8 * h), bfv = *(const LAS bf16x8*)(Bs + (32 * st + r) * LS + 16 * ks + 8 * h);
                    acc = __builtin_amdgcn_mfma_f32_32x32x16_bf16(af, bfv, acc, 0, 0, 0); } }
            const int scol = 32 * st + r; const float css = csL[scol];
#pragma unroll
            for (int rg = 0; rg < 16; ++rg) { const int lrow = 32 * lt + (rg & 3) + 8 * (rg >> 2) + 4 * h; const bool valid = (d == 0) ? (scol <= lrow) : (scol >= lrow);
                const float v = valid ? acc[rg] * __builtin_amdgcn_exp2f((csL[lrow] - css) * 1.4426950408889634f) : 0.f; Ms[lrow * LS + scol] = bf16_1(v); } } }
        __syncthreads();
        if (w < 4) { const int lt = w;
            f32x16 acc;
#pragma unroll
            for (int i = 0; i < 16; ++i) acc[i] = 0.f;
#pragma unroll
            for (int ks = 0; ks < 8; ++ks) { const bf16x8 af = *(const LAS bf16x8*)(Cs + (32 * lt + r) * LS + 16 * ks + 8 * h), bfv = *(const LAS bf16x8*)(Hb + r * LS + 16 * ks + 8 * h);
                acc = __builtin_amdgcn_mfma_f32_32x32x16_bf16(af, bfv, acc, 0, 0, 0); }
#pragma unroll
            for (int rg = 0; rg < 16; ++rg) acc[rg] *= ecsL[32 * lt + (rg & 3) + 8 * (rg >> 2) + 4 * h];
#pragma unroll
            for (int ks = 0; ks < 8; ++ks) { const bool skip = (d == 0) ? (16 * ks >= 32 * (lt + 1)) : (16 * ks + 15 < 32 * lt);
                if (!skip) { const bf16x8 af = *(const LAS bf16x8*)(Ms + (32 * lt + r) * LS + 16 * ks + 8 * h), bfv = *(const LAS bf16x8*)(XdT + r * LS + 16 * ks + 8 * h);
                    acc = __builtin_amdgcn_mfma_f32_32x32x16_bf16(af, bfv, acc, 0, 0, 0); } }
            bf16_t* yo = YD + (size_t)(r0 + 32 * lt + 4 * h) * 1024 + hd * 64 + ph * 32 + r;
#pragma unroll
            for (int rg = 0; rg < 16; ++rg) yo[(size_t)((rg & 3) + 8 * (rg >> 2)) * 1024] = bf16_1(acc[rg]);
        } else { const int nt = w - 4; const float eend = misc[0];
#pragma unroll
            for (int i = 0; i < 16; ++i) hacc[i] *= eend;
#pragma unroll
            for (int ks = 0; ks < 8; ++ks) { const int k0 = 16 * ks + 8 * h; const u32x4 xa = *(const LAS u32x4*)(XdT + r * LS + k0); const f32x4 e0 = *(const LAS f32x4*)(ewL + k0), e1 = *(const LAS f32x4*)(ewL + k0 + 4);
                u32x4 aw; aw.x = cvt_pk_bf16(bflo(xa.x) * e0[0], bfhi(xa.x) * e0[1]); aw.y = cvt_pk_bf16(bflo(xa.y) * e0[2], bfhi(xa.y) * e0[3]); aw.z = cvt_pk_bf16(bflo(xa.z) * e1[0], bfhi(xa.z) * e1[1]); aw.w = cvt_pk_bf16(bflo(xa.w) * e1[2], bfhi(xa.w) * e1[3]);
                const LAS bf16_t* bp = Bs + k0 * LS + 32 * nt + r; u32x4 bw;
                bw.x = (unsigned)bp[0 * LS] | ((unsigned)bp[1 * LS] << 16); bw.y = (unsigned)bp[2 * LS] | ((unsigned)bp[3 * LS] << 16); bw.z = (unsigned)bp[4 * LS] | ((unsigned)bp[5 * LS] << 16); bw.w = (unsigned)bp[6 * LS] | ((unsigned)bp[7 * LS] << 16);
                hacc = __builtin_amdgcn_mfma_f32_32x32x16_bf16(__builtin_bit_cast(bf16x8, aw), __builtin_bit_cast(bf16x8, bw), hacc, 0, 0, 0); }
        }
        __syncthreads();
        if (w >= 4) { const int nt = w - 4;
#pragma unroll
            for (int rg = 0; rg < 16; ++rg) Hb[((rg & 3) + 8 * (rg >> 2) + 4 * h) * LS + 32 * nt + r] = bf16_1(hacc[rg]); }
    }
    __syncthreads();
#undef SSD_R0
#undef SSD_ISSUE
}
__device__ __forceinline__ void s5_setup(const Args& A_, Frame& F, int l) {
    LAS float* Pre = (LAS float*)(F.lds); LAS float* Pim = Pre + 2 * 17 * 64; LAS float* BBr = Pim + 2 * 17 * 64; LAS float* BBi = BBr + 2 * 64 * 16; LAS float* Kt = BBi + 2 * 64 * 16;
    bf16_t* Bt1 = (bf16_t*)(F.ws + WS_S5M); bf16_t* Bt2 = Bt1 + (size_t)64 * 512 * 256; float* A16 = (float*)(F.ws + WS_S5A);
    const int tid = F.tid;
    for (int g = blockIdx.x; g < 64; g += F.G) {
        if (tid < 128) { const int d = tid >> 6, n = tid & 63; const int pg_ = (l * 2 + d) * 64 + g;
            const float lre = INP(I_LRE)[pg_ * 64 + n], lim = INP(I_LIM)[pg_ * 64 + n], step = expf(INP(I_LSTEP)[pg_]);
            for (int dl = 0; dl <= 16; ++dl) { const float mag = expf(lre * step * (float)dl), ang = lim * step * (float)dl; Pre[(d * 17 + dl) * 64 + n] = mag * cosf(ang); Pim[(d * 17 + dl) * 64 + n] = mag * sinf(ang); }
            const float abr = Pre[(d * 17 + 1) * 64 + n], abi = Pim[(d * 17 + 1) * 64 + n];
            const float den = lre * lre + lim * lim; const float kre = ((abr - 1.f) * lre + abi * lim) / den, kim = (abi * lre - (abr - 1.f) * lim) / den;
            const float* br = INP(I_BRE) + ((size_t)pg_ * 64 + n) * 16; const float* bi = INP(I_BIM) + ((size_t)pg_ * 64 + n) * 16;
            for (int i = 0; i < 16; ++i) { const float x = br[i], y = bi[i]; BBr[(d * 64 + n) * 16 + i] = kre * x - kim * y; BBi[(d * 64 + n) * 16 + i] = kre * y + kim * x; }
            A16[((d * 64 + g) * 64 + n) * 2] = Pre[(d * 17 + 16) * 64 + n]; A16[((d * 64 + g) * 64 + n) * 2 + 1] = Pim[(d * 17 + 16) * 64 + n]; }
        __syncthreads();
        for (int q = 0; q < 16; ++q) { const int idx = tid + 512 * q; const int d = idx >> 12, dl = (idx >> 8) & 15, o = (idx >> 4) & 15, i = idx & 15; const int pg_ = (l * 2 + d) * 64 + g;
            const float* cr = INP(I_CRE) + ((size_t)pg_ * 16 + o) * 64; const float* ci = INP(I_CIM) + ((size_t)pg_ * 16 + o) * 64; float acc = 0.f;
            for (int n = 0; n < 64; ++n) { const float pr = Pre[(d * 17 + dl) * 64 + n], pi = Pim[(d * 17 + dl) * 64 + n], br = BBr[(d * 64 + n) * 16 + i], bi = BBi[(d * 64 + n) * 16 + i];
                acc += cr[n] * (pr * br - pi * bi) - ci[n] * (pr * bi + pi * br); }
            Kt[idx] = acc; }
        __syncthreads();
        for (int q = 0; q < 16; ++q) { const int item = tid + 512 * q; const int c1 = item >> 5, kb = (item & 31) * 8; const int rin = kb >> 4, i0 = kb & 15, rout = c1 >> 4, o = c1 & 15;
            float v[8];
#pragma unroll
            for (int e = 0; e < 8; ++e) { const int i = i0 + e; float x = 0.f; if (rout >= rin) x += Kt[((0 * 16 + (rout - rin)) * 16 + o) * 16 + i]; if (rin >= rout) x += Kt[((1 * 16 + (rin - rout)) * 16 + o) * 16 + i];
                if (rin == rout && i == o) x += INP(I_S5D)[l * 1024 + 16 * g + i]; v[e] = x; }
            u32x4 w; w.x = cvt_pk_bf16(v[0], v[1]); w.y = cvt_pk_bf16(v[2], v[3]); w.z = cvt_pk_bf16(v[4], v[5]); w.w = cvt_pk_bf16(v[6], v[7]);
            *(u32x4*)(Bt1 + ((size_t)g * 512 + c1) * 256 + kb) = w; }
        for (int q = 0; q < 16; ++q) { const int item = tid + 512 * q; const int c1 = item >> 5, kb = (item & 31) * 8; const int rin = kb >> 4, i0 = kb & 15; const int d = c1 >> 7, part = c1 & 1, n = (c1 >> 1) & 63;
            const int ex = (d == 0) ? 15 - rin : rin; const float pr = Pre[(d * 17 + ex) * 64 + n], pi = Pim[(d * 17 + ex) * 64 + n];
            float v[8];
#pragma unroll
            for (int e = 0; e < 8; ++e) { const float br = BBr[(d * 64 + n) * 16 + i0 + e], bi = BBi[(d * 64 + n) * 16 + i0 + e]; v[e] = part ? (pr * bi + pi * br) : (pr * br - pi * bi); }
            u32x4 w; w.x = cvt_pk_bf16(v[0], v[1]); w.y = cvt_pk_bf16(v[2], v[3]); w.z = cvt_pk_bf16(v[4], v[5]); w.w = cvt_pk_bf16(v[6], v[7]);
            *(u32x4*)(Bt1 + ((size_t)g * 512 + 256 + c1) * 256 + kb) = w; }
        for (int q = 0; q < 16; ++q) { const int item = tid + 512 * q; const int c2 = item >> 5, kb = (item & 31) * 8; const int rout = c2 >> 4, o = c2 & 15; const int d = kb >> 7, part = (kb >> 6) & 1, n0 = kb & 63; const int pg_ = (l * 2 + d) * 64 + g;
            const int ex = (d == 0) ? rout + 1 : 16 - rout; const float* cr = INP(I_CRE) + ((size_t)pg_ * 16 + o) * 64 + n0; const float* ci = INP(I_CIM) + ((size_t)pg_ * 16 + o) * 64 + n0;
            float v[8];
#pragma unroll
            for (int e = 0; e < 8; ++e) { const float pr = Pre[(d * 17 + ex) * 64 + n0 + e], pi = Pim[(d * 17 + ex) * 64 + n0 + e]; v[e] = part ? -(cr[e] * pi + ci[e] * pr) : (cr[e] * pr - ci[e] * pi); }
            u32x4 w; w.x = cvt_pk_bf16(v[0], v[1]); w.y = cvt_pk_bf16(v[2], v[3]); w.z = cvt_pk_bf16(v[4], v[5]); w.w = cvt_pk_bf16(v[6], v[7]);
            *(u32x4*)(Bt2 + ((size_t)g * 256 + c2) * 256 + kb) = w; }
        __syncthreads();
    }
}
__device__ __forceinline__ void s5_carry(Frame& F, int cid) {
    const int b = cid >> 7, d = (cid >> 6) & 1, g = cid & 63, n = F.lane;
    const unsigned* ST = (const unsigned*)((const bf16_t*)(F.ws + WS_S5ST) + ((size_t)g * S5M + b * 272) * 256 + d * 128) + n;
    bf16_t* HP = (bf16_t*)(F.ws + WS_S5H) + ((size_t)g * 1280 + b * 272) * 256 + d * 128 + n;
    const float* A16 = (const float*)(F.ws + WS_S5A); const float ar = A16[((d * 64 + g) * 64 + n) * 2], ai = A16[((d * 64 + g) * 64 + n) * 2 + 1];
    float hr = 0.f, hi_ = 0.f;
    for (int k0 = 0; k0 < 272; k0 += 34) {
        unsigned wv[34];
#pragma unroll
        for (int e = 0; e < 34; ++e) { const int k = k0 + e; const int cc = (d == 0) ? k : (k < 16 ? 15 - k : 287 - k); wv[e] = ST[(size_t)cc * 128]; }
        asm volatile("s_waitcnt vmcnt(0)" ::: "memory");
#pragma unroll
        for (int e = 0; e < 34; ++e) { const int k = k0 + e; const int cc = (d == 0) ? k : (k < 16 ? 15 - k : 287 - k);
            HP[(size_t)cc * 256] = (bf16_t)(cvt_pk_bf16(hr, 0.f) & 0xffffu); HP[(size_t)cc * 256 + 64] = (bf16_t)(cvt_pk_bf16(hi_, 0.f) & 0xffffu);
            const float sr = bflo(wv[e]), si = bfhi(wv[e]); const float nr = ar * hr - ai * hi_ + sr, ni = ar * hi_ + ai * hr + si; hr = nr; hi_ = ni; }
    }
}
__device__ __forceinline__ void mixer_finalize(const Args& A_, Frame& F, int l) {
    bf16_t* P = (bf16_t*)(F.ws + WS_PROJ);
    const bf16_t* XC = (const bf16_t*)(F.ws + WS_HM); const bf16_t* YD0 = (const bf16_t*)(F.ws + WS_YD); const bf16_t* YD1 = YD0 + (size_t)R * 1024;
        const int c0 = F.lane * 16;
    for (int row = F.gw; row < R; row += F.NGW) {
        { const float dsk = INP(I_SSDD)[l * 16 + (c0 >> 6)];
          const float* nwp = INP(I_SSDN) + l * 1024 + c0;
          float v[16];
#pragma unroll
          for (int hh = 0; hh < 2; ++hh) { const u32x4 x = *(const u32x4*)(XC + (size_t)row * 2048 + c0 + 8 * hh), y0 = *(const u32x4*)(YD0 + (size_t)row * 1024 + c0 + 8 * hh), y1 = *(const u32x4*)(YD1 + (size_t)row * 1024 + c0 + 8 * hh), z = *(const u32x4*)(P + (size_t)row * LDP + PZ + c0 + 8 * hh);
#define SG(i, wx, wy0, wy1, wz) v[8 * hh + 2 * (i)] = (bflo(wx) * dsk + bflo(wy0) + bflo(wy1)) * bflo(wz); v[8 * hh + 2 * (i) + 1] = (bfhi(wx) * dsk + bfhi(wy0) + bfhi(wy1)) * bfhi(wz);
              SG(0, x.x, y0.x, y1.x, z.x) SG(1, x.y, y0.y, y1.y, z.y) SG(2, x.z, y0.z, y1.z, z.z) SG(3, x.w, y0.w, y1.w, z.w)
#undef SG
          }
          float ss = 0.f;
#pragma unroll
          for (int e = 0; e < 16; ++e) ss += v[e] * v[e];
          ss += shx(ss, 1, F.lane); ss += shx(ss, 2, F.lane); ss += shx(ss, 4, F.lane); ss += shx(ss, 8, F.lane);
          const float rs = 1.0f / sqrtf(ss * (1.f / 256.f) + RMS_EPS);
          const f32x4 n0 = *(const f32x4*)(nwp), n1 = *(const f32x4*)(nwp + 4), n2 = *(const f32x4*)(nwp + 8), n3 = *(const f32x4*)(nwp + 12);
          const float nw[16] = {n0[0], n0[1], n0[2], n0[3], n1[0], n1[1], n1[2], n1[3], n2[0], n2[1], n2[2], n2[3], n3[0], n3[1], n3[2], n3[3]};
          u32x4 o0, o1;
          o0.x = cvt_pk_bf16(v[0] * rs * nw[0], v[1] * rs * nw[1]); o0.y = cvt_pk_bf16(v[2] * rs * nw[2], v[3] * rs * nw[3]); o0.z = cvt_pk_bf16(v[4] * rs * nw[4], v[5] * rs * nw[5]); o0.w = cvt_pk_bf16(v[6] * rs * nw[6], v[7] * rs * nw[7]);
          o1.x = cvt_pk_bf16(v[8] * rs * nw[8], v[9] * rs * nw[9]); o1.y = cvt_pk_bf16(v[10] * rs * nw[10], v[11] * rs * nw[11]); o1.z = cvt_pk_bf16(v[12] * rs * nw[12], v[13] * rs * nw[13]); o1.w = cvt_pk_bf16(v[14] * rs * nw[14], v[15] * rs * nw[15]);
          *(u32x4*)(P + (size_t)row * LDP + PV + c0) = o0; *(u32x4*)(P + (size_t)row * LDP + PV + c0 + 8) = o1; }
    }
}


__global__ void __launch_bounds__(NWAVES * 64, 2) trunk_fwd(Args args) {
    extern __shared__ __attribute__((aligned(16))) unsigned char lds_raw[];
    Frame F;
    F.lds = (LAS unsigned char*)lds_raw;
    F.tid = threadIdx.x; F.lane = F.tid & 63; F.wave = __builtin_amdgcn_readfirstlane(F.tid >> 6);
    F.G = gridDim.x; { const int bx = blockIdx.x; F.vcu = (F.G % 8 == 0) ? (bx % 8) * (F.G / 8) + bx / 8 : bx; }
    F.gw = F.vcu * NWAVES + F.wave; F.NGW = F.G * NWAVES;
    F.ws = args.ws;
    volatile LAS unsigned* MISC = (volatile LAS unsigned*)(F.lds + MISC_OFF);
    for (int u = F.tid; u < (LDS_BYTES - LDSCTL_OFF) / 4; u += NWAVES * 64) ((LAS unsigned*)(F.lds + LDSCTL_OFF))[u] = 0u;
    __syncthreads();
    if (threadIdx.x < 32) ((LAS unsigned long long*)(F.lds + INTAB_OFF))[threadIdx.x] = (unsigned long long)args.in[threadIdx.x];
    __syncthreads();
    (void)xcd_barrier_post((unsigned*)(args.ws + WS_CTL) + CW_BAR, MISC + 8);
    const int lo = args.ph_lo, hi = args.ph_hi;
    const int wave0 = __builtin_amdgcn_readfirstlane((int)threadIdx.x >> 6);
    int pid = 0;
#define PH_BEGIN if (pid >= lo && pid < hi) { GAS unsigned char* wsg_ = (GAS unsigned char*)args.ws; int tid_; asm volatile("v_mbcnt_lo_u32_b32 %1, -1, 0\n\tv_mbcnt_hi_u32_b32 %1, -1, %1 ; PHASE_MARK_BEGIN %2" : "+s"(wsg_), "=v"(tid_) : "i"(__LINE__) : "memory"); tid_ += wave0 * 64; unsigned char* ws = (unsigned char*)wsg_; F.ws = ws; F.tid = tid_; F.lane = tid_ & 63; F.wave = __builtin_amdgcn_readfirstlane(tid_ >> 6); F.gw = F.vcu * NWAVES + F.wave;
#define PH_END   asm volatile("; PHASE_MARK_END %0" :: "i"(__LINE__)); if (pid + 1 < hi) { XcdBarrier bar_; bar_.bar = (unsigned*)(args.ws + WS_CTL) + CW_BAR; bar_.x = xb_xcc_id(); bar_.st = (volatile LAS unsigned*)(F.lds + MISC_OFF) + 8; xcd_barrier(bar_, wave0 * 64 + lane_now()); } } ++pid;

#define MOD ((float*)(ws + WS_MOD))
#define Hbuf ((float*)(ws + WS_H))
#define HM ((bf16_t*)(ws + WS_HM))
#define PROJ ((bf16_t*)(ws + WS_PROJ))
#define ROPEC ((float*)(ws + WS_ROPE))
#define ROPES (ROPEC + 1024)
#define WGT (ws + WS_W)

    PH_BEGIN
        s5_setup(args, F, 0);
        mod_partials(args, F);
        if (F.gw == 1) { float* idn = (float*)(ws + WS_IDENT); for (int i = F.lane; i < 2048; i += 64) { idn[i] = 1.0f; idn[2048 + i] = 0.0f; } }
        if (F.gw == 0) {
#pragma unroll
            for (int i = 0; i < 16; ++i) { const int idx = i * 64 + F.lane, pos = idx >> 4, f = idx & 15; const float inv = powf(10000.0f, -(float)f / 16.0f); const float ang = (float)pos * inv; ROPEC[idx] = cosf(ang); ROPES[idx] = sinf(ang); } }
    PH_END
    PH_BEGIN
        convert_layer_weights(args, F, 0);
        ln_pass(F, false, nullptr, nullptr, MOD, nullptr, INP(I_X), INP(I_CTX));
    PH_END

    for (int s = 0; s < 6; ++s) {
        const int l = s / 3, j = s - 3 * l;
        if (j != 1) {
            const int f = j >> 1;
            PH_BEGIN
                const int lat = (l == 1 && j == 2); pg8::Gemm g{D, D, D}; pg8::StaticOrder S; S.init(lat ? 64 : NPAN, N13 / 256, F.G, (int)blockIdx.x, HM, D, (const bf16_t*)(WGT + W_13) + (size_t)f * N13 * D, D, D, lat);
                EpiSwiGLU E{PROJ};
                pg8::gemm_phase<EpiSwiGLU, pg8::StaticOrder>(F.lds + RING_OFF, g, S, E, F.tid);
            PH_END
        } else {
            PH_BEGIN
                pg8::Gemm g{D, D, D}; pg8::StaticOrder S; S.init(NPAN, LDP / 256, F.G, (int)blockIdx.x, HM, D, (const bf16_t*)(WGT + W_IN), D, D);
                EpiProj E{PROJ, (float*)(ws + WS_DT), ROPEC, ROPES, (bf16_t*)(ws + WS_O)};
                pg8::gemm_phase<EpiProj, pg8::StaticOrder>(F.lds + RING_OFF, g, S, E, F.tid);
                { const int nfull = (NPAN * (LDP / 256)) % F.G;
                  if ((int)blockIdx.x >= nfull) { const int nw = (F.G - nfull) * NWAVES; for (int t = ((int)blockIdx.x - nfull) * NWAVES + F.wave; t < R / 32; t += nw) dt_tile(F, l, t); } }
            PH_END
            PH_BEGIN
                ssd_conv_pass(args, F, l);
                { pg8::Gemm g{256, 256, 256}; S5AOrder S{F.G, (int)blockIdx.x, (const char*)(ws + WS_O), (const char*)(ws + WS_S5M)};
                  EpiS5A E{(unsigned char*)(ws + WS_YS), (bf16_t*)(ws + WS_S5ST)};
                  pg8::gemm_phase<EpiS5A, S5AOrder>(F.lds + RING_OFF, g, S, E, F.tid); }
            PH_END
            PH_BEGIN
                if (F.wave < 2) s5_carry(F, (int)blockIdx.x * 2 + F.wave);
                ssd_chain_fast(args, F, l, (int)blockIdx.x);
                {
                    const float lam_init = 0.8f - 0.6f * expf(-0.3f * (float)l);
                    const float* lv = INP(I_ALAM) + l * 256;
                    const float s01 = wave_sum(lv[F.lane] * lv[64 + F.lane], F.lane), s23 = wave_sum(lv[128 + F.lane] * lv[192 + F.lane], F.lane);
                    const float lam = expf(s01) - expf(s23) + lam_init;
                    for (int i = 0;; ++i) { const int idx = i * F.G + F.vcu; if (idx >= 512 + (l == 0 ? 32 : 0)) break;
                        int b, h, q0, seq;
                        if (idx < 512) { b = idx >> 7; h = (idx >> 4) & 7; q0 = b * RB + CTX + (idx & 15) * 256; seq = RB; }
                        else { const int k = idx - 512; b = k >> 3; h = k & 7; q0 = b * RB; seq = CTX; }
                        const bf16_t* Q0 = PROJ + (size_t)q0 * LDP + PQ + h * 128; const bf16_t* Kh = PROJ + (size_t)(b * RB) * LDP + PK + h * 128; const bf16_t* Vh = PROJ + (size_t)(b * RB) * LDP + PV + h * 128;
                        attn128::unit((const attn128::bf16*)Q0, (const attn128::bf16*)Kh, (const attn128::bf16*)Vh, PROJ + (size_t)q0 * LDP + PQ + h * 128, seq, (char*)lds_raw + RING_OFF, F.tid, lam, 1.0f - lam_init, INP(I_ASUB) + l * 128);
                    }
                }
            PH_END
            PH_BEGIN
                mixer_finalize(args, F, l);
                { pg8::Gemm g{256, 256, 256}; S5COrder S{F.G, (int)blockIdx.x, (const char*)(ws + WS_S5H), (const char*)((bf16_t*)(ws + WS_S5M) + (size_t)64 * 512 * 256)};
                  EpiS5C E{(const unsigned char*)(ws + WS_YS), PROJ};
                  pg8::gemm_phase<EpiS5C, S5COrder>(F.lds + RING_OFF, g, S, E, F.tid); }
            PH_END
            PH_BEGIN
                pg8::Gemm g{LDP, 1024, 1024}; pg8::StaticOrder S; S.init(l == 1 ? 64 : NPAN, 4, F.G, (int)blockIdx.x, PROJ + PU, LDP, (const bf16_t*)(WGT + W_GLU), 1024, 1024, l == 1);
                EpiGlu E{PROJ, INP(I_GLUB) + l * 1024};
                pg8::gemm_phase<EpiGlu, pg8::StaticOrder>(F.lds + RING_OFF, g, S, E, F.tid);
            PH_END
            PH_BEGIN
                pg8::Gemm g{LDP, 3072, 3072}; pg8::StaticOrder S; S.init(l == 1 ? 64 : NPAN, 8, F.G, (int)blockIdx.x, PROJ, LDP, (const bf16_t*)(WGT + W_B), 3072, 3072, l == 1);
                EpiMerge E{PROJ, HM};
                pg8::gemm_phase<EpiMerge, pg8::StaticOrder, 0, true>(F.lds + RING_OFF, g, S, E, F.tid);
            PH_END
        }
        PH_BEGIN
            const int RK = (j == 1) ? D : DFF; const bf16_t* RA = (j == 1) ? HM : PROJ; const bf16_t* RBt = (j == 1) ? (const bf16_t*)(WGT + W_O) : (const bf16_t*)(WGT + W_2) + (size_t)(j >> 1) * D * DFF;
            const int lat = (l == 1 && j >= 1); pg8::Gemm g{RK, RK, RK}; pg8::StaticOrder S; S.init(64, D / 256, F.G, (int)blockIdx.x, RA, RK, RBt, RK, RK, 1, lat ? 0 : 128);
            const float* lg_ = (s == 0) ? (const float*)(ws + WS_IDENT) : INP(I_LNG) + (size_t)(s - 1) * D; const float* lb_ = (s == 0) ? (const float*)(ws + WS_IDENT) + 2048 : INP(I_LNB) + (size_t)(s - 1) * D;
            EpiResid E{(_Float16*)(ws + WS_H), (float*)(ws + WS_HC), MOD + (size_t)l * 5 * NMOD + (3 * j + 2) * D, lg_, lb_, (const float*)(ws + WS_STATS)};
            pg8::gemm_phase<EpiResid, pg8::StaticOrder>(F.lds + RING_OFF, g, S, E, F.tid);
        PH_END
        PH_BEGIN
            const bool fin = (s == 5);
            const int ln_ = (j == 2) ? l + 1 : l, jn = (j == 2) ? 0 : j + 1;
            ln_pass(F, true, INP(I_LNG) + (size_t)(l * 3 + j) * D, INP(I_LNB) + (size_t)(l * 3 + j) * D, fin ? nullptr : MOD + (size_t)ln_ * 5 * NMOD + 3 * jn * D, fin ? args.out : nullptr);
            if (s == 2) { s5_setup(args, F, 1); __syncthreads(); convert_layer_weights(args, F, 1); }
        PH_END
    }
#undef PH_BEGIN
#undef PH_END
}

static int count_phases() { int n = 2; for (int s = 0; s < 6; ++s) n += ((s % 3) != 1 ? 1 : 6) + 2; return n; }
extern "C" void kernel_launch(void* const* d_in, const int* in_sizes, int n_in, void* d_out, int out_size, void* d_ws, size_t ws_size, hipStream_t stream) {
    static int grid = 0;
    if (grid == 0) {
        if (n_in != 32 || out_size != NB * SEQ * D || ws_size < WS_END) { fprintf(stderr, "kernel_launch: unexpected shapes (n_in %d, out %d, ws %zu < %zu)\n", n_in, out_size, ws_size, (size_t)WS_END); grid = -1; return; }
        int dev = 0, cus = 0, per_cu = 0;
        if (hipGetDevice(&dev) != hipSuccess || hipDeviceGetAttribute(&cus, hipDeviceAttributeMultiprocessorCount, dev) != hipSuccess) { grid = -1; return; }
        if (hipFuncSetAttribute((const void*)trunk_fwd, hipFuncAttributeMaxDynamicSharedMemorySize, LDS_BYTES) != hipSuccess) { fprintf(stderr, "kernel_launch: hipFuncSetAttribute failed\n"); grid = -1; return; }
        if (hipOccupancyMaxActiveBlocksPerMultiprocessor(&per_cu, (const void*)trunk_fwd, NWAVES * 64, LDS_BYTES) != hipSuccess || per_cu < 1) fprintf(stderr, "kernel_launch: occupancy query says %d\n", per_cu);
        (void)hipGetLastError();
        if (cus != 256) { fprintf(stderr, "kernel_launch: this kernel deals its SSD chains / carries / attention units over exactly 256 workgroups (one per CU); device reports %d CUs; nothing launched\n", cus); grid = -1; return; }
        grid = cus;
    }
    if (grid < 0) return;
    (void)in_sizes;
    if (hipMemsetAsync((char*)d_ws + WS_CTL, 0, 2 * MiB  , stream) != hipSuccess) return;
    Args a{};
    for (int i = 0; i < 32; ++i) a.in[i] = (const float*)d_in[i];
    a.out = (float*)d_out; a.ws = (unsigned char*)d_ws;
    const int nph = count_phases();
#if MK_PER_PHASE
    for (int p = 0; p < nph; ++p) { a.ph_lo = p; a.ph_hi = p + 1; hipLaunchKernelGGL(trunk_fwd, dim3(grid), dim3(NWAVES * 64), LDS_BYTES, stream, a); }
#else
    a.ph_lo = 0; a.ph_hi = nph;
    hipLaunchKernelGGL(trunk_fwd, dim3(grid), dim3(NWAVES * 64), LDS_BYTES, stream, a);
#endif
    const hipError_t le = hipPeekAtLastError();
    if (le != hipSuccess) fprintf(stderr, "kernel_launch: launch failed: %s\n", hipGetErrorName(le));
}
```

```cpp
#include <hip/hip_runtime.h>
#include <hip/hip_bf16.h>
#include <cstdio>
#include <cstdint>
#include <cmath>

#ifndef MK_PER_PHASE
#define MK_PER_PHASE 0
#endif

#define LAS __attribute__((address_space(3)))
#define GAS __attribute__((address_space(1)))
typedef unsigned short bf16_t;
typedef short bf16x8 __attribute__((ext_vector_type(8)));
typedef float f32x4 __attribute__((ext_vector_type(4)));
typedef float f32x2 __attribute__((ext_vector_type(2)));
typedef float f32x16 __attribute__((ext_vector_type(16)));
typedef unsigned u32x4 __attribute__((ext_vector_type(4)));
typedef unsigned u32x2 __attribute__((ext_vector_type(2)));
typedef short s16x4 __attribute__((ext_vector_type(4)));

constexpr int NB = 4, SEQ = 4096, CTX = 256, RB = SEQ + CTX  , R = NB * RB  , NPAN = R / 256  , PPB = RB / 256  ;
constexpr int D = 2048, DFF = 5632, N13 = 2 * DFF, NMOD = 9 * D  ;
constexpr int LDP = 13312;
constexpr int NIN = 13568;
constexpr int PQ = 0, PK = 1024, PV = 2048, PZ = 3072, PX = 4096, PU = 6144, PG = 7168;
constexpr float DN_ALPHA = 1.41421356237309515f;
constexpr float LN_EPS = 1e-5f, RMS_EPS = 1e-6f;
constexpr float QSCALE = 0.125f * 1.4426950408889634f;

constexpr size_t MiB = 1u << 20;
constexpr size_t WS_CTL = 0, CTL_ZERO_BYTES = 1 * MiB;
constexpr size_t WS_MOD = 1 * MiB;
constexpr size_t WS_ROPE = 2 * MiB;
constexpr size_t WS_STATS = 2 * MiB + 65536;
constexpr size_t WS_IDENT = 2 * MiB + 262144;
constexpr size_t WS_MODP = 3 * MiB;
constexpr size_t WS_DT = 15 * MiB;
constexpr size_t WS_H = 18 * MiB;
constexpr size_t WS_HC = WS_H + 68 * MiB;
constexpr size_t WS_HM = 154 * MiB;
constexpr size_t WS_PROJ = 222 * MiB;
constexpr size_t WS_O = 664 * MiB;
constexpr size_t WS_YD = 732 * MiB;
constexpr size_t WS_YS = 800 * MiB;
constexpr size_t WS_W = 868 * MiB;
constexpr size_t W_13 = 0, W_2 = 88 * MiB, W_IN = 132 * MiB, W_B = 185 * MiB, W_O = 197 * MiB, W_GLU = 205 * MiB;
constexpr size_t WS_S5ST = 1075 * MiB;
constexpr size_t WS_S5H = 1143 * MiB;
constexpr size_t WS_S5M = 1183 * MiB;
constexpr size_t WS_S5A = 1207 * MiB;
constexpr size_t WS_GQ0 = WS_O + 34 * MiB, WS_GQ1 = WS_S5ST + 34 * MiB  , WS_GQ2 = 1208 * MiB;
constexpr size_t WS_END = 1242 * MiB;
__device__ __forceinline__ size_t gq_off(int j) { return j == 0 ? WS_GQ0 : (j == 1 ? WS_GQ1 : WS_GQ2); }
constexpr int S5M = 1088;
constexpr int CW_BAR = 4096;

__device__ __forceinline__ unsigned cvt_pk_bf16(float lo, float hi) { unsigned r; asm volatile("v_cvt_pk_bf16_f32 %0, %1, %2" : "=v"(r) : "v"(lo), "v"(hi)); return r; }
__device__ __forceinline__ float bflo(unsigned u) { return __uint_as_float(u << 16); }
__device__ __forceinline__ float bfhi(unsigned u) { return __uint_as_float(u & 0xffff0000u); }
__device__ __forceinline__ float bf1(bf16_t h) { return __uint_as_float((unsigned)h << 16); }
typedef _Float16 h16x2 __attribute__((ext_vector_type(2)));
typedef _Float16 h16x4 __attribute__((ext_vector_type(4)));
__device__ __forceinline__ f32x4 ld_h4(const _Float16* p) { const h16x4 h = *(const h16x4*)p; return (f32x4){(float)h[0], (float)h[1], (float)h[2], (float)h[3]}; }
__device__ __forceinline__ void st_h4(_Float16* p, f32x4 v) { h16x4 h; h[0] = (_Float16)v[0]; h[1] = (_Float16)v[1]; h[2] = (_Float16)v[2]; h[3] = (_Float16)v[3]; *(h16x4*)p = h; }
__device__ __forceinline__ float sigmoidf_(float x) { return __builtin_amdgcn_rcpf(1.0f + __builtin_amdgcn_exp2f(-1.4426950408889634f * x)); }
__device__ __forceinline__ float siluf_(float x) { return x * sigmoidf_(x); }
__device__ __forceinline__ int lane_now() { int l; asm volatile("v_mbcnt_lo_u32_b32 %0, -1, 0\n\tv_mbcnt_hi_u32_b32 %0, -1, %0" : "=v"(l)); return l; }
__device__ __forceinline__ float shx(float v, int m, int lane) { return __int_as_float(__builtin_amdgcn_ds_bpermute((lane ^ m) << 2, __float_as_int(v))); }
__device__ __forceinline__ float wave_sum(float v, int lane) {
#pragma unroll
    for (int o = 1; o < 64; o <<= 1) v += shx(v, o, lane);
    return v;
}
#define LDS_WAIT() asm volatile("s_waitcnt lgkmcnt(0)" ::: "memory")
#define VM_WAIT() asm volatile("s_waitcnt vmcnt(0)" ::: "memory")

namespace pg8 {
constexpr int BM = 256, BK = 64, HALF = 128, HTB = HALF * BK * 2, STAGE_BYTES = 8 * HTB, NXCD = 8, WGM = 8, PPB_ = 17;
__host__ __device__ __forceinline__ int lds_byte(int r, int c) { const int st = (r >> 4) * 2 + (c >> 5), rr = r & 15, cc = c & 31, ob = rr * 64 + cc * 2; return st * 1024 + (ob ^ (((ob >> 9) & 1) << 5)); }
__host__ __device__ __forceinline__ void stage_rc(int b, int& R_, int& C_) { const int st = b / 1024, sb = b % 1024, swz = sb ^ (((sb >> 9) & 1) << 5); R_ = (st >> 1) * 16 + swz / 64; C_ = (st & 1) * 32 + (swz % 64) / 2; }

struct Unit { int pm, pn, aux, kt; const char* a; const char* b; };
struct Gemm { int lda, ldb, K; };

__device__ __forceinline__ void xcd_remap(int L, int nM, int nN, int& pm, int& pn) {
    const int nwg = nM * nN; int wgid = L;
    { const int q = nwg / NXCD, r = nwg % NXCD, xcd = wgid % NXCD, off = wgid / NXCD; wgid = (xcd < r ? xcd * (q + 1) : r * (q + 1) + (xcd - r) * q) + off; }
    const int nig = WGM * nN, gid = wgid / nig, fm = gid * WGM, gsz = (nM - fm) < WGM ? (nM - fm) : WGM;
    pm = fm + ((wgid % nig) % gsz); pn = (wgid % nig) / gsz;
}
struct StaticOrder {
    int nM, nN, nwg, G, c, kt, latonly, nctx; const char* A; const char* B; size_t tA, tB;
    __device__ __forceinline__ void init(int nM_, int nN_, int G_, int c_, const void* A_, int lda, const void* B_, int ldb, int K, int latonly_ = 0, int nctx_ = 0) { nM = nM_; nN = nN_; nwg = nM * nN; G = G_; c = c_; kt = K / BK; latonly = latonly_; nctx = nctx_;
        A = (const char*)A_; B = (const char*)B_; tA = (size_t)BM * lda * 2; tB = (size_t)BM * ldb * 2; }
    __device__ __forceinline__ bool next(int i, Unit& u) const {
        const long L = (long)i * G + c;
        if (L < nwg) { xcd_remap((int)L, nM, nN, u.pm, u.pn); if (latonly) u.pm += (u.pm >> 4) + 1; u.aux = 0; u.kt = kt; u.a = A + (size_t)u.pm * tA; u.b = B + (size_t)u.pn * tB; return true; }
        const int x = (int)(L - nwg); if (x >= nctx) return false;
        const int q = x & 3, t2 = x >> 2; u.pm = PPB_ * (t2 / nN); u.pn = t2 % nN; u.aux = 1 + q; u.kt = kt >> 2;
        u.a = A + (size_t)u.pm * tA + (size_t)q * (kt >> 2) * BK * 2; u.b = B + (size_t)u.pn * tB + (size_t)q * (kt >> 2) * BK * 2; return true;
    }
};
template <class Epi, class Sched, int AMODE = 0, bool HOOK = false>
__device__ __forceinline__ void gemm_phase(LAS unsigned char* lds, const Gemm g, const Sched& S, const Epi& E, const int tid) {
    const int wid = __builtin_amdgcn_readfirstlane(tid >> 6), lane = tid & 63, wr = wid >> 2, wc = wid & 3, fr = lane & 15, fq = lane >> 4;
    unsigned voffA[2], voffB[2];
#pragma unroll
    for (int i = 0; i < 2; ++i) { int R_, C_; stage_rc(tid * 16 + i * 8192, R_, C_);
        voffA[i] = (AMODE == 1) ? (unsigned)((R_ * 16 + (C_ >> 4)) * LDP + (C_ & 15)) * 2u : (unsigned)(R_ * g.lda + C_) * 2u; voffB[i] = (unsigned)(R_ * g.ldb + C_) * 2u; }
    const size_t kstep = (size_t)(BK * 2), kstepA = (AMODE == 1) ? (size_t)(4 * LDP * 2) : kstep;
    const size_t hstepA = (AMODE == 1) ? (size_t)HALF * 16 * LDP * 2 : (size_t)HALF * g.lda * 2, hstepB = (size_t)HALF * g.ldb * 2;
    const unsigned ldsw = (unsigned)wid * 1024u;
    const int aoff = lds_byte(wr * 64 + fr, fq * 8), boff = lds_byte(wc * 32 + fr, fq * 8);
#define PG8_SA(b, h) (((b) * 2 + (h)) * HTB)
#define PG8_SB(b, h) ((4 + (b) * 2 + (h)) * HTB)
#define PG8_STAGE(bufoff, gbase, voff) do { _Pragma("unroll") for (int _i = 0; _i < 2; ++_i) \
        __builtin_amdgcn_global_load_lds((const unsigned*)((const char*)(gbase) + (voff)[_i]), (LAS unsigned*)(lds + (bufoff) + ldsw + _i * 8192), 16, 0, 0); } while (0)
#define PG8_LDA(dst, b, h) do { _Pragma("unroll") for (int m = 0; m < 4; ++m) _Pragma("unroll") for (int k = 0; k < 2; ++k) dst[m][k] = *(const LAS bf16x8*)(lds + PG8_SA(b, h) + aoff + m * 2048 + k * 1024); } while (0)
#define PG8_LDB(dst, b, h) do { _Pragma("unroll") for (int n = 0; n < 2; ++n) _Pragma("unroll") for (int k = 0; k < 2; ++k) dst[n][k] = *(const LAS bf16x8*)(lds + PG8_SB(b, h) + boff + n * 2048 + k * 1024); } while (0)
#define PG8_MMA(ai, bj, At, Bt) do { __builtin_amdgcn_s_setprio(1); _Pragma("unroll") for (int m = 0; m < 4; ++m) _Pragma("unroll") for (int n = 0; n < 2; ++n) _Pragma("unroll") for (int k = 0; k < 2; ++k) \
        acc[ai][bj][m][n] = __builtin_amdgcn_mfma_f32_16x16x32_bf16(Bt[n][k], At[m][k], acc[ai][bj][m][n], 0, 0, 0); __builtin_amdgcn_s_setprio(0); } while (0)
#define PG8_WAIT_V(n) asm volatile("s_waitcnt vmcnt(" #n ")" ::: "memory")
#define PG8_WAIT_L(n) asm volatile("s_waitcnt lgkmcnt(" #n ")" ::: "memory")
#define PG8_BAR __builtin_amdgcn_s_barrier()
#define PG8_SCHED __builtin_amdgcn_sched_barrier(0)
    Unit cur, nxt; int ui = 0;
    if (!S.next(0, cur)) return;
    f32x4 acc[2][2][4][2];
#pragma unroll
    for (int a = 0; a < 2; ++a)
#pragma unroll
        for (int b = 0; b < 2; ++b)
#pragma unroll
            for (int m = 0; m < 4; ++m)
#pragma unroll
                for (int n = 0; n < 2; ++n) acc[a][b][m][n] = (f32x4){0.f, 0.f, 0.f, 0.f};
    bf16x8 At[4][2], B0[2][2], B1[2][2];
    const char* cA = cur.a; const char* cB = cur.b;
    PG8_STAGE(PG8_SB(0, 0), cB, voffB); PG8_STAGE(PG8_SB(0, 1), cB + hstepB, voffB); PG8_STAGE(PG8_SA(0, 0), cA, voffA); PG8_STAGE(PG8_SA(0, 1), cA + hstepA, voffA);
    if (wr == 1) PG8_BAR;
    PG8_WAIT_V(2); PG8_BAR;
    PG8_STAGE(PG8_SB(1, 0), cB + kstep, voffB); PG8_STAGE(PG8_SA(1, 0), cA + kstepA, voffA); PG8_STAGE(PG8_SB(1, 1), cB + hstepB + kstep, voffB);
    PG8_WAIT_V(6); PG8_BAR;
    for (;;) {
        const bool has_next = S.next(ui + 1, nxt);
        const char* nA = has_next ? nxt.a : cA; const char* nB = has_next ? nxt.b : cB;
        const int nt = cur.kt;
        for (int t = 0; t < nt; t += 2) {
            const bool last = (t == nt - 2);
            if constexpr (HOOK) { if (t == 16 || t == 32) E.mid(acc, cur, t >> 4, wr, wc); }
            const char* a1 = cA + (size_t)(t + 1) * kstepA;
            const char* a2 = last ? nA : cA + (size_t)(t + 2) * kstepA; const char* b2 = last ? nB : cB + (size_t)(t + 2) * kstep;
            const char* a3 = a2 + kstepA; const char* b3 = b2 + kstep;
            PG8_LDB(B0, 0, 0); PG8_LDB(B1, 0, 1); PG8_SCHED; PG8_LDA(At, 0, 0); PG8_STAGE(PG8_SA(1, 1), a1 + hstepA, voffA);
            PG8_WAIT_V(8); PG8_WAIT_L(0); PG8_BAR; PG8_MMA(0, 0, At, B0); PG8_MMA(0, 1, At, B1); PG8_BAR; PG8_SCHED;
            PG8_LDA(At, 0, 1); PG8_STAGE(PG8_SB(0, 0), b2, voffB); PG8_STAGE(PG8_SB(0, 1), b2 + hstepB, voffB); PG8_STAGE(PG8_SA(0, 0), a2, voffA);
            PG8_WAIT_V(8); PG8_WAIT_L(0); PG8_BAR; PG8_MMA(1, 0, At, B0); PG8_MMA(1, 1, At, B1); PG8_BAR; PG8_SCHED;
            PG8_LDB(B0, 1, 0); PG8_LDB(B1, 1, 1); PG8_SCHED; PG8_LDA(At, 1, 0); PG8_STAGE(PG8_SA(0, 1), a2 + hstepA, voffA);
            PG8_WAIT_V(8); PG8_WAIT_L(0); PG8_BAR; PG8_MMA(0, 0, At, B0); PG8_MMA(0, 1, At, B1); PG8_BAR; PG8_SCHED;
            PG8_LDA(At, 1, 1); PG8_STAGE(PG8_SB(1, 0), b3, voffB); PG8_STAGE(PG8_SB(1, 1), b3 + hstepB, voffB); PG8_STAGE(PG8_SA(1, 0), a3, voffA);
            PG8_WAIT_V(8); PG8_WAIT_L(0); PG8_BAR; PG8_MMA(1, 0, At, B0); PG8_MMA(1, 1, At, B1); PG8_BAR; PG8_SCHED;
        }
        if (wr == 0) PG8_BAR;
        E(acc, cur, wr, wc, fr, fq);
        if (!has_next) break;
#pragma unroll
        for (int a = 0; a < 2; ++a)
#pragma unroll
            for (int b = 0; b < 2; ++b)
#pragma unroll
                for (int m = 0; m < 4; ++m)
#pragma unroll
                    for (int n = 0; n < 2; ++n) acc[a][b][m][n] = (f32x4){0.f, 0.f, 0.f, 0.f};
        cur = nxt; cA = nA; cB = nB; ++ui;
        if (wr == 1) PG8_BAR;
    }
    PG8_WAIT_V(0);
    PG8_BAR;
#undef PG8_SA
#undef PG8_SB
#undef PG8_STAGE
#undef PG8_LDA
#undef PG8_LDB
#undef PG8_MMA
#undef PG8_WAIT_V
#undef PG8_WAIT_L
#undef PG8_BAR
#undef PG8_SCHED
}
}

struct EpiSwiGLU {
    bf16_t* O;
    __device__ __forceinline__ void operator()(const f32x4 (&acc)[2][2][4][2], const pg8::Unit& u, int wr, int wc, int, int) const { const int ln_ = lane_now(); const int fr = ln_ & 15, fq = ln_ >> 4;
        const int row0 = u.pm * 256 + wr * 64 + fr, hc0 = u.pn * 128 + wc * 16 + 4 * fq;
#pragma unroll
        for (int ai = 0; ai < 2; ++ai)
#pragma unroll
            for (int m = 0; m < 4; ++m) { bf16_t* rowp = O + (size_t)(row0 + ai * 128 + m * 16) * DFF + hc0;
#pragma unroll
                for (int bj = 0; bj < 2; ++bj) { const f32x4 a = acc[ai][bj][m][0], b = acc[ai][bj][m][1];
                    u32x2 w; w.x = cvt_pk_bf16(siluf_(a[0]) * b[0], siluf_(a[1]) * b[1]); w.y = cvt_pk_bf16(siluf_(a[2]) * b[2], siluf_(a[3]) * b[3]);
                    *(u32x2*)(rowp + bj * 64) = w; } }
    }
};
struct EpiResid {
    _Float16* H; float* HC; const float* gate; const float* lng; const float* lnb; const float* stats;
    __device__ __forceinline__ void operator()(const f32x4 (&acc)[2][2][4][2], const pg8::Unit& u, int wr, int wc, int, int) const { const int ln_ = lane_now(); const int fr = ln_ & 15, fq = ln_ >> 4;
        const int pp = u.pm % PPB, mi = (pp == 0) ? 4 : (u.pm / PPB);
        const int rl0 = wr * 64 + fr, col0 = u.pn * 256 + wc * 32 + 4 * fq;
        if (u.aux) {
            float* hc = (float*)((char*)HC - WS_HC + WS_YD) + ((size_t)(u.aux - 1) * (NB * CTX) + (size_t)(u.pm / PPB) * 256) * D;
#pragma unroll
            for (int bj = 0; bj < 2; ++bj)
#pragma unroll
                for (int n = 0; n < 2; ++n) { const f32x4 gv = *(const f32x4*)(gate + (size_t)mi * NMOD + col0 + bj * 128 + n * 16);
#pragma unroll
                    for (int ai = 0; ai < 2; ++ai)
#pragma unroll
                        for (int m = 0; m < 4; ++m) { float* p = hc + (size_t)(rl0 + ai * 128 + m * 16) * D + col0 + bj * 128 + n * 16; const f32x4 v = gv * acc[ai][bj][m][n];
                            *(f32x4*)p = v; } }
            return;
        }
        f32x2 st[2][4];
#pragma unroll
        for (int ai = 0; ai < 2; ++ai)
#pragma unroll
            for (int m = 0; m < 4; ++m) st[ai][m] = *(const f32x2*)(stats + (size_t)(u.pm * 256 + rl0 + ai * 128 + m * 16) * 2);
#pragma unroll
        for (int bj = 0; bj < 2; ++bj) {
            h16x4 tv[2][2][4];
#pragma unroll
            for (int n = 0; n < 2; ++n)
#pragma unroll
                for (int ai = 0; ai < 2; ++ai)
#pragma unroll
                    for (int m = 0; m < 4; ++m) tv[n][ai][m] = *(const h16x4*)(H + (size_t)(u.pm * 256 + rl0 + ai * 128 + m * 16) * D + col0 + bj * 128 + n * 16);
#pragma unroll
            for (int n = 0; n < 2; ++n) { const int c = col0 + bj * 128 + n * 16; const f32x4 gv = *(const f32x4*)(gate + (size_t)mi * NMOD + c);
                const f32x4 g4 = *(const f32x4*)(lng + c) * DN_ALPHA, b4 = *(const f32x4*)(lnb + c) * DN_ALPHA;
#pragma unroll
                for (int ai = 0; ai < 2; ++ai)
#pragma unroll
                    for (int m = 0; m < 4; ++m) { const h16x4 h = tv[n][ai][m]; const f32x4 t = (f32x4){(float)h[0], (float)h[1], (float)h[2], (float)h[3]};
                        st_h4(H + (size_t)(u.pm * 256 + rl0 + ai * 128 + m * 16) * D + c, (t - st[ai][m].x) * st[ai][m].y * g4 + b4 + gv * acc[ai][bj][m][n]); } }
            asm volatile("" ::: "memory"); }
    }
};
struct EpiProj {
    bf16_t* P; float* DT; const float* rc; const float* rs; bf16_t* U2;
    __device__ __forceinline__ void operator()(const f32x4 (&acc)[2][2][4][2], const pg8::Unit& u, int wr, int wc, int, int) const { const int ln_ = lane_now(); const int fr = ln_ & 15, fq = ln_ >> 4;
        const int pp = u.pm % PPB; const int row0 = u.pm * 256 + wr * 64 + fr;
        const int pn = u.pn;
        if (pn == 52) {
            if (wc == 0) {
#pragma unroll
                for (int ai = 0; ai < 2; ++ai)
#pragma unroll
                    for (int m = 0; m < 4; ++m)
#pragma unroll
                        for (int n = 0; n < 2; ++n) *(f32x4*)(DT + (size_t)(row0 + ai * 128 + m * 16) * 32 + n * 16 + 4 * fq) = acc[ai][0][m][n];
            }
            return;
        }
        if (pn >= 28) {
            const int jg = (pn - 28) >> 3, pnd = (pn - 28) & 7;
            unsigned char* gq = (unsigned char*)P - WS_PROJ + gq_off(jg) + ((size_t)((u.pm * 8 + pnd) * 512 + (wr * 4 + wc) * 64 + ln_)) * 128;
#pragma unroll
            for (int ai = 0; ai < 2; ++ai)
#pragma unroll
                for (int m = 0; m < 4; ++m) { u32x4 w;
#pragma unroll
                    for (int bj = 0; bj < 2; ++bj)
#pragma unroll
                        for (int n = 0; n < 2; ++n) { const f32x4 v = acc[ai][bj][m][n]; unsigned q = 0;
#pragma unroll
                            for (int e = 0; e < 4; ++e) q |= (unsigned)fmaxf(__builtin_rintf(sigmoidf_(v[e]) * 255.0f), 1.0f) << (8 * e);
                            w[bj * 2 + n] = q; }
                    *(u32x4*)(gq + (ai * 4 + m) * 16) = w; }
            return;
        }
        const int col0 = pn * 256 + wc * 32 + 4 * fq;
        const int mode = (pn < 8) ? ((pp != 0) ? 1 : 0) : ((pn >= 12 && pn < 16) ? 2 : 0);
        const float sc = (pn < 4) ? QSCALE : 1.0f;
#pragma unroll
        for (int ai = 0; ai < 2; ++ai) {
          f32x4 csv[4], snv[4];
          if (mode == 1) {
#pragma unroll
              for (int m = 0; m < 4; ++m) { const int rl = ai * 128 + wr * 64 + m * 16 + fr; const int t = (pp - 1) * 256 + rl; const int pos = (wc & 1) ? (t & 63) : (t >> 6); csv[m] = *(const f32x4*)(rc + pos * 16 + 4 * fq); snv[m] = *(const f32x4*)(rs + pos * 16 + 4 * fq); }
              asm volatile("s_waitcnt vmcnt(0)" ::: "memory"); }
#pragma unroll
            for (int m = 0; m < 4; ++m) { const int rl = ai * 128 + wr * 64 + m * 16 + fr; bf16_t* rowp = P + (size_t)(u.pm * 256 + rl) * LDP + col0;
                f32x4 cs = (f32x4){1.f, 1.f, 1.f, 1.f}, sn = (f32x4){0.f, 0.f, 0.f, 0.f};
                if (mode == 1) { cs = csv[m]; sn = snv[m]; }
#pragma unroll
                for (int bj = 0; bj < 2; ++bj) { f32x4 v0 = acc[ai][bj][m][0], v1 = acc[ai][bj][m][1];
                    if (mode == 1) { const f32x4 o0 = v0 * cs - v1 * sn, o1 = v1 * cs + v0 * sn; v0 = o0; v1 = o1; }
                    else if (mode == 2) {
#pragma unroll
                        for (int e = 0; e < 4; ++e) { v0[e] = siluf_(v0[e]); v1[e] = siluf_(v1[e]); } }
                    if (pn >= 24 && pn < 28) {
                        bf16_t* u2 = U2 + ((size_t)(((pn - 24) * 256 + bj * 128 + wc * 32) >> 4) * R + (size_t)(u.pm * 256 + rl)) * 16 + 4 * fq;
                        u32x2 a0, a1; a0.x = cvt_pk_bf16(v0[0], v0[1]); a0.y = cvt_pk_bf16(v0[2], v0[3]); a1.x = cvt_pk_bf16(v1[0], v1[1]); a1.y = cvt_pk_bf16(v1[2], v1[3]);
                        *(u32x2*)u2 = a0; *(u32x2*)(u2 + (size_t)R * 16) = a1; continue; }
                    v0 = v0 * sc; v1 = v1 * sc;
                    u32x2 w0, w1; w0.x = cvt_pk_bf16(v0[0], v0[1]); w0.y = cvt_pk_bf16(v0[2], v0[3]); w1.x = cvt_pk_bf16(v1[0], v1[1]); w1.y = cvt_pk_bf16(v1[2], v1[3]);
                    *(u32x2*)(rowp + bj * 128) = w0; *(u32x2*)(rowp + bj * 128 + 16) = w1; } } }
    }
};
struct EpiGlu {
    bf16_t* P; const float* bias;
    __device__ __forceinline__ void operator()(const f32x4 (&acc)[2][2][4][2], const pg8::Unit& u, int wr, int wc, int, int) const { const int ln_ = lane_now(); const int fr = ln_ & 15, fq = ln_ >> 4;
        const int row0 = u.pm * 256 + wr * 64 + fr, col0 = u.pn * 256 + wc * 32 + 4 * fq;
        f32x4 bv[2][2];
#pragma unroll
        for (int bj = 0; bj < 2; ++bj)
#pragma unroll
            for (int n = 0; n < 2; ++n) bv[bj][n] = *(const f32x4*)(bias + col0 + bj * 128 + n * 16);
#pragma unroll
        for (int ai = 0; ai < 2; ++ai) {
            u32x2 tv[4][2][2];
#pragma unroll
            for (int m = 0; m < 4; ++m)
#pragma unroll
                for (int bj = 0; bj < 2; ++bj)
#pragma unroll
                    for (int n = 0; n < 2; ++n) tv[m][bj][n] = *(const u32x2*)(P + (size_t)(row0 + ai * 128 + m * 16) * LDP + PU + col0 + bj * 128 + n * 16);
            asm volatile("s_waitcnt vmcnt(0)" ::: "memory");
#pragma unroll
            for (int m = 0; m < 4; ++m) { bf16_t* rowp = P + (size_t)(row0 + ai * 128 + m * 16) * LDP;
#pragma unroll
                for (int bj = 0; bj < 2; ++bj)
#pragma unroll
                    for (int n = 0; n < 2; ++n) { const int c = col0 + bj * 128 + n * 16; const u32x2 t = tv[m][bj][n];
                        const f32x4 a = acc[ai][bj][m][n] + bv[bj][n]; u32x2 w;
                        w.x = cvt_pk_bf16(bflo(t.x) * sigmoidf_(a[0]), bfhi(t.x) * sigmoidf_(a[1])); w.y = cvt_pk_bf16(bflo(t.y) * sigmoidf_(a[2]), bfhi(t.y) * sigmoidf_(a[3]));
                        *(u32x2*)(rowp + PK + c) = w; } } }
    }
};
struct EpiMerge {
    const bf16_t* P; bf16_t* MIXB;
    static __device__ __forceinline__ int jmap(int seg) { return seg == 0 ? 0 : (seg == 1 ? 2 : 1); }
    __device__ __forceinline__ const unsigned char* gbase(const pg8::Unit& u, int seg, int wr, int wc, int ln_) const {
        return (const unsigned char*)P - WS_PROJ + gq_off(jmap(seg)) + ((size_t)((u.pm * 8 + u.pn) * 512 + (wr * 4 + wc) * 64 + ln_)) * 128; }
    __device__ __forceinline__ void mid(f32x4 (&acc)[2][2][4][2], const pg8::Unit& u, int seg, int wr, int wc) const {
        const int ln_ = lane_now(); const unsigned char* ga = gbase(u, seg - 1, wr, wc, ln_); const unsigned char* gb = gbase(u, seg, wr, wc, ln_);
        u32x4 a[2][4], b[2][4];
#pragma unroll
        for (int ai = 0; ai < 2; ++ai)
#pragma unroll
            for (int m = 0; m < 4; ++m) { a[ai][m] = *(const u32x4*)(ga + (ai * 4 + m) * 16); b[ai][m] = *(const u32x4*)(gb + (ai * 4 + m) * 16); }
        asm volatile("s_waitcnt vmcnt(0)" ::: "memory");
#pragma unroll
        for (int ai = 0; ai < 2; ++ai)
#pragma unroll
            for (int m = 0; m < 4; ++m)
#pragma unroll
                for (int bj = 0; bj < 2; ++bj)
#pragma unroll
                    for (int n = 0; n < 2; ++n) { const unsigned qa = a[ai][m][bj * 2 + n], qb = b[ai][m][bj * 2 + n]; f32x4 r;
#pragma unroll
                        for (int e = 0; e < 4; ++e) r[e] = (float)((qa >> (8 * e)) & 255u) * __builtin_amdgcn_rcpf((float)((qb >> (8 * e)) & 255u));
                        acc[ai][bj][m][n] = acc[ai][bj][m][n] * r; }
    }
    __device__ __forceinline__ void operator()(const f32x4 (&acc)[2][2][4][2], const pg8::Unit& u, int wr, int wc, int, int) const { const int ln_ = lane_now(); const int fr = ln_ & 15, fq = ln_ >> 4;
        const int row0 = u.pm * 256 + wr * 64 + fr, col0 = u.pn * 256 + wc * 32 + 4 * fq; const unsigned char* gl = gbase(u, 2, wr, wc, ln_);
        u32x4 gq[2][4];
#pragma unroll
        for (int ai = 0; ai < 2; ++ai)
#pragma unroll
            for (int m = 0; m < 4; ++m) gq[ai][m] = *(const u32x4*)(gl + (ai * 4 + m) * 16);
        asm volatile("s_waitcnt vmcnt(0)" ::: "memory");
#pragma unroll
        for (int ai = 0; ai < 2; ++ai)
#pragma unroll
            for (int m = 0; m < 4; ++m) { const size_t row = (size_t)(row0 + ai * 128 + m * 16); const u32x4 g4 = gq[ai][m];
#pragma unroll
                for (int bj = 0; bj < 2; ++bj)
#pragma unroll
                    for (int n = 0; n < 2; ++n) { const int c = col0 + bj * 128 + n * 16; const unsigned gv = g4[bj * 2 + n];
                        f32x4 v = acc[ai][bj][m][n];
#pragma unroll
                        for (int e = 0; e < 4; ++e) v[e] *= (float)((gv >> (8 * e)) & 255u) * (1.0f / 255.0f);
                        u32x2 w; w.x = cvt_pk_bf16(v[0], v[1]); w.y = cvt_pk_bf16(v[2], v[3]); *(u32x2*)(MIXB + row * D + c) = w; } }
    }
};

struct S5AOrder {
    int G, c; const char* A; const char* B;
    __device__ __forceinline__ bool next(int i, pg8::Unit& u) const {
        const int idx = i * G + c; if (idx >= 640) return false;
        const int g = idx / 10, r = idx - 10 * g, nt = r / 5, mt = r - 5 * nt;
        u.pm = mt; u.pn = nt; u.aux = g; u.kt = 4; u.a = A + ((size_t)g * (R / 16) + (size_t)mt * 256) * 256 * 2; u.b = B + (size_t)(g * 512 + nt * 256) * 256 * 2; return true;
    }
};
struct EpiS5A {
    unsigned char* YLF; bf16_t* ST;
    __device__ __forceinline__ void operator()(const f32x4 (&acc)[2][2][4][2], const pg8::Unit& u, int wr, int wc, int, int) const { const int ln_ = lane_now(); const int fr = ln_ & 15, fq = ln_ >> 4;
        const int g = u.aux;
        if (u.pn == 0) { unsigned char* yl = YLF + ((size_t)((g * 5 + u.pm) * 512 + (wr * 4 + wc) * 64 + ln_)) * 256;
#pragma unroll
            for (int ai = 0; ai < 2; ++ai)
#pragma unroll
                for (int m = 0; m < 4; ++m) { u32x4 w0, w1;
                    w0.x = cvt_pk_bf16(acc[ai][0][m][0][0], acc[ai][0][m][0][1]); w0.y = cvt_pk_bf16(acc[ai][0][m][0][2], acc[ai][0][m][0][3]); w0.z = cvt_pk_bf16(acc[ai][0][m][1][0], acc[ai][0][m][1][1]); w0.w = cvt_pk_bf16(acc[ai][0][m][1][2], acc[ai][0][m][1][3]);
                    w1.x = cvt_pk_bf16(acc[ai][1][m][0][0], acc[ai][1][m][0][1]); w1.y = cvt_pk_bf16(acc[ai][1][m][0][2], acc[ai][1][m][0][3]); w1.z = cvt_pk_bf16(acc[ai][1][m][1][0], acc[ai][1][m][1][1]); w1.w = cvt_pk_bf16(acc[ai][1][m][1][2], acc[ai][1][m][1][3]);
                    *(u32x4*)(yl + (ai * 4 + m) * 32) = w0; *(u32x4*)(yl + (ai * 4 + m) * 32 + 16) = w1; }
            return; }
#pragma unroll
        for (int ai = 0; ai < 2; ++ai)
#pragma unroll
            for (int m = 0; m < 4; ++m) { const int mr = u.pm * 256 + ai * 128 + wr * 64 + m * 16 + fr; if (mr < S5M) {
#pragma unroll
                for (int bj = 0; bj < 2; ++bj)
#pragma unroll
                    for (int n = 0; n < 2; ++n) { const f32x4 v = acc[ai][bj][m][n];
                        u32x2 w; w.x = cvt_pk_bf16(v[0], v[1]); w.y = cvt_pk_bf16(v[2], v[3]); *(u32x2*)(ST + ((size_t)g * S5M + mr) * 256 + bj * 128 + wc * 32 + n * 16 + 4 * fq) = w; } } }
    }
};
struct S5COrder {
    int G, c; const char* A; const char* B;
    __device__ __forceinline__ bool next(int i, pg8::Unit& u) const {
        const int idx = i * G + c; if (idx >= 320) return false;
        const int g = idx / 5, mt = idx - 5 * g;
        u.pm = mt; u.pn = 0; u.aux = g; u.kt = 4; u.a = A + ((size_t)g * 1280 + mt * 256) * 256 * 2; u.b = B + (size_t)g * 256 * 256 * 2; return true;
    }
};
struct EpiS5C {
    const unsigned char* YLF; bf16_t* P;
    __device__ __forceinline__ void operator()(const f32x4 (&acc)[2][2][4][2], const pg8::Unit& u, int wr, int wc, int, int) const { const int ln_ = lane_now(); const int fr = ln_ & 15, fq = ln_ >> 4;
        const int g = u.aux; const unsigned char* yl = YLF + ((size_t)((g * 5 + u.pm) * 512 + (wr * 4 + wc) * 64 + ln_)) * 256;
        u32x4 y0[2][4], y1[2][4];
#pragma unroll
        for (int ai = 0; ai < 2; ++ai)
#pragma unroll
            for (int m = 0; m < 4; ++m) { y0[ai][m] = *(const u32x4*)(yl + (ai * 4 + m) * 32); y1[ai][m] = *(const u32x4*)(yl + (ai * 4 + m) * 32 + 16); }
        asm volatile("s_waitcnt vmcnt(0)" ::: "memory");
#pragma unroll
        for (int ai = 0; ai < 2; ++ai)
#pragma unroll
            for (int m = 0; m < 4; ++m) { const int mr = u.pm * 256 + ai * 128 + wr * 64 + m * 16 + fr; if (mr < S5M) {
#pragma unroll
                for (int bj = 0; bj < 2; ++bj)
#pragma unroll
                    for (int n = 0; n < 2; ++n) { const int rho = 8 * bj + 2 * wc + n; const size_t row = (size_t)(16 * mr + rho);
                        const u32x4 yy = bj ? y1[ai][m] : y0[ai][m]; const unsigned ya = n ? yy.z : yy.x, yb = n ? yy.w : yy.y; f32x4 v = acc[ai][bj][m][n];
                        v[0] += bflo(ya); v[1] += bfhi(ya); v[2] += bflo(yb); v[3] += bfhi(yb);
#pragma unroll
                        for (int e = 0; e < 4; ++e) { const float x = v[e]; const float inner = 0.7978845608028654f * (x + 0.044715f * x * x * x); const float th = 1.0f - 2.0f * __builtin_amdgcn_rcpf(1.0f + __builtin_amdgcn_exp2f(2.8853900817779268f * inner)); v[e] = 0.5f * x * (1.0f + th); }
                        u32x2 w; w.x = cvt_pk_bf16(v[0], v[1]); w.y = cvt_pk_bf16(v[2], v[3]); *(u32x2*)(P + row * LDP + PU + 16 * g + 4 * fq) = w; } } }
    }
};

namespace attn128 {
using bf16 = __hip_bfloat16;
constexpr int NW = 8, QBLK = 32, KVBLK = 64, LDQ = LDP, LDK = LDP, LDOB = LDP;
constexpr size_t SHM_V = KVBLK * 128 * 2, SHM_K = KVBLK * 64 * 2, SHM_ATTN = 2 * SHM_V + 2 * SHM_K + NW * 64 * 4, SHM_TOTAL = SHM_ATTN + NW * 8192;
constexpr float THRL = 11.5f;
#define A128_KSWZ(row, colB) ((row) * 128 + ((colB) ^ (((row) & 7) << 4)))
#define A128_SBAR() __builtin_amdgcn_sched_barrier(0)
__device__ __forceinline__ int crow(int r, int hi) { return (r & 3) + 8 * (r >> 2) + 4 * hi; }
__device__ __forceinline__ void partialSM(f32x16& p0, f32x16& p1, float& m_reg, float& mn, float& alpha) {
  float pmax = p0[0];
#pragma unroll
  for (int r = 1; r < 16; ++r) pmax = fmaxf(pmax, p0[r]);
#pragma unroll
  for (int r = 0; r < 16; ++r) pmax = fmaxf(pmax, p1[r]);
  { auto rr = __builtin_amdgcn_permlane32_swap(__float_as_uint(pmax), __float_as_uint(pmax), false, false); pmax = fmaxf(__uint_as_float(rr[0]), __uint_as_float(rr[1])); }
  if (__builtin_expect(__all(pmax - m_reg <= THRL), 1)) { mn = m_reg; alpha = 1.f; }
  else { mn = fmaxf(m_reg, pmax); alpha = __builtin_amdgcn_exp2f(m_reg - mn); m_reg = mn; }
#pragma unroll
  for (int r = 0; r < 16; ++r) { p0[r] = p0[r] - mn; p1[r] = p1[r] - mn; }
#pragma unroll
  for (int r = 0; r < 16; ++r) p0[r] = __builtin_amdgcn_exp2f(p0[r]);
}
__device__ __forceinline__ void finishSM(f32x16& p0, f32x16& p1, float alpha, float& l_reg, bf16x8& pa0, bf16x8& pa1, bf16x8& pa2, bf16x8& pa3) {
#pragma unroll
  for (int r = 0; r < 16; ++r) p1[r] = __builtin_amdgcn_exp2f(p1[r]);
  float ps = 0;
#pragma unroll
  for (int r = 0; r < 16; ++r) ps += p0[r];
#pragma unroll
  for (int r = 0; r < 16; ++r) ps += p1[r];
  { auto rr = __builtin_amdgcn_permlane32_swap(__float_as_uint(ps), __float_as_uint(ps), false, false); ps = __uint_as_float(rr[0]) + __uint_as_float(rr[1]); }
  l_reg = l_reg * alpha + ps;
#define A128_PK4(P, BASE, OUT) do { unsigned a0 = cvt_pk_bf16(P[BASE + 0], P[BASE + 1]), a1 = cvt_pk_bf16(P[BASE + 2], P[BASE + 3]);   \
    unsigned b0 = cvt_pk_bf16(P[BASE + 4], P[BASE + 5]), b1 = cvt_pk_bf16(P[BASE + 6], P[BASE + 7]);                              \
    auto r0 = __builtin_amdgcn_permlane32_swap(a0, b0, false, false); auto r1 = __builtin_amdgcn_permlane32_swap(a1, b1, false, false); \
    u32x4 w = {r0[0], r1[0], r0[1], r1[1]}; OUT = __builtin_bit_cast(bf16x8, w); } while (0)
  A128_PK4(p0, 0, pa0); A128_PK4(p0, 8, pa1); A128_PK4(p1, 0, pa2); A128_PK4(p1, 8, pa3);
#undef A128_PK4
}
__device__ __forceinline__ void qkt(f32x16& p0, f32x16& p1, const char* Ks, const bf16x8* qr, int r32, int hi) {
#pragma unroll
  for (int i = 0; i < 16; ++i) { p0[i] = 0.f; p1[i] = 0.f; }
#pragma unroll
  for (int d0 = 0; d0 < 4; ++d0) { const int cb = (d0 * 16 + hi * 8) * 2;
    const bf16x8 b0 = *reinterpret_cast<const bf16x8*>(Ks + A128_KSWZ(r32, cb));
    const bf16x8 b1 = *reinterpret_cast<const bf16x8*>(Ks + A128_KSWZ(32 + r32, cb));
    p0 = __builtin_amdgcn_mfma_f32_32x32x16_bf16(b0, qr[d0], p0, 0, 0, 0);
    p1 = __builtin_amdgcn_mfma_f32_32x32x16_bf16(b1, qr[d0], p1, 0, 0, 0); }
}
__device__ __forceinline__ int v_st(int k, int c) { const int kk = (k & ~0xC) | ((k & 4) << 1) | ((k & 8) >> 1); return ((kk >> 3) * 4 + (c >> 5)) * 512 + ((kk & 7) * 32 + (c & 31)) * 2; }
__device__ __forceinline__ int v_rd_base(int lane) { return ((lane & 3) << 3) | (((lane >> 2) & 3) << 6) | (((lane >> 4) & 1) << 5) | (((lane >> 5) & 1) << 8); }
constexpr int v_rd_off(int d0, int ks, int half) { return d0 * 512 + ks * 4096 + half * 2048; }
template <int OFF> __device__ __forceinline__ s16x4 tr_read(int vb) { s16x4 r; asm volatile("ds_read_b64_tr_b16 %0, %1 offset:%2" : "=&v"(r) : "v"(vb), "i"(OFF) : "memory"); return r; }
template <int D0> __device__ __forceinline__ void pv_one(f32x16& od, int vb, bf16x8 pa0, bf16x8 pa1, bf16x8 pa2, bf16x8 pa3) {
  const s16x4 l0 = tr_read<v_rd_off(D0, 0, 0)>(vb), h0 = tr_read<v_rd_off(D0, 0, 1)>(vb), l1 = tr_read<v_rd_off(D0, 1, 0)>(vb), h1 = tr_read<v_rd_off(D0, 1, 1)>(vb);
  const s16x4 l2 = tr_read<v_rd_off(D0, 2, 0)>(vb), h2 = tr_read<v_rd_off(D0, 2, 1)>(vb), l3 = tr_read<v_rd_off(D0, 3, 0)>(vb), h3 = tr_read<v_rd_off(D0, 3, 1)>(vb);
  asm volatile("s_waitcnt lgkmcnt(0)" ::: "memory"); A128_SBAR();
#define A128_PK(L, H) (bf16x8){L[0], L[1], L[2], L[3], H[0], H[1], H[2], H[3]}
  od = __builtin_amdgcn_mfma_f32_32x32x16_bf16(pa0, A128_PK(l0, h0), od, 0, 0, 0);
  od = __builtin_amdgcn_mfma_f32_32x32x16_bf16(pa1, A128_PK(l1, h1), od, 0, 0, 0);
  od = __builtin_amdgcn_mfma_f32_32x32x16_bf16(pa2, A128_PK(l2, h2), od, 0, 0, 0);
  od = __builtin_amdgcn_mfma_f32_32x32x16_bf16(pa3, A128_PK(l3, h3), od, 0, 0, 0);
#undef A128_PK
}
__device__ __forceinline__ void pv_d0(f32x16* o, int vb, bf16x8 pa0, bf16x8 pa1, bf16x8 pa2, bf16x8 pa3) {
  pv_one<0>(o[0], vb, pa0, pa1, pa2, pa3); pv_one<1>(o[1], vb, pa0, pa1, pa2, pa3); pv_one<2>(o[2], vb, pa0, pa1, pa2, pa3); pv_one<3>(o[3], vb, pa0, pa1, pa2, pa3);
}
__device__ __forceinline__ void unit(const bf16* __restrict__ Qb0, const bf16* __restrict__ Kh0, const bf16* __restrict__ Vh, bf16_t* Ob, int seq, char* lds, const int tid_in, const float lam, const float onem, const float* __restrict__ subw) {
#pragma unroll 1
 for (int mp = 0; mp < 2; ++mp) {
  int tid = tid_in; asm volatile("" : "+v"(tid));
  bf16_t* stage = (bf16_t*)(lds + SHM_ATTN) + (tid >> 6) * 4096;
  const bf16* Qb = Qb0 + mp * 64; const bf16* Kh = Kh0 + mp * 64;
  const int wid = __builtin_amdgcn_readfirstlane(tid >> 6), lane = tid & 63, r32 = lane & 31, hi = lane >> 5;
  char* V_lds = lds; char* K_lds = lds + 2 * SHM_V;
  float* ws = (float*)(lds + 2 * SHM_V + 2 * SHM_K) + wid * 64; float* li_l = ws; float* al_l = ws + 32;
  float m_reg = -1e30f, l_reg = 0; f32x16 o[4]; bf16x8 qr[4];
#pragma unroll
  for (int d = 0; d < 4; ++d)
#pragma unroll
    for (int r = 0; r < 16; ++r) o[d][r] = 0.f;
  const bf16* Qw = Qb + (long)(wid * QBLK + r32) * LDQ + hi * 8;
#pragma unroll
  for (int d0 = 0; d0 < 4; ++d0) qr[d0] = *reinterpret_cast<const bf16x8*>(Qw + d0 * 16);
  const int sr = tid >> 4, sc = (tid & 15) * 8, vst0 = v_st(sr, sc), vst1 = v_st(32 + sr, sc);
  const int kr = tid >> 3, kc = (tid & 7) * 8, kst = A128_KSWZ(kr, kc * 2);
  const int vb0 = (int)(uintptr_t)V_lds + v_rd_base(lane);
  struct { bf16x8 vs0, vs1, ks0; } sr_[2];
#define A128_SLOAD(i, k0) do { sr_[i].vs0 = *reinterpret_cast<const bf16x8*>(&Vh[(long)((k0) + sr) * LDK + sc]); sr_[i].vs1 = *reinterpret_cast<const bf16x8*>(&Vh[(long)((k0) + 32 + sr) * LDK + sc]); \
    sr_[i].ks0 = *reinterpret_cast<const bf16x8*>(&Kh[(long)((k0) + kr) * LDK + kc]); } while (0)
#define A128_SWRITE(b, i) do { *(bf16x8*)(V_lds + (b) * SHM_V + vst0) = sr_[i].vs0; *(bf16x8*)(V_lds + (b) * SHM_V + vst1) = sr_[i].vs1; *(bf16x8*)(K_lds + (b) * SHM_K + kst) = sr_[i].ks0; } while (0)
#define A128_SWAIT() asm volatile("s_waitcnt vmcnt(3)" ::: "memory")
#define A128_RESC(a) do { if (__any((a) < 1.f)) { if (hi == 0) al_l[r32] = (a); asm volatile("s_waitcnt lgkmcnt(0)" ::: "memory"); \
    _Pragma("unroll") for (int d = 0; d < 4; ++d) _Pragma("unroll") for (int r = 0; r < 16; ++r) o[d][r] *= al_l[crow(r, hi)]; } } while (0)
  f32x16 pA0, pA1, pB0, pB1; float mnA, mnB, alA, alB; bf16x8 pa0, pa1, pa2, pa3; const int NT = seq / KVBLK;
  A128_SLOAD(0, 0); asm volatile("s_waitcnt vmcnt(0)" ::: "memory"); A128_SWRITE(0, 0); __syncthreads();
  qkt(pA0, pA1, K_lds, qr, r32, hi); partialSM(pA0, pA1, m_reg, mnA, alA);
  A128_SLOAD(1, KVBLK); if (2 < NT) A128_SLOAD(0, 2 * KVBLK);
  A128_SWAIT(); A128_SWRITE(1, 1); __syncthreads();
  for (int j = 1; j + 1 < NT; j += 2) {
    A128_SBAR(); qkt(pB0, pB1, K_lds + SHM_K, qr, r32, hi);
    finishSM(pA0, pA1, alA, l_reg, pa0, pa1, pa2, pa3); A128_SBAR();
    A128_SLOAD(1, (j + 2) * KVBLK); A128_SBAR();
    pv_d0(o, vb0, pa0, pa1, pa2, pa3); partialSM(pB0, pB1, m_reg, mnB, alB);
    __syncthreads(); A128_SWAIT(); A128_SWRITE(0, 0);
    A128_RESC(alB); __syncthreads();
    A128_SBAR(); qkt(pA0, pA1, K_lds, qr, r32, hi);
    finishSM(pB0, pB1, alB, l_reg, pa0, pa1, pa2, pa3); A128_SBAR();
    if (j + 3 < NT) A128_SLOAD(0, (j + 3) * KVBLK); A128_SBAR();
    pv_d0(o, vb0 + (int)SHM_V, pa0, pa1, pa2, pa3); partialSM(pA0, pA1, m_reg, mnA, alA);
    __syncthreads(); A128_SWAIT(); A128_SWRITE(1, 1);
    A128_RESC(alA); __syncthreads();
  }
  A128_SBAR(); qkt(pB0, pB1, K_lds + SHM_K, qr, r32, hi);
  finishSM(pA0, pA1, alA, l_reg, pa0, pa1, pa2, pa3); A128_SBAR();
  pv_d0(o, vb0, pa0, pa1, pa2, pa3); partialSM(pB0, pB1, m_reg, mnB, alB);
  __syncthreads(); A128_RESC(alB);
  finishSM(pB0, pB1, alB, l_reg, pa0, pa1, pa2, pa3); A128_SBAR();
  pv_d0(o, vb0 + (int)SHM_V, pa0, pa1, pa2, pa3);
  if (hi == 0) li_l[r32] = l_reg; asm volatile("s_waitcnt lgkmcnt(0)" ::: "memory");
  float rli[16];
#pragma unroll
  for (int r = 0; r < 16; ++r) rli[r] = __builtin_amdgcn_rcpf(li_l[crow(r, hi)]);
  if (mp == 0) {
#pragma unroll
    for (int r = 0; r < 16; ++r)
#pragma unroll
      for (int d0 = 0; d0 < 4; ++d0) stage[(r * 4 + d0) * 64 + lane] = (bf16_t)(cvt_pk_bf16(o[d0][r] * rli[r], 0.f) & 0xffffu);
  } else {
    float ss[16];
#pragma unroll
    for (int r = 0; r < 16; ++r) { float q = 0.f;
#pragma unroll
      for (int d0 = 0; d0 < 4; ++d0) { const float a = bf1(stage[(r * 4 + d0) * 64 + lane]) - lam * bf1((bf16_t)(cvt_pk_bf16(o[d0][r] * rli[r], 0.f) & 0xffffu)); o[d0][r] = a; q += a * a; }
      ss[r] = q; }
#pragma unroll
    for (int m = 1; m < 32; m <<= 1)
#pragma unroll
      for (int r = 0; r < 16; ++r) ss[r] += __int_as_float(__builtin_amdgcn_ds_bpermute((lane ^ m) << 2, __float_as_int(ss[r])));
    float sw[4];
#pragma unroll
    for (int d0 = 0; d0 < 4; ++d0) sw[d0] = subw[d0 * 32 + r32] * onem;
    bf16_t* Ow = Ob + (long)(wid * QBLK) * LDOB;
#pragma unroll
    for (int r = 0; r < 16; ++r) { const int orow = crow(r, hi); const float rs = 1.0f / sqrtf(ss[r] * (1.f / 128.f) + RMS_EPS);
#pragma unroll
      for (int d0 = 0; d0 < 4; ++d0) Ow[(long)orow * LDOB + d0 * 32 + r32] = (bf16_t)(cvt_pk_bf16(o[d0][r] * rs * sw[d0], 0.f) & 0xffffu); }
  }
  __syncthreads();
 }
#undef A128_SLOAD
#undef A128_SWRITE
#undef A128_SWAIT
#undef A128_RESC
}
#undef A128_KSWZ
#undef A128_SBAR
}

#define XB_TMO      128
#define XB_XCNT(j)  (256  + 64 * (j))
#define XB_XSUB(j)  (1280 + 64 * (j))
#define XB_XGEN(j)  (2304 + 64 * (j))
#define XB_TOP      3328
#define XB_TOPGEN   3392
#define XCD_BAR_WORDS 3456
#define XB_SPIN_CAP (1u << 18)
__device__ __forceinline__ unsigned xb_ld(unsigned* p)              { return __hip_atomic_load(p, __ATOMIC_RELAXED, __HIP_MEMORY_SCOPE_AGENT); }
__device__ __forceinline__ unsigned xb_add(unsigned* p, unsigned v) { return __hip_atomic_fetch_add(p, v, __ATOMIC_RELAXED, __HIP_MEMORY_SCOPE_AGENT); }
__device__ __forceinline__ unsigned xb_xcc_id() { return (unsigned)__builtin_amdgcn_s_getreg((3 << 11) | 20) & 0xFu; }
#define XB_SPIN(cond, bar) do { unsigned _sp = 0; while (cond) { __builtin_amdgcn_s_sleep(1); \
    if ((++_sp & 255u) == 0u) { if (xb_ld(&(bar)[XB_TMO])) break; if (_sp > XB_SPIN_CAP) { atomicAdd(&(bar)[XB_TMO], 1u); break; } } } } while (0)
struct XcdBarrier { unsigned* bar; unsigned x; volatile LAS unsigned* st; };
__device__ __forceinline__ XcdBarrier xcd_barrier_post(unsigned* bar, volatile LAS unsigned* st) {
    XcdBarrier b; b.bar = bar; b.x = xb_xcc_id(); b.st = st;
    if (threadIdx.x == 0) (void)xb_add(&bar[XB_XCNT(b.x)], 1u);
    return b;
}
__device__ __forceinline__ void xcd_barrier_complete(unsigned* bar, unsigned x, unsigned& nloc, unsigned& nx) {
    const unsigned G = gridDim.x * gridDim.y * gridDim.z;
    unsigned sum, cnt, mine, sp = 0u;
    for (;;) {
        sum = 0u; cnt = 0u; mine = 0u;
#pragma unroll
        for (unsigned j = 0; j < 16; ++j) { const unsigned c = xb_ld(&bar[XB_XCNT(j)]); sum += c; cnt += (c > 0u) ? 1u : 0u; mine = (j == x) ? c : mine; }
        if (sum == G) break;
        __builtin_amdgcn_s_sleep(1);
        if ((++sp & 255u) == 0u) { if (xb_ld(&bar[XB_TMO])) break; if (sp > XB_SPIN_CAP) { atomicAdd(&bar[XB_TMO], 1u); break; } }
    }
    nloc = mine > 0u ? mine : 1u; nx = cnt > 0u ? cnt : 1u;
}
__device__ __forceinline__ void xcd_barrier(const XcdBarrier& b, const int tid) {
    asm volatile("s_waitcnt vmcnt(0)" ::: "memory");
    __syncthreads();
    if (tid == 0) {
        unsigned* bar = b.bar;
        __builtin_amdgcn_s_waitcnt(0);
        unsigned nloc = b.st[0], nx = b.st[1];
        if (nloc == 0u) { xcd_barrier_complete(bar, b.x, nloc, nx); b.st[0] = nloc; b.st[1] = nx; }
        const unsigned old = xb_add(&bar[XB_XSUB(b.x)], 1u);
        const unsigned gen = old / nloc;
        if (old + 1u == (gen + 1u) * nloc) {
            __builtin_amdgcn_fence(__ATOMIC_RELEASE, "agent");
            asm volatile("s_waitcnt vmcnt(0)" ::: "memory");
            const unsigned og = xb_add(&bar[XB_TOP], 1u);
            const unsigned tg = og / nx;
            if (og + 1u == (tg + 1u) * nx) xb_add(&bar[XB_TOPGEN], 1u);
            else XB_SPIN(xb_ld(&bar[XB_TOPGEN]) == tg, bar);
            __builtin_amdgcn_fence(__ATOMIC_ACQUIRE, "agent");
            xb_add(&bar[XB_XGEN(b.x)], 1u);
            asm volatile("s_waitcnt vmcnt(0)" ::: "memory");
        } else {
            XB_SPIN(xb_ld(&bar[XB_XGEN(b.x)]) == gen, bar);
            __builtin_amdgcn_fence(__ATOMIC_ACQUIRE, "agent");
            asm volatile("s_waitcnt vmcnt(0)" ::: "memory");
        }
    }
    __syncthreads();
}

constexpr int NWAVES = 8;
constexpr int RING_OFF = 0, RING_BYTES = 131072;
constexpr int LDSCTL_OFF = RING_BYTES, MISC_OFF = LDSCTL_OFF + 320;
constexpr int LDS_BYTES = 147456;
static_assert(attn128::SHM_TOTAL <= (size_t)RING_BYTES, "attention scratch fits the ring");

struct Args { const float* in[32]; float* out; unsigned char* ws; int ph_lo, ph_hi; };
constexpr int INTAB_OFF = LDSCTL_OFF + 1024;
__device__ __forceinline__ const float* inptr(LAS unsigned char* lds, int i) {
    const unsigned long long v = ((const LAS unsigned long long*)(lds + INTAB_OFF))[i];
    const unsigned lo = __builtin_amdgcn_readfirstlane((unsigned)v), hi = __builtin_amdgcn_readfirstlane((unsigned)(v >> 32));
    return (const float*)(GAS const float*)(((unsigned long long)hi << 32) | lo);
}
#define INP(i) inptr(F.lds, (i))
struct Frame {
    LAS unsigned char* lds; int tid, lane, wave, vcu, G, gw, NGW;
    unsigned char* ws;
};
enum { I_X = 0, I_C, I_CTX, I_CCTX, I_WMOD, I_BMOD, I_LNG, I_LNB, I_W1, I_W3, I_W2, I_WIN, I_ALAM, I_ASUB, I_CONVW, I_CONVB, I_ALOG, I_DTB, I_SSDD, I_SSDN,
       I_LRE, I_LIM, I_LSTEP, I_BRE, I_BIM, I_CRE, I_CIM, I_S5D, I_GLUW, I_GLUB, I_WBR, I_WOUT };

__device__ __forceinline__ void transpose_item64(const float* srcA, const float* srcB, int ldn, bool ffn, bf16_t* dst, int ldk, LAS bf16_t* scr  , int lane) {
    const int q = lane & 15, kr = lane >> 4; const bool isB = q >= 8; const int c = (q & 7) * 4; const float* src = isB ? srcB : srcA;
    f32x4 v[16];
#pragma unroll
    for (int i = 0; i < 16; ++i) v[i] = src ? *(const f32x4*)(src + (size_t)(4 * i + kr) * ldn + c) : (f32x4){0.f, 0.f, 0.f, 0.f};
    const int drow = ffn ? (32 * (c >> 4) + (c & 15) + (isB ? 16 : 0)) : (c + (isB ? 32 : 0));
#pragma unroll
    for (int i = 0; i < 16; ++i) { const int k = 4 * i + kr; const unsigned p01 = cvt_pk_bf16(v[i][0], v[i][1]), p23 = cvt_pk_bf16(v[i][2], v[i][3]);
        scr[(drow + 0) * 72 + k] = (bf16_t)(p01 & 0xffffu); scr[(drow + 1) * 72 + k] = (bf16_t)(p01 >> 16); scr[(drow + 2) * 72 + k] = (bf16_t)(p23 & 0xffffu); scr[(drow + 3) * 72 + k] = (bf16_t)(p23 >> 16); }
    LDS_WAIT(); asm volatile("" ::: "memory");
    const int c8 = lane & 7;
#pragma unroll
    for (int jj = 0; jj < 8; ++jj) { const int n = (lane >> 3) + 8 * jj; *(u32x4*)(dst + (size_t)n * ldk + 8 * c8) = *(const LAS u32x4*)(scr + n * 72 + 8 * c8); }
    LDS_WAIT(); asm volatile("" ::: "memory");
}
__device__ __forceinline__ void convert_layer_weights(const Args& A_, Frame& F, int l) {
    LAS bf16_t* scr = (LAS bf16_t*)(F.lds + RING_OFF + F.wave * 16384);
    unsigned char* W = F.ws + WS_W;
    constexpr int I13 = 32 * 176, I2 = 88 * 32, IIN = 32 * 212, IB = 16 * 32, IO = 32 * 32, IG = 16 * 16;
    constexpr int NIT = 2 * I13 + 2 * I2 + IIN + 3 * IB + IO + IG;
    for (int it = F.gw; it < NIT; it += F.NGW) {
        int r = it;
        if (r < 2 * I13) { const int f = r / I13; r -= f * I13; const int kb = r / 176, nb = r % 176;
            const float* w1 = INP(I_W1) + ((size_t)(l * 2 + f) * D + 64 * kb) * DFF + 32 * nb; const float* w3 = INP(I_W3) + ((size_t)(l * 2 + f) * D + 64 * kb) * DFF + 32 * nb;
            transpose_item64(w1, w3, DFF, true, (bf16_t*)(W + W_13) + ((size_t)f * N13 + 64 * nb) * D + 64 * kb, D, scr, F.lane); continue; }
        r -= 2 * I13;
        if (r < 2 * I2) { const int f = r / I2; r -= f * I2; const int kb = r / 32, nb = r % 32;
            const float* w2 = INP(I_W2) + ((size_t)(l * 2 + f) * DFF + 64 * kb) * D + 64 * nb;
            transpose_item64(w2, w2 + 32, D, false, (bf16_t*)(W + W_2) + ((size_t)f * D + 64 * nb) * DFF + 64 * kb, DFF, scr, F.lane); continue; }
        r -= 2 * I2;
        if (r < IIN) { const int kb = r / 212, nb = r % 212; const int n0 = 64 * nb; const float* wb = INP(I_WIN) + ((size_t)l * D + 64 * kb) * 13344;
            const float* sa = nullptr; const float* sb = nullptr;
            if (n0 < 6144) { sa = wb + n0; sb = sa + 32; } else if (n0 < 13312) { sa = wb + n0 + 32; sb = sa + 32; } else if (n0 == 13312) { sa = wb + 6144; }
            transpose_item64(sa, sb, 13344, false, (bf16_t*)(W + W_IN) + (size_t)n0 * D + 64 * kb, D, scr, F.lane); continue; }
        r -= IIN;
        if (r < 3 * IB) { const int jb = r / IB; r -= jb * IB; const int kb = r / 32, nb = r % 32;
            const float* w = INP(I_WBR) + ((size_t)(l * 3 + jb) * 1024 + 64 * kb) * D + 64 * nb;
            const int sp = (jb == 0) ? 0 : (jb == 1 ? 2 : 1); transpose_item64(w, w + 32, D, false, (bf16_t*)(W + W_B) + (size_t)(64 * nb) * 3072 + sp * 1024 + 64 * kb, 3072, scr, F.lane); continue; }
        r -= 3 * IB;
        if (r < IO) { const int kb = r / 32, nb = r % 32; const float* w = INP(I_WOUT) + ((size_t)l * D + 64 * kb) * D + 64 * nb;
            transpose_item64(w, w + 32, D, false, (bf16_t*)(W + W_O) + (size_t)(64 * nb) * D + 64 * kb, D, scr, F.lane); continue; }
        r -= IO;
        { const int kb = r / 16, nb = r % 16; const float* w = INP(I_GLUW) + ((size_t)l * 1024 + 64 * kb) * 1024 + 64 * nb;
            transpose_item64(w, w + 32, 1024, false, (bf16_t*)(W + W_GLU) + (size_t)(64 * nb) * 1024 + 64 * kb, 1024, scr, F.lane); }
    }
}
__device__ __forceinline__ void mod_partials(const Args& A_, Frame& F) {
    float* MODw = (float*)(F.ws + WS_MOD);
    LAS float* sl = (LAS float*)(F.lds + RING_OFF + 98304 + F.wave * 4096);
    const int nskip = (F.G > 64) ? 64 : 0; if ((int)blockIdx.x < nskip) return;
    for (int it = ((int)blockIdx.x - nskip) * NWAVES + F.wave; it < 2 * 72 * 16; it += (F.G - nskip) * NWAVES) {
        const int l = it / (72 * 16), r = it % (72 * 16), ks = r / 72, cg = r % 72;
        const int col = cg * 256 + F.lane * 4; const float* w = INP(I_WMOD) + ((size_t)l * D + ks * 128) * NMOD + col;
        const float* c = INP(I_C) + ks * 128; const float* cc = INP(I_CCTX) + ks * 128;
#pragma unroll
        for (int h = 0; h < 2; ++h) { const int k = F.lane + 64 * h;
            sl[0 * 128 + k] = siluf_(c[k]); sl[1 * 128 + k] = siluf_(c[D + k]); sl[2 * 128 + k] = siluf_(c[2 * D + k]); sl[3 * 128 + k] = siluf_(c[3 * D + k]); sl[4 * 128 + k] = siluf_(cc[k]); }
        LDS_WAIT(); asm volatile("" ::: "memory");
        f32x4 a0 = {0.f, 0.f, 0.f, 0.f}, a1 = a0, a2 = a0, a3 = a0, a4 = a0;
        for (int k0 = 0; k0 < 128; k0 += 16) {
            f32x4 wv[16];
#pragma unroll
            for (int e = 0; e < 16; ++e) wv[e] = *(const f32x4*)(w + (size_t)(k0 + e) * NMOD);
            asm volatile("s_waitcnt vmcnt(0)" ::: "memory");
#pragma unroll
            for (int e = 0; e < 16; ++e) { a0 += wv[e] * sl[0 * 128 + k0 + e]; a1 += wv[e] * sl[1 * 128 + k0 + e]; a2 += wv[e] * sl[2 * 128 + k0 + e]; a3 += wv[e] * sl[3 * 128 + k0 + e]; a4 += wv[e] * sl[4 * 128 + k0 + e]; }
        }
        const int r9 = col / D; const float sc = (r9 == 2 || r9 == 8) ? 0.5f : 1.0f;
        if (ks == 0) { const f32x4 bv = *(const f32x4*)(INP(I_BMOD) + (size_t)l * NMOD + col); a0 += bv; a1 += bv; a2 += bv; a3 += bv; a4 += bv; }
        float* o = MODw + (size_t)l * 5 * NMOD + col;
#pragma unroll
        for (int e = 0; e < 4; ++e) { unsafeAtomicAdd(o + e, a0[e] * sc); unsafeAtomicAdd(o + NMOD + e, a1[e] * sc); unsafeAtomicAdd(o + 2 * NMOD + e, a2[e] * sc); unsafeAtomicAdd(o + 3 * NMOD + e, a3[e] * sc); unsafeAtomicAdd(o + 4 * NMOD + e, a4[e] * sc); }
        LDS_WAIT(); asm volatile("" ::: "memory");
    }
}
__device__ __forceinline__ void ln_pass(Frame& F, bool do_ln, const float* lng, const float* lnb, const float* modnext  , float* out, const float* xin = nullptr, const float* cin = nullptr, int nslab = 0) {
    _Float16* H = (_Float16*)(F.ws + WS_H); const float* SL = (const float*)(F.ws + WS_YD); float* HC = (float*)(F.ws + WS_HC); bf16_t* HM = (bf16_t*)(F.ws + WS_HM); float* ST = (float*)(F.ws + WS_STATS);
    f32x4 G[8], Bv[8];
    if (do_ln) {
#pragma unroll
        for (int i = 0; i < 8; ++i) { G[i] = *(const f32x4*)(lng + 256 * i + 4 * F.lane); Bv[i] = *(const f32x4*)(lnb + 256 * i + 4 * F.lane); }
    }
    for (int row = F.gw; row < R; row += F.NGW) {
        const int b = row / RB, rr = row % RB; const bool isctx = rr < CTX; const int mi = isctx ? 4 : b;
        float* hc = HC + ((size_t)b * CTX + rr) * D; _Float16* hr = H + (size_t)row * D;
        f32x4 v[8], sh4[8], sc4[8]; float s = 0.f;
        if (xin) { const float* src = isctx ? cin + ((size_t)b * CTX + rr) * D : xin + ((size_t)b * SEQ + (rr - CTX)) * D;
#pragma unroll
            for (int i = 0; i < 8; ++i) v[i] = *(const f32x4*)(src + 256 * i + 4 * F.lane);
        } else if (isctx) {
#pragma unroll
            for (int i = 0; i < 8; ++i) v[i] = *(const f32x4*)(hc + 256 * i + 4 * F.lane);
            if (nslab) {
#pragma unroll 1
                for (int q = 0; q < 4; ++q) { f32x4 sv[8];
#pragma unroll
                    for (int i = 0; i < 8; ++i) sv[i] = *(const f32x4*)(SL + ((size_t)q * (NB * CTX) + (size_t)b * CTX + rr) * D + 256 * i + 4 * F.lane);
#pragma unroll
                    for (int i = 0; i < 8; ++i) v[i] = v[i] + sv[i]; } }
        } else {
#pragma unroll
            for (int i = 0; i < 8; ++i) v[i] = ld_h4(hr + 256 * i + 4 * F.lane);
        }
        if (modnext) { const float* sh = modnext + (size_t)mi * NMOD; const float* sc = sh + D;
#pragma unroll
            for (int i = 0; i < 8; ++i) { sh4[i] = *(const f32x4*)(sh + 256 * i + 4 * F.lane); sc4[i] = *(const f32x4*)(sc + 256 * i + 4 * F.lane); } }
        asm volatile("s_waitcnt vmcnt(0)" ::: "memory");
#pragma unroll
        for (int i = 0; i < 8; ++i) s += (v[i][0] + v[i][1]) + (v[i][2] + v[i][3]);
        if (do_ln) {
            const float mean = wave_sum(s, F.lane) * (1.f / D); float s2 = 0.f;
#pragma unroll
            for (int i = 0; i < 8; ++i) { v[i] = v[i] - mean; s2 += (v[i][0] * v[i][0] + v[i][1] * v[i][1]) + (v[i][2] * v[i][2] + v[i][3] * v[i][3]); }
            const float rstd = 1.0f / sqrtf(wave_sum(s2, F.lane) * (1.f / D) + LN_EPS);
            if (!isctx && F.lane == 0) *(f32x2*)(ST + (size_t)row * 2) = (f32x2){mean, rstd};
#pragma unroll
            for (int i = 0; i < 8; ++i) { v[i] = v[i] * rstd * G[i] + Bv[i]; if (isctx) *(f32x4*)(hc + 256 * i + 4 * F.lane) = v[i] * DN_ALPHA; }
        } else if (isctx) {
#pragma unroll
            for (int i = 0; i < 8; ++i) *(f32x4*)(hc + 256 * i + 4 * F.lane) = v[i] * DN_ALPHA;
        } else {
#pragma unroll
            for (int i = 0; i < 8; ++i) st_h4(hr + 256 * i + 4 * F.lane, v[i]);
            if (F.lane == 0) *(f32x2*)(ST + (size_t)row * 2) = (f32x2){0.f, 1.f};
        }
        if (modnext) {
#pragma unroll
            for (int i = 0; i < 8; ++i) { const f32x4 m = v[i] * (sc4[i] + 1.0f) + sh4[i];
                u32x2 w; w.x = cvt_pk_bf16(m[0], m[1]); w.y = cvt_pk_bf16(m[2], m[3]); *(u32x2*)(HM + (size_t)row * D + 256 * i + 4 * F.lane) = w; }
        }
        if (out && !isctx) { float* orow = out + ((size_t)b * SEQ + (rr - CTX)) * D;
#pragma unroll
            for (int i = 0; i < 8; ++i) *(f32x4*)(orow + 256 * i + 4 * F.lane) = v[i]; }
    }
}

__device__ __forceinline__ void dt_tile(Frame& F, int l, int tile) {
    const bf16_t* A = (const bf16_t*)(F.ws + WS_HM) + (size_t)tile * 32 * D; const bf16_t* Bt = (const bf16_t*)(F.ws + WS_W + W_IN) + (size_t)13312 * D; float* DT = (float*)(F.ws + WS_DT);
    const int r = F.lane & 31, h = F.lane >> 5;
    f32x16 acc;
#pragma unroll
    for (int i = 0; i < 16; ++i) acc[i] = 0.f;
    const bf16_t* ap = A + (size_t)r * D + 8 * h; const bf16_t* bp = Bt + (size_t)r * D + 8 * h;
    for (int k0 = 0; k0 < 128; k0 += 16) {
        bf16x8 af[16], bfv[16];
#pragma unroll
        for (int e = 0; e < 16; ++e) { af[e] = *(const bf16x8*)(ap + 16 * (k0 + e)); bfv[e] = *(const bf16x8*)(bp + 16 * (k0 + e)); }
#pragma unroll
        for (int e = 0; e < 16; ++e) acc = __builtin_amdgcn_mfma_f32_32x32x16_bf16(af[e], bfv[e], acc, 0, 0, 0);
    }
    const float bias = INP(I_DTB)[l * 32 + r];
#pragma unroll
    for (int rg = 0; rg < 16; ++rg) { const int row = tile * 32 + (rg & 3) + 8 * (rg >> 2) + 4 * h; const float x = acc[rg] + bias; DT[(size_t)row * 32 + r] = fmaxf(x, 0.f) + log1pf(expf(-fabsf(x))); }
}
__device__ __forceinline__ void ssd_conv_pass(const Args& A_, Frame& F, int l) {
    const bf16_t* P = (const bf16_t*)(F.ws + WS_PROJ); bf16_t* XC = (bf16_t*)(F.ws + WS_HM);
    const float* cw = INP(I_CONVW) + (size_t)l * 5 * 2048; const float* cb = INP(I_CONVB) + (size_t)l * 2048;
    for (int it = F.gw; it < (R / 8) * 4; it += F.NGW) {
        const int r0 = (it >> 2) * 8, c0 = (it & 3) * 512 + F.lane * 8; const int rr0 = r0 % RB; const int lo = (rr0 < CTX) ? 0 : CTX, hi = (rr0 < CTX) ? CTX : RB;
        u32x4 x[12];
#pragma unroll
        for (int h = 0; h < 12; ++h) { const int r2 = rr0 + h - 2; x[h] = (r2 >= lo && r2 < hi) ? *(const u32x4*)(P + (size_t)(r0 + h - 2) * LDP + PX + c0) : (u32x4){0u, 0u, 0u, 0u}; }
        f32x4 w0[5], w1[5];
#pragma unroll
        for (int k = 0; k < 5; ++k) { w0[k] = *(const f32x4*)(cw + k * 2048 + c0); w1[k] = *(const f32x4*)(cw + k * 2048 + c0 + 4); }
        const f32x4 b0 = *(const f32x4*)(cb + c0), b1 = *(const f32x4*)(cb + c0 + 4);
#pragma unroll
        for (int jr = 0; jr < 8; ++jr) { f32x4 a0 = b0, a1 = b1;
#pragma unroll
            for (int k = 0; k < 5; ++k) { const u32x4 xv = x[jr + k];
                a0[0] += w0[k][0] * bflo(xv.x); a0[1] += w0[k][1] * bfhi(xv.x); a0[2] += w0[k][2] * bflo(xv.y); a0[3] += w0[k][3] * bfhi(xv.y);
                a1[0] += w1[k][0] * bflo(xv.z); a1[1] += w1[k][1] * bfhi(xv.z); a1[2] += w1[k][2] * bflo(xv.w); a1[3] += w1[k][3] * bfhi(xv.w); }
            u32x4 o; o.x = cvt_pk_bf16(siluf_(a0[0]), siluf_(a0[1])); o.y = cvt_pk_bf16(siluf_(a0[2]), siluf_(a0[3])); o.z = cvt_pk_bf16(siluf_(a1[0]), siluf_(a1[1])); o.w = cvt_pk_bf16(siluf_(a1[2]), siluf_(a1[3]));
            *(u32x4*)(XC + (size_t)(r0 + jr) * 2048 + c0) = o; }
    }
}
__device__ __forceinline__ int scan_row(int rb, int d, int step) { return d == 0 ? rb + step : (step < CTX ? rb + CTX - 1 - step : rb + (RB + CTX - 1) - step); }

__device__ __forceinline__ unsigned short bf16_1(float v) { return (unsigned short)(cvt_pk_bf16(v, 0.f) & 0xffffu); }
__device__ __forceinline__ void ssd_chain_fast(const Args& A_, Frame& F, int l, int cid) {
    constexpr int LS = 136;
    const int b = cid >> 6, d = (cid >> 5) & 1, hd = (cid >> 1) & 15, ph = cid & 1, g = hd >> 2; const int rb = b * RB;
    const bf16_t* XC = (const bf16_t*)(F.ws + WS_HM); const float* DT = (const float*)(F.ws + WS_DT); bf16_t* YD = (bf16_t*)(F.ws + WS_YD) + (size_t)d * R * 1024;
    const float a = -expf(INP(I_ALOG)[l * 32 + d * 16 + hd]);
    LAS bf16_t* Cs = (LAS bf16_t*)(F.lds); LAS bf16_t* Bs = Cs + 128 * LS; LAS bf16_t* Ms = Bs + 128 * LS; LAS bf16_t* XdT = Ms + 128 * LS; LAS bf16_t* Hb = XdT + 32 * LS;
    LAS float* csL = (LAS float*)(Hb + 32 * LS); LAS float* ecsL = csL + 128; LAS float* ewL = ecsL + 128; LAS float* misc = ewL + 128;
    const int tid = F.tid, lane = F.lane, w = F.wave, r = lane & 31, h = lane >> 5;
    f32x16 hacc;
#pragma unroll
    for (int i = 0; i < 16; ++i) hacc[i] = 0.f;
    for (int i = tid; i < 32 * LS / 2; i += 512) ((LAS unsigned*)Hb)[i] = 0u;
    u32x4 pc[4], pb[4], px; float pdt, pv0 = 0.f, pv1 = 0.f;
    const int rho0 = d ? 127 - lane : lane, rho1 = d ? 63 - lane : 64 + lane;
#define SSD_R0(k_) ((d == 0) ? rb + 128 * (k_) : ((k_) < 2 ? rb + 128 * (1 - (k_)) : rb + 256 + 128 * (33 - (k_))))
#define SSD_ISSUE(k_) do { const int r0n = SSD_R0(k_); \
        _Pragma("unroll") for (int i = 0; i < 4; ++i) { const int item = tid + 512 * i, row = item >> 4, seg = item & 15; const bf16_t* src = XC + (size_t)(r0n + row) * 2048 + g * 128 + seg * 8; pc[i] = *(const u32x4*)(src + 1536); pb[i] = *(const u32x4*)(src + 1024); } \
        { const int row = tid >> 2, seg = tid & 3; pdt = DT[(size_t)(r0n + row) * 32 + d * 16 + hd]; px = *(const u32x4*)(XC + (size_t)(r0n + row) * 2048 + hd * 64 + ph * 32 + seg * 8); } \
        if (w == 0) { pv0 = DT[(size_t)(r0n + rho0) * 32 + d * 16 + hd]; pv1 = DT[(size_t)(r0n + rho1) * 32 + d * 16 + hd]; } } while (0)
    SSD_ISSUE(0);
    unsigned ypk[8]; int yrow = -1;
#pragma unroll
    for (int i = 0; i < 8; ++i) ypk[i] = 0u;
#define SSD_YFLUSH() do { if (w < 4 && yrow >= 0) { bf16_t* yo = YD + (size_t)yrow * 1024 + hd * 64 + ph * 32 + r; \
        _Pragma("unroll") for (int rg = 0; rg < 16; ++rg) yo[(size_t)((rg & 3) + 8 * (rg >> 2)) * 1024] = (bf16_t)((rg & 1) ? (ypk[rg >> 1] >> 16) : (ypk[rg >> 1] & 0xffffu)); } } while (0)
    for (int k = 0; k < 34; ++k) {
        const int r0 = SSD_R0(k);
        __syncthreads();
#pragma unroll
        for (int i = 0; i < 4; ++i) { const int item = tid + 512 * i, row = item >> 4, seg = item & 15; *(LAS u32x4*)(Cs + row * LS + seg * 8) = pc[i]; *(LAS u32x4*)(Bs + row * LS + seg * 8) = pb[i]; }
        { const int row = tid >> 2, seg = tid & 3; const float dtv = pdt; const u32x4 xv = px;
            LAS bf16_t* xo = XdT + (seg * 8) * LS + row;
            xo[0 * LS] = bf16_1(bflo(xv.x) * dtv); xo[1 * LS] = bf16_1(bfhi(xv.x) * dtv); xo[2 * LS] = bf16_1(bflo(xv.y) * dtv); xo[3 * LS] = bf16_1(bfhi(xv.y) * dtv);
            xo[4 * LS] = bf16_1(bflo(xv.z) * dtv); xo[5 * LS] = bf16_1(bfhi(xv.z) * dtv); xo[6 * LS] = bf16_1(bflo(xv.w) * dtv); xo[7 * LS] = bf16_1(bfhi(xv.w) * dtv); }
        if (w == 0) {
            float v0 = pv0 * a, v1 = pv1 * a;
#pragma unroll
            for (int o = 1; o < 64; o <<= 1) { const float t0 = __int_as_float(__builtin_amdgcn_ds_bpermute((lane - o) << 2, __float_as_int(v0))), t1 = __int_as_float(__builtin_amdgcn_ds_bpermute((lane - o) << 2, __float_as_int(v1))); if (lane >= o) { v0 += t0; v1 += t1; } }
            const float tot0 = __int_as_float(__builtin_amdgcn_ds_bpermute(63 << 2, __float_as_int(v0))); v1 += tot0;
            const float cend = __int_as_float(__builtin_amdgcn_ds_bpermute(63 << 2, __float_as_int(v1)));
            csL[rho0] = v0; csL[rho1] = v1; ecsL[rho0] = __builtin_amdgcn_exp2f(v0 * 1.4426950408889634f); ecsL[rho1] = __builtin_amdgcn_exp2f(v1 * 1.4426950408889634f);
            ewL[rho0] = __builtin_amdgcn_exp2f((cend - v0) * 1.4426950408889634f); ewL[rho1] = __builtin_amdgcn_exp2f((cend - v1) * 1.4426950408889634f);
            if (lane == 0) misc[0] = __builtin_amdgcn_exp2f(cend * 1.4426950408889634f);
        }
        if (k + 1 < 34) SSD_ISSUE(k + 1);
        __syncthreads();
        { const int lt = w >> 1;
#pragma unroll
          for (int q = 0; q < 2; ++q) { const int st = (w & 1) * 2 + q; const bool zero = (d == 0) ? (st > lt) : (st < lt);
            f32x16 acc;
#pragma unroll
            for (int i = 0; i < 16; ++i) acc[i] = 0.f;
            if (!zero) { bf16x8 af[8], bfv[8];
#pragma unroll
                for (int ks = 0; ks < 8; ++ks) { af[ks] = *(const LAS bf16x8*)(Cs + (32 * lt + r) * LS + 16 * ks + 8 * h); bfv[ks] = *(const LAS bf16x8*)(Bs + (32 * st + r) * LS + 16 * ks + 8 * h); }
#pragma unroll
                for (int ks = 0; ks < 8; ++ks) acc = __builtin_amdgcn_mfma_f32_32x32x16_bf16(af[ks], bfv[ks], acc, 0, 0, 0); }
            const int scol = 32 * st + r; const float css = csL[scol];
            f32x4 cr4[4];
#pragma unroll
            for (int q4 = 0; q4 < 4; ++q4) cr4[q4] = *(const LAS f32x4*)(csL + 32 * lt + 8 * q4 + 4 * h);
#pragma unroll
            for (int rg = 0; rg < 16; ++rg) { const int lrow = 32 * lt + (rg & 3) + 8 * (rg >> 2) + 4 * h; const bool valid = (d == 0) ? (scol <= lrow) : (scol >= lrow);
                const float ex = __builtin_amdgcn_exp2f(fminf(cr4[rg >> 2][rg & 3] - css, 0.f) * 1.4426950408889634f);
                const float v = valid ? acc[rg] * ex : 0.f; Ms[lrow * LS + scol] = bf16_1(v); } } }
        __syncthreads();
        if (w < 4) { const int lt = w;
            f32x16 acc;
#pragma unroll
            for (int i = 0; i < 16; ++i) acc[i] = 0.f;
            { bf16x8 af[8], bfv[8];
#pragma unroll
              for (int ks = 0; ks < 8; ++ks) { af[ks] = *(const LAS bf16x8*)(Cs + (32 * lt + r) * LS + 16 * ks + 8 * h); bfv[ks] = *(const LAS bf16x8*)(Hb + r * LS + 16 * ks + 8 * h); }
#pragma unroll
              for (int ks = 0; ks < 8; ++ks) acc = __builtin_amdgcn_mfma_f32_32x32x16_bf16(af[ks], bfv[ks], acc, 0, 0, 0); }
            { f32x4 e4[4];
#pragma unroll
              for (int q4 = 0; q4 < 4; ++q4) e4[q4] = *(const LAS f32x4*)(ecsL + 32 * lt + 8 * q4 + 4 * h);
#pragma unroll
              for (int rg = 0; rg < 16; ++rg) acc[rg] *= e4[rg >> 2][rg & 3]; }
            { bf16x8 af[8], bfv[8];
#pragma unroll
              for (int ks = 0; ks < 8; ++ks) { af[ks] = *(const LAS bf16x8*)(Ms + (32 * lt + r) * LS + 16 * ks + 8 * h); bfv[ks] = *(const LAS bf16x8*)(XdT + r * LS + 16 * ks + 8 * h); }
#pragma unroll
              for (int ks = 0; ks < 8; ++ks) { const bool skip = (d == 0) ? (16 * ks >= 32 * (lt + 1)) : (16 * ks + 15 < 32 * lt);
                  if (!skip) acc = __builtin_amdgcn_mfma_f32_32x32x16_bf16(af[ks], bfv[ks], acc, 0, 0, 0); } }
            bf16_t* yo = YD + (size_t)(r0 + 32 * lt + 4 * h) * 1024 + hd * 64 + ph * 32 + r;
#pragma unroll
            for (int rg = 0; rg < 16; ++rg) yo[(size_t)((rg & 3) + 8 * (rg >> 2)) * 1024] = bf16_1(acc[rg]);
        } else { const int nt = w - 4; const float eend = misc[0];
#pragma unroll
            for (int i = 0; i < 16; ++i) hacc[i] *= eend;
            { typedef short v4i16_t_ __attribute__((ext_vector_type(4)));
#pragma unroll
              for (int kh = 0; kh < 2; ++kh) {
              u32x4 xa[8]; f32x4 e0[8], e1[8]; s16x4 t0[8], t1[8];
#pragma unroll
              for (int ks = 4 * kh; ks < 4 * kh + 4; ++ks) { const int k0 = 16 * ks + 8 * h; xa[ks] = *(const LAS u32x4*)(XdT + r * LS + k0); e0[ks] = *(const LAS f32x4*)(ewL + k0); e1[ks] = *(const LAS f32x4*)(ewL + k0 + 4);
                  const LAS bf16_t* tb = Bs + (k0 + ((lane & 15) >> 2)) * LS + 32 * nt + 16 * ((lane >> 4) & 1) + 4 * (lane & 3);
                  t0[ks] = __builtin_bit_cast(s16x4, __builtin_amdgcn_ds_read_tr16_b64_v4i16((LAS v4i16_t_*)tb)); t1[ks] = __builtin_bit_cast(s16x4, __builtin_amdgcn_ds_read_tr16_b64_v4i16((LAS v4i16_t_*)(tb + 4 * LS))); }
#pragma unroll
              for (int ks = 4 * kh; ks < 4 * kh + 4; ++ks) { u32x4 aw;
                  aw.x = cvt_pk_bf16(bflo(xa[ks].x) * e0[ks][0], bfhi(xa[ks].x) * e0[ks][1]); aw.y = cvt_pk_bf16(bflo(xa[ks].y) * e0[ks][2], bfhi(xa[ks].y) * e0[ks][3]); aw.z = cvt_pk_bf16(bflo(xa[ks].z) * e1[ks][0], bfhi(xa[ks].z) * e1[ks][1]); aw.w = cvt_pk_bf16(bflo(xa[ks].w) * e1[ks][2], bfhi(xa[ks].w) * e1[ks][3]);
                  const bf16x8 bw = (bf16x8){t0[ks][0], t0[ks][1], t0[ks][2], t0[ks][3], t1[ks][0], t1[ks][1], t1[ks][2], t1[ks][3]};
                  hacc = __builtin_amdgcn_mfma_f32_32x32x16_bf16(__builtin_bit_cast(bf16x8, aw), bw, hacc, 0, 0, 0); } } }
        }
        __syncthreads();
        if (w >= 4) { const int nt = w - 4;
#pragma unroll
            for (int rg = 0; rg < 16; ++rg) Hb[((rg & 3) + 8 * (rg >> 2) + 4 * h) * LS + 32 * nt + r] = bf16_1(hacc[rg]); }
    }
    __syncthreads();
#undef SSD_R0
#undef SSD_ISSUE
#undef SSD_YFLUSH
}
__device__ __forceinline__ void s5_setup(const Args& A_, Frame& F, int l, int boff = 0) {
    LAS float* Pre = (LAS float*)(F.lds); LAS float* Pim = Pre + 2 * 17 * 64; LAS float* BBr = Pim + 2 * 17 * 64; LAS float* BBi = BBr + 2 * 64 * 16; LAS float* Kt = BBi + 2 * 64 * 16;
    LAS float* CrL = Kt + 8192; LAS float* CiL = CrL + 2048;
    bf16_t* Bt1 = (bf16_t*)(F.ws + WS_S5M); bf16_t* Bt2 = Bt1 + (size_t)64 * 512 * 256; float* A16 = (float*)(F.ws + WS_S5A);
    const int tid = F.tid;
    for (int g = (int)blockIdx.x - boff; g >= 0 && g < 64; g += F.G) {
        { f32x4 c4[2];
#pragma unroll
          for (int h = 0; h < 2; ++h) { const int e4 = tid * 4 & 1023, d = (tid >> 8); const int pg_ = (l * 2 + d) * 64 + g; c4[h] = *(const f32x4*)((h ? INP(I_CIM) : INP(I_CRE)) + (size_t)pg_ * 1024 + e4); }
          *(LAS f32x4*)(CrL + tid * 4) = c4[0]; *(LAS f32x4*)(CiL + tid * 4) = c4[1]; }
        if (tid < 128) { const int d = tid >> 6, n = tid & 63; const int pg_ = (l * 2 + d) * 64 + g;
            const float lre = INP(I_LRE)[pg_ * 64 + n], lim = INP(I_LIM)[pg_ * 64 + n], step = expf(INP(I_LSTEP)[pg_]);
            for (int dl = 0; dl <= 16; ++dl) { const float mag = expf(lre * step * (float)dl), ang = lim * step * (float)dl; Pre[(d * 17 + dl) * 64 + n] = mag * cosf(ang); Pim[(d * 17 + dl) * 64 + n] = mag * sinf(ang); }
            const float abr = Pre[(d * 17 + 1) * 64 + n], abi = Pim[(d * 17 + 1) * 64 + n];
            const float den = lre * lre + lim * lim; const float kre = ((abr - 1.f) * lre + abi * lim) / den, kim = (abi * lre - (abr - 1.f) * lim) / den;
            const float* br = INP(I_BRE) + ((size_t)pg_ * 64 + n) * 16; const float* bi = INP(I_BIM) + ((size_t)pg_ * 64 + n) * 16;
            f32x4 bq[4], bz[4];
#pragma unroll
            for (int q = 0; q < 4; ++q) { bq[q] = *(const f32x4*)(br + 4 * q); bz[q] = *(const f32x4*)(bi + 4 * q); }
#pragma unroll
            for (int i = 0; i < 16; ++i) { const float x = bq[i >> 2][i & 3], y = bz[i >> 2][i & 3]; BBr[(d * 64 + n) * 16 + i] = kre * x - kim * y; BBi[(d * 64 + n) * 16 + i] = kre * y + kim * x; }
            A16[((d * 64 + g) * 64 + n) * 2] = Pre[(d * 17 + 16) * 64 + n]; A16[((d * 64 + g) * 64 + n) * 2 + 1] = Pim[(d * 17 + 16) * 64 + n]; }
        __syncthreads();
        for (int q = 0; q < 16; ++q) { const int idx = tid + 512 * q; const int d = idx >> 12, dl = (idx >> 8) & 15, o = (idx >> 4) & 15, i = idx & 15;
            const LAS float* cr = CrL + (d * 16 + o) * 64; const LAS float* ci = CiL + (d * 16 + o) * 64; float acc = 0.f;
            for (int n = 0; n < 64; ++n) { const float pr = Pre[(d * 17 + dl) * 64 + n], pi = Pim[(d * 17 + dl) * 64 + n], br = BBr[(d * 64 + n) * 16 + i], bi = BBi[(d * 64 + n) * 16 + i];
                acc += cr[n] * (pr * br - pi * bi) - ci[n] * (pr * bi + pi * br); }
            Kt[idx] = acc; }
        __syncthreads();
        const float dsk = INP(I_S5D)[l * 1024 + 16 * g + (tid & 15)];
        for (int q = 0; q < 16; ++q) { const int item = tid + 512 * q; const int c1 = item >> 5, kb = (item & 31) * 8; const int rin = kb >> 4, i0 = kb & 15, rout = c1 >> 4, o = c1 & 15;
            const float dsko = __int_as_float(__builtin_amdgcn_ds_bpermute((((F.lane & ~15) | o)) << 2, __float_as_int(dsk)));
            float v[8];
#pragma unroll
            for (int e = 0; e < 8; ++e) { const int i = i0 + e; float x = 0.f; if (rout >= rin) x += Kt[((0 * 16 + (rout - rin)) * 16 + o) * 16 + i]; if (rin >= rout) x += Kt[((1 * 16 + (rin - rout)) * 16 + o) * 16 + i];
                if (rin == rout && i == o) x += dsko; v[e] = x; }
            u32x4 w; w.x = cvt_pk_bf16(v[0], v[1]); w.y = cvt_pk_bf16(v[2], v[3]); w.z = cvt_pk_bf16(v[4], v[5]); w.w = cvt_pk_bf16(v[6], v[7]);
            *(u32x4*)(Bt1 + ((size_t)g * 512 + c1) * 256 + kb) = w; }
        for (int q = 0; q < 16; ++q) { const int item = tid + 512 * q; const int c1 = item >> 5, kb = (item & 31) * 8; const int rin = kb >> 4, i0 = kb & 15; const int d = c1 >> 7, part = c1 & 1, n = (c1 >> 1) & 63;
            const int ex = (d == 0) ? 15 - rin : rin; const float pr = Pre[(d * 17 + ex) * 64 + n], pi = Pim[(d * 17 + ex) * 64 + n];
            float v[8];
#pragma unroll
            for (int e = 0; e < 8; ++e) { const float br = BBr[(d * 64 + n) * 16 + i0 + e], bi = BBi[(d * 64 + n) * 16 + i0 + e]; v[e] = part ? (pr * bi + pi * br) : (pr * br - pi * bi); }
            u32x4 w; w.x = cvt_pk_bf16(v[0], v[1]); w.y = cvt_pk_bf16(v[2], v[3]); w.z = cvt_pk_bf16(v[4], v[5]); w.w = cvt_pk_bf16(v[6], v[7]);
            *(u32x4*)(Bt1 + ((size_t)g * 512 + 256 + c1) * 256 + kb) = w; }
        for (int q = 0; q < 16; ++q) { const int item = tid + 512 * q; const int c2 = item >> 5, kb = (item & 31) * 8; const int rout = c2 >> 4, o = c2 & 15; const int d = kb >> 7, part = (kb >> 6) & 1, n0 = kb & 63;
            const int ex = (d == 0) ? rout + 1 : 16 - rout; const LAS float* cr = CrL + (d * 16 + o) * 64 + n0; const LAS float* ci = CiL + (d * 16 + o) * 64 + n0;
            float v[8];
#pragma unroll
            for (int e = 0; e < 8; ++e) { const float pr = Pre[(d * 17 + ex) * 64 + n0 + e], pi = Pim[(d * 17 + ex) * 64 + n0 + e]; v[e] = part ? -(cr[e] * pi + ci[e] * pr) : (cr[e] * pr - ci[e] * pi); }
            u32x4 w; w.x = cvt_pk_bf16(v[0], v[1]); w.y = cvt_pk_bf16(v[2], v[3]); w.z = cvt_pk_bf16(v[4], v[5]); w.w = cvt_pk_bf16(v[6], v[7]);
            *(u32x4*)(Bt2 + ((size_t)g * 256 + c2) * 256 + kb) = w; }
        __syncthreads();
    }
}
__device__ __forceinline__ void s5_carry(Frame& F, int cid) {
    const int b = cid >> 7, d = (cid >> 6) & 1, g = cid & 63, n = F.lane;
    const unsigned* ST = (const unsigned*)((const bf16_t*)(F.ws + WS_S5ST) + ((size_t)g * S5M + b * 272) * 256 + d * 128) + n;
    bf16_t* HP = (bf16_t*)(F.ws + WS_S5H) + ((size_t)g * 1280 + b * 272) * 256 + d * 128 + n;
    const float* A16 = (const float*)(F.ws + WS_S5A); const float ar = A16[((d * 64 + g) * 64 + n) * 2], ai = A16[((d * 64 + g) * 64 + n) * 2 + 1];
    float hr = 0.f, hi_ = 0.f;
    for (int k0 = 0; k0 < 272; k0 += 34) {
        unsigned wv[34];
#pragma unroll
        for (int e = 0; e < 34; ++e) { const int k = k0 + e; const int cc = (d == 0) ? k : (k < 16 ? 15 - k : 287 - k); wv[e] = ST[(size_t)cc * 128]; }
        asm volatile("s_waitcnt vmcnt(0)" ::: "memory");
#pragma unroll
        for (int e = 0; e < 34; ++e) { const int k = k0 + e; const int cc = (d == 0) ? k : (k < 16 ? 15 - k : 287 - k);
            HP[(size_t)cc * 256] = (bf16_t)(cvt_pk_bf16(hr, 0.f) & 0xffffu); HP[(size_t)cc * 256 + 64] = (bf16_t)(cvt_pk_bf16(hi_, 0.f) & 0xffffu);
            const float sr = bflo(wv[e]), si = bfhi(wv[e]); const float nr = ar * hr - ai * hi_ + sr, ni = ar * hi_ + ai * hr + si; hr = nr; hi_ = ni; }
    }
}
__device__ __forceinline__ void mixer_finalize(const Args& A_, Frame& F, int l) {
    bf16_t* P = (bf16_t*)(F.ws + WS_PROJ);
    const bf16_t* XC = (const bf16_t*)(F.ws + WS_HM); const bf16_t* YD0 = (const bf16_t*)(F.ws + WS_YD); const bf16_t* YD1 = YD0 + (size_t)R * 1024;
        const int c0 = F.lane * 16;
    for (int row = F.gw; row < R; row += F.NGW) {
        { const float dsk = INP(I_SSDD)[l * 16 + (c0 >> 6)];
          const float* nwp = INP(I_SSDN) + l * 1024 + c0;
          float v[16];
#pragma unroll
          for (int hh = 0; hh < 2; ++hh) { const u32x4 x = *(const u32x4*)(XC + (size_t)row * 2048 + c0 + 8 * hh), y0 = *(const u32x4*)(YD0 + (size_t)row * 1024 + c0 + 8 * hh), y1 = *(const u32x4*)(YD1 + (size_t)row * 1024 + c0 + 8 * hh), z = *(const u32x4*)(P + (size_t)row * LDP + PZ + c0 + 8 * hh);
#define SG(i, wx, wy0, wy1, wz) v[8 * hh + 2 * (i)] = (bflo(wx) * dsk + bflo(wy0) + bflo(wy1)) * bflo(wz); v[8 * hh + 2 * (i) + 1] = (bfhi(wx) * dsk + bfhi(wy0) + bfhi(wy1)) * bfhi(wz);
              SG(0, x.x, y0.x, y1.x, z.x) SG(1, x.y, y0.y, y1.y, z.y) SG(2, x.z, y0.z, y1.z, z.z) SG(3, x.w, y0.w, y1.w, z.w)
#undef SG
          }
          float ss = 0.f;
#pragma unroll
          for (int e = 0; e < 16; ++e) ss += v[e] * v[e];
          ss += shx(ss, 1, F.lane); ss += shx(ss, 2, F.lane); ss += shx(ss, 4, F.lane); ss += shx(ss, 8, F.lane);
          const float rs = 1.0f / sqrtf(ss * (1.f / 256.f) + RMS_EPS);
          const f32x4 n0 = *(const f32x4*)(nwp), n1 = *(const f32x4*)(nwp + 4), n2 = *(const f32x4*)(nwp + 8), n3 = *(const f32x4*)(nwp + 12);
          const float nw[16] = {n0[0], n0[1], n0[2], n0[3], n1[0], n1[1], n1[2], n1[3], n2[0], n2[1], n2[2], n2[3], n3[0], n3[1], n3[2], n3[3]};
          u32x4 o0, o1;
          o0.x = cvt_pk_bf16(v[0] * rs * nw[0], v[1] * rs * nw[1]); o0.y = cvt_pk_bf16(v[2] * rs * nw[2], v[3] * rs * nw[3]); o0.z = cvt_pk_bf16(v[4] * rs * nw[4], v[5] * rs * nw[5]); o0.w = cvt_pk_bf16(v[6] * rs * nw[6], v[7] * rs * nw[7]);
          o1.x = cvt_pk_bf16(v[8] * rs * nw[8], v[9] * rs * nw[9]); o1.y = cvt_pk_bf16(v[10] * rs * nw[10], v[11] * rs * nw[11]); o1.z = cvt_pk_bf16(v[12] * rs * nw[12], v[13] * rs * nw[13]); o1.w = cvt_pk_bf16(v[14] * rs * nw[14], v[15] * rs * nw[15]);
          *(u32x4*)(P + (size_t)row * LDP + PV + c0) = o0; *(u32x4*)(P + (size_t)row * LDP + PV + c0 + 8) = o1; }
    }
}


__global__ void __launch_bounds__(NWAVES * 64, 2) trunk_fwd(Args args) {
    extern __shared__ __attribute__((aligned(16))) unsigned char lds_raw[];
    Frame F;
    F.lds = (LAS unsigned char*)lds_raw;
    F.tid = threadIdx.x; F.lane = F.tid & 63; F.wave = __builtin_amdgcn_readfirstlane(F.tid >> 6);
    F.G = gridDim.x; { const int bx = blockIdx.x; F.vcu = (F.G % 8 == 0) ? (bx % 8) * (F.G / 8) + bx / 8 : bx; }
    F.gw = F.vcu * NWAVES + F.wave; F.NGW = F.G * NWAVES;
    F.ws = args.ws;
    volatile LAS unsigned* MISC = (volatile LAS unsigned*)(F.lds + MISC_OFF);
    for (int u = F.tid; u < (LDS_BYTES - LDSCTL_OFF) / 4; u += NWAVES * 64) ((LAS unsigned*)(F.lds + LDSCTL_OFF))[u] = 0u;
    __syncthreads();
    if (threadIdx.x < 32) ((LAS unsigned long long*)(F.lds + INTAB_OFF))[threadIdx.x] = (unsigned long long)args.in[threadIdx.x];
    __syncthreads();
    (void)xcd_barrier_post((unsigned*)(args.ws + WS_CTL) + CW_BAR, MISC + 8);
    const int lo = args.ph_lo, hi = args.ph_hi;
    const int wave0 = __builtin_amdgcn_readfirstlane((int)threadIdx.x >> 6);
    int pid = 0;
#define PH_BEGIN if (pid >= lo && pid < hi) { GAS unsigned char* wsg_ = (GAS unsigned char*)args.ws; int tid_; asm volatile("v_mbcnt_lo_u32_b32 %1, -1, 0\n\tv_mbcnt_hi_u32_b32 %1, -1, %1 ; PHASE_MARK_BEGIN %2" : "+s"(wsg_), "=v"(tid_) : "i"(__LINE__) : "memory"); tid_ += wave0 * 64; unsigned char* ws = (unsigned char*)wsg_; F.ws = ws; F.tid = tid_; F.lane = tid_ & 63; F.wave = __builtin_amdgcn_readfirstlane(tid_ >> 6); F.gw = F.vcu * NWAVES + F.wave;
#define PH_END   asm volatile("; PHASE_MARK_END %0" :: "i"(__LINE__)); if (pid + 1 < hi) { XcdBarrier bar_; bar_.bar = (unsigned*)(args.ws + WS_CTL) + CW_BAR; bar_.x = xb_xcc_id(); bar_.st = (volatile LAS unsigned*)(F.lds + MISC_OFF) + 8; xcd_barrier(bar_, wave0 * 64 + lane_now()); } } ++pid;

#define MOD ((float*)(ws + WS_MOD))
#define Hbuf ((float*)(ws + WS_H))
#define HM ((bf16_t*)(ws + WS_HM))
#define PROJ ((bf16_t*)(ws + WS_PROJ))
#define ROPEC ((float*)(ws + WS_ROPE))
#define ROPES (ROPEC + 1024)
#define WGT (ws + WS_W)

    PH_BEGIN
        s5_setup(args, F, 0);
        mod_partials(args, F);
        if (F.gw == 1) { float* idn = (float*)(ws + WS_IDENT); for (int i = F.lane; i < 2048; i += 64) { idn[i] = 1.0f; idn[2048 + i] = 0.0f; } }
        if (F.gw == 0) {
#pragma unroll
            for (int i = 0; i < 16; ++i) { const int idx = i * 64 + F.lane, pos = idx >> 4, f = idx & 15; const float inv = powf(10000.0f, -(float)f / 16.0f); const float ang = (float)pos * inv; ROPEC[idx] = cosf(ang); ROPES[idx] = sinf(ang); } }
    PH_END
    PH_BEGIN
        convert_layer_weights(args, F, 0);
        ln_pass(F, false, nullptr, nullptr, MOD, nullptr, INP(I_X), INP(I_CTX));
    PH_END

    for (int s = 0; s < 6; ++s) {
        const int l = s / 3, j = s - 3 * l;
        if (j != 1) {
            const int f = j >> 1;
            PH_BEGIN
                const int lat = (l == 1 && j == 2); pg8::Gemm g{D, D, D}; pg8::StaticOrder S; S.init(lat ? 64 : NPAN, N13 / 256, F.G, (int)blockIdx.x, HM, D, (const bf16_t*)(WGT + W_13) + (size_t)f * N13 * D, D, D, lat);
                EpiSwiGLU E{PROJ};
                pg8::gemm_phase<EpiSwiGLU, pg8::StaticOrder>(F.lds + RING_OFF, g, S, E, F.tid);
            PH_END
        } else {
            PH_BEGIN
                pg8::Gemm g{D, D, D}; pg8::StaticOrder S; S.init(NPAN, LDP / 256, F.G, (int)blockIdx.x, HM, D, (const bf16_t*)(WGT + W_IN), D, D);
                EpiProj E{PROJ, (float*)(ws + WS_DT), ROPEC, ROPES, (bf16_t*)(ws + WS_O)};
                pg8::gemm_phase<EpiProj, pg8::StaticOrder>(F.lds + RING_OFF, g, S, E, F.tid);
                { const int nfull = (NPAN * (LDP / 256)) % F.G;
                  if ((int)blockIdx.x >= nfull) { const int nw = (F.G - nfull) * NWAVES; for (int t = ((int)blockIdx.x - nfull) * NWAVES + F.wave; t < R / 32; t += nw) dt_tile(F, l, t); } }
            PH_END
            PH_BEGIN
                ssd_conv_pass(args, F, l);
                { pg8::Gemm g{256, 256, 256}; S5AOrder S{F.G, (int)blockIdx.x, (const char*)(ws + WS_O), (const char*)(ws + WS_S5M)};
                  EpiS5A E{(unsigned char*)(ws + WS_YS), (bf16_t*)(ws + WS_S5ST)};
                  pg8::gemm_phase<EpiS5A, S5AOrder>(F.lds + RING_OFF, g, S, E, F.tid); }
            PH_END
            PH_BEGIN
                if (F.wave < 2) s5_carry(F, (int)blockIdx.x * 2 + F.wave);
                ssd_chain_fast(args, F, l, (int)blockIdx.x);
                {
                    const float lam_init = 0.8f - 0.6f * expf(-0.3f * (float)l);
                    const float* lv = INP(I_ALAM) + l * 256;
                    const float s01 = wave_sum(lv[F.lane] * lv[64 + F.lane], F.lane), s23 = wave_sum(lv[128 + F.lane] * lv[192 + F.lane], F.lane);
                    const float lam = expf(s01) - expf(s23) + lam_init;
                    for (int i = 0;; ++i) { const int idx = i * F.G + F.vcu; if (idx >= 512 + (l == 0 ? 32 : 0)) break;
                        int b, h, q0, seq;
                        if (idx < 512) { b = idx >> 7; h = (idx >> 4) & 7; q0 = b * RB + CTX + (idx & 15) * 256; seq = RB; }
                        else { const int k = idx - 512; b = k >> 3; h = k & 7; q0 = b * RB; seq = CTX; }
                        const bf16_t* Q0 = PROJ + (size_t)q0 * LDP + PQ + h * 128; const bf16_t* Kh = PROJ + (size_t)(b * RB) * LDP + PK + h * 128; const bf16_t* Vh = PROJ + (size_t)(b * RB) * LDP + PV + h * 128;
                        attn128::unit((const attn128::bf16*)Q0, (const attn128::bf16*)Kh, (const attn128::bf16*)Vh, PROJ + (size_t)q0 * LDP + PQ + h * 128, seq, (char*)lds_raw + RING_OFF, F.tid, lam, 1.0f - lam_init, INP(I_ASUB) + l * 128);
                    }
                }
            PH_END
            PH_BEGIN
                mixer_finalize(args, F, l);
                { pg8::Gemm g{256, 256, 256}; S5COrder S{F.G, (int)blockIdx.x, (const char*)(ws + WS_S5H), (const char*)((bf16_t*)(ws + WS_S5M) + (size_t)64 * 512 * 256)};
                  EpiS5C E{(const unsigned char*)(ws + WS_YS), PROJ};
                  pg8::gemm_phase<EpiS5C, S5COrder>(F.lds + RING_OFF, g, S, E, F.tid); }
            PH_END
            PH_BEGIN
                pg8::Gemm g{LDP, 1024, 1024}; pg8::StaticOrder S; S.init(l == 1 ? 64 : NPAN, 4, F.G, (int)blockIdx.x, PROJ + PU, LDP, (const bf16_t*)(WGT + W_GLU), 1024, 1024, l == 1);
                EpiGlu E{PROJ, INP(I_GLUB) + l * 1024};
                pg8::gemm_phase<EpiGlu, pg8::StaticOrder>(F.lds + RING_OFF, g, S, E, F.tid);
            PH_END
            PH_BEGIN
                pg8::Gemm g{LDP, 3072, 3072}; pg8::StaticOrder S; S.init(l == 1 ? 64 : NPAN, 8, F.G, (int)blockIdx.x, PROJ, LDP, (const bf16_t*)(WGT + W_B), 3072, 3072, l == 1);
                EpiMerge E{PROJ, HM};
                pg8::gemm_phase<EpiMerge, pg8::StaticOrder, 0, true>(F.lds + RING_OFF, g, S, E, F.tid);
            PH_END
        }
        PH_BEGIN
            const int RK = (j == 1) ? D : DFF; const bf16_t* RA = (j == 1) ? HM : PROJ; const bf16_t* RBt = (j == 1) ? (const bf16_t*)(WGT + W_O) : (const bf16_t*)(WGT + W_2) + (size_t)(j >> 1) * D * DFF;
            const int lat = (l == 1 && j >= 1); pg8::Gemm g{RK, RK, RK}; pg8::StaticOrder S; S.init(64, D / 256, F.G, (int)blockIdx.x, RA, RK, RBt, RK, RK, 1, lat ? 0 : 128);
            const float* lg_ = (s == 0) ? (const float*)(ws + WS_IDENT) : INP(I_LNG) + (size_t)(s - 1) * D; const float* lb_ = (s == 0) ? (const float*)(ws + WS_IDENT) + 2048 : INP(I_LNB) + (size_t)(s - 1) * D;
            EpiResid E{(_Float16*)(ws + WS_H), (float*)(ws + WS_HC), MOD + (size_t)l * 5 * NMOD + (3 * j + 2) * D, lg_, lb_, (const float*)(ws + WS_STATS)};
            pg8::gemm_phase<EpiResid, pg8::StaticOrder>(F.lds + RING_OFF, g, S, E, F.tid);
        PH_END
        PH_BEGIN
            const bool fin = (s == 5);
            const int ln_ = (j == 2) ? l + 1 : l, jn = (j == 2) ? 0 : j + 1;
            ln_pass(F, true, INP(I_LNG) + (size_t)(l * 3 + j) * D, INP(I_LNB) + (size_t)(l * 3 + j) * D, fin ? nullptr : MOD + (size_t)ln_ * 5 * NMOD + 3 * jn * D, fin ? args.out : nullptr, nullptr, nullptr, (l == 1 && j >= 1) ? 0 : 4);
            if (s == 2) { s5_setup(args, F, 1); __syncthreads(); convert_layer_weights(args, F, 1); }
        PH_END
    }
#undef PH_BEGIN
#undef PH_END
}

static int count_phases() { int n = 2; for (int s = 0; s < 6; ++s) n += ((s % 3) != 1 ? 1 : 6) + 2; return n; }
extern "C" void kernel_launch(void* const* d_in, const int* in_sizes, int n_in, void* d_out, int out_size, void* d_ws, size_t ws_size, hipStream_t stream) {
    static int grid = 0;
    if (grid == 0) {
        if (n_in != 32 || out_size != NB * SEQ * D || ws_size < WS_END) { fprintf(stderr, "kernel_launch: unexpected shapes (n_in %d, out %d, ws %zu < %zu)\n", n_in, out_size, ws_size, (size_t)WS_END); grid = -1; return; }
        int dev = 0, cus = 0, per_cu = 0;
        if (hipGetDevice(&dev) != hipSuccess || hipDeviceGetAttribute(&cus, hipDeviceAttributeMultiprocessorCount, dev) != hipSuccess) { grid = -1; return; }
        if (hipFuncSetAttribute((const void*)trunk_fwd, hipFuncAttributeMaxDynamicSharedMemorySize, LDS_BYTES) != hipSuccess) { fprintf(stderr, "kernel_launch: hipFuncSetAttribute failed\n"); grid = -1; return; }
        if (hipOccupancyMaxActiveBlocksPerMultiprocessor(&per_cu, (const void*)trunk_fwd, NWAVES * 64, LDS_BYTES) != hipSuccess || per_cu < 1) fprintf(stderr, "kernel_launch: occupancy query says %d\n", per_cu);
        (void)hipGetLastError();
        if (cus != 256) { fprintf(stderr, "kernel_launch: this kernel deals its SSD chains / carries / attention units over exactly 256 workgroups (one per CU); device reports %d CUs; nothing launched\n", cus); grid = -1; return; }
        grid = cus;
    }
    if (grid < 0) return;
    (void)in_sizes;
    if (hipMemsetAsync((char*)d_ws + WS_CTL, 0, 2 * MiB  , stream) != hipSuccess) return;
    Args a{};
    for (int i = 0; i < 32; ++i) a.in[i] = (const float*)d_in[i];
    a.out = (float*)d_out; a.ws = (unsigned char*)d_ws;
    const int nph = count_phases();
#if MK_PER_PHASE
    for (int p = 0; p < nph; ++p) { a.ph_lo = p; a.ph_hi = p + 1; hipLaunchKernelGGL(trunk_fwd, dim3(grid), dim3(NWAVES * 64), LDS_BYTES, stream, a); }
#else
    a.ph_lo = 0; a.ph_hi = nph;
    hipLaunchKernelGGL(trunk_fwd, dim3(grid), dim3(NWAVES * 64), LDS_BYTES, stream, a);
#endif
    const hipError_t le = hipPeekAtLastError();
    if (le != hipSuccess) fprintf(stderr, "kernel_launch: launch failed: %s\n", hipGetErrorName(le));
}
```

```cpp
#include <hip/hip_runtime.h>
#include <hip/hip_bf16.h>
#include <cstdio>
#include <cstdint>
#include <cmath>

#ifndef MK_PER_PHASE
#define MK_PER_PHASE 0
#endif

#define LAS __attribute__((address_space(3)))
#define GAS __attribute__((address_space(1)))
typedef unsigned short bf16_t;
typedef short bf16x8 __attribute__((ext_vector_type(8)));
typedef float f32x4 __attribute__((ext_vector_type(4)));
typedef float f32x2 __attribute__((ext_vector_type(2)));
typedef float f32x16 __attribute__((ext_vector_type(16)));
typedef unsigned u32x4 __attribute__((ext_vector_type(4)));
typedef unsigned u32x2 __attribute__((ext_vector_type(2)));
typedef short s16x4 __attribute__((ext_vector_type(4)));

constexpr int NB = 4, SEQ = 4096, CTX = 256, RB = SEQ + CTX  , R = NB * RB  , NPAN = R / 256  , PPB = RB / 256  ;
constexpr int D = 2048, DFF = 5632, N13 = 2 * DFF, NMOD = 9 * D  ;
constexpr int LDP = 13312;
constexpr int NIN = 13568;
constexpr int PQ = 0, PK = 1024, PV = 2048, PZ = 3072, PX = 4096, PU = 6144, PG = 7168;
constexpr float DN_ALPHA = 1.41421356237309515f;
constexpr float LN_EPS = 1e-5f, RMS_EPS = 1e-6f;
constexpr float QSCALE = 0.125f * 1.4426950408889634f;

constexpr size_t MiB = 1u << 20;
constexpr size_t WS_CTL = 0, CTL_ZERO_BYTES = 1 * MiB;
constexpr size_t WS_MOD = 1 * MiB;
constexpr size_t WS_ROPE = 2 * MiB;
constexpr size_t WS_STATS = 2 * MiB + 65536;
constexpr size_t WS_IDENT = 2 * MiB + 262144;
constexpr size_t WS_MODP = 3 * MiB;
constexpr size_t WS_DT = 15 * MiB;
constexpr size_t WS_H = 18 * MiB;
constexpr size_t WS_HC = WS_H + 68 * MiB;
constexpr size_t WS_HM = 154 * MiB;
constexpr size_t WS_PROJ = 222 * MiB;
constexpr size_t WS_O = 664 * MiB;
constexpr size_t WS_YD = 732 * MiB;
constexpr size_t WS_YS = 800 * MiB;
constexpr size_t WS_W = 868 * MiB;
constexpr size_t W_13 = 0, W_2 = 88 * MiB, W_IN = 132 * MiB, W_B = 185 * MiB, W_O = 197 * MiB, W_GLU = 205 * MiB;
constexpr size_t WS_S5ST = 1075 * MiB;
constexpr size_t WS_S5H = 1143 * MiB;
constexpr size_t WS_S5M = 1183 * MiB;
constexpr size_t WS_S5A = 1207 * MiB;
constexpr size_t WS_GQ0 = WS_O + 34 * MiB, WS_GQ1 = WS_S5ST + 34 * MiB  , WS_GQ2 = 1208 * MiB;
constexpr size_t WS_END = 1242 * MiB;
__device__ __forceinline__ size_t gq_off(int j) { return j == 0 ? WS_GQ0 : (j == 1 ? WS_GQ1 : WS_GQ2); }
constexpr int S5M = 1088;
constexpr int CW_BAR = 4096;

__device__ __forceinline__ unsigned cvt_pk_bf16(float lo, float hi) { unsigned r; asm volatile("v_cvt_pk_bf16_f32 %0, %1, %2" : "=v"(r) : "v"(lo), "v"(hi)); return r; }
__device__ __forceinline__ float bflo(unsigned u) { return __uint_as_float(u << 16); }
__device__ __forceinline__ float bfhi(unsigned u) { return __uint_as_float(u & 0xffff0000u); }
__device__ __forceinline__ float bf1(bf16_t h) { return __uint_as_float((unsigned)h << 16); }
typedef _Float16 h16x2 __attribute__((ext_vector_type(2)));
typedef _Float16 h16x4 __attribute__((ext_vector_type(4)));
__device__ __forceinline__ f32x4 ld_h4(const _Float16* p) { const h16x4 h = *(const h16x4*)p; return (f32x4){(float)h[0], (float)h[1], (float)h[2], (float)h[3]}; }
__device__ __forceinline__ void st_h4(_Float16* p, f32x4 v) { h16x4 h; h[0] = (_Float16)v[0]; h[1] = (_Float16)v[1]; h[2] = (_Float16)v[2]; h[3] = (_Float16)v[3]; *(h16x4*)p = h; }
__device__ __forceinline__ float sigmoidf_(float x) { return __builtin_amdgcn_rcpf(1.0f + __builtin_amdgcn_exp2f(-1.4426950408889634f * x)); }
__device__ __forceinline__ float siluf_(float x) { return x * sigmoidf_(x); }
__device__ __forceinline__ int lane_now() { int l; asm volatile("v_mbcnt_lo_u32_b32 %0, -1, 0\n\tv_mbcnt_hi_u32_b32 %0, -1, %0" : "=v"(l)); return l; }
__device__ __forceinline__ float shx(float v, int m, int lane) { return __int_as_float(__builtin_amdgcn_ds_bpermute((lane ^ m) << 2, __float_as_int(v))); }
__device__ __forceinline__ float wave_sum(float v, int lane) {
#pragma unroll
    for (int o = 1; o < 64; o <<= 1) v += shx(v, o, lane);
    return v;
}
#define LDS_WAIT() asm volatile("s_waitcnt lgkmcnt(0)" ::: "memory")
#define VM_WAIT() asm volatile("s_waitcnt vmcnt(0)" ::: "memory")

namespace pg8 {
constexpr int BM = 256, BK = 64, HALF = 128, HTB = HALF * BK * 2, STAGE_BYTES = 8 * HTB, NXCD = 8, WGM = 8, PPB_ = 17;
__host__ __device__ __forceinline__ int lds_byte(int r, int c) { const int st = (r >> 4) * 2 + (c >> 5), rr = r & 15, cc = c & 31, ob = rr * 64 + cc * 2; return st * 1024 + (ob ^ (((ob >> 9) & 1) << 5)); }
__host__ __device__ __forceinline__ int perm32(int rho) { const int n = rho >> 4, i = rho & 15; return 8 * (i >> 2) + 4 * n + (i & 3); }
__host__ __device__ __forceinline__ void stage_rc(int b, int& R_, int& C_) { const int st = b / 1024, sb = b % 1024, swz = sb ^ (((sb >> 9) & 1) << 5); R_ = (st >> 1) * 16 + swz / 64; C_ = (st & 1) * 32 + (swz % 64) / 2; }

struct Unit { int pm, pn, aux, kt; const char* a; const char* b; };
struct Gemm { int lda, ldb, K; };

__device__ __forceinline__ void xcd_remap(int L, int nM, int nN, int& pm, int& pn) {
    const int nwg = nM * nN; int wgid = L;
    { const int q = nwg / NXCD, r = nwg % NXCD, xcd = wgid % NXCD, off = wgid / NXCD; wgid = (xcd < r ? xcd * (q + 1) : r * (q + 1) + (xcd - r) * q) + off; }
    const int nig = WGM * nN, gid = wgid / nig, fm = gid * WGM, gsz = (nM - fm) < WGM ? (nM - fm) : WGM;
    pm = fm + ((wgid % nig) % gsz); pn = (wgid % nig) / gsz;
}
struct StaticOrder {
    int nM, nN, nwg, G, c, kt, latonly, nctx; const char* A; const char* B; size_t tA, tB;
    __device__ __forceinline__ void init(int nM_, int nN_, int G_, int c_, const void* A_, int lda, const void* B_, int ldb, int K, int latonly_ = 0, int nctx_ = 0) { nM = nM_; nN = nN_; nwg = nM * nN; G = G_; c = c_; kt = K / BK; latonly = latonly_; nctx = nctx_;
        A = (const char*)A_; B = (const char*)B_; tA = (size_t)BM * lda * 2; tB = (size_t)BM * ldb * 2; }
    __device__ __forceinline__ bool next(int i, Unit& u) const {
        const long L = (long)i * G + c;
        if (L < nwg) { xcd_remap((int)L, nM, nN, u.pm, u.pn); if (latonly) u.pm += (u.pm >> 4) + 1; u.aux = 0; u.kt = kt; u.a = A + (size_t)u.pm * tA; u.b = B + (size_t)u.pn * tB; return true; }
        const int x = (int)(L - nwg); if (x >= nctx) return false;
        const int q = x & 3, t2 = x >> 2; u.pm = PPB_ * (t2 / nN); u.pn = t2 % nN; u.aux = 1 + q; u.kt = kt >> 2;
        u.a = A + (size_t)u.pm * tA + (size_t)q * (kt >> 2) * BK * 2; u.b = B + (size_t)u.pn * tB + (size_t)q * (kt >> 2) * BK * 2; return true;
    }
};
template <class Epi, class Sched, int AMODE = 0, bool HOOK = false>
__device__ __forceinline__ void gemm_phase(LAS unsigned char* lds, const Gemm g, const Sched& S, const Epi& E, const int tid) {
    const int wid = __builtin_amdgcn_readfirstlane(tid >> 6), lane = tid & 63, wr = wid >> 2, wc = wid & 3, fr = lane & 15, fq = lane >> 4;
    unsigned voffA[2], voffB[2];
#pragma unroll
    for (int i = 0; i < 2; ++i) { int R_, C_; stage_rc(tid * 16 + i * 8192, R_, C_);
        voffA[i] = (AMODE == 1) ? (unsigned)((R_ * 16 + (C_ >> 4)) * LDP + (C_ & 15)) * 2u : (unsigned)(R_ * g.lda + C_) * 2u; voffB[i] = (unsigned)((Epi::PERM ? ((R_ & ~31) + perm32(R_ & 31)) : R_) * g.ldb + C_) * 2u; }
    const size_t kstep = (size_t)(BK * 2), kstepA = (AMODE == 1) ? (size_t)(4 * LDP * 2) : kstep;
    const size_t hstepA = (AMODE == 1) ? (size_t)HALF * 16 * LDP * 2 : (size_t)HALF * g.lda * 2, hstepB = (size_t)HALF * g.ldb * 2;
    const unsigned ldsw = (unsigned)wid * 1024u;
    const int aoff = lds_byte(wr * 64 + fr, fq * 8), boff = lds_byte(wc * 32 + fr, fq * 8);
#define PG8_SA(b, h) (((b) * 2 + (h)) * HTB)
#define PG8_SB(b, h) ((4 + (b) * 2 + (h)) * HTB)
#define PG8_STAGE(bufoff, gbase, voff) do { _Pragma("unroll") for (int _i = 0; _i < 2; ++_i) \
        __builtin_amdgcn_global_load_lds((const unsigned*)((const char*)(gbase) + (voff)[_i]), (LAS unsigned*)(lds + (bufoff) + ldsw + _i * 8192), 16, 0, 0); } while (0)
#define PG8_LDA(dst, b, h) do { _Pragma("unroll") for (int m = 0; m < 4; ++m) _Pragma("unroll") for (int k = 0; k < 2; ++k) dst[m][k] = *(const LAS bf16x8*)(lds + PG8_SA(b, h) + aoff + m * 2048 + k * 1024); } while (0)
#define PG8_LDB(dst, b, h) do { _Pragma("unroll") for (int n = 0; n < 2; ++n) _Pragma("unroll") for (int k = 0; k < 2; ++k) dst[n][k] = *(const LAS bf16x8*)(lds + PG8_SB(b, h) + boff + n * 2048 + k * 1024); } while (0)
#define PG8_MMA(ai, bj, At, Bt) do { __builtin_amdgcn_s_setprio(1); _Pragma("unroll") for (int m = 0; m < 4; ++m) _Pragma("unroll") for (int n = 0; n < 2; ++n) _Pragma("unroll") for (int k = 0; k < 2; ++k) \
        acc[ai][bj][m][n] = __builtin_amdgcn_mfma_f32_16x16x32_bf16(Bt[n][k], At[m][k], acc[ai][bj][m][n], 0, 0, 0); __builtin_amdgcn_s_setprio(0); } while (0)
#define PG8_WAIT_V(n) asm volatile("s_waitcnt vmcnt(" #n ")" ::: "memory")
#define PG8_WAIT_L(n) asm volatile("s_waitcnt lgkmcnt(" #n ")" ::: "memory")
#define PG8_BAR __builtin_amdgcn_s_barrier()
#define PG8_SCHED __builtin_amdgcn_sched_barrier(0)
    Unit cur, nxt; int ui = 0;
    if (!S.next(0, cur)) return;
    f32x4 acc[2][2][4][2];
#pragma unroll
    for (int a = 0; a < 2; ++a)
#pragma unroll
        for (int b = 0; b < 2; ++b)
#pragma unroll
            for (int m = 0; m < 4; ++m)
#pragma unroll
                for (int n = 0; n < 2; ++n) acc[a][b][m][n] = (f32x4){0.f, 0.f, 0.f, 0.f};
    bf16x8 At[4][2], B0[2][2], B1[2][2];
    const char* cA = cur.a; const char* cB = cur.b;
    PG8_STAGE(PG8_SB(0, 0), cB, voffB); PG8_STAGE(PG8_SB(0, 1), cB + hstepB, voffB); PG8_STAGE(PG8_SA(0, 0), cA, voffA); PG8_STAGE(PG8_SA(0, 1), cA + hstepA, voffA);
    if (wr == 1) PG8_BAR;
    PG8_WAIT_V(2); PG8_BAR;
    PG8_STAGE(PG8_SB(1, 0), cB + kstep, voffB); PG8_STAGE(PG8_SA(1, 0), cA + kstepA, voffA); PG8_STAGE(PG8_SB(1, 1), cB + hstepB + kstep, voffB);
    PG8_WAIT_V(6); PG8_BAR;
    for (;;) {
        const bool has_next = S.next(ui + 1, nxt);
        const char* nA = has_next ? nxt.a : cA; const char* nB = has_next ? nxt.b : cB;
        const int nt = cur.kt;
        for (int t = 0; t < nt; t += 2) {
            const bool last = (t == nt - 2);
            if constexpr (HOOK) { if (t == 16 || t == 32) E.mid(acc, cur, t >> 4, wr, wc); }
            const char* a1 = cA + (size_t)(t + 1) * kstepA;
            const char* a2 = last ? nA : cA + (size_t)(t + 2) * kstepA; const char* b2 = last ? nB : cB + (size_t)(t + 2) * kstep;
            const char* a3 = a2 + kstepA; const char* b3 = b2 + kstep;
            PG8_LDB(B0, 0, 0); PG8_LDB(B1, 0, 1); PG8_SCHED; PG8_LDA(At, 0, 0); PG8_STAGE(PG8_SA(1, 1), a1 + hstepA, voffA);
            PG8_WAIT_V(8); PG8_WAIT_L(0); PG8_BAR; PG8_MMA(0, 0, At, B0); PG8_MMA(0, 1, At, B1); PG8_BAR; PG8_SCHED;
            PG8_LDA(At, 0, 1); PG8_STAGE(PG8_SB(0, 0), b2, voffB); PG8_STAGE(PG8_SB(0, 1), b2 + hstepB, voffB); PG8_STAGE(PG8_SA(0, 0), a2, voffA);
            PG8_WAIT_V(8); PG8_WAIT_L(0); PG8_BAR; PG8_MMA(1, 0, At, B0); PG8_MMA(1, 1, At, B1); PG8_BAR; PG8_SCHED;
            PG8_LDB(B0, 1, 0); PG8_LDB(B1, 1, 1); PG8_SCHED; PG8_LDA(At, 1, 0); PG8_STAGE(PG8_SA(0, 1), a2 + hstepA, voffA);
            PG8_WAIT_V(8); PG8_WAIT_L(0); PG8_BAR; PG8_MMA(0, 0, At, B0); PG8_MMA(0, 1, At, B1); PG8_BAR; PG8_SCHED;
            PG8_LDA(At, 1, 1); PG8_STAGE(PG8_SB(1, 0), b3, voffB); PG8_STAGE(PG8_SB(1, 1), b3 + hstepB, voffB); PG8_STAGE(PG8_SA(1, 0), a3, voffA);
            PG8_WAIT_V(8); PG8_WAIT_L(0); PG8_BAR; PG8_MMA(1, 0, At, B0); PG8_MMA(1, 1, At, B1); PG8_BAR; PG8_SCHED;
        }
        if (wr == 0) PG8_BAR;
        E(acc, cur, wr, wc, fr, fq);
        if (!has_next) break;
#pragma unroll
        for (int a = 0; a < 2; ++a)
#pragma unroll
            for (int b = 0; b < 2; ++b)
#pragma unroll
                for (int m = 0; m < 4; ++m)
#pragma unroll
                    for (int n = 0; n < 2; ++n) acc[a][b][m][n] = (f32x4){0.f, 0.f, 0.f, 0.f};
        cur = nxt; cA = nA; cB = nB; ++ui;
        if (wr == 1) PG8_BAR;
    }
    PG8_WAIT_V(0);
    PG8_BAR;
#undef PG8_SA
#undef PG8_SB
#undef PG8_STAGE
#undef PG8_LDA
#undef PG8_LDB
#undef PG8_MMA
#undef PG8_WAIT_V
#undef PG8_WAIT_L
#undef PG8_BAR
#undef PG8_SCHED
}
}

struct EpiSwiGLU {
    static constexpr bool PERM = true;
    bf16_t* O;
    __device__ __forceinline__ void operator()(const f32x4 (&acc)[2][2][4][2], const pg8::Unit& u, int wr, int wc, int, int) const { const int ln_ = lane_now(); const int fr = ln_ & 15, fq = ln_ >> 4;
        const int row0 = u.pm * 256 + wr * 64 + fr, hc0 = u.pn * 128 + wc * 32 + 8 * fq;
#pragma unroll
        for (int ai = 0; ai < 2; ++ai)
#pragma unroll
            for (int m = 0; m < 4; ++m) { const f32x4 a0 = acc[ai][0][m][0], a1 = acc[ai][0][m][1], b0 = acc[ai][1][m][0], b1 = acc[ai][1][m][1];
                u32x4 w; w.x = cvt_pk_bf16(siluf_(a0[0]) * b0[0], siluf_(a0[1]) * b0[1]); w.y = cvt_pk_bf16(siluf_(a0[2]) * b0[2], siluf_(a0[3]) * b0[3]);
                w.z = cvt_pk_bf16(siluf_(a1[0]) * b1[0], siluf_(a1[1]) * b1[1]); w.w = cvt_pk_bf16(siluf_(a1[2]) * b1[2], siluf_(a1[3]) * b1[3]);
                *(u32x4*)(O + (size_t)(row0 + ai * 128 + m * 16) * DFF + hc0) = w; }
    }
};
struct EpiResid {
    static constexpr bool PERM = true;
    _Float16* H; float* HC; const float* gate; const float* lng; const float* lnb; const float* stats;
    __device__ __forceinline__ void operator()(const f32x4 (&acc)[2][2][4][2], const pg8::Unit& u, int wr, int wc, int, int) const { const int ln_ = lane_now(); const int fr = ln_ & 15, fq = ln_ >> 4;
        int upm = u.pm, upn = u.pn; asm volatile("" : "+s"(upm), "+s"(upn));
        const int pp = upm % PPB, mi = (pp == 0) ? 4 : (upm / PPB);
        const int rl0 = wr * 64 + fr, col0 = upn * 256 + wc * 32 + 8 * fq;
        if (u.aux) {
            float* hc = (float*)((char*)HC - WS_HC + WS_YD) + ((size_t)(u.aux - 1) * (NB * CTX) + (size_t)(upm / PPB) * 256) * D;
#pragma unroll
            for (int bj = 0; bj < 2; ++bj) { const f32x4 gv0 = *(const f32x4*)(gate + (size_t)mi * NMOD + col0 + bj * 128), gv1 = *(const f32x4*)(gate + (size_t)mi * NMOD + col0 + bj * 128 + 4);
#pragma unroll
                for (int ai = 0; ai < 2; ++ai)
#pragma unroll
                    for (int m = 0; m < 4; ++m) { float* p = hc + (size_t)(rl0 + ai * 128 + m * 16) * D + col0 + bj * 128; *(f32x4*)p = gv0 * acc[ai][bj][m][0]; *(f32x4*)(p + 4) = gv1 * acc[ai][bj][m][1]; } }
            return;
        }
#pragma unroll
        for (int bj = 0; bj < 2; ++bj) { const int c = col0 + bj * 128;
            const f32x4 gv0 = *(const f32x4*)(gate + (size_t)mi * NMOD + c), gv1 = *(const f32x4*)(gate + (size_t)mi * NMOD + c + 4);
            const f32x4 g0 = *(const f32x4*)(lng + c) * DN_ALPHA, g1 = *(const f32x4*)(lng + c + 4) * DN_ALPHA, b0 = *(const f32x4*)(lnb + c) * DN_ALPHA, b1 = *(const f32x4*)(lnb + c + 4) * DN_ALPHA;
#pragma unroll
            for (int ai = 0; ai < 2; ++ai) {
                u32x4 tv[4]; f32x2 st[4];
#pragma unroll
                for (int m = 0; m < 4; ++m) { const size_t row = (size_t)(upm * 256 + rl0 + ai * 128 + m * 16); tv[m] = *(const u32x4*)(H + row * D + c); st[m] = *(const f32x2*)(stats + row * 2); }
                asm volatile("s_waitcnt vmcnt(0)" ::: "memory");
#pragma unroll
                for (int m = 0; m < 4; ++m) { const h16x4 ha = __builtin_bit_cast(h16x4, (u32x2){tv[m].x, tv[m].y}), hb = __builtin_bit_cast(h16x4, (u32x2){tv[m].z, tv[m].w});
                    const f32x4 t0 = (f32x4){(float)ha[0], (float)ha[1], (float)ha[2], (float)ha[3]}, t1 = (f32x4){(float)hb[0], (float)hb[1], (float)hb[2], (float)hb[3]};
                    const f32x4 o0 = (t0 - st[m].x) * st[m].y * g0 + b0 + gv0 * acc[ai][bj][m][0], o1 = (t1 - st[m].x) * st[m].y * g1 + b1 + gv1 * acc[ai][bj][m][1];
                    h16x4 qa, qb; qa[0] = (_Float16)o0[0]; qa[1] = (_Float16)o0[1]; qa[2] = (_Float16)o0[2]; qa[3] = (_Float16)o0[3]; qb[0] = (_Float16)o1[0]; qb[1] = (_Float16)o1[1]; qb[2] = (_Float16)o1[2]; qb[3] = (_Float16)o1[3];
                    const u32x2 pa = __builtin_bit_cast(u32x2, qa), pb = __builtin_bit_cast(u32x2, qb);
                    *(u32x4*)(H + (size_t)(upm * 256 + rl0 + ai * 128 + m * 16) * D + c) = (u32x4){pa.x, pa.y, pb.x, pb.y}; } } }
    }
};
struct EpiProj {
    static constexpr bool PERM = true;
    bf16_t* P; float* DT; const float* rc; const float* rs; bf16_t* U2;
    __device__ __forceinline__ void operator()(const f32x4 (&acc)[2][2][4][2], const pg8::Unit& u, int wr, int wc, int, int) const { const int ln_ = lane_now(); const int fr = ln_ & 15, fq = ln_ >> 4;
        const int pp = u.pm % PPB; const int row0 = u.pm * 256 + wr * 64 + fr;
        const int pn = u.pn;
        if (pn == 52) {
            if (wc == 0) {
#pragma unroll
                for (int ai = 0; ai < 2; ++ai)
#pragma unroll
                    for (int m = 0; m < 4; ++m)
#pragma unroll
                        for (int n = 0; n < 2; ++n) *(f32x4*)(DT + (size_t)(row0 + ai * 128 + m * 16) * 32 + 8 * fq + 4 * n) = acc[ai][0][m][n];
            }
            return;
        }
        if (pn >= 28) {
            const int jg = (pn - 28) >> 3, pnd = (pn - 28) & 7;
            unsigned char* gq = (unsigned char*)P - WS_PROJ + gq_off(jg) + ((size_t)((u.pm * 8 + pnd) * 512 + (wr * 4 + wc) * 64 + ln_)) * 128;
#pragma unroll
            for (int ai = 0; ai < 2; ++ai)
#pragma unroll
                for (int m = 0; m < 4; ++m) { u32x4 w;
#pragma unroll
                    for (int bj = 0; bj < 2; ++bj)
#pragma unroll
                        for (int n = 0; n < 2; ++n) { const f32x4 v = acc[ai][bj][m][n]; unsigned q = 0;
#pragma unroll
                            for (int e = 0; e < 4; ++e) q |= (unsigned)fmaxf(__builtin_rintf(sigmoidf_(v[e]) * 255.0f), 1.0f) << (8 * e);
                            w[bj * 2 + n] = q; }
                    *(u32x4*)(gq + (ai * 4 + m) * 16) = w; }
            return;
        }
        const int col0 = pn * 256 + wc * 32 + 4 * fq;
        const int mode = (pn < 8) ? ((pp != 0) ? 1 : 0) : ((pn >= 12 && pn < 16) ? 2 : 0);
        const float sc = (pn < 4) ? QSCALE : 1.0f;
#pragma unroll
        for (int ai = 0; ai < 2; ++ai) {
          f32x4 csv[4], snv[4];
          if (mode == 1) {
#pragma unroll
              for (int m = 0; m < 4; ++m) { const int rl = ai * 128 + wr * 64 + m * 16 + fr; const int t = (pp - 1) * 256 + rl; const int pos = (wc & 1) ? (t & 63) : (t >> 6); csv[m] = *(const f32x4*)(rc + pos * 16 + 4 * fq); snv[m] = *(const f32x4*)(rs + pos * 16 + 4 * fq); }
              asm volatile("s_waitcnt vmcnt(0)" ::: "memory"); }
#pragma unroll
            for (int m = 0; m < 4; ++m) { const int rl = ai * 128 + wr * 64 + m * 16 + fr; bf16_t* rowp = P + (size_t)(u.pm * 256 + rl) * LDP + col0;
                f32x4 cs = (f32x4){1.f, 1.f, 1.f, 1.f}, sn = (f32x4){0.f, 0.f, 0.f, 0.f};
                if (mode == 1) { cs = csv[m]; sn = snv[m]; }
#pragma unroll
                for (int bj = 0; bj < 2; ++bj) { f32x4 v0 = acc[ai][bj][m][0], v1 = acc[ai][bj][m][1];
                    if (mode == 1) { const f32x4 o0 = v0 * cs - v1 * sn, o1 = v1 * cs + v0 * sn; v0 = o0; v1 = o1; }
                    else if (mode == 2) {
#pragma unroll
                        for (int e = 0; e < 4; ++e) { v0[e] = siluf_(v0[e]); v1[e] = siluf_(v1[e]); } }
                    if (pn >= 24 && pn < 28) {
                        const int cu = (pn - 24) * 256 + bj * 128 + wc * 32 + 8 * fq;
                        bf16_t* u2 = U2 + ((size_t)(cu >> 4) * R + (size_t)(u.pm * 256 + rl)) * 16 + (cu & 15);
                        u32x4 a; a.x = cvt_pk_bf16(v0[0], v0[1]); a.y = cvt_pk_bf16(v0[2], v0[3]); a.z = cvt_pk_bf16(v1[0], v1[1]); a.w = cvt_pk_bf16(v1[2], v1[3]);
                        *(u32x4*)u2 = a; continue; }
                    v0 = v0 * sc; v1 = v1 * sc;
                    if (pn < 8) { u32x2 w0, w1; w0.x = cvt_pk_bf16(v0[0], v0[1]); w0.y = cvt_pk_bf16(v0[2], v0[3]); w1.x = cvt_pk_bf16(v1[0], v1[1]); w1.y = cvt_pk_bf16(v1[2], v1[3]);
                        *(u32x2*)(rowp + bj * 128) = w0; *(u32x2*)(rowp + bj * 128 + 16) = w1; }
                    else { u32x4 w; w.x = cvt_pk_bf16(v0[0], v0[1]); w.y = cvt_pk_bf16(v0[2], v0[3]); w.z = cvt_pk_bf16(v1[0], v1[1]); w.w = cvt_pk_bf16(v1[2], v1[3]);
                        *(u32x4*)(rowp + 4 * fq + bj * 128) = w; } } } }
    }
};
struct EpiGlu {
    static constexpr bool PERM = false;
    bf16_t* P; const float* bias;
    __device__ __forceinline__ void operator()(const f32x4 (&acc)[2][2][4][2], const pg8::Unit& u, int wr, int wc, int, int) const { const int ln_ = lane_now(); const int fr = ln_ & 15, fq = ln_ >> 4;
        const int row0 = u.pm * 256 + wr * 64 + fr, col0 = u.pn * 256 + wc * 32 + 4 * fq;
        f32x4 bv[2][2];
#pragma unroll
        for (int bj = 0; bj < 2; ++bj)
#pragma unroll
            for (int n = 0; n < 2; ++n) bv[bj][n] = *(const f32x4*)(bias + col0 + bj * 128 + n * 16);
#pragma unroll
        for (int ai = 0; ai < 2; ++ai) {
            u32x2 tv[4][2][2];
#pragma unroll
            for (int m = 0; m < 4; ++m)
#pragma unroll
                for (int bj = 0; bj < 2; ++bj)
#pragma unroll
                    for (int n = 0; n < 2; ++n) tv[m][bj][n] = *(const u32x2*)(P + (size_t)(row0 + ai * 128 + m * 16) * LDP + PU + col0 + bj * 128 + n * 16);
            asm volatile("s_waitcnt vmcnt(0)" ::: "memory");
#pragma unroll
            for (int m = 0; m < 4; ++m) { bf16_t* rowp = P + (size_t)(row0 + ai * 128 + m * 16) * LDP;
#pragma unroll
                for (int bj = 0; bj < 2; ++bj)
#pragma unroll
                    for (int n = 0; n < 2; ++n) { const int c = col0 + bj * 128 + n * 16; const u32x2 t = tv[m][bj][n];
                        const f32x4 a = acc[ai][bj][m][n] + bv[bj][n]; u32x2 w;
                        w.x = cvt_pk_bf16(bflo(t.x) * sigmoidf_(a[0]), bfhi(t.x) * sigmoidf_(a[1])); w.y = cvt_pk_bf16(bflo(t.y) * sigmoidf_(a[2]), bfhi(t.y) * sigmoidf_(a[3]));
                        *(u32x2*)(rowp + PK + c) = w; } } }
    }
};
struct EpiMerge {
    static constexpr bool PERM = true;
    const bf16_t* P; bf16_t* MIXB;
    static __device__ __forceinline__ int jmap(int seg) { return seg == 0 ? 0 : (seg == 1 ? 2 : 1); }
    __device__ __forceinline__ const unsigned char* gbase(const pg8::Unit& u, int seg, int wr, int wc, int ln_) const {
        return (const unsigned char*)P - WS_PROJ + gq_off(jmap(seg)) + ((size_t)((u.pm * 8 + u.pn) * 512 + (wr * 4 + wc) * 64 + ln_)) * 128; }
    __device__ __forceinline__ void mid(f32x4 (&acc)[2][2][4][2], const pg8::Unit& u, int seg, int wr, int wc) const {
        const int ln_ = lane_now(); const unsigned char* ga = gbase(u, seg - 1, wr, wc, ln_); const unsigned char* gb = gbase(u, seg, wr, wc, ln_);
        u32x4 a[2][4], b[2][4];
#pragma unroll
        for (int ai = 0; ai < 2; ++ai)
#pragma unroll
            for (int m = 0; m < 4; ++m) { a[ai][m] = *(const u32x4*)(ga + (ai * 4 + m) * 16); b[ai][m] = *(const u32x4*)(gb + (ai * 4 + m) * 16); }
        asm volatile("s_waitcnt vmcnt(0)" ::: "memory");
#pragma unroll
        for (int ai = 0; ai < 2; ++ai)
#pragma unroll
            for (int m = 0; m < 4; ++m)
#pragma unroll
                for (int bj = 0; bj < 2; ++bj)
#pragma unroll
                    for (int n = 0; n < 2; ++n) { const unsigned qa = a[ai][m][bj * 2 + n], qb = b[ai][m][bj * 2 + n]; f32x4 r;
#pragma unroll
                        for (int e = 0; e < 4; ++e) r[e] = (float)((qa >> (8 * e)) & 255u) * __builtin_amdgcn_rcpf((float)((qb >> (8 * e)) & 255u));
                        acc[ai][bj][m][n] = acc[ai][bj][m][n] * r; }
    }
    __device__ __forceinline__ void operator()(const f32x4 (&acc)[2][2][4][2], const pg8::Unit& u, int wr, int wc, int, int) const { const int ln_ = lane_now(); const int fr = ln_ & 15, fq = ln_ >> 4;
        const int row0 = u.pm * 256 + wr * 64 + fr, col0 = u.pn * 256 + wc * 32 + 8 * fq; const unsigned char* gl = gbase(u, 2, wr, wc, ln_);
        u32x4 gq[2][4];
#pragma unroll
        for (int ai = 0; ai < 2; ++ai)
#pragma unroll
            for (int m = 0; m < 4; ++m) gq[ai][m] = *(const u32x4*)(gl + (ai * 4 + m) * 16);
        asm volatile("s_waitcnt vmcnt(0)" ::: "memory");
#pragma unroll
        for (int ai = 0; ai < 2; ++ai)
#pragma unroll
            for (int m = 0; m < 4; ++m) { const size_t row = (size_t)(row0 + ai * 128 + m * 16); const u32x4 g4 = gq[ai][m];
#pragma unroll
                for (int bj = 0; bj < 2; ++bj) { u32x4 w;
#pragma unroll
                    for (int n = 0; n < 2; ++n) { const unsigned gv = g4[bj * 2 + n];
                        f32x4 v = acc[ai][bj][m][n];
#pragma unroll
                        for (int e = 0; e < 4; ++e) v[e] *= (float)((gv >> (8 * e)) & 255u) * (1.0f / 255.0f);
                        w[2 * n] = cvt_pk_bf16(v[0], v[1]); w[2 * n + 1] = cvt_pk_bf16(v[2], v[3]); }
                    *(u32x4*)(MIXB + row * D + col0 + bj * 128) = w; } }
    }
};

struct S5AOrder {
    int G, c; const char* A; const char* B;
    __device__ __forceinline__ bool next(int i, pg8::Unit& u) const {
        const int idx = i * G + c; if (idx >= 640) return false;
        const int g = idx / 10, r = idx - 10 * g, nt = r / 5, mt = r - 5 * nt;
        u.pm = mt; u.pn = nt; u.aux = g; u.kt = 4; u.a = A + ((size_t)g * (R / 16) + (size_t)mt * 256) * 256 * 2; u.b = B + (size_t)(g * 512 + nt * 256) * 256 * 2; return true;
    }
};
struct EpiS5A {
    static constexpr bool PERM = false;
    unsigned char* YLF; bf16_t* ST;
    __device__ __forceinline__ void operator()(const f32x4 (&acc)[2][2][4][2], const pg8::Unit& u, int wr, int wc, int, int) const { const int ln_ = lane_now(); const int fr = ln_ & 15, fq = ln_ >> 4;
        const int g = u.aux;
        if (u.pn == 0) { unsigned char* yl = YLF + ((size_t)((g * 5 + u.pm) * 512 + (wr * 4 + wc) * 64 + ln_)) * 256;
#pragma unroll
            for (int ai = 0; ai < 2; ++ai)
#pragma unroll
                for (int m = 0; m < 4; ++m) { u32x4 w0, w1;
                    w0.x = cvt_pk_bf16(acc[ai][0][m][0][0], acc[ai][0][m][0][1]); w0.y = cvt_pk_bf16(acc[ai][0][m][0][2], acc[ai][0][m][0][3]); w0.z = cvt_pk_bf16(acc[ai][0][m][1][0], acc[ai][0][m][1][1]); w0.w = cvt_pk_bf16(acc[ai][0][m][1][2], acc[ai][0][m][1][3]);
                    w1.x = cvt_pk_bf16(acc[ai][1][m][0][0], acc[ai][1][m][0][1]); w1.y = cvt_pk_bf16(acc[ai][1][m][0][2], acc[ai][1][m][0][3]); w1.z = cvt_pk_bf16(acc[ai][1][m][1][0], acc[ai][1][m][1][1]); w1.w = cvt_pk_bf16(acc[ai][1][m][1][2], acc[ai][1][m][1][3]);
                    *(u32x4*)(yl + (ai * 4 + m) * 32) = w0; *(u32x4*)(yl + (ai * 4 + m) * 32 + 16) = w1; }
            return; }
#pragma unroll
        for (int ai = 0; ai < 2; ++ai)
#pragma unroll
            for (int m = 0; m < 4; ++m) { const int mr = u.pm * 256 + ai * 128 + wr * 64 + m * 16 + fr; if (mr < S5M) {
#pragma unroll
                for (int bj = 0; bj < 2; ++bj)
#pragma unroll
                    for (int n = 0; n < 2; ++n) { const f32x4 v = acc[ai][bj][m][n];
                        u32x2 w; w.x = cvt_pk_bf16(v[0], v[1]); w.y = cvt_pk_bf16(v[2], v[3]); *(u32x2*)(ST + ((size_t)g * S5M + mr) * 256 + bj * 128 + wc * 32 + n * 16 + 4 * fq) = w; } } }
    }
};
struct S5COrder {
    int G, c; const char* A; const char* B;
    __device__ __forceinline__ bool next(int i, pg8::Unit& u) const {
        const int idx = i * G + c; if (idx >= 320) return false;
        const int g = idx / 5, mt = idx - 5 * g;
        u.pm = mt; u.pn = 0; u.aux = g; u.kt = 4; u.a = A + ((size_t)g * 1280 + mt * 256) * 256 * 2; u.b = B + (size_t)g * 256 * 256 * 2; return true;
    }
};
struct EpiS5C {
    static constexpr bool PERM = false;
    const unsigned char* YLF; bf16_t* P;
    __device__ __forceinline__ void operator()(const f32x4 (&acc)[2][2][4][2], const pg8::Unit& u, int wr, int wc, int, int) const { const int ln_ = lane_now(); const int fr = ln_ & 15, fq = ln_ >> 4;
        const int g = u.aux; const unsigned char* yl = YLF + ((size_t)((g * 5 + u.pm) * 512 + (wr * 4 + wc) * 64 + ln_)) * 256;
#pragma unroll
        for (int ai = 0; ai < 2; ++ai) {
        u32x4 y0[2][4], y1[2][4];
#pragma unroll
            for (int m = 0; m < 4; ++m) { y0[ai][m] = *(const u32x4*)(yl + (ai * 4 + m) * 32); y1[ai][m] = *(const u32x4*)(yl + (ai * 4 + m) * 32 + 16); }
        asm volatile("s_waitcnt vmcnt(0)" ::: "memory");
#pragma unroll
            for (int m = 0; m < 4; ++m) { const int mr = u.pm * 256 + ai * 128 + wr * 64 + m * 16 + fr; if (mr < S5M) {
#pragma unroll
                for (int bj = 0; bj < 2; ++bj)
#pragma unroll
                    for (int n = 0; n < 2; ++n) { const int rho = 8 * bj + 2 * wc + n; const size_t row = (size_t)(16 * mr + rho);
                        const u32x4 yy = bj ? y1[ai][m] : y0[ai][m]; const unsigned ya = n ? yy.z : yy.x, yb = n ? yy.w : yy.y; f32x4 v = acc[ai][bj][m][n];
                        v[0] += bflo(ya); v[1] += bfhi(ya); v[2] += bflo(yb); v[3] += bfhi(yb);
#pragma unroll
                        for (int e = 0; e < 4; ++e) { const float x = v[e]; const float inner = 0.7978845608028654f * (x + 0.044715f * x * x * x); const float th = 1.0f - 2.0f * __builtin_amdgcn_rcpf(1.0f + __builtin_amdgcn_exp2f(2.8853900817779268f * inner)); v[e] = 0.5f * x * (1.0f + th); }
                        u32x2 w; w.x = cvt_pk_bf16(v[0], v[1]); w.y = cvt_pk_bf16(v[2], v[3]); *(u32x2*)(P + row * LDP + PU + 16 * g + 4 * fq) = w; } } } }
    }
};

namespace attn128 {
using bf16 = __hip_bfloat16;
constexpr int NW = 8, QBLK = 32, KVBLK = 64, LDQ = LDP, LDK = LDP, LDOB = LDP;
constexpr size_t SHM_V = KVBLK * 128 * 2, SHM_K = KVBLK * 64 * 2, SHM_ATTN = 2 * SHM_V + 2 * SHM_K + NW * 64 * 4, SHM_TOTAL = SHM_ATTN + NW * 8192;
constexpr float THRL = 11.5f;
#define A128_KSWZ(row, colB) ((row) * 128 + ((colB) ^ (((row) & 7) << 4)))
#define A128_SBAR() __builtin_amdgcn_sched_barrier(0)
__device__ __forceinline__ int crow(int r, int hi) { return (r & 3) + 8 * (r >> 2) + 4 * hi; }
__device__ __forceinline__ void partialSM(f32x16& p0, f32x16& p1, float& m_reg, float& mn, float& alpha) {
  float pmax = p0[0];
#pragma unroll
  for (int r = 1; r < 16; ++r) pmax = fmaxf(pmax, p0[r]);
#pragma unroll
  for (int r = 0; r < 16; ++r) pmax = fmaxf(pmax, p1[r]);
  { auto rr = __builtin_amdgcn_permlane32_swap(__float_as_uint(pmax), __float_as_uint(pmax), false, false); pmax = fmaxf(__uint_as_float(rr[0]), __uint_as_float(rr[1])); }
  if (__builtin_expect(__all(pmax - m_reg <= THRL), 1)) { mn = m_reg; alpha = 1.f; }
  else { mn = fmaxf(m_reg, pmax); alpha = __builtin_amdgcn_exp2f(m_reg - mn); m_reg = mn; }
#pragma unroll
  for (int r = 0; r < 16; ++r) { p0[r] = p0[r] - mn; p1[r] = p1[r] - mn; }
#pragma unroll
  for (int r = 0; r < 16; ++r) p0[r] = __builtin_amdgcn_exp2f(p0[r]);
}
__device__ __forceinline__ void finishSM(f32x16& p0, f32x16& p1, float alpha, float& l_reg, bf16x8& pa0, bf16x8& pa1, bf16x8& pa2, bf16x8& pa3) {
#pragma unroll
  for (int r = 0; r < 16; ++r) p1[r] = __builtin_amdgcn_exp2f(p1[r]);
  float ps = 0;
#pragma unroll
  for (int r = 0; r < 16; ++r) ps += p0[r];
#pragma unroll
  for (int r = 0; r < 16; ++r) ps += p1[r];
  { auto rr = __builtin_amdgcn_permlane32_swap(__float_as_uint(ps), __float_as_uint(ps), false, false); ps = __uint_as_float(rr[0]) + __uint_as_float(rr[1]); }
  l_reg = l_reg * alpha + ps;
#define A128_PK4(P, BASE, OUT) do { unsigned a0 = cvt_pk_bf16(P[BASE + 0], P[BASE + 1]), a1 = cvt_pk_bf16(P[BASE + 2], P[BASE + 3]);   \
    unsigned b0 = cvt_pk_bf16(P[BASE + 4], P[BASE + 5]), b1 = cvt_pk_bf16(P[BASE + 6], P[BASE + 7]);                              \
    auto r0 = __builtin_amdgcn_permlane32_swap(a0, b0, false, false); auto r1 = __builtin_amdgcn_permlane32_swap(a1, b1, false, false); \
    u32x4 w = {r0[0], r1[0], r0[1], r1[1]}; OUT = __builtin_bit_cast(bf16x8, w); } while (0)
  A128_PK4(p0, 0, pa0); A128_PK4(p0, 8, pa1); A128_PK4(p1, 0, pa2); A128_PK4(p1, 8, pa3);
#undef A128_PK4
}
__device__ __forceinline__ void qkt(f32x16& p0, f32x16& p1, const char* Ks, const bf16x8* qr, int r32, int hi) {
#pragma unroll
  for (int i = 0; i < 16; ++i) { p0[i] = 0.f; p1[i] = 0.f; }
#pragma unroll
  for (int d0 = 0; d0 < 4; ++d0) { const int cb = (d0 * 16 + hi * 8) * 2;
    const bf16x8 b0 = *reinterpret_cast<const bf16x8*>(Ks + A128_KSWZ(r32, cb));
    const bf16x8 b1 = *reinterpret_cast<const bf16x8*>(Ks + A128_KSWZ(32 + r32, cb));
    p0 = __builtin_amdgcn_mfma_f32_32x32x16_bf16(b0, qr[d0], p0, 0, 0, 0);
    p1 = __builtin_amdgcn_mfma_f32_32x32x16_bf16(b1, qr[d0], p1, 0, 0, 0); }
}
__device__ __forceinline__ int v_st(int k, int c) { const int kk = (k & ~0xC) | ((k & 4) << 1) | ((k & 8) >> 1); return ((kk >> 3) * 4 + (c >> 5)) * 512 + ((kk & 7) * 32 + (c & 31)) * 2; }
__device__ __forceinline__ int v_rd_base(int lane) { return ((lane & 3) << 3) | (((lane >> 2) & 3) << 6) | (((lane >> 4) & 1) << 5) | (((lane >> 5) & 1) << 8); }
constexpr int v_rd_off(int d0, int ks, int half) { return d0 * 512 + ks * 4096 + half * 2048; }
template <int OFF> __device__ __forceinline__ s16x4 tr_read(int vb) { s16x4 r; asm volatile("ds_read_b64_tr_b16 %0, %1 offset:%2" : "=&v"(r) : "v"(vb), "i"(OFF) : "memory"); return r; }
template <int D0> __device__ __forceinline__ void pv_one(f32x16& od, int vb, bf16x8 pa0, bf16x8 pa1, bf16x8 pa2, bf16x8 pa3) {
  const s16x4 l0 = tr_read<v_rd_off(D0, 0, 0)>(vb), h0 = tr_read<v_rd_off(D0, 0, 1)>(vb), l1 = tr_read<v_rd_off(D0, 1, 0)>(vb), h1 = tr_read<v_rd_off(D0, 1, 1)>(vb);
  const s16x4 l2 = tr_read<v_rd_off(D0, 2, 0)>(vb), h2 = tr_read<v_rd_off(D0, 2, 1)>(vb), l3 = tr_read<v_rd_off(D0, 3, 0)>(vb), h3 = tr_read<v_rd_off(D0, 3, 1)>(vb);
  asm volatile("s_waitcnt lgkmcnt(0)" ::: "memory"); A128_SBAR();
#define A128_PK(L, H) (bf16x8){L[0], L[1], L[2], L[3], H[0], H[1], H[2], H[3]}
  od = __builtin_amdgcn_mfma_f32_32x32x16_bf16(pa0, A128_PK(l0, h0), od, 0, 0, 0);
  od = __builtin_amdgcn_mfma_f32_32x32x16_bf16(pa1, A128_PK(l1, h1), od, 0, 0, 0);
  od = __builtin_amdgcn_mfma_f32_32x32x16_bf16(pa2, A128_PK(l2, h2), od, 0, 0, 0);
  od = __builtin_amdgcn_mfma_f32_32x32x16_bf16(pa3, A128_PK(l3, h3), od, 0, 0, 0);
#undef A128_PK
}
__device__ __forceinline__ void pv_d0(f32x16* o, int vb, bf16x8 pa0, bf16x8 pa1, bf16x8 pa2, bf16x8 pa3) {
  pv_one<0>(o[0], vb, pa0, pa1, pa2, pa3); pv_one<1>(o[1], vb, pa0, pa1, pa2, pa3); pv_one<2>(o[2], vb, pa0, pa1, pa2, pa3); pv_one<3>(o[3], vb, pa0, pa1, pa2, pa3);
}
__device__ __forceinline__ void unit(const bf16* __restrict__ Qb0, const bf16* __restrict__ Kh0, const bf16* __restrict__ Vh, bf16_t* Ob, int seq, char* lds, const int tid_in, const float lam, const float onem, const float* __restrict__ subw) {
#pragma unroll 1
 for (int mp = 0; mp < 2; ++mp) {
  int tid = tid_in; asm volatile("" : "+v"(tid));
  bf16_t* stage = (bf16_t*)(lds + SHM_ATTN) + (tid >> 6) * 4096;
  const bf16* Qb = Qb0 + mp * 64; const bf16* Kh = Kh0 + mp * 64;
  const int wid = __builtin_amdgcn_readfirstlane(tid >> 6), lane = tid & 63, r32 = lane & 31, hi = lane >> 5;
  char* V_lds = lds; char* K_lds = lds + 2 * SHM_V;
  float* ws = (float*)(lds + 2 * SHM_V + 2 * SHM_K) + wid * 64; float* li_l = ws; float* al_l = ws + 32;
  float m_reg = -1e30f, l_reg = 0; f32x16 o[4]; bf16x8 qr[4];
#pragma unroll
  for (int d = 0; d < 4; ++d)
#pragma unroll
    for (int r = 0; r < 16; ++r) o[d][r] = 0.f;
  const bf16* Qw = Qb + (long)(wid * QBLK + r32) * LDQ + hi * 8;
#pragma unroll
  for (int d0 = 0; d0 < 4; ++d0) qr[d0] = *reinterpret_cast<const bf16x8*>(Qw + d0 * 16);
  const int sr = tid >> 4, sc = (tid & 15) * 8, vst0 = v_st(sr, sc), vst1 = v_st(32 + sr, sc);
  const int kr = tid >> 3, kc = (tid & 7) * 8, kst = A128_KSWZ(kr, kc * 2);
  const int vb0 = (int)(uintptr_t)V_lds + v_rd_base(lane);
  struct { bf16x8 vs0, vs1, ks0; } sr_[2];
#define A128_SLOAD(i, k0) do { sr_[i].vs0 = *reinterpret_cast<const bf16x8*>(&Vh[(long)((k0) + sr) * LDK + sc]); sr_[i].vs1 = *reinterpret_cast<const bf16x8*>(&Vh[(long)((k0) + 32 + sr) * LDK + sc]); \
    sr_[i].ks0 = *reinterpret_cast<const bf16x8*>(&Kh[(long)((k0) + kr) * LDK + kc]); } while (0)
#define A128_SWRITE(b, i) do { *(bf16x8*)(V_lds + (b) * SHM_V + vst0) = sr_[i].vs0; *(bf16x8*)(V_lds + (b) * SHM_V + vst1) = sr_[i].vs1; *(bf16x8*)(K_lds + (b) * SHM_K + kst) = sr_[i].ks0; } while (0)
#define A128_SWAIT() asm volatile("s_waitcnt vmcnt(3)" ::: "memory")
#define A128_RESC(a) do { if (__any((a) < 1.f)) { if (hi == 0) al_l[r32] = (a); asm volatile("s_waitcnt lgkmcnt(0)" ::: "memory"); \
    _Pragma("unroll") for (int d = 0; d < 4; ++d) _Pragma("unroll") for (int r = 0; r < 16; ++r) o[d][r] *= al_l[crow(r, hi)]; } } while (0)
  f32x16 pA0, pA1, pB0, pB1; float mnA, mnB, alA, alB; bf16x8 pa0, pa1, pa2, pa3; const int NT = seq / KVBLK;
  A128_SLOAD(0, 0); asm volatile("s_waitcnt vmcnt(0)" ::: "memory"); A128_SWRITE(0, 0); __syncthreads();
  qkt(pA0, pA1, K_lds, qr, r32, hi); partialSM(pA0, pA1, m_reg, mnA, alA);
  A128_SLOAD(1, KVBLK); if (2 < NT) A128_SLOAD(0, 2 * KVBLK);
  A128_SWAIT(); A128_SWRITE(1, 1); __syncthreads();
  for (int j = 1; j + 1 < NT; j += 2) {
    A128_SBAR(); qkt(pB0, pB1, K_lds + SHM_K, qr, r32, hi);
    finishSM(pA0, pA1, alA, l_reg, pa0, pa1, pa2, pa3); A128_SBAR();
    A128_SLOAD(1, (j + 2) * KVBLK); A128_SBAR();
    pv_d0(o, vb0, pa0, pa1, pa2, pa3); partialSM(pB0, pB1, m_reg, mnB, alB);
    __syncthreads(); A128_SWAIT(); A128_SWRITE(0, 0);
    A128_RESC(alB); __syncthreads();
    A128_SBAR(); qkt(pA0, pA1, K_lds, qr, r32, hi);
    finishSM(pB0, pB1, alB, l_reg, pa0, pa1, pa2, pa3); A128_SBAR();
    if (j + 3 < NT) A128_SLOAD(0, (j + 3) * KVBLK); A128_SBAR();
    pv_d0(o, vb0 + (int)SHM_V, pa0, pa1, pa2, pa3); partialSM(pA0, pA1, m_reg, mnA, alA);
    __syncthreads(); A128_SWAIT(); A128_SWRITE(1, 1);
    A128_RESC(alA); __syncthreads();
  }
  A128_SBAR(); qkt(pB0, pB1, K_lds + SHM_K, qr, r32, hi);
  finishSM(pA0, pA1, alA, l_reg, pa0, pa1, pa2, pa3); A128_SBAR();
  pv_d0(o, vb0, pa0, pa1, pa2, pa3); partialSM(pB0, pB1, m_reg, mnB, alB);
  __syncthreads(); A128_RESC(alB);
  finishSM(pB0, pB1, alB, l_reg, pa0, pa1, pa2, pa3); A128_SBAR();
  pv_d0(o, vb0 + (int)SHM_V, pa0, pa1, pa2, pa3);
  if (hi == 0) li_l[r32] = l_reg; asm volatile("s_waitcnt lgkmcnt(0)" ::: "memory");
  float rli[16];
#pragma unroll
  for (int r = 0; r < 16; ++r) rli[r] = __builtin_amdgcn_rcpf(li_l[crow(r, hi)]);
  if (mp == 0) {
#pragma unroll
    for (int r = 0; r < 16; ++r)
#pragma unroll
      for (int d0 = 0; d0 < 4; ++d0) stage[(r * 4 + d0) * 64 + lane] = (bf16_t)(cvt_pk_bf16(o[d0][r] * rli[r], 0.f) & 0xffffu);
  } else {
    float ss[16];
#pragma unroll
    for (int r = 0; r < 16; ++r) { float q = 0.f;
#pragma unroll
      for (int d0 = 0; d0 < 4; ++d0) { const float a = bf1(stage[(r * 4 + d0) * 64 + lane]) - lam * bf1((bf16_t)(cvt_pk_bf16(o[d0][r] * rli[r], 0.f) & 0xffffu)); o[d0][r] = a; q += a * a; }
      ss[r] = q; }
#pragma unroll
    for (int m = 1; m < 32; m <<= 1)
#pragma unroll
      for (int r = 0; r < 16; ++r) ss[r] += __int_as_float(__builtin_amdgcn_ds_bpermute((lane ^ m) << 2, __float_as_int(ss[r])));
    float sw[4];
#pragma unroll
    for (int d0 = 0; d0 < 4; ++d0) sw[d0] = subw[d0 * 32 + r32] * onem;
    bf16_t* Ow = Ob + (long)(wid * QBLK) * LDOB;
#pragma unroll
    for (int r = 0; r < 16; ++r) { const int orow = crow(r, hi); const float rs = 1.0f / sqrtf(ss[r] * (1.f / 128.f) + RMS_EPS);
#pragma unroll
      for (int d0 = 0; d0 < 4; ++d0) Ow[(long)orow * LDOB + d0 * 32 + r32] = (bf16_t)(cvt_pk_bf16(o[d0][r] * rs * sw[d0], 0.f) & 0xffffu); }
  }
  __syncthreads();
 }
#undef A128_SLOAD
#undef A128_SWRITE
#undef A128_SWAIT
#undef A128_RESC
}
#undef A128_KSWZ
#undef A128_SBAR
}

#define XB_TMO      128
#define XB_XCNT(j)  (256  + 64 * (j))
#define XB_XSUB(j)  (1280 + 64 * (j))
#define XB_XGEN(j)  (2304 + 64 * (j))
#define XB_TOP      3328
#define XB_TOPGEN   3392
#define XCD_BAR_WORDS 3456
#define XB_SPIN_CAP (1u << 18)
__device__ __forceinline__ unsigned xb_ld(unsigned* p)              { return __hip_atomic_load(p, __ATOMIC_RELAXED, __HIP_MEMORY_SCOPE_AGENT); }
__device__ __forceinline__ unsigned xb_add(unsigned* p, unsigned v) { return __hip_atomic_fetch_add(p, v, __ATOMIC_RELAXED, __HIP_MEMORY_SCOPE_AGENT); }
__device__ __forceinline__ unsigned xb_xcc_id() { return (unsigned)__builtin_amdgcn_s_getreg((3 << 11) | 20) & 0xFu; }
#define XB_SPIN(cond, bar) do { unsigned _sp = 0; while (cond) { __builtin_amdgcn_s_sleep(1); \
    if ((++_sp & 255u) == 0u) { if (xb_ld(&(bar)[XB_TMO])) break; if (_sp > XB_SPIN_CAP) { atomicAdd(&(bar)[XB_TMO], 1u); break; } } } } while (0)
struct XcdBarrier { unsigned* bar; unsigned x; volatile LAS unsigned* st; };
__device__ __forceinline__ XcdBarrier xcd_barrier_post(unsigned* bar, volatile LAS unsigned* st) {
    XcdBarrier b; b.bar = bar; b.x = xb_xcc_id(); b.st = st;
    if (threadIdx.x == 0) (void)xb_add(&bar[XB_XCNT(b.x)], 1u);
    return b;
}
__device__ __forceinline__ void xcd_barrier_complete(unsigned* bar, unsigned x, unsigned& nloc, unsigned& nx) {
    const unsigned G = gridDim.x * gridDim.y * gridDim.z;
    unsigned sum, cnt, mine, sp = 0u;
    for (;;) {
        sum = 0u; cnt = 0u; mine = 0u;
#pragma unroll
        for (unsigned j = 0; j < 16; ++j) { const unsigned c = xb_ld(&bar[XB_XCNT(j)]); sum += c; cnt += (c > 0u) ? 1u : 0u; mine = (j == x) ? c : mine; }
        if (sum == G) break;
        __builtin_amdgcn_s_sleep(1);
        if ((++sp & 255u) == 0u) { if (xb_ld(&bar[XB_TMO])) break; if (sp > XB_SPIN_CAP) { atomicAdd(&bar[XB_TMO], 1u); break; } }
    }
    nloc = mine > 0u ? mine : 1u; nx = cnt > 0u ? cnt : 1u;
}
__device__ __forceinline__ void xcd_barrier(const XcdBarrier& b, const int tid) {
    asm volatile("s_waitcnt vmcnt(0)" ::: "memory");
    __syncthreads();
    if (tid == 0) {
        unsigned* bar = b.bar;
        __builtin_amdgcn_s_waitcnt(0);
        unsigned nloc = b.st[0], nx = b.st[1];
        if (nloc == 0u) { xcd_barrier_complete(bar, b.x, nloc, nx); b.st[0] = nloc; b.st[1] = nx; }
        const unsigned old = xb_add(&bar[XB_XSUB(b.x)], 1u);
        const unsigned gen = old / nloc;
        if (old + 1u == (gen + 1u) * nloc) {
            __builtin_amdgcn_fence(__ATOMIC_RELEASE, "agent");
            asm volatile("s_waitcnt vmcnt(0)" ::: "memory");
            const unsigned og = xb_add(&bar[XB_TOP], 1u);
            const unsigned tg = og / nx;
            if (og + 1u == (tg + 1u) * nx) xb_add(&bar[XB_TOPGEN], 1u);
            else XB_SPIN(xb_ld(&bar[XB_TOPGEN]) == tg, bar);
            __builtin_amdgcn_fence(__ATOMIC_ACQUIRE, "agent");
            xb_add(&bar[XB_XGEN(b.x)], 1u);
            asm volatile("s_waitcnt vmcnt(0)" ::: "memory");
        } else {
            XB_SPIN(xb_ld(&bar[XB_XGEN(b.x)]) == gen, bar);
            __builtin_amdgcn_fence(__ATOMIC_ACQUIRE, "agent");
            asm volatile("s_waitcnt vmcnt(0)" ::: "memory");
        }
    }
    __syncthreads();
}

constexpr int NWAVES = 8;
constexpr int RING_OFF = 0, RING_BYTES = 131072;
constexpr int LDSCTL_OFF = RING_BYTES, MISC_OFF = LDSCTL_OFF + 320;
constexpr int LDS_BYTES = 147456;
static_assert(attn128::SHM_TOTAL <= (size_t)RING_BYTES, "attention scratch fits the ring");

struct Args { const float* in[32]; float* out; unsigned char* ws; int ph_lo, ph_hi; };
constexpr int INTAB_OFF = LDSCTL_OFF + 1024;
__device__ __forceinline__ const float* inptr(LAS unsigned char* lds, int i) {
    const unsigned long long v = ((const LAS unsigned long long*)(lds + INTAB_OFF))[i];
    const unsigned lo = __builtin_amdgcn_readfirstlane((unsigned)v), hi = __builtin_amdgcn_readfirstlane((unsigned)(v >> 32));
    return (const float*)(GAS const float*)(((unsigned long long)hi << 32) | lo);
}
#define INP(i) inptr(F.lds, (i))
struct Frame {
    LAS unsigned char* lds; int tid, lane, wave, vcu, G, gw, NGW;
    unsigned char* ws;
};
enum { I_X = 0, I_C, I_CTX, I_CCTX, I_WMOD, I_BMOD, I_LNG, I_LNB, I_W1, I_W3, I_W2, I_WIN, I_ALAM, I_ASUB, I_CONVW, I_CONVB, I_ALOG, I_DTB, I_SSDD, I_SSDN,
       I_LRE, I_LIM, I_LSTEP, I_BRE, I_BIM, I_CRE, I_CIM, I_S5D, I_GLUW, I_GLUB, I_WBR, I_WOUT };

__device__ __forceinline__ void transpose_item64(const float* srcA, const float* srcB, int ldn, bool p32, bf16_t* dst, int ldk, LAS bf16_t* scr  , int lane) {
    const int q = lane & 15, kr = lane >> 4; const bool isB = q >= 8; const int c = (q & 7) * 4; const float* src = isB ? srcB : srcA;
    f32x4 v[16];
#pragma unroll
    for (int i = 0; i < 16; ++i) v[i] = src ? *(const f32x4*)(src + (size_t)(4 * i + kr) * ldn + c) : (f32x4){0.f, 0.f, 0.f, 0.f};
    const int drow = (p32 ? pg8::perm32(c) : c) + (isB ? 32 : 0);
#pragma unroll
    for (int i = 0; i < 16; ++i) { const int k = 4 * i + kr; const unsigned p01 = cvt_pk_bf16(v[i][0], v[i][1]), p23 = cvt_pk_bf16(v[i][2], v[i][3]);
        scr[(drow + 0) * 72 + k] = (bf16_t)(p01 & 0xffffu); scr[(drow + 1) * 72 + k] = (bf16_t)(p01 >> 16); scr[(drow + 2) * 72 + k] = (bf16_t)(p23 & 0xffffu); scr[(drow + 3) * 72 + k] = (bf16_t)(p23 >> 16); }
    LDS_WAIT(); asm volatile("" ::: "memory");
    const int c8 = lane & 7;
#pragma unroll
    for (int jj = 0; jj < 8; ++jj) { const int n = (lane >> 3) + 8 * jj; *(u32x4*)(dst + (size_t)n * ldk + 8 * c8) = *(const LAS u32x4*)(scr + n * 72 + 8 * c8); }
    LDS_WAIT(); asm volatile("" ::: "memory");
}
__device__ __forceinline__ void convert_layer_weights(const Args& A_, Frame& F, int l) {
    LAS bf16_t* scr = (LAS bf16_t*)(F.lds + RING_OFF + F.wave * 16384);
    unsigned char* W = F.ws + WS_W;
    constexpr int I13 = 32 * 176, I2 = 88 * 32, IIN = 32 * 212, IB = 16 * 32, IO = 32 * 32, IG = 16 * 16;
    constexpr int NIT = 2 * I13 + 2 * I2 + IIN + 3 * IB + IO + IG;
    for (int it = F.gw; it < NIT; it += F.NGW) {
        int r = it;
        if (r < 2 * I13) { const int f = r / I13; r -= f * I13; const int kb = r / 176, nb = r % 176;
            const float* wsrc = (((nb & 3) < 2) ? INP(I_W1) : INP(I_W3)) + ((size_t)(l * 2 + f) * D + 64 * kb) * DFF + 128 * (nb >> 2) + 64 * (nb & 1);
            transpose_item64(wsrc, wsrc + 32, DFF, false, (bf16_t*)(W + W_13) + ((size_t)f * N13 + 64 * nb) * D + 64 * kb, D, scr, F.lane); continue; }
        r -= 2 * I13;
        if (r < 2 * I2) { const int f = r / I2; r -= f * I2; const int kb = r / 32, nb = r % 32;
            const float* w2 = INP(I_W2) + ((size_t)(l * 2 + f) * DFF + 64 * kb) * D + 64 * nb;
            transpose_item64(w2, w2 + 32, D, false, (bf16_t*)(W + W_2) + ((size_t)f * D + 64 * nb) * DFF + 64 * kb, DFF, scr, F.lane); continue; }
        r -= 2 * I2;
        if (r < IIN) { const int kb = r / 212, nb = r % 212; const int n0 = 64 * nb; const float* wb = INP(I_WIN) + ((size_t)l * D + 64 * kb) * 13344;
            const float* sa = nullptr; const float* sb = nullptr;
            if (n0 < 6144) { sa = wb + n0; sb = sa + 32; } else if (n0 < 13312) { sa = wb + n0 + 32; sb = sa + 32; } else if (n0 == 13312) { sa = wb + 6144; }
            transpose_item64(sa, sb, 13344, n0 < 2048, (bf16_t*)(W + W_IN) + (size_t)n0 * D + 64 * kb, D, scr, F.lane); continue; }
        r -= IIN;
        if (r < 3 * IB) { const int jb = r / IB; r -= jb * IB; const int kb = r / 32, nb = r % 32;
            const float* w = INP(I_WBR) + ((size_t)(l * 3 + jb) * 1024 + 64 * kb) * D + 64 * nb;
            const int sp = (jb == 0) ? 0 : (jb == 1 ? 2 : 1); transpose_item64(w, w + 32, D, false, (bf16_t*)(W + W_B) + (size_t)(64 * nb) * 3072 + sp * 1024 + 64 * kb, 3072, scr, F.lane); continue; }
        r -= 3 * IB;
        if (r < IO) { const int kb = r / 32, nb = r % 32; const float* w = INP(I_WOUT) + ((size_t)l * D + 64 * kb) * D + 64 * nb;
            transpose_item64(w, w + 32, D, false, (bf16_t*)(W + W_O) + (size_t)(64 * nb) * D + 64 * kb, D, scr, F.lane); continue; }
        r -= IO;
        { const int kb = r / 16, nb = r % 16; const float* w = INP(I_GLUW) + ((size_t)l * 1024 + 64 * kb) * 1024 + 64 * nb;
            transpose_item64(w, w + 32, 1024, false, (bf16_t*)(W + W_GLU) + (size_t)(64 * nb) * 1024 + 64 * kb, 1024, scr, F.lane); }
    }
}
__device__ __forceinline__ void mod_partials(const Args& A_, Frame& F) {
    float* MODw = (float*)(F.ws + WS_MOD);
    LAS float* sl = (LAS float*)(F.lds + RING_OFF + 98304 + F.wave * 4096);
    const int nskip = (F.G > 64) ? 64 : 0; if ((int)blockIdx.x < nskip) return;
    for (int it = ((int)blockIdx.x - nskip) * NWAVES + F.wave; it < 2 * 72 * 16; it += (F.G - nskip) * NWAVES) {
        const int l = it / (72 * 16), r = it % (72 * 16), ks = r / 72, cg = r % 72;
        const int col = cg * 256 + F.lane * 4; const float* w = INP(I_WMOD) + ((size_t)l * D + ks * 128) * NMOD + col;
        const float* c = INP(I_C) + ks * 128; const float* cc = INP(I_CCTX) + ks * 128;
#pragma unroll
        for (int h = 0; h < 2; ++h) { const int k = F.lane + 64 * h;
            sl[0 * 128 + k] = siluf_(c[k]); sl[1 * 128 + k] = siluf_(c[D + k]); sl[2 * 128 + k] = siluf_(c[2 * D + k]); sl[3 * 128 + k] = siluf_(c[3 * D + k]); sl[4 * 128 + k] = siluf_(cc[k]); }
        LDS_WAIT(); asm volatile("" ::: "memory");
        f32x4 a0 = {0.f, 0.f, 0.f, 0.f}, a1 = a0, a2 = a0, a3 = a0, a4 = a0;
        for (int k0 = 0; k0 < 128; k0 += 16) {
            f32x4 wv[16];
#pragma unroll
            for (int e = 0; e < 16; ++e) wv[e] = *(const f32x4*)(w + (size_t)(k0 + e) * NMOD);
            asm volatile("s_waitcnt vmcnt(0)" ::: "memory");
#pragma unroll
            for (int e = 0; e < 16; ++e) { a0 += wv[e] * sl[0 * 128 + k0 + e]; a1 += wv[e] * sl[1 * 128 + k0 + e]; a2 += wv[e] * sl[2 * 128 + k0 + e]; a3 += wv[e] * sl[3 * 128 + k0 + e]; a4 += wv[e] * sl[4 * 128 + k0 + e]; }
        }
        const int r9 = col / D; const float sc = (r9 == 2 || r9 == 8) ? 0.5f : 1.0f;
        if (ks == 0) { const f32x4 bv = *(const f32x4*)(INP(I_BMOD) + (size_t)l * NMOD + col); a0 += bv; a1 += bv; a2 += bv; a3 += bv; a4 += bv; }
        float* o = MODw + (size_t)l * 5 * NMOD + col;
#pragma unroll
        for (int e = 0; e < 4; ++e) { unsafeAtomicAdd(o + e, a0[e] * sc); unsafeAtomicAdd(o + NMOD + e, a1[e] * sc); unsafeAtomicAdd(o + 2 * NMOD + e, a2[e] * sc); unsafeAtomicAdd(o + 3 * NMOD + e, a3[e] * sc); unsafeAtomicAdd(o + 4 * NMOD + e, a4[e] * sc); }
        LDS_WAIT(); asm volatile("" ::: "memory");
    }
}
__device__ __forceinline__ void ln_pass(Frame& F, bool do_ln, const float* lng, const float* lnb, const float* modnext  , float* out, const float* xin = nullptr, const float* cin = nullptr, int nslab = 0) {
    _Float16* H = (_Float16*)(F.ws + WS_H); const float* SL = (const float*)(F.ws + WS_YD); float* HC = (float*)(F.ws + WS_HC); bf16_t* HM = (bf16_t*)(F.ws + WS_HM); float* ST = (float*)(F.ws + WS_STATS);
    f32x4 G[8], Bv[8];
    if (do_ln) {
#pragma unroll
        for (int i = 0; i < 8; ++i) { G[i] = *(const f32x4*)(lng + 256 * i + 4 * F.lane); Bv[i] = *(const f32x4*)(lnb + 256 * i + 4 * F.lane); }
    }
    for (int row = F.gw; row < R; row += F.NGW) {
        const int b = row / RB, rr = row % RB; const bool isctx = rr < CTX; const int mi = isctx ? 4 : b;
        float* hc = HC + ((size_t)b * CTX + rr) * D; _Float16* hr = H + (size_t)row * D;
        f32x4 v[8], sh4[8], sc4[8]; float s = 0.f;
        if (xin) { const float* src = isctx ? cin + ((size_t)b * CTX + rr) * D : xin + ((size_t)b * SEQ + (rr - CTX)) * D;
#pragma unroll
            for (int i = 0; i < 8; ++i) v[i] = *(const f32x4*)(src + 256 * i + 4 * F.lane);
        } else if (isctx) {
#pragma unroll
            for (int i = 0; i < 8; ++i) v[i] = *(const f32x4*)(hc + 256 * i + 4 * F.lane);
            if (nslab) {
#pragma unroll 1
                for (int q = 0; q < 4; ++q) { f32x4 sv[8];
#pragma unroll
                    for (int i = 0; i < 8; ++i) sv[i] = *(const f32x4*)(SL + ((size_t)q * (NB * CTX) + (size_t)b * CTX + rr) * D + 256 * i + 4 * F.lane);
#pragma unroll
                    for (int i = 0; i < 8; ++i) v[i] = v[i] + sv[i]; } }
        } else {
#pragma unroll
            for (int i = 0; i < 8; ++i) v[i] = ld_h4(hr + 256 * i + 4 * F.lane);
        }
        if (modnext) { const float* sh = modnext + (size_t)mi * NMOD; const float* sc = sh + D;
#pragma unroll
            for (int i = 0; i < 8; ++i) { sh4[i] = *(const f32x4*)(sh + 256 * i + 4 * F.lane); sc4[i] = *(const f32x4*)(sc + 256 * i + 4 * F.lane); } }
        asm volatile("s_waitcnt vmcnt(0)" ::: "memory");
#pragma unroll
        for (int i = 0; i < 8; ++i) s += (v[i][0] + v[i][1]) + (v[i][2] + v[i][3]);
        if (do_ln) {
            const float mean = wave_sum(s, F.lane) * (1.f / D); float s2 = 0.f;
#pragma unroll
            for (int i = 0; i < 8; ++i) { v[i] = v[i] - mean; s2 += (v[i][0] * v[i][0] + v[i][1] * v[i][1]) + (v[i][2] * v[i][2] + v[i][3] * v[i][3]); }
            const float rstd = 1.0f / sqrtf(wave_sum(s2, F.lane) * (1.f / D) + LN_EPS);
            if (!isctx && F.lane == 0) *(f32x2*)(ST + (size_t)row * 2) = (f32x2){mean, rstd};
#pragma unroll
            for (int i = 0; i < 8; ++i) { v[i] = v[i] * rstd * G[i] + Bv[i]; if (isctx) *(f32x4*)(hc + 256 * i + 4 * F.lane) = v[i] * DN_ALPHA; }
        } else if (isctx) {
#pragma unroll
            for (int i = 0; i < 8; ++i) *(f32x4*)(hc + 256 * i + 4 * F.lane) = v[i] * DN_ALPHA;
        } else {
#pragma unroll
            for (int i = 0; i < 8; ++i) st_h4(hr + 256 * i + 4 * F.lane, v[i]);
            if (F.lane == 0) *(f32x2*)(ST + (size_t)row * 2) = (f32x2){0.f, 1.f};
        }
        if (modnext) {
#pragma unroll
            for (int i = 0; i < 8; ++i) { const f32x4 m = v[i] * (sc4[i] + 1.0f) + sh4[i];
                u32x2 w; w.x = cvt_pk_bf16(m[0], m[1]); w.y = cvt_pk_bf16(m[2], m[3]); *(u32x2*)(HM + (size_t)row * D + 256 * i + 4 * F.lane) = w; }
        }
        if (out && !isctx) { float* orow = out + ((size_t)b * SEQ + (rr - CTX)) * D;
#pragma unroll
            for (int i = 0; i < 8; ++i) *(f32x4*)(orow + 256 * i + 4 * F.lane) = v[i]; }
    }
}

__device__ __forceinline__ void dt_tile(Frame& F, int l, int tile) {
    const bf16_t* A = (const bf16_t*)(F.ws + WS_HM) + (size_t)tile * 32 * D; const bf16_t* Bt = (const bf16_t*)(F.ws + WS_W + W_IN) + (size_t)13312 * D; float* DT = (float*)(F.ws + WS_DT);
    const int r = F.lane & 31, h = F.lane >> 5;
    f32x16 acc;
#pragma unroll
    for (int i = 0; i < 16; ++i) acc[i] = 0.f;
    const bf16_t* ap = A + (size_t)r * D + 8 * h; const bf16_t* bp = Bt + (size_t)r * D + 8 * h;
    for (int k0 = 0; k0 < 128; k0 += 16) {
        bf16x8 af[16], bfv[16];
#pragma unroll
        for (int e = 0; e < 16; ++e) { af[e] = *(const bf16x8*)(ap + 16 * (k0 + e)); bfv[e] = *(const bf16x8*)(bp + 16 * (k0 + e)); }
#pragma unroll
        for (int e = 0; e < 16; ++e) acc = __builtin_amdgcn_mfma_f32_32x32x16_bf16(af[e], bfv[e], acc, 0, 0, 0);
    }
    const float bias = INP(I_DTB)[l * 32 + r];
#pragma unroll
    for (int rg = 0; rg < 16; ++rg) { const int row = tile * 32 + (rg & 3) + 8 * (rg >> 2) + 4 * h; const float x = acc[rg] + bias; DT[(size_t)row * 32 + r] = fmaxf(x, 0.f) + log1pf(expf(-fabsf(x))); }
}
__device__ __forceinline__ void ssd_conv_pass(const Args& A_, Frame& F, int l) {
    const bf16_t* P = (const bf16_t*)(F.ws + WS_PROJ); bf16_t* XC = (bf16_t*)(F.ws + WS_HM);
    const float* cw = INP(I_CONVW) + (size_t)l * 5 * 2048; const float* cb = INP(I_CONVB) + (size_t)l * 2048;
    for (int it = F.gw; it < (R / 8) * 4; it += F.NGW) {
        const int r0 = (it >> 2) * 8, c0 = (it & 3) * 512 + F.lane * 8; const int rr0 = r0 % RB; const int lo = (rr0 < CTX) ? 0 : CTX, hi = (rr0 < CTX) ? CTX : RB;
        u32x4 x[12];
#pragma unroll
        for (int h = 0; h < 12; ++h) { const int r2 = rr0 + h - 2; x[h] = (r2 >= lo && r2 < hi) ? *(const u32x4*)(P + (size_t)(r0 + h - 2) * LDP + PX + c0) : (u32x4){0u, 0u, 0u, 0u}; }
        f32x4 w0[5], w1[5];
#pragma unroll
        for (int k = 0; k < 5; ++k) { w0[k] = *(const f32x4*)(cw + k * 2048 + c0); w1[k] = *(const f32x4*)(cw + k * 2048 + c0 + 4); }
        const f32x4 b0 = *(const f32x4*)(cb + c0), b1 = *(const f32x4*)(cb + c0 + 4);
#pragma unroll
        for (int jr = 0; jr < 8; ++jr) { f32x4 a0 = b0, a1 = b1;
#pragma unroll
            for (int k = 0; k < 5; ++k) { const u32x4 xv = x[jr + k];
                a0[0] += w0[k][0] * bflo(xv.x); a0[1] += w0[k][1] * bfhi(xv.x); a0[2] += w0[k][2] * bflo(xv.y); a0[3] += w0[k][3] * bfhi(xv.y);
                a1[0] += w1[k][0] * bflo(xv.z); a1[1] += w1[k][1] * bfhi(xv.z); a1[2] += w1[k][2] * bflo(xv.w); a1[3] += w1[k][3] * bfhi(xv.w); }
            u32x4 o; o.x = cvt_pk_bf16(siluf_(a0[0]), siluf_(a0[1])); o.y = cvt_pk_bf16(siluf_(a0[2]), siluf_(a0[3])); o.z = cvt_pk_bf16(siluf_(a1[0]), siluf_(a1[1])); o.w = cvt_pk_bf16(siluf_(a1[2]), siluf_(a1[3]));
            *(u32x4*)(XC + (size_t)(r0 + jr) * 2048 + c0) = o; }
    }
}
__device__ __forceinline__ int scan_row(int rb, int d, int step) { return d == 0 ? rb + step : (step < CTX ? rb + CTX - 1 - step : rb + (RB + CTX - 1) - step); }

__device__ __forceinline__ unsigned short bf16_1(float v) { return (unsigned short)(cvt_pk_bf16(v, 0.f) & 0xffffu); }
__device__ __forceinline__ void ssd_chain_fast(const Args& A_, Frame& F, int l, int cid) {
    constexpr int LS = 136;
    const int b = cid >> 6, d = (cid >> 5) & 1, hd = (cid >> 1) & 15, ph = cid & 1, g = hd >> 2; const int rb = b * RB;
    const bf16_t* XC = (const bf16_t*)(F.ws + WS_HM); const float* DT = (const float*)(F.ws + WS_DT); bf16_t* YD = (bf16_t*)(F.ws + WS_YD) + (size_t)d * R * 1024;
    const float a = -expf(INP(I_ALOG)[l * 32 + d * 16 + hd]);
    LAS bf16_t* Cs = (LAS bf16_t*)(F.lds); LAS bf16_t* Bs = Cs + 128 * LS; LAS bf16_t* Ms = Bs + 128 * LS; LAS bf16_t* XdT = Ms + 128 * LS; LAS bf16_t* Hb = XdT + 32 * LS;
    LAS float* csL = (LAS float*)(Hb + 32 * LS); LAS float* ecsL = csL + 128; LAS float* ewL = ecsL + 128; LAS float* misc = ewL + 128;
    const int tid = F.tid, lane = F.lane, w = F.wave, r = lane & 31, h = lane >> 5;
    f32x16 hacc;
#pragma unroll
    for (int i = 0; i < 16; ++i) hacc[i] = 0.f;
    for (int i = tid; i < 32 * LS / 2; i += 512) ((LAS unsigned*)Hb)[i] = 0u;
    u32x4 pc[4], pb[4], px; float pdt, pv0 = 0.f, pv1 = 0.f;
    const int rho0 = d ? 127 - lane : lane, rho1 = d ? 63 - lane : 64 + lane;
#define SSD_R0(k_) ((d == 0) ? rb + 128 * (k_) : ((k_) < 2 ? rb + 128 * (1 - (k_)) : rb + 256 + 128 * (33 - (k_))))
#define SSD_ISSUE(k_) do { const int r0n = SSD_R0(k_); \
        _Pragma("unroll") for (int i = 0; i < 4; ++i) { const int item = tid + 512 * i, row = item >> 4, seg = item & 15; const bf16_t* src = XC + (size_t)(r0n + row) * 2048 + g * 128 + seg * 8; pc[i] = *(const u32x4*)(src + 1536); pb[i] = *(const u32x4*)(src + 1024); } \
        { const int row = tid >> 2, seg = tid & 3; pdt = DT[(size_t)(r0n + row) * 32 + d * 16 + hd]; px = *(const u32x4*)(XC + (size_t)(r0n + row) * 2048 + hd * 64 + ph * 32 + seg * 8); } \
        if (w == 0) { pv0 = DT[(size_t)(r0n + rho0) * 32 + d * 16 + hd]; pv1 = DT[(size_t)(r0n + rho1) * 32 + d * 16 + hd]; } } while (0)
    SSD_ISSUE(0);
    unsigned ypk[8]; int yrow = -1;
#pragma unroll
    for (int i = 0; i < 8; ++i) ypk[i] = 0u;
#define SSD_YFLUSH() do { if (w < 4 && yrow >= 0) { bf16_t* yo = YD + (size_t)yrow * 1024 + hd * 64 + ph * 32 + r; \
        _Pragma("unroll") for (int rg = 0; rg < 16; ++rg) yo[(size_t)((rg & 3) + 8 * (rg >> 2)) * 1024] = (bf16_t)((rg & 1) ? (ypk[rg >> 1] >> 16) : (ypk[rg >> 1] & 0xffffu)); } } while (0)
    for (int k = 0; k < 34; ++k) {
        const int r0 = SSD_R0(k);
        __syncthreads();
#pragma unroll
        for (int i = 0; i < 4; ++i) { const int item = tid + 512 * i, row = item >> 4, seg = item & 15; *(LAS u32x4*)(Cs + row * LS + seg * 8) = pc[i]; *(LAS u32x4*)(Bs + row * LS + seg * 8) = pb[i]; }
        { const int row = tid >> 2, seg = tid & 3; const float dtv = pdt; const u32x4 xv = px;
            LAS bf16_t* xo = XdT + (seg * 8) * LS + row;
            xo[0 * LS] = bf16_1(bflo(xv.x) * dtv); xo[1 * LS] = bf16_1(bfhi(xv.x) * dtv); xo[2 * LS] = bf16_1(bflo(xv.y) * dtv); xo[3 * LS] = bf16_1(bfhi(xv.y) * dtv);
            xo[4 * LS] = bf16_1(bflo(xv.z) * dtv); xo[5 * LS] = bf16_1(bfhi(xv.z) * dtv); xo[6 * LS] = bf16_1(bflo(xv.w) * dtv); xo[7 * LS] = bf16_1(bfhi(xv.w) * dtv); }
        if (w == 0) {
            float v0 = pv0 * a, v1 = pv1 * a;
#pragma unroll
            for (int o = 1; o < 64; o <<= 1) { const float t0 = __int_as_float(__builtin_amdgcn_ds_bpermute((lane - o) << 2, __float_as_int(v0))), t1 = __int_as_float(__builtin_amdgcn_ds_bpermute((lane - o) << 2, __float_as_int(v1))); if (lane >= o) { v0 += t0; v1 += t1; } }
            const float tot0 = __int_as_float(__builtin_amdgcn_ds_bpermute(63 << 2, __float_as_int(v0))); v1 += tot0;
            const float cend = __int_as_float(__builtin_amdgcn_ds_bpermute(63 << 2, __float_as_int(v1)));
            csL[rho0] = v0; csL[rho1] = v1; ecsL[rho0] = __builtin_amdgcn_exp2f(v0 * 1.4426950408889634f); ecsL[rho1] = __builtin_amdgcn_exp2f(v1 * 1.4426950408889634f);
            ewL[rho0] = __builtin_amdgcn_exp2f((cend - v0) * 1.4426950408889634f); ewL[rho1] = __builtin_amdgcn_exp2f((cend - v1) * 1.4426950408889634f);
            if (lane == 0) misc[0] = __builtin_amdgcn_exp2f(cend * 1.4426950408889634f);
        }
        if (k + 1 < 34) SSD_ISSUE(k + 1);
        __syncthreads();
        { const int lt = w >> 1;
#pragma unroll
          for (int q = 0; q < 2; ++q) { const int st = (w & 1) * 2 + q; const bool zero = (d == 0) ? (st > lt) : (st < lt);
            f32x16 acc;
#pragma unroll
            for (int i = 0; i < 16; ++i) acc[i] = 0.f;
            if (!zero) { bf16x8 af[8], bfv[8];
#pragma unroll
                for (int ks = 0; ks < 8; ++ks) { af[ks] = *(const LAS bf16x8*)(Cs + (32 * lt + r) * LS + 16 * ks + 8 * h); bfv[ks] = *(const LAS bf16x8*)(Bs + (32 * st + r) * LS + 16 * ks + 8 * h); }
#pragma unroll
                for (int ks = 0; ks < 8; ++ks) acc = __builtin_amdgcn_mfma_f32_32x32x16_bf16(af[ks], bfv[ks], acc, 0, 0, 0); }
            const int scol = 32 * st + r; const float css = csL[scol];
            f32x4 cr4[4];
#pragma unroll
            for (int q4 = 0; q4 < 4; ++q4) cr4[q4] = *(const LAS f32x4*)(csL + 32 * lt + 8 * q4 + 4 * h);
#pragma unroll
            for (int rg = 0; rg < 16; ++rg) { const int lrow = 32 * lt + (rg & 3) + 8 * (rg >> 2) + 4 * h; const bool valid = (d == 0) ? (scol <= lrow) : (scol >= lrow);
                const float ex = __builtin_amdgcn_exp2f(fminf(cr4[rg >> 2][rg & 3] - css, 0.f) * 1.4426950408889634f);
                const float v = valid ? acc[rg] * ex : 0.f; Ms[lrow * LS + scol] = bf16_1(v); } } }
        __syncthreads();
        if (w < 4) { const int lt = w;
            f32x16 acc;
#pragma unroll
            for (int i = 0; i < 16; ++i) acc[i] = 0.f;
            { bf16x8 af[8], bfv[8];
#pragma unroll
              for (int ks = 0; ks < 8; ++ks) { af[ks] = *(const LAS bf16x8*)(Cs + (32 * lt + r) * LS + 16 * ks + 8 * h); bfv[ks] = *(const LAS bf16x8*)(Hb + r * LS + 16 * ks + 8 * h); }
#pragma unroll
              for (int ks = 0; ks < 8; ++ks) acc = __builtin_amdgcn_mfma_f32_32x32x16_bf16(af[ks], bfv[ks], acc, 0, 0, 0); }
            { f32x4 e4[4];
#pragma unroll
              for (int q4 = 0; q4 < 4; ++q4) e4[q4] = *(const LAS f32x4*)(ecsL + 32 * lt + 8 * q4 + 4 * h);
#pragma unroll
              for (int rg = 0; rg < 16; ++rg) acc[rg] *= e4[rg >> 2][rg & 3]; }
            { bf16x8 af[8], bfv[8];
#pragma unroll
              for (int ks = 0; ks < 8; ++ks) { af[ks] = *(const LAS bf16x8*)(Ms + (32 * lt + r) * LS + 16 * ks + 8 * h); bfv[ks] = *(const LAS bf16x8*)(XdT + r * LS + 16 * ks + 8 * h); }
#pragma unroll
              for (int ks = 0; ks < 8; ++ks) { const bool skip = (d == 0) ? (16 * ks >= 32 * (lt + 1)) : (16 * ks + 15 < 32 * lt);
                  if (!skip) acc = __builtin_amdgcn_mfma_f32_32x32x16_bf16(af[ks], bfv[ks], acc, 0, 0, 0); } }
            bf16_t* yo = YD + (size_t)(r0 + 32 * lt + 4 * h) * 1024 + hd * 64 + ph * 32 + r;
#pragma unroll
            for (int rg = 0; rg < 16; ++rg) yo[(size_t)((rg & 3) + 8 * (rg >> 2)) * 1024] = bf16_1(acc[rg]);
        } else { const int nt = w - 4; const float eend = misc[0];
#pragma unroll
            for (int i = 0; i < 16; ++i) hacc[i] *= eend;
            { typedef short v4i16_t_ __attribute__((ext_vector_type(4)));
#pragma unroll
              for (int kh = 0; kh < 2; ++kh) {
              u32x4 xa[8]; f32x4 e0[8], e1[8]; s16x4 t0[8], t1[8];
#pragma unroll
              for (int ks = 4 * kh; ks < 4 * kh + 4; ++ks) { const int k0 = 16 * ks + 8 * h; xa[ks] = *(const LAS u32x4*)(XdT + r * LS + k0); e0[ks] = *(const LAS f32x4*)(ewL + k0); e1[ks] = *(const LAS f32x4*)(ewL + k0 + 4);
                  const LAS bf16_t* tb = Bs + (k0 + ((lane & 15) >> 2)) * LS + 32 * nt + 16 * ((lane >> 4) & 1) + 4 * (lane & 3);
                  t0[ks] = __builtin_bit_cast(s16x4, __builtin_amdgcn_ds_read_tr16_b64_v4i16((LAS v4i16_t_*)tb)); t1[ks] = __builtin_bit_cast(s16x4, __builtin_amdgcn_ds_read_tr16_b64_v4i16((LAS v4i16_t_*)(tb + 4 * LS))); }
#pragma unroll
              for (int ks = 4 * kh; ks < 4 * kh + 4; ++ks) { u32x4 aw;
                  aw.x = cvt_pk_bf16(bflo(xa[ks].x) * e0[ks][0], bfhi(xa[ks].x) * e0[ks][1]); aw.y = cvt_pk_bf16(bflo(xa[ks].y) * e0[ks][2], bfhi(xa[ks].y) * e0[ks][3]); aw.z = cvt_pk_bf16(bflo(xa[ks].z) * e1[ks][0], bfhi(xa[ks].z) * e1[ks][1]); aw.w = cvt_pk_bf16(bflo(xa[ks].w) * e1[ks][2], bfhi(xa[ks].w) * e1[ks][3]);
                  const bf16x8 bw = (bf16x8){t0[ks][0], t0[ks][1], t0[ks][2], t0[ks][3], t1[ks][0], t1[ks][1], t1[ks][2], t1[ks][3]};
                  hacc = __builtin_amdgcn_mfma_f32_32x32x16_bf16(__builtin_bit_cast(bf16x8, aw), bw, hacc, 0, 0, 0); } } }
        }
        __syncthreads();
        if (w >= 4) { const int nt = w - 4;
#pragma unroll
            for (int rg = 0; rg < 16; ++rg) Hb[((rg & 3) + 8 * (rg >> 2) + 4 * h) * LS + 32 * nt + r] = bf16_1(hacc[rg]); }
    }
    __syncthreads();
#undef SSD_R0
#undef SSD_ISSUE
#undef SSD_YFLUSH
}
__device__ __forceinline__ void s5_setup(const Args& A_, Frame& F, int l, int boff = 0) {
    LAS float* Pre = (LAS float*)(F.lds); LAS float* Pim = Pre + 2 * 17 * 64; LAS float* BBr = Pim + 2 * 17 * 64; LAS float* BBi = BBr + 2 * 64 * 16; LAS float* Kt = BBi + 2 * 64 * 16;
    LAS float* CrL = Kt + 8192; LAS float* CiL = CrL + 2048;
    bf16_t* Bt1 = (bf16_t*)(F.ws + WS_S5M); bf16_t* Bt2 = Bt1 + (size_t)64 * 512 * 256; float* A16 = (float*)(F.ws + WS_S5A);
    const int tid = F.tid;
    for (int g = (int)blockIdx.x - boff; g >= 0 && g < 64; g += F.G) {
        { f32x4 c4[2];
#pragma unroll
          for (int h = 0; h < 2; ++h) { const int e4 = tid * 4 & 1023, d = (tid >> 8); const int pg_ = (l * 2 + d) * 64 + g; c4[h] = *(const f32x4*)((h ? INP(I_CIM) : INP(I_CRE)) + (size_t)pg_ * 1024 + e4); }
          *(LAS f32x4*)(CrL + tid * 4) = c4[0]; *(LAS f32x4*)(CiL + tid * 4) = c4[1]; }
        if (tid < 128) { const int d = tid >> 6, n = tid & 63; const int pg_ = (l * 2 + d) * 64 + g;
            const float lre = INP(I_LRE)[pg_ * 64 + n], lim = INP(I_LIM)[pg_ * 64 + n], step = expf(INP(I_LSTEP)[pg_]);
            for (int dl = 0; dl <= 16; ++dl) { const float mag = expf(lre * step * (float)dl), ang = lim * step * (float)dl; Pre[(d * 17 + dl) * 64 + n] = mag * cosf(ang); Pim[(d * 17 + dl) * 64 + n] = mag * sinf(ang); }
            const float abr = Pre[(d * 17 + 1) * 64 + n], abi = Pim[(d * 17 + 1) * 64 + n];
            const float den = lre * lre + lim * lim; const float kre = ((abr - 1.f) * lre + abi * lim) / den, kim = (abi * lre - (abr - 1.f) * lim) / den;
            const float* br = INP(I_BRE) + ((size_t)pg_ * 64 + n) * 16; const float* bi = INP(I_BIM) + ((size_t)pg_ * 64 + n) * 16;
            f32x4 bq[4], bz[4];
#pragma unroll
            for (int q = 0; q < 4; ++q) { bq[q] = *(const f32x4*)(br + 4 * q); bz[q] = *(const f32x4*)(bi + 4 * q); }
#pragma unroll
            for (int i = 0; i < 16; ++i) { const float x = bq[i >> 2][i & 3], y = bz[i >> 2][i & 3]; BBr[(d * 64 + n) * 16 + i] = kre * x - kim * y; BBi[(d * 64 + n) * 16 + i] = kre * y + kim * x; }
            A16[((d * 64 + g) * 64 + n) * 2] = Pre[(d * 17 + 16) * 64 + n]; A16[((d * 64 + g) * 64 + n) * 2 + 1] = Pim[(d * 17 + 16) * 64 + n]; }
        __syncthreads();
        for (int q = 0; q < 16; ++q) { const int idx = tid + 512 * q; const int d = idx >> 12, dl = (idx >> 8) & 15, o = (idx >> 4) & 15, i = idx & 15;
            const LAS float* cr = CrL + (d * 16 + o) * 64; const LAS float* ci = CiL + (d * 16 + o) * 64; float acc = 0.f;
            for (int n = 0; n < 64; ++n) { const float pr = Pre[(d * 17 + dl) * 64 + n], pi = Pim[(d * 17 + dl) * 64 + n], br = BBr[(d * 64 + n) * 16 + i], bi = BBi[(d * 64 + n) * 16 + i];
                acc += cr[n] * (pr * br - pi * bi) - ci[n] * (pr * bi + pi * br); }
            Kt[idx] = acc; }
        __syncthreads();
        const float dsk = INP(I_S5D)[l * 1024 + 16 * g + (tid & 15)];
        for (int q = 0; q < 16; ++q) { const int item = tid + 512 * q; const int c1 = item >> 5, kb = (item & 31) * 8; const int rin = kb >> 4, i0 = kb & 15, rout = c1 >> 4, o = c1 & 15;
            const float dsko = __int_as_float(__builtin_amdgcn_ds_bpermute((((F.lane & ~15) | o)) << 2, __float_as_int(dsk)));
            float v[8];
#pragma unroll
            for (int e = 0; e < 8; ++e) { const int i = i0 + e; float x = 0.f; if (rout >= rin) x += Kt[((0 * 16 + (rout - rin)) * 16 + o) * 16 + i]; if (rin >= rout) x += Kt[((1 * 16 + (rin - rout)) * 16 + o) * 16 + i];
                if (rin == rout && i == o) x += dsko; v[e] = x; }
            u32x4 w; w.x = cvt_pk_bf16(v[0], v[1]); w.y = cvt_pk_bf16(v[2], v[3]); w.z = cvt_pk_bf16(v[4], v[5]); w.w = cvt_pk_bf16(v[6], v[7]);
            *(u32x4*)(Bt1 + ((size_t)g * 512 + c1) * 256 + kb) = w; }
        for (int q = 0; q < 16; ++q) { const int item = tid + 512 * q; const int c1 = item >> 5, kb = (item & 31) * 8; const int rin = kb >> 4, i0 = kb & 15; const int d = c1 >> 7, part = c1 & 1, n = (c1 >> 1) & 63;
            const int ex = (d == 0) ? 15 - rin : rin; const float pr = Pre[(d * 17 + ex) * 64 + n], pi = Pim[(d * 17 + ex) * 64 + n];
            float v[8];
#pragma unroll
            for (int e = 0; e < 8; ++e) { const float br = BBr[(d * 64 + n) * 16 + i0 + e], bi = BBi[(d * 64 + n) * 16 + i0 + e]; v[e] = part ? (pr * bi + pi * br) : (pr * br - pi * bi); }
            u32x4 w; w.x = cvt_pk_bf16(v[0], v[1]); w.y = cvt_pk_bf16(v[2], v[3]); w.z = cvt_pk_bf16(v[4], v[5]); w.w = cvt_pk_bf16(v[6], v[7]);
            *(u32x4*)(Bt1 + ((size_t)g * 512 + 256 + c1) * 256 + kb) = w; }
        for (int q = 0; q < 16; ++q) { const int item = tid + 512 * q; const int c2 = item >> 5, kb = (item & 31) * 8; const int rout = c2 >> 4, o = c2 & 15; const int d = kb >> 7, part = (kb >> 6) & 1, n0 = kb & 63;
            const int ex = (d == 0) ? rout + 1 : 16 - rout; const LAS float* cr = CrL + (d * 16 + o) * 64 + n0; const LAS float* ci = CiL + (d * 16 + o) * 64 + n0;
            float v[8];
#pragma unroll
            for (int e = 0; e < 8; ++e) { const float pr = Pre[(d * 17 + ex) * 64 + n0 + e], pi = Pim[(d * 17 + ex) * 64 + n0 + e]; v[e] = part ? -(cr[e] * pi + ci[e] * pr) : (cr[e] * pr - ci[e] * pi); }
            u32x4 w; w.x = cvt_pk_bf16(v[0], v[1]); w.y = cvt_pk_bf16(v[2], v[3]); w.z = cvt_pk_bf16(v[4], v[5]); w.w = cvt_pk_bf16(v[6], v[7]);
            *(u32x4*)(Bt2 + ((size_t)g * 256 + c2) * 256 + kb) = w; }
        __syncthreads();
    }
}
__device__ __forceinline__ void s5_carry(Frame& F, int cid) {
    const int b = cid >> 7, d = (cid >> 6) & 1, g = cid & 63, n = F.lane;
    const unsigned* ST = (const unsigned*)((const bf16_t*)(F.ws + WS_S5ST) + ((size_t)g * S5M + b * 272) * 256 + d * 128) + n;
    bf16_t* HP = (bf16_t*)(F.ws + WS_S5H) + ((size_t)g * 1280 + b * 272) * 256 + d * 128 + n;
    const float* A16 = (const float*)(F.ws + WS_S5A); const float ar = A16[((d * 64 + g) * 64 + n) * 2], ai = A16[((d * 64 + g) * 64 + n) * 2 + 1];
    float hr = 0.f, hi_ = 0.f;
    for (int k0 = 0; k0 < 272; k0 += 34) {
        unsigned wv[34];
#pragma unroll
        for (int e = 0; e < 34; ++e) { const int k = k0 + e; const int cc = (d == 0) ? k : (k < 16 ? 15 - k : 287 - k); wv[e] = ST[(size_t)cc * 128]; }
        asm volatile("s_waitcnt vmcnt(0)" ::: "memory");
#pragma unroll
        for (int e = 0; e < 34; ++e) { const int k = k0 + e; const int cc = (d == 0) ? k : (k < 16 ? 15 - k : 287 - k);
            HP[(size_t)cc * 256] = (bf16_t)(cvt_pk_bf16(hr, 0.f) & 0xffffu); HP[(size_t)cc * 256 + 64] = (bf16_t)(cvt_pk_bf16(hi_, 0.f) & 0xffffu);
            const float sr = bflo(wv[e]), si = bfhi(wv[e]); const float nr = ar * hr - ai * hi_ + sr, ni = ar * hi_ + ai * hr + si; hr = nr; hi_ = ni; }
    }
}
__device__ __forceinline__ void mixer_finalize(const Args& A_, Frame& F, int l) {
    bf16_t* P = (bf16_t*)(F.ws + WS_PROJ);
    const bf16_t* XC = (const bf16_t*)(F.ws + WS_HM); const bf16_t* YD0 = (const bf16_t*)(F.ws + WS_YD); const bf16_t* YD1 = YD0 + (size_t)R * 1024;
        const int c0 = F.lane * 16;
    for (int row = F.gw; row < R; row += F.NGW) {
        { const float dsk = INP(I_SSDD)[l * 16 + (c0 >> 6)];
          const float* nwp = INP(I_SSDN) + l * 1024 + c0;
          float v[16];
#pragma unroll
          for (int hh = 0; hh < 2; ++hh) { const u32x4 x = *(const u32x4*)(XC + (size_t)row * 2048 + c0 + 8 * hh), y0 = *(const u32x4*)(YD0 + (size_t)row * 1024 + c0 + 8 * hh), y1 = *(const u32x4*)(YD1 + (size_t)row * 1024 + c0 + 8 * hh), z = *(const u32x4*)(P + (size_t)row * LDP + PZ + c0 + 8 * hh);
#define SG(i, wx, wy0, wy1, wz) v[8 * hh + 2 * (i)] = (bflo(wx) * dsk + bflo(wy0) + bflo(wy1)) * bflo(wz); v[8 * hh + 2 * (i) + 1] = (bfhi(wx) * dsk + bfhi(wy0) + bfhi(wy1)) * bfhi(wz);
              SG(0, x.x, y0.x, y1.x, z.x) SG(1, x.y, y0.y, y1.y, z.y) SG(2, x.z, y0.z, y1.z, z.z) SG(3, x.w, y0.w, y1.w, z.w)
#undef SG
          }
          float ss = 0.f;
#pragma unroll
          for (int e = 0; e < 16; ++e) ss += v[e] * v[e];
          ss += shx(ss, 1, F.lane); ss += shx(ss, 2, F.lane); ss += shx(ss, 4, F.lane); ss += shx(ss, 8, F.lane);
          const float rs = 1.0f / sqrtf(ss * (1.f / 256.f) + RMS_EPS);
          const f32x4 n0 = *(const f32x4*)(nwp), n1 = *(const f32x4*)(nwp + 4), n2 = *(const f32x4*)(nwp + 8), n3 = *(const f32x4*)(nwp + 12);
          const float nw[16] = {n0[0], n0[1], n0[2], n0[3], n1[0], n1[1], n1[2], n1[3], n2[0], n2[1], n2[2], n2[3], n3[0], n3[1], n3[2], n3[3]};
          u32x4 o0, o1;
          o0.x = cvt_pk_bf16(v[0] * rs * nw[0], v[1] * rs * nw[1]); o0.y = cvt_pk_bf16(v[2] * rs * nw[2], v[3] * rs * nw[3]); o0.z = cvt_pk_bf16(v[4] * rs * nw[4], v[5] * rs * nw[5]); o0.w = cvt_pk_bf16(v[6] * rs * nw[6], v[7] * rs * nw[7]);
          o1.x = cvt_pk_bf16(v[8] * rs * nw[8], v[9] * rs * nw[9]); o1.y = cvt_pk_bf16(v[10] * rs * nw[10], v[11] * rs * nw[11]); o1.z = cvt_pk_bf16(v[12] * rs * nw[12], v[13] * rs * nw[13]); o1.w = cvt_pk_bf16(v[14] * rs * nw[14], v[15] * rs * nw[15]);
          *(u32x4*)(P + (size_t)row * LDP + PV + c0) = o0; *(u32x4*)(P + (size_t)row * LDP + PV + c0 + 8) = o1; }
    }
}


__global__ void __launch_bounds__(NWAVES * 64, 2) trunk_fwd(Args args) {
    extern __shared__ __attribute__((aligned(16))) unsigned char lds_raw[];
    Frame F;
    F.lds = (LAS unsigned char*)lds_raw;
    F.tid = threadIdx.x; F.lane = F.tid & 63; F.wave = __builtin_amdgcn_readfirstlane(F.tid >> 6);
    F.G = gridDim.x; { const int bx = blockIdx.x; F.vcu = (F.G % 8 == 0) ? (bx % 8) * (F.G / 8) + bx / 8 : bx; }
    F.gw = F.vcu * NWAVES + F.wave; F.NGW = F.G * NWAVES;
    F.ws = args.ws;
    volatile LAS unsigned* MISC = (volatile LAS unsigned*)(F.lds + MISC_OFF);
    for (int u = F.tid; u < (LDS_BYTES - LDSCTL_OFF) / 4; u += NWAVES * 64) ((LAS unsigned*)(F.lds + LDSCTL_OFF))[u] = 0u;
    __syncthreads();
    if (threadIdx.x < 32) ((LAS unsigned long long*)(F.lds + INTAB_OFF))[threadIdx.x] = (unsigned long long)args.in[threadIdx.x];
    __syncthreads();
    (void)xcd_barrier_post((unsigned*)(args.ws + WS_CTL) + CW_BAR, MISC + 8);
    const int lo = args.ph_lo, hi = args.ph_hi;
    const int wave0 = __builtin_amdgcn_readfirstlane((int)threadIdx.x >> 6);
    int pid = 0;
#define PH_BEGIN if (pid >= lo && pid < hi) { GAS unsigned char* wsg_ = (GAS unsigned char*)args.ws; int tid_; asm volatile("v_mbcnt_lo_u32_b32 %1, -1, 0\n\tv_mbcnt_hi_u32_b32 %1, -1, %1 ; PHASE_MARK_BEGIN %2" : "+s"(wsg_), "=v"(tid_) : "i"(__LINE__) : "memory"); tid_ += wave0 * 64; unsigned char* ws = (unsigned char*)wsg_; F.ws = ws; F.tid = tid_; F.lane = tid_ & 63; F.wave = __builtin_amdgcn_readfirstlane(tid_ >> 6); F.gw = F.vcu * NWAVES + F.wave;
#define PH_END   asm volatile("; PHASE_MARK_END %0" :: "i"(__LINE__)); if (pid + 1 < hi) { XcdBarrier bar_; bar_.bar = (unsigned*)(args.ws + WS_CTL) + CW_BAR; bar_.x = xb_xcc_id(); bar_.st = (volatile LAS unsigned*)(F.lds + MISC_OFF) + 8; xcd_barrier(bar_, wave0 * 64 + lane_now()); } } ++pid;

#define MOD ((float*)(ws + WS_MOD))
#define Hbuf ((float*)(ws + WS_H))
#define HM ((bf16_t*)(ws + WS_HM))
#define PROJ ((bf16_t*)(ws + WS_PROJ))
#define ROPEC ((float*)(ws + WS_ROPE))
#define ROPES (ROPEC + 1024)
#define WGT (ws + WS_W)

    PH_BEGIN
        s5_setup(args, F, 0);
        mod_partials(args, F);
        if (F.gw == 1) { float* idn = (float*)(ws + WS_IDENT); for (int i = F.lane; i < 2048; i += 64) { idn[i] = 1.0f; idn[2048 + i] = 0.0f; } }
        if (F.gw == 0) {
#pragma unroll
            for (int i = 0; i < 16; ++i) { const int idx = i * 64 + F.lane, pos = idx >> 4, f = idx & 15; const float inv = powf(10000.0f, -(float)f / 16.0f); const float ang = (float)pos * inv; ROPEC[idx] = cosf(ang); ROPES[idx] = sinf(ang); } }
    PH_END
    PH_BEGIN
        convert_layer_weights(args, F, 0);
        ln_pass(F, false, nullptr, nullptr, MOD, nullptr, INP(I_X), INP(I_CTX));
    PH_END

    for (int s = 0; s < 6; ++s) {
        const int l = s / 3, j = s - 3 * l;
        if (j != 1) {
            const int f = j >> 1;
            PH_BEGIN
                const int lat = (l == 1 && j == 2); pg8::Gemm g{D, D, D}; pg8::StaticOrder S; S.init(lat ? 64 : NPAN, N13 / 256, F.G, (int)blockIdx.x, HM, D, (const bf16_t*)(WGT + W_13) + (size_t)f * N13 * D, D, D, lat);
                EpiSwiGLU E{PROJ};
                pg8::gemm_phase<EpiSwiGLU, pg8::StaticOrder>(F.lds + RING_OFF, g, S, E, F.tid);
            PH_END
        } else {
            PH_BEGIN
                pg8::Gemm g{D, D, D}; pg8::StaticOrder S; S.init(NPAN, LDP / 256, F.G, (int)blockIdx.x, HM, D, (const bf16_t*)(WGT + W_IN), D, D);
                EpiProj E{PROJ, (float*)(ws + WS_DT), ROPEC, ROPES, (bf16_t*)(ws + WS_O)};
                pg8::gemm_phase<EpiProj, pg8::StaticOrder>(F.lds + RING_OFF, g, S, E, F.tid);
                { const int nfull = (NPAN * (LDP / 256)) % F.G;
                  if ((int)blockIdx.x >= nfull) { const int nw = (F.G - nfull) * NWAVES; for (int t = ((int)blockIdx.x - nfull) * NWAVES + F.wave; t < R / 32; t += nw) dt_tile(F, l, t); } }
            PH_END
            PH_BEGIN
                ssd_conv_pass(args, F, l);
                asm volatile("" : "+v"(F.tid));
                { pg8::Gemm g{256, 256, 256}; S5AOrder S{F.G, (int)blockIdx.x, (const char*)(ws + WS_O), (const char*)(ws + WS_S5M)};
                  EpiS5A E{(unsigned char*)(ws + WS_YS), (bf16_t*)(ws + WS_S5ST)};
                  pg8::gemm_phase<EpiS5A, S5AOrder>(F.lds + RING_OFF, g, S, E, F.tid); }
            PH_END
            PH_BEGIN
                if (F.wave < 2) s5_carry(F, (int)blockIdx.x * 2 + F.wave);
                ssd_chain_fast(args, F, l, (int)blockIdx.x);
                {
                    const float lam_init = 0.8f - 0.6f * expf(-0.3f * (float)l);
                    const float* lv = INP(I_ALAM) + l * 256;
                    const float s01 = wave_sum(lv[F.lane] * lv[64 + F.lane], F.lane), s23 = wave_sum(lv[128 + F.lane] * lv[192 + F.lane], F.lane);
                    const float lam = expf(s01) - expf(s23) + lam_init;
                    for (int i = 0;; ++i) { const int idx = i * F.G + F.vcu; if (idx >= 512 + (l == 0 ? 32 : 0)) break;
                        int b, h, q0, seq;
                        if (idx < 512) { b = idx >> 7; h = (idx >> 4) & 7; q0 = b * RB + CTX + (idx & 15) * 256; seq = RB; }
                        else { const int k = idx - 512; b = k >> 3; h = k & 7; q0 = b * RB; seq = CTX; }
                        const bf16_t* Q0 = PROJ + (size_t)q0 * LDP + PQ + h * 128; const bf16_t* Kh = PROJ + (size_t)(b * RB) * LDP + PK + h * 128; const bf16_t* Vh = PROJ + (size_t)(b * RB) * LDP + PV + h * 128;
                        attn128::unit((const attn128::bf16*)Q0, (const attn128::bf16*)Kh, (const attn128::bf16*)Vh, PROJ + (size_t)q0 * LDP + PQ + h * 128, seq, (char*)lds_raw + RING_OFF, F.tid, lam, 1.0f - lam_init, INP(I_ASUB) + l * 128);
                    }
                }
            PH_END
            PH_BEGIN
                mixer_finalize(args, F, l);
                asm volatile("" : "+v"(F.tid));
                { pg8::Gemm g{256, 256, 256}; S5COrder S{F.G, (int)blockIdx.x, (const char*)(ws + WS_S5H), (const char*)((bf16_t*)(ws + WS_S5M) + (size_t)64 * 512 * 256)};
                  EpiS5C E{(const unsigned char*)(ws + WS_YS), PROJ};
                  pg8::gemm_phase<EpiS5C, S5COrder>(F.lds + RING_OFF, g, S, E, F.tid); }
            PH_END
            PH_BEGIN
                pg8::Gemm g{LDP, 1024, 1024}; pg8::StaticOrder S; S.init(l == 1 ? 64 : NPAN, 4, F.G, (int)blockIdx.x, PROJ + PU, LDP, (const bf16_t*)(WGT + W_GLU), 1024, 1024, l == 1);
                EpiGlu E{PROJ, INP(I_GLUB) + l * 1024};
                pg8::gemm_phase<EpiGlu, pg8::StaticOrder>(F.lds + RING_OFF, g, S, E, F.tid);
            PH_END
            PH_BEGIN
                pg8::Gemm g{LDP, 3072, 3072}; pg8::StaticOrder S; S.init(l == 1 ? 64 : NPAN, 8, F.G, (int)blockIdx.x, PROJ, LDP, (const bf16_t*)(WGT + W_B), 3072, 3072, l == 1);
                EpiMerge E{PROJ, HM};
                pg8::gemm_phase<EpiMerge, pg8::StaticOrder, 0, true>(F.lds + RING_OFF, g, S, E, F.tid);
            PH_END
        }
        PH_BEGIN
            const int RK = (j == 1) ? D : DFF; const bf16_t* RA = (j == 1) ? HM : PROJ; const bf16_t* RBt = (j == 1) ? (const bf16_t*)(WGT + W_O) : (const bf16_t*)(WGT + W_2) + (size_t)(j >> 1) * D * DFF;
            const int lat = (l == 1 && j >= 1); pg8::Gemm g{RK, RK, RK}; pg8::StaticOrder S; S.init(64, D / 256, F.G, (int)blockIdx.x, RA, RK, RBt, RK, RK, 1, lat ? 0 : 128);
            const float* lg_ = (s == 0) ? (const float*)(ws + WS_IDENT) : INP(I_LNG) + (size_t)(s - 1) * D; const float* lb_ = (s == 0) ? (const float*)(ws + WS_IDENT) + 2048 : INP(I_LNB) + (size_t)(s - 1) * D;
            EpiResid E{(_Float16*)(ws + WS_H), (float*)(ws + WS_HC), MOD + (size_t)l * 5 * NMOD + (3 * j + 2) * D, lg_, lb_, (const float*)(ws + WS_STATS)};
            pg8::gemm_phase<EpiResid, pg8::StaticOrder>(F.lds + RING_OFF, g, S, E, F.tid);
        PH_END
        PH_BEGIN
            const bool fin = (s == 5);
            const int ln_ = (j == 2) ? l + 1 : l, jn = (j == 2) ? 0 : j + 1;
            ln_pass(F, true, INP(I_LNG) + (size_t)(l * 3 + j) * D, INP(I_LNB) + (size_t)(l * 3 + j) * D, fin ? nullptr : MOD + (size_t)ln_ * 5 * NMOD + 3 * jn * D, fin ? args.out : nullptr, nullptr, nullptr, (l == 1 && j >= 1) ? 0 : 4);
            if (s == 2) { s5_setup(args, F, 1); __syncthreads(); convert_layer_weights(args, F, 1); }
        PH_END
    }
#undef PH_BEGIN
#undef PH_END
}

static int count_phases() { int n = 2; for (int s = 0; s < 6; ++s) n += ((s % 3) != 1 ? 1 : 6) + 2; return n; }
extern "C" void kernel_launch(void* const* d_in, const int* in_sizes, int n_in, void* d_out, int out_size, void* d_ws, size_t ws_size, hipStream_t stream) {
    static int grid = 0;
    if (grid == 0) {
        if (n_in != 32 || out_size != NB * SEQ * D || ws_size < WS_END) { fprintf(stderr, "kernel_launch: unexpected shapes (n_in %d, out %d, ws %zu < %zu)\n", n_in, out_size, ws_size, (size_t)WS_END); grid = -1; return; }
        int dev = 0, cus = 0, per_cu = 0;
        if (hipGetDevice(&dev) != hipSuccess || hipDeviceGetAttribute(&cus, hipDeviceAttributeMultiprocessorCount, dev) != hipSuccess) { grid = -1; return; }
        if (hipFuncSetAttribute((const void*)trunk_fwd, hipFuncAttributeMaxDynamicSharedMemorySize, LDS_BYTES) != hipSuccess) { fprintf(stderr, "kernel_launch: hipFuncSetAttribute failed\n"); grid = -1; return; }
        if (hipOccupancyMaxActiveBlocksPerMultiprocessor(&per_cu, (const void*)trunk_fwd, NWAVES * 64, LDS_BYTES) != hipSuccess || per_cu < 1) fprintf(stderr, "kernel_launch: occupancy query says %d\n", per_cu);
        (void)hipGetLastError();
        if (cus != 256) { fprintf(stderr, "kernel_launch: this kernel deals its SSD chains / carries / attention units over exactly 256 workgroups (one per CU); device reports %d CUs; nothing launched\n", cus); grid = -1; return; }
        grid = cus;
    }
    if (grid < 0) return;
    (void)in_sizes;
    if (hipMemsetAsync((char*)d_ws + WS_CTL, 0, 2 * MiB  , stream) != hipSuccess) return;
    Args a{};
    for (int i = 0; i < 32; ++i) a.in[i] = (const float*)d_in[i];
    a.out = (float*)d_out; a.ws = (unsigned char*)d_ws;
    const int nph = count_phases();
#if MK_PER_PHASE
    for (int p = 0; p < nph; ++p) { a.ph_lo = p; a.ph_hi = p + 1; hipLaunchKernelGGL(trunk_fwd, dim3(grid), dim3(NWAVES * 64), LDS_BYTES, stream, a); }
#else
    a.ph_lo = 0; a.ph_hi = nph;
    hipLaunchKernelGGL(trunk_fwd, dim3(grid), dim3(NWAVES * 64), LDS_BYTES, stream, a);
#endif
    const hipError_t le = hipPeekAtLastError();
    if (le != hipSuccess) fprintf(stderr, "kernel_launch: launch failed: %s\n", hipGetErrorName(le));
}
```

```cpp
#include <hip/hip_runtime.h>
#include <hip/hip_bf16.h>
#include <cstdio>
#include <cstdint>
#include <cmath>

#ifndef MK_PER_PHASE
#define MK_PER_PHASE 0
#endif

#define LAS __attribute__((address_space(3)))
#define GAS __attribute__((address_space(1)))
typedef unsigned short bf16_t;
typedef short bf16x8 __attribute__((ext_vector_type(8)));
typedef float f32x4 __attribute__((ext_vector_type(4)));
typedef float f32x2 __attribute__((ext_vector_type(2)));
typedef float f32x16 __attribute__((ext_vector_type(16)));
typedef unsigned u32x4 __attribute__((ext_vector_type(4)));
typedef unsigned u32x2 __attribute__((ext_vector_type(2)));
typedef short s16x4 __attribute__((ext_vector_type(4)));

constexpr int NB = 4, SEQ = 4096, CTX = 256, RB = SEQ + CTX  , R = NB * RB  , NPAN = R / 256  , PPB = RB / 256  ;
constexpr int D = 2048, DFF = 5632, N13 = 2 * DFF, NMOD = 9 * D  ;
constexpr int LDP = 13312;
constexpr int NIN = 13568;
constexpr int PQ = 0, PK = 1024, PV = 2048, PZ = 3072, PX = 4096, PU = 6144, PG = 7168;
constexpr float DN_ALPHA = 1.41421356237309515f;
constexpr float LN_EPS = 1e-5f, RMS_EPS = 1e-6f;
constexpr float QSCALE = 0.125f * 1.4426950408889634f;

constexpr size_t MiB = 1u << 20;
constexpr size_t WS_CTL = 0, CTL_ZERO_BYTES = 1 * MiB;
constexpr size_t WS_MOD = 1 * MiB;
constexpr size_t WS_ROPE = 2 * MiB;
constexpr size_t WS_STATS = 2 * MiB + 65536;
constexpr size_t WS_IDENT = 2 * MiB + 262144;
constexpr size_t WS_MODP = 3 * MiB;
constexpr size_t WS_DT = 15 * MiB;
constexpr size_t WS_H = 18 * MiB;
constexpr size_t WS_HC = WS_H + 68 * MiB;
constexpr size_t WS_HM = 154 * MiB;
constexpr size_t WS_PROJ = 222 * MiB;
constexpr size_t WS_O = 664 * MiB;
constexpr size_t WS_YD = 732 * MiB;
constexpr size_t WS_YS = 800 * MiB;
constexpr size_t WS_W = 868 * MiB;
constexpr size_t W_13 = 0, W_2 = 88 * MiB, W_IN = 132 * MiB, W_B = 185 * MiB, W_O = 197 * MiB, W_GLU = 205 * MiB;
constexpr size_t WS_S5ST = 1075 * MiB;
constexpr size_t WS_S5H = 1143 * MiB;
constexpr size_t WS_S5M = 1183 * MiB;
constexpr size_t WS_S5A = 1207 * MiB;
constexpr size_t WS_GQ0 = WS_O + 34 * MiB, WS_GQ1 = WS_S5ST + 34 * MiB  , WS_GQ2 = 1208 * MiB;
constexpr size_t WS_END = 1242 * MiB;
__device__ __forceinline__ size_t gq_off(int j) { return j == 0 ? WS_GQ0 : (j == 1 ? WS_GQ1 : WS_GQ2); }
constexpr int S5M = 1088;
constexpr int CW_BAR = 4096;

__device__ __forceinline__ unsigned cvt_pk_bf16(float lo, float hi) { unsigned r; asm volatile("v_cvt_pk_bf16_f32 %0, %1, %2" : "=v"(r) : "v"(lo), "v"(hi)); return r; }
__device__ __forceinline__ float bflo(unsigned u) { return __uint_as_float(u << 16); }
__device__ __forceinline__ float bfhi(unsigned u) { return __uint_as_float(u & 0xffff0000u); }
__device__ __forceinline__ float bf1(bf16_t h) { return __uint_as_float((unsigned)h << 16); }
typedef _Float16 h16x2 __attribute__((ext_vector_type(2)));
typedef _Float16 h16x4 __attribute__((ext_vector_type(4)));
typedef _Float16 h16x8 __attribute__((ext_vector_type(8)));
__device__ __forceinline__ f32x4 ld_h4(const _Float16* p) { const h16x4 h = *(const h16x4*)p; return (f32x4){(float)h[0], (float)h[1], (float)h[2], (float)h[3]}; }
__device__ __forceinline__ void st_h4(_Float16* p, f32x4 v) { h16x4 h; h[0] = (_Float16)v[0]; h[1] = (_Float16)v[1]; h[2] = (_Float16)v[2]; h[3] = (_Float16)v[3]; *(h16x4*)p = h; }
__device__ __forceinline__ float sigmoidf_(float x) { return __builtin_amdgcn_rcpf(1.0f + __builtin_amdgcn_exp2f(-1.4426950408889634f * x)); }
__device__ __forceinline__ float siluf_(float x) { return x * sigmoidf_(x); }
__device__ __forceinline__ int lane_now() { int l; asm volatile("v_mbcnt_lo_u32_b32 %0, -1, 0\n\tv_mbcnt_hi_u32_b32 %0, -1, %0" : "=v"(l)); return l; }
__device__ __forceinline__ float shx(float v, int m, int lane) { return __int_as_float(__builtin_amdgcn_ds_bpermute((lane ^ m) << 2, __float_as_int(v))); }
__device__ __forceinline__ float wave_sum(float v, int lane) {
#pragma unroll
    for (int o = 1; o < 64; o <<= 1) v += shx(v, o, lane);
    return v;
}
#define LDS_WAIT() asm volatile("s_waitcnt lgkmcnt(0)" ::: "memory")
#define VM_WAIT() asm volatile("s_waitcnt vmcnt(0)" ::: "memory")

namespace pg8 {
constexpr int BM = 256, BK = 64, HALF = 128, HTB = HALF * BK * 2, STAGE_BYTES = 8 * HTB, NXCD = 8, WGM = 8, PPB_ = 17;
__host__ __device__ __forceinline__ int lds_byte(int r, int c) { const int st = (r >> 4) * 2 + (c >> 5), rr = r & 15, cc = c & 31, ob = rr * 64 + cc * 2; return st * 1024 + (ob ^ (((ob >> 9) & 1) << 5)); }
__host__ __device__ __forceinline__ int perm32(int rho) { const int n = rho >> 4, i = rho & 15; return 8 * (i >> 2) + 4 * n + (i & 3); }
__host__ __device__ __forceinline__ void stage_rc(int b, int& R_, int& C_) { const int st = b / 1024, sb = b % 1024, swz = sb ^ (((sb >> 9) & 1) << 5); R_ = (st >> 1) * 16 + swz / 64; C_ = (st & 1) * 32 + (swz % 64) / 2; }

struct Unit { int pm, pn, aux, kt; const char* a; const char* b; };
struct Gemm { int lda, ldb, K; };

__device__ __forceinline__ void xcd_remap(int L, int nM, int nN, int& pm, int& pn) {
    const int nwg = nM * nN; int wgid = L;
    { const int q = nwg / NXCD, r = nwg % NXCD, xcd = wgid % NXCD, off = wgid / NXCD; wgid = (xcd < r ? xcd * (q + 1) : r * (q + 1) + (xcd - r) * q) + off; }
    const int nig = WGM * nN, gid = wgid / nig, fm = gid * WGM, gsz = (nM - fm) < WGM ? (nM - fm) : WGM;
    pm = fm + ((wgid % nig) % gsz); pn = (wgid % nig) / gsz;
}
struct StaticOrder {
    int nM, nN, nwg, G, c, kt, latonly, nctx; const char* A; const char* B; size_t tA, tB;
    __device__ __forceinline__ void init(int nM_, int nN_, int G_, int c_, const void* A_, int lda, const void* B_, int ldb, int K, int latonly_ = 0, int nctx_ = 0) { nM = nM_; nN = nN_; nwg = nM * nN; G = G_; c = c_; kt = K / BK; latonly = latonly_; nctx = nctx_;
        A = (const char*)A_; B = (const char*)B_; tA = (size_t)BM * lda * 2; tB = (size_t)BM * ldb * 2; }
    __device__ __forceinline__ bool next(int i, Unit& u) const {
        const long L = (long)i * G + c;
        if (L < nwg) { xcd_remap((int)L, nM, nN, u.pm, u.pn); if (latonly) u.pm += (u.pm >> 4) + 1; u.aux = 0; u.kt = kt; u.a = A + (size_t)u.pm * tA; u.b = B + (size_t)u.pn * tB; return true; }
        const int x = (int)(L - nwg); if (x >= nctx) return false;
        const int q = x & 3, t2 = x >> 2; u.pm = PPB_ * (t2 / nN); u.pn = t2 % nN; u.aux = 1 + q; u.kt = kt >> 2;
        u.a = A + (size_t)u.pm * tA + (size_t)q * (kt >> 2) * BK * 2; u.b = B + (size_t)u.pn * tB + (size_t)q * (kt >> 2) * BK * 2; return true;
    }
};
template <class Epi, class Sched, int AMODE = 0, bool HOOK = false>
__device__ __forceinline__ void gemm_phase(LAS unsigned char* lds, const Gemm g, const Sched& S, const Epi& E, const int tid) {
    const int wid = __builtin_amdgcn_readfirstlane(tid >> 6), lane = tid & 63, wr = wid >> 2, wc = wid & 3, fr = lane & 15, fq = lane >> 4;
    unsigned voffA[2], voffB[2];
#pragma unroll
    for (int i = 0; i < 2; ++i) { int R_, C_; stage_rc(tid * 16 + i * 8192, R_, C_);
        voffA[i] = (AMODE == 1) ? (unsigned)((R_ * 16 + (C_ >> 4)) * LDP + (C_ & 15)) * 2u : (unsigned)(R_ * g.lda + C_) * 2u; voffB[i] = (unsigned)((Epi::PERM ? ((R_ & ~31) + perm32(R_ & 31)) : R_) * g.ldb + C_) * 2u; }
    const size_t kstep = (size_t)(BK * 2), kstepA = (AMODE == 1) ? (size_t)(4 * LDP * 2) : kstep;
    const size_t hstepA = (AMODE == 1) ? (size_t)HALF * 16 * LDP * 2 : (size_t)HALF * g.lda * 2, hstepB = (size_t)HALF * g.ldb * 2;
    const unsigned ldsw = (unsigned)wid * 1024u;
    const int aoff = lds_byte(wr * 64 + fr, fq * 8), boff = lds_byte(wc * 32 + fr, fq * 8);
#define PG8_SA(b, h) (((b) * 2 + (h)) * HTB)
#define PG8_SB(b, h) ((4 + (b) * 2 + (h)) * HTB)
#define PG8_STAGE(bufoff, gbase, voff) do { _Pragma("unroll") for (int _i = 0; _i < 2; ++_i) \
        __builtin_amdgcn_global_load_lds((const unsigned*)((const char*)(gbase) + (voff)[_i]), (LAS unsigned*)(lds + (bufoff) + ldsw + _i * 8192), 16, 0, 0); } while (0)
#define PG8_LDA(dst, b, h) do { _Pragma("unroll") for (int m = 0; m < 4; ++m) _Pragma("unroll") for (int k = 0; k < 2; ++k) dst[m][k] = *(const LAS bf16x8*)(lds + PG8_SA(b, h) + aoff + m * 2048 + k * 1024); } while (0)
#define PG8_LDB(dst, b, h) do { _Pragma("unroll") for (int n = 0; n < 2; ++n) _Pragma("unroll") for (int k = 0; k < 2; ++k) dst[n][k] = *(const LAS bf16x8*)(lds + PG8_SB(b, h) + boff + n * 2048 + k * 1024); } while (0)
#define PG8_MMA(ai, bj, At, Bt) do { __builtin_amdgcn_s_setprio(1); _Pragma("unroll") for (int m = 0; m < 4; ++m) _Pragma("unroll") for (int n = 0; n < 2; ++n) _Pragma("unroll") for (int k = 0; k < 2; ++k) \
        acc[ai][bj][m][n] = __builtin_amdgcn_mfma_f32_16x16x32_bf16(Bt[n][k], At[m][k], acc[ai][bj][m][n], 0, 0, 0); __builtin_amdgcn_s_setprio(0); } while (0)
#define PG8_WAIT_V(n) asm volatile("s_waitcnt vmcnt(" #n ")" ::: "memory")
#define PG8_WAIT_L(n) asm volatile("s_waitcnt lgkmcnt(" #n ")" ::: "memory")
#define PG8_BAR __builtin_amdgcn_s_barrier()
#define PG8_SCHED __builtin_amdgcn_sched_barrier(0)
    Unit cur, nxt; int ui = 0;
    if (!S.next(0, cur)) return;
    f32x4 acc[2][2][4][2];
#pragma unroll
    for (int a = 0; a < 2; ++a)
#pragma unroll
        for (int b = 0; b < 2; ++b)
#pragma unroll
            for (int m = 0; m < 4; ++m)
#pragma unroll
                for (int n = 0; n < 2; ++n) acc[a][b][m][n] = (f32x4){0.f, 0.f, 0.f, 0.f};
    bf16x8 At[4][2], B0[2][2], B1[2][2];
    const char* cA = cur.a; const char* cB = cur.b;
    PG8_STAGE(PG8_SB(0, 0), cB, voffB); PG8_STAGE(PG8_SB(0, 1), cB + hstepB, voffB); PG8_STAGE(PG8_SA(0, 0), cA, voffA); PG8_STAGE(PG8_SA(0, 1), cA + hstepA, voffA);
    if (wr == 1) PG8_BAR;
    PG8_WAIT_V(2); PG8_BAR;
    PG8_STAGE(PG8_SB(1, 0), cB + kstep, voffB); PG8_STAGE(PG8_SA(1, 0), cA + kstepA, voffA); PG8_STAGE(PG8_SB(1, 1), cB + hstepB + kstep, voffB);
    PG8_WAIT_V(6); PG8_BAR;
    for (;;) {
        const bool has_next = S.next(ui + 1, nxt);
        const char* nA = has_next ? nxt.a : cA; const char* nB = has_next ? nxt.b : cB;
        const int nt = cur.kt;
        for (int t = 0; t < nt; t += 2) {
            const bool last = (t == nt - 2);
            if constexpr (HOOK) { if (t == 16 || t == 32) E.mid(acc, cur, t >> 4, wr, wc); }
            const char* a1 = cA + (size_t)(t + 1) * kstepA;
            const char* a2 = last ? nA : cA + (size_t)(t + 2) * kstepA; const char* b2 = last ? nB : cB + (size_t)(t + 2) * kstep;
            const char* a3 = a2 + kstepA; const char* b3 = b2 + kstep;
            PG8_LDB(B0, 0, 0); PG8_LDB(B1, 0, 1); PG8_SCHED; PG8_LDA(At, 0, 0); PG8_STAGE(PG8_SA(1, 1), a1 + hstepA, voffA);
            PG8_WAIT_V(8); PG8_WAIT_L(0); PG8_BAR; PG8_MMA(0, 0, At, B0); PG8_MMA(0, 1, At, B1); PG8_BAR; PG8_SCHED;
            PG8_LDA(At, 0, 1); PG8_STAGE(PG8_SB(0, 0), b2, voffB); PG8_STAGE(PG8_SB(0, 1), b2 + hstepB, voffB); PG8_STAGE(PG8_SA(0, 0), a2, voffA);
            PG8_WAIT_V(8); PG8_WAIT_L(0); PG8_BAR; PG8_MMA(1, 0, At, B0); PG8_MMA(1, 1, At, B1); PG8_BAR; PG8_SCHED;
            PG8_LDB(B0, 1, 0); PG8_LDB(B1, 1, 1); PG8_SCHED; PG8_LDA(At, 1, 0); PG8_STAGE(PG8_SA(0, 1), a2 + hstepA, voffA);
            PG8_WAIT_V(8); PG8_WAIT_L(0); PG8_BAR; PG8_MMA(0, 0, At, B0); PG8_MMA(0, 1, At, B1); PG8_BAR; PG8_SCHED;
            PG8_LDA(At, 1, 1); PG8_STAGE(PG8_SB(1, 0), b3, voffB); PG8_STAGE(PG8_SB(1, 1), b3 + hstepB, voffB); PG8_STAGE(PG8_SA(1, 0), a3, voffA);
            PG8_WAIT_V(8); PG8_WAIT_L(0); PG8_BAR; PG8_MMA(1, 0, At, B0); PG8_MMA(1, 1, At, B1); PG8_BAR; PG8_SCHED;
        }
        if (wr == 0) PG8_BAR;
        E(acc, cur, wr, wc, fr, fq);
        if (!has_next) break;
#pragma unroll
        for (int a = 0; a < 2; ++a)
#pragma unroll
            for (int b = 0; b < 2; ++b)
#pragma unroll
                for (int m = 0; m < 4; ++m)
#pragma unroll
                    for (int n = 0; n < 2; ++n) acc[a][b][m][n] = (f32x4){0.f, 0.f, 0.f, 0.f};
        cur = nxt; cA = nA; cB = nB; ++ui;
        if (wr == 1) PG8_BAR;
    }
    PG8_WAIT_V(0);
    PG8_BAR;
#undef PG8_SA
#undef PG8_SB
#undef PG8_STAGE
#undef PG8_LDA
#undef PG8_LDB
#undef PG8_MMA
#undef PG8_WAIT_V
#undef PG8_WAIT_L
#undef PG8_BAR
#undef PG8_SCHED
}
}

struct EpiSwiGLU {
    static constexpr bool PERM = true;
    bf16_t* O;
    __device__ __forceinline__ void operator()(const f32x4 (&acc)[2][2][4][2], const pg8::Unit& u, int wr, int wc, int, int) const { const int ln_ = lane_now(); const int fr = ln_ & 15, fq = ln_ >> 4;
        const int row0 = u.pm * 256 + wr * 64 + fr, hc0 = u.pn * 128 + wc * 32 + 8 * fq;
#pragma unroll
        for (int ai = 0; ai < 2; ++ai)
#pragma unroll
            for (int m = 0; m < 4; ++m) { const f32x4 a0 = acc[ai][0][m][0], a1 = acc[ai][0][m][1], b0 = acc[ai][1][m][0], b1 = acc[ai][1][m][1];
                u32x4 w; w.x = cvt_pk_bf16(siluf_(a0[0]) * b0[0], siluf_(a0[1]) * b0[1]); w.y = cvt_pk_bf16(siluf_(a0[2]) * b0[2], siluf_(a0[3]) * b0[3]);
                w.z = cvt_pk_bf16(siluf_(a1[0]) * b1[0], siluf_(a1[1]) * b1[1]); w.w = cvt_pk_bf16(siluf_(a1[2]) * b1[2], siluf_(a1[3]) * b1[3]);
                *(u32x4*)(O + (size_t)(row0 + ai * 128 + m * 16) * DFF + hc0) = w; }
    }
};
struct EpiResid {
    static constexpr bool PERM = true;
    _Float16* H; float* HC; const float* gate; const float* lng; const float* lnb; const float* stats;
    __device__ __forceinline__ void operator()(const f32x4 (&acc)[2][2][4][2], const pg8::Unit& u, int wr, int wc, int, int) const { const int ln_ = lane_now(); const int fr = ln_ & 15, fq = ln_ >> 4;
        int upm = u.pm, upn = u.pn; asm volatile("" : "+s"(upm), "+s"(upn));
        const int pp = upm % PPB, mi = (pp == 0) ? 4 : (upm / PPB);
        const int rl0 = wr * 64 + fr, col0 = upn * 256 + wc * 32 + 8 * fq;
        if (u.aux) {
            float* hc = (float*)((char*)HC - WS_HC + WS_YD) + ((size_t)(u.aux - 1) * (NB * CTX) + (size_t)(upm / PPB) * 256) * D;
#pragma unroll
            for (int bj = 0; bj < 2; ++bj) { const f32x4 gv0 = *(const f32x4*)(gate + (size_t)mi * NMOD + col0 + bj * 128), gv1 = *(const f32x4*)(gate + (size_t)mi * NMOD + col0 + bj * 128 + 4);
#pragma unroll
                for (int ai = 0; ai < 2; ++ai)
#pragma unroll
                    for (int m = 0; m < 4; ++m) { float* p = hc + (size_t)(rl0 + ai * 128 + m * 16) * D + col0 + bj * 128; *(f32x4*)p = gv0 * acc[ai][bj][m][0]; *(f32x4*)(p + 4) = gv1 * acc[ai][bj][m][1]; } }
            return;
        }
#pragma unroll
        for (int bj = 0; bj < 2; ++bj) { const int c = col0 + bj * 128;
            const f32x4 gv0 = *(const f32x4*)(gate + (size_t)mi * NMOD + c), gv1 = *(const f32x4*)(gate + (size_t)mi * NMOD + c + 4);
            const f32x4 g0 = *(const f32x4*)(lng + c) * DN_ALPHA, g1 = *(const f32x4*)(lng + c + 4) * DN_ALPHA, b0 = *(const f32x4*)(lnb + c) * DN_ALPHA, b1 = *(const f32x4*)(lnb + c + 4) * DN_ALPHA;
#pragma unroll
            for (int ai = 0; ai < 2; ++ai) {
                u32x4 tv[4]; f32x2 st[4];
#pragma unroll
                for (int m = 0; m < 4; ++m) { const size_t row = (size_t)(upm * 256 + rl0 + ai * 128 + m * 16); tv[m] = *(const u32x4*)(H + row * D + c); st[m] = *(const f32x2*)(stats + row * 2); }
                asm volatile("s_waitcnt vmcnt(0)" ::: "memory");
#pragma unroll
                for (int m = 0; m < 4; ++m) { const h16x4 ha = __builtin_bit_cast(h16x4, (u32x2){tv[m].x, tv[m].y}), hb = __builtin_bit_cast(h16x4, (u32x2){tv[m].z, tv[m].w});
                    const f32x4 t0 = (f32x4){(float)ha[0], (float)ha[1], (float)ha[2], (float)ha[3]}, t1 = (f32x4){(float)hb[0], (float)hb[1], (float)hb[2], (float)hb[3]};
                    const f32x4 o0 = (t0 - st[m].x) * st[m].y * g0 + b0 + gv0 * acc[ai][bj][m][0], o1 = (t1 - st[m].x) * st[m].y * g1 + b1 + gv1 * acc[ai][bj][m][1];
                    h16x4 qa, qb; qa[0] = (_Float16)o0[0]; qa[1] = (_Float16)o0[1]; qa[2] = (_Float16)o0[2]; qa[3] = (_Float16)o0[3]; qb[0] = (_Float16)o1[0]; qb[1] = (_Float16)o1[1]; qb[2] = (_Float16)o1[2]; qb[3] = (_Float16)o1[3];
                    const u32x2 pa = __builtin_bit_cast(u32x2, qa), pb = __builtin_bit_cast(u32x2, qb);
                    *(u32x4*)(H + (size_t)(upm * 256 + rl0 + ai * 128 + m * 16) * D + c) = (u32x4){pa.x, pa.y, pb.x, pb.y}; } } }
    }
};
struct EpiProj {
    static constexpr bool PERM = true;
    bf16_t* P; float* DT; const float* rc; const float* rs; bf16_t* U2;
    __device__ __forceinline__ void operator()(const f32x4 (&acc)[2][2][4][2], const pg8::Unit& u, int wr, int wc, int, int) const { const int ln_ = lane_now(); const int fr = ln_ & 15, fq = ln_ >> 4;
        const int pp = u.pm % PPB; const int row0 = u.pm * 256 + wr * 64 + fr;
        const int pn = u.pn;
        if (pn == 52) {
            if (wc == 0) {
#pragma unroll
                for (int ai = 0; ai < 2; ++ai)
#pragma unroll
                    for (int m = 0; m < 4; ++m)
#pragma unroll
                        for (int n = 0; n < 2; ++n) *(f32x4*)(DT + (size_t)(row0 + ai * 128 + m * 16) * 32 + 8 * fq + 4 * n) = acc[ai][0][m][n];
            }
            return;
        }
        if (pn >= 28) {
            const int jg = (pn - 28) >> 3, pnd = (pn - 28) & 7;
            unsigned char* gq = (unsigned char*)P - WS_PROJ + gq_off(jg) + ((size_t)((u.pm * 8 + pnd) * 512 + (wr * 4 + wc) * 64 + ln_)) * 128;
#pragma unroll
            for (int ai = 0; ai < 2; ++ai)
#pragma unroll
                for (int m = 0; m < 4; ++m) { u32x4 w;
#pragma unroll
                    for (int bj = 0; bj < 2; ++bj)
#pragma unroll
                        for (int n = 0; n < 2; ++n) { const f32x4 v = acc[ai][bj][m][n]; unsigned q = 0;
#pragma unroll
                            for (int e = 0; e < 4; ++e) q |= (unsigned)fmaxf(__builtin_rintf(sigmoidf_(v[e]) * 255.0f), 1.0f) << (8 * e);
                            w[bj * 2 + n] = q; }
                    *(u32x4*)(gq + (ai * 4 + m) * 16) = w; }
            return;
        }
        const int col0 = pn * 256 + wc * 32 + 4 * fq;
        const int mode = (pn < 8) ? ((pp != 0) ? 1 : 0) : ((pn >= 12 && pn < 16) ? 2 : 0);
        const float sc = (pn < 4) ? QSCALE : 1.0f;
#pragma unroll
        for (int ai = 0; ai < 2; ++ai) {
          f32x4 csv[4], snv[4];
          if (mode == 1) {
#pragma unroll
              for (int m = 0; m < 4; ++m) { const int rl = ai * 128 + wr * 64 + m * 16 + fr; const int t = (pp - 1) * 256 + rl; const int pos = (wc & 1) ? (t & 63) : (t >> 6); csv[m] = *(const f32x4*)(rc + pos * 16 + 4 * fq); snv[m] = *(const f32x4*)(rs + pos * 16 + 4 * fq); }
              asm volatile("s_waitcnt vmcnt(0)" ::: "memory"); }
#pragma unroll
            for (int m = 0; m < 4; ++m) { const int rl = ai * 128 + wr * 64 + m * 16 + fr; bf16_t* rowp = P + (size_t)(u.pm * 256 + rl) * LDP + col0;
                f32x4 cs = (f32x4){1.f, 1.f, 1.f, 1.f}, sn = (f32x4){0.f, 0.f, 0.f, 0.f};
                if (mode == 1) { cs = csv[m]; sn = snv[m]; }
#pragma unroll
                for (int bj = 0; bj < 2; ++bj) { f32x4 v0 = acc[ai][bj][m][0], v1 = acc[ai][bj][m][1];
                    if (mode == 1) { const f32x4 o0 = v0 * cs - v1 * sn, o1 = v1 * cs + v0 * sn; v0 = o0; v1 = o1; }
                    else if (mode == 2) {
#pragma unroll
                        for (int e = 0; e < 4; ++e) { v0[e] = siluf_(v0[e]); v1[e] = siluf_(v1[e]); } }
                    if (pn >= 24 && pn < 28) {
                        const int cu = (pn - 24) * 256 + bj * 128 + wc * 32 + 8 * fq;
                        bf16_t* u2 = U2 + ((size_t)(cu >> 4) * R + (size_t)(u.pm * 256 + rl)) * 16 + (cu & 15);
                        u32x4 a; a.x = cvt_pk_bf16(v0[0], v0[1]); a.y = cvt_pk_bf16(v0[2], v0[3]); a.z = cvt_pk_bf16(v1[0], v1[1]); a.w = cvt_pk_bf16(v1[2], v1[3]);
                        *(u32x4*)u2 = a; continue; }
                    v0 = v0 * sc; v1 = v1 * sc;
                    if (pn < 8) { u32x2 w0, w1; w0.x = cvt_pk_bf16(v0[0], v0[1]); w0.y = cvt_pk_bf16(v0[2], v0[3]); w1.x = cvt_pk_bf16(v1[0], v1[1]); w1.y = cvt_pk_bf16(v1[2], v1[3]);
                        *(u32x2*)(rowp + bj * 128) = w0; *(u32x2*)(rowp + bj * 128 + 16) = w1; }
                    else { u32x4 w; w.x = cvt_pk_bf16(v0[0], v0[1]); w.y = cvt_pk_bf16(v0[2], v0[3]); w.z = cvt_pk_bf16(v1[0], v1[1]); w.w = cvt_pk_bf16(v1[2], v1[3]);
                        *(u32x4*)(rowp + 4 * fq + bj * 128) = w; } } } }
    }
};
struct EpiGlu {
    static constexpr bool PERM = false;
    bf16_t* P; const float* bias;
    __device__ __forceinline__ void operator()(const f32x4 (&acc)[2][2][4][2], const pg8::Unit& u, int wr, int wc, int, int) const { const int ln_ = lane_now(); const int fr = ln_ & 15, fq = ln_ >> 4;
        const int row0 = u.pm * 256 + wr * 64 + fr, col0 = u.pn * 256 + wc * 32 + 4 * fq;
        f32x4 bv[2][2];
#pragma unroll
        for (int bj = 0; bj < 2; ++bj)
#pragma unroll
            for (int n = 0; n < 2; ++n) bv[bj][n] = *(const f32x4*)(bias + col0 + bj * 128 + n * 16);
#pragma unroll
        for (int ai = 0; ai < 2; ++ai) {
            u32x2 tv[4][2][2];
#pragma unroll
            for (int m = 0; m < 4; ++m)
#pragma unroll
                for (int bj = 0; bj < 2; ++bj)
#pragma unroll
                    for (int n = 0; n < 2; ++n) tv[m][bj][n] = *(const u32x2*)(P + (size_t)(row0 + ai * 128 + m * 16) * LDP + PU + col0 + bj * 128 + n * 16);
            asm volatile("s_waitcnt vmcnt(0)" ::: "memory");
#pragma unroll
            for (int m = 0; m < 4; ++m) { bf16_t* rowp = P + (size_t)(row0 + ai * 128 + m * 16) * LDP;
#pragma unroll
                for (int bj = 0; bj < 2; ++bj)
#pragma unroll
                    for (int n = 0; n < 2; ++n) { const int c = col0 + bj * 128 + n * 16; const u32x2 t = tv[m][bj][n];
                        const f32x4 a = acc[ai][bj][m][n] + bv[bj][n]; u32x2 w;
                        w.x = cvt_pk_bf16(bflo(t.x) * sigmoidf_(a[0]), bfhi(t.x) * sigmoidf_(a[1])); w.y = cvt_pk_bf16(bflo(t.y) * sigmoidf_(a[2]), bfhi(t.y) * sigmoidf_(a[3]));
                        *(u32x2*)(rowp + PK + c) = w; } } }
    }
};
struct EpiMerge {
    static constexpr bool PERM = true;
    const bf16_t* P; bf16_t* MIXB;
    static __device__ __forceinline__ int jmap(int seg) { return seg == 0 ? 0 : (seg == 1 ? 2 : 1); }
    __device__ __forceinline__ const unsigned char* gbase(const pg8::Unit& u, int seg, int wr, int wc, int ln_) const {
        return (const unsigned char*)P - WS_PROJ + gq_off(jmap(seg)) + ((size_t)((u.pm * 8 + u.pn) * 512 + (wr * 4 + wc) * 64 + ln_)) * 128; }
    __device__ __forceinline__ void mid(f32x4 (&acc)[2][2][4][2], const pg8::Unit& u, int seg, int wr, int wc) const {
        const int ln_ = lane_now(); const unsigned char* ga = gbase(u, seg - 1, wr, wc, ln_); const unsigned char* gb = gbase(u, seg, wr, wc, ln_);
        u32x4 a[2][4], b[2][4];
#pragma unroll
        for (int ai = 0; ai < 2; ++ai)
#pragma unroll
            for (int m = 0; m < 4; ++m) { a[ai][m] = *(const u32x4*)(ga + (ai * 4 + m) * 16); b[ai][m] = *(const u32x4*)(gb + (ai * 4 + m) * 16); }
        asm volatile("s_waitcnt vmcnt(0)" ::: "memory");
#pragma unroll
        for (int ai = 0; ai < 2; ++ai)
#pragma unroll
            for (int m = 0; m < 4; ++m)
#pragma unroll
                for (int bj = 0; bj < 2; ++bj)
#pragma unroll
                    for (int n = 0; n < 2; ++n) { const unsigned qa = a[ai][m][bj * 2 + n], qb = b[ai][m][bj * 2 + n]; f32x4 r;
#pragma unroll
                        for (int e = 0; e < 4; ++e) r[e] = (float)((qa >> (8 * e)) & 255u) * __builtin_amdgcn_rcpf((float)((qb >> (8 * e)) & 255u));
                        acc[ai][bj][m][n] = acc[ai][bj][m][n] * r; }
    }
    __device__ __forceinline__ void operator()(const f32x4 (&acc)[2][2][4][2], const pg8::Unit& u, int wr, int wc, int, int) const { const int ln_ = lane_now(); const int fr = ln_ & 15, fq = ln_ >> 4;
        const int row0 = u.pm * 256 + wr * 64 + fr, col0 = u.pn * 256 + wc * 32 + 8 * fq; const unsigned char* gl = gbase(u, 2, wr, wc, ln_);
        u32x4 gq[2][4];
#pragma unroll
        for (int ai = 0; ai < 2; ++ai)
#pragma unroll
            for (int m = 0; m < 4; ++m) gq[ai][m] = *(const u32x4*)(gl + (ai * 4 + m) * 16);
        asm volatile("s_waitcnt vmcnt(0)" ::: "memory");
#pragma unroll
        for (int ai = 0; ai < 2; ++ai)
#pragma unroll
            for (int m = 0; m < 4; ++m) { const size_t row = (size_t)(row0 + ai * 128 + m * 16); const u32x4 g4 = gq[ai][m];
#pragma unroll
                for (int bj = 0; bj < 2; ++bj) { u32x4 w;
#pragma unroll
                    for (int n = 0; n < 2; ++n) { const unsigned gv = g4[bj * 2 + n];
                        f32x4 v = acc[ai][bj][m][n];
#pragma unroll
                        for (int e = 0; e < 4; ++e) v[e] *= (float)((gv >> (8 * e)) & 255u) * (1.0f / 255.0f);
                        w[2 * n] = cvt_pk_bf16(v[0], v[1]); w[2 * n + 1] = cvt_pk_bf16(v[2], v[3]); }
                    *(u32x4*)(MIXB + row * D + col0 + bj * 128) = w; } }
    }
};

struct S5AOrder {
    int G, c; const char* A; const char* B;
    __device__ __forceinline__ bool next(int i, pg8::Unit& u) const {
        const int idx = i * G + c; if (idx >= 640) return false;
        const int g = idx / 10, r = idx - 10 * g, nt = r / 5, mt = r - 5 * nt;
        u.pm = mt; u.pn = nt; u.aux = g; u.kt = 4; u.a = A + ((size_t)g * (R / 16) + (size_t)mt * 256) * 256 * 2; u.b = B + (size_t)(g * 512 + nt * 256) * 256 * 2; return true;
    }
};
struct EpiS5A {
    static constexpr bool PERM = false;
    unsigned char* YLF; bf16_t* ST;
    __device__ __forceinline__ void operator()(const f32x4 (&acc)[2][2][4][2], const pg8::Unit& u, int wr, int wc, int, int) const { const int ln_ = lane_now(); const int fr = ln_ & 15, fq = ln_ >> 4;
        const int g = u.aux;
        if (u.pn == 0) { unsigned char* yl = YLF + ((size_t)((g * 5 + u.pm) * 512 + (wr * 4 + wc) * 64 + ln_)) * 256;
#pragma unroll
            for (int ai = 0; ai < 2; ++ai)
#pragma unroll
                for (int m = 0; m < 4; ++m) { u32x4 w0, w1;
                    w0.x = cvt_pk_bf16(acc[ai][0][m][0][0], acc[ai][0][m][0][1]); w0.y = cvt_pk_bf16(acc[ai][0][m][0][2], acc[ai][0][m][0][3]); w0.z = cvt_pk_bf16(acc[ai][0][m][1][0], acc[ai][0][m][1][1]); w0.w = cvt_pk_bf16(acc[ai][0][m][1][2], acc[ai][0][m][1][3]);
                    w1.x = cvt_pk_bf16(acc[ai][1][m][0][0], acc[ai][1][m][0][1]); w1.y = cvt_pk_bf16(acc[ai][1][m][0][2], acc[ai][1][m][0][3]); w1.z = cvt_pk_bf16(acc[ai][1][m][1][0], acc[ai][1][m][1][1]); w1.w = cvt_pk_bf16(acc[ai][1][m][1][2], acc[ai][1][m][1][3]);
                    *(u32x4*)(yl + (ai * 4 + m) * 32) = w0; *(u32x4*)(yl + (ai * 4 + m) * 32 + 16) = w1; }
            return; }
#pragma unroll
        for (int ai = 0; ai < 2; ++ai)
#pragma unroll
            for (int m = 0; m < 4; ++m) { const int mr = u.pm * 256 + ai * 128 + wr * 64 + m * 16 + fr; if (mr < S5M) {
#pragma unroll
                for (int bj = 0; bj < 2; ++bj)
#pragma unroll
                    for (int n = 0; n < 2; ++n) { const f32x4 v = acc[ai][bj][m][n];
                        u32x2 w; w.x = cvt_pk_bf16(v[0], v[1]); w.y = cvt_pk_bf16(v[2], v[3]); *(u32x2*)(ST + ((size_t)g * S5M + mr) * 256 + bj * 128 + wc * 32 + n * 16 + 4 * fq) = w; } } }
    }
};
struct S5COrder {
    int G, c; const char* A; const char* B;
    __device__ __forceinline__ bool next(int i, pg8::Unit& u) const {
        const int idx = i * G + c; if (idx >= 320) return false;
        const int g = idx / 5, mt = idx - 5 * g;
        u.pm = mt; u.pn = 0; u.aux = g; u.kt = 4; u.a = A + ((size_t)g * 1280 + mt * 256) * 256 * 2; u.b = B + (size_t)g * 256 * 256 * 2; return true;
    }
};
struct EpiS5C {
    static constexpr bool PERM = false;
    const unsigned char* YLF; bf16_t* P;
    __device__ __forceinline__ void operator()(const f32x4 (&acc)[2][2][4][2], const pg8::Unit& u, int wr, int wc, int, int) const { const int ln_ = lane_now(); const int fr = ln_ & 15, fq = ln_ >> 4;
        const int g = u.aux; const unsigned char* yl = YLF + ((size_t)((g * 5 + u.pm) * 512 + (wr * 4 + wc) * 64 + ln_)) * 256;
#pragma unroll
        for (int ai = 0; ai < 2; ++ai) {
        u32x4 y0[2][4], y1[2][4];
#pragma unroll
            for (int m = 0; m < 4; ++m) { y0[ai][m] = *(const u32x4*)(yl + (ai * 4 + m) * 32); y1[ai][m] = *(const u32x4*)(yl + (ai * 4 + m) * 32 + 16); }
        asm volatile("s_waitcnt vmcnt(0)" ::: "memory");
#pragma unroll
            for (int m = 0; m < 4; ++m) { const int mr = u.pm * 256 + ai * 128 + wr * 64 + m * 16 + fr; if (mr < S5M) {
#pragma unroll
                for (int bj = 0; bj < 2; ++bj)
#pragma unroll
                    for (int n = 0; n < 2; ++n) { const int rho = 8 * bj + 2 * wc + n; const size_t row = (size_t)(16 * mr + rho);
                        const u32x4 yy = bj ? y1[ai][m] : y0[ai][m]; const unsigned ya = n ? yy.z : yy.x, yb = n ? yy.w : yy.y; f32x4 v = acc[ai][bj][m][n];
                        v[0] += bflo(ya); v[1] += bfhi(ya); v[2] += bflo(yb); v[3] += bfhi(yb);
#pragma unroll
                        for (int e = 0; e < 4; ++e) { const float x = v[e]; const float inner = 0.7978845608028654f * (x + 0.044715f * x * x * x); const float th = 1.0f - 2.0f * __builtin_amdgcn_rcpf(1.0f + __builtin_amdgcn_exp2f(2.8853900817779268f * inner)); v[e] = 0.5f * x * (1.0f + th); }
                        u32x2 w; w.x = cvt_pk_bf16(v[0], v[1]); w.y = cvt_pk_bf16(v[2], v[3]); *(u32x2*)(P + row * LDP + PU + 16 * g + 4 * fq) = w; } } } }
    }
};

namespace attn128 {
using bf16 = __hip_bfloat16;
constexpr int NW = 8, QBLK = 32, KVBLK = 64, LDQ = LDP, LDK = LDP, LDOB = LDP;
constexpr size_t SHM_V = KVBLK * 128 * 2, SHM_K = KVBLK * 64 * 2, SHM_ATTN = 2 * SHM_V + 2 * SHM_K + NW * 64 * 4, SHM_TOTAL = SHM_ATTN + NW * 8192;
constexpr float THRL = 11.5f;
#define A128_KSWZ(row, colB) ((row) * 128 + ((colB) ^ (((row) & 7) << 4)))
#define A128_SBAR() __builtin_amdgcn_sched_barrier(0)
__device__ __forceinline__ int crow(int r, int hi) { return (r & 3) + 8 * (r >> 2) + 4 * hi; }
__device__ __forceinline__ void partialSM(f32x16& p0, f32x16& p1, float& m_reg, float& mn, float& alpha) {
  float pmax = p0[0];
#pragma unroll
  for (int r = 1; r < 16; ++r) pmax = fmaxf(pmax, p0[r]);
#pragma unroll
  for (int r = 0; r < 16; ++r) pmax = fmaxf(pmax, p1[r]);
  { auto rr = __builtin_amdgcn_permlane32_swap(__float_as_uint(pmax), __float_as_uint(pmax), false, false); pmax = fmaxf(__uint_as_float(rr[0]), __uint_as_float(rr[1])); }
  if (__builtin_expect(__all(pmax - m_reg <= THRL), 1)) { mn = m_reg; alpha = 1.f; }
  else { mn = fmaxf(m_reg, pmax); alpha = __builtin_amdgcn_exp2f(m_reg - mn); m_reg = mn; }
#pragma unroll
  for (int r = 0; r < 16; ++r) { p0[r] = p0[r] - mn; p1[r] = p1[r] - mn; }
#pragma unroll
  for (int r = 0; r < 16; ++r) p0[r] = __builtin_amdgcn_exp2f(p0[r]);
}
__device__ __forceinline__ void finishSM(f32x16& p0, f32x16& p1, float alpha, float& l_reg, bf16x8& pa0, bf16x8& pa1, bf16x8& pa2, bf16x8& pa3) {
#pragma unroll
  for (int r = 0; r < 16; ++r) p1[r] = __builtin_amdgcn_exp2f(p1[r]);
  float ps = 0;
#pragma unroll
  for (int r = 0; r < 16; ++r) ps += p0[r];
#pragma unroll
  for (int r = 0; r < 16; ++r) ps += p1[r];
  { auto rr = __builtin_amdgcn_permlane32_swap(__float_as_uint(ps), __float_as_uint(ps), false, false); ps = __uint_as_float(rr[0]) + __uint_as_float(rr[1]); }
  l_reg = l_reg * alpha + ps;
#define A128_PK4(P, BASE, OUT) do { unsigned a0 = cvt_pk_bf16(P[BASE + 0], P[BASE + 1]), a1 = cvt_pk_bf16(P[BASE + 2], P[BASE + 3]);   \
    unsigned b0 = cvt_pk_bf16(P[BASE + 4], P[BASE + 5]), b1 = cvt_pk_bf16(P[BASE + 6], P[BASE + 7]);                              \
    auto r0 = __builtin_amdgcn_permlane32_swap(a0, b0, false, false); auto r1 = __builtin_amdgcn_permlane32_swap(a1, b1, false, false); \
    u32x4 w = {r0[0], r1[0], r0[1], r1[1]}; OUT = __builtin_bit_cast(bf16x8, w); } while (0)
  A128_PK4(p0, 0, pa0); A128_PK4(p0, 8, pa1); A128_PK4(p1, 0, pa2); A128_PK4(p1, 8, pa3);
#undef A128_PK4
}
__device__ __forceinline__ void qkt(f32x16& p0, f32x16& p1, const char* Ks, const bf16x8* qr, int r32, int hi) {
#pragma unroll
  for (int i = 0; i < 16; ++i) { p0[i] = 0.f; p1[i] = 0.f; }
#pragma unroll
  for (int d0 = 0; d0 < 4; ++d0) { const int cb = (d0 * 16 + hi * 8) * 2;
    const bf16x8 b0 = *reinterpret_cast<const bf16x8*>(Ks + A128_KSWZ(r32, cb));
    const bf16x8 b1 = *reinterpret_cast<const bf16x8*>(Ks + A128_KSWZ(32 + r32, cb));
    p0 = __builtin_amdgcn_mfma_f32_32x32x16_bf16(b0, qr[d0], p0, 0, 0, 0);
    p1 = __builtin_amdgcn_mfma_f32_32x32x16_bf16(b1, qr[d0], p1, 0, 0, 0); }
}
__device__ __forceinline__ int v_st(int k, int c) { const int kk = (k & ~0xC) | ((k & 4) << 1) | ((k & 8) >> 1); return ((kk >> 3) * 4 + (c >> 5)) * 512 + ((kk & 7) * 32 + (c & 31)) * 2; }
__device__ __forceinline__ int v_rd_base(int lane) { return ((lane & 3) << 3) | (((lane >> 2) & 3) << 6) | (((lane >> 4) & 1) << 5) | (((lane >> 5) & 1) << 8); }
constexpr int v_rd_off(int d0, int ks, int half) { return d0 * 512 + ks * 4096 + half * 2048; }
template <int OFF> __device__ __forceinline__ s16x4 tr_read(int vb) { s16x4 r; asm volatile("ds_read_b64_tr_b16 %0, %1 offset:%2" : "=&v"(r) : "v"(vb), "i"(OFF) : "memory"); return r; }
template <int D0> __device__ __forceinline__ void pv_one(f32x16& od, int vb, bf16x8 pa0, bf16x8 pa1, bf16x8 pa2, bf16x8 pa3) {
  const s16x4 l0 = tr_read<v_rd_off(D0, 0, 0)>(vb), h0 = tr_read<v_rd_off(D0, 0, 1)>(vb), l1 = tr_read<v_rd_off(D0, 1, 0)>(vb), h1 = tr_read<v_rd_off(D0, 1, 1)>(vb);
  const s16x4 l2 = tr_read<v_rd_off(D0, 2, 0)>(vb), h2 = tr_read<v_rd_off(D0, 2, 1)>(vb), l3 = tr_read<v_rd_off(D0, 3, 0)>(vb), h3 = tr_read<v_rd_off(D0, 3, 1)>(vb);
  asm volatile("s_waitcnt lgkmcnt(0)" ::: "memory"); A128_SBAR();
#define A128_PK(L, H) (bf16x8){L[0], L[1], L[2], L[3], H[0], H[1], H[2], H[3]}
  od = __builtin_amdgcn_mfma_f32_32x32x16_bf16(pa0, A128_PK(l0, h0), od, 0, 0, 0);
  od = __builtin_amdgcn_mfma_f32_32x32x16_bf16(pa1, A128_PK(l1, h1), od, 0, 0, 0);
  od = __builtin_amdgcn_mfma_f32_32x32x16_bf16(pa2, A128_PK(l2, h2), od, 0, 0, 0);
  od = __builtin_amdgcn_mfma_f32_32x32x16_bf16(pa3, A128_PK(l3, h3), od, 0, 0, 0);
#undef A128_PK
}
__device__ __forceinline__ void pv_d0(f32x16* o, int vb, bf16x8 pa0, bf16x8 pa1, bf16x8 pa2, bf16x8 pa3) {
  pv_one<0>(o[0], vb, pa0, pa1, pa2, pa3); pv_one<1>(o[1], vb, pa0, pa1, pa2, pa3); pv_one<2>(o[2], vb, pa0, pa1, pa2, pa3); pv_one<3>(o[3], vb, pa0, pa1, pa2, pa3);
}
__device__ __forceinline__ void unit(const bf16* __restrict__ Qb0, const bf16* __restrict__ Kh0, const bf16* __restrict__ Vh, bf16_t* Ob, int seq, char* lds, const int tid_in, const float lam, const float onem, const float* __restrict__ subw) {
#pragma unroll 1
 for (int mp = 0; mp < 2; ++mp) {
  int tid = tid_in; asm volatile("" : "+v"(tid));
  bf16_t* stage = (bf16_t*)(lds + SHM_ATTN) + (tid >> 6) * 4096;
  const bf16* Qb = Qb0 + mp * 64; const bf16* Kh = Kh0 + mp * 64;
  const int wid = __builtin_amdgcn_readfirstlane(tid >> 6), lane = tid & 63, r32 = lane & 31, hi = lane >> 5;
  char* V_lds = lds; char* K_lds = lds + 2 * SHM_V;
  float* ws = (float*)(lds + 2 * SHM_V + 2 * SHM_K) + wid * 64; float* li_l = ws; float* al_l = ws + 32;
  float m_reg = -1e30f, l_reg = 0; f32x16 o[4]; bf16x8 qr[4];
#pragma unroll
  for (int d = 0; d < 4; ++d)
#pragma unroll
    for (int r = 0; r < 16; ++r) o[d][r] = 0.f;
  const bf16* Qw = Qb + (long)(wid * QBLK + r32) * LDQ + hi * 8;
#pragma unroll
  for (int d0 = 0; d0 < 4; ++d0) qr[d0] = *reinterpret_cast<const bf16x8*>(Qw + d0 * 16);
  const int sr = tid >> 4, sc = (tid & 15) * 8, vst0 = v_st(sr, sc), vst1 = v_st(32 + sr, sc);
  const int kr = tid >> 3, kc = (tid & 7) * 8, kst = A128_KSWZ(kr, kc * 2);
  const int vb0 = (int)(uintptr_t)V_lds + v_rd_base(lane);
  struct { bf16x8 vs0, vs1, ks0; } sr_[2];
#define A128_SLOAD(i, k0) do { sr_[i].vs0 = *reinterpret_cast<const bf16x8*>(&Vh[(long)((k0) + sr) * LDK + sc]); sr_[i].vs1 = *reinterpret_cast<const bf16x8*>(&Vh[(long)((k0) + 32 + sr) * LDK + sc]); \
    sr_[i].ks0 = *reinterpret_cast<const bf16x8*>(&Kh[(long)((k0) + kr) * LDK + kc]); } while (0)
#define A128_SWRITE(b, i) do { *(bf16x8*)(V_lds + (b) * SHM_V + vst0) = sr_[i].vs0; *(bf16x8*)(V_lds + (b) * SHM_V + vst1) = sr_[i].vs1; *(bf16x8*)(K_lds + (b) * SHM_K + kst) = sr_[i].ks0; } while (0)
#define A128_SWAIT() asm volatile("s_waitcnt vmcnt(3)" ::: "memory")
#define A128_RESC(a) do { if (__any((a) < 1.f)) { if (hi == 0) al_l[r32] = (a); asm volatile("s_waitcnt lgkmcnt(0)" ::: "memory"); \
    _Pragma("unroll") for (int d = 0; d < 4; ++d) _Pragma("unroll") for (int r = 0; r < 16; ++r) o[d][r] *= al_l[crow(r, hi)]; } } while (0)
  f32x16 pA0, pA1, pB0, pB1; float mnA, mnB, alA, alB; bf16x8 pa0, pa1, pa2, pa3; const int NT = seq / KVBLK;
  A128_SLOAD(0, 0); asm volatile("s_waitcnt vmcnt(0)" ::: "memory"); A128_SWRITE(0, 0); __syncthreads();
  qkt(pA0, pA1, K_lds, qr, r32, hi); partialSM(pA0, pA1, m_reg, mnA, alA);
  A128_SLOAD(1, KVBLK); if (2 < NT) A128_SLOAD(0, 2 * KVBLK);
  A128_SWAIT(); A128_SWRITE(1, 1); __syncthreads();
  for (int j = 1; j + 1 < NT; j += 2) {
    A128_SBAR(); qkt(pB0, pB1, K_lds + SHM_K, qr, r32, hi);
    finishSM(pA0, pA1, alA, l_reg, pa0, pa1, pa2, pa3); A128_SBAR();
    A128_SLOAD(1, (j + 2) * KVBLK); A128_SBAR();
    pv_d0(o, vb0, pa0, pa1, pa2, pa3); partialSM(pB0, pB1, m_reg, mnB, alB);
    __syncthreads(); A128_SWAIT(); A128_SWRITE(0, 0);
    A128_RESC(alB); __syncthreads();
    A128_SBAR(); qkt(pA0, pA1, K_lds, qr, r32, hi);
    finishSM(pB0, pB1, alB, l_reg, pa0, pa1, pa2, pa3); A128_SBAR();
    if (j + 3 < NT) A128_SLOAD(0, (j + 3) * KVBLK); A128_SBAR();
    pv_d0(o, vb0 + (int)SHM_V, pa0, pa1, pa2, pa3); partialSM(pA0, pA1, m_reg, mnA, alA);
    __syncthreads(); A128_SWAIT(); A128_SWRITE(1, 1);
    A128_RESC(alA); __syncthreads();
  }
  A128_SBAR(); qkt(pB0, pB1, K_lds + SHM_K, qr, r32, hi);
  finishSM(pA0, pA1, alA, l_reg, pa0, pa1, pa2, pa3); A128_SBAR();
  pv_d0(o, vb0, pa0, pa1, pa2, pa3); partialSM(pB0, pB1, m_reg, mnB, alB);
  __syncthreads(); A128_RESC(alB);
  finishSM(pB0, pB1, alB, l_reg, pa0, pa1, pa2, pa3); A128_SBAR();
  pv_d0(o, vb0 + (int)SHM_V, pa0, pa1, pa2, pa3);
  if (hi == 0) li_l[r32] = l_reg; asm volatile("s_waitcnt lgkmcnt(0)" ::: "memory");
  float rli[16];
#pragma unroll
  for (int r = 0; r < 16; ++r) rli[r] = __builtin_amdgcn_rcpf(li_l[crow(r, hi)]);
  if (mp == 0) {
#pragma unroll
    for (int r = 0; r < 16; ++r)
#pragma unroll
      for (int d0 = 0; d0 < 4; ++d0) stage[(r * 4 + d0) * 64 + lane] = (bf16_t)(cvt_pk_bf16(o[d0][r] * rli[r], 0.f) & 0xffffu);
  } else {
    float ss[16];
#pragma unroll
    for (int r = 0; r < 16; ++r) { float q = 0.f;
#pragma unroll
      for (int d0 = 0; d0 < 4; ++d0) { const float a = bf1(stage[(r * 4 + d0) * 64 + lane]) - lam * bf1((bf16_t)(cvt_pk_bf16(o[d0][r] * rli[r], 0.f) & 0xffffu)); o[d0][r] = a; q += a * a; }
      ss[r] = q; }
#pragma unroll
    for (int m = 1; m < 32; m <<= 1)
#pragma unroll
      for (int r = 0; r < 16; ++r) ss[r] += __int_as_float(__builtin_amdgcn_ds_bpermute((lane ^ m) << 2, __float_as_int(ss[r])));
    float sw[4];
#pragma unroll
    for (int d0 = 0; d0 < 4; ++d0) sw[d0] = subw[d0 * 32 + r32] * onem;
    bf16_t* Ow = Ob + (long)(wid * QBLK) * LDOB;
#pragma unroll
    for (int r = 0; r < 16; ++r) { const int orow = crow(r, hi); const float rs = 1.0f / sqrtf(ss[r] * (1.f / 128.f) + RMS_EPS);
#pragma unroll
      for (int d0 = 0; d0 < 4; ++d0) Ow[(long)orow * LDOB + d0 * 32 + r32] = (bf16_t)(cvt_pk_bf16(o[d0][r] * rs * sw[d0], 0.f) & 0xffffu); }
  }
  __syncthreads();
 }
#undef A128_SLOAD
#undef A128_SWRITE
#undef A128_SWAIT
#undef A128_RESC
}
#undef A128_KSWZ
#undef A128_SBAR
}

#define XB_TMO      128
#define XB_XCNT(j)  (256  + 64 * (j))
#define XB_XSUB(j)  (1280 + 64 * (j))
#define XB_XGEN(j)  (2304 + 64 * (j))
#define XB_TOP      3328
#define XB_TOPGEN   3392
#define XCD_BAR_WORDS 3456
#define XB_SPIN_CAP (1u << 18)
__device__ __forceinline__ unsigned xb_ld(unsigned* p)              { return __hip_atomic_load(p, __ATOMIC_RELAXED, __HIP_MEMORY_SCOPE_AGENT); }
__device__ __forceinline__ unsigned xb_add(unsigned* p, unsigned v) { return __hip_atomic_fetch_add(p, v, __ATOMIC_RELAXED, __HIP_MEMORY_SCOPE_AGENT); }
__device__ __forceinline__ unsigned xb_xcc_id() { return (unsigned)__builtin_amdgcn_s_getreg((3 << 11) | 20) & 0xFu; }
#define XB_SPIN(cond, bar) do { unsigned _sp = 0; while (cond) { __builtin_amdgcn_s_sleep(1); \
    if ((++_sp & 255u) == 0u) { if (xb_ld(&(bar)[XB_TMO])) break; if (_sp > XB_SPIN_CAP) { atomicAdd(&(bar)[XB_TMO], 1u); break; } } } } while (0)
struct XcdBarrier { unsigned* bar; unsigned x; volatile LAS unsigned* st; };
__device__ __forceinline__ XcdBarrier xcd_barrier_post(unsigned* bar, volatile LAS unsigned* st) {
    XcdBarrier b; b.bar = bar; b.x = xb_xcc_id(); b.st = st;
    if (threadIdx.x == 0) (void)xb_add(&bar[XB_XCNT(b.x)], 1u);
    return b;
}
__device__ __forceinline__ void xcd_barrier_complete(unsigned* bar, unsigned x, unsigned& nloc, unsigned& nx) {
    const unsigned G = gridDim.x * gridDim.y * gridDim.z;
    unsigned sum, cnt, mine, sp = 0u;
    for (;;) {
        sum = 0u; cnt = 0u; mine = 0u;
#pragma unroll
        for (unsigned j = 0; j < 16; ++j) { const unsigned c = xb_ld(&bar[XB_XCNT(j)]); sum += c; cnt += (c > 0u) ? 1u : 0u; mine = (j == x) ? c : mine; }
        if (sum == G) break;
        __builtin_amdgcn_s_sleep(1);
        if ((++sp & 255u) == 0u) { if (xb_ld(&bar[XB_TMO])) break; if (sp > XB_SPIN_CAP) { atomicAdd(&bar[XB_TMO], 1u); break; } }
    }
    nloc = mine > 0u ? mine : 1u; nx = cnt > 0u ? cnt : 1u;
}
__device__ __forceinline__ void xcd_barrier(const XcdBarrier& b, const int tid) {
    asm volatile("s_waitcnt vmcnt(0)" ::: "memory");
    __syncthreads();
    if (tid == 0) {
        unsigned* bar = b.bar;
        __builtin_amdgcn_s_waitcnt(0);
        unsigned nloc = b.st[0], nx = b.st[1];
        if (nloc == 0u) { xcd_barrier_complete(bar, b.x, nloc, nx); b.st[0] = nloc; b.st[1] = nx; }
        const unsigned old = xb_add(&bar[XB_XSUB(b.x)], 1u);
        const unsigned gen = old / nloc;
        if (old + 1u == (gen + 1u) * nloc) {
            __builtin_amdgcn_fence(__ATOMIC_RELEASE, "agent");
            asm volatile("s_waitcnt vmcnt(0)" ::: "memory");
            const unsigned og = xb_add(&bar[XB_TOP], 1u);
            const unsigned tg = og / nx;
            if (og + 1u == (tg + 1u) * nx) xb_add(&bar[XB_TOPGEN], 1u);
            else XB_SPIN(xb_ld(&bar[XB_TOPGEN]) == tg, bar);
            __builtin_amdgcn_fence(__ATOMIC_ACQUIRE, "agent");
            xb_add(&bar[XB_XGEN(b.x)], 1u);
            asm volatile("s_waitcnt vmcnt(0)" ::: "memory");
        } else {
            XB_SPIN(xb_ld(&bar[XB_XGEN(b.x)]) == gen, bar);
            __builtin_amdgcn_fence(__ATOMIC_ACQUIRE, "agent");
            asm volatile("s_waitcnt vmcnt(0)" ::: "memory");
        }
    }
    __syncthreads();
}

constexpr int NWAVES = 8;
constexpr int RING_OFF = 0, RING_BYTES = 131072;
constexpr int LDSCTL_OFF = RING_BYTES, MISC_OFF = LDSCTL_OFF + 320;
constexpr int LDS_BYTES = 147456;
static_assert(attn128::SHM_TOTAL <= (size_t)RING_BYTES, "attention scratch fits the ring");

struct Args { const float* in[32]; float* out; unsigned char* ws; int ph_lo, ph_hi; };
constexpr int INTAB_OFF = LDSCTL_OFF + 1024;
__device__ __forceinline__ const float* inptr(LAS unsigned char* lds, int i) {
    const unsigned long long v = ((const LAS unsigned long long*)(lds + INTAB_OFF))[i];
    const unsigned lo = __builtin_amdgcn_readfirstlane((unsigned)v), hi = __builtin_amdgcn_readfirstlane((unsigned)(v >> 32));
    return (const float*)(GAS const float*)(((unsigned long long)hi << 32) | lo);
}
#define INP(i) inptr(F.lds, (i))
struct Frame {
    LAS unsigned char* lds; int tid, lane, wave, vcu, G, gw, NGW;
    unsigned char* ws;
};
enum { I_X = 0, I_C, I_CTX, I_CCTX, I_WMOD, I_BMOD, I_LNG, I_LNB, I_W1, I_W3, I_W2, I_WIN, I_ALAM, I_ASUB, I_CONVW, I_CONVB, I_ALOG, I_DTB, I_SSDD, I_SSDN,
       I_LRE, I_LIM, I_LSTEP, I_BRE, I_BIM, I_CRE, I_CIM, I_S5D, I_GLUW, I_GLUB, I_WBR, I_WOUT };

__device__ __forceinline__ void transpose_item64(const float* srcA, const float* srcB, int ldn, bool p32, bf16_t* dst, int ldk, LAS bf16_t* scr  , int lane) {
    const int q = lane & 15, kr = lane >> 4; const bool isB = q >= 8; const int c = (q & 7) * 4; const float* src = isB ? srcB : srcA;
    f32x4 v[16];
#pragma unroll
    for (int i = 0; i < 16; ++i) v[i] = src ? *(const f32x4*)(src + (size_t)(4 * i + kr) * ldn + c) : (f32x4){0.f, 0.f, 0.f, 0.f};
    const int drow = (p32 ? pg8::perm32(c) : c) + (isB ? 32 : 0);
#pragma unroll
    for (int i = 0; i < 16; ++i) { const int k = 4 * i + kr; const unsigned p01 = cvt_pk_bf16(v[i][0], v[i][1]), p23 = cvt_pk_bf16(v[i][2], v[i][3]);
        scr[(drow + 0) * 72 + k] = (bf16_t)(p01 & 0xffffu); scr[(drow + 1) * 72 + k] = (bf16_t)(p01 >> 16); scr[(drow + 2) * 72 + k] = (bf16_t)(p23 & 0xffffu); scr[(drow + 3) * 72 + k] = (bf16_t)(p23 >> 16); }
    LDS_WAIT(); asm volatile("" ::: "memory");
    const int c8 = lane & 7;
#pragma unroll
    for (int jj = 0; jj < 8; ++jj) { const int n = (lane >> 3) + 8 * jj; *(u32x4*)(dst + (size_t)n * ldk + 8 * c8) = *(const LAS u32x4*)(scr + n * 72 + 8 * c8); }
    LDS_WAIT(); asm volatile("" ::: "memory");
}
__device__ __forceinline__ void convert_layer_weights(const Args& A_, Frame& F, int l) {
    LAS bf16_t* scr = (LAS bf16_t*)(F.lds + RING_OFF + F.wave * 16384);
    unsigned char* W = F.ws + WS_W;
    constexpr int I13 = 32 * 176, I2 = 88 * 32, IIN = 32 * 212, IB = 16 * 32, IO = 32 * 32, IG = 16 * 16;
    constexpr int NIT = 2 * I13 + 2 * I2 + IIN + 3 * IB + IO + IG;
    for (int it = F.gw; it < NIT; it += F.NGW) {
        int r = it;
        if (r < 2 * I13) { const int f = r / I13; r -= f * I13; const int kb = r / 176, nb = r % 176;
            const float* wsrc = (((nb & 3) < 2) ? INP(I_W1) : INP(I_W3)) + ((size_t)(l * 2 + f) * D + 64 * kb) * DFF + 128 * (nb >> 2) + 64 * (nb & 1);
            transpose_item64(wsrc, wsrc + 32, DFF, false, (bf16_t*)(W + W_13) + ((size_t)f * N13 + 64 * nb) * D + 64 * kb, D, scr, F.lane); continue; }
        r -= 2 * I13;
        if (r < 2 * I2) { const int f = r / I2; r -= f * I2; const int kb = r / 32, nb = r % 32;
            const float* w2 = INP(I_W2) + ((size_t)(l * 2 + f) * DFF + 64 * kb) * D + 64 * nb;
            transpose_item64(w2, w2 + 32, D, false, (bf16_t*)(W + W_2) + ((size_t)f * D + 64 * nb) * DFF + 64 * kb, DFF, scr, F.lane); continue; }
        r -= 2 * I2;
        if (r < IIN) { const int kb = r / 212, nb = r % 212; const int n0 = 64 * nb; const float* wb = INP(I_WIN) + ((size_t)l * D + 64 * kb) * 13344;
            const float* sa = nullptr; const float* sb = nullptr;
            if (n0 < 6144) { sa = wb + n0; sb = sa + 32; } else if (n0 < 13312) { sa = wb + n0 + 32; sb = sa + 32; } else if (n0 == 13312) { sa = wb + 6144; }
            transpose_item64(sa, sb, 13344, n0 < 2048, (bf16_t*)(W + W_IN) + (size_t)n0 * D + 64 * kb, D, scr, F.lane); continue; }
        r -= IIN;
        if (r < 3 * IB) { const int jb = r / IB; r -= jb * IB; const int kb = r / 32, nb = r % 32;
            const float* w = INP(I_WBR) + ((size_t)(l * 3 + jb) * 1024 + 64 * kb) * D + 64 * nb;
            const int sp = (jb == 0) ? 0 : (jb == 1 ? 2 : 1); transpose_item64(w, w + 32, D, false, (bf16_t*)(W + W_B) + (size_t)(64 * nb) * 3072 + sp * 1024 + 64 * kb, 3072, scr, F.lane); continue; }
        r -= 3 * IB;
        if (r < IO) { const int kb = r / 32, nb = r % 32; const float* w = INP(I_WOUT) + ((size_t)l * D + 64 * kb) * D + 64 * nb;
            transpose_item64(w, w + 32, D, false, (bf16_t*)(W + W_O) + (size_t)(64 * nb) * D + 64 * kb, D, scr, F.lane); continue; }
        r -= IO;
        { const int kb = r / 16, nb = r % 16; const float* w = INP(I_GLUW) + ((size_t)l * 1024 + 64 * kb) * 1024 + 64 * nb;
            transpose_item64(w, w + 32, 1024, false, (bf16_t*)(W + W_GLU) + (size_t)(64 * nb) * 1024 + 64 * kb, 1024, scr, F.lane); }
    }
}
__device__ __forceinline__ void mod_partials(const Args& A_, Frame& F) {
    float* MODw = (float*)(F.ws + WS_MOD);
    LAS float* sl = (LAS float*)(F.lds + RING_OFF + 98304 + F.wave * 4096);
    const int nskip = (F.G > 64) ? 64 : 0; if ((int)blockIdx.x < nskip) return;
    for (int it = ((int)blockIdx.x - nskip) * NWAVES + F.wave; it < 2 * 72 * 16; it += (F.G - nskip) * NWAVES) {
        const int l = it / (72 * 16), r = it % (72 * 16), ks = r / 72, cg = r % 72;
        const int col = cg * 256 + F.lane * 4; const float* w = INP(I_WMOD) + ((size_t)l * D + ks * 128) * NMOD + col;
        const float* c = INP(I_C) + ks * 128; const float* cc = INP(I_CCTX) + ks * 128;
#pragma unroll
        for (int h = 0; h < 2; ++h) { const int k = F.lane + 64 * h;
            sl[0 * 128 + k] = siluf_(c[k]); sl[1 * 128 + k] = siluf_(c[D + k]); sl[2 * 128 + k] = siluf_(c[2 * D + k]); sl[3 * 128 + k] = siluf_(c[3 * D + k]); sl[4 * 128 + k] = siluf_(cc[k]); }
        LDS_WAIT(); asm volatile("" ::: "memory");
        f32x4 a0 = {0.f, 0.f, 0.f, 0.f}, a1 = a0, a2 = a0, a3 = a0, a4 = a0;
        for (int k0 = 0; k0 < 128; k0 += 16) {
            f32x4 wv[16];
#pragma unroll
            for (int e = 0; e < 16; ++e) wv[e] = *(const f32x4*)(w + (size_t)(k0 + e) * NMOD);
            asm volatile("s_waitcnt vmcnt(0)" ::: "memory");
#pragma unroll
            for (int e = 0; e < 16; ++e) { a0 += wv[e] * sl[0 * 128 + k0 + e]; a1 += wv[e] * sl[1 * 128 + k0 + e]; a2 += wv[e] * sl[2 * 128 + k0 + e]; a3 += wv[e] * sl[3 * 128 + k0 + e]; a4 += wv[e] * sl[4 * 128 + k0 + e]; }
        }
        const int r9 = col / D; const float sc = (r9 == 2 || r9 == 8) ? 0.5f : 1.0f;
        if (ks == 0) { const f32x4 bv = *(const f32x4*)(INP(I_BMOD) + (size_t)l * NMOD + col); a0 += bv; a1 += bv; a2 += bv; a3 += bv; a4 += bv; }
        float* o = MODw + (size_t)l * 5 * NMOD + col;
#pragma unroll
        for (int e = 0; e < 4; ++e) { unsafeAtomicAdd(o + e, a0[e] * sc); unsafeAtomicAdd(o + NMOD + e, a1[e] * sc); unsafeAtomicAdd(o + 2 * NMOD + e, a2[e] * sc); unsafeAtomicAdd(o + 3 * NMOD + e, a3[e] * sc); unsafeAtomicAdd(o + 4 * NMOD + e, a4[e] * sc); }
        LDS_WAIT(); asm volatile("" ::: "memory");
    }
}
__device__ __forceinline__ void ln_pass(Frame& F, bool do_ln, const float* lng, const float* lnb, const float* modnext  , float* out, const float* xin = nullptr, const float* cin = nullptr, int nslab = 0) {
#define LNCO(i) (512 * ((i) >> 1) + 8 * F.lane + 4 * ((i) & 1))
    _Float16* H = (_Float16*)(F.ws + WS_H); const float* SL = (const float*)(F.ws + WS_YD); float* HC = (float*)(F.ws + WS_HC); bf16_t* HM = (bf16_t*)(F.ws + WS_HM); float* ST = (float*)(F.ws + WS_STATS);
    f32x4 G[8], Bv[8];
    if (do_ln) {
#pragma unroll
        for (int i = 0; i < 8; ++i) { G[i] = *(const f32x4*)(lng + LNCO(i)); Bv[i] = *(const f32x4*)(lnb + LNCO(i)); }
    }
    const int nper = F.NGW / NB; f32x4 sh4[8], sc4[8];
    for (int it = 0; it < SEQ / nper + 1; ++it) {
        int b = F.gw / nper, rr = CTX + (F.gw % nper) + nper * it;
        if (it == SEQ / nper) { if (F.gw >= NB * CTX) break; b = F.gw / CTX; rr = F.gw % CTX; }
        const int row = b * RB + rr; const bool isctx = rr < CTX; const int mi = isctx ? 4 : b;
        float* hc = HC + ((size_t)b * CTX + rr) * D; _Float16* hr = H + (size_t)row * D;
        f32x4 v[8]; float s = 0.f;
        if (xin) { const float* src = isctx ? cin + ((size_t)b * CTX + rr) * D : xin + ((size_t)b * SEQ + (rr - CTX)) * D;
#pragma unroll
            for (int i = 0; i < 8; ++i) v[i] = *(const f32x4*)(src + LNCO(i));
        } else if (isctx) {
#pragma unroll
            for (int i = 0; i < 8; ++i) v[i] = *(const f32x4*)(hc + LNCO(i));
            if (nslab) {
#pragma unroll 1
                for (int q = 0; q < 4; ++q) { f32x4 sv[8];
#pragma unroll
                    for (int i = 0; i < 8; ++i) sv[i] = *(const f32x4*)(SL + ((size_t)q * (NB * CTX) + (size_t)b * CTX + rr) * D + LNCO(i));
#pragma unroll
                    for (int i = 0; i < 8; ++i) v[i] = v[i] + sv[i]; } }
        } else {
#pragma unroll
            for (int k = 0; k < 4; ++k) { const h16x8 h = *(const h16x8*)(hr + LNCO(2 * k)); v[2 * k] = (f32x4){(float)h[0], (float)h[1], (float)h[2], (float)h[3]}; v[2 * k + 1] = (f32x4){(float)h[4], (float)h[5], (float)h[6], (float)h[7]}; }
        }
        if (modnext && (it == 0 || it == SEQ / nper)) { const float* sh = modnext + (size_t)mi * NMOD; const float* sc = sh + D;
#pragma unroll
            for (int i = 0; i < 8; ++i) { sh4[i] = *(const f32x4*)(sh + LNCO(i)); sc4[i] = *(const f32x4*)(sc + LNCO(i)); } }
        asm volatile("s_waitcnt vmcnt(0)" ::: "memory");
#pragma unroll
        for (int i = 0; i < 8; ++i) s += (v[i][0] + v[i][1]) + (v[i][2] + v[i][3]);
        if (do_ln) {
            const float mean = wave_sum(s, F.lane) * (1.f / D); float s2 = 0.f;
#pragma unroll
            for (int i = 0; i < 8; ++i) { v[i] = v[i] - mean; s2 += (v[i][0] * v[i][0] + v[i][1] * v[i][1]) + (v[i][2] * v[i][2] + v[i][3] * v[i][3]); }
            const float rstd = 1.0f / sqrtf(wave_sum(s2, F.lane) * (1.f / D) + LN_EPS);
            if (!isctx && F.lane == 0) *(f32x2*)(ST + (size_t)row * 2) = (f32x2){mean, rstd};
#pragma unroll
            for (int i = 0; i < 8; ++i) { v[i] = v[i] * rstd * G[i] + Bv[i]; if (isctx) *(f32x4*)(hc + LNCO(i)) = v[i] * DN_ALPHA; }
        } else if (isctx) {
#pragma unroll
            for (int i = 0; i < 8; ++i) *(f32x4*)(hc + LNCO(i)) = v[i] * DN_ALPHA;
        } else {
#pragma unroll
            for (int k = 0; k < 4; ++k) { h16x8 h;
#pragma unroll
                for (int e = 0; e < 4; ++e) { h[e] = (_Float16)v[2 * k][e]; h[4 + e] = (_Float16)v[2 * k + 1][e]; }
                *(h16x8*)(hr + LNCO(2 * k)) = h; }
            if (F.lane == 0) *(f32x2*)(ST + (size_t)row * 2) = (f32x2){0.f, 1.f};
        }
        if (modnext) {
#pragma unroll
            for (int k = 0; k < 4; ++k) { const f32x4 m0 = v[2 * k] * (sc4[2 * k] + 1.0f) + sh4[2 * k], m1 = v[2 * k + 1] * (sc4[2 * k + 1] + 1.0f) + sh4[2 * k + 1];
                u32x4 w; w.x = cvt_pk_bf16(m0[0], m0[1]); w.y = cvt_pk_bf16(m0[2], m0[3]); w.z = cvt_pk_bf16(m1[0], m1[1]); w.w = cvt_pk_bf16(m1[2], m1[3]); *(u32x4*)(HM + (size_t)row * D + LNCO(2 * k)) = w; }
        }
        if (out && !isctx) { float* orow = out + ((size_t)b * SEQ + (rr - CTX)) * D;
#pragma unroll
            for (int i = 0; i < 8; ++i) *(f32x4*)(orow + LNCO(i)) = v[i]; }
    }
}
#undef LNCO

__device__ __forceinline__ void dt_tile(Frame& F, int l, int tile) {
    const bf16_t* A = (const bf16_t*)(F.ws + WS_HM) + (size_t)tile * 32 * D; const bf16_t* Bt = (const bf16_t*)(F.ws + WS_W + W_IN) + (size_t)13312 * D; float* DT = (float*)(F.ws + WS_DT);
    const int r = F.lane & 31, h = F.lane >> 5;
    f32x16 acc;
#pragma unroll
    for (int i = 0; i < 16; ++i) acc[i] = 0.f;
    const bf16_t* ap = A + (size_t)r * D + 8 * h; const bf16_t* bp = Bt + (size_t)r * D + 8 * h;
    for (int k0 = 0; k0 < 128; k0 += 16) {
        bf16x8 af[16], bfv[16];
#pragma unroll
        for (int e = 0; e < 16; ++e) { af[e] = *(const bf16x8*)(ap + 16 * (k0 + e)); bfv[e] = *(const bf16x8*)(bp + 16 * (k0 + e)); }
#pragma unroll
        for (int e = 0; e < 16; ++e) acc = __builtin_amdgcn_mfma_f32_32x32x16_bf16(af[e], bfv[e], acc, 0, 0, 0);
    }
    const float bias = INP(I_DTB)[l * 32 + r];
#pragma unroll
    for (int rg = 0; rg < 16; ++rg) { const int row = tile * 32 + (rg & 3) + 8 * (rg >> 2) + 4 * h; const float x = acc[rg] + bias; DT[(size_t)row * 32 + r] = fmaxf(x, 0.f) + log1pf(expf(-fabsf(x))); }
}
__device__ __forceinline__ void ssd_conv_pass(const Args& A_, Frame& F, int l) {
    const bf16_t* P = (const bf16_t*)(F.ws + WS_PROJ); bf16_t* XC = (bf16_t*)(F.ws + WS_HM);
    const float* cw = INP(I_CONVW) + (size_t)l * 5 * 2048; const float* cb = INP(I_CONVB) + (size_t)l * 2048;
    for (int it = F.gw; it < (R / 8) * 4; it += F.NGW) {
        const int r0 = (it >> 2) * 8, c0 = (it & 3) * 512 + F.lane * 8; const int rr0 = r0 % RB; const int lo = (rr0 < CTX) ? 0 : CTX, hi = (rr0 < CTX) ? CTX : RB;
        u32x4 x[12];
#pragma unroll
        for (int h = 0; h < 12; ++h) { const int r2 = rr0 + h - 2; x[h] = (r2 >= lo && r2 < hi) ? *(const u32x4*)(P + (size_t)(r0 + h - 2) * LDP + PX + c0) : (u32x4){0u, 0u, 0u, 0u}; }
        f32x4 w0[5], w1[5];
#pragma unroll
        for (int k = 0; k < 5; ++k) { w0[k] = *(const f32x4*)(cw + k * 2048 + c0); w1[k] = *(const f32x4*)(cw + k * 2048 + c0 + 4); }
        const f32x4 b0 = *(const f32x4*)(cb + c0), b1 = *(const f32x4*)(cb + c0 + 4);
#pragma unroll
        for (int jr = 0; jr < 8; ++jr) { f32x4 a0 = b0, a1 = b1;
#pragma unroll
            for (int k = 0; k < 5; ++k) { const u32x4 xv = x[jr + k];
                a0[0] += w0[k][0] * bflo(xv.x); a0[1] += w0[k][1] * bfhi(xv.x); a0[2] += w0[k][2] * bflo(xv.y); a0[3] += w0[k][3] * bfhi(xv.y);
                a1[0] += w1[k][0] * bflo(xv.z); a1[1] += w1[k][1] * bfhi(xv.z); a1[2] += w1[k][2] * bflo(xv.w); a1[3] += w1[k][3] * bfhi(xv.w); }
            u32x4 o; o.x = cvt_pk_bf16(siluf_(a0[0]), siluf_(a0[1])); o.y = cvt_pk_bf16(siluf_(a0[2]), siluf_(a0[3])); o.z = cvt_pk_bf16(siluf_(a1[0]), siluf_(a1[1])); o.w = cvt_pk_bf16(siluf_(a1[2]), siluf_(a1[3]));
            *(u32x4*)(XC + (size_t)(r0 + jr) * 2048 + c0) = o; }
    }
}
__device__ __forceinline__ int scan_row(int rb, int d, int step) { return d == 0 ? rb + step : (step < CTX ? rb + CTX - 1 - step : rb + (RB + CTX - 1) - step); }

__device__ __forceinline__ unsigned short bf16_1(float v) { return (unsigned short)(cvt_pk_bf16(v, 0.f) & 0xffffu); }
__device__ __forceinline__ void ssd_chain_fast(const Args& A_, Frame& F, int l, int cid) {
    constexpr int LS = 136;
    const int b = cid >> 6, d = (cid >> 5) & 1, hd = (cid >> 1) & 15, ph = cid & 1, g = hd >> 2; const int rb = b * RB;
    const bf16_t* XC = (const bf16_t*)(F.ws + WS_HM); const float* DT = (const float*)(F.ws + WS_DT); bf16_t* YD = (bf16_t*)(F.ws + WS_YD) + (size_t)d * R * 1024;
    const float a = -expf(INP(I_ALOG)[l * 32 + d * 16 + hd]);
    LAS bf16_t* Cs = (LAS bf16_t*)(F.lds); LAS bf16_t* Bs = Cs + 128 * LS; LAS bf16_t* Ms = Bs + 128 * LS; LAS bf16_t* XdT = Ms + 128 * LS; LAS bf16_t* Hb = XdT + 32 * LS;
    LAS float* csL = (LAS float*)(Hb + 32 * LS); LAS float* ecsL = csL + 128; LAS float* ewL = ecsL + 128; LAS float* misc = ewL + 128;
    const int tid = F.tid, lane = F.lane, w = F.wave, r = lane & 31, h = lane >> 5;
    f32x16 hacc;
#pragma unroll
    for (int i = 0; i < 16; ++i) hacc[i] = 0.f;
    for (int i = tid; i < 32 * LS / 2; i += 512) ((LAS unsigned*)Hb)[i] = 0u;
    u32x4 pc[4], pb[4], px; float pdt, pv0 = 0.f, pv1 = 0.f;
    const int rho0 = d ? 127 - lane : lane, rho1 = d ? 63 - lane : 64 + lane;
#define SSD_R0(k_) ((d == 0) ? rb + 128 * (k_) : ((k_) < 2 ? rb + 128 * (1 - (k_)) : rb + 256 + 128 * (33 - (k_))))
#define SSD_ISSUE(k_) do { const int r0n = SSD_R0(k_); \
        _Pragma("unroll") for (int i = 0; i < 4; ++i) { const int item = tid + 512 * i, row = item >> 4, seg = item & 15; const bf16_t* src = XC + (size_t)(r0n + row) * 2048 + g * 128 + seg * 8; pc[i] = *(const u32x4*)(src + 1536); pb[i] = *(const u32x4*)(src + 1024); } \
        { const int row = tid >> 2, seg = tid & 3; pdt = DT[(size_t)(r0n + row) * 32 + d * 16 + hd]; px = *(const u32x4*)(XC + (size_t)(r0n + row) * 2048 + hd * 64 + ph * 32 + seg * 8); } \
        if (w == 0) { pv0 = DT[(size_t)(r0n + rho0) * 32 + d * 16 + hd]; pv1 = DT[(size_t)(r0n + rho1) * 32 + d * 16 + hd]; } } while (0)
    SSD_ISSUE(0);
    unsigned ypk[8]; int yrow = -1;
#pragma unroll
    for (int i = 0; i < 8; ++i) ypk[i] = 0u;
#define SSD_YFLUSH() do { if (w < 4 && yrow >= 0) { bf16_t* yo = YD + (size_t)yrow * 1024 + hd * 64 + ph * 32 + r; \
        _Pragma("unroll") for (int rg = 0; rg < 16; ++rg) yo[(size_t)((rg & 3) + 8 * (rg >> 2)) * 1024] = (bf16_t)((rg & 1) ? (ypk[rg >> 1] >> 16) : (ypk[rg >> 1] & 0xffffu)); } } while (0)
    for (int k = 0; k < 34; ++k) {
        const int r0 = SSD_R0(k);
        __syncthreads();
#pragma unroll
        for (int i = 0; i < 4; ++i) { const int item = tid + 512 * i, row = item >> 4, seg = item & 15; *(LAS u32x4*)(Cs + row * LS + seg * 8) = pc[i]; *(LAS u32x4*)(Bs + row * LS + seg * 8) = pb[i]; }
        { const int row = tid >> 2, seg = tid & 3; const float dtv = pdt; const u32x4 xv = px;
            LAS bf16_t* xo = XdT + (seg * 8) * LS + row;
            xo[0 * LS] = bf16_1(bflo(xv.x) * dtv); xo[1 * LS] = bf16_1(bfhi(xv.x) * dtv); xo[2 * LS] = bf16_1(bflo(xv.y) * dtv); xo[3 * LS] = bf16_1(bfhi(xv.y) * dtv);
            xo[4 * LS] = bf16_1(bflo(xv.z) * dtv); xo[5 * LS] = bf16_1(bfhi(xv.z) * dtv); xo[6 * LS] = bf16_1(bflo(xv.w) * dtv); xo[7 * LS] = bf16_1(bfhi(xv.w) * dtv); }
        if (w == 0) {
            float v0 = pv0 * a, v1 = pv1 * a;
#pragma unroll
            for (int o = 1; o < 64; o <<= 1) { const float t0 = __int_as_float(__builtin_amdgcn_ds_bpermute((lane - o) << 2, __float_as_int(v0))), t1 = __int_as_float(__builtin_amdgcn_ds_bpermute((lane - o) << 2, __float_as_int(v1))); if (lane >= o) { v0 += t0; v1 += t1; } }
            const float tot0 = __int_as_float(__builtin_amdgcn_ds_bpermute(63 << 2, __float_as_int(v0))); v1 += tot0;
            const float cend = __int_as_float(__builtin_amdgcn_ds_bpermute(63 << 2, __float_as_int(v1)));
            csL[rho0] = v0; csL[rho1] = v1; ecsL[rho0] = __builtin_amdgcn_exp2f(v0 * 1.4426950408889634f); ecsL[rho1] = __builtin_amdgcn_exp2f(v1 * 1.4426950408889634f);
            ewL[rho0] = __builtin_amdgcn_exp2f((cend - v0) * 1.4426950408889634f); ewL[rho1] = __builtin_amdgcn_exp2f((cend - v1) * 1.4426950408889634f);
            if (lane == 0) misc[0] = __builtin_amdgcn_exp2f(cend * 1.4426950408889634f);
        }
        if (k + 1 < 34) SSD_ISSUE(k + 1);
        __syncthreads();
        { const int lt = w >> 1;
#pragma unroll
          for (int q = 0; q < 2; ++q) { const int st = (w & 1) * 2 + q; const bool zero = (d == 0) ? (st > lt) : (st < lt);
            f32x16 acc;
#pragma unroll
            for (int i = 0; i < 16; ++i) acc[i] = 0.f;
            if (!zero) { bf16x8 af[8], bfv[8];
#pragma unroll
                for (int ks = 0; ks < 8; ++ks) { af[ks] = *(const LAS bf16x8*)(Cs + (32 * lt + r) * LS + 16 * ks + 8 * h); bfv[ks] = *(const LAS bf16x8*)(Bs + (32 * st + r) * LS + 16 * ks + 8 * h); }
#pragma unroll
                for (int ks = 0; ks < 8; ++ks) acc = __builtin_amdgcn_mfma_f32_32x32x16_bf16(af[ks], bfv[ks], acc, 0, 0, 0); }
            const int scol = 32 * st + r; const float css = csL[scol];
            f32x4 cr4[4];
#pragma unroll
            for (int q4 = 0; q4 < 4; ++q4) cr4[q4] = *(const LAS f32x4*)(csL + 32 * lt + 8 * q4 + 4 * h);
#pragma unroll
            for (int rg = 0; rg < 16; ++rg) { const int lrow = 32 * lt + (rg & 3) + 8 * (rg >> 2) + 4 * h; const bool valid = (d == 0) ? (scol <= lrow) : (scol >= lrow);
                const float ex = __builtin_amdgcn_exp2f(fminf(cr4[rg >> 2][rg & 3] - css, 0.f) * 1.4426950408889634f);
                const float v = valid ? acc[rg] * ex : 0.f; Ms[lrow * LS + scol] = bf16_1(v); } } }
        __syncthreads();
        if (w < 4) { const int lt = w;
            f32x16 acc;
#pragma unroll
            for (int i = 0; i < 16; ++i) acc[i] = 0.f;
            { bf16x8 af[8], bfv[8];
#pragma unroll
              for (int ks = 0; ks < 8; ++ks) { af[ks] = *(const LAS bf16x8*)(Cs + (32 * lt + r) * LS + 16 * ks + 8 * h); bfv[ks] = *(const LAS bf16x8*)(Hb + r * LS + 16 * ks + 8 * h); }
#pragma unroll
              for (int ks = 0; ks < 8; ++ks) acc = __builtin_amdgcn_mfma_f32_32x32x16_bf16(af[ks], bfv[ks], acc, 0, 0, 0); }
            { f32x4 e4[4];
#pragma unroll
              for (int q4 = 0; q4 < 4; ++q4) e4[q4] = *(const LAS f32x4*)(ecsL + 32 * lt + 8 * q4 + 4 * h);
#pragma unroll
              for (int rg = 0; rg < 16; ++rg) acc[rg] *= e4[rg >> 2][rg & 3]; }
            { bf16x8 af[8], bfv[8];
#pragma unroll
              for (int ks = 0; ks < 8; ++ks) { af[ks] = *(const LAS bf16x8*)(Ms + (32 * lt + r) * LS + 16 * ks + 8 * h); bfv[ks] = *(const LAS bf16x8*)(XdT + r * LS + 16 * ks + 8 * h); }
#pragma unroll
              for (int ks = 0; ks < 8; ++ks) { const bool skip = (d == 0) ? (16 * ks >= 32 * (lt + 1)) : (16 * ks + 15 < 32 * lt);
                  if (!skip) acc = __builtin_amdgcn_mfma_f32_32x32x16_bf16(af[ks], bfv[ks], acc, 0, 0, 0); } }
            bf16_t* yo = YD + (size_t)(r0 + 32 * lt + 4 * h) * 1024 + hd * 64 + ph * 32 + r;
#pragma unroll
            for (int rg = 0; rg < 16; ++rg) yo[(size_t)((rg & 3) + 8 * (rg >> 2)) * 1024] = bf16_1(acc[rg]);
        } else { const int nt = w - 4; const float eend = misc[0];
#pragma unroll
            for (int i = 0; i < 16; ++i) hacc[i] *= eend;
            { typedef short v4i16_t_ __attribute__((ext_vector_type(4)));
#pragma unroll
              for (int kh = 0; kh < 2; ++kh) {
              u32x4 xa[8]; f32x4 e0[8], e1[8]; s16x4 t0[8], t1[8];
#pragma unroll
              for (int ks = 4 * kh; ks < 4 * kh + 4; ++ks) { const int k0 = 16 * ks + 8 * h; xa[ks] = *(const LAS u32x4*)(XdT + r * LS + k0); e0[ks] = *(const LAS f32x4*)(ewL + k0); e1[ks] = *(const LAS f32x4*)(ewL + k0 + 4);
                  const LAS bf16_t* tb = Bs + (k0 + ((lane & 15) >> 2)) * LS + 32 * nt + 16 * ((lane >> 4) & 1) + 4 * (lane & 3);
                  t0[ks] = __builtin_bit_cast(s16x4, __builtin_amdgcn_ds_read_tr16_b64_v4i16((LAS v4i16_t_*)tb)); t1[ks] = __builtin_bit_cast(s16x4, __builtin_amdgcn_ds_read_tr16_b64_v4i16((LAS v4i16_t_*)(tb + 4 * LS))); }
#pragma unroll
              for (int ks = 4 * kh; ks < 4 * kh + 4; ++ks) { u32x4 aw;
                  aw.x = cvt_pk_bf16(bflo(xa[ks].x) * e0[ks][0], bfhi(xa[ks].x) * e0[ks][1]); aw.y = cvt_pk_bf16(bflo(xa[ks].y) * e0[ks][2], bfhi(xa[ks].y) * e0[ks][3]); aw.z = cvt_pk_bf16(bflo(xa[ks].z) * e1[ks][0], bfhi(xa[ks].z) * e1[ks][1]); aw.w = cvt_pk_bf16(bflo(xa[ks].w) * e1[ks][2], bfhi(xa[ks].w) * e1[ks][3]);
                  const bf16x8 bw = (bf16x8){t0[ks][0], t0[ks][1], t0[ks][2], t0[ks][3], t1[ks][0], t1[ks][1], t1[ks][2], t1[ks][3]};
                  hacc = __builtin_amdgcn_mfma_f32_32x32x16_bf16(__builtin_bit_cast(bf16x8, aw), bw, hacc, 0, 0, 0); } } }
        }
        __syncthreads();
        if (w >= 4) { const int nt = w - 4;
#pragma unroll
            for (int rg = 0; rg < 16; ++rg) Hb[((rg & 3) + 8 * (rg >> 2) + 4 * h) * LS + 32 * nt + r] = bf16_1(hacc[rg]); }
    }
    __syncthreads();
#undef SSD_R0
#undef SSD_ISSUE
#undef SSD_YFLUSH
}
__device__ __forceinline__ void s5_setup(const Args& A_, Frame& F, int l, int boff = 0) {
    LAS float* Pre = (LAS float*)(F.lds); LAS float* Pim = Pre + 2 * 17 * 64; LAS float* BBr = Pim + 2 * 17 * 64; LAS float* BBi = BBr + 2 * 64 * 16; LAS float* Kt = BBi + 2 * 64 * 16;
    LAS float* CrL = Kt + 8192; LAS float* CiL = CrL + 2048; LAS float* CrT = CiL + 2048; LAS float* CiT = CrT + 2048;
    bf16_t* Bt1 = (bf16_t*)(F.ws + WS_S5M); bf16_t* Bt2 = Bt1 + (size_t)64 * 512 * 256; float* A16 = (float*)(F.ws + WS_S5A);
    const int tid = F.tid;
    for (int g = (int)blockIdx.x - boff; g >= 0 && g < 64; g += F.G) {
        { f32x4 c4[2];
#pragma unroll
          for (int h = 0; h < 2; ++h) { const int e4 = tid * 4 & 1023, d = (tid >> 8); const int pg_ = (l * 2 + d) * 64 + g; c4[h] = *(const f32x4*)((h ? INP(I_CIM) : INP(I_CRE)) + (size_t)pg_ * 1024 + e4); }
          *(LAS f32x4*)(CrL + tid * 4) = c4[0]; *(LAS f32x4*)(CiL + tid * 4) = c4[1];
          const int d = tid >> 8, o = (tid & 255) >> 4, n4 = (tid & 15) * 4;
#pragma unroll
          for (int e = 0; e < 4; ++e) { CrT[(d * 64 + n4 + e) * 16 + o] = c4[0][e]; CiT[(d * 64 + n4 + e) * 16 + o] = c4[1][e]; } }
        for (int q = tid; q < 2 * 17 * 64; q += 512) { const int d = q / (17 * 64), dl = (q >> 6) % 17, n = q & 63; const int pg_ = (l * 2 + d) * 64 + g;
            const float lre = INP(I_LRE)[pg_ * 64 + n], lim = INP(I_LIM)[pg_ * 64 + n], step = expf(INP(I_LSTEP)[pg_]);
            const float mag = expf(lre * step * (float)dl), ang = lim * step * (float)dl; Pre[q] = mag * cosf(ang); Pim[q] = mag * sinf(ang); }
        __syncthreads();
        if (tid < 128) { const int d = tid >> 6, n = tid & 63; const int pg_ = (l * 2 + d) * 64 + g;
            const float lre = INP(I_LRE)[pg_ * 64 + n], lim = INP(I_LIM)[pg_ * 64 + n];
            const float abr = Pre[(d * 17 + 1) * 64 + n], abi = Pim[(d * 17 + 1) * 64 + n];
            const float den = lre * lre + lim * lim; const float kre = ((abr - 1.f) * lre + abi * lim) / den, kim = (abi * lre - (abr - 1.f) * lim) / den;
            const float* br = INP(I_BRE) + ((size_t)pg_ * 64 + n) * 16; const float* bi = INP(I_BIM) + ((size_t)pg_ * 64 + n) * 16;
            f32x4 bq[4], bz[4];
#pragma unroll
            for (int q = 0; q < 4; ++q) { bq[q] = *(const f32x4*)(br + 4 * q); bz[q] = *(const f32x4*)(bi + 4 * q); }
#pragma unroll
            for (int i = 0; i < 16; ++i) { const float x = bq[i >> 2][i & 3], y = bz[i >> 2][i & 3]; BBr[(d * 64 + n) * 16 + i] = kre * x - kim * y; BBi[(d * 64 + n) * 16 + i] = kre * y + kim * x; }
            A16[((d * 64 + g) * 64 + n) * 2] = Pre[(d * 17 + 16) * 64 + n]; A16[((d * 64 + g) * 64 + n) * 2 + 1] = Pim[(d * 17 + 16) * 64 + n]; }
        __syncthreads();
        { const int d = tid >> 8, dl = (tid >> 4) & 15, i = tid & 15;
            f32x4 acc[4] = {{0.f, 0.f, 0.f, 0.f}, {0.f, 0.f, 0.f, 0.f}, {0.f, 0.f, 0.f, 0.f}, {0.f, 0.f, 0.f, 0.f}};
            for (int n = 0; n < 64; ++n) { const float pr = Pre[(d * 17 + dl) * 64 + n], pi = Pim[(d * 17 + dl) * 64 + n], br = BBr[(d * 64 + n) * 16 + i], bi = BBi[(d * 64 + n) * 16 + i];
                const float tr = pr * br - pi * bi, ti = pr * bi + pi * br;
#pragma unroll
                for (int o4 = 0; o4 < 4; ++o4) { const f32x4 cr = *(const LAS f32x4*)(CrT + (d * 64 + n) * 16 + 4 * o4), ci = *(const LAS f32x4*)(CiT + (d * 64 + n) * 16 + 4 * o4); acc[o4] += cr * tr - ci * ti; } }
#pragma unroll
            for (int o = 0; o < 16; ++o) Kt[((d * 16 + dl) * 16 + o) * 16 + i] = acc[o >> 2][o & 3]; }
        __syncthreads();
        const float dsk = INP(I_S5D)[l * 1024 + 16 * g + (tid & 15)];
        for (int q = 0; q < 16; ++q) { const int item = tid + 512 * q; const int c1 = item >> 5, kb = (item & 31) * 8; const int rin = kb >> 4, i0 = kb & 15, rout = c1 >> 4, o = c1 & 15;
            const float dsko = __int_as_float(__builtin_amdgcn_ds_bpermute((((F.lane & ~15) | o)) << 2, __float_as_int(dsk)));
            float v[8];
#pragma unroll
            for (int e = 0; e < 8; ++e) { const int i = i0 + e; float x = 0.f; if (rout >= rin) x += Kt[((0 * 16 + (rout - rin)) * 16 + o) * 16 + i]; if (rin >= rout) x += Kt[((1 * 16 + (rin - rout)) * 16 + o) * 16 + i];
                if (rin == rout && i == o) x += dsko; v[e] = x; }
            u32x4 w; w.x = cvt_pk_bf16(v[0], v[1]); w.y = cvt_pk_bf16(v[2], v[3]); w.z = cvt_pk_bf16(v[4], v[5]); w.w = cvt_pk_bf16(v[6], v[7]);
            *(u32x4*)(Bt1 + ((size_t)g * 512 + c1) * 256 + kb) = w; }
        for (int q = 0; q < 16; ++q) { const int item = tid + 512 * q; const int c1 = item >> 5, kb = (item & 31) * 8; const int rin = kb >> 4, i0 = kb & 15; const int d = c1 >> 7, part = c1 & 1, n = (c1 >> 1) & 63;
            const int ex = (d == 0) ? 15 - rin : rin; const float pr = Pre[(d * 17 + ex) * 64 + n], pi = Pim[(d * 17 + ex) * 64 + n];
            float v[8];
#pragma unroll
            for (int e = 0; e < 8; ++e) { const float br = BBr[(d * 64 + n) * 16 + i0 + e], bi = BBi[(d * 64 + n) * 16 + i0 + e]; v[e] = part ? (pr * bi + pi * br) : (pr * br - pi * bi); }
            u32x4 w; w.x = cvt_pk_bf16(v[0], v[1]); w.y = cvt_pk_bf16(v[2], v[3]); w.z = cvt_pk_bf16(v[4], v[5]); w.w = cvt_pk_bf16(v[6], v[7]);
            *(u32x4*)(Bt1 + ((size_t)g * 512 + 256 + c1) * 256 + kb) = w; }
        for (int q = 0; q < 16; ++q) { const int item = tid + 512 * q; const int c2 = item >> 5, kb = (item & 31) * 8; const int rout = c2 >> 4, o = c2 & 15; const int d = kb >> 7, part = (kb >> 6) & 1, n0 = kb & 63;
            const int ex = (d == 0) ? rout + 1 : 16 - rout; const LAS float* cr = CrL + (d * 16 + o) * 64 + n0; const LAS float* ci = CiL + (d * 16 + o) * 64 + n0;
            float v[8];
#pragma unroll
            for (int e = 0; e < 8; ++e) { const float pr = Pre[(d * 17 + ex) * 64 + n0 + e], pi = Pim[(d * 17 + ex) * 64 + n0 + e]; v[e] = part ? -(cr[e] * pi + ci[e] * pr) : (cr[e] * pr - ci[e] * pi); }
            u32x4 w; w.x = cvt_pk_bf16(v[0], v[1]); w.y = cvt_pk_bf16(v[2], v[3]); w.z = cvt_pk_bf16(v[4], v[5]); w.w = cvt_pk_bf16(v[6], v[7]);
            *(u32x4*)(Bt2 + ((size_t)g * 256 + c2) * 256 + kb) = w; }
        __syncthreads();
    }
}
__device__ __forceinline__ void s5_carry(Frame& F, int cid) {
    const int b = cid >> 7, d = (cid >> 6) & 1, g = cid & 63, n = F.lane;
    const unsigned* ST = (const unsigned*)((const bf16_t*)(F.ws + WS_S5ST) + ((size_t)g * S5M + b * 272) * 256 + d * 128) + n;
    bf16_t* HP = (bf16_t*)(F.ws + WS_S5H) + ((size_t)g * 1280 + b * 272) * 256 + d * 128 + n;
    const float* A16 = (const float*)(F.ws + WS_S5A); const float ar = A16[((d * 64 + g) * 64 + n) * 2], ai = A16[((d * 64 + g) * 64 + n) * 2 + 1];
    float hr = 0.f, hi_ = 0.f;
    for (int k0 = 0; k0 < 272; k0 += 34) {
        unsigned wv[34];
#pragma unroll
        for (int e = 0; e < 34; ++e) { const int k = k0 + e; const int cc = (d == 0) ? k : (k < 16 ? 15 - k : 287 - k); wv[e] = ST[(size_t)cc * 128]; }
        asm volatile("s_waitcnt vmcnt(0)" ::: "memory");
#pragma unroll
        for (int e = 0; e < 34; ++e) { const int k = k0 + e; const int cc = (d == 0) ? k : (k < 16 ? 15 - k : 287 - k);
            HP[(size_t)cc * 256] = (bf16_t)(cvt_pk_bf16(hr, 0.f) & 0xffffu); HP[(size_t)cc * 256 + 64] = (bf16_t)(cvt_pk_bf16(hi_, 0.f) & 0xffffu);
            const float sr = bflo(wv[e]), si = bfhi(wv[e]); const float nr = ar * hr - ai * hi_ + sr, ni = ar * hi_ + ai * hr + si; hr = nr; hi_ = ni; }
    }
}
__device__ __forceinline__ void mixer_finalize(const Args& A_, Frame& F, int l) {
    bf16_t* P = (bf16_t*)(F.ws + WS_PROJ);
    const bf16_t* XC = (const bf16_t*)(F.ws + WS_HM); const bf16_t* YD0 = (const bf16_t*)(F.ws + WS_YD); const bf16_t* YD1 = YD0 + (size_t)R * 1024;
        const int c0 = F.lane * 16;
    for (int row = F.gw; row < R; row += F.NGW) {
        { const float dsk = INP(I_SSDD)[l * 16 + (c0 >> 6)];
          const float* nwp = INP(I_SSDN) + l * 1024 + c0;
          float v[16];
#pragma unroll
          for (int hh = 0; hh < 2; ++hh) { const u32x4 x = *(const u32x4*)(XC + (size_t)row * 2048 + c0 + 8 * hh), y0 = *(const u32x4*)(YD0 + (size_t)row * 1024 + c0 + 8 * hh), y1 = *(const u32x4*)(YD1 + (size_t)row * 1024 + c0 + 8 * hh), z = *(const u32x4*)(P + (size_t)row * LDP + PZ + c0 + 8 * hh);
#define SG(i, wx, wy0, wy1, wz) v[8 * hh + 2 * (i)] = (bflo(wx) * dsk + bflo(wy0) + bflo(wy1)) * bflo(wz); v[8 * hh + 2 * (i) + 1] = (bfhi(wx) * dsk + bfhi(wy0) + bfhi(wy1)) * bfhi(wz);
              SG(0, x.x, y0.x, y1.x, z.x) SG(1, x.y, y0.y, y1.y, z.y) SG(2, x.z, y0.z, y1.z, z.z) SG(3, x.w, y0.w, y1.w, z.w)
#undef SG
          }
          float ss = 0.f;
#pragma unroll
          for (int e = 0; e < 16; ++e) ss += v[e] * v[e];
          ss += shx(ss, 1, F.lane); ss += shx(ss, 2, F.lane); ss += shx(ss, 4, F.lane); ss += shx(ss, 8, F.lane);
          const float rs = 1.0f / sqrtf(ss * (1.f / 256.f) + RMS_EPS);
          const f32x4 n0 = *(const f32x4*)(nwp), n1 = *(const f32x4*)(nwp + 4), n2 = *(const f32x4*)(nwp + 8), n3 = *(const f32x4*)(nwp + 12);
          const float nw[16] = {n0[0], n0[1], n0[2], n0[3], n1[0], n1[1], n1[2], n1[3], n2[0], n2[1], n2[2], n2[3], n3[0], n3[1], n3[2], n3[3]};
          u32x4 o0, o1;
          o0.x = cvt_pk_bf16(v[0] * rs * nw[0], v[1] * rs * nw[1]); o0.y = cvt_pk_bf16(v[2] * rs * nw[2], v[3] * rs * nw[3]); o0.z = cvt_pk_bf16(v[4] * rs * nw[4], v[5] * rs * nw[5]); o0.w = cvt_pk_bf16(v[6] * rs * nw[6], v[7] * rs * nw[7]);
          o1.x = cvt_pk_bf16(v[8] * rs * nw[8], v[9] * rs * nw[9]); o1.y = cvt_pk_bf16(v[10] * rs * nw[10], v[11] * rs * nw[11]); o1.z = cvt_pk_bf16(v[12] * rs * nw[12], v[13] * rs * nw[13]); o1.w = cvt_pk_bf16(v[14] * rs * nw[14], v[15] * rs * nw[15]);
          *(u32x4*)(P + (size_t)row * LDP + PV + c0) = o0; *(u32x4*)(P + (size_t)row * LDP + PV + c0 + 8) = o1; }
    }
}


__global__ void __launch_bounds__(NWAVES * 64, 2) trunk_fwd(Args args) {
    extern __shared__ __attribute__((aligned(16))) unsigned char lds_raw[];
    Frame F;
    F.lds = (LAS unsigned char*)lds_raw;
    F.tid = threadIdx.x; F.lane = F.tid & 63; F.wave = __builtin_amdgcn_readfirstlane(F.tid >> 6);
    F.G = gridDim.x; { const int bx = blockIdx.x; F.vcu = (F.G % 8 == 0) ? (bx % 8) * (F.G / 8) + bx / 8 : bx; }
    F.gw = F.vcu * NWAVES + F.wave; F.NGW = F.G * NWAVES;
    F.ws = args.ws;
    volatile LAS unsigned* MISC = (volatile LAS unsigned*)(F.lds + MISC_OFF);
    for (int u = F.tid; u < (LDS_BYTES - LDSCTL_OFF) / 4; u += NWAVES * 64) ((LAS unsigned*)(F.lds + LDSCTL_OFF))[u] = 0u;
    __syncthreads();
    if (threadIdx.x < 32) ((LAS unsigned long long*)(F.lds + INTAB_OFF))[threadIdx.x] = (unsigned long long)args.in[threadIdx.x];
    __syncthreads();
    (void)xcd_barrier_post((unsigned*)(args.ws + WS_CTL) + CW_BAR, MISC + 8);
    const int lo = args.ph_lo, hi = args.ph_hi;
    const int wave0 = __builtin_amdgcn_readfirstlane((int)threadIdx.x >> 6);
    int pid = 0;
#define PH_BEGIN if (pid >= lo && pid < hi) { GAS unsigned char* wsg_ = (GAS unsigned char*)args.ws; int tid_; asm volatile("v_mbcnt_lo_u32_b32 %1, -1, 0\n\tv_mbcnt_hi_u32_b32 %1, -1, %1 ; PHASE_MARK_BEGIN %2" : "+s"(wsg_), "=v"(tid_) : "i"(__LINE__) : "memory"); tid_ += wave0 * 64; unsigned char* ws = (unsigned char*)wsg_; F.ws = ws; F.tid = tid_; F.lane = tid_ & 63; F.wave = __builtin_amdgcn_readfirstlane(tid_ >> 6); F.gw = F.vcu * NWAVES + F.wave;
#define PH_END   asm volatile("; PHASE_MARK_END %0" :: "i"(__LINE__)); if (pid + 1 < hi) { XcdBarrier bar_; bar_.bar = (unsigned*)(args.ws + WS_CTL) + CW_BAR; bar_.x = xb_xcc_id(); bar_.st = (volatile LAS unsigned*)(F.lds + MISC_OFF) + 8; xcd_barrier(bar_, wave0 * 64 + lane_now()); } } ++pid;

#define MOD ((float*)(ws + WS_MOD))
#define Hbuf ((float*)(ws + WS_H))
#define HM ((bf16_t*)(ws + WS_HM))
#define PROJ ((bf16_t*)(ws + WS_PROJ))
#define ROPEC ((float*)(ws + WS_ROPE))
#define ROPES (ROPEC + 1024)
#define WGT (ws + WS_W)

    PH_BEGIN
        s5_setup(args, F, 0);
        mod_partials(args, F);
        if ((int)blockIdx.x == F.G - 1) {
            { float* idn = (float*)(ws + WS_IDENT); for (int i = F.tid; i < 2048; i += NWAVES * 64) { idn[i] = 1.0f; idn[2048 + i] = 0.0f; } }
#pragma unroll
            for (int i2 = 0; i2 < 2; ++i2) { const int idx = (F.wave * 2 + i2) * 64 + F.lane, pos = idx >> 4, f = idx & 15; const float inv = powf(10000.0f, -(float)f / 16.0f); const float ang = (float)pos * inv; ROPEC[idx] = cosf(ang); ROPES[idx] = sinf(ang); } }
    PH_END
    PH_BEGIN
        convert_layer_weights(args, F, 0);
        ln_pass(F, false, nullptr, nullptr, MOD, nullptr, INP(I_X), INP(I_CTX));
    PH_END

    for (int s = 0; s < 6; ++s) {
        const int l = s / 3, j = s - 3 * l;
        if (j != 1) {
            const int f = j >> 1;
            PH_BEGIN
                const int lat = (l == 1 && j == 2); pg8::Gemm g{D, D, D}; pg8::StaticOrder S; S.init(lat ? 64 : NPAN, N13 / 256, F.G, (int)blockIdx.x, HM, D, (const bf16_t*)(WGT + W_13) + (size_t)f * N13 * D, D, D, lat);
                EpiSwiGLU E{PROJ};
                pg8::gemm_phase<EpiSwiGLU, pg8::StaticOrder>(F.lds + RING_OFF, g, S, E, F.tid);
            PH_END
        } else {
            PH_BEGIN
                pg8::Gemm g{D, D, D}; pg8::StaticOrder S; S.init(NPAN, LDP / 256, F.G, (int)blockIdx.x, HM, D, (const bf16_t*)(WGT + W_IN), D, D);
                EpiProj E{PROJ, (float*)(ws + WS_DT), ROPEC, ROPES, (bf16_t*)(ws + WS_O)};
                pg8::gemm_phase<EpiProj, pg8::StaticOrder>(F.lds + RING_OFF, g, S, E, F.tid);
                { const int nfull = (NPAN * (LDP / 256)) % F.G;
                  if ((int)blockIdx.x >= nfull) { const int nw = (F.G - nfull) * NWAVES; for (int t = ((int)blockIdx.x - nfull) * NWAVES + F.wave; t < R / 32; t += nw) dt_tile(F, l, t); } }
            PH_END
            PH_BEGIN
                ssd_conv_pass(args, F, l);
                asm volatile("" : "+v"(F.tid));
                { pg8::Gemm g{256, 256, 256}; S5AOrder S{F.G, (int)blockIdx.x, (const char*)(ws + WS_O), (const char*)(ws + WS_S5M)};
                  EpiS5A E{(unsigned char*)(ws + WS_YS), (bf16_t*)(ws + WS_S5ST)};
                  pg8::gemm_phase<EpiS5A, S5AOrder>(F.lds + RING_OFF, g, S, E, F.tid); }
            PH_END
            PH_BEGIN
                if (F.wave < 2) s5_carry(F, (int)blockIdx.x * 2 + F.wave);
                ssd_chain_fast(args, F, l, (int)blockIdx.x);
                {
                    const float lam_init = 0.8f - 0.6f * expf(-0.3f * (float)l);
                    const float* lv = INP(I_ALAM) + l * 256;
                    const float s01 = wave_sum(lv[F.lane] * lv[64 + F.lane], F.lane), s23 = wave_sum(lv[128 + F.lane] * lv[192 + F.lane], F.lane);
                    const float lam = expf(s01) - expf(s23) + lam_init;
                    for (int i = 0;; ++i) { const int idx = i * F.G + F.vcu; if (idx >= 512 + (l == 0 ? 32 : 0)) break;
                        int b, h, q0, seq;
                        if (idx < 512) { b = idx >> 7; h = (idx >> 4) & 7; q0 = b * RB + CTX + (idx & 15) * 256; seq = RB; }
                        else { const int k = idx - 512; b = k >> 3; h = k & 7; q0 = b * RB; seq = CTX; }
                        const bf16_t* Q0 = PROJ + (size_t)q0 * LDP + PQ + h * 128; const bf16_t* Kh = PROJ + (size_t)(b * RB) * LDP + PK + h * 128; const bf16_t* Vh = PROJ + (size_t)(b * RB) * LDP + PV + h * 128;
                        attn128::unit((const attn128::bf16*)Q0, (const attn128::bf16*)Kh, (const attn128::bf16*)Vh, PROJ + (size_t)q0 * LDP + PQ + h * 128, seq, (char*)lds_raw + RING_OFF, F.tid, lam, 1.0f - lam_init, INP(I_ASUB) + l * 128);
                    }
                }
            PH_END
            PH_BEGIN
                mixer_finalize(args, F, l);
                asm volatile("" : "+v"(F.tid));
                { pg8::Gemm g{256, 256, 256}; S5COrder S{F.G, (int)blockIdx.x, (const char*)(ws + WS_S5H), (const char*)((bf16_t*)(ws + WS_S5M) + (size_t)64 * 512 * 256)};
                  EpiS5C E{(const unsigned char*)(ws + WS_YS), PROJ};
                  pg8::gemm_phase<EpiS5C, S5COrder>(F.lds + RING_OFF, g, S, E, F.tid); }
            PH_END
            PH_BEGIN
                pg8::Gemm g{LDP, 1024, 1024}; pg8::StaticOrder S; S.init(l == 1 ? 64 : NPAN, 4, F.G, (int)blockIdx.x, PROJ + PU, LDP, (const bf16_t*)(WGT + W_GLU), 1024, 1024, l == 1);
                EpiGlu E{PROJ, INP(I_GLUB) + l * 1024};
                pg8::gemm_phase<EpiGlu, pg8::StaticOrder>(F.lds + RING_OFF, g, S, E, F.tid);
            PH_END
            PH_BEGIN
                pg8::Gemm g{LDP, 3072, 3072}; pg8::StaticOrder S; S.init(l == 1 ? 64 : NPAN, 8, F.G, (int)blockIdx.x, PROJ, LDP, (const bf16_t*)(WGT + W_B), 3072, 3072, l == 1);
                EpiMerge E{PROJ, HM};
                pg8::gemm_phase<EpiMerge, pg8::StaticOrder, 0, true>(F.lds + RING_OFF, g, S, E, F.tid);
            PH_END
        }
        PH_BEGIN
            const int RK = (j == 1) ? D : DFF; const bf16_t* RA = (j == 1) ? HM : PROJ; const bf16_t* RBt = (j == 1) ? (const bf16_t*)(WGT + W_O) : (const bf16_t*)(WGT + W_2) + (size_t)(j >> 1) * D * DFF;
            const int lat = (l == 1 && j >= 1); pg8::Gemm g{RK, RK, RK}; pg8::StaticOrder S; S.init(64, D / 256, F.G, (int)blockIdx.x, RA, RK, RBt, RK, RK, 1, lat ? 0 : 128);
            const float* lg_ = (s == 0) ? (const float*)(ws + WS_IDENT) : INP(I_LNG) + (size_t)(s - 1) * D; const float* lb_ = (s == 0) ? (const float*)(ws + WS_IDENT) + 2048 : INP(I_LNB) + (size_t)(s - 1) * D;
            EpiResid E{(_Float16*)(ws + WS_H), (float*)(ws + WS_HC), MOD + (size_t)l * 5 * NMOD + (3 * j + 2) * D, lg_, lb_, (const float*)(ws + WS_STATS)};
            pg8::gemm_phase<EpiResid, pg8::StaticOrder>(F.lds + RING_OFF, g, S, E, F.tid);
        PH_END
        PH_BEGIN
            const bool fin = (s == 5);
            const int ln_ = (j == 2) ? l + 1 : l, jn = (j == 2) ? 0 : j + 1;
            ln_pass(F, true, INP(I_LNG) + (size_t)(l * 3 + j) * D, INP(I_LNB) + (size_t)(l * 3 + j) * D, fin ? nullptr : MOD + (size_t)ln_ * 5 * NMOD + 3 * jn * D, fin ? args.out : nullptr, nullptr, nullptr, (l == 1 && j >= 1) ? 0 : 4);
            if (s == 2) { s5_setup(args, F, 1); __syncthreads(); convert_layer_weights(args, F, 1); }
        PH_END
    }
#undef PH_BEGIN
#undef PH_END
}

static int count_phases() { int n = 2; for (int s = 0; s < 6; ++s) n += ((s % 3) != 1 ? 1 : 6) + 2; return n; }
extern "C" void kernel_launch(void* const* d_in, const int* in_sizes, int n_in, void* d_out, int out_size, void* d_ws, size_t ws_size, hipStream_t stream) {
    static int grid = 0;
    if (grid == 0) {
        if (n_in != 32 || out_size != NB * SEQ * D || ws_size < WS_END) { fprintf(stderr, "kernel_launch: unexpected shapes (n_in %d, out %d, ws %zu < %zu)\n", n_in, out_size, ws_size, (size_t)WS_END); grid = -1; return; }
        int dev = 0, cus = 0, per_cu = 0;
        if (hipGetDevice(&dev) != hipSuccess || hipDeviceGetAttribute(&cus, hipDeviceAttributeMultiprocessorCount, dev) != hipSuccess) { grid = -1; return; }
        if (hipFuncSetAttribute((const void*)trunk_fwd, hipFuncAttributeMaxDynamicSharedMemorySize, LDS_BYTES) != hipSuccess) { fprintf(stderr, "kernel_launch: hipFuncSetAttribute failed\n"); grid = -1; return; }
        if (hipOccupancyMaxActiveBlocksPerMultiprocessor(&per_cu, (const void*)trunk_fwd, NWAVES * 64, LDS_BYTES) != hipSuccess || per_cu < 1) fprintf(stderr, "kernel_launch: occupancy query says %d\n", per_cu);
        (void)hipGetLastError();
        if (cus != 256) { fprintf(stderr, "kernel_launch: this kernel deals its SSD chains / carries / attention units over exactly 256 workgroups (one per CU); device reports %d CUs; nothing launched\n", cus); grid = -1; return; }
        grid = cus;
    }
    if (grid < 0) return;
    (void)in_sizes;
    if (hipMemsetAsync((char*)d_ws + WS_CTL, 0, 2 * MiB  , stream) != hipSuccess) return;
    Args a{};
    for (int i = 0; i < 32; ++i) a.in[i] = (const float*)d_in[i];
    a.out = (float*)d_out; a.ws = (unsigned char*)d_ws;
    const int nph = count_phases();
#if MK_PER_PHASE
    for (int p = 0; p < nph; ++p) { a.ph_lo = p; a.ph_hi = p + 1; hipLaunchKernelGGL(trunk_fwd, dim3(grid), dim3(NWAVES * 64), LDS_BYTES, stream, a); }
#else
    a.ph_lo = 0; a.ph_hi = nph;
    hipLaunchKernelGGL(trunk_fwd, dim3(grid), dim3(NWAVES * 64), LDS_BYTES, stream, a);
#endif
    const hipError_t le = hipPeekAtLastError();
    if (le != hipSuccess) fprintf(stderr, "kernel_launch: launch failed: %s\n", hipGetErrorName(le));
}
```

```cpp
#include <hip/hip_runtime.h>
#include <hip/hip_bf16.h>
#include <cstdio>
#include <cstdint>
#include <cmath>

#ifndef MK_PER_PHASE
#define MK_PER_PHASE 0
#endif

#define LAS __attribute__((address_space(3)))
#define GAS __attribute__((address_space(1)))
typedef unsigned short bf16_t;
typedef short bf16x8 __attribute__((ext_vector_type(8)));
typedef float f32x4 __attribute__((ext_vector_type(4)));
typedef float f32x2 __attribute__((ext_vector_type(2)));
typedef float f32x16 __attribute__((ext_vector_type(16)));
typedef unsigned u32x4 __attribute__((ext_vector_type(4)));
typedef unsigned u32x2 __attribute__((ext_vector_type(2)));
typedef short s16x4 __attribute__((ext_vector_type(4)));

constexpr int NB = 4, SEQ = 4096, CTX = 256, RB = SEQ + CTX  , R = NB * RB  , NPAN = R / 256  , PPB = RB / 256  ;
constexpr int D = 2048, DFF = 5632, N13 = 2 * DFF, NMOD = 9 * D  ;
constexpr int LDP = 13312;
constexpr int NIN = 13568;
constexpr int PQ = 0, PK = 1024, PV = 2048, PZ = 3072, PX = 4096, PU = 6144, PG = 7168;
constexpr float DN_ALPHA = 1.41421356237309515f;
constexpr float LN_EPS = 1e-5f, RMS_EPS = 1e-6f;
constexpr float QSCALE = 0.125f * 1.4426950408889634f;

constexpr size_t MiB = 1u << 20;
constexpr size_t WS_CTL = 0, CTL_ZERO_BYTES = 1 * MiB;
constexpr size_t WS_MOD = 1 * MiB;
constexpr size_t WS_ROPE = 2 * MiB;
constexpr size_t WS_STATS = 2 * MiB + 65536;
constexpr size_t WS_IDENT = 2 * MiB + 262144;
constexpr size_t WS_MODP = 3 * MiB;
constexpr size_t WS_DT = 15 * MiB;
constexpr size_t WS_H = 18 * MiB;
constexpr size_t WS_HC = WS_H + 68 * MiB;
constexpr size_t WS_HM = 154 * MiB;
constexpr size_t WS_PROJ = 222 * MiB;
constexpr size_t WS_O = 664 * MiB;
constexpr size_t WS_YD = 732 * MiB;
constexpr size_t WS_YS = 800 * MiB;
constexpr size_t WS_W = 868 * MiB;
constexpr size_t W_13 = 0, W_2 = 88 * MiB, W_IN = 132 * MiB, W_B = 185 * MiB, W_O = 197 * MiB, W_GLU = 205 * MiB;
constexpr size_t WS_S5ST = 1075 * MiB;
constexpr size_t WS_S5H = 1143 * MiB;
constexpr size_t WS_S5M = 1183 * MiB;
constexpr size_t WS_S5A = 1207 * MiB;
constexpr size_t WS_GQ0 = WS_O + 34 * MiB, WS_GQ1 = WS_S5ST + 34 * MiB  , WS_GQ2 = 1208 * MiB;
constexpr size_t WS_END = 1242 * MiB;
__device__ __forceinline__ size_t gq_off(int j) { return j == 0 ? WS_GQ0 : (j == 1 ? WS_GQ1 : WS_GQ2); }
constexpr int S5M = 1088;
constexpr int CW_BAR = 4096;

__device__ __forceinline__ unsigned cvt_pk_bf16(float lo, float hi) { unsigned r; asm volatile("v_cvt_pk_bf16_f32 %0, %1, %2" : "=v"(r) : "v"(lo), "v"(hi)); return r; }
__device__ __forceinline__ float bflo(unsigned u) { return __uint_as_float(u << 16); }
__device__ __forceinline__ float bfhi(unsigned u) { return __uint_as_float(u & 0xffff0000u); }
__device__ __forceinline__ float bf1(bf16_t h) { return __uint_as_float((unsigned)h << 16); }
typedef _Float16 h16x2 __attribute__((ext_vector_type(2)));
typedef _Float16 h16x4 __attribute__((ext_vector_type(4)));
typedef _Float16 h16x8 __attribute__((ext_vector_type(8)));
__device__ __forceinline__ f32x4 ld_h4(const _Float16* p) { const h16x4 h = *(const h16x4*)p; return (f32x4){(float)h[0], (float)h[1], (float)h[2], (float)h[3]}; }
__device__ __forceinline__ void st_h4(_Float16* p, f32x4 v) { h16x4 h; h[0] = (_Float16)v[0]; h[1] = (_Float16)v[1]; h[2] = (_Float16)v[2]; h[3] = (_Float16)v[3]; *(h16x4*)p = h; }
__device__ __forceinline__ float sigmoidf_(float x) { return __builtin_amdgcn_rcpf(1.0f + __builtin_amdgcn_exp2f(-1.4426950408889634f * x)); }
__device__ __forceinline__ float siluf_(float x) { return x * sigmoidf_(x); }
__device__ __forceinline__ int lane_now() { int l; asm volatile("v_mbcnt_lo_u32_b32 %0, -1, 0\n\tv_mbcnt_hi_u32_b32 %0, -1, %0" : "=v"(l)); return l; }
__device__ __forceinline__ float shx(float v, int m, int lane) { return __int_as_float(__builtin_amdgcn_ds_bpermute((lane ^ m) << 2, __float_as_int(v))); }
__device__ __forceinline__ float wave_sum(float v, int lane) {
#pragma unroll
    for (int o = 1; o < 64; o <<= 1) v += shx(v, o, lane);
    return v;
}
#define LDS_WAIT() asm volatile("s_waitcnt lgkmcnt(0)" ::: "memory")
#define VM_WAIT() asm volatile("s_waitcnt vmcnt(0)" ::: "memory")

namespace pg8 {
constexpr int BM = 256, BK = 64, HALF = 128, HTB = HALF * BK * 2, STAGE_BYTES = 8 * HTB, NXCD = 8, WGM = 8, PPB_ = 17;
__host__ __device__ __forceinline__ int lds_byte(int r, int c) { const int st = (r >> 4) * 2 + (c >> 5), rr = r & 15, cc = c & 31, ob = rr * 64 + cc * 2; return st * 1024 + (ob ^ (((ob >> 9) & 1) << 5)); }
__host__ __device__ __forceinline__ int perm32(int rho) { const int n = rho >> 4, i = rho & 15; return 8 * (i >> 2) + 4 * n + (i & 3); }
__host__ __device__ __forceinline__ void stage_rc(int b, int& R_, int& C_) { const int st = b / 1024, sb = b % 1024, swz = sb ^ (((sb >> 9) & 1) << 5); R_ = (st >> 1) * 16 + swz / 64; C_ = (st & 1) * 32 + (swz % 64) / 2; }

struct Unit { int pm, pn, aux, kt; const char* a; const char* b; };
struct Gemm { int lda, ldb, K; };

__device__ __forceinline__ void xcd_remap(int L, int nM, int nN, int& pm, int& pn) {
    const int nwg = nM * nN; int wgid = L;
    { const int q = nwg / NXCD, r = nwg % NXCD, xcd = wgid % NXCD, off = wgid / NXCD; wgid = (xcd < r ? xcd * (q + 1) : r * (q + 1) + (xcd - r) * q) + off; }
    const int nig = WGM * nN, gid = wgid / nig, fm = gid * WGM, gsz = (nM - fm) < WGM ? (nM - fm) : WGM;
    pm = fm + ((wgid % nig) % gsz); pn = (wgid % nig) / gsz;
}
struct StaticOrder {
    int nM, nN, nwg, G, c, kt, latonly, nctx, cproj; const char* A; const char* B; size_t tA, tB;
    __device__ __forceinline__ void init(int nM_, int nN_, int G_, int c_, const void* A_, int lda, const void* B_, int ldb, int K, int latonly_ = 0, int nctx_ = 0) { nM = nM_; nN = nN_; nwg = nM * nN; G = G_; c = c_; kt = K / BK; latonly = latonly_; nctx = nctx_; cproj = 0;
        A = (const char*)A_; B = (const char*)B_; tA = (size_t)BM * lda * 2; tB = (size_t)BM * ldb * 2; }
    __device__ __forceinline__ bool next(int i, Unit& u) const {
        const long L = (long)i * G + c;
        if (L < nwg) { xcd_remap((int)L, nM, nN, u.pm, u.pn); if (latonly) u.pm += (u.pm >> 4) + 1; u.aux = 0; u.kt = kt; u.a = A + (size_t)u.pm * tA; u.b = B + (size_t)u.pn * tB; return true; }
        const int x = (int)(L - nwg); if (x >= nctx) return false;
        if (cproj) {
            const int p = x / 20, t2 = x - 20 * p; u.pm = PPB_ * p; u.pn = (t2 < 8) ? 4 + t2 : 8 + t2; u.aux = 0; u.kt = kt; u.a = A + (size_t)u.pm * tA; u.b = B + (size_t)u.pn * tB; return true; }
        const int q = x & 3, t2 = x >> 2; u.pm = PPB_ * (t2 / nN); u.pn = t2 % nN; u.aux = 1 + q; u.kt = kt >> 2;
        u.a = A + (size_t)u.pm * tA + (size_t)q * (kt >> 2) * BK * 2; u.b = B + (size_t)u.pn * tB + (size_t)q * (kt >> 2) * BK * 2; return true;
    }
};
template <class Epi, class Sched, int AMODE = 0, bool HOOK = false>
__device__ __forceinline__ void gemm_phase(LAS unsigned char* lds, const Gemm g, const Sched& S, const Epi& E, const int tid) {
    const int wid = __builtin_amdgcn_readfirstlane(tid >> 6), lane = tid & 63, wr = wid >> 2, wc = wid & 3, fr = lane & 15, fq = lane >> 4;
    unsigned voffA[2], voffB[2];
#pragma unroll
    for (int i = 0; i < 2; ++i) { int R_, C_; stage_rc(tid * 16 + i * 8192, R_, C_);
        voffA[i] = (AMODE == 1) ? (unsigned)((R_ * 16 + (C_ >> 4)) * LDP + (C_ & 15)) * 2u : (unsigned)(R_ * g.lda + C_) * 2u; voffB[i] = (unsigned)((Epi::PERM ? ((R_ & ~31) + perm32(R_ & 31)) : R_) * g.ldb + C_) * 2u; }
    const size_t kstep = (size_t)(BK * 2), kstepA = (AMODE == 1) ? (size_t)(4 * LDP * 2) : kstep;
    const size_t hstepA = (AMODE == 1) ? (size_t)HALF * 16 * LDP * 2 : (size_t)HALF * g.lda * 2, hstepB = (size_t)HALF * g.ldb * 2;
    const unsigned ldsw = (unsigned)wid * 1024u;
    const int aoff = lds_byte(wr * 64 + fr, fq * 8), boff = lds_byte(wc * 32 + fr, fq * 8);
#define PG8_SA(b, h) (((b) * 2 + (h)) * HTB)
#define PG8_SB(b, h) ((4 + (b) * 2 + (h)) * HTB)
#define PG8_STAGE(bufoff, gbase, voff) do { _Pragma("unroll") for (int _i = 0; _i < 2; ++_i) \
        __builtin_amdgcn_global_load_lds((const unsigned*)((const char*)(gbase) + (voff)[_i]), (LAS unsigned*)(lds + (bufoff) + ldsw + _i * 8192), 16, 0, 0); } while (0)
#define PG8_LDA(dst, b, h) do { _Pragma("unroll") for (int m = 0; m < 4; ++m) _Pragma("unroll") for (int k = 0; k < 2; ++k) dst[m][k] = *(const LAS bf16x8*)(lds + PG8_SA(b, h) + aoff + m * 2048 + k * 1024); } while (0)
#define PG8_LDB(dst, b, h) do { _Pragma("unroll") for (int n = 0; n < 2; ++n) _Pragma("unroll") for (int k = 0; k < 2; ++k) dst[n][k] = *(const LAS bf16x8*)(lds + PG8_SB(b, h) + boff + n * 2048 + k * 1024); } while (0)
#define PG8_MMA(ai, bj, At, Bt) do { __builtin_amdgcn_s_setprio(1); _Pragma("unroll") for (int m = 0; m < 4; ++m) _Pragma("unroll") for (int n = 0; n < 2; ++n) _Pragma("unroll") for (int k = 0; k < 2; ++k) \
        acc[ai][bj][m][n] = __builtin_amdgcn_mfma_f32_16x16x32_bf16(Bt[n][k], At[m][k], acc[ai][bj][m][n], 0, 0, 0); __builtin_amdgcn_s_setprio(0); } while (0)
#define PG8_WAIT_V(n) asm volatile("s_waitcnt vmcnt(" #n ")" ::: "memory")
#define PG8_WAIT_L(n) asm volatile("s_waitcnt lgkmcnt(" #n ")" ::: "memory")
#define PG8_BAR __builtin_amdgcn_s_barrier()
#define PG8_SCHED __builtin_amdgcn_sched_barrier(0)
    Unit cur, nxt; int ui = 0;
    if (!S.next(0, cur)) return;
    f32x4 acc[2][2][4][2];
#pragma unroll
    for (int a = 0; a < 2; ++a)
#pragma unroll
        for (int b = 0; b < 2; ++b)
#pragma unroll
            for (int m = 0; m < 4; ++m)
#pragma unroll
                for (int n = 0; n < 2; ++n) acc[a][b][m][n] = (f32x4){0.f, 0.f, 0.f, 0.f};
    bf16x8 At[4][2], B0[2][2], B1[2][2];
    const char* cA = cur.a; const char* cB = cur.b;
    PG8_STAGE(PG8_SB(0, 0), cB, voffB); PG8_STAGE(PG8_SB(0, 1), cB + hstepB, voffB); PG8_STAGE(PG8_SA(0, 0), cA, voffA); PG8_STAGE(PG8_SA(0, 1), cA + hstepA, voffA);
    if (wr == 1) PG8_BAR;
    PG8_WAIT_V(2); PG8_BAR;
    PG8_STAGE(PG8_SB(1, 0), cB + kstep, voffB); PG8_STAGE(PG8_SA(1, 0), cA + kstepA, voffA); PG8_STAGE(PG8_SB(1, 1), cB + hstepB + kstep, voffB);
    PG8_WAIT_V(6); PG8_BAR;
    for (;;) {
        const bool has_next = S.next(ui + 1, nxt);
        const char* nA = has_next ? nxt.a : cA; const char* nB = has_next ? nxt.b : cB;
        const int nt = cur.kt;
        for (int t = 0; t < nt; t += 2) {
            const bool last = (t == nt - 2);
            if constexpr (HOOK) { if (t == 16 || t == 32) E.mid(acc, cur, t >> 4, wr, wc); }
            const char* a1 = cA + (size_t)(t + 1) * kstepA;
            const char* a2 = last ? nA : cA + (size_t)(t + 2) * kstepA; const char* b2 = last ? nB : cB + (size_t)(t + 2) * kstep;
            const char* a3 = a2 + kstepA; const char* b3 = b2 + kstep;
            PG8_LDB(B0, 0, 0); PG8_LDB(B1, 0, 1); PG8_SCHED; PG8_LDA(At, 0, 0); PG8_STAGE(PG8_SA(1, 1), a1 + hstepA, voffA);
            PG8_WAIT_V(8); PG8_WAIT_L(0); PG8_BAR; PG8_MMA(0, 0, At, B0); PG8_MMA(0, 1, At, B1); PG8_BAR; PG8_SCHED;
            PG8_LDA(At, 0, 1); PG8_STAGE(PG8_SB(0, 0), b2, voffB); PG8_STAGE(PG8_SB(0, 1), b2 + hstepB, voffB); PG8_STAGE(PG8_SA(0, 0), a2, voffA);
            PG8_WAIT_V(8); PG8_WAIT_L(0); PG8_BAR; PG8_MMA(1, 0, At, B0); PG8_MMA(1, 1, At, B1); PG8_BAR; PG8_SCHED;
            PG8_LDB(B0, 1, 0); PG8_LDB(B1, 1, 1); PG8_SCHED; PG8_LDA(At, 1, 0); PG8_STAGE(PG8_SA(0, 1), a2 + hstepA, voffA);
            PG8_WAIT_V(8); PG8_WAIT_L(0); PG8_BAR; PG8_MMA(0, 0, At, B0); PG8_MMA(0, 1, At, B1); PG8_BAR; PG8_SCHED;
            PG8_LDA(At, 1, 1); PG8_STAGE(PG8_SB(1, 0), b3, voffB); PG8_STAGE(PG8_SB(1, 1), b3 + hstepB, voffB); PG8_STAGE(PG8_SA(1, 0), a3, voffA);
            PG8_WAIT_V(8); PG8_WAIT_L(0); PG8_BAR; PG8_MMA(1, 0, At, B0); PG8_MMA(1, 1, At, B1); PG8_BAR; PG8_SCHED;
        }
        if (wr == 0) PG8_BAR;
        E(acc, cur, wr, wc, fr, fq);
        if (!has_next) break;
#pragma unroll
        for (int a = 0; a < 2; ++a)
#pragma unroll
            for (int b = 0; b < 2; ++b)
#pragma unroll
                for (int m = 0; m < 4; ++m)
#pragma unroll
                    for (int n = 0; n < 2; ++n) acc[a][b][m][n] = (f32x4){0.f, 0.f, 0.f, 0.f};
        cur = nxt; cA = nA; cB = nB; ++ui;
        if (wr == 1) PG8_BAR;
    }
    PG8_WAIT_V(0);
    PG8_BAR;
#undef PG8_SA
#undef PG8_SB
#undef PG8_STAGE
#undef PG8_LDA
#undef PG8_LDB
#undef PG8_MMA
#undef PG8_WAIT_V
#undef PG8_WAIT_L
#undef PG8_BAR
#undef PG8_SCHED
}
}

struct EpiSwiGLU {
    static constexpr bool PERM = true;
    bf16_t* O;
    __device__ __forceinline__ void operator()(const f32x4 (&acc)[2][2][4][2], const pg8::Unit& u, int wr, int wc, int, int) const { const int ln_ = lane_now(); const int fr = ln_ & 15, fq = ln_ >> 4;
        const int row0 = u.pm * 256 + wr * 64 + fr, hc0 = u.pn * 128 + wc * 32 + 8 * fq;
#pragma unroll
        for (int ai = 0; ai < 2; ++ai)
#pragma unroll
            for (int m = 0; m < 4; ++m) { const f32x4 a0 = acc[ai][0][m][0], a1 = acc[ai][0][m][1], b0 = acc[ai][1][m][0], b1 = acc[ai][1][m][1];
                u32x4 w; w.x = cvt_pk_bf16(siluf_(a0[0]) * b0[0], siluf_(a0[1]) * b0[1]); w.y = cvt_pk_bf16(siluf_(a0[2]) * b0[2], siluf_(a0[3]) * b0[3]);
                w.z = cvt_pk_bf16(siluf_(a1[0]) * b1[0], siluf_(a1[1]) * b1[1]); w.w = cvt_pk_bf16(siluf_(a1[2]) * b1[2], siluf_(a1[3]) * b1[3]);
                *(u32x4*)(O + (size_t)(row0 + ai * 128 + m * 16) * DFF + hc0) = w; }
    }
};
struct EpiResid {
    static constexpr bool PERM = true;
    _Float16* H; float* HC; const float* gate; const float* lng; const float* lnb; const float* stats;
    __device__ __forceinline__ void operator()(const f32x4 (&acc)[2][2][4][2], const pg8::Unit& u, int wr, int wc, int, int) const { const int ln_ = lane_now(); const int fr = ln_ & 15, fq = ln_ >> 4;
        int upm = u.pm, upn = u.pn; asm volatile("" : "+s"(upm), "+s"(upn));
        const int pp = upm % PPB, mi = (pp == 0) ? 4 : (upm / PPB);
        const int rl0 = wr * 64 + fr, col0 = upn * 256 + wc * 32 + 8 * fq;
        if (u.aux) {
            float* hc = (float*)((char*)HC - WS_HC + WS_YD) + ((size_t)(u.aux - 1) * (NB * CTX) + (size_t)(upm / PPB) * 256) * D;
#pragma unroll
            for (int bj = 0; bj < 2; ++bj) { const f32x4 gv0 = *(const f32x4*)(gate + (size_t)mi * NMOD + col0 + bj * 128), gv1 = *(const f32x4*)(gate + (size_t)mi * NMOD + col0 + bj * 128 + 4);
#pragma unroll
                for (int ai = 0; ai < 2; ++ai)
#pragma unroll
                    for (int m = 0; m < 4; ++m) { float* p = hc + (size_t)(rl0 + ai * 128 + m * 16) * D + col0 + bj * 128; *(f32x4*)p = gv0 * acc[ai][bj][m][0]; *(f32x4*)(p + 4) = gv1 * acc[ai][bj][m][1]; } }
            return;
        }
#pragma unroll
        for (int bj = 0; bj < 2; ++bj) { const int c = col0 + bj * 128;
            const f32x4 gv0 = *(const f32x4*)(gate + (size_t)mi * NMOD + c), gv1 = *(const f32x4*)(gate + (size_t)mi * NMOD + c + 4);
            const f32x4 g0 = *(const f32x4*)(lng + c) * DN_ALPHA, g1 = *(const f32x4*)(lng + c + 4) * DN_ALPHA, b0 = *(const f32x4*)(lnb + c) * DN_ALPHA, b1 = *(const f32x4*)(lnb + c + 4) * DN_ALPHA;
#pragma unroll
            for (int ai = 0; ai < 2; ++ai) {
                u32x4 tv[4]; f32x2 st[4];
#pragma unroll
                for (int m = 0; m < 4; ++m) { const size_t row = (size_t)(upm * 256 + rl0 + ai * 128 + m * 16); tv[m] = *(const u32x4*)(H + row * D + c); st[m] = *(const f32x2*)(stats + row * 2); }
                asm volatile("s_waitcnt vmcnt(0)" ::: "memory");
#pragma unroll
                for (int m = 0; m < 4; ++m) { const h16x4 ha = __builtin_bit_cast(h16x4, (u32x2){tv[m].x, tv[m].y}), hb = __builtin_bit_cast(h16x4, (u32x2){tv[m].z, tv[m].w});
                    const f32x4 t0 = (f32x4){(float)ha[0], (float)ha[1], (float)ha[2], (float)ha[3]}, t1 = (f32x4){(float)hb[0], (float)hb[1], (float)hb[2], (float)hb[3]};
                    const f32x4 o0 = (t0 - st[m].x) * st[m].y * g0 + b0 + gv0 * acc[ai][bj][m][0], o1 = (t1 - st[m].x) * st[m].y * g1 + b1 + gv1 * acc[ai][bj][m][1];
                    h16x4 qa, qb; qa[0] = (_Float16)o0[0]; qa[1] = (_Float16)o0[1]; qa[2] = (_Float16)o0[2]; qa[3] = (_Float16)o0[3]; qb[0] = (_Float16)o1[0]; qb[1] = (_Float16)o1[1]; qb[2] = (_Float16)o1[2]; qb[3] = (_Float16)o1[3];
                    const u32x2 pa = __builtin_bit_cast(u32x2, qa), pb = __builtin_bit_cast(u32x2, qb);
                    *(u32x4*)(H + (size_t)(upm * 256 + rl0 + ai * 128 + m * 16) * D + c) = (u32x4){pa.x, pa.y, pb.x, pb.y}; } } }
    }
};
struct EpiProj {
    static constexpr bool PERM = true;
    bf16_t* P; float* DT; const float* rc; const float* rs; bf16_t* U2;
    __device__ __forceinline__ void operator()(const f32x4 (&acc)[2][2][4][2], const pg8::Unit& u, int wr, int wc, int, int) const { const int ln_ = lane_now(); const int fr = ln_ & 15, fq = ln_ >> 4;
        const int pp = u.pm % PPB; const int row0 = u.pm * 256 + wr * 64 + fr;
        const int pn = u.pn;
        if (pn == 52) {
            if (wc == 0) {
#pragma unroll
                for (int ai = 0; ai < 2; ++ai)
#pragma unroll
                    for (int m = 0; m < 4; ++m)
#pragma unroll
                        for (int n = 0; n < 2; ++n) *(f32x4*)(DT + (size_t)(row0 + ai * 128 + m * 16) * 32 + 8 * fq + 4 * n) = acc[ai][0][m][n];
            }
            return;
        }
        if (pn >= 28) {
            const int jg = (pn - 28) >> 3, pnd = (pn - 28) & 7;
            unsigned char* gq = (unsigned char*)P - WS_PROJ + gq_off(jg) + ((size_t)((u.pm * 8 + pnd) * 512 + (wr * 4 + wc) * 64 + ln_)) * 128;
#pragma unroll
            for (int ai = 0; ai < 2; ++ai)
#pragma unroll
                for (int m = 0; m < 4; ++m) { u32x4 w;
#pragma unroll
                    for (int bj = 0; bj < 2; ++bj)
#pragma unroll
                        for (int n = 0; n < 2; ++n) { const f32x4 v = acc[ai][bj][m][n]; unsigned q = 0;
#pragma unroll
                            for (int e = 0; e < 4; ++e) q |= (unsigned)fmaxf(__builtin_rintf(sigmoidf_(v[e]) * 255.0f), 1.0f) << (8 * e);
                            w[bj * 2 + n] = q; }
                    *(u32x4*)(gq + (ai * 4 + m) * 16) = w; }
            return;
        }
        const int col0 = pn * 256 + wc * 32 + 4 * fq;
        const int mode = (pn < 8) ? ((pp != 0) ? 1 : 0) : ((pn >= 12 && pn < 16) ? 2 : 0);
        const float sc = (pn < 4) ? QSCALE : 1.0f;
#pragma unroll
        for (int ai = 0; ai < 2; ++ai) {
          f32x4 csv[4], snv[4];
          if (mode == 1) {
#pragma unroll
              for (int m = 0; m < 4; ++m) { const int rl = ai * 128 + wr * 64 + m * 16 + fr; const int t = (pp - 1) * 256 + rl; const int pos = (wc & 1) ? (t & 63) : (t >> 6); csv[m] = *(const f32x4*)(rc + pos * 16 + 4 * fq); snv[m] = *(const f32x4*)(rs + pos * 16 + 4 * fq); }
              asm volatile("s_waitcnt vmcnt(0)" ::: "memory"); }
#pragma unroll
            for (int m = 0; m < 4; ++m) { const int rl = ai * 128 + wr * 64 + m * 16 + fr; bf16_t* rowp = P + (size_t)(u.pm * 256 + rl) * LDP + col0;
                f32x4 cs = (f32x4){1.f, 1.f, 1.f, 1.f}, sn = (f32x4){0.f, 0.f, 0.f, 0.f};
                if (mode == 1) { cs = csv[m]; sn = snv[m]; }
#pragma unroll
                for (int bj = 0; bj < 2; ++bj) { f32x4 v0 = acc[ai][bj][m][0], v1 = acc[ai][bj][m][1];
                    if (mode == 1) { const f32x4 o0 = v0 * cs - v1 * sn, o1 = v1 * cs + v0 * sn; v0 = o0; v1 = o1; }
                    else if (mode == 2) {
#pragma unroll
                        for (int e = 0; e < 4; ++e) { v0[e] = siluf_(v0[e]); v1[e] = siluf_(v1[e]); } }
                    if (pn >= 24 && pn < 28) {
                        const int cu = (pn - 24) * 256 + bj * 128 + wc * 32 + 8 * fq;
                        bf16_t* u2 = U2 + ((size_t)(cu >> 4) * R + (size_t)(u.pm * 256 + rl)) * 16 + (cu & 15);
                        u32x4 a; a.x = cvt_pk_bf16(v0[0], v0[1]); a.y = cvt_pk_bf16(v0[2], v0[3]); a.z = cvt_pk_bf16(v1[0], v1[1]); a.w = cvt_pk_bf16(v1[2], v1[3]);
                        *(u32x4*)u2 = a; continue; }
                    v0 = v0 * sc; v1 = v1 * sc;
                    if (pn < 8) { u32x2 w0, w1; w0.x = cvt_pk_bf16(v0[0], v0[1]); w0.y = cvt_pk_bf16(v0[2], v0[3]); w1.x = cvt_pk_bf16(v1[0], v1[1]); w1.y = cvt_pk_bf16(v1[2], v1[3]);
                        *(u32x2*)(rowp + bj * 128) = w0; *(u32x2*)(rowp + bj * 128 + 16) = w1; }
                    else { u32x4 w; w.x = cvt_pk_bf16(v0[0], v0[1]); w.y = cvt_pk_bf16(v0[2], v0[3]); w.z = cvt_pk_bf16(v1[0], v1[1]); w.w = cvt_pk_bf16(v1[2], v1[3]);
                        *(u32x4*)(rowp + 4 * fq + bj * 128) = w; } } } }
    }
};
struct EpiGlu {
    static constexpr bool PERM = false;
    bf16_t* P; const float* bias;
    __device__ __forceinline__ void operator()(const f32x4 (&acc)[2][2][4][2], const pg8::Unit& u, int wr, int wc, int, int) const { const int ln_ = lane_now(); const int fr = ln_ & 15, fq = ln_ >> 4;
        const int row0 = u.pm * 256 + wr * 64 + fr, col0 = u.pn * 256 + wc * 32 + 4 * fq;
        f32x4 bv[2][2];
#pragma unroll
        for (int bj = 0; bj < 2; ++bj)
#pragma unroll
            for (int n = 0; n < 2; ++n) bv[bj][n] = *(const f32x4*)(bias + col0 + bj * 128 + n * 16);
#pragma unroll
        for (int ai = 0; ai < 2; ++ai) {
            u32x2 tv[4][2][2];
#pragma unroll
            for (int m = 0; m < 4; ++m)
#pragma unroll
                for (int bj = 0; bj < 2; ++bj)
#pragma unroll
                    for (int n = 0; n < 2; ++n) tv[m][bj][n] = *(const u32x2*)(P + (size_t)(row0 + ai * 128 + m * 16) * LDP + PU + col0 + bj * 128 + n * 16);
            asm volatile("s_waitcnt vmcnt(0)" ::: "memory");
#pragma unroll
            for (int m = 0; m < 4; ++m) { bf16_t* rowp = P + (size_t)(row0 + ai * 128 + m * 16) * LDP;
#pragma unroll
                for (int bj = 0; bj < 2; ++bj)
#pragma unroll
                    for (int n = 0; n < 2; ++n) { const int c = col0 + bj * 128 + n * 16; const u32x2 t = tv[m][bj][n];
                        const f32x4 a = acc[ai][bj][m][n] + bv[bj][n]; u32x2 w;
                        w.x = cvt_pk_bf16(bflo(t.x) * sigmoidf_(a[0]), bfhi(t.x) * sigmoidf_(a[1])); w.y = cvt_pk_bf16(bflo(t.y) * sigmoidf_(a[2]), bfhi(t.y) * sigmoidf_(a[3]));
                        *(u32x2*)(rowp + PK + c) = w; } } }
    }
};
struct EpiMerge {
    static constexpr bool PERM = true;
    const bf16_t* P; bf16_t* MIXB;
    static __device__ __forceinline__ int jmap(int seg) { return seg == 0 ? 0 : (seg == 1 ? 2 : 1); }
    __device__ __forceinline__ const unsigned char* gbase(const pg8::Unit& u, int seg, int wr, int wc, int ln_) const {
        return (const unsigned char*)P - WS_PROJ + gq_off(jmap(seg)) + ((size_t)((u.pm * 8 + u.pn) * 512 + (wr * 4 + wc) * 64 + ln_)) * 128; }
    __device__ __forceinline__ void mid(f32x4 (&acc)[2][2][4][2], const pg8::Unit& u, int seg, int wr, int wc) const {
        const int ln_ = lane_now(); const unsigned char* ga = gbase(u, seg - 1, wr, wc, ln_); const unsigned char* gb = gbase(u, seg, wr, wc, ln_);
        u32x4 a[2][4], b[2][4];
#pragma unroll
        for (int ai = 0; ai < 2; ++ai)
#pragma unroll
            for (int m = 0; m < 4; ++m) { a[ai][m] = *(const u32x4*)(ga + (ai * 4 + m) * 16); b[ai][m] = *(const u32x4*)(gb + (ai * 4 + m) * 16); }
        asm volatile("s_waitcnt vmcnt(0)" ::: "memory");
#pragma unroll
        for (int ai = 0; ai < 2; ++ai)
#pragma unroll
            for (int m = 0; m < 4; ++m)
#pragma unroll
                for (int bj = 0; bj < 2; ++bj)
#pragma unroll
                    for (int n = 0; n < 2; ++n) { const unsigned qa = a[ai][m][bj * 2 + n], qb = b[ai][m][bj * 2 + n]; f32x4 r;
#pragma unroll
                        for (int e = 0; e < 4; ++e) r[e] = (float)((qa >> (8 * e)) & 255u) * __builtin_amdgcn_rcpf((float)((qb >> (8 * e)) & 255u));
                        acc[ai][bj][m][n] = acc[ai][bj][m][n] * r; }
    }
    __device__ __forceinline__ void operator()(const f32x4 (&acc)[2][2][4][2], const pg8::Unit& u, int wr, int wc, int, int) const { const int ln_ = lane_now(); const int fr = ln_ & 15, fq = ln_ >> 4;
        const int row0 = u.pm * 256 + wr * 64 + fr, col0 = u.pn * 256 + wc * 32 + 8 * fq; const unsigned char* gl = gbase(u, 2, wr, wc, ln_);
        u32x4 gq[2][4];
#pragma unroll
        for (int ai = 0; ai < 2; ++ai)
#pragma unroll
            for (int m = 0; m < 4; ++m) gq[ai][m] = *(const u32x4*)(gl + (ai * 4 + m) * 16);
        asm volatile("s_waitcnt vmcnt(0)" ::: "memory");
#pragma unroll
        for (int ai = 0; ai < 2; ++ai)
#pragma unroll
            for (int m = 0; m < 4; ++m) { const size_t row = (size_t)(row0 + ai * 128 + m * 16); const u32x4 g4 = gq[ai][m];
#pragma unroll
                for (int bj = 0; bj < 2; ++bj) { u32x4 w;
#pragma unroll
                    for (int n = 0; n < 2; ++n) { const unsigned gv = g4[bj * 2 + n];
                        f32x4 v = acc[ai][bj][m][n];
#pragma unroll
                        for (int e = 0; e < 4; ++e) v[e] *= (float)((gv >> (8 * e)) & 255u) * (1.0f / 255.0f);
                        w[2 * n] = cvt_pk_bf16(v[0], v[1]); w[2 * n + 1] = cvt_pk_bf16(v[2], v[3]); }
                    *(u32x4*)(MIXB + row * D + col0 + bj * 128) = w; } }
    }
};

struct S5AOrder {
    int G, c; const char* A; const char* B;
    __device__ __forceinline__ bool next(int i, pg8::Unit& u) const {
        const int idx = i * G + c; if (idx >= 640) return false;
        const int g = idx / 10, r = idx - 10 * g, nt = r / 5, mt = r - 5 * nt;
        u.pm = mt; u.pn = nt; u.aux = g; u.kt = 4; u.a = A + ((size_t)g * (R / 16) + (size_t)mt * 256) * 256 * 2; u.b = B + (size_t)(g * 512 + nt * 256) * 256 * 2; return true;
    }
};
struct EpiS5A {
    static constexpr bool PERM = false;
    unsigned char* YLF; bf16_t* ST;
    __device__ __forceinline__ void operator()(const f32x4 (&acc)[2][2][4][2], const pg8::Unit& u, int wr, int wc, int, int) const { const int ln_ = lane_now(); const int fr = ln_ & 15, fq = ln_ >> 4;
        const int g = u.aux;
        if (u.pn == 0) { unsigned char* yl = YLF + ((size_t)((g * 5 + u.pm) * 512 + (wr * 4 + wc) * 64 + ln_)) * 256;
#pragma unroll
            for (int ai = 0; ai < 2; ++ai)
#pragma unroll
                for (int m = 0; m < 4; ++m) { u32x4 w0, w1;
                    w0.x = cvt_pk_bf16(acc[ai][0][m][0][0], acc[ai][0][m][0][1]); w0.y = cvt_pk_bf16(acc[ai][0][m][0][2], acc[ai][0][m][0][3]); w0.z = cvt_pk_bf16(acc[ai][0][m][1][0], acc[ai][0][m][1][1]); w0.w = cvt_pk_bf16(acc[ai][0][m][1][2], acc[ai][0][m][1][3]);
                    w1.x = cvt_pk_bf16(acc[ai][1][m][0][0], acc[ai][1][m][0][1]); w1.y = cvt_pk_bf16(acc[ai][1][m][0][2], acc[ai][1][m][0][3]); w1.z = cvt_pk_bf16(acc[ai][1][m][1][0], acc[ai][1][m][1][1]); w1.w = cvt_pk_bf16(acc[ai][1][m][1][2], acc[ai][1][m][1][3]);
                    *(u32x4*)(yl + (ai * 4 + m) * 32) = w0; *(u32x4*)(yl + (ai * 4 + m) * 32 + 16) = w1; }
            return; }
#pragma unroll
        for (int ai = 0; ai < 2; ++ai)
#pragma unroll
            for (int m = 0; m < 4; ++m) { const int mr = u.pm * 256 + ai * 128 + wr * 64 + m * 16 + fr; if (mr < S5M) {
#pragma unroll
                for (int bj = 0; bj < 2; ++bj)
#pragma unroll
                    for (int n = 0; n < 2; ++n) { const f32x4 v = acc[ai][bj][m][n];
                        u32x2 w; w.x = cvt_pk_bf16(v[0], v[1]); w.y = cvt_pk_bf16(v[2], v[3]); *(u32x2*)(ST + ((size_t)g * S5M + mr) * 256 + bj * 128 + wc * 32 + n * 16 + 4 * fq) = w; } } }
    }
};
struct S5COrder {
    int G, c; const char* A; const char* B;
    __device__ __forceinline__ bool next(int i, pg8::Unit& u) const {
        const int idx = i * G + c; if (idx >= 320) return false;
        const int g = idx / 5, mt = idx - 5 * g;
        u.pm = mt; u.pn = 0; u.aux = g; u.kt = 4; u.a = A + ((size_t)g * 1280 + mt * 256) * 256 * 2; u.b = B + (size_t)g * 256 * 256 * 2; return true;
    }
};
struct EpiS5C {
    static constexpr bool PERM = false;
    const unsigned char* YLF; bf16_t* P;
    __device__ __forceinline__ void operator()(const f32x4 (&acc)[2][2][4][2], const pg8::Unit& u, int wr, int wc, int, int) const { const int ln_ = lane_now(); const int fr = ln_ & 15, fq = ln_ >> 4;
        const int g = u.aux; const unsigned char* yl = YLF + ((size_t)((g * 5 + u.pm) * 512 + (wr * 4 + wc) * 64 + ln_)) * 256;
#pragma unroll
        for (int ai = 0; ai < 2; ++ai) {
        u32x4 y0[2][4], y1[2][4];
#pragma unroll
            for (int m = 0; m < 4; ++m) { y0[ai][m] = *(const u32x4*)(yl + (ai * 4 + m) * 32); y1[ai][m] = *(const u32x4*)(yl + (ai * 4 + m) * 32 + 16); }
        asm volatile("s_waitcnt vmcnt(0)" ::: "memory");
#pragma unroll
            for (int m = 0; m < 4; ++m) { const int mr = u.pm * 256 + ai * 128 + wr * 64 + m * 16 + fr; if (mr < S5M) {
#pragma unroll
                for (int bj = 0; bj < 2; ++bj)
#pragma unroll
                    for (int n = 0; n < 2; ++n) { const int rho = 8 * bj + 2 * wc + n; const size_t row = (size_t)(16 * mr + rho);
                        const u32x4 yy = bj ? y1[ai][m] : y0[ai][m]; const unsigned ya = n ? yy.z : yy.x, yb = n ? yy.w : yy.y; f32x4 v = acc[ai][bj][m][n];
                        v[0] += bflo(ya); v[1] += bfhi(ya); v[2] += bflo(yb); v[3] += bfhi(yb);
#pragma unroll
                        for (int e = 0; e < 4; ++e) { const float x = v[e]; const float inner = 0.7978845608028654f * (x + 0.044715f * x * x * x); const float th = 1.0f - 2.0f * __builtin_amdgcn_rcpf(1.0f + __builtin_amdgcn_exp2f(2.8853900817779268f * inner)); v[e] = 0.5f * x * (1.0f + th); }
                        u32x2 w; w.x = cvt_pk_bf16(v[0], v[1]); w.y = cvt_pk_bf16(v[2], v[3]); *(u32x2*)(P + row * LDP + PU + 16 * g + 4 * fq) = w; } } } }
    }
};

namespace attn128 {
using bf16 = __hip_bfloat16;
constexpr int NW = 8, QBLK = 32, KVBLK = 64, LDQ = LDP, LDK = LDP, LDOB = LDP;
constexpr size_t SHM_V = KVBLK * 128 * 2, SHM_K = KVBLK * 64 * 2, SHM_ATTN = 2 * SHM_V + 2 * SHM_K + NW * 64 * 4, SHM_TOTAL = SHM_ATTN + NW * 8192;
constexpr float THRL = 11.5f;
#define A128_KSWZ(row, colB) ((row) * 128 + ((colB) ^ (((row) & 7) << 4)))
#define A128_SBAR() __builtin_amdgcn_sched_barrier(0)
__device__ __forceinline__ int crow(int r, int hi) { return (r & 3) + 8 * (r >> 2) + 4 * hi; }
__device__ __forceinline__ void partialSM(f32x16& p0, f32x16& p1, float& m_reg, float& mn, float& alpha) {
  float pmax = p0[0];
#pragma unroll
  for (int r = 1; r < 16; ++r) pmax = fmaxf(pmax, p0[r]);
#pragma unroll
  for (int r = 0; r < 16; ++r) pmax = fmaxf(pmax, p1[r]);
  { auto rr = __builtin_amdgcn_permlane32_swap(__float_as_uint(pmax), __float_as_uint(pmax), false, false); pmax = fmaxf(__uint_as_float(rr[0]), __uint_as_float(rr[1])); }
  if (__builtin_expect(__all(pmax - m_reg <= THRL), 1)) { mn = m_reg; alpha = 1.f; }
  else { mn = fmaxf(m_reg, pmax); alpha = __builtin_amdgcn_exp2f(m_reg - mn); m_reg = mn; }
#pragma unroll
  for (int r = 0; r < 16; ++r) { p0[r] = p0[r] - mn; p1[r] = p1[r] - mn; }
#pragma unroll
  for (int r = 0; r < 16; ++r) p0[r] = __builtin_amdgcn_exp2f(p0[r]);
}
__device__ __forceinline__ void finishSM(f32x16& p0, f32x16& p1, float alpha, float& l_reg, bf16x8& pa0, bf16x8& pa1, bf16x8& pa2, bf16x8& pa3) {
#pragma unroll
  for (int r = 0; r < 16; ++r) p1[r] = __builtin_amdgcn_exp2f(p1[r]);
  float ps = 0;
#pragma unroll
  for (int r = 0; r < 16; ++r) ps += p0[r];
#pragma unroll
  for (int r = 0; r < 16; ++r) ps += p1[r];
  { auto rr = __builtin_amdgcn_permlane32_swap(__float_as_uint(ps), __float_as_uint(ps), false, false); ps = __uint_as_float(rr[0]) + __uint_as_float(rr[1]); }
  l_reg = l_reg * alpha + ps;
#define A128_PK4(P, BASE, OUT) do { unsigned a0 = cvt_pk_bf16(P[BASE + 0], P[BASE + 1]), a1 = cvt_pk_bf16(P[BASE + 2], P[BASE + 3]);   \
    unsigned b0 = cvt_pk_bf16(P[BASE + 4], P[BASE + 5]), b1 = cvt_pk_bf16(P[BASE + 6], P[BASE + 7]);                              \
    auto r0 = __builtin_amdgcn_permlane32_swap(a0, b0, false, false); auto r1 = __builtin_amdgcn_permlane32_swap(a1, b1, false, false); \
    u32x4 w = {r0[0], r1[0], r0[1], r1[1]}; OUT = __builtin_bit_cast(bf16x8, w); } while (0)
  A128_PK4(p0, 0, pa0); A128_PK4(p0, 8, pa1); A128_PK4(p1, 0, pa2); A128_PK4(p1, 8, pa3);
#undef A128_PK4
}
__device__ __forceinline__ void qkt(f32x16& p0, f32x16& p1, const char* Ks, const bf16x8* qr, int r32, int hi) {
#pragma unroll
  for (int i = 0; i < 16; ++i) { p0[i] = 0.f; p1[i] = 0.f; }
#pragma unroll
  for (int d0 = 0; d0 < 4; ++d0) { const int cb = (d0 * 16 + hi * 8) * 2;
    const bf16x8 b0 = *reinterpret_cast<const bf16x8*>(Ks + A128_KSWZ(r32, cb));
    const bf16x8 b1 = *reinterpret_cast<const bf16x8*>(Ks + A128_KSWZ(32 + r32, cb));
    p0 = __builtin_amdgcn_mfma_f32_32x32x16_bf16(b0, qr[d0], p0, 0, 0, 0);
    p1 = __builtin_amdgcn_mfma_f32_32x32x16_bf16(b1, qr[d0], p1, 0, 0, 0); }
}
__device__ __forceinline__ int v_st(int k, int c) { const int kk = (k & ~0xC) | ((k & 4) << 1) | ((k & 8) >> 1); return ((kk >> 3) * 4 + (c >> 5)) * 512 + ((kk & 7) * 32 + (c & 31)) * 2; }
__device__ __forceinline__ int v_rd_base(int lane) { return ((lane & 3) << 3) | (((lane >> 2) & 3) << 6) | (((lane >> 4) & 1) << 5) | (((lane >> 5) & 1) << 8); }
constexpr int v_rd_off(int d0, int ks, int half) { return d0 * 512 + ks * 4096 + half * 2048; }
template <int OFF> __device__ __forceinline__ s16x4 tr_read(int vb) { s16x4 r; asm volatile("ds_read_b64_tr_b16 %0, %1 offset:%2" : "=&v"(r) : "v"(vb), "i"(OFF) : "memory"); return r; }
template <int D0> __device__ __forceinline__ void pv_one(f32x16& od, int vb, bf16x8 pa0, bf16x8 pa1, bf16x8 pa2, bf16x8 pa3) {
  const s16x4 l0 = tr_read<v_rd_off(D0, 0, 0)>(vb), h0 = tr_read<v_rd_off(D0, 0, 1)>(vb), l1 = tr_read<v_rd_off(D0, 1, 0)>(vb), h1 = tr_read<v_rd_off(D0, 1, 1)>(vb);
  const s16x4 l2 = tr_read<v_rd_off(D0, 2, 0)>(vb), h2 = tr_read<v_rd_off(D0, 2, 1)>(vb), l3 = tr_read<v_rd_off(D0, 3, 0)>(vb), h3 = tr_read<v_rd_off(D0, 3, 1)>(vb);
  asm volatile("s_waitcnt lgkmcnt(0)" ::: "memory"); A128_SBAR();
#define A128_PK(L, H) (bf16x8){L[0], L[1], L[2], L[3], H[0], H[1], H[2], H[3]}
  od = __builtin_amdgcn_mfma_f32_32x32x16_bf16(pa0, A128_PK(l0, h0), od, 0, 0, 0);
  od = __builtin_amdgcn_mfma_f32_32x32x16_bf16(pa1, A128_PK(l1, h1), od, 0, 0, 0);
  od = __builtin_amdgcn_mfma_f32_32x32x16_bf16(pa2, A128_PK(l2, h2), od, 0, 0, 0);
  od = __builtin_amdgcn_mfma_f32_32x32x16_bf16(pa3, A128_PK(l3, h3), od, 0, 0, 0);
#undef A128_PK
}
__device__ __forceinline__ void pv_d0(f32x16* o, int vb, bf16x8 pa0, bf16x8 pa1, bf16x8 pa2, bf16x8 pa3) {
  pv_one<0>(o[0], vb, pa0, pa1, pa2, pa3); pv_one<1>(o[1], vb, pa0, pa1, pa2, pa3); pv_one<2>(o[2], vb, pa0, pa1, pa2, pa3); pv_one<3>(o[3], vb, pa0, pa1, pa2, pa3);
}
__device__ __forceinline__ void unit(const bf16* __restrict__ Qb0, const bf16* __restrict__ Kh0, const bf16* __restrict__ Vh, bf16_t* Ob, int seq, char* lds, const int tid_in, const float lam, const float onem, const float* __restrict__ subw) {
#pragma unroll 1
 for (int mp = 0; mp < 2; ++mp) {
  int tid = tid_in; asm volatile("" : "+v"(tid));
  bf16_t* stage = (bf16_t*)(lds + SHM_ATTN) + (tid >> 6) * 4096;
  const bf16* Qb = Qb0 + mp * 64; const bf16* Kh = Kh0 + mp * 64;
  const int wid = __builtin_amdgcn_readfirstlane(tid >> 6), lane = tid & 63, r32 = lane & 31, hi = lane >> 5;
  char* V_lds = lds; char* K_lds = lds + 2 * SHM_V;
  float* ws = (float*)(lds + 2 * SHM_V + 2 * SHM_K) + wid * 64; float* li_l = ws; float* al_l = ws + 32;
  float m_reg = -1e30f, l_reg = 0; f32x16 o[4]; bf16x8 qr[4];
#pragma unroll
  for (int d = 0; d < 4; ++d)
#pragma unroll
    for (int r = 0; r < 16; ++r) o[d][r] = 0.f;
  const bf16* Qw = Qb + (long)(wid * QBLK + r32) * LDQ + hi * 8;
#pragma unroll
  for (int d0 = 0; d0 < 4; ++d0) qr[d0] = *reinterpret_cast<const bf16x8*>(Qw + d0 * 16);
  const int sr = tid >> 4, sc = (tid & 15) * 8, vst0 = v_st(sr, sc), vst1 = v_st(32 + sr, sc);
  const int kr = tid >> 3, kc = (tid & 7) * 8, kst = A128_KSWZ(kr, kc * 2);
  const int vb0 = (int)(uintptr_t)V_lds + v_rd_base(lane);
  struct { bf16x8 vs0, vs1, ks0; } sr_[2];
#define A128_SLOAD(i, k0) do { sr_[i].vs0 = *reinterpret_cast<const bf16x8*>(&Vh[(long)((k0) + sr) * LDK + sc]); sr_[i].vs1 = *reinterpret_cast<const bf16x8*>(&Vh[(long)((k0) + 32 + sr) * LDK + sc]); \
    sr_[i].ks0 = *reinterpret_cast<const bf16x8*>(&Kh[(long)((k0) + kr) * LDK + kc]); } while (0)
#define A128_SWRITE(b, i) do { *(bf16x8*)(V_lds + (b) * SHM_V + vst0) = sr_[i].vs0; *(bf16x8*)(V_lds + (b) * SHM_V + vst1) = sr_[i].vs1; *(bf16x8*)(K_lds + (b) * SHM_K + kst) = sr_[i].ks0; } while (0)
#define A128_SWAIT() asm volatile("s_waitcnt vmcnt(3)" ::: "memory")
#define A128_RESC(a) do { if (__any((a) < 1.f)) { if (hi == 0) al_l[r32] = (a); asm volatile("s_waitcnt lgkmcnt(0)" ::: "memory"); \
    _Pragma("unroll") for (int d = 0; d < 4; ++d) _Pragma("unroll") for (int r = 0; r < 16; ++r) o[d][r] *= al_l[crow(r, hi)]; } } while (0)
  f32x16 pA0, pA1, pB0, pB1; float mnA, mnB, alA, alB; bf16x8 pa0, pa1, pa2, pa3; const int NT = seq / KVBLK;
  A128_SLOAD(0, 0); asm volatile("s_waitcnt vmcnt(0)" ::: "memory"); A128_SWRITE(0, 0); __syncthreads();
  qkt(pA0, pA1, K_lds, qr, r32, hi); partialSM(pA0, pA1, m_reg, mnA, alA);
  A128_SLOAD(1, KVBLK); if (2 < NT) A128_SLOAD(0, 2 * KVBLK);
  A128_SWAIT(); A128_SWRITE(1, 1); __syncthreads();
  for (int j = 1; j + 1 < NT; j += 2) {
    A128_SBAR(); qkt(pB0, pB1, K_lds + SHM_K, qr, r32, hi);
    finishSM(pA0, pA1, alA, l_reg, pa0, pa1, pa2, pa3); A128_SBAR();
    A128_SLOAD(1, (j + 2) * KVBLK); A128_SBAR();
    pv_d0(o, vb0, pa0, pa1, pa2, pa3); partialSM(pB0, pB1, m_reg, mnB, alB);
    __syncthreads(); A128_SWAIT(); A128_SWRITE(0, 0);
    A128_RESC(alB); __syncthreads();
    A128_SBAR(); qkt(pA0, pA1, K_lds, qr, r32, hi);
    finishSM(pB0, pB1, alB, l_reg, pa0, pa1, pa2, pa3); A128_SBAR();
    if (j + 3 < NT) A128_SLOAD(0, (j + 3) * KVBLK); A128_SBAR();
    pv_d0(o, vb0 + (int)SHM_V, pa0, pa1, pa2, pa3); partialSM(pA0, pA1, m_reg, mnA, alA);
    __syncthreads(); A128_SWAIT(); A128_SWRITE(1, 1);
    A128_RESC(alA); __syncthreads();
  }
  A128_SBAR(); qkt(pB0, pB1, K_lds + SHM_K, qr, r32, hi);
  finishSM(pA0, pA1, alA, l_reg, pa0, pa1, pa2, pa3); A128_SBAR();
  pv_d0(o, vb0, pa0, pa1, pa2, pa3); partialSM(pB0, pB1, m_reg, mnB, alB);
  __syncthreads(); A128_RESC(alB);
  finishSM(pB0, pB1, alB, l_reg, pa0, pa1, pa2, pa3); A128_SBAR();
  pv_d0(o, vb0 + (int)SHM_V, pa0, pa1, pa2, pa3);
  if (hi == 0) li_l[r32] = l_reg; asm volatile("s_waitcnt lgkmcnt(0)" ::: "memory");
  float rli[16];
#pragma unroll
  for (int r = 0; r < 16; ++r) rli[r] = __builtin_amdgcn_rcpf(li_l[crow(r, hi)]);
  if (mp == 0) {
#pragma unroll
    for (int r = 0; r < 16; ++r)
#pragma unroll
      for (int d0 = 0; d0 < 4; ++d0) stage[(r * 4 + d0) * 64 + lane] = (bf16_t)(cvt_pk_bf16(o[d0][r] * rli[r], 0.f) & 0xffffu);
  } else {
    float ss[16];
#pragma unroll
    for (int r = 0; r < 16; ++r) { float q = 0.f;
#pragma unroll
      for (int d0 = 0; d0 < 4; ++d0) { const float a = bf1(stage[(r * 4 + d0) * 64 + lane]) - lam * bf1((bf16_t)(cvt_pk_bf16(o[d0][r] * rli[r], 0.f) & 0xffffu)); o[d0][r] = a; q += a * a; }
      ss[r] = q; }
#pragma unroll
    for (int m = 1; m < 32; m <<= 1)
#pragma unroll
      for (int r = 0; r < 16; ++r) ss[r] += __int_as_float(__builtin_amdgcn_ds_bpermute((lane ^ m) << 2, __float_as_int(ss[r])));
    float sw[4];
#pragma unroll
    for (int d0 = 0; d0 < 4; ++d0) sw[d0] = subw[d0 * 32 + r32] * onem;
    bf16_t* Ow = Ob + (long)(wid * QBLK) * LDOB;
#pragma unroll
    for (int r = 0; r < 16; ++r) { const int orow = crow(r, hi); const float rs = 1.0f / sqrtf(ss[r] * (1.f / 128.f) + RMS_EPS);
#pragma unroll
      for (int d0 = 0; d0 < 4; ++d0) Ow[(long)orow * LDOB + d0 * 32 + r32] = (bf16_t)(cvt_pk_bf16(o[d0][r] * rs * sw[d0], 0.f) & 0xffffu); }
  }
  __syncthreads();
 }
#undef A128_SLOAD
#undef A128_SWRITE
#undef A128_SWAIT
#undef A128_RESC
}
#undef A128_KSWZ
#undef A128_SBAR
}

#define XB_TMO      128
#define XB_XCNT(j)  (256  + 64 * (j))
#define XB_XSUB(j)  (1280 + 64 * (j))
#define XB_XGEN(j)  (2304 + 64 * (j))
#define XB_TOP      3328
#define XB_TOPGEN   3392
#define XCD_BAR_WORDS 3456
#define XB_SPIN_CAP (1u << 18)
__device__ __forceinline__ unsigned xb_ld(unsigned* p)              { return __hip_atomic_load(p, __ATOMIC_RELAXED, __HIP_MEMORY_SCOPE_AGENT); }
__device__ __forceinline__ unsigned xb_add(unsigned* p, unsigned v) { return __hip_atomic_fetch_add(p, v, __ATOMIC_RELAXED, __HIP_MEMORY_SCOPE_AGENT); }
__device__ __forceinline__ unsigned xb_xcc_id() { return (unsigned)__builtin_amdgcn_s_getreg((3 << 11) | 20) & 0xFu; }
#define XB_SPIN(cond, bar) do { unsigned _sp = 0; while (cond) { __builtin_amdgcn_s_sleep(1); \
    if ((++_sp & 255u) == 0u) { if (xb_ld(&(bar)[XB_TMO])) break; if (_sp > XB_SPIN_CAP) { atomicAdd(&(bar)[XB_TMO], 1u); break; } } } } while (0)
struct XcdBarrier { unsigned* bar; unsigned x; volatile LAS unsigned* st; };
__device__ __forceinline__ XcdBarrier xcd_barrier_post(unsigned* bar, volatile LAS unsigned* st) {
    XcdBarrier b; b.bar = bar; b.x = xb_xcc_id(); b.st = st;
    if (threadIdx.x == 0) (void)xb_add(&bar[XB_XCNT(b.x)], 1u);
    return b;
}
__device__ __forceinline__ void xcd_barrier_complete(unsigned* bar, unsigned x, unsigned& nloc, unsigned& nx) {
    const unsigned G = gridDim.x * gridDim.y * gridDim.z;
    unsigned sum, cnt, mine, sp = 0u;
    for (;;) {
        sum = 0u; cnt = 0u; mine = 0u;
#pragma unroll
        for (unsigned j = 0; j < 16; ++j) { const unsigned c = xb_ld(&bar[XB_XCNT(j)]); sum += c; cnt += (c > 0u) ? 1u : 0u; mine = (j == x) ? c : mine; }
        if (sum == G) break;
        __builtin_amdgcn_s_sleep(1);
        if ((++sp & 255u) == 0u) { if (xb_ld(&bar[XB_TMO])) break; if (sp > XB_SPIN_CAP) { atomicAdd(&bar[XB_TMO], 1u); break; } }
    }
    nloc = mine > 0u ? mine : 1u; nx = cnt > 0u ? cnt : 1u;
}
__device__ __forceinline__ void xcd_barrier(const XcdBarrier& b, const int tid) {
    asm volatile("s_waitcnt vmcnt(0)" ::: "memory");
    __syncthreads();
    if (tid == 0) {
        unsigned* bar = b.bar;
        __builtin_amdgcn_s_waitcnt(0);
        unsigned nloc = b.st[0], nx = b.st[1];
        if (nloc == 0u) { xcd_barrier_complete(bar, b.x, nloc, nx); b.st[0] = nloc; b.st[1] = nx; }
        const unsigned old = xb_add(&bar[XB_XSUB(b.x)], 1u);
        const unsigned gen = old / nloc;
        if (old + 1u == (gen + 1u) * nloc) {
            __builtin_amdgcn_fence(__ATOMIC_RELEASE, "agent");
            asm volatile("s_waitcnt vmcnt(0)" ::: "memory");
            const unsigned og = xb_add(&bar[XB_TOP], 1u);
            const unsigned tg = og / nx;
            if (og + 1u == (tg + 1u) * nx) xb_add(&bar[XB_TOPGEN], 1u);
            else XB_SPIN(xb_ld(&bar[XB_TOPGEN]) == tg, bar);
            __builtin_amdgcn_fence(__ATOMIC_ACQUIRE, "agent");
            xb_add(&bar[XB_XGEN(b.x)], 1u);
            asm volatile("s_waitcnt vmcnt(0)" ::: "memory");
        } else {
            XB_SPIN(xb_ld(&bar[XB_XGEN(b.x)]) == gen, bar);
            __builtin_amdgcn_fence(__ATOMIC_ACQUIRE, "agent");
            asm volatile("s_waitcnt vmcnt(0)" ::: "memory");
        }
    }
    __syncthreads();
}

constexpr int NWAVES = 8;
constexpr int RING_OFF = 0, RING_BYTES = 131072;
constexpr int LDSCTL_OFF = RING_BYTES, MISC_OFF = LDSCTL_OFF + 320;
constexpr int LDS_BYTES = 147456;
static_assert(attn128::SHM_TOTAL <= (size_t)RING_BYTES, "attention scratch fits the ring");

struct Args { const float* in[32]; float* out; unsigned char* ws; int ph_lo, ph_hi; };
constexpr int INTAB_OFF = LDSCTL_OFF + 1024;
__device__ __forceinline__ const float* inptr(LAS unsigned char* lds, int i) {
    const unsigned long long v = ((const LAS unsigned long long*)(lds + INTAB_OFF))[i];
    const unsigned lo = __builtin_amdgcn_readfirstlane((unsigned)v), hi = __builtin_amdgcn_readfirstlane((unsigned)(v >> 32));
    return (const float*)(GAS const float*)(((unsigned long long)hi << 32) | lo);
}
#define INP(i) inptr(F.lds, (i))
struct Frame {
    LAS unsigned char* lds; int tid, lane, wave, vcu, G, gw, NGW;
    unsigned char* ws;
};
enum { I_X = 0, I_C, I_CTX, I_CCTX, I_WMOD, I_BMOD, I_LNG, I_LNB, I_W1, I_W3, I_W2, I_WIN, I_ALAM, I_ASUB, I_CONVW, I_CONVB, I_ALOG, I_DTB, I_SSDD, I_SSDN,
       I_LRE, I_LIM, I_LSTEP, I_BRE, I_BIM, I_CRE, I_CIM, I_S5D, I_GLUW, I_GLUB, I_WBR, I_WOUT };

__device__ __forceinline__ void transpose_item64(const float* srcA, const float* srcB, int ldn, bool p32, bf16_t* dst, int ldk, LAS bf16_t* scr  , int lane) {
    const int q = lane & 15, kr = lane >> 4; const bool isB = q >= 8; const int c = (q & 7) * 4; const float* src = isB ? srcB : srcA;
    f32x4 v[16];
#pragma unroll
    for (int i = 0; i < 16; ++i) v[i] = src ? *(const f32x4*)(src + (size_t)(4 * i + kr) * ldn + c) : (f32x4){0.f, 0.f, 0.f, 0.f};
    const int drow = (p32 ? pg8::perm32(c) : c) + (isB ? 32 : 0);
#pragma unroll
    for (int i = 0; i < 16; ++i) { const int k = 4 * i + kr; const unsigned p01 = cvt_pk_bf16(v[i][0], v[i][1]), p23 = cvt_pk_bf16(v[i][2], v[i][3]);
        scr[(drow + 0) * 72 + k] = (bf16_t)(p01 & 0xffffu); scr[(drow + 1) * 72 + k] = (bf16_t)(p01 >> 16); scr[(drow + 2) * 72 + k] = (bf16_t)(p23 & 0xffffu); scr[(drow + 3) * 72 + k] = (bf16_t)(p23 >> 16); }
    LDS_WAIT(); asm volatile("" ::: "memory");
    const int c8 = lane & 7;
#pragma unroll
    for (int jj = 0; jj < 8; ++jj) { const int n = (lane >> 3) + 8 * jj; *(u32x4*)(dst + (size_t)n * ldk + 8 * c8) = *(const LAS u32x4*)(scr + n * 72 + 8 * c8); }
    LDS_WAIT(); asm volatile("" ::: "memory");
}
__device__ __forceinline__ void convert_layer_weights(const Args& A_, Frame& F, int l) {
    LAS bf16_t* scr = (LAS bf16_t*)(F.lds + RING_OFF + F.wave * 16384);
    unsigned char* W = F.ws + WS_W;
    constexpr int I13 = 32 * 176, I2 = 88 * 32, IIN = 32 * 212, IB = 16 * 32, IO = 32 * 32, IG = 16 * 16;
    constexpr int NIT = 2 * I13 + 2 * I2 + IIN + 3 * IB + IO + IG;
    for (int it = F.gw; it < NIT; it += F.NGW) {
        int r = it;
        if (r < 2 * I13) { const int f = r / I13; r -= f * I13; const int kb = r / 176, nb = r % 176;
            const float* wsrc = (((nb & 3) < 2) ? INP(I_W1) : INP(I_W3)) + ((size_t)(l * 2 + f) * D + 64 * kb) * DFF + 128 * (nb >> 2) + 64 * (nb & 1);
            transpose_item64(wsrc, wsrc + 32, DFF, false, (bf16_t*)(W + W_13) + ((size_t)f * N13 + 64 * nb) * D + 64 * kb, D, scr, F.lane); continue; }
        r -= 2 * I13;
        if (r < 2 * I2) { const int f = r / I2; r -= f * I2; const int kb = r / 32, nb = r % 32;
            const float* w2 = INP(I_W2) + ((size_t)(l * 2 + f) * DFF + 64 * kb) * D + 64 * nb;
            transpose_item64(w2, w2 + 32, D, false, (bf16_t*)(W + W_2) + ((size_t)f * D + 64 * nb) * DFF + 64 * kb, DFF, scr, F.lane); continue; }
        r -= 2 * I2;
        if (r < IIN) { const int kb = r / 212, nb = r % 212; const int n0 = 64 * nb; const float* wb = INP(I_WIN) + ((size_t)l * D + 64 * kb) * 13344;
            const float* sa = nullptr; const float* sb = nullptr;
            if (n0 < 6144) { sa = wb + n0; sb = sa + 32; } else if (n0 < 13312) { sa = wb + n0 + 32; sb = sa + 32; } else if (n0 == 13312) { sa = wb + 6144; }
            transpose_item64(sa, sb, 13344, n0 < 2048, (bf16_t*)(W + W_IN) + (size_t)n0 * D + 64 * kb, D, scr, F.lane); continue; }
        r -= IIN;
        if (r < 3 * IB) { const int jb = r / IB; r -= jb * IB; const int kb = r / 32, nb = r % 32;
            const float* w = INP(I_WBR) + ((size_t)(l * 3 + jb) * 1024 + 64 * kb) * D + 64 * nb;
            const int sp = (jb == 0) ? 0 : (jb == 1 ? 2 : 1); transpose_item64(w, w + 32, D, false, (bf16_t*)(W + W_B) + (size_t)(64 * nb) * 3072 + sp * 1024 + 64 * kb, 3072, scr, F.lane); continue; }
        r -= 3 * IB;
        if (r < IO) { const int kb = r / 32, nb = r % 32; const float* w = INP(I_WOUT) + ((size_t)l * D + 64 * kb) * D + 64 * nb;
            transpose_item64(w, w + 32, D, false, (bf16_t*)(W + W_O) + (size_t)(64 * nb) * D + 64 * kb, D, scr, F.lane); continue; }
        r -= IO;
        { const int kb = r / 16, nb = r % 16; const float* w = INP(I_GLUW) + ((size_t)l * 1024 + 64 * kb) * 1024 + 64 * nb;
            transpose_item64(w, w + 32, 1024, false, (bf16_t*)(W + W_GLU) + (size_t)(64 * nb) * 1024 + 64 * kb, 1024, scr, F.lane); }
    }
}
__device__ __forceinline__ void mod_partials(const Args& A_, Frame& F) {
    float* MODw = (float*)(F.ws + WS_MOD);
    LAS float* sl = (LAS float*)(F.lds + RING_OFF + 98304 + F.wave * 4096);
    const int nskip = (F.G > 64) ? 64 : 0; if ((int)blockIdx.x < nskip) return;
    for (int it = ((int)blockIdx.x - nskip) * NWAVES + F.wave; it < 2 * 72 * 16; it += (F.G - nskip) * NWAVES) {
        const int l = it / (72 * 16), r = it % (72 * 16), ks = r / 72, cg = r % 72;
        const int col = cg * 256 + F.lane * 4; const float* w = INP(I_WMOD) + ((size_t)l * D + ks * 128) * NMOD + col;
        const float* c = INP(I_C) + ks * 128; const float* cc = INP(I_CCTX) + ks * 128;
#pragma unroll
        for (int h = 0; h < 2; ++h) { const int k = F.lane + 64 * h;
            sl[0 * 128 + k] = siluf_(c[k]); sl[1 * 128 + k] = siluf_(c[D + k]); sl[2 * 128 + k] = siluf_(c[2 * D + k]); sl[3 * 128 + k] = siluf_(c[3 * D + k]); sl[4 * 128 + k] = siluf_(cc[k]); }
        LDS_WAIT(); asm volatile("" ::: "memory");
        f32x4 a0 = {0.f, 0.f, 0.f, 0.f}, a1 = a0, a2 = a0, a3 = a0, a4 = a0;
        for (int k0 = 0; k0 < 128; k0 += 16) {
            f32x4 wv[16];
#pragma unroll
            for (int e = 0; e < 16; ++e) wv[e] = *(const f32x4*)(w + (size_t)(k0 + e) * NMOD);
            asm volatile("s_waitcnt vmcnt(0)" ::: "memory");
#pragma unroll
            for (int e = 0; e < 16; ++e) { a0 += wv[e] * sl[0 * 128 + k0 + e]; a1 += wv[e] * sl[1 * 128 + k0 + e]; a2 += wv[e] * sl[2 * 128 + k0 + e]; a3 += wv[e] * sl[3 * 128 + k0 + e]; a4 += wv[e] * sl[4 * 128 + k0 + e]; }
        }
        const int r9 = col / D; const float sc = (r9 == 2 || r9 == 8) ? 0.5f : 1.0f;
        if (ks == 0) { const f32x4 bv = *(const f32x4*)(INP(I_BMOD) + (size_t)l * NMOD + col); a0 += bv; a1 += bv; a2 += bv; a3 += bv; a4 += bv; }
        float* o = MODw + (size_t)l * 5 * NMOD + col;
#pragma unroll
        for (int e = 0; e < 4; ++e) { unsafeAtomicAdd(o + e, a0[e] * sc); unsafeAtomicAdd(o + NMOD + e, a1[e] * sc); unsafeAtomicAdd(o + 2 * NMOD + e, a2[e] * sc); unsafeAtomicAdd(o + 3 * NMOD + e, a3[e] * sc); unsafeAtomicAdd(o + 4 * NMOD + e, a4[e] * sc); }
        LDS_WAIT(); asm volatile("" ::: "memory");
    }
}
__device__ __forceinline__ void ln_pass(Frame& F, bool do_ln, const float* lng, const float* lnb, const float* modnext  , float* out, const float* xin = nullptr, const float* cin = nullptr, int nslab = 0) {
#define LNCO(i) (512 * ((i) >> 1) + 8 * F.lane + 4 * ((i) & 1))
    _Float16* H = (_Float16*)(F.ws + WS_H); const float* SL = (const float*)(F.ws + WS_YD); float* HC = (float*)(F.ws + WS_HC); bf16_t* HM = (bf16_t*)(F.ws + WS_HM); float* ST = (float*)(F.ws + WS_STATS);
    f32x4 G[8], Bv[8];
    if (do_ln) {
#pragma unroll
        for (int i = 0; i < 8; ++i) { G[i] = *(const f32x4*)(lng + LNCO(i)); Bv[i] = *(const f32x4*)(lnb + LNCO(i)); }
    }
    const int nper = F.NGW / NB; f32x4 sh4[8], sc4[8];
    for (int it = 0; it < SEQ / nper + 1; ++it) {
        int b = F.gw / nper, rr = CTX + (F.gw % nper) + nper * it;
        if (it == SEQ / nper) { if (F.gw >= NB * CTX) break; b = F.gw / CTX; rr = F.gw % CTX; }
        const int row = b * RB + rr; const bool isctx = rr < CTX; const int mi = isctx ? 4 : b;
        float* hc = HC + ((size_t)b * CTX + rr) * D; _Float16* hr = H + (size_t)row * D;
        f32x4 v[8]; float s = 0.f;
        if (xin) { const float* src = isctx ? cin + ((size_t)b * CTX + rr) * D : xin + ((size_t)b * SEQ + (rr - CTX)) * D;
#pragma unroll
            for (int i = 0; i < 8; ++i) v[i] = *(const f32x4*)(src + LNCO(i));
        } else if (isctx) {
#pragma unroll
            for (int i = 0; i < 8; ++i) v[i] = *(const f32x4*)(hc + LNCO(i));
            if (nslab) {
#pragma unroll 1
                for (int q = 0; q < 4; ++q) { f32x4 sv[8];
#pragma unroll
                    for (int i = 0; i < 8; ++i) sv[i] = *(const f32x4*)(SL + ((size_t)q * (NB * CTX) + (size_t)b * CTX + rr) * D + LNCO(i));
#pragma unroll
                    for (int i = 0; i < 8; ++i) v[i] = v[i] + sv[i]; } }
        } else {
#pragma unroll
            for (int k = 0; k < 4; ++k) { const h16x8 h = *(const h16x8*)(hr + LNCO(2 * k)); v[2 * k] = (f32x4){(float)h[0], (float)h[1], (float)h[2], (float)h[3]}; v[2 * k + 1] = (f32x4){(float)h[4], (float)h[5], (float)h[6], (float)h[7]}; }
        }
        if (modnext && (it == 0 || it == SEQ / nper)) { const float* sh = modnext + (size_t)mi * NMOD; const float* sc = sh + D;
#pragma unroll
            for (int i = 0; i < 8; ++i) { sh4[i] = *(const f32x4*)(sh + LNCO(i)); sc4[i] = *(const f32x4*)(sc + LNCO(i)); } }
        asm volatile("s_waitcnt vmcnt(0)" ::: "memory");
#pragma unroll
        for (int i = 0; i < 8; ++i) s += (v[i][0] + v[i][1]) + (v[i][2] + v[i][3]);
        if (do_ln) {
            const float mean = wave_sum(s, F.lane) * (1.f / D); float s2 = 0.f;
#pragma unroll
            for (int i = 0; i < 8; ++i) { v[i] = v[i] - mean; s2 += (v[i][0] * v[i][0] + v[i][1] * v[i][1]) + (v[i][2] * v[i][2] + v[i][3] * v[i][3]); }
            const float rstd = 1.0f / sqrtf(wave_sum(s2, F.lane) * (1.f / D) + LN_EPS);
            if (!isctx && F.lane == 0) *(f32x2*)(ST + (size_t)row * 2) = (f32x2){mean, rstd};
#pragma unroll
            for (int i = 0; i < 8; ++i) { v[i] = v[i] * rstd * G[i] + Bv[i]; if (isctx) *(f32x4*)(hc + LNCO(i)) = v[i] * DN_ALPHA; }
        } else if (isctx) {
#pragma unroll
            for (int i = 0; i < 8; ++i) *(f32x4*)(hc + LNCO(i)) = v[i] * DN_ALPHA;
        } else {
#pragma unroll
            for (int k = 0; k < 4; ++k) { h16x8 h;
#pragma unroll
                for (int e = 0; e < 4; ++e) { h[e] = (_Float16)v[2 * k][e]; h[4 + e] = (_Float16)v[2 * k + 1][e]; }
                *(h16x8*)(hr + LNCO(2 * k)) = h; }
            if (F.lane == 0) *(f32x2*)(ST + (size_t)row * 2) = (f32x2){0.f, 1.f};
        }
        if (modnext) {
#pragma unroll
            for (int k = 0; k < 4; ++k) { const f32x4 m0 = v[2 * k] * (sc4[2 * k] + 1.0f) + sh4[2 * k], m1 = v[2 * k + 1] * (sc4[2 * k + 1] + 1.0f) + sh4[2 * k + 1];
                u32x4 w; w.x = cvt_pk_bf16(m0[0], m0[1]); w.y = cvt_pk_bf16(m0[2], m0[3]); w.z = cvt_pk_bf16(m1[0], m1[1]); w.w = cvt_pk_bf16(m1[2], m1[3]); *(u32x4*)(HM + (size_t)row * D + LNCO(2 * k)) = w; }
        }
        if (out && !isctx) { float* orow = out + ((size_t)b * SEQ + (rr - CTX)) * D;
#pragma unroll
            for (int i = 0; i < 8; ++i) *(f32x4*)(orow + LNCO(i)) = v[i]; }
    }
}
#undef LNCO

__device__ __forceinline__ void dt_tile(Frame& F, int l, int tile) {
    const bf16_t* A = (const bf16_t*)(F.ws + WS_HM) + (size_t)tile * 32 * D; const bf16_t* Bt = (const bf16_t*)(F.ws + WS_W + W_IN) + (size_t)13312 * D; float* DT = (float*)(F.ws + WS_DT);
    const int r = F.lane & 31, h = F.lane >> 5;
    f32x16 acc;
#pragma unroll
    for (int i = 0; i < 16; ++i) acc[i] = 0.f;
    const bf16_t* ap = A + (size_t)r * D + 8 * h; const bf16_t* bp = Bt + (size_t)r * D + 8 * h;
    for (int k0 = 0; k0 < 128; k0 += 16) {
        bf16x8 af[16], bfv[16];
#pragma unroll
        for (int e = 0; e < 16; ++e) { af[e] = *(const bf16x8*)(ap + 16 * (k0 + e)); bfv[e] = *(const bf16x8*)(bp + 16 * (k0 + e)); }
#pragma unroll
        for (int e = 0; e < 16; ++e) acc = __builtin_amdgcn_mfma_f32_32x32x16_bf16(af[e], bfv[e], acc, 0, 0, 0);
    }
    const float bias = INP(I_DTB)[l * 32 + r];
#pragma unroll
    for (int rg = 0; rg < 16; ++rg) { const int row = tile * 32 + (rg & 3) + 8 * (rg >> 2) + 4 * h; const float x = acc[rg] + bias; DT[(size_t)row * 32 + r] = fmaxf(x, 0.f) + log1pf(expf(-fabsf(x))); }
}
__device__ __forceinline__ void ssd_conv_pass(const Args& A_, Frame& F, int l) {
    const bf16_t* P = (const bf16_t*)(F.ws + WS_PROJ); bf16_t* XC = (bf16_t*)(F.ws + WS_HM);
    const float* cw = INP(I_CONVW) + (size_t)l * 5 * 2048; const float* cb = INP(I_CONVB) + (size_t)l * 2048;
    for (int it = F.gw; it < (R / 8) * 4; it += F.NGW) {
        const int r0 = (it >> 2) * 8, c0 = (it & 3) * 512 + F.lane * 8; const int rr0 = r0 % RB; const int lo = (rr0 < CTX) ? 0 : CTX, hi = (rr0 < CTX) ? CTX : RB;
        u32x4 x[12];
#pragma unroll
        for (int h = 0; h < 12; ++h) { const int r2 = rr0 + h - 2; x[h] = (r2 >= lo && r2 < hi) ? *(const u32x4*)(P + (size_t)(r0 + h - 2) * LDP + PX + c0) : (u32x4){0u, 0u, 0u, 0u}; }
        f32x4 w0[5], w1[5];
#pragma unroll
        for (int k = 0; k < 5; ++k) { w0[k] = *(const f32x4*)(cw + k * 2048 + c0); w1[k] = *(const f32x4*)(cw + k * 2048 + c0 + 4); }
        const f32x4 b0 = *(const f32x4*)(cb + c0), b1 = *(const f32x4*)(cb + c0 + 4);
#pragma unroll
        for (int jr = 0; jr < 8; ++jr) { f32x4 a0 = b0, a1 = b1;
#pragma unroll
            for (int k = 0; k < 5; ++k) { const u32x4 xv = x[jr + k];
                a0[0] += w0[k][0] * bflo(xv.x); a0[1] += w0[k][1] * bfhi(xv.x); a0[2] += w0[k][2] * bflo(xv.y); a0[3] += w0[k][3] * bfhi(xv.y);
                a1[0] += w1[k][0] * bflo(xv.z); a1[1] += w1[k][1] * bfhi(xv.z); a1[2] += w1[k][2] * bflo(xv.w); a1[3] += w1[k][3] * bfhi(xv.w); }
            u32x4 o; o.x = cvt_pk_bf16(siluf_(a0[0]), siluf_(a0[1])); o.y = cvt_pk_bf16(siluf_(a0[2]), siluf_(a0[3])); o.z = cvt_pk_bf16(siluf_(a1[0]), siluf_(a1[1])); o.w = cvt_pk_bf16(siluf_(a1[2]), siluf_(a1[3]));
            *(u32x4*)(XC + (size_t)(r0 + jr) * 2048 + c0) = o; }
    }
}
__device__ __forceinline__ int scan_row(int rb, int d, int step) { return d == 0 ? rb + step : (step < CTX ? rb + CTX - 1 - step : rb + (RB + CTX - 1) - step); }

__device__ __forceinline__ unsigned short bf16_1(float v) { return (unsigned short)(cvt_pk_bf16(v, 0.f) & 0xffffu); }
__device__ __forceinline__ void ssd_chain_fast(const Args& A_, Frame& F, int l, int cid) {
    constexpr int LS = 136;
    const int b = cid >> 6, d = (cid >> 5) & 1, hd = (cid >> 1) & 15, ph = cid & 1, g = hd >> 2; const int rb = b * RB;
    const bf16_t* XC = (const bf16_t*)(F.ws + WS_HM); const float* DT = (const float*)(F.ws + WS_DT); bf16_t* YD = (bf16_t*)(F.ws + WS_YD) + (size_t)d * R * 1024;
    const float a = -expf(INP(I_ALOG)[l * 32 + d * 16 + hd]);
    LAS bf16_t* Cs = (LAS bf16_t*)(F.lds); LAS bf16_t* Bs = Cs + 128 * LS; LAS bf16_t* Ms = Bs + 128 * LS; LAS bf16_t* XdT = Ms + 128 * LS; LAS bf16_t* Hb = XdT + 32 * LS;
    LAS float* csL = (LAS float*)(Hb + 32 * LS); LAS float* ecsL = csL + 128; LAS float* ewL = ecsL + 128; LAS float* misc = ewL + 128;
    const int tid = F.tid, lane = F.lane, w = F.wave, r = lane & 31, h = lane >> 5;
    f32x16 hacc;
#pragma unroll
    for (int i = 0; i < 16; ++i) hacc[i] = 0.f;
    for (int i = tid; i < 32 * LS / 2; i += 512) ((LAS unsigned*)Hb)[i] = 0u;
    u32x4 pc[4], pb[4], px; float pdt, pv0 = 0.f, pv1 = 0.f;
    const int rho0 = d ? 127 - lane : lane, rho1 = d ? 63 - lane : 64 + lane;
#define SSD_R0(k_) ((d == 0) ? rb + 128 * (k_) : ((k_) < 2 ? rb + 128 * (1 - (k_)) : rb + 256 + 128 * (33 - (k_))))
#define SSD_ISSUE(k_) do { const int r0n = SSD_R0(k_); \
        _Pragma("unroll") for (int i = 0; i < 4; ++i) { const int item = tid + 512 * i, row = item >> 4, seg = item & 15; const bf16_t* src = XC + (size_t)(r0n + row) * 2048 + g * 128 + seg * 8; pc[i] = *(const u32x4*)(src + 1536); pb[i] = *(const u32x4*)(src + 1024); } \
        { const int row = tid >> 2, seg = tid & 3; pdt = DT[(size_t)(r0n + row) * 32 + d * 16 + hd]; px = *(const u32x4*)(XC + (size_t)(r0n + row) * 2048 + hd * 64 + ph * 32 + seg * 8); } \
        if (w == 0) { pv0 = DT[(size_t)(r0n + rho0) * 32 + d * 16 + hd]; pv1 = DT[(size_t)(r0n + rho1) * 32 + d * 16 + hd]; } } while (0)
    SSD_ISSUE(0);
    unsigned ypk[8]; int yrow = -1;
#pragma unroll
    for (int i = 0; i < 8; ++i) ypk[i] = 0u;
#define SSD_YFLUSH() do { if (w < 4 && yrow >= 0) { bf16_t* yo = YD + (size_t)yrow * 1024 + hd * 64 + ph * 32 + r; \
        _Pragma("unroll") for (int rg = 0; rg < 16; ++rg) yo[(size_t)((rg & 3) + 8 * (rg >> 2)) * 1024] = (bf16_t)((rg & 1) ? (ypk[rg >> 1] >> 16) : (ypk[rg >> 1] & 0xffffu)); } } while (0)
    for (int k = 0; k < 34; ++k) {
        const int r0 = SSD_R0(k);
        __syncthreads();
#pragma unroll
        for (int i = 0; i < 4; ++i) { const int item = tid + 512 * i, row = item >> 4, seg = item & 15; *(LAS u32x4*)(Cs + row * LS + seg * 8) = pc[i]; *(LAS u32x4*)(Bs + row * LS + seg * 8) = pb[i]; }
        { const int row = tid >> 2, seg = tid & 3; const float dtv = pdt; const u32x4 xv = px;
            LAS bf16_t* xo = XdT + (seg * 8) * LS + row;
            xo[0 * LS] = bf16_1(bflo(xv.x) * dtv); xo[1 * LS] = bf16_1(bfhi(xv.x) * dtv); xo[2 * LS] = bf16_1(bflo(xv.y) * dtv); xo[3 * LS] = bf16_1(bfhi(xv.y) * dtv);
            xo[4 * LS] = bf16_1(bflo(xv.z) * dtv); xo[5 * LS] = bf16_1(bfhi(xv.z) * dtv); xo[6 * LS] = bf16_1(bflo(xv.w) * dtv); xo[7 * LS] = bf16_1(bfhi(xv.w) * dtv); }
        if (w == 0) {
            float v0 = pv0 * a, v1 = pv1 * a;
#pragma unroll
            for (int o = 1; o < 64; o <<= 1) { const float t0 = __int_as_float(__builtin_amdgcn_ds_bpermute((lane - o) << 2, __float_as_int(v0))), t1 = __int_as_float(__builtin_amdgcn_ds_bpermute((lane - o) << 2, __float_as_int(v1))); if (lane >= o) { v0 += t0; v1 += t1; } }
            const float tot0 = __int_as_float(__builtin_amdgcn_ds_bpermute(63 << 2, __float_as_int(v0))); v1 += tot0;
            const float cend = __int_as_float(__builtin_amdgcn_ds_bpermute(63 << 2, __float_as_int(v1)));
            csL[rho0] = v0; csL[rho1] = v1; ecsL[rho0] = __builtin_amdgcn_exp2f(v0 * 1.4426950408889634f); ecsL[rho1] = __builtin_amdgcn_exp2f(v1 * 1.4426950408889634f);
            ewL[rho0] = __builtin_amdgcn_exp2f((cend - v0) * 1.4426950408889634f); ewL[rho1] = __builtin_amdgcn_exp2f((cend - v1) * 1.4426950408889634f);
            if (lane == 0) misc[0] = __builtin_amdgcn_exp2f(cend * 1.4426950408889634f);
        }
        if (k + 1 < 34) SSD_ISSUE(k + 1);
        __syncthreads();
        { const int lt = w >> 1;
#pragma unroll
          for (int q = 0; q < 2; ++q) { const int st = (w & 1) * 2 + q; const bool zero = (d == 0) ? (st > lt) : (st < lt);
            f32x16 acc;
#pragma unroll
            for (int i = 0; i < 16; ++i) acc[i] = 0.f;
            if (!zero) { bf16x8 af[8], bfv[8];
#pragma unroll
                for (int ks = 0; ks < 8; ++ks) { af[ks] = *(const LAS bf16x8*)(Cs + (32 * lt + r) * LS + 16 * ks + 8 * h); bfv[ks] = *(const LAS bf16x8*)(Bs + (32 * st + r) * LS + 16 * ks + 8 * h); }
#pragma unroll
                for (int ks = 0; ks < 8; ++ks) acc = __builtin_amdgcn_mfma_f32_32x32x16_bf16(af[ks], bfv[ks], acc, 0, 0, 0); }
            const int scol = 32 * st + r; const float css = csL[scol];
            f32x4 cr4[4];
#pragma unroll
            for (int q4 = 0; q4 < 4; ++q4) cr4[q4] = *(const LAS f32x4*)(csL + 32 * lt + 8 * q4 + 4 * h);
#pragma unroll
            for (int rg = 0; rg < 16; ++rg) { const int lrow = 32 * lt + (rg & 3) + 8 * (rg >> 2) + 4 * h; const bool valid = (d == 0) ? (scol <= lrow) : (scol >= lrow);
                const float ex = __builtin_amdgcn_exp2f(fminf(cr4[rg >> 2][rg & 3] - css, 0.f) * 1.4426950408889634f);
                const float v = valid ? acc[rg] * ex : 0.f; Ms[lrow * LS + scol] = bf16_1(v); } } }
        __syncthreads();
        if (w < 4) { const int lt = w;
            f32x16 acc;
#pragma unroll
            for (int i = 0; i < 16; ++i) acc[i] = 0.f;
            { bf16x8 af[8], bfv[8];
#pragma unroll
              for (int ks = 0; ks < 8; ++ks) { af[ks] = *(const LAS bf16x8*)(Cs + (32 * lt + r) * LS + 16 * ks + 8 * h); bfv[ks] = *(const LAS bf16x8*)(Hb + r * LS + 16 * ks + 8 * h); }
#pragma unroll
              for (int ks = 0; ks < 8; ++ks) acc = __builtin_amdgcn_mfma_f32_32x32x16_bf16(af[ks], bfv[ks], acc, 0, 0, 0); }
            { f32x4 e4[4];
#pragma unroll
              for (int q4 = 0; q4 < 4; ++q4) e4[q4] = *(const LAS f32x4*)(ecsL + 32 * lt + 8 * q4 + 4 * h);
#pragma unroll
              for (int rg = 0; rg < 16; ++rg) acc[rg] *= e4[rg >> 2][rg & 3]; }
            { bf16x8 af[8], bfv[8];
#pragma unroll
              for (int ks = 0; ks < 8; ++ks) { af[ks] = *(const LAS bf16x8*)(Ms + (32 * lt + r) * LS + 16 * ks + 8 * h); bfv[ks] = *(const LAS bf16x8*)(XdT + r * LS + 16 * ks + 8 * h); }
#pragma unroll
              for (int ks = 0; ks < 8; ++ks) { const bool skip = (d == 0) ? (16 * ks >= 32 * (lt + 1)) : (16 * ks + 15 < 32 * lt);
                  if (!skip) acc = __builtin_amdgcn_mfma_f32_32x32x16_bf16(af[ks], bfv[ks], acc, 0, 0, 0); } }
            bf16_t* yo = YD + (size_t)(r0 + 32 * lt + 4 * h) * 1024 + hd * 64 + ph * 32 + r;
#pragma unroll
            for (int rg = 0; rg < 16; ++rg) yo[(size_t)((rg & 3) + 8 * (rg >> 2)) * 1024] = bf16_1(acc[rg]);
        } else { const int nt = w - 4; const float eend = misc[0];
#pragma unroll
            for (int i = 0; i < 16; ++i) hacc[i] *= eend;
            { typedef short v4i16_t_ __attribute__((ext_vector_type(4)));
#pragma unroll
              for (int kh = 0; kh < 2; ++kh) {
              u32x4 xa[8]; f32x4 e0[8], e1[8]; s16x4 t0[8], t1[8];
#pragma unroll
              for (int ks = 4 * kh; ks < 4 * kh + 4; ++ks) { const int k0 = 16 * ks + 8 * h; xa[ks] = *(const LAS u32x4*)(XdT + r * LS + k0); e0[ks] = *(const LAS f32x4*)(ewL + k0); e1[ks] = *(const LAS f32x4*)(ewL + k0 + 4);
                  const LAS bf16_t* tb = Bs + (k0 + ((lane & 15) >> 2)) * LS + 32 * nt + 16 * ((lane >> 4) & 1) + 4 * (lane & 3);
                  t0[ks] = __builtin_bit_cast(s16x4, __builtin_amdgcn_ds_read_tr16_b64_v4i16((LAS v4i16_t_*)tb)); t1[ks] = __builtin_bit_cast(s16x4, __builtin_amdgcn_ds_read_tr16_b64_v4i16((LAS v4i16_t_*)(tb + 4 * LS))); }
#pragma unroll
              for (int ks = 4 * kh; ks < 4 * kh + 4; ++ks) { u32x4 aw;
                  aw.x = cvt_pk_bf16(bflo(xa[ks].x) * e0[ks][0], bfhi(xa[ks].x) * e0[ks][1]); aw.y = cvt_pk_bf16(bflo(xa[ks].y) * e0[ks][2], bfhi(xa[ks].y) * e0[ks][3]); aw.z = cvt_pk_bf16(bflo(xa[ks].z) * e1[ks][0], bfhi(xa[ks].z) * e1[ks][1]); aw.w = cvt_pk_bf16(bflo(xa[ks].w) * e1[ks][2], bfhi(xa[ks].w) * e1[ks][3]);
                  const bf16x8 bw = (bf16x8){t0[ks][0], t0[ks][1], t0[ks][2], t0[ks][3], t1[ks][0], t1[ks][1], t1[ks][2], t1[ks][3]};
                  hacc = __builtin_amdgcn_mfma_f32_32x32x16_bf16(__builtin_bit_cast(bf16x8, aw), bw, hacc, 0, 0, 0); } } }
        }
        __syncthreads();
        if (w >= 4) { const int nt = w - 4;
#pragma unroll
            for (int rg = 0; rg < 16; ++rg) Hb[((rg & 3) + 8 * (rg >> 2) + 4 * h) * LS + 32 * nt + r] = bf16_1(hacc[rg]); }
    }
    __syncthreads();
#undef SSD_R0
#undef SSD_ISSUE
#undef SSD_YFLUSH
}
__device__ __forceinline__ void s5_setup(const Args& A_, Frame& F, int l, int boff = 0) {
    LAS float* Pre = (LAS float*)(F.lds); LAS float* Pim = Pre + 2 * 17 * 64; LAS float* BBr = Pim + 2 * 17 * 64; LAS float* BBi = BBr + 2 * 64 * 16; LAS float* Kt = BBi + 2 * 64 * 16;
    LAS float* CrL = Kt + 8192; LAS float* CiL = CrL + 2048; LAS float* CrT = CiL + 2048; LAS float* CiT = CrT + 2048;
    bf16_t* Bt1 = (bf16_t*)(F.ws + WS_S5M); bf16_t* Bt2 = Bt1 + (size_t)64 * 512 * 256; float* A16 = (float*)(F.ws + WS_S5A);
    const int tid = F.tid;
    for (int g = (int)blockIdx.x - boff; g >= 0 && g < 64; g += F.G) {
        { f32x4 c4[2];
#pragma unroll
          for (int h = 0; h < 2; ++h) { const int e4 = tid * 4 & 1023, d = (tid >> 8); const int pg_ = (l * 2 + d) * 64 + g; c4[h] = *(const f32x4*)((h ? INP(I_CIM) : INP(I_CRE)) + (size_t)pg_ * 1024 + e4); }
          *(LAS f32x4*)(CrL + tid * 4) = c4[0]; *(LAS f32x4*)(CiL + tid * 4) = c4[1];
          const int d = tid >> 8, o = (tid & 255) >> 4, n4 = (tid & 15) * 4;
#pragma unroll
          for (int e = 0; e < 4; ++e) { CrT[(d * 64 + n4 + e) * 16 + o] = c4[0][e]; CiT[(d * 64 + n4 + e) * 16 + o] = c4[1][e]; } }
        for (int q = tid; q < 2 * 17 * 64; q += 512) { const int d = q / (17 * 64), dl = (q >> 6) % 17, n = q & 63; const int pg_ = (l * 2 + d) * 64 + g;
            const float lre = INP(I_LRE)[pg_ * 64 + n], lim = INP(I_LIM)[pg_ * 64 + n], step = expf(INP(I_LSTEP)[pg_]);
            const float mag = expf(lre * step * (float)dl), ang = lim * step * (float)dl; Pre[q] = mag * cosf(ang); Pim[q] = mag * sinf(ang); }
        __syncthreads();
        if (tid < 128) { const int d = tid >> 6, n = tid & 63; const int pg_ = (l * 2 + d) * 64 + g;
            const float lre = INP(I_LRE)[pg_ * 64 + n], lim = INP(I_LIM)[pg_ * 64 + n];
            const float abr = Pre[(d * 17 + 1) * 64 + n], abi = Pim[(d * 17 + 1) * 64 + n];
            const float den = lre * lre + lim * lim; const float kre = ((abr - 1.f) * lre + abi * lim) / den, kim = (abi * lre - (abr - 1.f) * lim) / den;
            const float* br = INP(I_BRE) + ((size_t)pg_ * 64 + n) * 16; const float* bi = INP(I_BIM) + ((size_t)pg_ * 64 + n) * 16;
            f32x4 bq[4], bz[4];
#pragma unroll
            for (int q = 0; q < 4; ++q) { bq[q] = *(const f32x4*)(br + 4 * q); bz[q] = *(const f32x4*)(bi + 4 * q); }
#pragma unroll
            for (int i = 0; i < 16; ++i) { const float x = bq[i >> 2][i & 3], y = bz[i >> 2][i & 3]; BBr[(d * 64 + n) * 16 + i] = kre * x - kim * y; BBi[(d * 64 + n) * 16 + i] = kre * y + kim * x; }
            A16[((d * 64 + g) * 64 + n) * 2] = Pre[(d * 17 + 16) * 64 + n]; A16[((d * 64 + g) * 64 + n) * 2 + 1] = Pim[(d * 17 + 16) * 64 + n]; }
        __syncthreads();
        { const int d = tid >> 8, dl = (tid >> 4) & 15, i = tid & 15;
            f32x4 acc[4] = {{0.f, 0.f, 0.f, 0.f}, {0.f, 0.f, 0.f, 0.f}, {0.f, 0.f, 0.f, 0.f}, {0.f, 0.f, 0.f, 0.f}};
            for (int n = 0; n < 64; ++n) { const float pr = Pre[(d * 17 + dl) * 64 + n], pi = Pim[(d * 17 + dl) * 64 + n], br = BBr[(d * 64 + n) * 16 + i], bi = BBi[(d * 64 + n) * 16 + i];
                const float tr = pr * br - pi * bi, ti = pr * bi + pi * br;
#pragma unroll
                for (int o4 = 0; o4 < 4; ++o4) { const f32x4 cr = *(const LAS f32x4*)(CrT + (d * 64 + n) * 16 + 4 * o4), ci = *(const LAS f32x4*)(CiT + (d * 64 + n) * 16 + 4 * o4); acc[o4] += cr * tr - ci * ti; } }
#pragma unroll
            for (int o = 0; o < 16; ++o) Kt[((d * 16 + dl) * 16 + o) * 16 + i] = acc[o >> 2][o & 3]; }
        __syncthreads();
        const float dsk = INP(I_S5D)[l * 1024 + 16 * g + (tid & 15)];
        for (int q = 0; q < 16; ++q) { const int item = tid + 512 * q; const int c1 = item >> 5, kb = (item & 31) * 8; const int rin = kb >> 4, i0 = kb & 15, rout = c1 >> 4, o = c1 & 15;
            const float dsko = __int_as_float(__builtin_amdgcn_ds_bpermute((((F.lane & ~15) | o)) << 2, __float_as_int(dsk)));
            float v[8];
#pragma unroll
            for (int e = 0; e < 8; ++e) { const int i = i0 + e; float x = 0.f; if (rout >= rin) x += Kt[((0 * 16 + (rout - rin)) * 16 + o) * 16 + i]; if (rin >= rout) x += Kt[((1 * 16 + (rin - rout)) * 16 + o) * 16 + i];
                if (rin == rout && i == o) x += dsko; v[e] = x; }
            u32x4 w; w.x = cvt_pk_bf16(v[0], v[1]); w.y = cvt_pk_bf16(v[2], v[3]); w.z = cvt_pk_bf16(v[4], v[5]); w.w = cvt_pk_bf16(v[6], v[7]);
            *(u32x4*)(Bt1 + ((size_t)g * 512 + c1) * 256 + kb) = w; }
        for (int q = 0; q < 16; ++q) { const int item = tid + 512 * q; const int c1 = item >> 5, kb = (item & 31) * 8; const int rin = kb >> 4, i0 = kb & 15; const int d = c1 >> 7, part = c1 & 1, n = (c1 >> 1) & 63;
            const int ex = (d == 0) ? 15 - rin : rin; const float pr = Pre[(d * 17 + ex) * 64 + n], pi = Pim[(d * 17 + ex) * 64 + n];
            float v[8];
#pragma unroll
            for (int e = 0; e < 8; ++e) { const float br = BBr[(d * 64 + n) * 16 + i0 + e], bi = BBi[(d * 64 + n) * 16 + i0 + e]; v[e] = part ? (pr * bi + pi * br) : (pr * br - pi * bi); }
            u32x4 w; w.x = cvt_pk_bf16(v[0], v[1]); w.y = cvt_pk_bf16(v[2], v[3]); w.z = cvt_pk_bf16(v[4], v[5]); w.w = cvt_pk_bf16(v[6], v[7]);
            *(u32x4*)(Bt1 + ((size_t)g * 512 + 256 + c1) * 256 + kb) = w; }
        for (int q = 0; q < 16; ++q) { const int item = tid + 512 * q; const int c2 = item >> 5, kb = (item & 31) * 8; const int rout = c2 >> 4, o = c2 & 15; const int d = kb >> 7, part = (kb >> 6) & 1, n0 = kb & 63;
            const int ex = (d == 0) ? rout + 1 : 16 - rout; const LAS float* cr = CrL + (d * 16 + o) * 64 + n0; const LAS float* ci = CiL + (d * 16 + o) * 64 + n0;
            float v[8];
#pragma unroll
            for (int e = 0; e < 8; ++e) { const float pr = Pre[(d * 17 + ex) * 64 + n0 + e], pi = Pim[(d * 17 + ex) * 64 + n0 + e]; v[e] = part ? -(cr[e] * pi + ci[e] * pr) : (cr[e] * pr - ci[e] * pi); }
            u32x4 w; w.x = cvt_pk_bf16(v[0], v[1]); w.y = cvt_pk_bf16(v[2], v[3]); w.z = cvt_pk_bf16(v[4], v[5]); w.w = cvt_pk_bf16(v[6], v[7]);
            *(u32x4*)(Bt2 + ((size_t)g * 256 + c2) * 256 + kb) = w; }
        __syncthreads();
    }
}
__device__ __forceinline__ void s5_carry(Frame& F, int cid) {
    const int b = cid >> 7, d = (cid >> 6) & 1, g = cid & 63, n = F.lane;
    const unsigned* ST = (const unsigned*)((const bf16_t*)(F.ws + WS_S5ST) + ((size_t)g * S5M + b * 272) * 256 + d * 128) + n;
    bf16_t* HP = (bf16_t*)(F.ws + WS_S5H) + ((size_t)g * 1280 + b * 272) * 256 + d * 128 + n;
    const float* A16 = (const float*)(F.ws + WS_S5A); const float ar = A16[((d * 64 + g) * 64 + n) * 2], ai = A16[((d * 64 + g) * 64 + n) * 2 + 1];
    float hr = 0.f, hi_ = 0.f;
    for (int k0 = 0; k0 < 272; k0 += 34) {
        unsigned wv[34];
#pragma unroll
        for (int e = 0; e < 34; ++e) { const int k = k0 + e; const int cc = (d == 0) ? k : (k < 16 ? 15 - k : 287 - k); wv[e] = ST[(size_t)cc * 128]; }
        asm volatile("s_waitcnt vmcnt(0)" ::: "memory");
#pragma unroll
        for (int e = 0; e < 34; ++e) { const int k = k0 + e; const int cc = (d == 0) ? k : (k < 16 ? 15 - k : 287 - k);
            HP[(size_t)cc * 256] = (bf16_t)(cvt_pk_bf16(hr, 0.f) & 0xffffu); HP[(size_t)cc * 256 + 64] = (bf16_t)(cvt_pk_bf16(hi_, 0.f) & 0xffffu);
            const float sr = bflo(wv[e]), si = bfhi(wv[e]); const float nr = ar * hr - ai * hi_ + sr, ni = ar * hi_ + ai * hr + si; hr = nr; hi_ = ni; }
    }
}
__device__ __forceinline__ void mixer_finalize(const Args& A_, Frame& F, int l) {
    bf16_t* P = (bf16_t*)(F.ws + WS_PROJ);
    const bf16_t* XC = (const bf16_t*)(F.ws + WS_HM); const bf16_t* YD0 = (const bf16_t*)(F.ws + WS_YD); const bf16_t* YD1 = YD0 + (size_t)R * 1024;
        const int c0 = F.lane * 16;
    for (int row = F.gw; row < R; row += F.NGW) {
        { const float dsk = INP(I_SSDD)[l * 16 + (c0 >> 6)];
          const float* nwp = INP(I_SSDN) + l * 1024 + c0;
          float v[16];
#pragma unroll
          for (int hh = 0; hh < 2; ++hh) { const u32x4 x = *(const u32x4*)(XC + (size_t)row * 2048 + c0 + 8 * hh), y0 = *(const u32x4*)(YD0 + (size_t)row * 1024 + c0 + 8 * hh), y1 = *(const u32x4*)(YD1 + (size_t)row * 1024 + c0 + 8 * hh), z = *(const u32x4*)(P + (size_t)row * LDP + PZ + c0 + 8 * hh);
#define SG(i, wx, wy0, wy1, wz) v[8 * hh + 2 * (i)] = (bflo(wx) * dsk + bflo(wy0) + bflo(wy1)) * bflo(wz); v[8 * hh + 2 * (i) + 1] = (bfhi(wx) * dsk + bfhi(wy0) + bfhi(wy1)) * bfhi(wz);
              SG(0, x.x, y0.x, y1.x, z.x) SG(1, x.y, y0.y, y1.y, z.y) SG(2, x.z, y0.z, y1.z, z.z) SG(3, x.w, y0.w, y1.w, z.w)
#undef SG
          }
          float ss = 0.f;
#pragma unroll
          for (int e = 0; e < 16; ++e) ss += v[e] * v[e];
          ss += shx(ss, 1, F.lane); ss += shx(ss, 2, F.lane); ss += shx(ss, 4, F.lane); ss += shx(ss, 8, F.lane);
          const float rs = 1.0f / sqrtf(ss * (1.f / 256.f) + RMS_EPS);
          const f32x4 n0 = *(const f32x4*)(nwp), n1 = *(const f32x4*)(nwp + 4), n2 = *(const f32x4*)(nwp + 8), n3 = *(const f32x4*)(nwp + 12);
          const float nw[16] = {n0[0], n0[1], n0[2], n0[3], n1[0], n1[1], n1[2], n1[3], n2[0], n2[1], n2[2], n2[3], n3[0], n3[1], n3[2], n3[3]};
          u32x4 o0, o1;
          o0.x = cvt_pk_bf16(v[0] * rs * nw[0], v[1] * rs * nw[1]); o0.y = cvt_pk_bf16(v[2] * rs * nw[2], v[3] * rs * nw[3]); o0.z = cvt_pk_bf16(v[4] * rs * nw[4], v[5] * rs * nw[5]); o0.w = cvt_pk_bf16(v[6] * rs * nw[6], v[7] * rs * nw[7]);
          o1.x = cvt_pk_bf16(v[8] * rs * nw[8], v[9] * rs * nw[9]); o1.y = cvt_pk_bf16(v[10] * rs * nw[10], v[11] * rs * nw[11]); o1.z = cvt_pk_bf16(v[12] * rs * nw[12], v[13] * rs * nw[13]); o1.w = cvt_pk_bf16(v[14] * rs * nw[14], v[15] * rs * nw[15]);
          *(u32x4*)(P + (size_t)row * LDP + PV + c0) = o0; *(u32x4*)(P + (size_t)row * LDP + PV + c0 + 8) = o1; }
    }
}


__global__ void __launch_bounds__(NWAVES * 64, 2) trunk_fwd(Args args) {
    extern __shared__ __attribute__((aligned(16))) unsigned char lds_raw[];
    Frame F;
    F.lds = (LAS unsigned char*)lds_raw;
    F.tid = threadIdx.x; F.lane = F.tid & 63; F.wave = __builtin_amdgcn_readfirstlane(F.tid >> 6);
    F.G = gridDim.x; { const int bx = blockIdx.x; F.vcu = (F.G % 8 == 0) ? (bx % 8) * (F.G / 8) + bx / 8 : bx; }
    F.gw = F.vcu * NWAVES + F.wave; F.NGW = F.G * NWAVES;
    F.ws = args.ws;
    volatile LAS unsigned* MISC = (volatile LAS unsigned*)(F.lds + MISC_OFF);
    for (int u = F.tid; u < (LDS_BYTES - LDSCTL_OFF) / 4; u += NWAVES * 64) ((LAS unsigned*)(F.lds + LDSCTL_OFF))[u] = 0u;
    __syncthreads();
    if (threadIdx.x < 32) ((LAS unsigned long long*)(F.lds + INTAB_OFF))[threadIdx.x] = (unsigned long long)args.in[threadIdx.x];
    __syncthreads();
    (void)xcd_barrier_post((unsigned*)(args.ws + WS_CTL) + CW_BAR, MISC + 8);
    const int lo = args.ph_lo, hi = args.ph_hi;
    const int wave0 = __builtin_amdgcn_readfirstlane((int)threadIdx.x >> 6);
    int pid = 0;
#define PH_BEGIN if (pid >= lo && pid < hi) { GAS unsigned char* wsg_ = (GAS unsigned char*)args.ws; int tid_; asm volatile("v_mbcnt_lo_u32_b32 %1, -1, 0\n\tv_mbcnt_hi_u32_b32 %1, -1, %1 ; PHASE_MARK_BEGIN %2" : "+s"(wsg_), "=v"(tid_) : "i"(__LINE__) : "memory"); tid_ += wave0 * 64; unsigned char* ws = (unsigned char*)wsg_; F.ws = ws; F.tid = tid_; F.lane = tid_ & 63; F.wave = __builtin_amdgcn_readfirstlane(tid_ >> 6); F.gw = F.vcu * NWAVES + F.wave;
#define PH_END   asm volatile("; PHASE_MARK_END %0" :: "i"(__LINE__)); if (pid + 1 < hi) { XcdBarrier bar_; bar_.bar = (unsigned*)(args.ws + WS_CTL) + CW_BAR; bar_.x = xb_xcc_id(); bar_.st = (volatile LAS unsigned*)(F.lds + MISC_OFF) + 8; xcd_barrier(bar_, wave0 * 64 + lane_now()); } } ++pid;

#define MOD ((float*)(ws + WS_MOD))
#define Hbuf ((float*)(ws + WS_H))
#define HM ((bf16_t*)(ws + WS_HM))
#define PROJ ((bf16_t*)(ws + WS_PROJ))
#define ROPEC ((float*)(ws + WS_ROPE))
#define ROPES (ROPEC + 1024)
#define WGT (ws + WS_W)

    PH_BEGIN
        s5_setup(args, F, 0);
        mod_partials(args, F);
        if ((int)blockIdx.x == F.G - 1) {
            { float* idn = (float*)(ws + WS_IDENT); for (int i = F.tid; i < 2048; i += NWAVES * 64) { idn[i] = 1.0f; idn[2048 + i] = 0.0f; } }
#pragma unroll
            for (int i2 = 0; i2 < 2; ++i2) { const int idx = (F.wave * 2 + i2) * 64 + F.lane, pos = idx >> 4, f = idx & 15; const float inv = powf(10000.0f, -(float)f / 16.0f); const float ang = (float)pos * inv; ROPEC[idx] = cosf(ang); ROPES[idx] = sinf(ang); } }
    PH_END
    PH_BEGIN
        convert_layer_weights(args, F, 0);
        ln_pass(F, false, nullptr, nullptr, MOD, nullptr, INP(I_X), INP(I_CTX));
    PH_END

    for (int s = 0; s < 6; ++s) {
        const int l = s / 3, j = s - 3 * l;
        if (j != 1) {
            const int f = j >> 1;
            PH_BEGIN
                const int lat = (l == 1 && j == 2); pg8::Gemm g{D, D, D}; pg8::StaticOrder S; S.init(lat ? 64 : NPAN, N13 / 256, F.G, (int)blockIdx.x, HM, D, (const bf16_t*)(WGT + W_13) + (size_t)f * N13 * D, D, D, lat);
                EpiSwiGLU E{PROJ};
                pg8::gemm_phase<EpiSwiGLU, pg8::StaticOrder>(F.lds + RING_OFF, g, S, E, F.tid);
            PH_END
        } else {
            PH_BEGIN
                pg8::Gemm g{D, D, D}; pg8::StaticOrder S;
                if (l == 0) S.init(NPAN, LDP / 256, F.G, (int)blockIdx.x, HM, D, (const bf16_t*)(WGT + W_IN), D, D);
                else { S.init(64, LDP / 256, F.G, (int)blockIdx.x, HM, D, (const bf16_t*)(WGT + W_IN), D, D, 1, 80); S.cproj = 1; }
                EpiProj E{PROJ, (float*)(ws + WS_DT), ROPEC, ROPES, (bf16_t*)(ws + WS_O)};
                pg8::gemm_phase<EpiProj, pg8::StaticOrder>(F.lds + RING_OFF, g, S, E, F.tid);
                { const int nfull = ((l == 0 ? NPAN * (LDP / 256) : 64 * (LDP / 256) + 80)) % F.G;
                  if ((int)blockIdx.x >= nfull) { const int nw = (F.G - nfull) * NWAVES; for (int t = ((int)blockIdx.x - nfull) * NWAVES + F.wave; t < R / 32; t += nw) dt_tile(F, l, t); } }
            PH_END
            PH_BEGIN
                ssd_conv_pass(args, F, l);
                asm volatile("" : "+v"(F.tid));
                { pg8::Gemm g{256, 256, 256}; S5AOrder S{F.G, (int)blockIdx.x, (const char*)(ws + WS_O), (const char*)(ws + WS_S5M)};
                  EpiS5A E{(unsigned char*)(ws + WS_YS), (bf16_t*)(ws + WS_S5ST)};
                  pg8::gemm_phase<EpiS5A, S5AOrder>(F.lds + RING_OFF, g, S, E, F.tid); }
            PH_END
            PH_BEGIN
                if (F.wave < 2) s5_carry(F, (int)blockIdx.x * 2 + F.wave);
                ssd_chain_fast(args, F, l, (int)blockIdx.x);
                {
                    const float lam_init = 0.8f - 0.6f * expf(-0.3f * (float)l);
                    const float* lv = INP(I_ALAM) + l * 256;
                    const float s01 = wave_sum(lv[F.lane] * lv[64 + F.lane], F.lane), s23 = wave_sum(lv[128 + F.lane] * lv[192 + F.lane], F.lane);
                    const float lam = expf(s01) - expf(s23) + lam_init;
                    for (int i = 0;; ++i) { const int idx = i * F.G + F.vcu; if (idx >= 512 + (l == 0 ? 32 : 0)) break;
                        int b, h, q0, seq;
                        if (idx < 512) { b = idx >> 7; h = (idx >> 4) & 7; q0 = b * RB + CTX + (idx & 15) * 256; seq = RB; }
                        else { const int k = idx - 512; b = k >> 3; h = k & 7; q0 = b * RB; seq = CTX; }
                        const bf16_t* Q0 = PROJ + (size_t)q0 * LDP + PQ + h * 128; const bf16_t* Kh = PROJ + (size_t)(b * RB) * LDP + PK + h * 128; const bf16_t* Vh = PROJ + (size_t)(b * RB) * LDP + PV + h * 128;
                        attn128::unit((const attn128::bf16*)Q0, (const attn128::bf16*)Kh, (const attn128::bf16*)Vh, PROJ + (size_t)q0 * LDP + PQ + h * 128, seq, (char*)lds_raw + RING_OFF, F.tid, lam, 1.0f - lam_init, INP(I_ASUB) + l * 128);
                    }
                }
            PH_END
            PH_BEGIN
                mixer_finalize(args, F, l);
                asm volatile("" : "+v"(F.tid));
                { pg8::Gemm g{256, 256, 256}; S5COrder S{F.G, (int)blockIdx.x, (const char*)(ws + WS_S5H), (const char*)((bf16_t*)(ws + WS_S5M) + (size_t)64 * 512 * 256)};
                  EpiS5C E{(const unsigned char*)(ws + WS_YS), PROJ};
                  pg8::gemm_phase<EpiS5C, S5COrder>(F.lds + RING_OFF, g, S, E, F.tid); }
            PH_END
            PH_BEGIN
                pg8::Gemm g{LDP, 1024, 1024}; pg8::StaticOrder S; S.init(l == 1 ? 64 : NPAN, 4, F.G, (int)blockIdx.x, PROJ + PU, LDP, (const bf16_t*)(WGT + W_GLU), 1024, 1024, l == 1);
                EpiGlu E{PROJ, INP(I_GLUB) + l * 1024};
                pg8::gemm_phase<EpiGlu, pg8::StaticOrder>(F.lds + RING_OFF, g, S, E, F.tid);
            PH_END
            PH_BEGIN
                pg8::Gemm g{LDP, 3072, 3072}; pg8::StaticOrder S; S.init(l == 1 ? 64 : NPAN, 8, F.G, (int)blockIdx.x, PROJ, LDP, (const bf16_t*)(WGT + W_B), 3072, 3072, l == 1);
                EpiMerge E{PROJ, HM};
                pg8::gemm_phase<EpiMerge, pg8::StaticOrder, 0, true>(F.lds + RING_OFF, g, S, E, F.tid);
            PH_END
        }
        PH_BEGIN
            const int RK = (j == 1) ? D : DFF; const bf16_t* RA = (j == 1) ? HM : PROJ; const bf16_t* RBt = (j == 1) ? (const bf16_t*)(WGT + W_O) : (const bf16_t*)(WGT + W_2) + (size_t)(j >> 1) * D * DFF;
            const int lat = (l == 1 && j >= 1); pg8::Gemm g{RK, RK, RK}; pg8::StaticOrder S; S.init(64, D / 256, F.G, (int)blockIdx.x, RA, RK, RBt, RK, RK, 1, lat ? 0 : 128);
            const float* lg_ = (s == 0) ? (const float*)(ws + WS_IDENT) : INP(I_LNG) + (size_t)(s - 1) * D; const float* lb_ = (s == 0) ? (const float*)(ws + WS_IDENT) + 2048 : INP(I_LNB) + (size_t)(s - 1) * D;
            EpiResid E{(_Float16*)(ws + WS_H), (float*)(ws + WS_HC), MOD + (size_t)l * 5 * NMOD + (3 * j + 2) * D, lg_, lb_, (const float*)(ws + WS_STATS)};
            pg8::gemm_phase<EpiResid, pg8::StaticOrder>(F.lds + RING_OFF, g, S, E, F.tid);
        PH_END
        PH_BEGIN
            const bool fin = (s == 5);
            const int ln_ = (j == 2) ? l + 1 : l, jn = (j == 2) ? 0 : j + 1;
            ln_pass(F, true, INP(I_LNG) + (size_t)(l * 3 + j) * D, INP(I_LNB) + (size_t)(l * 3 + j) * D, fin ? nullptr : MOD + (size_t)ln_ * 5 * NMOD + 3 * jn * D, fin ? args.out : nullptr, nullptr, nullptr, (l == 1 && j >= 1) ? 0 : 4);
            if (s == 2) { s5_setup(args, F, 1); __syncthreads(); convert_layer_weights(args, F, 1); }
        PH_END
    }
#undef PH_BEGIN
#undef PH_END
}

static int count_phases() { int n = 2; for (int s = 0; s < 6; ++s) n += ((s % 3) != 1 ? 1 : 6) + 2; return n; }
extern "C" void kernel_launch(void* const* d_in, const int* in_sizes, int n_in, void* d_out, int out_size, void* d_ws, size_t ws_size, hipStream_t stream) {
    static int grid = 0;
    if (grid == 0) {
        if (n_in != 32 || out_size != NB * SEQ * D || ws_size < WS_END) { fprintf(stderr, "kernel_launch: unexpected shapes (n_in %d, out %d, ws %zu < %zu)\n", n_in, out_size, ws_size, (size_t)WS_END); grid = -1; return; }
        int dev = 0, cus = 0, per_cu = 0;
        if (hipGetDevice(&dev) != hipSuccess || hipDeviceGetAttribute(&cus, hipDeviceAttributeMultiprocessorCount, dev) != hipSuccess) { grid = -1; return; }
        if (hipFuncSetAttribute((const void*)trunk_fwd, hipFuncAttributeMaxDynamicSharedMemorySize, LDS_BYTES) != hipSuccess) { fprintf(stderr, "kernel_launch: hipFuncSetAttribute failed\n"); grid = -1; return; }
        if (hipOccupancyMaxActiveBlocksPerMultiprocessor(&per_cu, (const void*)trunk_fwd, NWAVES * 64, LDS_BYTES) != hipSuccess || per_cu < 1) fprintf(stderr, "kernel_launch: occupancy query says %d\n", per_cu);
        (void)hipGetLastError();
        if (cus != 256) { fprintf(stderr, "kernel_launch: this kernel deals its SSD chains / carries / attention units over exactly 256 workgroups (one per CU); device reports %d CUs; nothing launched\n", cus); grid = -1; return; }
        grid = cus;
    }
    if (grid < 0) return;
    (void)in_sizes;
    if (hipMemsetAsync((char*)d_ws + WS_CTL, 0, 2 * MiB  , stream) != hipSuccess) return;
    Args a{};
    for (int i = 0; i < 32; ++i) a.in[i] = (const float*)d_in[i];
    a.out = (float*)d_out; a.ws = (unsigned char*)d_ws;
    const int nph = count_phases();
#if MK_PER_PHASE
    for (int p = 0; p < nph; ++p) { a.ph_lo = p; a.ph_hi = p + 1; hipLaunchKernelGGL(trunk_fwd, dim3(grid), dim3(NWAVES * 64), LDS_BYTES, stream, a); }
#else
    a.ph_lo = 0; a.ph_hi = nph;
    hipLaunchKernelGGL(trunk_fwd, dim3(grid), dim3(NWAVES * 64), LDS_BYTES, stream, a);
#endif
    const hipError_t le = hipPeekAtLastError();
    if (le != hipSuccess) fprintf(stderr, "kernel_launch: launch failed: %s\n", hipGetErrorName(le));
}
```

```cpp
#include <hip/hip_runtime.h>
#include <hip/hip_bf16.h>
#include <cstdio>
#include <cstdint>
#include <cmath>

#ifndef MK_PER_PHASE
#define MK_PER_PHASE 0
#endif

#define LAS __attribute__((address_space(3)))
#define GAS __attribute__((address_space(1)))
typedef unsigned short bf16_t;
typedef short bf16x8 __attribute__((ext_vector_type(8)));
typedef float f32x4 __attribute__((ext_vector_type(4)));
typedef float f32x2 __attribute__((ext_vector_type(2)));
typedef float f32x16 __attribute__((ext_vector_type(16)));
typedef unsigned u32x4 __attribute__((ext_vector_type(4)));
typedef unsigned u32x2 __attribute__((ext_vector_type(2)));
typedef short s16x4 __attribute__((ext_vector_type(4)));

constexpr int NB = 4, SEQ = 4096, CTX = 256, RB = SEQ + CTX  , R = NB * RB  , NPAN = R / 256  , PPB = RB / 256  ;
constexpr int D = 2048, DFF = 5632, N13 = 2 * DFF, NMOD = 9 * D  ;
constexpr int LDP = 13312;
constexpr int NIN = 13568;
constexpr int PQ = 0, PK = 1024, PV = 2048, PZ = 3072, PX = 4096, PU = 6144, PG = 7168;
constexpr float DN_ALPHA = 1.41421356237309515f;
constexpr float LN_EPS = 1e-5f, RMS_EPS = 1e-6f;
constexpr float QSCALE = 0.125f * 1.4426950408889634f;

constexpr size_t MiB = 1u << 20;
constexpr size_t WS_CTL = 0, CTL_ZERO_BYTES = 1 * MiB;
constexpr size_t WS_MOD = 1 * MiB;
constexpr size_t WS_ROPE = 2 * MiB;
constexpr size_t WS_STATS = 2 * MiB + 65536;
constexpr size_t WS_IDENT = 2 * MiB + 262144;
constexpr size_t WS_MODP = 3 * MiB;
constexpr size_t WS_DT = 15 * MiB;
constexpr size_t WS_H = 18 * MiB;
constexpr size_t WS_HC = WS_H + 68 * MiB;
constexpr size_t WS_HM = 154 * MiB;
constexpr size_t WS_PROJ = 222 * MiB;
constexpr size_t WS_O = 664 * MiB;
constexpr size_t WS_YD = 732 * MiB;
constexpr size_t WS_YS = 800 * MiB;
constexpr size_t WS_W = 868 * MiB;
constexpr size_t W_13 = 0, W_2 = 88 * MiB, W_IN = 132 * MiB, W_B = 185 * MiB, W_O = 197 * MiB, W_GLU = 205 * MiB;
constexpr size_t WS_S5ST = 1075 * MiB;
constexpr size_t WS_S5H = 1143 * MiB;
constexpr size_t WS_S5M = 1183 * MiB;
constexpr size_t WS_S5A = 1207 * MiB;
constexpr size_t WS_GQ0 = WS_O + 34 * MiB, WS_GQ1 = WS_S5ST + 34 * MiB  , WS_GQ2 = 1208 * MiB;
constexpr size_t WS_END = 1242 * MiB;
__device__ __forceinline__ size_t gq_off(int j) { return j == 0 ? WS_GQ0 : (j == 1 ? WS_GQ1 : WS_GQ2); }
constexpr int S5M = 1088;
constexpr int CW_BAR = 4096;

__device__ __forceinline__ unsigned cvt_pk_bf16(float lo, float hi) { unsigned r; asm volatile("v_cvt_pk_bf16_f32 %0, %1, %2" : "=v"(r) : "v"(lo), "v"(hi)); return r; }
__device__ __forceinline__ float bflo(unsigned u) { return __uint_as_float(u << 16); }
__device__ __forceinline__ float bfhi(unsigned u) { return __uint_as_float(u & 0xffff0000u); }
__device__ __forceinline__ float bf1(bf16_t h) { return __uint_as_float((unsigned)h << 16); }
typedef _Float16 h16x2 __attribute__((ext_vector_type(2)));
typedef _Float16 h16x4 __attribute__((ext_vector_type(4)));
typedef _Float16 h16x8 __attribute__((ext_vector_type(8)));
__device__ __forceinline__ f32x4 ld_h4(const _Float16* p) { const h16x4 h = *(const h16x4*)p; return (f32x4){(float)h[0], (float)h[1], (float)h[2], (float)h[3]}; }
__device__ __forceinline__ void st_h4(_Float16* p, f32x4 v) { h16x4 h; h[0] = (_Float16)v[0]; h[1] = (_Float16)v[1]; h[2] = (_Float16)v[2]; h[3] = (_Float16)v[3]; *(h16x4*)p = h; }
__device__ __forceinline__ float sigmoidf_(float x) { return __builtin_amdgcn_rcpf(1.0f + __builtin_amdgcn_exp2f(-1.4426950408889634f * x)); }
__device__ __forceinline__ float siluf_(float x) { return x * sigmoidf_(x); }
__device__ __forceinline__ int lane_now() { int l; asm volatile("v_mbcnt_lo_u32_b32 %0, -1, 0\n\tv_mbcnt_hi_u32_b32 %0, -1, %0" : "=v"(l)); return l; }
__device__ __forceinline__ float shx(float v, int m, int lane) { return __int_as_float(__builtin_amdgcn_ds_bpermute((lane ^ m) << 2, __float_as_int(v))); }
__device__ __forceinline__ float wave_sum(float v, int lane) {
#pragma unroll
    for (int o = 1; o < 64; o <<= 1) v += shx(v, o, lane);
    return v;
}
#define LDS_WAIT() asm volatile("s_waitcnt lgkmcnt(0)" ::: "memory")
#define VM_WAIT() asm volatile("s_waitcnt vmcnt(0)" ::: "memory")

namespace pg8 {
constexpr int BM = 256, BK = 64, HALF = 128, HTB = HALF * BK * 2, STAGE_BYTES = 8 * HTB, NXCD = 8, WGM = 8, PPB_ = 17;
__host__ __device__ __forceinline__ int lds_byte(int r, int c) { const int st = (r >> 4) * 2 + (c >> 5), rr = r & 15, cc = c & 31, ob = rr * 64 + cc * 2; return st * 1024 + (ob ^ (((ob >> 9) & 1) << 5)); }
__host__ __device__ __forceinline__ int perm32(int rho) { const int n = rho >> 4, i = rho & 15; return 8 * (i >> 2) + 4 * n + (i & 3); }
__host__ __device__ __forceinline__ void stage_rc(int b, int& R_, int& C_) { const int st = b / 1024, sb = b % 1024, swz = sb ^ (((sb >> 9) & 1) << 5); R_ = (st >> 1) * 16 + swz / 64; C_ = (st & 1) * 32 + (swz % 64) / 2; }

struct Unit { int pm, pn, aux, kt; const char* a; const char* b; };
struct Gemm { int lda, ldb, K; };

__device__ __forceinline__ void xcd_remap(int L, int nM, int nN, int& pm, int& pn) {
    const int nwg = nM * nN; int wgid = L;
    { const int q = nwg / NXCD, r = nwg % NXCD, xcd = wgid % NXCD, off = wgid / NXCD; wgid = (xcd < r ? xcd * (q + 1) : r * (q + 1) + (xcd - r) * q) + off; }
    const int nig = WGM * nN, gid = wgid / nig, fm = gid * WGM, gsz = (nM - fm) < WGM ? (nM - fm) : WGM;
    pm = fm + ((wgid % nig) % gsz); pn = (wgid % nig) / gsz;
}
struct StaticOrder {
    int nM, nN, nwg, G, c, kt, latonly, nctx, cproj; const char* A; const char* B; size_t tA, tB;
    __device__ __forceinline__ void init(int nM_, int nN_, int G_, int c_, const void* A_, int lda, const void* B_, int ldb, int K, int latonly_ = 0, int nctx_ = 0) { nM = nM_; nN = nN_; nwg = nM * nN; G = G_; c = c_; kt = K / BK; latonly = latonly_; nctx = nctx_; cproj = 0;
        A = (const char*)A_; B = (const char*)B_; tA = (size_t)BM * lda * 2; tB = (size_t)BM * ldb * 2; }
    __device__ __forceinline__ bool next(int i, Unit& u) const {
        const long L = (long)i * G + c;
        if (L < nwg) { xcd_remap((int)L, nM, nN, u.pm, u.pn); if (latonly) u.pm += (u.pm >> 4) + 1; u.aux = 0; u.kt = kt; u.a = A + (size_t)u.pm * tA; u.b = B + (size_t)u.pn * tB; return true; }
        const int x = (int)(L - nwg); if (x >= nctx) return false;
        if (cproj) {
            const int p = x / 20, t2 = x - 20 * p; u.pm = PPB_ * p; u.pn = (t2 < 8) ? 4 + t2 : 8 + t2; u.aux = 0; u.kt = kt; u.a = A + (size_t)u.pm * tA; u.b = B + (size_t)u.pn * tB; return true; }
        const int q = x & 3, t2 = x >> 2; u.pm = PPB_ * (t2 / nN); u.pn = t2 % nN; u.aux = 1 + q; u.kt = kt >> 2;
        u.a = A + (size_t)u.pm * tA + (size_t)q * (kt >> 2) * BK * 2; u.b = B + (size_t)u.pn * tB + (size_t)q * (kt >> 2) * BK * 2; return true;
    }
};
template <class Epi, class Sched, int AMODE = 0, bool HOOK = false>
__device__ __forceinline__ void gemm_phase(LAS unsigned char* lds, const Gemm g, const Sched& S, const Epi& E, const int tid) {
    const int wid = __builtin_amdgcn_readfirstlane(tid >> 6), lane = tid & 63, wr = wid >> 2, wc = wid & 3, fr = lane & 15, fq = lane >> 4;
    unsigned voffA[2], voffB[2];
#pragma unroll
    for (int i = 0; i < 2; ++i) { int R_, C_; stage_rc(tid * 16 + i * 8192, R_, C_);
        voffA[i] = (AMODE == 1) ? (unsigned)((R_ * 16 + (C_ >> 4)) * LDP + (C_ & 15)) * 2u : (unsigned)(R_ * g.lda + C_) * 2u; voffB[i] = (unsigned)((Epi::PERM ? ((R_ & ~31) + perm32(R_ & 31)) : R_) * g.ldb + C_) * 2u; }
    const size_t kstep = (size_t)(BK * 2), kstepA = (AMODE == 1) ? (size_t)(4 * LDP * 2) : kstep;
    const size_t hstepA = (AMODE == 1) ? (size_t)HALF * 16 * LDP * 2 : (size_t)HALF * g.lda * 2, hstepB = (size_t)HALF * g.ldb * 2;
    const unsigned ldsw = (unsigned)wid * 1024u;
    const int aoff = lds_byte(wr * 64 + fr, fq * 8), boff = lds_byte(wc * 32 + fr, fq * 8);
#define PG8_SA(b, h) (((b) * 2 + (h)) * HTB)
#define PG8_SB(b, h) ((4 + (b) * 2 + (h)) * HTB)
#define PG8_STAGE(bufoff, gbase, voff) do { _Pragma("unroll") for (int _i = 0; _i < 2; ++_i) \
        __builtin_amdgcn_global_load_lds((const unsigned*)((const char*)(gbase) + (voff)[_i]), (LAS unsigned*)(lds + (bufoff) + ldsw + _i * 8192), 16, 0, 0); } while (0)
#define PG8_LDA(dst, b, h) do { _Pragma("unroll") for (int m = 0; m < 4; ++m) _Pragma("unroll") for (int k = 0; k < 2; ++k) dst[m][k] = *(const LAS bf16x8*)(lds + PG8_SA(b, h) + aoff + m * 2048 + k * 1024); } while (0)
#define PG8_LDB(dst, b, h) do { _Pragma("unroll") for (int n = 0; n < 2; ++n) _Pragma("unroll") for (int k = 0; k < 2; ++k) dst[n][k] = *(const LAS bf16x8*)(lds + PG8_SB(b, h) + boff + n * 2048 + k * 1024); } while (0)
#define PG8_MMA(ai, bj, At, Bt) do { __builtin_amdgcn_s_setprio(1); _Pragma("unroll") for (int m = 0; m < 4; ++m) _Pragma("unroll") for (int n = 0; n < 2; ++n) _Pragma("unroll") for (int k = 0; k < 2; ++k) \
        acc[ai][bj][m][n] = __builtin_amdgcn_mfma_f32_16x16x32_bf16(Bt[n][k], At[m][k], acc[ai][bj][m][n], 0, 0, 0); __builtin_amdgcn_s_setprio(0); } while (0)
#define PG8_WAIT_V(n) asm volatile("s_waitcnt vmcnt(" #n ")" ::: "memory")
#define PG8_WAIT_L(n) asm volatile("s_waitcnt lgkmcnt(" #n ")" ::: "memory")
#define PG8_BAR __builtin_amdgcn_s_barrier()
#define PG8_SCHED __builtin_amdgcn_sched_barrier(0)
    Unit cur, nxt; int ui = 0;
    if (!S.next(0, cur)) return;
    f32x4 acc[2][2][4][2];
#pragma unroll
    for (int a = 0; a < 2; ++a)
#pragma unroll
        for (int b = 0; b < 2; ++b)
#pragma unroll
            for (int m = 0; m < 4; ++m)
#pragma unroll
                for (int n = 0; n < 2; ++n) acc[a][b][m][n] = (f32x4){0.f, 0.f, 0.f, 0.f};
    bf16x8 At[4][2], B0[2][2], B1[2][2];
    const char* cA = cur.a; const char* cB = cur.b;
    PG8_STAGE(PG8_SB(0, 0), cB, voffB); PG8_STAGE(PG8_SB(0, 1), cB + hstepB, voffB); PG8_STAGE(PG8_SA(0, 0), cA, voffA); PG8_STAGE(PG8_SA(0, 1), cA + hstepA, voffA);
    if (wr == 1) PG8_BAR;
    PG8_WAIT_V(2); PG8_BAR;
    PG8_STAGE(PG8_SB(1, 0), cB + kstep, voffB); PG8_STAGE(PG8_SA(1, 0), cA + kstepA, voffA); PG8_STAGE(PG8_SB(1, 1), cB + hstepB + kstep, voffB);
    PG8_WAIT_V(6); PG8_BAR;
    for (;;) {
        const bool has_next = S.next(ui + 1, nxt);
        const char* nA = has_next ? nxt.a : cA; const char* nB = has_next ? nxt.b : cB;
        const int nt = cur.kt;
        for (int t = 0; t < nt; t += 2) {
            const bool last = (t == nt - 2);
            if constexpr (HOOK) { if (t == 16 || t == 32) E.mid(acc, cur, t >> 4, wr, wc); }
            const char* a1 = cA + (size_t)(t + 1) * kstepA;
            const char* a2 = last ? nA : cA + (size_t)(t + 2) * kstepA; const char* b2 = last ? nB : cB + (size_t)(t + 2) * kstep;
            const char* a3 = a2 + kstepA; const char* b3 = b2 + kstep;
            PG8_LDB(B0, 0, 0); PG8_LDB(B1, 0, 1); PG8_SCHED; PG8_LDA(At, 0, 0); PG8_STAGE(PG8_SA(1, 1), a1 + hstepA, voffA);
            PG8_WAIT_V(8); PG8_WAIT_L(0); PG8_BAR; PG8_MMA(0, 0, At, B0); PG8_MMA(0, 1, At, B1); PG8_BAR; PG8_SCHED;
            PG8_LDA(At, 0, 1); PG8_STAGE(PG8_SB(0, 0), b2, voffB); PG8_STAGE(PG8_SB(0, 1), b2 + hstepB, voffB); PG8_STAGE(PG8_SA(0, 0), a2, voffA);
            PG8_WAIT_V(8); PG8_WAIT_L(0); PG8_BAR; PG8_MMA(1, 0, At, B0); PG8_MMA(1, 1, At, B1); PG8_BAR; PG8_SCHED;
            PG8_LDB(B0, 1, 0); PG8_LDB(B1, 1, 1); PG8_SCHED; PG8_LDA(At, 1, 0); PG8_STAGE(PG8_SA(0, 1), a2 + hstepA, voffA);
            PG8_WAIT_V(8); PG8_WAIT_L(0); PG8_BAR; PG8_MMA(0, 0, At, B0); PG8_MMA(0, 1, At, B1); PG8_BAR; PG8_SCHED;
            PG8_LDA(At, 1, 1); PG8_STAGE(PG8_SB(1, 0), b3, voffB); PG8_STAGE(PG8_SB(1, 1), b3 + hstepB, voffB); PG8_STAGE(PG8_SA(1, 0), a3, voffA);
            PG8_WAIT_V(8); PG8_WAIT_L(0); PG8_BAR; PG8_MMA(1, 0, At, B0); PG8_MMA(1, 1, At, B1); PG8_BAR; PG8_SCHED;
        }
        if (wr == 0) PG8_BAR;
        E(acc, cur, wr, wc, fr, fq);
        if (!has_next) break;
#pragma unroll
        for (int a = 0; a < 2; ++a)
#pragma unroll
            for (int b = 0; b < 2; ++b)
#pragma unroll
                for (int m = 0; m < 4; ++m)
#pragma unroll
                    for (int n = 0; n < 2; ++n) acc[a][b][m][n] = (f32x4){0.f, 0.f, 0.f, 0.f};
        cur = nxt; cA = nA; cB = nB; ++ui;
        if (wr == 1) PG8_BAR;
    }
    PG8_WAIT_V(0);
    PG8_BAR;
#undef PG8_SA
#undef PG8_SB
#undef PG8_STAGE
#undef PG8_LDA
#undef PG8_LDB
#undef PG8_MMA
#undef PG8_WAIT_V
#undef PG8_WAIT_L
#undef PG8_BAR
#undef PG8_SCHED
}
}

struct EpiSwiGLU {
    static constexpr bool PERM = true;
    bf16_t* O;
    __device__ __forceinline__ void operator()(const f32x4 (&acc)[2][2][4][2], const pg8::Unit& u, int wr, int wc, int, int) const { const int ln_ = lane_now(); const int fr = ln_ & 15, fq = ln_ >> 4;
        const int row0 = u.pm * 256 + wr * 64 + fr, hc0 = u.pn * 128 + wc * 32 + 8 * fq;
#pragma unroll
        for (int ai = 0; ai < 2; ++ai)
#pragma unroll
            for (int m = 0; m < 4; ++m) { const f32x4 a0 = acc[ai][0][m][0], a1 = acc[ai][0][m][1], b0 = acc[ai][1][m][0], b1 = acc[ai][1][m][1];
                u32x4 w; w.x = cvt_pk_bf16(siluf_(a0[0]) * b0[0], siluf_(a0[1]) * b0[1]); w.y = cvt_pk_bf16(siluf_(a0[2]) * b0[2], siluf_(a0[3]) * b0[3]);
                w.z = cvt_pk_bf16(siluf_(a1[0]) * b1[0], siluf_(a1[1]) * b1[1]); w.w = cvt_pk_bf16(siluf_(a1[2]) * b1[2], siluf_(a1[3]) * b1[3]);
                *(u32x4*)(O + (size_t)(row0 + ai * 128 + m * 16) * DFF + hc0) = w; }
    }
};
struct EpiResid {
    static constexpr bool PERM = true;
    _Float16* H; float* HC; const float* gate; const float* lng; const float* lnb; const float* stats;
    __device__ __forceinline__ void operator()(const f32x4 (&acc)[2][2][4][2], const pg8::Unit& u, int wr, int wc, int, int) const { const int ln_ = lane_now(); const int fr = ln_ & 15, fq = ln_ >> 4;
        int upm = u.pm, upn = u.pn; asm volatile("" : "+s"(upm), "+s"(upn));
        const int pp = upm % PPB, mi = (pp == 0) ? 4 : (upm / PPB);
        const int rl0 = wr * 64 + fr, col0 = upn * 256 + wc * 32 + 8 * fq;
        if (u.aux) {
            float* hc = (float*)((char*)HC - WS_HC + WS_YD) + ((size_t)(u.aux - 1) * (NB * CTX) + (size_t)(upm / PPB) * 256) * D;
#pragma unroll
            for (int bj = 0; bj < 2; ++bj) { const f32x4 gv0 = *(const f32x4*)(gate + (size_t)mi * NMOD + col0 + bj * 128), gv1 = *(const f32x4*)(gate + (size_t)mi * NMOD + col0 + bj * 128 + 4);
#pragma unroll
                for (int ai = 0; ai < 2; ++ai)
#pragma unroll
                    for (int m = 0; m < 4; ++m) { float* p = hc + (size_t)(rl0 + ai * 128 + m * 16) * D + col0 + bj * 128; *(f32x4*)p = gv0 * acc[ai][bj][m][0]; *(f32x4*)(p + 4) = gv1 * acc[ai][bj][m][1]; } }
            return;
        }
#pragma unroll
        for (int bj = 0; bj < 2; ++bj) { const int c = col0 + bj * 128;
            const f32x4 gv0 = *(const f32x4*)(gate + (size_t)mi * NMOD + c), gv1 = *(const f32x4*)(gate + (size_t)mi * NMOD + c + 4);
            const f32x4 g0 = *(const f32x4*)(lng + c) * DN_ALPHA, g1 = *(const f32x4*)(lng + c + 4) * DN_ALPHA, b0 = *(const f32x4*)(lnb + c) * DN_ALPHA, b1 = *(const f32x4*)(lnb + c + 4) * DN_ALPHA;
#pragma unroll
            for (int ai = 0; ai < 2; ++ai) {
                u32x4 tv[4]; f32x2 st[4];
#pragma unroll
                for (int m = 0; m < 4; ++m) { const size_t row = (size_t)(upm * 256 + rl0 + ai * 128 + m * 16); tv[m] = *(const u32x4*)(H + row * D + c); st[m] = *(const f32x2*)(stats + row * 2); }
                asm volatile("s_waitcnt vmcnt(0)" ::: "memory");
#pragma unroll
                for (int m = 0; m < 4; ++m) { const h16x4 ha = __builtin_bit_cast(h16x4, (u32x2){tv[m].x, tv[m].y}), hb = __builtin_bit_cast(h16x4, (u32x2){tv[m].z, tv[m].w});
                    const f32x4 t0 = (f32x4){(float)ha[0], (float)ha[1], (float)ha[2], (float)ha[3]}, t1 = (f32x4){(float)hb[0], (float)hb[1], (float)hb[2], (float)hb[3]};
                    const f32x4 o0 = (t0 - st[m].x) * st[m].y * g0 + b0 + gv0 * acc[ai][bj][m][0], o1 = (t1 - st[m].x) * st[m].y * g1 + b1 + gv1 * acc[ai][bj][m][1];
                    h16x4 qa, qb; qa[0] = (_Float16)o0[0]; qa[1] = (_Float16)o0[1]; qa[2] = (_Float16)o0[2]; qa[3] = (_Float16)o0[3]; qb[0] = (_Float16)o1[0]; qb[1] = (_Float16)o1[1]; qb[2] = (_Float16)o1[2]; qb[3] = (_Float16)o1[3];
                    const u32x2 pa = __builtin_bit_cast(u32x2, qa), pb = __builtin_bit_cast(u32x2, qb);
                    *(u32x4*)(H + (size_t)(upm * 256 + rl0 + ai * 128 + m * 16) * D + c) = (u32x4){pa.x, pa.y, pb.x, pb.y}; } } }
    }
};
struct EpiProj {
    static constexpr bool PERM = true;
    bf16_t* P; float* DT; const float* rc; const float* rs; bf16_t* U2;
    __device__ __forceinline__ void operator()(const f32x4 (&acc)[2][2][4][2], const pg8::Unit& u, int wr, int wc, int, int) const { const int ln_ = lane_now(); const int fr = ln_ & 15, fq = ln_ >> 4;
        const int pp = u.pm % PPB; const int row0 = u.pm * 256 + wr * 64 + fr;
        const int pn = u.pn;
        if (pn == 52) {
            if (wc == 0) {
#pragma unroll
                for (int ai = 0; ai < 2; ++ai)
#pragma unroll
                    for (int m = 0; m < 4; ++m)
#pragma unroll
                        for (int n = 0; n < 2; ++n) *(f32x4*)(DT + (size_t)(row0 + ai * 128 + m * 16) * 32 + 8 * fq + 4 * n) = acc[ai][0][m][n];
            }
            return;
        }
        if (pn >= 28) {
            const int jg = (pn - 28) >> 3, pnd = (pn - 28) & 7;
            unsigned char* gq = (unsigned char*)P - WS_PROJ + gq_off(jg) + ((size_t)((u.pm * 8 + pnd) * 512 + (wr * 4 + wc) * 64 + ln_)) * 128;
#pragma unroll
            for (int ai = 0; ai < 2; ++ai)
#pragma unroll
                for (int m = 0; m < 4; ++m) { u32x4 w;
#pragma unroll
                    for (int bj = 0; bj < 2; ++bj)
#pragma unroll
                        for (int n = 0; n < 2; ++n) { const f32x4 v = acc[ai][bj][m][n]; unsigned q = 0;
#pragma unroll
                            for (int e = 0; e < 4; ++e) q |= (unsigned)fmaxf(__builtin_rintf(sigmoidf_(v[e]) * 255.0f), 1.0f) << (8 * e);
                            w[bj * 2 + n] = q; }
                    *(u32x4*)(gq + (ai * 4 + m) * 16) = w; }
            return;
        }
        const int col0 = pn * 256 + wc * 32 + 4 * fq;
        const int mode = (pn < 8) ? ((pp != 0) ? 1 : 0) : ((pn >= 12 && pn < 16) ? 2 : 0);
        const float sc = (pn < 4) ? QSCALE : 1.0f;
#pragma unroll
        for (int ai = 0; ai < 2; ++ai) {
          f32x4 csv[4], snv[4];
          if (mode == 1) {
#pragma unroll
              for (int m = 0; m < 4; ++m) { const int rl = ai * 128 + wr * 64 + m * 16 + fr; const int t = (pp - 1) * 256 + rl; const int pos = (wc & 1) ? (t & 63) : (t >> 6); csv[m] = *(const f32x4*)(rc + pos * 16 + 4 * fq); snv[m] = *(const f32x4*)(rs + pos * 16 + 4 * fq); }
              asm volatile("s_waitcnt vmcnt(0)" ::: "memory"); }
#pragma unroll
            for (int m = 0; m < 4; ++m) { const int rl = ai * 128 + wr * 64 + m * 16 + fr; bf16_t* rowp = P + (size_t)(u.pm * 256 + rl) * LDP + col0;
                f32x4 cs = (f32x4){1.f, 1.f, 1.f, 1.f}, sn = (f32x4){0.f, 0.f, 0.f, 0.f};
                if (mode == 1) { cs = csv[m]; sn = snv[m]; }
#pragma unroll
                for (int bj = 0; bj < 2; ++bj) { f32x4 v0 = acc[ai][bj][m][0], v1 = acc[ai][bj][m][1];
                    if (mode == 1) { const f32x4 o0 = v0 * cs - v1 * sn, o1 = v1 * cs + v0 * sn; v0 = o0; v1 = o1; }
                    else if (mode == 2) {
#pragma unroll
                        for (int e = 0; e < 4; ++e) { v0[e] = siluf_(v0[e]); v1[e] = siluf_(v1[e]); } }
                    if (pn >= 24 && pn < 28) {
                        const int cu = (pn - 24) * 256 + bj * 128 + wc * 32 + 8 * fq;
                        bf16_t* u2 = U2 + ((size_t)(cu >> 4) * R + (size_t)(u.pm * 256 + rl)) * 16 + (cu & 15);
                        u32x4 a; a.x = cvt_pk_bf16(v0[0], v0[1]); a.y = cvt_pk_bf16(v0[2], v0[3]); a.z = cvt_pk_bf16(v1[0], v1[1]); a.w = cvt_pk_bf16(v1[2], v1[3]);
                        *(u32x4*)u2 = a; continue; }
                    v0 = v0 * sc; v1 = v1 * sc;
                    if (pn < 8) { u32x2 w0, w1; w0.x = cvt_pk_bf16(v0[0], v0[1]); w0.y = cvt_pk_bf16(v0[2], v0[3]); w1.x = cvt_pk_bf16(v1[0], v1[1]); w1.y = cvt_pk_bf16(v1[2], v1[3]);
                        *(u32x2*)(rowp + bj * 128) = w0; *(u32x2*)(rowp + bj * 128 + 16) = w1; }
                    else { u32x4 w; w.x = cvt_pk_bf16(v0[0], v0[1]); w.y = cvt_pk_bf16(v0[2], v0[3]); w.z = cvt_pk_bf16(v1[0], v1[1]); w.w = cvt_pk_bf16(v1[2], v1[3]);
                        *(u32x4*)(rowp + 4 * fq + bj * 128) = w; } } } }
    }
};
struct EpiGlu {
    static constexpr bool PERM = false;
    bf16_t* P; const float* bias;
    __device__ __forceinline__ void operator()(const f32x4 (&acc)[2][2][4][2], const pg8::Unit& u, int wr, int wc, int, int) const { const int ln_ = lane_now(); const int fr = ln_ & 15, fq = ln_ >> 4;
        const int row0 = u.pm * 256 + wr * 64 + fr, col0 = u.pn * 256 + wc * 32 + 4 * fq;
        f32x4 bv[2][2];
#pragma unroll
        for (int bj = 0; bj < 2; ++bj)
#pragma unroll
            for (int n = 0; n < 2; ++n) bv[bj][n] = *(const f32x4*)(bias + col0 + bj * 128 + n * 16);
#pragma unroll
        for (int ai = 0; ai < 2; ++ai) {
            u32x2 tv[4][2][2];
#pragma unroll
            for (int m = 0; m < 4; ++m)
#pragma unroll
                for (int bj = 0; bj < 2; ++bj)
#pragma unroll
                    for (int n = 0; n < 2; ++n) tv[m][bj][n] = *(const u32x2*)(P + (size_t)(row0 + ai * 128 + m * 16) * LDP + PU + col0 + bj * 128 + n * 16);
            asm volatile("s_waitcnt vmcnt(0)" ::: "memory");
#pragma unroll
            for (int m = 0; m < 4; ++m) { bf16_t* rowp = P + (size_t)(row0 + ai * 128 + m * 16) * LDP;
#pragma unroll
                for (int bj = 0; bj < 2; ++bj)
#pragma unroll
                    for (int n = 0; n < 2; ++n) { const int c = col0 + bj * 128 + n * 16; const u32x2 t = tv[m][bj][n];
                        const f32x4 a = acc[ai][bj][m][n] + bv[bj][n]; u32x2 w;
                        w.x = cvt_pk_bf16(bflo(t.x) * sigmoidf_(a[0]), bfhi(t.x) * sigmoidf_(a[1])); w.y = cvt_pk_bf16(bflo(t.y) * sigmoidf_(a[2]), bfhi(t.y) * sigmoidf_(a[3]));
                        *(u32x2*)(rowp + PK + c) = w; } } }
    }
};
struct EpiMerge {
    static constexpr bool PERM = true;
    const bf16_t* P; bf16_t* MIXB;
    static __device__ __forceinline__ int jmap(int seg) { return seg == 0 ? 0 : (seg == 1 ? 2 : 1); }
    __device__ __forceinline__ const unsigned char* gbase(const pg8::Unit& u, int seg, int wr, int wc, int ln_) const {
        return (const unsigned char*)P - WS_PROJ + gq_off(jmap(seg)) + ((size_t)((u.pm * 8 + u.pn) * 512 + (wr * 4 + wc) * 64 + ln_)) * 128; }
    __device__ __forceinline__ void mid(f32x4 (&acc)[2][2][4][2], const pg8::Unit& u, int seg, int wr, int wc) const {
        const int ln_ = lane_now(); const unsigned char* ga = gbase(u, seg - 1, wr, wc, ln_); const unsigned char* gb = gbase(u, seg, wr, wc, ln_);
        u32x4 a[2][4], b[2][4];
#pragma unroll
        for (int ai = 0; ai < 2; ++ai)
#pragma unroll
            for (int m = 0; m < 4; ++m) { a[ai][m] = *(const u32x4*)(ga + (ai * 4 + m) * 16); b[ai][m] = *(const u32x4*)(gb + (ai * 4 + m) * 16); }
        asm volatile("s_waitcnt vmcnt(0)" ::: "memory");
#pragma unroll
        for (int ai = 0; ai < 2; ++ai)
#pragma unroll
            for (int m = 0; m < 4; ++m)
#pragma unroll
                for (int bj = 0; bj < 2; ++bj)
#pragma unroll
                    for (int n = 0; n < 2; ++n) { const unsigned qa = a[ai][m][bj * 2 + n], qb = b[ai][m][bj * 2 + n]; f32x4 r;
#pragma unroll
                        for (int e = 0; e < 4; ++e) r[e] = (float)((qa >> (8 * e)) & 255u) * __builtin_amdgcn_rcpf((float)((qb >> (8 * e)) & 255u));
                        acc[ai][bj][m][n] = acc[ai][bj][m][n] * r; }
    }
    __device__ __forceinline__ void operator()(const f32x4 (&acc)[2][2][4][2], const pg8::Unit& u, int wr, int wc, int, int) const { const int ln_ = lane_now(); const int fr = ln_ & 15, fq = ln_ >> 4;
        const int row0 = u.pm * 256 + wr * 64 + fr, col0 = u.pn * 256 + wc * 32 + 8 * fq; const unsigned char* gl = gbase(u, 2, wr, wc, ln_);
        u32x4 gq[2][4];
#pragma unroll
        for (int ai = 0; ai < 2; ++ai)
#pragma unroll
            for (int m = 0; m < 4; ++m) gq[ai][m] = *(const u32x4*)(gl + (ai * 4 + m) * 16);
        asm volatile("s_waitcnt vmcnt(0)" ::: "memory");
#pragma unroll
        for (int ai = 0; ai < 2; ++ai)
#pragma unroll
            for (int m = 0; m < 4; ++m) { const size_t row = (size_t)(row0 + ai * 128 + m * 16); const u32x4 g4 = gq[ai][m];
#pragma unroll
                for (int bj = 0; bj < 2; ++bj) { u32x4 w;
#pragma unroll
                    for (int n = 0; n < 2; ++n) { const unsigned gv = g4[bj * 2 + n];
                        f32x4 v = acc[ai][bj][m][n];
#pragma unroll
                        for (int e = 0; e < 4; ++e) v[e] *= (float)((gv >> (8 * e)) & 255u) * (1.0f / 255.0f);
                        w[2 * n] = cvt_pk_bf16(v[0], v[1]); w[2 * n + 1] = cvt_pk_bf16(v[2], v[3]); }
                    *(u32x4*)(MIXB + row * D + col0 + bj * 128) = w; } }
    }
};

struct S5AOrder {
    int G, c; const char* A; const char* B;
    __device__ __forceinline__ bool next(int i, pg8::Unit& u) const {
        const int idx = i * G + c; if (idx >= 640) return false;
        const int g = idx / 10, r = idx - 10 * g, nt = r / 5, mt = r - 5 * nt;
        u.pm = mt; u.pn = nt; u.aux = g; u.kt = 4; u.a = A + ((size_t)g * (R / 16) + (size_t)mt * 256) * 256 * 2; u.b = B + (size_t)(g * 512 + nt * 256) * 256 * 2; return true;
    }
};
struct EpiS5A {
    static constexpr bool PERM = false;
    unsigned char* YLF; bf16_t* ST;
    __device__ __forceinline__ void operator()(const f32x4 (&acc)[2][2][4][2], const pg8::Unit& u, int wr, int wc, int, int) const { const int ln_ = lane_now(); const int fr = ln_ & 15, fq = ln_ >> 4;
        const int g = u.aux;
        if (u.pn == 0) { unsigned char* yl = YLF + ((size_t)((g * 5 + u.pm) * 512 + (wr * 4 + wc) * 64 + ln_)) * 256;
#pragma unroll
            for (int ai = 0; ai < 2; ++ai)
#pragma unroll
                for (int m = 0; m < 4; ++m) { u32x4 w0, w1;
                    w0.x = cvt_pk_bf16(acc[ai][0][m][0][0], acc[ai][0][m][0][1]); w0.y = cvt_pk_bf16(acc[ai][0][m][0][2], acc[ai][0][m][0][3]); w0.z = cvt_pk_bf16(acc[ai][0][m][1][0], acc[ai][0][m][1][1]); w0.w = cvt_pk_bf16(acc[ai][0][m][1][2], acc[ai][0][m][1][3]);
                    w1.x = cvt_pk_bf16(acc[ai][1][m][0][0], acc[ai][1][m][0][1]); w1.y = cvt_pk_bf16(acc[ai][1][m][0][2], acc[ai][1][m][0][3]); w1.z = cvt_pk_bf16(acc[ai][1][m][1][0], acc[ai][1][m][1][1]); w1.w = cvt_pk_bf16(acc[ai][1][m][1][2], acc[ai][1][m][1][3]);
                    *(u32x4*)(yl + (ai * 4 + m) * 32) = w0; *(u32x4*)(yl + (ai * 4 + m) * 32 + 16) = w1; }
            return; }
#pragma unroll
        for (int ai = 0; ai < 2; ++ai)
#pragma unroll
            for (int m = 0; m < 4; ++m) { const int mr = u.pm * 256 + ai * 128 + wr * 64 + m * 16 + fr; if (mr < S5M) {
#pragma unroll
                for (int bj = 0; bj < 2; ++bj)
#pragma unroll
                    for (int n = 0; n < 2; ++n) { const f32x4 v = acc[ai][bj][m][n];
                        u32x2 w; w.x = cvt_pk_bf16(v[0], v[1]); w.y = cvt_pk_bf16(v[2], v[3]); *(u32x2*)(ST + ((size_t)g * S5M + mr) * 256 + bj * 128 + wc * 32 + n * 16 + 4 * fq) = w; } } }
    }
};
struct S5COrder {
    int G, c; const char* A; const char* B;
    __device__ __forceinline__ bool next(int i, pg8::Unit& u) const {
        const int idx = i * G + c; if (idx >= 320) return false;
        const int g = idx / 5, mt = idx - 5 * g;
        u.pm = mt; u.pn = 0; u.aux = g; u.kt = 4; u.a = A + ((size_t)g * 1280 + mt * 256) * 256 * 2; u.b = B + (size_t)g * 256 * 256 * 2; return true;
    }
};
struct EpiS5C {
    static constexpr bool PERM = false;
    const unsigned char* YLF; bf16_t* P;
    __device__ __forceinline__ void operator()(const f32x4 (&acc)[2][2][4][2], const pg8::Unit& u, int wr, int wc, int, int) const { const int ln_ = lane_now(); const int fr = ln_ & 15, fq = ln_ >> 4;
        const int g = u.aux; const unsigned char* yl = YLF + ((size_t)((g * 5 + u.pm) * 512 + (wr * 4 + wc) * 64 + ln_)) * 256;
#pragma unroll
        for (int ai = 0; ai < 2; ++ai) {
        u32x4 y0[2][4], y1[2][4];
#pragma unroll
            for (int m = 0; m < 4; ++m) { y0[ai][m] = *(const u32x4*)(yl + (ai * 4 + m) * 32); y1[ai][m] = *(const u32x4*)(yl + (ai * 4 + m) * 32 + 16); }
        asm volatile("s_waitcnt vmcnt(0)" ::: "memory");
#pragma unroll
            for (int m = 0; m < 4; ++m) { const int mr = u.pm * 256 + ai * 128 + wr * 64 + m * 16 + fr; if (mr < S5M) {
#pragma unroll
                for (int bj = 0; bj < 2; ++bj)
#pragma unroll
                    for (int n = 0; n < 2; ++n) { const int rho = 8 * bj + 2 * wc + n; const size_t row = (size_t)(16 * mr + rho);
                        const u32x4 yy = bj ? y1[ai][m] : y0[ai][m]; const unsigned ya = n ? yy.z : yy.x, yb = n ? yy.w : yy.y; f32x4 v = acc[ai][bj][m][n];
                        v[0] += bflo(ya); v[1] += bfhi(ya); v[2] += bflo(yb); v[3] += bfhi(yb);
#pragma unroll
                        for (int e = 0; e < 4; ++e) { const float x = v[e]; const float inner = 0.7978845608028654f * (x + 0.044715f * x * x * x); const float th = 1.0f - 2.0f * __builtin_amdgcn_rcpf(1.0f + __builtin_amdgcn_exp2f(2.8853900817779268f * inner)); v[e] = 0.5f * x * (1.0f + th); }
                        u32x2 w; w.x = cvt_pk_bf16(v[0], v[1]); w.y = cvt_pk_bf16(v[2], v[3]); *(u32x2*)(P + row * LDP + PU + 16 * g + 4 * fq) = w; } } } }
    }
};

namespace attn128 {
using bf16 = __hip_bfloat16;
constexpr int NW = 8, QBLK = 32, KVBLK = 64, LDQ = LDP, LDK = LDP, LDOB = LDP;
constexpr size_t SHM_V = KVBLK * 128 * 2, SHM_K = KVBLK * 64 * 2, SHM_ATTN = 2 * SHM_V + 2 * SHM_K + NW * 64 * 4, SHM_TOTAL = SHM_ATTN + NW * 8192;
constexpr float THRL = 11.5f;
#define A128_KSWZ(row, colB) ((row) * 128 + ((colB) ^ (((row) & 7) << 4)))
#define A128_SBAR() __builtin_amdgcn_sched_barrier(0)
__device__ __forceinline__ int crow(int r, int hi) { return (r & 3) + 8 * (r >> 2) + 4 * hi; }
template <bool FIRST = false>
__device__ __forceinline__ void partialSM(f32x16& p0, f32x16& p1, float& m_reg, float& mn, float& alpha) {
  float pmax = p0[0];
#pragma unroll
  for (int r = 1; r < 16; ++r) pmax = fmaxf(pmax, p0[r]);
#pragma unroll
  for (int r = 0; r < 16; ++r) pmax = fmaxf(pmax, p1[r]);
  { auto rr = __builtin_amdgcn_permlane32_swap(__float_as_uint(pmax), __float_as_uint(pmax), false, false); pmax = fmaxf(__uint_as_float(rr[0]), __uint_as_float(rr[1])); }
  if (FIRST) { m_reg = (__builtin_fabsf(pmax) <= THRL) ? 0.f : pmax; mn = m_reg; alpha = 1.f; }
  else if (__builtin_expect(__all(pmax - m_reg <= THRL), 1)) { mn = m_reg; alpha = 1.f; }
  else { mn = fmaxf(m_reg, pmax); alpha = __builtin_amdgcn_exp2f(m_reg - mn); m_reg = mn; }
  if (__builtin_expect(__any(mn != 0.f), 0)) {
#pragma unroll
    for (int r = 0; r < 16; ++r) { p0[r] = p0[r] - mn; p1[r] = p1[r] - mn; } }
#pragma unroll
  for (int r = 0; r < 16; ++r) p0[r] = __builtin_amdgcn_exp2f(p0[r]);
}
__device__ __forceinline__ void finishSM(f32x16& p0, f32x16& p1, float alpha, float& l_reg, bf16x8& pa0, bf16x8& pa1, bf16x8& pa2, bf16x8& pa3) {
#pragma unroll
  for (int r = 0; r < 16; ++r) p1[r] = __builtin_amdgcn_exp2f(p1[r]);
  float ps = 0;
#pragma unroll
  for (int r = 0; r < 16; ++r) ps += p0[r];
#pragma unroll
  for (int r = 0; r < 16; ++r) ps += p1[r];
  { auto rr = __builtin_amdgcn_permlane32_swap(__float_as_uint(ps), __float_as_uint(ps), false, false); ps = __uint_as_float(rr[0]) + __uint_as_float(rr[1]); }
  l_reg = l_reg * alpha + ps;
#define A128_PK4(P, BASE, OUT) do { unsigned a0 = cvt_pk_bf16(P[BASE + 0], P[BASE + 1]), a1 = cvt_pk_bf16(P[BASE + 2], P[BASE + 3]);   \
    unsigned b0 = cvt_pk_bf16(P[BASE + 4], P[BASE + 5]), b1 = cvt_pk_bf16(P[BASE + 6], P[BASE + 7]);                              \
    auto r0 = __builtin_amdgcn_permlane32_swap(a0, b0, false, false); auto r1 = __builtin_amdgcn_permlane32_swap(a1, b1, false, false); \
    u32x4 w = {r0[0], r1[0], r0[1], r1[1]}; OUT = __builtin_bit_cast(bf16x8, w); } while (0)
  A128_PK4(p0, 0, pa0); A128_PK4(p0, 8, pa1); A128_PK4(p1, 0, pa2); A128_PK4(p1, 8, pa3);
#undef A128_PK4
}
__device__ __forceinline__ void qkt(f32x16& p0, f32x16& p1, const char* Ks, const bf16x8* qr, int r32, int hi) {
#pragma unroll
  for (int i = 0; i < 16; ++i) { p0[i] = 0.f; p1[i] = 0.f; }
#pragma unroll
  for (int d0 = 0; d0 < 4; ++d0) { const int cb = (d0 * 16 + hi * 8) * 2;
    const bf16x8 b0 = *reinterpret_cast<const bf16x8*>(Ks + A128_KSWZ(r32, cb));
    const bf16x8 b1 = *reinterpret_cast<const bf16x8*>(Ks + A128_KSWZ(32 + r32, cb));
    p0 = __builtin_amdgcn_mfma_f32_32x32x16_bf16(b0, qr[d0], p0, 0, 0, 0);
    p1 = __builtin_amdgcn_mfma_f32_32x32x16_bf16(b1, qr[d0], p1, 0, 0, 0); }
}
__device__ __forceinline__ int v_st(int k, int c) { const int kk = (k & ~0xC) | ((k & 4) << 1) | ((k & 8) >> 1); return ((kk >> 3) * 4 + (c >> 5)) * 512 + ((kk & 7) * 32 + (c & 31)) * 2; }
__device__ __forceinline__ int v_rd_base(int lane) { return ((lane & 3) << 3) | (((lane >> 2) & 3) << 6) | (((lane >> 4) & 1) << 5) | (((lane >> 5) & 1) << 8); }
constexpr int v_rd_off(int d0, int ks, int half) { return d0 * 512 + ks * 4096 + half * 2048; }
template <int OFF> __device__ __forceinline__ s16x4 tr_read(int vb) { s16x4 r; asm volatile("ds_read_b64_tr_b16 %0, %1 offset:%2" : "=&v"(r) : "v"(vb), "i"(OFF) : "memory"); return r; }
template <int D0> __device__ __forceinline__ void pv_one(f32x16& od, int vb, bf16x8 pa0, bf16x8 pa1, bf16x8 pa2, bf16x8 pa3) {
  const s16x4 l0 = tr_read<v_rd_off(D0, 0, 0)>(vb), h0 = tr_read<v_rd_off(D0, 0, 1)>(vb), l1 = tr_read<v_rd_off(D0, 1, 0)>(vb), h1 = tr_read<v_rd_off(D0, 1, 1)>(vb);
  const s16x4 l2 = tr_read<v_rd_off(D0, 2, 0)>(vb), h2 = tr_read<v_rd_off(D0, 2, 1)>(vb), l3 = tr_read<v_rd_off(D0, 3, 0)>(vb), h3 = tr_read<v_rd_off(D0, 3, 1)>(vb);
  asm volatile("s_waitcnt lgkmcnt(0)" ::: "memory"); A128_SBAR();
#define A128_PK(L, H) (bf16x8){L[0], L[1], L[2], L[3], H[0], H[1], H[2], H[3]}
  od = __builtin_amdgcn_mfma_f32_32x32x16_bf16(pa0, A128_PK(l0, h0), od, 0, 0, 0);
  od = __builtin_amdgcn_mfma_f32_32x32x16_bf16(pa1, A128_PK(l1, h1), od, 0, 0, 0);
  od = __builtin_amdgcn_mfma_f32_32x32x16_bf16(pa2, A128_PK(l2, h2), od, 0, 0, 0);
  od = __builtin_amdgcn_mfma_f32_32x32x16_bf16(pa3, A128_PK(l3, h3), od, 0, 0, 0);
#undef A128_PK
}
__device__ __forceinline__ void pv_d0(f32x16* o, int vb, bf16x8 pa0, bf16x8 pa1, bf16x8 pa2, bf16x8 pa3) {
  pv_one<0>(o[0], vb, pa0, pa1, pa2, pa3); pv_one<1>(o[1], vb, pa0, pa1, pa2, pa3); pv_one<2>(o[2], vb, pa0, pa1, pa2, pa3); pv_one<3>(o[3], vb, pa0, pa1, pa2, pa3);
}
__device__ __forceinline__ void unit(const bf16* __restrict__ Qb0, const bf16* __restrict__ Kh0, const bf16* __restrict__ Vh, bf16_t* Ob, int seq, char* lds, const int tid_in, const float lam, const float onem, const float* __restrict__ subw) {
#pragma unroll 1
 for (int mp = 0; mp < 2; ++mp) {
  int tid = tid_in; asm volatile("" : "+v"(tid));
  bf16_t* stage = (bf16_t*)(lds + SHM_ATTN) + (tid >> 6) * 4096;
  const bf16* Qb = Qb0 + mp * 64; const bf16* Kh = Kh0 + mp * 64;
  const int wid = __builtin_amdgcn_readfirstlane(tid >> 6), lane = tid & 63, r32 = lane & 31, hi = lane >> 5;
  char* V_lds = lds; char* K_lds = lds + 2 * SHM_V;
  float* ws = (float*)(lds + 2 * SHM_V + 2 * SHM_K) + wid * 64; float* li_l = ws; float* al_l = ws + 32;
  float m_reg = 0.f, l_reg = 0; f32x16 o[4]; bf16x8 qr[4];
#pragma unroll
  for (int d = 0; d < 4; ++d)
#pragma unroll
    for (int r = 0; r < 16; ++r) o[d][r] = 0.f;
  const bf16* Qw = Qb + (long)(wid * QBLK + r32) * LDQ + hi * 8;
#pragma unroll
  for (int d0 = 0; d0 < 4; ++d0) qr[d0] = *reinterpret_cast<const bf16x8*>(Qw + d0 * 16);
  const int sr = tid >> 4, sc = (tid & 15) * 8, vst0 = v_st(sr, sc), vst1 = v_st(32 + sr, sc);
  const int kr = tid >> 3, kc = (tid & 7) * 8, kst = A128_KSWZ(kr, kc * 2);
  const int vb0 = (int)(uintptr_t)V_lds + v_rd_base(lane);
  struct { bf16x8 vs0, vs1, ks0; } sr_[2];
#define A128_SLOAD(i, k0) do { sr_[i].vs0 = *reinterpret_cast<const bf16x8*>(&Vh[(long)((k0) + sr) * LDK + sc]); sr_[i].vs1 = *reinterpret_cast<const bf16x8*>(&Vh[(long)((k0) + 32 + sr) * LDK + sc]); \
    sr_[i].ks0 = *reinterpret_cast<const bf16x8*>(&Kh[(long)((k0) + kr) * LDK + kc]); } while (0)
#define A128_SWRITE(b, i) do { *(bf16x8*)(V_lds + (b) * SHM_V + vst0) = sr_[i].vs0; *(bf16x8*)(V_lds + (b) * SHM_V + vst1) = sr_[i].vs1; *(bf16x8*)(K_lds + (b) * SHM_K + kst) = sr_[i].ks0; } while (0)
#define A128_SWAIT() asm volatile("s_waitcnt vmcnt(3)" ::: "memory")
#define A128_RESC(a) do { if (__any((a) < 1.f)) { if (hi == 0) al_l[r32] = (a); asm volatile("s_waitcnt lgkmcnt(0)" ::: "memory"); \
    _Pragma("unroll") for (int d = 0; d < 4; ++d) _Pragma("unroll") for (int r = 0; r < 16; ++r) o[d][r] *= al_l[crow(r, hi)]; } } while (0)
  f32x16 pA0, pA1, pB0, pB1; float mnA, mnB, alA, alB; bf16x8 pa0, pa1, pa2, pa3; const int NT = seq / KVBLK;
  A128_SLOAD(0, 0); asm volatile("s_waitcnt vmcnt(0)" ::: "memory"); A128_SWRITE(0, 0); __syncthreads();
  qkt(pA0, pA1, K_lds, qr, r32, hi); partialSM<true>(pA0, pA1, m_reg, mnA, alA);
  A128_SLOAD(1, KVBLK); if (2 < NT) A128_SLOAD(0, 2 * KVBLK);
  A128_SWAIT(); A128_SWRITE(1, 1); __syncthreads();
  for (int j = 1; j + 1 < NT; j += 2) {
    A128_SBAR(); qkt(pB0, pB1, K_lds + SHM_K, qr, r32, hi);
    finishSM(pA0, pA1, alA, l_reg, pa0, pa1, pa2, pa3); A128_SBAR();
    A128_SLOAD(1, (j + 2) * KVBLK); A128_SBAR();
    pv_d0(o, vb0, pa0, pa1, pa2, pa3); partialSM(pB0, pB1, m_reg, mnB, alB);
    __syncthreads(); A128_SWAIT(); A128_SWRITE(0, 0);
    A128_RESC(alB); __syncthreads();
    A128_SBAR(); qkt(pA0, pA1, K_lds, qr, r32, hi);
    finishSM(pB0, pB1, alB, l_reg, pa0, pa1, pa2, pa3); A128_SBAR();
    if (j + 3 < NT) A128_SLOAD(0, (j + 3) * KVBLK); A128_SBAR();
    pv_d0(o, vb0 + (int)SHM_V, pa0, pa1, pa2, pa3); partialSM(pA0, pA1, m_reg, mnA, alA);
    __syncthreads(); A128_SWAIT(); A128_SWRITE(1, 1);
    A128_RESC(alA); __syncthreads();
  }
  A128_SBAR(); qkt(pB0, pB1, K_lds + SHM_K, qr, r32, hi);
  finishSM(pA0, pA1, alA, l_reg, pa0, pa1, pa2, pa3); A128_SBAR();
  pv_d0(o, vb0, pa0, pa1, pa2, pa3); partialSM(pB0, pB1, m_reg, mnB, alB);
  __syncthreads(); A128_RESC(alB);
  finishSM(pB0, pB1, alB, l_reg, pa0, pa1, pa2, pa3); A128_SBAR();
  pv_d0(o, vb0 + (int)SHM_V, pa0, pa1, pa2, pa3);
  if (hi == 0) li_l[r32] = l_reg; asm volatile("s_waitcnt lgkmcnt(0)" ::: "memory");
  float rli[16];
#pragma unroll
  for (int r = 0; r < 16; ++r) rli[r] = __builtin_amdgcn_rcpf(li_l[crow(r, hi)]);
  if (mp == 0) {
#pragma unroll
    for (int r = 0; r < 16; ++r)
#pragma unroll
      for (int d0 = 0; d0 < 4; ++d0) stage[(r * 4 + d0) * 64 + lane] = (bf16_t)(cvt_pk_bf16(o[d0][r] * rli[r], 0.f) & 0xffffu);
  } else {
    float ss[16];
#pragma unroll
    for (int r = 0; r < 16; ++r) { float q = 0.f;
#pragma unroll
      for (int d0 = 0; d0 < 4; ++d0) { const float a = bf1(stage[(r * 4 + d0) * 64 + lane]) - lam * bf1((bf16_t)(cvt_pk_bf16(o[d0][r] * rli[r], 0.f) & 0xffffu)); o[d0][r] = a; q += a * a; }
      ss[r] = q; }
#pragma unroll
    for (int m = 1; m < 32; m <<= 1)
#pragma unroll
      for (int r = 0; r < 16; ++r) ss[r] += __int_as_float(__builtin_amdgcn_ds_bpermute((lane ^ m) << 2, __float_as_int(ss[r])));
    float sw[4];
#pragma unroll
    for (int d0 = 0; d0 < 4; ++d0) sw[d0] = subw[d0 * 32 + r32] * onem;
    bf16_t* Ow = Ob + (long)(wid * QBLK) * LDOB;
#pragma unroll
    for (int r = 0; r < 16; ++r) { const int orow = crow(r, hi); const float rs = 1.0f / sqrtf(ss[r] * (1.f / 128.f) + RMS_EPS);
#pragma unroll
      for (int d0 = 0; d0 < 4; ++d0) Ow[(long)orow * LDOB + d0 * 32 + r32] = (bf16_t)(cvt_pk_bf16(o[d0][r] * rs * sw[d0], 0.f) & 0xffffu); }
  }
  __syncthreads();
 }
#undef A128_SLOAD
#undef A128_SWRITE
#undef A128_SWAIT
#undef A128_RESC
}
#undef A128_KSWZ
#undef A128_SBAR
}

#define XB_TMO      128
#define XB_XCNT(j)  (256  + 64 * (j))
#define XB_XSUB(j)  (1280 + 64 * (j))
#define XB_XGEN(j)  (2304 + 64 * (j))
#define XB_TOP      3328
#define XB_TOPGEN   3392
#define XCD_BAR_WORDS 3456
#define XB_SPIN_CAP (1u << 18)
__device__ __forceinline__ unsigned xb_ld(unsigned* p)              { return __hip_atomic_load(p, __ATOMIC_RELAXED, __HIP_MEMORY_SCOPE_AGENT); }
__device__ __forceinline__ unsigned xb_add(unsigned* p, unsigned v) { return __hip_atomic_fetch_add(p, v, __ATOMIC_RELAXED, __HIP_MEMORY_SCOPE_AGENT); }
__device__ __forceinline__ unsigned xb_xcc_id() { return (unsigned)__builtin_amdgcn_s_getreg((3 << 11) | 20) & 0xFu; }
#define XB_SPIN(cond, bar) do { unsigned _sp = 0; while (cond) { __builtin_amdgcn_s_sleep(1); \
    if ((++_sp & 255u) == 0u) { if (xb_ld(&(bar)[XB_TMO])) break; if (_sp > XB_SPIN_CAP) { atomicAdd(&(bar)[XB_TMO], 1u); break; } } } } while (0)
struct XcdBarrier { unsigned* bar; unsigned x; volatile LAS unsigned* st; };
__device__ __forceinline__ XcdBarrier xcd_barrier_post(unsigned* bar, volatile LAS unsigned* st) {
    XcdBarrier b; b.bar = bar; b.x = xb_xcc_id(); b.st = st;
    if (threadIdx.x == 0) (void)xb_add(&bar[XB_XCNT(b.x)], 1u);
    return b;
}
__device__ __forceinline__ void xcd_barrier_complete(unsigned* bar, unsigned x, unsigned& nloc, unsigned& nx) {
    const unsigned G = gridDim.x * gridDim.y * gridDim.z;
    unsigned sum, cnt, mine, sp = 0u;
    for (;;) {
        sum = 0u; cnt = 0u; mine = 0u;
#pragma unroll
        for (unsigned j = 0; j < 16; ++j) { const unsigned c = xb_ld(&bar[XB_XCNT(j)]); sum += c; cnt += (c > 0u) ? 1u : 0u; mine = (j == x) ? c : mine; }
        if (sum == G) break;
        __builtin_amdgcn_s_sleep(1);
        if ((++sp & 255u) == 0u) { if (xb_ld(&bar[XB_TMO])) break; if (sp > XB_SPIN_CAP) { atomicAdd(&bar[XB_TMO], 1u); break; } }
    }
    nloc = mine > 0u ? mine : 1u; nx = cnt > 0u ? cnt : 1u;
}
__device__ __forceinline__ void xcd_barrier(const XcdBarrier& b, const int tid) {
    asm volatile("s_waitcnt vmcnt(0)" ::: "memory");
    __syncthreads();
    if (tid == 0) {
        unsigned* bar = b.bar;
        __builtin_amdgcn_s_waitcnt(0);
        unsigned nloc = b.st[0], nx = b.st[1];
        if (nloc == 0u) { xcd_barrier_complete(bar, b.x, nloc, nx); b.st[0] = nloc; b.st[1] = nx; }
        const unsigned old = xb_add(&bar[XB_XSUB(b.x)], 1u);
        const unsigned gen = old / nloc;
        if (old + 1u == (gen + 1u) * nloc) {
            __builtin_amdgcn_fence(__ATOMIC_RELEASE, "agent");
            asm volatile("s_waitcnt vmcnt(0)" ::: "memory");
            const unsigned og = xb_add(&bar[XB_TOP], 1u);
            const unsigned tg = og / nx;
            if (og + 1u == (tg + 1u) * nx) xb_add(&bar[XB_TOPGEN], 1u);
            else XB_SPIN(xb_ld(&bar[XB_TOPGEN]) == tg, bar);
            __builtin_amdgcn_fence(__ATOMIC_ACQUIRE, "agent");
            xb_add(&bar[XB_XGEN(b.x)], 1u);
            asm volatile("s_waitcnt vmcnt(0)" ::: "memory");
        } else {
            XB_SPIN(xb_ld(&bar[XB_XGEN(b.x)]) == gen, bar);
            __builtin_amdgcn_fence(__ATOMIC_ACQUIRE, "agent");
            asm volatile("s_waitcnt vmcnt(0)" ::: "memory");
        }
    }
    __syncthreads();
}

constexpr int NWAVES = 8;
constexpr int RING_OFF = 0, RING_BYTES = 131072;
constexpr int LDSCTL_OFF = RING_BYTES, MISC_OFF = LDSCTL_OFF + 320;
constexpr int LDS_BYTES = 147456;
static_assert(attn128::SHM_TOTAL <= (size_t)RING_BYTES, "attention scratch fits the ring");

struct Args { const float* in[32]; float* out; unsigned char* ws; int ph_lo, ph_hi; };
constexpr int INTAB_OFF = LDSCTL_OFF + 1024;
__device__ __forceinline__ const float* inptr(LAS unsigned char* lds, int i) {
    const unsigned long long v = ((const LAS unsigned long long*)(lds + INTAB_OFF))[i];
    const unsigned lo = __builtin_amdgcn_readfirstlane((unsigned)v), hi = __builtin_amdgcn_readfirstlane((unsigned)(v >> 32));
    return (const float*)(GAS const float*)(((unsigned long long)hi << 32) | lo);
}
#define INP(i) inptr(F.lds, (i))
struct Frame {
    LAS unsigned char* lds; int tid, lane, wave, vcu, G, gw, NGW;
    unsigned char* ws;
};
enum { I_X = 0, I_C, I_CTX, I_CCTX, I_WMOD, I_BMOD, I_LNG, I_LNB, I_W1, I_W3, I_W2, I_WIN, I_ALAM, I_ASUB, I_CONVW, I_CONVB, I_ALOG, I_DTB, I_SSDD, I_SSDN,
       I_LRE, I_LIM, I_LSTEP, I_BRE, I_BIM, I_CRE, I_CIM, I_S5D, I_GLUW, I_GLUB, I_WBR, I_WOUT };

__device__ __forceinline__ void transpose_item64(const float* srcA, const float* srcB, int ldn, bool p32, bf16_t* dst, int ldk, LAS bf16_t* scr  , int lane) {
    const int q = lane & 15, kr = lane >> 4; const bool isB = q >= 8; const int c = (q & 7) * 4; const float* src = isB ? srcB : srcA;
    f32x4 v[16];
#pragma unroll
    for (int i = 0; i < 16; ++i) v[i] = src ? *(const f32x4*)(src + (size_t)(4 * i + kr) * ldn + c) : (f32x4){0.f, 0.f, 0.f, 0.f};
    const int drow = (p32 ? pg8::perm32(c) : c) + (isB ? 32 : 0);
#pragma unroll
    for (int i = 0; i < 16; ++i) { const int k = 4 * i + kr; const unsigned p01 = cvt_pk_bf16(v[i][0], v[i][1]), p23 = cvt_pk_bf16(v[i][2], v[i][3]);
        scr[(drow + 0) * 72 + k] = (bf16_t)(p01 & 0xffffu); scr[(drow + 1) * 72 + k] = (bf16_t)(p01 >> 16); scr[(drow + 2) * 72 + k] = (bf16_t)(p23 & 0xffffu); scr[(drow + 3) * 72 + k] = (bf16_t)(p23 >> 16); }
    LDS_WAIT(); asm volatile("" ::: "memory");
    const int c8 = lane & 7;
#pragma unroll
    for (int jj = 0; jj < 8; ++jj) { const int n = (lane >> 3) + 8 * jj; *(u32x4*)(dst + (size_t)n * ldk + 8 * c8) = *(const LAS u32x4*)(scr + n * 72 + 8 * c8); }
    LDS_WAIT(); asm volatile("" ::: "memory");
}
__device__ __forceinline__ void convert_layer_weights(const Args& A_, Frame& F, int l) {
    LAS bf16_t* scr = (LAS bf16_t*)(F.lds + RING_OFF + F.wave * 16384);
    unsigned char* W = F.ws + WS_W;
    constexpr int I13 = 32 * 176, I2 = 88 * 32, IIN = 32 * 212, IB = 16 * 32, IO = 32 * 32, IG = 16 * 16;
    constexpr int NIT = 2 * I13 + 2 * I2 + IIN + 3 * IB + IO + IG;
    for (int it = F.gw; it < NIT; it += F.NGW) {
        int r = it;
        if (r < 2 * I13) { const int f = r / I13; r -= f * I13; const int kb = r / 176, nb = r % 176;
            const float* wsrc = (((nb & 3) < 2) ? INP(I_W1) : INP(I_W3)) + ((size_t)(l * 2 + f) * D + 64 * kb) * DFF + 128 * (nb >> 2) + 64 * (nb & 1);
            transpose_item64(wsrc, wsrc + 32, DFF, false, (bf16_t*)(W + W_13) + ((size_t)f * N13 + 64 * nb) * D + 64 * kb, D, scr, F.lane); continue; }
        r -= 2 * I13;
        if (r < 2 * I2) { const int f = r / I2; r -= f * I2; const int kb = r / 32, nb = r % 32;
            const float* w2 = INP(I_W2) + ((size_t)(l * 2 + f) * DFF + 64 * kb) * D + 64 * nb;
            transpose_item64(w2, w2 + 32, D, false, (bf16_t*)(W + W_2) + ((size_t)f * D + 64 * nb) * DFF + 64 * kb, DFF, scr, F.lane); continue; }
        r -= 2 * I2;
        if (r < IIN) { const int kb = r / 212, nb = r % 212; const int n0 = 64 * nb; const float* wb = INP(I_WIN) + ((size_t)l * D + 64 * kb) * 13344;
            const float* sa = nullptr; const float* sb = nullptr;
            if (n0 < 6144) { sa = wb + n0; sb = sa + 32; } else if (n0 < 13312) { sa = wb + n0 + 32; sb = sa + 32; } else if (n0 == 13312) { sa = wb + 6144; }
            transpose_item64(sa, sb, 13344, n0 < 2048, (bf16_t*)(W + W_IN) + (size_t)n0 * D + 64 * kb, D, scr, F.lane); continue; }
        r -= IIN;
        if (r < 3 * IB) { const int jb = r / IB; r -= jb * IB; const int kb = r / 32, nb = r % 32;
            const float* w = INP(I_WBR) + ((size_t)(l * 3 + jb) * 1024 + 64 * kb) * D + 64 * nb;
            const int sp = (jb == 0) ? 0 : (jb == 1 ? 2 : 1); transpose_item64(w, w + 32, D, false, (bf16_t*)(W + W_B) + (size_t)(64 * nb) * 3072 + sp * 1024 + 64 * kb, 3072, scr, F.lane); continue; }
        r -= 3 * IB;
        if (r < IO) { const int kb = r / 32, nb = r % 32; const float* w = INP(I_WOUT) + ((size_t)l * D + 64 * kb) * D + 64 * nb;
            transpose_item64(w, w + 32, D, false, (bf16_t*)(W + W_O) + (size_t)(64 * nb) * D + 64 * kb, D, scr, F.lane); continue; }
        r -= IO;
        { const int kb = r / 16, nb = r % 16; const float* w = INP(I_GLUW) + ((size_t)l * 1024 + 64 * kb) * 1024 + 64 * nb;
            transpose_item64(w, w + 32, 1024, false, (bf16_t*)(W + W_GLU) + (size_t)(64 * nb) * 1024 + 64 * kb, 1024, scr, F.lane); }
    }
}
__device__ __forceinline__ void mod_partials(const Args& A_, Frame& F) {
    float* MODw = (float*)(F.ws + WS_MOD);
    LAS float* sl = (LAS float*)(F.lds + RING_OFF + 98304 + F.wave * 4096);
    const int nskip = (F.G > 64) ? 64 : 0; if ((int)blockIdx.x < nskip) return;
    for (int it = ((int)blockIdx.x - nskip) * NWAVES + F.wave; it < 2 * 72 * 16; it += (F.G - nskip) * NWAVES) {
        const int l = it / (72 * 16), r = it % (72 * 16), ks = r / 72, cg = r % 72;
        const int col = cg * 256 + F.lane * 4; const float* w = INP(I_WMOD) + ((size_t)l * D + ks * 128) * NMOD + col;
        const float* c = INP(I_C) + ks * 128; const float* cc = INP(I_CCTX) + ks * 128;
#pragma unroll
        for (int h = 0; h < 2; ++h) { const int k = F.lane + 64 * h;
            sl[0 * 128 + k] = siluf_(c[k]); sl[1 * 128 + k] = siluf_(c[D + k]); sl[2 * 128 + k] = siluf_(c[2 * D + k]); sl[3 * 128 + k] = siluf_(c[3 * D + k]); sl[4 * 128 + k] = siluf_(cc[k]); }
        LDS_WAIT(); asm volatile("" ::: "memory");
        f32x4 a0 = {0.f, 0.f, 0.f, 0.f}, a1 = a0, a2 = a0, a3 = a0, a4 = a0;
        for (int k0 = 0; k0 < 128; k0 += 16) {
            f32x4 wv[16];
#pragma unroll
            for (int e = 0; e < 16; ++e) wv[e] = *(const f32x4*)(w + (size_t)(k0 + e) * NMOD);
            asm volatile("s_waitcnt vmcnt(0)" ::: "memory");
#pragma unroll
            for (int e = 0; e < 16; ++e) { a0 += wv[e] * sl[0 * 128 + k0 + e]; a1 += wv[e] * sl[1 * 128 + k0 + e]; a2 += wv[e] * sl[2 * 128 + k0 + e]; a3 += wv[e] * sl[3 * 128 + k0 + e]; a4 += wv[e] * sl[4 * 128 + k0 + e]; }
        }
        const int r9 = col / D; const float sc = (r9 == 2 || r9 == 8) ? 0.5f : 1.0f;
        if (ks == 0) { const f32x4 bv = *(const f32x4*)(INP(I_BMOD) + (size_t)l * NMOD + col); a0 += bv; a1 += bv; a2 += bv; a3 += bv; a4 += bv; }
        float* o = MODw + (size_t)l * 5 * NMOD + col;
#pragma unroll
        for (int e = 0; e < 4; ++e) { unsafeAtomicAdd(o + e, a0[e] * sc); unsafeAtomicAdd(o + NMOD + e, a1[e] * sc); unsafeAtomicAdd(o + 2 * NMOD + e, a2[e] * sc); unsafeAtomicAdd(o + 3 * NMOD + e, a3[e] * sc); unsafeAtomicAdd(o + 4 * NMOD + e, a4[e] * sc); }
        LDS_WAIT(); asm volatile("" ::: "memory");
    }
}
__device__ __forceinline__ void ln_pass(Frame& F, bool do_ln, const float* lng, const float* lnb, const float* modnext  , float* out, const float* xin = nullptr, const float* cin = nullptr, int nslab = 0) {
#define LNCO(i) (512 * ((i) >> 1) + 8 * F.lane + 4 * ((i) & 1))
    _Float16* H = (_Float16*)(F.ws + WS_H); const float* SL = (const float*)(F.ws + WS_YD); float* HC = (float*)(F.ws + WS_HC); bf16_t* HM = (bf16_t*)(F.ws + WS_HM); float* ST = (float*)(F.ws + WS_STATS);
    f32x4 G[8], Bv[8];
    if (do_ln) {
#pragma unroll
        for (int i = 0; i < 8; ++i) { G[i] = *(const f32x4*)(lng + LNCO(i)); Bv[i] = *(const f32x4*)(lnb + LNCO(i)); }
    }
    const int nper = F.NGW / NB; f32x4 sh4[8], sc4[8];
    for (int it = 0; it < SEQ / nper + 1; ++it) {
        int b = F.gw / nper, rr = CTX + (F.gw % nper) + nper * it;
        if (it == SEQ / nper) { if (F.gw >= NB * CTX) break; b = F.gw / CTX; rr = F.gw % CTX; }
        const int row = b * RB + rr; const bool isctx = rr < CTX; const int mi = isctx ? 4 : b;
        float* hc = HC + ((size_t)b * CTX + rr) * D; _Float16* hr = H + (size_t)row * D;
        f32x4 v[8]; float s = 0.f;
        if (xin) { const float* src = isctx ? cin + ((size_t)b * CTX + rr) * D : xin + ((size_t)b * SEQ + (rr - CTX)) * D;
#pragma unroll
            for (int i = 0; i < 8; ++i) v[i] = *(const f32x4*)(src + LNCO(i));
        } else if (isctx) {
#pragma unroll
            for (int i = 0; i < 8; ++i) v[i] = *(const f32x4*)(hc + LNCO(i));
            if (nslab) {
#pragma unroll 1
                for (int q = 0; q < 4; ++q) { f32x4 sv[8];
#pragma unroll
                    for (int i = 0; i < 8; ++i) sv[i] = *(const f32x4*)(SL + ((size_t)q * (NB * CTX) + (size_t)b * CTX + rr) * D + LNCO(i));
#pragma unroll
                    for (int i = 0; i < 8; ++i) v[i] = v[i] + sv[i]; } }
        } else {
#pragma unroll
            for (int k = 0; k < 4; ++k) { const h16x8 h = *(const h16x8*)(hr + LNCO(2 * k)); v[2 * k] = (f32x4){(float)h[0], (float)h[1], (float)h[2], (float)h[3]}; v[2 * k + 1] = (f32x4){(float)h[4], (float)h[5], (float)h[6], (float)h[7]}; }
        }
        if (modnext && (it == 0 || it == SEQ / nper)) { const float* sh = modnext + (size_t)mi * NMOD; const float* sc = sh + D;
#pragma unroll
            for (int i = 0; i < 8; ++i) { sh4[i] = *(const f32x4*)(sh + LNCO(i)); sc4[i] = *(const f32x4*)(sc + LNCO(i)); } }
        asm volatile("s_waitcnt vmcnt(0)" ::: "memory");
#pragma unroll
        for (int i = 0; i < 8; ++i) s += (v[i][0] + v[i][1]) + (v[i][2] + v[i][3]);
        if (do_ln) {
            const float mean = wave_sum(s, F.lane) * (1.f / D); float s2 = 0.f;
#pragma unroll
            for (int i = 0; i < 8; ++i) { v[i] = v[i] - mean; s2 += (v[i][0] * v[i][0] + v[i][1] * v[i][1]) + (v[i][2] * v[i][2] + v[i][3] * v[i][3]); }
            const float rstd = 1.0f / sqrtf(wave_sum(s2, F.lane) * (1.f / D) + LN_EPS);
            if (!isctx && F.lane == 0) *(f32x2*)(ST + (size_t)row * 2) = (f32x2){mean, rstd};
#pragma unroll
            for (int i = 0; i < 8; ++i) { v[i] = v[i] * rstd * G[i] + Bv[i]; if (isctx) *(f32x4*)(hc + LNCO(i)) = v[i] * DN_ALPHA; }
        } else if (isctx) {
#pragma unroll
            for (int i = 0; i < 8; ++i) *(f32x4*)(hc + LNCO(i)) = v[i] * DN_ALPHA;
        } else {
#pragma unroll
            for (int k = 0; k < 4; ++k) { h16x8 h;
#pragma unroll
                for (int e = 0; e < 4; ++e) { h[e] = (_Float16)v[2 * k][e]; h[4 + e] = (_Float16)v[2 * k + 1][e]; }
                *(h16x8*)(hr + LNCO(2 * k)) = h; }
            if (F.lane == 0) *(f32x2*)(ST + (size_t)row * 2) = (f32x2){0.f, 1.f};
        }
        if (modnext) {
#pragma unroll
            for (int k = 0; k < 4; ++k) { const f32x4 m0 = v[2 * k] * (sc4[2 * k] + 1.0f) + sh4[2 * k], m1 = v[2 * k + 1] * (sc4[2 * k + 1] + 1.0f) + sh4[2 * k + 1];
                u32x4 w; w.x = cvt_pk_bf16(m0[0], m0[1]); w.y = cvt_pk_bf16(m0[2], m0[3]); w.z = cvt_pk_bf16(m1[0], m1[1]); w.w = cvt_pk_bf16(m1[2], m1[3]); *(u32x4*)(HM + (size_t)row * D + LNCO(2 * k)) = w; }
        }
        if (out && !isctx) { float* orow = out + ((size_t)b * SEQ + (rr - CTX)) * D;
#pragma unroll
            for (int i = 0; i < 8; ++i) *(f32x4*)(orow + LNCO(i)) = v[i]; }
    }
}
#undef LNCO

__device__ __forceinline__ void dt_tile(Frame& F, int l, int tile) {
    const bf16_t* A = (const bf16_t*)(F.ws + WS_HM) + (size_t)tile * 32 * D; const bf16_t* Bt = (const bf16_t*)(F.ws + WS_W + W_IN) + (size_t)13312 * D; float* DT = (float*)(F.ws + WS_DT);
    const int r = F.lane & 31, h = F.lane >> 5;
    f32x16 acc;
#pragma unroll
    for (int i = 0; i < 16; ++i) acc[i] = 0.f;
    const bf16_t* ap = A + (size_t)r * D + 8 * h; const bf16_t* bp = Bt + (size_t)r * D + 8 * h;
    for (int k0 = 0; k0 < 128; k0 += 16) {
        bf16x8 af[16], bfv[16];
#pragma unroll
        for (int e = 0; e < 16; ++e) { af[e] = *(const bf16x8*)(ap + 16 * (k0 + e)); bfv[e] = *(const bf16x8*)(bp + 16 * (k0 + e)); }
#pragma unroll
        for (int e = 0; e < 16; ++e) acc = __builtin_amdgcn_mfma_f32_32x32x16_bf16(af[e], bfv[e], acc, 0, 0, 0);
    }
    const float bias = INP(I_DTB)[l * 32 + r];
#pragma unroll
    for (int rg = 0; rg < 16; ++rg) { const int row = tile * 32 + (rg & 3) + 8 * (rg >> 2) + 4 * h; const float x = acc[rg] + bias; DT[(size_t)row * 32 + r] = fmaxf(x, 0.f) + log1pf(expf(-fabsf(x))); }
}
__device__ __forceinline__ void ssd_conv_pass(const Args& A_, Frame& F, int l) {
    const bf16_t* P = (const bf16_t*)(F.ws + WS_PROJ); bf16_t* XC = (bf16_t*)(F.ws + WS_HM);
    const float* cw = INP(I_CONVW) + (size_t)l * 5 * 2048; const float* cb = INP(I_CONVB) + (size_t)l * 2048;
    for (int it = F.gw; it < (R / 8) * 4; it += F.NGW) {
        const int r0 = (it >> 2) * 8, c0 = (it & 3) * 512 + F.lane * 8; const int rr0 = r0 % RB; const int lo = (rr0 < CTX) ? 0 : CTX, hi = (rr0 < CTX) ? CTX : RB;
        u32x4 x[12];
#pragma unroll
        for (int h = 0; h < 12; ++h) { const int r2 = rr0 + h - 2; x[h] = (r2 >= lo && r2 < hi) ? *(const u32x4*)(P + (size_t)(r0 + h - 2) * LDP + PX + c0) : (u32x4){0u, 0u, 0u, 0u}; }
        f32x4 w0[5], w1[5];
#pragma unroll
        for (int k = 0; k < 5; ++k) { w0[k] = *(const f32x4*)(cw + k * 2048 + c0); w1[k] = *(const f32x4*)(cw + k * 2048 + c0 + 4); }
        const f32x4 b0 = *(const f32x4*)(cb + c0), b1 = *(const f32x4*)(cb + c0 + 4);
#pragma unroll
        for (int jr = 0; jr < 8; ++jr) { f32x4 a0 = b0, a1 = b1;
#pragma unroll
            for (int k = 0; k < 5; ++k) { const u32x4 xv = x[jr + k];
                a0[0] += w0[k][0] * bflo(xv.x); a0[1] += w0[k][1] * bfhi(xv.x); a0[2] += w0[k][2] * bflo(xv.y); a0[3] += w0[k][3] * bfhi(xv.y);
                a1[0] += w1[k][0] * bflo(xv.z); a1[1] += w1[k][1] * bfhi(xv.z); a1[2] += w1[k][2] * bflo(xv.w); a1[3] += w1[k][3] * bfhi(xv.w); }
            u32x4 o; o.x = cvt_pk_bf16(siluf_(a0[0]), siluf_(a0[1])); o.y = cvt_pk_bf16(siluf_(a0[2]), siluf_(a0[3])); o.z = cvt_pk_bf16(siluf_(a1[0]), siluf_(a1[1])); o.w = cvt_pk_bf16(siluf_(a1[2]), siluf_(a1[3]));
            *(u32x4*)(XC + (size_t)(r0 + jr) * 2048 + c0) = o; }
    }
}
__device__ __forceinline__ int scan_row(int rb, int d, int step) { return d == 0 ? rb + step : (step < CTX ? rb + CTX - 1 - step : rb + (RB + CTX - 1) - step); }

__device__ __forceinline__ unsigned short bf16_1(float v) { return (unsigned short)(cvt_pk_bf16(v, 0.f) & 0xffffu); }
__device__ __forceinline__ void ssd_chain_fast(const Args& A_, Frame& F, int l, int cid) {
    constexpr int LS = 136;
    const int b = cid >> 6, d = (cid >> 5) & 1, hd = (cid >> 1) & 15, ph = cid & 1, g = hd >> 2; const int rb = b * RB;
    const bf16_t* XC = (const bf16_t*)(F.ws + WS_HM); const float* DT = (const float*)(F.ws + WS_DT); bf16_t* YD = (bf16_t*)(F.ws + WS_YD) + (size_t)d * R * 1024;
    const float a = -expf(INP(I_ALOG)[l * 32 + d * 16 + hd]);
    LAS bf16_t* Cs = (LAS bf16_t*)(F.lds); LAS bf16_t* Bs = Cs + 128 * LS; LAS bf16_t* Ms = Bs + 128 * LS; LAS bf16_t* XdT = Ms + 128 * LS; LAS bf16_t* Hb = XdT + 32 * LS;
    LAS float* csL = (LAS float*)(Hb + 32 * LS); LAS float* ecsL = csL + 128; LAS float* ewL = ecsL + 128; LAS float* misc = ewL + 128;
    const int tid = F.tid, lane = F.lane, w = F.wave, r = lane & 31, h = lane >> 5;
    f32x16 hacc;
#pragma unroll
    for (int i = 0; i < 16; ++i) hacc[i] = 0.f;
    for (int i = tid; i < 32 * LS / 2; i += 512) ((LAS unsigned*)Hb)[i] = 0u;
    u32x4 pc[4], pb[4], px; float pdt, pv0 = 0.f, pv1 = 0.f;
    const int rho0 = d ? 127 - lane : lane, rho1 = d ? 63 - lane : 64 + lane;
#define SSD_R0(k_) ((d == 0) ? rb + 128 * (k_) : ((k_) < 2 ? rb + 128 * (1 - (k_)) : rb + 256 + 128 * (33 - (k_))))
#define SSD_ISSUE(k_) do { const int r0n = SSD_R0(k_); \
        _Pragma("unroll") for (int i = 0; i < 4; ++i) { const int item = tid + 512 * i, row = item >> 4, seg = item & 15; const bf16_t* src = XC + (size_t)(r0n + row) * 2048 + g * 128 + seg * 8; pc[i] = *(const u32x4*)(src + 1536); pb[i] = *(const u32x4*)(src + 1024); } \
        { const int row = tid >> 2, seg = tid & 3; pdt = DT[(size_t)(r0n + row) * 32 + d * 16 + hd]; px = *(const u32x4*)(XC + (size_t)(r0n + row) * 2048 + hd * 64 + ph * 32 + seg * 8); } \
        if (w == 0) { pv0 = DT[(size_t)(r0n + rho0) * 32 + d * 16 + hd]; pv1 = DT[(size_t)(r0n + rho1) * 32 + d * 16 + hd]; } } while (0)
    SSD_ISSUE(0);
    unsigned ypk[8]; int yrow = -1;
#pragma unroll
    for (int i = 0; i < 8; ++i) ypk[i] = 0u;
#define SSD_YFLUSH() do { if (w < 4 && yrow >= 0) { bf16_t* yo = YD + (size_t)yrow * 1024 + hd * 64 + ph * 32 + r; \
        _Pragma("unroll") for (int rg = 0; rg < 16; ++rg) yo[(size_t)((rg & 3) + 8 * (rg >> 2)) * 1024] = (bf16_t)((rg & 1) ? (ypk[rg >> 1] >> 16) : (ypk[rg >> 1] & 0xffffu)); } } while (0)
    for (int k = 0; k < 34; ++k) {
        const int r0 = SSD_R0(k);
        __syncthreads();
#pragma unroll
        for (int i = 0; i < 4; ++i) { const int item = tid + 512 * i, row = item >> 4, seg = item & 15; *(LAS u32x4*)(Cs + row * LS + seg * 8) = pc[i]; *(LAS u32x4*)(Bs + row * LS + seg * 8) = pb[i]; }
        { const int row = tid >> 2, seg = tid & 3; const float dtv = pdt; const u32x4 xv = px;
            LAS bf16_t* xo = XdT + (seg * 8) * LS + row;
            xo[0 * LS] = bf16_1(bflo(xv.x) * dtv); xo[1 * LS] = bf16_1(bfhi(xv.x) * dtv); xo[2 * LS] = bf16_1(bflo(xv.y) * dtv); xo[3 * LS] = bf16_1(bfhi(xv.y) * dtv);
            xo[4 * LS] = bf16_1(bflo(xv.z) * dtv); xo[5 * LS] = bf16_1(bfhi(xv.z) * dtv); xo[6 * LS] = bf16_1(bflo(xv.w) * dtv); xo[7 * LS] = bf16_1(bfhi(xv.w) * dtv); }
        if (w == 0) {
            float v0 = pv0 * a, v1 = pv1 * a;
#pragma unroll
            for (int o = 1; o < 64; o <<= 1) { const float t0 = __int_as_float(__builtin_amdgcn_ds_bpermute((lane - o) << 2, __float_as_int(v0))), t1 = __int_as_float(__builtin_amdgcn_ds_bpermute((lane - o) << 2, __float_as_int(v1))); if (lane >= o) { v0 += t0; v1 += t1; } }
            const float tot0 = __int_as_float(__builtin_amdgcn_ds_bpermute(63 << 2, __float_as_int(v0))); v1 += tot0;
            const float cend = __int_as_float(__builtin_amdgcn_ds_bpermute(63 << 2, __float_as_int(v1)));
            csL[rho0] = v0; csL[rho1] = v1; ecsL[rho0] = __builtin_amdgcn_exp2f(v0 * 1.4426950408889634f); ecsL[rho1] = __builtin_amdgcn_exp2f(v1 * 1.4426950408889634f);
            ewL[rho0] = __builtin_amdgcn_exp2f((cend - v0) * 1.4426950408889634f); ewL[rho1] = __builtin_amdgcn_exp2f((cend - v1) * 1.4426950408889634f);
            if (lane == 0) misc[0] = __builtin_amdgcn_exp2f(cend * 1.4426950408889634f);
        }
        if (k + 1 < 34) SSD_ISSUE(k + 1);
        __syncthreads();
        { const int lt = w >> 1;
#pragma unroll
          for (int q = 0; q < 2; ++q) { const int st = (w & 1) * 2 + q; const bool zero = (d == 0) ? (st > lt) : (st < lt);
            f32x16 acc;
#pragma unroll
            for (int i = 0; i < 16; ++i) acc[i] = 0.f;
            if (!zero) { bf16x8 af[8], bfv[8];
#pragma unroll
                for (int ks = 0; ks < 8; ++ks) { af[ks] = *(const LAS bf16x8*)(Cs + (32 * lt + r) * LS + 16 * ks + 8 * h); bfv[ks] = *(const LAS bf16x8*)(Bs + (32 * st + r) * LS + 16 * ks + 8 * h); }
#pragma unroll
                for (int ks = 0; ks < 8; ++ks) acc = __builtin_amdgcn_mfma_f32_32x32x16_bf16(af[ks], bfv[ks], acc, 0, 0, 0); }
            const int scol = 32 * st + r; const float css = csL[scol];
            f32x4 cr4[4];
#pragma unroll
            for (int q4 = 0; q4 < 4; ++q4) cr4[q4] = *(const LAS f32x4*)(csL + 32 * lt + 8 * q4 + 4 * h);
#pragma unroll
            for (int rg = 0; rg < 16; ++rg) { const int lrow = 32 * lt + (rg & 3) + 8 * (rg >> 2) + 4 * h; const bool valid = (d == 0) ? (scol <= lrow) : (scol >= lrow);
                const float ex = __builtin_amdgcn_exp2f(fminf(cr4[rg >> 2][rg & 3] - css, 0.f) * 1.4426950408889634f);
                const float v = valid ? acc[rg] * ex : 0.f; Ms[lrow * LS + scol] = bf16_1(v); } } }
        __syncthreads();
        if (w < 4) { const int lt = w;
            f32x16 acc;
#pragma unroll
            for (int i = 0; i < 16; ++i) acc[i] = 0.f;
            { bf16x8 af[8], bfv[8];
#pragma unroll
              for (int ks = 0; ks < 8; ++ks) { af[ks] = *(const LAS bf16x8*)(Cs + (32 * lt + r) * LS + 16 * ks + 8 * h); bfv[ks] = *(const LAS bf16x8*)(Hb + r * LS + 16 * ks + 8 * h); }
#pragma unroll
              for (int ks = 0; ks < 8; ++ks) acc = __builtin_amdgcn_mfma_f32_32x32x16_bf16(af[ks], bfv[ks], acc, 0, 0, 0); }
            { f32x4 e4[4];
#pragma unroll
              for (int q4 = 0; q4 < 4; ++q4) e4[q4] = *(const LAS f32x4*)(ecsL + 32 * lt + 8 * q4 + 4 * h);
#pragma unroll
              for (int rg = 0; rg < 16; ++rg) acc[rg] *= e4[rg >> 2][rg & 3]; }
            { bf16x8 af[8], bfv[8];
#pragma unroll
              for (int ks = 0; ks < 8; ++ks) { af[ks] = *(const LAS bf16x8*)(Ms + (32 * lt + r) * LS + 16 * ks + 8 * h); bfv[ks] = *(const LAS bf16x8*)(XdT + r * LS + 16 * ks + 8 * h); }
#pragma unroll
              for (int ks = 0; ks < 8; ++ks) { const bool skip = (d == 0) ? (16 * ks >= 32 * (lt + 1)) : (16 * ks + 15 < 32 * lt);
                  if (!skip) acc = __builtin_amdgcn_mfma_f32_32x32x16_bf16(af[ks], bfv[ks], acc, 0, 0, 0); } }
            bf16_t* yo = YD + (size_t)(r0 + 32 * lt + 4 * h) * 1024 + hd * 64 + ph * 32 + r;
#pragma unroll
            for (int rg = 0; rg < 16; ++rg) yo[(size_t)((rg & 3) + 8 * (rg >> 2)) * 1024] = bf16_1(acc[rg]);
        } else { const int nt = w - 4; const float eend = misc[0];
#pragma unroll
            for (int i = 0; i < 16; ++i) hacc[i] *= eend;
            { typedef short v4i16_t_ __attribute__((ext_vector_type(4)));
#pragma unroll
              for (int kh = 0; kh < 2; ++kh) {
              u32x4 xa[8]; f32x4 e0[8], e1[8]; s16x4 t0[8], t1[8];
#pragma unroll
              for (int ks = 4 * kh; ks < 4 * kh + 4; ++ks) { const int k0 = 16 * ks + 8 * h; xa[ks] = *(const LAS u32x4*)(XdT + r * LS + k0); e0[ks] = *(const LAS f32x4*)(ewL + k0); e1[ks] = *(const LAS f32x4*)(ewL + k0 + 4);
                  const LAS bf16_t* tb = Bs + (k0 + ((lane & 15) >> 2)) * LS + 32 * nt + 16 * ((lane >> 4) & 1) + 4 * (lane & 3);
                  t0[ks] = __builtin_bit_cast(s16x4, __builtin_amdgcn_ds_read_tr16_b64_v4i16((LAS v4i16_t_*)tb)); t1[ks] = __builtin_bit_cast(s16x4, __builtin_amdgcn_ds_read_tr16_b64_v4i16((LAS v4i16_t_*)(tb + 4 * LS))); }
#pragma unroll
              for (int ks = 4 * kh; ks < 4 * kh + 4; ++ks) { u32x4 aw;
                  aw.x = cvt_pk_bf16(bflo(xa[ks].x) * e0[ks][0], bfhi(xa[ks].x) * e0[ks][1]); aw.y = cvt_pk_bf16(bflo(xa[ks].y) * e0[ks][2], bfhi(xa[ks].y) * e0[ks][3]); aw.z = cvt_pk_bf16(bflo(xa[ks].z) * e1[ks][0], bfhi(xa[ks].z) * e1[ks][1]); aw.w = cvt_pk_bf16(bflo(xa[ks].w) * e1[ks][2], bfhi(xa[ks].w) * e1[ks][3]);
                  const bf16x8 bw = (bf16x8){t0[ks][0], t0[ks][1], t0[ks][2], t0[ks][3], t1[ks][0], t1[ks][1], t1[ks][2], t1[ks][3]};
                  hacc = __builtin_amdgcn_mfma_f32_32x32x16_bf16(__builtin_bit_cast(bf16x8, aw), bw, hacc, 0, 0, 0); } } }
        }
        __syncthreads();
        if (w >= 4) { const int nt = w - 4;
#pragma unroll
            for (int rg = 0; rg < 16; ++rg) Hb[((rg & 3) + 8 * (rg >> 2) + 4 * h) * LS + 32 * nt + r] = bf16_1(hacc[rg]); }
    }
    __syncthreads();
#undef SSD_R0
#undef SSD_ISSUE
#undef SSD_YFLUSH
}
__device__ __forceinline__ void s5_setup(const Args& A_, Frame& F, int l, int boff = 0) {
    LAS float* Pre = (LAS float*)(F.lds); LAS float* Pim = Pre + 2 * 17 * 64; LAS float* BBr = Pim + 2 * 17 * 64; LAS float* BBi = BBr + 2 * 64 * 16; LAS float* Kt = BBi + 2 * 64 * 16;
    LAS float* CrL = Kt + 8192; LAS float* CiL = CrL + 2048; LAS float* CrT = CiL + 2048; LAS float* CiT = CrT + 2048;
    bf16_t* Bt1 = (bf16_t*)(F.ws + WS_S5M); bf16_t* Bt2 = Bt1 + (size_t)64 * 512 * 256; float* A16 = (float*)(F.ws + WS_S5A);
    const int tid = F.tid;
    for (int g = (int)blockIdx.x - boff; g >= 0 && g < 64; g += F.G) {
        { f32x4 c4[2];
#pragma unroll
          for (int h = 0; h < 2; ++h) { const int e4 = tid * 4 & 1023, d = (tid >> 8); const int pg_ = (l * 2 + d) * 64 + g; c4[h] = *(const f32x4*)((h ? INP(I_CIM) : INP(I_CRE)) + (size_t)pg_ * 1024 + e4); }
          *(LAS f32x4*)(CrL + tid * 4) = c4[0]; *(LAS f32x4*)(CiL + tid * 4) = c4[1];
          const int d = tid >> 8, o = (tid & 255) >> 4, n4 = (tid & 15) * 4;
#pragma unroll
          for (int e = 0; e < 4; ++e) { CrT[(d * 64 + n4 + e) * 16 + o] = c4[0][e]; CiT[(d * 64 + n4 + e) * 16 + o] = c4[1][e]; } }
        for (int q = tid; q < 2 * 17 * 64; q += 512) { const int d = q / (17 * 64), dl = (q >> 6) % 17, n = q & 63; const int pg_ = (l * 2 + d) * 64 + g;
            const float lre = INP(I_LRE)[pg_ * 64 + n], lim = INP(I_LIM)[pg_ * 64 + n], step = expf(INP(I_LSTEP)[pg_]);
            const float mag = expf(lre * step * (float)dl), ang = lim * step * (float)dl; Pre[q] = mag * cosf(ang); Pim[q] = mag * sinf(ang); }
        __syncthreads();
        if (tid < 128) { const int d = tid >> 6, n = tid & 63; const int pg_ = (l * 2 + d) * 64 + g;
            const float lre = INP(I_LRE)[pg_ * 64 + n], lim = INP(I_LIM)[pg_ * 64 + n];
            const float abr = Pre[(d * 17 + 1) * 64 + n], abi = Pim[(d * 17 + 1) * 64 + n];
            const float den = lre * lre + lim * lim; const float kre = ((abr - 1.f) * lre + abi * lim) / den, kim = (abi * lre - (abr - 1.f) * lim) / den;
            const float* br = INP(I_BRE) + ((size_t)pg_ * 64 + n) * 16; const float* bi = INP(I_BIM) + ((size_t)pg_ * 64 + n) * 16;
            f32x4 bq[4], bz[4];
#pragma unroll
            for (int q = 0; q < 4; ++q) { bq[q] = *(const f32x4*)(br + 4 * q); bz[q] = *(const f32x4*)(bi + 4 * q); }
#pragma unroll
            for (int i = 0; i < 16; ++i) { const float x = bq[i >> 2][i & 3], y = bz[i >> 2][i & 3]; BBr[(d * 64 + n) * 16 + i] = kre * x - kim * y; BBi[(d * 64 + n) * 16 + i] = kre * y + kim * x; }
            A16[((d * 64 + g) * 64 + n) * 2] = Pre[(d * 17 + 16) * 64 + n]; A16[((d * 64 + g) * 64 + n) * 2 + 1] = Pim[(d * 17 + 16) * 64 + n]; }
        __syncthreads();
        { const int d = tid >> 8, dl = (tid >> 4) & 15, i = tid & 15;
            f32x4 acc[4] = {{0.f, 0.f, 0.f, 0.f}, {0.f, 0.f, 0.f, 0.f}, {0.f, 0.f, 0.f, 0.f}, {0.f, 0.f, 0.f, 0.f}};
            for (int n = 0; n < 64; ++n) { const float pr = Pre[(d * 17 + dl) * 64 + n], pi = Pim[(d * 17 + dl) * 64 + n], br = BBr[(d * 64 + n) * 16 + i], bi = BBi[(d * 64 + n) * 16 + i];
                const float tr = pr * br - pi * bi, ti = pr * bi + pi * br;
#pragma unroll
                for (int o4 = 0; o4 < 4; ++o4) { const f32x4 cr = *(const LAS f32x4*)(CrT + (d * 64 + n) * 16 + 4 * o4), ci = *(const LAS f32x4*)(CiT + (d * 64 + n) * 16 + 4 * o4); acc[o4] += cr * tr - ci * ti; } }
#pragma unroll
            for (int o = 0; o < 16; ++o) Kt[((d * 16 + dl) * 16 + o) * 16 + i] = acc[o >> 2][o & 3]; }
        __syncthreads();
        const float dsk = INP(I_S5D)[l * 1024 + 16 * g + (tid & 15)];
        for (int q = 0; q < 16; ++q) { const int item = tid + 512 * q; const int c1 = item >> 5, kb = (item & 31) * 8; const int rin = kb >> 4, i0 = kb & 15, rout = c1 >> 4, o = c1 & 15;
            const float dsko = __int_as_float(__builtin_amdgcn_ds_bpermute((((F.lane & ~15) | o)) << 2, __float_as_int(dsk)));
            float v[8];
#pragma unroll
            for (int e = 0; e < 8; ++e) { const int i = i0 + e; float x = 0.f; if (rout >= rin) x += Kt[((0 * 16 + (rout - rin)) * 16 + o) * 16 + i]; if (rin >= rout) x += Kt[((1 * 16 + (rin - rout)) * 16 + o) * 16 + i];
                if (rin == rout && i == o) x += dsko; v[e] = x; }
            u32x4 w; w.x = cvt_pk_bf16(v[0], v[1]); w.y = cvt_pk_bf16(v[2], v[3]); w.z = cvt_pk_bf16(v[4], v[5]); w.w = cvt_pk_bf16(v[6], v[7]);
            *(u32x4*)(Bt1 + ((size_t)g * 512 + c1) * 256 + kb) = w; }
        for (int q = 0; q < 16; ++q) { const int item = tid + 512 * q; const int c1 = item >> 5, kb = (item & 31) * 8; const int rin = kb >> 4, i0 = kb & 15; const int d = c1 >> 7, part = c1 & 1, n = (c1 >> 1) & 63;
            const int ex = (d == 0) ? 15 - rin : rin; const float pr = Pre[(d * 17 + ex) * 64 + n], pi = Pim[(d * 17 + ex) * 64 + n];
            float v[8];
#pragma unroll
            for (int e = 0; e < 8; ++e) { const float br = BBr[(d * 64 + n) * 16 + i0 + e], bi = BBi[(d * 64 + n) * 16 + i0 + e]; v[e] = part ? (pr * bi + pi * br) : (pr * br - pi * bi); }
            u32x4 w; w.x = cvt_pk_bf16(v[0], v[1]); w.y = cvt_pk_bf16(v[2], v[3]); w.z = cvt_pk_bf16(v[4], v[5]); w.w = cvt_pk_bf16(v[6], v[7]);
            *(u32x4*)(Bt1 + ((size_t)g * 512 + 256 + c1) * 256 + kb) = w; }
        for (int q = 0; q < 16; ++q) { const int item = tid + 512 * q; const int c2 = item >> 5, kb = (item & 31) * 8; const int rout = c2 >> 4, o = c2 & 15; const int d = kb >> 7, part = (kb >> 6) & 1, n0 = kb & 63;
            const int ex = (d == 0) ? rout + 1 : 16 - rout; const LAS float* cr = CrL + (d * 16 + o) * 64 + n0; const LAS float* ci = CiL + (d * 16 + o) * 64 + n0;
            float v[8];
#pragma unroll
            for (int e = 0; e < 8; ++e) { const float pr = Pre[(d * 17 + ex) * 64 + n0 + e], pi = Pim[(d * 17 + ex) * 64 + n0 + e]; v[e] = part ? -(cr[e] * pi + ci[e] * pr) : (cr[e] * pr - ci[e] * pi); }
            u32x4 w; w.x = cvt_pk_bf16(v[0], v[1]); w.y = cvt_pk_bf16(v[2], v[3]); w.z = cvt_pk_bf16(v[4], v[5]); w.w = cvt_pk_bf16(v[6], v[7]);
            *(u32x4*)(Bt2 + ((size_t)g * 256 + c2) * 256 + kb) = w; }
        __syncthreads();
    }
}
__device__ __forceinline__ void s5_carry(Frame& F, int cid) {
    const int b = cid >> 7, d = (cid >> 6) & 1, g = cid & 63, n = F.lane;
    const unsigned* ST = (const unsigned*)((const bf16_t*)(F.ws + WS_S5ST) + ((size_t)g * S5M + b * 272) * 256 + d * 128) + n;
    bf16_t* HP = (bf16_t*)(F.ws + WS_S5H) + ((size_t)g * 1280 + b * 272) * 256 + d * 128 + n;
    const float* A16 = (const float*)(F.ws + WS_S5A); const float ar = A16[((d * 64 + g) * 64 + n) * 2], ai = A16[((d * 64 + g) * 64 + n) * 2 + 1];
    float hr = 0.f, hi_ = 0.f;
    for (int k0 = 0; k0 < 272; k0 += 34) {
        unsigned wv[34];
#pragma unroll
        for (int e = 0; e < 34; ++e) { const int k = k0 + e; const int cc = (d == 0) ? k : (k < 16 ? 15 - k : 287 - k); wv[e] = ST[(size_t)cc * 128]; }
        asm volatile("s_waitcnt vmcnt(0)" ::: "memory");
#pragma unroll
        for (int e = 0; e < 34; ++e) { const int k = k0 + e; const int cc = (d == 0) ? k : (k < 16 ? 15 - k : 287 - k);
            HP[(size_t)cc * 256] = (bf16_t)(cvt_pk_bf16(hr, 0.f) & 0xffffu); HP[(size_t)cc * 256 + 64] = (bf16_t)(cvt_pk_bf16(hi_, 0.f) & 0xffffu);
            const float sr = bflo(wv[e]), si = bfhi(wv[e]); const float nr = ar * hr - ai * hi_ + sr, ni = ar * hi_ + ai * hr + si; hr = nr; hi_ = ni; }
    }
}
__device__ __forceinline__ void mixer_finalize(const Args& A_, Frame& F, int l) {
    bf16_t* P = (bf16_t*)(F.ws + WS_PROJ);
    const bf16_t* XC = (const bf16_t*)(F.ws + WS_HM); const bf16_t* YD0 = (const bf16_t*)(F.ws + WS_YD); const bf16_t* YD1 = YD0 + (size_t)R * 1024;
        const int c0 = F.lane * 16;
    for (int row = F.gw; row < R; row += F.NGW) {
        { const float dsk = INP(I_SSDD)[l * 16 + (c0 >> 6)];
          const float* nwp = INP(I_SSDN) + l * 1024 + c0;
          float v[16];
#pragma unroll
          for (int hh = 0; hh < 2; ++hh) { const u32x4 x = *(const u32x4*)(XC + (size_t)row * 2048 + c0 + 8 * hh), y0 = *(const u32x4*)(YD0 + (size_t)row * 1024 + c0 + 8 * hh), y1 = *(const u32x4*)(YD1 + (size_t)row * 1024 + c0 + 8 * hh), z = *(const u32x4*)(P + (size_t)row * LDP + PZ + c0 + 8 * hh);
#define SG(i, wx, wy0, wy1, wz) v[8 * hh + 2 * (i)] = (bflo(wx) * dsk + bflo(wy0) + bflo(wy1)) * bflo(wz); v[8 * hh + 2 * (i) + 1] = (bfhi(wx) * dsk + bfhi(wy0) + bfhi(wy1)) * bfhi(wz);
              SG(0, x.x, y0.x, y1.x, z.x) SG(1, x.y, y0.y, y1.y, z.y) SG(2, x.z, y0.z, y1.z, z.z) SG(3, x.w, y0.w, y1.w, z.w)
#undef SG
          }
          float ss = 0.f;
#pragma unroll
          for (int e = 0; e < 16; ++e) ss += v[e] * v[e];
          ss += shx(ss, 1, F.lane); ss += shx(ss, 2, F.lane); ss += shx(ss, 4, F.lane); ss += shx(ss, 8, F.lane);
          const float rs = 1.0f / sqrtf(ss * (1.f / 256.f) + RMS_EPS);
          const f32x4 n0 = *(const f32x4*)(nwp), n1 = *(const f32x4*)(nwp + 4), n2 = *(const f32x4*)(nwp + 8), n3 = *(const f32x4*)(nwp + 12);
          const float nw[16] = {n0[0], n0[1], n0[2], n0[3], n1[0], n1[1], n1[2], n1[3], n2[0], n2[1], n2[2], n2[3], n3[0], n3[1], n3[2], n3[3]};
          u32x4 o0, o1;
          o0.x = cvt_pk_bf16(v[0] * rs * nw[0], v[1] * rs * nw[1]); o0.y = cvt_pk_bf16(v[2] * rs * nw[2], v[3] * rs * nw[3]); o0.z = cvt_pk_bf16(v[4] * rs * nw[4], v[5] * rs * nw[5]); o0.w = cvt_pk_bf16(v[6] * rs * nw[6], v[7] * rs * nw[7]);
          o1.x = cvt_pk_bf16(v[8] * rs * nw[8], v[9] * rs * nw[9]); o1.y = cvt_pk_bf16(v[10] * rs * nw[10], v[11] * rs * nw[11]); o1.z = cvt_pk_bf16(v[12] * rs * nw[12], v[13] * rs * nw[13]); o1.w = cvt_pk_bf16(v[14] * rs * nw[14], v[15] * rs * nw[15]);
          *(u32x4*)(P + (size_t)row * LDP + PV + c0) = o0; *(u32x4*)(P + (size_t)row * LDP + PV + c0 + 8) = o1; }
    }
}


__global__ void __launch_bounds__(NWAVES * 64, 2) trunk_fwd(Args args) {
    extern __shared__ __attribute__((aligned(16))) unsigned char lds_raw[];
    Frame F;
    F.lds = (LAS unsigned char*)lds_raw;
    F.tid = threadIdx.x; F.lane = F.tid & 63; F.wave = __builtin_amdgcn_readfirstlane(F.tid >> 6);
    F.G = gridDim.x; { const int bx = blockIdx.x; F.vcu = (F.G % 8 == 0) ? (bx % 8) * (F.G / 8) + bx / 8 : bx; }
    F.gw = F.vcu * NWAVES + F.wave; F.NGW = F.G * NWAVES;
    F.ws = args.ws;
    volatile LAS unsigned* MISC = (volatile LAS unsigned*)(F.lds + MISC_OFF);
    for (int u = F.tid; u < (LDS_BYTES - LDSCTL_OFF) / 4; u += NWAVES * 64) ((LAS unsigned*)(F.lds + LDSCTL_OFF))[u] = 0u;
    __syncthreads();
    if (threadIdx.x < 32) ((LAS unsigned long long*)(F.lds + INTAB_OFF))[threadIdx.x] = (unsigned long long)args.in[threadIdx.x];
    __syncthreads();
    (void)xcd_barrier_post((unsigned*)(args.ws + WS_CTL) + CW_BAR, MISC + 8);
    const int lo = args.ph_lo, hi = args.ph_hi;
    const int wave0 = __builtin_amdgcn_readfirstlane((int)threadIdx.x >> 6);
    int pid = 0;
#define PH_BEGIN if (pid >= lo && pid < hi) { GAS unsigned char* wsg_ = (GAS unsigned char*)args.ws; int tid_; asm volatile("v_mbcnt_lo_u32_b32 %1, -1, 0\n\tv_mbcnt_hi_u32_b32 %1, -1, %1 ; PHASE_MARK_BEGIN %2" : "+s"(wsg_), "=v"(tid_) : "i"(__LINE__) : "memory"); tid_ += wave0 * 64; unsigned char* ws = (unsigned char*)wsg_; F.ws = ws; F.tid = tid_; F.lane = tid_ & 63; F.wave = __builtin_amdgcn_readfirstlane(tid_ >> 6); F.gw = F.vcu * NWAVES + F.wave;
#define PH_END   asm volatile("; PHASE_MARK_END %0" :: "i"(__LINE__)); if (pid + 1 < hi) { XcdBarrier bar_; bar_.bar = (unsigned*)(args.ws + WS_CTL) + CW_BAR; bar_.x = xb_xcc_id(); bar_.st = (volatile LAS unsigned*)(F.lds + MISC_OFF) + 8; xcd_barrier(bar_, wave0 * 64 + lane_now()); } } ++pid;

#define MOD ((float*)(ws + WS_MOD))
#define Hbuf ((float*)(ws + WS_H))
#define HM ((bf16_t*)(ws + WS_HM))
#define PROJ ((bf16_t*)(ws + WS_PROJ))
#define ROPEC ((float*)(ws + WS_ROPE))
#define ROPES (ROPEC + 1024)
#define WGT (ws + WS_W)

    PH_BEGIN
        s5_setup(args, F, 0);
        mod_partials(args, F);
        if ((int)blockIdx.x == F.G - 1) {
            { float* idn = (float*)(ws + WS_IDENT); for (int i = F.tid; i < 2048; i += NWAVES * 64) { idn[i] = 1.0f; idn[2048 + i] = 0.0f; } }
#pragma unroll
            for (int i2 = 0; i2 < 2; ++i2) { const int idx = (F.wave * 2 + i2) * 64 + F.lane, pos = idx >> 4, f = idx & 15; const float inv = powf(10000.0f, -(float)f / 16.0f); const float ang = (float)pos * inv; ROPEC[idx] = cosf(ang); ROPES[idx] = sinf(ang); } }
    PH_END
    PH_BEGIN
        convert_layer_weights(args, F, 0);
        ln_pass(F, false, nullptr, nullptr, MOD, nullptr, INP(I_X), INP(I_CTX));
    PH_END

    for (int s = 0; s < 6; ++s) {
        const int l = s / 3, j = s - 3 * l;
        if (j != 1) {
            const int f = j >> 1;
            PH_BEGIN
                const int lat = (l == 1 && j == 2); pg8::Gemm g{D, D, D}; pg8::StaticOrder S; S.init(lat ? 64 : NPAN, N13 / 256, F.G, (int)blockIdx.x, HM, D, (const bf16_t*)(WGT + W_13) + (size_t)f * N13 * D, D, D, lat);
                EpiSwiGLU E{PROJ};
                pg8::gemm_phase<EpiSwiGLU, pg8::StaticOrder>(F.lds + RING_OFF, g, S, E, F.tid);
            PH_END
        } else {
            PH_BEGIN
                pg8::Gemm g{D, D, D}; pg8::StaticOrder S;
                if (l == 0) S.init(NPAN, LDP / 256, F.G, (int)blockIdx.x, HM, D, (const bf16_t*)(WGT + W_IN), D, D);
                else { S.init(64, LDP / 256, F.G, (int)blockIdx.x, HM, D, (const bf16_t*)(WGT + W_IN), D, D, 1, 80); S.cproj = 1; }
                EpiProj E{PROJ, (float*)(ws + WS_DT), ROPEC, ROPES, (bf16_t*)(ws + WS_O)};
                pg8::gemm_phase<EpiProj, pg8::StaticOrder>(F.lds + RING_OFF, g, S, E, F.tid);
                { const int nfull = ((l == 0 ? NPAN * (LDP / 256) : 64 * (LDP / 256) + 80)) % F.G;
                  if ((int)blockIdx.x >= nfull) { const int nw = (F.G - nfull) * NWAVES; for (int t = ((int)blockIdx.x - nfull) * NWAVES + F.wave; t < R / 32; t += nw) dt_tile(F, l, t); } }
            PH_END
            PH_BEGIN
                ssd_conv_pass(args, F, l);
                asm volatile("" : "+v"(F.tid));
                { pg8::Gemm g{256, 256, 256}; S5AOrder S{F.G, (int)blockIdx.x, (const char*)(ws + WS_O), (const char*)(ws + WS_S5M)};
                  EpiS5A E{(unsigned char*)(ws + WS_YS), (bf16_t*)(ws + WS_S5ST)};
                  pg8::gemm_phase<EpiS5A, S5AOrder>(F.lds + RING_OFF, g, S, E, F.tid); }
            PH_END
            PH_BEGIN
                if (F.wave < 2) s5_carry(F, (int)blockIdx.x * 2 + F.wave);
                ssd_chain_fast(args, F, l, (int)blockIdx.x);
                {
                    const float lam_init = 0.8f - 0.6f * expf(-0.3f * (float)l);
                    const float* lv = INP(I_ALAM) + l * 256;
                    const float s01 = wave_sum(lv[F.lane] * lv[64 + F.lane], F.lane), s23 = wave_sum(lv[128 + F.lane] * lv[192 + F.lane], F.lane);
                    const float lam = expf(s01) - expf(s23) + lam_init;
                    for (int i = 0;; ++i) { const int idx = i * F.G + F.vcu; if (idx >= 512 + (l == 0 ? 32 : 0)) break;
                        int b, h, q0, seq;
                        if (idx < 512) { b = idx >> 7; h = (idx >> 4) & 7; q0 = b * RB + CTX + (idx & 15) * 256; seq = RB; }
                        else { const int k = idx - 512; b = k >> 3; h = k & 7; q0 = b * RB; seq = CTX; }
                        const bf16_t* Q0 = PROJ + (size_t)q0 * LDP + PQ + h * 128; const bf16_t* Kh = PROJ + (size_t)(b * RB) * LDP + PK + h * 128; const bf16_t* Vh = PROJ + (size_t)(b * RB) * LDP + PV + h * 128;
                        attn128::unit((const attn128::bf16*)Q0, (const attn128::bf16*)Kh, (const attn128::bf16*)Vh, PROJ + (size_t)q0 * LDP + PQ + h * 128, seq, (char*)lds_raw + RING_OFF, F.tid, lam, 1.0f - lam_init, INP(I_ASUB) + l * 128);
                    }
                }
            PH_END
            PH_BEGIN
                mixer_finalize(args, F, l);
                asm volatile("" : "+v"(F.tid));
                { pg8::Gemm g{256, 256, 256}; S5COrder S{F.G, (int)blockIdx.x, (const char*)(ws + WS_S5H), (const char*)((bf16_t*)(ws + WS_S5M) + (size_t)64 * 512 * 256)};
                  EpiS5C E{(const unsigned char*)(ws + WS_YS), PROJ};
                  pg8::gemm_phase<EpiS5C, S5COrder>(F.lds + RING_OFF, g, S, E, F.tid); }
            PH_END
            PH_BEGIN
                pg8::Gemm g{LDP, 1024, 1024}; pg8::StaticOrder S; S.init(l == 1 ? 64 : NPAN, 4, F.G, (int)blockIdx.x, PROJ + PU, LDP, (const bf16_t*)(WGT + W_GLU), 1024, 1024, l == 1);
                EpiGlu E{PROJ, INP(I_GLUB) + l * 1024};
                pg8::gemm_phase<EpiGlu, pg8::StaticOrder>(F.lds + RING_OFF, g, S, E, F.tid);
            PH_END
            PH_BEGIN
                pg8::Gemm g{LDP, 3072, 3072}; pg8::StaticOrder S; S.init(l == 1 ? 64 : NPAN, 8, F.G, (int)blockIdx.x, PROJ, LDP, (const bf16_t*)(WGT + W_B), 3072, 3072, l == 1);
                EpiMerge E{PROJ, HM};
                pg8::gemm_phase<EpiMerge, pg8::StaticOrder, 0, true>(F.lds + RING_OFF, g, S, E, F.tid);
            PH_END
        }
        PH_BEGIN
            const int RK = (j == 1) ? D : DFF; const bf16_t* RA = (j == 1) ? HM : PROJ; const bf16_t* RBt = (j == 1) ? (const bf16_t*)(WGT + W_O) : (const bf16_t*)(WGT + W_2) + (size_t)(j >> 1) * D * DFF;
            const int lat = (l == 1 && j >= 1); pg8::Gemm g{RK, RK, RK}; pg8::StaticOrder S; S.init(64, D / 256, F.G, (int)blockIdx.x, RA, RK, RBt, RK, RK, 1, lat ? 0 : 128);
            const float* lg_ = (s == 0) ? (const float*)(ws + WS_IDENT) : INP(I_LNG) + (size_t)(s - 1) * D; const float* lb_ = (s == 0) ? (const float*)(ws + WS_IDENT) + 2048 : INP(I_LNB) + (size_t)(s - 1) * D;
            EpiResid E{(_Float16*)(ws + WS_H), (float*)(ws + WS_HC), MOD + (size_t)l * 5 * NMOD + (3 * j + 2) * D, lg_, lb_, (const float*)(ws + WS_STATS)};
            pg8::gemm_phase<EpiResid, pg8::StaticOrder>(F.lds + RING_OFF, g, S, E, F.tid);
        PH_END
        PH_BEGIN
            const bool fin = (s == 5);
            const int ln_ = (j == 2) ? l + 1 : l, jn = (j == 2) ? 0 : j + 1;
            ln_pass(F, true, INP(I_LNG) + (size_t)(l * 3 + j) * D, INP(I_LNB) + (size_t)(l * 3 + j) * D, fin ? nullptr : MOD + (size_t)ln_ * 5 * NMOD + 3 * jn * D, fin ? args.out : nullptr, nullptr, nullptr, (l == 1 && j >= 1) ? 0 : 4);
            if (s == 2) { s5_setup(args, F, 1); __syncthreads(); convert_layer_weights(args, F, 1); }
        PH_END
    }
#undef PH_BEGIN
#undef PH_END
}

static int count_phases() { int n = 2; for (int s = 0; s < 6; ++s) n += ((s % 3) != 1 ? 1 : 6) + 2; return n; }
extern "C" void kernel_launch(void* const* d_in, const int* in_sizes, int n_in, void* d_out, int out_size, void* d_ws, size_t ws_size, hipStream_t stream) {
    static int grid = 0;
    if (grid == 0) {
        if (n_in != 32 || out_size != NB * SEQ * D || ws_size < WS_END) { fprintf(stderr, "kernel_launch: unexpected shapes (n_in %d, out %d, ws %zu < %zu)\n", n_in, out_size, ws_size, (size_t)WS_END); grid = -1; return; }
        int dev = 0, cus = 0, per_cu = 0;
        if (hipGetDevice(&dev) != hipSuccess || hipDeviceGetAttribute(&cus, hipDeviceAttributeMultiprocessorCount, dev) != hipSuccess) { grid = -1; return; }
        if (hipFuncSetAttribute((const void*)trunk_fwd, hipFuncAttributeMaxDynamicSharedMemorySize, LDS_BYTES) != hipSuccess) { fprintf(stderr, "kernel_launch: hipFuncSetAttribute failed\n"); grid = -1; return; }
        if (hipOccupancyMaxActiveBlocksPerMultiprocessor(&per_cu, (const void*)trunk_fwd, NWAVES * 64, LDS_BYTES) != hipSuccess || per_cu < 1) fprintf(stderr, "kernel_launch: occupancy query says %d\n", per_cu);
        (void)hipGetLastError();
        if (cus != 256) { fprintf(stderr, "kernel_launch: this kernel deals its SSD chains / carries / attention units over exactly 256 workgroups (one per CU); device reports %d CUs; nothing launched\n", cus); grid = -1; return; }
        grid = cus;
    }
    if (grid < 0) return;
    (void)in_sizes;
    if (hipMemsetAsync((char*)d_ws + WS_CTL, 0, 2 * MiB  , stream) != hipSuccess) return;
    Args a{};
    for (int i = 0; i < 32; ++i) a.in[i] = (const float*)d_in[i];
    a.out = (float*)d_out; a.ws = (unsigned char*)d_ws;
    const int nph = count_phases();
#if MK_PER_PHASE
    for (int p = 0; p < nph; ++p) { a.ph_lo = p; a.ph_hi = p + 1; hipLaunchKernelGGL(trunk_fwd, dim3(grid), dim3(NWAVES * 64), LDS_BYTES, stream, a); }
#else
    a.ph_lo = 0; a.ph_hi = nph;
    hipLaunchKernelGGL(trunk_fwd, dim3(grid), dim3(NWAVES * 64), LDS_BYTES, stream, a);
#endif
    const hipError_t le = hipPeekAtLastError();
    if (le != hipSuccess) fprintf(stderr, "kernel_launch: launch failed: %s\n", hipGetErrorName(le));
}
```

```cpp
#include <hip/hip_runtime.h>
#include <hip/hip_bf16.h>
#include <cstdio>
#include <cstdint>
#include <cmath>

#ifndef MK_PER_PHASE
#define MK_PER_PHASE 0
#endif

#define LAS __attribute__((address_space(3)))
#define GAS __attribute__((address_space(1)))
typedef unsigned short bf16_t;
typedef short bf16x8 __attribute__((ext_vector_type(8)));
typedef float f32x4 __attribute__((ext_vector_type(4)));
typedef float f32x2 __attribute__((ext_vector_type(2)));
typedef float f32x16 __attribute__((ext_vector_type(16)));
typedef unsigned u32x4 __attribute__((ext_vector_type(4)));
typedef unsigned u32x2 __attribute__((ext_vector_type(2)));
typedef short s16x4 __attribute__((ext_vector_type(4)));

constexpr int NB = 4, SEQ = 4096, CTX = 256, RB = SEQ + CTX  , R = NB * RB  , NPAN = R / 256  , PPB = RB / 256  ;
constexpr int D = 2048, DFF = 5632, N13 = 2 * DFF, NMOD = 9 * D  ;
constexpr int LDP = 13312;
constexpr int NIN = 13568;
constexpr int PQ = 0, PK = 1024, PV = 2048, PZ = 3072, PX = 4096, PU = 6144, PG = 7168;
constexpr float DN_ALPHA = 1.41421356237309515f;
constexpr float LN_EPS = 1e-5f, RMS_EPS = 1e-6f;
constexpr float QSCALE = 0.125f * 1.4426950408889634f;

constexpr size_t MiB = 1u << 20;
constexpr size_t WS_CTL = 0, CTL_ZERO_BYTES = 1 * MiB;
constexpr size_t WS_MOD = 1 * MiB;
constexpr size_t WS_ROPE = 2 * MiB;
constexpr size_t WS_STATS = 2 * MiB + 65536;
constexpr size_t WS_IDENT = 2 * MiB + 262144;
constexpr size_t WS_MODP = 3 * MiB;
constexpr size_t WS_DT = 15 * MiB;
constexpr size_t WS_H = 18 * MiB;
constexpr size_t WS_HC = WS_H + 68 * MiB;
constexpr size_t WS_HM = 154 * MiB;
constexpr size_t WS_PROJ = 222 * MiB;
constexpr size_t WS_O = 664 * MiB;
constexpr size_t WS_YD = 732 * MiB;
constexpr size_t WS_YS = 800 * MiB;
constexpr size_t WS_W = 868 * MiB;
constexpr size_t W_13 = 0, W_2 = 88 * MiB, W_IN = 132 * MiB, W_B = 185 * MiB, W_O = 197 * MiB, W_GLU = 205 * MiB;
constexpr size_t WS_S5ST = 1075 * MiB;
constexpr size_t WS_S5H = 1143 * MiB;
constexpr size_t WS_S5M = 1183 * MiB;
constexpr size_t WS_S5A = 1207 * MiB;
constexpr size_t WS_GQ0 = WS_O + 34 * MiB, WS_GQ1 = WS_S5ST + 34 * MiB  , WS_GQ2 = 1208 * MiB;
constexpr size_t WS_END = 1242 * MiB;
__device__ __forceinline__ size_t gq_off(int j) { return j == 0 ? WS_GQ0 : (j == 1 ? WS_GQ1 : WS_GQ2); }
constexpr int S5M = 1088;
constexpr int CW_BAR = 4096;
constexpr size_t WS_KM = WS_CTL + 512 * 1024;

__device__ __forceinline__ unsigned cvt_pk_bf16(float lo, float hi) { unsigned r; asm volatile("v_cvt_pk_bf16_f32 %0, %1, %2" : "=v"(r) : "v"(lo), "v"(hi)); return r; }
__device__ __forceinline__ float bflo(unsigned u) { return __uint_as_float(u << 16); }
__device__ __forceinline__ float bfhi(unsigned u) { return __uint_as_float(u & 0xffff0000u); }
__device__ __forceinline__ float bf1(bf16_t h) { return __uint_as_float((unsigned)h << 16); }
typedef _Float16 h16x2 __attribute__((ext_vector_type(2)));
typedef _Float16 h16x4 __attribute__((ext_vector_type(4)));
typedef _Float16 h16x8 __attribute__((ext_vector_type(8)));
__device__ __forceinline__ f32x4 ld_h4(const _Float16* p) { const h16x4 h = *(const h16x4*)p; return (f32x4){(float)h[0], (float)h[1], (float)h[2], (float)h[3]}; }
__device__ __forceinline__ void st_h4(_Float16* p, f32x4 v) { h16x4 h; h[0] = (_Float16)v[0]; h[1] = (_Float16)v[1]; h[2] = (_Float16)v[2]; h[3] = (_Float16)v[3]; *(h16x4*)p = h; }
__device__ __forceinline__ float sigmoidf_(float x) { return __builtin_amdgcn_rcpf(1.0f + __builtin_amdgcn_exp2f(-1.4426950408889634f * x)); }
__device__ __forceinline__ float siluf_(float x) { return x * sigmoidf_(x); }
__device__ __forceinline__ int lane_now() { int l; asm volatile("v_mbcnt_lo_u32_b32 %0, -1, 0\n\tv_mbcnt_hi_u32_b32 %0, -1, %0" : "=v"(l)); return l; }
__device__ __forceinline__ float shx(float v, int m, int lane) { return __int_as_float(__builtin_amdgcn_ds_bpermute((lane ^ m) << 2, __float_as_int(v))); }
__device__ __forceinline__ float wave_sum(float v, int lane) {
#pragma unroll
    for (int o = 1; o < 64; o <<= 1) v += shx(v, o, lane);
    return v;
}
#define LDS_WAIT() asm volatile("s_waitcnt lgkmcnt(0)" ::: "memory")
#define VM_WAIT() asm volatile("s_waitcnt vmcnt(0)" ::: "memory")

namespace pg8 {
constexpr int BM = 256, BK = 64, HALF = 128, HTB = HALF * BK * 2, STAGE_BYTES = 8 * HTB, NXCD = 8, WGM = 8, PPB_ = 17;
__host__ __device__ __forceinline__ int lds_byte(int r, int c) { const int st = (r >> 4) * 2 + (c >> 5), rr = r & 15, cc = c & 31, ob = rr * 64 + cc * 2; return st * 1024 + (ob ^ (((ob >> 9) & 1) << 5)); }
__host__ __device__ __forceinline__ int perm32(int rho) { const int n = rho >> 4, i = rho & 15; return 8 * (i >> 2) + 4 * n + (i & 3); }
__host__ __device__ __forceinline__ void stage_rc(int b, int& R_, int& C_) { const int st = b / 1024, sb = b % 1024, swz = sb ^ (((sb >> 9) & 1) << 5); R_ = (st >> 1) * 16 + swz / 64; C_ = (st & 1) * 32 + (swz % 64) / 2; }

struct Unit { int pm, pn, aux, kt; const char* a; const char* b; };
struct Gemm { int lda, ldb, K; };

__device__ __forceinline__ void xcd_remap(int L, int nM, int nN, int& pm, int& pn) {
    const int nwg = nM * nN; int wgid = L;
    { const int q = nwg / NXCD, r = nwg % NXCD, xcd = wgid % NXCD, off = wgid / NXCD; wgid = (xcd < r ? xcd * (q + 1) : r * (q + 1) + (xcd - r) * q) + off; }
    const int nig = WGM * nN, gid = wgid / nig, fm = gid * WGM, gsz = (nM - fm) < WGM ? (nM - fm) : WGM;
    pm = fm + ((wgid % nig) % gsz); pn = (wgid % nig) / gsz;
}
struct StaticOrder {
    int nM, nN, nwg, G, c, kt, latonly, nctx, cproj; const char* A; const char* B; size_t tA, tB;
    __device__ __forceinline__ void init(int nM_, int nN_, int G_, int c_, const void* A_, int lda, const void* B_, int ldb, int K, int latonly_ = 0, int nctx_ = 0) { nM = nM_; nN = nN_; nwg = nM * nN; G = G_; c = c_; kt = K / BK; latonly = latonly_; nctx = nctx_; cproj = 0;
        A = (const char*)A_; B = (const char*)B_; tA = (size_t)BM * lda * 2; tB = (size_t)BM * ldb * 2; }
    __device__ __forceinline__ bool next(int i, Unit& u) const {
        const long L = (long)i * G + c;
        if (L < nwg) { xcd_remap((int)L, nM, nN, u.pm, u.pn); if (latonly) u.pm += (u.pm >> 4) + 1; u.aux = 0; u.kt = kt; u.a = A + (size_t)u.pm * tA; u.b = B + (size_t)u.pn * tB; return true; }
        const int x = (int)(L - nwg); if (x >= nctx) return false;
        if (cproj) {
            const int p = x / 20, t2 = x - 20 * p; u.pm = PPB_ * p; u.pn = (t2 < 8) ? 4 + t2 : 8 + t2; u.aux = 0; u.kt = kt; u.a = A + (size_t)u.pm * tA; u.b = B + (size_t)u.pn * tB; return true; }
        const int q = x & 3, t2 = x >> 2; u.pm = PPB_ * (t2 / nN); u.pn = t2 % nN; u.aux = 1 + q; u.kt = kt >> 2;
        u.a = A + (size_t)u.pm * tA + (size_t)q * (kt >> 2) * BK * 2; u.b = B + (size_t)u.pn * tB + (size_t)q * (kt >> 2) * BK * 2; return true;
    }
};
template <class Epi, class Sched, int AMODE = 0, bool HOOK = false>
__device__ __forceinline__ void gemm_phase(LAS unsigned char* lds, const Gemm g, const Sched& S, const Epi& E, const int tid) {
    const int wid = __builtin_amdgcn_readfirstlane(tid >> 6), lane = tid & 63, wr = wid >> 2, wc = wid & 3, fr = lane & 15, fq = lane >> 4;
    unsigned voffA[2], voffB[2];
#pragma unroll
    for (int i = 0; i < 2; ++i) { int R_, C_; stage_rc(tid * 16 + i * 8192, R_, C_);
        voffA[i] = (AMODE == 1) ? (unsigned)((R_ * 16 + (C_ >> 4)) * LDP + (C_ & 15)) * 2u : (unsigned)(R_ * g.lda + C_) * 2u; voffB[i] = (unsigned)((Epi::PERM ? ((R_ & ~31) + perm32(R_ & 31)) : R_) * g.ldb + C_) * 2u; }
    const size_t kstep = (size_t)(BK * 2), kstepA = (AMODE == 1) ? (size_t)(4 * LDP * 2) : kstep;
    const size_t hstepA = (AMODE == 1) ? (size_t)HALF * 16 * LDP * 2 : (size_t)HALF * g.lda * 2, hstepB = (size_t)HALF * g.ldb * 2;
    const unsigned ldsw = (unsigned)wid * 1024u;
    const int aoff = lds_byte(wr * 64 + fr, fq * 8), boff = lds_byte(wc * 32 + fr, fq * 8);
#define PG8_SA(b, h) (((b) * 2 + (h)) * HTB)
#define PG8_SB(b, h) ((4 + (b) * 2 + (h)) * HTB)
#define PG8_STAGE(bufoff, gbase, voff) do { _Pragma("unroll") for (int _i = 0; _i < 2; ++_i) \
        __builtin_amdgcn_global_load_lds((const unsigned*)((const char*)(gbase) + (voff)[_i]), (LAS unsigned*)(lds + (bufoff) + ldsw + _i * 8192), 16, 0, 0); } while (0)
#define PG8_LDA(dst, b, h) do { _Pragma("unroll") for (int m = 0; m < 4; ++m) _Pragma("unroll") for (int k = 0; k < 2; ++k) dst[m][k] = *(const LAS bf16x8*)(lds + PG8_SA(b, h) + aoff + m * 2048 + k * 1024); } while (0)
#define PG8_LDB(dst, b, h) do { _Pragma("unroll") for (int n = 0; n < 2; ++n) _Pragma("unroll") for (int k = 0; k < 2; ++k) dst[n][k] = *(const LAS bf16x8*)(lds + PG8_SB(b, h) + boff + n * 2048 + k * 1024); } while (0)
#define PG8_MMA(ai, bj, At, Bt) do { __builtin_amdgcn_s_setprio(1); _Pragma("unroll") for (int m = 0; m < 4; ++m) _Pragma("unroll") for (int n = 0; n < 2; ++n) _Pragma("unroll") for (int k = 0; k < 2; ++k) \
        acc[ai][bj][m][n] = __builtin_amdgcn_mfma_f32_16x16x32_bf16(Bt[n][k], At[m][k], acc[ai][bj][m][n], 0, 0, 0); __builtin_amdgcn_s_setprio(0); } while (0)
#define PG8_WAIT_V(n) asm volatile("s_waitcnt vmcnt(" #n ")" ::: "memory")
#define PG8_WAIT_L(n) asm volatile("s_waitcnt lgkmcnt(" #n ")" ::: "memory")
#define PG8_BAR __builtin_amdgcn_s_barrier()
#define PG8_SCHED __builtin_amdgcn_sched_barrier(0)
    Unit cur, nxt; int ui = 0;
    if (!S.next(0, cur)) return;
    f32x4 acc[2][2][4][2];
#pragma unroll
    for (int a = 0; a < 2; ++a)
#pragma unroll
        for (int b = 0; b < 2; ++b)
#pragma unroll
            for (int m = 0; m < 4; ++m)
#pragma unroll
                for (int n = 0; n < 2; ++n) acc[a][b][m][n] = (f32x4){0.f, 0.f, 0.f, 0.f};
    bf16x8 At[4][2], B0[2][2], B1[2][2];
    const char* cA = cur.a; const char* cB = cur.b;
    PG8_STAGE(PG8_SB(0, 0), cB, voffB); PG8_STAGE(PG8_SB(0, 1), cB + hstepB, voffB); PG8_STAGE(PG8_SA(0, 0), cA, voffA); PG8_STAGE(PG8_SA(0, 1), cA + hstepA, voffA);
    if (wr == 1) PG8_BAR;
    PG8_WAIT_V(2); PG8_BAR;
    PG8_STAGE(PG8_SB(1, 0), cB + kstep, voffB); PG8_STAGE(PG8_SA(1, 0), cA + kstepA, voffA); PG8_STAGE(PG8_SB(1, 1), cB + hstepB + kstep, voffB);
    PG8_WAIT_V(6); PG8_BAR;
    for (;;) {
        const bool has_next = S.next(ui + 1, nxt);
        const char* nA = has_next ? nxt.a : cA; const char* nB = has_next ? nxt.b : cB;
        const int nt = cur.kt;
        for (int t = 0; t < nt; t += 2) {
            const bool last = (t == nt - 2);
            if constexpr (HOOK) { if (t == 16 || t == 32) E.mid(acc, cur, t >> 4, wr, wc); }
            const char* a1 = cA + (size_t)(t + 1) * kstepA;
            const char* a2 = last ? nA : cA + (size_t)(t + 2) * kstepA; const char* b2 = last ? nB : cB + (size_t)(t + 2) * kstep;
            const char* a3 = a2 + kstepA; const char* b3 = b2 + kstep;
            PG8_LDB(B0, 0, 0); PG8_LDB(B1, 0, 1); PG8_SCHED; PG8_LDA(At, 0, 0); PG8_STAGE(PG8_SA(1, 1), a1 + hstepA, voffA);
            PG8_WAIT_V(8); PG8_WAIT_L(0); PG8_BAR; PG8_MMA(0, 0, At, B0); PG8_MMA(0, 1, At, B1); PG8_BAR; PG8_SCHED;
            PG8_LDA(At, 0, 1); PG8_STAGE(PG8_SB(0, 0), b2, voffB); PG8_STAGE(PG8_SB(0, 1), b2 + hstepB, voffB); PG8_STAGE(PG8_SA(0, 0), a2, voffA);
            PG8_WAIT_V(8); PG8_WAIT_L(0); PG8_BAR; PG8_MMA(1, 0, At, B0); PG8_MMA(1, 1, At, B1); PG8_BAR; PG8_SCHED;
            PG8_LDB(B0, 1, 0); PG8_LDB(B1, 1, 1); PG8_SCHED; PG8_LDA(At, 1, 0); PG8_STAGE(PG8_SA(0, 1), a2 + hstepA, voffA);
            PG8_WAIT_V(8); PG8_WAIT_L(0); PG8_BAR; PG8_MMA(0, 0, At, B0); PG8_MMA(0, 1, At, B1); PG8_BAR; PG8_SCHED;
            PG8_LDA(At, 1, 1); PG8_STAGE(PG8_SB(1, 0), b3, voffB); PG8_STAGE(PG8_SB(1, 1), b3 + hstepB, voffB); PG8_STAGE(PG8_SA(1, 0), a3, voffA);
            PG8_WAIT_V(8); PG8_WAIT_L(0); PG8_BAR; PG8_MMA(1, 0, At, B0); PG8_MMA(1, 1, At, B1); PG8_BAR; PG8_SCHED;
        }
        if (wr == 0) PG8_BAR;
        E(acc, cur, wr, wc, fr, fq);
        if (!has_next) break;
#pragma unroll
        for (int a = 0; a < 2; ++a)
#pragma unroll
            for (int b = 0; b < 2; ++b)
#pragma unroll
                for (int m = 0; m < 4; ++m)
#pragma unroll
                    for (int n = 0; n < 2; ++n) acc[a][b][m][n] = (f32x4){0.f, 0.f, 0.f, 0.f};
        cur = nxt; cA = nA; cB = nB; ++ui;
        if (wr == 1) PG8_BAR;
    }
    PG8_WAIT_V(0);
    PG8_BAR;
#undef PG8_SA
#undef PG8_SB
#undef PG8_STAGE
#undef PG8_LDA
#undef PG8_LDB
#undef PG8_MMA
#undef PG8_WAIT_V
#undef PG8_WAIT_L
#undef PG8_BAR
#undef PG8_SCHED
}
}

struct EpiSwiGLU {
    static constexpr bool PERM = true;
    bf16_t* O;
    __device__ __forceinline__ void operator()(const f32x4 (&acc)[2][2][4][2], const pg8::Unit& u, int wr, int wc, int, int) const { const int ln_ = lane_now(); const int fr = ln_ & 15, fq = ln_ >> 4;
        const int row0 = u.pm * 256 + wr * 64 + fr, hc0 = u.pn * 128 + wc * 32 + 8 * fq;
#pragma unroll
        for (int ai = 0; ai < 2; ++ai)
#pragma unroll
            for (int m = 0; m < 4; ++m) { const f32x4 a0 = acc[ai][0][m][0], a1 = acc[ai][0][m][1], b0 = acc[ai][1][m][0], b1 = acc[ai][1][m][1];
                u32x4 w; w.x = cvt_pk_bf16(siluf_(a0[0]) * b0[0], siluf_(a0[1]) * b0[1]); w.y = cvt_pk_bf16(siluf_(a0[2]) * b0[2], siluf_(a0[3]) * b0[3]);
                w.z = cvt_pk_bf16(siluf_(a1[0]) * b1[0], siluf_(a1[1]) * b1[1]); w.w = cvt_pk_bf16(siluf_(a1[2]) * b1[2], siluf_(a1[3]) * b1[3]);
                *(u32x4*)(O + (size_t)(row0 + ai * 128 + m * 16) * DFF + hc0) = w; }
    }
};
struct EpiResid {
    static constexpr bool PERM = true;
    _Float16* H; float* HC; const float* gate; const float* lng; const float* lnb; const float* stats;
    __device__ __forceinline__ void operator()(const f32x4 (&acc)[2][2][4][2], const pg8::Unit& u, int wr, int wc, int, int) const { const int ln_ = lane_now(); const int fr = ln_ & 15, fq = ln_ >> 4;
        int upm = u.pm, upn = u.pn; asm volatile("" : "+s"(upm), "+s"(upn));
        const int pp = upm % PPB, mi = (pp == 0) ? 4 : (upm / PPB);
        const int rl0 = wr * 64 + fr, col0 = upn * 256 + wc * 32 + 8 * fq;
        if (u.aux) {
            float* hc = (float*)((char*)HC - WS_HC + WS_YD) + ((size_t)(u.aux - 1) * (NB * CTX) + (size_t)(upm / PPB) * 256) * D;
#pragma unroll
            for (int bj = 0; bj < 2; ++bj) { const f32x4 gv0 = *(const f32x4*)(gate + (size_t)mi * NMOD + col0 + bj * 128), gv1 = *(const f32x4*)(gate + (size_t)mi * NMOD + col0 + bj * 128 + 4);
#pragma unroll
                for (int ai = 0; ai < 2; ++ai)
#pragma unroll
                    for (int m = 0; m < 4; ++m) { float* p = hc + (size_t)(rl0 + ai * 128 + m * 16) * D + col0 + bj * 128; *(f32x4*)p = gv0 * acc[ai][bj][m][0]; *(f32x4*)(p + 4) = gv1 * acc[ai][bj][m][1]; } }
            return;
        }
#pragma unroll
        for (int bj = 0; bj < 2; ++bj) { const int c = col0 + bj * 128;
            const f32x4 gv0 = *(const f32x4*)(gate + (size_t)mi * NMOD + c), gv1 = *(const f32x4*)(gate + (size_t)mi * NMOD + c + 4);
            const f32x4 g0 = *(const f32x4*)(lng + c) * DN_ALPHA, g1 = *(const f32x4*)(lng + c + 4) * DN_ALPHA, b0 = *(const f32x4*)(lnb + c) * DN_ALPHA, b1 = *(const f32x4*)(lnb + c + 4) * DN_ALPHA;
#pragma unroll
            for (int ai = 0; ai < 2; ++ai) {
                u32x4 tv[4]; f32x2 st[4];
#pragma unroll
                for (int m = 0; m < 4; ++m) { const size_t row = (size_t)(upm * 256 + rl0 + ai * 128 + m * 16); tv[m] = *(const u32x4*)(H + row * D + c); st[m] = *(const f32x2*)(stats + row * 2); }
                asm volatile("s_waitcnt vmcnt(0)" ::: "memory");
#pragma unroll
                for (int m = 0; m < 4; ++m) { const h16x4 ha = __builtin_bit_cast(h16x4, (u32x2){tv[m].x, tv[m].y}), hb = __builtin_bit_cast(h16x4, (u32x2){tv[m].z, tv[m].w});
                    const f32x4 t0 = (f32x4){(float)ha[0], (float)ha[1], (float)ha[2], (float)ha[3]}, t1 = (f32x4){(float)hb[0], (float)hb[1], (float)hb[2], (float)hb[3]};
                    const f32x4 o0 = (t0 - st[m].x) * st[m].y * g0 + b0 + gv0 * acc[ai][bj][m][0], o1 = (t1 - st[m].x) * st[m].y * g1 + b1 + gv1 * acc[ai][bj][m][1];
                    h16x4 qa, qb; qa[0] = (_Float16)o0[0]; qa[1] = (_Float16)o0[1]; qa[2] = (_Float16)o0[2]; qa[3] = (_Float16)o0[3]; qb[0] = (_Float16)o1[0]; qb[1] = (_Float16)o1[1]; qb[2] = (_Float16)o1[2]; qb[3] = (_Float16)o1[3];
                    const u32x2 pa = __builtin_bit_cast(u32x2, qa), pb = __builtin_bit_cast(u32x2, qb);
                    *(u32x4*)(H + (size_t)(upm * 256 + rl0 + ai * 128 + m * 16) * D + c) = (u32x4){pa.x, pa.y, pb.x, pb.y}; } } }
    }
};
struct EpiProj {
    static constexpr bool PERM = true;
    bf16_t* P; float* DT; const float* rc; const float* rs; bf16_t* U2; unsigned* KM;
    __device__ __forceinline__ void operator()(const f32x4 (&acc)[2][2][4][2], const pg8::Unit& u, int wr, int wc, int, int) const { const int ln_ = lane_now(); const int fr = ln_ & 15, fq = ln_ >> 4;
        const int pp = u.pm % PPB; const int row0 = u.pm * 256 + wr * 64 + fr;
        const int pn = u.pn;
        if (pn == 52) {
            if (wc == 0) {
#pragma unroll
                for (int ai = 0; ai < 2; ++ai)
#pragma unroll
                    for (int m = 0; m < 4; ++m)
#pragma unroll
                        for (int n = 0; n < 2; ++n) *(f32x4*)(DT + (size_t)(row0 + ai * 128 + m * 16) * 32 + 8 * fq + 4 * n) = acc[ai][0][m][n];
            }
            return;
        }
        if (pn >= 28) {
            const int jg = (pn - 28) >> 3, pnd = (pn - 28) & 7;
            unsigned char* gq = (unsigned char*)P - WS_PROJ + gq_off(jg) + ((size_t)((u.pm * 8 + pnd) * 512 + (wr * 4 + wc) * 64 + ln_)) * 128;
#pragma unroll
            for (int ai = 0; ai < 2; ++ai)
#pragma unroll
                for (int m = 0; m < 4; ++m) { u32x4 w;
#pragma unroll
                    for (int bj = 0; bj < 2; ++bj)
#pragma unroll
                        for (int n = 0; n < 2; ++n) { const f32x4 v = acc[ai][bj][m][n]; unsigned q = 0;
#pragma unroll
                            for (int e = 0; e < 4; ++e) { const float ex = __builtin_amdgcn_exp2f(v[e] * -1.4426950408889634f);
                                q = __builtin_amdgcn_cvt_pk_u8_f32(fmaxf(__builtin_amdgcn_rcpf(__builtin_fmaf(ex, 1.0f / 255.0f, 1.0f / 255.0f)), 1.0f), e, q); }
                            w[bj * 2 + n] = q; }
                    *(u32x4*)(gq + (ai * 4 + m) * 16) = w; }
            return;
        }
        if (pn >= 4 && pn < 8) {
            float kmx0 = 0.f, kmx1 = 0.f;
#pragma unroll
            for (int ai = 0; ai < 2; ++ai)
#pragma unroll
                for (int m = 0; m < 4; ++m) { const f32x4 a2 = acc[ai][0][m][0] * acc[ai][0][m][0] + acc[ai][0][m][1] * acc[ai][0][m][1], b2 = acc[ai][1][m][0] * acc[ai][1][m][0] + acc[ai][1][m][1] * acc[ai][1][m][1];
                    kmx0 = fmaxf(kmx0, (a2[0] + a2[1]) + (a2[2] + a2[3])); kmx1 = fmaxf(kmx1, (b2[0] + b2[1]) + (b2[2] + b2[3])); }
#pragma unroll
            for (int o = 1; o < 16; o <<= 1) { kmx0 = fmaxf(kmx0, shx(kmx0, o, ln_)); kmx1 = fmaxf(kmx1, shx(kmx1, o, ln_)); }
            if (fr == 0) { const int b = u.pm / PPB; unsigned* km = KM + (((b * 8 + (pn - 4) * 2) * 2 + (wc >> 1)) * 8 + (wc & 1) * 4 + fq);
                __hip_atomic_fetch_max(km, __float_as_uint(kmx0), __ATOMIC_RELAXED, __HIP_MEMORY_SCOPE_AGENT); __hip_atomic_fetch_max(km + 16, __float_as_uint(kmx1), __ATOMIC_RELAXED, __HIP_MEMORY_SCOPE_AGENT); } }
        const int col0 = pn * 256 + wc * 32 + 4 * fq;
        const int mode = (pn < 8) ? ((pp != 0) ? 1 : 0) : ((pn >= 12 && pn < 16) ? 2 : 0);
        const float sc = (pn < 4) ? QSCALE : 1.0f;
#pragma unroll
        for (int ai = 0; ai < 2; ++ai) {
          f32x4 csv[4], snv[4];
          if (mode == 1) {
#pragma unroll
              for (int m = 0; m < 4; ++m) { const int rl = ai * 128 + wr * 64 + m * 16 + fr; const int t = (pp - 1) * 256 + rl; const int pos = (wc & 1) ? (t & 63) : (t >> 6); csv[m] = *(const f32x4*)(rc + pos * 16 + 4 * fq); snv[m] = *(const f32x4*)(rs + pos * 16 + 4 * fq); }
              asm volatile("s_waitcnt vmcnt(0)" ::: "memory"); }
#pragma unroll
            for (int m = 0; m < 4; ++m) { const int rl = ai * 128 + wr * 64 + m * 16 + fr; bf16_t* rowp = P + (size_t)(u.pm * 256 + rl) * LDP + col0;
                f32x4 cs = (f32x4){1.f, 1.f, 1.f, 1.f}, sn = (f32x4){0.f, 0.f, 0.f, 0.f};
                if (mode == 1) { cs = csv[m]; sn = snv[m]; }
#pragma unroll
                for (int bj = 0; bj < 2; ++bj) { f32x4 v0 = acc[ai][bj][m][0], v1 = acc[ai][bj][m][1];
                    if (mode == 1) { const f32x4 o0 = v0 * cs - v1 * sn, o1 = v1 * cs + v0 * sn; v0 = o0; v1 = o1; }
                    else if (mode == 2) {
#pragma unroll
                        for (int e = 0; e < 4; ++e) { v0[e] = siluf_(v0[e]); v1[e] = siluf_(v1[e]); } }
                    if (pn >= 24 && pn < 28) {
                        const int cu = (pn - 24) * 256 + bj * 128 + wc * 32 + 8 * fq;
                        bf16_t* u2 = U2 + ((size_t)(cu >> 4) * R + (size_t)(u.pm * 256 + rl)) * 16 + (cu & 15);
                        u32x4 a; a.x = cvt_pk_bf16(v0[0], v0[1]); a.y = cvt_pk_bf16(v0[2], v0[3]); a.z = cvt_pk_bf16(v1[0], v1[1]); a.w = cvt_pk_bf16(v1[2], v1[3]);
                        *(u32x4*)u2 = a; continue; }
                    v0 = v0 * sc; v1 = v1 * sc;
                    if (pn < 8) { u32x2 w0, w1; w0.x = cvt_pk_bf16(v0[0], v0[1]); w0.y = cvt_pk_bf16(v0[2], v0[3]); w1.x = cvt_pk_bf16(v1[0], v1[1]); w1.y = cvt_pk_bf16(v1[2], v1[3]);
                        *(u32x2*)(rowp + bj * 128) = w0; *(u32x2*)(rowp + bj * 128 + 16) = w1; }
                    else { u32x4 w; w.x = cvt_pk_bf16(v0[0], v0[1]); w.y = cvt_pk_bf16(v0[2], v0[3]); w.z = cvt_pk_bf16(v1[0], v1[1]); w.w = cvt_pk_bf16(v1[2], v1[3]);
                        *(u32x4*)(rowp + 4 * fq + bj * 128) = w; } } } }
    }
};
struct EpiGlu {
    static constexpr bool PERM = false;
    bf16_t* P; const float* bias;
    __device__ __forceinline__ void operator()(const f32x4 (&acc)[2][2][4][2], const pg8::Unit& u, int wr, int wc, int, int) const { const int ln_ = lane_now(); const int fr = ln_ & 15, fq = ln_ >> 4;
        const int row0 = u.pm * 256 + wr * 64 + fr, col0 = u.pn * 256 + wc * 32 + 4 * fq;
        f32x4 bv[2][2];
#pragma unroll
        for (int bj = 0; bj < 2; ++bj)
#pragma unroll
            for (int n = 0; n < 2; ++n) bv[bj][n] = *(const f32x4*)(bias + col0 + bj * 128 + n * 16);
#pragma unroll
        for (int ai = 0; ai < 2; ++ai) {
            u32x2 tv[4][2][2];
#pragma unroll
            for (int m = 0; m < 4; ++m)
#pragma unroll
                for (int bj = 0; bj < 2; ++bj)
#pragma unroll
                    for (int n = 0; n < 2; ++n) tv[m][bj][n] = *(const u32x2*)(P + (size_t)(row0 + ai * 128 + m * 16) * LDP + PU + col0 + bj * 128 + n * 16);
            asm volatile("s_waitcnt vmcnt(0)" ::: "memory");
#pragma unroll
            for (int m = 0; m < 4; ++m) { bf16_t* rowp = P + (size_t)(row0 + ai * 128 + m * 16) * LDP;
#pragma unroll
                for (int bj = 0; bj < 2; ++bj)
#pragma unroll
                    for (int n = 0; n < 2; ++n) { const int c = col0 + bj * 128 + n * 16; const u32x2 t = tv[m][bj][n];
                        const f32x4 a = acc[ai][bj][m][n] + bv[bj][n]; u32x2 w;
                        w.x = cvt_pk_bf16(bflo(t.x) * sigmoidf_(a[0]), bfhi(t.x) * sigmoidf_(a[1])); w.y = cvt_pk_bf16(bflo(t.y) * sigmoidf_(a[2]), bfhi(t.y) * sigmoidf_(a[3]));
                        *(u32x2*)(rowp + PK + c) = w; } } }
    }
};
struct EpiMerge {
    static constexpr bool PERM = true;
    const bf16_t* P; bf16_t* MIXB;
    static __device__ __forceinline__ int jmap(int seg) { return seg == 0 ? 0 : (seg == 1 ? 2 : 1); }
    __device__ __forceinline__ const unsigned char* gbase(const pg8::Unit& u, int seg, int wr, int wc, int ln_) const {
        return (const unsigned char*)P - WS_PROJ + gq_off(jmap(seg)) + ((size_t)((u.pm * 8 + u.pn) * 512 + (wr * 4 + wc) * 64 + ln_)) * 128; }
    __device__ __forceinline__ void mid(f32x4 (&acc)[2][2][4][2], const pg8::Unit& u, int seg, int wr, int wc) const {
        const int ln_ = lane_now(); const unsigned char* ga = gbase(u, seg - 1, wr, wc, ln_); const unsigned char* gb = gbase(u, seg, wr, wc, ln_);
        u32x4 a[2][4], b[2][4];
#pragma unroll
        for (int ai = 0; ai < 2; ++ai)
#pragma unroll
            for (int m = 0; m < 4; ++m) { a[ai][m] = *(const u32x4*)(ga + (ai * 4 + m) * 16); b[ai][m] = *(const u32x4*)(gb + (ai * 4 + m) * 16); }
        asm volatile("s_waitcnt vmcnt(0)" ::: "memory");
#pragma unroll
        for (int ai = 0; ai < 2; ++ai)
#pragma unroll
            for (int m = 0; m < 4; ++m)
#pragma unroll
                for (int bj = 0; bj < 2; ++bj)
#pragma unroll
                    for (int n = 0; n < 2; ++n) { const unsigned qa = a[ai][m][bj * 2 + n], qb = b[ai][m][bj * 2 + n]; f32x4 r;
#pragma unroll
                        for (int e = 0; e < 4; ++e) r[e] = (float)((qa >> (8 * e)) & 255u) * __builtin_amdgcn_rcpf((float)((qb >> (8 * e)) & 255u));
                        acc[ai][bj][m][n] = acc[ai][bj][m][n] * r; }
    }
    __device__ __forceinline__ void operator()(const f32x4 (&acc)[2][2][4][2], const pg8::Unit& u, int wr, int wc, int, int) const { const int ln_ = lane_now(); const int fr = ln_ & 15, fq = ln_ >> 4;
        const int row0 = u.pm * 256 + wr * 64 + fr, col0 = u.pn * 256 + wc * 32 + 8 * fq; const unsigned char* gl = gbase(u, 2, wr, wc, ln_);
        u32x4 gq[2][4];
#pragma unroll
        for (int ai = 0; ai < 2; ++ai)
#pragma unroll
            for (int m = 0; m < 4; ++m) gq[ai][m] = *(const u32x4*)(gl + (ai * 4 + m) * 16);
        asm volatile("s_waitcnt vmcnt(0)" ::: "memory");
#pragma unroll
        for (int ai = 0; ai < 2; ++ai)
#pragma unroll
            for (int m = 0; m < 4; ++m) { const size_t row = (size_t)(row0 + ai * 128 + m * 16); const u32x4 g4 = gq[ai][m];
#pragma unroll
                for (int bj = 0; bj < 2; ++bj) { u32x4 w;
#pragma unroll
                    for (int n = 0; n < 2; ++n) { const unsigned gv = g4[bj * 2 + n];
                        f32x4 v = acc[ai][bj][m][n];
#pragma unroll
                        for (int e = 0; e < 4; ++e) v[e] *= (float)((gv >> (8 * e)) & 255u) * (1.0f / 255.0f);
                        w[2 * n] = cvt_pk_bf16(v[0], v[1]); w[2 * n + 1] = cvt_pk_bf16(v[2], v[3]); }
                    *(u32x4*)(MIXB + row * D + col0 + bj * 128) = w; } }
    }
};

struct S5AOrder {
    int G, c; const char* A; const char* B;
    __device__ __forceinline__ bool next(int i, pg8::Unit& u) const {
        const int idx = i * G + c; if (idx >= 640) return false;
        const int g = idx / 10, r = idx - 10 * g, nt = r / 5, mt = r - 5 * nt;
        u.pm = mt; u.pn = nt; u.aux = g; u.kt = 4; u.a = A + ((size_t)g * (R / 16) + (size_t)mt * 256) * 256 * 2; u.b = B + (size_t)(g * 512 + nt * 256) * 256 * 2; return true;
    }
};
struct EpiS5A {
    static constexpr bool PERM = false;
    unsigned char* YLF; bf16_t* ST;
    __device__ __forceinline__ void operator()(const f32x4 (&acc)[2][2][4][2], const pg8::Unit& u, int wr, int wc, int, int) const { const int ln_ = lane_now(); const int fr = ln_ & 15, fq = ln_ >> 4;
        const int g = u.aux;
        if (u.pn == 0) { unsigned char* yl = YLF + ((size_t)((g * 5 + u.pm) * 512 + (wr * 4 + wc) * 64 + ln_)) * 256;
#pragma unroll
            for (int ai = 0; ai < 2; ++ai)
#pragma unroll
                for (int m = 0; m < 4; ++m) { u32x4 w0, w1;
                    w0.x = cvt_pk_bf16(acc[ai][0][m][0][0], acc[ai][0][m][0][1]); w0.y = cvt_pk_bf16(acc[ai][0][m][0][2], acc[ai][0][m][0][3]); w0.z = cvt_pk_bf16(acc[ai][0][m][1][0], acc[ai][0][m][1][1]); w0.w = cvt_pk_bf16(acc[ai][0][m][1][2], acc[ai][0][m][1][3]);
                    w1.x = cvt_pk_bf16(acc[ai][1][m][0][0], acc[ai][1][m][0][1]); w1.y = cvt_pk_bf16(acc[ai][1][m][0][2], acc[ai][1][m][0][3]); w1.z = cvt_pk_bf16(acc[ai][1][m][1][0], acc[ai][1][m][1][1]); w1.w = cvt_pk_bf16(acc[ai][1][m][1][2], acc[ai][1][m][1][3]);
                    *(u32x4*)(yl + (ai * 4 + m) * 32) = w0; *(u32x4*)(yl + (ai * 4 + m) * 32 + 16) = w1; }
            return; }
#pragma unroll
        for (int ai = 0; ai < 2; ++ai)
#pragma unroll
            for (int m = 0; m < 4; ++m) { const int mr = u.pm * 256 + ai * 128 + wr * 64 + m * 16 + fr; if (mr < S5M) {
#pragma unroll
                for (int bj = 0; bj < 2; ++bj)
#pragma unroll
                    for (int n = 0; n < 2; ++n) { const f32x4 v = acc[ai][bj][m][n];
                        u32x2 w; w.x = cvt_pk_bf16(v[0], v[1]); w.y = cvt_pk_bf16(v[2], v[3]); *(u32x2*)(ST + ((size_t)g * S5M + mr) * 256 + bj * 128 + wc * 32 + n * 16 + 4 * fq) = w; } } }
    }
};
struct S5COrder {
    int G, c; const char* A; const char* B;
    __device__ __forceinline__ bool next(int i, pg8::Unit& u) const {
        const int idx = i * G + c; if (idx >= 320) return false;
        const int g = idx / 5, mt = idx - 5 * g;
        u.pm = mt; u.pn = 0; u.aux = g; u.kt = 4; u.a = A + ((size_t)g * 1280 + mt * 256) * 256 * 2; u.b = B + (size_t)g * 256 * 256 * 2; return true;
    }
};
struct EpiS5C {
    static constexpr bool PERM = false;
    const unsigned char* YLF; bf16_t* P;
    __device__ __forceinline__ void operator()(const f32x4 (&acc)[2][2][4][2], const pg8::Unit& u, int wr, int wc, int, int) const { const int ln_ = lane_now(); const int fr = ln_ & 15, fq = ln_ >> 4;
        const int g = u.aux; const unsigned char* yl = YLF + ((size_t)((g * 5 + u.pm) * 512 + (wr * 4 + wc) * 64 + ln_)) * 256;
#pragma unroll
        for (int ai = 0; ai < 2; ++ai) {
        u32x4 y0[2][4], y1[2][4];
#pragma unroll
            for (int m = 0; m < 4; ++m) { y0[ai][m] = *(const u32x4*)(yl + (ai * 4 + m) * 32); y1[ai][m] = *(const u32x4*)(yl + (ai * 4 + m) * 32 + 16); }
        asm volatile("s_waitcnt vmcnt(0)" ::: "memory");
#pragma unroll
            for (int m = 0; m < 4; ++m) { const int mr = u.pm * 256 + ai * 128 + wr * 64 + m * 16 + fr; if (mr < S5M) {
#pragma unroll
                for (int bj = 0; bj < 2; ++bj)
#pragma unroll
                    for (int n = 0; n < 2; ++n) { const int rho = 8 * bj + 2 * wc + n; const size_t row = (size_t)(16 * mr + rho);
                        const u32x4 yy = bj ? y1[ai][m] : y0[ai][m]; const unsigned ya = n ? yy.z : yy.x, yb = n ? yy.w : yy.y; f32x4 v = acc[ai][bj][m][n];
                        v[0] += bflo(ya); v[1] += bfhi(ya); v[2] += bflo(yb); v[3] += bfhi(yb);
#pragma unroll
                        for (int e = 0; e < 4; ++e) { const float x = v[e]; const float inner = 0.7978845608028654f * (x + 0.044715f * x * x * x); const float th = 1.0f - 2.0f * __builtin_amdgcn_rcpf(1.0f + __builtin_amdgcn_exp2f(2.8853900817779268f * inner)); v[e] = 0.5f * x * (1.0f + th); }
                        u32x2 w; w.x = cvt_pk_bf16(v[0], v[1]); w.y = cvt_pk_bf16(v[2], v[3]); *(u32x2*)(P + row * LDP + PU + 16 * g + 4 * fq) = w; } } } }
    }
};

namespace attn128 {
using bf16 = __hip_bfloat16;
constexpr int NW = 8, QBLK = 32, KVBLK = 64, LDQ = LDP, LDK = LDP, LDOB = LDP;
constexpr size_t SHM_V = KVBLK * 128 * 2, SHM_K = KVBLK * 64 * 2, SHM_ATTN = 2 * SHM_V + 2 * SHM_K + NW * 64 * 4, SHM_TOTAL = SHM_ATTN + NW * 8192;
constexpr float THRL = 11.5f;
#define A128_KSWZ(row, colB) ((row) * 128 + ((colB) ^ (((row) & 7) << 4)))
#define A128_SBAR() __builtin_amdgcn_sched_barrier(0)
__device__ __forceinline__ int crow(int r, int hi) { return (r & 3) + 8 * (r >> 2) + 4 * hi; }
template <bool FIRST = false>
__device__ __forceinline__ void partialSM(f32x16& p0, f32x16& p1, float& m_reg, float& mn, float& alpha, const bool nomax) {
  if (nomax) { mn = 0.f; alpha = 1.f;
#pragma unroll
    for (int r = 0; r < 16; ++r) p0[r] = __builtin_amdgcn_exp2f(p0[r]);
    return; }
  float pmax = p0[0];
#pragma unroll
  for (int r = 1; r < 16; ++r) pmax = fmaxf(pmax, p0[r]);
#pragma unroll
  for (int r = 0; r < 16; ++r) pmax = fmaxf(pmax, p1[r]);
  { auto rr = __builtin_amdgcn_permlane32_swap(__float_as_uint(pmax), __float_as_uint(pmax), false, false); pmax = fmaxf(__uint_as_float(rr[0]), __uint_as_float(rr[1])); }
  if (FIRST) { m_reg = (__builtin_fabsf(pmax) <= THRL) ? 0.f : pmax; mn = m_reg; alpha = 1.f; }
  else if (__builtin_expect(__all(pmax - m_reg <= THRL), 1)) { mn = m_reg; alpha = 1.f; }
  else { mn = fmaxf(m_reg, pmax); alpha = __builtin_amdgcn_exp2f(m_reg - mn); m_reg = mn; }
  if (__builtin_expect(__any(mn != 0.f), 0)) {
#pragma unroll
    for (int r = 0; r < 16; ++r) { p0[r] = p0[r] - mn; p1[r] = p1[r] - mn; } }
#pragma unroll
  for (int r = 0; r < 16; ++r) p0[r] = __builtin_amdgcn_exp2f(p0[r]);
}
__device__ __forceinline__ void finishSM(f32x16& p0, f32x16& p1, float alpha, float& l_reg, bf16x8& pa0, bf16x8& pa1, bf16x8& pa2, bf16x8& pa3) {
#pragma unroll
  for (int r = 0; r < 16; ++r) p1[r] = __builtin_amdgcn_exp2f(p1[r]);
  float ps = 0;
#pragma unroll
  for (int r = 0; r < 16; ++r) ps += p0[r];
#pragma unroll
  for (int r = 0; r < 16; ++r) ps += p1[r];
  { auto rr = __builtin_amdgcn_permlane32_swap(__float_as_uint(ps), __float_as_uint(ps), false, false); ps = __uint_as_float(rr[0]) + __uint_as_float(rr[1]); }
  l_reg = l_reg * alpha + ps;
#define A128_PK4(P, BASE, OUT) do { unsigned a0 = cvt_pk_bf16(P[BASE + 0], P[BASE + 1]), a1 = cvt_pk_bf16(P[BASE + 2], P[BASE + 3]);   \
    unsigned b0 = cvt_pk_bf16(P[BASE + 4], P[BASE + 5]), b1 = cvt_pk_bf16(P[BASE + 6], P[BASE + 7]);                              \
    auto r0 = __builtin_amdgcn_permlane32_swap(a0, b0, false, false); auto r1 = __builtin_amdgcn_permlane32_swap(a1, b1, false, false); \
    u32x4 w = {r0[0], r1[0], r0[1], r1[1]}; OUT = __builtin_bit_cast(bf16x8, w); } while (0)
  A128_PK4(p0, 0, pa0); A128_PK4(p0, 8, pa1); A128_PK4(p1, 0, pa2); A128_PK4(p1, 8, pa3);
#undef A128_PK4
}
__device__ __forceinline__ void qkt(f32x16& p0, f32x16& p1, const char* Ks, const bf16x8* qr, int r32, int hi) {
#pragma unroll
  for (int i = 0; i < 16; ++i) { p0[i] = 0.f; p1[i] = 0.f; }
#pragma unroll
  for (int d0 = 0; d0 < 4; ++d0) { const int cb = (d0 * 16 + hi * 8) * 2;
    const bf16x8 b0 = *reinterpret_cast<const bf16x8*>(Ks + A128_KSWZ(r32, cb));
    const bf16x8 b1 = *reinterpret_cast<const bf16x8*>(Ks + A128_KSWZ(32 + r32, cb));
    p0 = __builtin_amdgcn_mfma_f32_32x32x16_bf16(b0, qr[d0], p0, 0, 0, 0);
    p1 = __builtin_amdgcn_mfma_f32_32x32x16_bf16(b1, qr[d0], p1, 0, 0, 0); }
}
__device__ __forceinline__ int v_st(int k, int c) { const int kk = (k & ~0xC) | ((k & 4) << 1) | ((k & 8) >> 1); return ((kk >> 3) * 4 + (c >> 5)) * 512 + ((kk & 7) * 32 + (c & 31)) * 2; }
__device__ __forceinline__ int v_rd_base(int lane) { return ((lane & 3) << 3) | (((lane >> 2) & 3) << 6) | (((lane >> 4) & 1) << 5) | (((lane >> 5) & 1) << 8); }
constexpr int v_rd_off(int d0, int ks, int half) { return d0 * 512 + ks * 4096 + half * 2048; }
template <int OFF> __device__ __forceinline__ s16x4 tr_read(int vb) { s16x4 r; asm volatile("ds_read_b64_tr_b16 %0, %1 offset:%2" : "=&v"(r) : "v"(vb), "i"(OFF) : "memory"); return r; }
template <int D0> __device__ __forceinline__ void pv_one(f32x16& od, int vb, bf16x8 pa0, bf16x8 pa1, bf16x8 pa2, bf16x8 pa3) {
  const s16x4 l0 = tr_read<v_rd_off(D0, 0, 0)>(vb), h0 = tr_read<v_rd_off(D0, 0, 1)>(vb), l1 = tr_read<v_rd_off(D0, 1, 0)>(vb), h1 = tr_read<v_rd_off(D0, 1, 1)>(vb);
  const s16x4 l2 = tr_read<v_rd_off(D0, 2, 0)>(vb), h2 = tr_read<v_rd_off(D0, 2, 1)>(vb), l3 = tr_read<v_rd_off(D0, 3, 0)>(vb), h3 = tr_read<v_rd_off(D0, 3, 1)>(vb);
  asm volatile("s_waitcnt lgkmcnt(0)" ::: "memory"); A128_SBAR();
#define A128_PK(L, H) (bf16x8){L[0], L[1], L[2], L[3], H[0], H[1], H[2], H[3]}
  od = __builtin_amdgcn_mfma_f32_32x32x16_bf16(pa0, A128_PK(l0, h0), od, 0, 0, 0);
  od = __builtin_amdgcn_mfma_f32_32x32x16_bf16(pa1, A128_PK(l1, h1), od, 0, 0, 0);
  od = __builtin_amdgcn_mfma_f32_32x32x16_bf16(pa2, A128_PK(l2, h2), od, 0, 0, 0);
  od = __builtin_amdgcn_mfma_f32_32x32x16_bf16(pa3, A128_PK(l3, h3), od, 0, 0, 0);
#undef A128_PK
}
__device__ __forceinline__ void pv_d0(f32x16* o, int vb, bf16x8 pa0, bf16x8 pa1, bf16x8 pa2, bf16x8 pa3) {
  pv_one<0>(o[0], vb, pa0, pa1, pa2, pa3); pv_one<1>(o[1], vb, pa0, pa1, pa2, pa3); pv_one<2>(o[2], vb, pa0, pa1, pa2, pa3); pv_one<3>(o[3], vb, pa0, pa1, pa2, pa3);
}
__device__ __forceinline__ void unit(const bf16* __restrict__ Qb0, const bf16* __restrict__ Kh0, const bf16* __restrict__ Vh, bf16_t* Ob, int seq, char* lds, const int tid_in, const float lam, const float onem, const float* __restrict__ subw, const float* __restrict__ kmb  ) {
#pragma unroll 1
 for (int mp = 0; mp < 2; ++mp) {
  int tid = tid_in; asm volatile("" : "+v"(tid));
  bf16_t* stage = (bf16_t*)(lds + SHM_ATTN) + (tid >> 6) * 4096;
  const bf16* Qb = Qb0 + mp * 64; const bf16* Kh = Kh0 + mp * 64;
  const int wid = __builtin_amdgcn_readfirstlane(tid >> 6), lane = tid & 63, r32 = lane & 31, hi = lane >> 5;
  char* V_lds = lds; char* K_lds = lds + 2 * SHM_V;
  float* ws = (float*)(lds + 2 * SHM_V + 2 * SHM_K) + wid * 64; float* li_l = ws; float* al_l = ws + 32;
  float m_reg = 0.f, l_reg = 0; f32x16 o[4]; bf16x8 qr[4];
#pragma unroll
  for (int d = 0; d < 4; ++d)
#pragma unroll
    for (int r = 0; r < 16; ++r) o[d][r] = 0.f;
  const bf16* Qw = Qb + (long)(wid * QBLK + r32) * LDQ + hi * 8;
#pragma unroll
  for (int d0 = 0; d0 < 4; ++d0) qr[d0] = *reinterpret_cast<const bf16x8*>(Qw + d0 * 16);
  bool nomax;
  { float qn2 = 0.f, kb2 = 0.f;
#pragma unroll
    for (int d0 = 0; d0 < 4; ++d0) { const u32x4 w = __builtin_bit_cast(u32x4, qr[d0]);
#pragma unroll
      for (int e = 0; e < 4; ++e) { const float x0 = bflo(w[e]), x1 = bfhi(w[e]); qn2 += x0 * x0 + x1 * x1; } }
    { auto rr = __builtin_amdgcn_permlane32_swap(__float_as_uint(qn2), __float_as_uint(qn2), false, false); qn2 = __uint_as_float(rr[0]) + __uint_as_float(rr[1]); }
#pragma unroll
    for (int i = 0; i < 8; ++i) kb2 += kmb[mp * 8 + i];
    nomax = __all(qn2 * kb2 * 1.12f <= 3600.0f); }
  const int sr = tid >> 4, sc = (tid & 15) * 8, vst0 = v_st(sr, sc), vst1 = v_st(32 + sr, sc);
  const int kr = tid >> 3, kc = (tid & 7) * 8, kst = A128_KSWZ(kr, kc * 2);
  const int vb0 = (int)(uintptr_t)V_lds + v_rd_base(lane);
  struct { bf16x8 vs0, vs1, ks0; } sr_[2];
#define A128_SLOAD(i, k0) do { sr_[i].vs0 = *reinterpret_cast<const bf16x8*>(&Vh[(long)((k0) + sr) * LDK + sc]); sr_[i].vs1 = *reinterpret_cast<const bf16x8*>(&Vh[(long)((k0) + 32 + sr) * LDK + sc]); \
    sr_[i].ks0 = *reinterpret_cast<const bf16x8*>(&Kh[(long)((k0) + kr) * LDK + kc]); } while (0)
#define A128_SWRITE(b, i) do { *(bf16x8*)(V_lds + (b) * SHM_V + vst0) = sr_[i].vs0; *(bf16x8*)(V_lds + (b) * SHM_V + vst1) = sr_[i].vs1; *(bf16x8*)(K_lds + (b) * SHM_K + kst) = sr_[i].ks0; } while (0)
#define A128_SWAIT() asm volatile("s_waitcnt vmcnt(3)" ::: "memory")
#define A128_RESC(a) do { if (__any((a) < 1.f)) { if (hi == 0) al_l[r32] = (a); asm volatile("s_waitcnt lgkmcnt(0)" ::: "memory"); \
    _Pragma("unroll") for (int d = 0; d < 4; ++d) _Pragma("unroll") for (int r = 0; r < 16; ++r) o[d][r] *= al_l[crow(r, hi)]; } } while (0)
  f32x16 pA0, pA1, pB0, pB1; float mnA, mnB, alA, alB; bf16x8 pa0, pa1, pa2, pa3; const int NT = seq / KVBLK;
  A128_SLOAD(0, 0); asm volatile("s_waitcnt vmcnt(0)" ::: "memory"); A128_SWRITE(0, 0); __syncthreads();
  qkt(pA0, pA1, K_lds, qr, r32, hi); partialSM<true>(pA0, pA1, m_reg, mnA, alA, nomax);
  A128_SLOAD(1, KVBLK); if (2 < NT) A128_SLOAD(0, 2 * KVBLK);
  A128_SWAIT(); A128_SWRITE(1, 1); __syncthreads();
  for (int j = 1; j + 1 < NT; j += 2) {
    A128_SBAR(); qkt(pB0, pB1, K_lds + SHM_K, qr, r32, hi);
    finishSM(pA0, pA1, alA, l_reg, pa0, pa1, pa2, pa3); A128_SBAR();
    A128_SLOAD(1, (j + 2) * KVBLK); A128_SBAR();
    pv_d0(o, vb0, pa0, pa1, pa2, pa3); partialSM(pB0, pB1, m_reg, mnB, alB, nomax);
    __syncthreads(); A128_SWAIT(); A128_SWRITE(0, 0);
    A128_RESC(alB); __syncthreads();
    A128_SBAR(); qkt(pA0, pA1, K_lds, qr, r32, hi);
    finishSM(pB0, pB1, alB, l_reg, pa0, pa1, pa2, pa3); A128_SBAR();
    if (j + 3 < NT) A128_SLOAD(0, (j + 3) * KVBLK); A128_SBAR();
    pv_d0(o, vb0 + (int)SHM_V, pa0, pa1, pa2, pa3); partialSM(pA0, pA1, m_reg, mnA, alA, nomax);
    __syncthreads(); A128_SWAIT(); A128_SWRITE(1, 1);
    A128_RESC(alA); __syncthreads();
  }
  A128_SBAR(); qkt(pB0, pB1, K_lds + SHM_K, qr, r32, hi);
  finishSM(pA0, pA1, alA, l_reg, pa0, pa1, pa2, pa3); A128_SBAR();
  pv_d0(o, vb0, pa0, pa1, pa2, pa3); partialSM(pB0, pB1, m_reg, mnB, alB, nomax);
  __syncthreads(); A128_RESC(alB);
  finishSM(pB0, pB1, alB, l_reg, pa0, pa1, pa2, pa3); A128_SBAR();
  pv_d0(o, vb0 + (int)SHM_V, pa0, pa1, pa2, pa3);
  if (hi == 0) li_l[r32] = l_reg; asm volatile("s_waitcnt lgkmcnt(0)" ::: "memory");
  float rli[16];
#pragma unroll
  for (int r = 0; r < 16; ++r) rli[r] = __builtin_amdgcn_rcpf(li_l[crow(r, hi)]);
  if (mp == 0) {
#pragma unroll
    for (int r = 0; r < 16; ++r)
#pragma unroll
      for (int d0 = 0; d0 < 4; ++d0) stage[(r * 4 + d0) * 64 + lane] = (bf16_t)(cvt_pk_bf16(o[d0][r] * rli[r], 0.f) & 0xffffu);
  } else {
    float ss[16];
#pragma unroll
    for (int r = 0; r < 16; ++r) { float q = 0.f;
#pragma unroll
      for (int d0 = 0; d0 < 4; ++d0) { const float a = bf1(stage[(r * 4 + d0) * 64 + lane]) - lam * bf1((bf16_t)(cvt_pk_bf16(o[d0][r] * rli[r], 0.f) & 0xffffu)); o[d0][r] = a; q += a * a; }
      ss[r] = q; }
#pragma unroll
    for (int m = 1; m < 32; m <<= 1)
#pragma unroll
      for (int r = 0; r < 16; ++r) ss[r] += __int_as_float(__builtin_amdgcn_ds_bpermute((lane ^ m) << 2, __float_as_int(ss[r])));
    float sw[4];
#pragma unroll
    for (int d0 = 0; d0 < 4; ++d0) sw[d0] = subw[d0 * 32 + r32] * onem;
    bf16_t* Ow = Ob + (long)(wid * QBLK) * LDOB;
#pragma unroll
    for (int r = 0; r < 16; ++r) { const int orow = crow(r, hi); const float rs = 1.0f / sqrtf(ss[r] * (1.f / 128.f) + RMS_EPS);
#pragma unroll
      for (int d0 = 0; d0 < 4; ++d0) Ow[(long)orow * LDOB + d0 * 32 + r32] = (bf16_t)(cvt_pk_bf16(o[d0][r] * rs * sw[d0], 0.f) & 0xffffu); }
  }
  __syncthreads();
 }
#undef A128_SLOAD
#undef A128_SWRITE
#undef A128_SWAIT
#undef A128_RESC
}
#undef A128_KSWZ
#undef A128_SBAR
}

#define XB_TMO      128
#define XB_XCNT(j)  (256  + 64 * (j))
#define XB_XSUB(j)  (1280 + 64 * (j))
#define XB_XGEN(j)  (2304 + 64 * (j))
#define XB_TOP      3328
#define XB_TOPGEN   3392
#define XCD_BAR_WORDS 3456
#define XB_SPIN_CAP (1u << 18)
__device__ __forceinline__ unsigned xb_ld(unsigned* p)              { return __hip_atomic_load(p, __ATOMIC_RELAXED, __HIP_MEMORY_SCOPE_AGENT); }
__device__ __forceinline__ unsigned xb_add(unsigned* p, unsigned v) { return __hip_atomic_fetch_add(p, v, __ATOMIC_RELAXED, __HIP_MEMORY_SCOPE_AGENT); }
__device__ __forceinline__ unsigned xb_xcc_id() { return (unsigned)__builtin_amdgcn_s_getreg((3 << 11) | 20) & 0xFu; }
#define XB_SPIN(cond, bar) do { unsigned _sp = 0; while (cond) { __builtin_amdgcn_s_sleep(1); \
    if ((++_sp & 255u) == 0u) { if (xb_ld(&(bar)[XB_TMO])) break; if (_sp > XB_SPIN_CAP) { atomicAdd(&(bar)[XB_TMO], 1u); break; } } } } while (0)
struct XcdBarrier { unsigned* bar; unsigned x; volatile LAS unsigned* st; };
__device__ __forceinline__ XcdBarrier xcd_barrier_post(unsigned* bar, volatile LAS unsigned* st) {
    XcdBarrier b; b.bar = bar; b.x = xb_xcc_id(); b.st = st;
    if (threadIdx.x == 0) (void)xb_add(&bar[XB_XCNT(b.x)], 1u);
    return b;
}
__device__ __forceinline__ void xcd_barrier_complete(unsigned* bar, unsigned x, unsigned& nloc, unsigned& nx) {
    const unsigned G = gridDim.x * gridDim.y * gridDim.z;
    unsigned sum, cnt, mine, sp = 0u;
    for (;;) {
        sum = 0u; cnt = 0u; mine = 0u;
#pragma unroll
        for (unsigned j = 0; j < 16; ++j) { const unsigned c = xb_ld(&bar[XB_XCNT(j)]); sum += c; cnt += (c > 0u) ? 1u : 0u; mine = (j == x) ? c : mine; }
        if (sum == G) break;
        __builtin_amdgcn_s_sleep(1);
        if ((++sp & 255u) == 0u) { if (xb_ld(&bar[XB_TMO])) break; if (sp > XB_SPIN_CAP) { atomicAdd(&bar[XB_TMO], 1u); break; } }
    }
    nloc = mine > 0u ? mine : 1u; nx = cnt > 0u ? cnt : 1u;
}
__device__ __forceinline__ void xcd_barrier(const XcdBarrier& b, const int tid) {
    asm volatile("s_waitcnt vmcnt(0)" ::: "memory");
    __syncthreads();
    if (tid == 0) {
        unsigned* bar = b.bar;
        __builtin_amdgcn_s_waitcnt(0);
        unsigned nloc = b.st[0], nx = b.st[1];
        if (nloc == 0u) { xcd_barrier_complete(bar, b.x, nloc, nx); b.st[0] = nloc; b.st[1] = nx; }
        const unsigned old = xb_add(&bar[XB_XSUB(b.x)], 1u);
        const unsigned gen = old / nloc;
        if (old + 1u == (gen + 1u) * nloc) {
            __builtin_amdgcn_fence(__ATOMIC_RELEASE, "agent");
            asm volatile("s_waitcnt vmcnt(0)" ::: "memory");
            const unsigned og = xb_add(&bar[XB_TOP], 1u);
            const unsigned tg = og / nx;
            if (og + 1u == (tg + 1u) * nx) xb_add(&bar[XB_TOPGEN], 1u);
            else XB_SPIN(xb_ld(&bar[XB_TOPGEN]) == tg, bar);
            __builtin_amdgcn_fence(__ATOMIC_ACQUIRE, "agent");
            xb_add(&bar[XB_XGEN(b.x)], 1u);
            asm volatile("s_waitcnt vmcnt(0)" ::: "memory");
        } else {
            XB_SPIN(xb_ld(&bar[XB_XGEN(b.x)]) == gen, bar);
            __builtin_amdgcn_fence(__ATOMIC_ACQUIRE, "agent");
            asm volatile("s_waitcnt vmcnt(0)" ::: "memory");
        }
    }
    __syncthreads();
}

constexpr int NWAVES = 8;
constexpr int RING_OFF = 0, RING_BYTES = 131072;
constexpr int LDSCTL_OFF = RING_BYTES, MISC_OFF = LDSCTL_OFF + 320;
constexpr int LDS_BYTES = 147456;
static_assert(attn128::SHM_TOTAL <= (size_t)RING_BYTES, "attention scratch fits the ring");

struct Args { const float* in[32]; float* out; unsigned char* ws; int ph_lo, ph_hi; };
constexpr int INTAB_OFF = LDSCTL_OFF + 1024;
__device__ __forceinline__ const float* inptr(LAS unsigned char* lds, int i) {
    const unsigned long long v = ((const LAS unsigned long long*)(lds + INTAB_OFF))[i];
    const unsigned lo = __builtin_amdgcn_readfirstlane((unsigned)v), hi = __builtin_amdgcn_readfirstlane((unsigned)(v >> 32));
    return (const float*)(GAS const float*)(((unsigned long long)hi << 32) | lo);
}
#define INP(i) inptr(F.lds, (i))
struct Frame {
    LAS unsigned char* lds; int tid, lane, wave, vcu, G, gw, NGW;
    unsigned char* ws;
};
enum { I_X = 0, I_C, I_CTX, I_CCTX, I_WMOD, I_BMOD, I_LNG, I_LNB, I_W1, I_W3, I_W2, I_WIN, I_ALAM, I_ASUB, I_CONVW, I_CONVB, I_ALOG, I_DTB, I_SSDD, I_SSDN,
       I_LRE, I_LIM, I_LSTEP, I_BRE, I_BIM, I_CRE, I_CIM, I_S5D, I_GLUW, I_GLUB, I_WBR, I_WOUT };

__device__ __forceinline__ void transpose_item64(const float* srcA, const float* srcB, int ldn, bool p32, bf16_t* dst, int ldk, LAS bf16_t* scr  , int lane) {
    const int q = lane & 15, kr = lane >> 4; const bool isB = q >= 8; const int c = (q & 7) * 4; const float* src = isB ? srcB : srcA;
    f32x4 v[16];
#pragma unroll
    for (int i = 0; i < 16; ++i) v[i] = src ? *(const f32x4*)(src + (size_t)(4 * i + kr) * ldn + c) : (f32x4){0.f, 0.f, 0.f, 0.f};
    const int drow = (p32 ? pg8::perm32(c) : c) + (isB ? 32 : 0);
#pragma unroll
    for (int i = 0; i < 16; ++i) { const int k = 4 * i + kr; const unsigned p01 = cvt_pk_bf16(v[i][0], v[i][1]), p23 = cvt_pk_bf16(v[i][2], v[i][3]);
        scr[(drow + 0) * 72 + k] = (bf16_t)(p01 & 0xffffu); scr[(drow + 1) * 72 + k] = (bf16_t)(p01 >> 16); scr[(drow + 2) * 72 + k] = (bf16_t)(p23 & 0xffffu); scr[(drow + 3) * 72 + k] = (bf16_t)(p23 >> 16); }
    LDS_WAIT(); asm volatile("" ::: "memory");
    const int c8 = lane & 7;
#pragma unroll
    for (int jj = 0; jj < 8; ++jj) { const int n = (lane >> 3) + 8 * jj; *(u32x4*)(dst + (size_t)n * ldk + 8 * c8) = *(const LAS u32x4*)(scr + n * 72 + 8 * c8); }
    LDS_WAIT(); asm volatile("" ::: "memory");
}
__device__ __forceinline__ void convert_layer_weights(const Args& A_, Frame& F, int l) {
    LAS bf16_t* scr = (LAS bf16_t*)(F.lds + RING_OFF + F.wave * 16384);
    unsigned char* W = F.ws + WS_W;
    constexpr int I13 = 32 * 176, I2 = 88 * 32, IIN = 32 * 212, IB = 16 * 32, IO = 32 * 32, IG = 16 * 16;
    constexpr int NIT = 2 * I13 + 2 * I2 + IIN + 3 * IB + IO + IG;
    for (int it = F.gw; it < NIT; it += F.NGW) {
        int r = it;
        if (r < 2 * I13) { const int f = r / I13; r -= f * I13; const int kb = r / 176, nb = r % 176;
            const float* wsrc = (((nb & 3) < 2) ? INP(I_W1) : INP(I_W3)) + ((size_t)(l * 2 + f) * D + 64 * kb) * DFF + 128 * (nb >> 2) + 64 * (nb & 1);
            transpose_item64(wsrc, wsrc + 32, DFF, false, (bf16_t*)(W + W_13) + ((size_t)f * N13 + 64 * nb) * D + 64 * kb, D, scr, F.lane); continue; }
        r -= 2 * I13;
        if (r < 2 * I2) { const int f = r / I2; r -= f * I2; const int kb = r / 32, nb = r % 32;
            const float* w2 = INP(I_W2) + ((size_t)(l * 2 + f) * DFF + 64 * kb) * D + 64 * nb;
            transpose_item64(w2, w2 + 32, D, false, (bf16_t*)(W + W_2) + ((size_t)f * D + 64 * nb) * DFF + 64 * kb, DFF, scr, F.lane); continue; }
        r -= 2 * I2;
        if (r < IIN) { const int kb = r / 212, nb = r % 212; const int n0 = 64 * nb; const float* wb = INP(I_WIN) + ((size_t)l * D + 64 * kb) * 13344;
            const float* sa = nullptr; const float* sb = nullptr;
            if (n0 < 6144) { sa = wb + n0; sb = sa + 32; } else if (n0 < 13312) { sa = wb + n0 + 32; sb = sa + 32; } else if (n0 == 13312) { sa = wb + 6144; }
            transpose_item64(sa, sb, 13344, n0 < 2048, (bf16_t*)(W + W_IN) + (size_t)n0 * D + 64 * kb, D, scr, F.lane); continue; }
        r -= IIN;
        if (r < 3 * IB) { const int jb = r / IB; r -= jb * IB; const int kb = r / 32, nb = r % 32;
            const float* w = INP(I_WBR) + ((size_t)(l * 3 + jb) * 1024 + 64 * kb) * D + 64 * nb;
            const int sp = (jb == 0) ? 0 : (jb == 1 ? 2 : 1); transpose_item64(w, w + 32, D, false, (bf16_t*)(W + W_B) + (size_t)(64 * nb) * 3072 + sp * 1024 + 64 * kb, 3072, scr, F.lane); continue; }
        r -= 3 * IB;
        if (r < IO) { const int kb = r / 32, nb = r % 32; const float* w = INP(I_WOUT) + ((size_t)l * D + 64 * kb) * D + 64 * nb;
            transpose_item64(w, w + 32, D, false, (bf16_t*)(W + W_O) + (size_t)(64 * nb) * D + 64 * kb, D, scr, F.lane); continue; }
        r -= IO;
        { const int kb = r / 16, nb = r % 16; const float* w = INP(I_GLUW) + ((size_t)l * 1024 + 64 * kb) * 1024 + 64 * nb;
            transpose_item64(w, w + 32, 1024, false, (bf16_t*)(W + W_GLU) + (size_t)(64 * nb) * 1024 + 64 * kb, 1024, scr, F.lane); }
    }
}
__device__ __forceinline__ void mod_partials(const Args& A_, Frame& F) {
    float* MODw = (float*)(F.ws + WS_MOD);
    LAS float* sl = (LAS float*)(F.lds + RING_OFF + 98304 + F.wave * 4096);
    const int nskip = (F.G > 64) ? 64 : 0; if ((int)blockIdx.x < nskip) return;
    for (int it = ((int)blockIdx.x - nskip) * NWAVES + F.wave; it < 2 * 72 * 16; it += (F.G - nskip) * NWAVES) {
        const int l = it / (72 * 16), r = it % (72 * 16), ks = r / 72, cg = r % 72;
        const int col = cg * 256 + F.lane * 4; const float* w = INP(I_WMOD) + ((size_t)l * D + ks * 128) * NMOD + col;
        const float* c = INP(I_C) + ks * 128; const float* cc = INP(I_CCTX) + ks * 128;
#pragma unroll
        for (int h = 0; h < 2; ++h) { const int k = F.lane + 64 * h;
            sl[0 * 128 + k] = siluf_(c[k]); sl[1 * 128 + k] = siluf_(c[D + k]); sl[2 * 128 + k] = siluf_(c[2 * D + k]); sl[3 * 128 + k] = siluf_(c[3 * D + k]); sl[4 * 128 + k] = siluf_(cc[k]); }
        LDS_WAIT(); asm volatile("" ::: "memory");
        f32x4 a0 = {0.f, 0.f, 0.f, 0.f}, a1 = a0, a2 = a0, a3 = a0, a4 = a0;
        for (int k0 = 0; k0 < 128; k0 += 16) {
            f32x4 wv[16];
#pragma unroll
            for (int e = 0; e < 16; ++e) wv[e] = *(const f32x4*)(w + (size_t)(k0 + e) * NMOD);
            asm volatile("s_waitcnt vmcnt(0)" ::: "memory");
#pragma unroll
            for (int e = 0; e < 16; ++e) { a0 += wv[e] * sl[0 * 128 + k0 + e]; a1 += wv[e] * sl[1 * 128 + k0 + e]; a2 += wv[e] * sl[2 * 128 + k0 + e]; a3 += wv[e] * sl[3 * 128 + k0 + e]; a4 += wv[e] * sl[4 * 128 + k0 + e]; }
        }
        const int r9 = col / D; const float sc = (r9 == 2 || r9 == 8) ? 0.5f : 1.0f;
        if (ks == 0) { const f32x4 bv = *(const f32x4*)(INP(I_BMOD) + (size_t)l * NMOD + col); a0 += bv; a1 += bv; a2 += bv; a3 += bv; a4 += bv; }
        float* o = MODw + (size_t)l * 5 * NMOD + col;
#pragma unroll
        for (int e = 0; e < 4; ++e) { unsafeAtomicAdd(o + e, a0[e] * sc); unsafeAtomicAdd(o + NMOD + e, a1[e] * sc); unsafeAtomicAdd(o + 2 * NMOD + e, a2[e] * sc); unsafeAtomicAdd(o + 3 * NMOD + e, a3[e] * sc); unsafeAtomicAdd(o + 4 * NMOD + e, a4[e] * sc); }
        LDS_WAIT(); asm volatile("" ::: "memory");
    }
}
__device__ __forceinline__ void ln_pass(Frame& F, bool do_ln, const float* lng, const float* lnb, const float* modnext  , float* out, const float* xin = nullptr, const float* cin = nullptr, int nslab = 0, bool skipctx = false) {
#define LNCO(i) (512 * ((i) >> 1) + 8 * F.lane + 4 * ((i) & 1))
    _Float16* H = (_Float16*)(F.ws + WS_H); const float* SL = (const float*)(F.ws + WS_YD); float* HC = (float*)(F.ws + WS_HC); bf16_t* HM = (bf16_t*)(F.ws + WS_HM); float* ST = (float*)(F.ws + WS_STATS);
    f32x4 G[8], Bv[8];
    if (do_ln) {
#pragma unroll
        for (int i = 0; i < 8; ++i) { G[i] = *(const f32x4*)(lng + LNCO(i)); Bv[i] = *(const f32x4*)(lnb + LNCO(i)); }
    }
    const int nper = F.NGW / NB; f32x4 sh4[8], sc4[8];
    for (int it = 0; it < SEQ / nper + 1; ++it) {
        int b = F.gw / nper, rr = CTX + (F.gw % nper) + nper * it;
        if (it == SEQ / nper) { if (skipctx || F.gw >= NB * CTX) break; b = F.gw / CTX; rr = F.gw % CTX; }
        const int row = b * RB + rr; const bool isctx = rr < CTX; const int mi = isctx ? 4 : b;
        float* hc = HC + ((size_t)b * CTX + rr) * D; _Float16* hr = H + (size_t)row * D;
        f32x4 v[8]; float s = 0.f;
        if (xin) { const float* src = isctx ? cin + ((size_t)b * CTX + rr) * D : xin + ((size_t)b * SEQ + (rr - CTX)) * D;
#pragma unroll
            for (int i = 0; i < 8; ++i) v[i] = *(const f32x4*)(src + LNCO(i));
        } else if (isctx) {
#pragma unroll
            for (int i = 0; i < 8; ++i) v[i] = *(const f32x4*)(hc + LNCO(i));
            if (nslab) {
#pragma unroll 1
                for (int q = 0; q < 4; ++q) { f32x4 sv[8];
#pragma unroll
                    for (int i = 0; i < 8; ++i) sv[i] = *(const f32x4*)(SL + ((size_t)q * (NB * CTX) + (size_t)b * CTX + rr) * D + LNCO(i));
#pragma unroll
                    for (int i = 0; i < 8; ++i) v[i] = v[i] + sv[i]; } }
        } else {
#pragma unroll
            for (int k = 0; k < 4; ++k) { const h16x8 h = *(const h16x8*)(hr + LNCO(2 * k)); v[2 * k] = (f32x4){(float)h[0], (float)h[1], (float)h[2], (float)h[3]}; v[2 * k + 1] = (f32x4){(float)h[4], (float)h[5], (float)h[6], (float)h[7]}; }
        }
        if (modnext && (it == 0 || it == SEQ / nper)) { const float* sh = modnext + (size_t)mi * NMOD; const float* sc = sh + D;
#pragma unroll
            for (int i = 0; i < 8; ++i) { sh4[i] = *(const f32x4*)(sh + LNCO(i)); sc4[i] = *(const f32x4*)(sc + LNCO(i)); }
            if (do_ln && !isctx) {
#pragma unroll
                for (int i = 0; i < 8; ++i) { sc4[i] = sc4[i] + 1.0f; sh4[i] = Bv[i] * sc4[i] + sh4[i]; sc4[i] = G[i] * sc4[i]; } } }
        asm volatile("s_waitcnt vmcnt(0)" ::: "memory");
#pragma unroll
        for (int i = 0; i < 8; ++i) s += (v[i][0] + v[i][1]) + (v[i][2] + v[i][3]);
        if (do_ln) {
            const float mean = wave_sum(s, F.lane) * (1.f / D); float s2 = 0.f;
#pragma unroll
            for (int i = 0; i < 8; ++i) { v[i] = v[i] - mean; s2 += (v[i][0] * v[i][0] + v[i][1] * v[i][1]) + (v[i][2] * v[i][2] + v[i][3] * v[i][3]); }
            const float rstd = 1.0f / sqrtf(wave_sum(s2, F.lane) * (1.f / D) + LN_EPS);
            if (!isctx && F.lane == 0) *(f32x2*)(ST + (size_t)row * 2) = (f32x2){mean, rstd};
#pragma unroll
            for (int i = 0; i < 8; ++i) { if (isctx || !modnext || out) { v[i] = v[i] * rstd * G[i] + Bv[i]; if (isctx) *(f32x4*)(hc + LNCO(i)) = v[i] * DN_ALPHA; } else v[i] = v[i] * rstd; }
        } else if (isctx) {
#pragma unroll
            for (int i = 0; i < 8; ++i) *(f32x4*)(hc + LNCO(i)) = v[i] * DN_ALPHA;
        } else {
#pragma unroll
            for (int k = 0; k < 4; ++k) { h16x8 h;
#pragma unroll
                for (int e = 0; e < 4; ++e) { h[e] = (_Float16)v[2 * k][e]; h[4 + e] = (_Float16)v[2 * k + 1][e]; }
                *(h16x8*)(hr + LNCO(2 * k)) = h; }
            if (F.lane == 0) *(f32x2*)(ST + (size_t)row * 2) = (f32x2){0.f, 1.f};
        }
        if (modnext) {
            const bool folded = do_ln && !isctx && !out;
#pragma unroll
            for (int k = 0; k < 4; ++k) { const f32x4 m0 = folded ? v[2 * k] * sc4[2 * k] + sh4[2 * k] : v[2 * k] * (sc4[2 * k] + 1.0f) + sh4[2 * k], m1 = folded ? v[2 * k + 1] * sc4[2 * k + 1] + sh4[2 * k + 1] : v[2 * k + 1] * (sc4[2 * k + 1] + 1.0f) + sh4[2 * k + 1];
                u32x4 w; w.x = cvt_pk_bf16(m0[0], m0[1]); w.y = cvt_pk_bf16(m0[2], m0[3]); w.z = cvt_pk_bf16(m1[0], m1[1]); w.w = cvt_pk_bf16(m1[2], m1[3]); *(u32x4*)(HM + (size_t)row * D + LNCO(2 * k)) = w; }
        }
        if (out && !isctx) { float* orow = out + ((size_t)b * SEQ + (rr - CTX)) * D;
#pragma unroll
            for (int i = 0; i < 8; ++i) *(f32x4*)(orow + LNCO(i)) = v[i]; }
    }
}
#undef LNCO

__device__ __forceinline__ void dt_tile(Frame& F, int l, int tile) {
    const bf16_t* A = (const bf16_t*)(F.ws + WS_HM) + (size_t)tile * 32 * D; const bf16_t* Bt = (const bf16_t*)(F.ws + WS_W + W_IN) + (size_t)13312 * D; float* DT = (float*)(F.ws + WS_DT);
    const int r = F.lane & 31, h = F.lane >> 5;
    f32x16 acc;
#pragma unroll
    for (int i = 0; i < 16; ++i) acc[i] = 0.f;
    const bf16_t* ap = A + (size_t)r * D + 8 * h; const bf16_t* bp = Bt + (size_t)r * D + 8 * h;
    for (int k0 = 0; k0 < 128; k0 += 16) {
        bf16x8 af[16], bfv[16];
#pragma unroll
        for (int e = 0; e < 16; ++e) { af[e] = *(const bf16x8*)(ap + 16 * (k0 + e)); bfv[e] = *(const bf16x8*)(bp + 16 * (k0 + e)); }
#pragma unroll
        for (int e = 0; e < 16; ++e) acc = __builtin_amdgcn_mfma_f32_32x32x16_bf16(af[e], bfv[e], acc, 0, 0, 0);
    }
    const float bias = INP(I_DTB)[l * 32 + r];
#pragma unroll
    for (int rg = 0; rg < 16; ++rg) { const int row = tile * 32 + (rg & 3) + 8 * (rg >> 2) + 4 * h; const float x = acc[rg] + bias; DT[(size_t)row * 32 + r] = fmaxf(x, 0.f) + log1pf(expf(-fabsf(x))); }
}
__device__ __forceinline__ void ssd_conv_pass(const Args& A_, Frame& F, int l) {
    const bf16_t* P = (const bf16_t*)(F.ws + WS_PROJ); bf16_t* XC = (bf16_t*)(F.ws + WS_HM);
    const float* cw = INP(I_CONVW) + (size_t)l * 5 * 2048; const float* cb = INP(I_CONVB) + (size_t)l * 2048;
    for (int it = F.gw; it < (R / 8) * 4; it += F.NGW) {
        const int r0 = (it >> 2) * 8, c0 = (it & 3) * 512 + F.lane * 8; const int rr0 = r0 % RB; const int lo = (rr0 < CTX) ? 0 : CTX, hi = (rr0 < CTX) ? CTX : RB;
        u32x4 x[12];
#pragma unroll
        for (int h = 0; h < 12; ++h) { const int r2 = rr0 + h - 2; x[h] = (r2 >= lo && r2 < hi) ? *(const u32x4*)(P + (size_t)(r0 + h - 2) * LDP + PX + c0) : (u32x4){0u, 0u, 0u, 0u}; }
        f32x4 w0[5], w1[5];
#pragma unroll
        for (int k = 0; k < 5; ++k) { w0[k] = *(const f32x4*)(cw + k * 2048 + c0); w1[k] = *(const f32x4*)(cw + k * 2048 + c0 + 4); }
        const f32x4 b0 = *(const f32x4*)(cb + c0), b1 = *(const f32x4*)(cb + c0 + 4);
#pragma unroll
        for (int jr = 0; jr < 8; ++jr) { f32x4 a0 = b0, a1 = b1;
#pragma unroll
            for (int k = 0; k < 5; ++k) { const u32x4 xv = x[jr + k];
                a0[0] += w0[k][0] * bflo(xv.x); a0[1] += w0[k][1] * bfhi(xv.x); a0[2] += w0[k][2] * bflo(xv.y); a0[3] += w0[k][3] * bfhi(xv.y);
                a1[0] += w1[k][0] * bflo(xv.z); a1[1] += w1[k][1] * bfhi(xv.z); a1[2] += w1[k][2] * bflo(xv.w); a1[3] += w1[k][3] * bfhi(xv.w); }
            u32x4 o; o.x = cvt_pk_bf16(siluf_(a0[0]), siluf_(a0[1])); o.y = cvt_pk_bf16(siluf_(a0[2]), siluf_(a0[3])); o.z = cvt_pk_bf16(siluf_(a1[0]), siluf_(a1[1])); o.w = cvt_pk_bf16(siluf_(a1[2]), siluf_(a1[3]));
            *(u32x4*)(XC + (size_t)(r0 + jr) * 2048 + c0) = o; }
    }
}
__device__ __forceinline__ int scan_row(int rb, int d, int step) { return d == 0 ? rb + step : (step < CTX ? rb + CTX - 1 - step : rb + (RB + CTX - 1) - step); }

__device__ __forceinline__ unsigned short bf16_1(float v) { return (unsigned short)(cvt_pk_bf16(v, 0.f) & 0xffffu); }
__device__ __forceinline__ void ssd_chain_fast(const Args& A_, Frame& F, int l, int cid) {
    constexpr int LS = 136;
    const int b = cid >> 6, d = (cid >> 5) & 1, hd = (cid >> 1) & 15, ph = cid & 1, g = hd >> 2; const int rb = b * RB;
    const bf16_t* XC = (const bf16_t*)(F.ws + WS_HM); const float* DT = (const float*)(F.ws + WS_DT); bf16_t* YD = (bf16_t*)(F.ws + WS_YD) + (size_t)d * R * 1024;
    const float a = -expf(INP(I_ALOG)[l * 32 + d * 16 + hd]);
    LAS bf16_t* Cs = (LAS bf16_t*)(F.lds); LAS bf16_t* Bs = Cs + 128 * LS; LAS bf16_t* Ms = Bs + 128 * LS; LAS bf16_t* XdT = Ms + 128 * LS; LAS bf16_t* Hb = XdT + 32 * LS;
    LAS float* csL = (LAS float*)(Hb + 32 * LS); LAS float* ecsL = csL + 128; LAS float* ewL = ecsL + 128; LAS float* misc = ewL + 128;
    const int tid = F.tid, lane = F.lane, w = F.wave, r = lane & 31, h = lane >> 5;
    f32x16 hacc;
#pragma unroll
    for (int i = 0; i < 16; ++i) hacc[i] = 0.f;
    for (int i = tid; i < 32 * LS / 2; i += 512) ((LAS unsigned*)Hb)[i] = 0u;
    u32x4 pc[4], pb[4], px; float pdt, pv0 = 0.f, pv1 = 0.f;
    const int rho0 = d ? 127 - lane : lane, rho1 = d ? 63 - lane : 64 + lane;
#define SSD_R0(k_) ((d == 0) ? rb + 128 * (k_) : ((k_) < 2 ? rb + 128 * (1 - (k_)) : rb + 256 + 128 * (33 - (k_))))
#define SSD_ISSUE(k_) do { const int r0n = SSD_R0(k_); \
        _Pragma("unroll") for (int i = 0; i < 4; ++i) { const int item = tid + 512 * i, row = item >> 4, seg = item & 15; const bf16_t* src = XC + (size_t)(r0n + row) * 2048 + g * 128 + seg * 8; pc[i] = *(const u32x4*)(src + 1536); pb[i] = *(const u32x4*)(src + 1024); } \
        { const int row = tid >> 2, seg = tid & 3; pdt = DT[(size_t)(r0n + row) * 32 + d * 16 + hd]; px = *(const u32x4*)(XC + (size_t)(r0n + row) * 2048 + hd * 64 + ph * 32 + seg * 8); } \
        if (w == 0) { pv0 = DT[(size_t)(r0n + rho0) * 32 + d * 16 + hd]; pv1 = DT[(size_t)(r0n + rho1) * 32 + d * 16 + hd]; } } while (0)
    SSD_ISSUE(0);
    unsigned ypk[8]; int yrow = -1;
#pragma unroll
    for (int i = 0; i < 8; ++i) ypk[i] = 0u;
#define SSD_YFLUSH() do { if (w < 4 && yrow >= 0) { bf16_t* yo = YD + (size_t)yrow * 1024 + hd * 64 + ph * 32 + r; \
        _Pragma("unroll") for (int rg = 0; rg < 16; ++rg) yo[(size_t)((rg & 3) + 8 * (rg >> 2)) * 1024] = (bf16_t)((rg & 1) ? (ypk[rg >> 1] >> 16) : (ypk[rg >> 1] & 0xffffu)); } } while (0)
    for (int k = 0; k < 34; ++k) {
        const int r0 = SSD_R0(k);
        __syncthreads();
#pragma unroll
        for (int i = 0; i < 4; ++i) { const int item = tid + 512 * i, row = item >> 4, seg = item & 15; *(LAS u32x4*)(Cs + row * LS + seg * 8) = pc[i]; *(LAS u32x4*)(Bs + row * LS + seg * 8) = pb[i]; }
        { const int row = tid >> 2, seg = tid & 3; const float dtv = pdt; const u32x4 xv = px;
            LAS bf16_t* xo = XdT + (seg * 8) * LS + row;
            xo[0 * LS] = bf16_1(bflo(xv.x) * dtv); xo[1 * LS] = bf16_1(bfhi(xv.x) * dtv); xo[2 * LS] = bf16_1(bflo(xv.y) * dtv); xo[3 * LS] = bf16_1(bfhi(xv.y) * dtv);
            xo[4 * LS] = bf16_1(bflo(xv.z) * dtv); xo[5 * LS] = bf16_1(bfhi(xv.z) * dtv); xo[6 * LS] = bf16_1(bflo(xv.w) * dtv); xo[7 * LS] = bf16_1(bfhi(xv.w) * dtv); }
        if (w == 0) {
            float v0 = pv0 * a, v1 = pv1 * a;
#pragma unroll
            for (int o = 1; o < 64; o <<= 1) { const float t0 = __int_as_float(__builtin_amdgcn_ds_bpermute((lane - o) << 2, __float_as_int(v0))), t1 = __int_as_float(__builtin_amdgcn_ds_bpermute((lane - o) << 2, __float_as_int(v1))); if (lane >= o) { v0 += t0; v1 += t1; } }
            const float tot0 = __int_as_float(__builtin_amdgcn_ds_bpermute(63 << 2, __float_as_int(v0))); v1 += tot0;
            const float cend = __int_as_float(__builtin_amdgcn_ds_bpermute(63 << 2, __float_as_int(v1)));
            csL[rho0] = v0; csL[rho1] = v1; ecsL[rho0] = __builtin_amdgcn_exp2f(v0 * 1.4426950408889634f); ecsL[rho1] = __builtin_amdgcn_exp2f(v1 * 1.4426950408889634f);
            ewL[rho0] = __builtin_amdgcn_exp2f((cend - v0) * 1.4426950408889634f); ewL[rho1] = __builtin_amdgcn_exp2f((cend - v1) * 1.4426950408889634f);
            if (lane == 0) misc[0] = __builtin_amdgcn_exp2f(cend * 1.4426950408889634f);
        }
        if (k + 1 < 34) SSD_ISSUE(k + 1);
        __syncthreads();
        { const int lt = w >> 1;
#pragma unroll
          for (int q = 0; q < 2; ++q) { const int st = (w & 1) * 2 + q; const bool zero = (d == 0) ? (st > lt) : (st < lt);
            f32x16 acc;
#pragma unroll
            for (int i = 0; i < 16; ++i) acc[i] = 0.f;
            if (!zero) { bf16x8 af[8], bfv[8];
#pragma unroll
                for (int ks = 0; ks < 8; ++ks) { af[ks] = *(const LAS bf16x8*)(Cs + (32 * lt + r) * LS + 16 * ks + 8 * h); bfv[ks] = *(const LAS bf16x8*)(Bs + (32 * st + r) * LS + 16 * ks + 8 * h); }
#pragma unroll
                for (int ks = 0; ks < 8; ++ks) acc = __builtin_amdgcn_mfma_f32_32x32x16_bf16(af[ks], bfv[ks], acc, 0, 0, 0); }
            const int scol = 32 * st + r; const float css = csL[scol];
            f32x4 cr4[4];
#pragma unroll
            for (int q4 = 0; q4 < 4; ++q4) cr4[q4] = *(const LAS f32x4*)(csL + 32 * lt + 8 * q4 + 4 * h);
#pragma unroll
            for (int rg = 0; rg < 16; ++rg) { const int lrow = 32 * lt + (rg & 3) + 8 * (rg >> 2) + 4 * h; const bool valid = (d == 0) ? (scol <= lrow) : (scol >= lrow);
                const float ex = __builtin_amdgcn_exp2f(fminf(cr4[rg >> 2][rg & 3] - css, 0.f) * 1.4426950408889634f);
                const float v = valid ? acc[rg] * ex : 0.f; Ms[lrow * LS + scol] = bf16_1(v); } } }
        __syncthreads();
        if (w < 4) { const int lt = w;
            f32x16 acc;
#pragma unroll
            for (int i = 0; i < 16; ++i) acc[i] = 0.f;
            { bf16x8 af[8], bfv[8];
#pragma unroll
              for (int ks = 0; ks < 8; ++ks) { af[ks] = *(const LAS bf16x8*)(Cs + (32 * lt + r) * LS + 16 * ks + 8 * h); bfv[ks] = *(const LAS bf16x8*)(Hb + r * LS + 16 * ks + 8 * h); }
#pragma unroll
              for (int ks = 0; ks < 8; ++ks) acc = __builtin_amdgcn_mfma_f32_32x32x16_bf16(af[ks], bfv[ks], acc, 0, 0, 0); }
            { f32x4 e4[4];
#pragma unroll
              for (int q4 = 0; q4 < 4; ++q4) e4[q4] = *(const LAS f32x4*)(ecsL + 32 * lt + 8 * q4 + 4 * h);
#pragma unroll
              for (int rg = 0; rg < 16; ++rg) acc[rg] *= e4[rg >> 2][rg & 3]; }
            { bf16x8 af[8], bfv[8];
#pragma unroll
              for (int ks = 0; ks < 8; ++ks) { af[ks] = *(const LAS bf16x8*)(Ms + (32 * lt + r) * LS + 16 * ks + 8 * h); bfv[ks] = *(const LAS bf16x8*)(XdT + r * LS + 16 * ks + 8 * h); }
#pragma unroll
              for (int ks = 0; ks < 8; ++ks) { const bool skip = (d == 0) ? (16 * ks >= 32 * (lt + 1)) : (16 * ks + 15 < 32 * lt);
                  if (!skip) acc = __builtin_amdgcn_mfma_f32_32x32x16_bf16(af[ks], bfv[ks], acc, 0, 0, 0); } }
            bf16_t* yo = YD + (size_t)(r0 + 32 * lt + 4 * h) * 1024 + hd * 64 + ph * 32 + r;
#pragma unroll
            for (int rg = 0; rg < 16; ++rg) yo[(size_t)((rg & 3) + 8 * (rg >> 2)) * 1024] = bf16_1(acc[rg]);
        } else { const int nt = w - 4; const float eend = misc[0];
#pragma unroll
            for (int i = 0; i < 16; ++i) hacc[i] *= eend;
            { typedef short v4i16_t_ __attribute__((ext_vector_type(4)));
#pragma unroll
              for (int kh = 0; kh < 2; ++kh) {
              u32x4 xa[8]; f32x4 e0[8], e1[8]; s16x4 t0[8], t1[8];
#pragma unroll
              for (int ks = 4 * kh; ks < 4 * kh + 4; ++ks) { const int k0 = 16 * ks + 8 * h; xa[ks] = *(const LAS u32x4*)(XdT + r * LS + k0); e0[ks] = *(const LAS f32x4*)(ewL + k0); e1[ks] = *(const LAS f32x4*)(ewL + k0 + 4);
                  const LAS bf16_t* tb = Bs + (k0 + ((lane & 15) >> 2)) * LS + 32 * nt + 16 * ((lane >> 4) & 1) + 4 * (lane & 3);
                  t0[ks] = __builtin_bit_cast(s16x4, __builtin_amdgcn_ds_read_tr16_b64_v4i16((LAS v4i16_t_*)tb)); t1[ks] = __builtin_bit_cast(s16x4, __builtin_amdgcn_ds_read_tr16_b64_v4i16((LAS v4i16_t_*)(tb + 4 * LS))); }
#pragma unroll
              for (int ks = 4 * kh; ks < 4 * kh + 4; ++ks) { u32x4 aw;
                  aw.x = cvt_pk_bf16(bflo(xa[ks].x) * e0[ks][0], bfhi(xa[ks].x) * e0[ks][1]); aw.y = cvt_pk_bf16(bflo(xa[ks].y) * e0[ks][2], bfhi(xa[ks].y) * e0[ks][3]); aw.z = cvt_pk_bf16(bflo(xa[ks].z) * e1[ks][0], bfhi(xa[ks].z) * e1[ks][1]); aw.w = cvt_pk_bf16(bflo(xa[ks].w) * e1[ks][2], bfhi(xa[ks].w) * e1[ks][3]);
                  const bf16x8 bw = (bf16x8){t0[ks][0], t0[ks][1], t0[ks][2], t0[ks][3], t1[ks][0], t1[ks][1], t1[ks][2], t1[ks][3]};
                  hacc = __builtin_amdgcn_mfma_f32_32x32x16_bf16(__builtin_bit_cast(bf16x8, aw), bw, hacc, 0, 0, 0); } } }
        }
        __syncthreads();
        if (w >= 4) { const int nt = w - 4;
#pragma unroll
            for (int rg = 0; rg < 16; ++rg) Hb[((rg & 3) + 8 * (rg >> 2) + 4 * h) * LS + 32 * nt + r] = bf16_1(hacc[rg]); }
    }
    __syncthreads();
#undef SSD_R0
#undef SSD_ISSUE
#undef SSD_YFLUSH
}
__device__ __forceinline__ void s5_setup(const Args& A_, Frame& F, int l, int boff = 0) {
    LAS float* Pre = (LAS float*)(F.lds); LAS float* Pim = Pre + 2 * 17 * 64; LAS float* BBr = Pim + 2 * 17 * 64; LAS float* BBi = BBr + 2 * 64 * 16; LAS float* Kt = BBi + 2 * 64 * 16;
    LAS float* CrL = Kt + 8192; LAS float* CiL = CrL + 2048; LAS float* CrT = CiL + 2048; LAS float* CiT = CrT + 2048;
    bf16_t* Bt1 = (bf16_t*)(F.ws + WS_S5M); bf16_t* Bt2 = Bt1 + (size_t)64 * 512 * 256; float* A16 = (float*)(F.ws + WS_S5A);
    const int tid = F.tid;
    for (int g = (int)blockIdx.x - boff; g >= 0 && g < 64; g += F.G) {
        { f32x4 c4[2];
#pragma unroll
          for (int h = 0; h < 2; ++h) { const int e4 = tid * 4 & 1023, d = (tid >> 8); const int pg_ = (l * 2 + d) * 64 + g; c4[h] = *(const f32x4*)((h ? INP(I_CIM) : INP(I_CRE)) + (size_t)pg_ * 1024 + e4); }
          *(LAS f32x4*)(CrL + tid * 4) = c4[0]; *(LAS f32x4*)(CiL + tid * 4) = c4[1];
          const int d = tid >> 8, o = (tid & 255) >> 4, n4 = (tid & 15) * 4;
#pragma unroll
          for (int e = 0; e < 4; ++e) { CrT[(d * 64 + n4 + e) * 16 + o] = c4[0][e]; CiT[(d * 64 + n4 + e) * 16 + o] = c4[1][e]; } }
        for (int q = tid; q < 2 * 17 * 64; q += 512) { const int d = q / (17 * 64), dl = (q >> 6) % 17, n = q & 63; const int pg_ = (l * 2 + d) * 64 + g;
            const float lre = INP(I_LRE)[pg_ * 64 + n], lim = INP(I_LIM)[pg_ * 64 + n], step = expf(INP(I_LSTEP)[pg_]);
            const float mag = expf(lre * step * (float)dl), ang = lim * step * (float)dl; Pre[q] = mag * cosf(ang); Pim[q] = mag * sinf(ang); }
        __syncthreads();
        if (tid < 128) { const int d = tid >> 6, n = tid & 63; const int pg_ = (l * 2 + d) * 64 + g;
            const float lre = INP(I_LRE)[pg_ * 64 + n], lim = INP(I_LIM)[pg_ * 64 + n];
            const float abr = Pre[(d * 17 + 1) * 64 + n], abi = Pim[(d * 17 + 1) * 64 + n];
            const float den = lre * lre + lim * lim; const float kre = ((abr - 1.f) * lre + abi * lim) / den, kim = (abi * lre - (abr - 1.f) * lim) / den;
            const float* br = INP(I_BRE) + ((size_t)pg_ * 64 + n) * 16; const float* bi = INP(I_BIM) + ((size_t)pg_ * 64 + n) * 16;
            f32x4 bq[4], bz[4];
#pragma unroll
            for (int q = 0; q < 4; ++q) { bq[q] = *(const f32x4*)(br + 4 * q); bz[q] = *(const f32x4*)(bi + 4 * q); }
#pragma unroll
            for (int i = 0; i < 16; ++i) { const float x = bq[i >> 2][i & 3], y = bz[i >> 2][i & 3]; BBr[(d * 64 + n) * 16 + i] = kre * x - kim * y; BBi[(d * 64 + n) * 16 + i] = kre * y + kim * x; }
            A16[((d * 64 + g) * 64 + n) * 2] = Pre[(d * 17 + 16) * 64 + n]; A16[((d * 64 + g) * 64 + n) * 2 + 1] = Pim[(d * 17 + 16) * 64 + n]; }
        __syncthreads();
        { const int d = tid >> 8, dl = (tid >> 4) & 15, i = tid & 15;
            f32x4 acc[4] = {{0.f, 0.f, 0.f, 0.f}, {0.f, 0.f, 0.f, 0.f}, {0.f, 0.f, 0.f, 0.f}, {0.f, 0.f, 0.f, 0.f}};
            for (int n = 0; n < 64; ++n) { const float pr = Pre[(d * 17 + dl) * 64 + n], pi = Pim[(d * 17 + dl) * 64 + n], br = BBr[(d * 64 + n) * 16 + i], bi = BBi[(d * 64 + n) * 16 + i];
                const float tr = pr * br - pi * bi, ti = pr * bi + pi * br;
#pragma unroll
                for (int o4 = 0; o4 < 4; ++o4) { const f32x4 cr = *(const LAS f32x4*)(CrT + (d * 64 + n) * 16 + 4 * o4), ci = *(const LAS f32x4*)(CiT + (d * 64 + n) * 16 + 4 * o4); acc[o4] += cr * tr - ci * ti; } }
#pragma unroll
            for (int o = 0; o < 16; ++o) Kt[((d * 16 + dl) * 16 + o) * 16 + i] = acc[o >> 2][o & 3]; }
        __syncthreads();
        const float dsk = INP(I_S5D)[l * 1024 + 16 * g + (tid & 15)];
        for (int q = 0; q < 16; ++q) { const int item = tid + 512 * q; const int c1 = item >> 5, kb = (item & 31) * 8; const int rin = kb >> 4, i0 = kb & 15, rout = c1 >> 4, o = c1 & 15;
            const float dsko = __int_as_float(__builtin_amdgcn_ds_bpermute((((F.lane & ~15) | o)) << 2, __float_as_int(dsk)));
            float v[8];
#pragma unroll
            for (int e = 0; e < 8; ++e) { const int i = i0 + e; float x = 0.f; if (rout >= rin) x += Kt[((0 * 16 + (rout - rin)) * 16 + o) * 16 + i]; if (rin >= rout) x += Kt[((1 * 16 + (rin - rout)) * 16 + o) * 16 + i];
                if (rin == rout && i == o) x += dsko; v[e] = x; }
            u32x4 w; w.x = cvt_pk_bf16(v[0], v[1]); w.y = cvt_pk_bf16(v[2], v[3]); w.z = cvt_pk_bf16(v[4], v[5]); w.w = cvt_pk_bf16(v[6], v[7]);
            *(u32x4*)(Bt1 + ((size_t)g * 512 + c1) * 256 + kb) = w; }
        for (int q = 0; q < 16; ++q) { const int item = tid + 512 * q; const int c1 = item >> 5, kb = (item & 31) * 8; const int rin = kb >> 4, i0 = kb & 15; const int d = c1 >> 7, part = c1 & 1, n = (c1 >> 1) & 63;
            const int ex = (d == 0) ? 15 - rin : rin; const float pr = Pre[(d * 17 + ex) * 64 + n], pi = Pim[(d * 17 + ex) * 64 + n];
            float v[8];
#pragma unroll
            for (int e = 0; e < 8; ++e) { const float br = BBr[(d * 64 + n) * 16 + i0 + e], bi = BBi[(d * 64 + n) * 16 + i0 + e]; v[e] = part ? (pr * bi + pi * br) : (pr * br - pi * bi); }
            u32x4 w; w.x = cvt_pk_bf16(v[0], v[1]); w.y = cvt_pk_bf16(v[2], v[3]); w.z = cvt_pk_bf16(v[4], v[5]); w.w = cvt_pk_bf16(v[6], v[7]);
            *(u32x4*)(Bt1 + ((size_t)g * 512 + 256 + c1) * 256 + kb) = w; }
        for (int q = 0; q < 16; ++q) { const int item = tid + 512 * q; const int c2 = item >> 5, kb = (item & 31) * 8; const int rout = c2 >> 4, o = c2 & 15; const int d = kb >> 7, part = (kb >> 6) & 1, n0 = kb & 63;
            const int ex = (d == 0) ? rout + 1 : 16 - rout; const LAS float* cr = CrL + (d * 16 + o) * 64 + n0; const LAS float* ci = CiL + (d * 16 + o) * 64 + n0;
            float v[8];
#pragma unroll
            for (int e = 0; e < 8; ++e) { const float pr = Pre[(d * 17 + ex) * 64 + n0 + e], pi = Pim[(d * 17 + ex) * 64 + n0 + e]; v[e] = part ? -(cr[e] * pi + ci[e] * pr) : (cr[e] * pr - ci[e] * pi); }
            u32x4 w; w.x = cvt_pk_bf16(v[0], v[1]); w.y = cvt_pk_bf16(v[2], v[3]); w.z = cvt_pk_bf16(v[4], v[5]); w.w = cvt_pk_bf16(v[6], v[7]);
            *(u32x4*)(Bt2 + ((size_t)g * 256 + c2) * 256 + kb) = w; }
        __syncthreads();
    }
}
__device__ __forceinline__ void s5_carry(Frame& F, int cid) {
    const int b = cid >> 7, d = (cid >> 6) & 1, g = cid & 63, n = F.lane;
    const unsigned* ST = (const unsigned*)((const bf16_t*)(F.ws + WS_S5ST) + ((size_t)g * S5M + b * 272) * 256 + d * 128) + n;
    bf16_t* HP = (bf16_t*)(F.ws + WS_S5H) + ((size_t)g * 1280 + b * 272) * 256 + d * 128 + n;
    const float* A16 = (const float*)(F.ws + WS_S5A); const float ar = A16[((d * 64 + g) * 64 + n) * 2], ai = A16[((d * 64 + g) * 64 + n) * 2 + 1];
    float hr = 0.f, hi_ = 0.f;
    for (int k0 = 0; k0 < 272; k0 += 34) {
        unsigned wv[34];
#pragma unroll
        for (int e = 0; e < 34; ++e) { const int k = k0 + e; const int cc = (d == 0) ? k : (k < 16 ? 15 - k : 287 - k); wv[e] = ST[(size_t)cc * 128]; }
        asm volatile("s_waitcnt vmcnt(0)" ::: "memory");
#pragma unroll
        for (int e = 0; e < 34; ++e) { const int k = k0 + e; const int cc = (d == 0) ? k : (k < 16 ? 15 - k : 287 - k);
            HP[(size_t)cc * 256] = (bf16_t)(cvt_pk_bf16(hr, 0.f) & 0xffffu); HP[(size_t)cc * 256 + 64] = (bf16_t)(cvt_pk_bf16(hi_, 0.f) & 0xffffu);
            const float sr = bflo(wv[e]), si = bfhi(wv[e]); const float nr = ar * hr - ai * hi_ + sr, ni = ar * hi_ + ai * hr + si; hr = nr; hi_ = ni; }
    }
}
__device__ __forceinline__ void mixer_finalize(const Args& A_, Frame& F, int l) {
    bf16_t* P = (bf16_t*)(F.ws + WS_PROJ);
    const bf16_t* XC = (const bf16_t*)(F.ws + WS_HM); const bf16_t* YD0 = (const bf16_t*)(F.ws + WS_YD); const bf16_t* YD1 = YD0 + (size_t)R * 1024;
        const int c0 = F.lane * 16;
    for (int row = F.gw; row < R; row += F.NGW) {
        { const float dsk = INP(I_SSDD)[l * 16 + (c0 >> 6)];
          const float* nwp = INP(I_SSDN) + l * 1024 + c0;
          float v[16];
#pragma unroll
          for (int hh = 0; hh < 2; ++hh) { const u32x4 x = *(const u32x4*)(XC + (size_t)row * 2048 + c0 + 8 * hh), y0 = *(const u32x4*)(YD0 + (size_t)row * 1024 + c0 + 8 * hh), y1 = *(const u32x4*)(YD1 + (size_t)row * 1024 + c0 + 8 * hh), z = *(const u32x4*)(P + (size_t)row * LDP + PZ + c0 + 8 * hh);
#define SG(i, wx, wy0, wy1, wz) v[8 * hh + 2 * (i)] = (bflo(wx) * dsk + bflo(wy0) + bflo(wy1)) * bflo(wz); v[8 * hh + 2 * (i) + 1] = (bfhi(wx) * dsk + bfhi(wy0) + bfhi(wy1)) * bfhi(wz);
              SG(0, x.x, y0.x, y1.x, z.x) SG(1, x.y, y0.y, y1.y, z.y) SG(2, x.z, y0.z, y1.z, z.z) SG(3, x.w, y0.w, y1.w, z.w)
#undef SG
          }
          float ss = 0.f;
#pragma unroll
          for (int e = 0; e < 16; ++e) ss += v[e] * v[e];
          ss += shx(ss, 1, F.lane); ss += shx(ss, 2, F.lane); ss += shx(ss, 4, F.lane); ss += shx(ss, 8, F.lane);
          const float rs = 1.0f / sqrtf(ss * (1.f / 256.f) + RMS_EPS);
          const f32x4 n0 = *(const f32x4*)(nwp), n1 = *(const f32x4*)(nwp + 4), n2 = *(const f32x4*)(nwp + 8), n3 = *(const f32x4*)(nwp + 12);
          const float nw[16] = {n0[0], n0[1], n0[2], n0[3], n1[0], n1[1], n1[2], n1[3], n2[0], n2[1], n2[2], n2[3], n3[0], n3[1], n3[2], n3[3]};
          u32x4 o0, o1;
          o0.x = cvt_pk_bf16(v[0] * rs * nw[0], v[1] * rs * nw[1]); o0.y = cvt_pk_bf16(v[2] * rs * nw[2], v[3] * rs * nw[3]); o0.z = cvt_pk_bf16(v[4] * rs * nw[4], v[5] * rs * nw[5]); o0.w = cvt_pk_bf16(v[6] * rs * nw[6], v[7] * rs * nw[7]);
          o1.x = cvt_pk_bf16(v[8] * rs * nw[8], v[9] * rs * nw[9]); o1.y = cvt_pk_bf16(v[10] * rs * nw[10], v[11] * rs * nw[11]); o1.z = cvt_pk_bf16(v[12] * rs * nw[12], v[13] * rs * nw[13]); o1.w = cvt_pk_bf16(v[14] * rs * nw[14], v[15] * rs * nw[15]);
          *(u32x4*)(P + (size_t)row * LDP + PV + c0) = o0; *(u32x4*)(P + (size_t)row * LDP + PV + c0 + 8) = o1; }
    }
}


__global__ void __launch_bounds__(NWAVES * 64, 2) trunk_fwd(Args args) {
    extern __shared__ __attribute__((aligned(16))) unsigned char lds_raw[];
    Frame F;
    F.lds = (LAS unsigned char*)lds_raw;
    F.tid = threadIdx.x; F.lane = F.tid & 63; F.wave = __builtin_amdgcn_readfirstlane(F.tid >> 6);
    F.G = gridDim.x; { const int bx = blockIdx.x; F.vcu = (F.G % 8 == 0) ? (bx % 8) * (F.G / 8) + bx / 8 : bx; }
    F.gw = F.vcu * NWAVES + F.wave; F.NGW = F.G * NWAVES;
    F.ws = args.ws;
    volatile LAS unsigned* MISC = (volatile LAS unsigned*)(F.lds + MISC_OFF);
    for (int u = F.tid; u < (LDS_BYTES - LDSCTL_OFF) / 4; u += NWAVES * 64) ((LAS unsigned*)(F.lds + LDSCTL_OFF))[u] = 0u;
    __syncthreads();
    if (threadIdx.x < 32) ((LAS unsigned long long*)(F.lds + INTAB_OFF))[threadIdx.x] = (unsigned long long)args.in[threadIdx.x];
    __syncthreads();
    (void)xcd_barrier_post((unsigned*)(args.ws + WS_CTL) + CW_BAR, MISC + 8);
    const int lo = args.ph_lo, hi = args.ph_hi;
    const int wave0 = __builtin_amdgcn_readfirstlane((int)threadIdx.x >> 6);
    int pid = 0;
#define PH_BEGIN if (pid >= lo && pid < hi) { GAS unsigned char* wsg_ = (GAS unsigned char*)args.ws; int tid_; asm volatile("v_mbcnt_lo_u32_b32 %1, -1, 0\n\tv_mbcnt_hi_u32_b32 %1, -1, %1 ; PHASE_MARK_BEGIN %2" : "+s"(wsg_), "=v"(tid_) : "i"(__LINE__) : "memory"); tid_ += wave0 * 64; unsigned char* ws = (unsigned char*)wsg_; F.ws = ws; F.tid = tid_; F.lane = tid_ & 63; F.wave = __builtin_amdgcn_readfirstlane(tid_ >> 6); F.gw = F.vcu * NWAVES + F.wave;
#define PH_END   asm volatile("; PHASE_MARK_END %0" :: "i"(__LINE__)); if (pid + 1 < hi) { XcdBarrier bar_; bar_.bar = (unsigned*)(args.ws + WS_CTL) + CW_BAR; bar_.x = xb_xcc_id(); bar_.st = (volatile LAS unsigned*)(F.lds + MISC_OFF) + 8; xcd_barrier(bar_, wave0 * 64 + lane_now()); } } ++pid;

#define MOD ((float*)(ws + WS_MOD))
#define Hbuf ((float*)(ws + WS_H))
#define HM ((bf16_t*)(ws + WS_HM))
#define PROJ ((bf16_t*)(ws + WS_PROJ))
#define ROPEC ((float*)(ws + WS_ROPE))
#define ROPES (ROPEC + 1024)
#define WGT (ws + WS_W)

    PH_BEGIN
        s5_setup(args, F, 0);
        mod_partials(args, F);
        if ((int)blockIdx.x == F.G - 1) {
            { float* idn = (float*)(ws + WS_IDENT); for (int i = F.tid; i < 2048; i += NWAVES * 64) { idn[i] = 1.0f; idn[2048 + i] = 0.0f; } }
#pragma unroll
            for (int i2 = 0; i2 < 2; ++i2) { const int idx = (F.wave * 2 + i2) * 64 + F.lane, pos = idx >> 4, f = idx & 15; const float inv = powf(10000.0f, -(float)f / 16.0f); const float ang = (float)pos * inv; ROPEC[idx] = cosf(ang); ROPES[idx] = sinf(ang); } }
    PH_END
    PH_BEGIN
        convert_layer_weights(args, F, 0);
        ln_pass(F, false, nullptr, nullptr, MOD, nullptr, INP(I_X), INP(I_CTX));
    PH_END

    for (int s = 0; s < 6; ++s) {
        const int l = s / 3, j = s - 3 * l;
        if (j != 1) {
            const int f = j >> 1;
            PH_BEGIN
                const int lat = (l == 1 && j == 2); pg8::Gemm g{D, D, D}; pg8::StaticOrder S; S.init(lat ? 64 : NPAN, N13 / 256, F.G, (int)blockIdx.x, HM, D, (const bf16_t*)(WGT + W_13) + (size_t)f * N13 * D, D, D, lat);
                EpiSwiGLU E{PROJ};
                pg8::gemm_phase<EpiSwiGLU, pg8::StaticOrder>(F.lds + RING_OFF, g, S, E, F.tid);
            PH_END
        } else {
            PH_BEGIN
                pg8::Gemm g{D, D, D}; pg8::StaticOrder S;
                if (l == 0) S.init(NPAN, LDP / 256, F.G, (int)blockIdx.x, HM, D, (const bf16_t*)(WGT + W_IN), D, D);
                else { S.init(64, LDP / 256, F.G, (int)blockIdx.x, HM, D, (const bf16_t*)(WGT + W_IN), D, D, 1, 80); S.cproj = 1; }
                EpiProj E{PROJ, (float*)(ws + WS_DT), ROPEC, ROPES, (bf16_t*)(ws + WS_O), (unsigned*)(ws + WS_KM) + l * 512};
                pg8::gemm_phase<EpiProj, pg8::StaticOrder>(F.lds + RING_OFF, g, S, E, F.tid);
                { const int nfull = ((l == 0 ? NPAN * (LDP / 256) : 64 * (LDP / 256) + 80)) % F.G;
                  if ((int)blockIdx.x >= nfull) { const int nw = (F.G - nfull) * NWAVES; for (int t = ((int)blockIdx.x - nfull) * NWAVES + F.wave; t < R / 32; t += nw) dt_tile(F, l, t); } }
            PH_END
            PH_BEGIN
                ssd_conv_pass(args, F, l);
                asm volatile("" : "+v"(F.tid));
                { pg8::Gemm g{256, 256, 256}; S5AOrder S{F.G, (int)blockIdx.x, (const char*)(ws + WS_O), (const char*)(ws + WS_S5M)};
                  EpiS5A E{(unsigned char*)(ws + WS_YS), (bf16_t*)(ws + WS_S5ST)};
                  pg8::gemm_phase<EpiS5A, S5AOrder>(F.lds + RING_OFF, g, S, E, F.tid); }
            PH_END
            PH_BEGIN
                if (F.wave < 2) s5_carry(F, (int)blockIdx.x * 2 + F.wave);
                ssd_chain_fast(args, F, l, (int)blockIdx.x);
                {
                    const float lam_init = 0.8f - 0.6f * expf(-0.3f * (float)l);
                    const float* lv = INP(I_ALAM) + l * 256;
                    const float s01 = wave_sum(lv[F.lane] * lv[64 + F.lane], F.lane), s23 = wave_sum(lv[128 + F.lane] * lv[192 + F.lane], F.lane);
                    const float lam = expf(s01) - expf(s23) + lam_init;
                    for (int i = 0;; ++i) { const int idx = i * F.G + F.vcu; if (idx >= 512 + (l == 0 ? 32 : 0)) break;
                        int b, h, q0, seq;
                        if (idx < 512) { b = idx >> 7; h = (idx >> 4) & 7; q0 = b * RB + CTX + (idx & 15) * 256; seq = RB; }
                        else { const int k = idx - 512; b = k >> 3; h = k & 7; q0 = b * RB; seq = CTX; }
                        const bf16_t* Q0 = PROJ + (size_t)q0 * LDP + PQ + h * 128; const bf16_t* Kh = PROJ + (size_t)(b * RB) * LDP + PK + h * 128; const bf16_t* Vh = PROJ + (size_t)(b * RB) * LDP + PV + h * 128;
                        attn128::unit((const attn128::bf16*)Q0, (const attn128::bf16*)Kh, (const attn128::bf16*)Vh, PROJ + (size_t)q0 * LDP + PQ + h * 128, seq, (char*)lds_raw + RING_OFF, F.tid, lam, 1.0f - lam_init, INP(I_ASUB) + l * 128, (const float*)(ws + WS_KM) + l * 512 + (b * 8 + h) * 16);
                    }
                }
            PH_END
            PH_BEGIN
                mixer_finalize(args, F, l);
                asm volatile("" : "+v"(F.tid));
                { pg8::Gemm g{256, 256, 256}; S5COrder S{F.G, (int)blockIdx.x, (const char*)(ws + WS_S5H), (const char*)((bf16_t*)(ws + WS_S5M) + (size_t)64 * 512 * 256)};
                  EpiS5C E{(const unsigned char*)(ws + WS_YS), PROJ};
                  pg8::gemm_phase<EpiS5C, S5COrder>(F.lds + RING_OFF, g, S, E, F.tid); }
            PH_END
            PH_BEGIN
                pg8::Gemm g{LDP, 1024, 1024}; pg8::StaticOrder S; S.init(l == 1 ? 64 : NPAN, 4, F.G, (int)blockIdx.x, PROJ + PU, LDP, (const bf16_t*)(WGT + W_GLU), 1024, 1024, l == 1);
                EpiGlu E{PROJ, INP(I_GLUB) + l * 1024};
                pg8::gemm_phase<EpiGlu, pg8::StaticOrder>(F.lds + RING_OFF, g, S, E, F.tid);
            PH_END
            PH_BEGIN
                pg8::Gemm g{LDP, 3072, 3072}; pg8::StaticOrder S; S.init(l == 1 ? 64 : NPAN, 8, F.G, (int)blockIdx.x, PROJ, LDP, (const bf16_t*)(WGT + W_B), 3072, 3072, l == 1);
                EpiMerge E{PROJ, HM};
                pg8::gemm_phase<EpiMerge, pg8::StaticOrder, 0, true>(F.lds + RING_OFF, g, S, E, F.tid);
            PH_END
        }
        PH_BEGIN
            const int RK = (j == 1) ? D : DFF; const bf16_t* RA = (j == 1) ? HM : PROJ; const bf16_t* RBt = (j == 1) ? (const bf16_t*)(WGT + W_O) : (const bf16_t*)(WGT + W_2) + (size_t)(j >> 1) * D * DFF;
            const int lat = (l == 1 && j >= 1); pg8::Gemm g{RK, RK, RK}; pg8::StaticOrder S; S.init(64, D / 256, F.G, (int)blockIdx.x, RA, RK, RBt, RK, RK, 1, lat ? 0 : 128);
            const float* lg_ = (s == 0) ? (const float*)(ws + WS_IDENT) : INP(I_LNG) + (size_t)(s - 1) * D; const float* lb_ = (s == 0) ? (const float*)(ws + WS_IDENT) + 2048 : INP(I_LNB) + (size_t)(s - 1) * D;
            EpiResid E{(_Float16*)(ws + WS_H), (float*)(ws + WS_HC), MOD + (size_t)l * 5 * NMOD + (3 * j + 2) * D, lg_, lb_, (const float*)(ws + WS_STATS)};
            pg8::gemm_phase<EpiResid, pg8::StaticOrder>(F.lds + RING_OFF, g, S, E, F.tid);
        PH_END
        PH_BEGIN
            const bool fin = (s == 5);
            const int ln_ = (j == 2) ? l + 1 : l, jn = (j == 2) ? 0 : j + 1;
            ln_pass(F, true, INP(I_LNG) + (size_t)(l * 3 + j) * D, INP(I_LNB) + (size_t)(l * 3 + j) * D, fin ? nullptr : MOD + (size_t)ln_ * 5 * NMOD + 3 * jn * D, fin ? args.out : nullptr, nullptr, nullptr, (l == 1 && j >= 1) ? 0 : 4, l == 1 && j >= 1  );
            if (s == 2) { s5_setup(args, F, 1); __syncthreads(); convert_layer_weights(args, F, 1); }
        PH_END
    }
#undef PH_BEGIN
#undef PH_END
}

static int count_phases() { int n = 2; for (int s = 0; s < 6; ++s) n += ((s % 3) != 1 ? 1 : 6) + 2; return n; }
extern "C" void kernel_launch(void* const* d_in, const int* in_sizes, int n_in, void* d_out, int out_size, void* d_ws, size_t ws_size, hipStream_t stream) {
    static int grid = 0;
    if (grid == 0) {
        if (n_in != 32 || out_size != NB * SEQ * D || ws_size < WS_END) { fprintf(stderr, "kernel_launch: unexpected shapes (n_in %d, out %d, ws %zu < %zu)\n", n_in, out_size, ws_size, (size_t)WS_END); grid = -1; return; }
        int dev = 0, cus = 0, per_cu = 0;
        if (hipGetDevice(&dev) != hipSuccess || hipDeviceGetAttribute(&cus, hipDeviceAttributeMultiprocessorCount, dev) != hipSuccess) { grid = -1; return; }
        if (hipFuncSetAttribute((const void*)trunk_fwd, hipFuncAttributeMaxDynamicSharedMemorySize, LDS_BYTES) != hipSuccess) { fprintf(stderr, "kernel_launch: hipFuncSetAttribute failed\n"); grid = -1; return; }
        if (hipOccupancyMaxActiveBlocksPerMultiprocessor(&per_cu, (const void*)trunk_fwd, NWAVES * 64, LDS_BYTES) != hipSuccess || per_cu < 1) fprintf(stderr, "kernel_launch: occupancy query says %d\n", per_cu);
        (void)hipGetLastError();
        if (cus != 256) { fprintf(stderr, "kernel_launch: this kernel deals its SSD chains / carries / attention units over exactly 256 workgroups (one per CU); device reports %d CUs; nothing launched\n", cus); grid = -1; return; }
        grid = cus;
    }
    if (grid < 0) return;
    (void)in_sizes;
    if (hipMemsetAsync((char*)d_ws + WS_CTL, 0, 2 * MiB  , stream) != hipSuccess) return;
    Args a{};
    for (int i = 0; i < 32; ++i) a.in[i] = (const float*)d_in[i];
    a.out = (float*)d_out; a.ws = (unsigned char*)d_ws;
    const int nph = count_phases();
#if MK_PER_PHASE
    for (int p = 0; p < nph; ++p) { a.ph_lo = p; a.ph_hi = p + 1; hipLaunchKernelGGL(trunk_fwd, dim3(grid), dim3(NWAVES * 64), LDS_BYTES, stream, a); }
#else
    a.ph_lo = 0; a.ph_hi = nph;
    hipLaunchKernelGGL(trunk_fwd, dim3(grid), dim3(NWAVES * 64), LDS_BYTES, stream, a);
#endif
    const hipError_t le = hipPeekAtLastError();
    if (le != hipSuccess) fprintf(stderr, "kernel_launch: launch failed: %s\n", hipGetErrorName(le));
}
```

```cpp
#include <hip/hip_runtime.h>
#include <hip/hip_bf16.h>
#include <cstdio>
#include <cstdint>
#include <cmath>

#ifndef MK_PER_PHASE
#define MK_PER_PHASE 0
#endif

#define LAS __attribute__((address_space(3)))
#define GAS __attribute__((address_space(1)))
typedef unsigned short bf16_t;
typedef short bf16x8 __attribute__((ext_vector_type(8)));
typedef float f32x4 __attribute__((ext_vector_type(4)));
typedef float f32x2 __attribute__((ext_vector_type(2)));
typedef float f32x16 __attribute__((ext_vector_type(16)));
typedef unsigned u32x4 __attribute__((ext_vector_type(4)));
typedef unsigned u32x2 __attribute__((ext_vector_type(2)));
typedef short s16x4 __attribute__((ext_vector_type(4)));

constexpr int NB = 4, SEQ = 4096, CTX = 256, RB = SEQ + CTX  , R = NB * RB  , NPAN = R / 256  , PPB = RB / 256  ;
constexpr int D = 2048, DFF = 5632, N13 = 2 * DFF, NMOD = 9 * D  ;
constexpr int LDP = 13312;
constexpr int NIN = 13568;
constexpr int PQ = 0, PK = 1024, PV = 2048, PZ = 3072, PX = 4096, PU = 6144, PG = 7168;
constexpr float DN_ALPHA = 1.41421356237309515f;
constexpr float LN_EPS = 1e-5f, RMS_EPS = 1e-6f;
constexpr float QSCALE = 0.125f * 1.4426950408889634f;

constexpr size_t MiB = 1u << 20;
constexpr size_t WS_CTL = 0, CTL_ZERO_BYTES = 1 * MiB;
constexpr size_t WS_MOD = 1 * MiB;
constexpr size_t WS_ROPE = 2 * MiB;
constexpr size_t WS_STATS = 2 * MiB + 65536;
constexpr size_t WS_IDENT = 2 * MiB + 262144;
constexpr size_t WS_MODP = 3 * MiB;
constexpr size_t WS_DT = 15 * MiB;
constexpr size_t WS_H = 18 * MiB;
constexpr size_t WS_HC = WS_H + 68 * MiB;
constexpr size_t WS_HM = 154 * MiB;
constexpr size_t WS_PROJ = 222 * MiB;
constexpr size_t WS_O = 664 * MiB;
constexpr size_t WS_YD = 732 * MiB;
constexpr size_t WS_YS = 800 * MiB;
constexpr size_t WS_W = 868 * MiB;
constexpr size_t W_13 = 0, W_2 = 88 * MiB, W_IN = 132 * MiB, W_B = 185 * MiB, W_O = 197 * MiB, W_GLU = 205 * MiB;
constexpr size_t WS_S5ST = 1075 * MiB;
constexpr size_t WS_S5H = 1143 * MiB;
constexpr size_t WS_S5M = 1183 * MiB;
constexpr size_t WS_S5A = 1207 * MiB;
constexpr size_t WS_GQ0 = WS_O + 34 * MiB, WS_GQ1 = WS_S5ST + 34 * MiB  , WS_GQ2 = 1208 * MiB;
constexpr size_t WS_END = 1242 * MiB;
__device__ __forceinline__ size_t gq_off(int j) { return j == 0 ? WS_GQ0 : (j == 1 ? WS_GQ1 : WS_GQ2); }
constexpr int S5M = 1088;
constexpr int CW_BAR = 4096;
constexpr size_t WS_KM = WS_CTL + 512 * 1024;

__device__ __forceinline__ unsigned cvt_pk_bf16(float lo, float hi) { unsigned r; asm volatile("v_cvt_pk_bf16_f32 %0, %1, %2" : "=v"(r) : "v"(lo), "v"(hi)); return r; }
__device__ __forceinline__ float bflo(unsigned u) { return __uint_as_float(u << 16); }
__device__ __forceinline__ float bfhi(unsigned u) { return __uint_as_float(u & 0xffff0000u); }
__device__ __forceinline__ float bf1(bf16_t h) { return __uint_as_float((unsigned)h << 16); }
typedef _Float16 h16x2 __attribute__((ext_vector_type(2)));
typedef _Float16 h16x4 __attribute__((ext_vector_type(4)));
typedef _Float16 h16x8 __attribute__((ext_vector_type(8)));
__device__ __forceinline__ f32x4 ld_h4(const _Float16* p) { const h16x4 h = *(const h16x4*)p; return (f32x4){(float)h[0], (float)h[1], (float)h[2], (float)h[3]}; }
__device__ __forceinline__ void st_h4(_Float16* p, f32x4 v) { h16x4 h; h[0] = (_Float16)v[0]; h[1] = (_Float16)v[1]; h[2] = (_Float16)v[2]; h[3] = (_Float16)v[3]; *(h16x4*)p = h; }
__device__ __forceinline__ float sigmoidf_(float x) { return __builtin_amdgcn_rcpf(1.0f + __builtin_amdgcn_exp2f(-1.4426950408889634f * x)); }
__device__ __forceinline__ float siluf_(float x) { return x * sigmoidf_(x); }
__device__ __forceinline__ int lane_now() { int l; asm volatile("v_mbcnt_lo_u32_b32 %0, -1, 0\n\tv_mbcnt_hi_u32_b32 %0, -1, %0" : "=v"(l)); return l; }
__device__ __forceinline__ float shx(float v, int m, int lane) { return __int_as_float(__builtin_amdgcn_ds_bpermute((lane ^ m) << 2, __float_as_int(v))); }
__device__ __forceinline__ float wave_sum(float v, int lane) {
#pragma unroll
    for (int o = 1; o < 64; o <<= 1) v += shx(v, o, lane);
    return v;
}
#define LDS_WAIT() asm volatile("s_waitcnt lgkmcnt(0)" ::: "memory")
#define VM_WAIT() asm volatile("s_waitcnt vmcnt(0)" ::: "memory")

namespace pg8 {
constexpr int BM = 256, BK = 64, HALF = 128, HTB = HALF * BK * 2, STAGE_BYTES = 8 * HTB, NXCD = 8, WGM = 8, PPB_ = 17;
__host__ __device__ __forceinline__ int lds_byte(int r, int c) { const int st = (r >> 4) * 2 + (c >> 5), rr = r & 15, cc = c & 31, ob = rr * 64 + cc * 2; return st * 1024 + (ob ^ (((ob >> 9) & 1) << 5)); }
__host__ __device__ __forceinline__ int perm32(int rho) { const int n = rho >> 4, i = rho & 15; return 8 * (i >> 2) + 4 * n + (i & 3); }
__host__ __device__ __forceinline__ void stage_rc(int b, int& R_, int& C_) { const int st = b / 1024, sb = b % 1024, swz = sb ^ (((sb >> 9) & 1) << 5); R_ = (st >> 1) * 16 + swz / 64; C_ = (st & 1) * 32 + (swz % 64) / 2; }

struct Unit { int pm, pn, aux, kt; const char* a; const char* b; };
struct Gemm { int lda, ldb, K; };

__device__ __forceinline__ void xcd_remap(int L, int nM, int nN, int& pm, int& pn) {
    const int nwg = nM * nN; int wgid = L;
    { const int q = nwg / NXCD, r = nwg % NXCD, xcd = wgid % NXCD, off = wgid / NXCD; wgid = (xcd < r ? xcd * (q + 1) : r * (q + 1) + (xcd - r) * q) + off; }
    const int nig = WGM * nN, gid = wgid / nig, fm = gid * WGM, gsz = (nM - fm) < WGM ? (nM - fm) : WGM;
    pm = fm + ((wgid % nig) % gsz); pn = (wgid % nig) / gsz;
}
struct StaticOrder {
    int nM, nN, nwg, G, c, kt, latonly, nctx, cproj; const char* A; const char* B; size_t tA, tB;
    __device__ __forceinline__ void init(int nM_, int nN_, int G_, int c_, const void* A_, int lda, const void* B_, int ldb, int K, int latonly_ = 0, int nctx_ = 0) { nM = nM_; nN = nN_; nwg = nM * nN; G = G_; c = c_; kt = K / BK; latonly = latonly_; nctx = nctx_; cproj = 0;
        A = (const char*)A_; B = (const char*)B_; tA = (size_t)BM * lda * 2; tB = (size_t)BM * ldb * 2; }
    __device__ __forceinline__ bool next(int i, Unit& u) const {
        const long L = (long)i * G + c;
        if (L < nwg) { xcd_remap((int)L, nM, nN, u.pm, u.pn); if (latonly) u.pm += (u.pm >> 4) + 1; u.aux = 0; u.kt = kt; u.a = A + (size_t)u.pm * tA; u.b = B + (size_t)u.pn * tB; return true; }
        const int x = (int)(L - nwg); if (x >= nctx) return false;
        if (cproj) {
            const int p = x / 20, t2 = x - 20 * p; u.pm = PPB_ * p; u.pn = (t2 < 8) ? 4 + t2 : 8 + t2; u.aux = 0; u.kt = kt; u.a = A + (size_t)u.pm * tA; u.b = B + (size_t)u.pn * tB; return true; }
        const int q = x & 3, t2 = x >> 2; u.pm = PPB_ * (t2 / nN); u.pn = t2 % nN; u.aux = 1 + q; u.kt = kt >> 2;
        u.a = A + (size_t)u.pm * tA + (size_t)q * (kt >> 2) * BK * 2; u.b = B + (size_t)u.pn * tB + (size_t)q * (kt >> 2) * BK * 2; return true;
    }
};
template <class Epi, class Sched, int AMODE = 0, bool HOOK = false>
__device__ __forceinline__ void gemm_phase(LAS unsigned char* lds, const Gemm g, const Sched& S, const Epi& E, const int tid) {
    const int wid = __builtin_amdgcn_readfirstlane(tid >> 6), lane = tid & 63, wr = wid >> 2, wc = wid & 3, fr = lane & 15, fq = lane >> 4;
    unsigned voffA[2], voffB[2];
#pragma unroll
    for (int i = 0; i < 2; ++i) { int R_, C_; stage_rc(tid * 16 + i * 8192, R_, C_);
        voffA[i] = (AMODE == 1) ? (unsigned)((R_ * 16 + (C_ >> 4)) * LDP + (C_ & 15)) * 2u : (unsigned)(R_ * g.lda + C_) * 2u; voffB[i] = (unsigned)((Epi::PERM ? ((R_ & ~31) + perm32(R_ & 31)) : R_) * g.ldb + C_) * 2u; }
    const size_t kstep = (size_t)(BK * 2), kstepA = (AMODE == 1) ? (size_t)(4 * LDP * 2) : kstep;
    const size_t hstepA = (AMODE == 1) ? (size_t)HALF * 16 * LDP * 2 : (size_t)HALF * g.lda * 2, hstepB = (size_t)HALF * g.ldb * 2;
    const unsigned ldsw = (unsigned)wid * 1024u;
    const int aoff = lds_byte(wr * 64 + fr, fq * 8), boff = lds_byte(wc * 32 + fr, fq * 8);
#define PG8_SA(b, h) (((b) * 2 + (h)) * HTB)
#define PG8_SB(b, h) ((4 + (b) * 2 + (h)) * HTB)
#define PG8_STAGE(bufoff, gbase, voff) do { const unsigned long long gb_ = (unsigned long long)(gbase);        \
        const unsigned long long gs_ = ((unsigned long long)(unsigned)__builtin_amdgcn_readfirstlane((int)(gb_ >> 32)) << 32) | (unsigned long long)(unsigned)__builtin_amdgcn_readfirstlane((int)gb_); \
        _Pragma("unroll") for (int _i = 0; _i < 2; ++_i) \
        asm volatile("s_mov_b32 m0, %2\n\ts_nop 0\n\tglobal_load_lds_dwordx4 %0, %1" :: "v"((voff)[_i]), "s"(gs_), "s"((unsigned)__builtin_amdgcn_readfirstlane((int)(unsigned)(uintptr_t)(lds + (bufoff) + ldsw + _i * 8192))) : "memory"); } while (0)
#define PG8_LDA(dst, b, h) do { _Pragma("unroll") for (int m = 0; m < 4; ++m) _Pragma("unroll") for (int k = 0; k < 2; ++k) dst[m][k] = *(const LAS bf16x8*)(lds + PG8_SA(b, h) + aoff + m * 2048 + k * 1024); } while (0)
#define PG8_LDB(dst, b, h) do { _Pragma("unroll") for (int n = 0; n < 2; ++n) _Pragma("unroll") for (int k = 0; k < 2; ++k) dst[n][k] = *(const LAS bf16x8*)(lds + PG8_SB(b, h) + boff + n * 2048 + k * 1024); } while (0)
#define PG8_MMA(ai, bj, At, Bt) do { __builtin_amdgcn_s_setprio(1); _Pragma("unroll") for (int m = 0; m < 4; ++m) _Pragma("unroll") for (int n = 0; n < 2; ++n) _Pragma("unroll") for (int k = 0; k < 2; ++k) \
        acc[ai][bj][m][n] = __builtin_amdgcn_mfma_f32_16x16x32_bf16(Bt[n][k], At[m][k], acc[ai][bj][m][n], 0, 0, 0); __builtin_amdgcn_s_setprio(0); } while (0)
#define PG8_WAIT_V(n) asm volatile("s_waitcnt vmcnt(" #n ")" ::: "memory")
#define PG8_WAIT_L(n) asm volatile("s_waitcnt lgkmcnt(" #n ")" ::: "memory")
#define PG8_BAR __builtin_amdgcn_s_barrier()
#define PG8_SCHED __builtin_amdgcn_sched_barrier(0)
    Unit cur, nxt; int ui = 0;
    if (!S.next(0, cur)) return;
    f32x4 acc[2][2][4][2];
#pragma unroll
    for (int a = 0; a < 2; ++a)
#pragma unroll
        for (int b = 0; b < 2; ++b)
#pragma unroll
            for (int m = 0; m < 4; ++m)
#pragma unroll
                for (int n = 0; n < 2; ++n) acc[a][b][m][n] = (f32x4){0.f, 0.f, 0.f, 0.f};
    bf16x8 At[4][2], B0[2][2], B1[2][2];
#define PG8_UNI(p) ((const char*)(((unsigned long long)(unsigned)__builtin_amdgcn_readfirstlane((int)((unsigned long long)(p) >> 32)) << 32) | (unsigned long long)(unsigned)__builtin_amdgcn_readfirstlane((int)(unsigned long long)(p))))
    const char* cA = PG8_UNI(cur.a); const char* cB = PG8_UNI(cur.b);
    PG8_STAGE(PG8_SB(0, 0), cB, voffB); PG8_STAGE(PG8_SB(0, 1), cB + hstepB, voffB); PG8_STAGE(PG8_SA(0, 0), cA, voffA); PG8_STAGE(PG8_SA(0, 1), cA + hstepA, voffA);
    if (wr == 1) PG8_BAR;
    PG8_WAIT_V(2); PG8_BAR;
    PG8_STAGE(PG8_SB(1, 0), cB + kstep, voffB); PG8_STAGE(PG8_SA(1, 0), cA + kstepA, voffA); PG8_STAGE(PG8_SB(1, 1), cB + hstepB + kstep, voffB);
    PG8_WAIT_V(6); PG8_BAR;
    for (;;) {
        const bool has_next = S.next(ui + 1, nxt);
        const char* nA = PG8_UNI(has_next ? nxt.a : cA); const char* nB = PG8_UNI(has_next ? nxt.b : cB);
        const int nt = cur.kt;
        for (int t = 0; t < nt; t += 2) {
            const bool last = (t == nt - 2);
            if constexpr (HOOK) { if (t == 16 || t == 32) E.mid(acc, cur, t >> 4, wr, wc); }
            const char* a1 = cA + (size_t)(t + 1) * kstepA;
            const char* a2 = last ? nA : cA + (size_t)(t + 2) * kstepA; const char* b2 = last ? nB : cB + (size_t)(t + 2) * kstep;
            const char* a3 = a2 + kstepA; const char* b3 = b2 + kstep;
            PG8_LDB(B0, 0, 0); PG8_LDB(B1, 0, 1); PG8_SCHED; PG8_LDA(At, 0, 0); PG8_STAGE(PG8_SA(1, 1), a1 + hstepA, voffA);
            PG8_WAIT_V(8); PG8_WAIT_L(0); PG8_BAR; PG8_MMA(0, 0, At, B0); PG8_MMA(0, 1, At, B1); PG8_BAR; PG8_SCHED;
            PG8_LDA(At, 0, 1); PG8_STAGE(PG8_SB(0, 0), b2, voffB); PG8_STAGE(PG8_SB(0, 1), b2 + hstepB, voffB); PG8_STAGE(PG8_SA(0, 0), a2, voffA);
            PG8_WAIT_V(8); PG8_WAIT_L(0); PG8_BAR; PG8_MMA(1, 0, At, B0); PG8_MMA(1, 1, At, B1); PG8_BAR; PG8_SCHED;
            PG8_LDB(B0, 1, 0); PG8_LDB(B1, 1, 1); PG8_SCHED; PG8_LDA(At, 1, 0); PG8_STAGE(PG8_SA(0, 1), a2 + hstepA, voffA);
            PG8_WAIT_V(8); PG8_WAIT_L(0); PG8_BAR; PG8_MMA(0, 0, At, B0); PG8_MMA(0, 1, At, B1); PG8_BAR; PG8_SCHED;
            PG8_LDA(At, 1, 1); PG8_STAGE(PG8_SB(1, 0), b3, voffB); PG8_STAGE(PG8_SB(1, 1), b3 + hstepB, voffB); PG8_STAGE(PG8_SA(1, 0), a3, voffA);
            PG8_WAIT_V(8); PG8_WAIT_L(0); PG8_BAR; PG8_MMA(1, 0, At, B0); PG8_MMA(1, 1, At, B1); PG8_BAR; PG8_SCHED;
        }
        if (wr == 0) PG8_BAR;
        E(acc, cur, wr, wc, fr, fq);
        if (!has_next) break;
#pragma unroll
        for (int a = 0; a < 2; ++a)
#pragma unroll
            for (int b = 0; b < 2; ++b)
#pragma unroll
                for (int m = 0; m < 4; ++m)
#pragma unroll
                    for (int n = 0; n < 2; ++n) acc[a][b][m][n] = (f32x4){0.f, 0.f, 0.f, 0.f};
        cur = nxt; cA = nA; cB = nB; ++ui;
        if (wr == 1) PG8_BAR;
    }
    PG8_WAIT_V(0);
    PG8_BAR;
#undef PG8_UNI
#undef PG8_SA
#undef PG8_SB
#undef PG8_STAGE
#undef PG8_LDA
#undef PG8_LDB
#undef PG8_MMA
#undef PG8_WAIT_V
#undef PG8_WAIT_L
#undef PG8_BAR
#undef PG8_SCHED
}
}

struct EpiSwiGLU {
    static constexpr bool PERM = true;
    bf16_t* O;
    __device__ __forceinline__ void operator()(const f32x4 (&acc)[2][2][4][2], const pg8::Unit& u, int wr, int wc, int, int) const { const int ln_ = lane_now(); const int fr = ln_ & 15, fq = ln_ >> 4;
        const int row0 = u.pm * 256 + wr * 64 + fr, hc0 = u.pn * 128 + wc * 32 + 8 * fq;
#pragma unroll
        for (int ai = 0; ai < 2; ++ai)
#pragma unroll
            for (int m = 0; m < 4; ++m) { const f32x4 a0 = acc[ai][0][m][0], a1 = acc[ai][0][m][1], b0 = acc[ai][1][m][0], b1 = acc[ai][1][m][1];
                f32x4 d0 = (f32x4){__builtin_amdgcn_exp2f(a0[0]), __builtin_amdgcn_exp2f(a0[1]), __builtin_amdgcn_exp2f(a0[2]), __builtin_amdgcn_exp2f(a0[3])} + 1.0f;
                f32x4 d1 = (f32x4){__builtin_amdgcn_exp2f(a1[0]), __builtin_amdgcn_exp2f(a1[1]), __builtin_amdgcn_exp2f(a1[2]), __builtin_amdgcn_exp2f(a1[3])} + 1.0f;
                const f32x4 o0 = (a0 * b0) * (f32x4){__builtin_amdgcn_rcpf(d0[0]), __builtin_amdgcn_rcpf(d0[1]), __builtin_amdgcn_rcpf(d0[2]), __builtin_amdgcn_rcpf(d0[3])};
                const f32x4 o1 = (a1 * b1) * (f32x4){__builtin_amdgcn_rcpf(d1[0]), __builtin_amdgcn_rcpf(d1[1]), __builtin_amdgcn_rcpf(d1[2]), __builtin_amdgcn_rcpf(d1[3])};
                u32x4 w; w.x = cvt_pk_bf16(o0[0], o0[1]); w.y = cvt_pk_bf16(o0[2], o0[3]); w.z = cvt_pk_bf16(o1[0], o1[1]); w.w = cvt_pk_bf16(o1[2], o1[3]);
                *(u32x4*)(O + (size_t)(row0 + ai * 128 + m * 16) * DFF + hc0) = w; }
    }
};
struct EpiResid {
    static constexpr bool PERM = true;
    _Float16* H; float* HC; const float* gate; const float* lng; const float* lnb; const float* stats;
    __device__ __forceinline__ void operator()(const f32x4 (&acc)[2][2][4][2], const pg8::Unit& u, int wr, int wc, int, int) const { const int ln_ = lane_now(); const int fr = ln_ & 15, fq = ln_ >> 4;
        int upm = u.pm, upn = u.pn; asm volatile("" : "+s"(upm), "+s"(upn));
        const int pp = upm % PPB, mi = (pp == 0) ? 4 : (upm / PPB);
        const int rl0 = wr * 64 + fr, col0 = upn * 256 + wc * 32 + 8 * fq;
        if (u.aux) {
            float* hc = (float*)((char*)HC - WS_HC + WS_YD) + ((size_t)(u.aux - 1) * (NB * CTX) + (size_t)(upm / PPB) * 256) * D;
#pragma unroll
            for (int bj = 0; bj < 2; ++bj) { const f32x4 gv0 = *(const f32x4*)(gate + (size_t)mi * NMOD + col0 + bj * 128), gv1 = *(const f32x4*)(gate + (size_t)mi * NMOD + col0 + bj * 128 + 4);
#pragma unroll
                for (int ai = 0; ai < 2; ++ai)
#pragma unroll
                    for (int m = 0; m < 4; ++m) { float* p = hc + (size_t)(rl0 + ai * 128 + m * 16) * D + col0 + bj * 128; *(f32x4*)p = gv0 * acc[ai][bj][m][0]; *(f32x4*)(p + 4) = gv1 * acc[ai][bj][m][1]; } }
            return;
        }
#pragma unroll
        for (int bj = 0; bj < 2; ++bj) { const int c = col0 + bj * 128;
            const f32x4 gv0 = *(const f32x4*)(gate + (size_t)mi * NMOD + c), gv1 = *(const f32x4*)(gate + (size_t)mi * NMOD + c + 4);
            const f32x4 g0 = *(const f32x4*)(lng + c) * DN_ALPHA, g1 = *(const f32x4*)(lng + c + 4) * DN_ALPHA, b0 = *(const f32x4*)(lnb + c) * DN_ALPHA, b1 = *(const f32x4*)(lnb + c + 4) * DN_ALPHA;
#pragma unroll
            for (int ai = 0; ai < 2; ++ai) {
                u32x4 tv[4]; f32x2 st[4];
#pragma unroll
                for (int m = 0; m < 4; ++m) { const size_t row = (size_t)(upm * 256 + rl0 + ai * 128 + m * 16); tv[m] = *(const u32x4*)(H + row * D + c); st[m] = *(const f32x2*)(stats + row * 2); }
                asm volatile("s_waitcnt vmcnt(0)" ::: "memory");
#pragma unroll
                for (int m = 0; m < 4; ++m) { const h16x4 ha = __builtin_bit_cast(h16x4, (u32x2){tv[m].x, tv[m].y}), hb = __builtin_bit_cast(h16x4, (u32x2){tv[m].z, tv[m].w});
                    const f32x4 t0 = (f32x4){(float)ha[0], (float)ha[1], (float)ha[2], (float)ha[3]}, t1 = (f32x4){(float)hb[0], (float)hb[1], (float)hb[2], (float)hb[3]};
                    const f32x4 o0 = (t0 - st[m].x) * st[m].y * g0 + b0 + gv0 * acc[ai][bj][m][0], o1 = (t1 - st[m].x) * st[m].y * g1 + b1 + gv1 * acc[ai][bj][m][1];
                    h16x4 qa, qb; qa[0] = (_Float16)o0[0]; qa[1] = (_Float16)o0[1]; qa[2] = (_Float16)o0[2]; qa[3] = (_Float16)o0[3]; qb[0] = (_Float16)o1[0]; qb[1] = (_Float16)o1[1]; qb[2] = (_Float16)o1[2]; qb[3] = (_Float16)o1[3];
                    const u32x2 pa = __builtin_bit_cast(u32x2, qa), pb = __builtin_bit_cast(u32x2, qb);
                    *(u32x4*)(H + (size_t)(upm * 256 + rl0 + ai * 128 + m * 16) * D + c) = (u32x4){pa.x, pa.y, pb.x, pb.y}; } } }
    }
};
struct EpiProj {
    static constexpr bool PERM = true;
    bf16_t* P; float* DT; const float* rc; const float* rs; bf16_t* U2; unsigned* KM;
    __device__ __forceinline__ void operator()(const f32x4 (&acc)[2][2][4][2], const pg8::Unit& u, int wr, int wc, int, int) const { const int ln_ = lane_now(); const int fr = ln_ & 15, fq = ln_ >> 4;
        const int pp = u.pm % PPB; const int row0 = u.pm * 256 + wr * 64 + fr;
        const int pn = u.pn;
        if (pn == 52) {
            if (wc == 0) {
#pragma unroll
                for (int ai = 0; ai < 2; ++ai)
#pragma unroll
                    for (int m = 0; m < 4; ++m)
#pragma unroll
                        for (int n = 0; n < 2; ++n) *(f32x4*)(DT + (size_t)(row0 + ai * 128 + m * 16) * 32 + 8 * fq + 4 * n) = acc[ai][0][m][n];
            }
            return;
        }
        if (pn >= 28) {
            const int jg = (pn - 28) >> 3, pnd = (pn - 28) & 7;
            unsigned char* gq = (unsigned char*)P - WS_PROJ + gq_off(jg) + ((size_t)((u.pm * 8 + pnd) * 512 + (wr * 4 + wc) * 64 + ln_)) * 128;
#pragma unroll
            for (int ai = 0; ai < 2; ++ai)
#pragma unroll
                for (int m = 0; m < 4; ++m) { u32x4 w;
#pragma unroll
                    for (int bj = 0; bj < 2; ++bj)
#pragma unroll
                        for (int n = 0; n < 2; ++n) { const f32x4 v = acc[ai][bj][m][n]; unsigned q = 0;
#pragma unroll
                            for (int e = 0; e < 4; ++e) { const float ex = __builtin_amdgcn_exp2f(v[e]);
                                q = __builtin_amdgcn_cvt_pk_u8_f32(fmaxf(__builtin_amdgcn_rcpf(__builtin_fmaf(ex, 1.0f / 255.0f, 1.0f / 255.0f)), 1.0f), e, q); }
                            w[bj * 2 + n] = q; }
                    *(u32x4*)(gq + (ai * 4 + m) * 16) = w; }
            return;
        }
        if (pn >= 4 && pn < 8) {
            float kmx0 = 0.f, kmx1 = 0.f;
#pragma unroll
            for (int ai = 0; ai < 2; ++ai)
#pragma unroll
                for (int m = 0; m < 4; ++m) { const f32x4 a2 = acc[ai][0][m][0] * acc[ai][0][m][0] + acc[ai][0][m][1] * acc[ai][0][m][1], b2 = acc[ai][1][m][0] * acc[ai][1][m][0] + acc[ai][1][m][1] * acc[ai][1][m][1];
                    kmx0 = fmaxf(kmx0, (a2[0] + a2[1]) + (a2[2] + a2[3])); kmx1 = fmaxf(kmx1, (b2[0] + b2[1]) + (b2[2] + b2[3])); }
#pragma unroll
            for (int o = 1; o < 16; o <<= 1) { kmx0 = fmaxf(kmx0, shx(kmx0, o, ln_)); kmx1 = fmaxf(kmx1, shx(kmx1, o, ln_)); }
            if (fr == 0) { const int b = u.pm / PPB; unsigned* km = KM + (((b * 8 + (pn - 4) * 2) * 2 + (wc >> 1)) * 8 + (wc & 1) * 4 + fq);
                __hip_atomic_fetch_max(km, __float_as_uint(kmx0), __ATOMIC_RELAXED, __HIP_MEMORY_SCOPE_AGENT); __hip_atomic_fetch_max(km + 16, __float_as_uint(kmx1), __ATOMIC_RELAXED, __HIP_MEMORY_SCOPE_AGENT); } }
        const int col0 = pn * 256 + wc * 32 + 4 * fq;
        const int mode = (pn < 8) ? ((pp != 0) ? 1 : 0) : ((pn >= 12 && pn < 16) ? 2 : 0);
        const float sc = (pn < 4) ? QSCALE : 1.0f;
#pragma unroll
        for (int ai = 0; ai < 2; ++ai) {
          f32x4 csv[4], snv[4];
          if (mode == 1) {
#pragma unroll
              for (int m = 0; m < 4; ++m) { const int rl = ai * 128 + wr * 64 + m * 16 + fr; const int t = (pp - 1) * 256 + rl; const int pos = (wc & 1) ? (t & 63) : (t >> 6); csv[m] = *(const f32x4*)(rc + pos * 16 + 4 * fq); snv[m] = *(const f32x4*)(rs + pos * 16 + 4 * fq); }
              asm volatile("s_waitcnt vmcnt(0)" ::: "memory"); }
#pragma unroll
            for (int m = 0; m < 4; ++m) { const int rl = ai * 128 + wr * 64 + m * 16 + fr; bf16_t* rowp = P + (size_t)(u.pm * 256 + rl) * LDP + col0;
                f32x4 cs = (f32x4){1.f, 1.f, 1.f, 1.f}, sn = (f32x4){0.f, 0.f, 0.f, 0.f};
                if (mode == 1) { cs = csv[m]; sn = snv[m]; }
#pragma unroll
                for (int bj = 0; bj < 2; ++bj) { f32x4 v0 = acc[ai][bj][m][0], v1 = acc[ai][bj][m][1];
                    if (mode == 1) { const f32x4 o0 = v0 * cs - v1 * sn, o1 = v1 * cs + v0 * sn; v0 = o0; v1 = o1; }
                    else if (mode == 2) {
#pragma unroll
                        for (int e = 0; e < 4; ++e) { v0[e] = siluf_(v0[e]); v1[e] = siluf_(v1[e]); } }
                    if (pn >= 24 && pn < 28) {
                        const int cu = (pn - 24) * 256 + bj * 128 + wc * 32 + 8 * fq;
                        bf16_t* u2 = U2 + ((size_t)(cu >> 4) * R + (size_t)(u.pm * 256 + rl)) * 16 + (cu & 15);
                        u32x4 a; a.x = cvt_pk_bf16(v0[0], v0[1]); a.y = cvt_pk_bf16(v0[2], v0[3]); a.z = cvt_pk_bf16(v1[0], v1[1]); a.w = cvt_pk_bf16(v1[2], v1[3]);
                        *(u32x4*)u2 = a; continue; }
                    v0 = v0 * sc; v1 = v1 * sc;
                    if (pn < 8) { u32x2 w0, w1; w0.x = cvt_pk_bf16(v0[0], v0[1]); w0.y = cvt_pk_bf16(v0[2], v0[3]); w1.x = cvt_pk_bf16(v1[0], v1[1]); w1.y = cvt_pk_bf16(v1[2], v1[3]);
                        *(u32x2*)(rowp + bj * 128) = w0; *(u32x2*)(rowp + bj * 128 + 16) = w1; }
                    else { u32x4 w; w.x = cvt_pk_bf16(v0[0], v0[1]); w.y = cvt_pk_bf16(v0[2], v0[3]); w.z = cvt_pk_bf16(v1[0], v1[1]); w.w = cvt_pk_bf16(v1[2], v1[3]);
                        *(u32x4*)(rowp + 4 * fq + bj * 128) = w; } } } }
    }
};
struct EpiGlu {
    static constexpr bool PERM = false;
    bf16_t* P; const float* bias;
    __device__ __forceinline__ void operator()(const f32x4 (&acc)[2][2][4][2], const pg8::Unit& u, int wr, int wc, int, int) const { const int ln_ = lane_now(); const int fr = ln_ & 15, fq = ln_ >> 4;
        const int row0 = u.pm * 256 + wr * 64 + fr, col0 = u.pn * 256 + wc * 32 + 4 * fq;
        f32x4 bv[2][2];
#pragma unroll
        for (int bj = 0; bj < 2; ++bj)
#pragma unroll
            for (int n = 0; n < 2; ++n) bv[bj][n] = *(const f32x4*)(bias + col0 + bj * 128 + n * 16);
#pragma unroll
        for (int ai = 0; ai < 2; ++ai) {
            u32x2 tv[4][2][2];
#pragma unroll
            for (int m = 0; m < 4; ++m)
#pragma unroll
                for (int bj = 0; bj < 2; ++bj)
#pragma unroll
                    for (int n = 0; n < 2; ++n) tv[m][bj][n] = *(const u32x2*)(P + (size_t)(row0 + ai * 128 + m * 16) * LDP + PU + col0 + bj * 128 + n * 16);
            asm volatile("s_waitcnt vmcnt(0)" ::: "memory");
#pragma unroll
            for (int m = 0; m < 4; ++m) { bf16_t* rowp = P + (size_t)(row0 + ai * 128 + m * 16) * LDP;
#pragma unroll
                for (int bj = 0; bj < 2; ++bj)
#pragma unroll
                    for (int n = 0; n < 2; ++n) { const int c = col0 + bj * 128 + n * 16; const u32x2 t = tv[m][bj][n];
                        const f32x4 a = acc[ai][bj][m][n] + bv[bj][n]; u32x2 w;
                        w.x = cvt_pk_bf16(bflo(t.x) * sigmoidf_(a[0]), bfhi(t.x) * sigmoidf_(a[1])); w.y = cvt_pk_bf16(bflo(t.y) * sigmoidf_(a[2]), bfhi(t.y) * sigmoidf_(a[3]));
                        *(u32x2*)(rowp + PK + c) = w; } } }
    }
};
struct EpiMerge {
    static constexpr bool PERM = true;
    const bf16_t* P; bf16_t* MIXB;
    static __device__ __forceinline__ int jmap(int seg) { return seg == 0 ? 0 : (seg == 1 ? 2 : 1); }
    __device__ __forceinline__ const unsigned char* gbase(const pg8::Unit& u, int seg, int wr, int wc, int ln_) const {
        return (const unsigned char*)P - WS_PROJ + gq_off(jmap(seg)) + ((size_t)((u.pm * 8 + u.pn) * 512 + (wr * 4 + wc) * 64 + ln_)) * 128; }
    __device__ __forceinline__ void mid(f32x4 (&acc)[2][2][4][2], const pg8::Unit& u, int seg, int wr, int wc) const {
        const int ln_ = lane_now(); const unsigned char* ga = gbase(u, seg - 1, wr, wc, ln_); const unsigned char* gb = gbase(u, seg, wr, wc, ln_);
        u32x4 a[2][4], b[2][4];
#pragma unroll
        for (int ai = 0; ai < 2; ++ai)
#pragma unroll
            for (int m = 0; m < 4; ++m) { a[ai][m] = *(const u32x4*)(ga + (ai * 4 + m) * 16); b[ai][m] = *(const u32x4*)(gb + (ai * 4 + m) * 16); }
        asm volatile("s_waitcnt vmcnt(0)" ::: "memory");
#pragma unroll
        for (int ai = 0; ai < 2; ++ai)
#pragma unroll
            for (int m = 0; m < 4; ++m)
#pragma unroll
                for (int bj = 0; bj < 2; ++bj)
#pragma unroll
                    for (int n = 0; n < 2; ++n) { const unsigned qa = a[ai][m][bj * 2 + n], qb = b[ai][m][bj * 2 + n]; f32x4 r;
#pragma unroll
                        for (int e = 0; e < 4; ++e) r[e] = (float)((qa >> (8 * e)) & 255u) * __builtin_amdgcn_rcpf((float)((qb >> (8 * e)) & 255u));
                        acc[ai][bj][m][n] = acc[ai][bj][m][n] * r; }
    }
    __device__ __forceinline__ void operator()(const f32x4 (&acc)[2][2][4][2], const pg8::Unit& u, int wr, int wc, int, int) const { const int ln_ = lane_now(); const int fr = ln_ & 15, fq = ln_ >> 4;
        const int row0 = u.pm * 256 + wr * 64 + fr, col0 = u.pn * 256 + wc * 32 + 8 * fq; const unsigned char* gl = gbase(u, 2, wr, wc, ln_);
        u32x4 gq[2][4];
#pragma unroll
        for (int ai = 0; ai < 2; ++ai)
#pragma unroll
            for (int m = 0; m < 4; ++m) gq[ai][m] = *(const u32x4*)(gl + (ai * 4 + m) * 16);
        asm volatile("s_waitcnt vmcnt(0)" ::: "memory");
#pragma unroll
        for (int ai = 0; ai < 2; ++ai)
#pragma unroll
            for (int m = 0; m < 4; ++m) { const size_t row = (size_t)(row0 + ai * 128 + m * 16); const u32x4 g4 = gq[ai][m];
#pragma unroll
                for (int bj = 0; bj < 2; ++bj) { u32x4 w;
#pragma unroll
                    for (int n = 0; n < 2; ++n) { const unsigned gv = g4[bj * 2 + n];
                        f32x4 v = acc[ai][bj][m][n];
#pragma unroll
                        for (int e = 0; e < 4; ++e) v[e] *= (float)((gv >> (8 * e)) & 255u) * (1.0f / 255.0f);
                        w[2 * n] = cvt_pk_bf16(v[0], v[1]); w[2 * n + 1] = cvt_pk_bf16(v[2], v[3]); }
                    *(u32x4*)(MIXB + row * D + col0 + bj * 128) = w; } }
    }
};

struct S5AOrder {
    int G, c; const char* A; const char* B;
    __device__ __forceinline__ bool next(int i, pg8::Unit& u) const {
        const int idx = i * G + c; if (idx >= 640) return false;
        const int g = idx / 10, r = idx - 10 * g, nt = r / 5, mt = r - 5 * nt;
        u.pm = mt; u.pn = nt; u.aux = g; u.kt = 4; u.a = A + ((size_t)g * (R / 16) + (size_t)mt * 256) * 256 * 2; u.b = B + (size_t)(g * 512 + nt * 256) * 256 * 2; return true;
    }
};
struct EpiS5A {
    static constexpr bool PERM = false;
    unsigned char* YLF; bf16_t* ST;
    __device__ __forceinline__ void operator()(const f32x4 (&acc)[2][2][4][2], const pg8::Unit& u, int wr, int wc, int, int) const { const int ln_ = lane_now(); const int fr = ln_ & 15, fq = ln_ >> 4;
        const int g = u.aux;
        if (u.pn == 0) { unsigned char* yl = YLF + ((size_t)((g * 5 + u.pm) * 512 + (wr * 4 + wc) * 64 + ln_)) * 256;
#pragma unroll
            for (int ai = 0; ai < 2; ++ai)
#pragma unroll
                for (int m = 0; m < 4; ++m) { u32x4 w0, w1;
                    w0.x = cvt_pk_bf16(acc[ai][0][m][0][0], acc[ai][0][m][0][1]); w0.y = cvt_pk_bf16(acc[ai][0][m][0][2], acc[ai][0][m][0][3]); w0.z = cvt_pk_bf16(acc[ai][0][m][1][0], acc[ai][0][m][1][1]); w0.w = cvt_pk_bf16(acc[ai][0][m][1][2], acc[ai][0][m][1][3]);
                    w1.x = cvt_pk_bf16(acc[ai][1][m][0][0], acc[ai][1][m][0][1]); w1.y = cvt_pk_bf16(acc[ai][1][m][0][2], acc[ai][1][m][0][3]); w1.z = cvt_pk_bf16(acc[ai][1][m][1][0], acc[ai][1][m][1][1]); w1.w = cvt_pk_bf16(acc[ai][1][m][1][2], acc[ai][1][m][1][3]);
                    *(u32x4*)(yl + (ai * 4 + m) * 32) = w0; *(u32x4*)(yl + (ai * 4 + m) * 32 + 16) = w1; }
            return; }
#pragma unroll
        for (int ai = 0; ai < 2; ++ai)
#pragma unroll
            for (int m = 0; m < 4; ++m) { const int mr = u.pm * 256 + ai * 128 + wr * 64 + m * 16 + fr; if (mr < S5M) {
#pragma unroll
                for (int bj = 0; bj < 2; ++bj)
#pragma unroll
                    for (int n = 0; n < 2; ++n) { const f32x4 v = acc[ai][bj][m][n];
                        u32x2 w; w.x = cvt_pk_bf16(v[0], v[1]); w.y = cvt_pk_bf16(v[2], v[3]); *(u32x2*)(ST + ((size_t)g * S5M + mr) * 256 + bj * 128 + wc * 32 + n * 16 + 4 * fq) = w; } } }
    }
};
struct S5COrder {
    int G, c; const char* A; const char* B;
    __device__ __forceinline__ bool next(int i, pg8::Unit& u) const {
        const int idx = i * G + c; if (idx >= 320) return false;
        const int g = idx / 5, mt = idx - 5 * g;
        u.pm = mt; u.pn = 0; u.aux = g; u.kt = 4; u.a = A + ((size_t)g * 1280 + mt * 256) * 256 * 2; u.b = B + (size_t)g * 256 * 256 * 2; return true;
    }
};
struct EpiS5C {
    static constexpr bool PERM = false;
    const unsigned char* YLF; bf16_t* P;
    __device__ __forceinline__ void operator()(const f32x4 (&acc)[2][2][4][2], const pg8::Unit& u, int wr, int wc, int, int) const { const int ln_ = lane_now(); const int fr = ln_ & 15, fq = ln_ >> 4;
        const int g = u.aux; const unsigned char* yl = YLF + ((size_t)((g * 5 + u.pm) * 512 + (wr * 4 + wc) * 64 + ln_)) * 256;
#pragma unroll
        for (int ai = 0; ai < 2; ++ai) {
        u32x4 y0[2][4], y1[2][4];
#pragma unroll
            for (int m = 0; m < 4; ++m) { y0[ai][m] = *(const u32x4*)(yl + (ai * 4 + m) * 32); y1[ai][m] = *(const u32x4*)(yl + (ai * 4 + m) * 32 + 16); }
        asm volatile("s_waitcnt vmcnt(0)" ::: "memory");
#pragma unroll
            for (int m = 0; m < 4; ++m) { const int mr = u.pm * 256 + ai * 128 + wr * 64 + m * 16 + fr; if (mr < S5M) {
#pragma unroll
                for (int bj = 0; bj < 2; ++bj)
#pragma unroll
                    for (int n = 0; n < 2; ++n) { const int rho = 8 * bj + 2 * wc + n; const size_t row = (size_t)(16 * mr + rho);
                        const u32x4 yy = bj ? y1[ai][m] : y0[ai][m]; const unsigned ya = n ? yy.z : yy.x, yb = n ? yy.w : yy.y; f32x4 v = acc[ai][bj][m][n];
                        v[0] += bflo(ya); v[1] += bfhi(ya); v[2] += bflo(yb); v[3] += bfhi(yb);
#pragma unroll
                        for (int e = 0; e < 4; ++e) { const float x = v[e]; const float inner = 0.7978845608028654f * (x + 0.044715f * x * x * x); const float th = 1.0f - 2.0f * __builtin_amdgcn_rcpf(1.0f + __builtin_amdgcn_exp2f(2.8853900817779268f * inner)); v[e] = 0.5f * x * (1.0f + th); }
                        u32x2 w; w.x = cvt_pk_bf16(v[0], v[1]); w.y = cvt_pk_bf16(v[2], v[3]); *(u32x2*)(P + row * LDP + PU + 16 * g + 4 * fq) = w; } } } }
    }
};

namespace attn128 {
using bf16 = __hip_bfloat16;
constexpr int NW = 8, QBLK = 32, KVBLK = 64, LDQ = LDP, LDK = LDP, LDOB = LDP;
constexpr size_t SHM_V = KVBLK * 128 * 2, SHM_K = KVBLK * 64 * 2, SHM_ATTN = 2 * SHM_V + 2 * SHM_K + NW * 64 * 4, SHM_TOTAL = SHM_ATTN + NW * 8192;
constexpr float THRL = 11.5f;
#define A128_KSWZ(row, colB) ((row) * 128 + ((colB) ^ (((row) & 7) << 4)))
#define A128_SBAR() __builtin_amdgcn_sched_barrier(0)
__device__ __forceinline__ int crow(int r, int hi) { return (r & 3) + 8 * (r >> 2) + 4 * hi; }
template <bool FIRST = false>
__device__ __forceinline__ void partialSM(f32x16& p0, f32x16& p1, float& m_reg, float& mn, float& alpha, const bool nomax) {
  if (nomax) { mn = 0.f; alpha = 1.f;
#pragma unroll
    for (int r = 0; r < 16; ++r) p0[r] = __builtin_amdgcn_exp2f(p0[r]);
    return; }
  float pmax = p0[0];
#pragma unroll
  for (int r = 1; r < 16; ++r) pmax = fmaxf(pmax, p0[r]);
#pragma unroll
  for (int r = 0; r < 16; ++r) pmax = fmaxf(pmax, p1[r]);
  { auto rr = __builtin_amdgcn_permlane32_swap(__float_as_uint(pmax), __float_as_uint(pmax), false, false); pmax = fmaxf(__uint_as_float(rr[0]), __uint_as_float(rr[1])); }
  if (FIRST) { m_reg = (__builtin_fabsf(pmax) <= THRL) ? 0.f : pmax; mn = m_reg; alpha = 1.f; }
  else if (__builtin_expect(__all(pmax - m_reg <= THRL), 1)) { mn = m_reg; alpha = 1.f; }
  else { mn = fmaxf(m_reg, pmax); alpha = __builtin_amdgcn_exp2f(m_reg - mn); m_reg = mn; }
  if (__builtin_expect(__any(mn != 0.f), 0)) {
#pragma unroll
    for (int r = 0; r < 16; ++r) { p0[r] = p0[r] - mn; p1[r] = p1[r] - mn; } }
#pragma unroll
  for (int r = 0; r < 16; ++r) p0[r] = __builtin_amdgcn_exp2f(p0[r]);
}
__device__ __forceinline__ void finishSM(f32x16& p0, f32x16& p1, float alpha, float& l_reg, bf16x8& pa0, bf16x8& pa1, bf16x8& pa2, bf16x8& pa3) {
#pragma unroll
  for (int r = 0; r < 16; ++r) p1[r] = __builtin_amdgcn_exp2f(p1[r]);
  typedef float f32x8_ __attribute__((ext_vector_type(8))); typedef float f32x2_ __attribute__((ext_vector_type(2)));
  const f32x16 s16_ = p0 + p1; const f32x8_ s8_ = s16_.lo + s16_.hi; const f32x4 s4_ = s8_.lo + s8_.hi; const f32x2_ s2_ = s4_.lo + s4_.hi;
  float ps = s2_.x + s2_.y;
  { auto rr = __builtin_amdgcn_permlane32_swap(__float_as_uint(ps), __float_as_uint(ps), false, false); ps = __uint_as_float(rr[0]) + __uint_as_float(rr[1]); }
  l_reg = l_reg * alpha + ps;
#define A128_PK4(P, BASE, OUT) do { u32x4 w = {cvt_pk_bf16(P[BASE + 0], P[BASE + 1]), cvt_pk_bf16(P[BASE + 2], P[BASE + 3]), cvt_pk_bf16(P[BASE + 4], P[BASE + 5]), cvt_pk_bf16(P[BASE + 6], P[BASE + 7])}; \
    OUT = __builtin_bit_cast(bf16x8, w); } while (0)
  A128_PK4(p0, 0, pa0); A128_PK4(p0, 8, pa1); A128_PK4(p1, 0, pa2); A128_PK4(p1, 8, pa3);
#undef A128_PK4
}
__device__ __forceinline__ void qkt(f32x16& p0, f32x16& p1, const char* Ks, const bf16x8* qr, int r32, int hi) {
#pragma unroll
  for (int i = 0; i < 16; ++i) { p0[i] = 0.f; p1[i] = 0.f; }
#pragma unroll
  for (int d0 = 0; d0 < 4; ++d0) { const int cb = (d0 * 16 + hi * 8) * 2;
    const bf16x8 b0 = *reinterpret_cast<const bf16x8*>(Ks + A128_KSWZ(r32, cb));
    const bf16x8 b1 = *reinterpret_cast<const bf16x8*>(Ks + A128_KSWZ(32 + r32, cb));
    p0 = __builtin_amdgcn_mfma_f32_32x32x16_bf16(b0, qr[d0], p0, 0, 0, 0);
    p1 = __builtin_amdgcn_mfma_f32_32x32x16_bf16(b1, qr[d0], p1, 0, 0, 0); }
}
__device__ __forceinline__ int v_st(int k, int c) { const int kk = k; return ((kk >> 3) * 4 + (c >> 5)) * 512 + ((kk & 7) * 32 + (c & 31)) * 2; }
__device__ __forceinline__ int v_rd_base(int lane) { return ((lane & 3) << 3) | (((lane >> 2) & 3) << 6) | (((lane >> 4) & 1) << 5) | (((lane >> 5) & 1) << 8); }
constexpr int v_rd_off(int d0, int ks, int half) { return d0 * 512 + ks * 4096 + half * 2048; }
template <int OFF> __device__ __forceinline__ s16x4 tr_read(int vb) { s16x4 r; asm volatile("ds_read_b64_tr_b16 %0, %1 offset:%2" : "=&v"(r) : "v"(vb), "i"(OFF) : "memory"); return r; }
template <int D0> __device__ __forceinline__ void pv_one(f32x16& od, int vb, bf16x8 pa0, bf16x8 pa1, bf16x8 pa2, bf16x8 pa3) {
  const s16x4 l0 = tr_read<v_rd_off(D0, 0, 0)>(vb), h0 = tr_read<v_rd_off(D0, 0, 1)>(vb), l1 = tr_read<v_rd_off(D0, 1, 0)>(vb), h1 = tr_read<v_rd_off(D0, 1, 1)>(vb);
  const s16x4 l2 = tr_read<v_rd_off(D0, 2, 0)>(vb), h2 = tr_read<v_rd_off(D0, 2, 1)>(vb), l3 = tr_read<v_rd_off(D0, 3, 0)>(vb), h3 = tr_read<v_rd_off(D0, 3, 1)>(vb);
  asm volatile("s_waitcnt lgkmcnt(0)" ::: "memory"); A128_SBAR();
#define A128_PK(L, H) (bf16x8){L[0], L[1], L[2], L[3], H[0], H[1], H[2], H[3]}
  od = __builtin_amdgcn_mfma_f32_32x32x16_bf16(pa0, A128_PK(l0, h0), od, 0, 0, 0);
  od = __builtin_amdgcn_mfma_f32_32x32x16_bf16(pa1, A128_PK(l1, h1), od, 0, 0, 0);
  od = __builtin_amdgcn_mfma_f32_32x32x16_bf16(pa2, A128_PK(l2, h2), od, 0, 0, 0);
  od = __builtin_amdgcn_mfma_f32_32x32x16_bf16(pa3, A128_PK(l3, h3), od, 0, 0, 0);
#undef A128_PK
}
__device__ __forceinline__ void pv_d0(f32x16* o, int vb, bf16x8 pa0, bf16x8 pa1, bf16x8 pa2, bf16x8 pa3) {
  pv_one<0>(o[0], vb, pa0, pa1, pa2, pa3); pv_one<1>(o[1], vb, pa0, pa1, pa2, pa3); pv_one<2>(o[2], vb, pa0, pa1, pa2, pa3); pv_one<3>(o[3], vb, pa0, pa1, pa2, pa3);
}
__device__ __forceinline__ void unit(const bf16* __restrict__ Qb0, const bf16* __restrict__ Kh0, const bf16* __restrict__ Vh, bf16_t* Ob, int seq, char* lds, const int tid_in, const float lam, const float onem, const float* __restrict__ subw, const float* __restrict__ kmb  ) {
#pragma unroll 1
 for (int mp = 0; mp < 2; ++mp) {
  int tid = tid_in; asm volatile("" : "+v"(tid));
  bf16_t* stage = (bf16_t*)(lds + SHM_ATTN) + (tid >> 6) * 4096;
  const bf16* Qb = Qb0 + mp * 64; const bf16* Kh = Kh0 + mp * 64;
  const int wid = __builtin_amdgcn_readfirstlane(tid >> 6), lane = tid & 63, r32 = lane & 31, hi = lane >> 5;
  char* V_lds = lds; char* K_lds = lds + 2 * SHM_V;
  float* ws = (float*)(lds + 2 * SHM_V + 2 * SHM_K) + wid * 64; float* li_l = ws; float* al_l = ws + 32;
  float m_reg = 0.f, l_reg = 0; f32x16 o[4]; bf16x8 qr[4];
#pragma unroll
  for (int d = 0; d < 4; ++d)
#pragma unroll
    for (int r = 0; r < 16; ++r) o[d][r] = 0.f;
  const bf16* Qw = Qb + (long)(wid * QBLK + r32) * LDQ + hi * 8;
#pragma unroll
  for (int d0 = 0; d0 < 4; ++d0) qr[d0] = *reinterpret_cast<const bf16x8*>(Qw + d0 * 16);
  bool nomax;
  { float qn2 = 0.f, kb2 = 0.f;
#pragma unroll
    for (int d0 = 0; d0 < 4; ++d0) { const u32x4 w = __builtin_bit_cast(u32x4, qr[d0]);
#pragma unroll
      for (int e = 0; e < 4; ++e) { const float x0 = bflo(w[e]), x1 = bfhi(w[e]); qn2 += x0 * x0 + x1 * x1; } }
    { auto rr = __builtin_amdgcn_permlane32_swap(__float_as_uint(qn2), __float_as_uint(qn2), false, false); qn2 = __uint_as_float(rr[0]) + __uint_as_float(rr[1]); }
#pragma unroll
    for (int i = 0; i < 8; ++i) kb2 += kmb[mp * 8 + i];
    nomax = __all(qn2 * kb2 * 1.12f <= 3600.0f); }
  const int sr = tid >> 4, sc = (tid & 15) * 8, vst0 = v_st(sr, sc), vst1 = v_st(32 + sr, sc);
  const int kr = tid >> 3, kc = (tid & 7) * 8, kst = A128_KSWZ(kr, kc * 2);
  const int vb0 = (int)(uintptr_t)V_lds + v_rd_base(lane);
  struct { bf16x8 vs0, vs1, ks0; } sr_[2];
#define A128_SLOAD(i, k0) do { sr_[i].vs0 = *reinterpret_cast<const bf16x8*>(&Vh[(long)((k0) + sr) * LDK + sc]); sr_[i].vs1 = *reinterpret_cast<const bf16x8*>(&Vh[(long)((k0) + 32 + sr) * LDK + sc]); \
    sr_[i].ks0 = *reinterpret_cast<const bf16x8*>(&Kh[(long)((k0) + kr) * LDK + kc]); } while (0)
#define A128_SWRITE(b, i) do { *(bf16x8*)(V_lds + (b) * SHM_V + vst0) = sr_[i].vs0; *(bf16x8*)(V_lds + (b) * SHM_V + vst1) = sr_[i].vs1; *(bf16x8*)(K_lds + (b) * SHM_K + kst) = sr_[i].ks0; } while (0)
#define A128_SWAIT() asm volatile("s_waitcnt vmcnt(3)" ::: "memory")
#define A128_RESC(a) do { if (__any((a) < 1.f)) { if (hi == 0) al_l[r32] = (a); asm volatile("s_waitcnt lgkmcnt(0)" ::: "memory"); \
    _Pragma("unroll") for (int d = 0; d < 4; ++d) _Pragma("unroll") for (int r = 0; r < 16; ++r) o[d][r] *= al_l[crow(r, hi)]; } } while (0)
  f32x16 pA0, pA1, pB0, pB1; float mnA, mnB, alA, alB; bf16x8 pa0, pa1, pa2, pa3; const int NT = seq / KVBLK;
  A128_SLOAD(0, 0); asm volatile("s_waitcnt vmcnt(0)" ::: "memory"); A128_SWRITE(0, 0); __syncthreads();
  qkt(pA0, pA1, K_lds, qr, r32, hi); partialSM<true>(pA0, pA1, m_reg, mnA, alA, nomax);
  A128_SLOAD(1, KVBLK); if (2 < NT) A128_SLOAD(0, 2 * KVBLK);
  A128_SWAIT(); A128_SWRITE(1, 1); __syncthreads();
  for (int j = 1; j + 1 < NT; j += 2) {
    A128_SBAR(); qkt(pB0, pB1, K_lds + SHM_K, qr, r32, hi);
    finishSM(pA0, pA1, alA, l_reg, pa0, pa1, pa2, pa3); A128_SBAR();
    A128_SLOAD(1, (j + 2) * KVBLK); A128_SBAR();
    pv_d0(o, vb0, pa0, pa1, pa2, pa3); partialSM(pB0, pB1, m_reg, mnB, alB, nomax);
    __syncthreads(); A128_SWAIT(); A128_SWRITE(0, 0);
    if (!nomax) A128_RESC(alB); __syncthreads();
    A128_SBAR(); qkt(pA0, pA1, K_lds, qr, r32, hi);
    finishSM(pB0, pB1, alB, l_reg, pa0, pa1, pa2, pa3); A128_SBAR();
    if (j + 3 < NT) A128_SLOAD(0, (j + 3) * KVBLK); A128_SBAR();
    pv_d0(o, vb0 + (int)SHM_V, pa0, pa1, pa2, pa3); partialSM(pA0, pA1, m_reg, mnA, alA, nomax);
    __syncthreads(); A128_SWAIT(); A128_SWRITE(1, 1);
    if (!nomax) A128_RESC(alA); __syncthreads();
  }
  A128_SBAR(); qkt(pB0, pB1, K_lds + SHM_K, qr, r32, hi);
  finishSM(pA0, pA1, alA, l_reg, pa0, pa1, pa2, pa3); A128_SBAR();
  pv_d0(o, vb0, pa0, pa1, pa2, pa3); partialSM(pB0, pB1, m_reg, mnB, alB, nomax);
  __syncthreads(); if (!nomax) A128_RESC(alB);
  finishSM(pB0, pB1, alB, l_reg, pa0, pa1, pa2, pa3); A128_SBAR();
  pv_d0(o, vb0 + (int)SHM_V, pa0, pa1, pa2, pa3);
  if (hi == 0) li_l[r32] = l_reg; asm volatile("s_waitcnt lgkmcnt(0)" ::: "memory");
  float rli[16];
#pragma unroll
  for (int r = 0; r < 16; ++r) rli[r] = __builtin_amdgcn_rcpf(li_l[crow(r, hi)]);
  if (mp == 0) {
#pragma unroll
    for (int r = 0; r < 16; ++r)
#pragma unroll
      for (int d0 = 0; d0 < 4; ++d0) stage[(r * 4 + d0) * 64 + lane] = (bf16_t)(cvt_pk_bf16(o[d0][r] * rli[r], 0.f) & 0xffffu);
  } else {
    float ss[16];
#pragma unroll
    for (int r = 0; r < 16; ++r) { float q = 0.f;
#pragma unroll
      for (int d0 = 0; d0 < 4; ++d0) { const float a = bf1(stage[(r * 4 + d0) * 64 + lane]) - lam * bf1((bf16_t)(cvt_pk_bf16(o[d0][r] * rli[r], 0.f) & 0xffffu)); o[d0][r] = a; q += a * a; }
      ss[r] = q; }
#pragma unroll
    for (int m = 1; m < 32; m <<= 1)
#pragma unroll
      for (int r = 0; r < 16; ++r) ss[r] += __int_as_float(__builtin_amdgcn_ds_bpermute((lane ^ m) << 2, __float_as_int(ss[r])));
    float sw[4];
#pragma unroll
    for (int d0 = 0; d0 < 4; ++d0) sw[d0] = subw[d0 * 32 + r32] * onem;
    bf16_t* Ow = Ob + (long)(wid * QBLK) * LDOB;
#pragma unroll
    for (int r = 0; r < 16; ++r) { const int orow = crow(r, hi); const float rs = 1.0f / sqrtf(ss[r] * (1.f / 128.f) + RMS_EPS);
#pragma unroll
      for (int d0 = 0; d0 < 4; ++d0) Ow[(long)orow * LDOB + d0 * 32 + r32] = (bf16_t)(cvt_pk_bf16(o[d0][r] * rs * sw[d0], 0.f) & 0xffffu); }
  }
  __syncthreads();
 }
#undef A128_SLOAD
#undef A128_SWRITE
#undef A128_SWAIT
#undef A128_RESC
}
#undef A128_KSWZ
#undef A128_SBAR
}

#define XB_TMO      128
#define XB_XCNT(j)  (256  + 64 * (j))
#define XB_XSUB(j)  (1280 + 64 * (j))
#define XB_XGEN(j)  (2304 + 64 * (j))
#define XB_TOP      3328
#define XB_TOPGEN   3392
#define XCD_BAR_WORDS 3456
#define XB_SPIN_CAP (1u << 18)
__device__ __forceinline__ unsigned xb_ld(unsigned* p)              { return __hip_atomic_load(p, __ATOMIC_RELAXED, __HIP_MEMORY_SCOPE_AGENT); }
__device__ __forceinline__ unsigned xb_add(unsigned* p, unsigned v) { return __hip_atomic_fetch_add(p, v, __ATOMIC_RELAXED, __HIP_MEMORY_SCOPE_AGENT); }
__device__ __forceinline__ unsigned xb_xcc_id() { return (unsigned)__builtin_amdgcn_s_getreg((3 << 11) | 20) & 0xFu; }
#define XB_SPIN(cond, bar) do { unsigned _sp = 0; while (cond) { __builtin_amdgcn_s_sleep(1); \
    if ((++_sp & 255u) == 0u) { if (xb_ld(&(bar)[XB_TMO])) break; if (_sp > XB_SPIN_CAP) { atomicAdd(&(bar)[XB_TMO], 1u); break; } } } } while (0)
struct XcdBarrier { unsigned* bar; unsigned x; volatile LAS unsigned* st; };
__device__ __forceinline__ XcdBarrier xcd_barrier_post(unsigned* bar, volatile LAS unsigned* st) {
    XcdBarrier b; b.bar = bar; b.x = xb_xcc_id(); b.st = st;
    if (threadIdx.x == 0) (void)xb_add(&bar[XB_XCNT(b.x)], 1u);
    return b;
}
__device__ __forceinline__ void xcd_barrier_complete(unsigned* bar, unsigned x, unsigned& nloc, unsigned& nx) {
    const unsigned G = gridDim.x * gridDim.y * gridDim.z;
    unsigned sum, cnt, mine, sp = 0u;
    for (;;) {
        sum = 0u; cnt = 0u; mine = 0u;
#pragma unroll
        for (unsigned j = 0; j < 16; ++j) { const unsigned c = xb_ld(&bar[XB_XCNT(j)]); sum += c; cnt += (c > 0u) ? 1u : 0u; mine = (j == x) ? c : mine; }
        if (sum == G) break;
        __builtin_amdgcn_s_sleep(1);
        if ((++sp & 255u) == 0u) { if (xb_ld(&bar[XB_TMO])) break; if (sp > XB_SPIN_CAP) { atomicAdd(&bar[XB_TMO], 1u); break; } }
    }
    nloc = mine > 0u ? mine : 1u; nx = cnt > 0u ? cnt : 1u;
}
__device__ __forceinline__ void xcd_barrier(const XcdBarrier& b, const int tid) {
    asm volatile("s_waitcnt vmcnt(0)" ::: "memory");
    __syncthreads();
    if (tid == 0) {
        unsigned* bar = b.bar;
        __builtin_amdgcn_s_waitcnt(0);
        unsigned nloc = b.st[0], nx = b.st[1];
        if (nloc == 0u) { xcd_barrier_complete(bar, b.x, nloc, nx); b.st[0] = nloc; b.st[1] = nx; }
        const unsigned old = xb_add(&bar[XB_XSUB(b.x)], 1u);
        const unsigned gen = old / nloc;
        if (old + 1u == (gen + 1u) * nloc) {
            __builtin_amdgcn_fence(__ATOMIC_RELEASE, "agent");
            asm volatile("s_waitcnt vmcnt(0)" ::: "memory");
            const unsigned og = xb_add(&bar[XB_TOP], 1u);
            const unsigned tg = og / nx;
            if (og + 1u == (tg + 1u) * nx) xb_add(&bar[XB_TOPGEN], 1u);
            else XB_SPIN(xb_ld(&bar[XB_TOPGEN]) == tg, bar);
            __builtin_amdgcn_fence(__ATOMIC_ACQUIRE, "agent");
            xb_add(&bar[XB_XGEN(b.x)], 1u);
            asm volatile("s_waitcnt vmcnt(0)" ::: "memory");
        } else {
            XB_SPIN(xb_ld(&bar[XB_XGEN(b.x)]) == gen, bar);
            __builtin_amdgcn_fence(__ATOMIC_ACQUIRE, "agent");
            asm volatile("s_waitcnt vmcnt(0)" ::: "memory");
        }
    }
    __syncthreads();
}

constexpr int NWAVES = 8;
constexpr int RING_OFF = 0, RING_BYTES = 131072;
constexpr int LDSCTL_OFF = RING_BYTES, MISC_OFF = LDSCTL_OFF + 320;
constexpr int LDS_BYTES = 147456;
static_assert(attn128::SHM_TOTAL <= (size_t)RING_BYTES, "attention scratch fits the ring");

struct Args { const float* in[32]; float* out; unsigned char* ws; int ph_lo, ph_hi; };
constexpr int INTAB_OFF = LDSCTL_OFF + 1024;
__device__ __forceinline__ const float* inptr(LAS unsigned char* lds, int i) {
    const unsigned long long v = ((const LAS unsigned long long*)(lds + INTAB_OFF))[i];
    const unsigned lo = __builtin_amdgcn_readfirstlane((unsigned)v), hi = __builtin_amdgcn_readfirstlane((unsigned)(v >> 32));
    return (const float*)(GAS const float*)(((unsigned long long)hi << 32) | lo);
}
#define INP(i) inptr(F.lds, (i))
struct Frame {
    LAS unsigned char* lds; int tid, lane, wave, vcu, G, gw, NGW;
    unsigned char* ws;
};
enum { I_X = 0, I_C, I_CTX, I_CCTX, I_WMOD, I_BMOD, I_LNG, I_LNB, I_W1, I_W3, I_W2, I_WIN, I_ALAM, I_ASUB, I_CONVW, I_CONVB, I_ALOG, I_DTB, I_SSDD, I_SSDN,
       I_LRE, I_LIM, I_LSTEP, I_BRE, I_BIM, I_CRE, I_CIM, I_S5D, I_GLUW, I_GLUB, I_WBR, I_WOUT };

__device__ __forceinline__ void transpose_item64(const float* srcA, const float* srcB, int ldn, bool p32, bf16_t* dst, int ldk, LAS bf16_t* scr  , int lane, float scale = 1.0f) {
    const int q = lane & 15, kr = lane >> 4; const bool isB = q >= 8; const int c = (q & 7) * 4; const float* src = isB ? srcB : srcA;
    f32x4 v[16];
#pragma unroll
    for (int i = 0; i < 16; ++i) v[i] = src ? *(const f32x4*)(src + (size_t)(4 * i + kr) * ldn + c) : (f32x4){0.f, 0.f, 0.f, 0.f};
    if (scale != 1.0f) {
#pragma unroll
        for (int i = 0; i < 16; ++i) v[i] = v[i] * scale; }
    const int drow = (p32 ? pg8::perm32(c) : c) + (isB ? 32 : 0);
#pragma unroll
    for (int i = 0; i < 16; ++i) { const int k = 4 * i + kr; const unsigned p01 = cvt_pk_bf16(v[i][0], v[i][1]), p23 = cvt_pk_bf16(v[i][2], v[i][3]);
        scr[(drow + 0) * 72 + k] = (bf16_t)(p01 & 0xffffu); scr[(drow + 1) * 72 + k] = (bf16_t)(p01 >> 16); scr[(drow + 2) * 72 + k] = (bf16_t)(p23 & 0xffffu); scr[(drow + 3) * 72 + k] = (bf16_t)(p23 >> 16); }
    LDS_WAIT(); asm volatile("" ::: "memory");
    const int c8 = lane & 7;
#pragma unroll
    for (int jj = 0; jj < 8; ++jj) { const int n = (lane >> 3) + 8 * jj; *(u32x4*)(dst + (size_t)n * ldk + 8 * c8) = *(const LAS u32x4*)(scr + n * 72 + 8 * c8); }
    LDS_WAIT(); asm volatile("" ::: "memory");
}
__device__ __forceinline__ void convert_layer_weights(const Args& A_, Frame& F, int l) {
    LAS bf16_t* scr = (LAS bf16_t*)(F.lds + RING_OFF + F.wave * 16384);
    unsigned char* W = F.ws + WS_W;
    constexpr int I13 = 32 * 176, I2 = 88 * 32, IIN = 32 * 212, IB = 16 * 32, IO = 32 * 32, IG = 16 * 16;
    constexpr int NIT = 2 * I13 + 2 * I2 + IIN + 3 * IB + IO + IG;
    for (int it = F.gw; it < NIT; it += F.NGW) {
        int r = it;
        if (r < 2 * I13) { const int f = r / I13; r -= f * I13; const int kb = r / 176, nb = r % 176;
            const float* wsrc = (((nb & 3) < 2) ? INP(I_W1) : INP(I_W3)) + ((size_t)(l * 2 + f) * D + 64 * kb) * DFF + 128 * (nb >> 2) + 64 * (nb & 1);
            transpose_item64(wsrc, wsrc + 32, DFF, false, (bf16_t*)(W + W_13) + ((size_t)f * N13 + 64 * nb) * D + 64 * kb, D, scr, F.lane, ((nb & 3) < 2) ? -1.4426950408889634f : -0.6931471805599453f); continue; }
        r -= 2 * I13;
        if (r < 2 * I2) { const int f = r / I2; r -= f * I2; const int kb = r / 32, nb = r % 32;
            const float* w2 = INP(I_W2) + ((size_t)(l * 2 + f) * DFF + 64 * kb) * D + 64 * nb;
            transpose_item64(w2, w2 + 32, D, false, (bf16_t*)(W + W_2) + ((size_t)f * D + 64 * nb) * DFF + 64 * kb, DFF, scr, F.lane); continue; }
        r -= 2 * I2;
        if (r < IIN) { const int kb = r / 212, nb = r % 212; const int n0 = 64 * nb; const float* wb = INP(I_WIN) + ((size_t)l * D + 64 * kb) * 13344;
            const float* sa = nullptr; const float* sb = nullptr;
            if (n0 < 6144) { sa = wb + n0; sb = sa + 32; } else if (n0 < 13312) { sa = wb + n0 + 32; sb = sa + 32; } else if (n0 == 13312) { sa = wb + 6144; }
            transpose_item64(sa, sb, 13344, n0 < 2048, (bf16_t*)(W + W_IN) + (size_t)n0 * D + 64 * kb, D, scr, F.lane, (n0 >= PG && n0 < 13312) ? -1.4426950408889634f : 1.0f); continue; }
        r -= IIN;
        if (r < 3 * IB) { const int jb = r / IB; r -= jb * IB; const int kb = r / 32, nb = r % 32;
            const float* w = INP(I_WBR) + ((size_t)(l * 3 + jb) * 1024 + 64 * kb) * D + 64 * nb;
            const int sp = (jb == 0) ? 0 : (jb == 1 ? 2 : 1); transpose_item64(w, w + 32, D, false, (bf16_t*)(W + W_B) + (size_t)(64 * nb) * 3072 + sp * 1024 + 64 * kb, 3072, scr, F.lane); continue; }
        r -= 3 * IB;
        if (r < IO) { const int kb = r / 32, nb = r % 32; const float* w = INP(I_WOUT) + ((size_t)l * D + 64 * kb) * D + 64 * nb;
            transpose_item64(w, w + 32, D, false, (bf16_t*)(W + W_O) + (size_t)(64 * nb) * D + 64 * kb, D, scr, F.lane); continue; }
        r -= IO;
        { const int kb = r / 16, nb = r % 16; const float* w = INP(I_GLUW) + ((size_t)l * 1024 + 64 * kb) * 1024 + 64 * nb;
            transpose_item64(w, w + 32, 1024, false, (bf16_t*)(W + W_GLU) + (size_t)(64 * nb) * 1024 + 64 * kb, 1024, scr, F.lane); }
    }
}
__device__ __forceinline__ void mod_partials(const Args& A_, Frame& F) {
    float* MODw = (float*)(F.ws + WS_MOD);
    LAS float* sl = (LAS float*)(F.lds + RING_OFF + 98304 + F.wave * 4096);
    const int nskip = (F.G > 64) ? 64 : 0; if ((int)blockIdx.x < nskip) return;
    for (int it = ((int)blockIdx.x - nskip) * NWAVES + F.wave; it < 2 * 72 * 16; it += (F.G - nskip) * NWAVES) {
        const int l = it / (72 * 16), r = it % (72 * 16), ks = r / 72, cg = r % 72;
        const int col = cg * 256 + F.lane * 4; const float* w = INP(I_WMOD) + ((size_t)l * D + ks * 128) * NMOD + col;
        const float* c = INP(I_C) + ks * 128; const float* cc = INP(I_CCTX) + ks * 128;
#pragma unroll
        for (int h = 0; h < 2; ++h) { const int k = F.lane + 64 * h;
            sl[0 * 128 + k] = siluf_(c[k]); sl[1 * 128 + k] = siluf_(c[D + k]); sl[2 * 128 + k] = siluf_(c[2 * D + k]); sl[3 * 128 + k] = siluf_(c[3 * D + k]); sl[4 * 128 + k] = siluf_(cc[k]); }
        LDS_WAIT(); asm volatile("" ::: "memory");
        f32x4 a0 = {0.f, 0.f, 0.f, 0.f}, a1 = a0, a2 = a0, a3 = a0, a4 = a0;
        for (int k0 = 0; k0 < 128; k0 += 16) {
            f32x4 wv[16];
#pragma unroll
            for (int e = 0; e < 16; ++e) wv[e] = *(const f32x4*)(w + (size_t)(k0 + e) * NMOD);
            asm volatile("s_waitcnt vmcnt(0)" ::: "memory");
#pragma unroll
            for (int e = 0; e < 16; ++e) { a0 += wv[e] * sl[0 * 128 + k0 + e]; a1 += wv[e] * sl[1 * 128 + k0 + e]; a2 += wv[e] * sl[2 * 128 + k0 + e]; a3 += wv[e] * sl[3 * 128 + k0 + e]; a4 += wv[e] * sl[4 * 128 + k0 + e]; }
        }
        const int r9 = col / D; const float sc = (r9 == 2 || r9 == 8) ? 0.5f : 1.0f;
        if (ks == 0) { const f32x4 bv = *(const f32x4*)(INP(I_BMOD) + (size_t)l * NMOD + col); a0 += bv; a1 += bv; a2 += bv; a3 += bv; a4 += bv; }
        float* o = MODw + (size_t)l * 5 * NMOD + col;
#pragma unroll
        for (int e = 0; e < 4; ++e) { unsafeAtomicAdd(o + e, a0[e] * sc); unsafeAtomicAdd(o + NMOD + e, a1[e] * sc); unsafeAtomicAdd(o + 2 * NMOD + e, a2[e] * sc); unsafeAtomicAdd(o + 3 * NMOD + e, a3[e] * sc); unsafeAtomicAdd(o + 4 * NMOD + e, a4[e] * sc); }
        LDS_WAIT(); asm volatile("" ::: "memory");
    }
}
__device__ __forceinline__ void ln_pass(Frame& F, bool do_ln, const float* lng, const float* lnb, const float* modnext  , float* out, const float* xin = nullptr, const float* cin = nullptr, int nslab = 0, bool skipctx = false) {
#define LNCO(i) (512 * ((i) >> 1) + 8 * F.lane + 4 * ((i) & 1))
    _Float16* H = (_Float16*)(F.ws + WS_H); const float* SL = (const float*)(F.ws + WS_YD); float* HC = (float*)(F.ws + WS_HC); bf16_t* HM = (bf16_t*)(F.ws + WS_HM); float* ST = (float*)(F.ws + WS_STATS);
    f32x4 G[8], Bv[8];
    if (do_ln) {
#pragma unroll
        for (int i = 0; i < 8; ++i) { G[i] = *(const f32x4*)(lng + LNCO(i)); Bv[i] = *(const f32x4*)(lnb + LNCO(i)); }
    }
    const int nper = F.NGW / NB; f32x4 sh4[8], sc4[8];
    for (int it = 0; it < SEQ / nper + 1; ++it) {
        int b = F.gw / nper, rr = CTX + (F.gw % nper) + nper * it;
        if (it == SEQ / nper) { if (skipctx || F.gw >= NB * CTX) break; b = F.gw / CTX; rr = F.gw % CTX; }
        const int row = b * RB + rr; const bool isctx = rr < CTX; const int mi = isctx ? 4 : b;
        float* hc = HC + ((size_t)b * CTX + rr) * D; _Float16* hr = H + (size_t)row * D;
        f32x4 v[8]; float s = 0.f;
        if (xin) { const float* src = isctx ? cin + ((size_t)b * CTX + rr) * D : xin + ((size_t)b * SEQ + (rr - CTX)) * D;
#pragma unroll
            for (int i = 0; i < 8; ++i) v[i] = *(const f32x4*)(src + LNCO(i));
        } else if (isctx) {
#pragma unroll
            for (int i = 0; i < 8; ++i) v[i] = *(const f32x4*)(hc + LNCO(i));
            if (nslab) {
#pragma unroll 1
                for (int q = 0; q < 4; ++q) { f32x4 sv[8];
#pragma unroll
                    for (int i = 0; i < 8; ++i) sv[i] = *(const f32x4*)(SL + ((size_t)q * (NB * CTX) + (size_t)b * CTX + rr) * D + LNCO(i));
#pragma unroll
                    for (int i = 0; i < 8; ++i) v[i] = v[i] + sv[i]; } }
        } else {
#pragma unroll
            for (int k = 0; k < 4; ++k) { const h16x8 h = *(const h16x8*)(hr + LNCO(2 * k)); v[2 * k] = (f32x4){(float)h[0], (float)h[1], (float)h[2], (float)h[3]}; v[2 * k + 1] = (f32x4){(float)h[4], (float)h[5], (float)h[6], (float)h[7]}; }
        }
        if (modnext && (it == 0 || it == SEQ / nper)) { const float* sh = modnext + (size_t)mi * NMOD; const float* sc = sh + D;
#pragma unroll
            for (int i = 0; i < 8; ++i) { sh4[i] = *(const f32x4*)(sh + LNCO(i)); sc4[i] = *(const f32x4*)(sc + LNCO(i)); }
            if (do_ln && !isctx) {
#pragma unroll
                for (int i = 0; i < 8; ++i) { sc4[i] = sc4[i] + 1.0f; sh4[i] = Bv[i] * sc4[i] + sh4[i]; sc4[i] = G[i] * sc4[i]; } } }
        asm volatile("s_waitcnt vmcnt(0)" ::: "memory");
        { const f32x4 sv_ = ((v[0] + v[1]) + (v[2] + v[3])) + ((v[4] + v[5]) + (v[6] + v[7])); s = (sv_[0] + sv_[1]) + (sv_[2] + sv_[3]); }
        if (do_ln) {
            const float mean = wave_sum(s, F.lane) * (1.f / D); float s2 = 0.f;
            f32x4 q4_ = {0.f, 0.f, 0.f, 0.f};
#pragma unroll
            for (int i = 0; i < 8; ++i) { v[i] = v[i] - mean; q4_ = q4_ + v[i] * v[i]; }
            s2 = (q4_[0] + q4_[1]) + (q4_[2] + q4_[3]);
            const float rstd = 1.0f / sqrtf(wave_sum(s2, F.lane) * (1.f / D) + LN_EPS);
            if (!isctx && F.lane == 0) *(f32x2*)(ST + (size_t)row * 2) = (f32x2){mean, rstd};
#pragma unroll
            for (int i = 0; i < 8; ++i) { if (isctx || !modnext || out) { v[i] = v[i] * rstd * G[i] + Bv[i]; if (isctx) *(f32x4*)(hc + LNCO(i)) = v[i] * DN_ALPHA; } else v[i] = v[i] * rstd; }
        } else if (isctx) {
#pragma unroll
            for (int i = 0; i < 8; ++i) *(f32x4*)(hc + LNCO(i)) = v[i] * DN_ALPHA;
        } else {
#pragma unroll
            for (int k = 0; k < 4; ++k) { h16x8 h;
#pragma unroll
                for (int e = 0; e < 4; ++e) { h[e] = (_Float16)v[2 * k][e]; h[4 + e] = (_Float16)v[2 * k + 1][e]; }
                *(h16x8*)(hr + LNCO(2 * k)) = h; }
            if (F.lane == 0) *(f32x2*)(ST + (size_t)row * 2) = (f32x2){0.f, 1.f};
        }
        if (modnext) {
            const bool folded = do_ln && !isctx && !out;
#pragma unroll
            for (int k = 0; k < 4; ++k) { const f32x4 m0 = folded ? v[2 * k] * sc4[2 * k] + sh4[2 * k] : v[2 * k] * (sc4[2 * k] + 1.0f) + sh4[2 * k], m1 = folded ? v[2 * k + 1] * sc4[2 * k + 1] + sh4[2 * k + 1] : v[2 * k + 1] * (sc4[2 * k + 1] + 1.0f) + sh4[2 * k + 1];
                u32x4 w; w.x = cvt_pk_bf16(m0[0], m0[1]); w.y = cvt_pk_bf16(m0[2], m0[3]); w.z = cvt_pk_bf16(m1[0], m1[1]); w.w = cvt_pk_bf16(m1[2], m1[3]); *(u32x4*)(HM + (size_t)row * D + LNCO(2 * k)) = w; }
        }
        if (out && !isctx) { float* orow = out + ((size_t)b * SEQ + (rr - CTX)) * D;
#pragma unroll
            for (int i = 0; i < 8; ++i) *(f32x4*)(orow + LNCO(i)) = v[i]; }
    }
}
#undef LNCO

__device__ __forceinline__ void dt_tile(Frame& F, int l, int tile) {
    const bf16_t* A = (const bf16_t*)(F.ws + WS_HM) + (size_t)tile * 32 * D; const bf16_t* Bt = (const bf16_t*)(F.ws + WS_W + W_IN) + (size_t)13312 * D; float* DT = (float*)(F.ws + WS_DT);
    const int r = F.lane & 31, h = F.lane >> 5;
    f32x16 acc;
#pragma unroll
    for (int i = 0; i < 16; ++i) acc[i] = 0.f;
    const bf16_t* ap = A + (size_t)r * D + 8 * h; const bf16_t* bp = Bt + (size_t)r * D + 8 * h;
    for (int k0 = 0; k0 < 128; k0 += 16) {
        bf16x8 af[16], bfv[16];
#pragma unroll
        for (int e = 0; e < 16; ++e) { af[e] = *(const bf16x8*)(ap + 16 * (k0 + e)); bfv[e] = *(const bf16x8*)(bp + 16 * (k0 + e)); }
#pragma unroll
        for (int e = 0; e < 16; ++e) acc = __builtin_amdgcn_mfma_f32_32x32x16_bf16(af[e], bfv[e], acc, 0, 0, 0);
    }
    const float bias = INP(I_DTB)[l * 32 + r];
#pragma unroll
    for (int rg = 0; rg < 16; ++rg) { const int row = tile * 32 + (rg & 3) + 8 * (rg >> 2) + 4 * h; const float x = acc[rg] + bias; DT[(size_t)row * 32 + r] = fmaxf(x, 0.f) + log1pf(expf(-fabsf(x))); }
}
__device__ __forceinline__ void ssd_conv_pass(const Args& A_, Frame& F, int l) {
    const bf16_t* P = (const bf16_t*)(F.ws + WS_PROJ); bf16_t* XC = (bf16_t*)(F.ws + WS_HM);
    const float* cw = INP(I_CONVW) + (size_t)l * 5 * 2048; const float* cb = INP(I_CONVB) + (size_t)l * 2048;
    for (int it = F.gw; it < (R / 8) * 4; it += F.NGW) {
        const int r0 = (it >> 2) * 8, c0 = (it & 3) * 512 + F.lane * 8; const int rr0 = r0 % RB; const int lo = (rr0 < CTX) ? 0 : CTX, hi = (rr0 < CTX) ? CTX : RB;
        u32x4 x[12];
#pragma unroll
        for (int h = 0; h < 12; ++h) { const int r2 = rr0 + h - 2; x[h] = (r2 >= lo && r2 < hi) ? *(const u32x4*)(P + (size_t)(r0 + h - 2) * LDP + PX + c0) : (u32x4){0u, 0u, 0u, 0u}; }
        f32x4 w0[5], w1[5];
#pragma unroll
        for (int k = 0; k < 5; ++k) { w0[k] = *(const f32x4*)(cw + k * 2048 + c0); w1[k] = *(const f32x4*)(cw + k * 2048 + c0 + 4); }
        const f32x4 b0 = *(const f32x4*)(cb + c0), b1 = *(const f32x4*)(cb + c0 + 4);
#pragma unroll
        for (int jr = 0; jr < 8; ++jr) { f32x4 a0 = b0, a1 = b1;
#pragma unroll
            for (int k = 0; k < 5; ++k) { const u32x4 xv = x[jr + k];
                a0 = a0 + w0[k] * (f32x4){bflo(xv.x), bfhi(xv.x), bflo(xv.y), bfhi(xv.y)};
                a1 = a1 + w1[k] * (f32x4){bflo(xv.z), bfhi(xv.z), bflo(xv.w), bfhi(xv.w)}; }
            u32x4 o; o.x = cvt_pk_bf16(siluf_(a0[0]), siluf_(a0[1])); o.y = cvt_pk_bf16(siluf_(a0[2]), siluf_(a0[3])); o.z = cvt_pk_bf16(siluf_(a1[0]), siluf_(a1[1])); o.w = cvt_pk_bf16(siluf_(a1[2]), siluf_(a1[3]));
            *(u32x4*)(XC + (size_t)(r0 + jr) * 2048 + c0) = o; }
    }
}
__device__ __forceinline__ int scan_row(int rb, int d, int step) { return d == 0 ? rb + step : (step < CTX ? rb + CTX - 1 - step : rb + (RB + CTX - 1) - step); }

__device__ __forceinline__ unsigned short bf16_1(float v) { return (unsigned short)(cvt_pk_bf16(v, 0.f) & 0xffffu); }
__device__ __forceinline__ void ssd_chain_fast(const Args& A_, Frame& F, int l, int cid) {
    constexpr int LS = 136;
    const int b = cid >> 6, d = (cid >> 5) & 1, hd = (cid >> 1) & 15, ph = cid & 1, g = hd >> 2; const int rb = b * RB;
    const bf16_t* XC = (const bf16_t*)(F.ws + WS_HM); const float* DT = (const float*)(F.ws + WS_DT); bf16_t* YD = (bf16_t*)(F.ws + WS_YD) + (size_t)d * R * 1024;
    const float a = -expf(INP(I_ALOG)[l * 32 + d * 16 + hd]);
    LAS bf16_t* Cs = (LAS bf16_t*)(F.lds); LAS bf16_t* Bs = Cs + 128 * LS; LAS bf16_t* Ms = Bs + 128 * LS; LAS bf16_t* XdT = Ms + 128 * LS; LAS bf16_t* Hb = XdT + 32 * LS;
    LAS float* csL = (LAS float*)(Hb + 32 * LS); LAS float* ecsL = csL + 128; LAS float* ewL = ecsL + 128; LAS float* misc = ewL + 128;
    const int tid = F.tid, lane = F.lane, w = F.wave, r = lane & 31, h = lane >> 5;
    f32x16 hacc;
#pragma unroll
    for (int i = 0; i < 16; ++i) hacc[i] = 0.f;
    for (int i = tid; i < 32 * LS / 2; i += 512) ((LAS unsigned*)Hb)[i] = 0u;
    u32x4 pc[4], pb[4], px; float pdt, pv0 = 0.f, pv1 = 0.f;
    const int rho0 = d ? 127 - lane : lane, rho1 = d ? 63 - lane : 64 + lane;
#define SSD_R0(k_) ((d == 0) ? rb + 128 * (k_) : ((k_) < 2 ? rb + 128 * (1 - (k_)) : rb + 256 + 128 * (33 - (k_))))
#define SSD_ISSUE(k_) do { const int r0n = SSD_R0(k_); \
        _Pragma("unroll") for (int i = 0; i < 4; ++i) { const int item = tid + 512 * i, row = item >> 4, seg = item & 15; const bf16_t* src = XC + (size_t)(r0n + row) * 2048 + g * 128 + seg * 8; pc[i] = *(const u32x4*)(src + 1536); pb[i] = *(const u32x4*)(src + 1024); } \
        { const int row = tid >> 2, seg = tid & 3; pdt = DT[(size_t)(r0n + row) * 32 + d * 16 + hd]; px = *(const u32x4*)(XC + (size_t)(r0n + row) * 2048 + hd * 64 + ph * 32 + seg * 8); } \
        if (w == 0) { pv0 = DT[(size_t)(r0n + rho0) * 32 + d * 16 + hd]; pv1 = DT[(size_t)(r0n + rho1) * 32 + d * 16 + hd]; } } while (0)
    SSD_ISSUE(0);
    unsigned ypk[8]; int yrow = -1;
#pragma unroll
    for (int i = 0; i < 8; ++i) ypk[i] = 0u;
#define SSD_YFLUSH() do { if (w < 4 && yrow >= 0) { bf16_t* yo = YD + (size_t)yrow * 1024 + hd * 64 + ph * 32 + r; \
        _Pragma("unroll") for (int rg = 0; rg < 16; ++rg) yo[(size_t)((rg & 3) + 8 * (rg >> 2)) * 1024] = (bf16_t)((rg & 1) ? (ypk[rg >> 1] >> 16) : (ypk[rg >> 1] & 0xffffu)); } } while (0)
    for (int k = 0; k < 34; ++k) {
        const int r0 = SSD_R0(k);
        __syncthreads();
#pragma unroll
        for (int i = 0; i < 4; ++i) { const int item = tid + 512 * i, row = item >> 4, seg = item & 15; *(LAS u32x4*)(Cs + row * LS + seg * 8) = pc[i]; *(LAS u32x4*)(Bs + row * LS + seg * 8) = pb[i]; }
        { const int row = tid >> 2, seg = tid & 3; const float dtv = pdt; const u32x4 xv = px;
            LAS bf16_t* xo = XdT + (seg * 8) * LS + row;
            xo[0 * LS] = bf16_1(bflo(xv.x) * dtv); xo[1 * LS] = bf16_1(bfhi(xv.x) * dtv); xo[2 * LS] = bf16_1(bflo(xv.y) * dtv); xo[3 * LS] = bf16_1(bfhi(xv.y) * dtv);
            xo[4 * LS] = bf16_1(bflo(xv.z) * dtv); xo[5 * LS] = bf16_1(bfhi(xv.z) * dtv); xo[6 * LS] = bf16_1(bflo(xv.w) * dtv); xo[7 * LS] = bf16_1(bfhi(xv.w) * dtv); }
        if (w == 0) {
            float v0 = pv0 * a, v1 = pv1 * a;
#pragma unroll
            for (int o = 1; o < 64; o <<= 1) { const float t0 = __int_as_float(__builtin_amdgcn_ds_bpermute((lane - o) << 2, __float_as_int(v0))), t1 = __int_as_float(__builtin_amdgcn_ds_bpermute((lane - o) << 2, __float_as_int(v1))); if (lane >= o) { v0 += t0; v1 += t1; } }
            const float tot0 = __int_as_float(__builtin_amdgcn_ds_bpermute(63 << 2, __float_as_int(v0))); v1 += tot0;
            const float cend = __int_as_float(__builtin_amdgcn_ds_bpermute(63 << 2, __float_as_int(v1)));
            csL[rho0] = v0 * 1.4426950408889634f; csL[rho1] = v1 * 1.4426950408889634f; ecsL[rho0] = __builtin_amdgcn_exp2f(v0 * 1.4426950408889634f); ecsL[rho1] = __builtin_amdgcn_exp2f(v1 * 1.4426950408889634f);
            ewL[rho0] = __builtin_amdgcn_exp2f((cend - v0) * 1.4426950408889634f); ewL[rho1] = __builtin_amdgcn_exp2f((cend - v1) * 1.4426950408889634f);
            if (lane == 0) misc[0] = __builtin_amdgcn_exp2f(cend * 1.4426950408889634f);
        }
        if (k + 1 < 34) SSD_ISSUE(k + 1);
        __syncthreads();
        { const int lt = w >> 1;
#pragma unroll
          for (int q = 0; q < 2; ++q) { const int st = (w & 1) * 2 + q; const bool zero = (d == 0) ? (st > lt) : (st < lt);
            if (zero) continue;
            f32x16 acc;
#pragma unroll
            for (int i = 0; i < 16; ++i) acc[i] = 0.f;
            { bf16x8 af[8], bfv[8];
#pragma unroll
                for (int ks = 0; ks < 8; ++ks) { af[ks] = *(const LAS bf16x8*)(Cs + (32 * lt + r) * LS + 16 * ks + 8 * h); bfv[ks] = *(const LAS bf16x8*)(Bs + (32 * st + r) * LS + 16 * ks + 8 * h); }
#pragma unroll
                for (int ks = 0; ks < 8; ++ks) acc = __builtin_amdgcn_mfma_f32_32x32x16_bf16(bfv[ks], af[ks], acc, 0, 0, 0); }
            const int lrow = 32 * lt + r; const float crl = csL[lrow];
            f32x4 cs4[4];
#pragma unroll
            for (int q4 = 0; q4 < 4; ++q4) cs4[q4] = *(const LAS f32x4*)(csL + 32 * st + 8 * q4 + 4 * h);
#pragma unroll
            for (int q4 = 0; q4 < 4; ++q4) { float v4[4];
#pragma unroll
                for (int e = 0; e < 4; ++e) { const int scol = 32 * st + 8 * q4 + 4 * h + e; const bool valid = (d == 0) ? (scol <= lrow) : (scol >= lrow);
                    const float ex = __builtin_amdgcn_exp2f(crl - cs4[q4][e]);
                    v4[e] = valid ? acc[4 * q4 + e] * ex : 0.f; }
                u32x2 w; w.x = cvt_pk_bf16(v4[0], v4[1]); w.y = cvt_pk_bf16(v4[2], v4[3]);
                *(LAS u32x2*)(Ms + lrow * LS + 32 * st + 8 * q4 + 4 * h) = w; } } }
        __syncthreads();
        if (w < 4) { const int lt = w;
            f32x16 acc;
#pragma unroll
            for (int i = 0; i < 16; ++i) acc[i] = 0.f;
            { bf16x8 af[8], bfv[8];
#pragma unroll
              for (int ks = 0; ks < 8; ++ks) { af[ks] = *(const LAS bf16x8*)(Cs + (32 * lt + r) * LS + 16 * ks + 8 * h); bfv[ks] = *(const LAS bf16x8*)(Hb + r * LS + 16 * ks + 8 * h); }
#pragma unroll
              for (int ks = 0; ks < 8; ++ks) acc = __builtin_amdgcn_mfma_f32_32x32x16_bf16(af[ks], bfv[ks], acc, 0, 0, 0); }
            { f32x4 e4[4];
#pragma unroll
              for (int q4 = 0; q4 < 4; ++q4) e4[q4] = *(const LAS f32x4*)(ecsL + 32 * lt + 8 * q4 + 4 * h);
#pragma unroll
              for (int rg = 0; rg < 16; ++rg) acc[rg] *= e4[rg >> 2][rg & 3]; }
            { bf16x8 af[8], bfv[8];
#pragma unroll
              for (int ks = 0; ks < 8; ++ks) { af[ks] = *(const LAS bf16x8*)(Ms + (32 * lt + r) * LS + 16 * ks + 8 * h); bfv[ks] = *(const LAS bf16x8*)(XdT + r * LS + 16 * ks + 8 * h); }
#pragma unroll
              for (int ks = 0; ks < 8; ++ks) { const bool skip = (d == 0) ? (16 * ks >= 32 * (lt + 1)) : (16 * ks + 15 < 32 * lt);
                  if (!skip) acc = __builtin_amdgcn_mfma_f32_32x32x16_bf16(af[ks], bfv[ks], acc, 0, 0, 0); } }
            bf16_t* yo = YD + (size_t)(r0 + 32 * lt + 4 * h) * 1024 + hd * 64 + ph * 32 + r;
#pragma unroll
            for (int rg = 0; rg < 16; ++rg) yo[(size_t)((rg & 3) + 8 * (rg >> 2)) * 1024] = bf16_1(acc[rg]);
        } else { const int nt = w - 4; const float eend = misc[0];
#pragma unroll
            for (int i = 0; i < 16; ++i) hacc[i] *= eend;
            { typedef short v4i16_t_ __attribute__((ext_vector_type(4)));
#pragma unroll
              for (int kh = 0; kh < 2; ++kh) {
              u32x4 xa[8]; f32x4 e0[8], e1[8]; s16x4 t0[8], t1[8];
#pragma unroll
              for (int ks = 4 * kh; ks < 4 * kh + 4; ++ks) { const int k0 = 16 * ks + 8 * h; xa[ks] = *(const LAS u32x4*)(XdT + r * LS + k0); e0[ks] = *(const LAS f32x4*)(ewL + k0); e1[ks] = *(const LAS f32x4*)(ewL + k0 + 4);
                  const LAS bf16_t* tb = Bs + (k0 + ((lane & 15) >> 2)) * LS + 32 * nt + 16 * ((lane >> 4) & 1) + 4 * (lane & 3);
                  t0[ks] = __builtin_bit_cast(s16x4, __builtin_amdgcn_ds_read_tr16_b64_v4i16((LAS v4i16_t_*)tb)); t1[ks] = __builtin_bit_cast(s16x4, __builtin_amdgcn_ds_read_tr16_b64_v4i16((LAS v4i16_t_*)(tb + 4 * LS))); }
#pragma unroll
              for (int ks = 4 * kh; ks < 4 * kh + 4; ++ks) { u32x4 aw;
                  aw.x = cvt_pk_bf16(bflo(xa[ks].x) * e0[ks][0], bfhi(xa[ks].x) * e0[ks][1]); aw.y = cvt_pk_bf16(bflo(xa[ks].y) * e0[ks][2], bfhi(xa[ks].y) * e0[ks][3]); aw.z = cvt_pk_bf16(bflo(xa[ks].z) * e1[ks][0], bfhi(xa[ks].z) * e1[ks][1]); aw.w = cvt_pk_bf16(bflo(xa[ks].w) * e1[ks][2], bfhi(xa[ks].w) * e1[ks][3]);
                  const bf16x8 bw = (bf16x8){t0[ks][0], t0[ks][1], t0[ks][2], t0[ks][3], t1[ks][0], t1[ks][1], t1[ks][2], t1[ks][3]};
                  hacc = __builtin_amdgcn_mfma_f32_32x32x16_bf16(bw, __builtin_bit_cast(bf16x8, aw), hacc, 0, 0, 0); } } }
        }
        __syncthreads();
        if (w >= 4) { const int nt = w - 4;
#pragma unroll
            for (int q4 = 0; q4 < 4; ++q4) { u32x2 wv_; wv_.x = cvt_pk_bf16(hacc[4 * q4], hacc[4 * q4 + 1]); wv_.y = cvt_pk_bf16(hacc[4 * q4 + 2], hacc[4 * q4 + 3]);
                *(LAS u32x2*)(Hb + r * LS + 32 * nt + 8 * q4 + 4 * h) = wv_; } }
    }
    __syncthreads();
#undef SSD_R0
#undef SSD_ISSUE
#undef SSD_YFLUSH
}
__device__ __forceinline__ void s5_setup(const Args& A_, Frame& F, int l, int boff = 0) {
    LAS float* Pre = (LAS float*)(F.lds); LAS float* Pim = Pre + 2 * 17 * 64; LAS float* BBr = Pim + 2 * 17 * 64; LAS float* BBi = BBr + 2 * 64 * 16; LAS float* Kt = BBi + 2 * 64 * 16;
    LAS float* CrL = Kt + 8192; LAS float* CiL = CrL + 2048; LAS float* CrT = CiL + 2048; LAS float* CiT = CrT + 2048;
    bf16_t* Bt1 = (bf16_t*)(F.ws + WS_S5M); bf16_t* Bt2 = Bt1 + (size_t)64 * 512 * 256; float* A16 = (float*)(F.ws + WS_S5A);
    const int tid = F.tid;
    for (int g = (int)blockIdx.x - boff; g >= 0 && g < 64; g += F.G) {
        { f32x4 c4[2];
#pragma unroll
          for (int h = 0; h < 2; ++h) { const int e4 = tid * 4 & 1023, d = (tid >> 8); const int pg_ = (l * 2 + d) * 64 + g; c4[h] = *(const f32x4*)((h ? INP(I_CIM) : INP(I_CRE)) + (size_t)pg_ * 1024 + e4); }
          *(LAS f32x4*)(CrL + tid * 4) = c4[0]; *(LAS f32x4*)(CiL + tid * 4) = c4[1];
          const int d = tid >> 8, o = (tid & 255) >> 4, n4 = (tid & 15) * 4;
#pragma unroll
          for (int e = 0; e < 4; ++e) { CrT[(d * 64 + n4 + e) * 16 + o] = c4[0][e]; CiT[(d * 64 + n4 + e) * 16 + o] = c4[1][e]; } }
        for (int q = tid; q < 2 * 17 * 64; q += 512) { const int d = q / (17 * 64), dl = (q >> 6) % 17, n = q & 63; const int pg_ = (l * 2 + d) * 64 + g;
            const float lre = INP(I_LRE)[pg_ * 64 + n], lim = INP(I_LIM)[pg_ * 64 + n], step = expf(INP(I_LSTEP)[pg_]);
            const float mag = expf(lre * step * (float)dl), ang = lim * step * (float)dl; Pre[q] = mag * cosf(ang); Pim[q] = mag * sinf(ang); }
        __syncthreads();
        if (tid < 128) { const int d = tid >> 6, n = tid & 63; const int pg_ = (l * 2 + d) * 64 + g;
            const float lre = INP(I_LRE)[pg_ * 64 + n], lim = INP(I_LIM)[pg_ * 64 + n];
            const float abr = Pre[(d * 17 + 1) * 64 + n], abi = Pim[(d * 17 + 1) * 64 + n];
            const float den = lre * lre + lim * lim; const float kre = ((abr - 1.f) * lre + abi * lim) / den, kim = (abi * lre - (abr - 1.f) * lim) / den;
            const float* br = INP(I_BRE) + ((size_t)pg_ * 64 + n) * 16; const float* bi = INP(I_BIM) + ((size_t)pg_ * 64 + n) * 16;
            f32x4 bq[4], bz[4];
#pragma unroll
            for (int q = 0; q < 4; ++q) { bq[q] = *(const f32x4*)(br + 4 * q); bz[q] = *(const f32x4*)(bi + 4 * q); }
#pragma unroll
            for (int i = 0; i < 16; ++i) { const float x = bq[i >> 2][i & 3], y = bz[i >> 2][i & 3]; BBr[(d * 64 + n) * 16 + i] = kre * x - kim * y; BBi[(d * 64 + n) * 16 + i] = kre * y + kim * x; }
            A16[((d * 64 + g) * 64 + n) * 2] = Pre[(d * 17 + 16) * 64 + n]; A16[((d * 64 + g) * 64 + n) * 2 + 1] = Pim[(d * 17 + 16) * 64 + n]; }
        __syncthreads();
        { const int d = tid >> 8, dl = (tid >> 4) & 15, i = tid & 15;
            f32x4 acc[4] = {{0.f, 0.f, 0.f, 0.f}, {0.f, 0.f, 0.f, 0.f}, {0.f, 0.f, 0.f, 0.f}, {0.f, 0.f, 0.f, 0.f}};
            for (int n = 0; n < 64; ++n) { const float pr = Pre[(d * 17 + dl) * 64 + n], pi = Pim[(d * 17 + dl) * 64 + n], br = BBr[(d * 64 + n) * 16 + i], bi = BBi[(d * 64 + n) * 16 + i];
                const float tr = pr * br - pi * bi, ti = pr * bi + pi * br;
#pragma unroll
                for (int o4 = 0; o4 < 4; ++o4) { const f32x4 cr = *(const LAS f32x4*)(CrT + (d * 64 + n) * 16 + 4 * o4), ci = *(const LAS f32x4*)(CiT + (d * 64 + n) * 16 + 4 * o4); acc[o4] += cr * tr - ci * ti; } }
#pragma unroll
            for (int o = 0; o < 16; ++o) Kt[((d * 16 + dl) * 16 + o) * 16 + i] = acc[o >> 2][o & 3]; }
        __syncthreads();
        const float dsk = INP(I_S5D)[l * 1024 + 16 * g + (tid & 15)];
        for (int q = 0; q < 16; ++q) { const int item = tid + 512 * q; const int c1 = item >> 5, kb = (item & 31) * 8; const int rin = kb >> 4, i0 = kb & 15, rout = c1 >> 4, o = c1 & 15;
            const float dsko = __int_as_float(__builtin_amdgcn_ds_bpermute((((F.lane & ~15) | o)) << 2, __float_as_int(dsk)));
            float v[8];
#pragma unroll
            for (int e = 0; e < 8; ++e) { const int i = i0 + e; float x = 0.f; if (rout >= rin) x += Kt[((0 * 16 + (rout - rin)) * 16 + o) * 16 + i]; if (rin >= rout) x += Kt[((1 * 16 + (rin - rout)) * 16 + o) * 16 + i];
                if (rin == rout && i == o) x += dsko; v[e] = x; }
            u32x4 w; w.x = cvt_pk_bf16(v[0], v[1]); w.y = cvt_pk_bf16(v[2], v[3]); w.z = cvt_pk_bf16(v[4], v[5]); w.w = cvt_pk_bf16(v[6], v[7]);
            *(u32x4*)(Bt1 + ((size_t)g * 512 + c1) * 256 + kb) = w; }
        for (int q = 0; q < 16; ++q) { const int item = tid + 512 * q; const int c1 = item >> 5, kb = (item & 31) * 8; const int rin = kb >> 4, i0 = kb & 15; const int d = c1 >> 7, part = c1 & 1, n = (c1 >> 1) & 63;
            const int ex = (d == 0) ? 15 - rin : rin; const float pr = Pre[(d * 17 + ex) * 64 + n], pi = Pim[(d * 17 + ex) * 64 + n];
            float v[8];
#pragma unroll
            for (int e = 0; e < 8; ++e) { const float br = BBr[(d * 64 + n) * 16 + i0 + e], bi = BBi[(d * 64 + n) * 16 + i0 + e]; v[e] = part ? (pr * bi + pi * br) : (pr * br - pi * bi); }
            u32x4 w; w.x = cvt_pk_bf16(v[0], v[1]); w.y = cvt_pk_bf16(v[2], v[3]); w.z = cvt_pk_bf16(v[4], v[5]); w.w = cvt_pk_bf16(v[6], v[7]);
            *(u32x4*)(Bt1 + ((size_t)g * 512 + 256 + c1) * 256 + kb) = w; }
        for (int q = 0; q < 16; ++q) { const int item = tid + 512 * q; const int c2 = item >> 5, kb = (item & 31) * 8; const int rout = c2 >> 4, o = c2 & 15; const int d = kb >> 7, part = (kb >> 6) & 1, n0 = kb & 63;
            const int ex = (d == 0) ? rout + 1 : 16 - rout; const LAS float* cr = CrL + (d * 16 + o) * 64 + n0; const LAS float* ci = CiL + (d * 16 + o) * 64 + n0;
            float v[8];
#pragma unroll
            for (int e = 0; e < 8; ++e) { const float pr = Pre[(d * 17 + ex) * 64 + n0 + e], pi = Pim[(d * 17 + ex) * 64 + n0 + e]; v[e] = part ? -(cr[e] * pi + ci[e] * pr) : (cr[e] * pr - ci[e] * pi); }
            u32x4 w; w.x = cvt_pk_bf16(v[0], v[1]); w.y = cvt_pk_bf16(v[2], v[3]); w.z = cvt_pk_bf16(v[4], v[5]); w.w = cvt_pk_bf16(v[6], v[7]);
            *(u32x4*)(Bt2 + ((size_t)g * 256 + c2) * 256 + kb) = w; }
        __syncthreads();
    }
}
__device__ __forceinline__ void s5_carry(Frame& F, int cid) {
    const int b = cid >> 7, d = (cid >> 6) & 1, g = cid & 63, n = F.lane;
    const unsigned* ST = (const unsigned*)((const bf16_t*)(F.ws + WS_S5ST) + ((size_t)g * S5M + b * 272) * 256 + d * 128) + n;
    bf16_t* HP = (bf16_t*)(F.ws + WS_S5H) + ((size_t)g * 1280 + b * 272) * 256 + d * 128 + n;
    const float* A16 = (const float*)(F.ws + WS_S5A); const float ar = A16[((d * 64 + g) * 64 + n) * 2], ai = A16[((d * 64 + g) * 64 + n) * 2 + 1];
    float hr = 0.f, hi_ = 0.f;
    for (int k0 = 0; k0 < 272; k0 += 34) {
        unsigned wv[34];
#pragma unroll
        for (int e = 0; e < 34; ++e) { const int k = k0 + e; const int cc = (d == 0) ? k : (k < 16 ? 15 - k : 287 - k); wv[e] = ST[(size_t)cc * 128]; }
        asm volatile("s_waitcnt vmcnt(0)" ::: "memory");
#pragma unroll
        for (int e = 0; e < 34; ++e) { const int k = k0 + e; const int cc = (d == 0) ? k : (k < 16 ? 15 - k : 287 - k);
            HP[(size_t)cc * 256] = (bf16_t)(cvt_pk_bf16(hr, 0.f) & 0xffffu); HP[(size_t)cc * 256 + 64] = (bf16_t)(cvt_pk_bf16(hi_, 0.f) & 0xffffu);
            const float sr = bflo(wv[e]), si = bfhi(wv[e]); const float nr = ar * hr - ai * hi_ + sr, ni = ar * hi_ + ai * hr + si; hr = nr; hi_ = ni; }
    }
}
__device__ __forceinline__ void mixer_finalize(const Args& A_, Frame& F, int l) {
    bf16_t* P = (bf16_t*)(F.ws + WS_PROJ);
    const bf16_t* XC = (const bf16_t*)(F.ws + WS_HM); const bf16_t* YD0 = (const bf16_t*)(F.ws + WS_YD); const bf16_t* YD1 = YD0 + (size_t)R * 1024;
        const int c0 = F.lane * 16;
    for (int row = F.gw; row < R; row += F.NGW) {
        { const float dsk = INP(I_SSDD)[l * 16 + (c0 >> 6)];
          const float* nwp = INP(I_SSDN) + l * 1024 + c0;
          float v[16];
#pragma unroll
          for (int hh = 0; hh < 2; ++hh) { const u32x4 x = *(const u32x4*)(XC + (size_t)row * 2048 + c0 + 8 * hh), y0 = *(const u32x4*)(YD0 + (size_t)row * 1024 + c0 + 8 * hh), y1 = *(const u32x4*)(YD1 + (size_t)row * 1024 + c0 + 8 * hh), z = *(const u32x4*)(P + (size_t)row * LDP + PZ + c0 + 8 * hh);
#define SG(i, wx, wy0, wy1, wz) v[8 * hh + 2 * (i)] = (bflo(wx) * dsk + bflo(wy0) + bflo(wy1)) * bflo(wz); v[8 * hh + 2 * (i) + 1] = (bfhi(wx) * dsk + bfhi(wy0) + bfhi(wy1)) * bfhi(wz);
              SG(0, x.x, y0.x, y1.x, z.x) SG(1, x.y, y0.y, y1.y, z.y) SG(2, x.z, y0.z, y1.z, z.z) SG(3, x.w, y0.w, y1.w, z.w)
#undef SG
          }
          float ss = 0.f;
#pragma unroll
          for (int e = 0; e < 16; ++e) ss += v[e] * v[e];
          ss += shx(ss, 1, F.lane); ss += shx(ss, 2, F.lane); ss += shx(ss, 4, F.lane); ss += shx(ss, 8, F.lane);
          const float rs = 1.0f / sqrtf(ss * (1.f / 256.f) + RMS_EPS);
          const f32x4 n0 = *(const f32x4*)(nwp), n1 = *(const f32x4*)(nwp + 4), n2 = *(const f32x4*)(nwp + 8), n3 = *(const f32x4*)(nwp + 12);
          const float nw[16] = {n0[0], n0[1], n0[2], n0[3], n1[0], n1[1], n1[2], n1[3], n2[0], n2[1], n2[2], n2[3], n3[0], n3[1], n3[2], n3[3]};
          u32x4 o0, o1;
          o0.x = cvt_pk_bf16(v[0] * rs * nw[0], v[1] * rs * nw[1]); o0.y = cvt_pk_bf16(v[2] * rs * nw[2], v[3] * rs * nw[3]); o0.z = cvt_pk_bf16(v[4] * rs * nw[4], v[5] * rs * nw[5]); o0.w = cvt_pk_bf16(v[6] * rs * nw[6], v[7] * rs * nw[7]);
          o1.x = cvt_pk_bf16(v[8] * rs * nw[8], v[9] * rs * nw[9]); o1.y = cvt_pk_bf16(v[10] * rs * nw[10], v[11] * rs * nw[11]); o1.z = cvt_pk_bf16(v[12] * rs * nw[12], v[13] * rs * nw[13]); o1.w = cvt_pk_bf16(v[14] * rs * nw[14], v[15] * rs * nw[15]);
          *(u32x4*)(P + (size_t)row * LDP + PV + c0) = o0; *(u32x4*)(P + (size_t)row * LDP + PV + c0 + 8) = o1; }
    }
}


__global__ void __launch_bounds__(NWAVES * 64, 2) trunk_fwd(Args args) {
    extern __shared__ __attribute__((aligned(16))) unsigned char lds_raw[];
    Frame F;
    F.lds = (LAS unsigned char*)lds_raw;
    F.tid = threadIdx.x; F.lane = F.tid & 63; F.wave = __builtin_amdgcn_readfirstlane(F.tid >> 6);
    F.G = gridDim.x; { const int bx = blockIdx.x; F.vcu = (F.G % 8 == 0) ? (bx % 8) * (F.G / 8) + bx / 8 : bx; }
    F.gw = F.vcu * NWAVES + F.wave; F.NGW = F.G * NWAVES;
    F.ws = args.ws;
    volatile LAS unsigned* MISC = (volatile LAS unsigned*)(F.lds + MISC_OFF);
    for (int u = F.tid; u < (LDS_BYTES - LDSCTL_OFF) / 4; u += NWAVES * 64) ((LAS unsigned*)(F.lds + LDSCTL_OFF))[u] = 0u;
    __syncthreads();
    if (threadIdx.x < 32) ((LAS unsigned long long*)(F.lds + INTAB_OFF))[threadIdx.x] = (unsigned long long)args.in[threadIdx.x];
    __syncthreads();
    (void)xcd_barrier_post((unsigned*)(args.ws + WS_CTL) + CW_BAR, MISC + 8);
    const int lo = args.ph_lo, hi = args.ph_hi;
    const int wave0 = __builtin_amdgcn_readfirstlane((int)threadIdx.x >> 6);
    int pid = 0;
#define PH_BEGIN if (pid >= lo && pid < hi) { GAS unsigned char* wsg_ = (GAS unsigned char*)args.ws; int tid_; asm volatile("v_mbcnt_lo_u32_b32 %1, -1, 0\n\tv_mbcnt_hi_u32_b32 %1, -1, %1 ; PHASE_MARK_BEGIN %2" : "+s"(wsg_), "=v"(tid_) : "i"(__LINE__) : "memory"); tid_ += wave0 * 64; unsigned char* ws = (unsigned char*)wsg_; F.ws = ws; F.tid = tid_; F.lane = tid_ & 63; F.wave = __builtin_amdgcn_readfirstlane(tid_ >> 6); F.gw = F.vcu * NWAVES + F.wave;
#define PH_END   asm volatile("; PHASE_MARK_END %0" :: "i"(__LINE__)); if (pid + 1 < hi) { XcdBarrier bar_; bar_.bar = (unsigned*)(args.ws + WS_CTL) + CW_BAR; bar_.x = xb_xcc_id(); bar_.st = (volatile LAS unsigned*)(F.lds + MISC_OFF) + 8; xcd_barrier(bar_, wave0 * 64 + lane_now()); } } ++pid;

#define MOD ((float*)(ws + WS_MOD))
#define Hbuf ((float*)(ws + WS_H))
#define HM ((bf16_t*)(ws + WS_HM))
#define PROJ ((bf16_t*)(ws + WS_PROJ))
#define ROPEC ((float*)(ws + WS_ROPE))
#define ROPES (ROPEC + 1024)
#define WGT (ws + WS_W)

    PH_BEGIN
        s5_setup(args, F, 0);
        mod_partials(args, F);
        if ((int)blockIdx.x == F.G - 1) {
            { float* idn = (float*)(ws + WS_IDENT); for (int i = F.tid; i < 2048; i += NWAVES * 64) { idn[i] = 1.0f; idn[2048 + i] = 0.0f; } }
#pragma unroll
            for (int i2 = 0; i2 < 2; ++i2) { const int idx = (F.wave * 2 + i2) * 64 + F.lane, pos = idx >> 4, f = idx & 15; const float inv = powf(10000.0f, -(float)f / 16.0f); const float ang = (float)pos * inv; ROPEC[idx] = cosf(ang); ROPES[idx] = sinf(ang); } }
    PH_END
    PH_BEGIN
        convert_layer_weights(args, F, 0);
        ln_pass(F, false, nullptr, nullptr, MOD, nullptr, INP(I_X), INP(I_CTX));
    PH_END

    for (int s = 0; s < 6; ++s) {
        const int l = s / 3, j = s - 3 * l;
        if (j != 1) {
            const int f = j >> 1;
            PH_BEGIN
                const int lat = (l == 1 && j == 2); pg8::Gemm g{D, D, D}; pg8::StaticOrder S; S.init(lat ? 64 : NPAN, N13 / 256, F.G, (int)blockIdx.x, HM, D, (const bf16_t*)(WGT + W_13) + (size_t)f * N13 * D, D, D, lat);
                EpiSwiGLU E{PROJ};
                pg8::gemm_phase<EpiSwiGLU, pg8::StaticOrder>(F.lds + RING_OFF, g, S, E, F.tid);
            PH_END
        } else {
            PH_BEGIN
                pg8::Gemm g{D, D, D}; pg8::StaticOrder S;
                if (l == 0) S.init(NPAN, LDP / 256, F.G, (int)blockIdx.x, HM, D, (const bf16_t*)(WGT + W_IN), D, D);
                else { S.init(64, LDP / 256, F.G, (int)blockIdx.x, HM, D, (const bf16_t*)(WGT + W_IN), D, D, 1, 80); S.cproj = 1; }
                EpiProj E{PROJ, (float*)(ws + WS_DT), ROPEC, ROPES, (bf16_t*)(ws + WS_O), (unsigned*)(ws + WS_KM) + l * 512};
                pg8::gemm_phase<EpiProj, pg8::StaticOrder>(F.lds + RING_OFF, g, S, E, F.tid);
                { const int nfull = ((l == 0 ? NPAN * (LDP / 256) : 64 * (LDP / 256) + 80)) % F.G;
                  if ((int)blockIdx.x >= nfull) { const int nw = (F.G - nfull) * NWAVES; for (int t = ((int)blockIdx.x - nfull) * NWAVES + F.wave; t < R / 32; t += nw) dt_tile(F, l, t); } }
            PH_END
            PH_BEGIN
                ssd_conv_pass(args, F, l);
                asm volatile("" : "+v"(F.tid));
                { pg8::Gemm g{256, 256, 256}; S5AOrder S{F.G, (int)blockIdx.x, (const char*)(ws + WS_O), (const char*)(ws + WS_S5M)};
                  EpiS5A E{(unsigned char*)(ws + WS_YS), (bf16_t*)(ws + WS_S5ST)};
                  pg8::gemm_phase<EpiS5A, S5AOrder>(F.lds + RING_OFF, g, S, E, F.tid); }
            PH_END
            PH_BEGIN
                if (F.wave < 2) s5_carry(F, (int)blockIdx.x * 2 + F.wave);
                ssd_chain_fast(args, F, l, (int)blockIdx.x);
                {
                    const float lam_init = 0.8f - 0.6f * expf(-0.3f * (float)l);
                    const float* lv = INP(I_ALAM) + l * 256;
                    const float s01 = wave_sum(lv[F.lane] * lv[64 + F.lane], F.lane), s23 = wave_sum(lv[128 + F.lane] * lv[192 + F.lane], F.lane);
                    const float lam = expf(s01) - expf(s23) + lam_init;
                    for (int i = 0;; ++i) { const int idx = i * F.G + F.vcu; if (idx >= 512 + (l == 0 ? 32 : 0)) break;
                        int b, h, q0, seq;
                        if (idx < 512) { b = idx >> 7; h = (idx >> 4) & 7; q0 = b * RB + CTX + (idx & 15) * 256; seq = RB; }
                        else { const int k = idx - 512; b = k >> 3; h = k & 7; q0 = b * RB; seq = CTX; }
                        const bf16_t* Q0 = PROJ + (size_t)q0 * LDP + PQ + h * 128; const bf16_t* Kh = PROJ + (size_t)(b * RB) * LDP + PK + h * 128; const bf16_t* Vh = PROJ + (size_t)(b * RB) * LDP + PV + h * 128;
                        attn128::unit((const attn128::bf16*)Q0, (const attn128::bf16*)Kh, (const attn128::bf16*)Vh, PROJ + (size_t)q0 * LDP + PQ + h * 128, seq, (char*)lds_raw + RING_OFF, F.tid, lam, 1.0f - lam_init, INP(I_ASUB) + l * 128, (const float*)(ws + WS_KM) + l * 512 + (b * 8 + h) * 16);
                    }
                }
            PH_END
            PH_BEGIN
                mixer_finalize(args, F, l);
                asm volatile("" : "+v"(F.tid));
                { pg8::Gemm g{256, 256, 256}; S5COrder S{F.G, (int)blockIdx.x, (const char*)(ws + WS_S5H), (const char*)((bf16_t*)(ws + WS_S5M) + (size_t)64 * 512 * 256)};
                  EpiS5C E{(const unsigned char*)(ws + WS_YS), PROJ};
                  pg8::gemm_phase<EpiS5C, S5COrder>(F.lds + RING_OFF, g, S, E, F.tid); }
            PH_END
            PH_BEGIN
                pg8::Gemm g{LDP, 1024, 1024}; pg8::StaticOrder S; S.init(l == 1 ? 64 : NPAN, 4, F.G, (int)blockIdx.x, PROJ + PU, LDP, (const bf16_t*)(WGT + W_GLU), 1024, 1024, l == 1);
                EpiGlu E{PROJ, INP(I_GLUB) + l * 1024};
                pg8::gemm_phase<EpiGlu, pg8::StaticOrder>(F.lds + RING_OFF, g, S, E, F.tid);
            PH_END
            PH_BEGIN
                pg8::Gemm g{LDP, 3072, 3072}; pg8::StaticOrder S; S.init(l == 1 ? 64 : NPAN, 8, F.G, (int)blockIdx.x, PROJ, LDP, (const bf16_t*)(WGT + W_B), 3072, 3072, l == 1);
                EpiMerge E{PROJ, HM};
                pg8::gemm_phase<EpiMerge, pg8::StaticOrder, 0, true>(F.lds + RING_OFF, g, S, E, F.tid);
            PH_END
        }
        PH_BEGIN
            const int RK = (j == 1) ? D : DFF; const bf16_t* RA = (j == 1) ? HM : PROJ; const bf16_t* RBt = (j == 1) ? (const bf16_t*)(WGT + W_O) : (const bf16_t*)(WGT + W_2) + (size_t)(j >> 1) * D * DFF;
            const int lat = (l == 1 && j >= 1); pg8::Gemm g{RK, RK, RK}; pg8::StaticOrder S; S.init(64, D / 256, F.G, (int)blockIdx.x, RA, RK, RBt, RK, RK, 1, lat ? 0 : 128);
            const float* lg_ = (s == 0) ? (const float*)(ws + WS_IDENT) : INP(I_LNG) + (size_t)(s - 1) * D; const float* lb_ = (s == 0) ? (const float*)(ws + WS_IDENT) + 2048 : INP(I_LNB) + (size_t)(s - 1) * D;
            EpiResid E{(_Float16*)(ws + WS_H), (float*)(ws + WS_HC), MOD + (size_t)l * 5 * NMOD + (3 * j + 2) * D, lg_, lb_, (const float*)(ws + WS_STATS)};
            pg8::gemm_phase<EpiResid, pg8::StaticOrder>(F.lds + RING_OFF, g, S, E, F.tid);
        PH_END
        PH_BEGIN
            const bool fin = (s == 5);
            const int ln_ = (j == 2) ? l + 1 : l, jn = (j == 2) ? 0 : j + 1;
            ln_pass(F, true, INP(I_LNG) + (size_t)(l * 3 + j) * D, INP(I_LNB) + (size_t)(l * 3 + j) * D, fin ? nullptr : MOD + (size_t)ln_ * 5 * NMOD + 3 * jn * D, fin ? args.out : nullptr, nullptr, nullptr, (l == 1 && j >= 1) ? 0 : 4, l == 1 && j >= 1  );
            if (s == 2) { s5_setup(args, F, 1); __syncthreads(); convert_layer_weights(args, F, 1); }
        PH_END
    }
#undef PH_BEGIN
#undef PH_END
}

static int count_phases() { int n = 2; for (int s = 0; s < 6; ++s) n += ((s % 3) != 1 ? 1 : 6) + 2; return n; }
extern "C" void kernel_launch(void* const* d_in, const int* in_sizes, int n_in, void* d_out, int out_size, void* d_ws, size_t ws_size, hipStream_t stream) {
    static int grid = 0;
    if (grid == 0) {
        if (n_in != 32 || out_size != NB * SEQ * D || ws_size < WS_END) { fprintf(stderr, "kernel_launch: unexpected shapes (n_in %d, out %d, ws %zu < %zu)\n", n_in, out_size, ws_size, (size_t)WS_END); grid = -1; return; }
        int dev = 0, cus = 0, per_cu = 0;
        if (hipGetDevice(&dev) != hipSuccess || hipDeviceGetAttribute(&cus, hipDeviceAttributeMultiprocessorCount, dev) != hipSuccess) { grid = -1; return; }
        if (hipFuncSetAttribute((const void*)trunk_fwd, hipFuncAttributeMaxDynamicSharedMemorySize, LDS_BYTES) != hipSuccess) { fprintf(stderr, "kernel_launch: hipFuncSetAttribute failed\n"); grid = -1; return; }
        if (hipOccupancyMaxActiveBlocksPerMultiprocessor(&per_cu, (const void*)trunk_fwd, NWAVES * 64, LDS_BYTES) != hipSuccess || per_cu < 1) fprintf(stderr, "kernel_launch: occupancy query says %d\n", per_cu);
        (void)hipGetLastError();
        if (cus != 256) { fprintf(stderr, "kernel_launch: this kernel deals its SSD chains / carries / attention units over exactly 256 workgroups (one per CU); device reports %d CUs; nothing launched\n", cus); grid = -1; return; }
        grid = cus;
    }
    if (grid < 0) return;
    (void)in_sizes;
    if (hipMemsetAsync((char*)d_ws + WS_CTL, 0, 2 * MiB  , stream) != hipSuccess) return;
    Args a{};
    for (int i = 0; i < 32; ++i) a.in[i] = (const float*)d_in[i];
    a.out = (float*)d_out; a.ws = (unsigned char*)d_ws;
    const int nph = count_phases();
#if MK_PER_PHASE
    for (int p = 0; p < nph; ++p) { a.ph_lo = p; a.ph_hi = p + 1; hipLaunchKernelGGL(trunk_fwd, dim3(grid), dim3(NWAVES * 64), LDS_BYTES, stream, a); }
#else
    a.ph_lo = 0; a.ph_hi = nph;
    hipLaunchKernelGGL(trunk_fwd, dim3(grid), dim3(NWAVES * 64), LDS_BYTES, stream, a);
#endif
    const hipError_t le = hipPeekAtLastError();
    if (le != hipSuccess) fprintf(stderr, "kernel_launch: launch failed: %s\n", hipGetErrorName(le));
}
```

```cpp
#include <hip/hip_runtime.h>
#include <hip/hip_bf16.h>
#include <cstdio>
#include <cstdint>
#include <cmath>

#ifndef MK_PER_PHASE
#define MK_PER_PHASE 0
#endif

#define LAS __attribute__((address_space(3)))
#define GAS __attribute__((address_space(1)))
typedef unsigned short bf16_t;
typedef short bf16x8 __attribute__((ext_vector_type(8)));
typedef float f32x4 __attribute__((ext_vector_type(4)));
typedef float f32x2 __attribute__((ext_vector_type(2)));
typedef float f32x16 __attribute__((ext_vector_type(16)));
typedef unsigned u32x4 __attribute__((ext_vector_type(4)));
typedef unsigned u32x2 __attribute__((ext_vector_type(2)));
typedef short s16x4 __attribute__((ext_vector_type(4)));

constexpr int NB = 4, SEQ = 4096, CTX = 256, RB = SEQ + CTX  , R = NB * RB  , NPAN = R / 256  , PPB = RB / 256  ;
constexpr int D = 2048, DFF = 5632, N13 = 2 * DFF, NMOD = 9 * D  ;
constexpr int LDP = 13312;
constexpr int NIN = 13568;
constexpr int PQ = 0, PK = 1024, PV = 2048, PZ = 3072, PX = 4096, PU = 6144, PG = 7168;
constexpr float DN_ALPHA = 1.41421356237309515f;
constexpr float LN_EPS = 1e-5f, RMS_EPS = 1e-6f;
constexpr float QSCALE = 0.125f * 1.4426950408889634f;

constexpr size_t MiB = 1u << 20;
constexpr size_t WS_CTL = 0, CTL_ZERO_BYTES = 1 * MiB;
constexpr size_t WS_MOD = 1 * MiB;
constexpr size_t WS_ROPE = 2 * MiB;
constexpr size_t WS_STATS = 2 * MiB + 65536;
constexpr size_t WS_IDENT = 2 * MiB + 262144;
constexpr size_t WS_MODP = 3 * MiB;
constexpr size_t WS_DT = 15 * MiB;
constexpr size_t WS_H = 18 * MiB;
constexpr size_t WS_HC = WS_H + 68 * MiB;
constexpr size_t WS_HM = 154 * MiB;
constexpr size_t WS_PROJ = 222 * MiB;
constexpr size_t WS_O = 664 * MiB;
constexpr size_t WS_YD = 732 * MiB;
constexpr size_t WS_YS = 800 * MiB;
constexpr size_t WS_W = 868 * MiB;
constexpr size_t W_13 = 0, W_2 = 88 * MiB, W_IN = 132 * MiB, W_B = 185 * MiB, W_O = 197 * MiB, W_GLU = 205 * MiB;
constexpr size_t WS_S5ST = 1075 * MiB;
constexpr size_t WS_S5H = 1143 * MiB;
constexpr size_t WS_S5M = 1183 * MiB;
constexpr size_t WS_S5A = 1207 * MiB;
constexpr size_t WS_GQ0 = WS_O + 34 * MiB, WS_GQ1 = WS_S5ST + 34 * MiB  , WS_GQ2 = 1208 * MiB;
constexpr size_t WS_END = 1242 * MiB;
__device__ __forceinline__ size_t gq_off(int j) { return j == 0 ? WS_GQ0 : (j == 1 ? WS_GQ1 : WS_GQ2); }
constexpr int S5M = 1088;
constexpr int CW_BAR = 4096;
constexpr size_t WS_KM = WS_CTL + 512 * 1024;

__device__ __forceinline__ unsigned cvt_pk_bf16(float lo, float hi) { unsigned r; asm volatile("v_cvt_pk_bf16_f32 %0, %1, %2" : "=v"(r) : "v"(lo), "v"(hi)); return r; }
__device__ __forceinline__ float bflo(unsigned u) { return __uint_as_float(u << 16); }
__device__ __forceinline__ float bfhi(unsigned u) { return __uint_as_float(u & 0xffff0000u); }
__device__ __forceinline__ float bf1(bf16_t h) { return __uint_as_float((unsigned)h << 16); }
typedef _Float16 h16x2 __attribute__((ext_vector_type(2)));
typedef _Float16 h16x4 __attribute__((ext_vector_type(4)));
typedef _Float16 h16x8 __attribute__((ext_vector_type(8)));
__device__ __forceinline__ f32x4 ld_h4(const _Float16* p) { const h16x4 h = *(const h16x4*)p; return (f32x4){(float)h[0], (float)h[1], (float)h[2], (float)h[3]}; }
__device__ __forceinline__ void st_h4(_Float16* p, f32x4 v) { h16x4 h; h[0] = (_Float16)v[0]; h[1] = (_Float16)v[1]; h[2] = (_Float16)v[2]; h[3] = (_Float16)v[3]; *(h16x4*)p = h; }
__device__ __forceinline__ float sigmoidf_(float x) { return __builtin_amdgcn_rcpf(1.0f + __builtin_amdgcn_exp2f(-1.4426950408889634f * x)); }
__device__ __forceinline__ float siluf_(float x) { return x * sigmoidf_(x); }
__device__ __forceinline__ int lane_now() { int l; asm volatile("v_mbcnt_lo_u32_b32 %0, -1, 0\n\tv_mbcnt_hi_u32_b32 %0, -1, %0" : "=v"(l)); return l; }
__device__ __forceinline__ float shx(float v, int m, int lane) { return __int_as_float(__builtin_amdgcn_ds_bpermute((lane ^ m) << 2, __float_as_int(v))); }
__device__ __forceinline__ float wave_sum(float v, int lane) {
#pragma unroll
    for (int o = 1; o < 64; o <<= 1) v += shx(v, o, lane);
    return v;
}
#define LDS_WAIT() asm volatile("s_waitcnt lgkmcnt(0)" ::: "memory")
#define VM_WAIT() asm volatile("s_waitcnt vmcnt(0)" ::: "memory")

namespace pg8 {
constexpr int BM = 256, BK = 64, HALF = 128, HTB = HALF * BK * 2, STAGE_BYTES = 8 * HTB, NXCD = 8, WGM = 8, PPB_ = 17;
__host__ __device__ __forceinline__ int lds_byte(int r, int c) { const int st = (r >> 4) * 2 + (c >> 5), rr = r & 15, cc = c & 31, ob = rr * 64 + cc * 2; return st * 1024 + (ob ^ (((ob >> 9) & 1) << 5)); }
__host__ __device__ __forceinline__ int perm32(int rho) { const int n = rho >> 4, i = rho & 15; return 8 * (i >> 2) + 4 * n + (i & 3); }
__host__ __device__ __forceinline__ void stage_rc(int b, int& R_, int& C_) { const int st = b / 1024, sb = b % 1024, swz = sb ^ (((sb >> 9) & 1) << 5); R_ = (st >> 1) * 16 + swz / 64; C_ = (st & 1) * 32 + (swz % 64) / 2; }

struct Unit { int pm, pn, aux, kt; const char* a; const char* b; };
struct Gemm { int lda, ldb, K; };

__device__ __forceinline__ void xcd_remap(int L, int nM, int nN, int& pm, int& pn) {
    const int nwg = nM * nN; int wgid = L;
    { const int q = nwg / NXCD, r = nwg % NXCD, xcd = wgid % NXCD, off = wgid / NXCD; wgid = (xcd < r ? xcd * (q + 1) : r * (q + 1) + (xcd - r) * q) + off; }
    const int nig = WGM * nN, gid = wgid / nig, fm = gid * WGM, gsz = (nM - fm) < WGM ? (nM - fm) : WGM;
    pm = fm + ((wgid % nig) % gsz); pn = (wgid % nig) / gsz;
}
struct StaticOrder {
    int nM, nN, nwg, G, c, kt, latonly, nctx, cproj; const char* A; const char* B; size_t tA, tB;
    __device__ __forceinline__ void init(int nM_, int nN_, int G_, int c_, const void* A_, int lda, const void* B_, int ldb, int K, int latonly_ = 0, int nctx_ = 0) { nM = nM_; nN = nN_; nwg = nM * nN; G = G_; c = c_; kt = K / BK; latonly = latonly_; nctx = nctx_; cproj = 0;
        A = (const char*)A_; B = (const char*)B_; tA = (size_t)BM * lda * 2; tB = (size_t)BM * ldb * 2; }
    __device__ __forceinline__ bool next(int i, Unit& u) const {
        const long L = (long)i * G + c;
        if (L < nwg) { xcd_remap((int)L, nM, nN, u.pm, u.pn); if (latonly) u.pm += (u.pm >> 4) + 1; u.aux = 0; u.kt = kt; u.a = A + (size_t)u.pm * tA; u.b = B + (size_t)u.pn * tB; return true; }
        const int x = (int)(L - nwg); if (x >= nctx) return false;
        if (cproj) {
            const int p = x / 20, t2 = x - 20 * p; u.pm = PPB_ * p; u.pn = (t2 < 8) ? 4 + t2 : 8 + t2; u.aux = 0; u.kt = kt; u.a = A + (size_t)u.pm * tA; u.b = B + (size_t)u.pn * tB; return true; }
        const int q = x & 3, t2 = x >> 2; u.pm = PPB_ * (t2 / nN); u.pn = t2 % nN; u.aux = 1 + q; u.kt = kt >> 2;
        u.a = A + (size_t)u.pm * tA + (size_t)q * (kt >> 2) * BK * 2; u.b = B + (size_t)u.pn * tB + (size_t)q * (kt >> 2) * BK * 2; return true;
    }
};
template <class Epi, class Sched, int AMODE = 0, bool HOOK = false>
__device__ __forceinline__ void gemm_phase(LAS unsigned char* lds, const Gemm g, const Sched& S, const Epi& E, const int tid) {
    const int wid = __builtin_amdgcn_readfirstlane(tid >> 6), lane = tid & 63, wr = wid >> 2, wc = wid & 3, fr = lane & 15, fq = lane >> 4;
    unsigned voffA[2], voffB[2];
#pragma unroll
    for (int i = 0; i < 2; ++i) { int R_, C_; stage_rc(tid * 16 + i * 8192, R_, C_);
        voffA[i] = (AMODE == 1) ? (unsigned)((R_ * 16 + (C_ >> 4)) * LDP + (C_ & 15)) * 2u : (unsigned)(R_ * g.lda + C_) * 2u; voffB[i] = (unsigned)((Epi::PERM ? ((R_ & ~31) + perm32(R_ & 31)) : R_) * g.ldb + C_) * 2u; }
    const size_t kstep = (size_t)(BK * 2), kstepA = (AMODE == 1) ? (size_t)(4 * LDP * 2) : kstep;
    const size_t hstepA = (AMODE == 1) ? (size_t)HALF * 16 * LDP * 2 : (size_t)HALF * g.lda * 2, hstepB = (size_t)HALF * g.ldb * 2;
    const unsigned ldsw = (unsigned)wid * 1024u;
    const int aoff = lds_byte(wr * 64 + fr, fq * 8), boff = lds_byte(wc * 32 + fr, fq * 8);
#define PG8_SA(b, h) (((b) * 2 + (h)) * HTB)
#define PG8_SB(b, h) ((4 + (b) * 2 + (h)) * HTB)
#define PG8_STAGE(bufoff, gbase, voff) do { const unsigned long long gb_ = (unsigned long long)(gbase);        \
        const unsigned long long gs_ = ((unsigned long long)(unsigned)__builtin_amdgcn_readfirstlane((int)(gb_ >> 32)) << 32) | (unsigned long long)(unsigned)__builtin_amdgcn_readfirstlane((int)gb_); \
        _Pragma("unroll") for (int _i = 0; _i < 2; ++_i) \
        asm volatile("s_mov_b32 m0, %2\n\ts_nop 0\n\tglobal_load_lds_dwordx4 %0, %1" :: "v"((voff)[_i]), "s"(gs_), "s"((unsigned)__builtin_amdgcn_readfirstlane((int)(unsigned)(uintptr_t)(lds + (bufoff) + ldsw + _i * 8192))) : "memory"); } while (0)
#define PG8_LDA(dst, b, h) do { _Pragma("unroll") for (int m = 0; m < 4; ++m) _Pragma("unroll") for (int k = 0; k < 2; ++k) dst[m][k] = *(const LAS bf16x8*)(lds + PG8_SA(b, h) + aoff + m * 2048 + k * 1024); } while (0)
#define PG8_LDB(dst, b, h) do { _Pragma("unroll") for (int n = 0; n < 2; ++n) _Pragma("unroll") for (int k = 0; k < 2; ++k) dst[n][k] = *(const LAS bf16x8*)(lds + PG8_SB(b, h) + boff + n * 2048 + k * 1024); } while (0)
#define PG8_MMA(ai, bj, At, Bt) do { __builtin_amdgcn_s_setprio(1); _Pragma("unroll") for (int m = 0; m < 4; ++m) _Pragma("unroll") for (int n = 0; n < 2; ++n) _Pragma("unroll") for (int k = 0; k < 2; ++k) \
        acc[ai][bj][m][n] = __builtin_amdgcn_mfma_f32_16x16x32_bf16(Bt[n][k], At[m][k], acc[ai][bj][m][n], 0, 0, 0); __builtin_amdgcn_s_setprio(0); } while (0)
#define PG8_WAIT_V(n) asm volatile("s_waitcnt vmcnt(" #n ")" ::: "memory")
#define PG8_WAIT_L(n) asm volatile("s_waitcnt lgkmcnt(" #n ")" ::: "memory")
#define PG8_BAR __builtin_amdgcn_s_barrier()
#define PG8_SCHED __builtin_amdgcn_sched_barrier(0)
    Unit cur, nxt; int ui = 0;
    if (!S.next(0, cur)) return;
    f32x4 acc[2][2][4][2];
#pragma unroll
    for (int a = 0; a < 2; ++a)
#pragma unroll
        for (int b = 0; b < 2; ++b)
#pragma unroll
            for (int m = 0; m < 4; ++m)
#pragma unroll
                for (int n = 0; n < 2; ++n) acc[a][b][m][n] = (f32x4){0.f, 0.f, 0.f, 0.f};
    bf16x8 At[4][2], B0[2][2], B1[2][2];
#define PG8_UNI(p) ((const char*)(((unsigned long long)(unsigned)__builtin_amdgcn_readfirstlane((int)((unsigned long long)(p) >> 32)) << 32) | (unsigned long long)(unsigned)__builtin_amdgcn_readfirstlane((int)(unsigned long long)(p))))
    const char* cA = PG8_UNI(cur.a); const char* cB = PG8_UNI(cur.b);
    PG8_STAGE(PG8_SB(0, 0), cB, voffB); PG8_STAGE(PG8_SB(0, 1), cB + hstepB, voffB); PG8_STAGE(PG8_SA(0, 0), cA, voffA); PG8_STAGE(PG8_SA(0, 1), cA + hstepA, voffA);
    if (wr == 1) PG8_BAR;
    PG8_WAIT_V(2); PG8_BAR;
    PG8_STAGE(PG8_SB(1, 0), cB + kstep, voffB); PG8_STAGE(PG8_SA(1, 0), cA + kstepA, voffA); PG8_STAGE(PG8_SB(1, 1), cB + hstepB + kstep, voffB);
    PG8_WAIT_V(6); PG8_BAR;
    for (;;) {
        const bool has_next = S.next(ui + 1, nxt);
        const char* nA = PG8_UNI(has_next ? nxt.a : cA); const char* nB = PG8_UNI(has_next ? nxt.b : cB);
        const int nt = cur.kt;
        for (int t = 0; t < nt; t += 2) {
            const bool last = (t == nt - 2);
            if constexpr (HOOK) { if (t == 16 || t == 32) E.mid(acc, cur, t >> 4, wr, wc); }
            const char* a1 = cA + (size_t)(t + 1) * kstepA;
            const char* a2 = last ? nA : cA + (size_t)(t + 2) * kstepA; const char* b2 = last ? nB : cB + (size_t)(t + 2) * kstep;
            const char* a3 = a2 + kstepA; const char* b3 = b2 + kstep;
            PG8_LDB(B0, 0, 0); PG8_LDB(B1, 0, 1); PG8_SCHED; PG8_LDA(At, 0, 0); PG8_STAGE(PG8_SA(1, 1), a1 + hstepA, voffA);
            PG8_WAIT_V(8); PG8_WAIT_L(0); PG8_BAR; PG8_MMA(0, 0, At, B0); PG8_MMA(0, 1, At, B1); PG8_BAR; PG8_SCHED;
            PG8_LDA(At, 0, 1); PG8_STAGE(PG8_SB(0, 0), b2, voffB); PG8_STAGE(PG8_SB(0, 1), b2 + hstepB, voffB); PG8_STAGE(PG8_SA(0, 0), a2, voffA);
            PG8_WAIT_V(8); PG8_WAIT_L(0); PG8_BAR; PG8_MMA(1, 0, At, B0); PG8_MMA(1, 1, At, B1); PG8_BAR; PG8_SCHED;
            PG8_LDB(B0, 1, 0); PG8_LDB(B1, 1, 1); PG8_SCHED; PG8_LDA(At, 1, 0); PG8_STAGE(PG8_SA(0, 1), a2 + hstepA, voffA);
            PG8_WAIT_V(8); PG8_WAIT_L(0); PG8_BAR; PG8_MMA(0, 0, At, B0); PG8_MMA(0, 1, At, B1); PG8_BAR; PG8_SCHED;
            PG8_LDA(At, 1, 1); PG8_STAGE(PG8_SB(1, 0), b3, voffB); PG8_STAGE(PG8_SB(1, 1), b3 + hstepB, voffB); PG8_STAGE(PG8_SA(1, 0), a3, voffA);
            PG8_WAIT_V(8); PG8_WAIT_L(0); PG8_BAR; PG8_MMA(1, 0, At, B0); PG8_MMA(1, 1, At, B1); PG8_BAR; PG8_SCHED;
        }
        if (wr == 0) PG8_BAR;
        E(acc, cur, wr, wc, fr, fq);
        if (!has_next) break;
#pragma unroll
        for (int a = 0; a < 2; ++a)
#pragma unroll
            for (int b = 0; b < 2; ++b)
#pragma unroll
                for (int m = 0; m < 4; ++m)
#pragma unroll
                    for (int n = 0; n < 2; ++n) acc[a][b][m][n] = (f32x4){0.f, 0.f, 0.f, 0.f};
        cur = nxt; cA = nA; cB = nB; ++ui;
        if (wr == 1) PG8_BAR;
    }
    PG8_WAIT_V(0);
    PG8_BAR;
#undef PG8_UNI
#undef PG8_SA
#undef PG8_SB
#undef PG8_STAGE
#undef PG8_LDA
#undef PG8_LDB
#undef PG8_MMA
#undef PG8_WAIT_V
#undef PG8_WAIT_L
#undef PG8_BAR
#undef PG8_SCHED
}
}

struct EpiSwiGLU {
    static constexpr bool PERM = true;
    bf16_t* O;
    __device__ __forceinline__ void operator()(const f32x4 (&acc)[2][2][4][2], const pg8::Unit& u, int wr, int wc, int, int) const { const int ln_ = lane_now(); const int fr = ln_ & 15, fq = ln_ >> 4;
        const int row0 = u.pm * 256 + wr * 64 + fr, hc0 = u.pn * 128 + wc * 32 + 8 * fq;
#pragma unroll
        for (int ai = 0; ai < 2; ++ai)
#pragma unroll
            for (int m = 0; m < 4; ++m) { const f32x4 a0 = acc[ai][0][m][0], a1 = acc[ai][0][m][1], b0 = acc[ai][1][m][0], b1 = acc[ai][1][m][1];
                f32x4 d0 = (f32x4){__builtin_amdgcn_exp2f(a0[0]), __builtin_amdgcn_exp2f(a0[1]), __builtin_amdgcn_exp2f(a0[2]), __builtin_amdgcn_exp2f(a0[3])} + 1.0f;
                f32x4 d1 = (f32x4){__builtin_amdgcn_exp2f(a1[0]), __builtin_amdgcn_exp2f(a1[1]), __builtin_amdgcn_exp2f(a1[2]), __builtin_amdgcn_exp2f(a1[3])} + 1.0f;
                const f32x4 o0 = (a0 * b0) * (f32x4){__builtin_amdgcn_rcpf(d0[0]), __builtin_amdgcn_rcpf(d0[1]), __builtin_amdgcn_rcpf(d0[2]), __builtin_amdgcn_rcpf(d0[3])};
                const f32x4 o1 = (a1 * b1) * (f32x4){__builtin_amdgcn_rcpf(d1[0]), __builtin_amdgcn_rcpf(d1[1]), __builtin_amdgcn_rcpf(d1[2]), __builtin_amdgcn_rcpf(d1[3])};
                u32x4 w; w.x = cvt_pk_bf16(o0[0], o0[1]); w.y = cvt_pk_bf16(o0[2], o0[3]); w.z = cvt_pk_bf16(o1[0], o1[1]); w.w = cvt_pk_bf16(o1[2], o1[3]);
                *(u32x4*)(O + (size_t)(row0 + ai * 128 + m * 16) * DFF + hc0) = w; }
    }
};
struct EpiResid {
    static constexpr bool PERM = true;
    _Float16* H; float* HC; const float* gate; const float* lng; const float* lnb; const float* stats;
    __device__ __forceinline__ void operator()(const f32x4 (&acc)[2][2][4][2], const pg8::Unit& u, int wr, int wc, int, int) const { const int ln_ = lane_now(); const int fr = ln_ & 15, fq = ln_ >> 4;
        int upm = u.pm, upn = u.pn; asm volatile("" : "+s"(upm), "+s"(upn));
        const int pp = upm % PPB, mi = (pp == 0) ? 4 : (upm / PPB);
        const int rl0 = wr * 64 + fr, col0 = upn * 256 + wc * 32 + 8 * fq;
        if (u.aux) {
            float* hc = (float*)((char*)HC - WS_HC + WS_YD) + ((size_t)(u.aux - 1) * (NB * CTX) + (size_t)(upm / PPB) * 256) * D;
#pragma unroll
            for (int bj = 0; bj < 2; ++bj) { const f32x4 gv0 = *(const f32x4*)(gate + (size_t)mi * NMOD + col0 + bj * 128), gv1 = *(const f32x4*)(gate + (size_t)mi * NMOD + col0 + bj * 128 + 4);
#pragma unroll
                for (int ai = 0; ai < 2; ++ai)
#pragma unroll
                    for (int m = 0; m < 4; ++m) { float* p = hc + (size_t)(rl0 + ai * 128 + m * 16) * D + col0 + bj * 128; *(f32x4*)p = gv0 * acc[ai][bj][m][0]; *(f32x4*)(p + 4) = gv1 * acc[ai][bj][m][1]; } }
            return;
        }
#pragma unroll
        for (int bj = 0; bj < 2; ++bj) { const int c = col0 + bj * 128;
            const f32x4 gv0 = *(const f32x4*)(gate + (size_t)mi * NMOD + c), gv1 = *(const f32x4*)(gate + (size_t)mi * NMOD + c + 4);
            const f32x4 g0 = *(const f32x4*)(lng + c) * DN_ALPHA, g1 = *(const f32x4*)(lng + c + 4) * DN_ALPHA, b0 = *(const f32x4*)(lnb + c) * DN_ALPHA, b1 = *(const f32x4*)(lnb + c + 4) * DN_ALPHA;
#pragma unroll
            for (int ai = 0; ai < 2; ++ai) {
                u32x4 tv[4]; f32x2 st[4];
#pragma unroll
                for (int m = 0; m < 4; ++m) { const size_t row = (size_t)(upm * 256 + rl0 + ai * 128 + m * 16); tv[m] = *(const u32x4*)(H + row * D + c); st[m] = *(const f32x2*)(stats + row * 2); }
                asm volatile("s_waitcnt vmcnt(0)" ::: "memory");
#pragma unroll
                for (int m = 0; m < 4; ++m) { const h16x4 ha = __builtin_bit_cast(h16x4, (u32x2){tv[m].x, tv[m].y}), hb = __builtin_bit_cast(h16x4, (u32x2){tv[m].z, tv[m].w});
                    const f32x4 t0 = (f32x4){(float)ha[0], (float)ha[1], (float)ha[2], (float)ha[3]}, t1 = (f32x4){(float)hb[0], (float)hb[1], (float)hb[2], (float)hb[3]};
                    const f32x4 o0 = (t0 - st[m].x) * st[m].y * g0 + b0 + gv0 * acc[ai][bj][m][0], o1 = (t1 - st[m].x) * st[m].y * g1 + b1 + gv1 * acc[ai][bj][m][1];
                    h16x4 qa, qb; qa[0] = (_Float16)o0[0]; qa[1] = (_Float16)o0[1]; qa[2] = (_Float16)o0[2]; qa[3] = (_Float16)o0[3]; qb[0] = (_Float16)o1[0]; qb[1] = (_Float16)o1[1]; qb[2] = (_Float16)o1[2]; qb[3] = (_Float16)o1[3];
                    const u32x2 pa = __builtin_bit_cast(u32x2, qa), pb = __builtin_bit_cast(u32x2, qb);
                    *(u32x4*)(H + (size_t)(upm * 256 + rl0 + ai * 128 + m * 16) * D + c) = (u32x4){pa.x, pa.y, pb.x, pb.y}; } } }
    }
};
struct EpiProj {
    static constexpr bool PERM = true;
    bf16_t* P; float* DT; const float* rc; const float* rs; bf16_t* U2; unsigned* KM;
    __device__ __forceinline__ void operator()(const f32x4 (&acc)[2][2][4][2], const pg8::Unit& u, int wr, int wc, int, int) const { const int ln_ = lane_now(); const int fr = ln_ & 15, fq = ln_ >> 4;
        const int pp = u.pm % PPB; const int row0 = u.pm * 256 + wr * 64 + fr;
        const int pn = u.pn;
        if (pn == 52) {
            if (wc == 0) {
#pragma unroll
                for (int ai = 0; ai < 2; ++ai)
#pragma unroll
                    for (int m = 0; m < 4; ++m)
#pragma unroll
                        for (int n = 0; n < 2; ++n) *(f32x4*)(DT + (size_t)(row0 + ai * 128 + m * 16) * 32 + 8 * fq + 4 * n) = acc[ai][0][m][n];
            }
            return;
        }
        if (pn >= 28) {
            const int jg = (pn - 28) >> 3, pnd = (pn - 28) & 7;
            unsigned char* gq = (unsigned char*)P - WS_PROJ + gq_off(jg) + ((size_t)((u.pm * 8 + pnd) * 512 + (wr * 4 + wc) * 64 + ln_)) * 128;
#pragma unroll
            for (int ai = 0; ai < 2; ++ai)
#pragma unroll
                for (int m = 0; m < 4; ++m) { u32x4 w;
#pragma unroll
                    for (int bj = 0; bj < 2; ++bj)
#pragma unroll
                        for (int n = 0; n < 2; ++n) { const f32x4 v = acc[ai][bj][m][n]; unsigned q = 0;
#pragma unroll
                            for (int e = 0; e < 4; ++e) { const float ex = __builtin_amdgcn_exp2f(v[e]);
                                q = __builtin_amdgcn_cvt_pk_u8_f32(fmaxf(__builtin_amdgcn_rcpf(__builtin_fmaf(ex, 1.0f / 255.0f, 1.0f / 255.0f)), 1.0f), e, q); }
                            w[bj * 2 + n] = q; }
                    *(u32x4*)(gq + (ai * 4 + m) * 16) = w; }
            return;
        }
        if (pn >= 4 && pn < 8) {
            float kmx0 = 0.f, kmx1 = 0.f;
#pragma unroll
            for (int ai = 0; ai < 2; ++ai)
#pragma unroll
                for (int m = 0; m < 4; ++m) { const f32x4 a2 = acc[ai][0][m][0] * acc[ai][0][m][0] + acc[ai][0][m][1] * acc[ai][0][m][1], b2 = acc[ai][1][m][0] * acc[ai][1][m][0] + acc[ai][1][m][1] * acc[ai][1][m][1];
                    kmx0 = fmaxf(kmx0, (a2[0] + a2[1]) + (a2[2] + a2[3])); kmx1 = fmaxf(kmx1, (b2[0] + b2[1]) + (b2[2] + b2[3])); }
#pragma unroll
            for (int o = 1; o < 16; o <<= 1) { kmx0 = fmaxf(kmx0, shx(kmx0, o, ln_)); kmx1 = fmaxf(kmx1, shx(kmx1, o, ln_)); }
            if (fr == 0) { const int b = u.pm / PPB; unsigned* km = KM + (((b * 8 + (pn - 4) * 2) * 2 + (wc >> 1)) * 8 + (wc & 1) * 4 + fq);
                __hip_atomic_fetch_max(km, __float_as_uint(kmx0), __ATOMIC_RELAXED, __HIP_MEMORY_SCOPE_AGENT); __hip_atomic_fetch_max(km + 16, __float_as_uint(kmx1), __ATOMIC_RELAXED, __HIP_MEMORY_SCOPE_AGENT); } }
        const int col0 = pn * 256 + wc * 32 + 4 * fq;
        const int mode = (pn < 8) ? ((pp != 0) ? 1 : 0) : ((pn >= 12 && pn < 16) ? 2 : 0);
        const float sc = (pn < 4) ? QSCALE : 1.0f;
#pragma unroll
        for (int ai = 0; ai < 2; ++ai) {
          f32x4 csv[4], snv[4];
          if (mode == 1) {
#pragma unroll
              for (int m = 0; m < 4; ++m) { const int rl = ai * 128 + wr * 64 + m * 16 + fr; const int t = (pp - 1) * 256 + rl; const int pos = (wc & 1) ? (t & 63) : (t >> 6); csv[m] = *(const f32x4*)(rc + pos * 16 + 4 * fq); snv[m] = *(const f32x4*)(rs + pos * 16 + 4 * fq); }
              asm volatile("s_waitcnt vmcnt(0)" ::: "memory"); }
#pragma unroll
            for (int m = 0; m < 4; ++m) { const int rl = ai * 128 + wr * 64 + m * 16 + fr; bf16_t* rowp = P + (size_t)(u.pm * 256 + rl) * LDP + col0;
                f32x4 cs = (f32x4){1.f, 1.f, 1.f, 1.f}, sn = (f32x4){0.f, 0.f, 0.f, 0.f};
                if (mode == 1) { cs = csv[m]; sn = snv[m]; }
#pragma unroll
                for (int bj = 0; bj < 2; ++bj) { f32x4 v0 = acc[ai][bj][m][0], v1 = acc[ai][bj][m][1];
                    if (mode == 1) { const f32x4 o0 = v0 * cs - v1 * sn, o1 = v1 * cs + v0 * sn; v0 = o0; v1 = o1; }
                    else if (mode == 2) {
#pragma unroll
                        for (int e = 0; e < 4; ++e) { v0[e] = siluf_(v0[e]); v1[e] = siluf_(v1[e]); } }
                    if (pn >= 24 && pn < 28) {
                        const int cu = (pn - 24) * 256 + bj * 128 + wc * 32 + 8 * fq;
                        bf16_t* u2 = U2 + ((size_t)(cu >> 4) * R + (size_t)(u.pm * 256 + rl)) * 16 + (cu & 15);
                        u32x4 a; a.x = cvt_pk_bf16(v0[0], v0[1]); a.y = cvt_pk_bf16(v0[2], v0[3]); a.z = cvt_pk_bf16(v1[0], v1[1]); a.w = cvt_pk_bf16(v1[2], v1[3]);
                        *(u32x4*)u2 = a; continue; }
                    v0 = v0 * sc; v1 = v1 * sc;
                    if (pn < 8) { u32x2 w0, w1; w0.x = cvt_pk_bf16(v0[0], v0[1]); w0.y = cvt_pk_bf16(v0[2], v0[3]); w1.x = cvt_pk_bf16(v1[0], v1[1]); w1.y = cvt_pk_bf16(v1[2], v1[3]);
                        *(u32x2*)(rowp + bj * 128) = w0; *(u32x2*)(rowp + bj * 128 + 16) = w1; }
                    else { u32x4 w; w.x = cvt_pk_bf16(v0[0], v0[1]); w.y = cvt_pk_bf16(v0[2], v0[3]); w.z = cvt_pk_bf16(v1[0], v1[1]); w.w = cvt_pk_bf16(v1[2], v1[3]);
                        *(u32x4*)(rowp + 4 * fq + bj * 128) = w; } } } }
    }
};
struct EpiGlu {
    static constexpr bool PERM = false;
    bf16_t* P; const float* bias;
    __device__ __forceinline__ void operator()(const f32x4 (&acc)[2][2][4][2], const pg8::Unit& u, int wr, int wc, int, int) const { const int ln_ = lane_now(); const int fr = ln_ & 15, fq = ln_ >> 4;
        const int row0 = u.pm * 256 + wr * 64 + fr, col0 = u.pn * 256 + wc * 32 + 4 * fq;
        f32x4 bv[2][2];
#pragma unroll
        for (int bj = 0; bj < 2; ++bj)
#pragma unroll
            for (int n = 0; n < 2; ++n) bv[bj][n] = *(const f32x4*)(bias + col0 + bj * 128 + n * 16);
#pragma unroll
        for (int ai = 0; ai < 2; ++ai) {
            u32x2 tv[4][2][2];
#pragma unroll
            for (int m = 0; m < 4; ++m)
#pragma unroll
                for (int bj = 0; bj < 2; ++bj)
#pragma unroll
                    for (int n = 0; n < 2; ++n) tv[m][bj][n] = *(const u32x2*)(P + (size_t)(row0 + ai * 128 + m * 16) * LDP + PU + col0 + bj * 128 + n * 16);
            asm volatile("s_waitcnt vmcnt(0)" ::: "memory");
#pragma unroll
            for (int m = 0; m < 4; ++m) { bf16_t* rowp = P + (size_t)(row0 + ai * 128 + m * 16) * LDP;
#pragma unroll
                for (int bj = 0; bj < 2; ++bj)
#pragma unroll
                    for (int n = 0; n < 2; ++n) { const int c = col0 + bj * 128 + n * 16; const u32x2 t = tv[m][bj][n];
                        const f32x4 a = acc[ai][bj][m][n] + bv[bj][n]; u32x2 w;
                        w.x = cvt_pk_bf16(bflo(t.x) * sigmoidf_(a[0]), bfhi(t.x) * sigmoidf_(a[1])); w.y = cvt_pk_bf16(bflo(t.y) * sigmoidf_(a[2]), bfhi(t.y) * sigmoidf_(a[3]));
                        *(u32x2*)(rowp + PK + c) = w; } } }
    }
};
struct EpiMerge {
    static constexpr bool PERM = true;
    const bf16_t* P; bf16_t* MIXB;
    static __device__ __forceinline__ int jmap(int seg) { return seg == 0 ? 0 : (seg == 1 ? 2 : 1); }
    __device__ __forceinline__ const unsigned char* gbase(const pg8::Unit& u, int seg, int wr, int wc, int ln_) const {
        return (const unsigned char*)P - WS_PROJ + gq_off(jmap(seg)) + ((size_t)((u.pm * 8 + u.pn) * 512 + (wr * 4 + wc) * 64 + ln_)) * 128; }
    __device__ __forceinline__ void mid(f32x4 (&acc)[2][2][4][2], const pg8::Unit& u, int seg, int wr, int wc) const {
        const int ln_ = lane_now(); const unsigned char* ga = gbase(u, seg - 1, wr, wc, ln_); const unsigned char* gb = gbase(u, seg, wr, wc, ln_);
        u32x4 a[2][4], b[2][4];
#pragma unroll
        for (int ai = 0; ai < 2; ++ai)
#pragma unroll
            for (int m = 0; m < 4; ++m) { a[ai][m] = *(const u32x4*)(ga + (ai * 4 + m) * 16); b[ai][m] = *(const u32x4*)(gb + (ai * 4 + m) * 16); }
        asm volatile("s_waitcnt vmcnt(0)" ::: "memory");
#pragma unroll
        for (int ai = 0; ai < 2; ++ai)
#pragma unroll
            for (int m = 0; m < 4; ++m)
#pragma unroll
                for (int bj = 0; bj < 2; ++bj)
#pragma unroll
                    for (int n = 0; n < 2; ++n) { const unsigned qa = a[ai][m][bj * 2 + n], qb = b[ai][m][bj * 2 + n]; f32x4 r;
#pragma unroll
                        for (int e = 0; e < 4; ++e) r[e] = (float)((qa >> (8 * e)) & 255u) * __builtin_amdgcn_rcpf((float)((qb >> (8 * e)) & 255u));
                        acc[ai][bj][m][n] = acc[ai][bj][m][n] * r; }
    }
    __device__ __forceinline__ void operator()(const f32x4 (&acc)[2][2][4][2], const pg8::Unit& u, int wr, int wc, int, int) const { const int ln_ = lane_now(); const int fr = ln_ & 15, fq = ln_ >> 4;
        const int row0 = u.pm * 256 + wr * 64 + fr, col0 = u.pn * 256 + wc * 32 + 8 * fq; const unsigned char* gl = gbase(u, 2, wr, wc, ln_);
        u32x4 gq[2][4];
#pragma unroll
        for (int ai = 0; ai < 2; ++ai)
#pragma unroll
            for (int m = 0; m < 4; ++m) gq[ai][m] = *(const u32x4*)(gl + (ai * 4 + m) * 16);
        asm volatile("s_waitcnt vmcnt(0)" ::: "memory");
#pragma unroll
        for (int ai = 0; ai < 2; ++ai)
#pragma unroll
            for (int m = 0; m < 4; ++m) { const size_t row = (size_t)(row0 + ai * 128 + m * 16); const u32x4 g4 = gq[ai][m];
#pragma unroll
                for (int bj = 0; bj < 2; ++bj) { u32x4 w;
#pragma unroll
                    for (int n = 0; n < 2; ++n) { const unsigned gv = g4[bj * 2 + n];
                        f32x4 v = acc[ai][bj][m][n];
#pragma unroll
                        for (int e = 0; e < 4; ++e) v[e] *= (float)((gv >> (8 * e)) & 255u) * (1.0f / 255.0f);
                        w[2 * n] = cvt_pk_bf16(v[0], v[1]); w[2 * n + 1] = cvt_pk_bf16(v[2], v[3]); }
                    *(u32x4*)(MIXB + row * D + col0 + bj * 128) = w; } }
    }
};

struct S5AOrder {
    int G, c; const char* A; const char* B;
    __device__ __forceinline__ bool next(int i, pg8::Unit& u) const {
        const int idx = i * G + c; if (idx >= 640) return false;
        const int g = idx / 10, r = idx - 10 * g, nt = r / 5, mt = r - 5 * nt;
        u.pm = mt; u.pn = nt; u.aux = g; u.kt = 4; u.a = A + ((size_t)g * (R / 16) + (size_t)mt * 256) * 256 * 2; u.b = B + (size_t)(g * 512 + nt * 256) * 256 * 2; return true;
    }
};
struct EpiS5A {
    static constexpr bool PERM = false;
    unsigned char* YLF; bf16_t* ST;
    __device__ __forceinline__ void operator()(const f32x4 (&acc)[2][2][4][2], const pg8::Unit& u, int wr, int wc, int, int) const { const int ln_ = lane_now(); const int fr = ln_ & 15, fq = ln_ >> 4;
        const int g = u.aux;
        if (u.pn == 0) { unsigned char* yl = YLF + ((size_t)((g * 5 + u.pm) * 512 + (wr * 4 + wc) * 64 + ln_)) * 256;
#pragma unroll
            for (int ai = 0; ai < 2; ++ai)
#pragma unroll
                for (int m = 0; m < 4; ++m) { u32x4 w0, w1;
                    w0.x = cvt_pk_bf16(acc[ai][0][m][0][0], acc[ai][0][m][0][1]); w0.y = cvt_pk_bf16(acc[ai][0][m][0][2], acc[ai][0][m][0][3]); w0.z = cvt_pk_bf16(acc[ai][0][m][1][0], acc[ai][0][m][1][1]); w0.w = cvt_pk_bf16(acc[ai][0][m][1][2], acc[ai][0][m][1][3]);
                    w1.x = cvt_pk_bf16(acc[ai][1][m][0][0], acc[ai][1][m][0][1]); w1.y = cvt_pk_bf16(acc[ai][1][m][0][2], acc[ai][1][m][0][3]); w1.z = cvt_pk_bf16(acc[ai][1][m][1][0], acc[ai][1][m][1][1]); w1.w = cvt_pk_bf16(acc[ai][1][m][1][2], acc[ai][1][m][1][3]);
                    *(u32x4*)(yl + (ai * 4 + m) * 32) = w0; *(u32x4*)(yl + (ai * 4 + m) * 32 + 16) = w1; }
            return; }
#pragma unroll
        for (int ai = 0; ai < 2; ++ai)
#pragma unroll
            for (int m = 0; m < 4; ++m) { const int mr = u.pm * 256 + ai * 128 + wr * 64 + m * 16 + fr; if (mr < S5M) {
#pragma unroll
                for (int bj = 0; bj < 2; ++bj)
#pragma unroll
                    for (int n = 0; n < 2; ++n) { const f32x4 v = acc[ai][bj][m][n];
                        u32x2 w; w.x = cvt_pk_bf16(v[0], v[1]); w.y = cvt_pk_bf16(v[2], v[3]); *(u32x2*)(ST + ((size_t)g * S5M + mr) * 256 + bj * 128 + wc * 32 + n * 16 + 4 * fq) = w; } } }
    }
};
struct S5COrder {
    int G, c; const char* A; const char* B;
    __device__ __forceinline__ bool next(int i, pg8::Unit& u) const {
        const int idx = i * G + c; if (idx >= 320) return false;
        const int g = idx / 5, mt = idx - 5 * g;
        u.pm = mt; u.pn = 0; u.aux = g; u.kt = 4; u.a = A + ((size_t)g * 1280 + mt * 256) * 256 * 2; u.b = B + (size_t)g * 256 * 256 * 2; return true;
    }
};
struct EpiS5C {
    static constexpr bool PERM = false;
    const unsigned char* YLF; bf16_t* P;
    __device__ __forceinline__ void operator()(const f32x4 (&acc)[2][2][4][2], const pg8::Unit& u, int wr, int wc, int, int) const { const int ln_ = lane_now(); const int fr = ln_ & 15, fq = ln_ >> 4;
        const int g = u.aux; const unsigned char* yl = YLF + ((size_t)((g * 5 + u.pm) * 512 + (wr * 4 + wc) * 64 + ln_)) * 256;
#pragma unroll
        for (int ai = 0; ai < 2; ++ai) {
        u32x4 y0[2][4], y1[2][4];
#pragma unroll
            for (int m = 0; m < 4; ++m) { y0[ai][m] = *(const u32x4*)(yl + (ai * 4 + m) * 32); y1[ai][m] = *(const u32x4*)(yl + (ai * 4 + m) * 32 + 16); }
        asm volatile("s_waitcnt vmcnt(0)" ::: "memory");
#pragma unroll
            for (int m = 0; m < 4; ++m) { const int mr = u.pm * 256 + ai * 128 + wr * 64 + m * 16 + fr; if (mr < S5M) {
#pragma unroll
                for (int bj = 0; bj < 2; ++bj)
#pragma unroll
                    for (int n = 0; n < 2; ++n) { const int rho = 8 * bj + 2 * wc + n; const size_t row = (size_t)(16 * mr + rho);
                        const u32x4 yy = bj ? y1[ai][m] : y0[ai][m]; const unsigned ya = n ? yy.z : yy.x, yb = n ? yy.w : yy.y; f32x4 v = acc[ai][bj][m][n];
                        v[0] += bflo(ya); v[1] += bfhi(ya); v[2] += bflo(yb); v[3] += bfhi(yb);
#pragma unroll
                        for (int e = 0; e < 4; ++e) { const float x = v[e]; const float inner = 0.7978845608028654f * (x + 0.044715f * x * x * x); const float th = 1.0f - 2.0f * __builtin_amdgcn_rcpf(1.0f + __builtin_amdgcn_exp2f(2.8853900817779268f * inner)); v[e] = 0.5f * x * (1.0f + th); }
                        u32x2 w; w.x = cvt_pk_bf16(v[0], v[1]); w.y = cvt_pk_bf16(v[2], v[3]); *(u32x2*)(P + row * LDP + PU + 16 * g + 4 * fq) = w; } } } }
    }
};

namespace attn128 {
using bf16 = __hip_bfloat16;
constexpr int NW = 8, QBLK = 32, KVBLK = 64, LDQ = LDP, LDK = LDP, LDOB = LDP;
constexpr size_t SHM_V = KVBLK * 128 * 2, SHM_K = KVBLK * 64 * 2, SHM_ATTN = 2 * SHM_V + 2 * SHM_K + NW * 64 * 4, SHM_TOTAL = SHM_ATTN + NW * 8192;
constexpr float THRL = 11.5f;
#define A128_KSWZ(row, colB) ((row) * 128 + ((colB) ^ (((row) & 7) << 4)))
#define A128_SBAR() __builtin_amdgcn_sched_barrier(0)
__device__ __forceinline__ int crow(int r, int hi) { return (r & 3) + 8 * (r >> 2) + 4 * hi; }
template <bool FIRST = false>
__device__ __forceinline__ void partialSM(f32x16& p0, f32x16& p1, float& m_reg, float& mn, float& alpha, const bool nomax) {
  if (nomax) { mn = 0.f; alpha = 1.f;
#pragma unroll
    for (int r = 0; r < 16; ++r) p0[r] = __builtin_amdgcn_exp2f(p0[r]);
    return; }
  float pmax = p0[0];
#pragma unroll
  for (int r = 1; r < 16; ++r) pmax = fmaxf(pmax, p0[r]);
#pragma unroll
  for (int r = 0; r < 16; ++r) pmax = fmaxf(pmax, p1[r]);
  { auto rr = __builtin_amdgcn_permlane32_swap(__float_as_uint(pmax), __float_as_uint(pmax), false, false); pmax = fmaxf(__uint_as_float(rr[0]), __uint_as_float(rr[1])); }
  if (FIRST) { m_reg = (__builtin_fabsf(pmax) <= THRL) ? 0.f : pmax; mn = m_reg; alpha = 1.f; }
  else if (__builtin_expect(__all(pmax - m_reg <= THRL), 1)) { mn = m_reg; alpha = 1.f; }
  else { mn = fmaxf(m_reg, pmax); alpha = __builtin_amdgcn_exp2f(m_reg - mn); m_reg = mn; }
  if (__builtin_expect(__any(mn != 0.f), 0)) {
#pragma unroll
    for (int r = 0; r < 16; ++r) { p0[r] = p0[r] - mn; p1[r] = p1[r] - mn; } }
#pragma unroll
  for (int r = 0; r < 16; ++r) p0[r] = __builtin_amdgcn_exp2f(p0[r]);
}
__device__ __forceinline__ void finishSM(f32x16& p0, f32x16& p1, float alpha, float& l_reg, bf16x8& pa0, bf16x8& pa1, bf16x8& pa2, bf16x8& pa3) {
#pragma unroll
  for (int r = 0; r < 16; ++r) p1[r] = __builtin_amdgcn_exp2f(p1[r]);
  typedef float f32x8_ __attribute__((ext_vector_type(8))); typedef float f32x2_ __attribute__((ext_vector_type(2)));
  const f32x16 s16_ = p0 + p1; const f32x8_ s8_ = s16_.lo + s16_.hi; const f32x4 s4_ = s8_.lo + s8_.hi; const f32x2_ s2_ = s4_.lo + s4_.hi;
  float ps = s2_.x + s2_.y;
  { auto rr = __builtin_amdgcn_permlane32_swap(__float_as_uint(ps), __float_as_uint(ps), false, false); ps = __uint_as_float(rr[0]) + __uint_as_float(rr[1]); }
  l_reg = l_reg * alpha + ps;
#define A128_PK4(P, BASE, OUT) do { u32x4 w = {cvt_pk_bf16(P[BASE + 0], P[BASE + 1]), cvt_pk_bf16(P[BASE + 2], P[BASE + 3]), cvt_pk_bf16(P[BASE + 4], P[BASE + 5]), cvt_pk_bf16(P[BASE + 6], P[BASE + 7])}; \
    OUT = __builtin_bit_cast(bf16x8, w); } while (0)
  A128_PK4(p0, 0, pa0); A128_PK4(p0, 8, pa1); A128_PK4(p1, 0, pa2); A128_PK4(p1, 8, pa3);
#undef A128_PK4
}
__device__ __forceinline__ void qkt(f32x16& p0, f32x16& p1, const char* Ks, const bf16x8* qr, int r32, int hi) {
#pragma unroll
  for (int i = 0; i < 16; ++i) { p0[i] = 0.f; p1[i] = 0.f; }
#pragma unroll
  for (int d0 = 0; d0 < 4; ++d0) { const int cb = (d0 * 16 + hi * 8) * 2;
    const bf16x8 b0 = *reinterpret_cast<const bf16x8*>(Ks + A128_KSWZ(r32, cb));
    const bf16x8 b1 = *reinterpret_cast<const bf16x8*>(Ks + A128_KSWZ(32 + r32, cb));
    p0 = __builtin_amdgcn_mfma_f32_32x32x16_bf16(b0, qr[d0], p0, 0, 0, 0);
    p1 = __builtin_amdgcn_mfma_f32_32x32x16_bf16(b1, qr[d0], p1, 0, 0, 0); }
}
__device__ __forceinline__ int v_st(int k, int c) { const int kk = k; return ((kk >> 3) * 4 + (c >> 5)) * 512 + ((kk & 7) * 32 + (c & 31)) * 2; }
__device__ __forceinline__ int v_rd_base(int lane) { return ((lane & 3) << 3) | (((lane >> 2) & 3) << 6) | (((lane >> 4) & 1) << 5) | (((lane >> 5) & 1) << 8); }
constexpr int v_rd_off(int d0, int ks, int half) { return d0 * 512 + ks * 4096 + half * 2048; }
template <int OFF> __device__ __forceinline__ s16x4 tr_read(int vb) { s16x4 r; asm volatile("ds_read_b64_tr_b16 %0, %1 offset:%2" : "=&v"(r) : "v"(vb), "i"(OFF) : "memory"); return r; }
template <int D0> __device__ __forceinline__ void pv_one(f32x16& od, int vb, bf16x8 pa0, bf16x8 pa1, bf16x8 pa2, bf16x8 pa3) {
  const s16x4 l0 = tr_read<v_rd_off(D0, 0, 0)>(vb), h0 = tr_read<v_rd_off(D0, 0, 1)>(vb), l1 = tr_read<v_rd_off(D0, 1, 0)>(vb), h1 = tr_read<v_rd_off(D0, 1, 1)>(vb);
  const s16x4 l2 = tr_read<v_rd_off(D0, 2, 0)>(vb), h2 = tr_read<v_rd_off(D0, 2, 1)>(vb), l3 = tr_read<v_rd_off(D0, 3, 0)>(vb), h3 = tr_read<v_rd_off(D0, 3, 1)>(vb);
  asm volatile("s_waitcnt lgkmcnt(0)" ::: "memory"); A128_SBAR();
#define A128_PK(L, H) (bf16x8){L[0], L[1], L[2], L[3], H[0], H[1], H[2], H[3]}
  od = __builtin_amdgcn_mfma_f32_32x32x16_bf16(pa0, A128_PK(l0, h0), od, 0, 0, 0);
  od = __builtin_amdgcn_mfma_f32_32x32x16_bf16(pa1, A128_PK(l1, h1), od, 0, 0, 0);
  od = __builtin_amdgcn_mfma_f32_32x32x16_bf16(pa2, A128_PK(l2, h2), od, 0, 0, 0);
  od = __builtin_amdgcn_mfma_f32_32x32x16_bf16(pa3, A128_PK(l3, h3), od, 0, 0, 0);
#undef A128_PK
}
__device__ __forceinline__ void pv_d0(f32x16* o, int vb, bf16x8 pa0, bf16x8 pa1, bf16x8 pa2, bf16x8 pa3) {
  pv_one<0>(o[0], vb, pa0, pa1, pa2, pa3); pv_one<1>(o[1], vb, pa0, pa1, pa2, pa3); pv_one<2>(o[2], vb, pa0, pa1, pa2, pa3); pv_one<3>(o[3], vb, pa0, pa1, pa2, pa3);
}
__device__ __forceinline__ void unit(const bf16* __restrict__ Qb0, const bf16* __restrict__ Kh0, const bf16* __restrict__ Vh, bf16_t* Ob, int seq, char* lds, const int tid_in, const float lam, const float onem, const float* __restrict__ subw, const float* __restrict__ kmb  ) {
#pragma unroll 1
 for (int mp = 0; mp < 2; ++mp) {
  int tid = tid_in; asm volatile("" : "+v"(tid));
  bf16_t* stage = (bf16_t*)(lds + SHM_ATTN) + (tid >> 6) * 4096;
  const bf16* Qb = Qb0 + mp * 64; const bf16* Kh = Kh0 + mp * 64;
  const int wid = __builtin_amdgcn_readfirstlane(tid >> 6), lane = tid & 63, r32 = lane & 31, hi = lane >> 5;
  char* V_lds = lds; char* K_lds = lds + 2 * SHM_V;
  float* ws = (float*)(lds + 2 * SHM_V + 2 * SHM_K) + wid * 64; float* li_l = ws; float* al_l = ws + 32;
  float m_reg = 0.f, l_reg = 0; f32x16 o[4]; bf16x8 qr[4];
#pragma unroll
  for (int d = 0; d < 4; ++d)
#pragma unroll
    for (int r = 0; r < 16; ++r) o[d][r] = 0.f;
  const bf16* Qw = Qb + (long)(wid * QBLK + r32) * LDQ + hi * 8;
#pragma unroll
  for (int d0 = 0; d0 < 4; ++d0) qr[d0] = *reinterpret_cast<const bf16x8*>(Qw + d0 * 16);
  bool nomax;
  { float qn2 = 0.f, kb2 = 0.f;
#pragma unroll
    for (int d0 = 0; d0 < 4; ++d0) { const u32x4 w = __builtin_bit_cast(u32x4, qr[d0]);
#pragma unroll
      for (int e = 0; e < 4; ++e) { const float x0 = bflo(w[e]), x1 = bfhi(w[e]); qn2 += x0 * x0 + x1 * x1; } }
    { auto rr = __builtin_amdgcn_permlane32_swap(__float_as_uint(qn2), __float_as_uint(qn2), false, false); qn2 = __uint_as_float(rr[0]) + __uint_as_float(rr[1]); }
#pragma unroll
    for (int i = 0; i < 8; ++i) kb2 += kmb[mp * 8 + i];
    nomax = __all(qn2 * kb2 * 1.12f <= 3600.0f); }
  const int sr = tid >> 4, sc = (tid & 15) * 8, vst0 = v_st(sr, sc), vst1 = v_st(32 + sr, sc);
  const int kr = tid >> 3, kc = (tid & 7) * 8, kst = A128_KSWZ(kr, kc * 2);
  const int vb0 = (int)(uintptr_t)V_lds + v_rd_base(lane);
  struct { bf16x8 vs0, vs1, ks0; } sr_[2];
#define A128_SLOAD(i, k0) do { sr_[i].vs0 = *reinterpret_cast<const bf16x8*>(&Vh[(long)((k0) + sr) * LDK + sc]); sr_[i].vs1 = *reinterpret_cast<const bf16x8*>(&Vh[(long)((k0) + 32 + sr) * LDK + sc]); \
    sr_[i].ks0 = *reinterpret_cast<const bf16x8*>(&Kh[(long)((k0) + kr) * LDK + kc]); } while (0)
#define A128_SWRITE(b, i) do { *(bf16x8*)(V_lds + (b) * SHM_V + vst0) = sr_[i].vs0; *(bf16x8*)(V_lds + (b) * SHM_V + vst1) = sr_[i].vs1; *(bf16x8*)(K_lds + (b) * SHM_K + kst) = sr_[i].ks0; } while (0)
#define A128_SWAIT() asm volatile("s_waitcnt vmcnt(3)" ::: "memory")
#define A128_RESC(a) do { if (__any((a) < 1.f)) { if (hi == 0) al_l[r32] = (a); asm volatile("s_waitcnt lgkmcnt(0)" ::: "memory"); \
    _Pragma("unroll") for (int d = 0; d < 4; ++d) _Pragma("unroll") for (int r = 0; r < 16; ++r) o[d][r] *= al_l[crow(r, hi)]; } } while (0)
  f32x16 pA0, pA1, pB0, pB1; float mnA, mnB, alA, alB; bf16x8 pa0, pa1, pa2, pa3; const int NT = seq / KVBLK;
  A128_SLOAD(0, 0); asm volatile("s_waitcnt vmcnt(0)" ::: "memory"); A128_SWRITE(0, 0); __syncthreads();
  qkt(pA0, pA1, K_lds, qr, r32, hi); partialSM<true>(pA0, pA1, m_reg, mnA, alA, nomax);
  A128_SLOAD(1, KVBLK); if (2 < NT) A128_SLOAD(0, 2 * KVBLK);
  A128_SWAIT(); A128_SWRITE(1, 1); __syncthreads();
  for (int j = 1; j + 1 < NT; j += 2) {
    A128_SBAR(); qkt(pB0, pB1, K_lds + SHM_K, qr, r32, hi);
    finishSM(pA0, pA1, alA, l_reg, pa0, pa1, pa2, pa3); A128_SBAR();
    A128_SLOAD(1, (j + 2) * KVBLK); A128_SBAR();
    pv_d0(o, vb0, pa0, pa1, pa2, pa3); partialSM(pB0, pB1, m_reg, mnB, alB, nomax);
    __syncthreads(); A128_SWAIT(); A128_SWRITE(0, 0);
    if (!nomax) A128_RESC(alB); __syncthreads();
    A128_SBAR(); qkt(pA0, pA1, K_lds, qr, r32, hi);
    finishSM(pB0, pB1, alB, l_reg, pa0, pa1, pa2, pa3); A128_SBAR();
    if (j + 3 < NT) A128_SLOAD(0, (j + 3) * KVBLK); A128_SBAR();
    pv_d0(o, vb0 + (int)SHM_V, pa0, pa1, pa2, pa3); partialSM(pA0, pA1, m_reg, mnA, alA, nomax);
    __syncthreads(); A128_SWAIT(); A128_SWRITE(1, 1);
    if (!nomax) A128_RESC(alA); __syncthreads();
  }
  A128_SBAR(); qkt(pB0, pB1, K_lds + SHM_K, qr, r32, hi);
  finishSM(pA0, pA1, alA, l_reg, pa0, pa1, pa2, pa3); A128_SBAR();
  pv_d0(o, vb0, pa0, pa1, pa2, pa3); partialSM(pB0, pB1, m_reg, mnB, alB, nomax);
  __syncthreads(); if (!nomax) A128_RESC(alB);
  finishSM(pB0, pB1, alB, l_reg, pa0, pa1, pa2, pa3); A128_SBAR();
  pv_d0(o, vb0 + (int)SHM_V, pa0, pa1, pa2, pa3);
  if (hi == 0) li_l[r32] = l_reg; asm volatile("s_waitcnt lgkmcnt(0)" ::: "memory");
  float rli[16];
#pragma unroll
  for (int r = 0; r < 16; ++r) rli[r] = __builtin_amdgcn_rcpf(li_l[crow(r, hi)]);
  if (mp == 0) {
#pragma unroll
    for (int r = 0; r < 16; ++r)
#pragma unroll
      for (int d0 = 0; d0 < 4; ++d0) stage[(r * 4 + d0) * 64 + lane] = (bf16_t)(cvt_pk_bf16(o[d0][r] * rli[r], 0.f) & 0xffffu);
  } else {
    float ss[16];
#pragma unroll
    for (int r = 0; r < 16; ++r) { float q = 0.f;
#pragma unroll
      for (int d0 = 0; d0 < 4; ++d0) { const float a = bf1(stage[(r * 4 + d0) * 64 + lane]) - lam * bf1((bf16_t)(cvt_pk_bf16(o[d0][r] * rli[r], 0.f) & 0xffffu)); o[d0][r] = a; q += a * a; }
      ss[r] = q; }
#pragma unroll
    for (int m = 1; m < 32; m <<= 1)
#pragma unroll
      for (int r = 0; r < 16; ++r) ss[r] += __int_as_float(__builtin_amdgcn_ds_bpermute((lane ^ m) << 2, __float_as_int(ss[r])));
    float sw[4];
#pragma unroll
    for (int d0 = 0; d0 < 4; ++d0) sw[d0] = subw[d0 * 32 + r32] * onem;
    bf16_t* Ow = Ob + (long)(wid * QBLK) * LDOB;
#pragma unroll
    for (int r = 0; r < 16; ++r) { const int orow = crow(r, hi); const float rs = 1.0f / sqrtf(ss[r] * (1.f / 128.f) + RMS_EPS);
#pragma unroll
      for (int d0 = 0; d0 < 4; ++d0) Ow[(long)orow * LDOB + d0 * 32 + r32] = (bf16_t)(cvt_pk_bf16(o[d0][r] * rs * sw[d0], 0.f) & 0xffffu); }
  }
  __syncthreads();
 }
#undef A128_SLOAD
#undef A128_SWRITE
#undef A128_SWAIT
#undef A128_RESC
}
#undef A128_KSWZ
#undef A128_SBAR
}

#define XB_TMO      128
#define XB_XCNT(j)  (256  + 64 * (j))
#define XB_XSUB(j)  (1280 + 64 * (j))
#define XB_XGEN(j)  (2304 + 64 * (j))
#define XB_TOP      3328
#define XB_TOPGEN   3392
#define XCD_BAR_WORDS 3456
#define XB_SPIN_CAP (1u << 18)
__device__ __forceinline__ unsigned xb_ld(unsigned* p)              { return __hip_atomic_load(p, __ATOMIC_RELAXED, __HIP_MEMORY_SCOPE_AGENT); }
__device__ __forceinline__ unsigned xb_add(unsigned* p, unsigned v) { return __hip_atomic_fetch_add(p, v, __ATOMIC_RELAXED, __HIP_MEMORY_SCOPE_AGENT); }
__device__ __forceinline__ unsigned xb_xcc_id() { return (unsigned)__builtin_amdgcn_s_getreg((3 << 11) | 20) & 0xFu; }
#define XB_SPIN(cond, bar) do { unsigned _sp = 0; while (cond) { __builtin_amdgcn_s_sleep(1); \
    if ((++_sp & 255u) == 0u) { if (xb_ld(&(bar)[XB_TMO])) break; if (_sp > XB_SPIN_CAP) { atomicAdd(&(bar)[XB_TMO], 1u); break; } } } } while (0)
struct XcdBarrier { unsigned* bar; unsigned x; volatile LAS unsigned* st; };
__device__ __forceinline__ XcdBarrier xcd_barrier_post(unsigned* bar, volatile LAS unsigned* st) {
    XcdBarrier b; b.bar = bar; b.x = xb_xcc_id(); b.st = st;
    if (threadIdx.x == 0) (void)xb_add(&bar[XB_XCNT(b.x)], 1u);
    return b;
}
__device__ __forceinline__ void xcd_barrier_complete(unsigned* bar, unsigned x, unsigned& nloc, unsigned& nx) {
    const unsigned G = gridDim.x * gridDim.y * gridDim.z;
    unsigned sum, cnt, mine, sp = 0u;
    for (;;) {
        sum = 0u; cnt = 0u; mine = 0u;
#pragma unroll
        for (unsigned j = 0; j < 16; ++j) { const unsigned c = xb_ld(&bar[XB_XCNT(j)]); sum += c; cnt += (c > 0u) ? 1u : 0u; mine = (j == x) ? c : mine; }
        if (sum == G) break;
        __builtin_amdgcn_s_sleep(1);
        if ((++sp & 255u) == 0u) { if (xb_ld(&bar[XB_TMO])) break; if (sp > XB_SPIN_CAP) { atomicAdd(&bar[XB_TMO], 1u); break; } }
    }
    nloc = mine > 0u ? mine : 1u; nx = cnt > 0u ? cnt : 1u;
}
__device__ __forceinline__ void xcd_barrier(const XcdBarrier& b, const int tid) {
    asm volatile("s_waitcnt vmcnt(0)" ::: "memory");
    __syncthreads();
    if (tid == 0) {
        unsigned* bar = b.bar;
        __builtin_amdgcn_s_waitcnt(0);
        unsigned nloc = b.st[0], nx = b.st[1];
        if (nloc == 0u) { xcd_barrier_complete(bar, b.x, nloc, nx); b.st[0] = nloc; b.st[1] = nx; }
        const unsigned old = xb_add(&bar[XB_XSUB(b.x)], 1u);
        const unsigned gen = old / nloc;
        if (old + 1u == (gen + 1u) * nloc) {
            __builtin_amdgcn_fence(__ATOMIC_RELEASE, "agent");
            asm volatile("s_waitcnt vmcnt(0)" ::: "memory");
            const unsigned og = xb_add(&bar[XB_TOP], 1u);
            const unsigned tg = og / nx;
            if (og + 1u == (tg + 1u) * nx) xb_add(&bar[XB_TOPGEN], 1u);
            else XB_SPIN(xb_ld(&bar[XB_TOPGEN]) == tg, bar);
            __builtin_amdgcn_fence(__ATOMIC_ACQUIRE, "agent");
            xb_add(&bar[XB_XGEN(b.x)], 1u);
            asm volatile("s_waitcnt vmcnt(0)" ::: "memory");
        } else {
            XB_SPIN(xb_ld(&bar[XB_XGEN(b.x)]) == gen, bar);
            __builtin_amdgcn_fence(__ATOMIC_ACQUIRE, "agent");
            asm volatile("s_waitcnt vmcnt(0)" ::: "memory");
        }
    }
    __syncthreads();
}

constexpr int NWAVES = 8;
constexpr int RING_OFF = 0, RING_BYTES = 131072;
constexpr int LDSCTL_OFF = RING_BYTES, MISC_OFF = LDSCTL_OFF + 320;
constexpr int LDS_BYTES = 147456;
static_assert(attn128::SHM_TOTAL <= (size_t)RING_BYTES, "attention scratch fits the ring");

struct Args { const float* in[32]; float* out; unsigned char* ws; int ph_lo, ph_hi; };
constexpr int INTAB_OFF = LDSCTL_OFF + 1024;
__device__ __forceinline__ const float* inptr(LAS unsigned char* lds, int i) {
    const unsigned long long v = ((const LAS unsigned long long*)(lds + INTAB_OFF))[i];
    const unsigned lo = __builtin_amdgcn_readfirstlane((unsigned)v), hi = __builtin_amdgcn_readfirstlane((unsigned)(v >> 32));
    return (const float*)(GAS const float*)(((unsigned long long)hi << 32) | lo);
}
#define INP(i) inptr(F.lds, (i))
struct Frame {
    LAS unsigned char* lds; int tid, lane, wave, vcu, G, gw, NGW;
    unsigned char* ws;
};
enum { I_X = 0, I_C, I_CTX, I_CCTX, I_WMOD, I_BMOD, I_LNG, I_LNB, I_W1, I_W3, I_W2, I_WIN, I_ALAM, I_ASUB, I_CONVW, I_CONVB, I_ALOG, I_DTB, I_SSDD, I_SSDN,
       I_LRE, I_LIM, I_LSTEP, I_BRE, I_BIM, I_CRE, I_CIM, I_S5D, I_GLUW, I_GLUB, I_WBR, I_WOUT };

__device__ __forceinline__ void transpose_item64(const float* srcA, const float* srcB, int ldn, bool p32, bf16_t* dst, int ldk, LAS bf16_t* scr  , int lane, float scale = 1.0f) {
    const int q = lane & 15, kr = lane >> 4; const bool isB = q >= 8; const int c = (q & 7) * 4; const float* src = isB ? srcB : srcA;
    f32x4 v[16];
#pragma unroll
    for (int i = 0; i < 16; ++i) v[i] = src ? *(const f32x4*)(src + (size_t)(4 * i + kr) * ldn + c) : (f32x4){0.f, 0.f, 0.f, 0.f};
    if (scale != 1.0f) {
#pragma unroll
        for (int i = 0; i < 16; ++i) v[i] = v[i] * scale; }
    const int drow = (p32 ? pg8::perm32(c) : c) + (isB ? 32 : 0);
#pragma unroll
    for (int i = 0; i < 16; ++i) { const int k = 4 * i + kr; const unsigned p01 = cvt_pk_bf16(v[i][0], v[i][1]), p23 = cvt_pk_bf16(v[i][2], v[i][3]);
        scr[(drow + 0) * 72 + k] = (bf16_t)(p01 & 0xffffu); scr[(drow + 1) * 72 + k] = (bf16_t)(p01 >> 16); scr[(drow + 2) * 72 + k] = (bf16_t)(p23 & 0xffffu); scr[(drow + 3) * 72 + k] = (bf16_t)(p23 >> 16); }
    LDS_WAIT(); asm volatile("" ::: "memory");
    const int c8 = lane & 7;
#pragma unroll
    for (int jj = 0; jj < 8; ++jj) { const int n = (lane >> 3) + 8 * jj; *(u32x4*)(dst + (size_t)n * ldk + 8 * c8) = *(const LAS u32x4*)(scr + n * 72 + 8 * c8); }
    LDS_WAIT(); asm volatile("" ::: "memory");
}
__device__ __forceinline__ void convert_layer_weights(const Args& A_, Frame& F, int l) {
    LAS bf16_t* scr = (LAS bf16_t*)(F.lds + RING_OFF + F.wave * 16384);
    unsigned char* W = F.ws + WS_W;
    constexpr int I13 = 32 * 176, I2 = 88 * 32, IIN = 32 * 212, IB = 16 * 32, IO = 32 * 32, IG = 16 * 16;
    constexpr int NIT = 2 * I13 + 2 * I2 + IIN + 3 * IB + IO + IG;
    for (int it = F.gw; it < NIT; it += F.NGW) {
        int r = it;
        if (r < 2 * I13) { const int f = r / I13; r -= f * I13; const int kb = r / 176, nb = r % 176;
            const float* wsrc = (((nb & 3) < 2) ? INP(I_W1) : INP(I_W3)) + ((size_t)(l * 2 + f) * D + 64 * kb) * DFF + 128 * (nb >> 2) + 64 * (nb & 1);
            transpose_item64(wsrc, wsrc + 32, DFF, false, (bf16_t*)(W + W_13) + ((size_t)f * N13 + 64 * nb) * D + 64 * kb, D, scr, F.lane, ((nb & 3) < 2) ? -1.4426950408889634f : -0.6931471805599453f); continue; }
        r -= 2 * I13;
        if (r < 2 * I2) { const int f = r / I2; r -= f * I2; const int kb = r / 32, nb = r % 32;
            const float* w2 = INP(I_W2) + ((size_t)(l * 2 + f) * DFF + 64 * kb) * D + 64 * nb;
            transpose_item64(w2, w2 + 32, D, false, (bf16_t*)(W + W_2) + ((size_t)f * D + 64 * nb) * DFF + 64 * kb, DFF, scr, F.lane); continue; }
        r -= 2 * I2;
        if (r < IIN) { const int kb = r / 212, nb = r % 212; const int n0 = 64 * nb; const float* wb = INP(I_WIN) + ((size_t)l * D + 64 * kb) * 13344;
            const float* sa = nullptr; const float* sb = nullptr;
            if (n0 < 6144) { sa = wb + n0; sb = sa + 32; } else if (n0 < 13312) { sa = wb + n0 + 32; sb = sa + 32; } else if (n0 == 13312) { sa = wb + 6144; }
            transpose_item64(sa, sb, 13344, n0 < 2048, (bf16_t*)(W + W_IN) + (size_t)n0 * D + 64 * kb, D, scr, F.lane, (n0 >= PG && n0 < 13312) ? -1.4426950408889634f : 1.0f); continue; }
        r -= IIN;
        if (r < 3 * IB) { const int jb = r / IB; r -= jb * IB; const int kb = r / 32, nb = r % 32;
            const float* w = INP(I_WBR) + ((size_t)(l * 3 + jb) * 1024 + 64 * kb) * D + 64 * nb;
            const int sp = (jb == 0) ? 0 : (jb == 1 ? 2 : 1); transpose_item64(w, w + 32, D, false, (bf16_t*)(W + W_B) + (size_t)(64 * nb) * 3072 + sp * 1024 + 64 * kb, 3072, scr, F.lane); continue; }
        r -= 3 * IB;
        if (r < IO) { const int kb = r / 32, nb = r % 32; const float* w = INP(I_WOUT) + ((size_t)l * D + 64 * kb) * D + 64 * nb;
            transpose_item64(w, w + 32, D, false, (bf16_t*)(W + W_O) + (size_t)(64 * nb) * D + 64 * kb, D, scr, F.lane); continue; }
        r -= IO;
        { const int kb = r / 16, nb = r % 16; const float* w = INP(I_GLUW) + ((size_t)l * 1024 + 64 * kb) * 1024 + 64 * nb;
            transpose_item64(w, w + 32, 1024, false, (bf16_t*)(W + W_GLU) + (size_t)(64 * nb) * 1024 + 64 * kb, 1024, scr, F.lane); }
    }
}
__device__ __forceinline__ void mod_partials(const Args& A_, Frame& F) {
    float* MODw = (float*)(F.ws + WS_MOD);
    LAS float* sl = (LAS float*)(F.lds + RING_OFF + 98304 + F.wave * 4096);
    const int nskip = (F.G > 64) ? 64 : 0; if ((int)blockIdx.x < nskip) return;
    for (int it = ((int)blockIdx.x - nskip) * NWAVES + F.wave; it < 2 * 72 * 16; it += (F.G - nskip) * NWAVES) {
        const int l = it / (72 * 16), r = it % (72 * 16), ks = r / 72, cg = r % 72;
        const int col = cg * 256 + F.lane * 4; const float* w = INP(I_WMOD) + ((size_t)l * D + ks * 128) * NMOD + col;
        const float* c = INP(I_C) + ks * 128; const float* cc = INP(I_CCTX) + ks * 128;
#pragma unroll
        for (int h = 0; h < 2; ++h) { const int k = F.lane + 64 * h;
            sl[0 * 128 + k] = siluf_(c[k]); sl[1 * 128 + k] = siluf_(c[D + k]); sl[2 * 128 + k] = siluf_(c[2 * D + k]); sl[3 * 128 + k] = siluf_(c[3 * D + k]); sl[4 * 128 + k] = siluf_(cc[k]); }
        LDS_WAIT(); asm volatile("" ::: "memory");
        f32x4 a0 = {0.f, 0.f, 0.f, 0.f}, a1 = a0, a2 = a0, a3 = a0, a4 = a0;
        for (int k0 = 0; k0 < 128; k0 += 16) {
            f32x4 wv[16];
#pragma unroll
            for (int e = 0; e < 16; ++e) wv[e] = *(const f32x4*)(w + (size_t)(k0 + e) * NMOD);
            asm volatile("s_waitcnt vmcnt(0)" ::: "memory");
#pragma unroll
            for (int e = 0; e < 16; ++e) { a0 += wv[e] * sl[0 * 128 + k0 + e]; a1 += wv[e] * sl[1 * 128 + k0 + e]; a2 += wv[e] * sl[2 * 128 + k0 + e]; a3 += wv[e] * sl[3 * 128 + k0 + e]; a4 += wv[e] * sl[4 * 128 + k0 + e]; }
        }
        const int r9 = col / D; const float sc = (r9 == 2 || r9 == 8) ? 0.5f : 1.0f;
        if (ks == 0) { const f32x4 bv = *(const f32x4*)(INP(I_BMOD) + (size_t)l * NMOD + col); a0 += bv; a1 += bv; a2 += bv; a3 += bv; a4 += bv; }
        float* o = MODw + (size_t)l * 5 * NMOD + col;
#pragma unroll
        for (int e = 0; e < 4; ++e) { unsafeAtomicAdd(o + e, a0[e] * sc); unsafeAtomicAdd(o + NMOD + e, a1[e] * sc); unsafeAtomicAdd(o + 2 * NMOD + e, a2[e] * sc); unsafeAtomicAdd(o + 3 * NMOD + e, a3[e] * sc); unsafeAtomicAdd(o + 4 * NMOD + e, a4[e] * sc); }
        LDS_WAIT(); asm volatile("" ::: "memory");
    }
}
__device__ __forceinline__ void ln_pass(Frame& F, bool do_ln, const float* lng, const float* lnb, const float* modnext  , float* out, const float* xin = nullptr, const float* cin = nullptr, int nslab = 0, bool skipctx = false) {
#define LNCO(i) (512 * ((i) >> 1) + 8 * F.lane + 4 * ((i) & 1))
    _Float16* H = (_Float16*)(F.ws + WS_H); const float* SL = (const float*)(F.ws + WS_YD); float* HC = (float*)(F.ws + WS_HC); bf16_t* HM = (bf16_t*)(F.ws + WS_HM); float* ST = (float*)(F.ws + WS_STATS);
    f32x4 G[8], Bv[8];
    if (do_ln) {
#pragma unroll
        for (int i = 0; i < 8; ++i) { G[i] = *(const f32x4*)(lng + LNCO(i)); Bv[i] = *(const f32x4*)(lnb + LNCO(i)); }
    }
    const int nper = F.NGW / NB; f32x4 sh4[8], sc4[8];
    for (int it = 0; it < SEQ / nper + 1; ++it) {
        int b = F.gw / nper, rr = CTX + (F.gw % nper) + nper * it;
        if (it == SEQ / nper) { if (skipctx || F.gw >= NB * CTX) break; b = F.gw / CTX; rr = F.gw % CTX; }
        const int row = b * RB + rr; const bool isctx = rr < CTX; const int mi = isctx ? 4 : b;
        float* hc = HC + ((size_t)b * CTX + rr) * D; _Float16* hr = H + (size_t)row * D;
        f32x4 v[8]; float s = 0.f;
        if (xin) { const float* src = isctx ? cin + ((size_t)b * CTX + rr) * D : xin + ((size_t)b * SEQ + (rr - CTX)) * D;
#pragma unroll
            for (int i = 0; i < 8; ++i) v[i] = *(const f32x4*)(src + LNCO(i));
        } else if (isctx) {
#pragma unroll
            for (int i = 0; i < 8; ++i) v[i] = *(const f32x4*)(hc + LNCO(i));
            if (nslab) {
#pragma unroll 1
                for (int q = 0; q < 4; ++q) { f32x4 sv[8];
#pragma unroll
                    for (int i = 0; i < 8; ++i) sv[i] = *(const f32x4*)(SL + ((size_t)q * (NB * CTX) + (size_t)b * CTX + rr) * D + LNCO(i));
#pragma unroll
                    for (int i = 0; i < 8; ++i) v[i] = v[i] + sv[i]; } }
        } else {
#pragma unroll
            for (int k = 0; k < 4; ++k) { const h16x8 h = *(const h16x8*)(hr + LNCO(2 * k)); v[2 * k] = (f32x4){(float)h[0], (float)h[1], (float)h[2], (float)h[3]}; v[2 * k + 1] = (f32x4){(float)h[4], (float)h[5], (float)h[6], (float)h[7]}; }
        }
        if (modnext && (it == 0 || it == SEQ / nper)) { const float* sh = modnext + (size_t)mi * NMOD; const float* sc = sh + D;
#pragma unroll
            for (int i = 0; i < 8; ++i) { sh4[i] = *(const f32x4*)(sh + LNCO(i)); sc4[i] = *(const f32x4*)(sc + LNCO(i)); }
            if (do_ln && !isctx) {
#pragma unroll
                for (int i = 0; i < 8; ++i) { sc4[i] = sc4[i] + 1.0f; sh4[i] = Bv[i] * sc4[i] + sh4[i]; sc4[i] = G[i] * sc4[i]; } } }
        asm volatile("s_waitcnt vmcnt(0)" ::: "memory");
        { const f32x4 sv_ = ((v[0] + v[1]) + (v[2] + v[3])) + ((v[4] + v[5]) + (v[6] + v[7])); s = (sv_[0] + sv_[1]) + (sv_[2] + sv_[3]); }
        if (do_ln) {
            const float mean = wave_sum(s, F.lane) * (1.f / D); float s2 = 0.f;
            f32x4 q4_ = {0.f, 0.f, 0.f, 0.f};
#pragma unroll
            for (int i = 0; i < 8; ++i) { v[i] = v[i] - mean; q4_ = q4_ + v[i] * v[i]; }
            s2 = (q4_[0] + q4_[1]) + (q4_[2] + q4_[3]);
            const float rstd = 1.0f / sqrtf(wave_sum(s2, F.lane) * (1.f / D) + LN_EPS);
            if (!isctx && F.lane == 0) *(f32x2*)(ST + (size_t)row * 2) = (f32x2){mean, rstd};
#pragma unroll
            for (int i = 0; i < 8; ++i) { if (isctx || !modnext || out) { v[i] = v[i] * rstd * G[i] + Bv[i]; if (isctx) *(f32x4*)(hc + LNCO(i)) = v[i] * DN_ALPHA; } else v[i] = v[i] * rstd; }
        } else if (isctx) {
#pragma unroll
            for (int i = 0; i < 8; ++i) *(f32x4*)(hc + LNCO(i)) = v[i] * DN_ALPHA;
        } else {
#pragma unroll
            for (int k = 0; k < 4; ++k) { h16x8 h;
#pragma unroll
                for (int e = 0; e < 4; ++e) { h[e] = (_Float16)v[2 * k][e]; h[4 + e] = (_Float16)v[2 * k + 1][e]; }
                *(h16x8*)(hr + LNCO(2 * k)) = h; }
            if (F.lane == 0) *(f32x2*)(ST + (size_t)row * 2) = (f32x2){0.f, 1.f};
        }
        if (modnext) {
            const bool folded = do_ln && !isctx && !out;
#pragma unroll
            for (int k = 0; k < 4; ++k) { const f32x4 m0 = folded ? v[2 * k] * sc4[2 * k] + sh4[2 * k] : v[2 * k] * (sc4[2 * k] + 1.0f) + sh4[2 * k], m1 = folded ? v[2 * k + 1] * sc4[2 * k + 1] + sh4[2 * k + 1] : v[2 * k + 1] * (sc4[2 * k + 1] + 1.0f) + sh4[2 * k + 1];
                u32x4 w; w.x = cvt_pk_bf16(m0[0], m0[1]); w.y = cvt_pk_bf16(m0[2], m0[3]); w.z = cvt_pk_bf16(m1[0], m1[1]); w.w = cvt_pk_bf16(m1[2], m1[3]); *(u32x4*)(HM + (size_t)row * D + LNCO(2 * k)) = w; }
        }
        if (out && !isctx) { float* orow = out + ((size_t)b * SEQ + (rr - CTX)) * D;
#pragma unroll
            for (int i = 0; i < 8; ++i) *(f32x4*)(orow + LNCO(i)) = v[i]; }
    }
}
#undef LNCO

__device__ __forceinline__ void dt_tile(Frame& F, int l, int tile) {
    const bf16_t* A = (const bf16_t*)(F.ws + WS_HM) + (size_t)tile * 32 * D; const bf16_t* Bt = (const bf16_t*)(F.ws + WS_W + W_IN) + (size_t)13312 * D; float* DT = (float*)(F.ws + WS_DT);
    const int r = F.lane & 31, h = F.lane >> 5;
    f32x16 acc;
#pragma unroll
    for (int i = 0; i < 16; ++i) acc[i] = 0.f;
    const bf16_t* ap = A + (size_t)r * D + 8 * h; const bf16_t* bp = Bt + (size_t)r * D + 8 * h;
    for (int k0 = 0; k0 < 128; k0 += 16) {
        bf16x8 af[16], bfv[16];
#pragma unroll
        for (int e = 0; e < 16; ++e) { af[e] = *(const bf16x8*)(ap + 16 * (k0 + e)); bfv[e] = *(const bf16x8*)(bp + 16 * (k0 + e)); }
#pragma unroll
        for (int e = 0; e < 16; ++e) acc = __builtin_amdgcn_mfma_f32_32x32x16_bf16(af[e], bfv[e], acc, 0, 0, 0);
    }
    const float bias = INP(I_DTB)[l * 32 + r];
#pragma unroll
    for (int rg = 0; rg < 16; ++rg) { const int row = tile * 32 + (rg & 3) + 8 * (rg >> 2) + 4 * h; const float x = acc[rg] + bias; DT[(size_t)row * 32 + r] = fmaxf(x, 0.f) + log1pf(expf(-fabsf(x))); }
}
__device__ __forceinline__ void ssd_conv_pass(const Args& A_, Frame& F, int l) {
    const bf16_t* P = (const bf16_t*)(F.ws + WS_PROJ); bf16_t* XC = (bf16_t*)(F.ws + WS_HM);
    const float* cw = INP(I_CONVW) + (size_t)l * 5 * 2048; const float* cb = INP(I_CONVB) + (size_t)l * 2048;
    for (int it = F.gw; it < (R / 8) * 4; it += F.NGW) {
        const int r0 = (it >> 2) * 8, c0 = (it & 3) * 512 + F.lane * 8; const int rr0 = r0 % RB; const int lo = (rr0 < CTX) ? 0 : CTX, hi = (rr0 < CTX) ? CTX : RB;
        u32x4 x[12];
#pragma unroll
        for (int h = 0; h < 12; ++h) { const int r2 = rr0 + h - 2; x[h] = (r2 >= lo && r2 < hi) ? *(const u32x4*)(P + (size_t)(r0 + h - 2) * LDP + PX + c0) : (u32x4){0u, 0u, 0u, 0u}; }
        f32x4 w0[5], w1[5];
#pragma unroll
        for (int k = 0; k < 5; ++k) { w0[k] = *(const f32x4*)(cw + k * 2048 + c0); w1[k] = *(const f32x4*)(cw + k * 2048 + c0 + 4); }
        const f32x4 b0 = *(const f32x4*)(cb + c0), b1 = *(const f32x4*)(cb + c0 + 4);
#pragma unroll
        for (int jr = 0; jr < 8; ++jr) { f32x4 a0 = b0, a1 = b1;
#pragma unroll
            for (int k = 0; k < 5; ++k) { const u32x4 xv = x[jr + k];
                a0 = a0 + w0[k] * (f32x4){bflo(xv.x), bfhi(xv.x), bflo(xv.y), bfhi(xv.y)};
                a1 = a1 + w1[k] * (f32x4){bflo(xv.z), bfhi(xv.z), bflo(xv.w), bfhi(xv.w)}; }
            u32x4 o; o.x = cvt_pk_bf16(siluf_(a0[0]), siluf_(a0[1])); o.y = cvt_pk_bf16(siluf_(a0[2]), siluf_(a0[3])); o.z = cvt_pk_bf16(siluf_(a1[0]), siluf_(a1[1])); o.w = cvt_pk_bf16(siluf_(a1[2]), siluf_(a1[3]));
            *(u32x4*)(XC + (size_t)(r0 + jr) * 2048 + c0) = o; }
    }
}
__device__ __forceinline__ int scan_row(int rb, int d, int step) { return d == 0 ? rb + step : (step < CTX ? rb + CTX - 1 - step : rb + (RB + CTX - 1) - step); }

__device__ __forceinline__ unsigned short bf16_1(float v) { return (unsigned short)(cvt_pk_bf16(v, 0.f) & 0xffffu); }
__device__ __forceinline__ void ssd_chain_fast(const Args& A_, Frame& F, int l, int cid) {
    constexpr int LS = 136;
    const int b = cid >> 6, d = (cid >> 5) & 1, hd = (cid >> 1) & 15, ph = cid & 1, g = hd >> 2; const int rb = b * RB;
    const bf16_t* XC = (const bf16_t*)(F.ws + WS_HM); const float* DT = (const float*)(F.ws + WS_DT); bf16_t* YD = (bf16_t*)(F.ws + WS_YD) + (size_t)d * R * 1024;
    const float a = -expf(INP(I_ALOG)[l * 32 + d * 16 + hd]);
    LAS bf16_t* Cs = (LAS bf16_t*)(F.lds); LAS bf16_t* Bs = Cs + 128 * LS; LAS bf16_t* Ms = Bs + 128 * LS; LAS bf16_t* XdT = Ms + 128 * LS; LAS bf16_t* Hb = XdT + 32 * LS;
    LAS float* csL = (LAS float*)(Hb + 32 * LS); LAS float* ecsL = csL + 128; LAS float* ewL = ecsL + 128; LAS float* misc = ewL + 128;
    const int tid = F.tid, lane = F.lane, w = F.wave, r = lane & 31, h = lane >> 5;
    f32x16 hacc;
#pragma unroll
    for (int i = 0; i < 16; ++i) hacc[i] = 0.f;
    for (int i = tid; i < 32 * LS / 2; i += 512) ((LAS unsigned*)Hb)[i] = 0u;
    u32x4 pc[4], pb[4], px; float pdt, pv0 = 0.f, pv1 = 0.f;
    const int rho0 = d ? 127 - lane : lane, rho1 = d ? 63 - lane : 64 + lane;
#define SSD_R0(k_) ((d == 0) ? rb + 128 * (k_) : ((k_) < 2 ? rb + 128 * (1 - (k_)) : rb + 256 + 128 * (33 - (k_))))
#define SSD_ISSUE(k_) do { const int r0n = SSD_R0(k_); \
        _Pragma("unroll") for (int i = 0; i < 4; ++i) { const int item = tid + 512 * i, row = item >> 4, seg = item & 15; const bf16_t* src = XC + (size_t)(r0n + row) * 2048 + g * 128 + seg * 8; pc[i] = *(const u32x4*)(src + 1536); pb[i] = *(const u32x4*)(src + 1024); } \
        { const int row = tid >> 2, seg = tid & 3; pdt = DT[(size_t)(r0n + row) * 32 + d * 16 + hd]; px = *(const u32x4*)(XC + (size_t)(r0n + row) * 2048 + hd * 64 + ph * 32 + seg * 8); } \
        if (w == 0) { pv0 = DT[(size_t)(r0n + rho0) * 32 + d * 16 + hd]; pv1 = DT[(size_t)(r0n + rho1) * 32 + d * 16 + hd]; } } while (0)
    SSD_ISSUE(0);
    unsigned ypk[8]; int yrow = -1;
#pragma unroll
    for (int i = 0; i < 8; ++i) ypk[i] = 0u;
#define SSD_YFLUSH() do { if (w < 4 && yrow >= 0) { bf16_t* yo = YD + (size_t)yrow * 1024 + hd * 64 + ph * 32 + r; \
        _Pragma("unroll") for (int rg = 0; rg < 16; ++rg) yo[(size_t)((rg & 3) + 8 * (rg >> 2)) * 1024] = (bf16_t)((rg & 1) ? (ypk[rg >> 1] >> 16) : (ypk[rg >> 1] & 0xffffu)); } } while (0)
    for (int k = 0; k < 34; ++k) {
        const int r0 = SSD_R0(k);
        __syncthreads();
#pragma unroll
        for (int i = 0; i < 4; ++i) { const int item = tid + 512 * i, row = item >> 4, seg = item & 15; *(LAS u32x4*)(Cs + row * LS + seg * 8) = pc[i]; *(LAS u32x4*)(Bs + row * LS + seg * 8) = pb[i]; }
        { const int row = tid >> 2, seg = tid & 3; const float dtv = pdt; const u32x4 xv = px;
            LAS bf16_t* xo = XdT + (seg * 8) * LS + row;
            xo[0 * LS] = bf16_1(bflo(xv.x) * dtv); xo[1 * LS] = bf16_1(bfhi(xv.x) * dtv); xo[2 * LS] = bf16_1(bflo(xv.y) * dtv); xo[3 * LS] = bf16_1(bfhi(xv.y) * dtv);
            xo[4 * LS] = bf16_1(bflo(xv.z) * dtv); xo[5 * LS] = bf16_1(bfhi(xv.z) * dtv); xo[6 * LS] = bf16_1(bflo(xv.w) * dtv); xo[7 * LS] = bf16_1(bfhi(xv.w) * dtv); }
        if (w == 0) {
            float v0 = pv0 * a, v1 = pv1 * a;
#pragma unroll
            for (int o = 1; o < 64; o <<= 1) { const float t0 = __int_as_float(__builtin_amdgcn_ds_bpermute((lane - o) << 2, __float_as_int(v0))), t1 = __int_as_float(__builtin_amdgcn_ds_bpermute((lane - o) << 2, __float_as_int(v1))); if (lane >= o) { v0 += t0; v1 += t1; } }
            const float tot0 = __int_as_float(__builtin_amdgcn_ds_bpermute(63 << 2, __float_as_int(v0))); v1 += tot0;
            const float cend = __int_as_float(__builtin_amdgcn_ds_bpermute(63 << 2, __float_as_int(v1)));
            csL[rho0] = v0 * 1.4426950408889634f; csL[rho1] = v1 * 1.4426950408889634f; ecsL[rho0] = __builtin_amdgcn_exp2f(v0 * 1.4426950408889634f); ecsL[rho1] = __builtin_amdgcn_exp2f(v1 * 1.4426950408889634f);
            ewL[rho0] = __builtin_amdgcn_exp2f((cend - v0) * 1.4426950408889634f); ewL[rho1] = __builtin_amdgcn_exp2f((cend - v1) * 1.4426950408889634f);
            if (lane == 0) misc[0] = __builtin_amdgcn_exp2f(cend * 1.4426950408889634f);
        }
        if (k + 1 < 34) SSD_ISSUE(k + 1);
        __syncthreads();
        { const int lt = w >> 1;
#pragma unroll
          for (int q = 0; q < 2; ++q) { const int st = (w & 1) * 2 + q; const bool zero = (d == 0) ? (st > lt) : (st < lt);
            if (zero) continue;
            f32x16 acc;
#pragma unroll
            for (int i = 0; i < 16; ++i) acc[i] = 0.f;
            { bf16x8 af[8], bfv[8];
#pragma unroll
                for (int ks = 0; ks < 8; ++ks) { af[ks] = *(const LAS bf16x8*)(Cs + (32 * lt + r) * LS + 16 * ks + 8 * h); bfv[ks] = *(const LAS bf16x8*)(Bs + (32 * st + r) * LS + 16 * ks + 8 * h); }
#pragma unroll
                for (int ks = 0; ks < 8; ++ks) acc = __builtin_amdgcn_mfma_f32_32x32x16_bf16(bfv[ks], af[ks], acc, 0, 0, 0); }
            const int lrow = 32 * lt + r; const float crl = csL[lrow];
            f32x4 cs4[4];
#pragma unroll
            for (int q4 = 0; q4 < 4; ++q4) cs4[q4] = *(const LAS f32x4*)(csL + 32 * st + 8 * q4 + 4 * h);
#pragma unroll
            for (int q4 = 0; q4 < 4; ++q4) { float v4[4];
#pragma unroll
                for (int e = 0; e < 4; ++e) { const int scol = 32 * st + 8 * q4 + 4 * h + e; const bool valid = (d == 0) ? (scol <= lrow) : (scol >= lrow);
                    const float ex = __builtin_amdgcn_exp2f(crl - cs4[q4][e]);
                    v4[e] = valid ? acc[4 * q4 + e] * ex : 0.f; }
                u32x2 w; w.x = cvt_pk_bf16(v4[0], v4[1]); w.y = cvt_pk_bf16(v4[2], v4[3]);
                *(LAS u32x2*)(Ms + lrow * LS + 32 * st + 8 * q4 + 4 * h) = w; } } }
        __syncthreads();
        if (w < 4) { const int lt = w;
            f32x16 acc;
#pragma unroll
            for (int i = 0; i < 16; ++i) acc[i] = 0.f;
            { bf16x8 af[8], bfv[8];
#pragma unroll
              for (int ks = 0; ks < 8; ++ks) { af[ks] = *(const LAS bf16x8*)(Cs + (32 * lt + r) * LS + 16 * ks + 8 * h); bfv[ks] = *(const LAS bf16x8*)(Hb + r * LS + 16 * ks + 8 * h); }
#pragma unroll
              for (int ks = 0; ks < 8; ++ks) acc = __builtin_amdgcn_mfma_f32_32x32x16_bf16(af[ks], bfv[ks], acc, 0, 0, 0); }
            { f32x4 e4[4];
#pragma unroll
              for (int q4 = 0; q4 < 4; ++q4) e4[q4] = *(const LAS f32x4*)(ecsL + 32 * lt + 8 * q4 + 4 * h);
#pragma unroll
              for (int rg = 0; rg < 16; ++rg) acc[rg] *= e4[rg >> 2][rg & 3]; }
            { bf16x8 af[8], bfv[8];
#pragma unroll
              for (int ks = 0; ks < 8; ++ks) { af[ks] = *(const LAS bf16x8*)(Ms + (32 * lt + r) * LS + 16 * ks + 8 * h); bfv[ks] = *(const LAS bf16x8*)(XdT + r * LS + 16 * ks + 8 * h); }
#pragma unroll
              for (int ks = 0; ks < 8; ++ks) { const bool skip = (d == 0) ? (16 * ks >= 32 * (lt + 1)) : (16 * ks + 15 < 32 * lt);
                  if (!skip) acc = __builtin_amdgcn_mfma_f32_32x32x16_bf16(af[ks], bfv[ks], acc, 0, 0, 0); } }
            bf16_t* yo = YD + (size_t)(r0 + 32 * lt + 4 * h) * 1024 + hd * 64 + ph * 32 + r;
#pragma unroll
            for (int rg = 0; rg < 16; ++rg) yo[(size_t)((rg & 3) + 8 * (rg >> 2)) * 1024] = bf16_1(acc[rg]);
        } else { const int nt = w - 4; const float eend = misc[0];
#pragma unroll
            for (int i = 0; i < 16; ++i) hacc[i] *= eend;
            { typedef short v4i16_t_ __attribute__((ext_vector_type(4)));
#pragma unroll
              for (int kh = 0; kh < 2; ++kh) {
              u32x4 xa[8]; f32x4 e0[8], e1[8]; s16x4 t0[8], t1[8];
#pragma unroll
              for (int ks = 4 * kh; ks < 4 * kh + 4; ++ks) { const int k0 = 16 * ks + 8 * h; xa[ks] = *(const LAS u32x4*)(XdT + r * LS + k0); e0[ks] = *(const LAS f32x4*)(ewL + k0); e1[ks] = *(const LAS f32x4*)(ewL + k0 + 4);
                  const LAS bf16_t* tb = Bs + (k0 + ((lane & 15) >> 2)) * LS + 32 * nt + 16 * ((lane >> 4) & 1) + 4 * (lane & 3);
                  t0[ks] = __builtin_bit_cast(s16x4, __builtin_amdgcn_ds_read_tr16_b64_v4i16((LAS v4i16_t_*)tb)); t1[ks] = __builtin_bit_cast(s16x4, __builtin_amdgcn_ds_read_tr16_b64_v4i16((LAS v4i16_t_*)(tb + 4 * LS))); }
#pragma unroll
              for (int ks = 4 * kh; ks < 4 * kh + 4; ++ks) { u32x4 aw;
                  aw.x = cvt_pk_bf16(bflo(xa[ks].x) * e0[ks][0], bfhi(xa[ks].x) * e0[ks][1]); aw.y = cvt_pk_bf16(bflo(xa[ks].y) * e0[ks][2], bfhi(xa[ks].y) * e0[ks][3]); aw.z = cvt_pk_bf16(bflo(xa[ks].z) * e1[ks][0], bfhi(xa[ks].z) * e1[ks][1]); aw.w = cvt_pk_bf16(bflo(xa[ks].w) * e1[ks][2], bfhi(xa[ks].w) * e1[ks][3]);
                  const bf16x8 bw = (bf16x8){t0[ks][0], t0[ks][1], t0[ks][2], t0[ks][3], t1[ks][0], t1[ks][1], t1[ks][2], t1[ks][3]};
                  hacc = __builtin_amdgcn_mfma_f32_32x32x16_bf16(bw, __builtin_bit_cast(bf16x8, aw), hacc, 0, 0, 0); } } }
        }
        __syncthreads();
        if (w >= 4) { const int nt = w - 4;
#pragma unroll
            for (int q4 = 0; q4 < 4; ++q4) { u32x2 wv_; wv_.x = cvt_pk_bf16(hacc[4 * q4], hacc[4 * q4 + 1]); wv_.y = cvt_pk_bf16(hacc[4 * q4 + 2], hacc[4 * q4 + 3]);
                *(LAS u32x2*)(Hb + r * LS + 32 * nt + 8 * q4 + 4 * h) = wv_; } }
    }
    __syncthreads();
#undef SSD_R0
#undef SSD_ISSUE
#undef SSD_YFLUSH
}
__device__ __forceinline__ void s5_setup(const Args& A_, Frame& F, int l, int boff = 0) {
    LAS float* Pre = (LAS float*)(F.lds); LAS float* Pim = Pre + 2 * 17 * 64; LAS float* BBr = Pim + 2 * 17 * 64; LAS float* BBi = BBr + 2 * 64 * 16; LAS float* Kt = BBi + 2 * 64 * 16;
    LAS float* CrL = Kt + 8192; LAS float* CiL = CrL + 2048; LAS float* CrT = CiL + 2048; LAS float* CiT = CrT + 2048;
    bf16_t* Bt1 = (bf16_t*)(F.ws + WS_S5M); bf16_t* Bt2 = Bt1 + (size_t)64 * 512 * 256; float* A16 = (float*)(F.ws + WS_S5A);
    const int tid = F.tid;
    for (int g = (int)blockIdx.x - boff; g >= 0 && g < 64; g += F.G) {
        { f32x4 c4[2];
#pragma unroll
          for (int h = 0; h < 2; ++h) { const int e4 = tid * 4 & 1023, d = (tid >> 8); const int pg_ = (l * 2 + d) * 64 + g; c4[h] = *(const f32x4*)((h ? INP(I_CIM) : INP(I_CRE)) + (size_t)pg_ * 1024 + e4); }
          *(LAS f32x4*)(CrL + tid * 4) = c4[0]; *(LAS f32x4*)(CiL + tid * 4) = c4[1];
          const int d = tid >> 8, o = (tid & 255) >> 4, n4 = (tid & 15) * 4;
#pragma unroll
          for (int e = 0; e < 4; ++e) { CrT[(d * 64 + n4 + e) * 16 + o] = c4[0][e]; CiT[(d * 64 + n4 + e) * 16 + o] = c4[1][e]; } }
        for (int q = tid; q < 2 * 17 * 64; q += 512) { const int d = q / (17 * 64), dl = (q >> 6) % 17, n = q & 63; const int pg_ = (l * 2 + d) * 64 + g;
            const float lre = INP(I_LRE)[pg_ * 64 + n], lim = INP(I_LIM)[pg_ * 64 + n], step = expf(INP(I_LSTEP)[pg_]);
            const float mag = expf(lre * step * (float)dl), ang = lim * step * (float)dl; Pre[q] = mag * cosf(ang); Pim[q] = mag * sinf(ang); }
        __syncthreads();
        if (tid < 128) { const int d = tid >> 6, n = tid & 63; const int pg_ = (l * 2 + d) * 64 + g;
            const float lre = INP(I_LRE)[pg_ * 64 + n], lim = INP(I_LIM)[pg_ * 64 + n];
            const float abr = Pre[(d * 17 + 1) * 64 + n], abi = Pim[(d * 17 + 1) * 64 + n];
            const float den = lre * lre + lim * lim; const float kre = ((abr - 1.f) * lre + abi * lim) / den, kim = (abi * lre - (abr - 1.f) * lim) / den;
            const float* br = INP(I_BRE) + ((size_t)pg_ * 64 + n) * 16; const float* bi = INP(I_BIM) + ((size_t)pg_ * 64 + n) * 16;
            f32x4 bq[4], bz[4];
#pragma unroll
            for (int q = 0; q < 4; ++q) { bq[q] = *(const f32x4*)(br + 4 * q); bz[q] = *(const f32x4*)(bi + 4 * q); }
#pragma unroll
            for (int i = 0; i < 16; ++i) { const float x = bq[i >> 2][i & 3], y = bz[i >> 2][i & 3]; BBr[(d * 64 + n) * 16 + i] = kre * x - kim * y; BBi[(d * 64 + n) * 16 + i] = kre * y + kim * x; }
            A16[((d * 64 + g) * 64 + n) * 2] = Pre[(d * 17 + 16) * 64 + n]; A16[((d * 64 + g) * 64 + n) * 2 + 1] = Pim[(d * 17 + 16) * 64 + n]; }
        __syncthreads();
        { const int d = tid >> 8, dl = (tid >> 4) & 15, i = tid & 15;
            f32x4 acc[4] = {{0.f, 0.f, 0.f, 0.f}, {0.f, 0.f, 0.f, 0.f}, {0.f, 0.f, 0.f, 0.f}, {0.f, 0.f, 0.f, 0.f}};
            for (int n = 0; n < 64; ++n) { const float pr = Pre[(d * 17 + dl) * 64 + n], pi = Pim[(d * 17 + dl) * 64 + n], br = BBr[(d * 64 + n) * 16 + i], bi = BBi[(d * 64 + n) * 16 + i];
                const float tr = pr * br - pi * bi, ti = pr * bi + pi * br;
#pragma unroll
                for (int o4 = 0; o4 < 4; ++o4) { const f32x4 cr = *(const LAS f32x4*)(CrT + (d * 64 + n) * 16 + 4 * o4), ci = *(const LAS f32x4*)(CiT + (d * 64 + n) * 16 + 4 * o4); acc[o4] += cr * tr - ci * ti; } }
#pragma unroll
            for (int o = 0; o < 16; ++o) Kt[((d * 16 + dl) * 16 + o) * 16 + i] = acc[o >> 2][o & 3]; }
        __syncthreads();
        const float dsk = INP(I_S5D)[l * 1024 + 16 * g + (tid & 15)];
        for (int q = 0; q < 16; ++q) { const int item = tid + 512 * q; const int c1 = item >> 5, kb = (item & 31) * 8; const int rin = kb >> 4, i0 = kb & 15, rout = c1 >> 4, o = c1 & 15;
            const float dsko = __int_as_float(__builtin_amdgcn_ds_bpermute((((F.lane & ~15) | o)) << 2, __float_as_int(dsk)));
            float v[8];
#pragma unroll
            for (int e = 0; e < 8; ++e) { const int i = i0 + e; float x = 0.f; if (rout >= rin) x += Kt[((0 * 16 + (rout - rin)) * 16 + o) * 16 + i]; if (rin >= rout) x += Kt[((1 * 16 + (rin - rout)) * 16 + o) * 16 + i];
                if (rin == rout && i == o) x += dsko; v[e] = x; }
            u32x4 w; w.x = cvt_pk_bf16(v[0], v[1]); w.y = cvt_pk_bf16(v[2], v[3]); w.z = cvt_pk_bf16(v[4], v[5]); w.w = cvt_pk_bf16(v[6], v[7]);
            *(u32x4*)(Bt1 + ((size_t)g * 512 + c1) * 256 + kb) = w; }
        for (int q = 0; q < 16; ++q) { const int item = tid + 512 * q; const int c1 = item >> 5, kb = (item & 31) * 8; const int rin = kb >> 4, i0 = kb & 15; const int d = c1 >> 7, part = c1 & 1, n = (c1 >> 1) & 63;
            const int ex = (d == 0) ? 15 - rin : rin; const float pr = Pre[(d * 17 + ex) * 64 + n], pi = Pim[(d * 17 + ex) * 64 + n];
            float v[8];
#pragma unroll
            for (int e = 0; e < 8; ++e) { const float br = BBr[(d * 64 + n) * 16 + i0 + e], bi = BBi[(d * 64 + n) * 16 + i0 + e]; v[e] = part ? (pr * bi + pi * br) : (pr * br - pi * bi); }
            u32x4 w; w.x = cvt_pk_bf16(v[0], v[1]); w.y = cvt_pk_bf16(v[2], v[3]); w.z = cvt_pk_bf16(v[4], v[5]); w.w = cvt_pk_bf16(v[6], v[7]);
            *(u32x4*)(Bt1 + ((size_t)g * 512 + 256 + c1) * 256 + kb) = w; }
        for (int q = 0; q < 16; ++q) { const int item = tid + 512 * q; const int c2 = item >> 5, kb = (item & 31) * 8; const int rout = c2 >> 4, o = c2 & 15; const int d = kb >> 7, part = (kb >> 6) & 1, n0 = kb & 63;
            const int ex = (d == 0) ? rout + 1 : 16 - rout; const LAS float* cr = CrL + (d * 16 + o) * 64 + n0; const LAS float* ci = CiL + (d * 16 + o) * 64 + n0;
            float v[8];
#pragma unroll
            for (int e = 0; e < 8; ++e) { const float pr = Pre[(d * 17 + ex) * 64 + n0 + e], pi = Pim[(d * 17 + ex) * 64 + n0 + e]; v[e] = part ? -(cr[e] * pi + ci[e] * pr) : (cr[e] * pr - ci[e] * pi); }
            u32x4 w; w.x = cvt_pk_bf16(v[0], v[1]); w.y = cvt_pk_bf16(v[2], v[3]); w.z = cvt_pk_bf16(v[4], v[5]); w.w = cvt_pk_bf16(v[6], v[7]);
            *(u32x4*)(Bt2 + ((size_t)g * 256 + c2) * 256 + kb) = w; }
        __syncthreads();
    }
}
__device__ __forceinline__ void s5_carry(Frame& F, int cid) {
    const int b = cid >> 7, d = (cid >> 6) & 1, g = cid & 63, n = F.lane;
    const unsigned* ST = (const unsigned*)((const bf16_t*)(F.ws + WS_S5ST) + ((size_t)g * S5M + b * 272) * 256 + d * 128) + n;
    bf16_t* HP = (bf16_t*)(F.ws + WS_S5H) + ((size_t)g * 1280 + b * 272) * 256 + d * 128 + n;
    const float* A16 = (const float*)(F.ws + WS_S5A); const float ar = A16[((d * 64 + g) * 64 + n) * 2], ai = A16[((d * 64 + g) * 64 + n) * 2 + 1];
    float hr = 0.f, hi_ = 0.f;
    for (int k0 = 0; k0 < 272; k0 += 34) {
        unsigned wv[34];
#pragma unroll
        for (int e = 0; e < 34; ++e) { const int k = k0 + e; const int cc = (d == 0) ? k : (k < 16 ? 15 - k : 287 - k); wv[e] = ST[(size_t)cc * 128]; }
        asm volatile("s_waitcnt vmcnt(0)" ::: "memory");
#pragma unroll
        for (int e = 0; e < 34; ++e) { const int k = k0 + e; const int cc = (d == 0) ? k : (k < 16 ? 15 - k : 287 - k);
            HP[(size_t)cc * 256] = (bf16_t)(cvt_pk_bf16(hr, 0.f) & 0xffffu); HP[(size_t)cc * 256 + 64] = (bf16_t)(cvt_pk_bf16(hi_, 0.f) & 0xffffu);
            const float sr = bflo(wv[e]), si = bfhi(wv[e]); const float nr = ar * hr - ai * hi_ + sr, ni = ar * hi_ + ai * hr + si; hr = nr; hi_ = ni; }
    }
}
__device__ __forceinline__ void mixer_finalize(const Args& A_, Frame& F, int l) {
    bf16_t* P = (bf16_t*)(F.ws + WS_PROJ);
    const bf16_t* XC = (const bf16_t*)(F.ws + WS_HM); const bf16_t* YD0 = (const bf16_t*)(F.ws + WS_YD); const bf16_t* YD1 = YD0 + (size_t)R * 1024;
        const int c0 = F.lane * 16;
    for (int row = F.gw; row < R; row += F.NGW) {
        { const float dsk = INP(I_SSDD)[l * 16 + (c0 >> 6)];
          const float* nwp = INP(I_SSDN) + l * 1024 + c0;
          f32x4 vv[4];
#define UNP_LO(q_) ((f32x4){bflo((q_).x), bfhi((q_).x), bflo((q_).y), bfhi((q_).y)})
#define UNP_HI(q_) ((f32x4){bflo((q_).z), bfhi((q_).z), bflo((q_).w), bfhi((q_).w)})
#pragma unroll
          for (int hh = 0; hh < 2; ++hh) { const u32x4 x = *(const u32x4*)(XC + (size_t)row * 2048 + c0 + 8 * hh), y0 = *(const u32x4*)(YD0 + (size_t)row * 1024 + c0 + 8 * hh), y1 = *(const u32x4*)(YD1 + (size_t)row * 1024 + c0 + 8 * hh), z = *(const u32x4*)(P + (size_t)row * LDP + PZ + c0 + 8 * hh);
              vv[2 * hh] = (UNP_LO(x) * dsk + UNP_LO(y0) + UNP_LO(y1)) * UNP_LO(z); vv[2 * hh + 1] = (UNP_HI(x) * dsk + UNP_HI(y0) + UNP_HI(y1)) * UNP_HI(z); }
#undef UNP_LO
#undef UNP_HI
          const f32x4 q4_ = (vv[0] * vv[0] + vv[1] * vv[1]) + (vv[2] * vv[2] + vv[3] * vv[3]);
          float ss = (q4_[0] + q4_[1]) + (q4_[2] + q4_[3]);
          ss += shx(ss, 1, F.lane); ss += shx(ss, 2, F.lane); ss += shx(ss, 4, F.lane); ss += shx(ss, 8, F.lane);
          const float rs = 1.0f / sqrtf(ss * (1.f / 256.f) + RMS_EPS);
          const f32x4 n0 = *(const f32x4*)(nwp), n1 = *(const f32x4*)(nwp + 4), n2 = *(const f32x4*)(nwp + 8), n3 = *(const f32x4*)(nwp + 12);
          const f32x4 r0 = vv[0] * rs * n0, r1 = vv[1] * rs * n1, r2 = vv[2] * rs * n2, r3 = vv[3] * rs * n3;
          u32x4 o0, o1;
          o0.x = cvt_pk_bf16(r0[0], r0[1]); o0.y = cvt_pk_bf16(r0[2], r0[3]); o0.z = cvt_pk_bf16(r1[0], r1[1]); o0.w = cvt_pk_bf16(r1[2], r1[3]);
          o1.x = cvt_pk_bf16(r2[0], r2[1]); o1.y = cvt_pk_bf16(r2[2], r2[3]); o1.z = cvt_pk_bf16(r3[0], r3[1]); o1.w = cvt_pk_bf16(r3[2], r3[3]);
          *(u32x4*)(P + (size_t)row * LDP + PV + c0) = o0; *(u32x4*)(P + (size_t)row * LDP + PV + c0 + 8) = o1; }
    }
}


__global__ void __launch_bounds__(NWAVES * 64, 2) trunk_fwd(Args args) {
    extern __shared__ __attribute__((aligned(16))) unsigned char lds_raw[];
    Frame F;
    F.lds = (LAS unsigned char*)lds_raw;
    F.tid = threadIdx.x; F.lane = F.tid & 63; F.wave = __builtin_amdgcn_readfirstlane(F.tid >> 6);
    F.G = gridDim.x; { const int bx = blockIdx.x; F.vcu = (F.G % 8 == 0) ? (bx % 8) * (F.G / 8) + bx / 8 : bx; }
    F.gw = F.vcu * NWAVES + F.wave; F.NGW = F.G * NWAVES;
    F.ws = args.ws;
    volatile LAS unsigned* MISC = (volatile LAS unsigned*)(F.lds + MISC_OFF);
    for (int u = F.tid; u < (LDS_BYTES - LDSCTL_OFF) / 4; u += NWAVES * 64) ((LAS unsigned*)(F.lds + LDSCTL_OFF))[u] = 0u;
    __syncthreads();
    if (threadIdx.x < 32) ((LAS unsigned long long*)(F.lds + INTAB_OFF))[threadIdx.x] = (unsigned long long)args.in[threadIdx.x];
    __syncthreads();
    (void)xcd_barrier_post((unsigned*)(args.ws + WS_CTL) + CW_BAR, MISC + 8);
    const int lo = args.ph_lo, hi = args.ph_hi;
    const int wave0 = __builtin_amdgcn_readfirstlane((int)threadIdx.x >> 6);
    int pid = 0;
#define PH_BEGIN if (pid >= lo && pid < hi) { GAS unsigned char* wsg_ = (GAS unsigned char*)args.ws; int tid_; asm volatile("v_mbcnt_lo_u32_b32 %1, -1, 0\n\tv_mbcnt_hi_u32_b32 %1, -1, %1 ; PHASE_MARK_BEGIN %2" : "+s"(wsg_), "=v"(tid_) : "i"(__LINE__) : "memory"); tid_ += wave0 * 64; unsigned char* ws = (unsigned char*)wsg_; F.ws = ws; F.tid = tid_; F.lane = tid_ & 63; F.wave = __builtin_amdgcn_readfirstlane(tid_ >> 6); F.gw = F.vcu * NWAVES + F.wave;
#define PH_END   asm volatile("; PHASE_MARK_END %0" :: "i"(__LINE__)); if (pid + 1 < hi) { XcdBarrier bar_; bar_.bar = (unsigned*)(args.ws + WS_CTL) + CW_BAR; bar_.x = xb_xcc_id(); bar_.st = (volatile LAS unsigned*)(F.lds + MISC_OFF) + 8; xcd_barrier(bar_, wave0 * 64 + lane_now()); } } ++pid;

#define MOD ((float*)(ws + WS_MOD))
#define Hbuf ((float*)(ws + WS_H))
#define HM ((bf16_t*)(ws + WS_HM))
#define PROJ ((bf16_t*)(ws + WS_PROJ))
#define ROPEC ((float*)(ws + WS_ROPE))
#define ROPES (ROPEC + 1024)
#define WGT (ws + WS_W)

    PH_BEGIN
        s5_setup(args, F, 0);
        mod_partials(args, F);
        if ((int)blockIdx.x == F.G - 1) {
            { float* idn = (float*)(ws + WS_IDENT); for (int i = F.tid; i < 2048; i += NWAVES * 64) { idn[i] = 1.0f; idn[2048 + i] = 0.0f; } }
#pragma unroll
            for (int i2 = 0; i2 < 2; ++i2) { const int idx = (F.wave * 2 + i2) * 64 + F.lane, pos = idx >> 4, f = idx & 15; const float inv = powf(10000.0f, -(float)f / 16.0f); const float ang = (float)pos * inv; ROPEC[idx] = cosf(ang); ROPES[idx] = sinf(ang); } }
    PH_END
    PH_BEGIN
        convert_layer_weights(args, F, 0);
        ln_pass(F, false, nullptr, nullptr, MOD, nullptr, INP(I_X), INP(I_CTX));
    PH_END

    for (int s = 0; s < 6; ++s) {
        const int l = s / 3, j = s - 3 * l;
        if (j != 1) {
            const int f = j >> 1;
            PH_BEGIN
                const int lat = (l == 1 && j == 2); pg8::Gemm g{D, D, D}; pg8::StaticOrder S; S.init(lat ? 64 : NPAN, N13 / 256, F.G, (int)blockIdx.x, HM, D, (const bf16_t*)(WGT + W_13) + (size_t)f * N13 * D, D, D, lat);
                EpiSwiGLU E{PROJ};
                pg8::gemm_phase<EpiSwiGLU, pg8::StaticOrder>(F.lds + RING_OFF, g, S, E, F.tid);
            PH_END
        } else {
            PH_BEGIN
                pg8::Gemm g{D, D, D}; pg8::StaticOrder S;
                if (l == 0) S.init(NPAN, LDP / 256, F.G, (int)blockIdx.x, HM, D, (const bf16_t*)(WGT + W_IN), D, D);
                else { S.init(64, LDP / 256, F.G, (int)blockIdx.x, HM, D, (const bf16_t*)(WGT + W_IN), D, D, 1, 80); S.cproj = 1; }
                EpiProj E{PROJ, (float*)(ws + WS_DT), ROPEC, ROPES, (bf16_t*)(ws + WS_O), (unsigned*)(ws + WS_KM) + l * 512};
                pg8::gemm_phase<EpiProj, pg8::StaticOrder>(F.lds + RING_OFF, g, S, E, F.tid);
                { const int nfull = ((l == 0 ? NPAN * (LDP / 256) : 64 * (LDP / 256) + 80)) % F.G;
                  if ((int)blockIdx.x >= nfull) { const int nw = (F.G - nfull) * NWAVES; for (int t = ((int)blockIdx.x - nfull) * NWAVES + F.wave; t < R / 32; t += nw) dt_tile(F, l, t); } }
            PH_END
            PH_BEGIN
                ssd_conv_pass(args, F, l);
                asm volatile("" : "+v"(F.tid));
                { pg8::Gemm g{256, 256, 256}; S5AOrder S{F.G, (int)blockIdx.x, (const char*)(ws + WS_O), (const char*)(ws + WS_S5M)};
                  EpiS5A E{(unsigned char*)(ws + WS_YS), (bf16_t*)(ws + WS_S5ST)};
                  pg8::gemm_phase<EpiS5A, S5AOrder>(F.lds + RING_OFF, g, S, E, F.tid); }
            PH_END
            PH_BEGIN
                if (F.wave < 2) s5_carry(F, (int)blockIdx.x * 2 + F.wave);
                ssd_chain_fast(args, F, l, (int)blockIdx.x);
                {
                    const float lam_init = 0.8f - 0.6f * expf(-0.3f * (float)l);
                    const float* lv = INP(I_ALAM) + l * 256;
                    const float s01 = wave_sum(lv[F.lane] * lv[64 + F.lane], F.lane), s23 = wave_sum(lv[128 + F.lane] * lv[192 + F.lane], F.lane);
                    const float lam = expf(s01) - expf(s23) + lam_init;
                    for (int i = 0;; ++i) { const int idx = i * F.G + F.vcu; if (idx >= 512 + (l == 0 ? 32 : 0)) break;
                        int b, h, q0, seq;
                        if (idx < 512) { b = idx >> 7; h = (idx >> 4) & 7; q0 = b * RB + CTX + (idx & 15) * 256; seq = RB; }
                        else { const int k = idx - 512; b = k >> 3; h = k & 7; q0 = b * RB; seq = CTX; }
                        const bf16_t* Q0 = PROJ + (size_t)q0 * LDP + PQ + h * 128; const bf16_t* Kh = PROJ + (size_t)(b * RB) * LDP + PK + h * 128; const bf16_t* Vh = PROJ + (size_t)(b * RB) * LDP + PV + h * 128;
                        attn128::unit((const attn128::bf16*)Q0, (const attn128::bf16*)Kh, (const attn128::bf16*)Vh, PROJ + (size_t)q0 * LDP + PQ + h * 128, seq, (char*)lds_raw + RING_OFF, F.tid, lam, 1.0f - lam_init, INP(I_ASUB) + l * 128, (const float*)(ws + WS_KM) + l * 512 + (b * 8 + h) * 16);
                    }
                }
            PH_END
            PH_BEGIN
                mixer_finalize(args, F, l);
                asm volatile("" : "+v"(F.tid));
                { pg8::Gemm g{256, 256, 256}; S5COrder S{F.G, (int)blockIdx.x, (const char*)(ws + WS_S5H), (const char*)((bf16_t*)(ws + WS_S5M) + (size_t)64 * 512 * 256)};
                  EpiS5C E{(const unsigned char*)(ws + WS_YS), PROJ};
                  pg8::gemm_phase<EpiS5C, S5COrder>(F.lds + RING_OFF, g, S, E, F.tid); }
            PH_END
            PH_BEGIN
                pg8::Gemm g{LDP, 1024, 1024}; pg8::StaticOrder S; S.init(l == 1 ? 64 : NPAN, 4, F.G, (int)blockIdx.x, PROJ + PU, LDP, (const bf16_t*)(WGT + W_GLU), 1024, 1024, l == 1);
                EpiGlu E{PROJ, INP(I_GLUB) + l * 1024};
                pg8::gemm_phase<EpiGlu, pg8::StaticOrder>(F.lds + RING_OFF, g, S, E, F.tid);
            PH_END
            PH_BEGIN
                pg8::Gemm g{LDP, 3072, 3072}; pg8::StaticOrder S; S.init(l == 1 ? 64 : NPAN, 8, F.G, (int)blockIdx.x, PROJ, LDP, (const bf16_t*)(WGT + W_B), 3072, 3072, l == 1);
                EpiMerge E{PROJ, HM};
                pg8::gemm_phase<EpiMerge, pg8::StaticOrder, 0, true>(F.lds + RING_OFF, g, S, E, F.tid);
            PH_END
        }
        PH_BEGIN
            const int RK = (j == 1) ? D : DFF; const bf16_t* RA = (j == 1) ? HM : PROJ; const bf16_t* RBt = (j == 1) ? (const bf16_t*)(WGT + W_O) : (const bf16_t*)(WGT + W_2) + (size_t)(j >> 1) * D * DFF;
            const int lat = (l == 1 && j >= 1); pg8::Gemm g{RK, RK, RK}; pg8::StaticOrder S; S.init(64, D / 256, F.G, (int)blockIdx.x, RA, RK, RBt, RK, RK, 1, lat ? 0 : 128);
            const float* lg_ = (s == 0) ? (const float*)(ws + WS_IDENT) : INP(I_LNG) + (size_t)(s - 1) * D; const float* lb_ = (s == 0) ? (const float*)(ws + WS_IDENT) + 2048 : INP(I_LNB) + (size_t)(s - 1) * D;
            EpiResid E{(_Float16*)(ws + WS_H), (float*)(ws + WS_HC), MOD + (size_t)l * 5 * NMOD + (3 * j + 2) * D, lg_, lb_, (const float*)(ws + WS_STATS)};
            pg8::gemm_phase<EpiResid, pg8::StaticOrder>(F.lds + RING_OFF, g, S, E, F.tid);
        PH_END
        PH_BEGIN
            const bool fin = (s == 5);
            const int ln_ = (j == 2) ? l + 1 : l, jn = (j == 2) ? 0 : j + 1;
            ln_pass(F, true, INP(I_LNG) + (size_t)(l * 3 + j) * D, INP(I_LNB) + (size_t)(l * 3 + j) * D, fin ? nullptr : MOD + (size_t)ln_ * 5 * NMOD + 3 * jn * D, fin ? args.out : nullptr, nullptr, nullptr, (l == 1 && j >= 1) ? 0 : 4, l == 1 && j >= 1  );
            if (s == 2) { s5_setup(args, F, 1); __syncthreads(); convert_layer_weights(args, F, 1); }
        PH_END
    }
#undef PH_BEGIN
#undef PH_END
}

static int count_phases() { int n = 2; for (int s = 0; s < 6; ++s) n += ((s % 3) != 1 ? 1 : 6) + 2; return n; }
extern "C" void kernel_launch(void* const* d_in, const int* in_sizes, int n_in, void* d_out, int out_size, void* d_ws, size_t ws_size, hipStream_t stream) {
    static int grid = 0;
    if (grid == 0) {
        if (n_in != 32 || out_size != NB * SEQ * D || ws_size < WS_END) { fprintf(stderr, "kernel_launch: unexpected shapes (n_in %d, out %d, ws %zu < %zu)\n", n_in, out_size, ws_size, (size_t)WS_END); grid = -1; return; }
        int dev = 0, cus = 0, per_cu = 0;
        if (hipGetDevice(&dev) != hipSuccess || hipDeviceGetAttribute(&cus, hipDeviceAttributeMultiprocessorCount, dev) != hipSuccess) { grid = -1; return; }
        if (hipFuncSetAttribute((const void*)trunk_fwd, hipFuncAttributeMaxDynamicSharedMemorySize, LDS_BYTES) != hipSuccess) { fprintf(stderr, "kernel_launch: hipFuncSetAttribute failed\n"); grid = -1; return; }
        if (hipOccupancyMaxActiveBlocksPerMultiprocessor(&per_cu, (const void*)trunk_fwd, NWAVES * 64, LDS_BYTES) != hipSuccess || per_cu < 1) fprintf(stderr, "kernel_launch: occupancy query says %d\n", per_cu);
        (void)hipGetLastError();
        if (cus != 256) { fprintf(stderr, "kernel_launch: this kernel deals its SSD chains / carries / attention units over exactly 256 workgroups (one per CU); device reports %d CUs; nothing launched\n", cus); grid = -1; return; }
        grid = cus;
    }
    if (grid < 0) return;
    (void)in_sizes;
    if (hipMemsetAsync((char*)d_ws + WS_CTL, 0, 2 * MiB  , stream) != hipSuccess) return;
    Args a{};
    for (int i = 0; i < 32; ++i) a.in[i] = (const float*)d_in[i];
    a.out = (float*)d_out; a.ws = (unsigned char*)d_ws;
    const int nph = count_phases();
#if MK_PER_PHASE
    for (int p = 0; p < nph; ++p) { a.ph_lo = p; a.ph_hi = p + 1; hipLaunchKernelGGL(trunk_fwd, dim3(grid), dim3(NWAVES * 64), LDS_BYTES, stream, a); }
#else
    a.ph_lo = 0; a.ph_hi = nph;
    hipLaunchKernelGGL(trunk_fwd, dim3(grid), dim3(NWAVES * 64), LDS_BYTES, stream, a);
#endif
    const hipError_t le = hipPeekAtLastError();
    if (le != hipSuccess) fprintf(stderr, "kernel_launch: launch failed: %s\n", hipGetErrorName(le));
}
```
